# Optimizing an MI355X kernel written in HIP

```python
import jax, jax.numpy as jnp
from jax import lax
import numpy as np

D_MODEL = 1024
BATCH = 8
SEQ = 4096
DEPTH = 4

GRID_W = 64
Q_BLOCK = 128
ROPE_THETA = 10000.0
EPS = 1e-6
N_HEADS_A = 8
N_KV_A = 2
GROUP_A = N_HEADS_A // N_KV_A
HEAD_DIM_A = 64
WIDTH_A = N_HEADS_A * HEAD_DIM_A
N_HEADS_B = 8
Q_LORA = 384
KV_LORA = 256
QK_NOPE = 64
QK_ROPE = 32
V_DIM_B = 64
WIDTH_B = N_HEADS_B * V_DIM_B
IN_SIZES = (WIDTH_A, N_KV_A * HEAD_DIM_A, N_KV_A * HEAD_DIM_A, Q_LORA, KV_LORA, QK_ROPE, D_MODEL, D_MODEL)
IN_COLS = sum(IN_SIZES)
N_MOD = 6
N_EXPERTS = 16
N_GROUPS = 4
EXPERTS_PER_GROUP = N_EXPERTS // N_GROUPS
TOP_K = 2
D_EXPERT = 512
MOE_BLOCK = 128

kernel_name = "hybrid_gqa_mla_grouped_moe_encoder"


def rms_norm(x, g):
    xf = x.astype(jnp.float32)
    y = xf * lax.rsqrt(jnp.mean(xf * xf, axis=-1, keepdims=True) + EPS)
    return (y * g.astype(jnp.float32)).astype(x.dtype)


def split_points(sizes):
    pts, acc = [], 0
    for s in sizes[:-1]:
        acc += s
        pts.append(acc)
    return pts


def axial_rope_tables(row, col, rot_dim):
    n = rot_dim // 4
    inv = 1.0 / (ROPE_THETA ** (jnp.arange(n, dtype=jnp.float32) / n))
    ang = jnp.concatenate([row[:, None] * inv, col[:, None] * inv], axis=-1)
    return jnp.cos(ang), jnp.sin(ang)


def apply_rope(x, cos, sin):
    half = x.shape[-1] // 2
    shape = (cos.shape[0],) + (1,) * (x.ndim - 3) + (half,)
    c = cos.reshape(shape).astype(x.dtype)
    s = sin.reshape(shape).astype(x.dtype)
    x1, x2 = x[..., :half], x[..., half:]
    return jnp.concatenate([x1 * c - x2 * s, x2 * c + x1 * s], axis=-1)


def gqa_attention(q, k, v):
    B, S, H, hd = q.shape
    nb = S // Q_BLOCK
    qb = q.reshape(B, nb, Q_BLOCK, N_KV_A, GROUP_A, hd).transpose(1, 0, 2, 3, 4, 5)
    scale = hd ** -0.5

    def block(qi):
        s = jnp.einsum('bqkgd,bskd->bkgqs', qi, k).astype(jnp.float32) * scale
        p = jax.nn.softmax(s, axis=-1).astype(v.dtype)
        return jnp.einsum('bkgqs,bskd->bqkgd', p, v)

    o = lax.map(block, qb)
    return o.transpose(1, 0, 2, 3, 4, 5).reshape(B, S, H * hd)


def mla_attention(q_nope, q_rope, k_nope, k_rope, v):
    B, S, H, dn = q_nope.shape
    dr = q_rope.shape[-1]
    nb = S // Q_BLOCK
    qn = q_nope.reshape(B, nb, Q_BLOCK, H, dn).swapaxes(0, 1)
    qr = q_rope.reshape(B, nb, Q_BLOCK, H, dr).swapaxes(0, 1)
    scale = (dn + dr) ** -0.5

    def block(args):
        qn_i, qr_i = args
        s = (jnp.einsum('bqhd,bshd->bhqs', qn_i, k_nope)
             + jnp.einsum('bqhr,bsr->bhqs', qr_i, k_rope)).astype(jnp.float32) * scale
        p = jax.nn.softmax(s, axis=-1).astype(v.dtype)
        return jnp.einsum('bhqs,bshd->bqhd', p, v)

    o = lax.map(block, (qn, qr))
    return o.swapaxes(0, 1).reshape(B, S, H * v.shape[-1])


def hybrid_mixer(h, w_in, q_norm_a, k_norm_a, q_a_norm, kv_norm, w_q_b, w_kv_b,
                 w_proj_a, w_proj_b, w_o, cos_a, sin_a, cos_b, sin_b):
    B, S, _ = h.shape
    z = h @ w_in
    q_a, k_a, v_a, q_lat, kv_lat, k_rope, gate_a, gate_b = jnp.split(z, split_points(IN_SIZES), axis=-1)

    qa = apply_rope(rms_norm(q_a.reshape(B, S, N_HEADS_A, HEAD_DIM_A), q_norm_a), cos_a, sin_a)
    ka = apply_rope(rms_norm(k_a.reshape(B, S, N_KV_A, HEAD_DIM_A), k_norm_a), cos_a, sin_a)
    va = v_a.reshape(B, S, N_KV_A, HEAD_DIM_A)
    y_a = gqa_attention(qa, ka, va) @ w_proj_a

    qb = (rms_norm(q_lat, q_a_norm) @ w_q_b).reshape(B, S, N_HEADS_B, QK_NOPE + QK_ROPE)
    qb_nope = qb[..., :QK_NOPE]
    qb_rope = apply_rope(qb[..., QK_NOPE:], cos_b, sin_b)
    kv = (rms_norm(kv_lat, kv_norm) @ w_kv_b).reshape(B, S, N_HEADS_B, QK_NOPE + V_DIM_B)
    k_nope, v_b = kv[..., :QK_NOPE], kv[..., QK_NOPE:]
    k_r = apply_rope(k_rope, cos_b, sin_b)
    y_b = mla_attention(qb_nope, qb_rope, k_nope, k_r, v_b) @ w_proj_b

    merged = jax.nn.sigmoid(gate_a) * y_a + jax.nn.sigmoid(gate_b) * y_b
    return merged @ w_o


def grouped_moe(h, w_router, router_bias, w1, w3, w2):
    T, D = h.shape
    scores = jax.nn.sigmoid((h @ w_router).astype(jnp.float32))
    biased = scores + router_bias.astype(jnp.float32)
    grp_score = lax.top_k(biased.reshape(T, N_GROUPS, EXPERTS_PER_GROUP), 2)[0].sum(-1)
    g_sel = jnp.argmax(grp_score, axis=-1)
    expert_group = jnp.arange(N_EXPERTS) // EXPERTS_PER_GROUP
    masked = jnp.where(expert_group[None, :] == g_sel[:, None], biased, -jnp.inf)
    _, expert = lax.top_k(masked, TOP_K)
    gw = jnp.take_along_axis(scores, expert, axis=1)
    gw = gw / jnp.sum(gw, axis=-1, keepdims=True)

    n_slots = T * TOP_K
    e_flat = expert.reshape(-1)
    tok_flat = jnp.repeat(jnp.arange(T), TOP_K)
    order = jnp.argsort(e_flat)
    e_sorted = e_flat[order]
    tok_sorted = tok_flat[order]
    g_sorted = gw.reshape(-1)[order]
    counts = jnp.bincount(e_flat, length=N_EXPERTS)
    padded = ((counts + MOE_BLOCK - 1) // MOE_BLOCK) * MOE_BLOCK
    starts = jnp.cumsum(counts) - counts
    pends = jnp.cumsum(padded)
    pstarts = pends - padded
    dest = pstarts[e_sorted] + (jnp.arange(n_slots) - starts[e_sorted])
    n_pad = ((n_slots + MOE_BLOCK - 1) // MOE_BLOCK) * MOE_BLOCK + N_EXPERTS * MOE_BLOCK
    n_blk = n_pad // MOE_BLOCK
    xs = jnp.zeros((n_pad, D), h.dtype).at[dest].set(h[tok_sorted])
    blk_e = jnp.clip(jnp.searchsorted(pends, jnp.arange(n_blk) * MOE_BLOCK, side='right'), 0, N_EXPERTS - 1)

    def expert_block(args):
        xb, e = args
        return (jax.nn.silu(xb @ w1[e]) * (xb @ w3[e])) @ w2[e]

    ys = lax.map(expert_block, (xs.reshape(n_blk, MOE_BLOCK, D), blk_e)).reshape(n_pad, D)
    return jnp.zeros((T, D), h.dtype).at[tok_sorted].add(ys[dest] * g_sorted[:, None].astype(h.dtype))


def setup_inputs(seed: int = 0) -> dict:
    key = jax.random.key(seed)
    ks = jax.random.split(key, 22)
    f32 = jnp.float32
    nrm = lambda k, shape, s: jax.random.normal(k, shape, f32) * s
    gain = lambda k, shape: 1.0 + 0.01 * jax.random.normal(k, shape, f32)
    return {
        "x": nrm(ks[0], (BATCH, SEQ, D_MODEL), 1.0),
        "c": nrm(ks[1], (BATCH, D_MODEL), 1.0),
        "w_ada": nrm(ks[2], (DEPTH, D_MODEL, N_MOD * D_MODEL), 0.5 * D_MODEL ** -0.5),
        "b_ada": nrm(ks[3], (DEPTH, N_MOD * D_MODEL), 0.01),
        "norm1": gain(ks[4], (DEPTH, D_MODEL)),
        "w_in": nrm(ks[5], (DEPTH, D_MODEL, IN_COLS), D_MODEL ** -0.5),
        "q_norm_a": gain(ks[6], (DEPTH, HEAD_DIM_A)),
        "k_norm_a": gain(ks[7], (DEPTH, HEAD_DIM_A)),
        "q_a_norm": gain(ks[8], (DEPTH, Q_LORA)),
        "kv_norm": gain(ks[9], (DEPTH, KV_LORA)),
        "w_q_b": nrm(ks[10], (DEPTH, Q_LORA, N_HEADS_B * (QK_NOPE + QK_ROPE)), Q_LORA ** -0.5),
        "w_kv_b": nrm(ks[11], (DEPTH, KV_LORA, N_HEADS_B * (QK_NOPE + V_DIM_B)), KV_LORA ** -0.5),
        "w_proj_a": nrm(ks[12], (DEPTH, WIDTH_A, D_MODEL), WIDTH_A ** -0.5),
        "w_proj_b": nrm(ks[13], (DEPTH, WIDTH_B, D_MODEL), WIDTH_B ** -0.5),
        "w_o": nrm(ks[14], (DEPTH, D_MODEL, D_MODEL), D_MODEL ** -0.5),
        "norm2": gain(ks[15], (DEPTH, D_MODEL)),
        "w_router": nrm(ks[16], (D_MODEL, N_EXPERTS), D_MODEL ** -0.5),
        "router_bias": nrm(ks[17], (N_EXPERTS,), 0.01),
        "w1": nrm(ks[18], (DEPTH, N_EXPERTS, D_MODEL, D_EXPERT), D_MODEL ** -0.5),
        "w3": nrm(ks[19], (DEPTH, N_EXPERTS, D_MODEL, D_EXPERT), D_MODEL ** -0.5),
        "w2": nrm(ks[20], (DEPTH, N_EXPERTS, D_EXPERT, D_MODEL), D_EXPERT ** -0.5),
        "norm_f": gain(ks[21], (D_MODEL,)),
    }


def reference(x, c, w_ada, b_ada, norm1, w_in, q_norm_a, k_norm_a, q_a_norm, kv_norm,
              w_q_b, w_kv_b, w_proj_a, w_proj_b, w_o, norm2, w_router, router_bias,
              w1, w3, w2, norm_f):
    B, S, D = x.shape
    rows = S // GRID_W
    row = jnp.broadcast_to(jnp.arange(rows, dtype=jnp.float32)[:, None], (rows, GRID_W)).reshape(S)
    col = jnp.broadcast_to(jnp.arange(GRID_W, dtype=jnp.float32)[None, :], (rows, GRID_W)).reshape(S)
    cos_a, sin_a = axial_rope_tables(row, col, HEAD_DIM_A)
    cos_b, sin_b = axial_rope_tables(row, col, QK_ROPE)
    cond = jax.nn.silu(c)

    for l in range(DEPTH):
        mod = (cond @ w_ada[l] + b_ada[l])[:, None, :]
        sh1, sc1, g1, sh2, sc2, g2 = jnp.split(mod, N_MOD, axis=-1)
        h = rms_norm(x, norm1[l]) * (1.0 + sc1) + sh1
        x = x + g1 * hybrid_mixer(h, w_in[l], q_norm_a[l], k_norm_a[l], q_a_norm[l], kv_norm[l],
                                  w_q_b[l], w_kv_b[l], w_proj_a[l], w_proj_b[l], w_o[l],
                                  cos_a, sin_a, cos_b, sin_b)
        h = rms_norm(x, norm2[l]) * (1.0 + sc2) + sh2
        x = x + g2 * grouped_moe(h.reshape(B * S, D), w_router, router_bias,
                                 w1[l], w3[l], w2[l]).reshape(B, S, D)

    return rms_norm(x, norm_f)
```

```cpp
#include <hip/hip_runtime.h>
#include <stdint.h>
#include <math.h>

namespace nv {
constexpr int D = 1024, NB = 8, S = 4096, L = 4, INC = 3488, NE = 16, F = 512;
constexpr int TB = S;
constexpr int NSLOT = TB * 2, NPAD = NSLOT + NE * 64, NTILE = NPAD / 64;
constexpr float EPS = 1e-6f;

__device__ __forceinline__ float wsum(float v) {
#pragma unroll
    for (int o = 1; o < 64; o <<= 1) v += __shfl_xor(v, o);
    return v;
}
__device__ __forceinline__ float sigm(float v) { return 1.f / (1.f + expf(-v)); }

__global__ void __launch_bounds__(256) k_mod(const float* c, const float* w_ada, const float* b_ada, float* mod) {
    const int n = blockIdx.x * 256 + threadIdx.x, l = blockIdx.y;
    float acc[NB];
#pragma unroll
    for (int b = 0; b < NB; ++b) acc[b] = 0.f;
    const float* w = w_ada + (size_t)l * D * 6 * D;
    for (int k = 0; k < D; ++k) {
        const float wv = w[(size_t)k * 6 * D + n];
#pragma unroll
        for (int b = 0; b < NB; ++b) { const float cv = c[b * D + k]; acc[b] += (cv / (1.f + expf(-cv))) * wv; }
    }
#pragma unroll
    for (int b = 0; b < NB; ++b) mod[((size_t)l * NB + b) * 6 * D + n] = acc[b] + b_ada[(size_t)l * 6 * D + n];
}

__global__ void k_tables(float* cosA, float* sinA, float* cosB, float* sinB) {
    const int s = blockIdx.x, i = threadIdx.x;
    const float row = (float)(s / 64), col = (float)(s % 64);
    if (i < 32) { const int j = i & 15; const float inv = 1.0f / powf(10000.0f, (float)j / 16.0f); const float a = (i < 16 ? row : col) * inv; cosA[s * 32 + i] = cosf(a); sinA[s * 32 + i] = sinf(a); }
    else if (i < 48) { const int ii = i - 32, j = ii & 7; const float inv = 1.0f / powf(10000.0f, (float)j / 8.0f); const float a = (ii < 8 ? row : col) * inv; cosB[s * 16 + ii] = cosf(a); sinB[s * 16 + ii] = sinf(a); }
}

__global__ void __launch_bounds__(256) k_rmsnorm(const float* x, int xp, const float* g, const float* sc, const float* sh, float* out, int op, int W, int rows) {
    const int r = blockIdx.x * 4 + (threadIdx.x >> 6), lane = threadIdx.x & 63;
    if (r >= rows) return;
    const float* xr = x + (size_t)r * xp; float ss = 0.f;
    for (int k = lane; k < W; k += 64) ss += xr[k] * xr[k];
    ss = wsum(ss);
    const float rstd = rsqrtf(ss / (float)W + EPS);
    for (int k = lane; k < W; k += 64) { float v = xr[k] * rstd * g[k]; if (sc) v = v * (1.f + sc[k]) + sh[k]; out[(size_t)r * op + k] = v; }
}

__global__ void __launch_bounds__(256) k_gemm(const float* A, int lda, const float* Bm, int ldb, float* C, int ldc, int M, int N, int K) {
    __shared__ float As[16][68]; __shared__ float Bs[16][68];
    const int tx = threadIdx.x & 15, ty = threadIdx.x >> 4, row0 = blockIdx.y * 64, col0 = blockIdx.x * 64;
    float acc[4][4];
#pragma unroll
    for (int i = 0; i < 4; ++i)
#pragma unroll
        for (int j = 0; j < 4; ++j) acc[i][j] = 0.f;
    for (int k0 = 0; k0 < K; k0 += 16) {
#pragma unroll
        for (int i = 0; i < 4; ++i) { const int e = threadIdx.x + i * 256, r = e >> 4, c = e & 15, gr = row0 + r; As[c][r] = gr < M ? A[(size_t)gr * lda + k0 + c] : 0.f; }
#pragma unroll
        for (int i = 0; i < 4; ++i) { const int e = threadIdx.x + i * 256, r = e >> 6, c = e & 63, gc = col0 + c; Bs[r][c] = gc < N ? Bm[(size_t)(k0 + r) * ldb + gc] : 0.f; }
        __syncthreads();
#pragma unroll
        for (int k = 0; k < 16; ++k) { float a[4], b[4];
#pragma unroll
            for (int i = 0; i < 4; ++i) { a[i] = As[k][ty * 4 + i]; b[i] = Bs[k][tx * 4 + i]; }
#pragma unroll
            for (int i = 0; i < 4; ++i)
#pragma unroll
                for (int j = 0; j < 4; ++j) acc[i][j] += a[i] * b[j]; }
        __syncthreads();
    }
#pragma unroll
    for (int i = 0; i < 4; ++i)
#pragma unroll
        for (int j = 0; j < 4; ++j) { const int gr = row0 + ty * 4 + i, gc = col0 + tx * 4 + j; if (gr < M && gc < N) C[(size_t)gr * ldc + gc] = acc[i][j]; }
}

__global__ void __launch_bounds__(256) k_gemm_moe(const float* A, int lda, const int* arow, const float* Bbase, size_t strideB, int ldb, float* C, int ldc, const int* tile_e, int N, int K) {
    __shared__ float As[16][68]; __shared__ float Bs[16][68];
    const int e = tile_e[blockIdx.y]; if (e < 0) return;
    const float* Bm = Bbase + (size_t)e * strideB;
    const int tx = threadIdx.x & 15, ty = threadIdx.x >> 4, row0 = blockIdx.y * 64, col0 = blockIdx.x * 64;
    float acc[4][4];
#pragma unroll
    for (int i = 0; i < 4; ++i)
#pragma unroll
        for (int j = 0; j < 4; ++j) acc[i][j] = 0.f;
    for (int k0 = 0; k0 < K; k0 += 16) {
#pragma unroll
        for (int i = 0; i < 4; ++i) { const int ee = threadIdx.x + i * 256, r = ee >> 4, c = ee & 15; int gr = row0 + r; if (arow) gr = arow[gr]; As[c][r] = gr >= 0 ? A[(size_t)gr * lda + k0 + c] : 0.f; }
#pragma unroll
        for (int i = 0; i < 4; ++i) { const int ee = threadIdx.x + i * 256, r = ee >> 6, c = ee & 63; Bs[r][c] = Bm[(size_t)(k0 + r) * ldb + col0 + c]; }
        __syncthreads();
#pragma unroll
        for (int k = 0; k < 16; ++k) { float a[4], b[4];
#pragma unroll
            for (int i = 0; i < 4; ++i) { a[i] = As[k][ty * 4 + i]; b[i] = Bs[k][tx * 4 + i]; }
#pragma unroll
            for (int i = 0; i < 4; ++i)
#pragma unroll
                for (int j = 0; j < 4; ++j) acc[i][j] += a[i] * b[j]; }
        __syncthreads();
    }
#pragma unroll
    for (int i = 0; i < 4; ++i)
#pragma unroll
        for (int j = 0; j < 4; ++j) C[(size_t)(row0 + ty * 4 + i) * ldc + col0 + tx * 4 + j] = acc[i][j];
}

__global__ void __launch_bounds__(64) k_qknorm_rope(const float* in, int ip, const float* g, const float* cosA, const float* sinA, float* out, int op, int nh) {
    const int t = blockIdx.x / nh, h = blockIdx.x % nh, i = threadIdx.x;
    const float v = in[(size_t)t * ip + h * 64 + i];
    const float ss = wsum(v * v);
    const float y = v * rsqrtf(ss / 64.f + EPS) * g[i];
    const float other = __shfl_xor(y, 32);
    const int a = i & 31; const float c = cosA[t * 32 + a], s = sinA[t * 32 + a];
    out[(size_t)t * op + h * 64 + i] = (i < 32) ? (y * c - other * s) : (y * c + other * s);
}
__global__ void __launch_bounds__(64) k_rope32(float* buf, int p, int hs, int nh, const float* cosB, const float* sinB) {
    const int t = blockIdx.x / nh, h = blockIdx.x % nh, i = threadIdx.x & 31;
    if (threadIdx.x >= 32) return;
    float* ptr = buf + (size_t)t * p + h * hs;
    const float y = ptr[i]; const float other = __shfl_xor(y, 16);
    const int a = i & 15; const float c = cosB[t * 16 + a], s = sinB[t * 16 + a];
    ptr[i] = (i < 16) ? (y * c - other * s) : (y * c + other * s);
}

template <int DN, int DR, int DV>
__global__ void __launch_bounds__(128) k_attn(const float* Q, int qp, const float* K1, int k1p, int k1hs, const float* K2, int k2p, const float* V, int vp, int vhs, float* O, int op, float scale, int group) {
    constexpr int DQK = DN + DR;
    __shared__ float Ks[32][DQK]; __shared__ float Vs[32][DV];
    const int h = blockIdx.y, kvh = h / group, s = blockIdx.x * 128 + threadIdx.x, tid = threadIdx.x;
    float q[DQK], o[DV];
#pragma unroll
    for (int d = 0; d < DQK; ++d) q[d] = Q[(size_t)s * qp + h * DQK + d] * scale;
#pragma unroll
    for (int d = 0; d < DV; ++d) o[d] = 0.f;
    float m = -INFINITY, l = 0.f;
    for (int kt = 0; kt < S; kt += 32) {
        __syncthreads();
        for (int e = tid; e < 32 * DQK; e += 128) { const int kk = e / DQK, d = e % DQK; Ks[kk][d] = d < DN ? K1[(size_t)(kt + kk) * k1p + kvh * k1hs + d] : K2[(size_t)(kt + kk) * k2p + (d - DN)]; }
        for (int e = tid; e < 32 * DV; e += 128) { const int kk = e / DV, d = e % DV; Vs[kk][d] = V[(size_t)(kt + kk) * vp + kvh * vhs + d]; }
        __syncthreads();
        for (int kk = 0; kk < 32; ++kk) {
            float sc = 0.f;
#pragma unroll
            for (int d = 0; d < DQK; ++d) sc += q[d] * Ks[kk][d];
            if (sc > m) { const float a = expf(m - sc); l *= a;
#pragma unroll
                for (int d = 0; d < DV; ++d) o[d] *= a;
                m = sc; }
            const float p = expf(sc - m); l += p;
#pragma unroll
            for (int d = 0; d < DV; ++d) o[d] += p * Vs[kk][d];
        }
    }
    const float il = 1.f / l;
#pragma unroll
    for (int d = 0; d < DV; ++d) O[(size_t)s * op + h * DV + d] = o[d] * il;
}

__global__ void __launch_bounds__(256) k_merge(const float* z, const float* ya, const float* yb, float* merged) {
    const size_t i = (size_t)blockIdx.x * 256 + threadIdx.x; const int t = (int)(i / D), d = (int)(i % D);
    merged[i] = sigm(z[(size_t)t * INC + 1440 + d]) * ya[i] + sigm(z[(size_t)t * INC + 2464 + d]) * yb[i];
}
__global__ void __launch_bounds__(256) k_resid(float* x, const float* g, const float* v) {
    const size_t i = (size_t)blockIdx.x * 256 + threadIdx.x; const int d = (int)(i % D);
    x[i] += g[d] * v[i];
}

__global__ void __launch_bounds__(256) k_router(const float* h2, const float* wr, const float* rb, int* eid, float* gwt, int* cnt) {
    const int t = blockIdx.x * 4 + (threadIdx.x >> 6), lane = threadIdx.x & 63;
    float acc[NE];
#pragma unroll
    for (int e = 0; e < NE; ++e) acc[e] = 0.f;
    for (int k = lane; k < D; k += 64) { const float hv = h2[(size_t)t * D + k];
#pragma unroll
        for (int e = 0; e < NE; ++e) acc[e] += hv * wr[k * NE + e]; }
#pragma unroll
    for (int e = 0; e < NE; ++e) acc[e] = wsum(acc[e]);
    if (lane == 0) {
        float sc[NE], bi[NE];
#pragma unroll
        for (int e = 0; e < NE; ++e) { sc[e] = sigm(acc[e]); bi[e] = sc[e] + rb[e]; }
        int gsel = 0; float gbest = -INFINITY;
#pragma unroll
        for (int g = 0; g < 4; ++g) { float m1 = -INFINITY, m2 = -INFINITY;
#pragma unroll
            for (int j = 0; j < 4; ++j) { const float v = bi[g * 4 + j]; if (v > m1) { m2 = m1; m1 = v; } else if (v > m2) m2 = v; }
            const float gs = m1 + m2; if (gs > gbest) { gbest = gs; gsel = g; } }
        int e1 = -1, e2 = -1; float b1 = -INFINITY, b2 = -INFINITY;
#pragma unroll
        for (int j = 0; j < 4; ++j) { float v = -INFINITY;
#pragma unroll
            for (int g = 0; g < 4; ++g) if (g == gsel) v = bi[g * 4 + j];
            const int e = gsel * 4 + j;
            if (v > b1) { b2 = b1; e2 = e1; b1 = v; e1 = e; } else if (v > b2) { b2 = v; e2 = e; } }
        float s1 = 0.f, s2 = 0.f;
#pragma unroll
        for (int e = 0; e < NE; ++e) { if (e == e1) s1 = sc[e]; if (e == e2) s2 = sc[e]; }
        const float inv = 1.f / (s1 + s2);
        eid[t * 2] = e1; eid[t * 2 + 1] = e2; gwt[t * 2] = s1 * inv; gwt[t * 2 + 1] = s2 * inv;
        atomicAdd(&cnt[e1], 1); atomicAdd(&cnt[e2], 1);
    }
}
__global__ void k_prefix(const int* cnt, int* pstart, int* tile_e) {
    if (threadIdx.x != 0 || blockIdx.x != 0) return;
    int acc = 0;
    for (int e = 0; e < NE; ++e) { pstart[e] = acc * 64; const int nt = (cnt[e] + 63) / 64; for (int i = 0; i < nt; ++i) tile_e[acc + i] = e; acc += nt; }
    for (int i = acc; i < NTILE; ++i) tile_e[i] = -1;
}
__global__ void __launch_bounds__(256) k_assign(const int* eid, const int* pstart, int* cnt2, int* arow, int* slot_of) {
    const int t = blockIdx.x * 256 + threadIdx.x;
    for (int k = 0; k < 2; ++k) { const int e = eid[t * 2 + k]; const int pos = atomicAdd(&cnt2[e], 1); const int slot = pstart[e] + pos; arow[slot] = t; slot_of[t * 2 + k] = slot; }
}
__global__ void __launch_bounds__(256) k_swiglu(const float* U1, const float* U3, float* U) {
    const size_t i = (size_t)blockIdx.x * 256 + threadIdx.x;
    const float a = U1[i]; U[i] = (a / (1.f + expf(-a))) * U3[i];
}
__global__ void __launch_bounds__(256) k_combine(float* x, const float* g2, const float* Y, const int* slot_of, const float* gwt) {
    const size_t i = (size_t)blockIdx.x * 256 + threadIdx.x; const int t = (int)(i / D), d = (int)(i % D);
    const int s0 = slot_of[t * 2], s1 = slot_of[t * 2 + 1];
    x[i] += g2[d] * (gwt[t * 2] * Y[(size_t)s0 * D + d] + gwt[t * 2 + 1] * Y[(size_t)s1 * D + d]);
}
}

extern "C" void kernel_launch(void* const* d_in, const int* in_sizes, int n_in, void* d_out, int out_size, void* d_ws, size_t ws_size, hipStream_t stream) {
    using namespace nv;
    const float* x = (const float*)d_in[0]; const float* c = (const float*)d_in[1]; const float* w_ada = (const float*)d_in[2]; const float* b_ada = (const float*)d_in[3];
    const float* norm1 = (const float*)d_in[4]; const float* w_in = (const float*)d_in[5]; const float* q_norm_a = (const float*)d_in[6]; const float* k_norm_a = (const float*)d_in[7];
    const float* q_a_norm = (const float*)d_in[8]; const float* kv_norm = (const float*)d_in[9]; const float* w_q_b = (const float*)d_in[10]; const float* w_kv_b = (const float*)d_in[11];
    const float* w_proj_a = (const float*)d_in[12]; const float* w_proj_b = (const float*)d_in[13]; const float* w_o = (const float*)d_in[14]; const float* norm2 = (const float*)d_in[15];
    const float* w_router = (const float*)d_in[16]; const float* router_bias = (const float*)d_in[17]; const float* w1 = (const float*)d_in[18]; const float* w3 = (const float*)d_in[19];
    const float* w2 = (const float*)d_in[20]; const float* norm_f = (const float*)d_in[21];
    float* xr = (float*)d_out;
    char* ws = (char*)d_ws; size_t off = 0;
    auto alloc = [&](size_t bytes) { void* p = ws + off; off += (bytes + 255) & ~(size_t)255; return p; };
    float* mod = (float*)alloc((size_t)L * NB * 6 * D * 4);
    float* cosA = (float*)alloc(S * 32 * 4); float* sinA = (float*)alloc(S * 32 * 4); float* cosB = (float*)alloc(S * 16 * 4); float* sinB = (float*)alloc(S * 16 * 4);
    float* h = (float*)alloc((size_t)TB * D * 4);
    float* z = (float*)alloc((size_t)TB * INC * 4);
    float* qa = (float*)alloc((size_t)TB * 512 * 4); float* ka = (float*)alloc((size_t)TB * 128 * 4); float* oa = (float*)alloc((size_t)TB * 512 * 4);
    float* ya = (float*)alloc((size_t)TB * D * 4); float* qln = (float*)alloc((size_t)TB * 384 * 4); float* qb = (float*)alloc((size_t)TB * 768 * 4);
    float* kvn = (float*)alloc((size_t)TB * 256 * 4); float* kvb = (float*)alloc((size_t)TB * 1024 * 4); float* ob = (float*)alloc((size_t)TB * 512 * 4);
    float* yb = (float*)alloc((size_t)TB * D * 4); float* merged = (float*)alloc((size_t)TB * D * 4); float* mo = (float*)alloc((size_t)TB * D * 4);
    int* eid = (int*)alloc(TB * 2 * 4); float* gwt = (float*)alloc(TB * 2 * 4); int* slot_of = (int*)alloc(TB * 2 * 4);
    int* cnt = (int*)alloc(256); int* cnt2 = cnt + 16; int* pstart = cnt + 32;
    int* tile_e = (int*)alloc(NTILE * 4); int* arow = (int*)alloc(NPAD * 4);
    float* U1 = (float*)alloc((size_t)NPAD * F * 4); float* U3 = (float*)alloc((size_t)NPAD * F * 4); float* U = (float*)alloc((size_t)NPAD * F * 4); float* Y = (float*)alloc((size_t)NPAD * D * 4);
    if (off > ws_size) return;

    hipMemcpyAsync(xr, x, (size_t)NB * S * D * 4, hipMemcpyDeviceToDevice, stream);
    k_mod<<<dim3(6 * D / 256, L), 256, 0, stream>>>(c, w_ada, b_ada, mod);
    k_tables<<<S, 64, 0, stream>>>(cosA, sinA, cosB, sinB);
    auto gemm = [&](const float* A, int lda, const float* Bm, int ldb, float* C, int ldc, int M, int N, int K) {
        k_gemm<<<dim3((N + 63) / 64, (M + 63) / 64), 256, 0, stream>>>(A, lda, Bm, ldb, C, ldc, M, N, K); };
    for (int b = 0; b < NB; ++b) {
        float* xb = xr + (size_t)b * S * D;
        for (int l = 0; l < L; ++l) {
            const float* md = mod + ((size_t)l * NB + b) * 6 * D;
            const float *sh1 = md, *sc1 = md + D, *g1 = md + 2 * D, *sh2 = md + 3 * D, *sc2 = md + 4 * D, *g2 = md + 5 * D;
            k_rmsnorm<<<TB / 4, 256, 0, stream>>>(xb, D, norm1 + l * D, sc1, sh1, h, D, D, TB);
            gemm(h, D, w_in + (size_t)l * D * INC, INC, z, INC, TB, INC, D);
            k_qknorm_rope<<<TB * 8, 64, 0, stream>>>(z, INC, q_norm_a + l * 64, cosA, sinA, qa, 512, 8);
            k_qknorm_rope<<<TB * 2, 64, 0, stream>>>(z + 512, INC, k_norm_a + l * 64, cosA, sinA, ka, 128, 2);
            k_attn<64, 0, 64><<<dim3(S / 128, 8), 128, 0, stream>>>(qa, 512, ka, 128, 64, nullptr, 0, z + 640, INC, 64, oa, 512, 0.125f, 4);
            gemm(oa, 512, w_proj_a + (size_t)l * 512 * D, D, ya, D, TB, D, 512);
            k_rmsnorm<<<TB / 4, 256, 0, stream>>>(z + 768, INC, q_a_norm + l * 384, nullptr, nullptr, qln, 384, 384, TB);
            gemm(qln, 384, w_q_b + (size_t)l * 384 * 768, 768, qb, 768, TB, 768, 384);
            k_rope32<<<TB * 8, 64, 0, stream>>>(qb + 64, 768, 96, 8, cosB, sinB);
            k_rmsnorm<<<TB / 4, 256, 0, stream>>>(z + 1152, INC, kv_norm + l * 256, nullptr, nullptr, kvn, 256, 256, TB);
            gemm(kvn, 256, w_kv_b + (size_t)l * 256 * 1024, 1024, kvb, 1024, TB, 1024, 256);
            k_rope32<<<TB, 64, 0, stream>>>(z + 1408, INC, 0, 1, cosB, sinB);
            k_attn<64, 32, 64><<<dim3(S / 128, 8), 128, 0, stream>>>(qb, 768, kvb, 1024, 128, z + 1408, INC, kvb + 64, 1024, 128, ob, 512, 0.10206207261596577f, 1);
            gemm(ob, 512, w_proj_b + (size_t)l * 512 * D, D, yb, D, TB, D, 512);
            k_merge<<<TB * D / 256, 256, 0, stream>>>(z, ya, yb, merged);
            gemm(merged, D, w_o + (size_t)l * D * D, D, mo, D, TB, D, D);
            k_resid<<<TB * D / 256, 256, 0, stream>>>(xb, g1, mo);
            k_rmsnorm<<<TB / 4, 256, 0, stream>>>(xb, D, norm2 + l * D, sc2, sh2, h, D, D, TB);
            hipMemsetAsync(cnt, 0, 256, stream);
            hipMemsetAsync(arow, 0xFF, NPAD * 4, stream);
            k_router<<<TB / 4, 256, 0, stream>>>(h, w_router, router_bias, eid, gwt, cnt);
            k_prefix<<<1, 64, 0, stream>>>(cnt, pstart, tile_e);
            k_assign<<<TB / 256, 256, 0, stream>>>(eid, pstart, cnt2, arow, slot_of);
            k_gemm_moe<<<dim3(F / 64, NTILE), 256, 0, stream>>>(h, D, arow, w1 + (size_t)l * NE * D * F, (size_t)D * F, F, U1, F, tile_e, F, D);
            k_gemm_moe<<<dim3(F / 64, NTILE), 256, 0, stream>>>(h, D, arow, w3 + (size_t)l * NE * D * F, (size_t)D * F, F, U3, F, tile_e, F, D);
            k_swiglu<<<NPAD * F / 256, 256, 0, stream>>>(U1, U3, U);
            k_gemm_moe<<<dim3(D / 64, NTILE), 256, 0, stream>>>(U, F, nullptr, w2 + (size_t)l * NE * F * D, (size_t)F * D, D, Y, D, tile_e, D, F);
            k_combine<<<TB * D / 256, 256, 0, stream>>>(xb, g2, Y, slot_of, gwt);
        }
        k_rmsnorm<<<TB / 4, 256, 0, stream>>>(xb, D, norm_f, nullptr, nullptr, xb, D, D, TB);
    }
}
```

```cpp
#include <hip/hip_runtime.h>
#include <stdint.h>
#include <stdio.h>
#include <math.h>

#ifndef FAST_GEMM
#define FAST_GEMM 0
#endif
#ifndef FAST_ATTN
#define FAST_ATTN 0
#endif
#ifndef N_LAUNCH_MODE
#define N_LAUNCH_MODE 0
#endif

#define LAS __attribute__((address_space(3)))
#define GAS __attribute__((address_space(1)))
typedef unsigned short bf16_t;
typedef short bf16x8 __attribute__((ext_vector_type(8)));
typedef float f32x4 __attribute__((ext_vector_type(4)));
typedef float f32x2 __attribute__((ext_vector_type(2)));
typedef float f32x16 __attribute__((ext_vector_type(16)));
typedef unsigned u32x4 __attribute__((ext_vector_type(4)));
typedef unsigned u32x2 __attribute__((ext_vector_type(2)));
typedef GAS unsigned gu32;

constexpr int D = 1024, NB = 8, S = 4096, T = NB * S, NL = 4, INC = 3488, NIN = 3584, NE = 16, FF = 512;
constexpr float EPS = 1e-6f, LOG2E = 1.4426950408889634f;
constexpr float QSCALE_A = 0.125f * LOG2E, QSCALE_B = 0.10206207261596577f * LOG2E;
constexpr int NWAVES = 8, NTHREADS = 512;
constexpr int NPHASE = 2 + 9 * NL;

constexpr size_t MiB = 1u << 20;
constexpr size_t WS_CTL = 0, CTL_BYTES = 1 * MiB;
constexpr size_t WS_MOD = 1 * MiB;
constexpr size_t WS_COSA = 2 * MiB, WS_SINA = WS_COSA + 512 * 1024, WS_COSB = 3 * MiB, WS_SINB = WS_COSB + 256 * 1024;
constexpr size_t WS_SSQ = 4 * MiB, WS_SSKV = 5 * MiB;
constexpr size_t WS_GW = 6 * MiB;
constexpr size_t WS_LIST = 7 * MiB;
constexpr size_t WS_WIN = 10 * MiB, WS_WQB = 17 * MiB, WS_WKVB = 18 * MiB, WS_WPA = 19 * MiB, WS_WPB = 20 * MiB, WS_WO = 21 * MiB, WS_W13 = 23 * MiB, WS_W2 = 55 * MiB;
constexpr size_t WS_H = 72 * MiB;
constexpr size_t WS_QA = 136 * MiB, WS_KA = 168 * MiB, WS_VA = 176 * MiB, WS_QLAT = 184 * MiB, WS_KVLAT = 208 * MiB;
constexpr size_t WS_KB = 224 * MiB, WS_VB = 272 * MiB, WS_QB = 304 * MiB, WS_OB = 352 * MiB, WS_SA = 384 * MiB, WS_SB = 448 * MiB, WS_END = 512 * MiB;
constexpr size_t WS_ACT = 136 * MiB, WS_Y2 = 208 * MiB;
constexpr int ACT_ROWS = 2 * T + NE * 256;
static_assert(WS_ACT + (size_t)ACT_ROWS * FF * 2 <= WS_Y2 && WS_Y2 + (size_t)2 * T * D * 2 <= WS_END, "moe overlay");
constexpr int CW_BAR = 4096;
constexpr int CW_CNT = 16384;

constexpr int RING_BYTES = 131072, MISC_OFF = RING_BYTES, LDS_BYTES = 147456;

__device__ __forceinline__ float bf2f(unsigned v) { return __uint_as_float(v << 16); }
__device__ __forceinline__ unsigned cvt_pk_bf16(float lo, float hi) { unsigned r; asm volatile("v_cvt_pk_bf16_f32 %0, %1, %2" : "=v"(r) : "v"(lo), "v"(hi)); return r; }
__device__ __forceinline__ u32x4 pack8(f32x4 a, f32x4 b) { u32x4 w; w.x = cvt_pk_bf16(a[0], a[1]); w.y = cvt_pk_bf16(a[2], a[3]); w.z = cvt_pk_bf16(b[0], b[1]); w.w = cvt_pk_bf16(b[2], b[3]); return w; }
__device__ __forceinline__ void unpack8(u32x4 w, f32x4& a, f32x4& b) { a[0] = bf2f(w.x & 0xffffu); a[1] = bf2f(w.x >> 16); a[2] = bf2f(w.y & 0xffffu); a[3] = bf2f(w.y >> 16); b[0] = bf2f(w.z & 0xffffu); b[1] = bf2f(w.z >> 16); b[2] = bf2f(w.w & 0xffffu); b[3] = bf2f(w.w >> 16); }
__device__ __forceinline__ float wave_sum(float v) {
#pragma unroll
    for (int o = 1; o < 64; o <<= 1) v += __shfl_xor(v, o);
    return v;
}
__device__ __forceinline__ float sigm(float v) { return 1.f / (1.f + __expf(-v)); }
#define VM_WAIT() asm volatile("s_waitcnt vmcnt(0)" ::: "memory")
#define LAUNDER_S(p) asm volatile("" : "+s"(p))
#define LAUNDER_V(v) asm volatile("" : "+v"(v))
#define LDS_WAIT() asm volatile("s_waitcnt lgkmcnt(0)" ::: "memory")

#define XB_TMO      128
#define XB_XCNT(j)  (256  + 64 * (j))
#define XB_XSUB(j)  (1280 + 64 * (j))
#define XB_XGEN(j)  (2304 + 64 * (j))
#define XB_TOP      3328
#define XB_TOPGEN   3392
#define XCD_BAR_WORDS 3456
#define XB_SPIN_CAP (1u << 22)
__device__ __forceinline__ unsigned xb_ld(unsigned* p)              { return __hip_atomic_load(p, __ATOMIC_RELAXED, __HIP_MEMORY_SCOPE_AGENT); }
__device__ __forceinline__ unsigned xb_add(unsigned* p, unsigned v) { return __hip_atomic_fetch_add(p, v, __ATOMIC_RELAXED, __HIP_MEMORY_SCOPE_AGENT); }
__device__ __forceinline__ unsigned xb_xcc_id() { return (unsigned)__builtin_amdgcn_s_getreg((3 << 11) | 20) & 0xFu; }
#define XB_SPIN(cond, bar) do { unsigned _sp = 0; while (cond) { __builtin_amdgcn_s_sleep(1); \
    if ((++_sp & 255u) == 0u) { if (xb_ld(&(bar)[XB_TMO])) break; if (_sp > XB_SPIN_CAP) { atomicAdd(&(bar)[XB_TMO], 1u); break; } } } } while (0)
struct XcdBarrier { unsigned* bar; unsigned x; volatile LAS unsigned* st; };
__device__ __forceinline__ XcdBarrier xcd_barrier_post(unsigned* bar, volatile LAS unsigned* st) {
    XcdBarrier b; b.bar = bar; b.x = xb_xcc_id(); b.st = st;
    if (threadIdx.x == 0) (void)xb_add(&bar[XB_XCNT(b.x)], 1u);
    return b;
}
__device__ __forceinline__ void xcd_barrier_complete(unsigned* bar, unsigned x, unsigned& nloc, unsigned& nx) {
    const unsigned G = gridDim.x * gridDim.y * gridDim.z;
    unsigned sum, cnt, mine, sp = 0u;
    for (;;) {
        sum = 0u; cnt = 0u; mine = 0u;
#pragma unroll
        for (unsigned j = 0; j < 16; ++j) { const unsigned c = xb_ld(&bar[XB_XCNT(j)]); sum += c; cnt += (c > 0u) ? 1u : 0u; mine = (j == x) ? c : mine; }
        if (sum == G) break;
        __builtin_amdgcn_s_sleep(1);
        if ((++sp & 255u) == 0u) { if (xb_ld(&bar[XB_TMO])) break; if (sp > XB_SPIN_CAP) { atomicAdd(&bar[XB_TMO], 1u); break; } }
    }
    nloc = mine > 0u ? mine : 1u; nx = cnt > 0u ? cnt : 1u;
}
__device__ __forceinline__ void xcd_barrier(const XcdBarrier& b) {
    asm volatile("s_waitcnt vmcnt(0)" ::: "memory");
    __syncthreads();
    if (threadIdx.x == 0) {
        unsigned* bar = b.bar;
        __builtin_amdgcn_s_waitcnt(0);
        unsigned nloc = b.st[0], nx = b.st[1];
        if (nloc == 0u) { xcd_barrier_complete(bar, b.x, nloc, nx); b.st[0] = nloc; b.st[1] = nx; }
        const unsigned old = xb_add(&bar[XB_XSUB(b.x)], 1u);
        const unsigned gen = old / nloc;
        if (old + 1u == (gen + 1u) * nloc) {
            __builtin_amdgcn_fence(__ATOMIC_RELEASE, "agent");
            asm volatile("s_waitcnt vmcnt(0)" ::: "memory");
            const unsigned og = xb_add(&bar[XB_TOP], 1u);
            const unsigned tg = og / nx;
            if (og + 1u == (tg + 1u) * nx) xb_add(&bar[XB_TOPGEN], 1u);
            else XB_SPIN(xb_ld(&bar[XB_TOPGEN]) == tg, bar);
            __builtin_amdgcn_fence(__ATOMIC_ACQUIRE, "agent");
            xb_add(&bar[XB_XGEN(b.x)], 1u);
            asm volatile("s_waitcnt vmcnt(0)" ::: "memory");
        } else {
            XB_SPIN(xb_ld(&bar[XB_XGEN(b.x)]) == gen, bar);
            __builtin_amdgcn_fence(__ATOMIC_ACQUIRE, "agent");
            asm volatile("s_waitcnt vmcnt(0)" ::: "memory");
        }
    }
    __syncthreads();
}

namespace gp {
constexpr int BM = 256, BK = 64, HALF = 128, HTB = HALF * BK * 2, NXCD = 8, WGM = 8;
__host__ __device__ __forceinline__ int lds_byte(int r, int c) { const int st = (r >> 4) * 2 + (c >> 5), rr = r & 15, cc = c & 31, ob = rr * 64 + cc * 2; return st * 1024 + (ob ^ (((ob >> 9) & 1) << 5)); }
__host__ __device__ __forceinline__ void stage_rc(int b, int& R, int& C) { const int st = b / 1024, sb = b % 1024, swz = sb ^ (((sb >> 9) & 1) << 5); R = (st >> 1) * 16 + swz / 64; C = (st & 1) * 32 + (swz % 64) / 2; }
__host__ __device__ __forceinline__ int perm32(int rho) { const int n = rho >> 4, i = rho & 15; return 8 * (i >> 2) + 4 * n + (i & 3); }

struct Unit { int pm, pn, be, rl, nv; };
struct Gemm { const bf16_t* A; const bf16_t* Bt; int K; size_t bstride; const unsigned* list; };

__device__ __forceinline__ int xcd_remap(int wgid, int nwg) { const int q = nwg / NXCD, r = nwg % NXCD, xcd = wgid % NXCD, off = wgid / NXCD; return (xcd < r ? xcd * (q + 1) : r * (q + 1) + (xcd - r) * q) + off; }
struct DenseOrder {
    int nM, nN, nwg, G, c;
    __device__ void init(int M, int N, int G_, int c_) { nM = M / BM; nN = N / BM; nwg = nM * nN; G = G_; c = c_; }
    __device__ bool next(int i, Unit& u) const {
        const long L = (long)i * G + c; if (L >= nwg) return false;
        const int wgid = xcd_remap((int)L, nwg);
        const int nig = WGM * nN, gid = wgid / nig, fm = gid * WGM, gsz = (nM - fm) < WGM ? (nM - fm) : WGM;
        u.pm = fm + ((wgid % nig) % gsz); u.pn = (wgid % nig) / gsz; u.be = 0; u.rl = 0; u.nv = 256; return true;
    }
};
struct MoeOrder {
    const LAS int* tab; int nwg, G, c;
    __device__ void init(const LAS int* tab_, int G_, int c_) { tab = tab_; nwg = tab_[16] * 4; G = G_; c = c_; }
    __device__ bool next(int i, Unit& u) const {
        const long L = (long)i * G + c; if (L >= nwg) return false;
        const int wgid = xcd_remap((int)L, nwg);
        const int tile = wgid >> 2; int e = 0;
        for (int k = 1; k < NE; ++k) e += (tab[k] <= tile) ? 1 : 0;
        u.pm = tile; u.pn = wgid & 3; u.be = e; u.rl = tile - tab[e]; const int rem = tab[32 + e] - u.rl * 256; u.nv = rem < 256 ? rem : 256; return true;
    }
};

#define ACC_T f32x4 (&acc)[2][2][4][2]

template <class Epi, class Sched, bool GATHER>
__device__ __forceinline__ void gemm_phase_ref(int tid, const Gemm g, const Sched& S, const Epi& E) {
    const int wid = __builtin_amdgcn_readfirstlane(tid >> 6), lane = tid & 63, wr = wid >> 2, wc = wid & 3, fr = lane & 15, fq = lane >> 4;
    const int K = g.K; Unit u;
    for (int ui = 0; S.next(ui, u); ++ui) {
        f32x4 acc[2][2][4][2];
#pragma unroll
        for (int a = 0; a < 2; ++a)
#pragma unroll
            for (int b = 0; b < 2; ++b)
#pragma unroll
                for (int m = 0; m < 4; ++m)
#pragma unroll
                    for (int n = 0; n < 2; ++n) acc[a][b][m][n] = (f32x4){0.f, 0.f, 0.f, 0.f};
        const bf16_t* Bt = g.Bt + (size_t)u.be * g.bstride + (size_t)u.pn * 256 * K;
        for (int ai = 0; ai < 2; ++ai)
            for (int m = 0; m < 4; ++m) {
                const int rloc = ai * 128 + wr * 64 + m * 16 + fr;
                size_t arow;
                if (GATHER) { arow = (rloc < u.nv) ? (size_t)(g.list[(size_t)u.be * T + u.rl * 256 + rloc] >> 1) : 0; }
                else arow = (size_t)u.pm * 256 + rloc;
                const bf16_t* ap = g.A + arow * K;
                for (int bj = 0; bj < 2; ++bj) {
                    const bf16_t* bp = Bt + (size_t)(bj * 128 + wc * 32 + fq * 8) * K;
                    float s[8];
#pragma unroll
                    for (int c = 0; c < 8; ++c) {
                        float sc = 0.f; const bf16_t* bpc = bp + (size_t)c * K;
#pragma unroll 2
                        for (int k = 0; k < K; k += 8) {
                            f32x4 a0, a1, b0, b1; unpack8(*(const u32x4*)(ap + k), a0, a1); unpack8(*(const u32x4*)(bpc + k), b0, b1);
                            sc += a0[0] * b0[0] + a0[1] * b0[1] + a0[2] * b0[2] + a0[3] * b0[3] + a1[0] * b1[0] + a1[1] * b1[1] + a1[2] * b1[2] + a1[3] * b1[3];
                        }
                        s[c] = sc; asm volatile("" : "+v"(s[c]));
                    }
#pragma unroll
                    for (int a2 = 0; a2 < 2; ++a2)
#pragma unroll
                        for (int b2 = 0; b2 < 2; ++b2)
#pragma unroll
                            for (int m2 = 0; m2 < 4; ++m2)
                                if (a2 == ai && b2 == bj && m2 == m) { acc[a2][b2][m2][0] = (f32x4){s[0], s[1], s[2], s[3]}; acc[a2][b2][m2][1] = (f32x4){s[4], s[5], s[6], s[7]}; }
                }
            }
        E(acc, u, wr, wc, fr, fq);
    }
}

#if FAST_GEMM
template <class Epi, class Sched, bool GATHER>
__device__ __forceinline__ void gemm_phase_fast(int tid, LAS unsigned char* lds, const Gemm g, const Sched& S, const Epi& E) {
    const int wid = __builtin_amdgcn_readfirstlane(tid >> 6), lane = tid & 63, wr = wid >> 2, wc = wid & 3, fr = lane & 15, fq = lane >> 4;
    const int K = g.K, nt = K / BK;
    int Rr[2], Cc[2]; unsigned voffB[2];
#pragma unroll
    for (int i = 0; i < 2; ++i) { stage_rc(tid * 16 + i * 8192, Rr[i], Cc[i]); const int Rb = (Rr[i] & ~31) + perm32(Rr[i] & 31); voffB[i] = (unsigned)(Rb * K + Cc[i]) * 2u; }
    const size_t kstep = (size_t)(BK * 2), hstep = (size_t)HALF * K * 2, tstep = 2 * hstep;
    const unsigned ldsw = (unsigned)wid * 1024u;
    const int aoff = lds_byte(wr * 64 + fr, fq * 8), boff = lds_byte(wc * 32 + fr, fq * 8);
#define GP_SA(b, h) (((b) * 2 + (h)) * HTB)
#define GP_SB(b, h) ((4 + (b) * 2 + (h)) * HTB)
#define GP_STAGE2(bufoff, gbase, v0, v1) do { \
        __builtin_amdgcn_global_load_lds((const unsigned*)((const char*)(gbase) + (v0)), (LAS unsigned*)(lds + (bufoff) + ldsw), 16, 0, 0); \
        __builtin_amdgcn_global_load_lds((const unsigned*)((const char*)(gbase) + (v1)), (LAS unsigned*)(lds + (bufoff) + ldsw + 8192), 16, 0, 0); } while (0)
#define GP_STAGEB(bufoff, gbase) GP_STAGE2(bufoff, gbase, voffB[0], voffB[1])
#define GP_LDA(dst, b, h) do { _Pragma("unroll") for (int m = 0; m < 4; ++m) _Pragma("unroll") for (int k = 0; k < 2; ++k) dst[m][k] = *(const LAS bf16x8*)(lds + GP_SA(b, h) + aoff + m * 2048 + k * 1024); } while (0)
#define GP_LDB(dst, b, h) do { _Pragma("unroll") for (int n = 0; n < 2; ++n) _Pragma("unroll") for (int k = 0; k < 2; ++k) dst[n][k] = *(const LAS bf16x8*)(lds + GP_SB(b, h) + boff + n * 2048 + k * 1024); } while (0)
#define GP_MMA(ai, bj, At, Bt) do { __builtin_amdgcn_s_setprio(1); _Pragma("unroll") for (int m = 0; m < 4; ++m) _Pragma("unroll") for (int n = 0; n < 2; ++n) _Pragma("unroll") for (int k = 0; k < 2; ++k) \
        acc[ai][bj][m][n] = __builtin_amdgcn_mfma_f32_16x16x32_bf16(Bt[n][k], At[m][k], acc[ai][bj][m][n], 0, 0, 0); __builtin_amdgcn_s_setprio(0); } while (0)
#define GP_WAIT_V(n) asm volatile("s_waitcnt vmcnt(" #n ")" ::: "memory")
#define GP_WAIT_L(n) asm volatile("s_waitcnt lgkmcnt(" #n ")" ::: "memory")
#define GP_BAR __builtin_amdgcn_s_barrier()
#define GP_SCHED __builtin_amdgcn_sched_barrier(0)
    Unit cur, nxt; int ui = 0;
    if (!S.next(0, cur)) return;
    f32x4 acc[2][2][4][2];
#pragma unroll
    for (int a = 0; a < 2; ++a)
#pragma unroll
        for (int b = 0; b < 2; ++b)
#pragma unroll
            for (int m = 0; m < 4; ++m)
#pragma unroll
                for (int n = 0; n < 2; ++n) acc[a][b][m][n] = (f32x4){0.f, 0.f, 0.f, 0.f};
    bf16x8 At[4][2], B0[2][2], B1[2][2];
    unsigned vC0, vC1, vC2, vC3, vN0, vN1, vN2, vN3;
#define GP_VOFF(u, o0, o1, o2, o3) do { if (GATHER) { \
        const unsigned* lp = g.list + (size_t)(u).be * T + (u).rl * 256; \
        const int p0 = Rr[0], p1 = Rr[1], p2 = 128 + Rr[0], p3 = 128 + Rr[1]; \
        const unsigned t0 = p0 < (u).nv ? (lp[p0] >> 1) : 0u, t1 = p1 < (u).nv ? (lp[p1] >> 1) : 0u, t2 = p2 < (u).nv ? (lp[p2] >> 1) : 0u, t3 = p3 < (u).nv ? (lp[p3] >> 1) : 0u; \
        o0 = (t0 * K + Cc[0]) * 2u; o1 = (t1 * K + Cc[1]) * 2u; o2 = (t2 * K + Cc[0]) * 2u; o3 = (t3 * K + Cc[1]) * 2u; \
      } else { o0 = (unsigned)(Rr[0] * K + Cc[0]) * 2u; o1 = (unsigned)(Rr[1] * K + Cc[1]) * 2u; o2 = o0 + (unsigned)hstep; o3 = o1 + (unsigned)hstep; } } while (0)
    GP_VOFF(cur, vC0, vC1, vC2, vC3);
    const char* cA = (const char*)g.A + (GATHER ? (size_t)0 : (size_t)cur.pm * tstep);
    const char* cB = (const char*)g.Bt + ((size_t)cur.be * g.bstride) * 2 + (size_t)cur.pn * tstep;
    GP_STAGEB(GP_SB(0, 0), cB); GP_STAGEB(GP_SB(0, 1), cB + hstep); GP_STAGE2(GP_SA(0, 0), cA, vC0, vC1); GP_STAGE2(GP_SA(0, 1), cA, vC2, vC3);
    if (wr == 1) GP_BAR;
    GP_WAIT_V(2); GP_BAR;
    GP_STAGEB(GP_SB(1, 0), cB + kstep); GP_STAGE2(GP_SA(1, 0), cA + kstep, vC0, vC1); GP_STAGEB(GP_SB(1, 1), cB + hstep + kstep);
    GP_WAIT_V(6); GP_BAR;
    for (;;) {
        const bool has_next = S.next(ui + 1, nxt);
        const char* nA = has_next ? (const char*)g.A + (GATHER ? (size_t)0 : (size_t)nxt.pm * tstep) : cA;
        const char* nB = has_next ? (const char*)g.Bt + ((size_t)nxt.be * g.bstride) * 2 + (size_t)nxt.pn * tstep : cB;
        if (has_next) { GP_VOFF(nxt, vN0, vN1, vN2, vN3); } else { vN0 = vC0; vN1 = vC1; vN2 = vC2; vN3 = vC3; }
        for (int t = 0; t < nt; t += 2) {
            const bool last = (t == nt - 2);
            const char* a1 = cA + (size_t)(t + 1) * kstep;
            const char* a2 = last ? nA : cA + (size_t)(t + 2) * kstep; const char* b2 = last ? nB : cB + (size_t)(t + 2) * kstep;
            const char* a3 = a2 + kstep; const char* b3 = b2 + kstep;
            const unsigned w0 = last ? vN0 : vC0, w1 = last ? vN1 : vC1, w2 = last ? vN2 : vC2, w3 = last ? vN3 : vC3;
            GP_LDB(B0, 0, 0); GP_LDB(B1, 0, 1); GP_SCHED; GP_LDA(At, 0, 0); GP_STAGE2(GP_SA(1, 1), a1, vC2, vC3);
            GP_WAIT_V(8); GP_WAIT_L(0); GP_BAR; GP_MMA(0, 0, At, B0); GP_MMA(0, 1, At, B1); GP_BAR; GP_SCHED;
            GP_LDA(At, 0, 1); GP_STAGEB(GP_SB(0, 0), b2); GP_STAGEB(GP_SB(0, 1), b2 + hstep); GP_STAGE2(GP_SA(0, 0), a2, w0, w1);
            GP_WAIT_V(8); GP_WAIT_L(0); GP_BAR; GP_MMA(1, 0, At, B0); GP_MMA(1, 1, At, B1); GP_BAR; GP_SCHED;
            GP_LDB(B0, 1, 0); GP_LDB(B1, 1, 1); GP_SCHED; GP_LDA(At, 1, 0); GP_STAGE2(GP_SA(0, 1), a2, w2, w3);
            GP_WAIT_V(8); GP_WAIT_L(0); GP_BAR; GP_MMA(0, 0, At, B0); GP_MMA(0, 1, At, B1); GP_BAR; GP_SCHED;
            GP_LDA(At, 1, 1); GP_STAGEB(GP_SB(1, 0), b3); GP_STAGEB(GP_SB(1, 1), b3 + hstep); GP_STAGE2(GP_SA(1, 0), a3, w0, w1);
            GP_WAIT_V(8); GP_WAIT_L(0); GP_BAR; GP_MMA(1, 0, At, B0); GP_MMA(1, 1, At, B1); GP_BAR; GP_SCHED;
        }
        if (wr == 0) GP_BAR;
        E(acc, cur, wr, wc, fr, fq);
        if (!has_next) break;
#pragma unroll
        for (int a = 0; a < 2; ++a)
#pragma unroll
            for (int b = 0; b < 2; ++b)
#pragma unroll
                for (int m = 0; m < 4; ++m)
#pragma unroll
                    for (int n = 0; n < 2; ++n) acc[a][b][m][n] = (f32x4){0.f, 0.f, 0.f, 0.f};
        cur = nxt; cA = nA; cB = nB; vC0 = vN0; vC1 = vN1; vC2 = vN2; vC3 = vN3; ++ui;
        if (wr == 1) GP_BAR;
    }
    GP_WAIT_V(0);
    GP_BAR;
#undef GP_SA
#undef GP_SB
#undef GP_STAGE2
#undef GP_STAGEB
#undef GP_LDA
#undef GP_LDB
#undef GP_MMA
#undef GP_WAIT_V
#undef GP_WAIT_L
#undef GP_BAR
#undef GP_SCHED
#undef GP_VOFF
}
#endif

template <class Epi, class Sched, bool GATHER = false>
__device__ __forceinline__ void gemm_phase(int tid, LAS unsigned char* lds, const Gemm g, const Sched& S, const Epi& E) {
#if FAST_GEMM
    gemm_phase_fast<Epi, Sched, GATHER>(tid, lds, g, S, E);
#else
    (void)lds; gemm_phase_ref<Epi, Sched, GATHER>(tid, g, S, E);
#endif
}

#define EPI_ROW(ai, m) (u.pm * 256 + (ai) * 128 + wr * 64 + (m) * 16 + fr)
#define EPI_COL(bj) (u.pn * 256 + (bj) * 128 + wc * 32 + fq * 8)
__device__ __forceinline__ float dot4(f32x4 a) { return (a[0] * a[0] + a[1] * a[1]) + (a[2] * a[2] + a[3] * a[3]); }

struct EpiIn {
    bf16_t *QA, *KA, *VA, *QLAT, *KVLAT, *KB, *SA, *SB; float *SSQ, *SSKV; const float *gq, *gk, *cosA, *sinA, *cosB, *sinB;
    __device__ __forceinline__ void operator()(const ACC_T, const Unit& u, int wr, int wc, int fr, int fq) const {
        const int wb = u.pn * 4 + wc;
        if (wb < 10) {
            const bool isq = wb < 8; const int head = isq ? wb : wb - 8; const float* g = isq ? gq : gk; bf16_t* dst = isq ? QA : KA; const int dp = isq ? 512 : 128; const float qs = isq ? QSCALE_A : 1.f;
            const f32x4 g00 = *(const f32x4*)(g + 8 * fq), g01 = *(const f32x4*)(g + 8 * fq + 4), g10 = *(const f32x4*)(g + 32 + 8 * fq), g11 = *(const f32x4*)(g + 36 + 8 * fq);
#pragma unroll
            for (int ai = 0; ai < 2; ++ai)
#pragma unroll
                for (int m = 0; m < 4; ++m) {
                    const int r = EPI_ROW(ai, m), pos = r & (S - 1);
                    const f32x4 v00 = acc[ai][0][m][0], v01 = acc[ai][0][m][1], v10 = acc[ai][1][m][0], v11 = acc[ai][1][m][1];
                    float ss = (dot4(v00) + dot4(v01)) + (dot4(v10) + dot4(v11)); ss += __shfl_xor(ss, 16); ss += __shfl_xor(ss, 32);
                    const float rstd = rsqrtf(ss * (1.f / 64.f) + EPS);
                    const f32x4 y00 = v00 * rstd * g00, y01 = v01 * rstd * g01, y10 = v10 * rstd * g10, y11 = v11 * rstd * g11;
                    const f32x4 c0 = *(const f32x4*)(cosA + pos * 32 + 8 * fq), c1 = *(const f32x4*)(cosA + pos * 32 + 8 * fq + 4), s0 = *(const f32x4*)(sinA + pos * 32 + 8 * fq), s1 = *(const f32x4*)(sinA + pos * 32 + 8 * fq + 4);
                    const f32x4 o00 = (y00 * c0 - y10 * s0) * qs, o01 = (y01 * c1 - y11 * s1) * qs, o10 = (y10 * c0 + y00 * s0) * qs, o11 = (y11 * c1 + y01 * s1) * qs;
                    bf16_t* p = dst + (size_t)r * dp + head * 64 + 8 * fq;
                    *(u32x4*)p = pack8(o00, o01); *(u32x4*)(p + 32) = pack8(o10, o11);
                }
        } else if (wb < 12) {
#pragma unroll
            for (int ai = 0; ai < 2; ++ai)
#pragma unroll
                for (int m = 0; m < 4; ++m) { bf16_t* p = VA + (size_t)EPI_ROW(ai, m) * 128 + (wb - 10) * 64 + 8 * fq;
                    *(u32x4*)p = pack8(acc[ai][0][m][0], acc[ai][0][m][1]); *(u32x4*)(p + 32) = pack8(acc[ai][1][m][0], acc[ai][1][m][1]); }
        } else if (wb < 22) {
            const bool isq = wb < 18; const int idx = isq ? wb - 12 : wb - 18; bf16_t* dst = isq ? QLAT : KVLAT; const int dp = isq ? 384 : 256;
#pragma unroll
            for (int ai = 0; ai < 2; ++ai)
#pragma unroll
                for (int m = 0; m < 4; ++m) {
                    const int r = EPI_ROW(ai, m);
                    const f32x4 v00 = acc[ai][0][m][0], v01 = acc[ai][0][m][1], v10 = acc[ai][1][m][0], v11 = acc[ai][1][m][1];
                    float ss = (dot4(v00) + dot4(v01)) + (dot4(v10) + dot4(v11)); ss += __shfl_xor(ss, 16); ss += __shfl_xor(ss, 32);
                    if (fq == 0) { if (isq) SSQ[(size_t)r * 8 + idx] = ss; else SSKV[(size_t)r * 4 + idx] = ss; }
                    bf16_t* p = dst + (size_t)r * dp + idx * 64 + 8 * fq;
                    *(u32x4*)p = pack8(v00, v01); *(u32x4*)(p + 32) = pack8(v10, v11);
                }
        } else if (wb == 22) {
            if (fq < 2) {
#pragma unroll
                for (int ai = 0; ai < 2; ++ai)
#pragma unroll
                    for (int m = 0; m < 4; ++m) {
                        const int r = EPI_ROW(ai, m), pos = r & (S - 1);
                        const f32x4 x10 = acc[ai][0][m][0], x11 = acc[ai][0][m][1], x20 = acc[ai][1][m][0], x21 = acc[ai][1][m][1];
                        const f32x4 c0 = *(const f32x4*)(cosB + pos * 16 + 8 * fq), c1 = *(const f32x4*)(cosB + pos * 16 + 8 * fq + 4), s0 = *(const f32x4*)(sinB + pos * 16 + 8 * fq), s1 = *(const f32x4*)(sinB + pos * 16 + 8 * fq + 4);
                        const u32x4 w1 = pack8(x10 * c0 - x20 * s0, x11 * c1 - x21 * s1), w2 = pack8(x20 * c0 + x10 * s0, x21 * c1 + x11 * s1);
                        bf16_t* p = KB + (size_t)r * 768 + 64 + 8 * fq;
#pragma unroll
                        for (int h = 0; h < 8; ++h) { *(u32x4*)(p + h * 96) = w1; *(u32x4*)(p + h * 96 + 16) = w2; }
                    }
            }
        } else if (wb == 23) {
        } else {
            const bool isa = wb < 40; const int idx = isa ? wb - 24 : wb - 40; bf16_t* dst = isa ? SA : SB;
#pragma unroll
            for (int ai = 0; ai < 2; ++ai)
#pragma unroll
                for (int m = 0; m < 4; ++m) { bf16_t* p = dst + (size_t)EPI_ROW(ai, m) * 1024 + idx * 64 + 8 * fq;
#pragma unroll
                    for (int bj = 0; bj < 2; ++bj) { f32x4 a = acc[ai][bj][m][0], b = acc[ai][bj][m][1];
#pragma unroll
                        for (int j = 0; j < 4; ++j) { a[j] = sigm(a[j]); b[j] = sigm(b[j]); }
                        *(u32x4*)(p + bj * 32) = pack8(a, b); } }
        }
    }
};
__host__ __device__ __forceinline__ int src_col_in(int n) {
    const int pn = n >> 8, nl = n & 255, bj = nl >> 7, wc = (nl & 127) >> 5, p = nl & 31, wb = pn * 4 + wc, s = bj * 32 + p;
    if (wb < 8) return wb * 64 + s;
    if (wb < 10) return 512 + (wb - 8) * 64 + s;
    if (wb < 12) return 640 + (wb - 10) * 64 + s;
    if (wb < 18) return 768 + (wb - 12) * 64 + s;
    if (wb < 22) return 1152 + (wb - 18) * 64 + s;
    if (wb == 22) return p < 16 ? 1408 + bj * 16 + p : -1;
    if (wb == 23) return -1;
    if (wb < 40) return 1440 + (wb - 24) * 64 + s;
    return 2464 + (wb - 40) * 64 + s;
}
struct EpiQb {
    bf16_t* QB; const float *SSQ, *cosB, *sinB;
    __device__ __forceinline__ void operator()(const ACC_T, const Unit& u, int wr, int wc, int fr, int fq) const {
#pragma unroll
        for (int ai = 0; ai < 2; ++ai)
#pragma unroll
            for (int m = 0; m < 4; ++m) {
                const int r = EPI_ROW(ai, m), pos = r & (S - 1);
                const f32x4 sa = *(const f32x4*)(SSQ + (size_t)r * 8); const f32x2 sb = *(const f32x2*)(SSQ + (size_t)r * 8 + 4);
                const float rstd = rsqrtf((((sa[0] + sa[1]) + (sa[2] + sa[3])) + (sb[0] + sb[1])) * (1.f / 384.f) + EPS);
#pragma unroll
                for (int bj = 0; bj < 2; ++bj) {
                    f32x4 v0 = acc[ai][bj][m][0] * rstd, v1 = acc[ai][bj][m][1] * rstd;
                    const int c32 = u.pn * 8 + bj * 4 + wc;
                    if (c32 % 3 == 2) {
                        f32x4 o0, o1;
#pragma unroll
                        for (int j = 0; j < 4; ++j) { o0[j] = __shfl_xor(v0[j], 32); o1[j] = __shfl_xor(v1[j], 32); }
                        const int i0 = 8 * (fq & 1);
                        const f32x4 c0 = *(const f32x4*)(cosB + pos * 16 + i0), c1 = *(const f32x4*)(cosB + pos * 16 + i0 + 4), s0 = *(const f32x4*)(sinB + pos * 16 + i0), s1 = *(const f32x4*)(sinB + pos * 16 + i0 + 4);
                        if (fq < 2) { v0 = v0 * c0 - o0 * s0; v1 = v1 * c1 - o1 * s1; } else { v0 = v0 * c0 + o0 * s0; v1 = v1 * c1 + o1 * s1; }
                    }
                    *(u32x4*)(QB + (size_t)r * 768 + EPI_COL(bj)) = pack8(v0 * QSCALE_B, v1 * QSCALE_B);
                }
            }
    }
};
struct EpiKvb {
    bf16_t *KB, *VB; const float* SSKV;
    __device__ __forceinline__ void operator()(const ACC_T, const Unit& u, int wr, int wc, int fr, int fq) const {
#pragma unroll
        for (int ai = 0; ai < 2; ++ai)
#pragma unroll
            for (int m = 0; m < 4; ++m) {
                const int r = EPI_ROW(ai, m);
                const f32x4 sa = *(const f32x4*)(SSKV + (size_t)r * 4);
                const float rstd = rsqrtf(((sa[0] + sa[1]) + (sa[2] + sa[3])) * (1.f / 256.f) + EPS);
#pragma unroll
                for (int bj = 0; bj < 2; ++bj) {
                    const int head = u.pn * 2 + bj, o = wc * 32 + fq * 8;
                    const u32x4 w = pack8(acc[ai][bj][m][0] * rstd, acc[ai][bj][m][1] * rstd);
                    if (wc < 2) *(u32x4*)(KB + (size_t)r * 768 + head * 96 + o) = w; else *(u32x4*)(VB + (size_t)r * 512 + head * 64 + (o - 64)) = w;
                }
            }
    }
};
template <int MODE> struct EpiProj {
    bf16_t* O; const bf16_t* gate;
    __device__ __forceinline__ void operator()(const ACC_T, const Unit& u, int wr, int wc, int fr, int fq) const {
#pragma unroll
        for (int ai = 0; ai < 2; ++ai)
#pragma unroll
            for (int m = 0; m < 4; ++m) {
                const int r = EPI_ROW(ai, m);
#pragma unroll
                for (int bj = 0; bj < 2; ++bj) {
                    const size_t off = (size_t)r * D + EPI_COL(bj);
                    f32x4 g0, g1; unpack8(*(const u32x4*)(gate + off), g0, g1);
                    f32x4 v0 = acc[ai][bj][m][0] * g0, v1 = acc[ai][bj][m][1] * g1;
                    if (MODE == 1) { f32x4 p0, p1; unpack8(*(const u32x4*)(O + off), p0, p1); v0 += p0; v1 += p1; }
                    *(u32x4*)(O + off) = pack8(v0, v1);
                }
            }
    }
};
struct EpiWo {
    float* X; const float* modl;
    __device__ __forceinline__ void operator()(const ACC_T, const Unit& u, int wr, int wc, int fr, int fq) const {
        const float* g1 = modl + (size_t)(u.pm >> 4) * 6 * D + 2 * D;
#pragma unroll
        for (int bj = 0; bj < 2; ++bj) {
            const int c = EPI_COL(bj); const f32x4 ga = *(const f32x4*)(g1 + c), gb = *(const f32x4*)(g1 + c + 4);
#pragma unroll
            for (int ai = 0; ai < 2; ++ai)
#pragma unroll
                for (int m = 0; m < 4; ++m) { float* p = X + (size_t)EPI_ROW(ai, m) * D + c;
                    const f32x4 x0 = *(const f32x4*)p, x1 = *(const f32x4*)(p + 4);
                    *(f32x4*)p = x0 + ga * acc[ai][bj][m][0]; *(f32x4*)(p + 4) = x1 + gb * acc[ai][bj][m][1]; }
        }
    }
};
struct EpiUp {
    bf16_t* ACT;
    __device__ __forceinline__ void operator()(const ACC_T, const Unit& u, int wr, int wc, int fr, int fq) const {
#pragma unroll
        for (int ai = 0; ai < 2; ++ai)
#pragma unroll
            for (int m = 0; m < 4; ++m) {
                f32x4 a = acc[ai][0][m][0], b = acc[ai][0][m][1]; const f32x4 c = acc[ai][1][m][0], d = acc[ai][1][m][1];
#pragma unroll
                for (int j = 0; j < 4; ++j) { a[j] = a[j] * sigm(a[j]) * c[j]; b[j] = b[j] * sigm(b[j]) * d[j]; }
                *(u32x4*)(ACT + (size_t)EPI_ROW(ai, m) * FF + u.pn * 128 + wc * 32 + fq * 8) = pack8(a, b);
            }
    }
};
struct EpiDown {
    bf16_t* Y2; const unsigned* list; const float* gw;
    __device__ __forceinline__ void operator()(const ACC_T, const Unit& u, int wr, int wc, int fr, int fq) const {
#pragma unroll
        for (int ai = 0; ai < 2; ++ai)
#pragma unroll
            for (int m = 0; m < 4; ++m) {
                const int rloc = ai * 128 + wr * 64 + m * 16 + fr;
                if (rloc < u.nv) {
                    const unsigned entry = list[(size_t)u.be * T + u.rl * 256 + rloc]; const float w = gw[entry];
#pragma unroll
                    for (int bj = 0; bj < 2; ++bj) *(u32x4*)(Y2 + (size_t)entry * D + EPI_COL(bj)) = pack8(acc[ai][bj][m][0] * w, acc[ai][bj][m][1] * w);
                }
            }
    }
};
}

namespace at {
struct Tensors { const bf16_t* Q; int qp; const bf16_t* K; int kp; const bf16_t* V; int vp; bf16_t* O; int op; int group; };
__device__ __forceinline__ bool next_unit(int i, int vcu, int G, int& bh, int& qb) {
    int u;
    if (G == 256) { if (i >= 4) return false; u = (vcu >> 5) * 128 + i * 32 + (vcu & 31); }
    else { u = i * G + vcu; if (u >= 1024) return false; }
    bh = u >> 4; qb = u & 15; return true;
}
template <int DQK>
__device__ __forceinline__ void attn_phase_ref(int tid, const Tensors& A, int vcu, int G) {
    int bh, qb;
    for (int i = 0; next_unit(i, vcu, G, bh, qb); ++i) {
        const int b = bh >> 3, h = bh & 7, kvh = h / A.group;
        {
            const int dh = tid >> 8;
            const size_t row = (size_t)b * S + qb * 256 + (tid & 255);
            float q[DQK], o[32];
#pragma unroll
            for (int d = 0; d < DQK; ++d) q[d] = bf2f(A.Q[row * A.qp + h * DQK + d]);
#pragma unroll
            for (int d = 0; d < 32; ++d) o[d] = 0.f;
            float l = 0.f;
            for (int k = 0; k < S; ++k) {
                const bf16_t* kr = A.K + ((size_t)b * S + k) * A.kp + kvh * DQK; const bf16_t* vr = A.V + ((size_t)b * S + k) * A.vp + kvh * 64 + dh * 32;
                float sc = 0.f;
#pragma unroll
                for (int d = 0; d < DQK; d += 8) { f32x4 k0, k1; unpack8(*(const u32x4*)(kr + d), k0, k1);
                    sc += q[d] * k0[0] + q[d + 1] * k0[1] + q[d + 2] * k0[2] + q[d + 3] * k0[3] + q[d + 4] * k1[0] + q[d + 5] * k1[1] + q[d + 6] * k1[2] + q[d + 7] * k1[3]; }
                const float p = bf2f(cvt_pk_bf16(exp2f(sc), 0.f) & 0xffffu); l += p;
#pragma unroll
                for (int d = 0; d < 32; d += 8) { f32x4 v0, v1; unpack8(*(const u32x4*)(vr + d), v0, v1);
                    o[d] += p * v0[0]; o[d + 1] += p * v0[1]; o[d + 2] += p * v0[2]; o[d + 3] += p * v0[3]; o[d + 4] += p * v1[0]; o[d + 5] += p * v1[1]; o[d + 6] += p * v1[2]; o[d + 7] += p * v1[3]; }
            }
            const float il = 1.f / l;
            __syncthreads();
#pragma unroll
            for (int d = 0; d < 32; d += 8) { f32x4 a = {o[d] * il, o[d + 1] * il, o[d + 2] * il, o[d + 3] * il}, c = {o[d + 4] * il, o[d + 5] * il, o[d + 6] * il, o[d + 7] * il};
                *(u32x4*)(A.O + row * A.op + h * 64 + dh * 32 + d) = pack8(a, c); }
        }
    }
}
template <int DQK>
__device__ __forceinline__ void attn_phase(int tid, LAS unsigned char* lds, const Tensors& A, int vcu, int G) {
    (void)lds; attn_phase_ref<DQK>(tid, A, vcu, G);
}
}


struct Args { const float* in[22]; float* out; unsigned char* ws; int ph_lo, ph_hi; };
struct Frame {
    LAS unsigned char* lds; volatile LAS unsigned* MISC; unsigned* ctl;
    int tid, lane, wave, vcu, G;
    unsigned char* ws; float* X;
};

__device__ __forceinline__ void p0_phase(Frame& F, const float* c, const float* w_ada, const float* b_ada) {
    LAS float* cs = (LAS float*)F.lds;
    LAS float* red = (LAS float*)(F.lds + 32768);
    for (int i = F.tid; i < NB * D; i += NTHREADS) { const float v = c[i]; cs[i] = v / (1.f + __expf(-v)); }
    __syncthreads();
    float* mod = (float*)(F.ws + WS_MOD);
    const int kq = F.wave, col = F.lane;
    for (int item = F.vcu; item < NL * 6 * D / 64; item += F.G) {
        const int l = item / (6 * D / 64), n0 = (item % (6 * D / 64)) * 64;
        const float* w = w_ada + (size_t)l * D * 6 * D + n0 + col;
        float acc[NB];
#pragma unroll
        for (int b = 0; b < NB; ++b) acc[b] = 0.f;
#pragma unroll 8
        for (int k = kq * 128; k < kq * 128 + 128; ++k) { const float wv = w[(size_t)k * 6 * D];
#pragma unroll
            for (int b = 0; b < NB; ++b) acc[b] += cs[b * D + k] * wv; }
#pragma unroll
        for (int b = 0; b < NB; ++b) red[(kq * NB + b) * 64 + col] = acc[b];
        __syncthreads();
        { const int b = F.wave; float s = 0.f;
#pragma unroll
          for (int q = 0; q < 8; ++q) s += red[(q * NB + b) * 64 + col];
          mod[((size_t)l * NB + b) * 6 * D + n0 + col] = s + b_ada[(size_t)l * 6 * D + n0 + col]; }
        __syncthreads();
    }
    float* cosA = (float*)(F.ws + WS_COSA); float* sinA = (float*)(F.ws + WS_SINA); float* cosB = (float*)(F.ws + WS_COSB); float* sinB = (float*)(F.ws + WS_SINB);
    for (int idx = F.vcu * NTHREADS + F.tid; idx < S * 48; idx += F.G * NTHREADS) {
        const int s = idx / 48, i = idx % 48; const float row = (float)(s >> 6), col2 = (float)(s & 63);
        if (i < 32) { const int j = i & 15; const float a = (i < 16 ? row : col2) * (1.0f / powf(10000.0f, (float)j / 16.0f)); cosA[s * 32 + i] = cosf(a); sinA[s * 32 + i] = sinf(a); }
        else { const int ii = i - 32, j = ii & 7; const float a = (ii < 8 ? row : col2) * (1.0f / powf(10000.0f, (float)j / 8.0f)); cosB[s * 16 + ii] = cosf(a); sinB[s * 16 + ii] = sinf(a); }
    }
}

template <class SrcFn>
__device__ __forceinline__ void cvt_item(const float* W, int K, int Nsrc, const float* kg, bf16_t* WT, LAS float* scr, int item, int nblk, int lane, const SrcFn& src) {
    const int kb = item / nblk, nb = item % nblk, k0 = 64 * kb, n0 = 32 * nb;
    const int sc = src(n0 + (lane & 31));
#pragma unroll 8
    for (int i = 0; i < 32; ++i) { const int kk = 2 * i + (lane >> 5); float v = sc >= 0 ? W[(size_t)(k0 + kk) * Nsrc + sc] : 0.f; if (kg) v *= kg[k0 + kk]; scr[kk * 33 + (lane & 31)] = v; }
    LDS_WAIT(); asm volatile("" ::: "memory");
    const int c = lane & 7;
#pragma unroll
    for (int j = 0; j < 4; ++j) { const int n = (lane >> 3) + 8 * j; const LAS float* s = scr + (8 * c) * 33 + n;
        u32x4 o; o.x = cvt_pk_bf16(s[0 * 33], s[1 * 33]); o.y = cvt_pk_bf16(s[2 * 33], s[3 * 33]); o.z = cvt_pk_bf16(s[4 * 33], s[5 * 33]); o.w = cvt_pk_bf16(s[6 * 33], s[7 * 33]);
        *(u32x4*)(WT + (size_t)(n0 + n) * K + k0 + 8 * c) = o; }
    LDS_WAIT(); asm volatile("" ::: "memory");
}
struct SrcId { __device__ int operator()(int n) const { return n; } };
struct SrcIn { __device__ int operator()(int n) const { return gp::src_col_in(n); } };
typedef __attribute__((address_space(4))) const Args CArgsW;
__device__ __forceinline__ void convert_weights(Frame& F, CArgsW* a, int l) {
    LAS float* scr = (LAS float*)(F.lds + F.wave * 16384);
    const int gw = F.vcu * NWAVES + F.wave, NGW = F.G * NWAVES;
    const float* w_in = a->in[5] + (size_t)l * D * INC; const float* w_q_b = a->in[10] + (size_t)l * 384 * 768; const float* w_kv_b = a->in[11] + (size_t)l * 256 * 1024;
    const float* w_pa = a->in[12] + (size_t)l * 512 * D; const float* w_pb = a->in[13] + (size_t)l * 512 * D; const float* w_o = a->in[14] + (size_t)l * D * D;
    const float* w1 = a->in[18] + (size_t)l * NE * D * FF; const float* w3 = a->in[19] + (size_t)l * NE * D * FF; const float* w2 = a->in[20] + (size_t)l * NE * FF * D;
    const float* gqa = a->in[8] + l * 384; const float* gkv = a->in[9] + l * 256;
    bf16_t* Win = (bf16_t*)(F.ws + WS_WIN); bf16_t* Wqb = (bf16_t*)(F.ws + WS_WQB); bf16_t* Wkvb = (bf16_t*)(F.ws + WS_WKVB); bf16_t* Wpa = (bf16_t*)(F.ws + WS_WPA); bf16_t* Wpb = (bf16_t*)(F.ws + WS_WPB);
    bf16_t* Wo = (bf16_t*)(F.ws + WS_WO); bf16_t* W13 = (bf16_t*)(F.ws + WS_W13); bf16_t* W2 = (bf16_t*)(F.ws + WS_W2);
    constexpr int I_IN = (D / 64) * (NIN / 32), I_QB = (384 / 64) * (768 / 32), I_KVB = (256 / 64) * (1024 / 32), I_P = (512 / 64) * (D / 32), I_O = (D / 64) * (D / 32);
    constexpr int I_13 = (D / 64) * (1024 / 32), I_2 = (FF / 64) * (D / 32);
    constexpr int NITEMS = I_IN + I_QB + I_KVB + 2 * I_P + I_O + NE * (I_13 + I_2);
    for (int it = gw; it < NITEMS; it += NGW) {
        int r = it;
        if (r < I_IN) { cvt_item(w_in, D, INC, nullptr, Win, scr, r, NIN / 32, F.lane, SrcIn()); continue; } r -= I_IN;
        if (r < I_QB) { cvt_item(w_q_b, 384, 768, gqa, Wqb, scr, r, 768 / 32, F.lane, SrcId()); continue; } r -= I_QB;
        if (r < I_KVB) { cvt_item(w_kv_b, 256, 1024, gkv, Wkvb, scr, r, 1024 / 32, F.lane, SrcId()); continue; } r -= I_KVB;
        if (r < I_P) { cvt_item(w_pa, 512, D, nullptr, Wpa, scr, r, D / 32, F.lane, SrcId()); continue; } r -= I_P;
        if (r < I_P) { cvt_item(w_pb, 512, D, nullptr, Wpb, scr, r, D / 32, F.lane, SrcId()); continue; } r -= I_P;
        if (r < I_O) { cvt_item(w_o, D, D, nullptr, Wo, scr, r, D / 32, F.lane, SrcId()); continue; } r -= I_O;
        if (r < NE * I_13) { const int e = r / I_13, q = r % I_13, nb = q % 32;
            const float* src = ((nb & 7) < 4 ? w1 : w3) + (size_t)e * D * FF; const int cb = (nb >> 3) * 128 + (nb & 3) * 32;
            struct SrcOff { int n0, cb; __device__ int operator()(int n) const { return cb + (n - n0); } } so{nb * 32, cb};
            cvt_item(src, D, FF, nullptr, W13 + (size_t)e * 1024 * D, scr, q, 32, F.lane, so); continue; } r -= NE * I_13;
        { const int e = r / I_2, q = r % I_2; cvt_item(w2 + (size_t)e * FF * D, FF, D, nullptr, W2 + (size_t)e * D * FF, scr, q, D / 32, F.lane, SrcId()); }
    }
}

__device__ __forceinline__ void row_phase(Frame& F, const float* xin, const float* g2prev  , const float* gain, const float* modl  , int sh_off, int sc_off, bf16_t* H, bool final_) {
    const int gw = F.vcu * NWAVES + F.wave, NGW = F.G * NWAVES;
    const bf16_t* Y2 = (const bf16_t*)(F.ws + WS_Y2);
    for (int m = gw; m < T; m += NGW) {
        const int b = m >> 12;
        f32x4 v[4]; float ss = 0.f;
#pragma unroll
        for (int j = 0; j < 4; ++j) {
            const int c = 4 * F.lane + 256 * j;
            if (g2prev) {
                f32x4 x = *(const f32x4*)(F.X + (size_t)m * D + c);
                const u32x2 ya = *(const u32x2*)(Y2 + (size_t)(2 * m) * D + c), yb = *(const u32x2*)(Y2 + (size_t)(2 * m + 1) * D + c);
                const f32x4 g = *(const f32x4*)(g2prev + (size_t)b * 6 * D + 5 * D + c);
                f32x4 y; y[0] = bf2f(ya.x & 0xffffu) + bf2f(yb.x & 0xffffu); y[1] = bf2f(ya.x >> 16) + bf2f(yb.x >> 16); y[2] = bf2f(ya.y & 0xffffu) + bf2f(yb.y & 0xffffu); y[3] = bf2f(ya.y >> 16) + bf2f(yb.y >> 16);
                v[j] = x + g * y;
            } else v[j] = *(const f32x4*)(xin + (size_t)m * D + c);
            ss += gp::dot4(v[j]);
        }
        ss = wave_sum(ss);
        const float rstd = rsqrtf(ss * (1.f / D) + EPS);
#pragma unroll
        for (int j = 0; j < 4; ++j) {
            const int c = 4 * F.lane + 256 * j;
            const f32x4 g = *(const f32x4*)(gain + c);
            if (final_) { *(f32x4*)(F.X + (size_t)m * D + c) = v[j] * rstd * g; }
            else {
                if (g2prev || xin != F.X) *(f32x4*)(F.X + (size_t)m * D + c) = v[j];
                const f32x4 sc = *(const f32x4*)(modl + (size_t)b * 6 * D + sc_off + c), sh = *(const f32x4*)(modl + (size_t)b * 6 * D + sh_off + c);
                const f32x4 hv = v[j] * rstd * g * (1.f + sc) + sh;
                u32x2 w; w.x = cvt_pk_bf16(hv[0], hv[1]); w.y = cvt_pk_bf16(hv[2], hv[3]);
                *(u32x2*)(H + (size_t)m * D + c) = w;
            }
        }
    }
}

__device__ __forceinline__ void t2_phase(Frame& F, const float* gain, const float* modl, const float* w_router, const float* rbias, int l) {
    LAS f32x4* wl = (LAS f32x4*)F.lds;
    LAS int* rec = (LAS int*)(F.lds + 65536);
    LAS float* recw = (LAS float*)(F.lds + 65536 + 2048);
    LAS int* lcnt = (LAS int*)(F.lds + 65536 + 4096);
    for (int idx = F.tid; idx < 4096; idx += NTHREADS) {
        const int lane = idx & 63, c = (idx >> 6) & 3, i = (idx >> 8) & 3, j = idx >> 10; const int k = 4 * lane + 256 * j + i;
        wl[idx] = *(const f32x4*)(w_router + (size_t)k * NE + 4 * c);
    }
    if (F.tid < 32) lcnt[F.tid] = 0;
    __syncthreads();
    const int gw = F.vcu * NWAVES + F.wave, NGW = F.G * NWAVES;
    bf16_t* H = (bf16_t*)(F.ws + WS_H);
    int it = 0;
    for (int m = gw; m < T; m += NGW, ++it) {
        const int b = m >> 12;
        f32x4 v[4]; float ss = 0.f;
#pragma unroll
        for (int j = 0; j < 4; ++j) { v[j] = *(const f32x4*)(F.X + (size_t)m * D + 4 * F.lane + 256 * j); ss += gp::dot4(v[j]); }
        ss = wave_sum(ss);
        const float rstd = rsqrtf(ss * (1.f / D) + EPS);
        float acc[NE];
#pragma unroll
        for (int e = 0; e < NE; ++e) acc[e] = 0.f;
#pragma unroll
        for (int j = 0; j < 4; ++j) {
            const int c = 4 * F.lane + 256 * j;
            const f32x4 g = *(const f32x4*)(gain + c), sc = *(const f32x4*)(modl + (size_t)b * 6 * D + 4 * D + c), sh = *(const f32x4*)(modl + (size_t)b * 6 * D + 3 * D + c);
            const f32x4 hv = v[j] * rstd * g * (1.f + sc) + sh;
            u32x2 w; w.x = cvt_pk_bf16(hv[0], hv[1]); w.y = cvt_pk_bf16(hv[2], hv[3]);
            *(u32x2*)(H + (size_t)m * D + c) = w;
#pragma unroll
            for (int i = 0; i < 4; ++i)
#pragma unroll
                for (int c4 = 0; c4 < 4; ++c4) { const f32x4 wv = wl[((j * 4 + i) * 4 + c4) * 64 + F.lane];
                    acc[4 * c4 + 0] += hv[i] * wv[0]; acc[4 * c4 + 1] += hv[i] * wv[1]; acc[4 * c4 + 2] += hv[i] * wv[2]; acc[4 * c4 + 3] += hv[i] * wv[3]; }
        }
#pragma unroll
        for (int e = 0; e < NE; ++e) acc[e] = wave_sum(acc[e]);
        float scv[NE], bi[NE];
#pragma unroll
        for (int e = 0; e < NE; ++e) { scv[e] = 1.f / (1.f + expf(-acc[e])); bi[e] = scv[e] + rbias[e]; }
        int gsel = 0; float gbest = -INFINITY;
#pragma unroll
        for (int g = 0; g < 4; ++g) { float m1 = -INFINITY, m2 = -INFINITY;
#pragma unroll
            for (int j = 0; j < 4; ++j) { const float x = bi[g * 4 + j]; if (x > m1) { m2 = m1; m1 = x; } else if (x > m2) m2 = x; }
            const float gs = m1 + m2; if (gs > gbest) { gbest = gs; gsel = g; } }
        int e1 = -1, e2 = -1; float b1 = -INFINITY, b2 = -INFINITY, s1 = 0.f, s2 = 0.f;
#pragma unroll
        for (int j = 0; j < 4; ++j) { float x = -INFINITY, sx = 0.f;
#pragma unroll
            for (int g = 0; g < 4; ++g) if (g == gsel) { x = bi[g * 4 + j]; sx = scv[g * 4 + j]; }
            const int e = gsel * 4 + j;
            if (x > b1) { b2 = b1; e2 = e1; s2 = s1; b1 = x; e1 = e; s1 = sx; } else if (x > b2) { b2 = x; e2 = e; s2 = sx; } }
        if (F.lane == 0) {
            const float inv = 1.f / (s1 + s2); const int slot = it * NWAVES + F.wave;
            rec[slot * 4 + 0] = e1; rec[slot * 4 + 1] = e2;
            rec[slot * 4 + 2] = __hip_atomic_fetch_add(&lcnt[e1], 1, __ATOMIC_RELAXED, __HIP_MEMORY_SCOPE_WORKGROUP);
            rec[slot * 4 + 3] = __hip_atomic_fetch_add(&lcnt[e2], 1, __ATOMIC_RELAXED, __HIP_MEMORY_SCOPE_WORKGROUP);
            recw[slot * 2 + 0] = s1 * inv; recw[slot * 2 + 1] = s2 * inv;
        }
    }
    __syncthreads();
    if (F.tid < NE) lcnt[16 + F.tid] = (int)__hip_atomic_fetch_add(F.ctl + CW_CNT + (l * NE + F.tid) * 64, (unsigned)lcnt[F.tid], __ATOMIC_RELAXED, __HIP_MEMORY_SCOPE_AGENT);
    __syncthreads();
    unsigned* list = (unsigned*)(F.ws + WS_LIST); float* gwb = (float*)(F.ws + WS_GW);
    const int nrows = it;
    for (int s = F.tid; s < nrows * NWAVES; s += NTHREADS) {
        const int i2 = s / NWAVES, w = s % NWAVES; const int m = F.vcu * NWAVES + w + i2 * NGW;
        const int e1 = rec[s * 4 + 0], e2 = rec[s * 4 + 1];
        list[(size_t)e1 * T + lcnt[16 + e1] + rec[s * 4 + 2]] = (unsigned)(2 * m); list[(size_t)e2 * T + lcnt[16 + e2] + rec[s * 4 + 3]] = (unsigned)(2 * m + 1);
        gwb[2 * m] = recw[s * 2]; gwb[2 * m + 1] = recw[s * 2 + 1];
    }
}
__device__ __forceinline__ const LAS int* moe_table(Frame& F, int l) {
    LAS int* tab = (LAS int*)(F.lds + MISC_OFF + 1024);
    __syncthreads();
    if (F.tid == 0) { int acc = 0;
        for (int e = 0; e < NE; ++e) { const int c = (int)__hip_atomic_load(F.ctl + CW_CNT + (l * NE + e) * 64, __ATOMIC_RELAXED, __HIP_MEMORY_SCOPE_AGENT); tab[e] = acc; tab[32 + e] = c; acc += (c + 255) >> 8; }
        tab[16] = acc; }
    __syncthreads();
    return tab;
}

typedef __attribute__((address_space(4))) const Args CArgs;
#define PH_BEGIN() LAUNDER_V(F.tid); F.lane = F.tid & 63; unsigned char* ws = F.ws; LAUNDER_S(ws); CArgs* ka = (CArgs*)__builtin_amdgcn_kernarg_segment_ptr(); LAUNDER_S(ka); \
    float* mod = (float*)(ws + WS_MOD); (void)mod; (void)ka
#define WSP(T_, off) ((T_*)(ws + (off)))
__global__ void __launch_bounds__(NTHREADS, 2) fwd_kernel(Args args) {
    extern __shared__ __attribute__((aligned(16))) unsigned char lds_raw[];
    Frame F;
    F.lds = (LAS unsigned char*)lds_raw; F.MISC = (volatile LAS unsigned*)(F.lds + MISC_OFF);
    F.tid = threadIdx.x; F.lane = F.tid & 63; F.wave = __builtin_amdgcn_readfirstlane(F.tid >> 6);
    F.G = gridDim.x; { const int bx = blockIdx.x; F.vcu = (F.G % 8 == 0) ? (bx % 8) * (F.G / 8) + bx / 8 : bx; }
    F.ws = args.ws; F.ctl = (unsigned*)(args.ws + WS_CTL); F.X = args.out;
    if (F.tid < 64) F.MISC[F.tid] = 0u;
    __syncthreads();
    XcdBarrier bar; bar.bar = F.ctl + CW_BAR; bar.x = 0; bar.st = nullptr;
    if (!N_LAUNCH_MODE) bar = xcd_barrier_post(F.ctl + CW_BAR, F.MISC + 8);
    const int lo = args.ph_lo, hi = args.ph_hi;
#define IN(k) (lo <= (k) && (k) < hi)
#define SEAM(k) do { if ((k) + 1 < hi) { if (!N_LAUNCH_MODE) xcd_barrier(bar); } } while (0)
    const int cidx = (int)blockIdx.x;

    if (IN(0)) { PH_BEGIN(); p0_phase(F, ka->in[1], ka->in[2], ka->in[3]); SEAM(0); }
    for (int l = 0; l < NL; ++l) {
        const int pb = 1 + 9 * l;
        if (IN(pb + 0)) {
            PH_BEGIN();
            convert_weights(F, ka, l);
            row_phase(F, ka->in[0], l > 0 ? mod + (size_t)(l - 1) * NB * 6 * D : nullptr, ka->in[4] + l * D, mod + (size_t)l * NB * 6 * D, 0, D, WSP(bf16_t, WS_H), false);
            SEAM(pb + 0);
        }
        if (IN(pb + 1)) {
            PH_BEGIN();
            gp::Gemm g{WSP(bf16_t, WS_H), WSP(const bf16_t, WS_WIN), D, 0, nullptr}; gp::DenseOrder So; So.init(T, NIN, F.G, cidx);
            gp::EpiIn E{WSP(bf16_t, WS_QA), WSP(bf16_t, WS_KA), WSP(bf16_t, WS_VA), WSP(bf16_t, WS_QLAT), WSP(bf16_t, WS_KVLAT), WSP(bf16_t, WS_KB), WSP(bf16_t, WS_SA), WSP(bf16_t, WS_SB), WSP(float, WS_SSQ), WSP(float, WS_SSKV),
                        ka->in[6] + l * 64, ka->in[7] + l * 64, WSP(const float, WS_COSA), WSP(const float, WS_SINA), WSP(const float, WS_COSB), WSP(const float, WS_SINB)};
            gp::gemm_phase<gp::EpiIn, gp::DenseOrder>(F.tid, F.lds, g, So, E);
            SEAM(pb + 1);
        }
        if (IN(pb + 2)) {
            { PH_BEGIN(); gp::Gemm g{WSP(bf16_t, WS_QLAT), WSP(const bf16_t, WS_WQB), 384, 0, nullptr}; gp::DenseOrder So; So.init(T, 768, F.G, cidx);
              gp::EpiQb E{WSP(bf16_t, WS_QB), WSP(const float, WS_SSQ), WSP(const float, WS_COSB), WSP(const float, WS_SINB)}; gp::gemm_phase<gp::EpiQb, gp::DenseOrder>(F.tid, F.lds, g, So, E); }
            { PH_BEGIN(); gp::Gemm g{WSP(bf16_t, WS_KVLAT), WSP(const bf16_t, WS_WKVB), 256, 0, nullptr}; gp::DenseOrder So; So.init(T, 1024, F.G, F.G - 1 - cidx);
              gp::EpiKvb E{WSP(bf16_t, WS_KB), WSP(bf16_t, WS_VB), WSP(const float, WS_SSKV)}; gp::gemm_phase<gp::EpiKvb, gp::DenseOrder>(F.tid, F.lds, g, So, E); }
            { PH_BEGIN(); const at::Tensors A{WSP(bf16_t, WS_QA), 512, WSP(bf16_t, WS_KA), 128, WSP(bf16_t, WS_VA), 128, WSP(bf16_t, WS_QA), 512, 4}; at::attn_phase<64>(F.tid, F.lds, A, F.vcu, F.G); }
            SEAM(pb + 2);
        }
        if (IN(pb + 3)) {
            PH_BEGIN();
            const at::Tensors A{WSP(bf16_t, WS_QB), 768, WSP(bf16_t, WS_KB), 768, WSP(bf16_t, WS_VB), 512, WSP(bf16_t, WS_OB), 512, 1}; at::attn_phase<96>(F.tid, F.lds, A, F.vcu, F.G);
            SEAM(pb + 3);
        }
        if (IN(pb + 4)) {
            { PH_BEGIN(); gp::Gemm g{WSP(bf16_t, WS_QA), WSP(const bf16_t, WS_WPA), 512, 0, nullptr}; gp::DenseOrder So; So.init(T, D, F.G, cidx);
              gp::EpiProj<0> E{WSP(bf16_t, WS_H), WSP(const bf16_t, WS_SA)}; gp::gemm_phase<gp::EpiProj<0>, gp::DenseOrder>(F.tid, F.lds, g, So, E); }
            { PH_BEGIN(); gp::Gemm g{WSP(bf16_t, WS_OB), WSP(const bf16_t, WS_WPB), 512, 0, nullptr}; gp::DenseOrder So; So.init(T, D, F.G, cidx);
              gp::EpiProj<1> E{WSP(bf16_t, WS_H), WSP(const bf16_t, WS_SB)}; gp::gemm_phase<gp::EpiProj<1>, gp::DenseOrder>(F.tid, F.lds, g, So, E); }
            SEAM(pb + 4);
        }
        if (IN(pb + 5)) {
            PH_BEGIN();
            gp::Gemm g{WSP(bf16_t, WS_H), WSP(const bf16_t, WS_WO), D, 0, nullptr}; gp::DenseOrder So; So.init(T, D, F.G, cidx);
            gp::EpiWo E{F.X, mod + (size_t)l * NB * 6 * D}; gp::gemm_phase<gp::EpiWo, gp::DenseOrder>(F.tid, F.lds, g, So, E);
            SEAM(pb + 5);
        }
        if (IN(pb + 6)) {
            PH_BEGIN();
            t2_phase(F, ka->in[15] + l * D, mod + (size_t)l * NB * 6 * D, ka->in[16], ka->in[17], l);
            SEAM(pb + 6);
        }
        if (IN(pb + 7)) {
            PH_BEGIN();
            const LAS int* tab = moe_table(F, l);
            gp::Gemm g{WSP(bf16_t, WS_H), WSP(const bf16_t, WS_W13), D, (size_t)1024 * D, WSP(const unsigned, WS_LIST)}; gp::MoeOrder So; So.init(tab, F.G, cidx);
            gp::EpiUp E{WSP(bf16_t, WS_ACT)}; gp::gemm_phase<gp::EpiUp, gp::MoeOrder, true>(F.tid, F.lds, g, So, E);
            SEAM(pb + 7);
        }
        if (IN(pb + 8)) {
            PH_BEGIN();
            const LAS int* tab = moe_table(F, l);
            gp::Gemm g{WSP(bf16_t, WS_ACT), WSP(const bf16_t, WS_W2), FF, (size_t)D * FF, nullptr}; gp::MoeOrder So; So.init(tab, F.G, cidx);
            gp::EpiDown E{WSP(bf16_t, WS_Y2), WSP(const unsigned, WS_LIST), WSP(const float, WS_GW)}; gp::gemm_phase<gp::EpiDown, gp::MoeOrder, false>(F.tid, F.lds, g, So, E);
            SEAM(pb + 8);
        }
    }
    if (IN(NPHASE - 1)) { PH_BEGIN(); row_phase(F, nullptr, mod + (size_t)(NL - 1) * NB * 6 * D, ka->in[21], nullptr, 0, 0, nullptr, true); }
#undef IN
#undef SEAM
}

extern "C" void kernel_launch(void* const* d_in, const int* in_sizes, int n_in, void* d_out, int out_size, void* d_ws, size_t ws_size, hipStream_t stream) {
    static int grid = 0;
    if (grid == 0) {
        if (n_in != 22 || out_size != T * D || ws_size < WS_END) { fprintf(stderr, "kernel_launch: unexpected problem (n_in %d out %d ws %zu)\n", n_in, out_size, ws_size); grid = -1; return; }
        int dev = 0, cus = 0, per_cu = 0;
        if (hipGetDevice(&dev) != hipSuccess || hipDeviceGetAttribute(&cus, hipDeviceAttributeMultiprocessorCount, dev) != hipSuccess) { grid = -1; return; }
        if (hipFuncSetAttribute((const void*)fwd_kernel, hipFuncAttributeMaxDynamicSharedMemorySize, LDS_BYTES) != hipSuccess) { grid = -1; return; }
        if (hipOccupancyMaxActiveBlocksPerMultiprocessor(&per_cu, (const void*)fwd_kernel, NTHREADS, LDS_BYTES) != hipSuccess || per_cu < 1) { fprintf(stderr, "kernel_launch: occupancy query says %d\n", per_cu); }
        (void)hipGetLastError();
        grid = cus;
        if (T % (grid * NWAVES) != 0) { fprintf(stderr, "kernel_launch: grid %d does not divide the row phases\n", grid); grid = -1; return; }
    }
    if (grid < 0) return;
    (void)hipMemsetAsync((char*)d_ws + WS_CTL, 0, CTL_BYTES, stream);
    Args a{};
    for (int i = 0; i < 22; ++i) a.in[i] = (const float*)d_in[i];
    a.out = (float*)d_out; a.ws = (unsigned char*)d_ws;
#if N_LAUNCH_MODE
    for (int p = 0; p < NPHASE; ++p) { a.ph_lo = p; a.ph_hi = p + 1; hipLaunchKernelGGL(fwd_kernel, dim3(grid), dim3(NTHREADS), LDS_BYTES, stream, a); }
#else
    a.ph_lo = 0; a.ph_hi = NPHASE;
    hipLaunchKernelGGL(fwd_kernel, dim3(grid), dim3(NTHREADS), LDS_BYTES, stream, a);
#endif
}
```

```cpp
#include <hip/hip_runtime.h>
#include <stdint.h>
#include <stdio.h>
#include <math.h>

#ifndef FAST_GEMM
#define FAST_GEMM 1
#endif
#ifndef FAST_ATTN
#define FAST_ATTN 1
#endif
#ifndef N_LAUNCH_MODE
#define N_LAUNCH_MODE 0
#endif

#define LAS __attribute__((address_space(3)))
#define GAS __attribute__((address_space(1)))
typedef unsigned short bf16_t;
typedef short bf16x8 __attribute__((ext_vector_type(8)));
typedef float f32x4 __attribute__((ext_vector_type(4)));
typedef float f32x2 __attribute__((ext_vector_type(2)));
typedef float f32x16 __attribute__((ext_vector_type(16)));
typedef unsigned u32x4 __attribute__((ext_vector_type(4)));
typedef unsigned u32x2 __attribute__((ext_vector_type(2)));
typedef GAS unsigned gu32;

constexpr int D = 1024, NB = 8, S = 4096, T = NB * S, NL = 4, INC = 3488, NIN = 3584, NE = 16, FF = 512;
constexpr float EPS = 1e-6f, LOG2E = 1.4426950408889634f;
constexpr float QSCALE_A = 0.125f * LOG2E, QSCALE_B = 0.10206207261596577f * LOG2E;
constexpr int NWAVES = 8, NTHREADS = 512;
constexpr int NPHASE = 2 + 9 * NL;

constexpr size_t MiB = 1u << 20;
constexpr size_t WS_CTL = 0, CTL_BYTES = 1 * MiB;
constexpr size_t WS_MOD = 1 * MiB;
constexpr size_t WS_COSA = 2 * MiB, WS_SINA = WS_COSA + 512 * 1024, WS_COSB = 3 * MiB, WS_SINB = WS_COSB + 256 * 1024;
constexpr size_t WS_SSQ = 4 * MiB, WS_SSKV = 5 * MiB;
constexpr size_t WS_GW = 6 * MiB;
constexpr size_t WS_LIST = 7 * MiB;
constexpr size_t WS_WIN = 10 * MiB, WS_WQB = 17 * MiB, WS_WKVB = 18 * MiB, WS_WPA = 19 * MiB, WS_WPB = 20 * MiB, WS_WO = 21 * MiB, WS_W13 = 23 * MiB, WS_W2 = 55 * MiB;
constexpr size_t WS_H = 72 * MiB;
constexpr size_t WS_QA = 136 * MiB, WS_KA = 168 * MiB, WS_VA = 176 * MiB, WS_QLAT = 184 * MiB, WS_KVLAT = 208 * MiB;
constexpr size_t WS_KB = 224 * MiB, WS_VB = 272 * MiB, WS_QB = 304 * MiB, WS_OB = 352 * MiB, WS_SA = 384 * MiB, WS_SB = 448 * MiB, WS_END = 512 * MiB;
constexpr size_t WS_ACT = 136 * MiB, WS_Y2 = 208 * MiB;
constexpr int ACT_ROWS = 2 * T + NE * 256;
static_assert(WS_ACT + (size_t)ACT_ROWS * FF * 2 <= WS_Y2 && WS_Y2 + (size_t)2 * T * D * 2 <= WS_END, "moe overlay");
constexpr int CW_BAR = 4096;
constexpr int CW_CNT = 16384;

constexpr int RING_BYTES = 131072, MISC_OFF = RING_BYTES, LDS_BYTES = 147456;

__device__ __forceinline__ float bf2f(unsigned v) { return __uint_as_float(v << 16); }
__device__ __forceinline__ unsigned cvt_pk_bf16(float lo, float hi) { unsigned r; asm volatile("v_cvt_pk_bf16_f32 %0, %1, %2" : "=v"(r) : "v"(lo), "v"(hi)); return r; }
__device__ __forceinline__ u32x4 pack8(f32x4 a, f32x4 b) { u32x4 w; w.x = cvt_pk_bf16(a[0], a[1]); w.y = cvt_pk_bf16(a[2], a[3]); w.z = cvt_pk_bf16(b[0], b[1]); w.w = cvt_pk_bf16(b[2], b[3]); return w; }
__device__ __forceinline__ void unpack8(u32x4 w, f32x4& a, f32x4& b) { a[0] = bf2f(w.x & 0xffffu); a[1] = bf2f(w.x >> 16); a[2] = bf2f(w.y & 0xffffu); a[3] = bf2f(w.y >> 16); b[0] = bf2f(w.z & 0xffffu); b[1] = bf2f(w.z >> 16); b[2] = bf2f(w.w & 0xffffu); b[3] = bf2f(w.w >> 16); }
__device__ __forceinline__ float wave_sum(float v) {
#pragma unroll
    for (int o = 1; o < 64; o <<= 1) v += __shfl_xor(v, o);
    return v;
}
__device__ __forceinline__ float sigm(float v) { return 1.f / (1.f + __expf(-v)); }
#define VM_WAIT() asm volatile("s_waitcnt vmcnt(0)" ::: "memory")
#define LAUNDER_S(p) asm volatile("" : "+s"(p))
#define LAUNDER_V(v) asm volatile("" : "+v"(v))
#define LDS_WAIT() asm volatile("s_waitcnt lgkmcnt(0)" ::: "memory")

#define XB_TMO      128
#define XB_XCNT(j)  (256  + 64 * (j))
#define XB_XSUB(j)  (1280 + 64 * (j))
#define XB_XGEN(j)  (2304 + 64 * (j))
#define XB_TOP      3328
#define XB_TOPGEN   3392
#define XCD_BAR_WORDS 3456
#define XB_SPIN_CAP (1u << 22)
__device__ __forceinline__ unsigned xb_ld(unsigned* p)              { return __hip_atomic_load(p, __ATOMIC_RELAXED, __HIP_MEMORY_SCOPE_AGENT); }
__device__ __forceinline__ unsigned xb_add(unsigned* p, unsigned v) { return __hip_atomic_fetch_add(p, v, __ATOMIC_RELAXED, __HIP_MEMORY_SCOPE_AGENT); }
__device__ __forceinline__ unsigned xb_xcc_id() { return (unsigned)__builtin_amdgcn_s_getreg((3 << 11) | 20) & 0xFu; }
#define XB_SPIN(cond, bar) do { unsigned _sp = 0; while (cond) { __builtin_amdgcn_s_sleep(1); \
    if ((++_sp & 255u) == 0u) { if (xb_ld(&(bar)[XB_TMO])) break; if (_sp > XB_SPIN_CAP) { atomicAdd(&(bar)[XB_TMO], 1u); break; } } } } while (0)
struct XcdBarrier { unsigned* bar; unsigned x; volatile LAS unsigned* st; };
__device__ __forceinline__ XcdBarrier xcd_barrier_post(unsigned* bar, volatile LAS unsigned* st) {
    XcdBarrier b; b.bar = bar; b.x = xb_xcc_id(); b.st = st;
    if (threadIdx.x == 0) (void)xb_add(&bar[XB_XCNT(b.x)], 1u);
    return b;
}
__device__ __forceinline__ void xcd_barrier_complete(unsigned* bar, unsigned x, unsigned& nloc, unsigned& nx) {
    const unsigned G = gridDim.x * gridDim.y * gridDim.z;
    unsigned sum, cnt, mine, sp = 0u;
    for (;;) {
        sum = 0u; cnt = 0u; mine = 0u;
#pragma unroll
        for (unsigned j = 0; j < 16; ++j) { const unsigned c = xb_ld(&bar[XB_XCNT(j)]); sum += c; cnt += (c > 0u) ? 1u : 0u; mine = (j == x) ? c : mine; }
        if (sum == G) break;
        __builtin_amdgcn_s_sleep(1);
        if ((++sp & 255u) == 0u) { if (xb_ld(&bar[XB_TMO])) break; if (sp > XB_SPIN_CAP) { atomicAdd(&bar[XB_TMO], 1u); break; } }
    }
    nloc = mine > 0u ? mine : 1u; nx = cnt > 0u ? cnt : 1u;
}
__device__ __forceinline__ void xcd_barrier(const XcdBarrier& b) {
    asm volatile("s_waitcnt vmcnt(0)" ::: "memory");
    __syncthreads();
    if (threadIdx.x == 0) {
        unsigned* bar = b.bar;
        __builtin_amdgcn_s_waitcnt(0);
        unsigned nloc = b.st[0], nx = b.st[1];
        if (nloc == 0u) { xcd_barrier_complete(bar, b.x, nloc, nx); b.st[0] = nloc; b.st[1] = nx; }
        const unsigned old = xb_add(&bar[XB_XSUB(b.x)], 1u);
        const unsigned gen = old / nloc;
        if (old + 1u == (gen + 1u) * nloc) {
            __builtin_amdgcn_fence(__ATOMIC_RELEASE, "agent");
            asm volatile("s_waitcnt vmcnt(0)" ::: "memory");
            const unsigned og = xb_add(&bar[XB_TOP], 1u);
            const unsigned tg = og / nx;
            if (og + 1u == (tg + 1u) * nx) xb_add(&bar[XB_TOPGEN], 1u);
            else XB_SPIN(xb_ld(&bar[XB_TOPGEN]) == tg, bar);
            __builtin_amdgcn_fence(__ATOMIC_ACQUIRE, "agent");
            xb_add(&bar[XB_XGEN(b.x)], 1u);
            asm volatile("s_waitcnt vmcnt(0)" ::: "memory");
        } else {
            XB_SPIN(xb_ld(&bar[XB_XGEN(b.x)]) == gen, bar);
            __builtin_amdgcn_fence(__ATOMIC_ACQUIRE, "agent");
            asm volatile("s_waitcnt vmcnt(0)" ::: "memory");
        }
    }
    __syncthreads();
}

namespace gp {
constexpr int BM = 256, BK = 64, HALF = 128, HTB = HALF * BK * 2, NXCD = 8, WGM = 8;
__host__ __device__ __forceinline__ int lds_byte(int r, int c) { const int st = (r >> 4) * 2 + (c >> 5), rr = r & 15, cc = c & 31, ob = rr * 64 + cc * 2; return st * 1024 + (ob ^ (((ob >> 9) & 1) << 5)); }
__host__ __device__ __forceinline__ void stage_rc(int b, int& R, int& C) { const int st = b / 1024, sb = b % 1024, swz = sb ^ (((sb >> 9) & 1) << 5); R = (st >> 1) * 16 + swz / 64; C = (st & 1) * 32 + (swz % 64) / 2; }
__host__ __device__ __forceinline__ int perm32(int rho) { const int n = rho >> 4, i = rho & 15; return 8 * (i >> 2) + 4 * n + (i & 3); }

struct Unit { int pm, pn, be, rl, nv; };
struct Gemm { const bf16_t* A; const bf16_t* Bt; int K; size_t bstride; const unsigned* list; };

__device__ __forceinline__ int xcd_remap(int wgid, int nwg) { const int q = nwg / NXCD, r = nwg % NXCD, xcd = wgid % NXCD, off = wgid / NXCD; return (xcd < r ? xcd * (q + 1) : r * (q + 1) + (xcd - r) * q) + off; }
struct DenseOrder {
    int nM, nN, nwg, G, c;
    __device__ void init(int M, int N, int G_, int c_) { nM = M / BM; nN = N / BM; nwg = nM * nN; G = G_; c = c_; }
    __device__ bool next(int i, Unit& u) const {
        const long L = (long)i * G + c; if (L >= nwg) return false;
        const int wgid = xcd_remap((int)L, nwg);
        const int nig = WGM * nN, gid = wgid / nig, fm = gid * WGM, gsz = (nM - fm) < WGM ? (nM - fm) : WGM;
        u.pm = fm + ((wgid % nig) % gsz); u.pn = (wgid % nig) / gsz; u.be = 0; u.rl = 0; u.nv = 256; return true;
    }
};
struct MoeOrder {
    const LAS int* tab; int nwg, G, c;
    __device__ static int rd(const LAS int* p) { return __builtin_amdgcn_readfirstlane(*p); }
    __device__ void init(const LAS int* tab_, int G_, int c_) { tab = tab_; nwg = rd(tab_ + 16) * 4; G = G_; c = c_; }
    __device__ bool next(int i, Unit& u) const {
        const long L = (long)i * G + c; if (L >= nwg) return false;
        const int wgid = xcd_remap((int)L, nwg);
        const int tile = wgid >> 2; int e = 0;
        for (int k = 1; k < NE; ++k) e += (rd(tab + k) <= tile) ? 1 : 0;
        u.pm = tile; u.pn = wgid & 3; u.be = e; u.rl = tile - rd(tab + e); const int rem = rd(tab + 32 + e) - u.rl * 256; u.nv = rem < 256 ? rem : 256; return true;
    }
};

#define ACC_T f32x4 (&acc)[2][2][4][2]

template <class Epi, class Sched, bool GATHER>
__device__ __forceinline__ void gemm_phase_ref(int tid, const Gemm g, const Sched& S, const Epi& E) {
    const int wid = __builtin_amdgcn_readfirstlane(tid >> 6), lane = tid & 63, wr = wid >> 2, wc = wid & 3, fr = lane & 15, fq = lane >> 4;
    const int K = g.K; Unit u;
    for (int ui = 0; S.next(ui, u); ++ui) {
        f32x4 acc[2][2][4][2];
#pragma unroll
        for (int a = 0; a < 2; ++a)
#pragma unroll
            for (int b = 0; b < 2; ++b)
#pragma unroll
                for (int m = 0; m < 4; ++m)
#pragma unroll
                    for (int n = 0; n < 2; ++n) acc[a][b][m][n] = (f32x4){0.f, 0.f, 0.f, 0.f};
        const bf16_t* Bt = g.Bt + (size_t)u.be * g.bstride + (size_t)u.pn * 256 * K;
        for (int ai = 0; ai < 2; ++ai)
            for (int m = 0; m < 4; ++m) {
                const int rloc = ai * 128 + wr * 64 + m * 16 + fr;
                size_t arow;
                if (GATHER) { arow = (rloc < u.nv) ? (size_t)(g.list[(size_t)u.be * T + u.rl * 256 + rloc] >> 1) : 0; }
                else arow = (size_t)u.pm * 256 + rloc;
                const bf16_t* ap = g.A + arow * K;
                for (int bj = 0; bj < 2; ++bj) {
                    const bf16_t* bp = Bt + (size_t)(bj * 128 + wc * 32 + fq * 8) * K;
                    float s[8];
#pragma unroll
                    for (int c = 0; c < 8; ++c) {
                        float sc = 0.f; const bf16_t* bpc = bp + (size_t)c * K;
#pragma unroll 2
                        for (int k = 0; k < K; k += 8) {
                            f32x4 a0, a1, b0, b1; unpack8(*(const u32x4*)(ap + k), a0, a1); unpack8(*(const u32x4*)(bpc + k), b0, b1);
                            sc += a0[0] * b0[0] + a0[1] * b0[1] + a0[2] * b0[2] + a0[3] * b0[3] + a1[0] * b1[0] + a1[1] * b1[1] + a1[2] * b1[2] + a1[3] * b1[3];
                        }
                        s[c] = sc; asm volatile("" : "+v"(s[c]));
                    }
#pragma unroll
                    for (int a2 = 0; a2 < 2; ++a2)
#pragma unroll
                        for (int b2 = 0; b2 < 2; ++b2)
#pragma unroll
                            for (int m2 = 0; m2 < 4; ++m2)
                                if (a2 == ai && b2 == bj && m2 == m) { acc[a2][b2][m2][0] = (f32x4){s[0], s[1], s[2], s[3]}; acc[a2][b2][m2][1] = (f32x4){s[4], s[5], s[6], s[7]}; }
                }
            }
        E(acc, u, wr, wc, fr, fq);
    }
}

#if FAST_GEMM
template <class Epi, class Sched, bool GATHER>
__device__ __forceinline__ void gemm_phase_fast(int tid, LAS unsigned char* lds, const Gemm g, const Sched& S, const Epi& E) {
    const int wid = __builtin_amdgcn_readfirstlane(tid >> 6), lane = tid & 63, wr = wid >> 2, wc = wid & 3, fr = lane & 15, fq = lane >> 4;
    const int K = g.K, nt = K / BK;
    int Rr[2], Cc[2]; unsigned voffB[2];
#pragma unroll
    for (int i = 0; i < 2; ++i) { stage_rc(tid * 16 + i * 8192, Rr[i], Cc[i]); const int Rb = (Rr[i] & ~31) + perm32(Rr[i] & 31); voffB[i] = (unsigned)(Rb * K + Cc[i]) * 2u; }
    const size_t kstep = (size_t)(BK * 2), hstep = (size_t)HALF * K * 2, tstep = 2 * hstep;
    const unsigned ldsw = (unsigned)wid * 1024u;
    const int aoff = lds_byte(wr * 64 + fr, fq * 8), boff = lds_byte(wc * 32 + fr, fq * 8);
#define GP_SA(b, h) (((b) * 2 + (h)) * HTB)
#define GP_SB(b, h) ((4 + (b) * 2 + (h)) * HTB)
#define GP_STAGE2(bufoff, gbase, v0, v1) do { \
        __builtin_amdgcn_global_load_lds((const unsigned*)((const char*)(gbase) + (v0)), (LAS unsigned*)(lds + (bufoff) + ldsw), 16, 0, 0); \
        __builtin_amdgcn_global_load_lds((const unsigned*)((const char*)(gbase) + (v1)), (LAS unsigned*)(lds + (bufoff) + ldsw + 8192), 16, 0, 0); } while (0)
#define GP_STAGEB(bufoff, gbase) GP_STAGE2(bufoff, gbase, voffB[0], voffB[1])
#define GP_LDA(dst, b, h) do { _Pragma("unroll") for (int m = 0; m < 4; ++m) _Pragma("unroll") for (int k = 0; k < 2; ++k) dst[m][k] = *(const LAS bf16x8*)(lds + GP_SA(b, h) + aoff + m * 2048 + k * 1024); } while (0)
#define GP_LDB(dst, b, h) do { _Pragma("unroll") for (int n = 0; n < 2; ++n) _Pragma("unroll") for (int k = 0; k < 2; ++k) dst[n][k] = *(const LAS bf16x8*)(lds + GP_SB(b, h) + boff + n * 2048 + k * 1024); } while (0)
#define GP_MMA(ai, bj, At, Bt) do { __builtin_amdgcn_s_setprio(1); _Pragma("unroll") for (int m = 0; m < 4; ++m) _Pragma("unroll") for (int n = 0; n < 2; ++n) _Pragma("unroll") for (int k = 0; k < 2; ++k) \
        acc[ai][bj][m][n] = __builtin_amdgcn_mfma_f32_16x16x32_bf16(Bt[n][k], At[m][k], acc[ai][bj][m][n], 0, 0, 0); __builtin_amdgcn_s_setprio(0); } while (0)
#define GP_WAIT_V(n) asm volatile("s_waitcnt vmcnt(" #n ")" ::: "memory")
#define GP_WAIT_L(n) asm volatile("s_waitcnt lgkmcnt(" #n ")" ::: "memory")
#define GP_BAR __builtin_amdgcn_s_barrier()
#define GP_SCHED __builtin_amdgcn_sched_barrier(0)
    Unit cur, nxt; int ui = 0;
    if (!S.next(0, cur)) return;
    f32x4 acc[2][2][4][2];
#pragma unroll
    for (int a = 0; a < 2; ++a)
#pragma unroll
        for (int b = 0; b < 2; ++b)
#pragma unroll
            for (int m = 0; m < 4; ++m)
#pragma unroll
                for (int n = 0; n < 2; ++n) acc[a][b][m][n] = (f32x4){0.f, 0.f, 0.f, 0.f};
    bf16x8 At[4][2], B0[2][2], B1[2][2];
    unsigned vC0, vC1, vC2, vC3, vN0, vN1, vN2, vN3;
#define GP_VOFF(u, o0, o1, o2, o3) do { if (GATHER) { \
        int tl_ = tid; LAUNDER_V(tl_); int R0_, C0_, R1_, C1_; stage_rc(tl_ * 16, R0_, C0_); stage_rc(tl_ * 16 + 8192, R1_, C1_);     \
        const unsigned* lp = g.list + (size_t)(u).be * T + (u).rl * 256; \
        const int nvm = (u).nv - 1; const int p0 = min(R0_, nvm), p1 = min(R1_, nvm), p2 = min(128 + R0_, nvm), p3 = min(128 + R1_, nvm); \
        const unsigned t0 = lp[p0] >> 1, t1 = lp[p1] >> 1, t2 = lp[p2] >> 1, t3 = lp[p3] >> 1; \
        o0 = (t0 * K + C0_) * 2u; o1 = (t1 * K + C1_) * 2u; o2 = (t2 * K + C0_) * 2u; o3 = (t3 * K + C1_) * 2u; \
      } else { o0 = (unsigned)(Rr[0] * K + Cc[0]) * 2u; o1 = (unsigned)(Rr[1] * K + Cc[1]) * 2u; o2 = o0 + (unsigned)hstep; o3 = o1 + (unsigned)hstep; } } while (0)
    GP_VOFF(cur, vC0, vC1, vC2, vC3);
    const char* cA = (const char*)g.A + (GATHER ? (size_t)0 : (size_t)cur.pm * tstep);
    const char* cB = (const char*)g.Bt + ((size_t)cur.be * g.bstride) * 2 + (size_t)cur.pn * tstep;
    GP_STAGEB(GP_SB(0, 0), cB); GP_STAGEB(GP_SB(0, 1), cB + hstep); GP_STAGE2(GP_SA(0, 0), cA, vC0, vC1); GP_STAGE2(GP_SA(0, 1), cA, vC2, vC3);
    if (wr == 1) GP_BAR;
    GP_WAIT_V(2); GP_BAR;
    GP_STAGEB(GP_SB(1, 0), cB + kstep); GP_STAGE2(GP_SA(1, 0), cA + kstep, vC0, vC1); GP_STAGEB(GP_SB(1, 1), cB + hstep + kstep);
    GP_WAIT_V(6); GP_BAR;
    for (;;) {
        const bool has_next = S.next(ui + 1, nxt);
        const char* nA = has_next ? (const char*)g.A + (GATHER ? (size_t)0 : (size_t)nxt.pm * tstep) : cA;
        const char* nB = has_next ? (const char*)g.Bt + ((size_t)nxt.be * g.bstride) * 2 + (size_t)nxt.pn * tstep : cB;
        if (has_next) { GP_VOFF(nxt, vN0, vN1, vN2, vN3); } else { vN0 = vC0; vN1 = vC1; vN2 = vC2; vN3 = vC3; }
#pragma nounroll
        for (int t = 0; t < nt; t += 2) {
            const bool last = (t == nt - 2);
            const char* a1 = cA + (size_t)(t + 1) * kstep;
            const char* a2 = last ? nA : cA + (size_t)(t + 2) * kstep; const char* b2 = last ? nB : cB + (size_t)(t + 2) * kstep;
            const char* a3 = a2 + kstep; const char* b3 = b2 + kstep;
            const unsigned w0 = last ? vN0 : vC0, w1 = last ? vN1 : vC1, w2 = last ? vN2 : vC2, w3 = last ? vN3 : vC3;
            GP_LDB(B0, 0, 0); GP_LDB(B1, 0, 1); GP_SCHED; GP_LDA(At, 0, 0); GP_STAGE2(GP_SA(1, 1), a1, vC2, vC3);
            GP_WAIT_V(8); GP_WAIT_L(0); GP_BAR; GP_MMA(0, 0, At, B0); GP_MMA(0, 1, At, B1); GP_BAR; GP_SCHED;
            GP_LDA(At, 0, 1); GP_STAGEB(GP_SB(0, 0), b2); GP_STAGEB(GP_SB(0, 1), b2 + hstep); GP_STAGE2(GP_SA(0, 0), a2, w0, w1);
            GP_WAIT_V(8); GP_WAIT_L(0); GP_BAR; GP_MMA(1, 0, At, B0); GP_MMA(1, 1, At, B1); GP_BAR; GP_SCHED;
            GP_LDB(B0, 1, 0); GP_LDB(B1, 1, 1); GP_SCHED; GP_LDA(At, 1, 0); GP_STAGE2(GP_SA(0, 1), a2, w2, w3);
            GP_WAIT_V(8); GP_WAIT_L(0); GP_BAR; GP_MMA(0, 0, At, B0); GP_MMA(0, 1, At, B1); GP_BAR; GP_SCHED;
            GP_LDA(At, 1, 1); GP_STAGEB(GP_SB(1, 0), b3); GP_STAGEB(GP_SB(1, 1), b3 + hstep); GP_STAGE2(GP_SA(1, 0), a3, w0, w1);
            GP_WAIT_V(8); GP_WAIT_L(0); GP_BAR; GP_MMA(1, 0, At, B0); GP_MMA(1, 1, At, B1); GP_BAR; GP_SCHED;
        }
        if (wr == 0) GP_BAR;
        E(acc, cur, wr, wc, fr, fq);
        if (!has_next) break;
#pragma unroll
        for (int a = 0; a < 2; ++a)
#pragma unroll
            for (int b = 0; b < 2; ++b)
#pragma unroll
                for (int m = 0; m < 4; ++m)
#pragma unroll
                    for (int n = 0; n < 2; ++n) acc[a][b][m][n] = (f32x4){0.f, 0.f, 0.f, 0.f};
        cur = nxt; cA = nA; cB = nB; vC0 = vN0; vC1 = vN1; vC2 = vN2; vC3 = vN3; ++ui;
        if (wr == 1) GP_BAR;
    }
    GP_WAIT_V(0);
    GP_BAR;
#undef GP_SA
#undef GP_SB
#undef GP_STAGE2
#undef GP_STAGEB
#undef GP_LDA
#undef GP_LDB
#undef GP_MMA
#undef GP_WAIT_V
#undef GP_WAIT_L
#undef GP_BAR
#undef GP_SCHED
#undef GP_VOFF
}
#endif

template <class Epi, class Sched, bool GATHER = false>
__device__ __forceinline__ void gemm_phase(int tid, LAS unsigned char* lds, const Gemm g, const Sched& S, const Epi& E) {
#if FAST_GEMM
    gemm_phase_fast<Epi, Sched, GATHER>(tid, lds, g, S, E);
#else
    (void)lds; gemm_phase_ref<Epi, Sched, GATHER>(tid, g, S, E);
#endif
}

#define EPI_ROW(ai, m) (u.pm * 256 + (ai) * 128 + wr * 64 + (m) * 16 + fr)
#define EPI_COL(bj) (u.pn * 256 + (bj) * 128 + wc * 32 + fq * 8)
__device__ __forceinline__ float dot4(f32x4 a) { return (a[0] * a[0] + a[1] * a[1]) + (a[2] * a[2] + a[3] * a[3]); }

struct EpiIn {
    bf16_t *QA, *KA, *VA, *QLAT, *KVLAT, *KB, *SA, *SB; float *SSQ, *SSKV; const float *gq, *gk, *cosA, *sinA, *cosB, *sinB;
    __device__ __forceinline__ void operator()(const ACC_T, const Unit& u, int wr, int wc, int fr, int fq) const {
        const int wb = u.pn * 4 + wc;
        if (wb < 10) {
            const bool isq = wb < 8; const int head = isq ? wb : wb - 8; const float* g = isq ? gq : gk; bf16_t* dst = isq ? QA : KA; const int dp = isq ? 512 : 128; const float qs = isq ? QSCALE_A : 1.f;
            const f32x4 g00 = *(const f32x4*)(g + 8 * fq), g01 = *(const f32x4*)(g + 8 * fq + 4), g10 = *(const f32x4*)(g + 32 + 8 * fq), g11 = *(const f32x4*)(g + 36 + 8 * fq);
#pragma unroll
            for (int ai = 0; ai < 2; ++ai)
#pragma unroll
                for (int m = 0; m < 4; ++m) {
                    const int r = EPI_ROW(ai, m), pos = r & (S - 1);
                    const f32x4 v00 = acc[ai][0][m][0], v01 = acc[ai][0][m][1], v10 = acc[ai][1][m][0], v11 = acc[ai][1][m][1];
                    float ss = (dot4(v00) + dot4(v01)) + (dot4(v10) + dot4(v11)); ss += __shfl_xor(ss, 16); ss += __shfl_xor(ss, 32);
                    const float rstd = rsqrtf(ss * (1.f / 64.f) + EPS);
                    const f32x4 y00 = v00 * rstd * g00, y01 = v01 * rstd * g01, y10 = v10 * rstd * g10, y11 = v11 * rstd * g11;
                    const f32x4 c0 = *(const f32x4*)(cosA + pos * 32 + 8 * fq), c1 = *(const f32x4*)(cosA + pos * 32 + 8 * fq + 4), s0 = *(const f32x4*)(sinA + pos * 32 + 8 * fq), s1 = *(const f32x4*)(sinA + pos * 32 + 8 * fq + 4);
                    const f32x4 o00 = (y00 * c0 - y10 * s0) * qs, o01 = (y01 * c1 - y11 * s1) * qs, o10 = (y10 * c0 + y00 * s0) * qs, o11 = (y11 * c1 + y01 * s1) * qs;
                    bf16_t* p = dst + (size_t)r * dp + head * 64 + 8 * fq;
                    *(u32x4*)p = pack8(o00, o01); *(u32x4*)(p + 32) = pack8(o10, o11);
                }
        } else if (wb < 12) {
#pragma unroll
            for (int ai = 0; ai < 2; ++ai)
#pragma unroll
                for (int m = 0; m < 4; ++m) { bf16_t* p = VA + (size_t)EPI_ROW(ai, m) * 128 + (wb - 10) * 64 + 8 * fq;
                    *(u32x4*)p = pack8(acc[ai][0][m][0], acc[ai][0][m][1]); *(u32x4*)(p + 32) = pack8(acc[ai][1][m][0], acc[ai][1][m][1]); }
        } else if (wb < 22) {
            const bool isq = wb < 18; const int idx = isq ? wb - 12 : wb - 18; bf16_t* dst = isq ? QLAT : KVLAT; const int dp = isq ? 384 : 256;
#pragma unroll
            for (int ai = 0; ai < 2; ++ai)
#pragma unroll
                for (int m = 0; m < 4; ++m) {
                    const int r = EPI_ROW(ai, m);
                    const f32x4 v00 = acc[ai][0][m][0], v01 = acc[ai][0][m][1], v10 = acc[ai][1][m][0], v11 = acc[ai][1][m][1];
                    float ss = (dot4(v00) + dot4(v01)) + (dot4(v10) + dot4(v11)); ss += __shfl_xor(ss, 16); ss += __shfl_xor(ss, 32);
                    if (fq == 0) { if (isq) SSQ[(size_t)r * 8 + idx] = ss; else SSKV[(size_t)r * 4 + idx] = ss; }
                    bf16_t* p = dst + (size_t)r * dp + idx * 64 + 8 * fq;
                    *(u32x4*)p = pack8(v00, v01); *(u32x4*)(p + 32) = pack8(v10, v11);
                }
        } else if (wb == 22) {
            if (fq < 2) {
#pragma unroll
                for (int ai = 0; ai < 2; ++ai)
#pragma unroll
                    for (int m = 0; m < 4; ++m) {
                        const int r = EPI_ROW(ai, m), pos = r & (S - 1);
                        const f32x4 x10 = acc[ai][0][m][0], x11 = acc[ai][0][m][1], x20 = acc[ai][1][m][0], x21 = acc[ai][1][m][1];
                        const f32x4 c0 = *(const f32x4*)(cosB + pos * 16 + 8 * fq), c1 = *(const f32x4*)(cosB + pos * 16 + 8 * fq + 4), s0 = *(const f32x4*)(sinB + pos * 16 + 8 * fq), s1 = *(const f32x4*)(sinB + pos * 16 + 8 * fq + 4);
                        const u32x4 w1 = pack8(x10 * c0 - x20 * s0, x11 * c1 - x21 * s1), w2 = pack8(x20 * c0 + x10 * s0, x21 * c1 + x11 * s1);
                        bf16_t* p = KB + (size_t)r * 768 + 64 + 8 * fq;
#pragma unroll
                        for (int h = 0; h < 8; ++h) { *(u32x4*)(p + h * 96) = w1; *(u32x4*)(p + h * 96 + 16) = w2; }
                    }
            }
        } else if (wb == 23) {
        } else {
            const bool isa = wb < 40; const int idx = isa ? wb - 24 : wb - 40; bf16_t* dst = isa ? SA : SB;
#pragma unroll
            for (int ai = 0; ai < 2; ++ai)
#pragma unroll
                for (int m = 0; m < 4; ++m) { bf16_t* p = dst + (size_t)EPI_ROW(ai, m) * 1024 + idx * 64 + 8 * fq;
#pragma unroll
                    for (int bj = 0; bj < 2; ++bj) { f32x4 a = acc[ai][bj][m][0], b = acc[ai][bj][m][1];
#pragma unroll
                        for (int j = 0; j < 4; ++j) { a[j] = sigm(a[j]); b[j] = sigm(b[j]); }
                        *(u32x4*)(p + bj * 32) = pack8(a, b); } }
        }
    }
};
__host__ __device__ __forceinline__ int src_col_in(int n) {
    const int pn = n >> 8, nl = n & 255, bj = nl >> 7, wc = (nl & 127) >> 5, p = nl & 31, wb = pn * 4 + wc, s = bj * 32 + p;
    if (wb < 8) return wb * 64 + s;
    if (wb < 10) return 512 + (wb - 8) * 64 + s;
    if (wb < 12) return 640 + (wb - 10) * 64 + s;
    if (wb < 18) return 768 + (wb - 12) * 64 + s;
    if (wb < 22) return 1152 + (wb - 18) * 64 + s;
    if (wb == 22) return p < 16 ? 1408 + bj * 16 + p : -1;
    if (wb == 23) return -1;
    if (wb < 40) return 1440 + (wb - 24) * 64 + s;
    return 2464 + (wb - 40) * 64 + s;
}
struct EpiQb {
    bf16_t* QB; const float *SSQ, *cosB, *sinB;
    __device__ __forceinline__ void operator()(const ACC_T, const Unit& u, int wr, int wc, int fr, int fq) const {
#pragma unroll
        for (int ai = 0; ai < 2; ++ai)
#pragma unroll
            for (int m = 0; m < 4; ++m) {
                const int r = EPI_ROW(ai, m), pos = r & (S - 1);
                const f32x4 sa = *(const f32x4*)(SSQ + (size_t)r * 8); const f32x2 sb = *(const f32x2*)(SSQ + (size_t)r * 8 + 4);
                const float rstd = rsqrtf((((sa[0] + sa[1]) + (sa[2] + sa[3])) + (sb[0] + sb[1])) * (1.f / 384.f) + EPS);
#pragma unroll
                for (int bj = 0; bj < 2; ++bj) {
                    f32x4 v0 = acc[ai][bj][m][0] * rstd, v1 = acc[ai][bj][m][1] * rstd;
                    const int c32 = u.pn * 8 + bj * 4 + wc;
                    if (c32 % 3 == 2) {
                        f32x4 o0, o1;
#pragma unroll
                        for (int j = 0; j < 4; ++j) { o0[j] = __shfl_xor(v0[j], 32); o1[j] = __shfl_xor(v1[j], 32); }
                        const int i0 = 8 * (fq & 1);
                        const f32x4 c0 = *(const f32x4*)(cosB + pos * 16 + i0), c1 = *(const f32x4*)(cosB + pos * 16 + i0 + 4), s0 = *(const f32x4*)(sinB + pos * 16 + i0), s1 = *(const f32x4*)(sinB + pos * 16 + i0 + 4);
                        if (fq < 2) { v0 = v0 * c0 - o0 * s0; v1 = v1 * c1 - o1 * s1; } else { v0 = v0 * c0 + o0 * s0; v1 = v1 * c1 + o1 * s1; }
                    }
                    *(u32x4*)(QB + (size_t)r * 768 + EPI_COL(bj)) = pack8(v0 * QSCALE_B, v1 * QSCALE_B);
                }
            }
    }
};
struct EpiKvb {
    bf16_t *KB, *VB; const float* SSKV;
    __device__ __forceinline__ void operator()(const ACC_T, const Unit& u, int wr, int wc, int fr, int fq) const {
#pragma unroll
        for (int ai = 0; ai < 2; ++ai)
#pragma unroll
            for (int m = 0; m < 4; ++m) {
                const int r = EPI_ROW(ai, m);
                const f32x4 sa = *(const f32x4*)(SSKV + (size_t)r * 4);
                const float rstd = rsqrtf(((sa[0] + sa[1]) + (sa[2] + sa[3])) * (1.f / 256.f) + EPS);
#pragma unroll
                for (int bj = 0; bj < 2; ++bj) {
                    const int head = u.pn * 2 + bj, o = wc * 32 + fq * 8;
                    const u32x4 w = pack8(acc[ai][bj][m][0] * rstd, acc[ai][bj][m][1] * rstd);
                    if (wc < 2) *(u32x4*)(KB + (size_t)r * 768 + head * 96 + o) = w; else *(u32x4*)(VB + (size_t)r * 512 + head * 64 + (o - 64)) = w;
                }
            }
    }
};
template <int MODE> struct EpiProj {
    bf16_t* O; const bf16_t* gate;
    __device__ __forceinline__ void operator()(const ACC_T, const Unit& u, int wr, int wc, int fr, int fq) const {
#pragma unroll
        for (int ai = 0; ai < 2; ++ai)
#pragma unroll
            for (int m = 0; m < 4; ++m) {
                const int r = EPI_ROW(ai, m);
#pragma unroll
                for (int bj = 0; bj < 2; ++bj) {
                    const size_t off = (size_t)r * D + EPI_COL(bj);
                    f32x4 g0, g1; unpack8(*(const u32x4*)(gate + off), g0, g1);
                    f32x4 v0 = acc[ai][bj][m][0] * g0, v1 = acc[ai][bj][m][1] * g1;
                    if (MODE == 1) { f32x4 p0, p1; unpack8(*(const u32x4*)(O + off), p0, p1); v0 += p0; v1 += p1; }
                    *(u32x4*)(O + off) = pack8(v0, v1);
                }
            }
    }
};
struct EpiWo {
    float* X; const float* modl;
    __device__ __forceinline__ void operator()(const ACC_T, const Unit& u, int wr, int wc, int fr, int fq) const {
        const float* g1 = modl + (size_t)(u.pm >> 4) * 6 * D + 2 * D;
#pragma unroll
        for (int bj = 0; bj < 2; ++bj) {
            const int c = EPI_COL(bj); const f32x4 ga = *(const f32x4*)(g1 + c), gb = *(const f32x4*)(g1 + c + 4);
#pragma unroll
            for (int ai = 0; ai < 2; ++ai)
#pragma unroll
                for (int m = 0; m < 4; ++m) { float* p = X + (size_t)EPI_ROW(ai, m) * D + c;
                    const f32x4 x0 = *(const f32x4*)p, x1 = *(const f32x4*)(p + 4);
                    *(f32x4*)p = x0 + ga * acc[ai][bj][m][0]; *(f32x4*)(p + 4) = x1 + gb * acc[ai][bj][m][1]; }
        }
    }
};
struct EpiUp {
    bf16_t* ACT;
    __device__ __forceinline__ void operator()(const ACC_T, const Unit& u, int wr, int wc, int fr, int fq) const {
#pragma unroll
        for (int ai = 0; ai < 2; ++ai)
#pragma unroll
            for (int m = 0; m < 4; ++m) {
                f32x4 a = acc[ai][0][m][0], b = acc[ai][0][m][1]; const f32x4 c = acc[ai][1][m][0], d = acc[ai][1][m][1];
#pragma unroll
                for (int j = 0; j < 4; ++j) { a[j] = a[j] * sigm(a[j]) * c[j]; b[j] = b[j] * sigm(b[j]) * d[j]; }
                *(u32x4*)(ACT + (size_t)EPI_ROW(ai, m) * FF + u.pn * 128 + wc * 32 + fq * 8) = pack8(a, b);
            }
    }
};
struct EpiDown {
    bf16_t* Y2; const unsigned* list; const float* gw;
    __device__ __forceinline__ void operator()(const ACC_T, const Unit& u, int wr, int wc, int fr, int fq) const {
#pragma unroll
        for (int ai = 0; ai < 2; ++ai)
#pragma unroll
            for (int m = 0; m < 4; ++m) {
                const int rloc = ai * 128 + wr * 64 + m * 16 + fr;
                if (rloc < u.nv) {
                    const unsigned entry = list[(size_t)u.be * T + u.rl * 256 + rloc]; const float w = gw[entry];
#pragma unroll
                    for (int bj = 0; bj < 2; ++bj) *(u32x4*)(Y2 + (size_t)entry * D + EPI_COL(bj)) = pack8(acc[ai][bj][m][0] * w, acc[ai][bj][m][1] * w);
                }
            }
    }
};
}

namespace at {
struct Tensors { const bf16_t* Q; int qp; const bf16_t* K; int kp; const bf16_t* V; int vp; bf16_t* O; int op; int group; };
__device__ __forceinline__ bool next_unit(int i, int vcu, int G, int& bh, int& qb) {
    int u;
    if (G == 256) { if (i >= 4) return false; u = (vcu >> 5) * 128 + i * 32 + (vcu & 31); }
    else { u = i * G + vcu; if (u >= 1024) return false; }
    bh = u >> 4; qb = u & 15; return true;
}
template <int DQK>
__device__ __forceinline__ void attn_phase_ref(int tid, const Tensors& A, int vcu, int G) {
    int bh, qb;
    for (int i = 0; next_unit(i, vcu, G, bh, qb); ++i) {
        const int b = bh >> 3, h = bh & 7, kvh = h / A.group;
        {
            const int dh = tid >> 8;
            const size_t row = (size_t)b * S + qb * 256 + (tid & 255);
            float q[DQK], o[32];
#pragma unroll
            for (int d = 0; d < DQK; ++d) q[d] = bf2f(A.Q[row * A.qp + h * DQK + d]);
#pragma unroll
            for (int d = 0; d < 32; ++d) o[d] = 0.f;
            float l = 0.f;
            for (int k = 0; k < S; ++k) {
                const bf16_t* kr = A.K + ((size_t)b * S + k) * A.kp + kvh * DQK; const bf16_t* vr = A.V + ((size_t)b * S + k) * A.vp + kvh * 64 + dh * 32;
                float sc = 0.f;
#pragma unroll
                for (int d = 0; d < DQK; d += 8) { f32x4 k0, k1; unpack8(*(const u32x4*)(kr + d), k0, k1);
                    sc += q[d] * k0[0] + q[d + 1] * k0[1] + q[d + 2] * k0[2] + q[d + 3] * k0[3] + q[d + 4] * k1[0] + q[d + 5] * k1[1] + q[d + 6] * k1[2] + q[d + 7] * k1[3]; }
                const float p = bf2f(cvt_pk_bf16(exp2f(sc), 0.f) & 0xffffu); l += p;
#pragma unroll
                for (int d = 0; d < 32; d += 8) { f32x4 v0, v1; unpack8(*(const u32x4*)(vr + d), v0, v1);
                    o[d] += p * v0[0]; o[d + 1] += p * v0[1]; o[d + 2] += p * v0[2]; o[d + 3] += p * v0[3]; o[d + 4] += p * v1[0]; o[d + 5] += p * v1[1]; o[d + 6] += p * v1[2]; o[d + 7] += p * v1[3]; }
            }
            const float il = 1.f / l;
            __syncthreads();
#pragma unroll
            for (int d = 0; d < 32; d += 8) { f32x4 a = {o[d] * il, o[d + 1] * il, o[d + 2] * il, o[d + 3] * il}, c = {o[d + 4] * il, o[d + 5] * il, o[d + 6] * il, o[d + 7] * il};
                *(u32x4*)(A.O + row * A.op + h * 64 + dh * 32 + d) = pack8(a, c); }
        }
    }
}
#if FAST_ATTN
typedef short s16x4 __attribute__((ext_vector_type(4)));
typedef __bf16 bf16x2_t __attribute__((ext_vector_type(2)));
__device__ __forceinline__ unsigned cvtpk(float lo, float hi) { f32x2 v = {lo, hi}; bf16x2_t b = __builtin_convertvector(v, bf16x2_t); return __builtin_bit_cast(unsigned, b); }
__device__ __forceinline__ s16x4 vtr(const LAS unsigned char* p) { return __builtin_bit_cast(s16x4, __builtin_amdgcn_ds_read_tr16_b64_v4i16((LAS s16x4*)p)); }
__device__ __forceinline__ int crow(int r, int hi) { return (r & 3) + 8 * (r >> 2) + 4 * hi; }
#define AT_BAR() asm volatile("s_barrier" ::: "memory")
#define AT_WAITBAR(N) asm volatile("s_waitcnt vmcnt(" #N ") lgkmcnt(0)\n\ts_barrier" ::: "memory")
#define AT_SCHED() __builtin_amdgcn_sched_barrier(0)
__device__ __forceinline__ void glds16(const void* gsrc, unsigned lds_dst) { unsigned keep;
    asm volatile("s_mov_b32 %0, m0\n\ts_mov_b32 m0, %2\n\ts_nop 0\n\tglobal_load_lds_dwordx4 %1, off\n\ts_mov_b32 m0, %0" : "=&s"(keep) : "v"(gsrc), "s"(lds_dst) : "memory"); }
#define AT_GLDS(g, l) glds16((const void*)(g), (unsigned)__builtin_amdgcn_readfirstlane((int)(unsigned)(uintptr_t)(l)))
template <int DQK>
__device__ __forceinline__ void attn_unit(int tid, LAS unsigned char* lds, const Tensors& A, int b, int h, int qb) {
    constexpr int ND = DQK / 16, NCH = DQK / 8, KSLOT = NCH * 1024, NKD = NCH > 8 ? 2 : 1, VSLOT = 8192, NT = S / 64;
    constexpr int KOFF = 0, VOFF = 3 * KSLOT, OST = VOFF + 3 * VSLOT, WSF = OST + 8 * 4096;
    static_assert(WSF + 8 * 256 <= RING_BYTES, "attention LDS");
    const int lane = tid & 63, r32 = lane & 31, hi = lane >> 5, wid = __builtin_amdgcn_readfirstlane(tid >> 6);
    const int kvh = h / A.group; const size_t rowb = (size_t)b * S;
    const bf16_t* ksrc = A.K + (rowb + lane) * A.kp + kvh * DQK + wid * 8;
    const bf16_t* ksrc2 = A.K + (rowb + lane) * A.kp + kvh * DQK + (8 + (wid & 3)) * 8;
    const bf16_t* vsrc = A.V + (rowb + 16 * (wid & 3) + (lane >> 2)) * A.vp + kvh * 64 + (wid >> 2) * 32 + (lane & 3) * 8;
    const size_t ktile = (size_t)64 * A.kp, vtile = (size_t)64 * A.vp;
    LAS unsigned char* kdst = lds + KOFF + wid * 1024; LAS unsigned char* kdst2 = lds + KOFF + (8 + (wid & 3)) * 1024; LAS unsigned char* vdst = lds + VOFF + wid * 1024;
#define DMA_K(j, so) do { AT_GLDS(ksrc + (size_t)(j) * ktile, kdst + (so)); if (NKD == 2) AT_GLDS(ksrc2 + (size_t)(j) * ktile, kdst2 + (so)); } while (0)
#define DMA_V(j, so) AT_GLDS(vsrc + (size_t)(j) * vtile, vdst + (so))
    const LAS unsigned char* kp0 = lds + KOFF + hi * 1024 + r32 * 16;
    const LAS unsigned char* vp0 = lds + VOFF + ((lane >> 4) & 1) * 32 + (lane & 3) * 8 + (4 * hi + ((lane & 15) >> 2)) * 64;
    DMA_K(0, 0); DMA_V(0, 0); DMA_K(1, KSLOT); DMA_V(1, VSLOT); DMA_K(2, 2 * KSLOT);
    const bf16_t* Qw = A.Q + (rowb + qb * 256 + wid * 32 + r32) * A.qp + h * DQK + hi * 8;
    bf16x8 qr[ND];
#pragma unroll
    for (int d0 = 0; d0 < ND; ++d0) qr[d0] = *(const bf16x8*)(Qw + d0 * 16);
    asm volatile("s_waitcnt vmcnt(0)\n\ts_barrier" ::: "memory");
    bf16x8 kf[2 * ND]; s16x4 vlo[8], vhi[8];
#define KLOAD(so) do { _Pragma("unroll") for (int d0 = 0; d0 < ND; ++d0) { kf[2 * d0] = *(const LAS bf16x8*)(kp0 + (so) + d0 * 2048); kf[2 * d0 + 1] = *(const LAS bf16x8*)(kp0 + (so) + d0 * 2048 + 512); } } while (0)
#define VLOAD(so) do { _Pragma("unroll") for (int i = 0; i < 8; ++i) { vlo[i] = vtr(vp0 + (so) + (i >> 2) * 4096 + (i & 3) * 1024); vhi[i] = vtr(vp0 + (so) + (i >> 2) * 4096 + (i & 3) * 1024 + 512); } } while (0)
#define VFR(i) (bf16x8){vlo[i][0], vlo[i][1], vlo[i][2], vlo[i][3], vhi[i][0], vhi[i][1], vhi[i][2], vhi[i][3]}
    KLOAD(0);
    asm volatile("s_waitcnt lgkmcnt(0)" ::: "memory");
    if (wid >= 4) AT_BAR();
    f32x16 o0 = {}, o1 = {}, C0, C1; u32x4 pw0, pw1, pw2, pw3; float lsum = 0.f;
    const f32x16 zero = {};
#define QK_BLOCK() do { C0 = __builtin_amdgcn_mfma_f32_32x32x16_bf16(kf[0], qr[0], zero, 0, 0, 0); C1 = __builtin_amdgcn_mfma_f32_32x32x16_bf16(kf[1], qr[0], zero, 0, 0, 0); \
        _Pragma("unroll") for (int d0 = 1; d0 < ND; ++d0) { C0 = __builtin_amdgcn_mfma_f32_32x32x16_bf16(kf[2 * d0], qr[d0], C0, 0, 0, 0); C1 = __builtin_amdgcn_mfma_f32_32x32x16_bf16(kf[2 * d0 + 1], qr[d0], C1, 0, 0, 0); } } while (0)
#define PAF(k) __builtin_bit_cast(bf16x8, pw##k)
#define PV_BLOCK() do { \
        o0 = __builtin_amdgcn_mfma_f32_32x32x16_bf16(PAF(0), VFR(0), o0, 0, 0, 0); o1 = __builtin_amdgcn_mfma_f32_32x32x16_bf16(PAF(0), VFR(4), o1, 0, 0, 0); \
        o0 = __builtin_amdgcn_mfma_f32_32x32x16_bf16(PAF(1), VFR(1), o0, 0, 0, 0); o1 = __builtin_amdgcn_mfma_f32_32x32x16_bf16(PAF(1), VFR(5), o1, 0, 0, 0); \
        o0 = __builtin_amdgcn_mfma_f32_32x32x16_bf16(PAF(2), VFR(2), o0, 0, 0, 0); o1 = __builtin_amdgcn_mfma_f32_32x32x16_bf16(PAF(2), VFR(6), o1, 0, 0, 0); \
        o0 = __builtin_amdgcn_mfma_f32_32x32x16_bf16(PAF(3), VFR(3), o0, 0, 0, 0); o1 = __builtin_amdgcn_mfma_f32_32x32x16_bf16(PAF(3), VFR(7), o1, 0, 0, 0); } while (0)
#define SOFTMAX() do { \
        _Pragma("unroll") for (int r = 0; r < 16; ++r) { C0[r] = __builtin_amdgcn_exp2f(C0[r]); C1[r] = __builtin_amdgcn_exp2f(C1[r]); } \
        float s0_ = 0.f, s1_ = 0.f; _Pragma("unroll") for (int r = 0; r < 16; ++r) { s0_ += C0[r]; s1_ += C1[r]; } lsum += s0_ + s1_; \
        pw0 = (u32x4){cvtpk(C0[0], C0[1]), cvtpk(C0[2], C0[3]), cvtpk(C0[4], C0[5]), cvtpk(C0[6], C0[7])}; pw1 = (u32x4){cvtpk(C0[8], C0[9]), cvtpk(C0[10], C0[11]), cvtpk(C0[12], C0[13]), cvtpk(C0[14], C0[15])}; \
        pw2 = (u32x4){cvtpk(C1[0], C1[1]), cvtpk(C1[2], C1[3]), cvtpk(C1[4], C1[5]), cvtpk(C1[6], C1[7])}; pw3 = (u32x4){cvtpk(C1[8], C1[9]), cvtpk(C1[10], C1[11]), cvtpk(C1[12], C1[13]), cvtpk(C1[14], C1[15])}; } while (0)
    int ka = 2 * KSLOT, kb = 0, kc = KSLOT, va = 2 * VSLOT, vb = 0, vc = VSLOT;
#define ROT() do { const int t_ = ka; ka = kb; kb = kc; kc = t_; const int u_ = va; va = vb; vb = vc; vc = u_; } while (0)
#define PINP() asm volatile("" : "+v"(lsum) : "v"(pw0), "v"(pw1), "v"(pw2), "v"(pw3))
#define STEP(sv, DOQK, DOPV, KL, VL, IK, IV) do { \
        AT_SCHED(); if (DOQK) QK_BLOCK(); if (DOPV) PV_BLOCK(); AT_SCHED(); AT_BAR(); AT_SCHED(); \
        if (KL) KLOAD(kc); if (VL) VLOAD(vb); if (IK) DMA_K((sv) + 4, kb); if (IV) DMA_V((sv) + 3, va); \
        if (DOQK) { SOFTMAX(); PINP(); } AT_SCHED(); \
        if (IK) { if (NKD == 2) { AT_WAITBAR(3); } else { AT_WAITBAR(2); } } else if (IV) { AT_WAITBAR(1); } else { AT_WAITBAR(0); } \
        AT_SCHED(); ROT(); } while (0)
    STEP(-1, true, false, true, true, true, true);
#pragma nounroll
    for (int s = 0; s < NT - 4; ++s) STEP(s, true, true, true, true, true, true);
    STEP(NT - 4, true, true, true, true, false, true);
    STEP(NT - 3, true, true, true, true, false, false);
    STEP(NT - 2, true, true, false, true, false, false);
    STEP(NT - 1, false, true, false, false, false, false);
#undef STEP
#undef PINP
    if (wid < 4) AT_BAR();
    { auto rr = __builtin_amdgcn_permlane32_swap(__float_as_uint(lsum), __float_as_uint(lsum), false, false); lsum = __uint_as_float(rr[0]) + __uint_as_float(rr[1]); }
    LAS float* wsf = (LAS float*)(lds + WSF + wid * 256);
    if (hi == 0) wsf[r32] = lsum;
    asm volatile("s_waitcnt lgkmcnt(0)" ::: "memory");
    LAS bf16_t* stg = (LAS bf16_t*)(lds + OST + wid * 4096);
#pragma unroll
    for (int r = 0; r < 16; ++r) { const int orow = crow(r, hi); const float rl = __builtin_amdgcn_rcpf(wsf[orow]);
        stg[orow * 64 + r32] = (bf16_t)(cvtpk(o0[r] * rl, 0.f) & 0xffffu); stg[orow * 64 + 32 + r32] = (bf16_t)(cvtpk(o1[r] * rl, 0.f) & 0xffffu); }
    asm volatile("s_waitcnt lgkmcnt(0)" ::: "memory");
    bf16_t* Ow = A.O + (rowb + qb * 256 + wid * 32) * A.op + h * 64;
#pragma unroll
    for (int i = 0; i < 4; ++i) { const int row = i * 8 + (lane >> 3), ch = lane & 7; const u32x4 v = *(const LAS u32x4*)(stg + row * 64 + ch * 8); *(u32x4*)(Ow + (size_t)row * A.op + ch * 8) = v; }
    asm volatile("s_waitcnt lgkmcnt(0)\n\ts_barrier" ::: "memory");
#undef DMA_K
#undef DMA_V
#undef KLOAD
#undef VLOAD
#undef VFR
#undef QK_BLOCK
#undef PAF
#undef PV_BLOCK
#undef SOFTMAX
#undef ROT
}
#endif
template <int DQK>
__device__ __forceinline__ void attn_phase(int tid, LAS unsigned char* lds, const Tensors& A, int vcu, int G) {
#if FAST_ATTN
    int bh, qb;
    for (int i = 0; next_unit(i, vcu, G, bh, qb); ++i) attn_unit<DQK>(tid, lds, A, bh >> 3, bh & 7, qb);
#else
    (void)lds; attn_phase_ref<DQK>(tid, A, vcu, G);
#endif
}
}


struct Args { const float* in[22]; float* out; unsigned char* ws; int ph_lo, ph_hi; };
struct Frame {
    LAS unsigned char* lds; volatile LAS unsigned* MISC; unsigned* ctl;
    int tid, lane, wave, vcu, G;
    unsigned char* ws; float* X;
};

__device__ __forceinline__ void p0_phase(Frame& F, const float* c, const float* w_ada, const float* b_ada) {
    LAS float* cs = (LAS float*)F.lds;
    LAS float* red = (LAS float*)(F.lds + 32768);
    for (int i = F.tid; i < NB * D; i += NTHREADS) { const float v = c[i]; cs[i] = v / (1.f + __expf(-v)); }
    __syncthreads();
    float* mod = (float*)(F.ws + WS_MOD);
    const int kq = F.wave, col = F.lane;
    for (int item = F.vcu; item < NL * 6 * D / 64; item += F.G) {
        const int l = item / (6 * D / 64), n0 = (item % (6 * D / 64)) * 64;
        const float* w = w_ada + (size_t)l * D * 6 * D + n0 + col;
        float acc[NB];
#pragma unroll
        for (int b = 0; b < NB; ++b) acc[b] = 0.f;
#pragma unroll 8
        for (int k = kq * 128; k < kq * 128 + 128; ++k) { const float wv = w[(size_t)k * 6 * D];
#pragma unroll
            for (int b = 0; b < NB; ++b) acc[b] += cs[b * D + k] * wv; }
#pragma unroll
        for (int b = 0; b < NB; ++b) red[(kq * NB + b) * 64 + col] = acc[b];
        __syncthreads();
        { const int b = F.wave; float s = 0.f;
#pragma unroll
          for (int q = 0; q < 8; ++q) s += red[(q * NB + b) * 64 + col];
          mod[((size_t)l * NB + b) * 6 * D + n0 + col] = s + b_ada[(size_t)l * 6 * D + n0 + col]; }
        __syncthreads();
    }
    float* cosA = (float*)(F.ws + WS_COSA); float* sinA = (float*)(F.ws + WS_SINA); float* cosB = (float*)(F.ws + WS_COSB); float* sinB = (float*)(F.ws + WS_SINB);
    for (int idx = F.vcu * NTHREADS + F.tid; idx < S * 48; idx += F.G * NTHREADS) {
        const int s = idx / 48, i = idx % 48; const float row = (float)(s >> 6), col2 = (float)(s & 63);
        if (i < 32) { const int j = i & 15; const float a = (i < 16 ? row : col2) * (1.0f / powf(10000.0f, (float)j / 16.0f)); cosA[s * 32 + i] = cosf(a); sinA[s * 32 + i] = sinf(a); }
        else { const int ii = i - 32, j = ii & 7; const float a = (ii < 8 ? row : col2) * (1.0f / powf(10000.0f, (float)j / 8.0f)); cosB[s * 16 + ii] = cosf(a); sinB[s * 16 + ii] = sinf(a); }
    }
}

template <class SrcFn>
__device__ __forceinline__ void cvt_item(const float* W, int K, int Nsrc, const float* kg, bf16_t* WT, LAS float* scr, int item, int nblk, int lane, const SrcFn& src) {
    const int kb = item / nblk, nb = item % nblk, k0 = 64 * kb, n0 = 32 * nb;
    const int sc = src(n0 + (lane & 31));
#pragma unroll 8
    for (int i = 0; i < 32; ++i) { const int kk = 2 * i + (lane >> 5); float v = sc >= 0 ? W[(size_t)(k0 + kk) * Nsrc + sc] : 0.f; if (kg) v *= kg[k0 + kk]; scr[kk * 33 + (lane & 31)] = v; }
    LDS_WAIT(); asm volatile("" ::: "memory");
    const int c = lane & 7;
#pragma unroll
    for (int j = 0; j < 4; ++j) { const int n = (lane >> 3) + 8 * j; const LAS float* s = scr + (8 * c) * 33 + n;
        u32x4 o; o.x = cvt_pk_bf16(s[0 * 33], s[1 * 33]); o.y = cvt_pk_bf16(s[2 * 33], s[3 * 33]); o.z = cvt_pk_bf16(s[4 * 33], s[5 * 33]); o.w = cvt_pk_bf16(s[6 * 33], s[7 * 33]);
        *(u32x4*)(WT + (size_t)(n0 + n) * K + k0 + 8 * c) = o; }
    LDS_WAIT(); asm volatile("" ::: "memory");
}
struct SrcId { __device__ int operator()(int n) const { return n; } };
struct SrcIn { __device__ int operator()(int n) const { return gp::src_col_in(n); } };
typedef __attribute__((address_space(4))) const Args CArgsW;
__device__ __forceinline__ void convert_weights(Frame& F, CArgsW* a, int l) {
    LAS float* scr = (LAS float*)(F.lds + F.wave * 16384);
    const int gw = F.vcu * NWAVES + F.wave, NGW = F.G * NWAVES;
    const float* w_in = ((const float*)(GAS const float*)a->in[5]) + (size_t)l * D * INC; const float* w_q_b = ((const float*)(GAS const float*)a->in[10]) + (size_t)l * 384 * 768; const float* w_kv_b = ((const float*)(GAS const float*)a->in[11]) + (size_t)l * 256 * 1024;
    const float* w_pa = ((const float*)(GAS const float*)a->in[12]) + (size_t)l * 512 * D; const float* w_pb = ((const float*)(GAS const float*)a->in[13]) + (size_t)l * 512 * D; const float* w_o = ((const float*)(GAS const float*)a->in[14]) + (size_t)l * D * D;
    const float* w1 = ((const float*)(GAS const float*)a->in[18]) + (size_t)l * NE * D * FF; const float* w3 = ((const float*)(GAS const float*)a->in[19]) + (size_t)l * NE * D * FF; const float* w2 = ((const float*)(GAS const float*)a->in[20]) + (size_t)l * NE * FF * D;
    const float* gqa = ((const float*)(GAS const float*)a->in[8]) + l * 384; const float* gkv = ((const float*)(GAS const float*)a->in[9]) + l * 256;
    bf16_t* Win = (bf16_t*)(F.ws + WS_WIN); bf16_t* Wqb = (bf16_t*)(F.ws + WS_WQB); bf16_t* Wkvb = (bf16_t*)(F.ws + WS_WKVB); bf16_t* Wpa = (bf16_t*)(F.ws + WS_WPA); bf16_t* Wpb = (bf16_t*)(F.ws + WS_WPB);
    bf16_t* Wo = (bf16_t*)(F.ws + WS_WO); bf16_t* W13 = (bf16_t*)(F.ws + WS_W13); bf16_t* W2 = (bf16_t*)(F.ws + WS_W2);
    constexpr int I_IN = (D / 64) * (NIN / 32), I_QB = (384 / 64) * (768 / 32), I_KVB = (256 / 64) * (1024 / 32), I_P = (512 / 64) * (D / 32), I_O = (D / 64) * (D / 32);
    constexpr int I_13 = (D / 64) * (1024 / 32), I_2 = (FF / 64) * (D / 32);
    constexpr int NITEMS = I_IN + I_QB + I_KVB + 2 * I_P + I_O + NE * (I_13 + I_2);
    for (int it = gw; it < NITEMS; it += NGW) {
        int r = it;
        if (r < I_IN) { cvt_item(w_in, D, INC, nullptr, Win, scr, r, NIN / 32, F.lane, SrcIn()); continue; } r -= I_IN;
        if (r < I_QB) { cvt_item(w_q_b, 384, 768, gqa, Wqb, scr, r, 768 / 32, F.lane, SrcId()); continue; } r -= I_QB;
        if (r < I_KVB) { cvt_item(w_kv_b, 256, 1024, gkv, Wkvb, scr, r, 1024 / 32, F.lane, SrcId()); continue; } r -= I_KVB;
        if (r < I_P) { cvt_item(w_pa, 512, D, nullptr, Wpa, scr, r, D / 32, F.lane, SrcId()); continue; } r -= I_P;
        if (r < I_P) { cvt_item(w_pb, 512, D, nullptr, Wpb, scr, r, D / 32, F.lane, SrcId()); continue; } r -= I_P;
        if (r < I_O) { cvt_item(w_o, D, D, nullptr, Wo, scr, r, D / 32, F.lane, SrcId()); continue; } r -= I_O;
        if (r < NE * I_13) { const int e = r / I_13, q = r % I_13, nb = q % 32;
            const float* src = ((nb & 7) < 4 ? w1 : w3) + (size_t)e * D * FF; const int cb = (nb >> 3) * 128 + (nb & 3) * 32;
            struct SrcOff { int n0, cb; __device__ int operator()(int n) const { return cb + (n - n0); } } so{nb * 32, cb};
            cvt_item(src, D, FF, nullptr, W13 + (size_t)e * 1024 * D, scr, q, 32, F.lane, so); continue; } r -= NE * I_13;
        { const int e = r / I_2, q = r % I_2; cvt_item(w2 + (size_t)e * FF * D, FF, D, nullptr, W2 + (size_t)e * D * FF, scr, q, D / 32, F.lane, SrcId()); }
    }
}

__device__ __forceinline__ void row_phase(Frame& F, const float* xin, const float* g2prev  , const float* gain, const float* modl  , int sh_off, int sc_off, bf16_t* H, bool final_) {
    const int gw = F.vcu * NWAVES + F.wave, NGW = F.G * NWAVES;
    const bf16_t* Y2 = (const bf16_t*)(F.ws + WS_Y2);
    for (int m = gw; m < T; m += NGW) {
        const int b = m >> 12;
        f32x4 v[4]; float ss = 0.f;
#pragma unroll
        for (int j = 0; j < 4; ++j) {
            const int c = 4 * F.lane + 256 * j;
            if (g2prev) {
                f32x4 x = *(const f32x4*)(F.X + (size_t)m * D + c);
                const u32x2 ya = *(const u32x2*)(Y2 + (size_t)(2 * m) * D + c), yb = *(const u32x2*)(Y2 + (size_t)(2 * m + 1) * D + c);
                const f32x4 g = *(const f32x4*)(g2prev + (size_t)b * 6 * D + 5 * D + c);
                f32x4 y; y[0] = bf2f(ya.x & 0xffffu) + bf2f(yb.x & 0xffffu); y[1] = bf2f(ya.x >> 16) + bf2f(yb.x >> 16); y[2] = bf2f(ya.y & 0xffffu) + bf2f(yb.y & 0xffffu); y[3] = bf2f(ya.y >> 16) + bf2f(yb.y >> 16);
                v[j] = x + g * y;
            } else v[j] = *(const f32x4*)(xin + (size_t)m * D + c);
            ss += gp::dot4(v[j]);
        }
        ss = wave_sum(ss);
        const float rstd = rsqrtf(ss * (1.f / D) + EPS);
#pragma unroll
        for (int j = 0; j < 4; ++j) {
            const int c = 4 * F.lane + 256 * j;
            const f32x4 g = *(const f32x4*)(gain + c);
            if (final_) { *(f32x4*)(F.X + (size_t)m * D + c) = v[j] * rstd * g; }
            else {
                if (g2prev || xin != F.X) *(f32x4*)(F.X + (size_t)m * D + c) = v[j];
                const f32x4 sc = *(const f32x4*)(modl + (size_t)b * 6 * D + sc_off + c), sh = *(const f32x4*)(modl + (size_t)b * 6 * D + sh_off + c);
                const f32x4 hv = v[j] * rstd * g * (1.f + sc) + sh;
                u32x2 w; w.x = cvt_pk_bf16(hv[0], hv[1]); w.y = cvt_pk_bf16(hv[2], hv[3]);
                *(u32x2*)(H + (size_t)m * D + c) = w;
            }
        }
    }
}

__device__ __forceinline__ void t2_phase(Frame& F, const float* gain, const float* modl, const float* w_router, const float* rbias, int l) {
    LAS f32x4* wl = (LAS f32x4*)F.lds;
    LAS int* rec = (LAS int*)(F.lds + 65536);
    LAS float* recw = (LAS float*)(F.lds + 65536 + 2048);
    LAS int* lcnt = (LAS int*)(F.lds + 65536 + 4096);
    for (int idx = F.tid; idx < 4096; idx += NTHREADS) {
        const int lane = idx & 63, c = (idx >> 6) & 3, i = (idx >> 8) & 3, j = idx >> 10; const int k = 4 * lane + 256 * j + i;
        wl[idx] = *(const f32x4*)(w_router + (size_t)k * NE + 4 * c);
    }
    if (F.tid < 32) lcnt[F.tid] = 0;
    __syncthreads();
    const int gw = F.vcu * NWAVES + F.wave, NGW = F.G * NWAVES;
    bf16_t* H = (bf16_t*)(F.ws + WS_H);
    int it = 0;
    for (int m = gw; m < T; m += NGW, ++it) {
        const int b = m >> 12;
        f32x4 v[4]; float ss = 0.f;
#pragma unroll
        for (int j = 0; j < 4; ++j) { v[j] = *(const f32x4*)(F.X + (size_t)m * D + 4 * F.lane + 256 * j); ss += gp::dot4(v[j]); }
        ss = wave_sum(ss);
        const float rstd = rsqrtf(ss * (1.f / D) + EPS);
        float acc[NE];
#pragma unroll
        for (int e = 0; e < NE; ++e) acc[e] = 0.f;
#pragma unroll
        for (int j = 0; j < 4; ++j) {
            const int c = 4 * F.lane + 256 * j;
            const f32x4 g = *(const f32x4*)(gain + c), sc = *(const f32x4*)(modl + (size_t)b * 6 * D + 4 * D + c), sh = *(const f32x4*)(modl + (size_t)b * 6 * D + 3 * D + c);
            const f32x4 hv = v[j] * rstd * g * (1.f + sc) + sh;
            u32x2 w; w.x = cvt_pk_bf16(hv[0], hv[1]); w.y = cvt_pk_bf16(hv[2], hv[3]);
            *(u32x2*)(H + (size_t)m * D + c) = w;
#pragma unroll
            for (int i = 0; i < 4; ++i)
#pragma unroll
                for (int c4 = 0; c4 < 4; ++c4) { const f32x4 wv = wl[((j * 4 + i) * 4 + c4) * 64 + F.lane];
                    acc[4 * c4 + 0] += hv[i] * wv[0]; acc[4 * c4 + 1] += hv[i] * wv[1]; acc[4 * c4 + 2] += hv[i] * wv[2]; acc[4 * c4 + 3] += hv[i] * wv[3]; }
        }
#pragma unroll
        for (int e = 0; e < NE; ++e) acc[e] = wave_sum(acc[e]);
        float scv[NE], bi[NE];
#pragma unroll
        for (int e = 0; e < NE; ++e) { scv[e] = 1.f / (1.f + expf(-acc[e])); bi[e] = scv[e] + rbias[e]; }
        int gsel = 0; float gbest = -INFINITY;
#pragma unroll
        for (int g = 0; g < 4; ++g) { float m1 = -INFINITY, m2 = -INFINITY;
#pragma unroll
            for (int j = 0; j < 4; ++j) { const float x = bi[g * 4 + j]; if (x > m1) { m2 = m1; m1 = x; } else if (x > m2) m2 = x; }
            const float gs = m1 + m2; if (gs > gbest) { gbest = gs; gsel = g; } }
        int e1 = -1, e2 = -1; float b1 = -INFINITY, b2 = -INFINITY, s1 = 0.f, s2 = 0.f;
#pragma unroll
        for (int j = 0; j < 4; ++j) { float x = -INFINITY, sx = 0.f;
#pragma unroll
            for (int g = 0; g < 4; ++g) if (g == gsel) { x = bi[g * 4 + j]; sx = scv[g * 4 + j]; }
            const int e = gsel * 4 + j;
            if (x > b1) { b2 = b1; e2 = e1; s2 = s1; b1 = x; e1 = e; s1 = sx; } else if (x > b2) { b2 = x; e2 = e; s2 = sx; } }
        if (F.lane == 0) {
            const float inv = 1.f / (s1 + s2); const int slot = it * NWAVES + F.wave;
            rec[slot * 4 + 0] = e1; rec[slot * 4 + 1] = e2;
            rec[slot * 4 + 2] = __hip_atomic_fetch_add(&lcnt[e1], 1, __ATOMIC_RELAXED, __HIP_MEMORY_SCOPE_WORKGROUP);
            rec[slot * 4 + 3] = __hip_atomic_fetch_add(&lcnt[e2], 1, __ATOMIC_RELAXED, __HIP_MEMORY_SCOPE_WORKGROUP);
            recw[slot * 2 + 0] = s1 * inv; recw[slot * 2 + 1] = s2 * inv;
        }
    }
    __syncthreads();
    if (F.tid < NE) lcnt[16 + F.tid] = (int)__hip_atomic_fetch_add(F.ctl + CW_CNT + (l * NE + F.tid) * 64, (unsigned)lcnt[F.tid], __ATOMIC_RELAXED, __HIP_MEMORY_SCOPE_AGENT);
    __syncthreads();
    unsigned* list = (unsigned*)(F.ws + WS_LIST); float* gwb = (float*)(F.ws + WS_GW);
    const int nrows = it;
    for (int s = F.tid; s < nrows * NWAVES; s += NTHREADS) {
        const int i2 = s / NWAVES, w = s % NWAVES; const int m = F.vcu * NWAVES + w + i2 * NGW;
        const int e1 = rec[s * 4 + 0], e2 = rec[s * 4 + 1];
        list[(size_t)e1 * T + lcnt[16 + e1] + rec[s * 4 + 2]] = (unsigned)(2 * m); list[(size_t)e2 * T + lcnt[16 + e2] + rec[s * 4 + 3]] = (unsigned)(2 * m + 1);
        gwb[2 * m] = recw[s * 2]; gwb[2 * m + 1] = recw[s * 2 + 1];
    }
}
__device__ __forceinline__ const LAS int* moe_table(Frame& F, int l) {
    LAS int* tab = (LAS int*)(F.lds + MISC_OFF + 1024);
    __syncthreads();
    if (F.tid == 0) { int acc = 0;
        for (int e = 0; e < NE; ++e) { const int c = (int)__hip_atomic_load(F.ctl + CW_CNT + (l * NE + e) * 64, __ATOMIC_RELAXED, __HIP_MEMORY_SCOPE_AGENT); tab[e] = acc; tab[32 + e] = c; acc += (c + 255) >> 8; }
        tab[16] = acc; }
    __syncthreads();
    return tab;
}

typedef __attribute__((address_space(4))) const Args CArgs;
#define LAUNDER_GP(T_, p) do { GAS T_* _t = (GAS T_*)(p); asm volatile("" : "+s"(_t)); (p) = (T_*)_t; } while (0)
#define PH_BEGIN() LAUNDER_V(F.tid); F.lane = F.tid & 63; LAUNDER_GP(unsigned, F.ctl); LAUNDER_GP(float, F.X); LAUNDER_GP(unsigned char, F.ws); GAS unsigned char* ws = (GAS unsigned char*)F.ws; CArgs* ka = (CArgs*)__builtin_amdgcn_kernarg_segment_ptr(); LAUNDER_S(ka); \
    float* mod = WSP(float, WS_MOD); (void)mod; (void)ka
#define WSP(T_, off) ((T_*)(GAS T_*)(ws + (off)))
#define KIN(i) ((const float*)(GAS const float*)ka->in[i])
__global__ void __launch_bounds__(NTHREADS, 2) fwd_kernel(Args args) {
    extern __shared__ __attribute__((aligned(16))) unsigned char lds_raw[];
    Frame F;
    F.lds = (LAS unsigned char*)lds_raw; F.MISC = (volatile LAS unsigned*)(F.lds + MISC_OFF);
    F.tid = threadIdx.x; F.lane = F.tid & 63; F.wave = __builtin_amdgcn_readfirstlane(F.tid >> 6);
    F.G = gridDim.x; { const int bx = blockIdx.x; F.vcu = (F.G % 8 == 0) ? (bx % 8) * (F.G / 8) + bx / 8 : bx; }
    F.ws = (unsigned char*)(GAS unsigned char*)args.ws; F.ctl = (unsigned*)(GAS unsigned*)(args.ws + WS_CTL); F.X = (float*)(GAS float*)args.out;
    if (F.tid < 64) F.MISC[F.tid] = 0u;
    __syncthreads();
    XcdBarrier bar; bar.bar = F.ctl + CW_BAR; bar.x = 0; bar.st = nullptr;
    if (!N_LAUNCH_MODE) bar = xcd_barrier_post(F.ctl + CW_BAR, F.MISC + 8);
    const int lo = args.ph_lo, hi = args.ph_hi;
#define IN(k) (lo <= (k) && (k) < hi)
#define SEAM(k) do { if ((k) + 1 < hi) { if (!N_LAUNCH_MODE) xcd_barrier(bar); } } while (0)
    const int cidx = (int)blockIdx.x;

    if (IN(0)) { PH_BEGIN(); p0_phase(F, KIN(1), KIN(2), KIN(3)); SEAM(0); }
    for (int l = 0; l < NL; ++l) {
        const int pb = 1 + 9 * l;
        if (IN(pb + 0)) {
            PH_BEGIN();
            convert_weights(F, ka, l);
            row_phase(F, KIN(0), l > 0 ? mod + (size_t)(l - 1) * NB * 6 * D : nullptr, KIN(4) + l * D, mod + (size_t)l * NB * 6 * D, 0, D, WSP(bf16_t, WS_H), false);
            SEAM(pb + 0);
        }
        if (IN(pb + 1)) {
            PH_BEGIN();
            gp::Gemm g{WSP(bf16_t, WS_H), WSP(const bf16_t, WS_WIN), D, 0, nullptr}; gp::DenseOrder So; So.init(T, NIN, F.G, cidx);
            gp::EpiIn E{WSP(bf16_t, WS_QA), WSP(bf16_t, WS_KA), WSP(bf16_t, WS_VA), WSP(bf16_t, WS_QLAT), WSP(bf16_t, WS_KVLAT), WSP(bf16_t, WS_KB), WSP(bf16_t, WS_SA), WSP(bf16_t, WS_SB), WSP(float, WS_SSQ), WSP(float, WS_SSKV),
                        KIN(6) + l * 64, KIN(7) + l * 64, WSP(const float, WS_COSA), WSP(const float, WS_SINA), WSP(const float, WS_COSB), WSP(const float, WS_SINB)};
            gp::gemm_phase<gp::EpiIn, gp::DenseOrder>(F.tid, F.lds, g, So, E);
            SEAM(pb + 1);
        }
        if (IN(pb + 2)) {
            { PH_BEGIN(); gp::Gemm g{WSP(bf16_t, WS_QLAT), WSP(const bf16_t, WS_WQB), 384, 0, nullptr}; gp::DenseOrder So; So.init(T, 768, F.G, cidx);
              gp::EpiQb E{WSP(bf16_t, WS_QB), WSP(const float, WS_SSQ), WSP(const float, WS_COSB), WSP(const float, WS_SINB)}; gp::gemm_phase<gp::EpiQb, gp::DenseOrder>(F.tid, F.lds, g, So, E); }
            { PH_BEGIN(); gp::Gemm g{WSP(bf16_t, WS_KVLAT), WSP(const bf16_t, WS_WKVB), 256, 0, nullptr}; gp::DenseOrder So; So.init(T, 1024, F.G, F.G - 1 - cidx);
              gp::EpiKvb E{WSP(bf16_t, WS_KB), WSP(bf16_t, WS_VB), WSP(const float, WS_SSKV)}; gp::gemm_phase<gp::EpiKvb, gp::DenseOrder>(F.tid, F.lds, g, So, E); }
            { PH_BEGIN(); const at::Tensors A{WSP(bf16_t, WS_QA), 512, WSP(bf16_t, WS_KA), 128, WSP(bf16_t, WS_VA), 128, WSP(bf16_t, WS_QA), 512, 4}; at::attn_phase<64>(F.tid, F.lds, A, F.vcu, F.G); }
            SEAM(pb + 2);
        }
        if (IN(pb + 3)) {
            PH_BEGIN();
            const at::Tensors A{WSP(bf16_t, WS_QB), 768, WSP(bf16_t, WS_KB), 768, WSP(bf16_t, WS_VB), 512, WSP(bf16_t, WS_OB), 512, 1}; at::attn_phase<96>(F.tid, F.lds, A, F.vcu, F.G);
            SEAM(pb + 3);
        }
        if (IN(pb + 4)) {
            { PH_BEGIN(); gp::Gemm g{WSP(bf16_t, WS_QA), WSP(const bf16_t, WS_WPA), 512, 0, nullptr}; gp::DenseOrder So; So.init(T, D, F.G, cidx);
              gp::EpiProj<0> E{WSP(bf16_t, WS_H), WSP(const bf16_t, WS_SA)}; gp::gemm_phase<gp::EpiProj<0>, gp::DenseOrder>(F.tid, F.lds, g, So, E); }
            { PH_BEGIN(); gp::Gemm g{WSP(bf16_t, WS_OB), WSP(const bf16_t, WS_WPB), 512, 0, nullptr}; gp::DenseOrder So; So.init(T, D, F.G, cidx);
              gp::EpiProj<1> E{WSP(bf16_t, WS_H), WSP(const bf16_t, WS_SB)}; gp::gemm_phase<gp::EpiProj<1>, gp::DenseOrder>(F.tid, F.lds, g, So, E); }
            SEAM(pb + 4);
        }
        if (IN(pb + 5)) {
            PH_BEGIN();
            gp::Gemm g{WSP(bf16_t, WS_H), WSP(const bf16_t, WS_WO), D, 0, nullptr}; gp::DenseOrder So; So.init(T, D, F.G, cidx);
            gp::EpiWo E{F.X, mod + (size_t)l * NB * 6 * D}; gp::gemm_phase<gp::EpiWo, gp::DenseOrder>(F.tid, F.lds, g, So, E);
            SEAM(pb + 5);
        }
        if (IN(pb + 6)) {
            PH_BEGIN();
            t2_phase(F, KIN(15) + l * D, mod + (size_t)l * NB * 6 * D, KIN(16), KIN(17), l);
            SEAM(pb + 6);
        }
        if (IN(pb + 7)) {
            PH_BEGIN();
            const LAS int* tab = moe_table(F, l);
            gp::Gemm g{WSP(bf16_t, WS_H), WSP(const bf16_t, WS_W13), D, (size_t)1024 * D, WSP(const unsigned, WS_LIST)}; gp::MoeOrder So; So.init(tab, F.G, cidx);
            gp::EpiUp E{WSP(bf16_t, WS_ACT)}; gp::gemm_phase<gp::EpiUp, gp::MoeOrder, true>(F.tid, F.lds, g, So, E);
            SEAM(pb + 7);
        }
        if (IN(pb + 8)) {
            PH_BEGIN();
            const LAS int* tab = moe_table(F, l);
            gp::Gemm g{WSP(bf16_t, WS_ACT), WSP(const bf16_t, WS_W2), FF, (size_t)D * FF, nullptr}; gp::MoeOrder So; So.init(tab, F.G, cidx);
            gp::EpiDown E{WSP(bf16_t, WS_Y2), WSP(const unsigned, WS_LIST), WSP(const float, WS_GW)}; gp::gemm_phase<gp::EpiDown, gp::MoeOrder, false>(F.tid, F.lds, g, So, E);
            SEAM(pb + 8);
        }
    }
    if (IN(NPHASE - 1)) { PH_BEGIN(); row_phase(F, nullptr, mod + (size_t)(NL - 1) * NB * 6 * D, KIN(21), nullptr, 0, 0, nullptr, true); }
#undef IN
#undef SEAM
}

extern "C" void kernel_launch(void* const* d_in, const int* in_sizes, int n_in, void* d_out, int out_size, void* d_ws, size_t ws_size, hipStream_t stream) {
    static int grid = 0;
    if (grid == 0) {
        if (n_in != 22 || out_size != T * D || ws_size < WS_END) { fprintf(stderr, "kernel_launch: unexpected problem (n_in %d out %d ws %zu)\n", n_in, out_size, ws_size); grid = -1; return; }
        int dev = 0, cus = 0, per_cu = 0;
        if (hipGetDevice(&dev) != hipSuccess || hipDeviceGetAttribute(&cus, hipDeviceAttributeMultiprocessorCount, dev) != hipSuccess) { grid = -1; return; }
        if (hipFuncSetAttribute((const void*)fwd_kernel, hipFuncAttributeMaxDynamicSharedMemorySize, LDS_BYTES) != hipSuccess) { grid = -1; return; }
        if (hipOccupancyMaxActiveBlocksPerMultiprocessor(&per_cu, (const void*)fwd_kernel, NTHREADS, LDS_BYTES) != hipSuccess || per_cu < 1) { fprintf(stderr, "kernel_launch: occupancy query says %d\n", per_cu); }
        (void)hipGetLastError();
        grid = cus;
        if (T % (grid * NWAVES) != 0) { fprintf(stderr, "kernel_launch: grid %d does not divide the row phases\n", grid); grid = -1; return; }
    }
    if (grid < 0) return;
    (void)hipMemsetAsync((char*)d_ws + WS_CTL, 0, CTL_BYTES, stream);
    Args a{};
    for (int i = 0; i < 22; ++i) a.in[i] = (const float*)d_in[i];
    a.out = (float*)d_out; a.ws = (unsigned char*)d_ws;
#if N_LAUNCH_MODE
    for (int p = 0; p < NPHASE; ++p) { a.ph_lo = p; a.ph_hi = p + 1; hipLaunchKernelGGL(fwd_kernel, dim3(grid), dim3(NTHREADS), LDS_BYTES, stream, a); }
#else
    a.ph_lo = 0; a.ph_hi = NPHASE;
    hipLaunchKernelGGL(fwd_kernel, dim3(grid), dim3(NTHREADS), LDS_BYTES, stream, a);
#endif
}
```

```cpp
#include <hip/hip_runtime.h>
#include <stdint.h>
#include <stdio.h>
#include <math.h>

#ifndef FAST_GEMM
#define FAST_GEMM 1
#endif
#ifndef FAST_ATTN
#define FAST_ATTN 1
#endif
#ifndef PROBE_DUP
#define PROBE_DUP 0
#endif
#ifndef PROBE_ATT
#define PROBE_ATT 0
#endif
#ifndef N_LAUNCH_MODE
#define N_LAUNCH_MODE 0
#endif

#define LAS __attribute__((address_space(3)))
#define GAS __attribute__((address_space(1)))
typedef unsigned short bf16_t;
typedef short bf16x8 __attribute__((ext_vector_type(8)));
typedef float f32x4 __attribute__((ext_vector_type(4)));
typedef float f32x2 __attribute__((ext_vector_type(2)));
typedef float f32x16 __attribute__((ext_vector_type(16)));
typedef unsigned u32x4 __attribute__((ext_vector_type(4)));
typedef unsigned u32x2 __attribute__((ext_vector_type(2)));
typedef GAS unsigned gu32;

constexpr int D = 1024, NB = 8, S = 4096, T = NB * S, NL = 4, INC = 3488, NIN = 3584, NE = 16, FF = 512;
constexpr float EPS = 1e-6f, LOG2E = 1.4426950408889634f;
constexpr float QSCALE_A = 0.125f * LOG2E, QSCALE_B = 0.10206207261596577f * LOG2E;
constexpr int NWAVES = 8, NTHREADS = 512;
constexpr int NPHASE = 2 + 9 * NL;

constexpr size_t MiB = 1u << 20;
constexpr size_t WS_CTL = 0, CTL_BYTES = 1 * MiB;
constexpr size_t WS_MOD = 1 * MiB;
constexpr size_t WS_COSA = 2 * MiB, WS_SINA = WS_COSA + 512 * 1024, WS_COSB = 3 * MiB, WS_SINB = WS_COSB + 256 * 1024;
constexpr size_t WS_SSQ = 4 * MiB, WS_SSKV = 5 * MiB;
constexpr size_t WS_GW = 6 * MiB;
constexpr size_t WS_LIST = 7 * MiB;
constexpr size_t WS_WIN = 10 * MiB, WS_WQB = 17 * MiB, WS_WKVB = 18 * MiB, WS_WPA = 19 * MiB, WS_WPB = 20 * MiB, WS_WO = 21 * MiB, WS_W13 = 23 * MiB, WS_W2 = 55 * MiB;
constexpr size_t WS_H = 72 * MiB;
constexpr size_t WS_QA = 136 * MiB, WS_KA = 168 * MiB, WS_VA = 176 * MiB, WS_QLAT = 184 * MiB, WS_KVLAT = 208 * MiB;
constexpr size_t WS_KB = 224 * MiB, WS_VB = 272 * MiB, WS_QB = 304 * MiB, WS_OB = 352 * MiB, WS_SA = 384 * MiB, WS_SB = 448 * MiB, WS_END = 512 * MiB;
constexpr size_t WS_ACT = 136 * MiB, WS_Y2 = 208 * MiB;
constexpr int ACT_ROWS = 2 * T + NE * 256;
static_assert(WS_ACT + (size_t)ACT_ROWS * FF * 2 <= WS_Y2 && WS_Y2 + (size_t)2 * T * D * 2 <= WS_END, "moe overlay");
constexpr int CW_BAR = 4096;
constexpr int CW_CNT = 16384;

constexpr int RING_BYTES = 131072, MISC_OFF = RING_BYTES, LDS_BYTES = 147456;

__device__ __forceinline__ float bf2f(unsigned v) { return __uint_as_float(v << 16); }
__device__ __forceinline__ unsigned cvt_pk_bf16(float lo, float hi) { unsigned r; asm volatile("v_cvt_pk_bf16_f32 %0, %1, %2" : "=v"(r) : "v"(lo), "v"(hi)); return r; }
__device__ __forceinline__ u32x4 pack8(f32x4 a, f32x4 b) { u32x4 w; w.x = cvt_pk_bf16(a[0], a[1]); w.y = cvt_pk_bf16(a[2], a[3]); w.z = cvt_pk_bf16(b[0], b[1]); w.w = cvt_pk_bf16(b[2], b[3]); return w; }
__device__ __forceinline__ void unpack8(u32x4 w, f32x4& a, f32x4& b) { a[0] = bf2f(w.x & 0xffffu); a[1] = bf2f(w.x >> 16); a[2] = bf2f(w.y & 0xffffu); a[3] = bf2f(w.y >> 16); b[0] = bf2f(w.z & 0xffffu); b[1] = bf2f(w.z >> 16); b[2] = bf2f(w.w & 0xffffu); b[3] = bf2f(w.w >> 16); }
__device__ __forceinline__ float wave_sum(float v) {
#pragma unroll
    for (int o = 1; o < 64; o <<= 1) v += __shfl_xor(v, o);
    return v;
}
__device__ __forceinline__ float sigm(float v) { return 1.f / (1.f + __expf(-v)); }
#define VM_WAIT() asm volatile("s_waitcnt vmcnt(0)" ::: "memory")
#define LAUNDER_S(p) asm volatile("" : "+s"(p))
#define LAUNDER_V(v) asm volatile("" : "+v"(v))
#define LDS_WAIT() asm volatile("s_waitcnt lgkmcnt(0)" ::: "memory")

#define XB_TMO      128
#define XB_XCNT(j)  (256  + 64 * (j))
#define XB_XSUB(j)  (1280 + 64 * (j))
#define XB_XGEN(j)  (2304 + 64 * (j))
#define XB_TOP      3328
#define XB_TOPGEN   3392
#define XCD_BAR_WORDS 3456
#define XB_SPIN_CAP (1u << 22)
__device__ __forceinline__ unsigned xb_ld(unsigned* p)              { return __hip_atomic_load(p, __ATOMIC_RELAXED, __HIP_MEMORY_SCOPE_AGENT); }
__device__ __forceinline__ unsigned xb_add(unsigned* p, unsigned v) { return __hip_atomic_fetch_add(p, v, __ATOMIC_RELAXED, __HIP_MEMORY_SCOPE_AGENT); }
__device__ __forceinline__ unsigned xb_xcc_id() { return (unsigned)__builtin_amdgcn_s_getreg((3 << 11) | 20) & 0xFu; }
#define XB_SPIN(cond, bar) do { unsigned _sp = 0; while (cond) { __builtin_amdgcn_s_sleep(1); \
    if ((++_sp & 255u) == 0u) { if (xb_ld(&(bar)[XB_TMO])) break; if (_sp > XB_SPIN_CAP) { atomicAdd(&(bar)[XB_TMO], 1u); break; } } } } while (0)
struct XcdBarrier { unsigned* bar; unsigned x; volatile LAS unsigned* st; };
__device__ __forceinline__ XcdBarrier xcd_barrier_post(unsigned* bar, volatile LAS unsigned* st) {
    XcdBarrier b; b.bar = bar; b.x = xb_xcc_id(); b.st = st;
    if (threadIdx.x == 0) (void)xb_add(&bar[XB_XCNT(b.x)], 1u);
    return b;
}
__device__ __forceinline__ void xcd_barrier_complete(unsigned* bar, unsigned x, unsigned& nloc, unsigned& nx) {
    const unsigned G = gridDim.x * gridDim.y * gridDim.z;
    unsigned sum, cnt, mine, sp = 0u;
    for (;;) {
        sum = 0u; cnt = 0u; mine = 0u;
#pragma unroll
        for (unsigned j = 0; j < 16; ++j) { const unsigned c = xb_ld(&bar[XB_XCNT(j)]); sum += c; cnt += (c > 0u) ? 1u : 0u; mine = (j == x) ? c : mine; }
        if (sum == G) break;
        __builtin_amdgcn_s_sleep(1);
        if ((++sp & 255u) == 0u) { if (xb_ld(&bar[XB_TMO])) break; if (sp > XB_SPIN_CAP) { atomicAdd(&bar[XB_TMO], 1u); break; } }
    }
    nloc = mine > 0u ? mine : 1u; nx = cnt > 0u ? cnt : 1u;
}
__device__ __forceinline__ void xcd_barrier(const XcdBarrier& b) {
    asm volatile("s_waitcnt vmcnt(0)" ::: "memory");
    __syncthreads();
    if (threadIdx.x == 0) {
        unsigned* bar = b.bar;
        __builtin_amdgcn_s_waitcnt(0);
        unsigned nloc = b.st[0], nx = b.st[1];
        if (nloc == 0u) { xcd_barrier_complete(bar, b.x, nloc, nx); b.st[0] = nloc; b.st[1] = nx; }
        const unsigned old = xb_add(&bar[XB_XSUB(b.x)], 1u);
        const unsigned gen = old / nloc;
        if (old + 1u == (gen + 1u) * nloc) {
            __builtin_amdgcn_fence(__ATOMIC_RELEASE, "agent");
            asm volatile("s_waitcnt vmcnt(0)" ::: "memory");
            const unsigned og = xb_add(&bar[XB_TOP], 1u);
            const unsigned tg = og / nx;
            if (og + 1u == (tg + 1u) * nx) xb_add(&bar[XB_TOPGEN], 1u);
            else XB_SPIN(xb_ld(&bar[XB_TOPGEN]) == tg, bar);
            __builtin_amdgcn_fence(__ATOMIC_ACQUIRE, "agent");
            xb_add(&bar[XB_XGEN(b.x)], 1u);
            asm volatile("s_waitcnt vmcnt(0)" ::: "memory");
        } else {
            XB_SPIN(xb_ld(&bar[XB_XGEN(b.x)]) == gen, bar);
            __builtin_amdgcn_fence(__ATOMIC_ACQUIRE, "agent");
            asm volatile("s_waitcnt vmcnt(0)" ::: "memory");
        }
    }
    __syncthreads();
}

namespace gp {
constexpr int BM = 256, BK = 64, HALF = 128, HTB = HALF * BK * 2, NXCD = 8, WGM = 8;
__host__ __device__ __forceinline__ int lds_byte(int r, int c) { const int st = (r >> 4) * 2 + (c >> 5), rr = r & 15, cc = c & 31, ob = rr * 64 + cc * 2; return st * 1024 + (ob ^ (((ob >> 9) & 1) << 5)); }
__host__ __device__ __forceinline__ void stage_rc(int b, int& R, int& C) { const int st = b / 1024, sb = b % 1024, swz = sb ^ (((sb >> 9) & 1) << 5); R = (st >> 1) * 16 + swz / 64; C = (st & 1) * 32 + (swz % 64) / 2; }
__host__ __device__ __forceinline__ int perm32(int rho) { const int n = rho >> 4, i = rho & 15; return 8 * (i >> 2) + 4 * n + (i & 3); }

struct Unit { int pm, pn, be, rl, nv; };
struct Gemm { const bf16_t* A; const bf16_t* Bt; int K; size_t bstride; const unsigned* list; };

__device__ __forceinline__ int xcd_remap(int wgid, int nwg) { const int q = nwg / NXCD, r = nwg % NXCD, xcd = wgid % NXCD, off = wgid / NXCD; return (xcd < r ? xcd * (q + 1) : r * (q + 1) + (xcd - r) * q) + off; }
struct DenseOrder {
    int nM, nN, nwg, G, c;
    __device__ void init(int M, int N, int G_, int c_) { nM = M / BM; nN = N / BM; nwg = nM * nN; G = G_; c = c_; }
    __device__ bool next(int i, Unit& u) const {
        const long L = (long)i * G + c; if (L >= nwg) return false;
        const int wgid = xcd_remap((int)L, nwg);
        const int nig = WGM * nN, gid = wgid / nig, fm = gid * WGM, gsz = (nM - fm) < WGM ? (nM - fm) : WGM;
        u.pm = fm + ((wgid % nig) % gsz); u.pn = (wgid % nig) / gsz; u.be = 0; u.rl = 0; u.nv = 256; return true;
    }
};
struct MoeOrder {
    const LAS int* tab; int nwg, G, c;
    __device__ static int rd(const LAS int* p) { return __builtin_amdgcn_readfirstlane(*p); }
    __device__ void init(const LAS int* tab_, int G_, int c_) { tab = tab_; nwg = rd(tab_ + 16) * 4; G = G_; c = c_; }
    __device__ bool next(int i, Unit& u) const {
        const long L = (long)i * G + c; if (L >= nwg) return false;
        const int wgid = xcd_remap((int)L, nwg);
        const int tile = wgid >> 2; int e = 0;
        for (int k = 1; k < NE; ++k) e += (rd(tab + k) <= tile) ? 1 : 0;
        u.pm = tile; u.pn = wgid & 3; u.be = e; u.rl = tile - rd(tab + e); const int rem = rd(tab + 32 + e) - u.rl * 256; u.nv = rem < 256 ? rem : 256; return true;
    }
};

#define ACC_T f32x4 (&acc)[2][2][4][2]

template <class Epi, class Sched, bool GATHER>
__device__ __forceinline__ void gemm_phase_ref(int tid, const Gemm g, const Sched& S, const Epi& E) {
    const int wid = __builtin_amdgcn_readfirstlane(tid >> 6), lane = tid & 63, wr = wid >> 2, wc = wid & 3, fr = lane & 15, fq = lane >> 4;
    const int K = g.K; Unit u;
    for (int ui = 0; S.next(ui, u); ++ui) {
        f32x4 acc[2][2][4][2];
#pragma unroll
        for (int a = 0; a < 2; ++a)
#pragma unroll
            for (int b = 0; b < 2; ++b)
#pragma unroll
                for (int m = 0; m < 4; ++m)
#pragma unroll
                    for (int n = 0; n < 2; ++n) acc[a][b][m][n] = (f32x4){0.f, 0.f, 0.f, 0.f};
        const bf16_t* Bt = g.Bt + (size_t)u.be * g.bstride + (size_t)u.pn * 256 * K;
        for (int ai = 0; ai < 2; ++ai)
            for (int m = 0; m < 4; ++m) {
                const int rloc = ai * 128 + wr * 64 + m * 16 + fr;
                size_t arow;
                if (GATHER) { arow = (rloc < u.nv) ? (size_t)(g.list[(size_t)u.be * T + u.rl * 256 + rloc] >> 1) : 0; }
                else arow = (size_t)u.pm * 256 + rloc;
                const bf16_t* ap = g.A + arow * K;
                for (int bj = 0; bj < 2; ++bj) {
                    const bf16_t* bp = Bt + (size_t)(bj * 128 + wc * 32 + fq * 8) * K;
                    float s[8];
#pragma unroll
                    for (int c = 0; c < 8; ++c) {
                        float sc = 0.f; const bf16_t* bpc = bp + (size_t)c * K;
#pragma unroll 2
                        for (int k = 0; k < K; k += 8) {
                            f32x4 a0, a1, b0, b1; unpack8(*(const u32x4*)(ap + k), a0, a1); unpack8(*(const u32x4*)(bpc + k), b0, b1);
                            sc += a0[0] * b0[0] + a0[1] * b0[1] + a0[2] * b0[2] + a0[3] * b0[3] + a1[0] * b1[0] + a1[1] * b1[1] + a1[2] * b1[2] + a1[3] * b1[3];
                        }
                        s[c] = sc; asm volatile("" : "+v"(s[c]));
                    }
#pragma unroll
                    for (int a2 = 0; a2 < 2; ++a2)
#pragma unroll
                        for (int b2 = 0; b2 < 2; ++b2)
#pragma unroll
                            for (int m2 = 0; m2 < 4; ++m2)
                                if (a2 == ai && b2 == bj && m2 == m) { acc[a2][b2][m2][0] = (f32x4){s[0], s[1], s[2], s[3]}; acc[a2][b2][m2][1] = (f32x4){s[4], s[5], s[6], s[7]}; }
                }
            }
        E(acc, u, wr, wc, fr, fq);
    }
}

#if FAST_GEMM
template <class Epi, class Sched, bool GATHER>
__device__ __forceinline__ void gemm_phase_fast(int tid, LAS unsigned char* lds, const Gemm g, const Sched& S, const Epi& E) {
    const int wid = __builtin_amdgcn_readfirstlane(tid >> 6), lane = tid & 63, wr = wid >> 2, wc = wid & 3, fr = lane & 15, fq = lane >> 4;
    const int K = g.K, nt = K / BK;
    int Rr[2], Cc[2]; unsigned voffB[2];
#pragma unroll
    for (int i = 0; i < 2; ++i) { stage_rc(tid * 16 + i * 8192, Rr[i], Cc[i]); const int Rb = (Rr[i] & ~31) + perm32(Rr[i] & 31); voffB[i] = (unsigned)(Rb * K + Cc[i]) * 2u; }
    const size_t kstep = (size_t)(BK * 2), hstep = (size_t)HALF * K * 2, tstep = 2 * hstep;
    const unsigned ldsw = (unsigned)wid * 1024u;
    const int aoff = lds_byte(wr * 64 + fr, fq * 8), boff = lds_byte(wc * 32 + fr, fq * 8);
#define GP_SA(b, h) (((b) * 2 + (h)) * HTB)
#define GP_SB(b, h) ((4 + (b) * 2 + (h)) * HTB)
#define GP_STAGE2(bufoff, gbase, v0, v1) do { \
        __builtin_amdgcn_global_load_lds((const unsigned*)((const char*)(gbase) + (v0)), (LAS unsigned*)(lds + (bufoff) + ldsw), 16, 0, 0); \
        __builtin_amdgcn_global_load_lds((const unsigned*)((const char*)(gbase) + (v1)), (LAS unsigned*)(lds + (bufoff) + ldsw + 8192), 16, 0, 0); } while (0)
#define GP_STAGEB(bufoff, gbase) GP_STAGE2(bufoff, gbase, voffB[0], voffB[1])
#define GP_LDA(dst, b, h) do { _Pragma("unroll") for (int m = 0; m < 4; ++m) _Pragma("unroll") for (int k = 0; k < 2; ++k) dst[m][k] = *(const LAS bf16x8*)(lds + GP_SA(b, h) + aoff + m * 2048 + k * 1024); } while (0)
#define GP_LDB(dst, b, h) do { _Pragma("unroll") for (int n = 0; n < 2; ++n) _Pragma("unroll") for (int k = 0; k < 2; ++k) dst[n][k] = *(const LAS bf16x8*)(lds + GP_SB(b, h) + boff + n * 2048 + k * 1024); } while (0)
#define GP_MMA(ai, bj, At, Bt) do { __builtin_amdgcn_s_setprio(1); _Pragma("unroll") for (int m = 0; m < 4; ++m) _Pragma("unroll") for (int n = 0; n < 2; ++n) _Pragma("unroll") for (int k = 0; k < 2; ++k) \
        acc[ai][bj][m][n] = __builtin_amdgcn_mfma_f32_16x16x32_bf16(Bt[n][k], At[m][k], acc[ai][bj][m][n], 0, 0, 0); __builtin_amdgcn_s_setprio(0); } while (0)
#define GP_WAIT_V(n) asm volatile("s_waitcnt vmcnt(" #n ")" ::: "memory")
#define GP_WAIT_L(n) asm volatile("s_waitcnt lgkmcnt(" #n ")" ::: "memory")
#define GP_BAR __builtin_amdgcn_s_barrier()
#define GP_SCHED __builtin_amdgcn_sched_barrier(0)
    Unit cur, nxt; int ui = 0;
    if (!S.next(0, cur)) return;
    f32x4 acc[2][2][4][2];
#pragma unroll
    for (int a = 0; a < 2; ++a)
#pragma unroll
        for (int b = 0; b < 2; ++b)
#pragma unroll
            for (int m = 0; m < 4; ++m)
#pragma unroll
                for (int n = 0; n < 2; ++n) acc[a][b][m][n] = (f32x4){0.f, 0.f, 0.f, 0.f};
    bf16x8 At[4][2], B0[2][2], B1[2][2];
    unsigned vC0, vC1, vC2, vC3, vN0, vN1, vN2, vN3;
#define GP_VOFF(u, o0, o1, o2, o3) do { if (GATHER) { \
        int tl_ = tid; LAUNDER_V(tl_); int R0_, C0_, R1_, C1_; stage_rc(tl_ * 16, R0_, C0_); stage_rc(tl_ * 16 + 8192, R1_, C1_);     \
        const unsigned* lp = g.list + (size_t)(u).be * T + (u).rl * 256; \
        const int nvm = (u).nv - 1; const int p0 = min(R0_, nvm), p1 = min(R1_, nvm), p2 = min(128 + R0_, nvm), p3 = min(128 + R1_, nvm); \
        const unsigned t0 = lp[p0] >> 1, t1 = lp[p1] >> 1, t2 = lp[p2] >> 1, t3 = lp[p3] >> 1; \
        o0 = (t0 * K + C0_) * 2u; o1 = (t1 * K + C1_) * 2u; o2 = (t2 * K + C0_) * 2u; o3 = (t3 * K + C1_) * 2u; \
      } else { o0 = (unsigned)(Rr[0] * K + Cc[0]) * 2u; o1 = (unsigned)(Rr[1] * K + Cc[1]) * 2u; o2 = o0 + (unsigned)hstep; o3 = o1 + (unsigned)hstep; } } while (0)
    GP_VOFF(cur, vC0, vC1, vC2, vC3);
    const char* cA = (const char*)g.A + (GATHER ? (size_t)0 : (size_t)cur.pm * tstep);
    const char* cB = (const char*)g.Bt + ((size_t)cur.be * g.bstride) * 2 + (size_t)cur.pn * tstep;
    GP_STAGEB(GP_SB(0, 0), cB); GP_STAGEB(GP_SB(0, 1), cB + hstep); GP_STAGE2(GP_SA(0, 0), cA, vC0, vC1); GP_STAGE2(GP_SA(0, 1), cA, vC2, vC3);
    if (wr == 1) GP_BAR;
    GP_WAIT_V(2); GP_BAR;
    GP_STAGEB(GP_SB(1, 0), cB + kstep); GP_STAGE2(GP_SA(1, 0), cA + kstep, vC0, vC1); GP_STAGEB(GP_SB(1, 1), cB + hstep + kstep);
    GP_WAIT_V(6); GP_BAR;
    for (;;) {
        const bool has_next = S.next(ui + 1, nxt);
        const char* nA = has_next ? (const char*)g.A + (GATHER ? (size_t)0 : (size_t)nxt.pm * tstep) : cA;
        const char* nB = has_next ? (const char*)g.Bt + ((size_t)nxt.be * g.bstride) * 2 + (size_t)nxt.pn * tstep : cB;
        if (has_next) { GP_VOFF(nxt, vN0, vN1, vN2, vN3); } else { vN0 = vC0; vN1 = vC1; vN2 = vC2; vN3 = vC3; }
#pragma nounroll
        for (int t = 0; t < nt; t += 2) {
            const bool last = (t == nt - 2);
            const char* a1 = cA + (size_t)(t + 1) * kstep;
            const char* a2 = last ? nA : cA + (size_t)(t + 2) * kstep; const char* b2 = last ? nB : cB + (size_t)(t + 2) * kstep;
            const char* a3 = a2 + kstep; const char* b3 = b2 + kstep;
            const unsigned w0 = last ? vN0 : vC0, w1 = last ? vN1 : vC1, w2 = last ? vN2 : vC2, w3 = last ? vN3 : vC3;
            GP_LDB(B0, 0, 0); GP_LDB(B1, 0, 1); GP_SCHED; GP_LDA(At, 0, 0); GP_STAGE2(GP_SA(1, 1), a1, vC2, vC3);
            GP_WAIT_V(8); GP_WAIT_L(0); GP_BAR; GP_MMA(0, 0, At, B0); GP_MMA(0, 1, At, B1); GP_BAR; GP_SCHED;
            GP_LDA(At, 0, 1); GP_STAGEB(GP_SB(0, 0), b2); GP_STAGEB(GP_SB(0, 1), b2 + hstep); GP_STAGE2(GP_SA(0, 0), a2, w0, w1);
            GP_WAIT_V(8); GP_WAIT_L(0); GP_BAR; GP_MMA(1, 0, At, B0); GP_MMA(1, 1, At, B1); GP_BAR; GP_SCHED;
            GP_LDB(B0, 1, 0); GP_LDB(B1, 1, 1); GP_SCHED; GP_LDA(At, 1, 0); GP_STAGE2(GP_SA(0, 1), a2, w2, w3);
            GP_WAIT_V(8); GP_WAIT_L(0); GP_BAR; GP_MMA(0, 0, At, B0); GP_MMA(0, 1, At, B1); GP_BAR; GP_SCHED;
            GP_LDA(At, 1, 1); GP_STAGEB(GP_SB(1, 0), b3); GP_STAGEB(GP_SB(1, 1), b3 + hstep); GP_STAGE2(GP_SA(1, 0), a3, w0, w1);
            GP_WAIT_V(8); GP_WAIT_L(0); GP_BAR; GP_MMA(1, 0, At, B0); GP_MMA(1, 1, At, B1); GP_BAR; GP_SCHED;
        }
        if (wr == 0) GP_BAR;
        E(acc, cur, wr, wc, fr, fq);
        if (!has_next) break;
#pragma unroll
        for (int a = 0; a < 2; ++a)
#pragma unroll
            for (int b = 0; b < 2; ++b)
#pragma unroll
                for (int m = 0; m < 4; ++m)
#pragma unroll
                    for (int n = 0; n < 2; ++n) acc[a][b][m][n] = (f32x4){0.f, 0.f, 0.f, 0.f};
        cur = nxt; cA = nA; cB = nB; vC0 = vN0; vC1 = vN1; vC2 = vN2; vC3 = vN3; ++ui;
        if (wr == 1) GP_BAR;
    }
    GP_WAIT_V(0);
    GP_BAR;
#undef GP_SA
#undef GP_SB
#undef GP_STAGE2
#undef GP_STAGEB
#undef GP_LDA
#undef GP_LDB
#undef GP_MMA
#undef GP_WAIT_V
#undef GP_WAIT_L
#undef GP_BAR
#undef GP_SCHED
#undef GP_VOFF
}
#endif

template <class Epi, class Sched, bool GATHER = false>
__device__ __forceinline__ void gemm_phase(int tid, LAS unsigned char* lds, const Gemm g, const Sched& S, const Epi& E) {
#if FAST_GEMM
    gemm_phase_fast<Epi, Sched, GATHER>(tid, lds, g, S, E);
#else
    (void)lds; gemm_phase_ref<Epi, Sched, GATHER>(tid, g, S, E);
#endif
}

#define EPI_ROW(ai, m) (u.pm * 256 + (ai) * 128 + wr * 64 + (m) * 16 + fr)
#define EPI_COL(bj) (u.pn * 256 + (bj) * 128 + wc * 32 + fq * 8)
__device__ __forceinline__ float dot4(f32x4 a) { return (a[0] * a[0] + a[1] * a[1]) + (a[2] * a[2] + a[3] * a[3]); }

struct EpiIn {
    bf16_t *QA, *KA, *VA, *QLAT, *KVLAT, *KB, *SA, *SB; float *SSQ, *SSKV; const float *gq, *gk, *cosA, *sinA, *cosB, *sinB;
    __device__ __forceinline__ void operator()(const ACC_T, const Unit& u, int wr, int wc, int fr, int fq) const {
        const int wb = u.pn * 4 + wc;
        if (wb < 10) {
            const bool isq = wb < 8; const int head = isq ? wb : wb - 8; const float* g = isq ? gq : gk; bf16_t* dst = isq ? QA : KA; const int dp = isq ? 512 : 128; const float qs = isq ? QSCALE_A : 1.f;
            const f32x4 g00 = *(const f32x4*)(g + 8 * fq), g01 = *(const f32x4*)(g + 8 * fq + 4), g10 = *(const f32x4*)(g + 32 + 8 * fq), g11 = *(const f32x4*)(g + 36 + 8 * fq);
#pragma unroll
            for (int ai = 0; ai < 2; ++ai)
#pragma unroll
                for (int m = 0; m < 4; ++m) {
                    const int r = EPI_ROW(ai, m), pos = r & (S - 1);
                    const f32x4 v00 = acc[ai][0][m][0], v01 = acc[ai][0][m][1], v10 = acc[ai][1][m][0], v11 = acc[ai][1][m][1];
                    float ss = (dot4(v00) + dot4(v01)) + (dot4(v10) + dot4(v11)); ss += __shfl_xor(ss, 16); ss += __shfl_xor(ss, 32);
                    const float rstd = rsqrtf(ss * (1.f / 64.f) + EPS);
                    const f32x4 y00 = v00 * rstd * g00, y01 = v01 * rstd * g01, y10 = v10 * rstd * g10, y11 = v11 * rstd * g11;
                    const f32x4 c0 = *(const f32x4*)(cosA + pos * 32 + 8 * fq), c1 = *(const f32x4*)(cosA + pos * 32 + 8 * fq + 4), s0 = *(const f32x4*)(sinA + pos * 32 + 8 * fq), s1 = *(const f32x4*)(sinA + pos * 32 + 8 * fq + 4);
                    const f32x4 o00 = (y00 * c0 - y10 * s0) * qs, o01 = (y01 * c1 - y11 * s1) * qs, o10 = (y10 * c0 + y00 * s0) * qs, o11 = (y11 * c1 + y01 * s1) * qs;
                    bf16_t* p = dst + (size_t)r * dp + head * 64 + 8 * fq;
                    *(u32x4*)p = pack8(o00, o01); *(u32x4*)(p + 32) = pack8(o10, o11);
                }
        } else if (wb < 12) {
#pragma unroll
            for (int ai = 0; ai < 2; ++ai)
#pragma unroll
                for (int m = 0; m < 4; ++m) { bf16_t* p = VA + (size_t)EPI_ROW(ai, m) * 128 + (wb - 10) * 64 + 8 * fq;
                    *(u32x4*)p = pack8(acc[ai][0][m][0], acc[ai][0][m][1]); *(u32x4*)(p + 32) = pack8(acc[ai][1][m][0], acc[ai][1][m][1]); }
        } else if (wb < 22) {
            const bool isq = wb < 18; const int idx = isq ? wb - 12 : wb - 18; bf16_t* dst = isq ? QLAT : KVLAT; const int dp = isq ? 384 : 256;
#pragma unroll
            for (int ai = 0; ai < 2; ++ai)
#pragma unroll
                for (int m = 0; m < 4; ++m) {
                    const int r = EPI_ROW(ai, m);
                    const f32x4 v00 = acc[ai][0][m][0], v01 = acc[ai][0][m][1], v10 = acc[ai][1][m][0], v11 = acc[ai][1][m][1];
                    float ss = (dot4(v00) + dot4(v01)) + (dot4(v10) + dot4(v11)); ss += __shfl_xor(ss, 16); ss += __shfl_xor(ss, 32);
                    if (fq == 0) { if (isq) SSQ[(size_t)r * 8 + idx] = ss; else SSKV[(size_t)r * 4 + idx] = ss; }
                    bf16_t* p = dst + (size_t)r * dp + idx * 64 + 8 * fq;
                    *(u32x4*)p = pack8(v00, v01); *(u32x4*)(p + 32) = pack8(v10, v11);
                }
        } else if (wb == 22) {
            if (fq < 2) {
#pragma unroll
                for (int ai = 0; ai < 2; ++ai)
#pragma unroll
                    for (int m = 0; m < 4; ++m) {
                        const int r = EPI_ROW(ai, m), pos = r & (S - 1);
                        const f32x4 x10 = acc[ai][0][m][0], x11 = acc[ai][0][m][1], x20 = acc[ai][1][m][0], x21 = acc[ai][1][m][1];
                        const f32x4 c0 = *(const f32x4*)(cosB + pos * 16 + 8 * fq), c1 = *(const f32x4*)(cosB + pos * 16 + 8 * fq + 4), s0 = *(const f32x4*)(sinB + pos * 16 + 8 * fq), s1 = *(const f32x4*)(sinB + pos * 16 + 8 * fq + 4);
                        const u32x4 w1 = pack8(x10 * c0 - x20 * s0, x11 * c1 - x21 * s1), w2 = pack8(x20 * c0 + x10 * s0, x21 * c1 + x11 * s1);
                        bf16_t* p = KB + (size_t)r * 768 + 64 + 8 * fq;
#pragma unroll
                        for (int h = 0; h < 8; ++h) { *(u32x4*)(p + h * 96) = w1; *(u32x4*)(p + h * 96 + 16) = w2; }
                    }
            }
        } else if (wb == 23) {
        } else {
            const bool isa = wb < 40; const int idx = isa ? wb - 24 : wb - 40; bf16_t* dst = isa ? SA : SB;
#pragma unroll
            for (int ai = 0; ai < 2; ++ai)
#pragma unroll
                for (int m = 0; m < 4; ++m) { bf16_t* p = dst + (size_t)EPI_ROW(ai, m) * 1024 + idx * 64 + 8 * fq;
#pragma unroll
                    for (int bj = 0; bj < 2; ++bj) { f32x4 a = acc[ai][bj][m][0], b = acc[ai][bj][m][1];
#pragma unroll
                        for (int j = 0; j < 4; ++j) { a[j] = sigm(a[j]); b[j] = sigm(b[j]); }
                        *(u32x4*)(p + bj * 32) = pack8(a, b); } }
        }
    }
};
__host__ __device__ __forceinline__ int src_col_in(int n) {
    const int pn = n >> 8, nl = n & 255, bj = nl >> 7, wc = (nl & 127) >> 5, p = nl & 31, wb = pn * 4 + wc, s = bj * 32 + p;
    if (wb < 8) return wb * 64 + s;
    if (wb < 10) return 512 + (wb - 8) * 64 + s;
    if (wb < 12) return 640 + (wb - 10) * 64 + s;
    if (wb < 18) return 768 + (wb - 12) * 64 + s;
    if (wb < 22) return 1152 + (wb - 18) * 64 + s;
    if (wb == 22) return p < 16 ? 1408 + bj * 16 + p : -1;
    if (wb == 23) return -1;
    if (wb < 40) return 1440 + (wb - 24) * 64 + s;
    return 2464 + (wb - 40) * 64 + s;
}
struct EpiQb {
    bf16_t* QB; const float *SSQ, *cosB, *sinB;
    __device__ __forceinline__ void operator()(const ACC_T, const Unit& u, int wr, int wc, int fr, int fq) const {
#pragma unroll
        for (int ai = 0; ai < 2; ++ai)
#pragma unroll
            for (int m = 0; m < 4; ++m) {
                const int r = EPI_ROW(ai, m), pos = r & (S - 1);
                const f32x4 sa = *(const f32x4*)(SSQ + (size_t)r * 8); const f32x2 sb = *(const f32x2*)(SSQ + (size_t)r * 8 + 4);
                const float rstd = rsqrtf((((sa[0] + sa[1]) + (sa[2] + sa[3])) + (sb[0] + sb[1])) * (1.f / 384.f) + EPS);
#pragma unroll
                for (int bj = 0; bj < 2; ++bj) {
                    f32x4 v0 = acc[ai][bj][m][0] * rstd, v1 = acc[ai][bj][m][1] * rstd;
                    const int c32 = u.pn * 8 + bj * 4 + wc;
                    if (c32 % 3 == 2) {
                        f32x4 o0, o1;
#pragma unroll
                        for (int j = 0; j < 4; ++j) { o0[j] = __shfl_xor(v0[j], 32); o1[j] = __shfl_xor(v1[j], 32); }
                        const int i0 = 8 * (fq & 1);
                        const f32x4 c0 = *(const f32x4*)(cosB + pos * 16 + i0), c1 = *(const f32x4*)(cosB + pos * 16 + i0 + 4), s0 = *(const f32x4*)(sinB + pos * 16 + i0), s1 = *(const f32x4*)(sinB + pos * 16 + i0 + 4);
                        if (fq < 2) { v0 = v0 * c0 - o0 * s0; v1 = v1 * c1 - o1 * s1; } else { v0 = v0 * c0 + o0 * s0; v1 = v1 * c1 + o1 * s1; }
                    }
                    *(u32x4*)(QB + (size_t)r * 768 + EPI_COL(bj)) = pack8(v0 * QSCALE_B, v1 * QSCALE_B);
                }
            }
    }
};
struct EpiKvb {
    bf16_t *KB, *VB; const float* SSKV;
    __device__ __forceinline__ void operator()(const ACC_T, const Unit& u, int wr, int wc, int fr, int fq) const {
#pragma unroll
        for (int ai = 0; ai < 2; ++ai)
#pragma unroll
            for (int m = 0; m < 4; ++m) {
                const int r = EPI_ROW(ai, m);
                const f32x4 sa = *(const f32x4*)(SSKV + (size_t)r * 4);
                const float rstd = rsqrtf(((sa[0] + sa[1]) + (sa[2] + sa[3])) * (1.f / 256.f) + EPS);
#pragma unroll
                for (int bj = 0; bj < 2; ++bj) {
                    const int head = u.pn * 2 + bj, o = wc * 32 + fq * 8;
                    const u32x4 w = pack8(acc[ai][bj][m][0] * rstd, acc[ai][bj][m][1] * rstd);
                    if (wc < 2) *(u32x4*)(KB + (size_t)r * 768 + head * 96 + o) = w; else *(u32x4*)(VB + (size_t)r * 512 + head * 64 + (o - 64)) = w;
                }
            }
    }
};
template <int MODE> struct EpiProj {
    bf16_t* O; const bf16_t* gate;
    __device__ __forceinline__ void operator()(const ACC_T, const Unit& u, int wr, int wc, int fr, int fq) const {
#pragma unroll
        for (int ai = 0; ai < 2; ++ai)
#pragma unroll
            for (int m = 0; m < 4; ++m) {
                const int r = EPI_ROW(ai, m);
#pragma unroll
                for (int bj = 0; bj < 2; ++bj) {
                    const size_t off = (size_t)r * D + EPI_COL(bj);
                    f32x4 g0, g1; unpack8(*(const u32x4*)(gate + off), g0, g1);
                    f32x4 v0 = acc[ai][bj][m][0] * g0, v1 = acc[ai][bj][m][1] * g1;
                    if (MODE == 1) { f32x4 p0, p1; unpack8(*(const u32x4*)(O + off), p0, p1); v0 += p0; v1 += p1; }
                    *(u32x4*)(O + off) = pack8(v0, v1);
                }
            }
    }
};
struct EpiWo {
    float* X; const float* modl; float* XO;
    __device__ __forceinline__ void operator()(const ACC_T, const Unit& u, int wr, int wc, int fr, int fq) const {
        const float* g1 = modl + (size_t)(u.pm >> 4) * 6 * D + 2 * D;
#pragma unroll
        for (int bj = 0; bj < 2; ++bj) {
            const int c = EPI_COL(bj); const f32x4 ga = *(const f32x4*)(g1 + c), gb = *(const f32x4*)(g1 + c + 4);
#pragma unroll
            for (int ai = 0; ai < 2; ++ai)
#pragma unroll
                for (int m = 0; m < 4; ++m) { float* p = X + (size_t)EPI_ROW(ai, m) * D + c;
                    const f32x4 x0 = *(const f32x4*)p, x1 = *(const f32x4*)(p + 4);
                    float* q = XO + (size_t)EPI_ROW(ai, m) * D + c; *(f32x4*)q = x0 + ga * acc[ai][bj][m][0]; *(f32x4*)(q + 4) = x1 + gb * acc[ai][bj][m][1]; }
        }
    }
};
struct EpiUp {
    bf16_t* ACT;
    __device__ __forceinline__ void operator()(const ACC_T, const Unit& u, int wr, int wc, int fr, int fq) const {
#pragma unroll
        for (int ai = 0; ai < 2; ++ai)
#pragma unroll
            for (int m = 0; m < 4; ++m) {
                f32x4 a = acc[ai][0][m][0], b = acc[ai][0][m][1]; const f32x4 c = acc[ai][1][m][0], d = acc[ai][1][m][1];
#pragma unroll
                for (int j = 0; j < 4; ++j) { a[j] = a[j] * sigm(a[j]) * c[j]; b[j] = b[j] * sigm(b[j]) * d[j]; }
                *(u32x4*)(ACT + (size_t)EPI_ROW(ai, m) * FF + u.pn * 128 + wc * 32 + fq * 8) = pack8(a, b);
            }
    }
};
struct EpiDown {
    bf16_t* Y2; const unsigned* list; const float* gw;
    __device__ __forceinline__ void operator()(const ACC_T, const Unit& u, int wr, int wc, int fr, int fq) const {
#pragma unroll
        for (int ai = 0; ai < 2; ++ai)
#pragma unroll
            for (int m = 0; m < 4; ++m) {
                const int rloc = ai * 128 + wr * 64 + m * 16 + fr;
                if (rloc < u.nv) {
                    const unsigned entry = list[(size_t)u.be * T + u.rl * 256 + rloc]; const float w = gw[entry];
#pragma unroll
                    for (int bj = 0; bj < 2; ++bj) *(u32x4*)(Y2 + (size_t)entry * D + EPI_COL(bj)) = pack8(acc[ai][bj][m][0] * w, acc[ai][bj][m][1] * w);
                }
            }
    }
};
}

namespace at {
struct Tensors { const bf16_t* Q; int qp; const bf16_t* K; int kp; const bf16_t* V; int vp; bf16_t* O; int op; int group; };
__device__ __forceinline__ bool next_unit(int i, int vcu, int G, int& bh, int& qb) {
    int u;
    if (G == 256) { if (i >= 4) return false; u = (vcu >> 5) * 128 + i * 32 + (vcu & 31); }
    else { u = i * G + vcu; if (u >= 1024) return false; }
    bh = u >> 4; qb = u & 15; return true;
}
template <int DQK>
__device__ __forceinline__ void attn_phase_ref(int tid, const Tensors& A, int vcu, int G) {
    int bh, qb;
    for (int i = 0; next_unit(i, vcu, G, bh, qb); ++i) {
        const int b = bh >> 3, h = bh & 7, kvh = h / A.group;
        {
            const int dh = tid >> 8;
            const size_t row = (size_t)b * S + qb * 256 + (tid & 255);
            float q[DQK], o[32];
#pragma unroll
            for (int d = 0; d < DQK; ++d) q[d] = bf2f(A.Q[row * A.qp + h * DQK + d]);
#pragma unroll
            for (int d = 0; d < 32; ++d) o[d] = 0.f;
            float l = 0.f;
            for (int k = 0; k < S; ++k) {
                const bf16_t* kr = A.K + ((size_t)b * S + k) * A.kp + kvh * DQK; const bf16_t* vr = A.V + ((size_t)b * S + k) * A.vp + kvh * 64 + dh * 32;
                float sc = 0.f;
#pragma unroll
                for (int d = 0; d < DQK; d += 8) { f32x4 k0, k1; unpack8(*(const u32x4*)(kr + d), k0, k1);
                    sc += q[d] * k0[0] + q[d + 1] * k0[1] + q[d + 2] * k0[2] + q[d + 3] * k0[3] + q[d + 4] * k1[0] + q[d + 5] * k1[1] + q[d + 6] * k1[2] + q[d + 7] * k1[3]; }
                const float p = bf2f(cvt_pk_bf16(exp2f(sc), 0.f) & 0xffffu); l += p;
#pragma unroll
                for (int d = 0; d < 32; d += 8) { f32x4 v0, v1; unpack8(*(const u32x4*)(vr + d), v0, v1);
                    o[d] += p * v0[0]; o[d + 1] += p * v0[1]; o[d + 2] += p * v0[2]; o[d + 3] += p * v0[3]; o[d + 4] += p * v1[0]; o[d + 5] += p * v1[1]; o[d + 6] += p * v1[2]; o[d + 7] += p * v1[3]; }
            }
            const float il = 1.f / l;
            __syncthreads();
#pragma unroll
            for (int d = 0; d < 32; d += 8) { f32x4 a = {o[d] * il, o[d + 1] * il, o[d + 2] * il, o[d + 3] * il}, c = {o[d + 4] * il, o[d + 5] * il, o[d + 6] * il, o[d + 7] * il};
                *(u32x4*)(A.O + row * A.op + h * 64 + dh * 32 + d) = pack8(a, c); }
        }
    }
}
#if FAST_ATTN
typedef short s16x4 __attribute__((ext_vector_type(4)));
typedef __bf16 bf16x2_t __attribute__((ext_vector_type(2)));
__device__ __forceinline__ unsigned cvtpk(float lo, float hi) { f32x2 v = {lo, hi}; bf16x2_t b = __builtin_convertvector(v, bf16x2_t); return __builtin_bit_cast(unsigned, b); }
__device__ __forceinline__ s16x4 vtr(const LAS unsigned char* p) { return __builtin_bit_cast(s16x4, __builtin_amdgcn_ds_read_tr16_b64_v4i16((LAS s16x4*)p)); }
__device__ __forceinline__ int crow(int r, int hi) { return (r & 3) + 8 * (r >> 2) + 4 * hi; }
#define AT_BAR() asm volatile("s_barrier" ::: "memory")
#define AT_WAITBAR(N) asm volatile("s_waitcnt vmcnt(" #N ") lgkmcnt(0)\n\ts_barrier" ::: "memory")
#define AT_SCHED() __builtin_amdgcn_sched_barrier(0)
__device__ __forceinline__ void glds16(const void* gsrc, unsigned lds_dst) { unsigned keep;
    asm volatile("s_mov_b32 %0, m0\n\ts_mov_b32 m0, %2\n\ts_nop 0\n\tglobal_load_lds_dwordx4 %1, off\n\ts_mov_b32 m0, %0" : "=&s"(keep) : "v"(gsrc), "s"(lds_dst) : "memory"); }
#define AT_GLDS(g, l) glds16((const void*)(g), (unsigned)__builtin_amdgcn_readfirstlane((int)(unsigned)(uintptr_t)(l)))
template <int DQK>
__device__ __forceinline__ void attn_unit(int tid, LAS unsigned char* lds, const Tensors& A, int b, int h, int qb) {
    constexpr int ND = DQK / 16, NCH = DQK / 8, KSLOT = NCH * 1024, NKD = NCH > 8 ? 2 : 1, VSLOT = 8192, NT = S / 64;
    constexpr int KOFF = 0, VOFF = 3 * KSLOT, OST = VOFF + 3 * VSLOT, WSF = OST + 8 * 4096;
    static_assert(WSF + 8 * 256 <= RING_BYTES, "attention LDS");
    const int lane = tid & 63, r32 = lane & 31, hi = lane >> 5, wid = __builtin_amdgcn_readfirstlane(tid >> 6);
    const int kvh = h / A.group; const size_t rowb = (size_t)b * S;
    const bf16_t* ksrc = A.K + (rowb + lane) * A.kp + kvh * DQK + wid * 8;
    const bf16_t* ksrc2 = A.K + (rowb + lane) * A.kp + kvh * DQK + (8 + (wid & 3)) * 8;
    const bf16_t* vsrc = A.V + (rowb + 16 * (wid & 3) + (lane >> 2)) * A.vp + kvh * 64 + (wid >> 2) * 32 + (lane & 3) * 8;
    const size_t ktile = (size_t)64 * A.kp, vtile = (size_t)64 * A.vp;
    LAS unsigned char* kdst = lds + KOFF + wid * 1024; LAS unsigned char* kdst2 = lds + KOFF + (8 + (wid & 3)) * 1024; LAS unsigned char* vdst = lds + VOFF + wid * 1024;
#define DMA_K(j, so) do { AT_GLDS(ksrc + (size_t)(j) * ktile, kdst + (so)); if (NKD == 2) AT_GLDS(ksrc2 + (size_t)(j) * ktile, kdst2 + (so)); } while (0)
#define DMA_V(j, so) AT_GLDS(vsrc + (size_t)(j) * vtile, vdst + (so))
    const LAS unsigned char* kp0 = lds + KOFF + hi * 1024 + r32 * 16;
    const LAS unsigned char* vp0 = lds + VOFF + ((lane >> 4) & 1) * 32 + (lane & 3) * 8 + (4 * hi + ((lane & 15) >> 2)) * 64;
    DMA_K(0, 0); DMA_V(0, 0); DMA_K(1, KSLOT); DMA_V(1, VSLOT); DMA_K(2, 2 * KSLOT);
    const bf16_t* Qw = A.Q + (rowb + qb * 256 + wid * 32 + r32) * A.qp + h * DQK + hi * 8;
    bf16x8 qr[ND];
#pragma unroll
    for (int d0 = 0; d0 < ND; ++d0) qr[d0] = *(const bf16x8*)(Qw + d0 * 16);
    asm volatile("s_waitcnt vmcnt(0)\n\ts_barrier" ::: "memory");
    bf16x8 kf[2 * ND]; s16x4 vlo[8], vhi[8];
#define KLOAD(so) do { _Pragma("unroll") for (int d0 = 0; d0 < ND; ++d0) { kf[2 * d0] = *(const LAS bf16x8*)(kp0 + (so) + d0 * 2048); kf[2 * d0 + 1] = *(const LAS bf16x8*)(kp0 + (so) + d0 * 2048 + 512); } } while (0)
#define VLOAD(so) do { _Pragma("unroll") for (int i = 0; i < 8; ++i) { vlo[i] = vtr(vp0 + (so) + (i >> 2) * 4096 + (i & 3) * 1024); vhi[i] = vtr(vp0 + (so) + (i >> 2) * 4096 + (i & 3) * 1024 + 512); } } while (0)
#define VFR(i) (bf16x8){vlo[i][0], vlo[i][1], vlo[i][2], vlo[i][3], vhi[i][0], vhi[i][1], vhi[i][2], vhi[i][3]}
    KLOAD(0);
    asm volatile("s_waitcnt lgkmcnt(0)" ::: "memory");
    if (PROBE_ATT != 5 && wid >= 4) AT_BAR();
    f32x16 o0 = {}, o1 = {}, C0, C1; u32x4 pw0, pw1, pw2, pw3; float lsum = 0.f;
    const f32x16 zero = {};
#define QK_BLOCK() do { C0 = __builtin_amdgcn_mfma_f32_32x32x16_bf16(kf[0], qr[0], zero, 0, 0, 0); C1 = __builtin_amdgcn_mfma_f32_32x32x16_bf16(kf[1], qr[0], zero, 0, 0, 0); \
        _Pragma("unroll") for (int d0 = 1; d0 < ND; ++d0) { C0 = __builtin_amdgcn_mfma_f32_32x32x16_bf16(kf[2 * d0], qr[d0], C0, 0, 0, 0); C1 = __builtin_amdgcn_mfma_f32_32x32x16_bf16(kf[2 * d0 + 1], qr[d0], C1, 0, 0, 0); } } while (0)
#define PAF(k) __builtin_bit_cast(bf16x8, pw##k)
#define PV_BLOCK() do { \
        o0 = __builtin_amdgcn_mfma_f32_32x32x16_bf16(PAF(0), VFR(0), o0, 0, 0, 0); o1 = __builtin_amdgcn_mfma_f32_32x32x16_bf16(PAF(0), VFR(4), o1, 0, 0, 0); \
        o0 = __builtin_amdgcn_mfma_f32_32x32x16_bf16(PAF(1), VFR(1), o0, 0, 0, 0); o1 = __builtin_amdgcn_mfma_f32_32x32x16_bf16(PAF(1), VFR(5), o1, 0, 0, 0); \
        o0 = __builtin_amdgcn_mfma_f32_32x32x16_bf16(PAF(2), VFR(2), o0, 0, 0, 0); o1 = __builtin_amdgcn_mfma_f32_32x32x16_bf16(PAF(2), VFR(6), o1, 0, 0, 0); \
        o0 = __builtin_amdgcn_mfma_f32_32x32x16_bf16(PAF(3), VFR(3), o0, 0, 0, 0); o1 = __builtin_amdgcn_mfma_f32_32x32x16_bf16(PAF(3), VFR(7), o1, 0, 0, 0); } while (0)
#define SOFTMAX() do { \
        _Pragma("unroll") for (int r = 0; r < 16; ++r) { C0[r] = __builtin_amdgcn_exp2f(C0[r]); C1[r] = __builtin_amdgcn_exp2f(C1[r]); } \
        float s0_ = 0.f, s1_ = 0.f; _Pragma("unroll") for (int r = 0; r < 16; ++r) { s0_ += C0[r]; s1_ += C1[r]; } lsum += s0_ + s1_; \
        pw0 = (u32x4){cvtpk(C0[0], C0[1]), cvtpk(C0[2], C0[3]), cvtpk(C0[4], C0[5]), cvtpk(C0[6], C0[7])}; pw1 = (u32x4){cvtpk(C0[8], C0[9]), cvtpk(C0[10], C0[11]), cvtpk(C0[12], C0[13]), cvtpk(C0[14], C0[15])}; \
        pw2 = (u32x4){cvtpk(C1[0], C1[1]), cvtpk(C1[2], C1[3]), cvtpk(C1[4], C1[5]), cvtpk(C1[6], C1[7])}; pw3 = (u32x4){cvtpk(C1[8], C1[9]), cvtpk(C1[10], C1[11]), cvtpk(C1[12], C1[13]), cvtpk(C1[14], C1[15])}; } while (0)
    int ka = 2 * KSLOT, kb = 0, kc = KSLOT, va = 2 * VSLOT, vb = 0, vc = VSLOT;
#define ROT() do { const int t_ = ka; ka = kb; kb = kc; kc = t_; const int u_ = va; va = vb; vb = vc; vc = u_; } while (0)
#define PINP() asm volatile("" : "+v"(lsum) : "v"(pw0), "v"(pw1), "v"(pw2), "v"(pw3))
#define STEP(sv, DOQK, DOPV, KL, VL, IK, IV) do { \
        AT_SCHED(); if (DOQK) QK_BLOCK(); if (DOPV) PV_BLOCK(); \
        if (PROBE_ATT == 4) { f32x16 dm_ = zero; _Pragma("unroll") for (int q_ = 0; q_ < 8; ++q_) dm_ = __builtin_amdgcn_mfma_f32_32x32x16_bf16(kf[q_ & 1], qr[0], dm_, 0, 0, 0); asm volatile("" :: "v"(dm_)); } \
        AT_SCHED(); \
          \
        asm volatile("s_barrier\n\ts_nop 15\n\ts_nop 3" : "+v"(C0), "+v"(C1), "+v"(o0), "+v"(o1) :: "memory"); AT_SCHED(); \
        if (KL) KLOAD(kc); if (VL) VLOAD(vb); if (IK) DMA_K((sv) + 4, kb); if (IV) DMA_V((sv) + 3, va); \
        if (PROBE_ATT == 2) { if (IK) DMA_K((sv) + 4, kb); if (IV) DMA_V((sv) + 3, va); } \
        if (PROBE_ATT == 3) { bf16x8 d_[8]; _Pragma("unroll") for (int q_ = 0; q_ < 8; ++q_) { d_[q_] = *(const LAS bf16x8*)(kp0 + kc + (q_ >> 1) * 2048 + (q_ & 1) * 512); } _Pragma("unroll") for (int q_ = 0; q_ < 8; ++q_) asm volatile("" :: "v"(d_[q_])); \
                              s16x4 e_[16]; _Pragma("unroll") for (int q_ = 0; q_ < 16; ++q_) { e_[q_] = vtr(vp0 + vb + (q_ >> 3) * 4096 + ((q_ >> 1) & 3) * 1024 + (q_ & 1) * 512); } _Pragma("unroll") for (int q_ = 0; q_ < 16; ++q_) asm volatile("" :: "v"(e_[q_])); } \
        if (DOQK) { SOFTMAX(); PINP(); } \
        if (PROBE_ATT == 1 && DOQK) { _Pragma("unroll") for (int r = 0; r < 16; ++r) { float x_ = __builtin_amdgcn_exp2f(C0[r]), y_ = __builtin_amdgcn_exp2f(C1[r]); asm volatile("" :: "v"(x_), "v"(y_)); } } \
        AT_SCHED(); \
        if (IK) { if (NKD == 2) { AT_WAITBAR(3); } else { AT_WAITBAR(2); } } else if (IV) { AT_WAITBAR(1); } else { AT_WAITBAR(0); } \
        AT_SCHED(); ROT(); } while (0)
    STEP(-1, true, false, true, true, true, true);
#pragma nounroll
    for (int s = 0; s < NT - 4; ++s) STEP(s, true, true, true, true, true, true);
    STEP(NT - 4, true, true, true, true, false, true);
    STEP(NT - 3, true, true, true, true, false, false);
    STEP(NT - 2, true, true, false, true, false, false);
    STEP(NT - 1, false, true, false, false, false, false);
#undef STEP
#undef PINP
    if (PROBE_ATT != 5 && wid < 4) AT_BAR();
    { auto rr = __builtin_amdgcn_permlane32_swap(__float_as_uint(lsum), __float_as_uint(lsum), false, false); lsum = __uint_as_float(rr[0]) + __uint_as_float(rr[1]); }
    LAS float* wsf = (LAS float*)(lds + WSF + wid * 256);
    if (hi == 0) wsf[r32] = lsum;
    asm volatile("s_waitcnt lgkmcnt(0)" ::: "memory");
    LAS bf16_t* stg = (LAS bf16_t*)(lds + OST + wid * 4096);
#pragma unroll
    for (int r = 0; r < 16; ++r) { const int orow = crow(r, hi); const float rl = __builtin_amdgcn_rcpf(wsf[orow]);
        stg[orow * 64 + r32] = (bf16_t)(cvtpk(o0[r] * rl, 0.f) & 0xffffu); stg[orow * 64 + 32 + r32] = (bf16_t)(cvtpk(o1[r] * rl, 0.f) & 0xffffu); }
    asm volatile("s_waitcnt lgkmcnt(0)" ::: "memory");
    bf16_t* Ow = A.O + (rowb + qb * 256 + wid * 32) * A.op + h * 64;
#pragma unroll
    for (int i = 0; i < 4; ++i) { const int row = i * 8 + (lane >> 3), ch = lane & 7; const u32x4 v = *(const LAS u32x4*)(stg + row * 64 + ch * 8); *(u32x4*)(Ow + (size_t)row * A.op + ch * 8) = v; }
    asm volatile("s_waitcnt lgkmcnt(0)\n\ts_barrier" ::: "memory");
#undef DMA_K
#undef DMA_V
#undef KLOAD
#undef VLOAD
#undef VFR
#undef QK_BLOCK
#undef PAF
#undef PV_BLOCK
#undef SOFTMAX
#undef ROT
}
#endif
template <int DQK>
__device__ __forceinline__ void attn_phase(int tid, LAS unsigned char* lds, const Tensors& A, int vcu, int G) {
#if FAST_ATTN
    int bh, qb;
    for (int i = 0; next_unit(i, vcu, G, bh, qb); ++i) attn_unit<DQK>(tid, lds, A, bh >> 3, bh & 7, qb);
#else
    (void)lds; attn_phase_ref<DQK>(tid, A, vcu, G);
#endif
}
}


struct Args { const float* in[22]; float* out; unsigned char* ws; int ph_lo, ph_hi; };
struct Frame {
    LAS unsigned char* lds; volatile LAS unsigned* MISC; unsigned* ctl;
    int tid, lane, wave, vcu, G;
    unsigned char* ws; float* X;
};

__device__ __forceinline__ void p0_phase(Frame& F, const float* c, const float* w_ada, const float* b_ada) {
    LAS float* cs = (LAS float*)F.lds;
    LAS float* red = (LAS float*)(F.lds + 32768);
    for (int i = F.tid; i < NB * D; i += NTHREADS) { const float v = c[i]; cs[i] = v / (1.f + __expf(-v)); }
    __syncthreads();
    float* mod = (float*)(F.ws + WS_MOD);
    const int kq = F.wave, col = F.lane;
    for (int item = F.vcu; item < NL * 6 * D / 64; item += F.G) {
        const int l = item / (6 * D / 64), n0 = (item % (6 * D / 64)) * 64;
        const float* w = w_ada + (size_t)l * D * 6 * D + n0 + col;
        float acc[NB];
#pragma unroll
        for (int b = 0; b < NB; ++b) acc[b] = 0.f;
#pragma unroll 8
        for (int k = kq * 128; k < kq * 128 + 128; ++k) { const float wv = w[(size_t)k * 6 * D];
#pragma unroll
            for (int b = 0; b < NB; ++b) acc[b] += cs[b * D + k] * wv; }
#pragma unroll
        for (int b = 0; b < NB; ++b) red[(kq * NB + b) * 64 + col] = acc[b];
        __syncthreads();
        { const int b = F.wave; float s = 0.f;
#pragma unroll
          for (int q = 0; q < 8; ++q) s += red[(q * NB + b) * 64 + col];
          mod[((size_t)l * NB + b) * 6 * D + n0 + col] = s + b_ada[(size_t)l * 6 * D + n0 + col]; }
        __syncthreads();
    }
    float* cosA = (float*)(F.ws + WS_COSA); float* sinA = (float*)(F.ws + WS_SINA); float* cosB = (float*)(F.ws + WS_COSB); float* sinB = (float*)(F.ws + WS_SINB);
    for (int idx = F.vcu * NTHREADS + F.tid; idx < S * 48; idx += F.G * NTHREADS) {
        const int s = idx / 48, i = idx % 48; const float row = (float)(s >> 6), col2 = (float)(s & 63);
        if (i < 32) { const int j = i & 15; const float a = (i < 16 ? row : col2) * (1.0f / powf(10000.0f, (float)j / 16.0f)); cosA[s * 32 + i] = cosf(a); sinA[s * 32 + i] = sinf(a); }
        else { const int ii = i - 32, j = ii & 7; const float a = (ii < 8 ? row : col2) * (1.0f / powf(10000.0f, (float)j / 8.0f)); cosB[s * 16 + ii] = cosf(a); sinB[s * 16 + ii] = sinf(a); }
    }
}

template <class SrcFn>
__device__ __forceinline__ void cvt_item(const float* W, int K, int Nsrc, const float* kg, bf16_t* WT, LAS float* scr, int item, int nblk, int lane, const SrcFn& src) {
    const int kb = item / nblk, nb = item % nblk, k0 = 64 * kb, n0 = 32 * nb;
    const int sc = src(n0 + (lane & 31));
#pragma unroll
    for (int i = 0; i < 32; ++i) { const int kk = 2 * i + (lane >> 5); float v = sc >= 0 ? W[(size_t)(k0 + kk) * Nsrc + sc] : 0.f; if (kg) v *= kg[k0 + kk]; scr[kk * 33 + (lane & 31)] = v; }
    LDS_WAIT(); asm volatile("" ::: "memory");
    const int c = lane & 7;
#pragma unroll
    for (int j = 0; j < 4; ++j) { const int n = (lane >> 3) + 8 * j; const LAS float* s = scr + (8 * c) * 33 + n;
        u32x4 o; o.x = cvt_pk_bf16(s[0 * 33], s[1 * 33]); o.y = cvt_pk_bf16(s[2 * 33], s[3 * 33]); o.z = cvt_pk_bf16(s[4 * 33], s[5 * 33]); o.w = cvt_pk_bf16(s[6 * 33], s[7 * 33]);
        *(u32x4*)(WT + (size_t)(n0 + n) * K + k0 + 8 * c) = o; }
    LDS_WAIT(); asm volatile("" ::: "memory");
}
struct SrcId { __device__ int operator()(int n) const { return n; } };
struct SrcIn { __device__ int operator()(int n) const { return gp::src_col_in(n); } };
typedef __attribute__((address_space(4))) const Args CArgsW;
__device__ __forceinline__ void convert_weights(Frame& F, CArgsW* a, int l) {
    LAS float* scr = (LAS float*)(F.lds + F.wave * 16384);
    const int gw = F.vcu * NWAVES + F.wave, NGW = F.G * NWAVES;
    const float* w_in = ((const float*)(GAS const float*)a->in[5]) + (size_t)l * D * INC; const float* w_q_b = ((const float*)(GAS const float*)a->in[10]) + (size_t)l * 384 * 768; const float* w_kv_b = ((const float*)(GAS const float*)a->in[11]) + (size_t)l * 256 * 1024;
    const float* w_pa = ((const float*)(GAS const float*)a->in[12]) + (size_t)l * 512 * D; const float* w_pb = ((const float*)(GAS const float*)a->in[13]) + (size_t)l * 512 * D; const float* w_o = ((const float*)(GAS const float*)a->in[14]) + (size_t)l * D * D;
    const float* w1 = ((const float*)(GAS const float*)a->in[18]) + (size_t)l * NE * D * FF; const float* w3 = ((const float*)(GAS const float*)a->in[19]) + (size_t)l * NE * D * FF; const float* w2 = ((const float*)(GAS const float*)a->in[20]) + (size_t)l * NE * FF * D;
    const float* gqa = ((const float*)(GAS const float*)a->in[8]) + l * 384; const float* gkv = ((const float*)(GAS const float*)a->in[9]) + l * 256;
    bf16_t* Win = (bf16_t*)(F.ws + WS_WIN); bf16_t* Wqb = (bf16_t*)(F.ws + WS_WQB); bf16_t* Wkvb = (bf16_t*)(F.ws + WS_WKVB); bf16_t* Wpa = (bf16_t*)(F.ws + WS_WPA); bf16_t* Wpb = (bf16_t*)(F.ws + WS_WPB);
    bf16_t* Wo = (bf16_t*)(F.ws + WS_WO); bf16_t* W13 = (bf16_t*)(F.ws + WS_W13); bf16_t* W2 = (bf16_t*)(F.ws + WS_W2);
    constexpr int I_IN = (D / 64) * (NIN / 32), I_QB = (384 / 64) * (768 / 32), I_KVB = (256 / 64) * (1024 / 32), I_P = (512 / 64) * (D / 32), I_O = (D / 64) * (D / 32);
    constexpr int I_13 = (D / 64) * (1024 / 32), I_2 = (FF / 64) * (D / 32);
    constexpr int NITEMS = I_IN + I_QB + I_KVB + 2 * I_P + I_O + NE * (I_13 + I_2);
    for (int it = gw; it < NITEMS; it += NGW) {
        int r = it;
        if (r < I_IN) { cvt_item(w_in, D, INC, nullptr, Win, scr, r, NIN / 32, F.lane, SrcIn()); continue; } r -= I_IN;
        if (r < I_QB) { cvt_item(w_q_b, 384, 768, gqa, Wqb, scr, r, 768 / 32, F.lane, SrcId()); continue; } r -= I_QB;
        if (r < I_KVB) { cvt_item(w_kv_b, 256, 1024, gkv, Wkvb, scr, r, 1024 / 32, F.lane, SrcId()); continue; } r -= I_KVB;
        if (r < I_P) { cvt_item(w_pa, 512, D, nullptr, Wpa, scr, r, D / 32, F.lane, SrcId()); continue; } r -= I_P;
        if (r < I_P) { cvt_item(w_pb, 512, D, nullptr, Wpb, scr, r, D / 32, F.lane, SrcId()); continue; } r -= I_P;
        if (r < I_O) { cvt_item(w_o, D, D, nullptr, Wo, scr, r, D / 32, F.lane, SrcId()); continue; } r -= I_O;
        if (r < NE * I_13) { const int e = r / I_13, q = r % I_13, nb = q % 32;
            const float* src = ((nb & 7) < 4 ? w1 : w3) + (size_t)e * D * FF; const int cb = (nb >> 3) * 128 + (nb & 3) * 32;
            struct SrcOff { int n0, cb; __device__ int operator()(int n) const { return cb + (n - n0); } } so{nb * 32, cb};
            cvt_item(src, D, FF, nullptr, W13 + (size_t)e * 1024 * D, scr, q, 32, F.lane, so); continue; } r -= NE * I_13;
        { const int e = r / I_2, q = r % I_2; cvt_item(w2 + (size_t)e * FF * D, FF, D, nullptr, W2 + (size_t)e * D * FF, scr, q, D / 32, F.lane, SrcId()); }
    }
}

template <int MODE>
__device__ __forceinline__ void row_phase(Frame& F, const float* xin, const float* g2prev, const float* gain, const float* modl, int sh_off, int sc_off, bf16_t* H, float* Xout) {
    constexpr int RB = 4;
    const int gw = F.vcu * NWAVES + F.wave, NGW = F.G * NWAVES;
    const bf16_t* Y2 = (const bf16_t*)(F.ws + WS_Y2);
    for (int m0 = gw; m0 < T; m0 += RB * NGW) {
        f32x4 v[RB][4]; float ss[RB];
        if (MODE == 0) {
#pragma unroll
            for (int r = 0; r < RB; ++r)
#pragma unroll
                for (int j = 0; j < 4; ++j) v[r][j] = *(const f32x4*)(xin + (size_t)(m0 + r * NGW) * D + 4 * F.lane + 256 * j);
        } else {
            u32x2 ya[RB][4], yb[RB][4]; f32x4 g[RB][4];
#pragma unroll
            for (int r = 0; r < RB; ++r)
#pragma unroll
                for (int j = 0; j < 4; ++j) { const int m = m0 + r * NGW, c = 4 * F.lane + 256 * j;
                    v[r][j] = *(const f32x4*)(F.X + (size_t)m * D + c); ya[r][j] = *(const u32x2*)(Y2 + (size_t)(2 * m) * D + c); yb[r][j] = *(const u32x2*)(Y2 + (size_t)(2 * m + 1) * D + c);
                    g[r][j] = *(const f32x4*)(g2prev + (size_t)(m >> 12) * 6 * D + 5 * D + c); }
#pragma unroll
            for (int r = 0; r < RB; ++r)
#pragma unroll
                for (int j = 0; j < 4; ++j) { f32x4 y; y[0] = bf2f(ya[r][j].x & 0xffffu) + bf2f(yb[r][j].x & 0xffffu); y[1] = bf2f(ya[r][j].x >> 16) + bf2f(yb[r][j].x >> 16); y[2] = bf2f(ya[r][j].y & 0xffffu) + bf2f(yb[r][j].y & 0xffffu); y[3] = bf2f(ya[r][j].y >> 16) + bf2f(yb[r][j].y >> 16);
                    v[r][j] += g[r][j] * y; }
        }
#pragma unroll
        for (int r = 0; r < RB; ++r) { ss[r] = (gp::dot4(v[r][0]) + gp::dot4(v[r][1])) + (gp::dot4(v[r][2]) + gp::dot4(v[r][3])); }
#pragma unroll
        for (int o = 1; o < 64; o <<= 1)
#pragma unroll
            for (int r = 0; r < RB; ++r) ss[r] += __shfl_xor(ss[r], o);
#pragma unroll
        for (int r = 0; r < RB; ++r) {
            const int m = m0 + r * NGW, b = m >> 12; const float rstd = rsqrtf(ss[r] * (1.f / D) + EPS);
#pragma unroll
            for (int j = 0; j < 4; ++j) {
                const int c = 4 * F.lane + 256 * j; const f32x4 gn = *(const f32x4*)(gain + c);
                if (MODE == 2) { *(f32x4*)(Xout + (size_t)m * D + c) = v[r][j] * rstd * gn; }
                else {
                    *(f32x4*)(Xout + (size_t)m * D + c) = v[r][j];
                    const f32x4 sc = *(const f32x4*)(modl + (size_t)b * 6 * D + sc_off + c), sh = *(const f32x4*)(modl + (size_t)b * 6 * D + sh_off + c);
                    const f32x4 hv = v[r][j] * rstd * gn * (1.f + sc) + sh;
                    u32x2 w; w.x = cvt_pk_bf16(hv[0], hv[1]); w.y = cvt_pk_bf16(hv[2], hv[3]);
                    *(u32x2*)(H + (size_t)m * D + c) = w;
                }
            }
        }
    }
}

__device__ __forceinline__ void t2_phase(Frame& F, const float* gain, const float* modl, const float* w_router, const float* rbias, int l, bool record) {
    LAS f32x4* wl = (LAS f32x4*)F.lds;
    LAS int* rec = (LAS int*)(F.lds + 65536);
    LAS float* recw = (LAS float*)(F.lds + 65536 + 2048);
    LAS int* lcnt = (LAS int*)(F.lds + 65536 + 4096);
    for (int idx = F.tid; idx < 4096; idx += NTHREADS) {
        const int lane = idx & 63, c = (idx >> 6) & 3, i = (idx >> 8) & 3, j = idx >> 10; const int k = 4 * lane + 256 * j + i;
        wl[idx] = *(const f32x4*)(w_router + (size_t)k * NE + 4 * c);
    }
    if (F.tid < 32) lcnt[F.tid] = 0;
    __syncthreads();
    constexpr int RB = 4;
    const int gw = F.vcu * NWAVES + F.wave, NGW = F.G * NWAVES;
    bf16_t* H = (bf16_t*)(F.ws + WS_H);
    const int lane = F.lane, myrow = lane >> 4, mye = lane & 15;
    int it = 0;
    for (int m0 = gw; m0 < T; m0 += RB * NGW, ++it) {
        f32x4 v[RB][4]; float ss[RB];
#pragma unroll
        for (int r = 0; r < RB; ++r)
#pragma unroll
            for (int j = 0; j < 4; ++j) v[r][j] = *(const f32x4*)(F.X + (size_t)(m0 + r * NGW) * D + 4 * lane + 256 * j);
#pragma unroll
        for (int r = 0; r < RB; ++r) ss[r] = (gp::dot4(v[r][0]) + gp::dot4(v[r][1])) + (gp::dot4(v[r][2]) + gp::dot4(v[r][3]));
#pragma unroll
        for (int o = 1; o < 64; o <<= 1)
#pragma unroll
            for (int r = 0; r < RB; ++r) ss[r] += __shfl_xor(ss[r], o);
        float acc[RB * NE];
#pragma unroll
        for (int q = 0; q < RB * NE; ++q) acc[q] = 0.f;
#pragma unroll
        for (int j = 0; j < 4; ++j) {
            const int c = 4 * lane + 256 * j; const f32x4 gn = *(const f32x4*)(gain + c);
#pragma unroll
            for (int r = 0; r < RB; ++r) {
                const int m = m0 + r * NGW, b = m >> 12; const float rstd = rsqrtf(ss[r] * (1.f / D) + EPS);
                const f32x4 sc = *(const f32x4*)(modl + (size_t)b * 6 * D + 4 * D + c), sh = *(const f32x4*)(modl + (size_t)b * 6 * D + 3 * D + c);
                v[r][j] = v[r][j] * rstd * gn * (1.f + sc) + sh;
                u32x2 w; w.x = cvt_pk_bf16(v[r][j][0], v[r][j][1]); w.y = cvt_pk_bf16(v[r][j][2], v[r][j][3]);
                *(u32x2*)(H + (size_t)m * D + c) = w;
            }
#pragma unroll
            for (int i = 0; i < 4; ++i)
#pragma unroll
                for (int c4 = 0; c4 < 4; ++c4) { const f32x4 wv = wl[((j * 4 + i) * 4 + c4) * 64 + lane];
#pragma unroll
                    for (int r = 0; r < RB; ++r) { const float hv = v[r][j][i];
                        acc[r * NE + 4 * c4 + 0] += hv * wv[0]; acc[r * NE + 4 * c4 + 1] += hv * wv[1]; acc[r * NE + 4 * c4 + 2] += hv * wv[2]; acc[r * NE + 4 * c4 + 3] += hv * wv[3]; } }
        }
#pragma unroll
        for (int sft = 32; sft >= 1; sft >>= 1) {
            const bool up = (lane & sft) != 0;
#pragma unroll
            for (int k = 0; k < sft; ++k) { const float a = acc[k], b = acc[k + sft]; const float keep = up ? b : a, send = up ? a : b; acc[k] = keep + __shfl_xor(send, sft); }
        }
        const float logit = acc[0];
        const float score = 1.f / (1.f + expf(-logit));
        float scv[NE], bi[NE];
#pragma unroll
        for (int e = 0; e < NE; ++e) { scv[e] = __shfl(score, (lane & 48) | e); bi[e] = scv[e] + rbias[e]; }
        int gsel = 0; float gbest = -INFINITY;
#pragma unroll
        for (int g = 0; g < 4; ++g) { float m1 = -INFINITY, m2 = -INFINITY;
#pragma unroll
            for (int j = 0; j < 4; ++j) { const float x = bi[g * 4 + j]; if (x > m1) { m2 = m1; m1 = x; } else if (x > m2) m2 = x; }
            const float gs = m1 + m2; if (gs > gbest) { gbest = gs; gsel = g; } }
        int e1 = -1, e2 = -1; float b1 = -INFINITY, b2 = -INFINITY, s1 = 0.f, s2 = 0.f;
#pragma unroll
        for (int j = 0; j < 4; ++j) { float x = -INFINITY, sx = 0.f;
#pragma unroll
            for (int g = 0; g < 4; ++g) if (g == gsel) { x = bi[g * 4 + j]; sx = scv[g * 4 + j]; }
            const int e = gsel * 4 + j;
            if (x > b1) { b2 = b1; e2 = e1; s2 = s1; b1 = x; e1 = e; s1 = sx; } else if (x > b2) { b2 = x; e2 = e; s2 = sx; } }
        if (mye == 0) {
            const float inv = 1.f / (s1 + s2); const int slot = (it * RB + myrow) * NWAVES + F.wave;
            rec[slot * 4 + 0] = e1; rec[slot * 4 + 1] = e2;
            rec[slot * 4 + 2] = __hip_atomic_fetch_add(&lcnt[e1], 1, __ATOMIC_RELAXED, __HIP_MEMORY_SCOPE_WORKGROUP);
            rec[slot * 4 + 3] = __hip_atomic_fetch_add(&lcnt[e2], 1, __ATOMIC_RELAXED, __HIP_MEMORY_SCOPE_WORKGROUP);
            recw[slot * 2 + 0] = s1 * inv; recw[slot * 2 + 1] = s2 * inv;
        }
    }
    __syncthreads();
    if (!record) return;
    if (F.tid < NE) lcnt[16 + F.tid] = (int)__hip_atomic_fetch_add(F.ctl + CW_CNT + (l * NE + F.tid) * 64, (unsigned)lcnt[F.tid], __ATOMIC_RELAXED, __HIP_MEMORY_SCOPE_AGENT);
    __syncthreads();
    unsigned* list = (unsigned*)(F.ws + WS_LIST); float* gwb = (float*)(F.ws + WS_GW);
    const int nrows = it * RB;
    for (int s = F.tid; s < nrows * NWAVES; s += NTHREADS) {
        const int i2 = s / NWAVES, w = s % NWAVES; const int m = F.vcu * NWAVES + w + i2 * NGW;
        const int e1 = rec[s * 4 + 0], e2 = rec[s * 4 + 1];
        list[(size_t)e1 * T + lcnt[16 + e1] + rec[s * 4 + 2]] = (unsigned)(2 * m); list[(size_t)e2 * T + lcnt[16 + e2] + rec[s * 4 + 3]] = (unsigned)(2 * m + 1);
        gwb[2 * m] = recw[s * 2]; gwb[2 * m + 1] = recw[s * 2 + 1];
    }
}
__device__ __forceinline__ const LAS int* moe_table(Frame& F, int l) {
    LAS int* tab = (LAS int*)(F.lds + MISC_OFF + 1024);
    __syncthreads();
    if (F.tid == 0) { int acc = 0;
        for (int e = 0; e < NE; ++e) { const int c = (int)__hip_atomic_load(F.ctl + CW_CNT + (l * NE + e) * 64, __ATOMIC_RELAXED, __HIP_MEMORY_SCOPE_AGENT); tab[e] = acc; tab[32 + e] = c; acc += (c + 255) >> 8; }
        tab[16] = acc; }
    __syncthreads();
    return tab;
}

typedef __attribute__((address_space(4))) const Args CArgs;
#define LAUNDER_GP(T_, p) do { GAS T_* _t = (GAS T_*)(p); asm volatile("" : "+s"(_t)); (p) = (T_*)_t; } while (0)
#define PH_BEGIN() LAUNDER_V(F.tid); F.lane = F.tid & 63; LAUNDER_GP(unsigned, F.ctl); LAUNDER_GP(float, F.X); LAUNDER_GP(unsigned char, F.ws); GAS unsigned char* ws = (GAS unsigned char*)F.ws; CArgs* ka = (CArgs*)__builtin_amdgcn_kernarg_segment_ptr(); LAUNDER_S(ka); \
    float* mod = WSP(float, WS_MOD); (void)mod; (void)ka
#define WSP(T_, off) ((T_*)(GAS T_*)(ws + (off)))
#define KIN(i) ((const float*)(GAS const float*)ka->in[i])
__global__ void __launch_bounds__(NTHREADS, 2) fwd_kernel(Args args) {
    extern __shared__ __attribute__((aligned(16))) unsigned char lds_raw[];
    Frame F;
    F.lds = (LAS unsigned char*)lds_raw; F.MISC = (volatile LAS unsigned*)(F.lds + MISC_OFF);
    F.tid = threadIdx.x; F.lane = F.tid & 63; F.wave = __builtin_amdgcn_readfirstlane(F.tid >> 6);
    F.G = gridDim.x; { const int bx = blockIdx.x; F.vcu = (F.G % 8 == 0) ? (bx % 8) * (F.G / 8) + bx / 8 : bx; }
    F.ws = (unsigned char*)(GAS unsigned char*)args.ws; F.ctl = (unsigned*)(GAS unsigned*)(args.ws + WS_CTL); F.X = (float*)(GAS float*)args.out;
    if (F.tid < 64) F.MISC[F.tid] = 0u;
    __syncthreads();
    XcdBarrier bar; bar.bar = F.ctl + CW_BAR; bar.x = 0; bar.st = nullptr;
    if (!N_LAUNCH_MODE) bar = xcd_barrier_post(F.ctl + CW_BAR, F.MISC + 8);
    const int lo = args.ph_lo, hi = args.ph_hi;
#define IN(k) (lo <= (k) && (k) < hi)
#define SEAM(k) do { if ((k) + 1 < hi) { if (!N_LAUNCH_MODE) xcd_barrier(bar); } } while (0)
    const int cidx = (int)blockIdx.x;

    if (IN(0)) { PH_BEGIN(); p0_phase(F, KIN(1), KIN(2), KIN(3)); SEAM(0); }
    for (int l = 0; l < NL; ++l) {
        const int pb = 1 + 9 * l;
        if (IN(pb + 0)) {
            PH_BEGIN();
            for (int rep = 0; rep < ((PROBE_DUP & 8) ? 2 : 1); ++rep) { LAUNDER_V(F.tid); F.lane = F.tid & 63; convert_weights(F, ka, l); }
            if (l == 0) row_phase<0>(F, KIN(0), nullptr, KIN(4) + l * D, mod + (size_t)l * NB * 6 * D, 0, D, WSP(bf16_t, WS_H), F.X);
            else row_phase<1>(F, nullptr, mod + (size_t)(l - 1) * NB * 6 * D, KIN(4) + l * D, mod + (size_t)l * NB * 6 * D, 0, D, WSP(bf16_t, WS_H), F.X);
            SEAM(pb + 0);
        }
        if (IN(pb + 1)) {
            PH_BEGIN();
            gp::Gemm g{WSP(bf16_t, WS_H), WSP(const bf16_t, WS_WIN), D, 0, nullptr}; gp::DenseOrder So; So.init(T, NIN, F.G, cidx);
            gp::EpiIn E{WSP(bf16_t, WS_QA), WSP(bf16_t, WS_KA), WSP(bf16_t, WS_VA), WSP(bf16_t, WS_QLAT), WSP(bf16_t, WS_KVLAT), WSP(bf16_t, WS_KB), WSP(bf16_t, WS_SA), WSP(bf16_t, WS_SB), WSP(float, WS_SSQ), WSP(float, WS_SSKV),
                        KIN(6) + l * 64, KIN(7) + l * 64, WSP(const float, WS_COSA), WSP(const float, WS_SINA), WSP(const float, WS_COSB), WSP(const float, WS_SINB)};
            gp::gemm_phase<gp::EpiIn, gp::DenseOrder>(F.tid, F.lds, g, So, E); if (PROBE_DUP & 2) { LAUNDER_V(F.tid); gp::gemm_phase<gp::EpiIn, gp::DenseOrder>(F.tid, F.lds, g, So, E); }
            SEAM(pb + 1);
        }
        if (IN(pb + 2)) {
            { PH_BEGIN(); gp::Gemm g{WSP(bf16_t, WS_QLAT), WSP(const bf16_t, WS_WQB), 384, 0, nullptr}; gp::DenseOrder So; So.init(T, 768, F.G, cidx);
              gp::EpiQb E{WSP(bf16_t, WS_QB), WSP(const float, WS_SSQ), WSP(const float, WS_COSB), WSP(const float, WS_SINB)}; gp::gemm_phase<gp::EpiQb, gp::DenseOrder>(F.tid, F.lds, g, So, E); if (PROBE_DUP & 2) { LAUNDER_V(F.tid); gp::gemm_phase<gp::EpiQb, gp::DenseOrder>(F.tid, F.lds, g, So, E); } }
            { PH_BEGIN(); gp::Gemm g{WSP(bf16_t, WS_KVLAT), WSP(const bf16_t, WS_WKVB), 256, 0, nullptr}; gp::DenseOrder So; So.init(T, 1024, F.G, F.G - 1 - cidx);
              gp::EpiKvb E{WSP(bf16_t, WS_KB), WSP(bf16_t, WS_VB), WSP(const float, WS_SSKV)}; gp::gemm_phase<gp::EpiKvb, gp::DenseOrder>(F.tid, F.lds, g, So, E); if (PROBE_DUP & 2) { LAUNDER_V(F.tid); gp::gemm_phase<gp::EpiKvb, gp::DenseOrder>(F.tid, F.lds, g, So, E); } }
            if (PROBE_DUP & 1) { PH_BEGIN(); const at::Tensors A{WSP(bf16_t, WS_QA), 512, WSP(bf16_t, WS_KA), 128, WSP(bf16_t, WS_VA), 128, WSP(bf16_t, WS_OB), 512, 4}; at::attn_phase<64>(F.tid, F.lds, A, F.vcu, F.G); }
            { PH_BEGIN(); const at::Tensors A{WSP(bf16_t, WS_QA), 512, WSP(bf16_t, WS_KA), 128, WSP(bf16_t, WS_VA), 128, WSP(bf16_t, WS_QA), 512, 4}; at::attn_phase<64>(F.tid, F.lds, A, F.vcu, F.G); }
            SEAM(pb + 2);
        }
        if (IN(pb + 3)) {
            PH_BEGIN();
            const at::Tensors A{WSP(bf16_t, WS_QB), 768, WSP(bf16_t, WS_KB), 768, WSP(bf16_t, WS_VB), 512, WSP(bf16_t, WS_OB), 512, 1}; for (int rep = 0; rep < ((PROBE_DUP & 1) ? 2 : 1); ++rep) at::attn_phase<96>(F.tid, F.lds, A, F.vcu, F.G);
            SEAM(pb + 3);
        }
        if (IN(pb + 4)) for (int rep3 = 0; rep3 < ((PROBE_DUP & 2) ? 2 : 1); ++rep3) {
            { PH_BEGIN(); gp::Gemm g{WSP(bf16_t, WS_QA), WSP(const bf16_t, WS_WPA), 512, 0, nullptr}; gp::DenseOrder So; So.init(T, D, F.G, cidx);
              gp::EpiProj<0> E{WSP(bf16_t, WS_H), WSP(const bf16_t, WS_SA)}; gp::gemm_phase<gp::EpiProj<0>, gp::DenseOrder>(F.tid, F.lds, g, So, E); }
            { PH_BEGIN(); gp::Gemm g{WSP(bf16_t, WS_OB), WSP(const bf16_t, WS_WPB), 512, 0, nullptr}; gp::DenseOrder So; So.init(T, D, F.G, cidx);
              gp::EpiProj<1> E{WSP(bf16_t, WS_H), WSP(const bf16_t, WS_SB)}; gp::gemm_phase<gp::EpiProj<1>, gp::DenseOrder>(F.tid, F.lds, g, So, E); }
            if (rep3 + 1 == ((PROBE_DUP & 2) ? 2 : 1)) SEAM(pb + 4);
        }
        if (IN(pb + 5)) {
            PH_BEGIN();
            gp::Gemm g{WSP(bf16_t, WS_H), WSP(const bf16_t, WS_WO), D, 0, nullptr}; gp::DenseOrder So; So.init(T, D, F.G, cidx);
            if (PROBE_DUP & 32) { gp::EpiWo E2{F.X, mod + (size_t)l * NB * 6 * D, WSP(float, WS_KB)}; gp::gemm_phase<gp::EpiWo, gp::DenseOrder>(F.tid, F.lds, g, So, E2); LAUNDER_V(F.tid); }
            gp::EpiWo E{F.X, mod + (size_t)l * NB * 6 * D, F.X}; gp::gemm_phase<gp::EpiWo, gp::DenseOrder>(F.tid, F.lds, g, So, E);
            SEAM(pb + 5);
        }
        if (IN(pb + 6)) {
            PH_BEGIN();
            if (PROBE_DUP & 16) { t2_phase(F, KIN(15) + l * D, mod + (size_t)l * NB * 6 * D, KIN(16), KIN(17), l, false); LAUNDER_V(F.tid); F.lane = F.tid & 63; __syncthreads(); }
            t2_phase(F, KIN(15) + l * D, mod + (size_t)l * NB * 6 * D, KIN(16), KIN(17), l, true);
            SEAM(pb + 6);
        }
        if (IN(pb + 7)) {
            PH_BEGIN();
            const LAS int* tab = moe_table(F, l);
            gp::Gemm g{WSP(bf16_t, WS_H), WSP(const bf16_t, WS_W13), D, (size_t)1024 * D, WSP(const unsigned, WS_LIST)}; gp::MoeOrder So; So.init(tab, F.G, cidx);
            gp::EpiUp E{WSP(bf16_t, WS_ACT)}; gp::gemm_phase<gp::EpiUp, gp::MoeOrder, true>(F.tid, F.lds, g, So, E); if (PROBE_DUP & 4) { LAUNDER_V(F.tid); gp::gemm_phase<gp::EpiUp, gp::MoeOrder, true>(F.tid, F.lds, g, So, E); }
            SEAM(pb + 7);
        }
        if (IN(pb + 8)) {
            PH_BEGIN();
            const LAS int* tab = moe_table(F, l);
            gp::Gemm g{WSP(bf16_t, WS_ACT), WSP(const bf16_t, WS_W2), FF, (size_t)D * FF, nullptr}; gp::MoeOrder So; So.init(tab, F.G, cidx);
            gp::EpiDown E{WSP(bf16_t, WS_Y2), WSP(const unsigned, WS_LIST), WSP(const float, WS_GW)}; gp::gemm_phase<gp::EpiDown, gp::MoeOrder, false>(F.tid, F.lds, g, So, E); if (PROBE_DUP & 4) { LAUNDER_V(F.tid); gp::gemm_phase<gp::EpiDown, gp::MoeOrder, false>(F.tid, F.lds, g, So, E); }
            SEAM(pb + 8);
        }
    }
    if (IN(NPHASE - 1)) { PH_BEGIN(); row_phase<2>(F, nullptr, mod + (size_t)(NL - 1) * NB * 6 * D, KIN(21), nullptr, 0, 0, nullptr, F.X); }
#undef IN
#undef SEAM
}

extern "C" void kernel_launch(void* const* d_in, const int* in_sizes, int n_in, void* d_out, int out_size, void* d_ws, size_t ws_size, hipStream_t stream) {
    static int grid = 0;
    if (grid == 0) {
        if (n_in != 22 || out_size != T * D || ws_size < WS_END) { fprintf(stderr, "kernel_launch: unexpected problem (n_in %d out %d ws %zu)\n", n_in, out_size, ws_size); grid = -1; return; }
        int dev = 0, cus = 0, per_cu = 0;
        if (hipGetDevice(&dev) != hipSuccess || hipDeviceGetAttribute(&cus, hipDeviceAttributeMultiprocessorCount, dev) != hipSuccess) { grid = -1; return; }
        if (hipFuncSetAttribute((const void*)fwd_kernel, hipFuncAttributeMaxDynamicSharedMemorySize, LDS_BYTES) != hipSuccess) { grid = -1; return; }
        if (hipOccupancyMaxActiveBlocksPerMultiprocessor(&per_cu, (const void*)fwd_kernel, NTHREADS, LDS_BYTES) != hipSuccess || per_cu < 1) { fprintf(stderr, "kernel_launch: occupancy query says %d\n", per_cu); }
        (void)hipGetLastError();
        grid = cus;
        if (T % (grid * NWAVES * 4) != 0) { fprintf(stderr, "kernel_launch: grid %d does not divide the row phases\n", grid); grid = -1; return; }
    }
    if (grid < 0) return;
    (void)hipMemsetAsync((char*)d_ws + WS_CTL, 0, CTL_BYTES, stream);
    Args a{};
    for (int i = 0; i < 22; ++i) a.in[i] = (const float*)d_in[i];
    a.out = (float*)d_out; a.ws = (unsigned char*)d_ws;
#if N_LAUNCH_MODE
    for (int p = 0; p < NPHASE; ++p) { a.ph_lo = p; a.ph_hi = p + 1; hipLaunchKernelGGL(fwd_kernel, dim3(grid), dim3(NTHREADS), LDS_BYTES, stream, a); }
#else
    a.ph_lo = 0; a.ph_hi = NPHASE;
    hipLaunchKernelGGL(fwd_kernel, dim3(grid), dim3(NTHREADS), LDS_BYTES, stream, a);
#endif
}
```

```cpp
#include <hip/hip_runtime.h>
#include <stdint.h>
#include <stdio.h>
#include <math.h>

#ifndef FAST_GEMM
#define FAST_GEMM 1
#endif
#ifndef FAST_ATTN
#define FAST_ATTN 1
#endif
#ifndef PROBE_DUP
#define PROBE_DUP 0
#endif
#ifndef PROBE_ATT
#define PROBE_ATT 0
#endif
#ifndef N_LAUNCH_MODE
#define N_LAUNCH_MODE 0
#endif

#define LAS __attribute__((address_space(3)))
#define GAS __attribute__((address_space(1)))
typedef unsigned short bf16_t;
typedef short bf16x8 __attribute__((ext_vector_type(8)));
typedef float f32x4 __attribute__((ext_vector_type(4)));
typedef float f32x2 __attribute__((ext_vector_type(2)));
typedef float f32x16 __attribute__((ext_vector_type(16)));
typedef unsigned u32x4 __attribute__((ext_vector_type(4)));
typedef unsigned u32x2 __attribute__((ext_vector_type(2)));
typedef GAS unsigned gu32;

constexpr int D = 1024, NB = 8, S = 4096, T = NB * S, NL = 4, INC = 3488, NIN = 3584, NE = 16, FF = 512;
constexpr float EPS = 1e-6f, LOG2E = 1.4426950408889634f;
constexpr float QSCALE_A = 0.125f * LOG2E, QSCALE_B = 0.10206207261596577f * LOG2E;
constexpr int NWAVES = 8, NTHREADS = 512;
constexpr int NPHASE = 2 + 9 * NL;

constexpr size_t MiB = 1u << 20;
constexpr size_t WS_CTL = 0, CTL_BYTES = 1 * MiB;
constexpr size_t WS_MOD = 1 * MiB;
constexpr size_t WS_COSA = 2 * MiB, WS_SINA = WS_COSA + 512 * 1024, WS_COSB = 3 * MiB, WS_SINB = WS_COSB + 256 * 1024;
constexpr size_t WS_SSQ = 4 * MiB, WS_SSKV = 5 * MiB;
constexpr size_t WS_GW = 6 * MiB;
constexpr size_t WS_LIST = 7 * MiB;
constexpr size_t WS_WIN = 10 * MiB, WS_WQB = 17 * MiB, WS_WKVB = 18 * MiB, WS_WPA = 19 * MiB, WS_WPB = 20 * MiB, WS_WO = 21 * MiB, WS_W13 = 23 * MiB, WS_W2 = 55 * MiB;
constexpr size_t WS_H = 72 * MiB;
constexpr size_t WS_QA = 136 * MiB, WS_KA = 168 * MiB, WS_VA = 176 * MiB, WS_QLAT = 184 * MiB, WS_KVLAT = 208 * MiB;
constexpr size_t WS_KB = 224 * MiB, WS_VB = 272 * MiB, WS_QB = 304 * MiB, WS_OB = 352 * MiB, WS_SA = 384 * MiB, WS_SB = 448 * MiB, WS_END = 512 * MiB;
constexpr size_t WS_ACT = 136 * MiB, WS_Y2 = 208 * MiB;
constexpr int ACT_ROWS = 2 * T + NE * 256;
static_assert(WS_ACT + (size_t)ACT_ROWS * FF * 2 <= WS_Y2 && WS_Y2 + (size_t)2 * T * D * 2 <= WS_END, "moe overlay");
constexpr int CW_BAR = 4096;
constexpr int CW_CNT = 16384;

constexpr int RING_BYTES = 131072, MISC_OFF = RING_BYTES, LDS_BYTES = 147456;

__device__ __forceinline__ float bf2f(unsigned v) { return __uint_as_float(v << 16); }
typedef __bf16 bf16x2_t __attribute__((ext_vector_type(2)));
__device__ __forceinline__ unsigned cvt_pk_bf16(float lo, float hi) { f32x2 v = {lo, hi}; bf16x2_t b = __builtin_convertvector(v, bf16x2_t); return __builtin_bit_cast(unsigned, b); }
__device__ __forceinline__ u32x4 pack8(f32x4 a, f32x4 b) { u32x4 w; w.x = cvt_pk_bf16(a[0], a[1]); w.y = cvt_pk_bf16(a[2], a[3]); w.z = cvt_pk_bf16(b[0], b[1]); w.w = cvt_pk_bf16(b[2], b[3]); return w; }
__device__ __forceinline__ void unpack8(u32x4 w, f32x4& a, f32x4& b) { a[0] = bf2f(w.x & 0xffffu); a[1] = bf2f(w.x >> 16); a[2] = bf2f(w.y & 0xffffu); a[3] = bf2f(w.y >> 16); b[0] = bf2f(w.z & 0xffffu); b[1] = bf2f(w.z >> 16); b[2] = bf2f(w.w & 0xffffu); b[3] = bf2f(w.w >> 16); }
__device__ __forceinline__ float wave_sum(float v) {
#pragma unroll
    for (int o = 1; o < 64; o <<= 1) v += __shfl_xor(v, o);
    return v;
}
__device__ __forceinline__ float sigm(float v) { return __builtin_amdgcn_rcpf(1.f + __builtin_amdgcn_exp2f(v * (-LOG2E))); }
#define VM_WAIT() asm volatile("s_waitcnt vmcnt(0)" ::: "memory")
#define LAUNDER_S(p) asm volatile("" : "+s"(p))
#define LAUNDER_V(v) asm volatile("" : "+v"(v))
#define LDS_WAIT() asm volatile("s_waitcnt lgkmcnt(0)" ::: "memory")

#define XB_TMO      128
#define XB_XCNT(j)  (256  + 64 * (j))
#define XB_XSUB(j)  (1280 + 64 * (j))
#define XB_XGEN(j)  (2304 + 64 * (j))
#define XB_TOP      3328
#define XB_TOPGEN   3392
#define XCD_BAR_WORDS 3456
#define XB_SPIN_CAP (1u << 22)
__device__ __forceinline__ unsigned xb_ld(unsigned* p)              { return __hip_atomic_load(p, __ATOMIC_RELAXED, __HIP_MEMORY_SCOPE_AGENT); }
__device__ __forceinline__ unsigned xb_add(unsigned* p, unsigned v) { return __hip_atomic_fetch_add(p, v, __ATOMIC_RELAXED, __HIP_MEMORY_SCOPE_AGENT); }
__device__ __forceinline__ unsigned xb_xcc_id() { return (unsigned)__builtin_amdgcn_s_getreg((3 << 11) | 20) & 0xFu; }
#define XB_SPIN(cond, bar) do { unsigned _sp = 0; while (cond) { __builtin_amdgcn_s_sleep(1); \
    if ((++_sp & 255u) == 0u) { if (xb_ld(&(bar)[XB_TMO])) break; if (_sp > XB_SPIN_CAP) { atomicAdd(&(bar)[XB_TMO], 1u); break; } } } } while (0)
struct XcdBarrier { unsigned* bar; unsigned x; volatile LAS unsigned* st; };
__device__ __forceinline__ XcdBarrier xcd_barrier_post(unsigned* bar, volatile LAS unsigned* st) {
    XcdBarrier b; b.bar = bar; b.x = xb_xcc_id(); b.st = st;
    if (threadIdx.x == 0) (void)xb_add(&bar[XB_XCNT(b.x)], 1u);
    return b;
}
__device__ __forceinline__ void xcd_barrier_complete(unsigned* bar, unsigned x, unsigned& nloc, unsigned& nx) {
    const unsigned G = gridDim.x * gridDim.y * gridDim.z;
    unsigned sum, cnt, mine, sp = 0u;
    for (;;) {
        sum = 0u; cnt = 0u; mine = 0u;
#pragma unroll
        for (unsigned j = 0; j < 16; ++j) { const unsigned c = xb_ld(&bar[XB_XCNT(j)]); sum += c; cnt += (c > 0u) ? 1u : 0u; mine = (j == x) ? c : mine; }
        if (sum == G) break;
        __builtin_amdgcn_s_sleep(1);
        if ((++sp & 255u) == 0u) { if (xb_ld(&bar[XB_TMO])) break; if (sp > XB_SPIN_CAP) { atomicAdd(&bar[XB_TMO], 1u); break; } }
    }
    nloc = mine > 0u ? mine : 1u; nx = cnt > 0u ? cnt : 1u;
}
__device__ __forceinline__ void xcd_barrier(const XcdBarrier& b) {
    asm volatile("s_waitcnt vmcnt(0)" ::: "memory");
    __syncthreads();
    if (threadIdx.x == 0) {
        unsigned* bar = b.bar;
        __builtin_amdgcn_s_waitcnt(0);
        unsigned nloc = b.st[0], nx = b.st[1];
        if (nloc == 0u) { xcd_barrier_complete(bar, b.x, nloc, nx); b.st[0] = nloc; b.st[1] = nx; }
        const unsigned old = xb_add(&bar[XB_XSUB(b.x)], 1u);
        const unsigned gen = old / nloc;
        if (old + 1u == (gen + 1u) * nloc) {
            __builtin_amdgcn_fence(__ATOMIC_RELEASE, "agent");
            asm volatile("s_waitcnt vmcnt(0)" ::: "memory");
            const unsigned og = xb_add(&bar[XB_TOP], 1u);
            const unsigned tg = og / nx;
            if (og + 1u == (tg + 1u) * nx) xb_add(&bar[XB_TOPGEN], 1u);
            else XB_SPIN(xb_ld(&bar[XB_TOPGEN]) == tg, bar);
            __builtin_amdgcn_fence(__ATOMIC_ACQUIRE, "agent");
            xb_add(&bar[XB_XGEN(b.x)], 1u);
            asm volatile("s_waitcnt vmcnt(0)" ::: "memory");
        } else {
            XB_SPIN(xb_ld(&bar[XB_XGEN(b.x)]) == gen, bar);
            __builtin_amdgcn_fence(__ATOMIC_ACQUIRE, "agent");
            asm volatile("s_waitcnt vmcnt(0)" ::: "memory");
        }
    }
    __syncthreads();
}

namespace gp {
constexpr int BM = 256, BK = 64, HALF = 128, HTB = HALF * BK * 2, NXCD = 8, WGM = 8;
__host__ __device__ __forceinline__ int lds_byte(int r, int c) { const int st = (r >> 4) * 2 + (c >> 5), rr = r & 15, cc = c & 31, ob = rr * 64 + cc * 2; return st * 1024 + (ob ^ (((ob >> 9) & 1) << 5)); }
__host__ __device__ __forceinline__ void stage_rc(int b, int& R, int& C) { const int st = b / 1024, sb = b % 1024, swz = sb ^ (((sb >> 9) & 1) << 5); R = (st >> 1) * 16 + swz / 64; C = (st & 1) * 32 + (swz % 64) / 2; }
__host__ __device__ __forceinline__ int perm32(int rho) { const int n = rho >> 4, i = rho & 15; return 8 * (i >> 2) + 4 * n + (i & 3); }

struct Unit { int pm, pn, be, rl, nv; };
struct Gemm { const bf16_t* A; const bf16_t* Bt; int K; size_t bstride; const unsigned* list; };

__device__ __forceinline__ int xcd_remap(int wgid, int nwg) { const int q = nwg / NXCD, r = nwg % NXCD, xcd = wgid % NXCD, off = wgid / NXCD; return (xcd < r ? xcd * (q + 1) : r * (q + 1) + (xcd - r) * q) + off; }
struct DenseOrder {
    int nM, nN, nwg, G, c;
    __device__ void init(int M, int N, int G_, int c_) { nM = M / BM; nN = N / BM; nwg = nM * nN; G = G_; c = c_; }
    __device__ bool next(int i, Unit& u) const {
        const long L = (long)i * G + c; if (L >= nwg) return false;
        const int wgid = xcd_remap((int)L, nwg);
        const int nig = WGM * nN, gid = wgid / nig, fm = gid * WGM, gsz = (nM - fm) < WGM ? (nM - fm) : WGM;
        u.pm = fm + ((wgid % nig) % gsz); u.pn = (wgid % nig) / gsz; u.be = 0; u.rl = 0; u.nv = 256; return true;
    }
};
struct MoeOrder {
    const LAS int* tab; int nwg, G, c;
    __device__ static int rd(const LAS int* p) { return __builtin_amdgcn_readfirstlane(*p); }
    __device__ void init(const LAS int* tab_, int G_, int c_) { tab = tab_; nwg = rd(tab_ + 16) * 4; G = G_; c = c_; }
    __device__ bool next(int i, Unit& u) const {
        const long L = (long)i * G + c; if (L >= nwg) return false;
        const int wgid = xcd_remap((int)L, nwg);
        const int tile = wgid >> 2; int e = 0;
        for (int k = 1; k < NE; ++k) e += (rd(tab + k) <= tile) ? 1 : 0;
        u.pm = tile; u.pn = wgid & 3; u.be = e; u.rl = tile - rd(tab + e); const int rem = rd(tab + 32 + e) - u.rl * 256; u.nv = rem < 256 ? rem : 256; return true;
    }
};

#define ACC_T f32x4 (&acc)[2][2][4][2]

template <class Epi, class Sched, bool GATHER>
__device__ __forceinline__ void gemm_phase_ref(int tid, const Gemm g, const Sched& S, const Epi& E) {
    const int wid = __builtin_amdgcn_readfirstlane(tid >> 6), lane = tid & 63, wr = wid >> 2, wc = wid & 3, fr = lane & 15, fq = lane >> 4;
    const int K = g.K; Unit u;
    for (int ui = 0; S.next(ui, u); ++ui) {
        f32x4 acc[2][2][4][2];
#pragma unroll
        for (int a = 0; a < 2; ++a)
#pragma unroll
            for (int b = 0; b < 2; ++b)
#pragma unroll
                for (int m = 0; m < 4; ++m)
#pragma unroll
                    for (int n = 0; n < 2; ++n) acc[a][b][m][n] = (f32x4){0.f, 0.f, 0.f, 0.f};
        const bf16_t* Bt = g.Bt + (size_t)u.be * g.bstride + (size_t)u.pn * 256 * K;
        for (int ai = 0; ai < 2; ++ai)
            for (int m = 0; m < 4; ++m) {
                const int rloc = ai * 128 + wr * 64 + m * 16 + fr;
                size_t arow;
                if (GATHER) { arow = (rloc < u.nv) ? (size_t)(g.list[(size_t)u.be * T + u.rl * 256 + rloc] >> 1) : 0; }
                else arow = (size_t)u.pm * 256 + rloc;
                const bf16_t* ap = g.A + arow * K;
                for (int bj = 0; bj < 2; ++bj) {
                    const bf16_t* bp = Bt + (size_t)(bj * 128 + wc * 32 + fq * 8) * K;
                    float s[8];
#pragma unroll
                    for (int c = 0; c < 8; ++c) {
                        float sc = 0.f; const bf16_t* bpc = bp + (size_t)c * K;
#pragma unroll 2
                        for (int k = 0; k < K; k += 8) {
                            f32x4 a0, a1, b0, b1; unpack8(*(const u32x4*)(ap + k), a0, a1); unpack8(*(const u32x4*)(bpc + k), b0, b1);
                            sc += a0[0] * b0[0] + a0[1] * b0[1] + a0[2] * b0[2] + a0[3] * b0[3] + a1[0] * b1[0] + a1[1] * b1[1] + a1[2] * b1[2] + a1[3] * b1[3];
                        }
                        s[c] = sc; asm volatile("" : "+v"(s[c]));
                    }
#pragma unroll
                    for (int a2 = 0; a2 < 2; ++a2)
#pragma unroll
                        for (int b2 = 0; b2 < 2; ++b2)
#pragma unroll
                            for (int m2 = 0; m2 < 4; ++m2)
                                if (a2 == ai && b2 == bj && m2 == m) { acc[a2][b2][m2][0] = (f32x4){s[0], s[1], s[2], s[3]}; acc[a2][b2][m2][1] = (f32x4){s[4], s[5], s[6], s[7]}; }
                }
            }
        E(acc, u, wr, wc, fr, fq);
    }
}

#if FAST_GEMM
template <class Epi, class Sched, bool GATHER>
__device__ __forceinline__ void gemm_phase_fast(int tid, LAS unsigned char* lds, const Gemm g, const Sched& S, const Epi& E) {
    const int wid = __builtin_amdgcn_readfirstlane(tid >> 6), lane = tid & 63, wr = wid >> 2, wc = wid & 3, fr = lane & 15, fq = lane >> 4;
    const int K = g.K, nt = K / BK;
    int Rr[2], Cc[2]; unsigned voffB[2];
#pragma unroll
    for (int i = 0; i < 2; ++i) { stage_rc(tid * 16 + i * 8192, Rr[i], Cc[i]); const int Rb = (Rr[i] & ~31) + perm32(Rr[i] & 31); voffB[i] = (unsigned)(Rb * K + Cc[i]) * 2u; }
    const size_t kstep = (size_t)(BK * 2), hstep = (size_t)HALF * K * 2, tstep = 2 * hstep;
    const unsigned ldsw = (unsigned)wid * 1024u;
    const int aoff = lds_byte(wr * 64 + fr, fq * 8), boff = lds_byte(wc * 32 + fr, fq * 8);
#define GP_SA(b, h) (((b) * 2 + (h)) * HTB)
#define GP_SB(b, h) ((4 + (b) * 2 + (h)) * HTB)
#define GP_STAGE2(bufoff, gbase, v0, v1) do { \
        __builtin_amdgcn_global_load_lds((const unsigned*)((const char*)(gbase) + (v0)), (LAS unsigned*)(lds + (bufoff) + ldsw), 16, 0, 0); \
        __builtin_amdgcn_global_load_lds((const unsigned*)((const char*)(gbase) + (v1)), (LAS unsigned*)(lds + (bufoff) + ldsw + 8192), 16, 0, 0); } while (0)
#define GP_STAGEB(bufoff, gbase) GP_STAGE2(bufoff, gbase, voffB[0], voffB[1])
#define GP_LDA(dst, b, h) do { _Pragma("unroll") for (int m = 0; m < 4; ++m) _Pragma("unroll") for (int k = 0; k < 2; ++k) dst[m][k] = *(const LAS bf16x8*)(lds + GP_SA(b, h) + aoff + m * 2048 + k * 1024); } while (0)
#define GP_LDB(dst, b, h) do { _Pragma("unroll") for (int n = 0; n < 2; ++n) _Pragma("unroll") for (int k = 0; k < 2; ++k) dst[n][k] = *(const LAS bf16x8*)(lds + GP_SB(b, h) + boff + n * 2048 + k * 1024); } while (0)
#define GP_MMA(ai, bj, At, Bt) do { __builtin_amdgcn_s_setprio(1); _Pragma("unroll") for (int m = 0; m < 4; ++m) _Pragma("unroll") for (int n = 0; n < 2; ++n) _Pragma("unroll") for (int k = 0; k < 2; ++k) \
        acc[ai][bj][m][n] = __builtin_amdgcn_mfma_f32_16x16x32_bf16(Bt[n][k], At[m][k], acc[ai][bj][m][n], 0, 0, 0); __builtin_amdgcn_s_setprio(0); } while (0)
#define GP_WAIT_V(n) asm volatile("s_waitcnt vmcnt(" #n ")" ::: "memory")
#define GP_WAIT_L(n) asm volatile("s_waitcnt lgkmcnt(" #n ")" ::: "memory")
#define GP_BAR __builtin_amdgcn_s_barrier()
#define GP_SCHED __builtin_amdgcn_sched_barrier(0)
    Unit cur, nxt; int ui = 0;
    if (!S.next(0, cur)) return;
    f32x4 acc[2][2][4][2];
#pragma unroll
    for (int a = 0; a < 2; ++a)
#pragma unroll
        for (int b = 0; b < 2; ++b)
#pragma unroll
            for (int m = 0; m < 4; ++m)
#pragma unroll
                for (int n = 0; n < 2; ++n) acc[a][b][m][n] = (f32x4){0.f, 0.f, 0.f, 0.f};
    bf16x8 At[4][2], B0[2][2], B1[2][2];
    unsigned vC0, vC1, vC2, vC3, vN0, vN1, vN2, vN3;
#define GP_VOFF(u, o0, o1, o2, o3) do { if (GATHER) { \
        int tl_ = tid; LAUNDER_V(tl_); int R0_, C0_, R1_, C1_; stage_rc(tl_ * 16, R0_, C0_); stage_rc(tl_ * 16 + 8192, R1_, C1_);     \
        const unsigned* lp = g.list + (size_t)(u).be * T + (u).rl * 256; \
        const int nvm = (u).nv - 1; const int p0 = min(R0_, nvm), p1 = min(R1_, nvm), p2 = min(128 + R0_, nvm), p3 = min(128 + R1_, nvm); \
        const unsigned t0 = lp[p0] >> 1, t1 = lp[p1] >> 1, t2 = lp[p2] >> 1, t3 = lp[p3] >> 1; \
        o0 = (t0 * K + C0_) * 2u; o1 = (t1 * K + C1_) * 2u; o2 = (t2 * K + C0_) * 2u; o3 = (t3 * K + C1_) * 2u; \
      } else { o0 = (unsigned)(Rr[0] * K + Cc[0]) * 2u; o1 = (unsigned)(Rr[1] * K + Cc[1]) * 2u; o2 = o0 + (unsigned)hstep; o3 = o1 + (unsigned)hstep; } } while (0)
    GP_VOFF(cur, vC0, vC1, vC2, vC3);
    const char* cA = (const char*)g.A + (GATHER ? (size_t)0 : (size_t)cur.pm * tstep);
    const char* cB = (const char*)g.Bt + ((size_t)cur.be * g.bstride) * 2 + (size_t)cur.pn * tstep;
    GP_STAGEB(GP_SB(0, 0), cB); GP_STAGEB(GP_SB(0, 1), cB + hstep); GP_STAGE2(GP_SA(0, 0), cA, vC0, vC1); GP_STAGE2(GP_SA(0, 1), cA, vC2, vC3);
    if (wr == 1) GP_BAR;
    GP_WAIT_V(2); GP_BAR;
    GP_STAGEB(GP_SB(1, 0), cB + kstep); GP_STAGE2(GP_SA(1, 0), cA + kstep, vC0, vC1); GP_STAGEB(GP_SB(1, 1), cB + hstep + kstep);
    GP_WAIT_V(6); GP_BAR;
    for (;;) {
        const bool has_next = S.next(ui + 1, nxt);
        const char* nA = has_next ? (const char*)g.A + (GATHER ? (size_t)0 : (size_t)nxt.pm * tstep) : cA;
        const char* nB = has_next ? (const char*)g.Bt + ((size_t)nxt.be * g.bstride) * 2 + (size_t)nxt.pn * tstep : cB;
        if (has_next) { GP_VOFF(nxt, vN0, vN1, vN2, vN3); } else { vN0 = vC0; vN1 = vC1; vN2 = vC2; vN3 = vC3; }
#pragma nounroll
        for (int t = 0; t < nt; t += 2) {
            const bool last = (t == nt - 2);
            const char* a1 = cA + (size_t)(t + 1) * kstep;
            const char* a2 = last ? nA : cA + (size_t)(t + 2) * kstep; const char* b2 = last ? nB : cB + (size_t)(t + 2) * kstep;
            const char* a3 = a2 + kstep; const char* b3 = b2 + kstep;
            const unsigned w0 = last ? vN0 : vC0, w1 = last ? vN1 : vC1, w2 = last ? vN2 : vC2, w3 = last ? vN3 : vC3;
            GP_LDB(B0, 0, 0); GP_LDB(B1, 0, 1); GP_SCHED; GP_LDA(At, 0, 0); GP_STAGE2(GP_SA(1, 1), a1, vC2, vC3);
            GP_WAIT_V(8); GP_WAIT_L(0); GP_BAR; GP_MMA(0, 0, At, B0); GP_MMA(0, 1, At, B1); GP_BAR; GP_SCHED;
            GP_LDA(At, 0, 1); GP_STAGEB(GP_SB(0, 0), b2); GP_STAGEB(GP_SB(0, 1), b2 + hstep); GP_STAGE2(GP_SA(0, 0), a2, w0, w1);
            GP_WAIT_V(8); GP_WAIT_L(0); GP_BAR; GP_MMA(1, 0, At, B0); GP_MMA(1, 1, At, B1); GP_BAR; GP_SCHED;
            GP_LDB(B0, 1, 0); GP_LDB(B1, 1, 1); GP_SCHED; GP_LDA(At, 1, 0); GP_STAGE2(GP_SA(0, 1), a2, w2, w3);
            GP_WAIT_V(8); GP_WAIT_L(0); GP_BAR; GP_MMA(0, 0, At, B0); GP_MMA(0, 1, At, B1); GP_BAR; GP_SCHED;
            GP_LDA(At, 1, 1); GP_STAGEB(GP_SB(1, 0), b3); GP_STAGEB(GP_SB(1, 1), b3 + hstep); GP_STAGE2(GP_SA(1, 0), a3, w0, w1);
            GP_WAIT_V(8); GP_WAIT_L(0); GP_BAR; GP_MMA(1, 0, At, B0); GP_MMA(1, 1, At, B1); GP_BAR; GP_SCHED;
        }
        if (wr == 0) GP_BAR;
        E(acc, cur, wr, wc, fr, fq);
        if (!has_next) break;
#pragma unroll
        for (int a = 0; a < 2; ++a)
#pragma unroll
            for (int b = 0; b < 2; ++b)
#pragma unroll
                for (int m = 0; m < 4; ++m)
#pragma unroll
                    for (int n = 0; n < 2; ++n) acc[a][b][m][n] = (f32x4){0.f, 0.f, 0.f, 0.f};
        cur = nxt; cA = nA; cB = nB; vC0 = vN0; vC1 = vN1; vC2 = vN2; vC3 = vN3; ++ui;
        if (wr == 1) GP_BAR;
    }
    GP_WAIT_V(0);
    GP_BAR;
#undef GP_SA
#undef GP_SB
#undef GP_STAGE2
#undef GP_STAGEB
#undef GP_LDA
#undef GP_LDB
#undef GP_MMA
#undef GP_WAIT_V
#undef GP_WAIT_L
#undef GP_BAR
#undef GP_SCHED
#undef GP_VOFF
}
#endif

template <class Epi, class Sched, bool GATHER = false>
__device__ __forceinline__ void gemm_phase(int tid, LAS unsigned char* lds, const Gemm g, const Sched& S, const Epi& E) {
#if FAST_GEMM
    gemm_phase_fast<Epi, Sched, GATHER>(tid, lds, g, S, E);
#else
    (void)lds; gemm_phase_ref<Epi, Sched, GATHER>(tid, g, S, E);
#endif
}

#define EPI_ROW(ai, m) (u.pm * 256 + (ai) * 128 + wr * 64 + (m) * 16 + fr)
#define EPI_COL(bj) (u.pn * 256 + (bj) * 128 + wc * 32 + fq * 8)
__device__ __forceinline__ float dot4(f32x4 a) { return (a[0] * a[0] + a[1] * a[1]) + (a[2] * a[2] + a[3] * a[3]); }

struct EpiNull {
    __device__ __forceinline__ void operator()(const ACC_T, const Unit& u, int wr, int wc, int fr, int fq) const {
#pragma unroll
        for (int ai = 0; ai < 2; ++ai)
#pragma unroll
            for (int bj = 0; bj < 2; ++bj)
#pragma unroll
                for (int m = 0; m < 4; ++m) asm volatile("" :: "v"(acc[ai][bj][m][0]), "v"(acc[ai][bj][m][1]));
    }
};
struct EpiIn {
    bf16_t *QA, *KA, *VA, *QLAT, *KVLAT, *KB, *SA, *SB; float *SSQ, *SSKV; const float *gq, *gk, *cosA, *sinA, *cosB, *sinB;
    __device__ __forceinline__ void operator()(const ACC_T, const Unit& u, int wr, int wc, int fr, int fq) const {
        const int wb = u.pn * 4 + wc;
        if (wb < 10) {
            const bool isq = wb < 8; const int head = isq ? wb : wb - 8; const float* g = isq ? gq : gk; bf16_t* dst = isq ? QA : KA; const int dp = isq ? 512 : 128; const float qs = isq ? QSCALE_A : 1.f;
            const f32x4 g00 = *(const f32x4*)(g + 8 * fq), g01 = *(const f32x4*)(g + 8 * fq + 4), g10 = *(const f32x4*)(g + 32 + 8 * fq), g11 = *(const f32x4*)(g + 36 + 8 * fq);
#pragma unroll
            for (int ai = 0; ai < 2; ++ai)
#pragma unroll
                for (int m = 0; m < 4; ++m) {
                    const int r = EPI_ROW(ai, m), pos = r & (S - 1);
                    const f32x4 v00 = acc[ai][0][m][0], v01 = acc[ai][0][m][1], v10 = acc[ai][1][m][0], v11 = acc[ai][1][m][1];
                    float ss = (dot4(v00) + dot4(v01)) + (dot4(v10) + dot4(v11)); ss += __shfl_xor(ss, 16); ss += __shfl_xor(ss, 32);
                    const float rstd = rsqrtf(ss * (1.f / 64.f) + EPS);
                    const f32x4 y00 = v00 * rstd * g00, y01 = v01 * rstd * g01, y10 = v10 * rstd * g10, y11 = v11 * rstd * g11;
                    const f32x4 c0 = *(const f32x4*)(cosA + pos * 32 + 8 * fq), c1 = *(const f32x4*)(cosA + pos * 32 + 8 * fq + 4), s0 = *(const f32x4*)(sinA + pos * 32 + 8 * fq), s1 = *(const f32x4*)(sinA + pos * 32 + 8 * fq + 4);
                    const f32x4 o00 = (y00 * c0 - y10 * s0) * qs, o01 = (y01 * c1 - y11 * s1) * qs, o10 = (y10 * c0 + y00 * s0) * qs, o11 = (y11 * c1 + y01 * s1) * qs;
                    bf16_t* p = dst + (size_t)r * dp + head * 64 + 8 * fq;
                    *(u32x4*)p = pack8(o00, o01); *(u32x4*)(p + 32) = pack8(o10, o11);
                }
        } else if (wb < 12) {
#pragma unroll
            for (int ai = 0; ai < 2; ++ai)
#pragma unroll
                for (int m = 0; m < 4; ++m) { bf16_t* p = VA + (size_t)EPI_ROW(ai, m) * 128 + (wb - 10) * 64 + 8 * fq;
                    *(u32x4*)p = pack8(acc[ai][0][m][0], acc[ai][0][m][1]); *(u32x4*)(p + 32) = pack8(acc[ai][1][m][0], acc[ai][1][m][1]); }
        } else if (wb < 22) {
            const bool isq = wb < 18; const int idx = isq ? wb - 12 : wb - 18; bf16_t* dst = isq ? QLAT : KVLAT; const int dp = isq ? 384 : 256;
#pragma unroll
            for (int ai = 0; ai < 2; ++ai)
#pragma unroll
                for (int m = 0; m < 4; ++m) {
                    const int r = EPI_ROW(ai, m);
                    const f32x4 v00 = acc[ai][0][m][0], v01 = acc[ai][0][m][1], v10 = acc[ai][1][m][0], v11 = acc[ai][1][m][1];
                    float ss = (dot4(v00) + dot4(v01)) + (dot4(v10) + dot4(v11)); ss += __shfl_xor(ss, 16); ss += __shfl_xor(ss, 32);
                    if (fq == 0) { if (isq) SSQ[(size_t)r * 8 + idx] = ss; else SSKV[(size_t)r * 4 + idx] = ss; }
                    bf16_t* p = dst + (size_t)r * dp + idx * 64 + 8 * fq;
                    *(u32x4*)p = pack8(v00, v01); *(u32x4*)(p + 32) = pack8(v10, v11);
                }
        } else if (wb == 22) {
            if (fq < 2) {
#pragma unroll
                for (int ai = 0; ai < 2; ++ai)
#pragma unroll
                    for (int m = 0; m < 4; ++m) {
                        const int r = EPI_ROW(ai, m), pos = r & (S - 1);
                        const f32x4 x10 = acc[ai][0][m][0], x11 = acc[ai][0][m][1], x20 = acc[ai][1][m][0], x21 = acc[ai][1][m][1];
                        const f32x4 c0 = *(const f32x4*)(cosB + pos * 16 + 8 * fq), c1 = *(const f32x4*)(cosB + pos * 16 + 8 * fq + 4), s0 = *(const f32x4*)(sinB + pos * 16 + 8 * fq), s1 = *(const f32x4*)(sinB + pos * 16 + 8 * fq + 4);
                        const u32x4 w1 = pack8(x10 * c0 - x20 * s0, x11 * c1 - x21 * s1), w2 = pack8(x20 * c0 + x10 * s0, x21 * c1 + x11 * s1);
                        bf16_t* p = KB + (size_t)r * 768 + 64 + 8 * fq;
#pragma unroll
                        for (int h = 0; h < 8; ++h) { *(u32x4*)(p + h * 96) = w1; *(u32x4*)(p + h * 96 + 16) = w2; }
                    }
            }
        } else if (wb == 23) {
        } else {
            const bool isa = wb < 40; const int idx = isa ? wb - 24 : wb - 40; bf16_t* dst = isa ? SA : SB;
#pragma unroll
            for (int ai = 0; ai < 2; ++ai)
#pragma unroll
                for (int m = 0; m < 4; ++m) { bf16_t* p = dst + (size_t)EPI_ROW(ai, m) * 1024 + idx * 64 + 8 * fq;
#pragma unroll
                    for (int bj = 0; bj < 2; ++bj) { f32x4 a = acc[ai][bj][m][0], b = acc[ai][bj][m][1];
#pragma unroll
                        for (int j = 0; j < 4; ++j) { a[j] = sigm(a[j]); b[j] = sigm(b[j]); }
                        *(u32x4*)(p + bj * 32) = pack8(a, b); } }
        }
    }
};
__host__ __device__ __forceinline__ int src_col_in(int n) {
    const int pn = n >> 8, nl = n & 255, bj = nl >> 7, wc = (nl & 127) >> 5, p = nl & 31, wb = pn * 4 + wc, s = bj * 32 + p;
    if (wb < 8) return wb * 64 + s;
    if (wb < 10) return 512 + (wb - 8) * 64 + s;
    if (wb < 12) return 640 + (wb - 10) * 64 + s;
    if (wb < 18) return 768 + (wb - 12) * 64 + s;
    if (wb < 22) return 1152 + (wb - 18) * 64 + s;
    if (wb == 22) return p < 16 ? 1408 + bj * 16 + p : -1;
    if (wb == 23) return -1;
    if (wb < 40) return 1440 + (wb - 24) * 64 + s;
    return 2464 + (wb - 40) * 64 + s;
}
struct EpiQb {
    bf16_t* QB; const float *SSQ, *cosB, *sinB;
    __device__ __forceinline__ void operator()(const ACC_T, const Unit& u, int wr, int wc, int fr, int fq) const {
#pragma unroll
        for (int ai = 0; ai < 2; ++ai)
#pragma unroll
            for (int m = 0; m < 4; ++m) {
                const int r = EPI_ROW(ai, m), pos = r & (S - 1);
                const f32x4 sa = *(const f32x4*)(SSQ + (size_t)r * 8); const f32x2 sb = *(const f32x2*)(SSQ + (size_t)r * 8 + 4);
                const float rstd = rsqrtf((((sa[0] + sa[1]) + (sa[2] + sa[3])) + (sb[0] + sb[1])) * (1.f / 384.f) + EPS);
#pragma unroll
                for (int bj = 0; bj < 2; ++bj) {
                    f32x4 v0 = acc[ai][bj][m][0] * rstd, v1 = acc[ai][bj][m][1] * rstd;
                    const int c32 = u.pn * 8 + bj * 4 + wc;
                    if (c32 % 3 == 2) {
                        f32x4 o0, o1;
#pragma unroll
                        for (int j = 0; j < 4; ++j) { o0[j] = __shfl_xor(v0[j], 32); o1[j] = __shfl_xor(v1[j], 32); }
                        const int i0 = 8 * (fq & 1);
                        const f32x4 c0 = *(const f32x4*)(cosB + pos * 16 + i0), c1 = *(const f32x4*)(cosB + pos * 16 + i0 + 4), s0 = *(const f32x4*)(sinB + pos * 16 + i0), s1 = *(const f32x4*)(sinB + pos * 16 + i0 + 4);
                        if (fq < 2) { v0 = v0 * c0 - o0 * s0; v1 = v1 * c1 - o1 * s1; } else { v0 = v0 * c0 + o0 * s0; v1 = v1 * c1 + o1 * s1; }
                    }
                    *(u32x4*)(QB + (size_t)r * 768 + EPI_COL(bj)) = pack8(v0 * QSCALE_B, v1 * QSCALE_B);
                }
            }
    }
};
struct EpiKvb {
    bf16_t *KB, *VB; const float* SSKV;
    __device__ __forceinline__ void operator()(const ACC_T, const Unit& u, int wr, int wc, int fr, int fq) const {
#pragma unroll
        for (int ai = 0; ai < 2; ++ai)
#pragma unroll
            for (int m = 0; m < 4; ++m) {
                const int r = EPI_ROW(ai, m);
                const f32x4 sa = *(const f32x4*)(SSKV + (size_t)r * 4);
                const float rstd = rsqrtf(((sa[0] + sa[1]) + (sa[2] + sa[3])) * (1.f / 256.f) + EPS);
#pragma unroll
                for (int bj = 0; bj < 2; ++bj) {
                    const int head = u.pn * 2 + bj, o = wc * 32 + fq * 8;
                    const u32x4 w = pack8(acc[ai][bj][m][0] * rstd, acc[ai][bj][m][1] * rstd);
                    if (wc < 2) *(u32x4*)(KB + (size_t)r * 768 + head * 96 + o) = w; else *(u32x4*)(VB + (size_t)r * 512 + head * 64 + (o - 64)) = w;
                }
            }
    }
};
template <int MODE> struct EpiProj {
    bf16_t* O; const bf16_t* gate;
    __device__ __forceinline__ void operator()(const ACC_T, const Unit& u, int wr, int wc, int fr, int fq) const {
#pragma unroll
        for (int ai = 0; ai < 2; ++ai)
#pragma unroll
            for (int m = 0; m < 4; ++m) {
                const int r = EPI_ROW(ai, m);
#pragma unroll
                for (int bj = 0; bj < 2; ++bj) {
                    const size_t off = (size_t)r * D + EPI_COL(bj);
                    f32x4 g0, g1; unpack8(*(const u32x4*)(gate + off), g0, g1);
                    f32x4 v0 = acc[ai][bj][m][0] * g0, v1 = acc[ai][bj][m][1] * g1;
                    if (MODE == 1) { f32x4 p0, p1; unpack8(*(const u32x4*)(O + off), p0, p1); v0 += p0; v1 += p1; }
                    *(u32x4*)(O + off) = pack8(v0, v1);
                }
            }
    }
};
struct EpiWo {
    float* X; const float* modl; float* XO;
    __device__ __forceinline__ void operator()(const ACC_T, const Unit& u, int wr, int wc, int fr, int fq) const {
        const float* g1 = modl + (size_t)(u.pm >> 4) * 6 * D + 2 * D;
#pragma unroll
        for (int bj = 0; bj < 2; ++bj) {
            const int c = EPI_COL(bj); const f32x4 ga = *(const f32x4*)(g1 + c), gb = *(const f32x4*)(g1 + c + 4);
#pragma unroll
            for (int ai = 0; ai < 2; ++ai)
#pragma unroll
                for (int m = 0; m < 4; ++m) { float* p = X + (size_t)EPI_ROW(ai, m) * D + c;
                    const f32x4 x0 = *(const f32x4*)p, x1 = *(const f32x4*)(p + 4);
                    float* q = XO + (size_t)EPI_ROW(ai, m) * D + c; *(f32x4*)q = x0 + ga * acc[ai][bj][m][0]; *(f32x4*)(q + 4) = x1 + gb * acc[ai][bj][m][1]; }
        }
    }
};
struct EpiUp {
    bf16_t* ACT;
    __device__ __forceinline__ void operator()(const ACC_T, const Unit& u, int wr, int wc, int fr, int fq) const {
#pragma unroll
        for (int ai = 0; ai < 2; ++ai)
#pragma unroll
            for (int m = 0; m < 4; ++m) {
                f32x4 a = acc[ai][0][m][0], b = acc[ai][0][m][1]; const f32x4 c = acc[ai][1][m][0], d = acc[ai][1][m][1];
#pragma unroll
                for (int j = 0; j < 4; ++j) { a[j] = a[j] * sigm(a[j]) * c[j]; b[j] = b[j] * sigm(b[j]) * d[j]; }
                *(u32x4*)(ACT + (size_t)EPI_ROW(ai, m) * FF + u.pn * 128 + wc * 32 + fq * 8) = pack8(a, b);
            }
    }
};
struct EpiDown {
    bf16_t* Y2; const unsigned* list; const float* gw;
    __device__ __forceinline__ void operator()(const ACC_T, const Unit& u, int wr, int wc, int fr, int fq) const {
#pragma unroll
        for (int ai = 0; ai < 2; ++ai)
#pragma unroll
            for (int m = 0; m < 4; ++m) {
                const int rloc = ai * 128 + wr * 64 + m * 16 + fr;
                if (rloc < u.nv) {
                    const unsigned entry = list[(size_t)u.be * T + u.rl * 256 + rloc]; const float w = gw[entry];
#pragma unroll
                    for (int bj = 0; bj < 2; ++bj) *(u32x4*)(Y2 + (size_t)entry * D + EPI_COL(bj)) = pack8(acc[ai][bj][m][0] * w, acc[ai][bj][m][1] * w);
                }
            }
    }
};
}

namespace at {
struct Tensors { const bf16_t* Q; int qp; const bf16_t* K; int kp; const bf16_t* V; int vp; bf16_t* O; int op; int group; };
__device__ __forceinline__ bool next_unit(int i, int vcu, int G, int& bh, int& qb) {
    int u;
    if (G == 256) { if (i >= 4) return false; u = (vcu >> 5) * 128 + i * 32 + (vcu & 31); }
    else { u = i * G + vcu; if (u >= 1024) return false; }
    bh = u >> 4; qb = u & 15; return true;
}
template <int DQK>
__device__ __forceinline__ void attn_phase_ref(int tid, const Tensors& A, int vcu, int G) {
    int bh, qb;
    for (int i = 0; next_unit(i, vcu, G, bh, qb); ++i) {
        const int b = bh >> 3, h = bh & 7, kvh = h / A.group;
        {
            const int dh = tid >> 8;
            const size_t row = (size_t)b * S + qb * 256 + (tid & 255);
            float q[DQK], o[32];
#pragma unroll
            for (int d = 0; d < DQK; ++d) q[d] = bf2f(A.Q[row * A.qp + h * DQK + d]);
#pragma unroll
            for (int d = 0; d < 32; ++d) o[d] = 0.f;
            float l = 0.f;
            for (int k = 0; k < S; ++k) {
                const bf16_t* kr = A.K + ((size_t)b * S + k) * A.kp + kvh * DQK; const bf16_t* vr = A.V + ((size_t)b * S + k) * A.vp + kvh * 64 + dh * 32;
                float sc = 0.f;
#pragma unroll
                for (int d = 0; d < DQK; d += 8) { f32x4 k0, k1; unpack8(*(const u32x4*)(kr + d), k0, k1);
                    sc += q[d] * k0[0] + q[d + 1] * k0[1] + q[d + 2] * k0[2] + q[d + 3] * k0[3] + q[d + 4] * k1[0] + q[d + 5] * k1[1] + q[d + 6] * k1[2] + q[d + 7] * k1[3]; }
                const float p = bf2f(cvt_pk_bf16(exp2f(sc), 0.f) & 0xffffu); l += p;
#pragma unroll
                for (int d = 0; d < 32; d += 8) { f32x4 v0, v1; unpack8(*(const u32x4*)(vr + d), v0, v1);
                    o[d] += p * v0[0]; o[d + 1] += p * v0[1]; o[d + 2] += p * v0[2]; o[d + 3] += p * v0[3]; o[d + 4] += p * v1[0]; o[d + 5] += p * v1[1]; o[d + 6] += p * v1[2]; o[d + 7] += p * v1[3]; }
            }
            const float il = 1.f / l;
            __syncthreads();
#pragma unroll
            for (int d = 0; d < 32; d += 8) { f32x4 a = {o[d] * il, o[d + 1] * il, o[d + 2] * il, o[d + 3] * il}, c = {o[d + 4] * il, o[d + 5] * il, o[d + 6] * il, o[d + 7] * il};
                *(u32x4*)(A.O + row * A.op + h * 64 + dh * 32 + d) = pack8(a, c); }
        }
    }
}
#if FAST_ATTN
typedef short s16x4 __attribute__((ext_vector_type(4)));
__device__ __forceinline__ unsigned cvtpk(float lo, float hi) { f32x2 v = {lo, hi}; bf16x2_t b = __builtin_convertvector(v, bf16x2_t); return __builtin_bit_cast(unsigned, b); }
__device__ __forceinline__ s16x4 vtr(const LAS unsigned char* p) { return __builtin_bit_cast(s16x4, __builtin_amdgcn_ds_read_tr16_b64_v4i16((LAS s16x4*)p)); }
__device__ __forceinline__ int crow(int r, int hi) { return (r & 3) + 8 * (r >> 2) + 4 * hi; }
#define AT_BAR() asm volatile("s_barrier" ::: "memory")
#define AT_WAITBAR(N) asm volatile("s_waitcnt vmcnt(" #N ") lgkmcnt(0)\n\ts_barrier" ::: "memory")
#define AT_SCHED() __builtin_amdgcn_sched_barrier(0)
__device__ __forceinline__ void glds16(const void* gsrc, unsigned lds_dst) { unsigned keep;
    asm volatile("s_mov_b32 %0, m0\n\ts_mov_b32 m0, %2\n\ts_nop 0\n\tglobal_load_lds_dwordx4 %1, off\n\ts_mov_b32 m0, %0" : "=&s"(keep) : "v"(gsrc), "s"(lds_dst) : "memory"); }
#define AT_GLDS(g, l) glds16((const void*)(g), (unsigned)__builtin_amdgcn_readfirstlane((int)(unsigned)(uintptr_t)(l)))
template <int DQK>
__device__ __forceinline__ void attn_unit(int tid, LAS unsigned char* lds, const Tensors& A, int b, int h, int qb) {
    constexpr int ND = DQK / 16, NCH = DQK / 8, KSLOT = NCH * 1024, NKD = NCH > 8 ? 2 : 1, VSLOT = 8192, NT = S / 64;
    constexpr int KOFF = 0, VOFF = 3 * KSLOT, OST = VOFF + 3 * VSLOT, WSF = OST + 8 * 4096;
    static_assert(WSF + 8 * 256 <= RING_BYTES, "attention LDS");
    const int lane = tid & 63, r32 = lane & 31, hi = lane >> 5, wid = __builtin_amdgcn_readfirstlane(tid >> 6);
    const int kvh = h / A.group; const size_t rowb = (size_t)b * S;
    const bf16_t* ksrc = A.K + (rowb + lane) * A.kp + kvh * DQK + wid * 8;
    const bf16_t* ksrc2 = A.K + (rowb + lane) * A.kp + kvh * DQK + (8 + (wid & 3)) * 8;
    const bf16_t* vsrc = A.V + (rowb + 16 * (wid & 3) + (lane >> 2)) * A.vp + kvh * 64 + (wid >> 2) * 32 + (lane & 3) * 8;
    const size_t ktile = (size_t)64 * A.kp, vtile = (size_t)64 * A.vp;
    LAS unsigned char* kdst = lds + KOFF + wid * 1024; LAS unsigned char* kdst2 = lds + KOFF + (8 + (wid & 3)) * 1024; LAS unsigned char* vdst = lds + VOFF + wid * 1024;
#define DMA_K(j, so) do { AT_GLDS(ksrc + (size_t)(j) * ktile, kdst + (so)); if (NKD == 2) AT_GLDS(ksrc2 + (size_t)(j) * ktile, kdst2 + (so)); } while (0)
#define DMA_V(j, so) AT_GLDS(vsrc + (size_t)(j) * vtile, vdst + (so))
    const LAS unsigned char* kp0 = lds + KOFF + hi * 1024 + r32 * 16;
    const LAS unsigned char* vp0 = lds + VOFF + ((lane >> 4) & 1) * 32 + (lane & 3) * 8 + (4 * hi + ((lane & 15) >> 2)) * 64;
    DMA_K(0, 0); DMA_V(0, 0); DMA_K(1, KSLOT); DMA_V(1, VSLOT); DMA_K(2, 2 * KSLOT);
    const bf16_t* Qw = A.Q + (rowb + qb * 256 + wid * 32 + r32) * A.qp + h * DQK + hi * 8;
    bf16x8 qr[ND];
#pragma unroll
    for (int d0 = 0; d0 < ND; ++d0) qr[d0] = *(const bf16x8*)(Qw + d0 * 16);
    asm volatile("s_waitcnt vmcnt(0)\n\ts_barrier" ::: "memory");
    bf16x8 kf[2 * ND]; s16x4 vlo[8], vhi[8];
#define KLOAD(so) do { _Pragma("unroll") for (int d0 = 0; d0 < ND; ++d0) { kf[2 * d0] = *(const LAS bf16x8*)(kp0 + (so) + d0 * 2048); kf[2 * d0 + 1] = *(const LAS bf16x8*)(kp0 + (so) + d0 * 2048 + 512); } } while (0)
#define VLOAD(so) do { _Pragma("unroll") for (int i = 0; i < 8; ++i) { vlo[i] = vtr(vp0 + (so) + (i >> 2) * 4096 + (i & 3) * 1024); vhi[i] = vtr(vp0 + (so) + (i >> 2) * 4096 + (i & 3) * 1024 + 512); } } while (0)
#define VFR(i) (bf16x8){vlo[i][0], vlo[i][1], vlo[i][2], vlo[i][3], vhi[i][0], vhi[i][1], vhi[i][2], vhi[i][3]}
    KLOAD(0);
    asm volatile("s_waitcnt lgkmcnt(0)" ::: "memory");
    if (PROBE_ATT != 5 && wid >= 4) AT_BAR();
    f32x16 o0 = {}, o1 = {}, C0, C1; u32x4 pw0, pw1, pw2, pw3; float lsum = 0.f;
    const f32x16 zero = {};
#define QK_BLOCK() do { C0 = __builtin_amdgcn_mfma_f32_32x32x16_bf16(kf[0], qr[0], zero, 0, 0, 0); C1 = __builtin_amdgcn_mfma_f32_32x32x16_bf16(kf[1], qr[0], zero, 0, 0, 0); \
        _Pragma("unroll") for (int d0 = 1; d0 < ND; ++d0) { C0 = __builtin_amdgcn_mfma_f32_32x32x16_bf16(kf[2 * d0], qr[d0], C0, 0, 0, 0); C1 = __builtin_amdgcn_mfma_f32_32x32x16_bf16(kf[2 * d0 + 1], qr[d0], C1, 0, 0, 0); } } while (0)
#define PAF(k) __builtin_bit_cast(bf16x8, pw##k)
#define PV_BLOCK() do { \
        o0 = __builtin_amdgcn_mfma_f32_32x32x16_bf16(PAF(0), VFR(0), o0, 0, 0, 0); o1 = __builtin_amdgcn_mfma_f32_32x32x16_bf16(PAF(0), VFR(4), o1, 0, 0, 0); \
        o0 = __builtin_amdgcn_mfma_f32_32x32x16_bf16(PAF(1), VFR(1), o0, 0, 0, 0); o1 = __builtin_amdgcn_mfma_f32_32x32x16_bf16(PAF(1), VFR(5), o1, 0, 0, 0); \
        o0 = __builtin_amdgcn_mfma_f32_32x32x16_bf16(PAF(2), VFR(2), o0, 0, 0, 0); o1 = __builtin_amdgcn_mfma_f32_32x32x16_bf16(PAF(2), VFR(6), o1, 0, 0, 0); \
        o0 = __builtin_amdgcn_mfma_f32_32x32x16_bf16(PAF(3), VFR(3), o0, 0, 0, 0); o1 = __builtin_amdgcn_mfma_f32_32x32x16_bf16(PAF(3), VFR(7), o1, 0, 0, 0); } while (0)
#define SOFTMAX() do { \
        _Pragma("unroll") for (int r = 0; r < 16; ++r) { C0[r] = __builtin_amdgcn_exp2f(C0[r]); C1[r] = __builtin_amdgcn_exp2f(C1[r]); } \
        float s0_ = 0.f, s1_ = 0.f; _Pragma("unroll") for (int r = 0; r < 16; ++r) { s0_ += C0[r]; s1_ += C1[r]; } lsum += s0_ + s1_; \
        pw0 = (u32x4){cvtpk(C0[0], C0[1]), cvtpk(C0[2], C0[3]), cvtpk(C0[4], C0[5]), cvtpk(C0[6], C0[7])}; pw1 = (u32x4){cvtpk(C0[8], C0[9]), cvtpk(C0[10], C0[11]), cvtpk(C0[12], C0[13]), cvtpk(C0[14], C0[15])}; \
        pw2 = (u32x4){cvtpk(C1[0], C1[1]), cvtpk(C1[2], C1[3]), cvtpk(C1[4], C1[5]), cvtpk(C1[6], C1[7])}; pw3 = (u32x4){cvtpk(C1[8], C1[9]), cvtpk(C1[10], C1[11]), cvtpk(C1[12], C1[13]), cvtpk(C1[14], C1[15])}; } while (0)
    int ka = 2 * KSLOT, kb = 0, kc = KSLOT, va = 2 * VSLOT, vb = 0, vc = VSLOT;
#define ROT() do { const int t_ = ka; ka = kb; kb = kc; kc = t_; const int u_ = va; va = vb; vb = vc; vc = u_; } while (0)
#define PINP() asm volatile("" : "+v"(lsum) : "v"(pw0), "v"(pw1), "v"(pw2), "v"(pw3))
#define STEP(sv, DOQK, DOPV, KL, VL, IK, IV) do { \
        AT_SCHED(); if (DOQK) QK_BLOCK(); if (DOPV) PV_BLOCK(); \
        if (PROBE_ATT == 4) { f32x16 dm_ = zero; _Pragma("unroll") for (int q_ = 0; q_ < 8; ++q_) dm_ = __builtin_amdgcn_mfma_f32_32x32x16_bf16(kf[q_ & 1], qr[0], dm_, 0, 0, 0); asm volatile("" :: "v"(dm_)); } \
        AT_SCHED(); \
          \
        asm volatile("s_barrier\n\ts_nop 15\n\ts_nop 3" : "+v"(C0), "+v"(C1), "+v"(o0), "+v"(o1) :: "memory"); AT_SCHED(); \
        if (KL) KLOAD(kc); if (VL) VLOAD(vb); if (IK) DMA_K((sv) + 4, kb); if (IV) DMA_V((sv) + 3, va); \
        if (PROBE_ATT == 2) { if (IK) DMA_K((sv) + 4, kb); if (IV) DMA_V((sv) + 3, va); } \
        if (PROBE_ATT == 3) { bf16x8 d_[8]; _Pragma("unroll") for (int q_ = 0; q_ < 8; ++q_) { d_[q_] = *(const LAS bf16x8*)(kp0 + kc + (q_ >> 1) * 2048 + (q_ & 1) * 512); } _Pragma("unroll") for (int q_ = 0; q_ < 8; ++q_) asm volatile("" :: "v"(d_[q_])); \
                              s16x4 e_[16]; _Pragma("unroll") for (int q_ = 0; q_ < 16; ++q_) { e_[q_] = vtr(vp0 + vb + (q_ >> 3) * 4096 + ((q_ >> 1) & 3) * 1024 + (q_ & 1) * 512); } _Pragma("unroll") for (int q_ = 0; q_ < 16; ++q_) asm volatile("" :: "v"(e_[q_])); } \
        if (DOQK) { SOFTMAX(); PINP(); } \
        if (PROBE_ATT == 1 && DOQK) { _Pragma("unroll") for (int r = 0; r < 16; ++r) { float x_ = __builtin_amdgcn_exp2f(C0[r]), y_ = __builtin_amdgcn_exp2f(C1[r]); asm volatile("" :: "v"(x_), "v"(y_)); } } \
        AT_SCHED(); \
        if (IK) { if (NKD == 2) { AT_WAITBAR(3); } else { AT_WAITBAR(2); } } else if (IV) { AT_WAITBAR(1); } else { AT_WAITBAR(0); } \
        AT_SCHED(); ROT(); } while (0)
    STEP(-1, true, false, true, true, true, true);
#pragma nounroll
    for (int s = 0; s < NT - 4; ++s) STEP(s, true, true, true, true, true, true);
    STEP(NT - 4, true, true, true, true, false, true);
    STEP(NT - 3, true, true, true, true, false, false);
    STEP(NT - 2, true, true, false, true, false, false);
    STEP(NT - 1, false, true, false, false, false, false);
#undef STEP
#undef PINP
    if (PROBE_ATT != 5 && wid < 4) AT_BAR();
    { auto rr = __builtin_amdgcn_permlane32_swap(__float_as_uint(lsum), __float_as_uint(lsum), false, false); lsum = __uint_as_float(rr[0]) + __uint_as_float(rr[1]); }
    LAS float* wsf = (LAS float*)(lds + WSF + wid * 256);
    if (hi == 0) wsf[r32] = lsum;
    asm volatile("s_waitcnt lgkmcnt(0)" ::: "memory");
    LAS bf16_t* stg = (LAS bf16_t*)(lds + OST + wid * 4096);
#pragma unroll
    for (int r = 0; r < 16; ++r) { const int orow = crow(r, hi); const float rl = __builtin_amdgcn_rcpf(wsf[orow]);
        stg[orow * 64 + r32] = (bf16_t)(cvtpk(o0[r] * rl, 0.f) & 0xffffu); stg[orow * 64 + 32 + r32] = (bf16_t)(cvtpk(o1[r] * rl, 0.f) & 0xffffu); }
    asm volatile("s_waitcnt lgkmcnt(0)" ::: "memory");
    bf16_t* Ow = A.O + (rowb + qb * 256 + wid * 32) * A.op + h * 64;
#pragma unroll
    for (int i = 0; i < 4; ++i) { const int row = i * 8 + (lane >> 3), ch = lane & 7; const u32x4 v = *(const LAS u32x4*)(stg + row * 64 + ch * 8); *(u32x4*)(Ow + (size_t)row * A.op + ch * 8) = v; }
    asm volatile("s_waitcnt lgkmcnt(0)\n\ts_barrier" ::: "memory");
#undef DMA_K
#undef DMA_V
#undef KLOAD
#undef VLOAD
#undef VFR
#undef QK_BLOCK
#undef PAF
#undef PV_BLOCK
#undef SOFTMAX
#undef ROT
}
#endif
template <int DQK>
__device__ __forceinline__ void attn_phase(int tid, LAS unsigned char* lds, const Tensors& A, int vcu, int G) {
#if FAST_ATTN
    int bh, qb;
    for (int i = 0; next_unit(i, vcu, G, bh, qb); ++i) attn_unit<DQK>(tid, lds, A, bh >> 3, bh & 7, qb);
#else
    (void)lds; attn_phase_ref<DQK>(tid, A, vcu, G);
#endif
}
}


struct Args { const float* in[22]; float* out; unsigned char* ws; int ph_lo, ph_hi; };
struct Frame {
    LAS unsigned char* lds; volatile LAS unsigned* MISC; unsigned* ctl;
    int tid, lane, wave, vcu, G;
    unsigned char* ws; float* X;
};

__device__ __forceinline__ void p0_phase(Frame& F, const float* c, const float* w_ada, const float* b_ada) {
    LAS float* cs = (LAS float*)F.lds;
    LAS float* red = (LAS float*)(F.lds + 32768);
    for (int i = F.tid; i < NB * D; i += NTHREADS) { const float v = c[i]; cs[i] = v / (1.f + __expf(-v)); }
    __syncthreads();
    float* mod = (float*)(F.ws + WS_MOD);
    const int kq = F.wave, col = F.lane;
    for (int item = F.vcu; item < NL * 6 * D / 64; item += F.G) {
        const int l = item / (6 * D / 64), n0 = (item % (6 * D / 64)) * 64;
        const float* w = w_ada + (size_t)l * D * 6 * D + n0 + col;
        float acc[NB];
#pragma unroll
        for (int b = 0; b < NB; ++b) acc[b] = 0.f;
#pragma unroll 8
        for (int k = kq * 128; k < kq * 128 + 128; ++k) { const float wv = w[(size_t)k * 6 * D];
#pragma unroll
            for (int b = 0; b < NB; ++b) acc[b] += cs[b * D + k] * wv; }
#pragma unroll
        for (int b = 0; b < NB; ++b) red[(kq * NB + b) * 64 + col] = acc[b];
        __syncthreads();
        { const int b = F.wave; float s = 0.f;
#pragma unroll
          for (int q = 0; q < 8; ++q) s += red[(q * NB + b) * 64 + col];
          mod[((size_t)l * NB + b) * 6 * D + n0 + col] = s + b_ada[(size_t)l * 6 * D + n0 + col]; }
        __syncthreads();
    }
    float* cosA = (float*)(F.ws + WS_COSA); float* sinA = (float*)(F.ws + WS_SINA); float* cosB = (float*)(F.ws + WS_COSB); float* sinB = (float*)(F.ws + WS_SINB);
    for (int idx = F.vcu * NTHREADS + F.tid; idx < S * 48; idx += F.G * NTHREADS) {
        const int s = idx / 48, i = idx % 48; const float row = (float)(s >> 6), col2 = (float)(s & 63);
        if (i < 32) { const int j = i & 15; const float a = (i < 16 ? row : col2) * (1.0f / powf(10000.0f, (float)j / 16.0f)); cosA[s * 32 + i] = cosf(a); sinA[s * 32 + i] = sinf(a); }
        else { const int ii = i - 32, j = ii & 7; const float a = (ii < 8 ? row : col2) * (1.0f / powf(10000.0f, (float)j / 8.0f)); cosB[s * 16 + ii] = cosf(a); sinB[s * 16 + ii] = sinf(a); }
    }
}

template <class SrcFn>
__device__ __forceinline__ void cvt_item(const float* W, int K, int Nsrc, const float* kg, bf16_t* WT, LAS float* scr, int item, int nblk, int lane, const SrcFn& src) {
    const int kb = item / nblk, nb = item % nblk, k0 = 64 * kb, n0 = 32 * nb;
    const int sc = src(n0 + (lane & 31));
#pragma unroll
    for (int i = 0; i < 32; ++i) { const int kk = 2 * i + (lane >> 5); float v = sc >= 0 ? W[(size_t)(k0 + kk) * Nsrc + sc] : 0.f; if (kg) v *= kg[k0 + kk]; scr[kk * 33 + (lane & 31)] = v; }
    LDS_WAIT(); asm volatile("" ::: "memory");
    const int c = lane & 7;
#pragma unroll
    for (int j = 0; j < 4; ++j) { const int n = (lane >> 3) + 8 * j; const LAS float* s = scr + (8 * c) * 33 + n;
        u32x4 o; o.x = cvt_pk_bf16(s[0 * 33], s[1 * 33]); o.y = cvt_pk_bf16(s[2 * 33], s[3 * 33]); o.z = cvt_pk_bf16(s[4 * 33], s[5 * 33]); o.w = cvt_pk_bf16(s[6 * 33], s[7 * 33]);
        *(u32x4*)(WT + (size_t)(n0 + n) * K + k0 + 8 * c) = o; }
    LDS_WAIT(); asm volatile("" ::: "memory");
}
struct SrcId { __device__ int operator()(int n) const { return n; } };
struct SrcIn { __device__ int operator()(int n) const { return gp::src_col_in(n); } };
typedef __attribute__((address_space(4))) const Args CArgsW;
__device__ __forceinline__ void convert_weights(Frame& F, CArgsW* a, int l) {
    LAS float* scr = (LAS float*)(F.lds + F.wave * 16384);
    const int gw = F.vcu * NWAVES + F.wave, NGW = F.G * NWAVES;
    const float* w_in = ((const float*)(GAS const float*)a->in[5]) + (size_t)l * D * INC; const float* w_q_b = ((const float*)(GAS const float*)a->in[10]) + (size_t)l * 384 * 768; const float* w_kv_b = ((const float*)(GAS const float*)a->in[11]) + (size_t)l * 256 * 1024;
    const float* w_pa = ((const float*)(GAS const float*)a->in[12]) + (size_t)l * 512 * D; const float* w_pb = ((const float*)(GAS const float*)a->in[13]) + (size_t)l * 512 * D; const float* w_o = ((const float*)(GAS const float*)a->in[14]) + (size_t)l * D * D;
    const float* w1 = ((const float*)(GAS const float*)a->in[18]) + (size_t)l * NE * D * FF; const float* w3 = ((const float*)(GAS const float*)a->in[19]) + (size_t)l * NE * D * FF; const float* w2 = ((const float*)(GAS const float*)a->in[20]) + (size_t)l * NE * FF * D;
    const float* gqa = ((const float*)(GAS const float*)a->in[8]) + l * 384; const float* gkv = ((const float*)(GAS const float*)a->in[9]) + l * 256;
    bf16_t* Win = (bf16_t*)(F.ws + WS_WIN); bf16_t* Wqb = (bf16_t*)(F.ws + WS_WQB); bf16_t* Wkvb = (bf16_t*)(F.ws + WS_WKVB); bf16_t* Wpa = (bf16_t*)(F.ws + WS_WPA); bf16_t* Wpb = (bf16_t*)(F.ws + WS_WPB);
    bf16_t* Wo = (bf16_t*)(F.ws + WS_WO); bf16_t* W13 = (bf16_t*)(F.ws + WS_W13); bf16_t* W2 = (bf16_t*)(F.ws + WS_W2);
    constexpr int I_IN = (D / 64) * (NIN / 32), I_QB = (384 / 64) * (768 / 32), I_KVB = (256 / 64) * (1024 / 32), I_P = (512 / 64) * (D / 32), I_O = (D / 64) * (D / 32);
    constexpr int I_13 = (D / 64) * (1024 / 32), I_2 = (FF / 64) * (D / 32);
    constexpr int NITEMS = I_IN + I_QB + I_KVB + 2 * I_P + I_O + NE * (I_13 + I_2);
    for (int it = gw; it < NITEMS; it += NGW) {
        int r = it;
        if (r < I_IN) { cvt_item(w_in, D, INC, nullptr, Win, scr, r, NIN / 32, F.lane, SrcIn()); continue; } r -= I_IN;
        if (r < I_QB) { cvt_item(w_q_b, 384, 768, gqa, Wqb, scr, r, 768 / 32, F.lane, SrcId()); continue; } r -= I_QB;
        if (r < I_KVB) { cvt_item(w_kv_b, 256, 1024, gkv, Wkvb, scr, r, 1024 / 32, F.lane, SrcId()); continue; } r -= I_KVB;
        if (r < I_P) { cvt_item(w_pa, 512, D, nullptr, Wpa, scr, r, D / 32, F.lane, SrcId()); continue; } r -= I_P;
        if (r < I_P) { cvt_item(w_pb, 512, D, nullptr, Wpb, scr, r, D / 32, F.lane, SrcId()); continue; } r -= I_P;
        if (r < I_O) { cvt_item(w_o, D, D, nullptr, Wo, scr, r, D / 32, F.lane, SrcId()); continue; } r -= I_O;
        if (r < NE * I_13) { const int e = r / I_13, q = r % I_13, nb = q % 32;
            const float* src = ((nb & 7) < 4 ? w1 : w3) + (size_t)e * D * FF; const int cb = (nb >> 3) * 128 + (nb & 3) * 32;
            struct SrcOff { int n0, cb; __device__ int operator()(int n) const { return cb + (n - n0); } } so{nb * 32, cb};
            cvt_item(src, D, FF, nullptr, W13 + (size_t)e * 1024 * D, scr, q, 32, F.lane, so); continue; } r -= NE * I_13;
        { const int e = r / I_2, q = r % I_2; cvt_item(w2 + (size_t)e * FF * D, FF, D, nullptr, W2 + (size_t)e * D * FF, scr, q, D / 32, F.lane, SrcId()); }
    }
}

template <int MODE>
__device__ __forceinline__ void row_phase(Frame& F, const float* xin, const float* g2prev, const float* gain, const float* modl, int sh_off, int sc_off, bf16_t* H, float* Xout) {
    constexpr int RB = 4;
    const int gw = F.vcu * NWAVES + F.wave, NGW = F.G * NWAVES;
    const bf16_t* Y2 = (const bf16_t*)(F.ws + WS_Y2);
    for (int m0 = gw; m0 < T; m0 += RB * NGW) {
        f32x4 v[RB][4]; float ss[RB];
        if (MODE == 0) {
#pragma unroll
            for (int r = 0; r < RB; ++r)
#pragma unroll
                for (int j = 0; j < 4; ++j) v[r][j] = *(const f32x4*)(xin + (size_t)(m0 + r * NGW) * D + 4 * F.lane + 256 * j);
        } else {
            u32x2 ya[RB][4], yb[RB][4]; f32x4 g[RB][4];
#pragma unroll
            for (int r = 0; r < RB; ++r)
#pragma unroll
                for (int j = 0; j < 4; ++j) { const int m = m0 + r * NGW, c = 4 * F.lane + 256 * j;
                    v[r][j] = *(const f32x4*)(F.X + (size_t)m * D + c); ya[r][j] = *(const u32x2*)(Y2 + (size_t)(2 * m) * D + c); yb[r][j] = *(const u32x2*)(Y2 + (size_t)(2 * m + 1) * D + c);
                    g[r][j] = *(const f32x4*)(g2prev + (size_t)(m >> 12) * 6 * D + 5 * D + c); }
#pragma unroll
            for (int r = 0; r < RB; ++r)
#pragma unroll
                for (int j = 0; j < 4; ++j) { f32x4 y; y[0] = bf2f(ya[r][j].x & 0xffffu) + bf2f(yb[r][j].x & 0xffffu); y[1] = bf2f(ya[r][j].x >> 16) + bf2f(yb[r][j].x >> 16); y[2] = bf2f(ya[r][j].y & 0xffffu) + bf2f(yb[r][j].y & 0xffffu); y[3] = bf2f(ya[r][j].y >> 16) + bf2f(yb[r][j].y >> 16);
                    v[r][j] += g[r][j] * y; }
        }
#pragma unroll
        for (int r = 0; r < RB; ++r) { ss[r] = (gp::dot4(v[r][0]) + gp::dot4(v[r][1])) + (gp::dot4(v[r][2]) + gp::dot4(v[r][3])); }
#pragma unroll
        for (int o = 1; o < 64; o <<= 1)
#pragma unroll
            for (int r = 0; r < RB; ++r) ss[r] += __shfl_xor(ss[r], o);
#pragma unroll
        for (int r = 0; r < RB; ++r) {
            const int m = m0 + r * NGW, b = m >> 12; const float rstd = rsqrtf(ss[r] * (1.f / D) + EPS);
#pragma unroll
            for (int j = 0; j < 4; ++j) {
                const int c = 4 * F.lane + 256 * j; const f32x4 gn = *(const f32x4*)(gain + c);
                if (MODE == 2) { *(f32x4*)(Xout + (size_t)m * D + c) = v[r][j] * rstd * gn; }
                else {
                    *(f32x4*)(Xout + (size_t)m * D + c) = v[r][j];
                    const f32x4 sc = *(const f32x4*)(modl + (size_t)b * 6 * D + sc_off + c), sh = *(const f32x4*)(modl + (size_t)b * 6 * D + sh_off + c);
                    const f32x4 hv = v[r][j] * rstd * gn * (1.f + sc) + sh;
                    u32x2 w; w.x = cvt_pk_bf16(hv[0], hv[1]); w.y = cvt_pk_bf16(hv[2], hv[3]);
                    *(u32x2*)(H + (size_t)m * D + c) = w;
                }
            }
        }
    }
}

__device__ __forceinline__ void t2_phase(Frame& F, const float* gain, const float* modl, const float* w_router, const float* rbias, int l, bool record) {
    LAS f32x4* wl = (LAS f32x4*)F.lds;
    LAS int* rec = (LAS int*)(F.lds + 65536);
    LAS float* recw = (LAS float*)(F.lds + 65536 + 2048);
    LAS int* lcnt = (LAS int*)(F.lds + 65536 + 4096);
    for (int idx = F.tid; idx < 4096; idx += NTHREADS) {
        const int lane = idx & 63, c = (idx >> 6) & 3, i = (idx >> 8) & 3, j = idx >> 10; const int k = 4 * lane + 256 * j + i;
        wl[idx] = *(const f32x4*)(w_router + (size_t)k * NE + 4 * c);
    }
    if (F.tid < 32) lcnt[F.tid] = 0;
    __syncthreads();
    constexpr int RB = 4;
    const int gw = F.vcu * NWAVES + F.wave, NGW = F.G * NWAVES;
    bf16_t* H = (bf16_t*)(F.ws + WS_H);
    const int lane = F.lane, myrow = lane >> 4, mye = lane & 15;
    int it = 0;
    for (int m0 = gw; m0 < T; m0 += RB * NGW, ++it) {
        f32x4 v[RB][4]; float ss[RB];
#pragma unroll
        for (int r = 0; r < RB; ++r)
#pragma unroll
            for (int j = 0; j < 4; ++j) v[r][j] = *(const f32x4*)(F.X + (size_t)(m0 + r * NGW) * D + 4 * lane + 256 * j);
#pragma unroll
        for (int r = 0; r < RB; ++r) ss[r] = (gp::dot4(v[r][0]) + gp::dot4(v[r][1])) + (gp::dot4(v[r][2]) + gp::dot4(v[r][3]));
#pragma unroll
        for (int o = 1; o < 64; o <<= 1)
#pragma unroll
            for (int r = 0; r < RB; ++r) ss[r] += __shfl_xor(ss[r], o);
        float acc[RB * NE];
#pragma unroll
        for (int q = 0; q < RB * NE; ++q) acc[q] = 0.f;
#pragma unroll
        for (int j = 0; j < 4; ++j) {
            const int c = 4 * lane + 256 * j; const f32x4 gn = *(const f32x4*)(gain + c);
#pragma unroll
            for (int r = 0; r < RB; ++r) {
                const int m = m0 + r * NGW, b = m >> 12; const float rstd = rsqrtf(ss[r] * (1.f / D) + EPS);
                const f32x4 sc = *(const f32x4*)(modl + (size_t)b * 6 * D + 4 * D + c), sh = *(const f32x4*)(modl + (size_t)b * 6 * D + 3 * D + c);
                v[r][j] = v[r][j] * rstd * gn * (1.f + sc) + sh;
                u32x2 w; w.x = cvt_pk_bf16(v[r][j][0], v[r][j][1]); w.y = cvt_pk_bf16(v[r][j][2], v[r][j][3]);
                *(u32x2*)(H + (size_t)m * D + c) = w;
            }
#pragma unroll
            for (int i = 0; i < 4; ++i)
#pragma unroll
                for (int c4 = 0; c4 < 4; ++c4) { const f32x4 wv = wl[((j * 4 + i) * 4 + c4) * 64 + lane];
#pragma unroll
                    for (int r = 0; r < RB; ++r) { const float hv = v[r][j][i];
                        acc[r * NE + 4 * c4 + 0] += hv * wv[0]; acc[r * NE + 4 * c4 + 1] += hv * wv[1]; acc[r * NE + 4 * c4 + 2] += hv * wv[2]; acc[r * NE + 4 * c4 + 3] += hv * wv[3]; } }
        }
#pragma unroll
        for (int sft = 32; sft >= 1; sft >>= 1) {
            const bool up = (lane & sft) != 0;
#pragma unroll
            for (int k = 0; k < sft; ++k) { const float a = acc[k], b = acc[k + sft]; const float keep = up ? b : a, send = up ? a : b; acc[k] = keep + __shfl_xor(send, sft); }
        }
        const float logit = acc[0];
        const float score = 1.f / (1.f + expf(-logit));
        float scv[NE], bi[NE];
#pragma unroll
        for (int e = 0; e < NE; ++e) { scv[e] = __shfl(score, (lane & 48) | e); bi[e] = scv[e] + rbias[e]; }
        int gsel = 0; float gbest = -INFINITY;
#pragma unroll
        for (int g = 0; g < 4; ++g) { float m1 = -INFINITY, m2 = -INFINITY;
#pragma unroll
            for (int j = 0; j < 4; ++j) { const float x = bi[g * 4 + j]; if (x > m1) { m2 = m1; m1 = x; } else if (x > m2) m2 = x; }
            const float gs = m1 + m2; if (gs > gbest) { gbest = gs; gsel = g; } }
        int e1 = -1, e2 = -1; float b1 = -INFINITY, b2 = -INFINITY, s1 = 0.f, s2 = 0.f;
#pragma unroll
        for (int j = 0; j < 4; ++j) { float x = -INFINITY, sx = 0.f;
#pragma unroll
            for (int g = 0; g < 4; ++g) if (g == gsel) { x = bi[g * 4 + j]; sx = scv[g * 4 + j]; }
            const int e = gsel * 4 + j;
            if (x > b1) { b2 = b1; e2 = e1; s2 = s1; b1 = x; e1 = e; s1 = sx; } else if (x > b2) { b2 = x; e2 = e; s2 = sx; } }
        if (mye == 0) {
            const float inv = 1.f / (s1 + s2); const int slot = (it * RB + myrow) * NWAVES + F.wave;
            rec[slot * 4 + 0] = e1; rec[slot * 4 + 1] = e2;
            rec[slot * 4 + 2] = __hip_atomic_fetch_add(&lcnt[e1], 1, __ATOMIC_RELAXED, __HIP_MEMORY_SCOPE_WORKGROUP);
            rec[slot * 4 + 3] = __hip_atomic_fetch_add(&lcnt[e2], 1, __ATOMIC_RELAXED, __HIP_MEMORY_SCOPE_WORKGROUP);
            recw[slot * 2 + 0] = s1 * inv; recw[slot * 2 + 1] = s2 * inv;
        }
    }
    __syncthreads();
    if (!record) return;
    if (F.tid < NE) lcnt[16 + F.tid] = (int)__hip_atomic_fetch_add(F.ctl + CW_CNT + (l * NE + F.tid) * 64, (unsigned)lcnt[F.tid], __ATOMIC_RELAXED, __HIP_MEMORY_SCOPE_AGENT);
    __syncthreads();
    unsigned* list = (unsigned*)(F.ws + WS_LIST); float* gwb = (float*)(F.ws + WS_GW);
    const int nrows = it * RB;
    for (int s = F.tid; s < nrows * NWAVES; s += NTHREADS) {
        const int i2 = s / NWAVES, w = s % NWAVES; const int m = F.vcu * NWAVES + w + i2 * NGW;
        const int e1 = rec[s * 4 + 0], e2 = rec[s * 4 + 1];
        list[(size_t)e1 * T + lcnt[16 + e1] + rec[s * 4 + 2]] = (unsigned)(2 * m); list[(size_t)e2 * T + lcnt[16 + e2] + rec[s * 4 + 3]] = (unsigned)(2 * m + 1);
        gwb[2 * m] = recw[s * 2]; gwb[2 * m + 1] = recw[s * 2 + 1];
    }
}
__device__ __forceinline__ const LAS int* moe_table(Frame& F, int l) {
    LAS int* tab = (LAS int*)(F.lds + MISC_OFF + 1024);
    __syncthreads();
    if (F.tid == 0) { int acc = 0;
        for (int e = 0; e < NE; ++e) { const int c = (int)__hip_atomic_load(F.ctl + CW_CNT + (l * NE + e) * 64, __ATOMIC_RELAXED, __HIP_MEMORY_SCOPE_AGENT); tab[e] = acc; tab[32 + e] = c; acc += (c + 255) >> 8; }
        tab[16] = acc; }
    __syncthreads();
    return tab;
}

typedef __attribute__((address_space(4))) const Args CArgs;
#define LAUNDER_GP(T_, p) do { GAS T_* _t = (GAS T_*)(p); asm volatile("" : "+s"(_t)); (p) = (T_*)_t; } while (0)
#define PH_BEGIN() LAUNDER_V(F.tid); F.lane = F.tid & 63; LAUNDER_GP(unsigned, F.ctl); LAUNDER_GP(float, F.X); LAUNDER_GP(unsigned char, F.ws); GAS unsigned char* ws = (GAS unsigned char*)F.ws; CArgs* ka = (CArgs*)__builtin_amdgcn_kernarg_segment_ptr(); LAUNDER_S(ka); \
    float* mod = WSP(float, WS_MOD); (void)mod; (void)ka
#define WSP(T_, off) ((T_*)(GAS T_*)(ws + (off)))
#define KIN(i) ((const float*)(GAS const float*)ka->in[i])
__global__ void __launch_bounds__(NTHREADS, 2) fwd_kernel(Args args) {
    extern __shared__ __attribute__((aligned(16))) unsigned char lds_raw[];
    Frame F;
    F.lds = (LAS unsigned char*)lds_raw; F.MISC = (volatile LAS unsigned*)(F.lds + MISC_OFF);
    F.tid = threadIdx.x; F.lane = F.tid & 63; F.wave = __builtin_amdgcn_readfirstlane(F.tid >> 6);
    F.G = gridDim.x; { const int bx = blockIdx.x; F.vcu = (F.G % 8 == 0) ? (bx % 8) * (F.G / 8) + bx / 8 : bx; }
    F.ws = (unsigned char*)(GAS unsigned char*)args.ws; F.ctl = (unsigned*)(GAS unsigned*)(args.ws + WS_CTL); F.X = (float*)(GAS float*)args.out;
    if (F.tid < 64) F.MISC[F.tid] = 0u;
    __syncthreads();
    XcdBarrier bar; bar.bar = F.ctl + CW_BAR; bar.x = 0; bar.st = nullptr;
    if (!N_LAUNCH_MODE) bar = xcd_barrier_post(F.ctl + CW_BAR, F.MISC + 8);
    const int lo = args.ph_lo, hi = args.ph_hi;
#define IN(k) (lo <= (k) && (k) < hi)
#define SEAM(k) do { if ((k) + 1 < hi) { if (!N_LAUNCH_MODE) xcd_barrier(bar); } } while (0)
    const int cidx = (int)blockIdx.x;

    if (IN(0)) { PH_BEGIN(); p0_phase(F, KIN(1), KIN(2), KIN(3)); SEAM(0); }
    for (int l = 0; l < NL; ++l) {
        const int pb = 1 + 9 * l;
        if (IN(pb + 0)) {
            PH_BEGIN();
            for (int rep = 0; rep < ((PROBE_DUP & 8) ? 2 : 1); ++rep) { LAUNDER_V(F.tid); F.lane = F.tid & 63; convert_weights(F, ka, l); }
            if (l == 0) row_phase<0>(F, KIN(0), nullptr, KIN(4) + l * D, mod + (size_t)l * NB * 6 * D, 0, D, WSP(bf16_t, WS_H), F.X);
            else { if (PROBE_DUP & 64) { row_phase<1>(F, nullptr, mod + (size_t)(l - 1) * NB * 6 * D, KIN(4) + l * D, mod + (size_t)l * NB * 6 * D, 0, D, WSP(bf16_t, WS_QA), WSP(float, WS_SA)); LAUNDER_V(F.tid); F.lane = F.tid & 63; }
                   row_phase<1>(F, nullptr, mod + (size_t)(l - 1) * NB * 6 * D, KIN(4) + l * D, mod + (size_t)l * NB * 6 * D, 0, D, WSP(bf16_t, WS_H), F.X); }
            SEAM(pb + 0);
        }
        if (IN(pb + 1)) {
            PH_BEGIN();
            gp::Gemm g{WSP(bf16_t, WS_H), WSP(const bf16_t, WS_WIN), D, 0, nullptr}; gp::DenseOrder So; So.init(T, NIN, F.G, cidx);
            gp::EpiIn E{WSP(bf16_t, WS_QA), WSP(bf16_t, WS_KA), WSP(bf16_t, WS_VA), WSP(bf16_t, WS_QLAT), WSP(bf16_t, WS_KVLAT), WSP(bf16_t, WS_KB), WSP(bf16_t, WS_SA), WSP(bf16_t, WS_SB), WSP(float, WS_SSQ), WSP(float, WS_SSKV),
                        KIN(6) + l * 64, KIN(7) + l * 64, WSP(const float, WS_COSA), WSP(const float, WS_SINA), WSP(const float, WS_COSB), WSP(const float, WS_SINB)};
            if (PROBE_DUP & 128) { gp::EpiNull En; gp::gemm_phase<gp::EpiNull, gp::DenseOrder>(F.tid, F.lds, g, So, En); LAUNDER_V(F.tid); }
            gp::gemm_phase<gp::EpiIn, gp::DenseOrder>(F.tid, F.lds, g, So, E); if (PROBE_DUP & 2) { LAUNDER_V(F.tid); gp::gemm_phase<gp::EpiIn, gp::DenseOrder>(F.tid, F.lds, g, So, E); }
            SEAM(pb + 1);
        }
        if (IN(pb + 2)) {
            { PH_BEGIN(); gp::Gemm g{WSP(bf16_t, WS_QLAT), WSP(const bf16_t, WS_WQB), 384, 0, nullptr}; gp::DenseOrder So; So.init(T, 768, F.G, cidx);
              gp::EpiQb E{WSP(bf16_t, WS_QB), WSP(const float, WS_SSQ), WSP(const float, WS_COSB), WSP(const float, WS_SINB)}; gp::gemm_phase<gp::EpiQb, gp::DenseOrder>(F.tid, F.lds, g, So, E); if (PROBE_DUP & 2) { LAUNDER_V(F.tid); gp::gemm_phase<gp::EpiQb, gp::DenseOrder>(F.tid, F.lds, g, So, E); } }
            { PH_BEGIN(); gp::Gemm g{WSP(bf16_t, WS_KVLAT), WSP(const bf16_t, WS_WKVB), 256, 0, nullptr}; gp::DenseOrder So; So.init(T, 1024, F.G, F.G - 1 - cidx);
              gp::EpiKvb E{WSP(bf16_t, WS_KB), WSP(bf16_t, WS_VB), WSP(const float, WS_SSKV)}; gp::gemm_phase<gp::EpiKvb, gp::DenseOrder>(F.tid, F.lds, g, So, E); if (PROBE_DUP & 2) { LAUNDER_V(F.tid); gp::gemm_phase<gp::EpiKvb, gp::DenseOrder>(F.tid, F.lds, g, So, E); } }
            if (PROBE_DUP & 1) { PH_BEGIN(); const at::Tensors A{WSP(bf16_t, WS_QA), 512, WSP(bf16_t, WS_KA), 128, WSP(bf16_t, WS_VA), 128, WSP(bf16_t, WS_OB), 512, 4}; at::attn_phase<64>(F.tid, F.lds, A, F.vcu, F.G); }
            { PH_BEGIN(); const at::Tensors A{WSP(bf16_t, WS_QA), 512, WSP(bf16_t, WS_KA), 128, WSP(bf16_t, WS_VA), 128, WSP(bf16_t, WS_QA), 512, 4}; at::attn_phase<64>(F.tid, F.lds, A, F.vcu, F.G); }
            SEAM(pb + 2);
        }
        if (IN(pb + 3)) {
            PH_BEGIN();
            const at::Tensors A{WSP(bf16_t, WS_QB), 768, WSP(bf16_t, WS_KB), 768, WSP(bf16_t, WS_VB), 512, WSP(bf16_t, WS_OB), 512, 1}; for (int rep = 0; rep < ((PROBE_DUP & 1) ? 2 : 1); ++rep) at::attn_phase<96>(F.tid, F.lds, A, F.vcu, F.G);
            SEAM(pb + 3);
        }
        if (IN(pb + 4)) for (int rep3 = 0; rep3 < ((PROBE_DUP & 2) ? 2 : 1); ++rep3) {
            { PH_BEGIN(); gp::Gemm g{WSP(bf16_t, WS_QA), WSP(const bf16_t, WS_WPA), 512, 0, nullptr}; gp::DenseOrder So; So.init(T, D, F.G, cidx);
              gp::EpiProj<0> E{WSP(bf16_t, WS_H), WSP(const bf16_t, WS_SA)}; gp::gemm_phase<gp::EpiProj<0>, gp::DenseOrder>(F.tid, F.lds, g, So, E); }
            { PH_BEGIN(); gp::Gemm g{WSP(bf16_t, WS_OB), WSP(const bf16_t, WS_WPB), 512, 0, nullptr}; gp::DenseOrder So; So.init(T, D, F.G, cidx);
              gp::EpiProj<1> E{WSP(bf16_t, WS_H), WSP(const bf16_t, WS_SB)}; gp::gemm_phase<gp::EpiProj<1>, gp::DenseOrder>(F.tid, F.lds, g, So, E); }
            if (rep3 + 1 == ((PROBE_DUP & 2) ? 2 : 1)) SEAM(pb + 4);
        }
        if (IN(pb + 5)) {
            PH_BEGIN();
            gp::Gemm g{WSP(bf16_t, WS_H), WSP(const bf16_t, WS_WO), D, 0, nullptr}; gp::DenseOrder So; So.init(T, D, F.G, cidx);
            if (PROBE_DUP & 32) { gp::EpiWo E2{F.X, mod + (size_t)l * NB * 6 * D, WSP(float, WS_KB)}; gp::gemm_phase<gp::EpiWo, gp::DenseOrder>(F.tid, F.lds, g, So, E2); LAUNDER_V(F.tid); }
            gp::EpiWo E{F.X, mod + (size_t)l * NB * 6 * D, F.X}; gp::gemm_phase<gp::EpiWo, gp::DenseOrder>(F.tid, F.lds, g, So, E);
            SEAM(pb + 5);
        }
        if (IN(pb + 6)) {
            PH_BEGIN();
            if (PROBE_DUP & 16) { t2_phase(F, KIN(15) + l * D, mod + (size_t)l * NB * 6 * D, KIN(16), KIN(17), l, false); LAUNDER_V(F.tid); F.lane = F.tid & 63; __syncthreads(); }
            t2_phase(F, KIN(15) + l * D, mod + (size_t)l * NB * 6 * D, KIN(16), KIN(17), l, true);
            SEAM(pb + 6);
        }
        if (IN(pb + 7)) {
            PH_BEGIN();
            const LAS int* tab = moe_table(F, l);
            gp::Gemm g{WSP(bf16_t, WS_H), WSP(const bf16_t, WS_W13), D, (size_t)1024 * D, WSP(const unsigned, WS_LIST)}; gp::MoeOrder So; So.init(tab, F.G, cidx);
            if (PROBE_DUP & 256) { gp::EpiNull En; gp::gemm_phase<gp::EpiNull, gp::MoeOrder, true>(F.tid, F.lds, g, So, En); LAUNDER_V(F.tid); }
            gp::EpiUp E{WSP(bf16_t, WS_ACT)}; gp::gemm_phase<gp::EpiUp, gp::MoeOrder, true>(F.tid, F.lds, g, So, E); if (PROBE_DUP & 4) { LAUNDER_V(F.tid); gp::gemm_phase<gp::EpiUp, gp::MoeOrder, true>(F.tid, F.lds, g, So, E); }
            SEAM(pb + 7);
        }
        if (IN(pb + 8)) {
            PH_BEGIN();
            const LAS int* tab = moe_table(F, l);
            gp::Gemm g{WSP(bf16_t, WS_ACT), WSP(const bf16_t, WS_W2), FF, (size_t)D * FF, nullptr}; gp::MoeOrder So; So.init(tab, F.G, cidx);
            gp::EpiDown E{WSP(bf16_t, WS_Y2), WSP(const unsigned, WS_LIST), WSP(const float, WS_GW)}; gp::gemm_phase<gp::EpiDown, gp::MoeOrder, false>(F.tid, F.lds, g, So, E); if (PROBE_DUP & 4) { LAUNDER_V(F.tid); gp::gemm_phase<gp::EpiDown, gp::MoeOrder, false>(F.tid, F.lds, g, So, E); }
            SEAM(pb + 8);
        }
    }
    if (IN(NPHASE - 1)) { PH_BEGIN(); row_phase<2>(F, nullptr, mod + (size_t)(NL - 1) * NB * 6 * D, KIN(21), nullptr, 0, 0, nullptr, F.X); }
#undef IN
#undef SEAM
}

extern "C" void kernel_launch(void* const* d_in, const int* in_sizes, int n_in, void* d_out, int out_size, void* d_ws, size_t ws_size, hipStream_t stream) {
    static int grid = 0;
    if (grid == 0) {
        if (n_in != 22 || out_size != T * D || ws_size < WS_END) { fprintf(stderr, "kernel_launch: unexpected problem (n_in %d out %d ws %zu)\n", n_in, out_size, ws_size); grid = -1; return; }
        int dev = 0, cus = 0, per_cu = 0;
        if (hipGetDevice(&dev) != hipSuccess || hipDeviceGetAttribute(&cus, hipDeviceAttributeMultiprocessorCount, dev) != hipSuccess) { grid = -1; return; }
        if (hipFuncSetAttribute((const void*)fwd_kernel, hipFuncAttributeMaxDynamicSharedMemorySize, LDS_BYTES) != hipSuccess) { grid = -1; return; }
        if (hipOccupancyMaxActiveBlocksPerMultiprocessor(&per_cu, (const void*)fwd_kernel, NTHREADS, LDS_BYTES) != hipSuccess || per_cu < 1) { fprintf(stderr, "kernel_launch: occupancy query says %d\n", per_cu); }
        (void)hipGetLastError();
        grid = cus;
        if (T % (grid * NWAVES * 4) != 0) { fprintf(stderr, "kernel_launch: grid %d does not divide the row phases\n", grid); grid = -1; return; }
    }
    if (grid < 0) return;
    (void)hipMemsetAsync((char*)d_ws + WS_CTL, 0, CTL_BYTES, stream);
    Args a{};
    for (int i = 0; i < 22; ++i) a.in[i] = (const float*)d_in[i];
    a.out = (float*)d_out; a.ws = (unsigned char*)d_ws;
#if N_LAUNCH_MODE
    for (int p = 0; p < NPHASE; ++p) { a.ph_lo = p; a.ph_hi = p + 1; hipLaunchKernelGGL(fwd_kernel, dim3(grid), dim3(NTHREADS), LDS_BYTES, stream, a); }
#else
    a.ph_lo = 0; a.ph_hi = NPHASE;
    hipLaunchKernelGGL(fwd_kernel, dim3(grid), dim3(NTHREADS), LDS_BYTES, stream, a);
#endif
}
```

```cpp
#include <hip/hip_runtime.h>
#include <stdint.h>
#include <stdio.h>
#include <math.h>

#ifndef FAST_GEMM
#define FAST_GEMM 1
#endif
#ifndef FAST_ATTN
#define FAST_ATTN 1
#endif
#ifndef PROBE_DUP
#define PROBE_DUP 0
#endif
#ifndef PROBE_ATT
#define PROBE_ATT 0
#endif
#ifndef ATT_REGSTAGE
#define ATT_REGSTAGE 0
#endif
#ifndef N_LAUNCH_MODE
#define N_LAUNCH_MODE 0
#endif

#define LAS __attribute__((address_space(3)))
#define GAS __attribute__((address_space(1)))
typedef unsigned short bf16_t;
typedef short bf16x8 __attribute__((ext_vector_type(8)));
typedef float f32x4 __attribute__((ext_vector_type(4)));
typedef float f32x2 __attribute__((ext_vector_type(2)));
typedef float f32x16 __attribute__((ext_vector_type(16)));
typedef unsigned u32x4 __attribute__((ext_vector_type(4)));
typedef unsigned u32x2 __attribute__((ext_vector_type(2)));
typedef GAS unsigned gu32;

constexpr int D = 1024, NB = 8, S = 4096, T = NB * S, NL = 4, INC = 3488, NIN = 3584, NE = 16, FF = 512;
constexpr float EPS = 1e-6f, LOG2E = 1.4426950408889634f;
constexpr float QSCALE_A = 0.125f * LOG2E, QSCALE_B = 0.10206207261596577f * LOG2E;
constexpr int NWAVES = 8, NTHREADS = 512;
constexpr int NPHASE = 2 + 9 * NL;

constexpr size_t MiB = 1u << 20;
constexpr size_t WS_CTL = 0, CTL_BYTES = 1 * MiB;
constexpr size_t WS_MOD = 1 * MiB;
constexpr size_t WS_COSA = 2 * MiB, WS_SINA = WS_COSA + 512 * 1024, WS_COSB = 3 * MiB, WS_SINB = WS_COSB + 256 * 1024;
constexpr size_t WS_SSQ = 4 * MiB, WS_SSKV = 5 * MiB;
constexpr size_t WS_GW = 6 * MiB;
constexpr size_t WS_LIST = 7 * MiB;
constexpr size_t WS_WIN = 10 * MiB, WS_WQB = 17 * MiB, WS_WKVB = 18 * MiB, WS_WPA = 19 * MiB, WS_WPB = 20 * MiB, WS_WO = 21 * MiB, WS_W13 = 23 * MiB, WS_W2 = 55 * MiB;
constexpr size_t WS_H = 72 * MiB;
constexpr size_t WS_QA = 136 * MiB, WS_KA = 168 * MiB, WS_VA = 176 * MiB, WS_QLAT = 184 * MiB, WS_KVLAT = 208 * MiB;
constexpr size_t WS_KB = 224 * MiB, WS_VB = 272 * MiB, WS_QB = 304 * MiB, WS_OB = 352 * MiB, WS_SA = 384 * MiB, WS_SB = 448 * MiB, WS_END = 512 * MiB;
constexpr size_t WS_ACT = 136 * MiB, WS_Y2 = 208 * MiB;
constexpr int ACT_ROWS = 2 * T + NE * 256;
static_assert(WS_ACT + (size_t)ACT_ROWS * FF * 2 <= WS_Y2 && WS_Y2 + (size_t)2 * T * D * 2 <= WS_END, "moe overlay");
constexpr int CW_BAR = 4096;
constexpr int CW_CNT = 16384;

constexpr int RING_BYTES = 131072, MISC_OFF = RING_BYTES, LDS_BYTES = 147456;

__device__ __forceinline__ float bf2f(unsigned v) { return __uint_as_float(v << 16); }
typedef __bf16 bf16x2_t __attribute__((ext_vector_type(2)));
__device__ __forceinline__ unsigned cvt_pk_bf16(float lo, float hi) { f32x2 v = {lo, hi}; bf16x2_t b = __builtin_convertvector(v, bf16x2_t); return __builtin_bit_cast(unsigned, b); }
__device__ __forceinline__ u32x4 pack8(f32x4 a, f32x4 b) { u32x4 w; w.x = cvt_pk_bf16(a[0], a[1]); w.y = cvt_pk_bf16(a[2], a[3]); w.z = cvt_pk_bf16(b[0], b[1]); w.w = cvt_pk_bf16(b[2], b[3]); return w; }
__device__ __forceinline__ void unpack8(u32x4 w, f32x4& a, f32x4& b) { a[0] = bf2f(w.x & 0xffffu); a[1] = bf2f(w.x >> 16); a[2] = bf2f(w.y & 0xffffu); a[3] = bf2f(w.y >> 16); b[0] = bf2f(w.z & 0xffffu); b[1] = bf2f(w.z >> 16); b[2] = bf2f(w.w & 0xffffu); b[3] = bf2f(w.w >> 16); }
__device__ __forceinline__ float wave_sum(float v) {
#pragma unroll
    for (int o = 1; o < 64; o <<= 1) v += __shfl_xor(v, o);
    return v;
}
__device__ __forceinline__ float sigm(float v) { return __builtin_amdgcn_rcpf(1.f + __builtin_amdgcn_exp2f(v * (-LOG2E))); }
#define VM_WAIT() asm volatile("s_waitcnt vmcnt(0)" ::: "memory")
#define LAUNDER_S(p) asm volatile("" : "+s"(p))
#define LAUNDER_V(v) asm volatile("" : "+v"(v))
#define LDS_WAIT() asm volatile("s_waitcnt lgkmcnt(0)" ::: "memory")

#define XB_TMO      128
#define XB_XCNT(j)  (256  + 64 * (j))
#define XB_XSUB(j)  (1280 + 64 * (j))
#define XB_XGEN(j)  (2304 + 64 * (j))
#define XB_TOP      3328
#define XB_TOPGEN   3392
#define XCD_BAR_WORDS 3456
#define XB_SPIN_CAP (1u << 22)
__device__ __forceinline__ unsigned xb_ld(unsigned* p)              { return __hip_atomic_load(p, __ATOMIC_RELAXED, __HIP_MEMORY_SCOPE_AGENT); }
__device__ __forceinline__ unsigned xb_add(unsigned* p, unsigned v) { return __hip_atomic_fetch_add(p, v, __ATOMIC_RELAXED, __HIP_MEMORY_SCOPE_AGENT); }
__device__ __forceinline__ unsigned xb_xcc_id() { return (unsigned)__builtin_amdgcn_s_getreg((3 << 11) | 20) & 0xFu; }
#define XB_SPIN(cond, bar) do { unsigned _sp = 0; while (cond) { __builtin_amdgcn_s_sleep(1); \
    if ((++_sp & 255u) == 0u) { if (xb_ld(&(bar)[XB_TMO])) break; if (_sp > XB_SPIN_CAP) { atomicAdd(&(bar)[XB_TMO], 1u); break; } } } } while (0)
struct XcdBarrier { unsigned* bar; unsigned x; volatile LAS unsigned* st; };
__device__ __forceinline__ XcdBarrier xcd_barrier_post(unsigned* bar, volatile LAS unsigned* st) {
    XcdBarrier b; b.bar = bar; b.x = xb_xcc_id(); b.st = st;
    if (threadIdx.x == 0) (void)xb_add(&bar[XB_XCNT(b.x)], 1u);
    return b;
}
__device__ __forceinline__ void xcd_barrier_complete(unsigned* bar, unsigned x, unsigned& nloc, unsigned& nx) {
    const unsigned G = gridDim.x * gridDim.y * gridDim.z;
    unsigned sum, cnt, mine, sp = 0u;
    for (;;) {
        sum = 0u; cnt = 0u; mine = 0u;
#pragma unroll
        for (unsigned j = 0; j < 16; ++j) { const unsigned c = xb_ld(&bar[XB_XCNT(j)]); sum += c; cnt += (c > 0u) ? 1u : 0u; mine = (j == x) ? c : mine; }
        if (sum == G) break;
        __builtin_amdgcn_s_sleep(1);
        if ((++sp & 255u) == 0u) { if (xb_ld(&bar[XB_TMO])) break; if (sp > XB_SPIN_CAP) { atomicAdd(&bar[XB_TMO], 1u); break; } }
    }
    nloc = mine > 0u ? mine : 1u; nx = cnt > 0u ? cnt : 1u;
}
__device__ __forceinline__ void xcd_barrier(const XcdBarrier& b) {
    asm volatile("s_waitcnt vmcnt(0)" ::: "memory");
    __syncthreads();
    if (threadIdx.x == 0) {
        unsigned* bar = b.bar;
        __builtin_amdgcn_s_waitcnt(0);
        unsigned nloc = b.st[0], nx = b.st[1];
        if (nloc == 0u) { xcd_barrier_complete(bar, b.x, nloc, nx); b.st[0] = nloc; b.st[1] = nx; }
        const unsigned old = xb_add(&bar[XB_XSUB(b.x)], 1u);
        const unsigned gen = old / nloc;
        if (old + 1u == (gen + 1u) * nloc) {
            __builtin_amdgcn_fence(__ATOMIC_RELEASE, "agent");
            asm volatile("s_waitcnt vmcnt(0)" ::: "memory");
            const unsigned og = xb_add(&bar[XB_TOP], 1u);
            const unsigned tg = og / nx;
            if (og + 1u == (tg + 1u) * nx) xb_add(&bar[XB_TOPGEN], 1u);
            else XB_SPIN(xb_ld(&bar[XB_TOPGEN]) == tg, bar);
            __builtin_amdgcn_fence(__ATOMIC_ACQUIRE, "agent");
            xb_add(&bar[XB_XGEN(b.x)], 1u);
            asm volatile("s_waitcnt vmcnt(0)" ::: "memory");
        } else {
            XB_SPIN(xb_ld(&bar[XB_XGEN(b.x)]) == gen, bar);
            __builtin_amdgcn_fence(__ATOMIC_ACQUIRE, "agent");
            asm volatile("s_waitcnt vmcnt(0)" ::: "memory");
        }
    }
    __syncthreads();
}

namespace gp {
constexpr int BM = 256, BK = 64, HALF = 128, HTB = HALF * BK * 2, NXCD = 8, WGM = 8;
__host__ __device__ __forceinline__ int lds_byte(int r, int c) { const int st = (r >> 4) * 2 + (c >> 5), rr = r & 15, cc = c & 31, ob = rr * 64 + cc * 2; return st * 1024 + (ob ^ (((ob >> 9) & 1) << 5)); }
__host__ __device__ __forceinline__ void stage_rc(int b, int& R, int& C) { const int st = b / 1024, sb = b % 1024, swz = sb ^ (((sb >> 9) & 1) << 5); R = (st >> 1) * 16 + swz / 64; C = (st & 1) * 32 + (swz % 64) / 2; }
__host__ __device__ __forceinline__ int perm32(int rho) { const int n = rho >> 4, i = rho & 15; return 8 * (i >> 2) + 4 * n + (i & 3); }

struct Unit { int pm, pn, be, rl, nv; };
struct Gemm { const bf16_t* A; const bf16_t* Bt; int K; size_t bstride; const unsigned* list; };

__device__ __forceinline__ int xcd_remap(int wgid, int nwg) { const int q = nwg / NXCD, r = nwg % NXCD, xcd = wgid % NXCD, off = wgid / NXCD; return (xcd < r ? xcd * (q + 1) : r * (q + 1) + (xcd - r) * q) + off; }
struct DenseOrder {
    int nM, nN, nwg, G, c;
    __device__ void init(int M, int N, int G_, int c_) { nM = M / BM; nN = N / BM; nwg = nM * nN; G = G_; c = c_; }
    __device__ bool next(int i, Unit& u) const {
        const long L = (long)i * G + c; if (L >= nwg) return false;
        const int wgid = xcd_remap((int)L, nwg);
        const int nig = WGM * nN, gid = wgid / nig, fm = gid * WGM, gsz = (nM - fm) < WGM ? (nM - fm) : WGM;
        u.pm = fm + ((wgid % nig) % gsz); u.pn = (wgid % nig) / gsz; u.be = 0; u.rl = 0; u.nv = 256; return true;
    }
};
struct MoeOrder {
    const LAS int* tab; int nwg, G, c;
    __device__ static int rd(const LAS int* p) { return __builtin_amdgcn_readfirstlane(*p); }
    __device__ void init(const LAS int* tab_, int G_, int c_) { tab = tab_; nwg = rd(tab_ + 16) * 4; G = G_; c = c_; }
    __device__ bool next(int i, Unit& u) const {
        const long L = (long)i * G + c; if (L >= nwg) return false;
        const int wgid = xcd_remap((int)L, nwg);
        const int tile = wgid >> 2; int e = 0;
        for (int k = 1; k < NE; ++k) e += (rd(tab + k) <= tile) ? 1 : 0;
        u.pm = tile; u.pn = wgid & 3; u.be = e; u.rl = tile - rd(tab + e); const int rem = rd(tab + 32 + e) - u.rl * 256; u.nv = rem < 256 ? rem : 256; return true;
    }
};

#define ACC_T f32x4 (&acc)[2][2][4][2]

template <class Epi, class Sched, bool GATHER>
__device__ __forceinline__ void gemm_phase_ref(int tid, const Gemm g, const Sched& S, const Epi& E) {
    const int wid = __builtin_amdgcn_readfirstlane(tid >> 6), lane = tid & 63, wr = wid >> 2, wc = wid & 3, fr = lane & 15, fq = lane >> 4;
    const int K = g.K; Unit u;
    for (int ui = 0; S.next(ui, u); ++ui) {
        f32x4 acc[2][2][4][2];
#pragma unroll
        for (int a = 0; a < 2; ++a)
#pragma unroll
            for (int b = 0; b < 2; ++b)
#pragma unroll
                for (int m = 0; m < 4; ++m)
#pragma unroll
                    for (int n = 0; n < 2; ++n) acc[a][b][m][n] = (f32x4){0.f, 0.f, 0.f, 0.f};
        const bf16_t* Bt = g.Bt + (size_t)u.be * g.bstride + (size_t)u.pn * 256 * K;
        for (int ai = 0; ai < 2; ++ai)
            for (int m = 0; m < 4; ++m) {
                const int rloc = ai * 128 + wr * 64 + m * 16 + fr;
                size_t arow;
                if (GATHER) { arow = (rloc < u.nv) ? (size_t)(g.list[(size_t)u.be * T + u.rl * 256 + rloc] >> 1) : 0; }
                else arow = (size_t)u.pm * 256 + rloc;
                const bf16_t* ap = g.A + arow * K;
                for (int bj = 0; bj < 2; ++bj) {
                    const bf16_t* bp = Bt + (size_t)(bj * 128 + wc * 32 + fq * 8) * K;
                    float s[8];
#pragma unroll
                    for (int c = 0; c < 8; ++c) {
                        float sc = 0.f; const bf16_t* bpc = bp + (size_t)c * K;
#pragma unroll 2
                        for (int k = 0; k < K; k += 8) {
                            f32x4 a0, a1, b0, b1; unpack8(*(const u32x4*)(ap + k), a0, a1); unpack8(*(const u32x4*)(bpc + k), b0, b1);
                            sc += a0[0] * b0[0] + a0[1] * b0[1] + a0[2] * b0[2] + a0[3] * b0[3] + a1[0] * b1[0] + a1[1] * b1[1] + a1[2] * b1[2] + a1[3] * b1[3];
                        }
                        s[c] = sc; asm volatile("" : "+v"(s[c]));
                    }
#pragma unroll
                    for (int a2 = 0; a2 < 2; ++a2)
#pragma unroll
                        for (int b2 = 0; b2 < 2; ++b2)
#pragma unroll
                            for (int m2 = 0; m2 < 4; ++m2)
                                if (a2 == ai && b2 == bj && m2 == m) { acc[a2][b2][m2][0] = (f32x4){s[0], s[1], s[2], s[3]}; acc[a2][b2][m2][1] = (f32x4){s[4], s[5], s[6], s[7]}; }
                }
            }
        E(acc, u, wr, wc, fr, fq);
    }
}

#if FAST_GEMM
template <class Epi, class Sched, bool GATHER>
__device__ __forceinline__ void gemm_phase_fast(int tid, LAS unsigned char* lds, const Gemm g, const Sched& S, const Epi& E) {
    const int wid = __builtin_amdgcn_readfirstlane(tid >> 6), lane = tid & 63, wr = wid >> 2, wc = wid & 3, fr = lane & 15, fq = lane >> 4;
    const int K = g.K, nt = K / BK;
    int Rr[2], Cc[2]; unsigned voffB[2];
#pragma unroll
    for (int i = 0; i < 2; ++i) { stage_rc(tid * 16 + i * 8192, Rr[i], Cc[i]); const int Rb = (Rr[i] & ~31) + perm32(Rr[i] & 31); voffB[i] = (unsigned)(Rb * K + Cc[i]) * 2u; }
    const size_t kstep = (size_t)(BK * 2), hstep = (size_t)HALF * K * 2, tstep = 2 * hstep;
    const unsigned ldsw = (unsigned)wid * 1024u;
    const int aoff = lds_byte(wr * 64 + fr, fq * 8), boff = lds_byte(wc * 32 + fr, fq * 8);
#define GP_SA(b, h) (((b) * 2 + (h)) * HTB)
#define GP_SB(b, h) ((4 + (b) * 2 + (h)) * HTB)
#define GP_STAGE2(bufoff, gbase, v0, v1) do { \
        __builtin_amdgcn_global_load_lds((const unsigned*)((const char*)(gbase) + (v0)), (LAS unsigned*)(lds + (bufoff) + ldsw), 16, 0, 0); \
        __builtin_amdgcn_global_load_lds((const unsigned*)((const char*)(gbase) + (v1)), (LAS unsigned*)(lds + (bufoff) + ldsw + 8192), 16, 0, 0); } while (0)
#define GP_STAGEB(bufoff, gbase) GP_STAGE2(bufoff, gbase, voffB[0], voffB[1])
#define GP_LDA(dst, b, h) do { _Pragma("unroll") for (int m = 0; m < 4; ++m) _Pragma("unroll") for (int k = 0; k < 2; ++k) dst[m][k] = *(const LAS bf16x8*)(lds + GP_SA(b, h) + aoff + m * 2048 + k * 1024); } while (0)
#define GP_LDB(dst, b, h) do { _Pragma("unroll") for (int n = 0; n < 2; ++n) _Pragma("unroll") for (int k = 0; k < 2; ++k) dst[n][k] = *(const LAS bf16x8*)(lds + GP_SB(b, h) + boff + n * 2048 + k * 1024); } while (0)
#define GP_MMA(ai, bj, At, Bt) do { __builtin_amdgcn_s_setprio(1); _Pragma("unroll") for (int m = 0; m < 4; ++m) _Pragma("unroll") for (int n = 0; n < 2; ++n) _Pragma("unroll") for (int k = 0; k < 2; ++k) \
        acc[ai][bj][m][n] = __builtin_amdgcn_mfma_f32_16x16x32_bf16(Bt[n][k], At[m][k], acc[ai][bj][m][n], 0, 0, 0); __builtin_amdgcn_s_setprio(0); } while (0)
#define GP_WAIT_V(n) asm volatile("s_waitcnt vmcnt(" #n ")" ::: "memory")
#define GP_WAIT_L(n) asm volatile("s_waitcnt lgkmcnt(" #n ")" ::: "memory")
#define GP_BAR __builtin_amdgcn_s_barrier()
#define GP_SCHED __builtin_amdgcn_sched_barrier(0)
    Unit cur, nxt; int ui = 0;
    if (!S.next(0, cur)) return;
    f32x4 acc[2][2][4][2];
#pragma unroll
    for (int a = 0; a < 2; ++a)
#pragma unroll
        for (int b = 0; b < 2; ++b)
#pragma unroll
            for (int m = 0; m < 4; ++m)
#pragma unroll
                for (int n = 0; n < 2; ++n) acc[a][b][m][n] = (f32x4){0.f, 0.f, 0.f, 0.f};
    bf16x8 At[4][2], B0[2][2], B1[2][2];
    unsigned vC0, vC1, vC2, vC3, vN0, vN1, vN2, vN3;
#define GP_VOFF(u, o0, o1, o2, o3) do { if (GATHER) { \
        int tl_ = tid; LAUNDER_V(tl_); int R0_, C0_, R1_, C1_; stage_rc(tl_ * 16, R0_, C0_); stage_rc(tl_ * 16 + 8192, R1_, C1_);     \
        const unsigned* lp = g.list + (size_t)(u).be * T + (u).rl * 256; \
        const int nvm = (u).nv - 1; const int p0 = min(R0_, nvm), p1 = min(R1_, nvm), p2 = min(128 + R0_, nvm), p3 = min(128 + R1_, nvm); \
        const unsigned t0 = lp[p0] >> 1, t1 = lp[p1] >> 1, t2 = lp[p2] >> 1, t3 = lp[p3] >> 1; \
        o0 = (t0 * K + C0_) * 2u; o1 = (t1 * K + C1_) * 2u; o2 = (t2 * K + C0_) * 2u; o3 = (t3 * K + C1_) * 2u; \
      } else { o0 = (unsigned)(Rr[0] * K + Cc[0]) * 2u; o1 = (unsigned)(Rr[1] * K + Cc[1]) * 2u; o2 = o0 + (unsigned)hstep; o3 = o1 + (unsigned)hstep; } } while (0)
    GP_VOFF(cur, vC0, vC1, vC2, vC3);
    const char* cA = (const char*)g.A + (GATHER ? (size_t)0 : (size_t)cur.pm * tstep);
    const char* cB = (const char*)g.Bt + ((size_t)cur.be * g.bstride) * 2 + (size_t)cur.pn * tstep;
    GP_STAGEB(GP_SB(0, 0), cB); GP_STAGEB(GP_SB(0, 1), cB + hstep); GP_STAGE2(GP_SA(0, 0), cA, vC0, vC1); GP_STAGE2(GP_SA(0, 1), cA, vC2, vC3);
    if (wr == 1) GP_BAR;
    GP_WAIT_V(2); GP_BAR;
    GP_STAGEB(GP_SB(1, 0), cB + kstep); GP_STAGE2(GP_SA(1, 0), cA + kstep, vC0, vC1); GP_STAGEB(GP_SB(1, 1), cB + hstep + kstep);
    GP_WAIT_V(6); GP_BAR;
    for (;;) {
        const bool has_next = S.next(ui + 1, nxt);
        const char* nA = has_next ? (const char*)g.A + (GATHER ? (size_t)0 : (size_t)nxt.pm * tstep) : cA;
        const char* nB = has_next ? (const char*)g.Bt + ((size_t)nxt.be * g.bstride) * 2 + (size_t)nxt.pn * tstep : cB;
        if (has_next) { GP_VOFF(nxt, vN0, vN1, vN2, vN3); } else { vN0 = vC0; vN1 = vC1; vN2 = vC2; vN3 = vC3; }
#pragma nounroll
        for (int t = 0; t < nt; t += 2) {
            const bool last = (t == nt - 2);
            const char* a1 = cA + (size_t)(t + 1) * kstep;
            const char* a2 = last ? nA : cA + (size_t)(t + 2) * kstep; const char* b2 = last ? nB : cB + (size_t)(t + 2) * kstep;
            const char* a3 = a2 + kstep; const char* b3 = b2 + kstep;
            const unsigned w0 = last ? vN0 : vC0, w1 = last ? vN1 : vC1, w2 = last ? vN2 : vC2, w3 = last ? vN3 : vC3;
            GP_LDB(B0, 0, 0); GP_LDB(B1, 0, 1); GP_SCHED; GP_LDA(At, 0, 0); GP_STAGE2(GP_SA(1, 1), a1, vC2, vC3);
            GP_WAIT_V(8); GP_WAIT_L(0); GP_BAR; GP_MMA(0, 0, At, B0); GP_MMA(0, 1, At, B1); GP_BAR; GP_SCHED;
            GP_LDA(At, 0, 1); GP_STAGEB(GP_SB(0, 0), b2); GP_STAGEB(GP_SB(0, 1), b2 + hstep); GP_STAGE2(GP_SA(0, 0), a2, w0, w1);
            GP_WAIT_V(8); GP_WAIT_L(0); GP_BAR; GP_MMA(1, 0, At, B0); GP_MMA(1, 1, At, B1); GP_BAR; GP_SCHED;
            GP_LDB(B0, 1, 0); GP_LDB(B1, 1, 1); GP_SCHED; GP_LDA(At, 1, 0); GP_STAGE2(GP_SA(0, 1), a2, w2, w3);
            GP_WAIT_V(8); GP_WAIT_L(0); GP_BAR; GP_MMA(0, 0, At, B0); GP_MMA(0, 1, At, B1); GP_BAR; GP_SCHED;
            GP_LDA(At, 1, 1); GP_STAGEB(GP_SB(1, 0), b3); GP_STAGEB(GP_SB(1, 1), b3 + hstep); GP_STAGE2(GP_SA(1, 0), a3, w0, w1);
            GP_WAIT_V(8); GP_WAIT_L(0); GP_BAR; GP_MMA(1, 0, At, B0); GP_MMA(1, 1, At, B1); GP_BAR; GP_SCHED;
        }
        if (wr == 0) GP_BAR;
        E(acc, cur, wr, wc, fr, fq);
        if (!has_next) break;
#pragma unroll
        for (int a = 0; a < 2; ++a)
#pragma unroll
            for (int b = 0; b < 2; ++b)
#pragma unroll
                for (int m = 0; m < 4; ++m)
#pragma unroll
                    for (int n = 0; n < 2; ++n) acc[a][b][m][n] = (f32x4){0.f, 0.f, 0.f, 0.f};
        cur = nxt; cA = nA; cB = nB; vC0 = vN0; vC1 = vN1; vC2 = vN2; vC3 = vN3; ++ui;
        if (wr == 1) GP_BAR;
    }
    GP_WAIT_V(0);
    GP_BAR;
#undef GP_SA
#undef GP_SB
#undef GP_STAGE2
#undef GP_STAGEB
#undef GP_LDA
#undef GP_LDB
#undef GP_MMA
#undef GP_WAIT_V
#undef GP_WAIT_L
#undef GP_BAR
#undef GP_SCHED
#undef GP_VOFF
}
#endif

template <class Epi, class Sched, bool GATHER = false>
__device__ __forceinline__ void gemm_phase(int tid, LAS unsigned char* lds, const Gemm g, const Sched& S, const Epi& E) {
#if FAST_GEMM
    gemm_phase_fast<Epi, Sched, GATHER>(tid, lds, g, S, E);
#else
    (void)lds; gemm_phase_ref<Epi, Sched, GATHER>(tid, g, S, E);
#endif
}

#define EPI_ROW(ai, m) (u.pm * 256 + (ai) * 128 + wr * 64 + (m) * 16 + fr)
#define EPI_COL(bj) (u.pn * 256 + (bj) * 128 + wc * 32 + fq * 8)
__device__ __forceinline__ float dot4(f32x4 a) { return (a[0] * a[0] + a[1] * a[1]) + (a[2] * a[2] + a[3] * a[3]); }

struct EpiNull {
    __device__ __forceinline__ void operator()(const ACC_T, const Unit& u, int wr, int wc, int fr, int fq) const {
#pragma unroll
        for (int ai = 0; ai < 2; ++ai)
#pragma unroll
            for (int bj = 0; bj < 2; ++bj)
#pragma unroll
                for (int m = 0; m < 4; ++m) asm volatile("" :: "v"(acc[ai][bj][m][0]), "v"(acc[ai][bj][m][1]));
    }
};
struct EpiIn {
    bf16_t *QA, *KA, *VA, *QLAT, *KVLAT, *KB, *SA, *SB; float *SSQ, *SSKV; const float *gq, *gk, *cosA, *sinA, *cosB, *sinB;
    __device__ __forceinline__ void operator()(const ACC_T, const Unit& u, int wr, int wc, int fr, int fq) const {
        const int wb = u.pn * 4 + wc;
        if (wb < 10) {
            const bool isq = wb < 8; const int head = isq ? wb : wb - 8; const float* g = isq ? gq : gk; bf16_t* dst = isq ? QA : KA; const int dp = isq ? 512 : 128; const float qs = isq ? QSCALE_A : 1.f;
            const f32x4 g00 = *(const f32x4*)(g + 8 * fq), g01 = *(const f32x4*)(g + 8 * fq + 4), g10 = *(const f32x4*)(g + 32 + 8 * fq), g11 = *(const f32x4*)(g + 36 + 8 * fq);
#pragma unroll
            for (int ai = 0; ai < 2; ++ai)
#pragma unroll
                for (int m = 0; m < 4; ++m) {
                    const int r = EPI_ROW(ai, m), pos = r & (S - 1);
                    const f32x4 v00 = acc[ai][0][m][0], v01 = acc[ai][0][m][1], v10 = acc[ai][1][m][0], v11 = acc[ai][1][m][1];
                    float ss = (dot4(v00) + dot4(v01)) + (dot4(v10) + dot4(v11)); ss += __shfl_xor(ss, 16); ss += __shfl_xor(ss, 32);
                    const float rstd = rsqrtf(ss * (1.f / 64.f) + EPS);
                    const f32x4 y00 = v00 * rstd * g00, y01 = v01 * rstd * g01, y10 = v10 * rstd * g10, y11 = v11 * rstd * g11;
                    const f32x4 c0 = *(const f32x4*)(cosA + pos * 32 + 8 * fq), c1 = *(const f32x4*)(cosA + pos * 32 + 8 * fq + 4), s0 = *(const f32x4*)(sinA + pos * 32 + 8 * fq), s1 = *(const f32x4*)(sinA + pos * 32 + 8 * fq + 4);
                    const f32x4 o00 = (y00 * c0 - y10 * s0) * qs, o01 = (y01 * c1 - y11 * s1) * qs, o10 = (y10 * c0 + y00 * s0) * qs, o11 = (y11 * c1 + y01 * s1) * qs;
                    bf16_t* p = dst + (size_t)r * dp + head * 64 + 8 * fq;
                    *(u32x4*)p = pack8(o00, o01); *(u32x4*)(p + 32) = pack8(o10, o11);
                }
        } else if (wb < 12) {
#pragma unroll
            for (int ai = 0; ai < 2; ++ai)
#pragma unroll
                for (int m = 0; m < 4; ++m) { bf16_t* p = VA + (size_t)EPI_ROW(ai, m) * 128 + (wb - 10) * 64 + 8 * fq;
                    *(u32x4*)p = pack8(acc[ai][0][m][0], acc[ai][0][m][1]); *(u32x4*)(p + 32) = pack8(acc[ai][1][m][0], acc[ai][1][m][1]); }
        } else if (wb < 22) {
            const bool isq = wb < 18; const int idx = isq ? wb - 12 : wb - 18; bf16_t* dst = isq ? QLAT : KVLAT; const int dp = isq ? 384 : 256;
#pragma unroll
            for (int ai = 0; ai < 2; ++ai)
#pragma unroll
                for (int m = 0; m < 4; ++m) {
                    const int r = EPI_ROW(ai, m);
                    const f32x4 v00 = acc[ai][0][m][0], v01 = acc[ai][0][m][1], v10 = acc[ai][1][m][0], v11 = acc[ai][1][m][1];
                    float ss = (dot4(v00) + dot4(v01)) + (dot4(v10) + dot4(v11)); ss += __shfl_xor(ss, 16); ss += __shfl_xor(ss, 32);
                    if (fq == 0) { if (isq) SSQ[(size_t)r * 8 + idx] = ss; else SSKV[(size_t)r * 4 + idx] = ss; }
                    bf16_t* p = dst + (size_t)r * dp + idx * 64 + 8 * fq;
                    *(u32x4*)p = pack8(v00, v01); *(u32x4*)(p + 32) = pack8(v10, v11);
                }
        } else if (wb == 22) {
            if (fq < 2) {
#pragma unroll
                for (int ai = 0; ai < 2; ++ai)
#pragma unroll
                    for (int m = 0; m < 4; ++m) {
                        const int r = EPI_ROW(ai, m), pos = r & (S - 1);
                        const f32x4 x10 = acc[ai][0][m][0], x11 = acc[ai][0][m][1], x20 = acc[ai][1][m][0], x21 = acc[ai][1][m][1];
                        const f32x4 c0 = *(const f32x4*)(cosB + pos * 16 + 8 * fq), c1 = *(const f32x4*)(cosB + pos * 16 + 8 * fq + 4), s0 = *(const f32x4*)(sinB + pos * 16 + 8 * fq), s1 = *(const f32x4*)(sinB + pos * 16 + 8 * fq + 4);
                        const u32x4 w1 = pack8(x10 * c0 - x20 * s0, x11 * c1 - x21 * s1), w2 = pack8(x20 * c0 + x10 * s0, x21 * c1 + x11 * s1);
                        bf16_t* p = KB + (size_t)r * 768 + 64 + 8 * fq;
#pragma unroll
                        for (int h = 0; h < 8; ++h) { *(u32x4*)(p + h * 96) = w1; *(u32x4*)(p + h * 96 + 16) = w2; }
                    }
            }
        } else if (wb == 23) {
        } else {
            const bool isa = wb < 40; const int idx = isa ? wb - 24 : wb - 40; bf16_t* dst = isa ? SA : SB;
#pragma unroll
            for (int ai = 0; ai < 2; ++ai)
#pragma unroll
                for (int m = 0; m < 4; ++m) { bf16_t* p = dst + (size_t)EPI_ROW(ai, m) * 1024 + idx * 64 + 8 * fq;
#pragma unroll
                    for (int bj = 0; bj < 2; ++bj) { f32x4 a = acc[ai][bj][m][0], b = acc[ai][bj][m][1];
#pragma unroll
                        for (int j = 0; j < 4; ++j) { a[j] = sigm(a[j]); b[j] = sigm(b[j]); }
                        *(u32x4*)(p + bj * 32) = pack8(a, b); } }
        }
    }
};
__host__ __device__ __forceinline__ int src_col_in(int n) {
    const int pn = n >> 8, nl = n & 255, bj = nl >> 7, wc = (nl & 127) >> 5, p = nl & 31, wb = pn * 4 + wc, s = bj * 32 + p;
    if (wb < 8) return wb * 64 + s;
    if (wb < 10) return 512 + (wb - 8) * 64 + s;
    if (wb < 12) return 640 + (wb - 10) * 64 + s;
    if (wb < 18) return 768 + (wb - 12) * 64 + s;
    if (wb < 22) return 1152 + (wb - 18) * 64 + s;
    if (wb == 22) return p < 16 ? 1408 + bj * 16 + p : -1;
    if (wb == 23) return -1;
    if (wb < 40) return 1440 + (wb - 24) * 64 + s;
    return 2464 + (wb - 40) * 64 + s;
}
struct EpiQb {
    bf16_t* QB; const float *SSQ, *cosB, *sinB;
    __device__ __forceinline__ void operator()(const ACC_T, const Unit& u, int wr, int wc, int fr, int fq) const {
#pragma unroll
        for (int ai = 0; ai < 2; ++ai)
#pragma unroll
            for (int m = 0; m < 4; ++m) {
                const int r = EPI_ROW(ai, m), pos = r & (S - 1);
                const f32x4 sa = *(const f32x4*)(SSQ + (size_t)r * 8); const f32x2 sb = *(const f32x2*)(SSQ + (size_t)r * 8 + 4);
                const float rstd = rsqrtf((((sa[0] + sa[1]) + (sa[2] + sa[3])) + (sb[0] + sb[1])) * (1.f / 384.f) + EPS);
#pragma unroll
                for (int bj = 0; bj < 2; ++bj) {
                    f32x4 v0 = acc[ai][bj][m][0] * rstd, v1 = acc[ai][bj][m][1] * rstd;
                    const int c32 = u.pn * 8 + bj * 4 + wc;
                    if (c32 % 3 == 2) {
                        f32x4 o0, o1;
#pragma unroll
                        for (int j = 0; j < 4; ++j) { o0[j] = __shfl_xor(v0[j], 32); o1[j] = __shfl_xor(v1[j], 32); }
                        const int i0 = 8 * (fq & 1);
                        const f32x4 c0 = *(const f32x4*)(cosB + pos * 16 + i0), c1 = *(const f32x4*)(cosB + pos * 16 + i0 + 4), s0 = *(const f32x4*)(sinB + pos * 16 + i0), s1 = *(const f32x4*)(sinB + pos * 16 + i0 + 4);
                        if (fq < 2) { v0 = v0 * c0 - o0 * s0; v1 = v1 * c1 - o1 * s1; } else { v0 = v0 * c0 + o0 * s0; v1 = v1 * c1 + o1 * s1; }
                    }
                    *(u32x4*)(QB + (size_t)r * 768 + EPI_COL(bj)) = pack8(v0 * QSCALE_B, v1 * QSCALE_B);
                }
            }
    }
};
struct EpiKvb {
    bf16_t *KB, *VB; const float* SSKV;
    __device__ __forceinline__ void operator()(const ACC_T, const Unit& u, int wr, int wc, int fr, int fq) const {
#pragma unroll
        for (int ai = 0; ai < 2; ++ai)
#pragma unroll
            for (int m = 0; m < 4; ++m) {
                const int r = EPI_ROW(ai, m);
                const f32x4 sa = *(const f32x4*)(SSKV + (size_t)r * 4);
                const float rstd = rsqrtf(((sa[0] + sa[1]) + (sa[2] + sa[3])) * (1.f / 256.f) + EPS);
#pragma unroll
                for (int bj = 0; bj < 2; ++bj) {
                    const int head = u.pn * 2 + bj, o = wc * 32 + fq * 8;
                    const u32x4 w = pack8(acc[ai][bj][m][0] * rstd, acc[ai][bj][m][1] * rstd);
                    if (wc < 2) *(u32x4*)(KB + (size_t)r * 768 + head * 96 + o) = w; else *(u32x4*)(VB + (size_t)r * 512 + head * 64 + (o - 64)) = w;
                }
            }
    }
};
template <int MODE> struct EpiProj {
    bf16_t* O; const bf16_t* gate;
    __device__ __forceinline__ void operator()(const ACC_T, const Unit& u, int wr, int wc, int fr, int fq) const {
#pragma unroll
        for (int ai = 0; ai < 2; ++ai)
#pragma unroll
            for (int m = 0; m < 4; ++m) {
                const int r = EPI_ROW(ai, m);
#pragma unroll
                for (int bj = 0; bj < 2; ++bj) {
                    const size_t off = (size_t)r * D + EPI_COL(bj);
                    f32x4 g0, g1; unpack8(*(const u32x4*)(gate + off), g0, g1);
                    f32x4 v0 = acc[ai][bj][m][0] * g0, v1 = acc[ai][bj][m][1] * g1;
                    if (MODE == 1) { f32x4 p0, p1; unpack8(*(const u32x4*)(O + off), p0, p1); v0 += p0; v1 += p1; }
                    *(u32x4*)(O + off) = pack8(v0, v1);
                }
            }
    }
};
struct EpiWo {
    float* X; const float* modl; float* XO;
    __device__ __forceinline__ void operator()(const ACC_T, const Unit& u, int wr, int wc, int fr, int fq) const {
        const float* g1 = modl + (size_t)(u.pm >> 4) * 6 * D + 2 * D;
#pragma unroll
        for (int bj = 0; bj < 2; ++bj) {
            const int c = EPI_COL(bj); const f32x4 ga = *(const f32x4*)(g1 + c), gb = *(const f32x4*)(g1 + c + 4);
#pragma unroll
            for (int ai = 0; ai < 2; ++ai)
#pragma unroll
                for (int m = 0; m < 4; ++m) { float* p = X + (size_t)EPI_ROW(ai, m) * D + c;
                    const f32x4 x0 = *(const f32x4*)p, x1 = *(const f32x4*)(p + 4);
                    float* q = XO + (size_t)EPI_ROW(ai, m) * D + c; *(f32x4*)q = x0 + ga * acc[ai][bj][m][0]; *(f32x4*)(q + 4) = x1 + gb * acc[ai][bj][m][1]; }
        }
    }
};
struct EpiUp {
    bf16_t* ACT;
    __device__ __forceinline__ void operator()(const ACC_T, const Unit& u, int wr, int wc, int fr, int fq) const {
#pragma unroll
        for (int ai = 0; ai < 2; ++ai)
#pragma unroll
            for (int m = 0; m < 4; ++m) {
                f32x4 a = acc[ai][0][m][0], b = acc[ai][0][m][1]; const f32x4 c = acc[ai][1][m][0], d = acc[ai][1][m][1];
#pragma unroll
                for (int j = 0; j < 4; ++j) { a[j] = a[j] * sigm(a[j]) * c[j]; b[j] = b[j] * sigm(b[j]) * d[j]; }
                *(u32x4*)(ACT + (size_t)EPI_ROW(ai, m) * FF + u.pn * 128 + wc * 32 + fq * 8) = pack8(a, b);
            }
    }
};
struct EpiDown {
    bf16_t* Y2; const unsigned* list; const float* gw;
    __device__ __forceinline__ void operator()(const ACC_T, const Unit& u, int wr, int wc, int fr, int fq) const {
#pragma unroll
        for (int ai = 0; ai < 2; ++ai)
#pragma unroll
            for (int m = 0; m < 4; ++m) {
                const int rloc = ai * 128 + wr * 64 + m * 16 + fr;
                if (rloc < u.nv) {
                    const unsigned entry = list[(size_t)u.be * T + u.rl * 256 + rloc]; const float w = gw[entry];
#pragma unroll
                    for (int bj = 0; bj < 2; ++bj) *(u32x4*)(Y2 + (size_t)entry * D + EPI_COL(bj)) = pack8(acc[ai][bj][m][0] * w, acc[ai][bj][m][1] * w);
                }
            }
    }
};
}

namespace at {
struct Tensors { const bf16_t* Q; int qp; const bf16_t* K; int kp; const bf16_t* V; int vp; bf16_t* O; int op; int group; };
__device__ __forceinline__ bool next_unit(int i, int vcu, int G, int& bh, int& qb) {
    int u;
    if (G == 256) { if (i >= 4) return false; u = (vcu >> 5) * 128 + i * 32 + (vcu & 31); }
    else { u = i * G + vcu; if (u >= 1024) return false; }
    bh = u >> 4; qb = u & 15; return true;
}
template <int DQK>
__device__ __forceinline__ void attn_phase_ref(int tid, const Tensors& A, int vcu, int G) {
    int bh, qb;
    for (int i = 0; next_unit(i, vcu, G, bh, qb); ++i) {
        const int b = bh >> 3, h = bh & 7, kvh = h / A.group;
        {
            const int dh = tid >> 8;
            const size_t row = (size_t)b * S + qb * 256 + (tid & 255);
            float q[DQK], o[32];
#pragma unroll
            for (int d = 0; d < DQK; ++d) q[d] = bf2f(A.Q[row * A.qp + h * DQK + d]);
#pragma unroll
            for (int d = 0; d < 32; ++d) o[d] = 0.f;
            float l = 0.f;
            for (int k = 0; k < S; ++k) {
                const bf16_t* kr = A.K + ((size_t)b * S + k) * A.kp + kvh * DQK; const bf16_t* vr = A.V + ((size_t)b * S + k) * A.vp + kvh * 64 + dh * 32;
                float sc = 0.f;
#pragma unroll
                for (int d = 0; d < DQK; d += 8) { f32x4 k0, k1; unpack8(*(const u32x4*)(kr + d), k0, k1);
                    sc += q[d] * k0[0] + q[d + 1] * k0[1] + q[d + 2] * k0[2] + q[d + 3] * k0[3] + q[d + 4] * k1[0] + q[d + 5] * k1[1] + q[d + 6] * k1[2] + q[d + 7] * k1[3]; }
                const float p = bf2f(cvt_pk_bf16(exp2f(sc), 0.f) & 0xffffu); l += p;
#pragma unroll
                for (int d = 0; d < 32; d += 8) { f32x4 v0, v1; unpack8(*(const u32x4*)(vr + d), v0, v1);
                    o[d] += p * v0[0]; o[d + 1] += p * v0[1]; o[d + 2] += p * v0[2]; o[d + 3] += p * v0[3]; o[d + 4] += p * v1[0]; o[d + 5] += p * v1[1]; o[d + 6] += p * v1[2]; o[d + 7] += p * v1[3]; }
            }
            const float il = 1.f / l;
            __syncthreads();
#pragma unroll
            for (int d = 0; d < 32; d += 8) { f32x4 a = {o[d] * il, o[d + 1] * il, o[d + 2] * il, o[d + 3] * il}, c = {o[d + 4] * il, o[d + 5] * il, o[d + 6] * il, o[d + 7] * il};
                *(u32x4*)(A.O + row * A.op + h * 64 + dh * 32 + d) = pack8(a, c); }
        }
    }
}
#if FAST_ATTN
typedef short s16x4 __attribute__((ext_vector_type(4)));
__device__ __forceinline__ unsigned cvtpk(float lo, float hi) { f32x2 v = {lo, hi}; bf16x2_t b = __builtin_convertvector(v, bf16x2_t); return __builtin_bit_cast(unsigned, b); }
__device__ __forceinline__ s16x4 vtr(const LAS unsigned char* p) { return __builtin_bit_cast(s16x4, __builtin_amdgcn_ds_read_tr16_b64_v4i16((LAS s16x4*)p)); }
__device__ __forceinline__ int crow(int r, int hi) { return (r & 3) + 8 * (r >> 2) + 4 * hi; }
#define AT_BAR() asm volatile("s_barrier" ::: "memory")
#define AT_WAITBAR(N) asm volatile("s_waitcnt vmcnt(" #N ") lgkmcnt(0)\n\ts_barrier" ::: "memory")
#define AT_SCHED() __builtin_amdgcn_sched_barrier(0)
__device__ __forceinline__ void glds16(const void* gsrc, unsigned lds_dst) { unsigned keep;
    asm volatile("s_mov_b32 %0, m0\n\ts_mov_b32 m0, %2\n\ts_nop 0\n\tglobal_load_lds_dwordx4 %1, off\n\ts_mov_b32 m0, %0" : "=&s"(keep) : "v"(gsrc), "s"(lds_dst) : "memory"); }
#define AT_GLDS(g, l) glds16((const void*)(g), (unsigned)__builtin_amdgcn_readfirstlane((int)(unsigned)(uintptr_t)(l)))
template <int DQK>
__device__ __forceinline__ void attn_unit(int tid, LAS unsigned char* lds, const Tensors& A, int b, int h, int qb) {
    constexpr int ND = DQK / 16, NCH = DQK / 8, KSLOT = NCH * 1024, NKD = NCH > 8 ? 2 : 1, VSLOT = 8192, NT = S / 64;
    constexpr int KOFF = 0, VOFF = 3 * KSLOT, OST = VOFF + 3 * VSLOT, WSF = OST + 8 * 4096;
    static_assert(WSF + 8 * 256 <= RING_BYTES, "attention LDS");
    const int lane = tid & 63, r32 = lane & 31, hi = lane >> 5, wid = __builtin_amdgcn_readfirstlane(tid >> 6);
    const int kvh = h / A.group; const size_t rowb = (size_t)b * S;
    const bf16_t* ksrc = A.K + (rowb + lane) * A.kp + kvh * DQK + wid * 8;
    const bf16_t* ksrc2 = A.K + (rowb + lane) * A.kp + kvh * DQK + (8 + (wid & 3)) * 8;
    const bf16_t* vsrc = A.V + (rowb + 16 * (wid & 3) + (lane >> 2)) * A.vp + kvh * 64 + (wid >> 2) * 32 + (lane & 3) * 8;
    const size_t ktile = (size_t)64 * A.kp, vtile = (size_t)64 * A.vp;
    LAS unsigned char* kdst = lds + KOFF + wid * 1024; LAS unsigned char* kdst2 = lds + KOFF + (8 + (wid & 3)) * 1024; LAS unsigned char* vdst = lds + VOFF + wid * 1024;
#define DMA_K(j, so) do { AT_GLDS(ksrc + (size_t)(j) * ktile, kdst + (so)); if (NKD == 2) AT_GLDS(ksrc2 + (size_t)(j) * ktile, kdst2 + (so)); } while (0)
#define DMA_V(j, so) AT_GLDS(vsrc + (size_t)(j) * vtile, vdst + (so))
    const LAS unsigned char* kp0 = lds + KOFF + hi * 1024 + r32 * 16;
    const LAS unsigned char* vp0 = lds + VOFF + ((lane >> 4) & 1) * 32 + (lane & 3) * 8 + (4 * hi + ((lane & 15) >> 2)) * 64;
    DMA_K(0, 0); DMA_V(0, 0); DMA_K(1, KSLOT); DMA_V(1, VSLOT); DMA_K(2, 2 * KSLOT);
    const bf16_t* Qw = A.Q + (rowb + qb * 256 + wid * 32 + r32) * A.qp + h * DQK + hi * 8;
    bf16x8 qr[ND];
#pragma unroll
    for (int d0 = 0; d0 < ND; ++d0) qr[d0] = *(const bf16x8*)(Qw + d0 * 16);
    asm volatile("s_waitcnt vmcnt(0)\n\ts_barrier" ::: "memory");
    bf16x8 kf[2 * ND]; s16x4 vlo[8], vhi[8];
#define KLOAD(so) do { _Pragma("unroll") for (int d0 = 0; d0 < ND; ++d0) { kf[2 * d0] = *(const LAS bf16x8*)(kp0 + (so) + d0 * 2048); kf[2 * d0 + 1] = *(const LAS bf16x8*)(kp0 + (so) + d0 * 2048 + 512); } } while (0)
#define VLOAD(so) do { _Pragma("unroll") for (int i = 0; i < 8; ++i) { vlo[i] = vtr(vp0 + (so) + (i >> 2) * 4096 + (i & 3) * 1024); vhi[i] = vtr(vp0 + (so) + (i >> 2) * 4096 + (i & 3) * 1024 + 512); } } while (0)
#define VFR(i) (bf16x8){vlo[i][0], vlo[i][1], vlo[i][2], vlo[i][3], vhi[i][0], vhi[i][1], vhi[i][2], vhi[i][3]}
    KLOAD(0);
    asm volatile("s_waitcnt lgkmcnt(0)" ::: "memory");
    if (PROBE_ATT != 5 && wid >= 4) AT_BAR();
    f32x16 o0 = {}, o1 = {}, C0, C1; u32x4 pw0, pw1, pw2, pw3; float lsum = 0.f;
    const f32x16 zero = {};
#define QK_BLOCK() do { C0 = __builtin_amdgcn_mfma_f32_32x32x16_bf16(kf[0], qr[0], zero, 0, 0, 0); C1 = __builtin_amdgcn_mfma_f32_32x32x16_bf16(kf[1], qr[0], zero, 0, 0, 0); \
        _Pragma("unroll") for (int d0 = 1; d0 < ND; ++d0) { C0 = __builtin_amdgcn_mfma_f32_32x32x16_bf16(kf[2 * d0], qr[d0], C0, 0, 0, 0); C1 = __builtin_amdgcn_mfma_f32_32x32x16_bf16(kf[2 * d0 + 1], qr[d0], C1, 0, 0, 0); } } while (0)
#define PAF(k) __builtin_bit_cast(bf16x8, pw##k)
#define PV_BLOCK() do { \
        o0 = __builtin_amdgcn_mfma_f32_32x32x16_bf16(PAF(0), VFR(0), o0, 0, 0, 0); o1 = __builtin_amdgcn_mfma_f32_32x32x16_bf16(PAF(0), VFR(4), o1, 0, 0, 0); \
        o0 = __builtin_amdgcn_mfma_f32_32x32x16_bf16(PAF(1), VFR(1), o0, 0, 0, 0); o1 = __builtin_amdgcn_mfma_f32_32x32x16_bf16(PAF(1), VFR(5), o1, 0, 0, 0); \
        o0 = __builtin_amdgcn_mfma_f32_32x32x16_bf16(PAF(2), VFR(2), o0, 0, 0, 0); o1 = __builtin_amdgcn_mfma_f32_32x32x16_bf16(PAF(2), VFR(6), o1, 0, 0, 0); \
        o0 = __builtin_amdgcn_mfma_f32_32x32x16_bf16(PAF(3), VFR(3), o0, 0, 0, 0); o1 = __builtin_amdgcn_mfma_f32_32x32x16_bf16(PAF(3), VFR(7), o1, 0, 0, 0); } while (0)
#define SOFTMAX() do { \
        _Pragma("unroll") for (int r = 0; r < 16; ++r) { C0[r] = __builtin_amdgcn_exp2f(C0[r]); C1[r] = __builtin_amdgcn_exp2f(C1[r]); } \
        f32x2 s0_ = {C0[0], C0[1]}, s1_ = {C1[0], C1[1]}; _Pragma("unroll") for (int r = 2; r < 16; r += 2) { s0_ += (f32x2){C0[r], C0[r + 1]}; s1_ += (f32x2){C1[r], C1[r + 1]}; } s0_ += s1_; lsum += s0_[0] + s0_[1]; \
        pw0 = (u32x4){cvtpk(C0[0], C0[1]), cvtpk(C0[2], C0[3]), cvtpk(C0[4], C0[5]), cvtpk(C0[6], C0[7])}; pw1 = (u32x4){cvtpk(C0[8], C0[9]), cvtpk(C0[10], C0[11]), cvtpk(C0[12], C0[13]), cvtpk(C0[14], C0[15])}; \
        pw2 = (u32x4){cvtpk(C1[0], C1[1]), cvtpk(C1[2], C1[3]), cvtpk(C1[4], C1[5]), cvtpk(C1[6], C1[7])}; pw3 = (u32x4){cvtpk(C1[8], C1[9]), cvtpk(C1[10], C1[11]), cvtpk(C1[12], C1[13]), cvtpk(C1[14], C1[15])}; } while (0)
    int ka = 2 * KSLOT, kb = 0, kc = KSLOT, va = 2 * VSLOT, vb = 0, vc = VSLOT;
#define ROT() do { const int t_ = ka; ka = kb; kb = kc; kc = t_; const int u_ = va; va = vb; vb = vc; vc = u_; } while (0)
#define PINP() asm volatile("" : "+v"(lsum) : "v"(pw0), "v"(pw1), "v"(pw2), "v"(pw3))
#if ATT_REGSTAGE
    u32x4 kst = {}, kst2 = {}, vst = {};
    const LAS unsigned char* kw = lds + KOFF + wid * 1024 + lane * 16; const LAS unsigned char* kw2 = lds + KOFF + (8 + (wid & 3)) * 1024 + lane * 16; const LAS unsigned char* vw = lds + VOFF + wid * 1024 + lane * 16;
#define ST_WRITE(WK, WV) do { if (WK) { *(LAS u32x4*)(kw + ka) = kst; if (NKD == 2 && wid < 4) *(LAS u32x4*)(kw2 + ka) = kst2; } if (WV) *(LAS u32x4*)(vw + vc) = vst; } while (0)
#define ST_LOAD(sv, IK, IV) do { if (IK) { kst = *(const u32x4*)(ksrc + (size_t)((sv) + 4) * ktile); if (NKD == 2 && wid < 4) kst2 = *(const u32x4*)(ksrc2 + (size_t)((sv) + 4) * ktile); } if (IV) vst = *(const u32x4*)(vsrc + (size_t)((sv) + 3) * vtile); } while (0)
#define STEP(sv, DOQK, DOPV, KL, VL, IK, IV, WK, WV) do { \
        AT_SCHED(); if (DOQK) QK_BLOCK(); if (DOPV) PV_BLOCK(); AT_SCHED(); \
        asm volatile("s_barrier\n\ts_nop 15\n\ts_nop 3" : "+v"(C0), "+v"(C1), "+v"(o0), "+v"(o1) :: "memory"); AT_SCHED(); \
        if (KL) KLOAD(kc); if (VL) VLOAD(vb); ST_WRITE(WK, WV); ST_LOAD(sv, IK, IV); \
        if (DOQK) { SOFTMAX(); PINP(); } AT_SCHED(); \
        asm volatile("s_waitcnt lgkmcnt(0)\n\ts_barrier" ::: "memory"); \
        AT_SCHED(); ROT(); } while (0)
    STEP(-1, true, false, true, true, true, true, false, false);
#pragma nounroll
    for (int s = 0; s < NT - 4; ++s) STEP(s, true, true, true, true, true, true, true, true);
    STEP(NT - 4, true, true, true, true, false, true, true, true);
    STEP(NT - 3, true, true, true, true, false, false, false, true);
    STEP(NT - 2, true, true, false, true, false, false, false, false);
    STEP(NT - 1, false, true, false, false, false, false, false, false);
#undef ST_WRITE
#undef ST_LOAD
#else
#define STEP(sv, DOQK, DOPV, KL, VL, IK, IV) do { \
        AT_SCHED(); if (DOQK) QK_BLOCK(); if (DOPV) PV_BLOCK(); AT_SCHED(); \
          \
        asm volatile("s_barrier\n\ts_nop 15\n\ts_nop 3" : "+v"(C0), "+v"(C1), "+v"(o0), "+v"(o1) :: "memory"); AT_SCHED(); \
        if (KL) KLOAD(kc); if (VL) VLOAD(vb); if (IK) DMA_K((sv) + 4, kb); if (IV) DMA_V((sv) + 3, va); \
        if (DOQK) { SOFTMAX(); PINP(); } AT_SCHED(); \
        if (IK) { if (NKD == 2) { AT_WAITBAR(3); } else { AT_WAITBAR(2); } } else if (IV) { AT_WAITBAR(1); } else { AT_WAITBAR(0); } \
        AT_SCHED(); ROT(); } while (0)
    STEP(-1, true, false, true, true, true, true);
#pragma nounroll
    for (int s = 0; s < NT - 4; ++s) STEP(s, true, true, true, true, true, true);
    STEP(NT - 4, true, true, true, true, false, true);
    STEP(NT - 3, true, true, true, true, false, false);
    STEP(NT - 2, true, true, false, true, false, false);
    STEP(NT - 1, false, true, false, false, false, false);
#endif
#undef STEP
#undef PINP
    if (PROBE_ATT != 5 && wid < 4) AT_BAR();
    { auto rr = __builtin_amdgcn_permlane32_swap(__float_as_uint(lsum), __float_as_uint(lsum), false, false); lsum = __uint_as_float(rr[0]) + __uint_as_float(rr[1]); }
    LAS float* wsf = (LAS float*)(lds + WSF + wid * 256);
    if (hi == 0) wsf[r32] = lsum;
    asm volatile("s_waitcnt lgkmcnt(0)" ::: "memory");
    LAS bf16_t* stg = (LAS bf16_t*)(lds + OST + wid * 4096);
#pragma unroll
    for (int r = 0; r < 16; ++r) { const int orow = crow(r, hi); const float rl = __builtin_amdgcn_rcpf(wsf[orow]);
        stg[orow * 64 + r32] = (bf16_t)(cvtpk(o0[r] * rl, 0.f) & 0xffffu); stg[orow * 64 + 32 + r32] = (bf16_t)(cvtpk(o1[r] * rl, 0.f) & 0xffffu); }
    asm volatile("s_waitcnt lgkmcnt(0)" ::: "memory");
    bf16_t* Ow = A.O + (rowb + qb * 256 + wid * 32) * A.op + h * 64;
#pragma unroll
    for (int i = 0; i < 4; ++i) { const int row = i * 8 + (lane >> 3), ch = lane & 7; const u32x4 v = *(const LAS u32x4*)(stg + row * 64 + ch * 8); *(u32x4*)(Ow + (size_t)row * A.op + ch * 8) = v; }
    asm volatile("s_waitcnt lgkmcnt(0)\n\ts_barrier" ::: "memory");
#undef DMA_K
#undef DMA_V
#undef KLOAD
#undef VLOAD
#undef VFR
#undef QK_BLOCK
#undef PAF
#undef PV_BLOCK
#undef SOFTMAX
#undef ROT
}
#endif
template <int DQK>
__device__ __forceinline__ void attn_phase(int tid, LAS unsigned char* lds, const Tensors& A, int vcu, int G) {
#if FAST_ATTN
    int bh, qb;
    for (int i = 0; next_unit(i, vcu, G, bh, qb); ++i) attn_unit<DQK>(tid, lds, A, bh >> 3, bh & 7, qb);
#else
    (void)lds; attn_phase_ref<DQK>(tid, A, vcu, G);
#endif
}
}


struct Args { const float* in[22]; float* out; unsigned char* ws; int ph_lo, ph_hi; };
struct Frame {
    LAS unsigned char* lds; volatile LAS unsigned* MISC; unsigned* ctl;
    int tid, lane, wave, vcu, G;
    unsigned char* ws; float* X;
};

__device__ __forceinline__ void p0_phase(Frame& F, const float* c, const float* w_ada, const float* b_ada) {
    LAS float* cs = (LAS float*)F.lds;
    LAS float* red = (LAS float*)(F.lds + 32768);
    for (int i = F.tid; i < NB * D; i += NTHREADS) { const float v = c[i]; cs[i] = v / (1.f + __expf(-v)); }
    __syncthreads();
    float* mod = (float*)(F.ws + WS_MOD);
    const int kq = F.wave, col = F.lane;
    for (int item = F.vcu; item < NL * 6 * D / 64; item += F.G) {
        const int l = item / (6 * D / 64), n0 = (item % (6 * D / 64)) * 64;
        const float* w = w_ada + (size_t)l * D * 6 * D + n0 + col;
        float acc[NB];
#pragma unroll
        for (int b = 0; b < NB; ++b) acc[b] = 0.f;
#pragma unroll 8
        for (int k = kq * 128; k < kq * 128 + 128; ++k) { const float wv = w[(size_t)k * 6 * D];
#pragma unroll
            for (int b = 0; b < NB; ++b) acc[b] += cs[b * D + k] * wv; }
#pragma unroll
        for (int b = 0; b < NB; ++b) red[(kq * NB + b) * 64 + col] = acc[b];
        __syncthreads();
        { const int b = F.wave; float s = 0.f;
#pragma unroll
          for (int q = 0; q < 8; ++q) s += red[(q * NB + b) * 64 + col];
          mod[((size_t)l * NB + b) * 6 * D + n0 + col] = s + b_ada[(size_t)l * 6 * D + n0 + col]; }
        __syncthreads();
    }
    float* cosA = (float*)(F.ws + WS_COSA); float* sinA = (float*)(F.ws + WS_SINA); float* cosB = (float*)(F.ws + WS_COSB); float* sinB = (float*)(F.ws + WS_SINB);
    for (int idx = F.vcu * NTHREADS + F.tid; idx < S * 48; idx += F.G * NTHREADS) {
        const int s = idx / 48, i = idx % 48; const float row = (float)(s >> 6), col2 = (float)(s & 63);
        if (i < 32) { const int j = i & 15; const float a = (i < 16 ? row : col2) * (1.0f / powf(10000.0f, (float)j / 16.0f)); cosA[s * 32 + i] = cosf(a); sinA[s * 32 + i] = sinf(a); }
        else { const int ii = i - 32, j = ii & 7; const float a = (ii < 8 ? row : col2) * (1.0f / powf(10000.0f, (float)j / 8.0f)); cosB[s * 16 + ii] = cosf(a); sinB[s * 16 + ii] = sinf(a); }
    }
}

template <class SrcFn>
__device__ __forceinline__ void cvt_item(const float* W, int K, int Nsrc, const float* kg, bf16_t* WT, LAS float* scr, int item, int nblk, int lane, const SrcFn& src) {
    const int kb = item / nblk, nb = item % nblk, k0 = 64 * kb, n0 = 32 * nb;
    const int sc = src(n0 + (lane & 31));
#pragma unroll
    for (int i = 0; i < 32; ++i) { const int kk = 2 * i + (lane >> 5); float v = sc >= 0 ? W[(size_t)(k0 + kk) * Nsrc + sc] : 0.f; if (kg) v *= kg[k0 + kk]; scr[kk * 33 + (lane & 31)] = v; }
    LDS_WAIT(); asm volatile("" ::: "memory");
    const int c = lane & 7;
#pragma unroll
    for (int j = 0; j < 4; ++j) { const int n = (lane >> 3) + 8 * j; const LAS float* s = scr + (8 * c) * 33 + n;
        u32x4 o; o.x = cvt_pk_bf16(s[0 * 33], s[1 * 33]); o.y = cvt_pk_bf16(s[2 * 33], s[3 * 33]); o.z = cvt_pk_bf16(s[4 * 33], s[5 * 33]); o.w = cvt_pk_bf16(s[6 * 33], s[7 * 33]);
        *(u32x4*)(WT + (size_t)(n0 + n) * K + k0 + 8 * c) = o; }
    LDS_WAIT(); asm volatile("" ::: "memory");
}
struct SrcId { __device__ int operator()(int n) const { return n; } };
struct SrcIn { __device__ int operator()(int n) const { return gp::src_col_in(n); } };
typedef __attribute__((address_space(4))) const Args CArgsW;
__device__ __forceinline__ void convert_weights(Frame& F, CArgsW* a, int l) {
    LAS float* scr = (LAS float*)(F.lds + F.wave * 16384);
    const int gw = F.vcu * NWAVES + F.wave, NGW = F.G * NWAVES;
    const float* w_in = ((const float*)(GAS const float*)a->in[5]) + (size_t)l * D * INC; const float* w_q_b = ((const float*)(GAS const float*)a->in[10]) + (size_t)l * 384 * 768; const float* w_kv_b = ((const float*)(GAS const float*)a->in[11]) + (size_t)l * 256 * 1024;
    const float* w_pa = ((const float*)(GAS const float*)a->in[12]) + (size_t)l * 512 * D; const float* w_pb = ((const float*)(GAS const float*)a->in[13]) + (size_t)l * 512 * D; const float* w_o = ((const float*)(GAS const float*)a->in[14]) + (size_t)l * D * D;
    const float* w1 = ((const float*)(GAS const float*)a->in[18]) + (size_t)l * NE * D * FF; const float* w3 = ((const float*)(GAS const float*)a->in[19]) + (size_t)l * NE * D * FF; const float* w2 = ((const float*)(GAS const float*)a->in[20]) + (size_t)l * NE * FF * D;
    const float* gqa = ((const float*)(GAS const float*)a->in[8]) + l * 384; const float* gkv = ((const float*)(GAS const float*)a->in[9]) + l * 256;
    bf16_t* Win = (bf16_t*)(F.ws + WS_WIN); bf16_t* Wqb = (bf16_t*)(F.ws + WS_WQB); bf16_t* Wkvb = (bf16_t*)(F.ws + WS_WKVB); bf16_t* Wpa = (bf16_t*)(F.ws + WS_WPA); bf16_t* Wpb = (bf16_t*)(F.ws + WS_WPB);
    bf16_t* Wo = (bf16_t*)(F.ws + WS_WO); bf16_t* W13 = (bf16_t*)(F.ws + WS_W13); bf16_t* W2 = (bf16_t*)(F.ws + WS_W2);
    constexpr int I_IN = (D / 64) * (NIN / 32), I_QB = (384 / 64) * (768 / 32), I_KVB = (256 / 64) * (1024 / 32), I_P = (512 / 64) * (D / 32), I_O = (D / 64) * (D / 32);
    constexpr int I_13 = (D / 64) * (1024 / 32), I_2 = (FF / 64) * (D / 32);
    constexpr int NITEMS = I_IN + I_QB + I_KVB + 2 * I_P + I_O + NE * (I_13 + I_2);
    for (int it = gw; it < NITEMS; it += NGW) {
        int r = it;
        if (r < I_IN) { cvt_item(w_in, D, INC, nullptr, Win, scr, r, NIN / 32, F.lane, SrcIn()); continue; } r -= I_IN;
        if (r < I_QB) { cvt_item(w_q_b, 384, 768, gqa, Wqb, scr, r, 768 / 32, F.lane, SrcId()); continue; } r -= I_QB;
        if (r < I_KVB) { cvt_item(w_kv_b, 256, 1024, gkv, Wkvb, scr, r, 1024 / 32, F.lane, SrcId()); continue; } r -= I_KVB;
        if (r < I_P) { cvt_item(w_pa, 512, D, nullptr, Wpa, scr, r, D / 32, F.lane, SrcId()); continue; } r -= I_P;
        if (r < I_P) { cvt_item(w_pb, 512, D, nullptr, Wpb, scr, r, D / 32, F.lane, SrcId()); continue; } r -= I_P;
        if (r < I_O) { cvt_item(w_o, D, D, nullptr, Wo, scr, r, D / 32, F.lane, SrcId()); continue; } r -= I_O;
        if (r < NE * I_13) { const int e = r / I_13, q = r % I_13, nb = q % 32;
            const float* src = ((nb & 7) < 4 ? w1 : w3) + (size_t)e * D * FF; const int cb = (nb >> 3) * 128 + (nb & 3) * 32;
            struct SrcOff { int n0, cb; __device__ int operator()(int n) const { return cb + (n - n0); } } so{nb * 32, cb};
            cvt_item(src, D, FF, nullptr, W13 + (size_t)e * 1024 * D, scr, q, 32, F.lane, so); continue; } r -= NE * I_13;
        { const int e = r / I_2, q = r % I_2; cvt_item(w2 + (size_t)e * FF * D, FF, D, nullptr, W2 + (size_t)e * D * FF, scr, q, D / 32, F.lane, SrcId()); }
    }
}

template <int MODE>
__device__ __forceinline__ void row_phase(Frame& F, const float* xin, const float* g2prev, const float* gain, const float* modl, int sh_off, int sc_off, bf16_t* H, float* Xout) {
    constexpr int RB = 4;
    const int gw = F.vcu * NWAVES + F.wave, NGW = F.G * NWAVES;
    const bf16_t* Y2 = (const bf16_t*)(F.ws + WS_Y2);
    for (int m0 = gw; m0 < T; m0 += RB * NGW) {
        f32x4 v[RB][4]; float ss[RB];
        if (MODE == 0) {
#pragma unroll
            for (int r = 0; r < RB; ++r)
#pragma unroll
                for (int j = 0; j < 4; ++j) v[r][j] = *(const f32x4*)(xin + (size_t)(m0 + r * NGW) * D + 4 * F.lane + 256 * j);
        } else {
            u32x2 ya[RB][4], yb[RB][4]; f32x4 g[RB][4];
#pragma unroll
            for (int r = 0; r < RB; ++r)
#pragma unroll
                for (int j = 0; j < 4; ++j) { const int m = m0 + r * NGW, c = 4 * F.lane + 256 * j;
                    v[r][j] = *(const f32x4*)(F.X + (size_t)m * D + c); ya[r][j] = *(const u32x2*)(Y2 + (size_t)(2 * m) * D + c); yb[r][j] = *(const u32x2*)(Y2 + (size_t)(2 * m + 1) * D + c);
                    g[r][j] = *(const f32x4*)(g2prev + (size_t)(m >> 12) * 6 * D + 5 * D + c); }
#pragma unroll
            for (int r = 0; r < RB; ++r)
#pragma unroll
                for (int j = 0; j < 4; ++j) { f32x4 y; y[0] = bf2f(ya[r][j].x & 0xffffu) + bf2f(yb[r][j].x & 0xffffu); y[1] = bf2f(ya[r][j].x >> 16) + bf2f(yb[r][j].x >> 16); y[2] = bf2f(ya[r][j].y & 0xffffu) + bf2f(yb[r][j].y & 0xffffu); y[3] = bf2f(ya[r][j].y >> 16) + bf2f(yb[r][j].y >> 16);
                    v[r][j] += g[r][j] * y; }
        }
#pragma unroll
        for (int r = 0; r < RB; ++r) { ss[r] = (gp::dot4(v[r][0]) + gp::dot4(v[r][1])) + (gp::dot4(v[r][2]) + gp::dot4(v[r][3])); }
#pragma unroll
        for (int o = 1; o < 64; o <<= 1)
#pragma unroll
            for (int r = 0; r < RB; ++r) ss[r] += __shfl_xor(ss[r], o);
#pragma unroll
        for (int r = 0; r < RB; ++r) {
            const int m = m0 + r * NGW, b = m >> 12; const float rstd = rsqrtf(ss[r] * (1.f / D) + EPS);
#pragma unroll
            for (int j = 0; j < 4; ++j) {
                const int c = 4 * F.lane + 256 * j; const f32x4 gn = *(const f32x4*)(gain + c);
                if (MODE == 2) { *(f32x4*)(Xout + (size_t)m * D + c) = v[r][j] * rstd * gn; }
                else {
                    *(f32x4*)(Xout + (size_t)m * D + c) = v[r][j];
                    const f32x4 sc = *(const f32x4*)(modl + (size_t)b * 6 * D + sc_off + c), sh = *(const f32x4*)(modl + (size_t)b * 6 * D + sh_off + c);
                    const f32x4 hv = v[r][j] * rstd * gn * (1.f + sc) + sh;
                    u32x2 w; w.x = cvt_pk_bf16(hv[0], hv[1]); w.y = cvt_pk_bf16(hv[2], hv[3]);
                    *(u32x2*)(H + (size_t)m * D + c) = w;
                }
            }
        }
    }
}

__device__ __forceinline__ void t2_phase(Frame& F, const float* gain, const float* modl, const float* w_router, const float* rbias, int l, bool record) {
    LAS f32x4* wl = (LAS f32x4*)F.lds;
    LAS int* rec = (LAS int*)(F.lds + 65536);
    LAS float* recw = (LAS float*)(F.lds + 65536 + 2048);
    LAS int* lcnt = (LAS int*)(F.lds + 65536 + 4096);
    for (int idx = F.tid; idx < 4096; idx += NTHREADS) {
        const int lane = idx & 63, c = (idx >> 6) & 3, i = (idx >> 8) & 3, j = idx >> 10; const int k = 4 * lane + 256 * j + i;
        wl[idx] = *(const f32x4*)(w_router + (size_t)k * NE + 4 * c);
    }
    if (F.tid < 32) lcnt[F.tid] = 0;
    __syncthreads();
    constexpr int RB = 4;
    const int gw = F.vcu * NWAVES + F.wave, NGW = F.G * NWAVES;
    bf16_t* H = (bf16_t*)(F.ws + WS_H);
    const int lane = F.lane, myrow = lane >> 4, mye = lane & 15;
    int it = 0;
    for (int m0 = gw; m0 < T; m0 += RB * NGW, ++it) {
        f32x4 v[RB][4]; float ss[RB];
#pragma unroll
        for (int r = 0; r < RB; ++r)
#pragma unroll
            for (int j = 0; j < 4; ++j) v[r][j] = *(const f32x4*)(F.X + (size_t)(m0 + r * NGW) * D + 4 * lane + 256 * j);
#pragma unroll
        for (int r = 0; r < RB; ++r) ss[r] = (gp::dot4(v[r][0]) + gp::dot4(v[r][1])) + (gp::dot4(v[r][2]) + gp::dot4(v[r][3]));
#pragma unroll
        for (int o = 1; o < 64; o <<= 1)
#pragma unroll
            for (int r = 0; r < RB; ++r) ss[r] += __shfl_xor(ss[r], o);
        float acc[RB * NE];
#pragma unroll
        for (int q = 0; q < RB * NE; ++q) acc[q] = 0.f;
#pragma unroll
        for (int j = 0; j < 4; ++j) {
            const int c = 4 * lane + 256 * j; const f32x4 gn = *(const f32x4*)(gain + c);
#pragma unroll
            for (int r = 0; r < RB; ++r) {
                const int m = m0 + r * NGW, b = m >> 12; const float rstd = rsqrtf(ss[r] * (1.f / D) + EPS);
                const f32x4 sc = *(const f32x4*)(modl + (size_t)b * 6 * D + 4 * D + c), sh = *(const f32x4*)(modl + (size_t)b * 6 * D + 3 * D + c);
                v[r][j] = v[r][j] * rstd * gn * (1.f + sc) + sh;
                u32x2 w; w.x = cvt_pk_bf16(v[r][j][0], v[r][j][1]); w.y = cvt_pk_bf16(v[r][j][2], v[r][j][3]);
                *(u32x2*)(H + (size_t)m * D + c) = w;
            }
#pragma unroll
            for (int i = 0; i < 4; ++i)
#pragma unroll
                for (int c4 = 0; c4 < 4; ++c4) { const f32x4 wv = wl[((j * 4 + i) * 4 + c4) * 64 + lane];
#pragma unroll
                    for (int r = 0; r < RB; ++r) { const float hv = v[r][j][i];
                        acc[r * NE + 4 * c4 + 0] += hv * wv[0]; acc[r * NE + 4 * c4 + 1] += hv * wv[1]; acc[r * NE + 4 * c4 + 2] += hv * wv[2]; acc[r * NE + 4 * c4 + 3] += hv * wv[3]; } }
        }
#pragma unroll
        for (int sft = 32; sft >= 1; sft >>= 1) {
            const bool up = (lane & sft) != 0;
#pragma unroll
            for (int k = 0; k < sft; ++k) { const float a = acc[k], b = acc[k + sft]; const float keep = up ? b : a, send = up ? a : b; acc[k] = keep + __shfl_xor(send, sft); }
        }
        const float logit = acc[0];
        const float score = 1.f / (1.f + expf(-logit));
        float scv[NE], bi[NE];
#pragma unroll
        for (int e = 0; e < NE; ++e) { scv[e] = __shfl(score, (lane & 48) | e); bi[e] = scv[e] + rbias[e]; }
        int gsel = 0; float gbest = -INFINITY;
#pragma unroll
        for (int g = 0; g < 4; ++g) { float m1 = -INFINITY, m2 = -INFINITY;
#pragma unroll
            for (int j = 0; j < 4; ++j) { const float x = bi[g * 4 + j]; if (x > m1) { m2 = m1; m1 = x; } else if (x > m2) m2 = x; }
            const float gs = m1 + m2; if (gs > gbest) { gbest = gs; gsel = g; } }
        int e1 = -1, e2 = -1; float b1 = -INFINITY, b2 = -INFINITY, s1 = 0.f, s2 = 0.f;
#pragma unroll
        for (int j = 0; j < 4; ++j) { float x = -INFINITY, sx = 0.f;
#pragma unroll
            for (int g = 0; g < 4; ++g) if (g == gsel) { x = bi[g * 4 + j]; sx = scv[g * 4 + j]; }
            const int e = gsel * 4 + j;
            if (x > b1) { b2 = b1; e2 = e1; s2 = s1; b1 = x; e1 = e; s1 = sx; } else if (x > b2) { b2 = x; e2 = e; s2 = sx; } }
        if (mye == 0) {
            const float inv = 1.f / (s1 + s2); const int slot = (it * RB + myrow) * NWAVES + F.wave;
            rec[slot * 4 + 0] = e1; rec[slot * 4 + 1] = e2;
            rec[slot * 4 + 2] = __hip_atomic_fetch_add(&lcnt[e1], 1, __ATOMIC_RELAXED, __HIP_MEMORY_SCOPE_WORKGROUP);
            rec[slot * 4 + 3] = __hip_atomic_fetch_add(&lcnt[e2], 1, __ATOMIC_RELAXED, __HIP_MEMORY_SCOPE_WORKGROUP);
            recw[slot * 2 + 0] = s1 * inv; recw[slot * 2 + 1] = s2 * inv;
        }
    }
    __syncthreads();
    if (!record) return;
    if (F.tid < NE) lcnt[16 + F.tid] = (int)__hip_atomic_fetch_add(F.ctl + CW_CNT + (l * NE + F.tid) * 64, (unsigned)lcnt[F.tid], __ATOMIC_RELAXED, __HIP_MEMORY_SCOPE_AGENT);
    __syncthreads();
    unsigned* list = (unsigned*)(F.ws + WS_LIST); float* gwb = (float*)(F.ws + WS_GW);
    const int nrows = it * RB;
    for (int s = F.tid; s < nrows * NWAVES; s += NTHREADS) {
        const int i2 = s / NWAVES, w = s % NWAVES; const int m = F.vcu * NWAVES + w + i2 * NGW;
        const int e1 = rec[s * 4 + 0], e2 = rec[s * 4 + 1];
        list[(size_t)e1 * T + lcnt[16 + e1] + rec[s * 4 + 2]] = (unsigned)(2 * m); list[(size_t)e2 * T + lcnt[16 + e2] + rec[s * 4 + 3]] = (unsigned)(2 * m + 1);
        gwb[2 * m] = recw[s * 2]; gwb[2 * m + 1] = recw[s * 2 + 1];
    }
}
__device__ __forceinline__ const LAS int* moe_table(Frame& F, int l) {
    LAS int* tab = (LAS int*)(F.lds + MISC_OFF + 1024);
    __syncthreads();
    if (F.tid == 0) { int acc = 0;
        for (int e = 0; e < NE; ++e) { const int c = (int)__hip_atomic_load(F.ctl + CW_CNT + (l * NE + e) * 64, __ATOMIC_RELAXED, __HIP_MEMORY_SCOPE_AGENT); tab[e] = acc; tab[32 + e] = c; acc += (c + 255) >> 8; }
        tab[16] = acc; }
    __syncthreads();
    return tab;
}

typedef __attribute__((address_space(4))) const Args CArgs;
#define LAUNDER_GP(T_, p) do { GAS T_* _t = (GAS T_*)(p); asm volatile("" : "+s"(_t)); (p) = (T_*)_t; } while (0)
#define PH_BEGIN() LAUNDER_V(F.tid); F.lane = F.tid & 63; LAUNDER_GP(unsigned, F.ctl); LAUNDER_GP(float, F.X); LAUNDER_GP(unsigned char, F.ws); GAS unsigned char* ws = (GAS unsigned char*)F.ws; CArgs* ka = (CArgs*)__builtin_amdgcn_kernarg_segment_ptr(); LAUNDER_S(ka); \
    float* mod = WSP(float, WS_MOD); (void)mod; (void)ka
#define WSP(T_, off) ((T_*)(GAS T_*)(ws + (off)))
#define KIN(i) ((const float*)(GAS const float*)ka->in[i])
__global__ void __launch_bounds__(NTHREADS, 2) fwd_kernel(Args args) {
    extern __shared__ __attribute__((aligned(16))) unsigned char lds_raw[];
    Frame F;
    F.lds = (LAS unsigned char*)lds_raw; F.MISC = (volatile LAS unsigned*)(F.lds + MISC_OFF);
    F.tid = threadIdx.x; F.lane = F.tid & 63; F.wave = __builtin_amdgcn_readfirstlane(F.tid >> 6);
    F.G = gridDim.x; { const int bx = blockIdx.x; F.vcu = (F.G % 8 == 0) ? (bx % 8) * (F.G / 8) + bx / 8 : bx; }
    F.ws = (unsigned char*)(GAS unsigned char*)args.ws; F.ctl = (unsigned*)(GAS unsigned*)(args.ws + WS_CTL); F.X = (float*)(GAS float*)args.out;
    if (F.tid < 64) F.MISC[F.tid] = 0u;
    __syncthreads();
    XcdBarrier bar; bar.bar = F.ctl + CW_BAR; bar.x = 0; bar.st = nullptr;
    if (!N_LAUNCH_MODE) bar = xcd_barrier_post(F.ctl + CW_BAR, F.MISC + 8);
    const int lo = args.ph_lo, hi = args.ph_hi;
#define IN(k) (lo <= (k) && (k) < hi)
#define SEAM(k) do { if ((k) + 1 < hi) { if (!N_LAUNCH_MODE) xcd_barrier(bar); } } while (0)
    const int cidx = (int)blockIdx.x;

    if (IN(0)) { PH_BEGIN(); p0_phase(F, KIN(1), KIN(2), KIN(3)); SEAM(0); }
    for (int l = 0; l < NL; ++l) {
        const int pb = 1 + 9 * l;
        if (IN(pb + 0)) {
            PH_BEGIN();
            for (int rep = 0; rep < ((PROBE_DUP & 8) ? 2 : 1); ++rep) { LAUNDER_V(F.tid); F.lane = F.tid & 63; convert_weights(F, ka, l); }
            if (l == 0) row_phase<0>(F, KIN(0), nullptr, KIN(4) + l * D, mod + (size_t)l * NB * 6 * D, 0, D, WSP(bf16_t, WS_H), F.X);
            else { if (PROBE_DUP & 64) { row_phase<1>(F, nullptr, mod + (size_t)(l - 1) * NB * 6 * D, KIN(4) + l * D, mod + (size_t)l * NB * 6 * D, 0, D, WSP(bf16_t, WS_QA), WSP(float, WS_SA)); LAUNDER_V(F.tid); F.lane = F.tid & 63; }
                   row_phase<1>(F, nullptr, mod + (size_t)(l - 1) * NB * 6 * D, KIN(4) + l * D, mod + (size_t)l * NB * 6 * D, 0, D, WSP(bf16_t, WS_H), F.X); }
            SEAM(pb + 0);
        }
        if (IN(pb + 1)) {
            PH_BEGIN();
            gp::Gemm g{WSP(bf16_t, WS_H), WSP(const bf16_t, WS_WIN), D, 0, nullptr}; gp::DenseOrder So; So.init(T, NIN, F.G, cidx);
            gp::EpiIn E{WSP(bf16_t, WS_QA), WSP(bf16_t, WS_KA), WSP(bf16_t, WS_VA), WSP(bf16_t, WS_QLAT), WSP(bf16_t, WS_KVLAT), WSP(bf16_t, WS_KB), WSP(bf16_t, WS_SA), WSP(bf16_t, WS_SB), WSP(float, WS_SSQ), WSP(float, WS_SSKV),
                        KIN(6) + l * 64, KIN(7) + l * 64, WSP(const float, WS_COSA), WSP(const float, WS_SINA), WSP(const float, WS_COSB), WSP(const float, WS_SINB)};
            if (PROBE_DUP & 128) { gp::EpiNull En; gp::gemm_phase<gp::EpiNull, gp::DenseOrder>(F.tid, F.lds, g, So, En); LAUNDER_V(F.tid); }
            gp::gemm_phase<gp::EpiIn, gp::DenseOrder>(F.tid, F.lds, g, So, E); if (PROBE_DUP & (2 | 512)) { LAUNDER_V(F.tid); gp::gemm_phase<gp::EpiIn, gp::DenseOrder>(F.tid, F.lds, g, So, E); }
            SEAM(pb + 1);
        }
        if (IN(pb + 2)) {
            { PH_BEGIN(); gp::Gemm g{WSP(bf16_t, WS_QLAT), WSP(const bf16_t, WS_WQB), 384, 0, nullptr}; gp::DenseOrder So; So.init(T, 768, F.G, cidx);
              gp::EpiQb E{WSP(bf16_t, WS_QB), WSP(const float, WS_SSQ), WSP(const float, WS_COSB), WSP(const float, WS_SINB)}; gp::gemm_phase<gp::EpiQb, gp::DenseOrder>(F.tid, F.lds, g, So, E); if (PROBE_DUP & 2) { LAUNDER_V(F.tid); gp::gemm_phase<gp::EpiQb, gp::DenseOrder>(F.tid, F.lds, g, So, E); } }
            { PH_BEGIN(); gp::Gemm g{WSP(bf16_t, WS_KVLAT), WSP(const bf16_t, WS_WKVB), 256, 0, nullptr}; gp::DenseOrder So; So.init(T, 1024, F.G, F.G - 1 - cidx);
              gp::EpiKvb E{WSP(bf16_t, WS_KB), WSP(bf16_t, WS_VB), WSP(const float, WS_SSKV)}; gp::gemm_phase<gp::EpiKvb, gp::DenseOrder>(F.tid, F.lds, g, So, E); if (PROBE_DUP & 2) { LAUNDER_V(F.tid); gp::gemm_phase<gp::EpiKvb, gp::DenseOrder>(F.tid, F.lds, g, So, E); } }
            if (PROBE_DUP & 1) { PH_BEGIN(); const at::Tensors A{WSP(bf16_t, WS_QA), 512, WSP(bf16_t, WS_KA), 128, WSP(bf16_t, WS_VA), 128, WSP(bf16_t, WS_OB), 512, 4}; at::attn_phase<64>(F.tid, F.lds, A, F.vcu, F.G); }
            { PH_BEGIN(); const at::Tensors A{WSP(bf16_t, WS_QA), 512, WSP(bf16_t, WS_KA), 128, WSP(bf16_t, WS_VA), 128, WSP(bf16_t, WS_QA), 512, 4}; at::attn_phase<64>(F.tid, F.lds, A, F.vcu, F.G); }
            SEAM(pb + 2);
        }
        if (IN(pb + 3)) {
            PH_BEGIN();
            const at::Tensors A{WSP(bf16_t, WS_QB), 768, WSP(bf16_t, WS_KB), 768, WSP(bf16_t, WS_VB), 512, WSP(bf16_t, WS_OB), 512, 1}; for (int rep = 0; rep < ((PROBE_DUP & 1) ? 2 : 1); ++rep) at::attn_phase<96>(F.tid, F.lds, A, F.vcu, F.G);
            SEAM(pb + 3);
        }
        if (IN(pb + 4)) for (int rep3 = 0; rep3 < ((PROBE_DUP & (2 | 1024)) ? 2 : 1); ++rep3) {
            { PH_BEGIN(); gp::Gemm g{WSP(bf16_t, WS_QA), WSP(const bf16_t, WS_WPA), 512, 0, nullptr}; gp::DenseOrder So; So.init(T, D, F.G, cidx);
              gp::EpiProj<0> E{WSP(bf16_t, WS_H), WSP(const bf16_t, WS_SA)}; gp::gemm_phase<gp::EpiProj<0>, gp::DenseOrder>(F.tid, F.lds, g, So, E); }
            { PH_BEGIN(); gp::Gemm g{WSP(bf16_t, WS_OB), WSP(const bf16_t, WS_WPB), 512, 0, nullptr}; gp::DenseOrder So; So.init(T, D, F.G, cidx);
              gp::EpiProj<1> E{WSP(bf16_t, WS_H), WSP(const bf16_t, WS_SB)}; gp::gemm_phase<gp::EpiProj<1>, gp::DenseOrder>(F.tid, F.lds, g, So, E); }
            if (rep3 + 1 == ((PROBE_DUP & (2 | 1024)) ? 2 : 1)) SEAM(pb + 4);
        }
        if (IN(pb + 5)) {
            PH_BEGIN();
            gp::Gemm g{WSP(bf16_t, WS_H), WSP(const bf16_t, WS_WO), D, 0, nullptr}; gp::DenseOrder So; So.init(T, D, F.G, cidx);
            if (PROBE_DUP & 32) { gp::EpiWo E2{F.X, mod + (size_t)l * NB * 6 * D, WSP(float, WS_KB)}; gp::gemm_phase<gp::EpiWo, gp::DenseOrder>(F.tid, F.lds, g, So, E2); LAUNDER_V(F.tid); }
            gp::EpiWo E{F.X, mod + (size_t)l * NB * 6 * D, F.X}; gp::gemm_phase<gp::EpiWo, gp::DenseOrder>(F.tid, F.lds, g, So, E);
            SEAM(pb + 5);
        }
        if (IN(pb + 6)) {
            PH_BEGIN();
            if (PROBE_DUP & 16) { t2_phase(F, KIN(15) + l * D, mod + (size_t)l * NB * 6 * D, KIN(16), KIN(17), l, false); LAUNDER_V(F.tid); F.lane = F.tid & 63; __syncthreads(); }
            t2_phase(F, KIN(15) + l * D, mod + (size_t)l * NB * 6 * D, KIN(16), KIN(17), l, true);
            SEAM(pb + 6);
        }
        if (IN(pb + 7)) {
            PH_BEGIN();
            const LAS int* tab = moe_table(F, l);
            gp::Gemm g{WSP(bf16_t, WS_H), WSP(const bf16_t, WS_W13), D, (size_t)1024 * D, WSP(const unsigned, WS_LIST)}; gp::MoeOrder So; So.init(tab, F.G, cidx);
            if (PROBE_DUP & 256) { gp::EpiNull En; gp::gemm_phase<gp::EpiNull, gp::MoeOrder, true>(F.tid, F.lds, g, So, En); LAUNDER_V(F.tid); }
            gp::EpiUp E{WSP(bf16_t, WS_ACT)}; gp::gemm_phase<gp::EpiUp, gp::MoeOrder, true>(F.tid, F.lds, g, So, E); if (PROBE_DUP & 4) { LAUNDER_V(F.tid); gp::gemm_phase<gp::EpiUp, gp::MoeOrder, true>(F.tid, F.lds, g, So, E); }
            SEAM(pb + 7);
        }
        if (IN(pb + 8)) {
            PH_BEGIN();
            const LAS int* tab = moe_table(F, l);
            gp::Gemm g{WSP(bf16_t, WS_ACT), WSP(const bf16_t, WS_W2), FF, (size_t)D * FF, nullptr}; gp::MoeOrder So; So.init(tab, F.G, cidx);
            gp::EpiDown E{WSP(bf16_t, WS_Y2), WSP(const unsigned, WS_LIST), WSP(const float, WS_GW)}; gp::gemm_phase<gp::EpiDown, gp::MoeOrder, false>(F.tid, F.lds, g, So, E); if (PROBE_DUP & 4) { LAUNDER_V(F.tid); gp::gemm_phase<gp::EpiDown, gp::MoeOrder, false>(F.tid, F.lds, g, So, E); }
            SEAM(pb + 8);
        }
    }
    if (IN(NPHASE - 1)) { PH_BEGIN(); row_phase<2>(F, nullptr, mod + (size_t)(NL - 1) * NB * 6 * D, KIN(21), nullptr, 0, 0, nullptr, F.X); }
#undef IN
#undef SEAM
}

extern "C" void kernel_launch(void* const* d_in, const int* in_sizes, int n_in, void* d_out, int out_size, void* d_ws, size_t ws_size, hipStream_t stream) {
    static int grid = 0;
    if (grid == 0) {
        if (n_in != 22 || out_size != T * D || ws_size < WS_END) { fprintf(stderr, "kernel_launch: unexpected problem (n_in %d out %d ws %zu)\n", n_in, out_size, ws_size); grid = -1; return; }
        int dev = 0, cus = 0, per_cu = 0;
        if (hipGetDevice(&dev) != hipSuccess || hipDeviceGetAttribute(&cus, hipDeviceAttributeMultiprocessorCount, dev) != hipSuccess) { grid = -1; return; }
        if (hipFuncSetAttribute((const void*)fwd_kernel, hipFuncAttributeMaxDynamicSharedMemorySize, LDS_BYTES) != hipSuccess) { grid = -1; return; }
        if (hipOccupancyMaxActiveBlocksPerMultiprocessor(&per_cu, (const void*)fwd_kernel, NTHREADS, LDS_BYTES) != hipSuccess || per_cu < 1) { fprintf(stderr, "kernel_launch: occupancy query says %d\n", per_cu); }
        (void)hipGetLastError();
        grid = cus;
        if (T % (grid * NWAVES * 4) != 0) { fprintf(stderr, "kernel_launch: grid %d does not divide the row phases\n", grid); grid = -1; return; }
    }
    if (grid < 0) return;
    (void)hipMemsetAsync((char*)d_ws + WS_CTL, 0, CTL_BYTES, stream);
    Args a{};
    for (int i = 0; i < 22; ++i) a.in[i] = (const float*)d_in[i];
    a.out = (float*)d_out; a.ws = (unsigned char*)d_ws;
#if N_LAUNCH_MODE
    for (int p = 0; p < NPHASE; ++p) { a.ph_lo = p; a.ph_hi = p + 1; hipLaunchKernelGGL(fwd_kernel, dim3(grid), dim3(NTHREADS), LDS_BYTES, stream, a); }
#else
    a.ph_lo = 0; a.ph_hi = NPHASE;
    hipLaunchKernelGGL(fwd_kernel, dim3(grid), dim3(NTHREADS), LDS_BYTES, stream, a);
#endif
}
```

```cpp
#include <hip/hip_runtime.h>
#include <stdint.h>
#include <stdio.h>
#include <math.h>

#ifndef FAST_GEMM
#define FAST_GEMM 1
#endif
#ifndef FAST_ATTN
#define FAST_ATTN 1
#endif
#ifndef PROBE_DUP
#define PROBE_DUP 0
#endif
#ifndef PROBE_ATT
#define PROBE_ATT 0
#endif
#ifndef ATT_REGSTAGE
#define ATT_REGSTAGE 0
#endif
#ifndef N_LAUNCH_MODE
#define N_LAUNCH_MODE 0
#endif

#define LAS __attribute__((address_space(3)))
#define GAS __attribute__((address_space(1)))
typedef unsigned short bf16_t;
typedef short bf16x8 __attribute__((ext_vector_type(8)));
typedef float f32x4 __attribute__((ext_vector_type(4)));
typedef float f32x2 __attribute__((ext_vector_type(2)));
typedef float f32x16 __attribute__((ext_vector_type(16)));
typedef unsigned u32x4 __attribute__((ext_vector_type(4)));
typedef unsigned u32x2 __attribute__((ext_vector_type(2)));
typedef GAS unsigned gu32;

constexpr int D = 1024, NB = 8, S = 4096, T = NB * S, NL = 4, INC = 3488, NIN = 3584, NE = 16, FF = 512;
constexpr float EPS = 1e-6f, LOG2E = 1.4426950408889634f;
constexpr float QSCALE_A = 0.125f * LOG2E, QSCALE_B = 0.10206207261596577f * LOG2E;
constexpr int NWAVES = 8, NTHREADS = 512;
constexpr int NPHASE = 2 + 9 * NL;

constexpr size_t MiB = 1u << 20;
constexpr size_t WS_CTL = 0, CTL_BYTES = 1 * MiB;
constexpr size_t WS_MOD = 1 * MiB;
constexpr size_t WS_COSA = 2 * MiB, WS_SINA = WS_COSA + 512 * 1024, WS_COSB = 3 * MiB, WS_SINB = WS_COSB + 256 * 1024;
constexpr size_t WS_SSQ = 4 * MiB, WS_SSKV = 5 * MiB;
constexpr size_t WS_GW = 6 * MiB;
constexpr size_t WS_LIST = 7 * MiB;
constexpr size_t WS_WIN = 10 * MiB, WS_WQB = 17 * MiB, WS_WKVB = 18 * MiB, WS_WPA = 19 * MiB, WS_WPB = 20 * MiB, WS_WO = 21 * MiB, WS_W13 = 23 * MiB, WS_W2 = 55 * MiB;
constexpr size_t WS_H = 72 * MiB;
constexpr size_t WS_QA = 136 * MiB, WS_KA = 168 * MiB, WS_VA = 176 * MiB, WS_QLAT = 184 * MiB, WS_KVLAT = 208 * MiB;
constexpr size_t WS_KB = 224 * MiB, WS_VB = 272 * MiB, WS_QB = 304 * MiB, WS_OB = 352 * MiB, WS_SA = 384 * MiB, WS_SB = 448 * MiB, WS_XB = 512 * MiB, WS_END = 576 * MiB;
constexpr size_t WS_ACT = 136 * MiB, WS_Y2 = 208 * MiB;
constexpr int ACT_ROWS = 2 * T + NE * 256;
static_assert(WS_ACT + (size_t)ACT_ROWS * FF * 2 <= WS_Y2 && WS_Y2 + (size_t)2 * T * D * 2 <= WS_XB, "moe overlay");
constexpr int CW_BAR = 4096;
constexpr int CW_CNT = 16384;

constexpr int RING_BYTES = 131072, MISC_OFF = RING_BYTES, LDS_BYTES = 147456;

__device__ __forceinline__ float bf2f(unsigned v) { return __uint_as_float(v << 16); }
typedef __bf16 bf16x2_t __attribute__((ext_vector_type(2)));
__device__ __forceinline__ unsigned cvt_pk_bf16(float lo, float hi) { f32x2 v = {lo, hi}; bf16x2_t b = __builtin_convertvector(v, bf16x2_t); return __builtin_bit_cast(unsigned, b); }
__device__ __forceinline__ u32x4 pack8(f32x4 a, f32x4 b) { u32x4 w; w.x = cvt_pk_bf16(a[0], a[1]); w.y = cvt_pk_bf16(a[2], a[3]); w.z = cvt_pk_bf16(b[0], b[1]); w.w = cvt_pk_bf16(b[2], b[3]); return w; }
__device__ __forceinline__ void unpack8(u32x4 w, f32x4& a, f32x4& b) { a[0] = bf2f(w.x & 0xffffu); a[1] = bf2f(w.x >> 16); a[2] = bf2f(w.y & 0xffffu); a[3] = bf2f(w.y >> 16); b[0] = bf2f(w.z & 0xffffu); b[1] = bf2f(w.z >> 16); b[2] = bf2f(w.w & 0xffffu); b[3] = bf2f(w.w >> 16); }
__device__ __forceinline__ float wave_sum(float v) {
#pragma unroll
    for (int o = 1; o < 64; o <<= 1) v += __shfl_xor(v, o);
    return v;
}
__device__ __forceinline__ float sigm(float v) { return __builtin_amdgcn_rcpf(1.f + __builtin_amdgcn_exp2f(v * (-LOG2E))); }
#define VM_WAIT() asm volatile("s_waitcnt vmcnt(0)" ::: "memory")
#define LAUNDER_S(p) asm volatile("" : "+s"(p))
#define LAUNDER_V(v) asm volatile("" : "+v"(v))
#define LDS_WAIT() asm volatile("s_waitcnt lgkmcnt(0)" ::: "memory")

#define XB_TMO      128
#define XB_XCNT(j)  (256  + 64 * (j))
#define XB_XSUB(j)  (1280 + 64 * (j))
#define XB_XGEN(j)  (2304 + 64 * (j))
#define XB_TOP      3328
#define XB_TOPGEN   3392
#define XCD_BAR_WORDS 3456
#define XB_SPIN_CAP (1u << 22)
__device__ __forceinline__ unsigned xb_ld(unsigned* p)              { return __hip_atomic_load(p, __ATOMIC_RELAXED, __HIP_MEMORY_SCOPE_AGENT); }
__device__ __forceinline__ unsigned xb_add(unsigned* p, unsigned v) { return __hip_atomic_fetch_add(p, v, __ATOMIC_RELAXED, __HIP_MEMORY_SCOPE_AGENT); }
__device__ __forceinline__ unsigned xb_xcc_id() { return (unsigned)__builtin_amdgcn_s_getreg((3 << 11) | 20) & 0xFu; }
#define XB_SPIN(cond, bar) do { unsigned _sp = 0; while (cond) { __builtin_amdgcn_s_sleep(1); \
    if ((++_sp & 255u) == 0u) { if (xb_ld(&(bar)[XB_TMO])) break; if (_sp > XB_SPIN_CAP) { atomicAdd(&(bar)[XB_TMO], 1u); break; } } } } while (0)
struct XcdBarrier { unsigned* bar; unsigned x; volatile LAS unsigned* st; };
__device__ __forceinline__ XcdBarrier xcd_barrier_post(unsigned* bar, volatile LAS unsigned* st) {
    XcdBarrier b; b.bar = bar; b.x = xb_xcc_id(); b.st = st;
    if (threadIdx.x == 0) (void)xb_add(&bar[XB_XCNT(b.x)], 1u);
    return b;
}
__device__ __forceinline__ void xcd_barrier_complete(unsigned* bar, unsigned x, unsigned& nloc, unsigned& nx) {
    const unsigned G = gridDim.x * gridDim.y * gridDim.z;
    unsigned sum, cnt, mine, sp = 0u;
    for (;;) {
        sum = 0u; cnt = 0u; mine = 0u;
#pragma unroll
        for (unsigned j = 0; j < 16; ++j) { const unsigned c = xb_ld(&bar[XB_XCNT(j)]); sum += c; cnt += (c > 0u) ? 1u : 0u; mine = (j == x) ? c : mine; }
        if (sum == G) break;
        __builtin_amdgcn_s_sleep(1);
        if ((++sp & 255u) == 0u) { if (xb_ld(&bar[XB_TMO])) break; if (sp > XB_SPIN_CAP) { atomicAdd(&bar[XB_TMO], 1u); break; } }
    }
    nloc = mine > 0u ? mine : 1u; nx = cnt > 0u ? cnt : 1u;
}
__device__ __forceinline__ void xcd_barrier(const XcdBarrier& b) {
    asm volatile("s_waitcnt vmcnt(0)" ::: "memory");
    __syncthreads();
    if (threadIdx.x == 0) {
        unsigned* bar = b.bar;
        __builtin_amdgcn_s_waitcnt(0);
        unsigned nloc = b.st[0], nx = b.st[1];
        if (nloc == 0u) { xcd_barrier_complete(bar, b.x, nloc, nx); b.st[0] = nloc; b.st[1] = nx; }
        const unsigned old = xb_add(&bar[XB_XSUB(b.x)], 1u);
        const unsigned gen = old / nloc;
        if (old + 1u == (gen + 1u) * nloc) {
            __builtin_amdgcn_fence(__ATOMIC_RELEASE, "agent");
            asm volatile("s_waitcnt vmcnt(0)" ::: "memory");
            const unsigned og = xb_add(&bar[XB_TOP], 1u);
            const unsigned tg = og / nx;
            if (og + 1u == (tg + 1u) * nx) xb_add(&bar[XB_TOPGEN], 1u);
            else XB_SPIN(xb_ld(&bar[XB_TOPGEN]) == tg, bar);
            __builtin_amdgcn_fence(__ATOMIC_ACQUIRE, "agent");
            xb_add(&bar[XB_XGEN(b.x)], 1u);
            asm volatile("s_waitcnt vmcnt(0)" ::: "memory");
        } else {
            XB_SPIN(xb_ld(&bar[XB_XGEN(b.x)]) == gen, bar);
            __builtin_amdgcn_fence(__ATOMIC_ACQUIRE, "agent");
            asm volatile("s_waitcnt vmcnt(0)" ::: "memory");
        }
    }
    __syncthreads();
}

namespace gp {
constexpr int BM = 256, BK = 64, HALF = 128, HTB = HALF * BK * 2, NXCD = 8, WGM = 8;
__host__ __device__ __forceinline__ int lds_byte(int r, int c) { const int st = (r >> 4) * 2 + (c >> 5), rr = r & 15, cc = c & 31, ob = rr * 64 + cc * 2; return st * 1024 + (ob ^ (((ob >> 9) & 1) << 5)); }
__host__ __device__ __forceinline__ void stage_rc(int b, int& R, int& C) { const int st = b / 1024, sb = b % 1024, swz = sb ^ (((sb >> 9) & 1) << 5); R = (st >> 1) * 16 + swz / 64; C = (st & 1) * 32 + (swz % 64) / 2; }
__host__ __device__ __forceinline__ int perm32(int rho) { const int n = rho >> 4, i = rho & 15; return 8 * (i >> 2) + 4 * n + (i & 3); }

struct Unit { int pm, pn, be, rl, nv; };
struct Gemm { const bf16_t* A; const bf16_t* Bt; int K; size_t bstride; const unsigned* list; };

__device__ __forceinline__ int xcd_remap(int wgid, int nwg) { const int q = nwg / NXCD, r = nwg % NXCD, xcd = wgid % NXCD, off = wgid / NXCD; return (xcd < r ? xcd * (q + 1) : r * (q + 1) + (xcd - r) * q) + off; }
struct DenseOrder {
    int nM, nN, nwg, G, c;
    __device__ void init(int M, int N, int G_, int c_) { nM = M / BM; nN = N / BM; nwg = nM * nN; G = G_; c = c_; }
    __device__ bool next(int i, Unit& u) const {
        const long L = (long)i * G + c; if (L >= nwg) return false;
        const int wgid = xcd_remap((int)L, nwg);
        const int nig = WGM * nN, gid = wgid / nig, fm = gid * WGM, gsz = (nM - fm) < WGM ? (nM - fm) : WGM;
        u.pm = fm + ((wgid % nig) % gsz); u.pn = (wgid % nig) / gsz; u.be = 0; u.rl = 0; u.nv = 256; return true;
    }
};
struct MoeOrder {
    const LAS int* tab; int nwg, G, c;
    __device__ static int rd(const LAS int* p) { return __builtin_amdgcn_readfirstlane(*p); }
    __device__ void init(const LAS int* tab_, int G_, int c_) { tab = tab_; nwg = rd(tab_ + 16) * 4; G = G_; c = c_; }
    __device__ bool next(int i, Unit& u) const {
        const long L = (long)i * G + c; if (L >= nwg) return false;
        const int wgid = xcd_remap((int)L, nwg);
        const int tile = wgid >> 2; int e = 0;
        for (int k = 1; k < NE; ++k) e += (rd(tab + k) <= tile) ? 1 : 0;
        u.pm = tile; u.pn = wgid & 3; u.be = e; u.rl = tile - rd(tab + e); const int rem = rd(tab + 32 + e) - u.rl * 256; u.nv = rem < 256 ? rem : 256; return true;
    }
};

#define ACC_T f32x4 (&acc)[2][2][4][2]

template <class Epi, class Sched, bool GATHER>
__device__ __forceinline__ void gemm_phase_ref(int tid, const Gemm g, const Sched& S, const Epi& E) {
    const int wid = __builtin_amdgcn_readfirstlane(tid >> 6), lane = tid & 63, wr = wid >> 2, wc = wid & 3, fr = lane & 15, fq = lane >> 4;
    const int K = g.K; Unit u;
    for (int ui = 0; S.next(ui, u); ++ui) {
        f32x4 acc[2][2][4][2];
#pragma unroll
        for (int a = 0; a < 2; ++a)
#pragma unroll
            for (int b = 0; b < 2; ++b)
#pragma unroll
                for (int m = 0; m < 4; ++m)
#pragma unroll
                    for (int n = 0; n < 2; ++n) acc[a][b][m][n] = (f32x4){0.f, 0.f, 0.f, 0.f};
        const bf16_t* Bt = g.Bt + (size_t)u.be * g.bstride + (size_t)u.pn * 256 * K;
        for (int ai = 0; ai < 2; ++ai)
            for (int m = 0; m < 4; ++m) {
                const int rloc = ai * 128 + wr * 64 + m * 16 + fr;
                size_t arow;
                if (GATHER) { arow = (rloc < u.nv) ? (size_t)(g.list[(size_t)u.be * T + u.rl * 256 + rloc] >> 1) : 0; }
                else arow = (size_t)u.pm * 256 + rloc;
                const bf16_t* ap = g.A + arow * K;
                for (int bj = 0; bj < 2; ++bj) {
                    const bf16_t* bp = Bt + (size_t)(bj * 128 + wc * 32 + fq * 8) * K;
                    float s[8];
#pragma unroll
                    for (int c = 0; c < 8; ++c) {
                        float sc = 0.f; const bf16_t* bpc = bp + (size_t)c * K;
#pragma unroll 2
                        for (int k = 0; k < K; k += 8) {
                            f32x4 a0, a1, b0, b1; unpack8(*(const u32x4*)(ap + k), a0, a1); unpack8(*(const u32x4*)(bpc + k), b0, b1);
                            sc += a0[0] * b0[0] + a0[1] * b0[1] + a0[2] * b0[2] + a0[3] * b0[3] + a1[0] * b1[0] + a1[1] * b1[1] + a1[2] * b1[2] + a1[3] * b1[3];
                        }
                        s[c] = sc; asm volatile("" : "+v"(s[c]));
                    }
#pragma unroll
                    for (int a2 = 0; a2 < 2; ++a2)
#pragma unroll
                        for (int b2 = 0; b2 < 2; ++b2)
#pragma unroll
                            for (int m2 = 0; m2 < 4; ++m2)
                                if (a2 == ai && b2 == bj && m2 == m) { acc[a2][b2][m2][0] = (f32x4){s[0], s[1], s[2], s[3]}; acc[a2][b2][m2][1] = (f32x4){s[4], s[5], s[6], s[7]}; }
                }
            }
        E(acc, u, wr, wc, fr, fq);
    }
}

#if FAST_GEMM
template <class Epi, class Sched, bool GATHER>
__device__ __forceinline__ void gemm_phase_fast(int tid, LAS unsigned char* lds, const Gemm g, const Sched& S, const Epi& E) {
    const int wid = __builtin_amdgcn_readfirstlane(tid >> 6), lane = tid & 63, wr = wid >> 2, wc = wid & 3, fr = lane & 15, fq = lane >> 4;
    const int K = g.K, nt = K / BK;
    int Rr[2], Cc[2]; unsigned voffB[2];
#pragma unroll
    for (int i = 0; i < 2; ++i) { stage_rc(tid * 16 + i * 8192, Rr[i], Cc[i]); const int Rb = (Rr[i] & ~31) + perm32(Rr[i] & 31); voffB[i] = (unsigned)(Rb * K + Cc[i]) * 2u; }
    const size_t kstep = (size_t)(BK * 2), hstep = (size_t)HALF * K * 2, tstep = 2 * hstep;
    const unsigned ldsw = (unsigned)wid * 1024u;
    const int aoff = lds_byte(wr * 64 + fr, fq * 8), boff = lds_byte(wc * 32 + fr, fq * 8);
#define GP_SA(b, h) (((b) * 2 + (h)) * HTB)
#define GP_SB(b, h) ((4 + (b) * 2 + (h)) * HTB)
#define GP_STAGE2(bufoff, gbase, v0, v1) do { \
        __builtin_amdgcn_global_load_lds((const unsigned*)((const char*)(gbase) + (v0)), (LAS unsigned*)(lds + (bufoff) + ldsw), 16, 0, 0); \
        __builtin_amdgcn_global_load_lds((const unsigned*)((const char*)(gbase) + (v1)), (LAS unsigned*)(lds + (bufoff) + ldsw + 8192), 16, 0, 0); } while (0)
#define GP_STAGEB(bufoff, gbase) GP_STAGE2(bufoff, gbase, voffB[0], voffB[1])
#define GP_LDA(dst, b, h) do { _Pragma("unroll") for (int m = 0; m < 4; ++m) _Pragma("unroll") for (int k = 0; k < 2; ++k) dst[m][k] = *(const LAS bf16x8*)(lds + GP_SA(b, h) + aoff + m * 2048 + k * 1024); } while (0)
#define GP_LDB(dst, b, h) do { _Pragma("unroll") for (int n = 0; n < 2; ++n) _Pragma("unroll") for (int k = 0; k < 2; ++k) dst[n][k] = *(const LAS bf16x8*)(lds + GP_SB(b, h) + boff + n * 2048 + k * 1024); } while (0)
#define GP_MMA(ai, bj, At, Bt) do { __builtin_amdgcn_s_setprio(1); _Pragma("unroll") for (int m = 0; m < 4; ++m) _Pragma("unroll") for (int n = 0; n < 2; ++n) _Pragma("unroll") for (int k = 0; k < 2; ++k) \
        acc[ai][bj][m][n] = __builtin_amdgcn_mfma_f32_16x16x32_bf16(Bt[n][k], At[m][k], acc[ai][bj][m][n], 0, 0, 0); __builtin_amdgcn_s_setprio(0); } while (0)
#define GP_WAIT_V(n) asm volatile("s_waitcnt vmcnt(" #n ")" ::: "memory")
#define GP_WAIT_L(n) asm volatile("s_waitcnt lgkmcnt(" #n ")" ::: "memory")
#define GP_BAR __builtin_amdgcn_s_barrier()
#define GP_SCHED __builtin_amdgcn_sched_barrier(0)
    Unit cur, nxt; int ui = 0;
    if (!S.next(0, cur)) return;
    f32x4 acc[2][2][4][2];
#pragma unroll
    for (int a = 0; a < 2; ++a)
#pragma unroll
        for (int b = 0; b < 2; ++b)
#pragma unroll
            for (int m = 0; m < 4; ++m)
#pragma unroll
                for (int n = 0; n < 2; ++n) acc[a][b][m][n] = (f32x4){0.f, 0.f, 0.f, 0.f};
    bf16x8 At[4][2], B0[2][2], B1[2][2];
    unsigned vC0, vC1, vC2, vC3, vN0, vN1, vN2, vN3;
#define GP_VOFF(u, o0, o1, o2, o3) do { if (GATHER) { \
        int tl_ = tid; LAUNDER_V(tl_); int R0_, C0_, R1_, C1_; stage_rc(tl_ * 16, R0_, C0_); stage_rc(tl_ * 16 + 8192, R1_, C1_);     \
        const unsigned* lp = g.list + (size_t)(u).be * T + (u).rl * 256; \
        const int nvm = (u).nv - 1; const int p0 = min(R0_, nvm), p1 = min(R1_, nvm), p2 = min(128 + R0_, nvm), p3 = min(128 + R1_, nvm); \
        const unsigned t0 = lp[p0] >> 1, t1 = lp[p1] >> 1, t2 = lp[p2] >> 1, t3 = lp[p3] >> 1; \
        o0 = (t0 * K + C0_) * 2u; o1 = (t1 * K + C1_) * 2u; o2 = (t2 * K + C0_) * 2u; o3 = (t3 * K + C1_) * 2u; \
      } else { o0 = (unsigned)(Rr[0] * K + Cc[0]) * 2u; o1 = (unsigned)(Rr[1] * K + Cc[1]) * 2u; o2 = o0 + (unsigned)hstep; o3 = o1 + (unsigned)hstep; } } while (0)
    GP_VOFF(cur, vC0, vC1, vC2, vC3);
    const char* cA = (const char*)g.A + (GATHER ? (size_t)0 : (size_t)cur.pm * tstep);
    const char* cB = (const char*)g.Bt + ((size_t)cur.be * g.bstride) * 2 + (size_t)cur.pn * tstep;
    GP_STAGEB(GP_SB(0, 0), cB); GP_STAGEB(GP_SB(0, 1), cB + hstep); GP_STAGE2(GP_SA(0, 0), cA, vC0, vC1); GP_STAGE2(GP_SA(0, 1), cA, vC2, vC3);
    if (wr == 1) GP_BAR;
    GP_WAIT_V(2); GP_BAR;
    GP_STAGEB(GP_SB(1, 0), cB + kstep); GP_STAGE2(GP_SA(1, 0), cA + kstep, vC0, vC1); GP_STAGEB(GP_SB(1, 1), cB + hstep + kstep);
    GP_WAIT_V(6); GP_BAR;
    for (;;) {
        const bool has_next = S.next(ui + 1, nxt);
        const char* nA = has_next ? (const char*)g.A + (GATHER ? (size_t)0 : (size_t)nxt.pm * tstep) : cA;
        const char* nB = has_next ? (const char*)g.Bt + ((size_t)nxt.be * g.bstride) * 2 + (size_t)nxt.pn * tstep : cB;
        if (has_next) { GP_VOFF(nxt, vN0, vN1, vN2, vN3); } else { vN0 = vC0; vN1 = vC1; vN2 = vC2; vN3 = vC3; }
#pragma nounroll
        for (int t = 0; t < nt; t += 2) {
            const bool last = (t == nt - 2);
            const char* a1 = cA + (size_t)(t + 1) * kstep;
            const char* a2 = last ? nA : cA + (size_t)(t + 2) * kstep; const char* b2 = last ? nB : cB + (size_t)(t + 2) * kstep;
            const char* a3 = a2 + kstep; const char* b3 = b2 + kstep;
            const unsigned w0 = last ? vN0 : vC0, w1 = last ? vN1 : vC1, w2 = last ? vN2 : vC2, w3 = last ? vN3 : vC3;
            GP_LDB(B0, 0, 0); GP_LDB(B1, 0, 1); GP_SCHED; GP_LDA(At, 0, 0); GP_STAGE2(GP_SA(1, 1), a1, vC2, vC3);
            GP_WAIT_V(8); GP_WAIT_L(0); GP_BAR; GP_MMA(0, 0, At, B0); GP_MMA(0, 1, At, B1); GP_BAR; GP_SCHED;
            GP_LDA(At, 0, 1); GP_STAGEB(GP_SB(0, 0), b2); GP_STAGEB(GP_SB(0, 1), b2 + hstep); GP_STAGE2(GP_SA(0, 0), a2, w0, w1);
            GP_WAIT_V(8); GP_WAIT_L(0); GP_BAR; GP_MMA(1, 0, At, B0); GP_MMA(1, 1, At, B1); GP_BAR; GP_SCHED;
            GP_LDB(B0, 1, 0); GP_LDB(B1, 1, 1); GP_SCHED; GP_LDA(At, 1, 0); GP_STAGE2(GP_SA(0, 1), a2, w2, w3);
            GP_WAIT_V(8); GP_WAIT_L(0); GP_BAR; GP_MMA(0, 0, At, B0); GP_MMA(0, 1, At, B1); GP_BAR; GP_SCHED;
            GP_LDA(At, 1, 1); GP_STAGEB(GP_SB(1, 0), b3); GP_STAGEB(GP_SB(1, 1), b3 + hstep); GP_STAGE2(GP_SA(1, 0), a3, w0, w1);
            GP_WAIT_V(8); GP_WAIT_L(0); GP_BAR; GP_MMA(1, 0, At, B0); GP_MMA(1, 1, At, B1); GP_BAR; GP_SCHED;
        }
        if (wr == 0) GP_BAR;
        E(acc, cur, wr, wc, fr, fq);
        if (!has_next) break;
#pragma unroll
        for (int a = 0; a < 2; ++a)
#pragma unroll
            for (int b = 0; b < 2; ++b)
#pragma unroll
                for (int m = 0; m < 4; ++m)
#pragma unroll
                    for (int n = 0; n < 2; ++n) acc[a][b][m][n] = (f32x4){0.f, 0.f, 0.f, 0.f};
        cur = nxt; cA = nA; cB = nB; vC0 = vN0; vC1 = vN1; vC2 = vN2; vC3 = vN3; ++ui;
        if (wr == 1) GP_BAR;
    }
    GP_WAIT_V(0);
    GP_BAR;
#undef GP_SA
#undef GP_SB
#undef GP_STAGE2
#undef GP_STAGEB
#undef GP_LDA
#undef GP_LDB
#undef GP_MMA
#undef GP_WAIT_V
#undef GP_WAIT_L
#undef GP_BAR
#undef GP_SCHED
#undef GP_VOFF
}
#endif

template <class Epi, class Sched, bool GATHER = false>
__device__ __forceinline__ void gemm_phase(int tid, LAS unsigned char* lds, const Gemm g, const Sched& S, const Epi& E) {
#if FAST_GEMM
    gemm_phase_fast<Epi, Sched, GATHER>(tid, lds, g, S, E);
#else
    (void)lds; gemm_phase_ref<Epi, Sched, GATHER>(tid, g, S, E);
#endif
}

#define EPI_ROW(ai, m) (u.pm * 256 + (ai) * 128 + wr * 64 + (m) * 16 + fr)
#define EPI_COL(bj) (u.pn * 256 + (bj) * 128 + wc * 32 + fq * 8)
__device__ __forceinline__ float dot4(f32x4 a) { return (a[0] * a[0] + a[1] * a[1]) + (a[2] * a[2] + a[3] * a[3]); }

struct EpiNull {
    __device__ __forceinline__ void operator()(const ACC_T, const Unit& u, int wr, int wc, int fr, int fq) const {
#pragma unroll
        for (int ai = 0; ai < 2; ++ai)
#pragma unroll
            for (int bj = 0; bj < 2; ++bj)
#pragma unroll
                for (int m = 0; m < 4; ++m) asm volatile("" :: "v"(acc[ai][bj][m][0]), "v"(acc[ai][bj][m][1]));
    }
};
struct EpiIn {
    bf16_t *QA, *KA, *VA, *QLAT, *KVLAT, *KB, *SA, *SB; float *SSQ, *SSKV; const float *gq, *gk, *cosA, *sinA, *cosB, *sinB;
    __device__ __forceinline__ void operator()(const ACC_T, const Unit& u, int wr, int wc, int fr, int fq) const {
        const int wb = u.pn * 4 + wc;
        if (wb < 10) {
            const bool isq = wb < 8; const int head = isq ? wb : wb - 8; const float* g = isq ? gq : gk; bf16_t* dst = isq ? QA : KA; const int dp = isq ? 512 : 128; const float qs = isq ? QSCALE_A : 1.f;
            const f32x4 g00 = *(const f32x4*)(g + 8 * fq), g01 = *(const f32x4*)(g + 8 * fq + 4), g10 = *(const f32x4*)(g + 32 + 8 * fq), g11 = *(const f32x4*)(g + 36 + 8 * fq);
#pragma unroll
            for (int ai = 0; ai < 2; ++ai)
#pragma unroll
                for (int m = 0; m < 4; ++m) {
                    const int r = EPI_ROW(ai, m), pos = r & (S - 1);
                    const f32x4 v00 = acc[ai][0][m][0], v01 = acc[ai][0][m][1], v10 = acc[ai][1][m][0], v11 = acc[ai][1][m][1];
                    float ss = (dot4(v00) + dot4(v01)) + (dot4(v10) + dot4(v11)); ss += __shfl_xor(ss, 16); ss += __shfl_xor(ss, 32);
                    const float rstd = rsqrtf(ss * (1.f / 64.f) + EPS);
                    const f32x4 y00 = v00 * rstd * g00, y01 = v01 * rstd * g01, y10 = v10 * rstd * g10, y11 = v11 * rstd * g11;
                    const f32x4 c0 = *(const f32x4*)(cosA + pos * 32 + 8 * fq), c1 = *(const f32x4*)(cosA + pos * 32 + 8 * fq + 4), s0 = *(const f32x4*)(sinA + pos * 32 + 8 * fq), s1 = *(const f32x4*)(sinA + pos * 32 + 8 * fq + 4);
                    const f32x4 o00 = (y00 * c0 - y10 * s0) * qs, o01 = (y01 * c1 - y11 * s1) * qs, o10 = (y10 * c0 + y00 * s0) * qs, o11 = (y11 * c1 + y01 * s1) * qs;
                    bf16_t* p = dst + (size_t)r * dp + head * 64 + 8 * fq;
                    *(u32x4*)p = pack8(o00, o01); *(u32x4*)(p + 32) = pack8(o10, o11);
                }
        } else if (wb < 12) {
#pragma unroll
            for (int ai = 0; ai < 2; ++ai)
#pragma unroll
                for (int m = 0; m < 4; ++m) { bf16_t* p = VA + (size_t)EPI_ROW(ai, m) * 128 + (wb - 10) * 64 + 8 * fq;
                    *(u32x4*)p = pack8(acc[ai][0][m][0], acc[ai][0][m][1]); *(u32x4*)(p + 32) = pack8(acc[ai][1][m][0], acc[ai][1][m][1]); }
        } else if (wb < 22) {
            const bool isq = wb < 18; const int idx = isq ? wb - 12 : wb - 18; bf16_t* dst = isq ? QLAT : KVLAT; const int dp = isq ? 384 : 256;
#pragma unroll
            for (int ai = 0; ai < 2; ++ai)
#pragma unroll
                for (int m = 0; m < 4; ++m) {
                    const int r = EPI_ROW(ai, m);
                    const f32x4 v00 = acc[ai][0][m][0], v01 = acc[ai][0][m][1], v10 = acc[ai][1][m][0], v11 = acc[ai][1][m][1];
                    float ss = (dot4(v00) + dot4(v01)) + (dot4(v10) + dot4(v11)); ss += __shfl_xor(ss, 16); ss += __shfl_xor(ss, 32);
                    if (fq == 0) { if (isq) SSQ[(size_t)r * 8 + idx] = ss; else SSKV[(size_t)r * 4 + idx] = ss; }
                    bf16_t* p = dst + (size_t)r * dp + idx * 64 + 8 * fq;
                    *(u32x4*)p = pack8(v00, v01); *(u32x4*)(p + 32) = pack8(v10, v11);
                }
        } else if (wb == 22) {
            if (fq < 2) {
#pragma unroll
                for (int ai = 0; ai < 2; ++ai)
#pragma unroll
                    for (int m = 0; m < 4; ++m) {
                        const int r = EPI_ROW(ai, m), pos = r & (S - 1);
                        const f32x4 x10 = acc[ai][0][m][0], x11 = acc[ai][0][m][1], x20 = acc[ai][1][m][0], x21 = acc[ai][1][m][1];
                        const f32x4 c0 = *(const f32x4*)(cosB + pos * 16 + 8 * fq), c1 = *(const f32x4*)(cosB + pos * 16 + 8 * fq + 4), s0 = *(const f32x4*)(sinB + pos * 16 + 8 * fq), s1 = *(const f32x4*)(sinB + pos * 16 + 8 * fq + 4);
                        const u32x4 w1 = pack8(x10 * c0 - x20 * s0, x11 * c1 - x21 * s1), w2 = pack8(x20 * c0 + x10 * s0, x21 * c1 + x11 * s1);
                        bf16_t* p = KB + (size_t)r * 768 + 64 + 8 * fq;
#pragma unroll
                        for (int h = 0; h < 8; ++h) { *(u32x4*)(p + h * 96) = w1; *(u32x4*)(p + h * 96 + 16) = w2; }
                    }
            }
        } else if (wb == 23) {
        } else {
            const bool isa = wb < 40; const int idx = isa ? wb - 24 : wb - 40; bf16_t* dst = isa ? SA : SB;
#pragma unroll
            for (int ai = 0; ai < 2; ++ai)
#pragma unroll
                for (int m = 0; m < 4; ++m) { bf16_t* p = dst + (size_t)EPI_ROW(ai, m) * 1024 + idx * 64 + 8 * fq;
#pragma unroll
                    for (int bj = 0; bj < 2; ++bj) { f32x4 a = acc[ai][bj][m][0], b = acc[ai][bj][m][1];
#pragma unroll
                        for (int j = 0; j < 4; ++j) { a[j] = sigm(a[j]); b[j] = sigm(b[j]); }
                        *(u32x4*)(p + bj * 32) = pack8(a, b); } }
        }
    }
};
__host__ __device__ __forceinline__ int src_col_in(int n) {
    const int pn = n >> 8, nl = n & 255, bj = nl >> 7, wc = (nl & 127) >> 5, p = nl & 31, wb = pn * 4 + wc, s = bj * 32 + p;
    if (wb < 8) return wb * 64 + s;
    if (wb < 10) return 512 + (wb - 8) * 64 + s;
    if (wb < 12) return 640 + (wb - 10) * 64 + s;
    if (wb < 18) return 768 + (wb - 12) * 64 + s;
    if (wb < 22) return 1152 + (wb - 18) * 64 + s;
    if (wb == 22) return p < 16 ? 1408 + bj * 16 + p : -1;
    if (wb == 23) return -1;
    if (wb < 40) return 1440 + (wb - 24) * 64 + s;
    return 2464 + (wb - 40) * 64 + s;
}
struct EpiQb {
    bf16_t* QB; const float *SSQ, *cosB, *sinB;
    __device__ __forceinline__ void operator()(const ACC_T, const Unit& u, int wr, int wc, int fr, int fq) const {
#pragma unroll
        for (int ai = 0; ai < 2; ++ai)
#pragma unroll
            for (int m = 0; m < 4; ++m) {
                const int r = EPI_ROW(ai, m), pos = r & (S - 1);
                const f32x4 sa = *(const f32x4*)(SSQ + (size_t)r * 8); const f32x2 sb = *(const f32x2*)(SSQ + (size_t)r * 8 + 4);
                const float rstd = rsqrtf((((sa[0] + sa[1]) + (sa[2] + sa[3])) + (sb[0] + sb[1])) * (1.f / 384.f) + EPS);
#pragma unroll
                for (int bj = 0; bj < 2; ++bj) {
                    f32x4 v0 = acc[ai][bj][m][0] * rstd, v1 = acc[ai][bj][m][1] * rstd;
                    const int c32 = u.pn * 8 + bj * 4 + wc;
                    if (c32 % 3 == 2) {
                        f32x4 o0, o1;
#pragma unroll
                        for (int j = 0; j < 4; ++j) { o0[j] = __shfl_xor(v0[j], 32); o1[j] = __shfl_xor(v1[j], 32); }
                        const int i0 = 8 * (fq & 1);
                        const f32x4 c0 = *(const f32x4*)(cosB + pos * 16 + i0), c1 = *(const f32x4*)(cosB + pos * 16 + i0 + 4), s0 = *(const f32x4*)(sinB + pos * 16 + i0), s1 = *(const f32x4*)(sinB + pos * 16 + i0 + 4);
                        if (fq < 2) { v0 = v0 * c0 - o0 * s0; v1 = v1 * c1 - o1 * s1; } else { v0 = v0 * c0 + o0 * s0; v1 = v1 * c1 + o1 * s1; }
                    }
                    *(u32x4*)(QB + (size_t)r * 768 + EPI_COL(bj)) = pack8(v0 * QSCALE_B, v1 * QSCALE_B);
                }
            }
    }
};
struct EpiKvb {
    bf16_t *KB, *VB; const float* SSKV;
    __device__ __forceinline__ void operator()(const ACC_T, const Unit& u, int wr, int wc, int fr, int fq) const {
#pragma unroll
        for (int ai = 0; ai < 2; ++ai)
#pragma unroll
            for (int m = 0; m < 4; ++m) {
                const int r = EPI_ROW(ai, m);
                const f32x4 sa = *(const f32x4*)(SSKV + (size_t)r * 4);
                const float rstd = rsqrtf(((sa[0] + sa[1]) + (sa[2] + sa[3])) * (1.f / 256.f) + EPS);
#pragma unroll
                for (int bj = 0; bj < 2; ++bj) {
                    const int head = u.pn * 2 + bj, o = wc * 32 + fq * 8;
                    const u32x4 w = pack8(acc[ai][bj][m][0] * rstd, acc[ai][bj][m][1] * rstd);
                    if (wc < 2) *(u32x4*)(KB + (size_t)r * 768 + head * 96 + o) = w; else *(u32x4*)(VB + (size_t)r * 512 + head * 64 + (o - 64)) = w;
                }
            }
    }
};
template <int MODE> struct EpiProj {
    bf16_t* O; const bf16_t* gate;
    __device__ __forceinline__ void operator()(const ACC_T, const Unit& u, int wr, int wc, int fr, int fq) const {
#pragma unroll
        for (int ai = 0; ai < 2; ++ai)
#pragma unroll
            for (int m = 0; m < 4; ++m) {
                const int r = EPI_ROW(ai, m);
#pragma unroll
                for (int bj = 0; bj < 2; ++bj) {
                    const size_t off = (size_t)r * D + EPI_COL(bj);
                    f32x4 g0, g1; unpack8(*(const u32x4*)(gate + off), g0, g1);
                    f32x4 v0 = acc[ai][bj][m][0] * g0, v1 = acc[ai][bj][m][1] * g1;
                    if (MODE == 1) { f32x4 p0, p1; unpack8(*(const u32x4*)(O + off), p0, p1); v0 += p0; v1 += p1; }
                    *(u32x4*)(O + off) = pack8(v0, v1);
                }
            }
    }
};
struct EpiWo {
    const bf16_t* X; const float* modl; bf16_t* XO;
    __device__ __forceinline__ void operator()(const ACC_T, const Unit& u, int wr, int wc, int fr, int fq) const {
        const float* g1 = modl + (size_t)(u.pm >> 4) * 6 * D + 2 * D;
#pragma unroll
        for (int bj = 0; bj < 2; ++bj) {
            const int c = EPI_COL(bj); const f32x4 ga = *(const f32x4*)(g1 + c), gb = *(const f32x4*)(g1 + c + 4);
#pragma unroll
            for (int ai = 0; ai < 2; ++ai)
#pragma unroll
                for (int m = 0; m < 4; ++m) { const size_t off = (size_t)EPI_ROW(ai, m) * D + c;
                    f32x4 x0, x1; unpack8(*(const u32x4*)(X + off), x0, x1);
                    *(u32x4*)(XO + off) = pack8(x0 + ga * acc[ai][bj][m][0], x1 + gb * acc[ai][bj][m][1]); }
        }
    }
};
struct EpiUp {
    bf16_t* ACT;
    __device__ __forceinline__ void operator()(const ACC_T, const Unit& u, int wr, int wc, int fr, int fq) const {
#pragma unroll
        for (int ai = 0; ai < 2; ++ai)
#pragma unroll
            for (int m = 0; m < 4; ++m) {
                f32x4 a = acc[ai][0][m][0], b = acc[ai][0][m][1]; const f32x4 c = acc[ai][1][m][0], d = acc[ai][1][m][1];
#pragma unroll
                for (int j = 0; j < 4; ++j) { a[j] = a[j] * sigm(a[j]) * c[j]; b[j] = b[j] * sigm(b[j]) * d[j]; }
                *(u32x4*)(ACT + (size_t)EPI_ROW(ai, m) * FF + u.pn * 128 + wc * 32 + fq * 8) = pack8(a, b);
            }
    }
};
struct EpiDown {
    bf16_t* Y2; const unsigned* list; const float* gw;
    __device__ __forceinline__ void operator()(const ACC_T, const Unit& u, int wr, int wc, int fr, int fq) const {
#pragma unroll
        for (int ai = 0; ai < 2; ++ai)
#pragma unroll
            for (int m = 0; m < 4; ++m) {
                const int rloc = ai * 128 + wr * 64 + m * 16 + fr;
                if (rloc < u.nv) {
                    const unsigned entry = list[(size_t)u.be * T + u.rl * 256 + rloc]; const float w = gw[entry];
#pragma unroll
                    for (int bj = 0; bj < 2; ++bj) *(u32x4*)(Y2 + (size_t)entry * D + EPI_COL(bj)) = pack8(acc[ai][bj][m][0] * w, acc[ai][bj][m][1] * w);
                }
            }
    }
};
}

namespace at {
struct Tensors { const bf16_t* Q; int qp; const bf16_t* K; int kp; const bf16_t* V; int vp; bf16_t* O; int op; int group; };
__device__ __forceinline__ bool next_unit(int i, int vcu, int G, int& bh, int& qb) {
    int u;
    if (G == 256) { if (i >= 4) return false; u = (vcu >> 5) * 128 + i * 32 + (vcu & 31); }
    else { u = i * G + vcu; if (u >= 1024) return false; }
    bh = u >> 4; qb = u & 15; return true;
}
template <int DQK>
__device__ __forceinline__ void attn_phase_ref(int tid, const Tensors& A, int vcu, int G) {
    int bh, qb;
    for (int i = 0; next_unit(i, vcu, G, bh, qb); ++i) {
        const int b = bh >> 3, h = bh & 7, kvh = h / A.group;
        {
            const int dh = tid >> 8;
            const size_t row = (size_t)b * S + qb * 256 + (tid & 255);
            float q[DQK], o[32];
#pragma unroll
            for (int d = 0; d < DQK; ++d) q[d] = bf2f(A.Q[row * A.qp + h * DQK + d]);
#pragma unroll
            for (int d = 0; d < 32; ++d) o[d] = 0.f;
            float l = 0.f;
            for (int k = 0; k < S; ++k) {
                const bf16_t* kr = A.K + ((size_t)b * S + k) * A.kp + kvh * DQK; const bf16_t* vr = A.V + ((size_t)b * S + k) * A.vp + kvh * 64 + dh * 32;
                float sc = 0.f;
#pragma unroll
                for (int d = 0; d < DQK; d += 8) { f32x4 k0, k1; unpack8(*(const u32x4*)(kr + d), k0, k1);
                    sc += q[d] * k0[0] + q[d + 1] * k0[1] + q[d + 2] * k0[2] + q[d + 3] * k0[3] + q[d + 4] * k1[0] + q[d + 5] * k1[1] + q[d + 6] * k1[2] + q[d + 7] * k1[3]; }
                const float p = bf2f(cvt_pk_bf16(exp2f(sc), 0.f) & 0xffffu); l += p;
#pragma unroll
                for (int d = 0; d < 32; d += 8) { f32x4 v0, v1; unpack8(*(const u32x4*)(vr + d), v0, v1);
                    o[d] += p * v0[0]; o[d + 1] += p * v0[1]; o[d + 2] += p * v0[2]; o[d + 3] += p * v0[3]; o[d + 4] += p * v1[0]; o[d + 5] += p * v1[1]; o[d + 6] += p * v1[2]; o[d + 7] += p * v1[3]; }
            }
            const float il = 1.f / l;
            __syncthreads();
#pragma unroll
            for (int d = 0; d < 32; d += 8) { f32x4 a = {o[d] * il, o[d + 1] * il, o[d + 2] * il, o[d + 3] * il}, c = {o[d + 4] * il, o[d + 5] * il, o[d + 6] * il, o[d + 7] * il};
                *(u32x4*)(A.O + row * A.op + h * 64 + dh * 32 + d) = pack8(a, c); }
        }
    }
}
#if FAST_ATTN
typedef short s16x4 __attribute__((ext_vector_type(4)));
__device__ __forceinline__ unsigned cvtpk(float lo, float hi) { f32x2 v = {lo, hi}; bf16x2_t b = __builtin_convertvector(v, bf16x2_t); return __builtin_bit_cast(unsigned, b); }
__device__ __forceinline__ s16x4 vtr(const LAS unsigned char* p) { return __builtin_bit_cast(s16x4, __builtin_amdgcn_ds_read_tr16_b64_v4i16((LAS s16x4*)p)); }
__device__ __forceinline__ int crow(int r, int hi) { return (r & 3) + 8 * (r >> 2) + 4 * hi; }
#define AT_BAR() asm volatile("s_barrier" ::: "memory")
#define AT_WAITBAR(N) asm volatile("s_waitcnt vmcnt(" #N ") lgkmcnt(0)\n\ts_barrier" ::: "memory")
#define AT_SCHED() __builtin_amdgcn_sched_barrier(0)
__device__ __forceinline__ void glds16(const void* gsrc, unsigned lds_dst) { unsigned keep;
    asm volatile("s_mov_b32 %0, m0\n\ts_mov_b32 m0, %2\n\ts_nop 0\n\tglobal_load_lds_dwordx4 %1, off\n\ts_mov_b32 m0, %0" : "=&s"(keep) : "v"(gsrc), "s"(lds_dst) : "memory"); }
#define AT_GLDS(g, l) glds16((const void*)(g), (unsigned)__builtin_amdgcn_readfirstlane((int)(unsigned)(uintptr_t)(l)))
template <int DQK>
__device__ __forceinline__ void attn_unit(int tid, LAS unsigned char* lds, const Tensors& A, int b, int h, int qb) {
    constexpr int ND = DQK / 16, NCH = DQK / 8, KSLOT = NCH * 1024, NKD = NCH > 8 ? 2 : 1, VSLOT = 8192, NT = S / 64;
    constexpr int KOFF = 0, VOFF = 3 * KSLOT, OST = VOFF + 3 * VSLOT, WSF = OST + 8 * 4096;
    static_assert(WSF + 8 * 256 <= RING_BYTES, "attention LDS");
    const int lane = tid & 63, r32 = lane & 31, hi = lane >> 5, wid = __builtin_amdgcn_readfirstlane(tid >> 6);
    const int kvh = h / A.group; const size_t rowb = (size_t)b * S;
    const bf16_t* ksrc = A.K + (rowb + lane) * A.kp + kvh * DQK + wid * 8;
    const bf16_t* ksrc2 = A.K + (rowb + lane) * A.kp + kvh * DQK + (8 + (wid & 3)) * 8;
    const bf16_t* vsrc = A.V + (rowb + 16 * (wid & 3) + (lane >> 2)) * A.vp + kvh * 64 + (wid >> 2) * 32 + (lane & 3) * 8;
    const size_t ktile = (size_t)64 * A.kp, vtile = (size_t)64 * A.vp;
    LAS unsigned char* kdst = lds + KOFF + wid * 1024; LAS unsigned char* kdst2 = lds + KOFF + (8 + (wid & 3)) * 1024; LAS unsigned char* vdst = lds + VOFF + wid * 1024;
#define DMA_K(j, so) do { AT_GLDS(ksrc + (size_t)(j) * ktile, kdst + (so)); if (NKD == 2) AT_GLDS(ksrc2 + (size_t)(j) * ktile, kdst2 + (so)); } while (0)
#define DMA_V(j, so) AT_GLDS(vsrc + (size_t)(j) * vtile, vdst + (so))
    const LAS unsigned char* kp0 = lds + KOFF + hi * 1024 + r32 * 16;
    const LAS unsigned char* vp0 = lds + VOFF + ((lane >> 4) & 1) * 32 + (lane & 3) * 8 + (4 * hi + ((lane & 15) >> 2)) * 64;
    DMA_K(0, 0); DMA_V(0, 0); DMA_K(1, KSLOT); DMA_V(1, VSLOT); DMA_K(2, 2 * KSLOT);
    const bf16_t* Qw = A.Q + (rowb + qb * 256 + wid * 32 + r32) * A.qp + h * DQK + hi * 8;
    bf16x8 qr[ND];
#pragma unroll
    for (int d0 = 0; d0 < ND; ++d0) qr[d0] = *(const bf16x8*)(Qw + d0 * 16);
    asm volatile("s_waitcnt vmcnt(0)\n\ts_barrier" ::: "memory");
    bf16x8 kf[2 * ND]; s16x4 vlo[8], vhi[8];
#define KLOAD(so) do { _Pragma("unroll") for (int d0 = 0; d0 < ND; ++d0) { kf[2 * d0] = *(const LAS bf16x8*)(kp0 + (so) + d0 * 2048); kf[2 * d0 + 1] = *(const LAS bf16x8*)(kp0 + (so) + d0 * 2048 + 512); } } while (0)
#define VLOAD(so) do { _Pragma("unroll") for (int i = 0; i < 8; ++i) { vlo[i] = vtr(vp0 + (so) + (i >> 2) * 4096 + (i & 3) * 1024); vhi[i] = vtr(vp0 + (so) + (i >> 2) * 4096 + (i & 3) * 1024 + 512); } } while (0)
#define VFR(i) (bf16x8){vlo[i][0], vlo[i][1], vlo[i][2], vlo[i][3], vhi[i][0], vhi[i][1], vhi[i][2], vhi[i][3]}
    KLOAD(0);
    asm volatile("s_waitcnt lgkmcnt(0)" ::: "memory");
    if (PROBE_ATT != 5 && wid >= 4) AT_BAR();
    f32x16 o0 = {}, o1 = {}, C0, C1; u32x4 pw0, pw1, pw2, pw3; float lsum = 0.f;
    const f32x16 zero = {};
#define QK_BLOCK() do { C0 = __builtin_amdgcn_mfma_f32_32x32x16_bf16(kf[0], qr[0], zero, 0, 0, 0); C1 = __builtin_amdgcn_mfma_f32_32x32x16_bf16(kf[1], qr[0], zero, 0, 0, 0); \
        _Pragma("unroll") for (int d0 = 1; d0 < ND; ++d0) { C0 = __builtin_amdgcn_mfma_f32_32x32x16_bf16(kf[2 * d0], qr[d0], C0, 0, 0, 0); C1 = __builtin_amdgcn_mfma_f32_32x32x16_bf16(kf[2 * d0 + 1], qr[d0], C1, 0, 0, 0); } } while (0)
#define PAF(k) __builtin_bit_cast(bf16x8, pw##k)
#define PV_BLOCK() do { \
        o0 = __builtin_amdgcn_mfma_f32_32x32x16_bf16(PAF(0), VFR(0), o0, 0, 0, 0); o1 = __builtin_amdgcn_mfma_f32_32x32x16_bf16(PAF(0), VFR(4), o1, 0, 0, 0); \
        o0 = __builtin_amdgcn_mfma_f32_32x32x16_bf16(PAF(1), VFR(1), o0, 0, 0, 0); o1 = __builtin_amdgcn_mfma_f32_32x32x16_bf16(PAF(1), VFR(5), o1, 0, 0, 0); \
        o0 = __builtin_amdgcn_mfma_f32_32x32x16_bf16(PAF(2), VFR(2), o0, 0, 0, 0); o1 = __builtin_amdgcn_mfma_f32_32x32x16_bf16(PAF(2), VFR(6), o1, 0, 0, 0); \
        o0 = __builtin_amdgcn_mfma_f32_32x32x16_bf16(PAF(3), VFR(3), o0, 0, 0, 0); o1 = __builtin_amdgcn_mfma_f32_32x32x16_bf16(PAF(3), VFR(7), o1, 0, 0, 0); } while (0)
#define SOFTMAX() do { \
        _Pragma("unroll") for (int r = 0; r < 16; ++r) { C0[r] = __builtin_amdgcn_exp2f(C0[r]); C1[r] = __builtin_amdgcn_exp2f(C1[r]); } \
        f32x2 s0_ = {C0[0], C0[1]}, s1_ = {C1[0], C1[1]}; _Pragma("unroll") for (int r = 2; r < 16; r += 2) { s0_ += (f32x2){C0[r], C0[r + 1]}; s1_ += (f32x2){C1[r], C1[r + 1]}; } s0_ += s1_; lsum += s0_[0] + s0_[1]; \
        pw0 = (u32x4){cvtpk(C0[0], C0[1]), cvtpk(C0[2], C0[3]), cvtpk(C0[4], C0[5]), cvtpk(C0[6], C0[7])}; pw1 = (u32x4){cvtpk(C0[8], C0[9]), cvtpk(C0[10], C0[11]), cvtpk(C0[12], C0[13]), cvtpk(C0[14], C0[15])}; \
        pw2 = (u32x4){cvtpk(C1[0], C1[1]), cvtpk(C1[2], C1[3]), cvtpk(C1[4], C1[5]), cvtpk(C1[6], C1[7])}; pw3 = (u32x4){cvtpk(C1[8], C1[9]), cvtpk(C1[10], C1[11]), cvtpk(C1[12], C1[13]), cvtpk(C1[14], C1[15])}; } while (0)
    int ka = 2 * KSLOT, kb = 0, kc = KSLOT, va = 2 * VSLOT, vb = 0, vc = VSLOT;
#define ROT() do { const int t_ = ka; ka = kb; kb = kc; kc = t_; const int u_ = va; va = vb; vb = vc; vc = u_; } while (0)
#define PINP() asm volatile("" : "+v"(lsum) : "v"(pw0), "v"(pw1), "v"(pw2), "v"(pw3))
#if ATT_REGSTAGE
    u32x4 kst = {}, kst2 = {}, vst = {};
    const LAS unsigned char* kw = lds + KOFF + wid * 1024 + lane * 16; const LAS unsigned char* kw2 = lds + KOFF + (8 + (wid & 3)) * 1024 + lane * 16; const LAS unsigned char* vw = lds + VOFF + wid * 1024 + lane * 16;
#define ST_WRITE(WK, WV) do { if (WK) { *(LAS u32x4*)(kw + ka) = kst; if (NKD == 2 && wid < 4) *(LAS u32x4*)(kw2 + ka) = kst2; } if (WV) *(LAS u32x4*)(vw + vc) = vst; } while (0)
#define ST_LOAD(sv, IK, IV) do { if (IK) { kst = *(const u32x4*)(ksrc + (size_t)((sv) + 4) * ktile); if (NKD == 2 && wid < 4) kst2 = *(const u32x4*)(ksrc2 + (size_t)((sv) + 4) * ktile); } if (IV) vst = *(const u32x4*)(vsrc + (size_t)((sv) + 3) * vtile); } while (0)
#define STEP(sv, DOQK, DOPV, KL, VL, IK, IV, WK, WV) do { \
        AT_SCHED(); if (DOQK) QK_BLOCK(); if (DOPV) PV_BLOCK(); AT_SCHED(); \
        asm volatile("s_barrier\n\ts_nop 15\n\ts_nop 3" : "+v"(C0), "+v"(C1), "+v"(o0), "+v"(o1) :: "memory"); AT_SCHED(); \
        if (KL) KLOAD(kc); if (VL) VLOAD(vb); ST_WRITE(WK, WV); ST_LOAD(sv, IK, IV); \
        if (DOQK) { SOFTMAX(); PINP(); } AT_SCHED(); \
        asm volatile("s_waitcnt lgkmcnt(0)\n\ts_barrier" ::: "memory"); \
        AT_SCHED(); ROT(); } while (0)
    STEP(-1, true, false, true, true, true, true, false, false);
#pragma nounroll
    for (int s = 0; s < NT - 4; ++s) STEP(s, true, true, true, true, true, true, true, true);
    STEP(NT - 4, true, true, true, true, false, true, true, true);
    STEP(NT - 3, true, true, true, true, false, false, false, true);
    STEP(NT - 2, true, true, false, true, false, false, false, false);
    STEP(NT - 1, false, true, false, false, false, false, false, false);
#undef ST_WRITE
#undef ST_LOAD
#else
#define STEP(sv, DOQK, DOPV, KL, VL, IK, IV) do { \
        AT_SCHED(); if (DOQK) QK_BLOCK(); if (DOPV) PV_BLOCK(); AT_SCHED(); \
          \
        asm volatile("s_barrier\n\ts_nop 15\n\ts_nop 3" : "+v"(C0), "+v"(C1), "+v"(o0), "+v"(o1) :: "memory"); AT_SCHED(); \
        if (KL) KLOAD(kc); if (VL) VLOAD(vb); if (IK) DMA_K((sv) + 4, kb); if (IV) DMA_V((sv) + 3, va); \
        if (DOQK) { SOFTMAX(); PINP(); } AT_SCHED(); \
        if (IK) { if (NKD == 2) { AT_WAITBAR(3); } else { AT_WAITBAR(2); } } else if (IV) { AT_WAITBAR(1); } else { AT_WAITBAR(0); } \
        AT_SCHED(); ROT(); } while (0)
    STEP(-1, true, false, true, true, true, true);
#pragma nounroll
    for (int s = 0; s < NT - 4; ++s) STEP(s, true, true, true, true, true, true);
    STEP(NT - 4, true, true, true, true, false, true);
    STEP(NT - 3, true, true, true, true, false, false);
    STEP(NT - 2, true, true, false, true, false, false);
    STEP(NT - 1, false, true, false, false, false, false);
#endif
#undef STEP
#undef PINP
    if (PROBE_ATT != 5 && wid < 4) AT_BAR();
    { auto rr = __builtin_amdgcn_permlane32_swap(__float_as_uint(lsum), __float_as_uint(lsum), false, false); lsum = __uint_as_float(rr[0]) + __uint_as_float(rr[1]); }
    LAS float* wsf = (LAS float*)(lds + WSF + wid * 256);
    if (hi == 0) wsf[r32] = lsum;
    asm volatile("s_waitcnt lgkmcnt(0)" ::: "memory");
    LAS bf16_t* stg = (LAS bf16_t*)(lds + OST + wid * 4096);
#pragma unroll
    for (int r = 0; r < 16; ++r) { const int orow = crow(r, hi); const float rl = __builtin_amdgcn_rcpf(wsf[orow]);
        stg[orow * 64 + r32] = (bf16_t)(cvtpk(o0[r] * rl, 0.f) & 0xffffu); stg[orow * 64 + 32 + r32] = (bf16_t)(cvtpk(o1[r] * rl, 0.f) & 0xffffu); }
    asm volatile("s_waitcnt lgkmcnt(0)" ::: "memory");
    bf16_t* Ow = A.O + (rowb + qb * 256 + wid * 32) * A.op + h * 64;
#pragma unroll
    for (int i = 0; i < 4; ++i) { const int row = i * 8 + (lane >> 3), ch = lane & 7; const u32x4 v = *(const LAS u32x4*)(stg + row * 64 + ch * 8); *(u32x4*)(Ow + (size_t)row * A.op + ch * 8) = v; }
    asm volatile("s_waitcnt lgkmcnt(0)\n\ts_barrier" ::: "memory");
#undef DMA_K
#undef DMA_V
#undef KLOAD
#undef VLOAD
#undef VFR
#undef QK_BLOCK
#undef PAF
#undef PV_BLOCK
#undef SOFTMAX
#undef ROT
}
#endif
template <int DQK>
__device__ __forceinline__ void attn_phase(int tid, LAS unsigned char* lds, const Tensors& A, int vcu, int G) {
#if FAST_ATTN
    int bh, qb;
    for (int i = 0; next_unit(i, vcu, G, bh, qb); ++i) attn_unit<DQK>(tid, lds, A, bh >> 3, bh & 7, qb);
#else
    (void)lds; attn_phase_ref<DQK>(tid, A, vcu, G);
#endif
}
}


struct Args { const float* in[22]; float* out; unsigned char* ws; int ph_lo, ph_hi; };
struct Frame {
    LAS unsigned char* lds; volatile LAS unsigned* MISC; unsigned* ctl;
    int tid, lane, wave, vcu, G;
    unsigned char* ws; float* OUT;
};

__device__ __forceinline__ void p0_phase(Frame& F, const float* c, const float* w_ada, const float* b_ada) {
    LAS float* cs = (LAS float*)F.lds;
    LAS float* red = (LAS float*)(F.lds + 32768);
    for (int i = F.tid; i < NB * D; i += NTHREADS) { const float v = c[i]; cs[i] = v / (1.f + __expf(-v)); }
    __syncthreads();
    float* mod = (float*)(F.ws + WS_MOD);
    const int kq = F.wave, col = F.lane;
    for (int item = F.vcu; item < NL * 6 * D / 64; item += F.G) {
        const int l = item / (6 * D / 64), n0 = (item % (6 * D / 64)) * 64;
        const float* w = w_ada + (size_t)l * D * 6 * D + n0 + col;
        float acc[NB];
#pragma unroll
        for (int b = 0; b < NB; ++b) acc[b] = 0.f;
#pragma unroll 8
        for (int k = kq * 128; k < kq * 128 + 128; ++k) { const float wv = w[(size_t)k * 6 * D];
#pragma unroll
            for (int b = 0; b < NB; ++b) acc[b] += cs[b * D + k] * wv; }
#pragma unroll
        for (int b = 0; b < NB; ++b) red[(kq * NB + b) * 64 + col] = acc[b];
        __syncthreads();
        { const int b = F.wave; float s = 0.f;
#pragma unroll
          for (int q = 0; q < 8; ++q) s += red[(q * NB + b) * 64 + col];
          mod[((size_t)l * NB + b) * 6 * D + n0 + col] = s + b_ada[(size_t)l * 6 * D + n0 + col]; }
        __syncthreads();
    }
    float* cosA = (float*)(F.ws + WS_COSA); float* sinA = (float*)(F.ws + WS_SINA); float* cosB = (float*)(F.ws + WS_COSB); float* sinB = (float*)(F.ws + WS_SINB);
    for (int idx = F.vcu * NTHREADS + F.tid; idx < S * 48; idx += F.G * NTHREADS) {
        const int s = idx / 48, i = idx % 48; const float row = (float)(s >> 6), col2 = (float)(s & 63);
        if (i < 32) { const int j = i & 15; const float a = (i < 16 ? row : col2) * (1.0f / powf(10000.0f, (float)j / 16.0f)); cosA[s * 32 + i] = cosf(a); sinA[s * 32 + i] = sinf(a); }
        else { const int ii = i - 32, j = ii & 7; const float a = (ii < 8 ? row : col2) * (1.0f / powf(10000.0f, (float)j / 8.0f)); cosB[s * 16 + ii] = cosf(a); sinB[s * 16 + ii] = sinf(a); }
    }
}

template <class SrcFn>
__device__ __forceinline__ void cvt_item(const float* W, int K, int Nsrc, const float* kg, bf16_t* WT, LAS float* scr, int item, int nblk, int lane, const SrcFn& src) {
    const int kb = item / nblk, nb = item % nblk, k0 = 64 * kb, n0 = 32 * nb;
    const int sc = src(n0 + (lane & 31));
#pragma unroll
    for (int i = 0; i < 32; ++i) { const int kk = 2 * i + (lane >> 5); float v = sc >= 0 ? W[(size_t)(k0 + kk) * Nsrc + sc] : 0.f; if (kg) v *= kg[k0 + kk]; scr[kk * 33 + (lane & 31)] = v; }
    LDS_WAIT(); asm volatile("" ::: "memory");
    const int c = lane & 7;
#pragma unroll
    for (int j = 0; j < 4; ++j) { const int n = (lane >> 3) + 8 * j; const LAS float* s = scr + (8 * c) * 33 + n;
        u32x4 o; o.x = cvt_pk_bf16(s[0 * 33], s[1 * 33]); o.y = cvt_pk_bf16(s[2 * 33], s[3 * 33]); o.z = cvt_pk_bf16(s[4 * 33], s[5 * 33]); o.w = cvt_pk_bf16(s[6 * 33], s[7 * 33]);
        *(u32x4*)(WT + (size_t)(n0 + n) * K + k0 + 8 * c) = o; }
    LDS_WAIT(); asm volatile("" ::: "memory");
}
struct SrcId { __device__ int operator()(int n) const { return n; } };
struct SrcIn { __device__ int operator()(int n) const { return gp::src_col_in(n); } };
typedef __attribute__((address_space(4))) const Args CArgsW;
__device__ __forceinline__ void convert_weights(Frame& F, CArgsW* a, int l) {
    LAS float* scr = (LAS float*)(F.lds + F.wave * 16384);
    const int gw = F.vcu * NWAVES + F.wave, NGW = F.G * NWAVES;
    const float* w_in = ((const float*)(GAS const float*)a->in[5]) + (size_t)l * D * INC; const float* w_q_b = ((const float*)(GAS const float*)a->in[10]) + (size_t)l * 384 * 768; const float* w_kv_b = ((const float*)(GAS const float*)a->in[11]) + (size_t)l * 256 * 1024;
    const float* w_pa = ((const float*)(GAS const float*)a->in[12]) + (size_t)l * 512 * D; const float* w_pb = ((const float*)(GAS const float*)a->in[13]) + (size_t)l * 512 * D; const float* w_o = ((const float*)(GAS const float*)a->in[14]) + (size_t)l * D * D;
    const float* w1 = ((const float*)(GAS const float*)a->in[18]) + (size_t)l * NE * D * FF; const float* w3 = ((const float*)(GAS const float*)a->in[19]) + (size_t)l * NE * D * FF; const float* w2 = ((const float*)(GAS const float*)a->in[20]) + (size_t)l * NE * FF * D;
    const float* gqa = ((const float*)(GAS const float*)a->in[8]) + l * 384; const float* gkv = ((const float*)(GAS const float*)a->in[9]) + l * 256;
    bf16_t* Win = (bf16_t*)(F.ws + WS_WIN); bf16_t* Wqb = (bf16_t*)(F.ws + WS_WQB); bf16_t* Wkvb = (bf16_t*)(F.ws + WS_WKVB); bf16_t* Wpa = (bf16_t*)(F.ws + WS_WPA); bf16_t* Wpb = (bf16_t*)(F.ws + WS_WPB);
    bf16_t* Wo = (bf16_t*)(F.ws + WS_WO); bf16_t* W13 = (bf16_t*)(F.ws + WS_W13); bf16_t* W2 = (bf16_t*)(F.ws + WS_W2);
    constexpr int I_IN = (D / 64) * (NIN / 32), I_QB = (384 / 64) * (768 / 32), I_KVB = (256 / 64) * (1024 / 32), I_P = (512 / 64) * (D / 32), I_O = (D / 64) * (D / 32);
    constexpr int I_13 = (D / 64) * (1024 / 32), I_2 = (FF / 64) * (D / 32);
    constexpr int NITEMS = I_IN + I_QB + I_KVB + 2 * I_P + I_O + NE * (I_13 + I_2);
    for (int it = gw; it < NITEMS; it += NGW) {
        int r = it;
        if (r < I_IN) { cvt_item(w_in, D, INC, nullptr, Win, scr, r, NIN / 32, F.lane, SrcIn()); continue; } r -= I_IN;
        if (r < I_QB) { cvt_item(w_q_b, 384, 768, gqa, Wqb, scr, r, 768 / 32, F.lane, SrcId()); continue; } r -= I_QB;
        if (r < I_KVB) { cvt_item(w_kv_b, 256, 1024, gkv, Wkvb, scr, r, 1024 / 32, F.lane, SrcId()); continue; } r -= I_KVB;
        if (r < I_P) { cvt_item(w_pa, 512, D, nullptr, Wpa, scr, r, D / 32, F.lane, SrcId()); continue; } r -= I_P;
        if (r < I_P) { cvt_item(w_pb, 512, D, nullptr, Wpb, scr, r, D / 32, F.lane, SrcId()); continue; } r -= I_P;
        if (r < I_O) { cvt_item(w_o, D, D, nullptr, Wo, scr, r, D / 32, F.lane, SrcId()); continue; } r -= I_O;
        if (r < NE * I_13) { const int e = r / I_13, q = r % I_13, nb = q % 32;
            const float* src = ((nb & 7) < 4 ? w1 : w3) + (size_t)e * D * FF; const int cb = (nb >> 3) * 128 + (nb & 3) * 32;
            struct SrcOff { int n0, cb; __device__ int operator()(int n) const { return cb + (n - n0); } } so{nb * 32, cb};
            cvt_item(src, D, FF, nullptr, W13 + (size_t)e * 1024 * D, scr, q, 32, F.lane, so); continue; } r -= NE * I_13;
        { const int e = r / I_2, q = r % I_2; cvt_item(w2 + (size_t)e * FF * D, FF, D, nullptr, W2 + (size_t)e * D * FF, scr, q, D / 32, F.lane, SrcId()); }
    }
}

template <int MODE>
__device__ __forceinline__ void row_phase(Frame& F, const float* xin, const float* g2prev, const float* gain, const float* modl, int sh_off, int sc_off, bf16_t* H, bf16_t* XB, float* OUT) {
    constexpr int RB = 4;
    const int gw = F.vcu * NWAVES + F.wave, NGW = F.G * NWAVES;
    const bf16_t* Y2 = (const bf16_t*)(F.ws + WS_Y2);
    for (int m0 = gw; m0 < T; m0 += RB * NGW) {
        f32x4 v[RB][4]; float ss[RB];
        if (MODE == 0) {
#pragma unroll
            for (int r = 0; r < RB; ++r)
#pragma unroll
                for (int j = 0; j < 4; ++j) v[r][j] = *(const f32x4*)(xin + (size_t)(m0 + r * NGW) * D + 4 * F.lane + 256 * j);
        } else {
            u32x2 ya[RB][4], yb[RB][4]; f32x4 g[RB][4];
#pragma unroll
            for (int r = 0; r < RB; ++r)
#pragma unroll
                for (int j = 0; j < 4; ++j) { const int m = m0 + r * NGW, c = 4 * F.lane + 256 * j;
                    { const u32x2 xb = *(const u32x2*)(XB + (size_t)m * D + c); v[r][j] = (f32x4){bf2f(xb.x & 0xffffu), bf2f(xb.x >> 16), bf2f(xb.y & 0xffffu), bf2f(xb.y >> 16)}; } ya[r][j] = *(const u32x2*)(Y2 + (size_t)(2 * m) * D + c); yb[r][j] = *(const u32x2*)(Y2 + (size_t)(2 * m + 1) * D + c);
                    g[r][j] = *(const f32x4*)(g2prev + (size_t)(m >> 12) * 6 * D + 5 * D + c); }
#pragma unroll
            for (int r = 0; r < RB; ++r)
#pragma unroll
                for (int j = 0; j < 4; ++j) { f32x4 y; y[0] = bf2f(ya[r][j].x & 0xffffu) + bf2f(yb[r][j].x & 0xffffu); y[1] = bf2f(ya[r][j].x >> 16) + bf2f(yb[r][j].x >> 16); y[2] = bf2f(ya[r][j].y & 0xffffu) + bf2f(yb[r][j].y & 0xffffu); y[3] = bf2f(ya[r][j].y >> 16) + bf2f(yb[r][j].y >> 16);
                    v[r][j] += g[r][j] * y; }
        }
#pragma unroll
        for (int r = 0; r < RB; ++r) { ss[r] = (gp::dot4(v[r][0]) + gp::dot4(v[r][1])) + (gp::dot4(v[r][2]) + gp::dot4(v[r][3])); }
#pragma unroll
        for (int o = 1; o < 64; o <<= 1)
#pragma unroll
            for (int r = 0; r < RB; ++r) ss[r] += __shfl_xor(ss[r], o);
#pragma unroll
        for (int r = 0; r < RB; ++r) {
            const int m = m0 + r * NGW, b = m >> 12; const float rstd = rsqrtf(ss[r] * (1.f / D) + EPS);
#pragma unroll
            for (int j = 0; j < 4; ++j) {
                const int c = 4 * F.lane + 256 * j; const f32x4 gn = *(const f32x4*)(gain + c);
                if (MODE == 2) { *(f32x4*)(OUT + (size_t)m * D + c) = v[r][j] * rstd * gn; }
                else {
                    { u32x2 xw; xw.x = cvt_pk_bf16(v[r][j][0], v[r][j][1]); xw.y = cvt_pk_bf16(v[r][j][2], v[r][j][3]); *(u32x2*)(XB + (size_t)m * D + c) = xw; }
                    const f32x4 sc = *(const f32x4*)(modl + (size_t)b * 6 * D + sc_off + c), sh = *(const f32x4*)(modl + (size_t)b * 6 * D + sh_off + c);
                    const f32x4 hv = v[r][j] * rstd * gn * (1.f + sc) + sh;
                    u32x2 w; w.x = cvt_pk_bf16(hv[0], hv[1]); w.y = cvt_pk_bf16(hv[2], hv[3]);
                    *(u32x2*)(H + (size_t)m * D + c) = w;
                }
            }
        }
    }
}

__device__ __forceinline__ void t2_phase(Frame& F, const float* gain, const float* modl, const float* w_router, const float* rbias, int l, bool record) {
    LAS f32x4* wl = (LAS f32x4*)F.lds;
    LAS int* rec = (LAS int*)(F.lds + 65536);
    LAS float* recw = (LAS float*)(F.lds + 65536 + 2048);
    LAS int* lcnt = (LAS int*)(F.lds + 65536 + 4096);
    for (int idx = F.tid; idx < 4096; idx += NTHREADS) {
        const int lane = idx & 63, c = (idx >> 6) & 3, i = (idx >> 8) & 3, j = idx >> 10; const int k = 4 * lane + 256 * j + i;
        wl[idx] = *(const f32x4*)(w_router + (size_t)k * NE + 4 * c);
    }
    if (F.tid < 32) lcnt[F.tid] = 0;
    __syncthreads();
    constexpr int RB = 4;
    const int gw = F.vcu * NWAVES + F.wave, NGW = F.G * NWAVES;
    bf16_t* H = (bf16_t*)(F.ws + WS_H); const bf16_t* XB = (const bf16_t*)(F.ws + WS_XB);
    const int lane = F.lane, myrow = lane >> 4, mye = lane & 15;
    int it = 0;
    for (int m0 = gw; m0 < T; m0 += RB * NGW, ++it) {
        f32x4 v[RB][4]; float ss[RB];
#pragma unroll
        for (int r = 0; r < RB; ++r)
#pragma unroll
            for (int j = 0; j < 4; ++j) { const u32x2 xb = *(const u32x2*)(XB + (size_t)(m0 + r * NGW) * D + 4 * lane + 256 * j); v[r][j] = (f32x4){bf2f(xb.x & 0xffffu), bf2f(xb.x >> 16), bf2f(xb.y & 0xffffu), bf2f(xb.y >> 16)}; }
#pragma unroll
        for (int r = 0; r < RB; ++r) ss[r] = (gp::dot4(v[r][0]) + gp::dot4(v[r][1])) + (gp::dot4(v[r][2]) + gp::dot4(v[r][3]));
#pragma unroll
        for (int o = 1; o < 64; o <<= 1)
#pragma unroll
            for (int r = 0; r < RB; ++r) ss[r] += __shfl_xor(ss[r], o);
        float acc[RB * NE];
#pragma unroll
        for (int q = 0; q < RB * NE; ++q) acc[q] = 0.f;
#pragma unroll
        for (int j = 0; j < 4; ++j) {
            const int c = 4 * lane + 256 * j; const f32x4 gn = *(const f32x4*)(gain + c);
#pragma unroll
            for (int r = 0; r < RB; ++r) {
                const int m = m0 + r * NGW, b = m >> 12; const float rstd = rsqrtf(ss[r] * (1.f / D) + EPS);
                const f32x4 sc = *(const f32x4*)(modl + (size_t)b * 6 * D + 4 * D + c), sh = *(const f32x4*)(modl + (size_t)b * 6 * D + 3 * D + c);
                v[r][j] = v[r][j] * rstd * gn * (1.f + sc) + sh;
                u32x2 w; w.x = cvt_pk_bf16(v[r][j][0], v[r][j][1]); w.y = cvt_pk_bf16(v[r][j][2], v[r][j][3]);
                *(u32x2*)(H + (size_t)m * D + c) = w;
            }
#pragma unroll
            for (int i = 0; i < 4; ++i)
#pragma unroll
                for (int c4 = 0; c4 < 4; ++c4) { const f32x4 wv = wl[((j * 4 + i) * 4 + c4) * 64 + lane];
#pragma unroll
                    for (int r = 0; r < RB; ++r) { const float hv = v[r][j][i];
                        acc[r * NE + 4 * c4 + 0] += hv * wv[0]; acc[r * NE + 4 * c4 + 1] += hv * wv[1]; acc[r * NE + 4 * c4 + 2] += hv * wv[2]; acc[r * NE + 4 * c4 + 3] += hv * wv[3]; } }
        }
#pragma unroll
        for (int sft = 32; sft >= 1; sft >>= 1) {
            const bool up = (lane & sft) != 0;
#pragma unroll
            for (int k = 0; k < sft; ++k) { const float a = acc[k], b = acc[k + sft]; const float keep = up ? b : a, send = up ? a : b; acc[k] = keep + __shfl_xor(send, sft); }
        }
        const float logit = acc[0];
        const float score = 1.f / (1.f + expf(-logit));
        float scv[NE], bi[NE];
#pragma unroll
        for (int e = 0; e < NE; ++e) { scv[e] = __shfl(score, (lane & 48) | e); bi[e] = scv[e] + rbias[e]; }
        int gsel = 0; float gbest = -INFINITY;
#pragma unroll
        for (int g = 0; g < 4; ++g) { float m1 = -INFINITY, m2 = -INFINITY;
#pragma unroll
            for (int j = 0; j < 4; ++j) { const float x = bi[g * 4 + j]; if (x > m1) { m2 = m1; m1 = x; } else if (x > m2) m2 = x; }
            const float gs = m1 + m2; if (gs > gbest) { gbest = gs; gsel = g; } }
        int e1 = -1, e2 = -1; float b1 = -INFINITY, b2 = -INFINITY, s1 = 0.f, s2 = 0.f;
#pragma unroll
        for (int j = 0; j < 4; ++j) { float x = -INFINITY, sx = 0.f;
#pragma unroll
            for (int g = 0; g < 4; ++g) if (g == gsel) { x = bi[g * 4 + j]; sx = scv[g * 4 + j]; }
            const int e = gsel * 4 + j;
            if (x > b1) { b2 = b1; e2 = e1; s2 = s1; b1 = x; e1 = e; s1 = sx; } else if (x > b2) { b2 = x; e2 = e; s2 = sx; } }
        if (mye == 0) {
            const float inv = 1.f / (s1 + s2); const int slot = (it * RB + myrow) * NWAVES + F.wave;
            rec[slot * 4 + 0] = e1; rec[slot * 4 + 1] = e2;
            rec[slot * 4 + 2] = __hip_atomic_fetch_add(&lcnt[e1], 1, __ATOMIC_RELAXED, __HIP_MEMORY_SCOPE_WORKGROUP);
            rec[slot * 4 + 3] = __hip_atomic_fetch_add(&lcnt[e2], 1, __ATOMIC_RELAXED, __HIP_MEMORY_SCOPE_WORKGROUP);
            recw[slot * 2 + 0] = s1 * inv; recw[slot * 2 + 1] = s2 * inv;
        }
    }
    __syncthreads();
    if (!record) return;
    if (F.tid < NE) lcnt[16 + F.tid] = (int)__hip_atomic_fetch_add(F.ctl + CW_CNT + (l * NE + F.tid) * 64, (unsigned)lcnt[F.tid], __ATOMIC_RELAXED, __HIP_MEMORY_SCOPE_AGENT);
    __syncthreads();
    unsigned* list = (unsigned*)(F.ws + WS_LIST); float* gwb = (float*)(F.ws + WS_GW);
    const int nrows = it * RB;
    for (int s = F.tid; s < nrows * NWAVES; s += NTHREADS) {
        const int i2 = s / NWAVES, w = s % NWAVES; const int m = F.vcu * NWAVES + w + i2 * NGW;
        const int e1 = rec[s * 4 + 0], e2 = rec[s * 4 + 1];
        list[(size_t)e1 * T + lcnt[16 + e1] + rec[s * 4 + 2]] = (unsigned)(2 * m); list[(size_t)e2 * T + lcnt[16 + e2] + rec[s * 4 + 3]] = (unsigned)(2 * m + 1);
        gwb[2 * m] = recw[s * 2]; gwb[2 * m + 1] = recw[s * 2 + 1];
    }
}
__device__ __forceinline__ const LAS int* moe_table(Frame& F, int l) {
    LAS int* tab = (LAS int*)(F.lds + MISC_OFF + 1024);
    __syncthreads();
    if (F.tid == 0) { int acc = 0;
        for (int e = 0; e < NE; ++e) { const int c = (int)__hip_atomic_load(F.ctl + CW_CNT + (l * NE + e) * 64, __ATOMIC_RELAXED, __HIP_MEMORY_SCOPE_AGENT); tab[e] = acc; tab[32 + e] = c; acc += (c + 255) >> 8; }
        tab[16] = acc; }
    __syncthreads();
    return tab;
}

typedef __attribute__((address_space(4))) const Args CArgs;
#define LAUNDER_GP(T_, p) do { GAS T_* _t = (GAS T_*)(p); asm volatile("" : "+s"(_t)); (p) = (T_*)_t; } while (0)
#define PH_BEGIN() LAUNDER_V(F.tid); F.lane = F.tid & 63; LAUNDER_GP(unsigned, F.ctl); LAUNDER_GP(float, F.OUT); LAUNDER_GP(unsigned char, F.ws); GAS unsigned char* ws = (GAS unsigned char*)F.ws; CArgs* ka = (CArgs*)__builtin_amdgcn_kernarg_segment_ptr(); LAUNDER_S(ka); \
    float* mod = WSP(float, WS_MOD); (void)mod; (void)ka
#define WSP(T_, off) ((T_*)(GAS T_*)(ws + (off)))
#define KIN(i) ((const float*)(GAS const float*)ka->in[i])
__global__ void __launch_bounds__(NTHREADS, 2) fwd_kernel(Args args) {
    extern __shared__ __attribute__((aligned(16))) unsigned char lds_raw[];
    Frame F;
    F.lds = (LAS unsigned char*)lds_raw; F.MISC = (volatile LAS unsigned*)(F.lds + MISC_OFF);
    F.tid = threadIdx.x; F.lane = F.tid & 63; F.wave = __builtin_amdgcn_readfirstlane(F.tid >> 6);
    F.G = gridDim.x; { const int bx = blockIdx.x; F.vcu = (F.G % 8 == 0) ? (bx % 8) * (F.G / 8) + bx / 8 : bx; }
    F.ws = (unsigned char*)(GAS unsigned char*)args.ws; F.ctl = (unsigned*)(GAS unsigned*)(args.ws + WS_CTL); F.OUT = (float*)(GAS float*)args.out;
    if (F.tid < 64) F.MISC[F.tid] = 0u;
    __syncthreads();
    XcdBarrier bar; bar.bar = F.ctl + CW_BAR; bar.x = 0; bar.st = nullptr;
    if (!N_LAUNCH_MODE) bar = xcd_barrier_post(F.ctl + CW_BAR, F.MISC + 8);
    const int lo = args.ph_lo, hi = args.ph_hi;
#define IN(k) (lo <= (k) && (k) < hi)
#define SEAM(k) do { if ((k) + 1 < hi) { if (!N_LAUNCH_MODE) xcd_barrier(bar); } } while (0)
    const int cidx = (int)blockIdx.x;

    if (IN(0)) { PH_BEGIN(); p0_phase(F, KIN(1), KIN(2), KIN(3)); SEAM(0); }
    for (int l = 0; l < NL; ++l) {
        const int pb = 1 + 9 * l;
        if (IN(pb + 0)) {
            PH_BEGIN();
            for (int rep = 0; rep < ((PROBE_DUP & 8) ? 2 : 1); ++rep) { LAUNDER_V(F.tid); F.lane = F.tid & 63; convert_weights(F, ka, l); }
            if (l == 0) row_phase<0>(F, KIN(0), nullptr, KIN(4) + l * D, mod + (size_t)l * NB * 6 * D, 0, D, WSP(bf16_t, WS_H), WSP(bf16_t, WS_XB), nullptr);
            else row_phase<1>(F, nullptr, mod + (size_t)(l - 1) * NB * 6 * D, KIN(4) + l * D, mod + (size_t)l * NB * 6 * D, 0, D, WSP(bf16_t, WS_H), WSP(bf16_t, WS_XB), nullptr);
            SEAM(pb + 0);
        }
        if (IN(pb + 1)) {
            PH_BEGIN();
            gp::Gemm g{WSP(bf16_t, WS_H), WSP(const bf16_t, WS_WIN), D, 0, nullptr}; gp::DenseOrder So; So.init(T, NIN, F.G, cidx);
            gp::EpiIn E{WSP(bf16_t, WS_QA), WSP(bf16_t, WS_KA), WSP(bf16_t, WS_VA), WSP(bf16_t, WS_QLAT), WSP(bf16_t, WS_KVLAT), WSP(bf16_t, WS_KB), WSP(bf16_t, WS_SA), WSP(bf16_t, WS_SB), WSP(float, WS_SSQ), WSP(float, WS_SSKV),
                        KIN(6) + l * 64, KIN(7) + l * 64, WSP(const float, WS_COSA), WSP(const float, WS_SINA), WSP(const float, WS_COSB), WSP(const float, WS_SINB)};
            if (PROBE_DUP & 128) { gp::EpiNull En; gp::gemm_phase<gp::EpiNull, gp::DenseOrder>(F.tid, F.lds, g, So, En); LAUNDER_V(F.tid); }
            gp::gemm_phase<gp::EpiIn, gp::DenseOrder>(F.tid, F.lds, g, So, E); if (PROBE_DUP & (2 | 512)) { LAUNDER_V(F.tid); gp::gemm_phase<gp::EpiIn, gp::DenseOrder>(F.tid, F.lds, g, So, E); }
            SEAM(pb + 1);
        }
        if (IN(pb + 2)) {
            { PH_BEGIN(); gp::Gemm g{WSP(bf16_t, WS_QLAT), WSP(const bf16_t, WS_WQB), 384, 0, nullptr}; gp::DenseOrder So; So.init(T, 768, F.G, cidx);
              gp::EpiQb E{WSP(bf16_t, WS_QB), WSP(const float, WS_SSQ), WSP(const float, WS_COSB), WSP(const float, WS_SINB)}; gp::gemm_phase<gp::EpiQb, gp::DenseOrder>(F.tid, F.lds, g, So, E); if (PROBE_DUP & 2) { LAUNDER_V(F.tid); gp::gemm_phase<gp::EpiQb, gp::DenseOrder>(F.tid, F.lds, g, So, E); } }
            { PH_BEGIN(); gp::Gemm g{WSP(bf16_t, WS_KVLAT), WSP(const bf16_t, WS_WKVB), 256, 0, nullptr}; gp::DenseOrder So; So.init(T, 1024, F.G, F.G - 1 - cidx);
              gp::EpiKvb E{WSP(bf16_t, WS_KB), WSP(bf16_t, WS_VB), WSP(const float, WS_SSKV)}; gp::gemm_phase<gp::EpiKvb, gp::DenseOrder>(F.tid, F.lds, g, So, E); if (PROBE_DUP & 2) { LAUNDER_V(F.tid); gp::gemm_phase<gp::EpiKvb, gp::DenseOrder>(F.tid, F.lds, g, So, E); } }
            if (PROBE_DUP & 1) { PH_BEGIN(); const at::Tensors A{WSP(bf16_t, WS_QA), 512, WSP(bf16_t, WS_KA), 128, WSP(bf16_t, WS_VA), 128, WSP(bf16_t, WS_OB), 512, 4}; at::attn_phase<64>(F.tid, F.lds, A, F.vcu, F.G); }
            { PH_BEGIN(); const at::Tensors A{WSP(bf16_t, WS_QA), 512, WSP(bf16_t, WS_KA), 128, WSP(bf16_t, WS_VA), 128, WSP(bf16_t, WS_QA), 512, 4}; at::attn_phase<64>(F.tid, F.lds, A, F.vcu, F.G); }
            SEAM(pb + 2);
        }
        if (IN(pb + 3)) {
            PH_BEGIN();
            const at::Tensors A{WSP(bf16_t, WS_QB), 768, WSP(bf16_t, WS_KB), 768, WSP(bf16_t, WS_VB), 512, WSP(bf16_t, WS_OB), 512, 1}; for (int rep = 0; rep < ((PROBE_DUP & 1) ? 2 : 1); ++rep) at::attn_phase<96>(F.tid, F.lds, A, F.vcu, F.G);
            SEAM(pb + 3);
        }
        if (IN(pb + 4)) for (int rep3 = 0; rep3 < ((PROBE_DUP & (2 | 1024)) ? 2 : 1); ++rep3) {
            { PH_BEGIN(); gp::Gemm g{WSP(bf16_t, WS_QA), WSP(const bf16_t, WS_WPA), 512, 0, nullptr}; gp::DenseOrder So; So.init(T, D, F.G, cidx);
              gp::EpiProj<0> E{WSP(bf16_t, WS_H), WSP(const bf16_t, WS_SA)}; gp::gemm_phase<gp::EpiProj<0>, gp::DenseOrder>(F.tid, F.lds, g, So, E); }
            { PH_BEGIN(); gp::Gemm g{WSP(bf16_t, WS_OB), WSP(const bf16_t, WS_WPB), 512, 0, nullptr}; gp::DenseOrder So; So.init(T, D, F.G, cidx);
              gp::EpiProj<1> E{WSP(bf16_t, WS_H), WSP(const bf16_t, WS_SB)}; gp::gemm_phase<gp::EpiProj<1>, gp::DenseOrder>(F.tid, F.lds, g, So, E); }
            if (rep3 + 1 == ((PROBE_DUP & (2 | 1024)) ? 2 : 1)) SEAM(pb + 4);
        }
        if (IN(pb + 5)) {
            PH_BEGIN();
            gp::Gemm g{WSP(bf16_t, WS_H), WSP(const bf16_t, WS_WO), D, 0, nullptr}; gp::DenseOrder So; So.init(T, D, F.G, cidx);
            gp::EpiWo E{WSP(const bf16_t, WS_XB), mod + (size_t)l * NB * 6 * D, WSP(bf16_t, WS_XB)}; gp::gemm_phase<gp::EpiWo, gp::DenseOrder>(F.tid, F.lds, g, So, E);
            SEAM(pb + 5);
        }
        if (IN(pb + 6)) {
            PH_BEGIN();
            if (PROBE_DUP & 16) { t2_phase(F, KIN(15) + l * D, mod + (size_t)l * NB * 6 * D, KIN(16), KIN(17), l, false); LAUNDER_V(F.tid); F.lane = F.tid & 63; __syncthreads(); }
            t2_phase(F, KIN(15) + l * D, mod + (size_t)l * NB * 6 * D, KIN(16), KIN(17), l, true);
            SEAM(pb + 6);
        }
        if (IN(pb + 7)) {
            PH_BEGIN();
            const LAS int* tab = moe_table(F, l);
            gp::Gemm g{WSP(bf16_t, WS_H), WSP(const bf16_t, WS_W13), D, (size_t)1024 * D, WSP(const unsigned, WS_LIST)}; gp::MoeOrder So; So.init(tab, F.G, cidx);
            if (PROBE_DUP & 256) { gp::EpiNull En; gp::gemm_phase<gp::EpiNull, gp::MoeOrder, true>(F.tid, F.lds, g, So, En); LAUNDER_V(F.tid); }
            gp::EpiUp E{WSP(bf16_t, WS_ACT)}; gp::gemm_phase<gp::EpiUp, gp::MoeOrder, true>(F.tid, F.lds, g, So, E); if (PROBE_DUP & 4) { LAUNDER_V(F.tid); gp::gemm_phase<gp::EpiUp, gp::MoeOrder, true>(F.tid, F.lds, g, So, E); }
            SEAM(pb + 7);
        }
        if (IN(pb + 8)) {
            PH_BEGIN();
            const LAS int* tab = moe_table(F, l);
            gp::Gemm g{WSP(bf16_t, WS_ACT), WSP(const bf16_t, WS_W2), FF, (size_t)D * FF, nullptr}; gp::MoeOrder So; So.init(tab, F.G, cidx);
            gp::EpiDown E{WSP(bf16_t, WS_Y2), WSP(const unsigned, WS_LIST), WSP(const float, WS_GW)}; gp::gemm_phase<gp::EpiDown, gp::MoeOrder, false>(F.tid, F.lds, g, So, E); if (PROBE_DUP & 4) { LAUNDER_V(F.tid); gp::gemm_phase<gp::EpiDown, gp::MoeOrder, false>(F.tid, F.lds, g, So, E); }
            SEAM(pb + 8);
        }
    }
    if (IN(NPHASE - 1)) { PH_BEGIN(); row_phase<2>(F, nullptr, mod + (size_t)(NL - 1) * NB * 6 * D, KIN(21), nullptr, 0, 0, nullptr, WSP(bf16_t, WS_XB), F.OUT); }
#undef IN
#undef SEAM
}

extern "C" void kernel_launch(void* const* d_in, const int* in_sizes, int n_in, void* d_out, int out_size, void* d_ws, size_t ws_size, hipStream_t stream) {
    static int grid = 0;
    if (grid == 0) {
        if (n_in != 22 || out_size != T * D || ws_size < WS_END) { fprintf(stderr, "kernel_launch: unexpected problem (n_in %d out %d ws %zu)\n", n_in, out_size, ws_size); grid = -1; return; }
        int dev = 0, cus = 0, per_cu = 0;
        if (hipGetDevice(&dev) != hipSuccess || hipDeviceGetAttribute(&cus, hipDeviceAttributeMultiprocessorCount, dev) != hipSuccess) { grid = -1; return; }
        if (hipFuncSetAttribute((const void*)fwd_kernel, hipFuncAttributeMaxDynamicSharedMemorySize, LDS_BYTES) != hipSuccess) { grid = -1; return; }
        if (hipOccupancyMaxActiveBlocksPerMultiprocessor(&per_cu, (const void*)fwd_kernel, NTHREADS, LDS_BYTES) != hipSuccess || per_cu < 1) { fprintf(stderr, "kernel_launch: occupancy query says %d\n", per_cu); }
        (void)hipGetLastError();
        grid = cus;
        if (T % (grid * NWAVES * 4) != 0) { fprintf(stderr, "kernel_launch: grid %d does not divide the row phases\n", grid); grid = -1; return; }
    }
    if (grid < 0) return;
    (void)hipMemsetAsync((char*)d_ws + WS_CTL, 0, CTL_BYTES, stream);
    Args a{};
    for (int i = 0; i < 22; ++i) a.in[i] = (const float*)d_in[i];
    a.out = (float*)d_out; a.ws = (unsigned char*)d_ws;
#if N_LAUNCH_MODE
    for (int p = 0; p < NPHASE; ++p) { a.ph_lo = p; a.ph_hi = p + 1; hipLaunchKernelGGL(fwd_kernel, dim3(grid), dim3(NTHREADS), LDS_BYTES, stream, a); }
#else
    a.ph_lo = 0; a.ph_hi = NPHASE;
    hipLaunchKernelGGL(fwd_kernel, dim3(grid), dim3(NTHREADS), LDS_BYTES, stream, a);
#endif
}
```

```cpp
#include <hip/hip_runtime.h>
#include <stdint.h>
#include <stdio.h>
#include <math.h>

#ifndef FAST_GEMM
#define FAST_GEMM 1
#endif
#ifndef FAST_ATTN
#define FAST_ATTN 1
#endif
#ifndef PROBE_DUP
#define PROBE_DUP 0
#endif
#ifndef PROBE_ATT
#define PROBE_ATT 0
#endif
#ifndef ATT_REGSTAGE
#define ATT_REGSTAGE 0
#endif
#ifndef N_LAUNCH_MODE
#define N_LAUNCH_MODE 0
#endif

#define LAS __attribute__((address_space(3)))
#define GAS __attribute__((address_space(1)))
typedef unsigned short bf16_t;
typedef short bf16x8 __attribute__((ext_vector_type(8)));
typedef float f32x4 __attribute__((ext_vector_type(4)));
typedef float f32x2 __attribute__((ext_vector_type(2)));
typedef float f32x16 __attribute__((ext_vector_type(16)));
typedef unsigned u32x4 __attribute__((ext_vector_type(4)));
typedef unsigned u32x2 __attribute__((ext_vector_type(2)));
typedef GAS unsigned gu32;

constexpr int D = 1024, NB = 8, S = 4096, T = NB * S, NL = 4, INC = 3488, NIN = 3584, NE = 16, FF = 512;
constexpr float EPS = 1e-6f, LOG2E = 1.4426950408889634f;
constexpr float QSCALE_A = 0.125f * LOG2E, QSCALE_B = 0.10206207261596577f * LOG2E;
constexpr int NWAVES = 8, NTHREADS = 512;
constexpr int NPHASE = 2 + 9 * NL;

constexpr size_t MiB = 1u << 20;
constexpr size_t WS_CTL = 0, CTL_BYTES = 1 * MiB;
constexpr size_t WS_MOD = 1 * MiB;
constexpr size_t WS_COSA = 2 * MiB, WS_SINA = WS_COSA + 512 * 1024, WS_COSB = 3 * MiB, WS_SINB = WS_COSB + 256 * 1024;
constexpr size_t WS_SSQ = 4 * MiB, WS_SSKV = 5 * MiB;
constexpr size_t WS_GW = 6 * MiB;
constexpr size_t WS_LIST = 7 * MiB;
constexpr size_t WS_WIN = 10 * MiB, WS_WQB = 17 * MiB, WS_WKVB = 18 * MiB, WS_WPA = 19 * MiB, WS_WPB = 20 * MiB, WS_WO = 21 * MiB, WS_W13 = 23 * MiB, WS_W2 = 55 * MiB;
constexpr size_t WS_H = 72 * MiB;
constexpr size_t WS_QA = 136 * MiB, WS_KA = 168 * MiB, WS_VA = 176 * MiB, WS_QLAT = 184 * MiB, WS_KVLAT = 208 * MiB;
constexpr size_t WS_KB = 224 * MiB, WS_VB = 272 * MiB, WS_QB = 304 * MiB, WS_OB = 352 * MiB, WS_SA = 384 * MiB, WS_SB = 448 * MiB, WS_XB = 512 * MiB, WS_END = 576 * MiB;
constexpr size_t WS_ACT = 136 * MiB, WS_Y2 = 208 * MiB;
constexpr int ACT_ROWS = 2 * T + NE * 256;
static_assert(WS_ACT + (size_t)ACT_ROWS * FF * 2 <= WS_Y2 && WS_Y2 + (size_t)2 * T * D * 2 <= WS_XB, "moe overlay");
constexpr int CW_BAR = 4096;
constexpr int CW_CNT = 16384;

constexpr int RING_BYTES = 131072, MISC_OFF = RING_BYTES, LDS_BYTES = 147456;

__device__ __forceinline__ float bf2f(unsigned v) { return __uint_as_float(v << 16); }
typedef __bf16 bf16x2_t __attribute__((ext_vector_type(2)));
__device__ __forceinline__ unsigned cvt_pk_bf16(float lo, float hi) { f32x2 v = {lo, hi}; bf16x2_t b = __builtin_convertvector(v, bf16x2_t); return __builtin_bit_cast(unsigned, b); }
__device__ __forceinline__ u32x4 pack8(f32x4 a, f32x4 b) { u32x4 w; w.x = cvt_pk_bf16(a[0], a[1]); w.y = cvt_pk_bf16(a[2], a[3]); w.z = cvt_pk_bf16(b[0], b[1]); w.w = cvt_pk_bf16(b[2], b[3]); return w; }
__device__ __forceinline__ void unpack8(u32x4 w, f32x4& a, f32x4& b) { a[0] = bf2f(w.x & 0xffffu); a[1] = bf2f(w.x >> 16); a[2] = bf2f(w.y & 0xffffu); a[3] = bf2f(w.y >> 16); b[0] = bf2f(w.z & 0xffffu); b[1] = bf2f(w.z >> 16); b[2] = bf2f(w.w & 0xffffu); b[3] = bf2f(w.w >> 16); }
__device__ __forceinline__ float wave_sum(float v) {
#pragma unroll
    for (int o = 1; o < 64; o <<= 1) v += __shfl_xor(v, o);
    return v;
}
__device__ __forceinline__ float sigm(float v) { return __builtin_amdgcn_rcpf(1.f + __builtin_amdgcn_exp2f(v * (-LOG2E))); }
#define VM_WAIT() asm volatile("s_waitcnt vmcnt(0)" ::: "memory")
#define LAUNDER_S(p) asm volatile("" : "+s"(p))
#define LAUNDER_V(v) asm volatile("" : "+v"(v))
#define LDS_WAIT() asm volatile("s_waitcnt lgkmcnt(0)" ::: "memory")

#define XB_TMO      128
#define XB_XCNT(j)  (256  + 64 * (j))
#define XB_XSUB(j)  (1280 + 64 * (j))
#define XB_XGEN(j)  (2304 + 64 * (j))
#define XB_TOP      3328
#define XB_TOPGEN   3392
#define XCD_BAR_WORDS 3456
#define XB_SPIN_CAP (1u << 22)
__device__ __forceinline__ unsigned xb_ld(unsigned* p)              { return __hip_atomic_load(p, __ATOMIC_RELAXED, __HIP_MEMORY_SCOPE_AGENT); }
__device__ __forceinline__ unsigned xb_add(unsigned* p, unsigned v) { return __hip_atomic_fetch_add(p, v, __ATOMIC_RELAXED, __HIP_MEMORY_SCOPE_AGENT); }
__device__ __forceinline__ unsigned xb_xcc_id() { return (unsigned)__builtin_amdgcn_s_getreg((3 << 11) | 20) & 0xFu; }
#define XB_SPIN(cond, bar) do { unsigned _sp = 0; while (cond) { __builtin_amdgcn_s_sleep(1); \
    if ((++_sp & 255u) == 0u) { if (xb_ld(&(bar)[XB_TMO])) break; if (_sp > XB_SPIN_CAP) { atomicAdd(&(bar)[XB_TMO], 1u); break; } } } } while (0)
struct XcdBarrier { unsigned* bar; unsigned x; volatile LAS unsigned* st; };
__device__ __forceinline__ XcdBarrier xcd_barrier_post(unsigned* bar, volatile LAS unsigned* st) {
    XcdBarrier b; b.bar = bar; b.x = xb_xcc_id(); b.st = st;
    if (threadIdx.x == 0) (void)xb_add(&bar[XB_XCNT(b.x)], 1u);
    return b;
}
__device__ __forceinline__ void xcd_barrier_complete(unsigned* bar, unsigned x, unsigned& nloc, unsigned& nx) {
    const unsigned G = gridDim.x * gridDim.y * gridDim.z;
    unsigned sum, cnt, mine, sp = 0u;
    for (;;) {
        sum = 0u; cnt = 0u; mine = 0u;
#pragma unroll
        for (unsigned j = 0; j < 16; ++j) { const unsigned c = xb_ld(&bar[XB_XCNT(j)]); sum += c; cnt += (c > 0u) ? 1u : 0u; mine = (j == x) ? c : mine; }
        if (sum == G) break;
        __builtin_amdgcn_s_sleep(1);
        if ((++sp & 255u) == 0u) { if (xb_ld(&bar[XB_TMO])) break; if (sp > XB_SPIN_CAP) { atomicAdd(&bar[XB_TMO], 1u); break; } }
    }
    nloc = mine > 0u ? mine : 1u; nx = cnt > 0u ? cnt : 1u;
}
__device__ __forceinline__ void xcd_barrier(const XcdBarrier& b) {
    asm volatile("s_waitcnt vmcnt(0)" ::: "memory");
    __syncthreads();
    if (threadIdx.x == 0) {
        unsigned* bar = b.bar;
        __builtin_amdgcn_s_waitcnt(0);
        unsigned nloc = b.st[0], nx = b.st[1];
        if (nloc == 0u) { xcd_barrier_complete(bar, b.x, nloc, nx); b.st[0] = nloc; b.st[1] = nx; }
        const unsigned old = xb_add(&bar[XB_XSUB(b.x)], 1u);
        const unsigned gen = old / nloc;
        if (old + 1u == (gen + 1u) * nloc) {
            __builtin_amdgcn_fence(__ATOMIC_RELEASE, "agent");
            asm volatile("s_waitcnt vmcnt(0)" ::: "memory");
            const unsigned og = xb_add(&bar[XB_TOP], 1u);
            const unsigned tg = og / nx;
            if (og + 1u == (tg + 1u) * nx) xb_add(&bar[XB_TOPGEN], 1u);
            else XB_SPIN(xb_ld(&bar[XB_TOPGEN]) == tg, bar);
            __builtin_amdgcn_fence(__ATOMIC_ACQUIRE, "agent");
            xb_add(&bar[XB_XGEN(b.x)], 1u);
            asm volatile("s_waitcnt vmcnt(0)" ::: "memory");
        } else {
            XB_SPIN(xb_ld(&bar[XB_XGEN(b.x)]) == gen, bar);
            __builtin_amdgcn_fence(__ATOMIC_ACQUIRE, "agent");
            asm volatile("s_waitcnt vmcnt(0)" ::: "memory");
        }
    }
    __syncthreads();
}

namespace gp {
constexpr int BM = 256, BK = 64, HALF = 128, HTB = HALF * BK * 2, NXCD = 8, WGM = 8;
__host__ __device__ __forceinline__ int lds_byte(int r, int c) { const int st = (r >> 4) * 2 + (c >> 5), rr = r & 15, cc = c & 31, ob = rr * 64 + cc * 2; return st * 1024 + (ob ^ (((ob >> 9) & 1) << 5)); }
__host__ __device__ __forceinline__ void stage_rc(int b, int& R, int& C) { const int st = b / 1024, sb = b % 1024, swz = sb ^ (((sb >> 9) & 1) << 5); R = (st >> 1) * 16 + swz / 64; C = (st & 1) * 32 + (swz % 64) / 2; }
__host__ __device__ __forceinline__ int perm32(int rho) { const int n = rho >> 4, i = rho & 15; return 8 * (i >> 2) + 4 * n + (i & 3); }

struct Unit { int pm, pn, be, rl, nv; };
struct Gemm { const bf16_t* A; const bf16_t* Bt; int K; size_t bstride; const unsigned* list; };

__device__ __forceinline__ int xcd_remap(int wgid, int nwg) { const int q = nwg / NXCD, r = nwg % NXCD, xcd = wgid % NXCD, off = wgid / NXCD; return (xcd < r ? xcd * (q + 1) : r * (q + 1) + (xcd - r) * q) + off; }
struct DenseOrder {
    int nM, nN, nwg, G, c;
    __device__ void init(int M, int N, int G_, int c_) { nM = M / BM; nN = N / BM; nwg = nM * nN; G = G_; c = c_; }
    __device__ bool next(int i, Unit& u) const {
        const long L = (long)i * G + c; if (L >= nwg) return false;
        const int wgid = xcd_remap((int)L, nwg);
        const int nig = WGM * nN, gid = wgid / nig, fm = gid * WGM, gsz = (nM - fm) < WGM ? (nM - fm) : WGM;
        u.pm = fm + ((wgid % nig) % gsz); u.pn = (wgid % nig) / gsz; u.be = 0; u.rl = 0; u.nv = 256; return true;
    }
};
struct MoeOrder {
    const LAS int* tab; int nwg, G, c;
    __device__ static int rd(const LAS int* p) { return __builtin_amdgcn_readfirstlane(*p); }
    __device__ void init(const LAS int* tab_, int G_, int c_) { tab = tab_; nwg = rd(tab_ + 16) * 4; G = G_; c = c_; }
    __device__ bool next(int i, Unit& u) const {
        const long L = (long)i * G + c; if (L >= nwg) return false;
        const int wgid = xcd_remap((int)L, nwg);
        const int tile = wgid >> 2; int e = 0;
        for (int k = 1; k < NE; ++k) e += (rd(tab + k) <= tile) ? 1 : 0;
        u.pm = tile; u.pn = wgid & 3; u.be = e; u.rl = tile - rd(tab + e); const int rem = rd(tab + 32 + e) - u.rl * 256; u.nv = rem < 256 ? rem : 256; return true;
    }
};

#define ACC_T f32x4 (&acc)[2][2][4][2]

template <class Epi, class Sched, bool GATHER>
__device__ __forceinline__ void gemm_phase_ref(int tid, const Gemm g, const Sched& S, const Epi& E) {
    const int wid = __builtin_amdgcn_readfirstlane(tid >> 6), lane = tid & 63, wr = wid >> 2, wc = wid & 3, fr = lane & 15, fq = lane >> 4;
    const int K = g.K; Unit u;
    for (int ui = 0; S.next(ui, u); ++ui) {
        f32x4 acc[2][2][4][2];
#pragma unroll
        for (int a = 0; a < 2; ++a)
#pragma unroll
            for (int b = 0; b < 2; ++b)
#pragma unroll
                for (int m = 0; m < 4; ++m)
#pragma unroll
                    for (int n = 0; n < 2; ++n) acc[a][b][m][n] = (f32x4){0.f, 0.f, 0.f, 0.f};
        const bf16_t* Bt = g.Bt + (size_t)u.be * g.bstride + (size_t)u.pn * 256 * K;
        for (int ai = 0; ai < 2; ++ai)
            for (int m = 0; m < 4; ++m) {
                const int rloc = ai * 128 + wr * 64 + m * 16 + fr;
                size_t arow;
                if (GATHER) { arow = (rloc < u.nv) ? (size_t)(g.list[(size_t)u.be * T + u.rl * 256 + rloc] >> 1) : 0; }
                else arow = (size_t)u.pm * 256 + rloc;
                const bf16_t* ap = g.A + arow * K;
                for (int bj = 0; bj < 2; ++bj) {
                    const bf16_t* bp = Bt + (size_t)(bj * 128 + wc * 32 + fq * 8) * K;
                    float s[8];
#pragma unroll
                    for (int c = 0; c < 8; ++c) {
                        float sc = 0.f; const bf16_t* bpc = bp + (size_t)c * K;
#pragma unroll 2
                        for (int k = 0; k < K; k += 8) {
                            f32x4 a0, a1, b0, b1; unpack8(*(const u32x4*)(ap + k), a0, a1); unpack8(*(const u32x4*)(bpc + k), b0, b1);
                            sc += a0[0] * b0[0] + a0[1] * b0[1] + a0[2] * b0[2] + a0[3] * b0[3] + a1[0] * b1[0] + a1[1] * b1[1] + a1[2] * b1[2] + a1[3] * b1[3];
                        }
                        s[c] = sc; asm volatile("" : "+v"(s[c]));
                    }
#pragma unroll
                    for (int a2 = 0; a2 < 2; ++a2)
#pragma unroll
                        for (int b2 = 0; b2 < 2; ++b2)
#pragma unroll
                            for (int m2 = 0; m2 < 4; ++m2)
                                if (a2 == ai && b2 == bj && m2 == m) { acc[a2][b2][m2][0] = (f32x4){s[0], s[1], s[2], s[3]}; acc[a2][b2][m2][1] = (f32x4){s[4], s[5], s[6], s[7]}; }
                }
            }
        E(acc, u, wr, wc, fr, fq);
    }
}

#if FAST_GEMM
template <class Epi, class Sched, bool GATHER>
__device__ __forceinline__ void gemm_phase_fast(int tid, LAS unsigned char* lds, const Gemm g, const Sched& S, const Epi& E) {
    const int wid = __builtin_amdgcn_readfirstlane(tid >> 6), lane = tid & 63, wr = wid >> 2, wc = wid & 3, fr = lane & 15, fq = lane >> 4;
    const int K = g.K, nt = K / BK;
    int Rr[2], Cc[2]; unsigned voffB[2];
#pragma unroll
    for (int i = 0; i < 2; ++i) { stage_rc(tid * 16 + i * 8192, Rr[i], Cc[i]); const int Rb = (Rr[i] & ~31) + perm32(Rr[i] & 31); voffB[i] = (unsigned)(Rb * K + Cc[i]) * 2u; }
    const size_t kstep = (size_t)(BK * 2), hstep = (size_t)HALF * K * 2, tstep = 2 * hstep;
    const unsigned ldsw = (unsigned)wid * 1024u;
    const int aoff = lds_byte(wr * 64 + fr, fq * 8), boff = lds_byte(wc * 32 + fr, fq * 8);
#define GP_SA(b, h) (((b) * 2 + (h)) * HTB)
#define GP_SB(b, h) ((4 + (b) * 2 + (h)) * HTB)
#define GP_STAGE2(bufoff, gbase, v0, v1) do { \
        __builtin_amdgcn_global_load_lds((const unsigned*)((const char*)(gbase) + (v0)), (LAS unsigned*)(lds + (bufoff) + ldsw), 16, 0, 0); \
        __builtin_amdgcn_global_load_lds((const unsigned*)((const char*)(gbase) + (v1)), (LAS unsigned*)(lds + (bufoff) + ldsw + 8192), 16, 0, 0); } while (0)
#define GP_STAGEB(bufoff, gbase) GP_STAGE2(bufoff, gbase, voffB[0], voffB[1])
#define GP_LDA(dst, b, h) do { _Pragma("unroll") for (int m = 0; m < 4; ++m) _Pragma("unroll") for (int k = 0; k < 2; ++k) dst[m][k] = *(const LAS bf16x8*)(lds + GP_SA(b, h) + aoff + m * 2048 + k * 1024); } while (0)
#define GP_LDB(dst, b, h) do { _Pragma("unroll") for (int n = 0; n < 2; ++n) _Pragma("unroll") for (int k = 0; k < 2; ++k) dst[n][k] = *(const LAS bf16x8*)(lds + GP_SB(b, h) + boff + n * 2048 + k * 1024); } while (0)
#define GP_MMA(ai, bj, At, Bt) do { __builtin_amdgcn_s_setprio(1); _Pragma("unroll") for (int m = 0; m < 4; ++m) _Pragma("unroll") for (int n = 0; n < 2; ++n) _Pragma("unroll") for (int k = 0; k < 2; ++k) \
        acc[ai][bj][m][n] = __builtin_amdgcn_mfma_f32_16x16x32_bf16(Bt[n][k], At[m][k], acc[ai][bj][m][n], 0, 0, 0); __builtin_amdgcn_s_setprio(0); } while (0)
#define GP_WAIT_V(n) asm volatile("s_waitcnt vmcnt(" #n ")" ::: "memory")
#define GP_WAIT_L(n) asm volatile("s_waitcnt lgkmcnt(" #n ")" ::: "memory")
#define GP_BAR __builtin_amdgcn_s_barrier()
#define GP_SCHED __builtin_amdgcn_sched_barrier(0)
    Unit cur, nxt; int ui = 0;
    if (!S.next(0, cur)) return;
    f32x4 acc[2][2][4][2];
#pragma unroll
    for (int a = 0; a < 2; ++a)
#pragma unroll
        for (int b = 0; b < 2; ++b)
#pragma unroll
            for (int m = 0; m < 4; ++m)
#pragma unroll
                for (int n = 0; n < 2; ++n) acc[a][b][m][n] = (f32x4){0.f, 0.f, 0.f, 0.f};
    bf16x8 At[4][2], B0[2][2], B1[2][2];
    unsigned vC0, vC1, vC2, vC3, vN0, vN1, vN2, vN3;
#define GP_VOFF(u, o0, o1, o2, o3) do { if (GATHER) { \
        int tl_ = tid; LAUNDER_V(tl_); int R0_, C0_, R1_, C1_; stage_rc(tl_ * 16, R0_, C0_); stage_rc(tl_ * 16 + 8192, R1_, C1_);     \
        const unsigned* lp = g.list + (size_t)(u).be * T + (u).rl * 256; \
        const int nvm = (u).nv - 1; const int p0 = min(R0_, nvm), p1 = min(R1_, nvm), p2 = min(128 + R0_, nvm), p3 = min(128 + R1_, nvm); \
        const unsigned t0 = lp[p0] >> 1, t1 = lp[p1] >> 1, t2 = lp[p2] >> 1, t3 = lp[p3] >> 1; \
        o0 = (t0 * K + C0_) * 2u; o1 = (t1 * K + C1_) * 2u; o2 = (t2 * K + C0_) * 2u; o3 = (t3 * K + C1_) * 2u; \
      } else { o0 = (unsigned)(Rr[0] * K + Cc[0]) * 2u; o1 = (unsigned)(Rr[1] * K + Cc[1]) * 2u; o2 = o0 + (unsigned)hstep; o3 = o1 + (unsigned)hstep; } } while (0)
    GP_VOFF(cur, vC0, vC1, vC2, vC3);
    const char* cA = (const char*)g.A + (GATHER ? (size_t)0 : (size_t)cur.pm * tstep);
    const char* cB = (const char*)g.Bt + ((size_t)cur.be * g.bstride) * 2 + (size_t)cur.pn * tstep;
    GP_STAGEB(GP_SB(0, 0), cB); GP_STAGEB(GP_SB(0, 1), cB + hstep); GP_STAGE2(GP_SA(0, 0), cA, vC0, vC1); GP_STAGE2(GP_SA(0, 1), cA, vC2, vC3);
    if (wr == 1) GP_BAR;
    GP_WAIT_V(2); GP_BAR;
    GP_STAGEB(GP_SB(1, 0), cB + kstep); GP_STAGE2(GP_SA(1, 0), cA + kstep, vC0, vC1); GP_STAGEB(GP_SB(1, 1), cB + hstep + kstep);
    GP_WAIT_V(6); GP_BAR;
    for (;;) {
        const bool has_next = S.next(ui + 1, nxt);
        const char* nA = has_next ? (const char*)g.A + (GATHER ? (size_t)0 : (size_t)nxt.pm * tstep) : cA;
        const char* nB = has_next ? (const char*)g.Bt + ((size_t)nxt.be * g.bstride) * 2 + (size_t)nxt.pn * tstep : cB;
        if (has_next) { GP_VOFF(nxt, vN0, vN1, vN2, vN3); } else { vN0 = vC0; vN1 = vC1; vN2 = vC2; vN3 = vC3; }
#pragma nounroll
        for (int t = 0; t < nt; t += 2) {
            const bool last = (t == nt - 2);
            const char* a1 = cA + (size_t)(t + 1) * kstep;
            const char* a2 = last ? nA : cA + (size_t)(t + 2) * kstep; const char* b2 = last ? nB : cB + (size_t)(t + 2) * kstep;
            const char* a3 = a2 + kstep; const char* b3 = b2 + kstep;
            const unsigned w0 = last ? vN0 : vC0, w1 = last ? vN1 : vC1, w2 = last ? vN2 : vC2, w3 = last ? vN3 : vC3;
            GP_LDB(B0, 0, 0); GP_LDB(B1, 0, 1); GP_SCHED; GP_LDA(At, 0, 0); GP_STAGE2(GP_SA(1, 1), a1, vC2, vC3);
            GP_WAIT_V(8); GP_WAIT_L(0); GP_BAR; GP_MMA(0, 0, At, B0); GP_MMA(0, 1, At, B1); GP_BAR; GP_SCHED;
            GP_LDA(At, 0, 1); GP_STAGEB(GP_SB(0, 0), b2); GP_STAGEB(GP_SB(0, 1), b2 + hstep); GP_STAGE2(GP_SA(0, 0), a2, w0, w1);
            GP_WAIT_V(8); GP_WAIT_L(0); GP_BAR; GP_MMA(1, 0, At, B0); GP_MMA(1, 1, At, B1); GP_BAR; GP_SCHED;
            GP_LDB(B0, 1, 0); GP_LDB(B1, 1, 1); GP_SCHED; GP_LDA(At, 1, 0); GP_STAGE2(GP_SA(0, 1), a2, w2, w3);
            GP_WAIT_V(8); GP_WAIT_L(0); GP_BAR; GP_MMA(0, 0, At, B0); GP_MMA(0, 1, At, B1); GP_BAR; GP_SCHED;
            GP_LDA(At, 1, 1); GP_STAGEB(GP_SB(1, 0), b3); GP_STAGEB(GP_SB(1, 1), b3 + hstep); GP_STAGE2(GP_SA(1, 0), a3, w0, w1);
            GP_WAIT_V(8); GP_WAIT_L(0); GP_BAR; GP_MMA(1, 0, At, B0); GP_MMA(1, 1, At, B1); GP_BAR; GP_SCHED;
        }
        if (wr == 0) GP_BAR;
        E(acc, cur, wr, wc, fr, fq);
        if (!has_next) break;
#pragma unroll
        for (int a = 0; a < 2; ++a)
#pragma unroll
            for (int b = 0; b < 2; ++b)
#pragma unroll
                for (int m = 0; m < 4; ++m)
#pragma unroll
                    for (int n = 0; n < 2; ++n) acc[a][b][m][n] = (f32x4){0.f, 0.f, 0.f, 0.f};
        cur = nxt; cA = nA; cB = nB; vC0 = vN0; vC1 = vN1; vC2 = vN2; vC3 = vN3; ++ui;
        if (wr == 1) GP_BAR;
    }
    GP_WAIT_V(0);
    GP_BAR;
#undef GP_SA
#undef GP_SB
#undef GP_STAGE2
#undef GP_STAGEB
#undef GP_LDA
#undef GP_LDB
#undef GP_MMA
#undef GP_WAIT_V
#undef GP_WAIT_L
#undef GP_BAR
#undef GP_SCHED
#undef GP_VOFF
}
#endif

template <class Epi, class Sched, bool GATHER = false>
__device__ __forceinline__ void gemm_phase(int tid, LAS unsigned char* lds, const Gemm g, const Sched& S, const Epi& E) {
#if FAST_GEMM
    gemm_phase_fast<Epi, Sched, GATHER>(tid, lds, g, S, E);
#else
    (void)lds; gemm_phase_ref<Epi, Sched, GATHER>(tid, g, S, E);
#endif
}

#define EPI_ROW(ai, m) (u.pm * 256 + (ai) * 128 + wr * 64 + (m) * 16 + fr)
#define EPI_COL(bj) (u.pn * 256 + (bj) * 128 + wc * 32 + fq * 8)
__device__ __forceinline__ float dot4(f32x4 a) { return (a[0] * a[0] + a[1] * a[1]) + (a[2] * a[2] + a[3] * a[3]); }

struct EpiNull {
    __device__ __forceinline__ void operator()(const ACC_T, const Unit& u, int wr, int wc, int fr, int fq) const {
#pragma unroll
        for (int ai = 0; ai < 2; ++ai)
#pragma unroll
            for (int bj = 0; bj < 2; ++bj)
#pragma unroll
                for (int m = 0; m < 4; ++m) asm volatile("" :: "v"(acc[ai][bj][m][0]), "v"(acc[ai][bj][m][1]));
    }
};
struct EpiIn {
    bf16_t *QA, *KA, *VA, *QLAT, *KVLAT, *KB, *SA, *SB; float *SSQ, *SSKV; const float *gq, *gk, *cosA, *sinA, *cosB, *sinB;
    __device__ __forceinline__ void operator()(const ACC_T, const Unit& u, int wr, int wc, int fr, int fq) const {
        const int wb = u.pn * 4 + wc;
        if (wb < 10) {
            const bool isq = wb < 8; const int head = isq ? wb : wb - 8; const float* g = isq ? gq : gk; bf16_t* dst = isq ? QA : KA; const int dp = isq ? 512 : 128; const float qs = isq ? QSCALE_A : 1.f;
            const f32x4 g00 = *(const f32x4*)(g + 8 * fq), g01 = *(const f32x4*)(g + 8 * fq + 4), g10 = *(const f32x4*)(g + 32 + 8 * fq), g11 = *(const f32x4*)(g + 36 + 8 * fq);
#pragma unroll
            for (int ai = 0; ai < 2; ++ai)
#pragma unroll
                for (int m = 0; m < 4; ++m) {
                    const int r = EPI_ROW(ai, m), pos = r & (S - 1);
                    const f32x4 v00 = acc[ai][0][m][0], v01 = acc[ai][0][m][1], v10 = acc[ai][1][m][0], v11 = acc[ai][1][m][1];
                    float ss = (dot4(v00) + dot4(v01)) + (dot4(v10) + dot4(v11)); ss += __shfl_xor(ss, 16); ss += __shfl_xor(ss, 32);
                    const float rstd = rsqrtf(ss * (1.f / 64.f) + EPS);
                    const f32x4 y00 = v00 * rstd * g00, y01 = v01 * rstd * g01, y10 = v10 * rstd * g10, y11 = v11 * rstd * g11;
                    const f32x4 c0 = *(const f32x4*)(cosA + pos * 32 + 8 * fq), c1 = *(const f32x4*)(cosA + pos * 32 + 8 * fq + 4), s0 = *(const f32x4*)(sinA + pos * 32 + 8 * fq), s1 = *(const f32x4*)(sinA + pos * 32 + 8 * fq + 4);
                    const f32x4 o00 = (y00 * c0 - y10 * s0) * qs, o01 = (y01 * c1 - y11 * s1) * qs, o10 = (y10 * c0 + y00 * s0) * qs, o11 = (y11 * c1 + y01 * s1) * qs;
                    bf16_t* p = dst + (size_t)r * dp + head * 64 + 8 * fq;
                    *(u32x4*)p = pack8(o00, o01); *(u32x4*)(p + 32) = pack8(o10, o11);
                }
        } else if (wb < 12) {
#pragma unroll
            for (int ai = 0; ai < 2; ++ai)
#pragma unroll
                for (int m = 0; m < 4; ++m) { bf16_t* p = VA + (size_t)EPI_ROW(ai, m) * 128 + (wb - 10) * 64 + 8 * fq;
                    *(u32x4*)p = pack8(acc[ai][0][m][0], acc[ai][0][m][1]); *(u32x4*)(p + 32) = pack8(acc[ai][1][m][0], acc[ai][1][m][1]); }
        } else if (wb < 22) {
            const bool isq = wb < 18; const int idx = isq ? wb - 12 : wb - 18; bf16_t* dst = isq ? QLAT : KVLAT; const int dp = isq ? 384 : 256;
#pragma unroll
            for (int ai = 0; ai < 2; ++ai)
#pragma unroll
                for (int m = 0; m < 4; ++m) {
                    const int r = EPI_ROW(ai, m);
                    const f32x4 v00 = acc[ai][0][m][0], v01 = acc[ai][0][m][1], v10 = acc[ai][1][m][0], v11 = acc[ai][1][m][1];
                    float ss = (dot4(v00) + dot4(v01)) + (dot4(v10) + dot4(v11)); ss += __shfl_xor(ss, 16); ss += __shfl_xor(ss, 32);
                    if (fq == 0) { if (isq) SSQ[(size_t)r * 8 + idx] = ss; else SSKV[(size_t)r * 4 + idx] = ss; }
                    bf16_t* p = dst + (size_t)r * dp + idx * 64 + 8 * fq;
                    *(u32x4*)p = pack8(v00, v01); *(u32x4*)(p + 32) = pack8(v10, v11);
                }
        } else if (wb == 22) {
            if (fq < 2) {
#pragma unroll
                for (int ai = 0; ai < 2; ++ai)
#pragma unroll
                    for (int m = 0; m < 4; ++m) {
                        const int r = EPI_ROW(ai, m), pos = r & (S - 1);
                        const f32x4 x10 = acc[ai][0][m][0], x11 = acc[ai][0][m][1], x20 = acc[ai][1][m][0], x21 = acc[ai][1][m][1];
                        const f32x4 c0 = *(const f32x4*)(cosB + pos * 16 + 8 * fq), c1 = *(const f32x4*)(cosB + pos * 16 + 8 * fq + 4), s0 = *(const f32x4*)(sinB + pos * 16 + 8 * fq), s1 = *(const f32x4*)(sinB + pos * 16 + 8 * fq + 4);
                        const u32x4 w1 = pack8(x10 * c0 - x20 * s0, x11 * c1 - x21 * s1), w2 = pack8(x20 * c0 + x10 * s0, x21 * c1 + x11 * s1);
                        bf16_t* p = KB + (size_t)r * 768 + 64 + 8 * fq;
#pragma unroll
                        for (int h = 0; h < 8; ++h) { *(u32x4*)(p + h * 96) = w1; *(u32x4*)(p + h * 96 + 16) = w2; }
                    }
            }
        } else if (wb == 23) {
        } else {
            const bool isa = wb < 40; const int idx = isa ? wb - 24 : wb - 40; unsigned char* dst = (unsigned char*)(isa ? SA : SB);
#pragma unroll
            for (int ai = 0; ai < 2; ++ai)
#pragma unroll
                for (int m = 0; m < 4; ++m) { unsigned char* p = dst + (size_t)EPI_ROW(ai, m) * 1024 + idx * 64 + 8 * fq;
#pragma unroll
                    for (int bj = 0; bj < 2; ++bj) { const f32x4 a = acc[ai][bj][m][0], b = acc[ai][bj][m][1]; u32x2 w;
                        w.x = (unsigned)__builtin_amdgcn_cvt_pk_fp8_f32(a[2], a[3], __builtin_amdgcn_cvt_pk_fp8_f32(a[0], a[1], 0, false), true);
                        w.y = (unsigned)__builtin_amdgcn_cvt_pk_fp8_f32(b[2], b[3], __builtin_amdgcn_cvt_pk_fp8_f32(b[0], b[1], 0, false), true);
                        *(u32x2*)(p + bj * 32) = w; } }
        }
    }
};
__host__ __device__ __forceinline__ int src_col_in(int n) {
    const int pn = n >> 8, nl = n & 255, bj = nl >> 7, wc = (nl & 127) >> 5, p = nl & 31, wb = pn * 4 + wc, s = bj * 32 + p;
    if (wb < 8) return wb * 64 + s;
    if (wb < 10) return 512 + (wb - 8) * 64 + s;
    if (wb < 12) return 640 + (wb - 10) * 64 + s;
    if (wb < 18) return 768 + (wb - 12) * 64 + s;
    if (wb < 22) return 1152 + (wb - 18) * 64 + s;
    if (wb == 22) return p < 16 ? 1408 + bj * 16 + p : -1;
    if (wb == 23) return -1;
    if (wb < 40) return 1440 + (wb - 24) * 64 + s;
    return 2464 + (wb - 40) * 64 + s;
}
struct EpiQb {
    bf16_t* QB; const float *SSQ, *cosB, *sinB;
    __device__ __forceinline__ void operator()(const ACC_T, const Unit& u, int wr, int wc, int fr, int fq) const {
#pragma unroll
        for (int ai = 0; ai < 2; ++ai)
#pragma unroll
            for (int m = 0; m < 4; ++m) {
                const int r = EPI_ROW(ai, m), pos = r & (S - 1);
                const f32x4 sa = *(const f32x4*)(SSQ + (size_t)r * 8); const f32x2 sb = *(const f32x2*)(SSQ + (size_t)r * 8 + 4);
                const float rstd = rsqrtf((((sa[0] + sa[1]) + (sa[2] + sa[3])) + (sb[0] + sb[1])) * (1.f / 384.f) + EPS);
#pragma unroll
                for (int bj = 0; bj < 2; ++bj) {
                    f32x4 v0 = acc[ai][bj][m][0] * rstd, v1 = acc[ai][bj][m][1] * rstd;
                    const int c32 = u.pn * 8 + bj * 4 + wc;
                    if (c32 % 3 == 2) {
                        f32x4 o0, o1;
#pragma unroll
                        for (int j = 0; j < 4; ++j) { o0[j] = __shfl_xor(v0[j], 32); o1[j] = __shfl_xor(v1[j], 32); }
                        const int i0 = 8 * (fq & 1);
                        const f32x4 c0 = *(const f32x4*)(cosB + pos * 16 + i0), c1 = *(const f32x4*)(cosB + pos * 16 + i0 + 4), s0 = *(const f32x4*)(sinB + pos * 16 + i0), s1 = *(const f32x4*)(sinB + pos * 16 + i0 + 4);
                        if (fq < 2) { v0 = v0 * c0 - o0 * s0; v1 = v1 * c1 - o1 * s1; } else { v0 = v0 * c0 + o0 * s0; v1 = v1 * c1 + o1 * s1; }
                    }
                    *(u32x4*)(QB + (size_t)r * 768 + EPI_COL(bj)) = pack8(v0 * QSCALE_B, v1 * QSCALE_B);
                }
            }
    }
};
struct EpiKvb {
    bf16_t *KB, *VB; const float* SSKV;
    __device__ __forceinline__ void operator()(const ACC_T, const Unit& u, int wr, int wc, int fr, int fq) const {
#pragma unroll
        for (int ai = 0; ai < 2; ++ai)
#pragma unroll
            for (int m = 0; m < 4; ++m) {
                const int r = EPI_ROW(ai, m);
                const f32x4 sa = *(const f32x4*)(SSKV + (size_t)r * 4);
                const float rstd = rsqrtf(((sa[0] + sa[1]) + (sa[2] + sa[3])) * (1.f / 256.f) + EPS);
#pragma unroll
                for (int bj = 0; bj < 2; ++bj) {
                    const int head = u.pn * 2 + bj, o = wc * 32 + fq * 8;
                    const u32x4 w = pack8(acc[ai][bj][m][0] * rstd, acc[ai][bj][m][1] * rstd);
                    if (wc < 2) *(u32x4*)(KB + (size_t)r * 768 + head * 96 + o) = w; else *(u32x4*)(VB + (size_t)r * 512 + head * 64 + (o - 64)) = w;
                }
            }
    }
};
template <int MODE> struct EpiProj {
    bf16_t* O; const bf16_t* gate;
    __device__ __forceinline__ void operator()(const ACC_T, const Unit& u, int wr, int wc, int fr, int fq) const {
#pragma unroll
        for (int ai = 0; ai < 2; ++ai)
#pragma unroll
            for (int m = 0; m < 4; ++m) {
                const int r = EPI_ROW(ai, m);
#pragma unroll
                for (int bj = 0; bj < 2; ++bj) {
                    const size_t off = (size_t)r * D + EPI_COL(bj);
                    const u32x2 gw = *(const u32x2*)((const unsigned char*)gate + off);
                    const f32x2 q0 = __builtin_amdgcn_cvt_pk_f32_fp8((int)gw.x, false), q1 = __builtin_amdgcn_cvt_pk_f32_fp8((int)gw.x, true), q2 = __builtin_amdgcn_cvt_pk_f32_fp8((int)gw.y, false), q3 = __builtin_amdgcn_cvt_pk_f32_fp8((int)gw.y, true);
                    const f32x4 g0 = {sigm(q0[0]), sigm(q0[1]), sigm(q1[0]), sigm(q1[1])}, g1 = {sigm(q2[0]), sigm(q2[1]), sigm(q3[0]), sigm(q3[1])};
                    f32x4 v0 = acc[ai][bj][m][0] * g0, v1 = acc[ai][bj][m][1] * g1;
                    if (MODE == 1) { f32x4 p0, p1; unpack8(*(const u32x4*)(O + off), p0, p1); v0 += p0; v1 += p1; }
                    *(u32x4*)(O + off) = pack8(v0, v1);
                }
            }
    }
};
struct EpiWo {
    const bf16_t* X; const float* modl; bf16_t* XO;
    __device__ __forceinline__ void operator()(const ACC_T, const Unit& u, int wr, int wc, int fr, int fq) const {
        const float* g1 = modl + (size_t)(u.pm >> 4) * 6 * D + 2 * D;
#pragma unroll
        for (int bj = 0; bj < 2; ++bj) {
            const int c = EPI_COL(bj); const f32x4 ga = *(const f32x4*)(g1 + c), gb = *(const f32x4*)(g1 + c + 4);
#pragma unroll
            for (int ai = 0; ai < 2; ++ai)
#pragma unroll
                for (int m = 0; m < 4; ++m) { const size_t off = (size_t)EPI_ROW(ai, m) * D + c;
                    f32x4 x0, x1; unpack8(*(const u32x4*)(X + off), x0, x1);
                    *(u32x4*)(XO + off) = pack8(x0 + ga * acc[ai][bj][m][0], x1 + gb * acc[ai][bj][m][1]); }
        }
    }
};
struct EpiUp {
    bf16_t* ACT;
    __device__ __forceinline__ void operator()(const ACC_T, const Unit& u, int wr, int wc, int fr, int fq) const {
#pragma unroll
        for (int ai = 0; ai < 2; ++ai)
#pragma unroll
            for (int m = 0; m < 4; ++m) {
                f32x4 a = acc[ai][0][m][0], b = acc[ai][0][m][1]; const f32x4 c = acc[ai][1][m][0], d = acc[ai][1][m][1];
#pragma unroll
                for (int j = 0; j < 4; ++j) { a[j] = a[j] * sigm(a[j]) * c[j]; b[j] = b[j] * sigm(b[j]) * d[j]; }
                *(u32x4*)(ACT + (size_t)EPI_ROW(ai, m) * FF + u.pn * 128 + wc * 32 + fq * 8) = pack8(a, b);
            }
    }
};
struct EpiDown {
    bf16_t* Y2; const unsigned* list; const float* gw;
    __device__ __forceinline__ void operator()(const ACC_T, const Unit& u, int wr, int wc, int fr, int fq) const {
#pragma unroll
        for (int ai = 0; ai < 2; ++ai)
#pragma unroll
            for (int m = 0; m < 4; ++m) {
                const int rloc = ai * 128 + wr * 64 + m * 16 + fr;
                if (rloc < u.nv) {
                    const unsigned entry = list[(size_t)u.be * T + u.rl * 256 + rloc]; const float w = gw[entry];
#pragma unroll
                    for (int bj = 0; bj < 2; ++bj) *(u32x4*)(Y2 + (size_t)entry * D + EPI_COL(bj)) = pack8(acc[ai][bj][m][0] * w, acc[ai][bj][m][1] * w);
                }
            }
    }
};
}

namespace at {
struct Tensors { const bf16_t* Q; int qp; const bf16_t* K; int kp; const bf16_t* V; int vp; bf16_t* O; int op; int group; };
__device__ __forceinline__ bool next_unit(int i, int vcu, int G, int& bh, int& qb) {
    int u;
    if (G == 256) { if (i >= 4) return false; u = (vcu >> 5) * 128 + i * 32 + (vcu & 31); }
    else { u = i * G + vcu; if (u >= 1024) return false; }
    bh = u >> 4; qb = u & 15; return true;
}
template <int DQK>
__device__ __forceinline__ void attn_phase_ref(int tid, const Tensors& A, int vcu, int G) {
    int bh, qb;
    for (int i = 0; next_unit(i, vcu, G, bh, qb); ++i) {
        const int b = bh >> 3, h = bh & 7, kvh = h / A.group;
        {
            const int dh = tid >> 8;
            const size_t row = (size_t)b * S + qb * 256 + (tid & 255);
            float q[DQK], o[32];
#pragma unroll
            for (int d = 0; d < DQK; ++d) q[d] = bf2f(A.Q[row * A.qp + h * DQK + d]);
#pragma unroll
            for (int d = 0; d < 32; ++d) o[d] = 0.f;
            float l = 0.f;
            for (int k = 0; k < S; ++k) {
                const bf16_t* kr = A.K + ((size_t)b * S + k) * A.kp + kvh * DQK; const bf16_t* vr = A.V + ((size_t)b * S + k) * A.vp + kvh * 64 + dh * 32;
                float sc = 0.f;
#pragma unroll
                for (int d = 0; d < DQK; d += 8) { f32x4 k0, k1; unpack8(*(const u32x4*)(kr + d), k0, k1);
                    sc += q[d] * k0[0] + q[d + 1] * k0[1] + q[d + 2] * k0[2] + q[d + 3] * k0[3] + q[d + 4] * k1[0] + q[d + 5] * k1[1] + q[d + 6] * k1[2] + q[d + 7] * k1[3]; }
                const float p = bf2f(cvt_pk_bf16(exp2f(sc), 0.f) & 0xffffu); l += p;
#pragma unroll
                for (int d = 0; d < 32; d += 8) { f32x4 v0, v1; unpack8(*(const u32x4*)(vr + d), v0, v1);
                    o[d] += p * v0[0]; o[d + 1] += p * v0[1]; o[d + 2] += p * v0[2]; o[d + 3] += p * v0[3]; o[d + 4] += p * v1[0]; o[d + 5] += p * v1[1]; o[d + 6] += p * v1[2]; o[d + 7] += p * v1[3]; }
            }
            const float il = 1.f / l;
            __syncthreads();
#pragma unroll
            for (int d = 0; d < 32; d += 8) { f32x4 a = {o[d] * il, o[d + 1] * il, o[d + 2] * il, o[d + 3] * il}, c = {o[d + 4] * il, o[d + 5] * il, o[d + 6] * il, o[d + 7] * il};
                *(u32x4*)(A.O + row * A.op + h * 64 + dh * 32 + d) = pack8(a, c); }
        }
    }
}
#if FAST_ATTN
typedef short s16x4 __attribute__((ext_vector_type(4)));
__device__ __forceinline__ unsigned cvtpk(float lo, float hi) { f32x2 v = {lo, hi}; bf16x2_t b = __builtin_convertvector(v, bf16x2_t); return __builtin_bit_cast(unsigned, b); }
__device__ __forceinline__ s16x4 vtr(const LAS unsigned char* p) { return __builtin_bit_cast(s16x4, __builtin_amdgcn_ds_read_tr16_b64_v4i16((LAS s16x4*)p)); }
__device__ __forceinline__ int crow(int r, int hi) { return (r & 3) + 8 * (r >> 2) + 4 * hi; }
#define AT_BAR() asm volatile("s_barrier" ::: "memory")
#define AT_WAITBAR(N) asm volatile("s_waitcnt vmcnt(" #N ") lgkmcnt(0)\n\ts_barrier" ::: "memory")
#define AT_SCHED() __builtin_amdgcn_sched_barrier(0)
__device__ __forceinline__ void glds16(const void* gsrc, unsigned lds_dst) { unsigned keep;
    asm volatile("s_mov_b32 %0, m0\n\ts_mov_b32 m0, %2\n\ts_nop 0\n\tglobal_load_lds_dwordx4 %1, off\n\ts_mov_b32 m0, %0" : "=&s"(keep) : "v"(gsrc), "s"(lds_dst) : "memory"); }
#define AT_GLDS(g, l) glds16((const void*)(g), (unsigned)__builtin_amdgcn_readfirstlane((int)(unsigned)(uintptr_t)(l)))
template <int DQK>
__device__ __forceinline__ void attn_unit(int tid, LAS unsigned char* lds, const Tensors& A, int b, int h, int qb) {
    constexpr int ND = DQK / 16, NCH = DQK / 8, KSLOT = NCH * 1024, NKD = NCH > 8 ? 2 : 1, VSLOT = 8192, NT = S / 64;
    constexpr int KOFF = 0, VOFF = 3 * KSLOT, OST = VOFF + 3 * VSLOT, WSF = OST + 8 * 4096;
    static_assert(WSF + 8 * 256 <= RING_BYTES, "attention LDS");
    const int lane = tid & 63, r32 = lane & 31, hi = lane >> 5, wid = __builtin_amdgcn_readfirstlane(tid >> 6);
    const int kvh = h / A.group; const size_t rowb = (size_t)b * S;
    const bf16_t* ksrc = A.K + (rowb + lane) * A.kp + kvh * DQK + wid * 8;
    const bf16_t* ksrc2 = A.K + (rowb + lane) * A.kp + kvh * DQK + (8 + (wid & 3)) * 8;
    const bf16_t* vsrc = A.V + (rowb + 16 * (wid & 3) + (lane >> 2)) * A.vp + kvh * 64 + (wid >> 2) * 32 + (lane & 3) * 8;
    const size_t ktile = (size_t)64 * A.kp, vtile = (size_t)64 * A.vp;
    LAS unsigned char* kdst = lds + KOFF + wid * 1024; LAS unsigned char* kdst2 = lds + KOFF + (8 + (wid & 3)) * 1024; LAS unsigned char* vdst = lds + VOFF + wid * 1024;
#define DMA_K(j, so) do { AT_GLDS(ksrc + (size_t)(j) * ktile, kdst + (so)); if (NKD == 2) AT_GLDS(ksrc2 + (size_t)(j) * ktile, kdst2 + (so)); } while (0)
#define DMA_V(j, so) AT_GLDS(vsrc + (size_t)(j) * vtile, vdst + (so))
    const LAS unsigned char* kp0 = lds + KOFF + hi * 1024 + r32 * 16;
    const LAS unsigned char* vp0 = lds + VOFF + ((lane >> 4) & 1) * 32 + (lane & 3) * 8 + (4 * hi + ((lane & 15) >> 2)) * 64;
    DMA_K(0, 0); DMA_V(0, 0); DMA_K(1, KSLOT); DMA_V(1, VSLOT); DMA_K(2, 2 * KSLOT);
    const bf16_t* Qw = A.Q + (rowb + qb * 256 + wid * 32 + r32) * A.qp + h * DQK + hi * 8;
    bf16x8 qr[ND];
#pragma unroll
    for (int d0 = 0; d0 < ND; ++d0) qr[d0] = *(const bf16x8*)(Qw + d0 * 16);
    asm volatile("s_waitcnt vmcnt(0)\n\ts_barrier" ::: "memory");
    bf16x8 kf[2 * ND]; s16x4 vlo[8], vhi[8];
#define KLOAD(so) do { _Pragma("unroll") for (int d0 = 0; d0 < ND; ++d0) { kf[2 * d0] = *(const LAS bf16x8*)(kp0 + (so) + d0 * 2048); kf[2 * d0 + 1] = *(const LAS bf16x8*)(kp0 + (so) + d0 * 2048 + 512); } } while (0)
#define VLOAD(so) do { _Pragma("unroll") for (int i = 0; i < 8; ++i) { vlo[i] = vtr(vp0 + (so) + (i >> 2) * 4096 + (i & 3) * 1024); vhi[i] = vtr(vp0 + (so) + (i >> 2) * 4096 + (i & 3) * 1024 + 512); } } while (0)
#define VFR(i) (bf16x8){vlo[i][0], vlo[i][1], vlo[i][2], vlo[i][3], vhi[i][0], vhi[i][1], vhi[i][2], vhi[i][3]}
    KLOAD(0);
    asm volatile("s_waitcnt lgkmcnt(0)" ::: "memory");
    if (PROBE_ATT != 5 && wid >= 4) AT_BAR();
    f32x16 o0 = {}, o1 = {}, C0, C1; u32x4 pw0, pw1, pw2, pw3; float lsum = 0.f;
    const f32x16 zero = {};
#define QK_BLOCK() do { C0 = __builtin_amdgcn_mfma_f32_32x32x16_bf16(kf[0], qr[0], zero, 0, 0, 0); C1 = __builtin_amdgcn_mfma_f32_32x32x16_bf16(kf[1], qr[0], zero, 0, 0, 0); \
        _Pragma("unroll") for (int d0 = 1; d0 < ND; ++d0) { C0 = __builtin_amdgcn_mfma_f32_32x32x16_bf16(kf[2 * d0], qr[d0], C0, 0, 0, 0); C1 = __builtin_amdgcn_mfma_f32_32x32x16_bf16(kf[2 * d0 + 1], qr[d0], C1, 0, 0, 0); } } while (0)
#define PAF(k) __builtin_bit_cast(bf16x8, pw##k)
#define PV_BLOCK() do { \
        o0 = __builtin_amdgcn_mfma_f32_32x32x16_bf16(PAF(0), VFR(0), o0, 0, 0, 0); o1 = __builtin_amdgcn_mfma_f32_32x32x16_bf16(PAF(0), VFR(4), o1, 0, 0, 0); \
        o0 = __builtin_amdgcn_mfma_f32_32x32x16_bf16(PAF(1), VFR(1), o0, 0, 0, 0); o1 = __builtin_amdgcn_mfma_f32_32x32x16_bf16(PAF(1), VFR(5), o1, 0, 0, 0); \
        o0 = __builtin_amdgcn_mfma_f32_32x32x16_bf16(PAF(2), VFR(2), o0, 0, 0, 0); o1 = __builtin_amdgcn_mfma_f32_32x32x16_bf16(PAF(2), VFR(6), o1, 0, 0, 0); \
        o0 = __builtin_amdgcn_mfma_f32_32x32x16_bf16(PAF(3), VFR(3), o0, 0, 0, 0); o1 = __builtin_amdgcn_mfma_f32_32x32x16_bf16(PAF(3), VFR(7), o1, 0, 0, 0); } while (0)
#define SOFTMAX() do { \
        _Pragma("unroll") for (int r = 0; r < 16; ++r) { C0[r] = __builtin_amdgcn_exp2f(C0[r]); C1[r] = __builtin_amdgcn_exp2f(C1[r]); } \
        f32x2 s0_ = {C0[0], C0[1]}, s1_ = {C1[0], C1[1]}; _Pragma("unroll") for (int r = 2; r < 16; r += 2) { s0_ += (f32x2){C0[r], C0[r + 1]}; s1_ += (f32x2){C1[r], C1[r + 1]}; } s0_ += s1_; lsum += s0_[0] + s0_[1]; \
        pw0 = (u32x4){cvtpk(C0[0], C0[1]), cvtpk(C0[2], C0[3]), cvtpk(C0[4], C0[5]), cvtpk(C0[6], C0[7])}; pw1 = (u32x4){cvtpk(C0[8], C0[9]), cvtpk(C0[10], C0[11]), cvtpk(C0[12], C0[13]), cvtpk(C0[14], C0[15])}; \
        pw2 = (u32x4){cvtpk(C1[0], C1[1]), cvtpk(C1[2], C1[3]), cvtpk(C1[4], C1[5]), cvtpk(C1[6], C1[7])}; pw3 = (u32x4){cvtpk(C1[8], C1[9]), cvtpk(C1[10], C1[11]), cvtpk(C1[12], C1[13]), cvtpk(C1[14], C1[15])}; } while (0)
    int ka = 2 * KSLOT, kb = 0, kc = KSLOT, va = 2 * VSLOT, vb = 0, vc = VSLOT;
#define ROT() do { const int t_ = ka; ka = kb; kb = kc; kc = t_; const int u_ = va; va = vb; vb = vc; vc = u_; } while (0)
#define PINP() asm volatile("" : "+v"(lsum) : "v"(pw0), "v"(pw1), "v"(pw2), "v"(pw3))
#if ATT_REGSTAGE
    u32x4 kst = {}, kst2 = {}, vst = {};
    const LAS unsigned char* kw = lds + KOFF + wid * 1024 + lane * 16; const LAS unsigned char* kw2 = lds + KOFF + (8 + (wid & 3)) * 1024 + lane * 16; const LAS unsigned char* vw = lds + VOFF + wid * 1024 + lane * 16;
#define ST_WRITE(WK, WV) do { if (WK) { *(LAS u32x4*)(kw + ka) = kst; if (NKD == 2 && wid < 4) *(LAS u32x4*)(kw2 + ka) = kst2; } if (WV) *(LAS u32x4*)(vw + vc) = vst; } while (0)
#define ST_LOAD(sv, IK, IV) do { if (IK) { kst = *(const u32x4*)(ksrc + (size_t)((sv) + 4) * ktile); if (NKD == 2 && wid < 4) kst2 = *(const u32x4*)(ksrc2 + (size_t)((sv) + 4) * ktile); } if (IV) vst = *(const u32x4*)(vsrc + (size_t)((sv) + 3) * vtile); } while (0)
#define STEP(sv, DOQK, DOPV, KL, VL, IK, IV, WK, WV) do { \
        AT_SCHED(); if (DOQK) QK_BLOCK(); if (DOPV) PV_BLOCK(); AT_SCHED(); \
        asm volatile("s_barrier\n\ts_nop 15\n\ts_nop 3" : "+v"(C0), "+v"(C1), "+v"(o0), "+v"(o1) :: "memory"); AT_SCHED(); \
        if (KL) KLOAD(kc); if (VL) VLOAD(vb); ST_WRITE(WK, WV); ST_LOAD(sv, IK, IV); \
        if (DOQK) { SOFTMAX(); PINP(); } AT_SCHED(); \
        asm volatile("s_waitcnt lgkmcnt(0)\n\ts_barrier" ::: "memory"); \
        AT_SCHED(); ROT(); } while (0)
    STEP(-1, true, false, true, true, true, true, false, false);
#pragma nounroll
    for (int s = 0; s < NT - 4; ++s) STEP(s, true, true, true, true, true, true, true, true);
    STEP(NT - 4, true, true, true, true, false, true, true, true);
    STEP(NT - 3, true, true, true, true, false, false, false, true);
    STEP(NT - 2, true, true, false, true, false, false, false, false);
    STEP(NT - 1, false, true, false, false, false, false, false, false);
#undef ST_WRITE
#undef ST_LOAD
#else
#define STEP(sv, DOQK, DOPV, KL, VL, IK, IV) do { \
        AT_SCHED(); if (DOQK) QK_BLOCK(); if (DOPV) PV_BLOCK(); AT_SCHED(); \
          \
        asm volatile("s_barrier\n\ts_nop 15\n\ts_nop 3" : "+v"(C0), "+v"(C1), "+v"(o0), "+v"(o1) :: "memory"); AT_SCHED(); \
        if (KL) KLOAD(kc); if (VL) VLOAD(vb); if (IK) DMA_K((sv) + 4, kb); if (IV) DMA_V((sv) + 3, va); \
        if (DOQK) { SOFTMAX(); PINP(); } AT_SCHED(); \
        if (IK) { if (NKD == 2) { AT_WAITBAR(3); } else { AT_WAITBAR(2); } } else if (IV) { AT_WAITBAR(1); } else { AT_WAITBAR(0); } \
        AT_SCHED(); ROT(); } while (0)
    STEP(-1, true, false, true, true, true, true);
#pragma nounroll
    for (int s = 0; s < NT - 4; ++s) STEP(s, true, true, true, true, true, true);
    STEP(NT - 4, true, true, true, true, false, true);
    STEP(NT - 3, true, true, true, true, false, false);
    STEP(NT - 2, true, true, false, true, false, false);
    STEP(NT - 1, false, true, false, false, false, false);
#endif
#undef STEP
#undef PINP
    if (PROBE_ATT != 5 && wid < 4) AT_BAR();
    { auto rr = __builtin_amdgcn_permlane32_swap(__float_as_uint(lsum), __float_as_uint(lsum), false, false); lsum = __uint_as_float(rr[0]) + __uint_as_float(rr[1]); }
    LAS float* wsf = (LAS float*)(lds + WSF + wid * 256);
    if (hi == 0) wsf[r32] = lsum;
    asm volatile("s_waitcnt lgkmcnt(0)" ::: "memory");
    LAS bf16_t* stg = (LAS bf16_t*)(lds + OST + wid * 4096);
#pragma unroll
    for (int r = 0; r < 16; ++r) { const int orow = crow(r, hi); const float rl = __builtin_amdgcn_rcpf(wsf[orow]);
        stg[orow * 64 + r32] = (bf16_t)(cvtpk(o0[r] * rl, 0.f) & 0xffffu); stg[orow * 64 + 32 + r32] = (bf16_t)(cvtpk(o1[r] * rl, 0.f) & 0xffffu); }
    asm volatile("s_waitcnt lgkmcnt(0)" ::: "memory");
    bf16_t* Ow = A.O + (rowb + qb * 256 + wid * 32) * A.op + h * 64;
#pragma unroll
    for (int i = 0; i < 4; ++i) { const int row = i * 8 + (lane >> 3), ch = lane & 7; const u32x4 v = *(const LAS u32x4*)(stg + row * 64 + ch * 8); *(u32x4*)(Ow + (size_t)row * A.op + ch * 8) = v; }
    asm volatile("s_waitcnt lgkmcnt(0)\n\ts_barrier" ::: "memory");
#undef DMA_K
#undef DMA_V
#undef KLOAD
#undef VLOAD
#undef VFR
#undef QK_BLOCK
#undef PAF
#undef PV_BLOCK
#undef SOFTMAX
#undef ROT
}
#endif
template <int DQK>
__device__ __forceinline__ void attn_phase(int tid, LAS unsigned char* lds, const Tensors& A, int vcu, int G) {
#if FAST_ATTN
    int bh, qb;
    for (int i = 0; next_unit(i, vcu, G, bh, qb); ++i) attn_unit<DQK>(tid, lds, A, bh >> 3, bh & 7, qb);
#else
    (void)lds; attn_phase_ref<DQK>(tid, A, vcu, G);
#endif
}
}


struct Args { const float* in[22]; float* out; unsigned char* ws; int ph_lo, ph_hi; };
struct Frame {
    LAS unsigned char* lds; volatile LAS unsigned* MISC; unsigned* ctl;
    int tid, lane, wave, vcu, G;
    unsigned char* ws; float* OUT;
};

__device__ __forceinline__ void p0_phase(Frame& F, const float* c, const float* w_ada, const float* b_ada) {
    LAS float* cs = (LAS float*)F.lds;
    LAS float* red = (LAS float*)(F.lds + 32768);
    for (int i = F.tid; i < NB * D; i += NTHREADS) { const float v = c[i]; cs[i] = v / (1.f + __expf(-v)); }
    __syncthreads();
    float* mod = (float*)(F.ws + WS_MOD);
    const int kq = F.wave, col = F.lane;
    for (int item = F.vcu; item < NL * 6 * D / 64; item += F.G) {
        const int l = item / (6 * D / 64), n0 = (item % (6 * D / 64)) * 64;
        const float* w = w_ada + (size_t)l * D * 6 * D + n0 + col;
        float acc[NB];
#pragma unroll
        for (int b = 0; b < NB; ++b) acc[b] = 0.f;
#pragma unroll 8
        for (int k = kq * 128; k < kq * 128 + 128; ++k) { const float wv = w[(size_t)k * 6 * D];
#pragma unroll
            for (int b = 0; b < NB; ++b) acc[b] += cs[b * D + k] * wv; }
#pragma unroll
        for (int b = 0; b < NB; ++b) red[(kq * NB + b) * 64 + col] = acc[b];
        __syncthreads();
        { const int b = F.wave; float s = 0.f;
#pragma unroll
          for (int q = 0; q < 8; ++q) s += red[(q * NB + b) * 64 + col];
          mod[((size_t)l * NB + b) * 6 * D + n0 + col] = s + b_ada[(size_t)l * 6 * D + n0 + col]; }
        __syncthreads();
    }
    float* cosA = (float*)(F.ws + WS_COSA); float* sinA = (float*)(F.ws + WS_SINA); float* cosB = (float*)(F.ws + WS_COSB); float* sinB = (float*)(F.ws + WS_SINB);
    for (int idx = F.vcu * NTHREADS + F.tid; idx < S * 48; idx += F.G * NTHREADS) {
        const int s = idx / 48, i = idx % 48; const float row = (float)(s >> 6), col2 = (float)(s & 63);
        if (i < 32) { const int j = i & 15; const float a = (i < 16 ? row : col2) * (1.0f / powf(10000.0f, (float)j / 16.0f)); cosA[s * 32 + i] = cosf(a); sinA[s * 32 + i] = sinf(a); }
        else { const int ii = i - 32, j = ii & 7; const float a = (ii < 8 ? row : col2) * (1.0f / powf(10000.0f, (float)j / 8.0f)); cosB[s * 16 + ii] = cosf(a); sinB[s * 16 + ii] = sinf(a); }
    }
}

template <class SrcFn>
__device__ __forceinline__ void cvt_item(const float* W, int K, int Nsrc, const float* kg, bf16_t* WT, LAS float* scr, int item, int nblk, int lane, const SrcFn& src) {
    const int kb = item / nblk, nb = item % nblk, k0 = 64 * kb, n0 = 32 * nb;
    const int sc = src(n0 + (lane & 31));
#pragma unroll
    for (int i = 0; i < 32; ++i) { const int kk = 2 * i + (lane >> 5); float v = sc >= 0 ? W[(size_t)(k0 + kk) * Nsrc + sc] : 0.f; if (kg) v *= kg[k0 + kk]; scr[kk * 33 + (lane & 31)] = v; }
    LDS_WAIT(); asm volatile("" ::: "memory");
    const int c = lane & 7;
#pragma unroll
    for (int j = 0; j < 4; ++j) { const int n = (lane >> 3) + 8 * j; const LAS float* s = scr + (8 * c) * 33 + n;
        u32x4 o; o.x = cvt_pk_bf16(s[0 * 33], s[1 * 33]); o.y = cvt_pk_bf16(s[2 * 33], s[3 * 33]); o.z = cvt_pk_bf16(s[4 * 33], s[5 * 33]); o.w = cvt_pk_bf16(s[6 * 33], s[7 * 33]);
        *(u32x4*)(WT + (size_t)(n0 + n) * K + k0 + 8 * c) = o; }
    LDS_WAIT(); asm volatile("" ::: "memory");
}
struct SrcId { __device__ int operator()(int n) const { return n; } };
struct SrcIn { __device__ int operator()(int n) const { return gp::src_col_in(n); } };
typedef __attribute__((address_space(4))) const Args CArgsW;
__device__ __forceinline__ void convert_weights(Frame& F, CArgsW* a, int l) {
    LAS float* scr = (LAS float*)(F.lds + F.wave * 16384);
    const int gw = F.vcu * NWAVES + F.wave, NGW = F.G * NWAVES;
    const float* w_in = ((const float*)(GAS const float*)a->in[5]) + (size_t)l * D * INC; const float* w_q_b = ((const float*)(GAS const float*)a->in[10]) + (size_t)l * 384 * 768; const float* w_kv_b = ((const float*)(GAS const float*)a->in[11]) + (size_t)l * 256 * 1024;
    const float* w_pa = ((const float*)(GAS const float*)a->in[12]) + (size_t)l * 512 * D; const float* w_pb = ((const float*)(GAS const float*)a->in[13]) + (size_t)l * 512 * D; const float* w_o = ((const float*)(GAS const float*)a->in[14]) + (size_t)l * D * D;
    const float* w1 = ((const float*)(GAS const float*)a->in[18]) + (size_t)l * NE * D * FF; const float* w3 = ((const float*)(GAS const float*)a->in[19]) + (size_t)l * NE * D * FF; const float* w2 = ((const float*)(GAS const float*)a->in[20]) + (size_t)l * NE * FF * D;
    const float* gqa = ((const float*)(GAS const float*)a->in[8]) + l * 384; const float* gkv = ((const float*)(GAS const float*)a->in[9]) + l * 256;
    bf16_t* Win = (bf16_t*)(F.ws + WS_WIN); bf16_t* Wqb = (bf16_t*)(F.ws + WS_WQB); bf16_t* Wkvb = (bf16_t*)(F.ws + WS_WKVB); bf16_t* Wpa = (bf16_t*)(F.ws + WS_WPA); bf16_t* Wpb = (bf16_t*)(F.ws + WS_WPB);
    bf16_t* Wo = (bf16_t*)(F.ws + WS_WO); bf16_t* W13 = (bf16_t*)(F.ws + WS_W13); bf16_t* W2 = (bf16_t*)(F.ws + WS_W2);
    constexpr int I_IN = (D / 64) * (NIN / 32), I_QB = (384 / 64) * (768 / 32), I_KVB = (256 / 64) * (1024 / 32), I_P = (512 / 64) * (D / 32), I_O = (D / 64) * (D / 32);
    constexpr int I_13 = (D / 64) * (1024 / 32), I_2 = (FF / 64) * (D / 32);
    constexpr int NITEMS = I_IN + I_QB + I_KVB + 2 * I_P + I_O + NE * (I_13 + I_2);
    for (int it = gw; it < NITEMS; it += NGW) {
        int r = it;
        if (r < I_IN) { cvt_item(w_in, D, INC, nullptr, Win, scr, r, NIN / 32, F.lane, SrcIn()); continue; } r -= I_IN;
        if (r < I_QB) { cvt_item(w_q_b, 384, 768, gqa, Wqb, scr, r, 768 / 32, F.lane, SrcId()); continue; } r -= I_QB;
        if (r < I_KVB) { cvt_item(w_kv_b, 256, 1024, gkv, Wkvb, scr, r, 1024 / 32, F.lane, SrcId()); continue; } r -= I_KVB;
        if (r < I_P) { cvt_item(w_pa, 512, D, nullptr, Wpa, scr, r, D / 32, F.lane, SrcId()); continue; } r -= I_P;
        if (r < I_P) { cvt_item(w_pb, 512, D, nullptr, Wpb, scr, r, D / 32, F.lane, SrcId()); continue; } r -= I_P;
        if (r < I_O) { cvt_item(w_o, D, D, nullptr, Wo, scr, r, D / 32, F.lane, SrcId()); continue; } r -= I_O;
        if (r < NE * I_13) { const int e = r / I_13, q = r % I_13, nb = q % 32;
            const float* src = ((nb & 7) < 4 ? w1 : w3) + (size_t)e * D * FF; const int cb = (nb >> 3) * 128 + (nb & 3) * 32;
            struct SrcOff { int n0, cb; __device__ int operator()(int n) const { return cb + (n - n0); } } so{nb * 32, cb};
            cvt_item(src, D, FF, nullptr, W13 + (size_t)e * 1024 * D, scr, q, 32, F.lane, so); continue; } r -= NE * I_13;
        { const int e = r / I_2, q = r % I_2; cvt_item(w2 + (size_t)e * FF * D, FF, D, nullptr, W2 + (size_t)e * D * FF, scr, q, D / 32, F.lane, SrcId()); }
    }
}

template <int MODE>
__device__ __forceinline__ void row_phase(Frame& F, const float* xin, const float* g2prev, const float* gain, const float* modl, int sh_off, int sc_off, bf16_t* H, bf16_t* XB, float* OUT) {
    constexpr int RB = 4;
    const int gw = F.vcu * NWAVES + F.wave, NGW = F.G * NWAVES;
    const bf16_t* Y2 = (const bf16_t*)(F.ws + WS_Y2);
    for (int m0 = gw; m0 < T; m0 += RB * NGW) {
        f32x4 v[RB][4]; float ss[RB];
        if (MODE == 0) {
#pragma unroll
            for (int r = 0; r < RB; ++r)
#pragma unroll
                for (int j = 0; j < 4; ++j) v[r][j] = *(const f32x4*)(xin + (size_t)(m0 + r * NGW) * D + 4 * F.lane + 256 * j);
        } else {
            u32x2 ya[RB][4], yb[RB][4]; f32x4 g[RB][4];
#pragma unroll
            for (int r = 0; r < RB; ++r)
#pragma unroll
                for (int j = 0; j < 4; ++j) { const int m = m0 + r * NGW, c = 4 * F.lane + 256 * j;
                    { const u32x2 xb = *(const u32x2*)(XB + (size_t)m * D + c); v[r][j] = (f32x4){bf2f(xb.x & 0xffffu), bf2f(xb.x >> 16), bf2f(xb.y & 0xffffu), bf2f(xb.y >> 16)}; } ya[r][j] = *(const u32x2*)(Y2 + (size_t)(2 * m) * D + c); yb[r][j] = *(const u32x2*)(Y2 + (size_t)(2 * m + 1) * D + c);
                    g[r][j] = *(const f32x4*)(g2prev + (size_t)(m >> 12) * 6 * D + 5 * D + c); }
#pragma unroll
            for (int r = 0; r < RB; ++r)
#pragma unroll
                for (int j = 0; j < 4; ++j) { f32x4 y; y[0] = bf2f(ya[r][j].x & 0xffffu) + bf2f(yb[r][j].x & 0xffffu); y[1] = bf2f(ya[r][j].x >> 16) + bf2f(yb[r][j].x >> 16); y[2] = bf2f(ya[r][j].y & 0xffffu) + bf2f(yb[r][j].y & 0xffffu); y[3] = bf2f(ya[r][j].y >> 16) + bf2f(yb[r][j].y >> 16);
                    v[r][j] += g[r][j] * y; }
        }
#pragma unroll
        for (int r = 0; r < RB; ++r) { ss[r] = (gp::dot4(v[r][0]) + gp::dot4(v[r][1])) + (gp::dot4(v[r][2]) + gp::dot4(v[r][3])); }
#pragma unroll
        for (int o = 1; o < 64; o <<= 1)
#pragma unroll
            for (int r = 0; r < RB; ++r) ss[r] += __shfl_xor(ss[r], o);
#pragma unroll
        for (int r = 0; r < RB; ++r) {
            const int m = m0 + r * NGW, b = m >> 12; const float rstd = rsqrtf(ss[r] * (1.f / D) + EPS);
#pragma unroll
            for (int j = 0; j < 4; ++j) {
                const int c = 4 * F.lane + 256 * j; const f32x4 gn = *(const f32x4*)(gain + c);
                if (MODE == 2) { *(f32x4*)(OUT + (size_t)m * D + c) = v[r][j] * rstd * gn; }
                else {
                    { u32x2 xw; xw.x = cvt_pk_bf16(v[r][j][0], v[r][j][1]); xw.y = cvt_pk_bf16(v[r][j][2], v[r][j][3]); *(u32x2*)(XB + (size_t)m * D + c) = xw; }
                    const f32x4 sc = *(const f32x4*)(modl + (size_t)b * 6 * D + sc_off + c), sh = *(const f32x4*)(modl + (size_t)b * 6 * D + sh_off + c);
                    const f32x4 hv = v[r][j] * rstd * gn * (1.f + sc) + sh;
                    u32x2 w; w.x = cvt_pk_bf16(hv[0], hv[1]); w.y = cvt_pk_bf16(hv[2], hv[3]);
                    *(u32x2*)(H + (size_t)m * D + c) = w;
                }
            }
        }
    }
}

__device__ __forceinline__ void t2_phase(Frame& F, const float* gain, const float* modl, const float* w_router, const float* rbias, int l, bool record) {
    LAS f32x4* wl = (LAS f32x4*)F.lds;
    LAS int* rec = (LAS int*)(F.lds + 65536);
    LAS float* recw = (LAS float*)(F.lds + 65536 + 2048);
    LAS int* lcnt = (LAS int*)(F.lds + 65536 + 4096);
    for (int idx = F.tid; idx < 4096; idx += NTHREADS) {
        const int lane = idx & 63, c = (idx >> 6) & 3, i = (idx >> 8) & 3, j = idx >> 10; const int k = 4 * lane + 256 * j + i;
        wl[idx] = *(const f32x4*)(w_router + (size_t)k * NE + 4 * c);
    }
    if (F.tid < 32) lcnt[F.tid] = 0;
    __syncthreads();
    constexpr int RB = 4;
    const int gw = F.vcu * NWAVES + F.wave, NGW = F.G * NWAVES;
    bf16_t* H = (bf16_t*)(F.ws + WS_H); const bf16_t* XB = (const bf16_t*)(F.ws + WS_XB);
    const int lane = F.lane, myrow = lane >> 4, mye = lane & 15;
    int it = 0;
    for (int m0 = gw; m0 < T; m0 += RB * NGW, ++it) {
        f32x4 v[RB][4]; float ss[RB];
#pragma unroll
        for (int r = 0; r < RB; ++r)
#pragma unroll
            for (int j = 0; j < 4; ++j) { const u32x2 xb = *(const u32x2*)(XB + (size_t)(m0 + r * NGW) * D + 4 * lane + 256 * j); v[r][j] = (f32x4){bf2f(xb.x & 0xffffu), bf2f(xb.x >> 16), bf2f(xb.y & 0xffffu), bf2f(xb.y >> 16)}; }
#pragma unroll
        for (int r = 0; r < RB; ++r) ss[r] = (gp::dot4(v[r][0]) + gp::dot4(v[r][1])) + (gp::dot4(v[r][2]) + gp::dot4(v[r][3]));
#pragma unroll
        for (int o = 1; o < 64; o <<= 1)
#pragma unroll
            for (int r = 0; r < RB; ++r) ss[r] += __shfl_xor(ss[r], o);
        float acc[RB * NE];
#pragma unroll
        for (int q = 0; q < RB * NE; ++q) acc[q] = 0.f;
#pragma unroll
        for (int j = 0; j < 4; ++j) {
            const int c = 4 * lane + 256 * j; const f32x4 gn = *(const f32x4*)(gain + c);
#pragma unroll
            for (int r = 0; r < RB; ++r) {
                const int m = m0 + r * NGW, b = m >> 12; const float rstd = rsqrtf(ss[r] * (1.f / D) + EPS);
                const f32x4 sc = *(const f32x4*)(modl + (size_t)b * 6 * D + 4 * D + c), sh = *(const f32x4*)(modl + (size_t)b * 6 * D + 3 * D + c);
                v[r][j] = v[r][j] * rstd * gn * (1.f + sc) + sh;
                u32x2 w; w.x = cvt_pk_bf16(v[r][j][0], v[r][j][1]); w.y = cvt_pk_bf16(v[r][j][2], v[r][j][3]);
                *(u32x2*)(H + (size_t)m * D + c) = w;
            }
#pragma unroll
            for (int i = 0; i < 4; ++i)
#pragma unroll
                for (int c4 = 0; c4 < 4; ++c4) { const f32x4 wv = wl[((j * 4 + i) * 4 + c4) * 64 + lane];
#pragma unroll
                    for (int r = 0; r < RB; ++r) { const float hv = v[r][j][i];
                        acc[r * NE + 4 * c4 + 0] += hv * wv[0]; acc[r * NE + 4 * c4 + 1] += hv * wv[1]; acc[r * NE + 4 * c4 + 2] += hv * wv[2]; acc[r * NE + 4 * c4 + 3] += hv * wv[3]; } }
        }
#pragma unroll
        for (int sft = 32; sft >= 1; sft >>= 1) {
            const bool up = (lane & sft) != 0;
#pragma unroll
            for (int k = 0; k < sft; ++k) { const float a = acc[k], b = acc[k + sft]; const float keep = up ? b : a, send = up ? a : b; acc[k] = keep + __shfl_xor(send, sft); }
        }
        const float logit = acc[0];
        const float score = 1.f / (1.f + expf(-logit));
        float scv[NE], bi[NE];
#pragma unroll
        for (int e = 0; e < NE; ++e) { scv[e] = __shfl(score, (lane & 48) | e); bi[e] = scv[e] + rbias[e]; }
        int gsel = 0; float gbest = -INFINITY;
#pragma unroll
        for (int g = 0; g < 4; ++g) { float m1 = -INFINITY, m2 = -INFINITY;
#pragma unroll
            for (int j = 0; j < 4; ++j) { const float x = bi[g * 4 + j]; if (x > m1) { m2 = m1; m1 = x; } else if (x > m2) m2 = x; }
            const float gs = m1 + m2; if (gs > gbest) { gbest = gs; gsel = g; } }
        int e1 = -1, e2 = -1; float b1 = -INFINITY, b2 = -INFINITY, s1 = 0.f, s2 = 0.f;
#pragma unroll
        for (int j = 0; j < 4; ++j) { float x = -INFINITY, sx = 0.f;
#pragma unroll
            for (int g = 0; g < 4; ++g) if (g == gsel) { x = bi[g * 4 + j]; sx = scv[g * 4 + j]; }
            const int e = gsel * 4 + j;
            if (x > b1) { b2 = b1; e2 = e1; s2 = s1; b1 = x; e1 = e; s1 = sx; } else if (x > b2) { b2 = x; e2 = e; s2 = sx; } }
        if (mye == 0) {
            const float inv = 1.f / (s1 + s2); const int slot = (it * RB + myrow) * NWAVES + F.wave;
            rec[slot * 4 + 0] = e1; rec[slot * 4 + 1] = e2;
            rec[slot * 4 + 2] = __hip_atomic_fetch_add(&lcnt[e1], 1, __ATOMIC_RELAXED, __HIP_MEMORY_SCOPE_WORKGROUP);
            rec[slot * 4 + 3] = __hip_atomic_fetch_add(&lcnt[e2], 1, __ATOMIC_RELAXED, __HIP_MEMORY_SCOPE_WORKGROUP);
            recw[slot * 2 + 0] = s1 * inv; recw[slot * 2 + 1] = s2 * inv;
        }
    }
    __syncthreads();
    if (!record) return;
    if (F.tid < NE) lcnt[16 + F.tid] = (int)__hip_atomic_fetch_add(F.ctl + CW_CNT + (l * NE + F.tid) * 64, (unsigned)lcnt[F.tid], __ATOMIC_RELAXED, __HIP_MEMORY_SCOPE_AGENT);
    __syncthreads();
    unsigned* list = (unsigned*)(F.ws + WS_LIST); float* gwb = (float*)(F.ws + WS_GW);
    const int nrows = it * RB;
    for (int s = F.tid; s < nrows * NWAVES; s += NTHREADS) {
        const int i2 = s / NWAVES, w = s % NWAVES; const int m = F.vcu * NWAVES + w + i2 * NGW;
        const int e1 = rec[s * 4 + 0], e2 = rec[s * 4 + 1];
        list[(size_t)e1 * T + lcnt[16 + e1] + rec[s * 4 + 2]] = (unsigned)(2 * m); list[(size_t)e2 * T + lcnt[16 + e2] + rec[s * 4 + 3]] = (unsigned)(2 * m + 1);
        gwb[2 * m] = recw[s * 2]; gwb[2 * m + 1] = recw[s * 2 + 1];
    }
}
__device__ __forceinline__ const LAS int* moe_table(Frame& F, int l) {
    LAS int* tab = (LAS int*)(F.lds + MISC_OFF + 1024);
    __syncthreads();
    if (F.tid == 0) { int acc = 0;
        for (int e = 0; e < NE; ++e) { const int c = (int)__hip_atomic_load(F.ctl + CW_CNT + (l * NE + e) * 64, __ATOMIC_RELAXED, __HIP_MEMORY_SCOPE_AGENT); tab[e] = acc; tab[32 + e] = c; acc += (c + 255) >> 8; }
        tab[16] = acc; }
    __syncthreads();
    return tab;
}

typedef __attribute__((address_space(4))) const Args CArgs;
#define LAUNDER_GP(T_, p) do { GAS T_* _t = (GAS T_*)(p); asm volatile("" : "+s"(_t)); (p) = (T_*)_t; } while (0)
#define PH_BEGIN() LAUNDER_V(F.tid); F.lane = F.tid & 63; LAUNDER_GP(unsigned, F.ctl); LAUNDER_GP(float, F.OUT); LAUNDER_GP(unsigned char, F.ws); GAS unsigned char* ws = (GAS unsigned char*)F.ws; CArgs* ka = (CArgs*)__builtin_amdgcn_kernarg_segment_ptr(); LAUNDER_S(ka); \
    float* mod = WSP(float, WS_MOD); (void)mod; (void)ka
#define WSP(T_, off) ((T_*)(GAS T_*)(ws + (off)))
#define KIN(i) ((const float*)(GAS const float*)ka->in[i])
__global__ void __launch_bounds__(NTHREADS, 2) fwd_kernel(Args args) {
    extern __shared__ __attribute__((aligned(16))) unsigned char lds_raw[];
    Frame F;
    F.lds = (LAS unsigned char*)lds_raw; F.MISC = (volatile LAS unsigned*)(F.lds + MISC_OFF);
    F.tid = threadIdx.x; F.lane = F.tid & 63; F.wave = __builtin_amdgcn_readfirstlane(F.tid >> 6);
    F.G = gridDim.x; { const int bx = blockIdx.x; F.vcu = (F.G % 8 == 0) ? (bx % 8) * (F.G / 8) + bx / 8 : bx; }
    F.ws = (unsigned char*)(GAS unsigned char*)args.ws; F.ctl = (unsigned*)(GAS unsigned*)(args.ws + WS_CTL); F.OUT = (float*)(GAS float*)args.out;
    if (F.tid < 64) F.MISC[F.tid] = 0u;
    __syncthreads();
    XcdBarrier bar; bar.bar = F.ctl + CW_BAR; bar.x = 0; bar.st = nullptr;
    if (!N_LAUNCH_MODE) bar = xcd_barrier_post(F.ctl + CW_BAR, F.MISC + 8);
    const int lo = args.ph_lo, hi = args.ph_hi;
#define IN(k) (lo <= (k) && (k) < hi)
#define SEAM(k) do { if ((k) + 1 < hi) { if (!N_LAUNCH_MODE) xcd_barrier(bar); } } while (0)
    const int cidx = (int)blockIdx.x;

    if (IN(0)) { PH_BEGIN(); p0_phase(F, KIN(1), KIN(2), KIN(3)); SEAM(0); }
    for (int l = 0; l < NL; ++l) {
        const int pb = 1 + 9 * l;
        if (IN(pb + 0)) {
            PH_BEGIN();
            for (int rep = 0; rep < ((PROBE_DUP & 8) ? 2 : 1); ++rep) { LAUNDER_V(F.tid); F.lane = F.tid & 63; convert_weights(F, ka, l); }
            if (l == 0) row_phase<0>(F, KIN(0), nullptr, KIN(4) + l * D, mod + (size_t)l * NB * 6 * D, 0, D, WSP(bf16_t, WS_H), WSP(bf16_t, WS_XB), nullptr);
            else row_phase<1>(F, nullptr, mod + (size_t)(l - 1) * NB * 6 * D, KIN(4) + l * D, mod + (size_t)l * NB * 6 * D, 0, D, WSP(bf16_t, WS_H), WSP(bf16_t, WS_XB), nullptr);
            SEAM(pb + 0);
        }
        if (IN(pb + 1)) {
            PH_BEGIN();
            gp::Gemm g{WSP(bf16_t, WS_H), WSP(const bf16_t, WS_WIN), D, 0, nullptr}; gp::DenseOrder So; So.init(T, NIN, F.G, cidx);
            gp::EpiIn E{WSP(bf16_t, WS_QA), WSP(bf16_t, WS_KA), WSP(bf16_t, WS_VA), WSP(bf16_t, WS_QLAT), WSP(bf16_t, WS_KVLAT), WSP(bf16_t, WS_KB), WSP(bf16_t, WS_SA), WSP(bf16_t, WS_SB), WSP(float, WS_SSQ), WSP(float, WS_SSKV),
                        KIN(6) + l * 64, KIN(7) + l * 64, WSP(const float, WS_COSA), WSP(const float, WS_SINA), WSP(const float, WS_COSB), WSP(const float, WS_SINB)};
            if (PROBE_DUP & 128) { gp::EpiNull En; gp::gemm_phase<gp::EpiNull, gp::DenseOrder>(F.tid, F.lds, g, So, En); LAUNDER_V(F.tid); }
            gp::gemm_phase<gp::EpiIn, gp::DenseOrder>(F.tid, F.lds, g, So, E); if (PROBE_DUP & (2 | 512)) { LAUNDER_V(F.tid); gp::gemm_phase<gp::EpiIn, gp::DenseOrder>(F.tid, F.lds, g, So, E); }
            SEAM(pb + 1);
        }
        if (IN(pb + 2)) {
            { PH_BEGIN(); gp::Gemm g{WSP(bf16_t, WS_QLAT), WSP(const bf16_t, WS_WQB), 384, 0, nullptr}; gp::DenseOrder So; So.init(T, 768, F.G, cidx);
              gp::EpiQb E{WSP(bf16_t, WS_QB), WSP(const float, WS_SSQ), WSP(const float, WS_COSB), WSP(const float, WS_SINB)}; gp::gemm_phase<gp::EpiQb, gp::DenseOrder>(F.tid, F.lds, g, So, E); if (PROBE_DUP & 2) { LAUNDER_V(F.tid); gp::gemm_phase<gp::EpiQb, gp::DenseOrder>(F.tid, F.lds, g, So, E); } }
            { PH_BEGIN(); gp::Gemm g{WSP(bf16_t, WS_KVLAT), WSP(const bf16_t, WS_WKVB), 256, 0, nullptr}; gp::DenseOrder So; So.init(T, 1024, F.G, F.G - 1 - cidx);
              gp::EpiKvb E{WSP(bf16_t, WS_KB), WSP(bf16_t, WS_VB), WSP(const float, WS_SSKV)}; gp::gemm_phase<gp::EpiKvb, gp::DenseOrder>(F.tid, F.lds, g, So, E); if (PROBE_DUP & 2) { LAUNDER_V(F.tid); gp::gemm_phase<gp::EpiKvb, gp::DenseOrder>(F.tid, F.lds, g, So, E); } }
            if (PROBE_DUP & 1) { PH_BEGIN(); const at::Tensors A{WSP(bf16_t, WS_QA), 512, WSP(bf16_t, WS_KA), 128, WSP(bf16_t, WS_VA), 128, WSP(bf16_t, WS_OB), 512, 4}; at::attn_phase<64>(F.tid, F.lds, A, F.vcu, F.G); }
            { PH_BEGIN(); const at::Tensors A{WSP(bf16_t, WS_QA), 512, WSP(bf16_t, WS_KA), 128, WSP(bf16_t, WS_VA), 128, WSP(bf16_t, WS_QA), 512, 4}; at::attn_phase<64>(F.tid, F.lds, A, F.vcu, F.G); }
            SEAM(pb + 2);
        }
        if (IN(pb + 3)) {
            PH_BEGIN();
            const at::Tensors A{WSP(bf16_t, WS_QB), 768, WSP(bf16_t, WS_KB), 768, WSP(bf16_t, WS_VB), 512, WSP(bf16_t, WS_OB), 512, 1}; for (int rep = 0; rep < ((PROBE_DUP & 1) ? 2 : 1); ++rep) at::attn_phase<96>(F.tid, F.lds, A, F.vcu, F.G);
            SEAM(pb + 3);
        }
        if (IN(pb + 4)) for (int rep3 = 0; rep3 < ((PROBE_DUP & (2 | 1024)) ? 2 : 1); ++rep3) {
            { PH_BEGIN(); gp::Gemm g{WSP(bf16_t, WS_QA), WSP(const bf16_t, WS_WPA), 512, 0, nullptr}; gp::DenseOrder So; So.init(T, D, F.G, cidx);
              gp::EpiProj<0> E{WSP(bf16_t, WS_H), WSP(const bf16_t, WS_SA)}; gp::gemm_phase<gp::EpiProj<0>, gp::DenseOrder>(F.tid, F.lds, g, So, E); }
            { PH_BEGIN(); gp::Gemm g{WSP(bf16_t, WS_OB), WSP(const bf16_t, WS_WPB), 512, 0, nullptr}; gp::DenseOrder So; So.init(T, D, F.G, cidx);
              gp::EpiProj<1> E{WSP(bf16_t, WS_H), WSP(const bf16_t, WS_SB)}; gp::gemm_phase<gp::EpiProj<1>, gp::DenseOrder>(F.tid, F.lds, g, So, E); }
            if (rep3 + 1 == ((PROBE_DUP & (2 | 1024)) ? 2 : 1)) SEAM(pb + 4);
        }
        if (IN(pb + 5)) {
            PH_BEGIN();
            gp::Gemm g{WSP(bf16_t, WS_H), WSP(const bf16_t, WS_WO), D, 0, nullptr}; gp::DenseOrder So; So.init(T, D, F.G, cidx);
            gp::EpiWo E{WSP(const bf16_t, WS_XB), mod + (size_t)l * NB * 6 * D, WSP(bf16_t, WS_XB)}; gp::gemm_phase<gp::EpiWo, gp::DenseOrder>(F.tid, F.lds, g, So, E);
            SEAM(pb + 5);
        }
        if (IN(pb + 6)) {
            PH_BEGIN();
            if (PROBE_DUP & 16) { t2_phase(F, KIN(15) + l * D, mod + (size_t)l * NB * 6 * D, KIN(16), KIN(17), l, false); LAUNDER_V(F.tid); F.lane = F.tid & 63; __syncthreads(); }
            t2_phase(F, KIN(15) + l * D, mod + (size_t)l * NB * 6 * D, KIN(16), KIN(17), l, true);
            SEAM(pb + 6);
        }
        if (IN(pb + 7)) {
            PH_BEGIN();
            const LAS int* tab = moe_table(F, l);
            gp::Gemm g{WSP(bf16_t, WS_H), WSP(const bf16_t, WS_W13), D, (size_t)1024 * D, WSP(const unsigned, WS_LIST)}; gp::MoeOrder So; So.init(tab, F.G, cidx);
            if (PROBE_DUP & 256) { gp::EpiNull En; gp::gemm_phase<gp::EpiNull, gp::MoeOrder, true>(F.tid, F.lds, g, So, En); LAUNDER_V(F.tid); }
            gp::EpiUp E{WSP(bf16_t, WS_ACT)}; gp::gemm_phase<gp::EpiUp, gp::MoeOrder, true>(F.tid, F.lds, g, So, E); if (PROBE_DUP & 4) { LAUNDER_V(F.tid); gp::gemm_phase<gp::EpiUp, gp::MoeOrder, true>(F.tid, F.lds, g, So, E); }
            SEAM(pb + 7);
        }
        if (IN(pb + 8)) {
            PH_BEGIN();
            const LAS int* tab = moe_table(F, l);
            gp::Gemm g{WSP(bf16_t, WS_ACT), WSP(const bf16_t, WS_W2), FF, (size_t)D * FF, nullptr}; gp::MoeOrder So; So.init(tab, F.G, cidx);
            gp::EpiDown E{WSP(bf16_t, WS_Y2), WSP(const unsigned, WS_LIST), WSP(const float, WS_GW)}; gp::gemm_phase<gp::EpiDown, gp::MoeOrder, false>(F.tid, F.lds, g, So, E); if (PROBE_DUP & 4) { LAUNDER_V(F.tid); gp::gemm_phase<gp::EpiDown, gp::MoeOrder, false>(F.tid, F.lds, g, So, E); }
            SEAM(pb + 8);
        }
    }
    if (IN(NPHASE - 1)) { PH_BEGIN(); row_phase<2>(F, nullptr, mod + (size_t)(NL - 1) * NB * 6 * D, KIN(21), nullptr, 0, 0, nullptr, WSP(bf16_t, WS_XB), F.OUT); }
#undef IN
#undef SEAM
}

extern "C" void kernel_launch(void* const* d_in, const int* in_sizes, int n_in, void* d_out, int out_size, void* d_ws, size_t ws_size, hipStream_t stream) {
    static int grid = 0;
    if (grid == 0) {
        if (n_in != 22 || out_size != T * D || ws_size < WS_END) { fprintf(stderr, "kernel_launch: unexpected problem (n_in %d out %d ws %zu)\n", n_in, out_size, ws_size); grid = -1; return; }
        int dev = 0, cus = 0, per_cu = 0;
        if (hipGetDevice(&dev) != hipSuccess || hipDeviceGetAttribute(&cus, hipDeviceAttributeMultiprocessorCount, dev) != hipSuccess) { grid = -1; return; }
        if (hipFuncSetAttribute((const void*)fwd_kernel, hipFuncAttributeMaxDynamicSharedMemorySize, LDS_BYTES) != hipSuccess) { grid = -1; return; }
        if (hipOccupancyMaxActiveBlocksPerMultiprocessor(&per_cu, (const void*)fwd_kernel, NTHREADS, LDS_BYTES) != hipSuccess || per_cu < 1) { fprintf(stderr, "kernel_launch: occupancy query says %d\n", per_cu); }
        (void)hipGetLastError();
        grid = cus;
        if (T % (grid * NWAVES * 4) != 0) { fprintf(stderr, "kernel_launch: grid %d does not divide the row phases\n", grid); grid = -1; return; }
    }
    if (grid < 0) return;
    (void)hipMemsetAsync((char*)d_ws + WS_CTL, 0, CTL_BYTES, stream);
    Args a{};
    for (int i = 0; i < 22; ++i) a.in[i] = (const float*)d_in[i];
    a.out = (float*)d_out; a.ws = (unsigned char*)d_ws;
#if N_LAUNCH_MODE
    for (int p = 0; p < NPHASE; ++p) { a.ph_lo = p; a.ph_hi = p + 1; hipLaunchKernelGGL(fwd_kernel, dim3(grid), dim3(NTHREADS), LDS_BYTES, stream, a); }
#else
    a.ph_lo = 0; a.ph_hi = NPHASE;
    hipLaunchKernelGGL(fwd_kernel, dim3(grid), dim3(NTHREADS), LDS_BYTES, stream, a);
#endif
}
```

```cpp
#include <hip/hip_runtime.h>
#include <stdint.h>
#include <stdio.h>
#include <math.h>

#ifndef FAST_GEMM
#define FAST_GEMM 1
#endif
#ifndef FAST_ATTN
#define FAST_ATTN 1
#endif
#ifndef PROBE_DUP
#define PROBE_DUP 0
#endif
#ifndef PROBE_ATT
#define PROBE_ATT 0
#endif
#ifndef ATT_REGSTAGE
#define ATT_REGSTAGE 0
#endif
#ifndef N_LAUNCH_MODE
#define N_LAUNCH_MODE 0
#endif

#define LAS __attribute__((address_space(3)))
#define GAS __attribute__((address_space(1)))
typedef unsigned short bf16_t;
typedef short bf16x8 __attribute__((ext_vector_type(8)));
typedef float f32x4 __attribute__((ext_vector_type(4)));
typedef float f32x2 __attribute__((ext_vector_type(2)));
typedef float f32x16 __attribute__((ext_vector_type(16)));
typedef unsigned u32x4 __attribute__((ext_vector_type(4)));
typedef unsigned u32x2 __attribute__((ext_vector_type(2)));
typedef GAS unsigned gu32;

constexpr int D = 1024, NB = 8, S = 4096, T = NB * S, NL = 4, INC = 3488, NIN = 3584, NE = 16, FF = 512;
constexpr float EPS = 1e-6f, LOG2E = 1.4426950408889634f;
constexpr float QSCALE_A = 0.125f * LOG2E, QSCALE_B = 0.10206207261596577f * LOG2E;
constexpr int NWAVES = 8, NTHREADS = 512;
constexpr int NPHASE = 2 + 9 * NL;

constexpr size_t MiB = 1u << 20;
constexpr size_t WS_CTL = 0, CTL_BYTES = 1 * MiB;
constexpr size_t WS_MOD = 1 * MiB;
constexpr size_t WS_COSA = 2 * MiB, WS_SINA = WS_COSA + 512 * 1024, WS_COSB = 3 * MiB, WS_SINB = WS_COSB + 256 * 1024;
constexpr size_t WS_SSQ = 4 * MiB, WS_SSKV = 5 * MiB;
constexpr size_t WS_GW = 6 * MiB;
constexpr size_t WS_LIST = 7 * MiB;
constexpr size_t WS_WIN = 10 * MiB, WS_WQB = 17 * MiB, WS_WKVB = 18 * MiB, WS_WPA = 19 * MiB, WS_WPB = 20 * MiB, WS_WO = 21 * MiB, WS_W13 = 23 * MiB, WS_W2 = 55 * MiB;
constexpr size_t WS_H = 72 * MiB;
constexpr size_t WS_QA = 136 * MiB, WS_KA = 168 * MiB, WS_VA = 176 * MiB, WS_QLAT = 184 * MiB, WS_KVLAT = 208 * MiB;
constexpr size_t WS_KB = 224 * MiB, WS_VB = 272 * MiB, WS_QB = 304 * MiB, WS_OB = 352 * MiB, WS_SA = 384 * MiB, WS_SB = 448 * MiB, WS_XB = 512 * MiB, WS_END = 576 * MiB;
constexpr size_t WS_ACT = 136 * MiB, WS_Y2 = 208 * MiB;
constexpr int ACT_ROWS = 2 * T + NE * 256;
static_assert(WS_ACT + (size_t)ACT_ROWS * FF * 2 <= WS_Y2 && WS_Y2 + (size_t)2 * T * D * 2 <= WS_XB, "moe overlay");
constexpr int CW_BAR = 4096;
constexpr int CW_CNT = 16384;

constexpr int RING_BYTES = 131072, MISC_OFF = RING_BYTES, LDS_BYTES = 147456;

__device__ __forceinline__ float bf2f(unsigned v) { return __uint_as_float(v << 16); }
typedef __bf16 bf16x2_t __attribute__((ext_vector_type(2)));
__device__ __forceinline__ unsigned cvt_pk_bf16(float lo, float hi) { f32x2 v = {lo, hi}; bf16x2_t b = __builtin_convertvector(v, bf16x2_t); return __builtin_bit_cast(unsigned, b); }
__device__ __forceinline__ u32x4 pack8(f32x4 a, f32x4 b) { u32x4 w; w.x = cvt_pk_bf16(a[0], a[1]); w.y = cvt_pk_bf16(a[2], a[3]); w.z = cvt_pk_bf16(b[0], b[1]); w.w = cvt_pk_bf16(b[2], b[3]); return w; }
__device__ __forceinline__ void unpack8(u32x4 w, f32x4& a, f32x4& b) { a[0] = bf2f(w.x & 0xffffu); a[1] = bf2f(w.x >> 16); a[2] = bf2f(w.y & 0xffffu); a[3] = bf2f(w.y >> 16); b[0] = bf2f(w.z & 0xffffu); b[1] = bf2f(w.z >> 16); b[2] = bf2f(w.w & 0xffffu); b[3] = bf2f(w.w >> 16); }
__device__ __forceinline__ float wave_sum(float v) {
#pragma unroll
    for (int o = 1; o < 64; o <<= 1) v += __shfl_xor(v, o);
    return v;
}
__device__ __forceinline__ float sigm(float v) { return __builtin_amdgcn_rcpf(1.f + __builtin_amdgcn_exp2f(v * (-LOG2E))); }
#define VM_WAIT() asm volatile("s_waitcnt vmcnt(0)" ::: "memory")
#define LAUNDER_S(p) asm volatile("" : "+s"(p))
#define LAUNDER_V(v) asm volatile("" : "+v"(v))
#define LDS_WAIT() asm volatile("s_waitcnt lgkmcnt(0)" ::: "memory")

#define XB_TMO      128
#define XB_XCNT(j)  (256  + 64 * (j))
#define XB_XSUB(j)  (1280 + 64 * (j))
#define XB_XGEN(j)  (2304 + 64 * (j))
#define XB_TOP      3328
#define XB_TOPGEN   3392
#define XCD_BAR_WORDS 3456
#define XB_SPIN_CAP (1u << 22)
__device__ __forceinline__ unsigned xb_ld(unsigned* p)              { return __hip_atomic_load(p, __ATOMIC_RELAXED, __HIP_MEMORY_SCOPE_AGENT); }
__device__ __forceinline__ unsigned xb_add(unsigned* p, unsigned v) { return __hip_atomic_fetch_add(p, v, __ATOMIC_RELAXED, __HIP_MEMORY_SCOPE_AGENT); }
__device__ __forceinline__ unsigned xb_xcc_id() { return (unsigned)__builtin_amdgcn_s_getreg((3 << 11) | 20) & 0xFu; }
#define XB_SPIN(cond, bar) do { unsigned _sp = 0; while (cond) { __builtin_amdgcn_s_sleep(1); \
    if ((++_sp & 255u) == 0u) { if (xb_ld(&(bar)[XB_TMO])) break; if (_sp > XB_SPIN_CAP) { atomicAdd(&(bar)[XB_TMO], 1u); break; } } } } while (0)
struct XcdBarrier { unsigned* bar; unsigned x; volatile LAS unsigned* st; };
__device__ __forceinline__ XcdBarrier xcd_barrier_post(unsigned* bar, volatile LAS unsigned* st) {
    XcdBarrier b; b.bar = bar; b.x = xb_xcc_id(); b.st = st;
    if (threadIdx.x == 0) (void)xb_add(&bar[XB_XCNT(b.x)], 1u);
    return b;
}
__device__ __forceinline__ void xcd_barrier_complete(unsigned* bar, unsigned x, unsigned& nloc, unsigned& nx) {
    const unsigned G = gridDim.x * gridDim.y * gridDim.z;
    unsigned sum, cnt, mine, sp = 0u;
    for (;;) {
        sum = 0u; cnt = 0u; mine = 0u;
#pragma unroll
        for (unsigned j = 0; j < 16; ++j) { const unsigned c = xb_ld(&bar[XB_XCNT(j)]); sum += c; cnt += (c > 0u) ? 1u : 0u; mine = (j == x) ? c : mine; }
        if (sum == G) break;
        __builtin_amdgcn_s_sleep(1);
        if ((++sp & 255u) == 0u) { if (xb_ld(&bar[XB_TMO])) break; if (sp > XB_SPIN_CAP) { atomicAdd(&bar[XB_TMO], 1u); break; } }
    }
    nloc = mine > 0u ? mine : 1u; nx = cnt > 0u ? cnt : 1u;
}
__device__ __forceinline__ void xcd_barrier(const XcdBarrier& b) {
    asm volatile("s_waitcnt vmcnt(0)" ::: "memory");
    __syncthreads();
    if (threadIdx.x == 0) {
        unsigned* bar = b.bar;
        __builtin_amdgcn_s_waitcnt(0);
        unsigned nloc = b.st[0], nx = b.st[1];
        if (nloc == 0u) { xcd_barrier_complete(bar, b.x, nloc, nx); b.st[0] = nloc; b.st[1] = nx; }
        const unsigned old = xb_add(&bar[XB_XSUB(b.x)], 1u);
        const unsigned gen = old / nloc;
        if (old + 1u == (gen + 1u) * nloc) {
            __builtin_amdgcn_fence(__ATOMIC_RELEASE, "agent");
            asm volatile("s_waitcnt vmcnt(0)" ::: "memory");
            const unsigned og = xb_add(&bar[XB_TOP], 1u);
            const unsigned tg = og / nx;
            if (og + 1u == (tg + 1u) * nx) xb_add(&bar[XB_TOPGEN], 1u);
            else XB_SPIN(xb_ld(&bar[XB_TOPGEN]) == tg, bar);
            __builtin_amdgcn_fence(__ATOMIC_ACQUIRE, "agent");
            xb_add(&bar[XB_XGEN(b.x)], 1u);
            asm volatile("s_waitcnt vmcnt(0)" ::: "memory");
        } else {
            XB_SPIN(xb_ld(&bar[XB_XGEN(b.x)]) == gen, bar);
            __builtin_amdgcn_fence(__ATOMIC_ACQUIRE, "agent");
            asm volatile("s_waitcnt vmcnt(0)" ::: "memory");
        }
    }
    __syncthreads();
}

namespace gp {
constexpr int BM = 256, BK = 64, HALF = 128, HTB = HALF * BK * 2, NXCD = 8, WGM = 8;
__host__ __device__ __forceinline__ int lds_byte(int r, int c) { const int st = (r >> 4) * 2 + (c >> 5), rr = r & 15, cc = c & 31, ob = rr * 64 + cc * 2; return st * 1024 + (ob ^ (((ob >> 9) & 1) << 5)); }
__host__ __device__ __forceinline__ void stage_rc(int b, int& R, int& C) { const int st = b / 1024, sb = b % 1024, swz = sb ^ (((sb >> 9) & 1) << 5); R = (st >> 1) * 16 + swz / 64; C = (st & 1) * 32 + (swz % 64) / 2; }
__host__ __device__ __forceinline__ int perm32(int rho) { const int n = rho >> 4, i = rho & 15; return 8 * (i >> 2) + 4 * n + (i & 3); }

struct Unit { int pm, pn, be, rl, nv; };
struct Gemm { const bf16_t* A; const bf16_t* Bt; int K; size_t bstride; const unsigned* list; };

__device__ __forceinline__ int xcd_remap(int wgid, int nwg) { const int q = nwg / NXCD, r = nwg % NXCD, xcd = wgid % NXCD, off = wgid / NXCD; return (xcd < r ? xcd * (q + 1) : r * (q + 1) + (xcd - r) * q) + off; }
struct DenseOrder {
    int nM, nN, nwg, G, c;
    __device__ void init(int M, int N, int G_, int c_) { nM = M / BM; nN = N / BM; nwg = nM * nN; G = G_; c = c_; }
    __device__ bool next(int i, Unit& u) const {
        const long L = (long)i * G + c; if (L >= nwg) return false;
        const int wgid = xcd_remap((int)L, nwg);
        const int nig = WGM * nN, gid = wgid / nig, fm = gid * WGM, gsz = (nM - fm) < WGM ? (nM - fm) : WGM;
        u.pm = fm + ((wgid % nig) % gsz); u.pn = (wgid % nig) / gsz; u.be = 0; u.rl = 0; u.nv = 256; return true;
    }
};
struct MoeOrder {
    const LAS int* tab; int nwg, G, c;
    __device__ static int rd(const LAS int* p) { return __builtin_amdgcn_readfirstlane(*p); }
    __device__ void init(const LAS int* tab_, int G_, int c_) { tab = tab_; nwg = rd(tab_ + 16) * 4; G = G_; c = c_; }
    __device__ bool next(int i, Unit& u) const {
        const long L = (long)i * G + c; if (L >= nwg) return false;
        const int wgid = xcd_remap((int)L, nwg);
        const int tile = wgid >> 2; int e = 0;
        for (int k = 1; k < NE; ++k) e += (rd(tab + k) <= tile) ? 1 : 0;
        u.pm = tile; u.pn = wgid & 3; u.be = e; u.rl = tile - rd(tab + e); const int rem = rd(tab + 32 + e) - u.rl * 256; u.nv = rem < 256 ? rem : 256; return true;
    }
};

#define ACC_T f32x4 (&acc)[2][2][4][2]

template <class Epi, class Sched, bool GATHER>
__device__ __forceinline__ void gemm_phase_ref(int tid, const Gemm g, const Sched& S, const Epi& E) {
    const int wid = __builtin_amdgcn_readfirstlane(tid >> 6), lane = tid & 63, wr = wid >> 2, wc = wid & 3, fr = lane & 15, fq = lane >> 4;
    const int K = g.K; Unit u;
    for (int ui = 0; S.next(ui, u); ++ui) {
        f32x4 acc[2][2][4][2];
#pragma unroll
        for (int a = 0; a < 2; ++a)
#pragma unroll
            for (int b = 0; b < 2; ++b)
#pragma unroll
                for (int m = 0; m < 4; ++m)
#pragma unroll
                    for (int n = 0; n < 2; ++n) acc[a][b][m][n] = (f32x4){0.f, 0.f, 0.f, 0.f};
        const bf16_t* Bt = g.Bt + (size_t)u.be * g.bstride + (size_t)u.pn * 256 * K;
        for (int ai = 0; ai < 2; ++ai)
            for (int m = 0; m < 4; ++m) {
                const int rloc = ai * 128 + wr * 64 + m * 16 + fr;
                size_t arow;
                if (GATHER) { arow = (rloc < u.nv) ? (size_t)(g.list[(size_t)u.be * T + u.rl * 256 + rloc] >> 1) : 0; }
                else arow = (size_t)u.pm * 256 + rloc;
                const bf16_t* ap = g.A + arow * K;
                for (int bj = 0; bj < 2; ++bj) {
                    const bf16_t* bp = Bt + (size_t)(bj * 128 + wc * 32 + fq * 8) * K;
                    float s[8];
#pragma unroll
                    for (int c = 0; c < 8; ++c) {
                        float sc = 0.f; const bf16_t* bpc = bp + (size_t)c * K;
#pragma unroll 2
                        for (int k = 0; k < K; k += 8) {
                            f32x4 a0, a1, b0, b1; unpack8(*(const u32x4*)(ap + k), a0, a1); unpack8(*(const u32x4*)(bpc + k), b0, b1);
                            sc += a0[0] * b0[0] + a0[1] * b0[1] + a0[2] * b0[2] + a0[3] * b0[3] + a1[0] * b1[0] + a1[1] * b1[1] + a1[2] * b1[2] + a1[3] * b1[3];
                        }
                        s[c] = sc; asm volatile("" : "+v"(s[c]));
                    }
#pragma unroll
                    for (int a2 = 0; a2 < 2; ++a2)
#pragma unroll
                        for (int b2 = 0; b2 < 2; ++b2)
#pragma unroll
                            for (int m2 = 0; m2 < 4; ++m2)
                                if (a2 == ai && b2 == bj && m2 == m) { acc[a2][b2][m2][0] = (f32x4){s[0], s[1], s[2], s[3]}; acc[a2][b2][m2][1] = (f32x4){s[4], s[5], s[6], s[7]}; }
                }
            }
        E(acc, u, wr, wc, fr, fq);
    }
}

#if FAST_GEMM
template <class Epi, class Sched, bool GATHER>
__device__ __forceinline__ void gemm_phase_fast(int tid, LAS unsigned char* lds, const Gemm g, const Sched& S, const Epi& E) {
    const int wid = __builtin_amdgcn_readfirstlane(tid >> 6), lane = tid & 63, wr = wid >> 2, wc = wid & 3, fr = lane & 15, fq = lane >> 4;
    const int K = g.K, nt = K / BK;
    int Rr[2], Cc[2]; unsigned voffB[2];
#pragma unroll
    for (int i = 0; i < 2; ++i) { stage_rc(tid * 16 + i * 8192, Rr[i], Cc[i]); const int Rb = (Rr[i] & ~31) + perm32(Rr[i] & 31); voffB[i] = (unsigned)(Rb * K + Cc[i]) * 2u; }
    const size_t kstep = (size_t)(BK * 2), hstep = (size_t)HALF * K * 2, tstep = 2 * hstep;
    const unsigned ldsw = (unsigned)wid * 1024u;
    const int aoff = lds_byte(wr * 64 + fr, fq * 8), boff = lds_byte(wc * 32 + fr, fq * 8);
#define GP_SA(b, h) (((b) * 2 + (h)) * HTB)
#define GP_SB(b, h) ((4 + (b) * 2 + (h)) * HTB)
#define GP_STAGE2(bufoff, gbase, v0, v1) do { \
        __builtin_amdgcn_global_load_lds((const unsigned*)((const char*)(gbase) + (v0)), (LAS unsigned*)(lds + (bufoff) + ldsw), 16, 0, 0); \
        __builtin_amdgcn_global_load_lds((const unsigned*)((const char*)(gbase) + (v1)), (LAS unsigned*)(lds + (bufoff) + ldsw + 8192), 16, 0, 0); } while (0)
#define GP_STAGEB(bufoff, gbase) GP_STAGE2(bufoff, gbase, voffB[0], voffB[1])
#define GP_LDA(dst, b, h) do { _Pragma("unroll") for (int m = 0; m < 4; ++m) _Pragma("unroll") for (int k = 0; k < 2; ++k) dst[m][k] = *(const LAS bf16x8*)(lds + GP_SA(b, h) + aoff + m * 2048 + k * 1024); } while (0)
#define GP_LDB(dst, b, h) do { _Pragma("unroll") for (int n = 0; n < 2; ++n) _Pragma("unroll") for (int k = 0; k < 2; ++k) dst[n][k] = *(const LAS bf16x8*)(lds + GP_SB(b, h) + boff + n * 2048 + k * 1024); } while (0)
#define GP_MMA(ai, bj, At, Bt) do { __builtin_amdgcn_s_setprio(1); _Pragma("unroll") for (int m = 0; m < 4; ++m) _Pragma("unroll") for (int n = 0; n < 2; ++n) _Pragma("unroll") for (int k = 0; k < 2; ++k) \
        acc[ai][bj][m][n] = __builtin_amdgcn_mfma_f32_16x16x32_bf16(Bt[n][k], At[m][k], acc[ai][bj][m][n], 0, 0, 0); __builtin_amdgcn_s_setprio(0); } while (0)
#define GP_WAIT_V(n) asm volatile("s_waitcnt vmcnt(" #n ")" ::: "memory")
#define GP_WAIT_L(n) asm volatile("s_waitcnt lgkmcnt(" #n ")" ::: "memory")
#define GP_BAR __builtin_amdgcn_s_barrier()
#define GP_SCHED __builtin_amdgcn_sched_barrier(0)
    Unit cur, nxt; int ui = 0;
    if (!S.next(0, cur)) return;
    f32x4 acc[2][2][4][2];
#pragma unroll
    for (int a = 0; a < 2; ++a)
#pragma unroll
        for (int b = 0; b < 2; ++b)
#pragma unroll
            for (int m = 0; m < 4; ++m)
#pragma unroll
                for (int n = 0; n < 2; ++n) acc[a][b][m][n] = (f32x4){0.f, 0.f, 0.f, 0.f};
    bf16x8 At[4][2], B0[2][2], B1[2][2];
    unsigned vC0, vC1, vC2, vC3, vN0, vN1, vN2, vN3;
#define GP_VOFF(u, o0, o1, o2, o3) do { if (GATHER) { \
        int tl_ = tid; LAUNDER_V(tl_); int R0_, C0_, R1_, C1_; stage_rc(tl_ * 16, R0_, C0_); stage_rc(tl_ * 16 + 8192, R1_, C1_);     \
        const unsigned* lp = g.list + (size_t)(u).be * T + (u).rl * 256; \
        const int nvm = (u).nv - 1; const int p0 = min(R0_, nvm), p1 = min(R1_, nvm), p2 = min(128 + R0_, nvm), p3 = min(128 + R1_, nvm); \
        const unsigned t0 = lp[p0] >> 1, t1 = lp[p1] >> 1, t2 = lp[p2] >> 1, t3 = lp[p3] >> 1; \
        o0 = (t0 * K + C0_) * 2u; o1 = (t1 * K + C1_) * 2u; o2 = (t2 * K + C0_) * 2u; o3 = (t3 * K + C1_) * 2u; \
      } else { o0 = (unsigned)(Rr[0] * K + Cc[0]) * 2u; o1 = (unsigned)(Rr[1] * K + Cc[1]) * 2u; o2 = o0 + (unsigned)hstep; o3 = o1 + (unsigned)hstep; } } while (0)
    GP_VOFF(cur, vC0, vC1, vC2, vC3);
    const char* cA = (const char*)g.A + (GATHER ? (size_t)0 : (size_t)cur.pm * tstep);
    const char* cB = (const char*)g.Bt + ((size_t)cur.be * g.bstride) * 2 + (size_t)cur.pn * tstep;
    GP_STAGEB(GP_SB(0, 0), cB); GP_STAGEB(GP_SB(0, 1), cB + hstep); GP_STAGE2(GP_SA(0, 0), cA, vC0, vC1); GP_STAGE2(GP_SA(0, 1), cA, vC2, vC3);
    if (wr == 1) GP_BAR;
    GP_WAIT_V(2); GP_BAR;
    GP_STAGEB(GP_SB(1, 0), cB + kstep); GP_STAGE2(GP_SA(1, 0), cA + kstep, vC0, vC1); GP_STAGEB(GP_SB(1, 1), cB + hstep + kstep);
    GP_WAIT_V(6); GP_BAR;
    for (;;) {
        const bool has_next = S.next(ui + 1, nxt);
        const char* nA = has_next ? (const char*)g.A + (GATHER ? (size_t)0 : (size_t)nxt.pm * tstep) : cA;
        const char* nB = has_next ? (const char*)g.Bt + ((size_t)nxt.be * g.bstride) * 2 + (size_t)nxt.pn * tstep : cB;
        if (has_next) { GP_VOFF(nxt, vN0, vN1, vN2, vN3); } else { vN0 = vC0; vN1 = vC1; vN2 = vC2; vN3 = vC3; }
#pragma nounroll
        for (int t = 0; t < nt; t += 2) {
            const bool last = (t == nt - 2);
            const char* a1 = cA + (size_t)(t + 1) * kstep;
            const char* a2 = last ? nA : cA + (size_t)(t + 2) * kstep; const char* b2 = last ? nB : cB + (size_t)(t + 2) * kstep;
            const char* a3 = a2 + kstep; const char* b3 = b2 + kstep;
            const unsigned w0 = last ? vN0 : vC0, w1 = last ? vN1 : vC1, w2 = last ? vN2 : vC2, w3 = last ? vN3 : vC3;
            GP_LDB(B0, 0, 0); GP_LDB(B1, 0, 1); GP_SCHED; GP_LDA(At, 0, 0); GP_STAGE2(GP_SA(1, 1), a1, vC2, vC3);
            GP_WAIT_V(8); GP_WAIT_L(0); GP_BAR; GP_MMA(0, 0, At, B0); GP_MMA(0, 1, At, B1); GP_BAR; GP_SCHED;
            GP_LDA(At, 0, 1); GP_STAGEB(GP_SB(0, 0), b2); GP_STAGEB(GP_SB(0, 1), b2 + hstep); GP_STAGE2(GP_SA(0, 0), a2, w0, w1);
            GP_WAIT_V(8); GP_WAIT_L(0); GP_BAR; GP_MMA(1, 0, At, B0); GP_MMA(1, 1, At, B1); GP_BAR; GP_SCHED;
            GP_LDB(B0, 1, 0); GP_LDB(B1, 1, 1); GP_SCHED; GP_LDA(At, 1, 0); GP_STAGE2(GP_SA(0, 1), a2, w2, w3);
            GP_WAIT_V(8); GP_WAIT_L(0); GP_BAR; GP_MMA(0, 0, At, B0); GP_MMA(0, 1, At, B1); GP_BAR; GP_SCHED;
            GP_LDA(At, 1, 1); GP_STAGEB(GP_SB(1, 0), b3); GP_STAGEB(GP_SB(1, 1), b3 + hstep); GP_STAGE2(GP_SA(1, 0), a3, w0, w1);
            GP_WAIT_V(8); GP_WAIT_L(0); GP_BAR; GP_MMA(1, 0, At, B0); GP_MMA(1, 1, At, B1); GP_BAR; GP_SCHED;
        }
        if (wr == 0) GP_BAR;
        E(acc, cur, wr, wc, fr, fq);
        if (!has_next) break;
#pragma unroll
        for (int a = 0; a < 2; ++a)
#pragma unroll
            for (int b = 0; b < 2; ++b)
#pragma unroll
                for (int m = 0; m < 4; ++m)
#pragma unroll
                    for (int n = 0; n < 2; ++n) acc[a][b][m][n] = (f32x4){0.f, 0.f, 0.f, 0.f};
        cur = nxt; cA = nA; cB = nB; vC0 = vN0; vC1 = vN1; vC2 = vN2; vC3 = vN3; ++ui;
        if (wr == 1) GP_BAR;
    }
    GP_WAIT_V(0);
    GP_BAR;
#undef GP_SA
#undef GP_SB
#undef GP_STAGE2
#undef GP_STAGEB
#undef GP_LDA
#undef GP_LDB
#undef GP_MMA
#undef GP_WAIT_V
#undef GP_WAIT_L
#undef GP_BAR
#undef GP_SCHED
#undef GP_VOFF
}
#endif

template <class Epi, class Sched, bool GATHER = false>
__device__ __forceinline__ void gemm_phase(int tid, LAS unsigned char* lds, const Gemm g, const Sched& S, const Epi& E) {
#if FAST_GEMM
    gemm_phase_fast<Epi, Sched, GATHER>(tid, lds, g, S, E);
#else
    (void)lds; gemm_phase_ref<Epi, Sched, GATHER>(tid, g, S, E);
#endif
}

#define EPI_ROW(ai, m) (u.pm * 256 + (ai) * 128 + wr * 64 + (m) * 16 + fr)
#define EPI_COL(bj) (u.pn * 256 + (bj) * 128 + wc * 32 + fq * 8)
__device__ __forceinline__ float dot4(f32x4 a) { return (a[0] * a[0] + a[1] * a[1]) + (a[2] * a[2] + a[3] * a[3]); }

struct EpiNull {
    __device__ __forceinline__ void operator()(const ACC_T, const Unit& u, int wr, int wc, int fr, int fq) const {
#pragma unroll
        for (int ai = 0; ai < 2; ++ai)
#pragma unroll
            for (int bj = 0; bj < 2; ++bj)
#pragma unroll
                for (int m = 0; m < 4; ++m) asm volatile("" :: "v"(acc[ai][bj][m][0]), "v"(acc[ai][bj][m][1]));
    }
};
struct EpiIn {
    bf16_t *QA, *KA, *VA, *QLAT, *KVLAT, *KB, *SA, *SB; float *SSQ, *SSKV; const float *gq, *gk, *cosA, *sinA, *cosB, *sinB;
    __device__ __forceinline__ void operator()(const ACC_T, const Unit& u, int wr, int wc, int fr, int fq) const {
        const int wb = u.pn * 4 + wc;
        if (wb < 10) {
            const bool isq = wb < 8; const int head = isq ? wb : wb - 8; const float* g = isq ? gq : gk; bf16_t* dst = isq ? QA : KA; const int dp = isq ? 512 : 128; const float qs = isq ? QSCALE_A : 1.f;
            const f32x4 g00 = *(const f32x4*)(g + 8 * fq), g01 = *(const f32x4*)(g + 8 * fq + 4), g10 = *(const f32x4*)(g + 32 + 8 * fq), g11 = *(const f32x4*)(g + 36 + 8 * fq);
#pragma unroll
            for (int ai = 0; ai < 2; ++ai)
#pragma unroll
                for (int m = 0; m < 4; ++m) {
                    const int r = EPI_ROW(ai, m), pos = r & (S - 1);
                    const f32x4 v00 = acc[ai][0][m][0], v01 = acc[ai][0][m][1], v10 = acc[ai][1][m][0], v11 = acc[ai][1][m][1];
                    float ss = (dot4(v00) + dot4(v01)) + (dot4(v10) + dot4(v11)); ss += __shfl_xor(ss, 16); ss += __shfl_xor(ss, 32);
                    const float rstd = rsqrtf(ss * (1.f / 64.f) + EPS);
                    const f32x4 y00 = v00 * rstd * g00, y01 = v01 * rstd * g01, y10 = v10 * rstd * g10, y11 = v11 * rstd * g11;
                    const f32x4 c0 = *(const f32x4*)(cosA + pos * 32 + 8 * fq), c1 = *(const f32x4*)(cosA + pos * 32 + 8 * fq + 4), s0 = *(const f32x4*)(sinA + pos * 32 + 8 * fq), s1 = *(const f32x4*)(sinA + pos * 32 + 8 * fq + 4);
                    const f32x4 o00 = (y00 * c0 - y10 * s0) * qs, o01 = (y01 * c1 - y11 * s1) * qs, o10 = (y10 * c0 + y00 * s0) * qs, o11 = (y11 * c1 + y01 * s1) * qs;
                    bf16_t* p = dst + (size_t)r * dp + head * 64 + 8 * fq;
                    *(u32x4*)p = pack8(o00, o01); *(u32x4*)(p + 32) = pack8(o10, o11);
                }
        } else if (wb < 12) {
#pragma unroll
            for (int ai = 0; ai < 2; ++ai)
#pragma unroll
                for (int m = 0; m < 4; ++m) { bf16_t* p = VA + (size_t)EPI_ROW(ai, m) * 128 + (wb - 10) * 64 + 8 * fq;
                    *(u32x4*)p = pack8(acc[ai][0][m][0], acc[ai][0][m][1]); *(u32x4*)(p + 32) = pack8(acc[ai][1][m][0], acc[ai][1][m][1]); }
        } else if (wb < 22) {
            const bool isq = wb < 18; const int idx = isq ? wb - 12 : wb - 18; bf16_t* dst = isq ? QLAT : KVLAT; const int dp = isq ? 384 : 256;
#pragma unroll
            for (int ai = 0; ai < 2; ++ai)
#pragma unroll
                for (int m = 0; m < 4; ++m) {
                    const int r = EPI_ROW(ai, m);
                    const f32x4 v00 = acc[ai][0][m][0], v01 = acc[ai][0][m][1], v10 = acc[ai][1][m][0], v11 = acc[ai][1][m][1];
                    float ss = (dot4(v00) + dot4(v01)) + (dot4(v10) + dot4(v11)); ss += __shfl_xor(ss, 16); ss += __shfl_xor(ss, 32);
                    if (fq == 0) { if (isq) SSQ[(size_t)r * 8 + idx] = ss; else SSKV[(size_t)r * 4 + idx] = ss; }
                    bf16_t* p = dst + (size_t)r * dp + idx * 64 + 8 * fq;
                    *(u32x4*)p = pack8(v00, v01); *(u32x4*)(p + 32) = pack8(v10, v11);
                }
        } else if (wb == 22) {
            if (fq < 2) {
#pragma unroll
                for (int ai = 0; ai < 2; ++ai)
#pragma unroll
                    for (int m = 0; m < 4; ++m) {
                        const int r = EPI_ROW(ai, m), pos = r & (S - 1);
                        const f32x4 x10 = acc[ai][0][m][0], x11 = acc[ai][0][m][1], x20 = acc[ai][1][m][0], x21 = acc[ai][1][m][1];
                        const f32x4 c0 = *(const f32x4*)(cosB + pos * 16 + 8 * fq), c1 = *(const f32x4*)(cosB + pos * 16 + 8 * fq + 4), s0 = *(const f32x4*)(sinB + pos * 16 + 8 * fq), s1 = *(const f32x4*)(sinB + pos * 16 + 8 * fq + 4);
                        const u32x4 w1 = pack8(x10 * c0 - x20 * s0, x11 * c1 - x21 * s1), w2 = pack8(x20 * c0 + x10 * s0, x21 * c1 + x11 * s1);
                        bf16_t* p = KB + (size_t)r * 768 + 64 + 8 * fq;
#pragma unroll
                        for (int h = 0; h < 8; ++h) { *(u32x4*)(p + h * 96) = w1; *(u32x4*)(p + h * 96 + 16) = w2; }
                    }
            }
        } else if (wb == 23) {
        } else {
            const bool isa = wb < 40; const int idx = isa ? wb - 24 : wb - 40; unsigned char* dst = (unsigned char*)(isa ? SA : SB);
#pragma unroll
            for (int ai = 0; ai < 2; ++ai)
#pragma unroll
                for (int m = 0; m < 4; ++m) { unsigned char* p = dst + (size_t)EPI_ROW(ai, m) * 1024 + idx * 64 + 8 * fq;
#pragma unroll
                    for (int bj = 0; bj < 2; ++bj) { const f32x4 a = acc[ai][bj][m][0], b = acc[ai][bj][m][1]; u32x2 w;
                        w.x = (unsigned)__builtin_amdgcn_cvt_pk_fp8_f32(a[2], a[3], __builtin_amdgcn_cvt_pk_fp8_f32(a[0], a[1], 0, false), true);
                        w.y = (unsigned)__builtin_amdgcn_cvt_pk_fp8_f32(b[2], b[3], __builtin_amdgcn_cvt_pk_fp8_f32(b[0], b[1], 0, false), true);
                        *(u32x2*)(p + bj * 32) = w; } }
        }
    }
};
__host__ __device__ __forceinline__ int src_col_in(int n) {
    const int pn = n >> 8, nl = n & 255, bj = nl >> 7, wc = (nl & 127) >> 5, p = nl & 31, wb = pn * 4 + wc, s = bj * 32 + p;
    if (wb < 8) return wb * 64 + s;
    if (wb < 10) return 512 + (wb - 8) * 64 + s;
    if (wb < 12) return 640 + (wb - 10) * 64 + s;
    if (wb < 18) return 768 + (wb - 12) * 64 + s;
    if (wb < 22) return 1152 + (wb - 18) * 64 + s;
    if (wb == 22) return p < 16 ? 1408 + bj * 16 + p : -1;
    if (wb == 23) return -1;
    if (wb < 40) return 1440 + (wb - 24) * 64 + s;
    return 2464 + (wb - 40) * 64 + s;
}
struct EpiQb {
    bf16_t* QB; const float *SSQ, *cosB, *sinB;
    __device__ __forceinline__ void operator()(const ACC_T, const Unit& u, int wr, int wc, int fr, int fq) const {
#pragma unroll
        for (int ai = 0; ai < 2; ++ai)
#pragma unroll
            for (int m = 0; m < 4; ++m) {
                const int r = EPI_ROW(ai, m), pos = r & (S - 1);
                const f32x4 sa = *(const f32x4*)(SSQ + (size_t)r * 8); const f32x2 sb = *(const f32x2*)(SSQ + (size_t)r * 8 + 4);
                const float rstd = rsqrtf((((sa[0] + sa[1]) + (sa[2] + sa[3])) + (sb[0] + sb[1])) * (1.f / 384.f) + EPS);
#pragma unroll
                for (int bj = 0; bj < 2; ++bj) {
                    f32x4 v0 = acc[ai][bj][m][0] * rstd, v1 = acc[ai][bj][m][1] * rstd;
                    const int c32 = u.pn * 8 + bj * 4 + wc;
                    if (c32 % 3 == 2) {
                        f32x4 o0, o1;
#pragma unroll
                        for (int j = 0; j < 4; ++j) { o0[j] = __shfl_xor(v0[j], 32); o1[j] = __shfl_xor(v1[j], 32); }
                        const int i0 = 8 * (fq & 1);
                        const f32x4 c0 = *(const f32x4*)(cosB + pos * 16 + i0), c1 = *(const f32x4*)(cosB + pos * 16 + i0 + 4), s0 = *(const f32x4*)(sinB + pos * 16 + i0), s1 = *(const f32x4*)(sinB + pos * 16 + i0 + 4);
                        if (fq < 2) { v0 = v0 * c0 - o0 * s0; v1 = v1 * c1 - o1 * s1; } else { v0 = v0 * c0 + o0 * s0; v1 = v1 * c1 + o1 * s1; }
                    }
                    *(u32x4*)(QB + (size_t)r * 768 + EPI_COL(bj)) = pack8(v0 * QSCALE_B, v1 * QSCALE_B);
                }
            }
    }
};
struct EpiKvb {
    bf16_t *KB, *VB; const float* SSKV;
    __device__ __forceinline__ void operator()(const ACC_T, const Unit& u, int wr, int wc, int fr, int fq) const {
#pragma unroll
        for (int ai = 0; ai < 2; ++ai)
#pragma unroll
            for (int m = 0; m < 4; ++m) {
                const int r = EPI_ROW(ai, m);
                const f32x4 sa = *(const f32x4*)(SSKV + (size_t)r * 4);
                const float rstd = rsqrtf(((sa[0] + sa[1]) + (sa[2] + sa[3])) * (1.f / 256.f) + EPS);
#pragma unroll
                for (int bj = 0; bj < 2; ++bj) {
                    const int head = u.pn * 2 + bj, o = wc * 32 + fq * 8;
                    const u32x4 w = pack8(acc[ai][bj][m][0] * rstd, acc[ai][bj][m][1] * rstd);
                    if (wc < 2) *(u32x4*)(KB + (size_t)r * 768 + head * 96 + o) = w; else *(u32x4*)(VB + (size_t)r * 512 + head * 64 + (o - 64)) = w;
                }
            }
    }
};
template <int MODE> struct EpiProj {
    bf16_t* O; const bf16_t* gate;
    __device__ __forceinline__ void operator()(const ACC_T, const Unit& u, int wr, int wc, int fr, int fq) const {
#pragma unroll
        for (int ai = 0; ai < 2; ++ai)
#pragma unroll
            for (int m = 0; m < 4; ++m) {
                const int r = EPI_ROW(ai, m);
#pragma unroll
                for (int bj = 0; bj < 2; ++bj) {
                    const size_t off = (size_t)r * D + EPI_COL(bj);
                    const u32x2 gw = *(const u32x2*)((const unsigned char*)gate + off);
                    const f32x2 q0 = __builtin_amdgcn_cvt_pk_f32_fp8((int)gw.x, false), q1 = __builtin_amdgcn_cvt_pk_f32_fp8((int)gw.x, true), q2 = __builtin_amdgcn_cvt_pk_f32_fp8((int)gw.y, false), q3 = __builtin_amdgcn_cvt_pk_f32_fp8((int)gw.y, true);
                    const f32x4 g0 = {sigm(q0[0]), sigm(q0[1]), sigm(q1[0]), sigm(q1[1])}, g1 = {sigm(q2[0]), sigm(q2[1]), sigm(q3[0]), sigm(q3[1])};
                    f32x4 v0 = acc[ai][bj][m][0] * g0, v1 = acc[ai][bj][m][1] * g1;
                    if (MODE == 1) { f32x4 p0, p1; unpack8(*(const u32x4*)(O + off), p0, p1); v0 += p0; v1 += p1; }
                    *(u32x4*)(O + off) = pack8(v0, v1);
                }
            }
    }
};
struct EpiWo {
    const bf16_t* X; const float* modl; bf16_t* XO;
    __device__ __forceinline__ void operator()(const ACC_T, const Unit& u, int wr, int wc, int fr, int fq) const {
        const float* g1 = modl + (size_t)(u.pm >> 4) * 6 * D + 2 * D;
#pragma unroll
        for (int bj = 0; bj < 2; ++bj) {
            const int c = EPI_COL(bj); const f32x4 ga = *(const f32x4*)(g1 + c), gb = *(const f32x4*)(g1 + c + 4);
#pragma unroll
            for (int ai = 0; ai < 2; ++ai)
#pragma unroll
                for (int m = 0; m < 4; ++m) { const size_t off = (size_t)EPI_ROW(ai, m) * D + c;
                    f32x4 x0, x1; unpack8(*(const u32x4*)(X + off), x0, x1);
                    *(u32x4*)(XO + off) = pack8(x0 + ga * acc[ai][bj][m][0], x1 + gb * acc[ai][bj][m][1]); }
        }
    }
};
struct EpiUp {
    bf16_t* ACT;
    __device__ __forceinline__ void operator()(const ACC_T, const Unit& u, int wr, int wc, int fr, int fq) const {
#pragma unroll
        for (int ai = 0; ai < 2; ++ai)
#pragma unroll
            for (int m = 0; m < 4; ++m) {
                f32x4 a = acc[ai][0][m][0], b = acc[ai][0][m][1]; const f32x4 c = acc[ai][1][m][0], d = acc[ai][1][m][1];
#pragma unroll
                for (int j = 0; j < 4; ++j) { a[j] = a[j] * sigm(a[j]) * c[j]; b[j] = b[j] * sigm(b[j]) * d[j]; }
                *(u32x4*)(ACT + (size_t)EPI_ROW(ai, m) * FF + u.pn * 128 + wc * 32 + fq * 8) = pack8(a, b);
            }
    }
};
struct EpiDown {
    bf16_t* Y2; const unsigned* list; const float* gw;
    __device__ __forceinline__ void operator()(const ACC_T, const Unit& u, int wr, int wc, int fr, int fq) const {
#pragma unroll
        for (int ai = 0; ai < 2; ++ai)
#pragma unroll
            for (int m = 0; m < 4; ++m) {
                const int rloc = ai * 128 + wr * 64 + m * 16 + fr;
                if (rloc < u.nv) {
                    const unsigned entry = list[(size_t)u.be * T + u.rl * 256 + rloc]; const float w = gw[entry];
#pragma unroll
                    for (int bj = 0; bj < 2; ++bj) { const f32x4 a = acc[ai][bj][m][0] * (w * 16.f), b = acc[ai][bj][m][1] * (w * 16.f); u32x2 q;
                        q.x = (unsigned)__builtin_amdgcn_cvt_pk_fp8_f32(a[2], a[3], __builtin_amdgcn_cvt_pk_fp8_f32(a[0], a[1], 0, false), true);
                        q.y = (unsigned)__builtin_amdgcn_cvt_pk_fp8_f32(b[2], b[3], __builtin_amdgcn_cvt_pk_fp8_f32(b[0], b[1], 0, false), true);
                        *(u32x2*)((unsigned char*)Y2 + (size_t)entry * D + EPI_COL(bj)) = q; }
                }
            }
    }
};
}

namespace at {
struct Tensors { const bf16_t* Q; int qp; const bf16_t* K; int kp; const bf16_t* V; int vp; bf16_t* O; int op; int group; };
__device__ __forceinline__ bool next_unit(int i, int vcu, int G, int& bh, int& qb) {
    int u;
    if (G == 256) { if (i >= 4) return false; u = (vcu >> 5) * 128 + i * 32 + (vcu & 31); }
    else { u = i * G + vcu; if (u >= 1024) return false; }
    bh = u >> 4; qb = u & 15; return true;
}
template <int DQK>
__device__ __forceinline__ void attn_phase_ref(int tid, const Tensors& A, int vcu, int G) {
    int bh, qb;
    for (int i = 0; next_unit(i, vcu, G, bh, qb); ++i) {
        const int b = bh >> 3, h = bh & 7, kvh = h / A.group;
        {
            const int dh = tid >> 8;
            const size_t row = (size_t)b * S + qb * 256 + (tid & 255);
            float q[DQK], o[32];
#pragma unroll
            for (int d = 0; d < DQK; ++d) q[d] = bf2f(A.Q[row * A.qp + h * DQK + d]);
#pragma unroll
            for (int d = 0; d < 32; ++d) o[d] = 0.f;
            float l = 0.f;
            for (int k = 0; k < S; ++k) {
                const bf16_t* kr = A.K + ((size_t)b * S + k) * A.kp + kvh * DQK; const bf16_t* vr = A.V + ((size_t)b * S + k) * A.vp + kvh * 64 + dh * 32;
                float sc = 0.f;
#pragma unroll
                for (int d = 0; d < DQK; d += 8) { f32x4 k0, k1; unpack8(*(const u32x4*)(kr + d), k0, k1);
                    sc += q[d] * k0[0] + q[d + 1] * k0[1] + q[d + 2] * k0[2] + q[d + 3] * k0[3] + q[d + 4] * k1[0] + q[d + 5] * k1[1] + q[d + 6] * k1[2] + q[d + 7] * k1[3]; }
                const float p = bf2f(cvt_pk_bf16(exp2f(sc), 0.f) & 0xffffu); l += p;
#pragma unroll
                for (int d = 0; d < 32; d += 8) { f32x4 v0, v1; unpack8(*(const u32x4*)(vr + d), v0, v1);
                    o[d] += p * v0[0]; o[d + 1] += p * v0[1]; o[d + 2] += p * v0[2]; o[d + 3] += p * v0[3]; o[d + 4] += p * v1[0]; o[d + 5] += p * v1[1]; o[d + 6] += p * v1[2]; o[d + 7] += p * v1[3]; }
            }
            const float il = 1.f / l;
            __syncthreads();
#pragma unroll
            for (int d = 0; d < 32; d += 8) { f32x4 a = {o[d] * il, o[d + 1] * il, o[d + 2] * il, o[d + 3] * il}, c = {o[d + 4] * il, o[d + 5] * il, o[d + 6] * il, o[d + 7] * il};
                *(u32x4*)(A.O + row * A.op + h * 64 + dh * 32 + d) = pack8(a, c); }
        }
    }
}
#if FAST_ATTN
typedef short s16x4 __attribute__((ext_vector_type(4)));
__device__ __forceinline__ unsigned cvtpk(float lo, float hi) { f32x2 v = {lo, hi}; bf16x2_t b = __builtin_convertvector(v, bf16x2_t); return __builtin_bit_cast(unsigned, b); }
__device__ __forceinline__ s16x4 vtr(const LAS unsigned char* p) { return __builtin_bit_cast(s16x4, __builtin_amdgcn_ds_read_tr16_b64_v4i16((LAS s16x4*)p)); }
__device__ __forceinline__ int crow(int r, int hi) { return (r & 3) + 8 * (r >> 2) + 4 * hi; }
#define AT_BAR() asm volatile("s_barrier" ::: "memory")
#define AT_WAITBAR(N) asm volatile("s_waitcnt vmcnt(" #N ") lgkmcnt(0)\n\ts_barrier" ::: "memory")
#define AT_SCHED() __builtin_amdgcn_sched_barrier(0)
__device__ __forceinline__ void glds16(const void* gsrc, unsigned lds_dst) { unsigned keep;
    asm volatile("s_mov_b32 %0, m0\n\ts_mov_b32 m0, %2\n\ts_nop 0\n\tglobal_load_lds_dwordx4 %1, off\n\ts_mov_b32 m0, %0" : "=&s"(keep) : "v"(gsrc), "s"(lds_dst) : "memory"); }
#define AT_GLDS(g, l) glds16((const void*)(g), (unsigned)__builtin_amdgcn_readfirstlane((int)(unsigned)(uintptr_t)(l)))
template <int DQK>
__device__ __forceinline__ void attn_unit(int tid, LAS unsigned char* lds, const Tensors& A, int b, int h, int qb) {
    constexpr int ND = DQK / 16, NCH = DQK / 8, KSLOT = NCH * 1024, NKD = NCH > 8 ? 2 : 1, VSLOT = 8192, NT = S / 64;
    constexpr int KOFF = 0, VOFF = 3 * KSLOT, OST = VOFF + 3 * VSLOT, WSF = OST + 8 * 4096;
    static_assert(WSF + 8 * 256 <= RING_BYTES, "attention LDS");
    const int lane = tid & 63, r32 = lane & 31, hi = lane >> 5, wid = __builtin_amdgcn_readfirstlane(tid >> 6);
    const int kvh = h / A.group; const size_t rowb = (size_t)b * S;
    const bf16_t* ksrc = A.K + (rowb + lane) * A.kp + kvh * DQK + wid * 8;
    const bf16_t* ksrc2 = A.K + (rowb + lane) * A.kp + kvh * DQK + (8 + (wid & 3)) * 8;
    const bf16_t* vsrc = A.V + (rowb + 16 * (wid & 3) + (lane >> 2)) * A.vp + kvh * 64 + (wid >> 2) * 32 + (lane & 3) * 8;
    const size_t ktile = (size_t)64 * A.kp, vtile = (size_t)64 * A.vp;
    LAS unsigned char* kdst = lds + KOFF + wid * 1024; LAS unsigned char* kdst2 = lds + KOFF + (8 + (wid & 3)) * 1024; LAS unsigned char* vdst = lds + VOFF + wid * 1024;
#define DMA_K(j, so) do { AT_GLDS(ksrc + (size_t)(j) * ktile, kdst + (so)); if (NKD == 2) AT_GLDS(ksrc2 + (size_t)(j) * ktile, kdst2 + (so)); } while (0)
#define DMA_V(j, so) AT_GLDS(vsrc + (size_t)(j) * vtile, vdst + (so))
    const LAS unsigned char* kp0 = lds + KOFF + hi * 1024 + r32 * 16;
    const LAS unsigned char* vp0 = lds + VOFF + ((lane >> 4) & 1) * 32 + (lane & 3) * 8 + (4 * hi + ((lane & 15) >> 2)) * 64;
    DMA_K(0, 0); DMA_V(0, 0); DMA_K(1, KSLOT); DMA_V(1, VSLOT); DMA_K(2, 2 * KSLOT);
    const bf16_t* Qw = A.Q + (rowb + qb * 256 + wid * 32 + r32) * A.qp + h * DQK + hi * 8;
    bf16x8 qr[ND];
#pragma unroll
    for (int d0 = 0; d0 < ND; ++d0) qr[d0] = *(const bf16x8*)(Qw + d0 * 16);
    asm volatile("s_waitcnt vmcnt(0)\n\ts_barrier" ::: "memory");
    bf16x8 kf[2 * ND]; s16x4 vlo[8], vhi[8];
#define KLOAD(so) do { _Pragma("unroll") for (int d0 = 0; d0 < ND; ++d0) { kf[2 * d0] = *(const LAS bf16x8*)(kp0 + (so) + d0 * 2048); kf[2 * d0 + 1] = *(const LAS bf16x8*)(kp0 + (so) + d0 * 2048 + 512); } } while (0)
#define VLOAD(so) do { _Pragma("unroll") for (int i = 0; i < 8; ++i) { vlo[i] = vtr(vp0 + (so) + (i >> 2) * 4096 + (i & 3) * 1024); vhi[i] = vtr(vp0 + (so) + (i >> 2) * 4096 + (i & 3) * 1024 + 512); } } while (0)
#define VFR(i) (bf16x8){vlo[i][0], vlo[i][1], vlo[i][2], vlo[i][3], vhi[i][0], vhi[i][1], vhi[i][2], vhi[i][3]}
    KLOAD(0);
    asm volatile("s_waitcnt lgkmcnt(0)" ::: "memory");
    if (PROBE_ATT != 5 && wid >= 4) AT_BAR();
    f32x16 o0 = {}, o1 = {}, C0, C1; u32x4 pw0, pw1, pw2, pw3; float lsum = 0.f;
    const f32x16 zero = {};
#define QK_BLOCK() do { C0 = __builtin_amdgcn_mfma_f32_32x32x16_bf16(kf[0], qr[0], zero, 0, 0, 0); C1 = __builtin_amdgcn_mfma_f32_32x32x16_bf16(kf[1], qr[0], zero, 0, 0, 0); \
        _Pragma("unroll") for (int d0 = 1; d0 < ND; ++d0) { C0 = __builtin_amdgcn_mfma_f32_32x32x16_bf16(kf[2 * d0], qr[d0], C0, 0, 0, 0); C1 = __builtin_amdgcn_mfma_f32_32x32x16_bf16(kf[2 * d0 + 1], qr[d0], C1, 0, 0, 0); } } while (0)
#define PAF(k) __builtin_bit_cast(bf16x8, pw##k)
#define PV_BLOCK() do { \
        o0 = __builtin_amdgcn_mfma_f32_32x32x16_bf16(PAF(0), VFR(0), o0, 0, 0, 0); o1 = __builtin_amdgcn_mfma_f32_32x32x16_bf16(PAF(0), VFR(4), o1, 0, 0, 0); \
        o0 = __builtin_amdgcn_mfma_f32_32x32x16_bf16(PAF(1), VFR(1), o0, 0, 0, 0); o1 = __builtin_amdgcn_mfma_f32_32x32x16_bf16(PAF(1), VFR(5), o1, 0, 0, 0); \
        o0 = __builtin_amdgcn_mfma_f32_32x32x16_bf16(PAF(2), VFR(2), o0, 0, 0, 0); o1 = __builtin_amdgcn_mfma_f32_32x32x16_bf16(PAF(2), VFR(6), o1, 0, 0, 0); \
        o0 = __builtin_amdgcn_mfma_f32_32x32x16_bf16(PAF(3), VFR(3), o0, 0, 0, 0); o1 = __builtin_amdgcn_mfma_f32_32x32x16_bf16(PAF(3), VFR(7), o1, 0, 0, 0); } while (0)
#define SOFTMAX() do { \
        _Pragma("unroll") for (int r = 0; r < 16; ++r) { C0[r] = __builtin_amdgcn_exp2f(C0[r]); C1[r] = __builtin_amdgcn_exp2f(C1[r]); } \
        f32x2 s0_ = {C0[0], C0[1]}, s1_ = {C1[0], C1[1]}; _Pragma("unroll") for (int r = 2; r < 16; r += 2) { s0_ += (f32x2){C0[r], C0[r + 1]}; s1_ += (f32x2){C1[r], C1[r + 1]}; } s0_ += s1_; lsum += s0_[0] + s0_[1]; \
        pw0 = (u32x4){cvtpk(C0[0], C0[1]), cvtpk(C0[2], C0[3]), cvtpk(C0[4], C0[5]), cvtpk(C0[6], C0[7])}; pw1 = (u32x4){cvtpk(C0[8], C0[9]), cvtpk(C0[10], C0[11]), cvtpk(C0[12], C0[13]), cvtpk(C0[14], C0[15])}; \
        pw2 = (u32x4){cvtpk(C1[0], C1[1]), cvtpk(C1[2], C1[3]), cvtpk(C1[4], C1[5]), cvtpk(C1[6], C1[7])}; pw3 = (u32x4){cvtpk(C1[8], C1[9]), cvtpk(C1[10], C1[11]), cvtpk(C1[12], C1[13]), cvtpk(C1[14], C1[15])}; } while (0)
    int ka = 2 * KSLOT, kb = 0, kc = KSLOT, va = 2 * VSLOT, vb = 0, vc = VSLOT;
#define ROT() do { const int t_ = ka; ka = kb; kb = kc; kc = t_; const int u_ = va; va = vb; vb = vc; vc = u_; } while (0)
#define PINP() asm volatile("" : "+v"(lsum) : "v"(pw0), "v"(pw1), "v"(pw2), "v"(pw3))
#if ATT_REGSTAGE
    u32x4 kst = {}, kst2 = {}, vst = {};
    const LAS unsigned char* kw = lds + KOFF + wid * 1024 + lane * 16; const LAS unsigned char* kw2 = lds + KOFF + (8 + (wid & 3)) * 1024 + lane * 16; const LAS unsigned char* vw = lds + VOFF + wid * 1024 + lane * 16;
#define ST_WRITE(WK, WV) do { if (WK) { *(LAS u32x4*)(kw + ka) = kst; if (NKD == 2 && wid < 4) *(LAS u32x4*)(kw2 + ka) = kst2; } if (WV) *(LAS u32x4*)(vw + vc) = vst; } while (0)
#define ST_LOAD(sv, IK, IV) do { if (IK) { kst = *(const u32x4*)(ksrc + (size_t)((sv) + 4) * ktile); if (NKD == 2 && wid < 4) kst2 = *(const u32x4*)(ksrc2 + (size_t)((sv) + 4) * ktile); } if (IV) vst = *(const u32x4*)(vsrc + (size_t)((sv) + 3) * vtile); } while (0)
#define STEP(sv, DOQK, DOPV, KL, VL, IK, IV, WK, WV) do { \
        AT_SCHED(); if (DOQK) QK_BLOCK(); if (DOPV) PV_BLOCK(); AT_SCHED(); \
        asm volatile("s_barrier\n\ts_nop 15\n\ts_nop 3" : "+v"(C0), "+v"(C1), "+v"(o0), "+v"(o1) :: "memory"); AT_SCHED(); \
        if (KL) KLOAD(kc); if (VL) VLOAD(vb); ST_WRITE(WK, WV); ST_LOAD(sv, IK, IV); \
        if (DOQK) { SOFTMAX(); PINP(); } AT_SCHED(); \
        asm volatile("s_waitcnt lgkmcnt(0)\n\ts_barrier" ::: "memory"); \
        AT_SCHED(); ROT(); } while (0)
    STEP(-1, true, false, true, true, true, true, false, false);
#pragma nounroll
    for (int s = 0; s < NT - 4; ++s) STEP(s, true, true, true, true, true, true, true, true);
    STEP(NT - 4, true, true, true, true, false, true, true, true);
    STEP(NT - 3, true, true, true, true, false, false, false, true);
    STEP(NT - 2, true, true, false, true, false, false, false, false);
    STEP(NT - 1, false, true, false, false, false, false, false, false);
#undef ST_WRITE
#undef ST_LOAD
#else
#define STEP(sv, DOQK, DOPV, KL, VL, IK, IV) do { \
        AT_SCHED(); if (DOQK) QK_BLOCK(); if (DOPV) PV_BLOCK(); AT_SCHED(); \
          \
        asm volatile("s_barrier\n\ts_nop 15\n\ts_nop 3" : "+v"(C0), "+v"(C1), "+v"(o0), "+v"(o1) :: "memory"); AT_SCHED(); \
        if (KL) KLOAD(kc); if (VL) VLOAD(vb); if (IK) DMA_K((sv) + 4, kb); if (IV) DMA_V((sv) + 3, va); \
        if (DOQK) { SOFTMAX(); PINP(); } AT_SCHED(); \
        if (IK) { if (NKD == 2) { AT_WAITBAR(3); } else { AT_WAITBAR(2); } } else if (IV) { AT_WAITBAR(1); } else { AT_WAITBAR(0); } \
        AT_SCHED(); ROT(); } while (0)
    STEP(-1, true, false, true, true, true, true);
#pragma nounroll
    for (int s = 0; s < NT - 4; ++s) STEP(s, true, true, true, true, true, true);
    STEP(NT - 4, true, true, true, true, false, true);
    STEP(NT - 3, true, true, true, true, false, false);
    STEP(NT - 2, true, true, false, true, false, false);
    STEP(NT - 1, false, true, false, false, false, false);
#endif
#undef STEP
#undef PINP
    if (PROBE_ATT != 5 && wid < 4) AT_BAR();
    { auto rr = __builtin_amdgcn_permlane32_swap(__float_as_uint(lsum), __float_as_uint(lsum), false, false); lsum = __uint_as_float(rr[0]) + __uint_as_float(rr[1]); }
    LAS float* wsf = (LAS float*)(lds + WSF + wid * 256);
    if (hi == 0) wsf[r32] = lsum;
    asm volatile("s_waitcnt lgkmcnt(0)" ::: "memory");
    LAS bf16_t* stg = (LAS bf16_t*)(lds + OST + wid * 4096);
#pragma unroll
    for (int r = 0; r < 16; ++r) { const int orow = crow(r, hi); const float rl = __builtin_amdgcn_rcpf(wsf[orow]);
        stg[orow * 64 + r32] = (bf16_t)(cvtpk(o0[r] * rl, 0.f) & 0xffffu); stg[orow * 64 + 32 + r32] = (bf16_t)(cvtpk(o1[r] * rl, 0.f) & 0xffffu); }
    asm volatile("s_waitcnt lgkmcnt(0)" ::: "memory");
    bf16_t* Ow = A.O + (rowb + qb * 256 + wid * 32) * A.op + h * 64;
#pragma unroll
    for (int i = 0; i < 4; ++i) { const int row = i * 8 + (lane >> 3), ch = lane & 7; const u32x4 v = *(const LAS u32x4*)(stg + row * 64 + ch * 8); *(u32x4*)(Ow + (size_t)row * A.op + ch * 8) = v; }
    asm volatile("s_waitcnt lgkmcnt(0)\n\ts_barrier" ::: "memory");
#undef DMA_K
#undef DMA_V
#undef KLOAD
#undef VLOAD
#undef VFR
#undef QK_BLOCK
#undef PAF
#undef PV_BLOCK
#undef SOFTMAX
#undef ROT
}
#endif
template <int DQK>
__device__ __forceinline__ void attn_phase(int tid, LAS unsigned char* lds, const Tensors& A, int vcu, int G) {
#if FAST_ATTN
    int bh, qb;
    for (int i = 0; next_unit(i, vcu, G, bh, qb); ++i) attn_unit<DQK>(tid, lds, A, bh >> 3, bh & 7, qb);
#else
    (void)lds; attn_phase_ref<DQK>(tid, A, vcu, G);
#endif
}
}


struct Args { const float* in[22]; float* out; unsigned char* ws; int ph_lo, ph_hi; };
struct Frame {
    LAS unsigned char* lds; volatile LAS unsigned* MISC; unsigned* ctl;
    int tid, lane, wave, vcu, G;
    unsigned char* ws; float* OUT;
};

__device__ __forceinline__ void p0_phase(Frame& F, const float* c, const float* w_ada, const float* b_ada) {
    LAS float* cs = (LAS float*)F.lds;
    LAS float* red = (LAS float*)(F.lds + 32768);
    for (int i = F.tid; i < NB * D; i += NTHREADS) { const float v = c[i]; cs[i] = v / (1.f + __expf(-v)); }
    __syncthreads();
    float* mod = (float*)(F.ws + WS_MOD);
    const int kq = F.wave, col = F.lane;
    for (int item = F.vcu; item < NL * 6 * D / 64; item += F.G) {
        const int l = item / (6 * D / 64), n0 = (item % (6 * D / 64)) * 64;
        const float* w = w_ada + (size_t)l * D * 6 * D + n0 + col;
        float acc[NB];
#pragma unroll
        for (int b = 0; b < NB; ++b) acc[b] = 0.f;
#pragma unroll 8
        for (int k = kq * 128; k < kq * 128 + 128; ++k) { const float wv = w[(size_t)k * 6 * D];
#pragma unroll
            for (int b = 0; b < NB; ++b) acc[b] += cs[b * D + k] * wv; }
#pragma unroll
        for (int b = 0; b < NB; ++b) red[(kq * NB + b) * 64 + col] = acc[b];
        __syncthreads();
        { const int b = F.wave; float s = 0.f;
#pragma unroll
          for (int q = 0; q < 8; ++q) s += red[(q * NB + b) * 64 + col];
          mod[((size_t)l * NB + b) * 6 * D + n0 + col] = s + b_ada[(size_t)l * 6 * D + n0 + col]; }
        __syncthreads();
    }
    float* cosA = (float*)(F.ws + WS_COSA); float* sinA = (float*)(F.ws + WS_SINA); float* cosB = (float*)(F.ws + WS_COSB); float* sinB = (float*)(F.ws + WS_SINB);
    for (int idx = F.vcu * NTHREADS + F.tid; idx < S * 48; idx += F.G * NTHREADS) {
        const int s = idx / 48, i = idx % 48; const float row = (float)(s >> 6), col2 = (float)(s & 63);
        if (i < 32) { const int j = i & 15; const float a = (i < 16 ? row : col2) * (1.0f / powf(10000.0f, (float)j / 16.0f)); cosA[s * 32 + i] = cosf(a); sinA[s * 32 + i] = sinf(a); }
        else { const int ii = i - 32, j = ii & 7; const float a = (ii < 8 ? row : col2) * (1.0f / powf(10000.0f, (float)j / 8.0f)); cosB[s * 16 + ii] = cosf(a); sinB[s * 16 + ii] = sinf(a); }
    }
}

template <class SrcFn>
__device__ __forceinline__ void cvt_item(const float* W, int K, int Nsrc, const float* kg, bf16_t* WT, LAS float* scr, int item, int nblk, int lane, const SrcFn& src) {
    const int kb = item / nblk, nb = item % nblk, k0 = 64 * kb, n0 = 32 * nb;
    const int sc = src(n0 + (lane & 31));
#pragma unroll
    for (int i = 0; i < 32; ++i) { const int kk = 2 * i + (lane >> 5); float v = sc >= 0 ? W[(size_t)(k0 + kk) * Nsrc + sc] : 0.f; if (kg) v *= kg[k0 + kk]; scr[kk * 33 + (lane & 31)] = v; }
    LDS_WAIT(); asm volatile("" ::: "memory");
    const int c = lane & 7;
#pragma unroll
    for (int j = 0; j < 4; ++j) { const int n = (lane >> 3) + 8 * j; const LAS float* s = scr + (8 * c) * 33 + n;
        u32x4 o; o.x = cvt_pk_bf16(s[0 * 33], s[1 * 33]); o.y = cvt_pk_bf16(s[2 * 33], s[3 * 33]); o.z = cvt_pk_bf16(s[4 * 33], s[5 * 33]); o.w = cvt_pk_bf16(s[6 * 33], s[7 * 33]);
        *(u32x4*)(WT + (size_t)(n0 + n) * K + k0 + 8 * c) = o; }
    LDS_WAIT(); asm volatile("" ::: "memory");
}
struct SrcId { __device__ int operator()(int n) const { return n; } };
struct SrcIn { __device__ int operator()(int n) const { return gp::src_col_in(n); } };
typedef __attribute__((address_space(4))) const Args CArgsW;
__device__ __forceinline__ void convert_weights(Frame& F, CArgsW* a, int l) {
    LAS float* scr = (LAS float*)(F.lds + F.wave * 16384);
    const int gw = F.vcu * NWAVES + F.wave, NGW = F.G * NWAVES;
    const float* w_in = ((const float*)(GAS const float*)a->in[5]) + (size_t)l * D * INC; const float* w_q_b = ((const float*)(GAS const float*)a->in[10]) + (size_t)l * 384 * 768; const float* w_kv_b = ((const float*)(GAS const float*)a->in[11]) + (size_t)l * 256 * 1024;
    const float* w_pa = ((const float*)(GAS const float*)a->in[12]) + (size_t)l * 512 * D; const float* w_pb = ((const float*)(GAS const float*)a->in[13]) + (size_t)l * 512 * D; const float* w_o = ((const float*)(GAS const float*)a->in[14]) + (size_t)l * D * D;
    const float* w1 = ((const float*)(GAS const float*)a->in[18]) + (size_t)l * NE * D * FF; const float* w3 = ((const float*)(GAS const float*)a->in[19]) + (size_t)l * NE * D * FF; const float* w2 = ((const float*)(GAS const float*)a->in[20]) + (size_t)l * NE * FF * D;
    const float* gqa = ((const float*)(GAS const float*)a->in[8]) + l * 384; const float* gkv = ((const float*)(GAS const float*)a->in[9]) + l * 256;
    bf16_t* Win = (bf16_t*)(F.ws + WS_WIN); bf16_t* Wqb = (bf16_t*)(F.ws + WS_WQB); bf16_t* Wkvb = (bf16_t*)(F.ws + WS_WKVB); bf16_t* Wpa = (bf16_t*)(F.ws + WS_WPA); bf16_t* Wpb = (bf16_t*)(F.ws + WS_WPB);
    bf16_t* Wo = (bf16_t*)(F.ws + WS_WO); bf16_t* W13 = (bf16_t*)(F.ws + WS_W13); bf16_t* W2 = (bf16_t*)(F.ws + WS_W2);
    constexpr int I_IN = (D / 64) * (NIN / 32), I_QB = (384 / 64) * (768 / 32), I_KVB = (256 / 64) * (1024 / 32), I_P = (512 / 64) * (D / 32), I_O = (D / 64) * (D / 32);
    constexpr int I_13 = (D / 64) * (1024 / 32), I_2 = (FF / 64) * (D / 32);
    constexpr int NITEMS = I_IN + I_QB + I_KVB + 2 * I_P + I_O + NE * (I_13 + I_2);
    for (int it = gw; it < NITEMS; it += NGW) {
        int r = it;
        if (r < I_IN) { cvt_item(w_in, D, INC, nullptr, Win, scr, r, NIN / 32, F.lane, SrcIn()); continue; } r -= I_IN;
        if (r < I_QB) { cvt_item(w_q_b, 384, 768, gqa, Wqb, scr, r, 768 / 32, F.lane, SrcId()); continue; } r -= I_QB;
        if (r < I_KVB) { cvt_item(w_kv_b, 256, 1024, gkv, Wkvb, scr, r, 1024 / 32, F.lane, SrcId()); continue; } r -= I_KVB;
        if (r < I_P) { cvt_item(w_pa, 512, D, nullptr, Wpa, scr, r, D / 32, F.lane, SrcId()); continue; } r -= I_P;
        if (r < I_P) { cvt_item(w_pb, 512, D, nullptr, Wpb, scr, r, D / 32, F.lane, SrcId()); continue; } r -= I_P;
        if (r < I_O) { cvt_item(w_o, D, D, nullptr, Wo, scr, r, D / 32, F.lane, SrcId()); continue; } r -= I_O;
        if (r < NE * I_13) { const int e = r / I_13, q = r % I_13, nb = q % 32;
            const float* src = ((nb & 7) < 4 ? w1 : w3) + (size_t)e * D * FF; const int cb = (nb >> 3) * 128 + (nb & 3) * 32;
            struct SrcOff { int n0, cb; __device__ int operator()(int n) const { return cb + (n - n0); } } so{nb * 32, cb};
            cvt_item(src, D, FF, nullptr, W13 + (size_t)e * 1024 * D, scr, q, 32, F.lane, so); continue; } r -= NE * I_13;
        { const int e = r / I_2, q = r % I_2; cvt_item(w2 + (size_t)e * FF * D, FF, D, nullptr, W2 + (size_t)e * D * FF, scr, q, D / 32, F.lane, SrcId()); }
    }
}

template <int MODE>
__device__ __forceinline__ void row_phase(Frame& F, const float* xin, const float* g2prev, const float* gain, const float* modl, int sh_off, int sc_off, bf16_t* H, bf16_t* XB, float* OUT) {
    constexpr int RB = 4;
    const int gw = F.vcu * NWAVES + F.wave, NGW = F.G * NWAVES;
    const bf16_t* Y2 = (const bf16_t*)(F.ws + WS_Y2);
    for (int m0 = gw; m0 < T; m0 += RB * NGW) {
        f32x4 v[RB][4]; float ss[RB];
        if (MODE == 0) {
#pragma unroll
            for (int r = 0; r < RB; ++r)
#pragma unroll
                for (int j = 0; j < 4; ++j) v[r][j] = *(const f32x4*)(xin + (size_t)(m0 + r * NGW) * D + 4 * F.lane + 256 * j);
        } else {
            unsigned ya[RB][4], yb[RB][4]; f32x4 g[RB][4];
#pragma unroll
            for (int r = 0; r < RB; ++r)
#pragma unroll
                for (int j = 0; j < 4; ++j) { const int m = m0 + r * NGW, c = 4 * F.lane + 256 * j;
                    { const u32x2 xb = *(const u32x2*)(XB + (size_t)m * D + c); v[r][j] = (f32x4){bf2f(xb.x & 0xffffu), bf2f(xb.x >> 16), bf2f(xb.y & 0xffffu), bf2f(xb.y >> 16)}; } ya[r][j] = *(const unsigned*)((const unsigned char*)Y2 + (size_t)(2 * m) * D + c); yb[r][j] = *(const unsigned*)((const unsigned char*)Y2 + (size_t)(2 * m + 1) * D + c);
                    g[r][j] = *(const f32x4*)(g2prev + (size_t)(m >> 12) * 6 * D + 5 * D + c); }
#pragma unroll
            for (int r = 0; r < RB; ++r)
#pragma unroll
                for (int j = 0; j < 4; ++j) { const f32x2 a0 = __builtin_amdgcn_cvt_pk_f32_fp8((int)ya[r][j], false), a1 = __builtin_amdgcn_cvt_pk_f32_fp8((int)ya[r][j], true), b0 = __builtin_amdgcn_cvt_pk_f32_fp8((int)yb[r][j], false), b1 = __builtin_amdgcn_cvt_pk_f32_fp8((int)yb[r][j], true);
                    const f32x4 y = (f32x4){a0[0] + b0[0], a0[1] + b0[1], a1[0] + b1[0], a1[1] + b1[1]} * 0.0625f;
                    v[r][j] += g[r][j] * y; }
        }
#pragma unroll
        for (int r = 0; r < RB; ++r) { ss[r] = (gp::dot4(v[r][0]) + gp::dot4(v[r][1])) + (gp::dot4(v[r][2]) + gp::dot4(v[r][3])); }
#pragma unroll
        for (int o = 1; o < 64; o <<= 1)
#pragma unroll
            for (int r = 0; r < RB; ++r) ss[r] += __shfl_xor(ss[r], o);
#pragma unroll
        for (int r = 0; r < RB; ++r) {
            const int m = m0 + r * NGW, b = m >> 12; const float rstd = rsqrtf(ss[r] * (1.f / D) + EPS);
#pragma unroll
            for (int j = 0; j < 4; ++j) {
                const int c = 4 * F.lane + 256 * j; const f32x4 gn = *(const f32x4*)(gain + c);
                if (MODE == 2) { *(f32x4*)(OUT + (size_t)m * D + c) = v[r][j] * rstd * gn; }
                else {
                    { u32x2 xw; xw.x = cvt_pk_bf16(v[r][j][0], v[r][j][1]); xw.y = cvt_pk_bf16(v[r][j][2], v[r][j][3]); *(u32x2*)(XB + (size_t)m * D + c) = xw; }
                    const f32x4 sc = *(const f32x4*)(modl + (size_t)b * 6 * D + sc_off + c), sh = *(const f32x4*)(modl + (size_t)b * 6 * D + sh_off + c);
                    const f32x4 hv = v[r][j] * rstd * gn * (1.f + sc) + sh;
                    u32x2 w; w.x = cvt_pk_bf16(hv[0], hv[1]); w.y = cvt_pk_bf16(hv[2], hv[3]);
                    *(u32x2*)(H + (size_t)m * D + c) = w;
                }
            }
        }
    }
}

__device__ __forceinline__ void t2_phase(Frame& F, const float* gain, const float* modl, const float* w_router, const float* rbias, int l, bool record) {
    LAS f32x4* wl = (LAS f32x4*)F.lds;
    LAS int* rec = (LAS int*)(F.lds + 65536);
    LAS float* recw = (LAS float*)(F.lds + 65536 + 2048);
    LAS int* lcnt = (LAS int*)(F.lds + 65536 + 4096);
    for (int idx = F.tid; idx < 4096; idx += NTHREADS) {
        const int lane = idx & 63, c = (idx >> 6) & 3, i = (idx >> 8) & 3, j = idx >> 10; const int k = 4 * lane + 256 * j + i;
        wl[idx] = *(const f32x4*)(w_router + (size_t)k * NE + 4 * c);
    }
    if (F.tid < 32) lcnt[F.tid] = 0;
    __syncthreads();
    constexpr int RB = 4;
    const int gw = F.vcu * NWAVES + F.wave, NGW = F.G * NWAVES;
    bf16_t* H = (bf16_t*)(F.ws + WS_H); const bf16_t* XB = (const bf16_t*)(F.ws + WS_XB);
    const int lane = F.lane, myrow = lane >> 4, mye = lane & 15;
    int it = 0;
    for (int m0 = gw; m0 < T; m0 += RB * NGW, ++it) {
        f32x4 v[RB][4]; float ss[RB];
#pragma unroll
        for (int r = 0; r < RB; ++r)
#pragma unroll
            for (int j = 0; j < 4; ++j) { const u32x2 xb = *(const u32x2*)(XB + (size_t)(m0 + r * NGW) * D + 4 * lane + 256 * j); v[r][j] = (f32x4){bf2f(xb.x & 0xffffu), bf2f(xb.x >> 16), bf2f(xb.y & 0xffffu), bf2f(xb.y >> 16)}; }
#pragma unroll
        for (int r = 0; r < RB; ++r) ss[r] = (gp::dot4(v[r][0]) + gp::dot4(v[r][1])) + (gp::dot4(v[r][2]) + gp::dot4(v[r][3]));
#pragma unroll
        for (int o = 1; o < 64; o <<= 1)
#pragma unroll
            for (int r = 0; r < RB; ++r) ss[r] += __shfl_xor(ss[r], o);
        float acc[RB * NE];
#pragma unroll
        for (int q = 0; q < RB * NE; ++q) acc[q] = 0.f;
#pragma unroll
        for (int j = 0; j < 4; ++j) {
            const int c = 4 * lane + 256 * j; const f32x4 gn = *(const f32x4*)(gain + c);
#pragma unroll
            for (int r = 0; r < RB; ++r) {
                const int m = m0 + r * NGW, b = m >> 12; const float rstd = rsqrtf(ss[r] * (1.f / D) + EPS);
                const f32x4 sc = *(const f32x4*)(modl + (size_t)b * 6 * D + 4 * D + c), sh = *(const f32x4*)(modl + (size_t)b * 6 * D + 3 * D + c);
                v[r][j] = v[r][j] * rstd * gn * (1.f + sc) + sh;
                u32x2 w; w.x = cvt_pk_bf16(v[r][j][0], v[r][j][1]); w.y = cvt_pk_bf16(v[r][j][2], v[r][j][3]);
                *(u32x2*)(H + (size_t)m * D + c) = w;
            }
#pragma unroll
            for (int i = 0; i < 4; ++i)
#pragma unroll
                for (int c4 = 0; c4 < 4; ++c4) { const f32x4 wv = wl[((j * 4 + i) * 4 + c4) * 64 + lane];
#pragma unroll
                    for (int r = 0; r < RB; ++r) { const float hv = v[r][j][i];
                        acc[r * NE + 4 * c4 + 0] += hv * wv[0]; acc[r * NE + 4 * c4 + 1] += hv * wv[1]; acc[r * NE + 4 * c4 + 2] += hv * wv[2]; acc[r * NE + 4 * c4 + 3] += hv * wv[3]; } }
        }
#pragma unroll
        for (int sft = 32; sft >= 1; sft >>= 1) {
            const bool up = (lane & sft) != 0;
#pragma unroll
            for (int k = 0; k < sft; ++k) { const float a = acc[k], b = acc[k + sft]; const float keep = up ? b : a, send = up ? a : b; acc[k] = keep + __shfl_xor(send, sft); }
        }
        const float logit = acc[0];
        const float score = 1.f / (1.f + expf(-logit));
        float scv[NE], bi[NE];
#pragma unroll
        for (int e = 0; e < NE; ++e) { scv[e] = __shfl(score, (lane & 48) | e); bi[e] = scv[e] + rbias[e]; }
        int gsel = 0; float gbest = -INFINITY;
#pragma unroll
        for (int g = 0; g < 4; ++g) { float m1 = -INFINITY, m2 = -INFINITY;
#pragma unroll
            for (int j = 0; j < 4; ++j) { const float x = bi[g * 4 + j]; if (x > m1) { m2 = m1; m1 = x; } else if (x > m2) m2 = x; }
            const float gs = m1 + m2; if (gs > gbest) { gbest = gs; gsel = g; } }
        int e1 = -1, e2 = -1; float b1 = -INFINITY, b2 = -INFINITY, s1 = 0.f, s2 = 0.f;
#pragma unroll
        for (int j = 0; j < 4; ++j) { float x = -INFINITY, sx = 0.f;
#pragma unroll
            for (int g = 0; g < 4; ++g) if (g == gsel) { x = bi[g * 4 + j]; sx = scv[g * 4 + j]; }
            const int e = gsel * 4 + j;
            if (x > b1) { b2 = b1; e2 = e1; s2 = s1; b1 = x; e1 = e; s1 = sx; } else if (x > b2) { b2 = x; e2 = e; s2 = sx; } }
        if (mye == 0) {
            const float inv = 1.f / (s1 + s2); const int slot = (it * RB + myrow) * NWAVES + F.wave;
            rec[slot * 4 + 0] = e1; rec[slot * 4 + 1] = e2;
            rec[slot * 4 + 2] = __hip_atomic_fetch_add(&lcnt[e1], 1, __ATOMIC_RELAXED, __HIP_MEMORY_SCOPE_WORKGROUP);
            rec[slot * 4 + 3] = __hip_atomic_fetch_add(&lcnt[e2], 1, __ATOMIC_RELAXED, __HIP_MEMORY_SCOPE_WORKGROUP);
            recw[slot * 2 + 0] = s1 * inv; recw[slot * 2 + 1] = s2 * inv;
        }
    }
    __syncthreads();
    if (!record) return;
    if (F.tid < NE) lcnt[16 + F.tid] = (int)__hip_atomic_fetch_add(F.ctl + CW_CNT + (l * NE + F.tid) * 64, (unsigned)lcnt[F.tid], __ATOMIC_RELAXED, __HIP_MEMORY_SCOPE_AGENT);
    __syncthreads();
    unsigned* list = (unsigned*)(F.ws + WS_LIST); float* gwb = (float*)(F.ws + WS_GW);
    const int nrows = it * RB;
    for (int s = F.tid; s < nrows * NWAVES; s += NTHREADS) {
        const int i2 = s / NWAVES, w = s % NWAVES; const int m = F.vcu * NWAVES + w + i2 * NGW;
        const int e1 = rec[s * 4 + 0], e2 = rec[s * 4 + 1];
        list[(size_t)e1 * T + lcnt[16 + e1] + rec[s * 4 + 2]] = (unsigned)(2 * m); list[(size_t)e2 * T + lcnt[16 + e2] + rec[s * 4 + 3]] = (unsigned)(2 * m + 1);
        gwb[2 * m] = recw[s * 2]; gwb[2 * m + 1] = recw[s * 2 + 1];
    }
}
__device__ __forceinline__ const LAS int* moe_table(Frame& F, int l) {
    LAS int* tab = (LAS int*)(F.lds + MISC_OFF + 1024);
    __syncthreads();
    if (F.tid == 0) { int acc = 0;
        for (int e = 0; e < NE; ++e) { const int c = (int)__hip_atomic_load(F.ctl + CW_CNT + (l * NE + e) * 64, __ATOMIC_RELAXED, __HIP_MEMORY_SCOPE_AGENT); tab[e] = acc; tab[32 + e] = c; acc += (c + 255) >> 8; }
        tab[16] = acc; }
    __syncthreads();
    return tab;
}

typedef __attribute__((address_space(4))) const Args CArgs;
#define LAUNDER_GP(T_, p) do { GAS T_* _t = (GAS T_*)(p); asm volatile("" : "+s"(_t)); (p) = (T_*)_t; } while (0)
#define PH_BEGIN() LAUNDER_V(F.tid); F.lane = F.tid & 63; LAUNDER_GP(unsigned, F.ctl); LAUNDER_GP(float, F.OUT); LAUNDER_GP(unsigned char, F.ws); GAS unsigned char* ws = (GAS unsigned char*)F.ws; CArgs* ka = (CArgs*)__builtin_amdgcn_kernarg_segment_ptr(); LAUNDER_S(ka); \
    float* mod = WSP(float, WS_MOD); (void)mod; (void)ka
#define WSP(T_, off) ((T_*)(GAS T_*)(ws + (off)))
#define KIN(i) ((const float*)(GAS const float*)ka->in[i])
__global__ void __launch_bounds__(NTHREADS, 2) fwd_kernel(Args args) {
    extern __shared__ __attribute__((aligned(16))) unsigned char lds_raw[];
    Frame F;
    F.lds = (LAS unsigned char*)lds_raw; F.MISC = (volatile LAS unsigned*)(F.lds + MISC_OFF);
    F.tid = threadIdx.x; F.lane = F.tid & 63; F.wave = __builtin_amdgcn_readfirstlane(F.tid >> 6);
    F.G = gridDim.x; { const int bx = blockIdx.x; F.vcu = (F.G % 8 == 0) ? (bx % 8) * (F.G / 8) + bx / 8 : bx; }
    F.ws = (unsigned char*)(GAS unsigned char*)args.ws; F.ctl = (unsigned*)(GAS unsigned*)(args.ws + WS_CTL); F.OUT = (float*)(GAS float*)args.out;
    if (F.tid < 64) F.MISC[F.tid] = 0u;
    __syncthreads();
    XcdBarrier bar; bar.bar = F.ctl + CW_BAR; bar.x = 0; bar.st = nullptr;
    if (!N_LAUNCH_MODE) bar = xcd_barrier_post(F.ctl + CW_BAR, F.MISC + 8);
    const int lo = args.ph_lo, hi = args.ph_hi;
#define IN(k) (lo <= (k) && (k) < hi)
#define SEAM(k) do { if ((k) + 1 < hi) { if (!N_LAUNCH_MODE) xcd_barrier(bar); } } while (0)
    const int cidx = (int)blockIdx.x;

    if (IN(0)) { PH_BEGIN(); p0_phase(F, KIN(1), KIN(2), KIN(3)); SEAM(0); }
    for (int l = 0; l < NL; ++l) {
        const int pb = 1 + 9 * l;
        if (IN(pb + 0)) {
            PH_BEGIN();
            for (int rep = 0; rep < ((PROBE_DUP & 8) ? 2 : 1); ++rep) { LAUNDER_V(F.tid); F.lane = F.tid & 63; convert_weights(F, ka, l); }
            if (l == 0) row_phase<0>(F, KIN(0), nullptr, KIN(4) + l * D, mod + (size_t)l * NB * 6 * D, 0, D, WSP(bf16_t, WS_H), WSP(bf16_t, WS_XB), nullptr);
            else row_phase<1>(F, nullptr, mod + (size_t)(l - 1) * NB * 6 * D, KIN(4) + l * D, mod + (size_t)l * NB * 6 * D, 0, D, WSP(bf16_t, WS_H), WSP(bf16_t, WS_XB), nullptr);
            SEAM(pb + 0);
        }
        if (IN(pb + 1)) {
            PH_BEGIN();
            gp::Gemm g{WSP(bf16_t, WS_H), WSP(const bf16_t, WS_WIN), D, 0, nullptr}; gp::DenseOrder So; So.init(T, NIN, F.G, cidx);
            gp::EpiIn E{WSP(bf16_t, WS_QA), WSP(bf16_t, WS_KA), WSP(bf16_t, WS_VA), WSP(bf16_t, WS_QLAT), WSP(bf16_t, WS_KVLAT), WSP(bf16_t, WS_KB), WSP(bf16_t, WS_SA), WSP(bf16_t, WS_SB), WSP(float, WS_SSQ), WSP(float, WS_SSKV),
                        KIN(6) + l * 64, KIN(7) + l * 64, WSP(const float, WS_COSA), WSP(const float, WS_SINA), WSP(const float, WS_COSB), WSP(const float, WS_SINB)};
            if (PROBE_DUP & 128) { gp::EpiNull En; gp::gemm_phase<gp::EpiNull, gp::DenseOrder>(F.tid, F.lds, g, So, En); LAUNDER_V(F.tid); }
            gp::gemm_phase<gp::EpiIn, gp::DenseOrder>(F.tid, F.lds, g, So, E); if (PROBE_DUP & (2 | 512)) { LAUNDER_V(F.tid); gp::gemm_phase<gp::EpiIn, gp::DenseOrder>(F.tid, F.lds, g, So, E); }
            SEAM(pb + 1);
        }
        if (IN(pb + 2)) {
            { PH_BEGIN(); gp::Gemm g{WSP(bf16_t, WS_QLAT), WSP(const bf16_t, WS_WQB), 384, 0, nullptr}; gp::DenseOrder So; So.init(T, 768, F.G, cidx);
              gp::EpiQb E{WSP(bf16_t, WS_QB), WSP(const float, WS_SSQ), WSP(const float, WS_COSB), WSP(const float, WS_SINB)}; gp::gemm_phase<gp::EpiQb, gp::DenseOrder>(F.tid, F.lds, g, So, E); if (PROBE_DUP & 2) { LAUNDER_V(F.tid); gp::gemm_phase<gp::EpiQb, gp::DenseOrder>(F.tid, F.lds, g, So, E); } }
            { PH_BEGIN(); gp::Gemm g{WSP(bf16_t, WS_KVLAT), WSP(const bf16_t, WS_WKVB), 256, 0, nullptr}; gp::DenseOrder So; So.init(T, 1024, F.G, F.G - 1 - cidx);
              gp::EpiKvb E{WSP(bf16_t, WS_KB), WSP(bf16_t, WS_VB), WSP(const float, WS_SSKV)}; gp::gemm_phase<gp::EpiKvb, gp::DenseOrder>(F.tid, F.lds, g, So, E); if (PROBE_DUP & 2) { LAUNDER_V(F.tid); gp::gemm_phase<gp::EpiKvb, gp::DenseOrder>(F.tid, F.lds, g, So, E); } }
            if (PROBE_DUP & 1) { PH_BEGIN(); const at::Tensors A{WSP(bf16_t, WS_QA), 512, WSP(bf16_t, WS_KA), 128, WSP(bf16_t, WS_VA), 128, WSP(bf16_t, WS_OB), 512, 4}; at::attn_phase<64>(F.tid, F.lds, A, F.vcu, F.G); }
            { PH_BEGIN(); const at::Tensors A{WSP(bf16_t, WS_QA), 512, WSP(bf16_t, WS_KA), 128, WSP(bf16_t, WS_VA), 128, WSP(bf16_t, WS_QA), 512, 4}; at::attn_phase<64>(F.tid, F.lds, A, F.vcu, F.G); }
            SEAM(pb + 2);
        }
        if (IN(pb + 3)) {
            PH_BEGIN();
            const at::Tensors A{WSP(bf16_t, WS_QB), 768, WSP(bf16_t, WS_KB), 768, WSP(bf16_t, WS_VB), 512, WSP(bf16_t, WS_OB), 512, 1}; for (int rep = 0; rep < ((PROBE_DUP & 1) ? 2 : 1); ++rep) at::attn_phase<96>(F.tid, F.lds, A, F.vcu, F.G);
            SEAM(pb + 3);
        }
        if (IN(pb + 4)) for (int rep3 = 0; rep3 < ((PROBE_DUP & (2 | 1024)) ? 2 : 1); ++rep3) {
            { PH_BEGIN(); gp::Gemm g{WSP(bf16_t, WS_QA), WSP(const bf16_t, WS_WPA), 512, 0, nullptr}; gp::DenseOrder So; So.init(T, D, F.G, cidx);
              gp::EpiProj<0> E{WSP(bf16_t, WS_H), WSP(const bf16_t, WS_SA)}; gp::gemm_phase<gp::EpiProj<0>, gp::DenseOrder>(F.tid, F.lds, g, So, E); }
            { PH_BEGIN(); gp::Gemm g{WSP(bf16_t, WS_OB), WSP(const bf16_t, WS_WPB), 512, 0, nullptr}; gp::DenseOrder So; So.init(T, D, F.G, cidx);
              gp::EpiProj<1> E{WSP(bf16_t, WS_H), WSP(const bf16_t, WS_SB)}; gp::gemm_phase<gp::EpiProj<1>, gp::DenseOrder>(F.tid, F.lds, g, So, E); }
            if (rep3 + 1 == ((PROBE_DUP & (2 | 1024)) ? 2 : 1)) SEAM(pb + 4);
        }
        if (IN(pb + 5)) {
            PH_BEGIN();
            gp::Gemm g{WSP(bf16_t, WS_H), WSP(const bf16_t, WS_WO), D, 0, nullptr}; gp::DenseOrder So; So.init(T, D, F.G, cidx);
            gp::EpiWo E{WSP(const bf16_t, WS_XB), mod + (size_t)l * NB * 6 * D, WSP(bf16_t, WS_XB)}; gp::gemm_phase<gp::EpiWo, gp::DenseOrder>(F.tid, F.lds, g, So, E);
            SEAM(pb + 5);
        }
        if (IN(pb + 6)) {
            PH_BEGIN();
            if (PROBE_DUP & 16) { t2_phase(F, KIN(15) + l * D, mod + (size_t)l * NB * 6 * D, KIN(16), KIN(17), l, false); LAUNDER_V(F.tid); F.lane = F.tid & 63; __syncthreads(); }
            t2_phase(F, KIN(15) + l * D, mod + (size_t)l * NB * 6 * D, KIN(16), KIN(17), l, true);
            SEAM(pb + 6);
        }
        if (IN(pb + 7)) {
            PH_BEGIN();
            const LAS int* tab = moe_table(F, l);
            gp::Gemm g{WSP(bf16_t, WS_H), WSP(const bf16_t, WS_W13), D, (size_t)1024 * D, WSP(const unsigned, WS_LIST)}; gp::MoeOrder So; So.init(tab, F.G, cidx);
            if (PROBE_DUP & 256) { gp::EpiNull En; gp::gemm_phase<gp::EpiNull, gp::MoeOrder, true>(F.tid, F.lds, g, So, En); LAUNDER_V(F.tid); }
            gp::EpiUp E{WSP(bf16_t, WS_ACT)}; gp::gemm_phase<gp::EpiUp, gp::MoeOrder, true>(F.tid, F.lds, g, So, E); if (PROBE_DUP & 4) { LAUNDER_V(F.tid); gp::gemm_phase<gp::EpiUp, gp::MoeOrder, true>(F.tid, F.lds, g, So, E); }
            SEAM(pb + 7);
        }
        if (IN(pb + 8)) {
            PH_BEGIN();
            const LAS int* tab = moe_table(F, l);
            gp::Gemm g{WSP(bf16_t, WS_ACT), WSP(const bf16_t, WS_W2), FF, (size_t)D * FF, nullptr}; gp::MoeOrder So; So.init(tab, F.G, cidx);
            gp::EpiDown E{WSP(bf16_t, WS_Y2), WSP(const unsigned, WS_LIST), WSP(const float, WS_GW)}; gp::gemm_phase<gp::EpiDown, gp::MoeOrder, false>(F.tid, F.lds, g, So, E); if (PROBE_DUP & 4) { LAUNDER_V(F.tid); gp::gemm_phase<gp::EpiDown, gp::MoeOrder, false>(F.tid, F.lds, g, So, E); }
            SEAM(pb + 8);
        }
    }
    if (IN(NPHASE - 1)) { PH_BEGIN(); row_phase<2>(F, nullptr, mod + (size_t)(NL - 1) * NB * 6 * D, KIN(21), nullptr, 0, 0, nullptr, WSP(bf16_t, WS_XB), F.OUT); }
#undef IN
#undef SEAM
}

extern "C" void kernel_launch(void* const* d_in, const int* in_sizes, int n_in, void* d_out, int out_size, void* d_ws, size_t ws_size, hipStream_t stream) {
    static int grid = 0;
    if (grid == 0) {
        if (n_in != 22 || out_size != T * D || ws_size < WS_END) { fprintf(stderr, "kernel_launch: unexpected problem (n_in %d out %d ws %zu)\n", n_in, out_size, ws_size); grid = -1; return; }
        int dev = 0, cus = 0, per_cu = 0;
        if (hipGetDevice(&dev) != hipSuccess || hipDeviceGetAttribute(&cus, hipDeviceAttributeMultiprocessorCount, dev) != hipSuccess) { grid = -1; return; }
        if (hipFuncSetAttribute((const void*)fwd_kernel, hipFuncAttributeMaxDynamicSharedMemorySize, LDS_BYTES) != hipSuccess) { grid = -1; return; }
        if (hipOccupancyMaxActiveBlocksPerMultiprocessor(&per_cu, (const void*)fwd_kernel, NTHREADS, LDS_BYTES) != hipSuccess || per_cu < 1) { fprintf(stderr, "kernel_launch: occupancy query says %d\n", per_cu); }
        (void)hipGetLastError();
        grid = cus;
        if (T % (grid * NWAVES * 4) != 0) { fprintf(stderr, "kernel_launch: grid %d does not divide the row phases\n", grid); grid = -1; return; }
    }
    if (grid < 0) return;
    (void)hipMemsetAsync((char*)d_ws + WS_CTL, 0, CTL_BYTES, stream);
    Args a{};
    for (int i = 0; i < 22; ++i) a.in[i] = (const float*)d_in[i];
    a.out = (float*)d_out; a.ws = (unsigned char*)d_ws;
#if N_LAUNCH_MODE
    for (int p = 0; p < NPHASE; ++p) { a.ph_lo = p; a.ph_hi = p + 1; hipLaunchKernelGGL(fwd_kernel, dim3(grid), dim3(NTHREADS), LDS_BYTES, stream, a); }
#else
    a.ph_lo = 0; a.ph_hi = NPHASE;
    hipLaunchKernelGGL(fwd_kernel, dim3(grid), dim3(NTHREADS), LDS_BYTES, stream, a);
#endif
}
```

```cpp
#include <hip/hip_runtime.h>
#include <stdint.h>
#include <stdio.h>
#include <math.h>

#ifndef FAST_GEMM
#define FAST_GEMM 1
#endif
#ifndef FAST_ATTN
#define FAST_ATTN 1
#endif
#ifndef PROBE_DUP
#define PROBE_DUP 0
#endif
#ifndef PROBE_ATT
#define PROBE_ATT 0
#endif
#ifndef ATT_REGSTAGE
#define ATT_REGSTAGE 0
#endif
#ifndef WT_STORES
#define WT_STORES 0
#endif
#ifndef N_LAUNCH_MODE
#define N_LAUNCH_MODE 0
#endif

#define LAS __attribute__((address_space(3)))
#define GAS __attribute__((address_space(1)))
typedef unsigned short bf16_t;
typedef short bf16x8 __attribute__((ext_vector_type(8)));
typedef float f32x4 __attribute__((ext_vector_type(4)));
typedef float f32x2 __attribute__((ext_vector_type(2)));
typedef float f32x16 __attribute__((ext_vector_type(16)));
typedef unsigned u32x4 __attribute__((ext_vector_type(4)));
typedef unsigned u32x2 __attribute__((ext_vector_type(2)));
typedef GAS unsigned gu32;

constexpr int D = 1024, NB = 8, S = 4096, T = NB * S, NL = 4, INC = 3488, NIN = 3584, NE = 16, FF = 512;
constexpr float EPS = 1e-6f, LOG2E = 1.4426950408889634f;
constexpr float QSCALE_A = 0.125f * LOG2E, QSCALE_B = 0.10206207261596577f * LOG2E;
constexpr int NWAVES = 8, NTHREADS = 512;
constexpr int NPHASE = 2 + 9 * NL;

constexpr size_t MiB = 1u << 20;
constexpr size_t WS_CTL = 0, CTL_BYTES = 1 * MiB;
constexpr size_t WS_MOD = 1 * MiB;
constexpr size_t WS_COSA = 2 * MiB, WS_SINA = WS_COSA + 512 * 1024, WS_COSB = 3 * MiB, WS_SINB = WS_COSB + 256 * 1024;
constexpr size_t WS_SSQ = 4 * MiB, WS_SSKV = 5 * MiB;
constexpr size_t WS_GW = 6 * MiB;
constexpr size_t WS_LIST = 7 * MiB;
constexpr size_t WS_WIN = 10 * MiB, WS_WQB = 17 * MiB, WS_WKVB = 18 * MiB, WS_WPA = 19 * MiB, WS_WPB = 20 * MiB, WS_WO = 21 * MiB, WS_W13 = 23 * MiB, WS_W2 = 55 * MiB;
constexpr size_t WS_H = 72 * MiB;
constexpr size_t WS_QA = 136 * MiB, WS_KA = 168 * MiB, WS_VA = 176 * MiB, WS_QLAT = 184 * MiB, WS_KVLAT = 208 * MiB;
constexpr size_t WS_KB = 224 * MiB, WS_VB = 272 * MiB, WS_QB = 304 * MiB, WS_OB = 352 * MiB, WS_SA = 384 * MiB, WS_SB = 448 * MiB, WS_XB = 512 * MiB, WS_END = 576 * MiB;
constexpr size_t WS_ACT = 136 * MiB, WS_Y2 = 208 * MiB;
constexpr int ACT_ROWS = 2 * T + NE * 256;
static_assert(WS_ACT + (size_t)ACT_ROWS * FF * 2 <= WS_Y2 && WS_Y2 + (size_t)2 * T * D * 2 <= WS_XB, "moe overlay");
constexpr int CW_BAR = 4096;
constexpr int CW_CNT = 16384;

constexpr int RING_BYTES = 131072, MISC_OFF = RING_BYTES, LDS_BYTES = 147456;

__device__ __forceinline__ float bf2f(unsigned v) { return __uint_as_float(v << 16); }
typedef __bf16 bf16x2_t __attribute__((ext_vector_type(2)));
__device__ __forceinline__ unsigned cvt_pk_bf16(float lo, float hi) { f32x2 v = {lo, hi}; bf16x2_t b = __builtin_convertvector(v, bf16x2_t); return __builtin_bit_cast(unsigned, b); }
__device__ __forceinline__ u32x4 pack8(f32x4 a, f32x4 b) { u32x4 w; w.x = cvt_pk_bf16(a[0], a[1]); w.y = cvt_pk_bf16(a[2], a[3]); w.z = cvt_pk_bf16(b[0], b[1]); w.w = cvt_pk_bf16(b[2], b[3]); return w; }
__device__ __forceinline__ void unpack8(u32x4 w, f32x4& a, f32x4& b) { a[0] = bf2f(w.x & 0xffffu); a[1] = bf2f(w.x >> 16); a[2] = bf2f(w.y & 0xffffu); a[3] = bf2f(w.y >> 16); b[0] = bf2f(w.z & 0xffffu); b[1] = bf2f(w.z >> 16); b[2] = bf2f(w.w & 0xffffu); b[3] = bf2f(w.w >> 16); }
__device__ __forceinline__ float wave_sum(float v) {
#pragma unroll
    for (int o = 1; o < 64; o <<= 1) v += __shfl_xor(v, o);
    return v;
}
__device__ __forceinline__ float sigm(float v) { return __builtin_amdgcn_rcpf(1.f + __builtin_amdgcn_exp2f(v * (-LOG2E))); }
#if WT_STORES
__device__ __forceinline__ void st16(void* p, u32x4 v) { asm volatile("global_store_dwordx4 %0, %1, off sc1\n\ts_nop 1" :: "v"(p), "v"(v) : "memory"); }
__device__ __forceinline__ void st8(void* p, u32x2 v) { asm volatile("global_store_dwordx2 %0, %1, off sc1\n\ts_nop 1" :: "v"(p), "v"(v) : "memory"); }
#else
__device__ __forceinline__ void st16(void* p, u32x4 v) { *(u32x4*)p = v; }
__device__ __forceinline__ void st8(void* p, u32x2 v) { *(u32x2*)p = v; }
#endif
#define VM_WAIT() asm volatile("s_waitcnt vmcnt(0)" ::: "memory")
#define LAUNDER_S(p) asm volatile("" : "+s"(p))
#define LAUNDER_V(v) asm volatile("" : "+v"(v))
#define LDS_WAIT() asm volatile("s_waitcnt lgkmcnt(0)" ::: "memory")

#define XB_TMO      128
#define XB_XCNT(j)  (256  + 64 * (j))
#define XB_XSUB(j)  (1280 + 64 * (j))
#define XB_XGEN(j)  (2304 + 64 * (j))
#define XB_TOP      3328
#define XB_TOPGEN   3392
#define XCD_BAR_WORDS 3456
#define XB_SPIN_CAP (1u << 22)
__device__ __forceinline__ unsigned xb_ld(unsigned* p)              { return __hip_atomic_load(p, __ATOMIC_RELAXED, __HIP_MEMORY_SCOPE_AGENT); }
__device__ __forceinline__ unsigned xb_add(unsigned* p, unsigned v) { return __hip_atomic_fetch_add(p, v, __ATOMIC_RELAXED, __HIP_MEMORY_SCOPE_AGENT); }
__device__ __forceinline__ unsigned xb_xcc_id() { return (unsigned)__builtin_amdgcn_s_getreg((3 << 11) | 20) & 0xFu; }
#define XB_SPIN(cond, bar) do { unsigned _sp = 0; while (cond) { __builtin_amdgcn_s_sleep(1); \
    if ((++_sp & 255u) == 0u) { if (xb_ld(&(bar)[XB_TMO])) break; if (_sp > XB_SPIN_CAP) { atomicAdd(&(bar)[XB_TMO], 1u); break; } } } } while (0)
struct XcdBarrier { unsigned* bar; unsigned x; volatile LAS unsigned* st; };
__device__ __forceinline__ XcdBarrier xcd_barrier_post(unsigned* bar, volatile LAS unsigned* st) {
    XcdBarrier b; b.bar = bar; b.x = xb_xcc_id(); b.st = st;
    if (threadIdx.x == 0) (void)xb_add(&bar[XB_XCNT(b.x)], 1u);
    return b;
}
__device__ __forceinline__ void xcd_barrier_complete(unsigned* bar, unsigned x, unsigned& nloc, unsigned& nx) {
    const unsigned G = gridDim.x * gridDim.y * gridDim.z;
    unsigned sum, cnt, mine, sp = 0u;
    for (;;) {
        sum = 0u; cnt = 0u; mine = 0u;
#pragma unroll
        for (unsigned j = 0; j < 16; ++j) { const unsigned c = xb_ld(&bar[XB_XCNT(j)]); sum += c; cnt += (c > 0u) ? 1u : 0u; mine = (j == x) ? c : mine; }
        if (sum == G) break;
        __builtin_amdgcn_s_sleep(1);
        if ((++sp & 255u) == 0u) { if (xb_ld(&bar[XB_TMO])) break; if (sp > XB_SPIN_CAP) { atomicAdd(&bar[XB_TMO], 1u); break; } }
    }
    nloc = mine > 0u ? mine : 1u; nx = cnt > 0u ? cnt : 1u;
}
__device__ __forceinline__ void xcd_barrier(const XcdBarrier& b) {
    asm volatile("s_waitcnt vmcnt(0)" ::: "memory");
    __syncthreads();
    if (threadIdx.x == 0) {
        unsigned* bar = b.bar;
        __builtin_amdgcn_s_waitcnt(0);
        unsigned nloc = b.st[0], nx = b.st[1];
        if (nloc == 0u) { xcd_barrier_complete(bar, b.x, nloc, nx); b.st[0] = nloc; b.st[1] = nx; }
        const unsigned old = xb_add(&bar[XB_XSUB(b.x)], 1u);
        const unsigned gen = old / nloc;
        if (old + 1u == (gen + 1u) * nloc) {
            __builtin_amdgcn_fence(__ATOMIC_RELEASE, "agent");
            asm volatile("s_waitcnt vmcnt(0)" ::: "memory");
            const unsigned og = xb_add(&bar[XB_TOP], 1u);
            const unsigned tg = og / nx;
            if (og + 1u == (tg + 1u) * nx) xb_add(&bar[XB_TOPGEN], 1u);
            else XB_SPIN(xb_ld(&bar[XB_TOPGEN]) == tg, bar);
            __builtin_amdgcn_fence(__ATOMIC_ACQUIRE, "agent");
            xb_add(&bar[XB_XGEN(b.x)], 1u);
            asm volatile("s_waitcnt vmcnt(0)" ::: "memory");
        } else {
            XB_SPIN(xb_ld(&bar[XB_XGEN(b.x)]) == gen, bar);
            __builtin_amdgcn_fence(__ATOMIC_ACQUIRE, "agent");
            asm volatile("s_waitcnt vmcnt(0)" ::: "memory");
        }
    }
    __syncthreads();
}

namespace gp {
constexpr int BM = 256, BK = 64, HALF = 128, HTB = HALF * BK * 2, NXCD = 8, WGM = 8;
__host__ __device__ __forceinline__ int lds_byte(int r, int c) { const int st = (r >> 4) * 2 + (c >> 5), rr = r & 15, cc = c & 31, ob = rr * 64 + cc * 2; return st * 1024 + (ob ^ (((ob >> 9) & 1) << 5)); }
__host__ __device__ __forceinline__ void stage_rc(int b, int& R, int& C) { const int st = b / 1024, sb = b % 1024, swz = sb ^ (((sb >> 9) & 1) << 5); R = (st >> 1) * 16 + swz / 64; C = (st & 1) * 32 + (swz % 64) / 2; }
__host__ __device__ __forceinline__ int perm32(int rho) { const int n = rho >> 4, i = rho & 15; return 8 * (i >> 2) + 4 * n + (i & 3); }

struct Unit { int pm, pn, be, rl, nv; };
struct Gemm { const bf16_t* A; const bf16_t* Bt; int K; size_t bstride; const unsigned* list; size_t astride; };

__device__ __forceinline__ int xcd_remap(int wgid, int nwg) { const int q = nwg / NXCD, r = nwg % NXCD, xcd = wgid % NXCD, off = wgid / NXCD; return (xcd < r ? xcd * (q + 1) : r * (q + 1) + (xcd - r) * q) + off; }
struct DenseOrder {
    int nM, nN, nwg, G, c;
    __device__ void init(int M, int N, int G_, int c_) { nM = M / BM; nN = N / BM; nwg = nM * nN; G = G_; c = c_; }
    __device__ bool next(int i, Unit& u) const {
        const long L = (long)i * G + c; if (L >= nwg) return false;
        const int wgid = xcd_remap((int)L, nwg);
        const int nig = WGM * nN, gid = wgid / nig, fm = gid * WGM, gsz = (nM - fm) < WGM ? (nM - fm) : WGM;
        u.pm = fm + ((wgid % nig) % gsz); u.pn = (wgid % nig) / gsz; u.be = 0; u.rl = 0; u.nv = 256; return true;
    }
};
struct PairOrder {
    DenseOrder d;
    __device__ void init(int M, int N, int G_, int c_) { d.init(M, N, G_, c_); }
    __device__ bool next(int i, Unit& u) const { if (!d.next(i >> 1, u)) return false; u.be = i & 1; return true; }
};
struct MoeOrder {
    const LAS int* tab; int nwg, G, c;
    __device__ static int rd(const LAS int* p) { return __builtin_amdgcn_readfirstlane(*p); }
    __device__ void init(const LAS int* tab_, int G_, int c_) { tab = tab_; nwg = rd(tab_ + 16) * 4; G = G_; c = c_; }
    __device__ bool next(int i, Unit& u) const {
        const long L = (long)i * G + c; if (L >= nwg) return false;
        const int wgid = xcd_remap((int)L, nwg);
        const int tile = wgid >> 2; int e = 0;
        for (int k = 1; k < NE; ++k) e += (rd(tab + k) <= tile) ? 1 : 0;
        u.pm = tile; u.pn = wgid & 3; u.be = e; u.rl = tile - rd(tab + e); const int rem = rd(tab + 32 + e) - u.rl * 256; u.nv = rem < 256 ? rem : 256; return true;
    }
};

#define ACC_T f32x4 (&acc)[2][2][4][2]

template <class Epi, class Sched, bool GATHER>
__device__ __forceinline__ void gemm_phase_ref(int tid, const Gemm g, const Sched& S, const Epi& E) {
    const int wid = __builtin_amdgcn_readfirstlane(tid >> 6), lane = tid & 63, wr = wid >> 2, wc = wid & 3, fr = lane & 15, fq = lane >> 4;
    const int K = g.K; Unit u;
    for (int ui = 0; S.next(ui, u); ++ui) {
        f32x4 acc[2][2][4][2];
#pragma unroll
        for (int a = 0; a < 2; ++a)
#pragma unroll
            for (int b = 0; b < 2; ++b)
#pragma unroll
                for (int m = 0; m < 4; ++m)
#pragma unroll
                    for (int n = 0; n < 2; ++n) acc[a][b][m][n] = (f32x4){0.f, 0.f, 0.f, 0.f};
        const bf16_t* Bt = g.Bt + (size_t)u.be * g.bstride + (size_t)u.pn * 256 * K;
        for (int ai = 0; ai < 2; ++ai)
            for (int m = 0; m < 4; ++m) {
                const int rloc = ai * 128 + wr * 64 + m * 16 + fr;
                size_t arow;
                if (GATHER) { arow = (rloc < u.nv) ? (size_t)(g.list[(size_t)u.be * T + u.rl * 256 + rloc] >> 1) : 0; }
                else arow = (size_t)u.pm * 256 + rloc;
                const bf16_t* ap = g.A + arow * K;
                for (int bj = 0; bj < 2; ++bj) {
                    const bf16_t* bp = Bt + (size_t)(bj * 128 + wc * 32 + fq * 8) * K;
                    float s[8];
#pragma unroll
                    for (int c = 0; c < 8; ++c) {
                        float sc = 0.f; const bf16_t* bpc = bp + (size_t)c * K;
#pragma unroll 2
                        for (int k = 0; k < K; k += 8) {
                            f32x4 a0, a1, b0, b1; unpack8(*(const u32x4*)(ap + k), a0, a1); unpack8(*(const u32x4*)(bpc + k), b0, b1);
                            sc += a0[0] * b0[0] + a0[1] * b0[1] + a0[2] * b0[2] + a0[3] * b0[3] + a1[0] * b1[0] + a1[1] * b1[1] + a1[2] * b1[2] + a1[3] * b1[3];
                        }
                        s[c] = sc; asm volatile("" : "+v"(s[c]));
                    }
#pragma unroll
                    for (int a2 = 0; a2 < 2; ++a2)
#pragma unroll
                        for (int b2 = 0; b2 < 2; ++b2)
#pragma unroll
                            for (int m2 = 0; m2 < 4; ++m2)
                                if (a2 == ai && b2 == bj && m2 == m) { acc[a2][b2][m2][0] = (f32x4){s[0], s[1], s[2], s[3]}; acc[a2][b2][m2][1] = (f32x4){s[4], s[5], s[6], s[7]}; }
                }
            }
        E(acc, u, wr, wc, fr, fq);
    }
}

template <class E> struct EpiTraits { static constexpr bool KEEP = false; };
#if FAST_GEMM
template <class Epi, class Sched, bool GATHER>
__device__ __forceinline__ void gemm_phase_fast(int tid, LAS unsigned char* lds, const Gemm g, const Sched& S, const Epi& E) {
    const int wid = __builtin_amdgcn_readfirstlane(tid >> 6), lane = tid & 63, wr = wid >> 2, wc = wid & 3, fr = lane & 15, fq = lane >> 4;
    const int K = g.K, nt = K / BK;
    int Rr[2], Cc[2]; unsigned voffB[2];
#pragma unroll
    for (int i = 0; i < 2; ++i) { stage_rc(tid * 16 + i * 8192, Rr[i], Cc[i]); const int Rb = (Rr[i] & ~31) + perm32(Rr[i] & 31); voffB[i] = (unsigned)(Rb * K + Cc[i]) * 2u; }
    const size_t kstep = (size_t)(BK * 2), hstep = (size_t)HALF * K * 2, tstep = 2 * hstep;
    const unsigned ldsw = (unsigned)wid * 1024u;
    const int aoff = lds_byte(wr * 64 + fr, fq * 8), boff = lds_byte(wc * 32 + fr, fq * 8);
#define GP_SA(b, h) (((b) * 2 + (h)) * HTB)
#define GP_SB(b, h) ((4 + (b) * 2 + (h)) * HTB)
#define GP_STAGE2(bufoff, gbase, v0, v1) do { \
        __builtin_amdgcn_global_load_lds((const unsigned*)((const char*)(gbase) + (v0)), (LAS unsigned*)(lds + (bufoff) + ldsw), 16, 0, 0); \
        __builtin_amdgcn_global_load_lds((const unsigned*)((const char*)(gbase) + (v1)), (LAS unsigned*)(lds + (bufoff) + ldsw + 8192), 16, 0, 0); } while (0)
#define GP_STAGEB(bufoff, gbase) GP_STAGE2(bufoff, gbase, voffB[0], voffB[1])
#define GP_LDA(dst, b, h) do { _Pragma("unroll") for (int m = 0; m < 4; ++m) _Pragma("unroll") for (int k = 0; k < 2; ++k) dst[m][k] = *(const LAS bf16x8*)(lds + GP_SA(b, h) + aoff + m * 2048 + k * 1024); } while (0)
#define GP_LDB(dst, b, h) do { _Pragma("unroll") for (int n = 0; n < 2; ++n) _Pragma("unroll") for (int k = 0; k < 2; ++k) dst[n][k] = *(const LAS bf16x8*)(lds + GP_SB(b, h) + boff + n * 2048 + k * 1024); } while (0)
#define GP_MMA(ai, bj, At, Bt) do { __builtin_amdgcn_s_setprio(1); _Pragma("unroll") for (int m = 0; m < 4; ++m) _Pragma("unroll") for (int n = 0; n < 2; ++n) _Pragma("unroll") for (int k = 0; k < 2; ++k) \
        acc[ai][bj][m][n] = __builtin_amdgcn_mfma_f32_16x16x32_bf16(Bt[n][k], At[m][k], acc[ai][bj][m][n], 0, 0, 0); __builtin_amdgcn_s_setprio(0); } while (0)
#define GP_WAIT_V(n) asm volatile("s_waitcnt vmcnt(" #n ")" ::: "memory")
#define GP_WAIT_L(n) asm volatile("s_waitcnt lgkmcnt(" #n ")" ::: "memory")
#define GP_BAR __builtin_amdgcn_s_barrier()
#define GP_SCHED __builtin_amdgcn_sched_barrier(0)
    Unit cur, nxt; int ui = 0;
    if (!S.next(0, cur)) return;
    f32x4 acc[2][2][4][2];
#pragma unroll
    for (int a = 0; a < 2; ++a)
#pragma unroll
        for (int b = 0; b < 2; ++b)
#pragma unroll
            for (int m = 0; m < 4; ++m)
#pragma unroll
                for (int n = 0; n < 2; ++n) acc[a][b][m][n] = (f32x4){0.f, 0.f, 0.f, 0.f};
    bf16x8 At[4][2], B0[2][2], B1[2][2];
    unsigned vC0, vC1, vC2, vC3, vN0, vN1, vN2, vN3;
#define GP_VOFF(u, o0, o1, o2, o3) do { if (GATHER) { \
        int tl_ = tid; LAUNDER_V(tl_); int R0_, C0_, R1_, C1_; stage_rc(tl_ * 16, R0_, C0_); stage_rc(tl_ * 16 + 8192, R1_, C1_);     \
        const unsigned* lp = g.list + (size_t)(u).be * T + (u).rl * 256; \
        const int nvm = (u).nv - 1; const int p0 = min(R0_, nvm), p1 = min(R1_, nvm), p2 = min(128 + R0_, nvm), p3 = min(128 + R1_, nvm); \
        const unsigned t0 = lp[p0] >> 1, t1 = lp[p1] >> 1, t2 = lp[p2] >> 1, t3 = lp[p3] >> 1; \
        o0 = (t0 * K + C0_) * 2u; o1 = (t1 * K + C1_) * 2u; o2 = (t2 * K + C0_) * 2u; o3 = (t3 * K + C1_) * 2u; \
      } else { o0 = (unsigned)(Rr[0] * K + Cc[0]) * 2u; o1 = (unsigned)(Rr[1] * K + Cc[1]) * 2u; o2 = o0 + (unsigned)hstep; o3 = o1 + (unsigned)hstep; } } while (0)
    GP_VOFF(cur, vC0, vC1, vC2, vC3);
    const char* cA = (const char*)g.A + ((size_t)cur.be * g.astride) * 2 + (GATHER ? (size_t)0 : (size_t)cur.pm * tstep);
    const char* cB = (const char*)g.Bt + ((size_t)cur.be * g.bstride) * 2 + (size_t)cur.pn * tstep;
    GP_STAGEB(GP_SB(0, 0), cB); GP_STAGEB(GP_SB(0, 1), cB + hstep); GP_STAGE2(GP_SA(0, 0), cA, vC0, vC1); GP_STAGE2(GP_SA(0, 1), cA, vC2, vC3);
    if (wr == 1) GP_BAR;
    GP_WAIT_V(2); GP_BAR;
    GP_STAGEB(GP_SB(1, 0), cB + kstep); GP_STAGE2(GP_SA(1, 0), cA + kstep, vC0, vC1); GP_STAGEB(GP_SB(1, 1), cB + hstep + kstep);
    GP_WAIT_V(6); GP_BAR;
    for (;;) {
        const bool has_next = S.next(ui + 1, nxt);
        const char* nA = has_next ? (const char*)g.A + ((size_t)nxt.be * g.astride) * 2 + (GATHER ? (size_t)0 : (size_t)nxt.pm * tstep) : cA;
        const char* nB = has_next ? (const char*)g.Bt + ((size_t)nxt.be * g.bstride) * 2 + (size_t)nxt.pn * tstep : cB;
        if (has_next) { GP_VOFF(nxt, vN0, vN1, vN2, vN3); } else { vN0 = vC0; vN1 = vC1; vN2 = vC2; vN3 = vC3; }
#pragma nounroll
        for (int t = 0; t < nt; t += 2) {
            const bool last = (t == nt - 2);
            const char* a1 = cA + (size_t)(t + 1) * kstep;
            const char* a2 = last ? nA : cA + (size_t)(t + 2) * kstep; const char* b2 = last ? nB : cB + (size_t)(t + 2) * kstep;
            const char* a3 = a2 + kstep; const char* b3 = b2 + kstep;
            const unsigned w0 = last ? vN0 : vC0, w1 = last ? vN1 : vC1, w2 = last ? vN2 : vC2, w3 = last ? vN3 : vC3;
            GP_LDB(B0, 0, 0); GP_LDB(B1, 0, 1); GP_SCHED; GP_LDA(At, 0, 0); GP_STAGE2(GP_SA(1, 1), a1, vC2, vC3);
            GP_WAIT_V(8); GP_WAIT_L(0); GP_BAR; GP_MMA(0, 0, At, B0); GP_MMA(0, 1, At, B1); GP_BAR; GP_SCHED;
            GP_LDA(At, 0, 1); GP_STAGEB(GP_SB(0, 0), b2); GP_STAGEB(GP_SB(0, 1), b2 + hstep); GP_STAGE2(GP_SA(0, 0), a2, w0, w1);
            GP_WAIT_V(8); GP_WAIT_L(0); GP_BAR; GP_MMA(1, 0, At, B0); GP_MMA(1, 1, At, B1); GP_BAR; GP_SCHED;
            GP_LDB(B0, 1, 0); GP_LDB(B1, 1, 1); GP_SCHED; GP_LDA(At, 1, 0); GP_STAGE2(GP_SA(0, 1), a2, w2, w3);
            GP_WAIT_V(8); GP_WAIT_L(0); GP_BAR; GP_MMA(0, 0, At, B0); GP_MMA(0, 1, At, B1); GP_BAR; GP_SCHED;
            GP_LDA(At, 1, 1); GP_STAGEB(GP_SB(1, 0), b3); GP_STAGEB(GP_SB(1, 1), b3 + hstep); GP_STAGE2(GP_SA(1, 0), a3, w0, w1);
            GP_WAIT_V(8); GP_WAIT_L(0); GP_BAR; GP_MMA(1, 0, At, B0); GP_MMA(1, 1, At, B1); GP_BAR; GP_SCHED;
        }
        if (wr == 0) GP_BAR;
        E(acc, cur, wr, wc, fr, fq);
        if (!has_next) break;
        if (!(EpiTraits<Epi>::KEEP && cur.be == 0)) {
#pragma unroll
        for (int a = 0; a < 2; ++a)
#pragma unroll
            for (int b = 0; b < 2; ++b)
#pragma unroll
                for (int m = 0; m < 4; ++m)
#pragma unroll
                    for (int n = 0; n < 2; ++n) acc[a][b][m][n] = (f32x4){0.f, 0.f, 0.f, 0.f};
        }
        cur = nxt; cA = nA; cB = nB; vC0 = vN0; vC1 = vN1; vC2 = vN2; vC3 = vN3; ++ui;
        if (wr == 1) GP_BAR;
    }
    GP_WAIT_V(0);
    GP_BAR;
#undef GP_SA
#undef GP_SB
#undef GP_STAGE2
#undef GP_STAGEB
#undef GP_LDA
#undef GP_LDB
#undef GP_MMA
#undef GP_WAIT_V
#undef GP_WAIT_L
#undef GP_BAR
#undef GP_SCHED
#undef GP_VOFF
}
#endif

template <class Epi, class Sched, bool GATHER = false>
__device__ __forceinline__ void gemm_phase(int tid, LAS unsigned char* lds, const Gemm g, const Sched& S, const Epi& E) {
#if FAST_GEMM
    gemm_phase_fast<Epi, Sched, GATHER>(tid, lds, g, S, E);
#else
    (void)lds; gemm_phase_ref<Epi, Sched, GATHER>(tid, g, S, E);
#endif
}

#define EPI_ROW(ai, m) (u.pm * 256 + (ai) * 128 + wr * 64 + (m) * 16 + fr)
#define EPI_COL(bj) (u.pn * 256 + (bj) * 128 + wc * 32 + fq * 8)
__device__ __forceinline__ float dot4(f32x4 a) { return (a[0] * a[0] + a[1] * a[1]) + (a[2] * a[2] + a[3] * a[3]); }

struct EpiNull {
    __device__ __forceinline__ void operator()(const ACC_T, const Unit& u, int wr, int wc, int fr, int fq) const {
#pragma unroll
        for (int ai = 0; ai < 2; ++ai)
#pragma unroll
            for (int bj = 0; bj < 2; ++bj)
#pragma unroll
                for (int m = 0; m < 4; ++m) asm volatile("" :: "v"(acc[ai][bj][m][0]), "v"(acc[ai][bj][m][1]));
    }
};
struct EpiIn {
    bf16_t *QA, *KA, *VA, *QLAT, *KVLAT, *KB, *SA, *SB; float *SSQ, *SSKV; const float *gq, *gk, *cosA, *sinA, *cosB, *sinB;
    __device__ __forceinline__ void operator()(const ACC_T, const Unit& u, int wr, int wc, int fr, int fq) const {
        const int wb = u.pn * 4 + wc;
        if (wb < 10) {
            const bool isq = wb < 8; const int head = isq ? wb : wb - 8; const float* g = isq ? gq : gk; bf16_t* dst = isq ? QA : KA; const int dp = isq ? 512 : 128; const float qs = isq ? QSCALE_A : 1.f;
            const f32x4 g00 = *(const f32x4*)(g + 8 * fq), g01 = *(const f32x4*)(g + 8 * fq + 4), g10 = *(const f32x4*)(g + 32 + 8 * fq), g11 = *(const f32x4*)(g + 36 + 8 * fq);
#pragma unroll
            for (int ai = 0; ai < 2; ++ai)
#pragma unroll
                for (int m = 0; m < 4; ++m) {
                    const int r = EPI_ROW(ai, m), pos = r & (S - 1);
                    const f32x4 v00 = acc[ai][0][m][0], v01 = acc[ai][0][m][1], v10 = acc[ai][1][m][0], v11 = acc[ai][1][m][1];
                    float ss = (dot4(v00) + dot4(v01)) + (dot4(v10) + dot4(v11)); ss += __shfl_xor(ss, 16); ss += __shfl_xor(ss, 32);
                    const float rstd = rsqrtf(ss * (1.f / 64.f) + EPS);
                    const f32x4 y00 = v00 * rstd * g00, y01 = v01 * rstd * g01, y10 = v10 * rstd * g10, y11 = v11 * rstd * g11;
                    const f32x4 c0 = *(const f32x4*)(cosA + pos * 32 + 8 * fq), c1 = *(const f32x4*)(cosA + pos * 32 + 8 * fq + 4), s0 = *(const f32x4*)(sinA + pos * 32 + 8 * fq), s1 = *(const f32x4*)(sinA + pos * 32 + 8 * fq + 4);
                    const f32x4 o00 = (y00 * c0 - y10 * s0) * qs, o01 = (y01 * c1 - y11 * s1) * qs, o10 = (y10 * c0 + y00 * s0) * qs, o11 = (y11 * c1 + y01 * s1) * qs;
                    bf16_t* p = dst + (size_t)r * dp + head * 64 + 8 * fq;
                    st16(p, pack8(o00, o01)); st16((p + 32), pack8(o10, o11));
                }
        } else if (wb < 12) {
#pragma unroll
            for (int ai = 0; ai < 2; ++ai)
#pragma unroll
                for (int m = 0; m < 4; ++m) { bf16_t* p = VA + (size_t)EPI_ROW(ai, m) * 128 + (wb - 10) * 64 + 8 * fq;
                    st16(p, pack8(acc[ai][0][m][0], acc[ai][0][m][1])); st16((p + 32), pack8(acc[ai][1][m][0], acc[ai][1][m][1])); }
        } else if (wb < 22) {
            const bool isq = wb < 18; const int idx = isq ? wb - 12 : wb - 18; bf16_t* dst = isq ? QLAT : KVLAT; const int dp = isq ? 384 : 256;
#pragma unroll
            for (int ai = 0; ai < 2; ++ai)
#pragma unroll
                for (int m = 0; m < 4; ++m) {
                    const int r = EPI_ROW(ai, m);
                    const f32x4 v00 = acc[ai][0][m][0], v01 = acc[ai][0][m][1], v10 = acc[ai][1][m][0], v11 = acc[ai][1][m][1];
                    float ss = (dot4(v00) + dot4(v01)) + (dot4(v10) + dot4(v11)); ss += __shfl_xor(ss, 16); ss += __shfl_xor(ss, 32);
                    if (fq == 0) { if (isq) SSQ[(size_t)r * 8 + idx] = ss; else SSKV[(size_t)r * 4 + idx] = ss; }
                    bf16_t* p = dst + (size_t)r * dp + idx * 64 + 8 * fq;
                    st16(p, pack8(v00, v01)); st16((p + 32), pack8(v10, v11));
                }
        } else if (wb == 22) {
            if (fq < 2) {
#pragma unroll
                for (int ai = 0; ai < 2; ++ai)
#pragma unroll
                    for (int m = 0; m < 4; ++m) {
                        const int r = EPI_ROW(ai, m), pos = r & (S - 1);
                        const f32x4 x10 = acc[ai][0][m][0], x11 = acc[ai][0][m][1], x20 = acc[ai][1][m][0], x21 = acc[ai][1][m][1];
                        const f32x4 c0 = *(const f32x4*)(cosB + pos * 16 + 8 * fq), c1 = *(const f32x4*)(cosB + pos * 16 + 8 * fq + 4), s0 = *(const f32x4*)(sinB + pos * 16 + 8 * fq), s1 = *(const f32x4*)(sinB + pos * 16 + 8 * fq + 4);
                        const u32x4 w1 = pack8(x10 * c0 - x20 * s0, x11 * c1 - x21 * s1), w2 = pack8(x20 * c0 + x10 * s0, x21 * c1 + x11 * s1);
                        bf16_t* p = KB + (size_t)r * 768 + 64 + 8 * fq;
#pragma unroll
                        for (int h = 0; h < 8; ++h) { st16((p + h * 96), w1); st16((p + h * 96 + 16), w2); }
                    }
            }
        } else if (wb == 23) {
        } else {
            const bool isa = wb < 40; const int idx = isa ? wb - 24 : wb - 40; unsigned char* dst = (unsigned char*)(isa ? SA : SB);
#pragma unroll
            for (int ai = 0; ai < 2; ++ai)
#pragma unroll
                for (int m = 0; m < 4; ++m) { unsigned char* p = dst + (size_t)EPI_ROW(ai, m) * 1024 + idx * 64 + 8 * fq;
#pragma unroll
                    for (int bj = 0; bj < 2; ++bj) { const f32x4 a = acc[ai][bj][m][0], b = acc[ai][bj][m][1]; u32x2 w;
                        w.x = (unsigned)__builtin_amdgcn_cvt_pk_fp8_f32(a[2], a[3], __builtin_amdgcn_cvt_pk_fp8_f32(a[0], a[1], 0, false), true);
                        w.y = (unsigned)__builtin_amdgcn_cvt_pk_fp8_f32(b[2], b[3], __builtin_amdgcn_cvt_pk_fp8_f32(b[0], b[1], 0, false), true);
                        st8((p + bj * 32), w); } }
        }
    }
};
__host__ __device__ __forceinline__ int src_col_in(int n) {
    const int pn = n >> 8, nl = n & 255, bj = nl >> 7, wc = (nl & 127) >> 5, p = nl & 31, wb = pn * 4 + wc, s = bj * 32 + p;
    if (wb < 8) return wb * 64 + s;
    if (wb < 10) return 512 + (wb - 8) * 64 + s;
    if (wb < 12) return 640 + (wb - 10) * 64 + s;
    if (wb < 18) return 768 + (wb - 12) * 64 + s;
    if (wb < 22) return 1152 + (wb - 18) * 64 + s;
    if (wb == 22) return p < 16 ? 1408 + bj * 16 + p : -1;
    if (wb == 23) return -1;
    if (wb < 40) return 1440 + (wb - 24) * 64 + s;
    return 2464 + (wb - 40) * 64 + s;
}
struct EpiQb {
    bf16_t* QB; const float *SSQ, *cosB, *sinB;
    __device__ __forceinline__ void operator()(const ACC_T, const Unit& u, int wr, int wc, int fr, int fq) const {
#pragma unroll
        for (int ai = 0; ai < 2; ++ai)
#pragma unroll
            for (int m = 0; m < 4; ++m) {
                const int r = EPI_ROW(ai, m), pos = r & (S - 1);
                const f32x4 sa = *(const f32x4*)(SSQ + (size_t)r * 8); const f32x2 sb = *(const f32x2*)(SSQ + (size_t)r * 8 + 4);
                const float rstd = rsqrtf((((sa[0] + sa[1]) + (sa[2] + sa[3])) + (sb[0] + sb[1])) * (1.f / 384.f) + EPS);
#pragma unroll
                for (int bj = 0; bj < 2; ++bj) {
                    f32x4 v0 = acc[ai][bj][m][0] * rstd, v1 = acc[ai][bj][m][1] * rstd;
                    const int c32 = u.pn * 8 + bj * 4 + wc;
                    if (c32 % 3 == 2) {
                        f32x4 o0, o1;
#pragma unroll
                        for (int j = 0; j < 4; ++j) { o0[j] = __shfl_xor(v0[j], 32); o1[j] = __shfl_xor(v1[j], 32); }
                        const int i0 = 8 * (fq & 1);
                        const f32x4 c0 = *(const f32x4*)(cosB + pos * 16 + i0), c1 = *(const f32x4*)(cosB + pos * 16 + i0 + 4), s0 = *(const f32x4*)(sinB + pos * 16 + i0), s1 = *(const f32x4*)(sinB + pos * 16 + i0 + 4);
                        if (fq < 2) { v0 = v0 * c0 - o0 * s0; v1 = v1 * c1 - o1 * s1; } else { v0 = v0 * c0 + o0 * s0; v1 = v1 * c1 + o1 * s1; }
                    }
                    st16((QB + (size_t)r * 768 + EPI_COL(bj)), pack8(v0 * QSCALE_B, v1 * QSCALE_B));
                }
            }
    }
};
struct EpiKvb {
    bf16_t *KB, *VB; const float* SSKV;
    __device__ __forceinline__ void operator()(const ACC_T, const Unit& u, int wr, int wc, int fr, int fq) const {
#pragma unroll
        for (int ai = 0; ai < 2; ++ai)
#pragma unroll
            for (int m = 0; m < 4; ++m) {
                const int r = EPI_ROW(ai, m);
                const f32x4 sa = *(const f32x4*)(SSKV + (size_t)r * 4);
                const float rstd = rsqrtf(((sa[0] + sa[1]) + (sa[2] + sa[3])) * (1.f / 256.f) + EPS);
#pragma unroll
                for (int bj = 0; bj < 2; ++bj) {
                    const int head = u.pn * 2 + bj, o = wc * 32 + fq * 8;
                    const u32x4 w = pack8(acc[ai][bj][m][0] * rstd, acc[ai][bj][m][1] * rstd);
                    if (wc < 2) st16((KB + (size_t)r * 768 + head * 96 + o), w); else st16((VB + (size_t)r * 512 + head * 64 + (o - 64)), w);
                }
            }
    }
};
template <int MODE> struct EpiProj {
    bf16_t* O; const bf16_t* gate;
    __device__ __forceinline__ void operator()(const ACC_T, const Unit& u, int wr, int wc, int fr, int fq) const {
#pragma unroll
        for (int ai = 0; ai < 2; ++ai)
#pragma unroll
            for (int m = 0; m < 4; ++m) {
                const int r = EPI_ROW(ai, m);
#pragma unroll
                for (int bj = 0; bj < 2; ++bj) {
                    const size_t off = (size_t)r * D + EPI_COL(bj);
                    const u32x2 gw = *(const u32x2*)((const unsigned char*)gate + off);
                    const f32x2 q0 = __builtin_amdgcn_cvt_pk_f32_fp8((int)gw.x, false), q1 = __builtin_amdgcn_cvt_pk_f32_fp8((int)gw.x, true), q2 = __builtin_amdgcn_cvt_pk_f32_fp8((int)gw.y, false), q3 = __builtin_amdgcn_cvt_pk_f32_fp8((int)gw.y, true);
                    const f32x4 g0 = {sigm(q0[0]), sigm(q0[1]), sigm(q1[0]), sigm(q1[1])}, g1 = {sigm(q2[0]), sigm(q2[1]), sigm(q3[0]), sigm(q3[1])};
                    f32x4 v0 = acc[ai][bj][m][0] * g0, v1 = acc[ai][bj][m][1] * g1;
                    if (MODE == 1) { f32x4 p0, p1; unpack8(*(const u32x4*)(O + off), p0, p1); v0 += p0; v1 += p1; }
                    if (MODE == 1) st16(O + off, pack8(v0, v1)); else *(u32x4*)(O + off) = pack8(v0, v1);
                }
            }
    }
};
struct EpiProjP {
    bf16_t* O; const unsigned char* SA; const unsigned char* SB;
    __device__ static __forceinline__ void gates(const unsigned char* G, size_t off, f32x4& g0, f32x4& g1) {
        const u32x2 gw = *(const u32x2*)(G + off);
        const f32x2 q0 = __builtin_amdgcn_cvt_pk_f32_fp8((int)gw.x, false), q1 = __builtin_amdgcn_cvt_pk_f32_fp8((int)gw.x, true), q2 = __builtin_amdgcn_cvt_pk_f32_fp8((int)gw.y, false), q3 = __builtin_amdgcn_cvt_pk_f32_fp8((int)gw.y, true);
        g0 = (f32x4){sigm(q0[0]), sigm(q0[1]), sigm(q1[0]), sigm(q1[1])}; g1 = (f32x4){sigm(q2[0]), sigm(q2[1]), sigm(q3[0]), sigm(q3[1])};
    }
    __device__ __forceinline__ void operator()(f32x4 (&acc)[2][2][4][2], const Unit& u, int wr, int wc, int fr, int fq) const {
#pragma unroll
        for (int ai = 0; ai < 2; ++ai)
#pragma unroll
            for (int m = 0; m < 4; ++m) {
                const int r = EPI_ROW(ai, m);
#pragma unroll
                for (int bj = 0; bj < 2; ++bj) {
                    const size_t off = (size_t)r * D + EPI_COL(bj);
                    f32x4 b0, b1; gates(SB, off, b0, b1);
#pragma unroll
                    for (int j = 0; j < 4; ++j) { b0[j] = fmaxf(b0[j], 9.094947e-13f); b1[j] = fmaxf(b1[j], 9.094947e-13f); }
                    if (u.be == 0) {
                        f32x4 a0, a1; gates(SA, off, a0, a1);
#pragma unroll
                        for (int j = 0; j < 4; ++j) { acc[ai][bj][m][0][j] *= a0[j] * __builtin_amdgcn_rcpf(b0[j]); acc[ai][bj][m][1][j] *= a1[j] * __builtin_amdgcn_rcpf(b1[j]); }
                    } else st16(O + off, pack8(acc[ai][bj][m][0] * b0, acc[ai][bj][m][1] * b1));
                }
            }
    }
};
template <> struct EpiTraits<EpiProjP> { static constexpr bool KEEP = true; };
struct EpiWo {
    const bf16_t* X; const float* modl; bf16_t* XO;
    __device__ __forceinline__ void operator()(const ACC_T, const Unit& u, int wr, int wc, int fr, int fq) const {
        const float* g1 = modl + (size_t)(u.pm >> 4) * 6 * D + 2 * D;
#pragma unroll
        for (int bj = 0; bj < 2; ++bj) {
            const int c = EPI_COL(bj); const f32x4 ga = *(const f32x4*)(g1 + c), gb = *(const f32x4*)(g1 + c + 4);
#pragma unroll
            for (int ai = 0; ai < 2; ++ai)
#pragma unroll
                for (int m = 0; m < 4; ++m) { const size_t off = (size_t)EPI_ROW(ai, m) * D + c;
                    f32x4 x0, x1; unpack8(*(const u32x4*)(X + off), x0, x1);
                    st16((XO + off), pack8(x0 + ga * acc[ai][bj][m][0], x1 + gb * acc[ai][bj][m][1])); }
        }
    }
};
struct EpiUp {
    bf16_t* ACT;
    __device__ __forceinline__ void operator()(const ACC_T, const Unit& u, int wr, int wc, int fr, int fq) const {
#pragma unroll
        for (int ai = 0; ai < 2; ++ai)
#pragma unroll
            for (int m = 0; m < 4; ++m) {
                f32x4 a = acc[ai][0][m][0], b = acc[ai][0][m][1]; const f32x4 c = acc[ai][1][m][0], d = acc[ai][1][m][1];
#pragma unroll
                for (int j = 0; j < 4; ++j) { a[j] = a[j] * sigm(a[j]) * c[j]; b[j] = b[j] * sigm(b[j]) * d[j]; }
                st16((ACT + (size_t)EPI_ROW(ai, m) * FF + u.pn * 128 + wc * 32 + fq * 8), pack8(a, b));
            }
    }
};
struct EpiDown {
    bf16_t* Y2; const unsigned* list; const float* gw;
    __device__ __forceinline__ void operator()(const ACC_T, const Unit& u, int wr, int wc, int fr, int fq) const {
#pragma unroll
        for (int ai = 0; ai < 2; ++ai)
#pragma unroll
            for (int m = 0; m < 4; ++m) {
                const int rloc = ai * 128 + wr * 64 + m * 16 + fr;
                if (rloc < u.nv) {
                    const unsigned entry = list[(size_t)u.be * T + u.rl * 256 + rloc]; const float w = gw[entry];
#pragma unroll
                    for (int bj = 0; bj < 2; ++bj) { const f32x4 a = acc[ai][bj][m][0] * (w * 16.f), b = acc[ai][bj][m][1] * (w * 16.f); u32x2 q;
                        q.x = (unsigned)__builtin_amdgcn_cvt_pk_fp8_f32(a[2], a[3], __builtin_amdgcn_cvt_pk_fp8_f32(a[0], a[1], 0, false), true);
                        q.y = (unsigned)__builtin_amdgcn_cvt_pk_fp8_f32(b[2], b[3], __builtin_amdgcn_cvt_pk_fp8_f32(b[0], b[1], 0, false), true);
                        st8(((unsigned char*)Y2 + (size_t)entry * D + EPI_COL(bj)), q); }
                }
            }
    }
};
}

namespace at {
struct Tensors { const bf16_t* Q; int qp; const bf16_t* K; int kp; const bf16_t* V; int vp; bf16_t* O; int op; int group; };
__device__ __forceinline__ bool next_unit(int i, int vcu, int G, int& bh, int& qb) {
    int u;
    if (G == 256) { if (i >= 4) return false; u = (vcu >> 5) * 128 + i * 32 + (vcu & 31); }
    else { u = i * G + vcu; if (u >= 1024) return false; }
    bh = u >> 4; qb = u & 15; return true;
}
template <int DQK>
__device__ __forceinline__ void attn_phase_ref(int tid, const Tensors& A, int vcu, int G) {
    int bh, qb;
    for (int i = 0; next_unit(i, vcu, G, bh, qb); ++i) {
        const int b = bh >> 3, h = bh & 7, kvh = h / A.group;
        {
            const int dh = tid >> 8;
            const size_t row = (size_t)b * S + qb * 256 + (tid & 255);
            float q[DQK], o[32];
#pragma unroll
            for (int d = 0; d < DQK; ++d) q[d] = bf2f(A.Q[row * A.qp + h * DQK + d]);
#pragma unroll
            for (int d = 0; d < 32; ++d) o[d] = 0.f;
            float l = 0.f;
            for (int k = 0; k < S; ++k) {
                const bf16_t* kr = A.K + ((size_t)b * S + k) * A.kp + kvh * DQK; const bf16_t* vr = A.V + ((size_t)b * S + k) * A.vp + kvh * 64 + dh * 32;
                float sc = 0.f;
#pragma unroll
                for (int d = 0; d < DQK; d += 8) { f32x4 k0, k1; unpack8(*(const u32x4*)(kr + d), k0, k1);
                    sc += q[d] * k0[0] + q[d + 1] * k0[1] + q[d + 2] * k0[2] + q[d + 3] * k0[3] + q[d + 4] * k1[0] + q[d + 5] * k1[1] + q[d + 6] * k1[2] + q[d + 7] * k1[3]; }
                const float p = bf2f(cvt_pk_bf16(exp2f(sc), 0.f) & 0xffffu); l += p;
#pragma unroll
                for (int d = 0; d < 32; d += 8) { f32x4 v0, v1; unpack8(*(const u32x4*)(vr + d), v0, v1);
                    o[d] += p * v0[0]; o[d + 1] += p * v0[1]; o[d + 2] += p * v0[2]; o[d + 3] += p * v0[3]; o[d + 4] += p * v1[0]; o[d + 5] += p * v1[1]; o[d + 6] += p * v1[2]; o[d + 7] += p * v1[3]; }
            }
            const float il = 1.f / l;
            __syncthreads();
#pragma unroll
            for (int d = 0; d < 32; d += 8) { f32x4 a = {o[d] * il, o[d + 1] * il, o[d + 2] * il, o[d + 3] * il}, c = {o[d + 4] * il, o[d + 5] * il, o[d + 6] * il, o[d + 7] * il};
                *(u32x4*)(A.O + row * A.op + h * 64 + dh * 32 + d) = pack8(a, c); }
        }
    }
}
#if FAST_ATTN
typedef short s16x4 __attribute__((ext_vector_type(4)));
__device__ __forceinline__ unsigned cvtpk(float lo, float hi) { f32x2 v = {lo, hi}; bf16x2_t b = __builtin_convertvector(v, bf16x2_t); return __builtin_bit_cast(unsigned, b); }
__device__ __forceinline__ s16x4 vtr(const LAS unsigned char* p) { return __builtin_bit_cast(s16x4, __builtin_amdgcn_ds_read_tr16_b64_v4i16((LAS s16x4*)p)); }
__device__ __forceinline__ int crow(int r, int hi) { return (r & 3) + 8 * (r >> 2) + 4 * hi; }
#define AT_BAR() asm volatile("s_barrier" ::: "memory")
#define AT_WAITBAR(N) asm volatile("s_waitcnt vmcnt(" #N ") lgkmcnt(0)\n\ts_barrier" ::: "memory")
#define AT_SCHED() __builtin_amdgcn_sched_barrier(0)
__device__ __forceinline__ void glds16(const void* gsrc, unsigned lds_dst) { unsigned keep;
    asm volatile("s_mov_b32 %0, m0\n\ts_mov_b32 m0, %2\n\ts_nop 0\n\tglobal_load_lds_dwordx4 %1, off\n\ts_mov_b32 m0, %0" : "=&s"(keep) : "v"(gsrc), "s"(lds_dst) : "memory"); }
#define AT_GLDS(g, l) glds16((const void*)(g), (unsigned)__builtin_amdgcn_readfirstlane((int)(unsigned)(uintptr_t)(l)))
template <int DQK>
__device__ __forceinline__ void attn_unit(int tid, LAS unsigned char* lds, const Tensors& A, int b, int h, int qb) {
    constexpr int ND = DQK / 16, NCH = DQK / 8, KSLOT = NCH * 1024, NKD = NCH > 8 ? 2 : 1, VSLOT = 8192, NT = S / 64;
    constexpr int KOFF = 0, VOFF = 3 * KSLOT, OST = VOFF + 3 * VSLOT, WSF = OST + 8 * 4096;
    static_assert(WSF + 8 * 256 <= RING_BYTES, "attention LDS");
    const int lane = tid & 63, r32 = lane & 31, hi = lane >> 5, wid = __builtin_amdgcn_readfirstlane(tid >> 6);
    const int kvh = h / A.group; const size_t rowb = (size_t)b * S;
    const bf16_t* ksrc = A.K + (rowb + lane) * A.kp + kvh * DQK + wid * 8;
    const bf16_t* ksrc2 = A.K + (rowb + lane) * A.kp + kvh * DQK + (8 + (wid & 3)) * 8;
    const bf16_t* vsrc = A.V + (rowb + 16 * (wid & 3) + (lane >> 2)) * A.vp + kvh * 64 + (wid >> 2) * 32 + (lane & 3) * 8;
    const size_t ktile = (size_t)64 * A.kp, vtile = (size_t)64 * A.vp;
    LAS unsigned char* kdst = lds + KOFF + wid * 1024; LAS unsigned char* kdst2 = lds + KOFF + (8 + (wid & 3)) * 1024; LAS unsigned char* vdst = lds + VOFF + wid * 1024;
#define DMA_K(j, so) do { AT_GLDS(ksrc + (size_t)(j) * ktile, kdst + (so)); if (NKD == 2) AT_GLDS(ksrc2 + (size_t)(j) * ktile, kdst2 + (so)); } while (0)
#define DMA_V(j, so) AT_GLDS(vsrc + (size_t)(j) * vtile, vdst + (so))
    const LAS unsigned char* kp0 = lds + KOFF + hi * 1024 + r32 * 16;
    const LAS unsigned char* vp0 = lds + VOFF + ((lane >> 4) & 1) * 32 + (lane & 3) * 8 + (4 * hi + ((lane & 15) >> 2)) * 64;
    DMA_K(0, 0); DMA_V(0, 0); DMA_K(1, KSLOT); DMA_V(1, VSLOT); DMA_K(2, 2 * KSLOT);
    const bf16_t* Qw = A.Q + (rowb + qb * 256 + wid * 32 + r32) * A.qp + h * DQK + hi * 8;
    bf16x8 qr[ND];
#pragma unroll
    for (int d0 = 0; d0 < ND; ++d0) qr[d0] = *(const bf16x8*)(Qw + d0 * 16);
    asm volatile("s_waitcnt vmcnt(0)\n\ts_barrier" ::: "memory");
    bf16x8 kf[2 * ND]; s16x4 vlo[8], vhi[8];
#define KLOAD(so) do { _Pragma("unroll") for (int d0 = 0; d0 < ND; ++d0) { kf[2 * d0] = *(const LAS bf16x8*)(kp0 + (so) + d0 * 2048); kf[2 * d0 + 1] = *(const LAS bf16x8*)(kp0 + (so) + d0 * 2048 + 512); } } while (0)
#define VLOAD(so) do { _Pragma("unroll") for (int i = 0; i < 8; ++i) { vlo[i] = vtr(vp0 + (so) + (i >> 2) * 4096 + (i & 3) * 1024); vhi[i] = vtr(vp0 + (so) + (i >> 2) * 4096 + (i & 3) * 1024 + 512); } } while (0)
#define VFR(i) (bf16x8){vlo[i][0], vlo[i][1], vlo[i][2], vlo[i][3], vhi[i][0], vhi[i][1], vhi[i][2], vhi[i][3]}
    KLOAD(0);
    asm volatile("s_waitcnt lgkmcnt(0)" ::: "memory");
    if (PROBE_ATT != 5 && wid >= 4) AT_BAR();
    f32x16 o0 = {}, o1 = {}, C0, C1; u32x4 pw0, pw1, pw2, pw3; float lsum = 0.f;
    const f32x16 zero = {};
#define QK_BLOCK() do { C0 = __builtin_amdgcn_mfma_f32_32x32x16_bf16(kf[0], qr[0], zero, 0, 0, 0); C1 = __builtin_amdgcn_mfma_f32_32x32x16_bf16(kf[1], qr[0], zero, 0, 0, 0); \
        _Pragma("unroll") for (int d0 = 1; d0 < ND; ++d0) { C0 = __builtin_amdgcn_mfma_f32_32x32x16_bf16(kf[2 * d0], qr[d0], C0, 0, 0, 0); C1 = __builtin_amdgcn_mfma_f32_32x32x16_bf16(kf[2 * d0 + 1], qr[d0], C1, 0, 0, 0); } } while (0)
#define PAF(k) __builtin_bit_cast(bf16x8, pw##k)
#define PV_BLOCK() do { \
        o0 = __builtin_amdgcn_mfma_f32_32x32x16_bf16(PAF(0), VFR(0), o0, 0, 0, 0); o1 = __builtin_amdgcn_mfma_f32_32x32x16_bf16(PAF(0), VFR(4), o1, 0, 0, 0); \
        o0 = __builtin_amdgcn_mfma_f32_32x32x16_bf16(PAF(1), VFR(1), o0, 0, 0, 0); o1 = __builtin_amdgcn_mfma_f32_32x32x16_bf16(PAF(1), VFR(5), o1, 0, 0, 0); \
        o0 = __builtin_amdgcn_mfma_f32_32x32x16_bf16(PAF(2), VFR(2), o0, 0, 0, 0); o1 = __builtin_amdgcn_mfma_f32_32x32x16_bf16(PAF(2), VFR(6), o1, 0, 0, 0); \
        o0 = __builtin_amdgcn_mfma_f32_32x32x16_bf16(PAF(3), VFR(3), o0, 0, 0, 0); o1 = __builtin_amdgcn_mfma_f32_32x32x16_bf16(PAF(3), VFR(7), o1, 0, 0, 0); } while (0)
#define SOFTMAX() do { \
        _Pragma("unroll") for (int r = 0; r < 16; ++r) { C0[r] = __builtin_amdgcn_exp2f(C0[r]); C1[r] = __builtin_amdgcn_exp2f(C1[r]); } \
        f32x2 s0_ = {C0[0], C0[1]}, s1_ = {C1[0], C1[1]}; _Pragma("unroll") for (int r = 2; r < 16; r += 2) { s0_ += (f32x2){C0[r], C0[r + 1]}; s1_ += (f32x2){C1[r], C1[r + 1]}; } s0_ += s1_; lsum += s0_[0] + s0_[1]; \
        pw0 = (u32x4){cvtpk(C0[0], C0[1]), cvtpk(C0[2], C0[3]), cvtpk(C0[4], C0[5]), cvtpk(C0[6], C0[7])}; pw1 = (u32x4){cvtpk(C0[8], C0[9]), cvtpk(C0[10], C0[11]), cvtpk(C0[12], C0[13]), cvtpk(C0[14], C0[15])}; \
        pw2 = (u32x4){cvtpk(C1[0], C1[1]), cvtpk(C1[2], C1[3]), cvtpk(C1[4], C1[5]), cvtpk(C1[6], C1[7])}; pw3 = (u32x4){cvtpk(C1[8], C1[9]), cvtpk(C1[10], C1[11]), cvtpk(C1[12], C1[13]), cvtpk(C1[14], C1[15])}; } while (0)
    int ka = 2 * KSLOT, kb = 0, kc = KSLOT, va = 2 * VSLOT, vb = 0, vc = VSLOT;
#define ROT() do { const int t_ = ka; ka = kb; kb = kc; kc = t_; const int u_ = va; va = vb; vb = vc; vc = u_; } while (0)
#define PINP() asm volatile("" : "+v"(lsum) : "v"(pw0), "v"(pw1), "v"(pw2), "v"(pw3))
#if ATT_REGSTAGE
    u32x4 kst = {}, kst2 = {}, vst = {};
    const LAS unsigned char* kw = lds + KOFF + wid * 1024 + lane * 16; const LAS unsigned char* kw2 = lds + KOFF + (8 + (wid & 3)) * 1024 + lane * 16; const LAS unsigned char* vw = lds + VOFF + wid * 1024 + lane * 16;
#define ST_WRITE(WK, WV) do { if (WK) { *(LAS u32x4*)(kw + ka) = kst; if (NKD == 2 && wid < 4) *(LAS u32x4*)(kw2 + ka) = kst2; } if (WV) *(LAS u32x4*)(vw + vc) = vst; } while (0)
#define ST_LOAD(sv, IK, IV) do { if (IK) { kst = *(const u32x4*)(ksrc + (size_t)((sv) + 4) * ktile); if (NKD == 2 && wid < 4) kst2 = *(const u32x4*)(ksrc2 + (size_t)((sv) + 4) * ktile); } if (IV) vst = *(const u32x4*)(vsrc + (size_t)((sv) + 3) * vtile); } while (0)
#define STEP(sv, DOQK, DOPV, KL, VL, IK, IV, WK, WV) do { \
        AT_SCHED(); if (DOQK) QK_BLOCK(); if (DOPV) PV_BLOCK(); AT_SCHED(); \
        asm volatile("s_barrier\n\ts_nop 15\n\ts_nop 3" : "+v"(C0), "+v"(C1), "+v"(o0), "+v"(o1) :: "memory"); AT_SCHED(); \
        if (KL) KLOAD(kc); if (VL) VLOAD(vb); ST_WRITE(WK, WV); ST_LOAD(sv, IK, IV); \
        if (DOQK) { SOFTMAX(); PINP(); } AT_SCHED(); \
        asm volatile("s_waitcnt lgkmcnt(0)\n\ts_barrier" ::: "memory"); \
        AT_SCHED(); ROT(); } while (0)
    STEP(-1, true, false, true, true, true, true, false, false);
#pragma nounroll
    for (int s = 0; s < NT - 4; ++s) STEP(s, true, true, true, true, true, true, true, true);
    STEP(NT - 4, true, true, true, true, false, true, true, true);
    STEP(NT - 3, true, true, true, true, false, false, false, true);
    STEP(NT - 2, true, true, false, true, false, false, false, false);
    STEP(NT - 1, false, true, false, false, false, false, false, false);
#undef ST_WRITE
#undef ST_LOAD
#else
#define STEP(sv, DOQK, DOPV, KL, VL, IK, IV) do { \
        AT_SCHED(); if (DOQK) QK_BLOCK(); if (DOPV) PV_BLOCK(); AT_SCHED(); \
          \
        asm volatile("s_barrier\n\ts_nop 15\n\ts_nop 3" : "+v"(C0), "+v"(C1), "+v"(o0), "+v"(o1) :: "memory"); AT_SCHED(); \
        if (KL) KLOAD(kc); if (VL) VLOAD(vb); if (IK) DMA_K((sv) + 4, kb); if (IV) DMA_V((sv) + 3, va); \
        if (DOQK) { SOFTMAX(); PINP(); } AT_SCHED(); \
        if (IK) { if (NKD == 2) { AT_WAITBAR(3); } else { AT_WAITBAR(2); } } else if (IV) { AT_WAITBAR(1); } else { AT_WAITBAR(0); } \
        AT_SCHED(); ROT(); } while (0)
    STEP(-1, true, false, true, true, true, true);
#pragma nounroll
    for (int s = 0; s < NT - 4; ++s) STEP(s, true, true, true, true, true, true);
    STEP(NT - 4, true, true, true, true, false, true);
    STEP(NT - 3, true, true, true, true, false, false);
    STEP(NT - 2, true, true, false, true, false, false);
    STEP(NT - 1, false, true, false, false, false, false);
#endif
#undef STEP
#undef PINP
    if (PROBE_ATT != 5 && wid < 4) AT_BAR();
    { auto rr = __builtin_amdgcn_permlane32_swap(__float_as_uint(lsum), __float_as_uint(lsum), false, false); lsum = __uint_as_float(rr[0]) + __uint_as_float(rr[1]); }
    LAS float* wsf = (LAS float*)(lds + WSF + wid * 256);
    if (hi == 0) wsf[r32] = lsum;
    asm volatile("s_waitcnt lgkmcnt(0)" ::: "memory");
    LAS bf16_t* stg = (LAS bf16_t*)(lds + OST + wid * 4096);
#pragma unroll
    for (int r = 0; r < 16; ++r) { const int orow = crow(r, hi); const float rl = __builtin_amdgcn_rcpf(wsf[orow]);
        stg[orow * 64 + r32] = (bf16_t)(cvtpk(o0[r] * rl, 0.f) & 0xffffu); stg[orow * 64 + 32 + r32] = (bf16_t)(cvtpk(o1[r] * rl, 0.f) & 0xffffu); }
    asm volatile("s_waitcnt lgkmcnt(0)" ::: "memory");
    bf16_t* Ow = A.O + (rowb + qb * 256 + wid * 32) * A.op + h * 64;
#pragma unroll
    for (int i = 0; i < 4; ++i) { const int row = i * 8 + (lane >> 3), ch = lane & 7; const u32x4 v = *(const LAS u32x4*)(stg + row * 64 + ch * 8); st16((Ow + (size_t)row * A.op + ch * 8), v); }
    asm volatile("s_waitcnt lgkmcnt(0)\n\ts_barrier" ::: "memory");
#undef DMA_K
#undef DMA_V
#undef KLOAD
#undef VLOAD
#undef VFR
#undef QK_BLOCK
#undef PAF
#undef PV_BLOCK
#undef SOFTMAX
#undef ROT
}
#endif
template <int DQK>
__device__ __forceinline__ void attn_phase(int tid, LAS unsigned char* lds, const Tensors& A, int vcu, int G) {
#if FAST_ATTN
    int bh, qb;
    for (int i = 0; next_unit(i, vcu, G, bh, qb); ++i) attn_unit<DQK>(tid, lds, A, bh >> 3, bh & 7, qb);
#else
    (void)lds; attn_phase_ref<DQK>(tid, A, vcu, G);
#endif
}
}


struct Args { const float* in[22]; float* out; unsigned char* ws; int ph_lo, ph_hi; };
struct Frame {
    LAS unsigned char* lds; volatile LAS unsigned* MISC; unsigned* ctl;
    int tid, lane, wave, vcu, G;
    unsigned char* ws; float* OUT;
};

__device__ __forceinline__ void p0_phase(Frame& F, const float* c, const float* w_ada, const float* b_ada) {
    LAS float* cs = (LAS float*)F.lds;
    LAS float* red = (LAS float*)(F.lds + 32768);
    for (int i = F.tid; i < NB * D; i += NTHREADS) { const float v = c[i]; cs[i] = v / (1.f + __expf(-v)); }
    __syncthreads();
    float* mod = (float*)(F.ws + WS_MOD);
    const int kq = F.wave, col = F.lane;
    for (int item = F.vcu; item < NL * 6 * D / 64; item += F.G) {
        const int l = item / (6 * D / 64), n0 = (item % (6 * D / 64)) * 64;
        const float* w = w_ada + (size_t)l * D * 6 * D + n0 + col;
        float acc[NB];
#pragma unroll
        for (int b = 0; b < NB; ++b) acc[b] = 0.f;
#pragma unroll 8
        for (int k = kq * 128; k < kq * 128 + 128; ++k) { const float wv = w[(size_t)k * 6 * D];
#pragma unroll
            for (int b = 0; b < NB; ++b) acc[b] += cs[b * D + k] * wv; }
#pragma unroll
        for (int b = 0; b < NB; ++b) red[(kq * NB + b) * 64 + col] = acc[b];
        __syncthreads();
        { const int b = F.wave; float s = 0.f;
#pragma unroll
          for (int q = 0; q < 8; ++q) s += red[(q * NB + b) * 64 + col];
          mod[((size_t)l * NB + b) * 6 * D + n0 + col] = s + b_ada[(size_t)l * 6 * D + n0 + col]; }
        __syncthreads();
    }
    float* cosA = (float*)(F.ws + WS_COSA); float* sinA = (float*)(F.ws + WS_SINA); float* cosB = (float*)(F.ws + WS_COSB); float* sinB = (float*)(F.ws + WS_SINB);
    for (int idx = F.vcu * NTHREADS + F.tid; idx < S * 48; idx += F.G * NTHREADS) {
        const int s = idx / 48, i = idx % 48; const float row = (float)(s >> 6), col2 = (float)(s & 63);
        if (i < 32) { const int j = i & 15; const float a = (i < 16 ? row : col2) * (1.0f / powf(10000.0f, (float)j / 16.0f)); cosA[s * 32 + i] = cosf(a); sinA[s * 32 + i] = sinf(a); }
        else { const int ii = i - 32, j = ii & 7; const float a = (ii < 8 ? row : col2) * (1.0f / powf(10000.0f, (float)j / 8.0f)); cosB[s * 16 + ii] = cosf(a); sinB[s * 16 + ii] = sinf(a); }
    }
}

template <class SrcFn>
__device__ __forceinline__ void cvt_item(const float* W, int K, int Nsrc, const float* kg, bf16_t* WT, LAS float* scr, int item, int nblk, int lane, const SrcFn& src) {
    const int kb = item / nblk, nb = item % nblk, k0 = 64 * kb, n0 = 32 * nb;
    const int sc = src(n0 + (lane & 31));
#pragma unroll
    for (int i = 0; i < 32; ++i) { const int kk = 2 * i + (lane >> 5); float v = sc >= 0 ? W[(size_t)(k0 + kk) * Nsrc + sc] : 0.f; if (kg) v *= kg[k0 + kk]; scr[kk * 33 + (lane & 31)] = v; }
    LDS_WAIT(); asm volatile("" ::: "memory");
    const int c = lane & 7;
#pragma unroll
    for (int j = 0; j < 4; ++j) { const int n = (lane >> 3) + 8 * j; const LAS float* s = scr + (8 * c) * 33 + n;
        u32x4 o; o.x = cvt_pk_bf16(s[0 * 33], s[1 * 33]); o.y = cvt_pk_bf16(s[2 * 33], s[3 * 33]); o.z = cvt_pk_bf16(s[4 * 33], s[5 * 33]); o.w = cvt_pk_bf16(s[6 * 33], s[7 * 33]);
        *(u32x4*)(WT + (size_t)(n0 + n) * K + k0 + 8 * c) = o; }
    LDS_WAIT(); asm volatile("" ::: "memory");
}
struct SrcId { __device__ int operator()(int n) const { return n; } };
struct SrcIn { __device__ int operator()(int n) const { return gp::src_col_in(n); } };
typedef __attribute__((address_space(4))) const Args CArgsW;
__device__ __forceinline__ void convert_weights(Frame& F, CArgsW* a, int l) {
    LAS float* scr = (LAS float*)(F.lds + F.wave * 16384);
    const int gw = F.vcu * NWAVES + F.wave, NGW = F.G * NWAVES;
    const float* w_in = ((const float*)(GAS const float*)a->in[5]) + (size_t)l * D * INC; const float* w_q_b = ((const float*)(GAS const float*)a->in[10]) + (size_t)l * 384 * 768; const float* w_kv_b = ((const float*)(GAS const float*)a->in[11]) + (size_t)l * 256 * 1024;
    const float* w_pa = ((const float*)(GAS const float*)a->in[12]) + (size_t)l * 512 * D; const float* w_pb = ((const float*)(GAS const float*)a->in[13]) + (size_t)l * 512 * D; const float* w_o = ((const float*)(GAS const float*)a->in[14]) + (size_t)l * D * D;
    const float* w1 = ((const float*)(GAS const float*)a->in[18]) + (size_t)l * NE * D * FF; const float* w3 = ((const float*)(GAS const float*)a->in[19]) + (size_t)l * NE * D * FF; const float* w2 = ((const float*)(GAS const float*)a->in[20]) + (size_t)l * NE * FF * D;
    const float* gqa = ((const float*)(GAS const float*)a->in[8]) + l * 384; const float* gkv = ((const float*)(GAS const float*)a->in[9]) + l * 256;
    bf16_t* Win = (bf16_t*)(F.ws + WS_WIN); bf16_t* Wqb = (bf16_t*)(F.ws + WS_WQB); bf16_t* Wkvb = (bf16_t*)(F.ws + WS_WKVB); bf16_t* Wpa = (bf16_t*)(F.ws + WS_WPA); bf16_t* Wpb = (bf16_t*)(F.ws + WS_WPB);
    bf16_t* Wo = (bf16_t*)(F.ws + WS_WO); bf16_t* W13 = (bf16_t*)(F.ws + WS_W13); bf16_t* W2 = (bf16_t*)(F.ws + WS_W2);
    constexpr int I_IN = (D / 64) * (NIN / 32), I_QB = (384 / 64) * (768 / 32), I_KVB = (256 / 64) * (1024 / 32), I_P = (512 / 64) * (D / 32), I_O = (D / 64) * (D / 32);
    constexpr int I_13 = (D / 64) * (1024 / 32), I_2 = (FF / 64) * (D / 32);
    constexpr int NITEMS = I_IN + I_QB + I_KVB + 2 * I_P + I_O + NE * (I_13 + I_2);
    for (int it = gw; it < NITEMS; it += NGW) {
        int r = it;
        if (r < I_IN) { cvt_item(w_in, D, INC, nullptr, Win, scr, r, NIN / 32, F.lane, SrcIn()); continue; } r -= I_IN;
        if (r < I_QB) { cvt_item(w_q_b, 384, 768, gqa, Wqb, scr, r, 768 / 32, F.lane, SrcId()); continue; } r -= I_QB;
        if (r < I_KVB) { cvt_item(w_kv_b, 256, 1024, gkv, Wkvb, scr, r, 1024 / 32, F.lane, SrcId()); continue; } r -= I_KVB;
        if (r < I_P) { cvt_item(w_pa, 512, D, nullptr, Wpa, scr, r, D / 32, F.lane, SrcId()); continue; } r -= I_P;
        if (r < I_P) { cvt_item(w_pb, 512, D, nullptr, Wpb, scr, r, D / 32, F.lane, SrcId()); continue; } r -= I_P;
        if (r < I_O) { cvt_item(w_o, D, D, nullptr, Wo, scr, r, D / 32, F.lane, SrcId()); continue; } r -= I_O;
        if (r < NE * I_13) { const int e = r / I_13, q = r % I_13, nb = q % 32;
            const float* src = ((nb & 7) < 4 ? w1 : w3) + (size_t)e * D * FF; const int cb = (nb >> 3) * 128 + (nb & 3) * 32;
            struct SrcOff { int n0, cb; __device__ int operator()(int n) const { return cb + (n - n0); } } so{nb * 32, cb};
            cvt_item(src, D, FF, nullptr, W13 + (size_t)e * 1024 * D, scr, q, 32, F.lane, so); continue; } r -= NE * I_13;
        { const int e = r / I_2, q = r % I_2; cvt_item(w2 + (size_t)e * FF * D, FF, D, nullptr, W2 + (size_t)e * D * FF, scr, q, D / 32, F.lane, SrcId()); }
    }
}

template <int MODE>
__device__ __forceinline__ void row_phase(Frame& F, const float* xin, const float* g2prev, const float* gain, const float* modl, int sh_off, int sc_off, bf16_t* H, bf16_t* XB, float* OUT) {
    constexpr int RB = 4;
    const int gw = F.vcu * NWAVES + F.wave, NGW = F.G * NWAVES;
    const bf16_t* Y2 = (const bf16_t*)(F.ws + WS_Y2);
    for (int m0 = gw; m0 < T; m0 += RB * NGW) {
        f32x4 v[RB][4]; float ss[RB];
        if (MODE == 0) {
#pragma unroll
            for (int r = 0; r < RB; ++r)
#pragma unroll
                for (int j = 0; j < 4; ++j) v[r][j] = *(const f32x4*)(xin + (size_t)(m0 + r * NGW) * D + 4 * F.lane + 256 * j);
        } else {
            unsigned ya[RB][4], yb[RB][4]; f32x4 g[RB][4];
#pragma unroll
            for (int r = 0; r < RB; ++r)
#pragma unroll
                for (int j = 0; j < 4; ++j) { const int m = m0 + r * NGW, c = 4 * F.lane + 256 * j;
                    { const u32x2 xb = *(const u32x2*)(XB + (size_t)m * D + c); v[r][j] = (f32x4){bf2f(xb.x & 0xffffu), bf2f(xb.x >> 16), bf2f(xb.y & 0xffffu), bf2f(xb.y >> 16)}; } ya[r][j] = *(const unsigned*)((const unsigned char*)Y2 + (size_t)(2 * m) * D + c); yb[r][j] = *(const unsigned*)((const unsigned char*)Y2 + (size_t)(2 * m + 1) * D + c);
                    g[r][j] = *(const f32x4*)(g2prev + (size_t)(m >> 12) * 6 * D + 5 * D + c); }
#pragma unroll
            for (int r = 0; r < RB; ++r)
#pragma unroll
                for (int j = 0; j < 4; ++j) { const f32x2 a0 = __builtin_amdgcn_cvt_pk_f32_fp8((int)ya[r][j], false), a1 = __builtin_amdgcn_cvt_pk_f32_fp8((int)ya[r][j], true), b0 = __builtin_amdgcn_cvt_pk_f32_fp8((int)yb[r][j], false), b1 = __builtin_amdgcn_cvt_pk_f32_fp8((int)yb[r][j], true);
                    const f32x4 y = (f32x4){a0[0] + b0[0], a0[1] + b0[1], a1[0] + b1[0], a1[1] + b1[1]} * 0.0625f;
                    v[r][j] += g[r][j] * y; }
        }
#pragma unroll
        for (int r = 0; r < RB; ++r) { ss[r] = (gp::dot4(v[r][0]) + gp::dot4(v[r][1])) + (gp::dot4(v[r][2]) + gp::dot4(v[r][3])); }
#pragma unroll
        for (int o = 1; o < 64; o <<= 1)
#pragma unroll
            for (int r = 0; r < RB; ++r) ss[r] += __shfl_xor(ss[r], o);
#pragma unroll
        for (int r = 0; r < RB; ++r) {
            const int m = m0 + r * NGW, b = m >> 12; const float rstd = rsqrtf(ss[r] * (1.f / D) + EPS);
#pragma unroll
            for (int j = 0; j < 4; ++j) {
                const int c = 4 * F.lane + 256 * j; const f32x4 gn = *(const f32x4*)(gain + c);
                if (MODE == 2) { *(f32x4*)(OUT + (size_t)m * D + c) = v[r][j] * rstd * gn; }
                else {
                    { u32x2 xw; xw.x = cvt_pk_bf16(v[r][j][0], v[r][j][1]); xw.y = cvt_pk_bf16(v[r][j][2], v[r][j][3]); st8((XB + (size_t)m * D + c), xw); }
                    const f32x4 sc = *(const f32x4*)(modl + (size_t)b * 6 * D + sc_off + c), sh = *(const f32x4*)(modl + (size_t)b * 6 * D + sh_off + c);
                    const f32x4 hv = v[r][j] * rstd * gn * (1.f + sc) + sh;
                    u32x2 w; w.x = cvt_pk_bf16(hv[0], hv[1]); w.y = cvt_pk_bf16(hv[2], hv[3]);
                    st8((H + (size_t)m * D + c), w);
                }
            }
        }
    }
}

__device__ __forceinline__ void t2_phase(Frame& F, const float* gain, const float* modl, const float* w_router, const float* rbias, int l, bool record) {
    LAS f32x4* wl = (LAS f32x4*)F.lds;
    LAS int* rec = (LAS int*)(F.lds + 65536);
    LAS float* recw = (LAS float*)(F.lds + 65536 + 2048);
    LAS int* lcnt = (LAS int*)(F.lds + 65536 + 4096);
    for (int idx = F.tid; idx < 4096; idx += NTHREADS) {
        const int lane = idx & 63, c = (idx >> 6) & 3, i = (idx >> 8) & 3, j = idx >> 10; const int k = 4 * lane + 256 * j + i;
        wl[idx] = *(const f32x4*)(w_router + (size_t)k * NE + 4 * c);
    }
    if (F.tid < 32) lcnt[F.tid] = 0;
    __syncthreads();
    constexpr int RB = 4;
    const int gw = F.vcu * NWAVES + F.wave, NGW = F.G * NWAVES;
    bf16_t* H = (bf16_t*)(F.ws + WS_H); const bf16_t* XB = (const bf16_t*)(F.ws + WS_XB);
    const int lane = F.lane, myrow = lane >> 4, mye = lane & 15;
    int it = 0;
    for (int m0 = gw; m0 < T; m0 += RB * NGW, ++it) {
        f32x4 v[RB][4]; float ss[RB];
#pragma unroll
        for (int r = 0; r < RB; ++r)
#pragma unroll
            for (int j = 0; j < 4; ++j) { const u32x2 xb = *(const u32x2*)(XB + (size_t)(m0 + r * NGW) * D + 4 * lane + 256 * j); v[r][j] = (f32x4){bf2f(xb.x & 0xffffu), bf2f(xb.x >> 16), bf2f(xb.y & 0xffffu), bf2f(xb.y >> 16)}; }
#pragma unroll
        for (int r = 0; r < RB; ++r) ss[r] = (gp::dot4(v[r][0]) + gp::dot4(v[r][1])) + (gp::dot4(v[r][2]) + gp::dot4(v[r][3]));
#pragma unroll
        for (int o = 1; o < 64; o <<= 1)
#pragma unroll
            for (int r = 0; r < RB; ++r) ss[r] += __shfl_xor(ss[r], o);
        float acc[RB * NE];
#pragma unroll
        for (int q = 0; q < RB * NE; ++q) acc[q] = 0.f;
#pragma unroll
        for (int j = 0; j < 4; ++j) {
            const int c = 4 * lane + 256 * j; const f32x4 gn = *(const f32x4*)(gain + c);
#pragma unroll
            for (int r = 0; r < RB; ++r) {
                const int m = m0 + r * NGW, b = m >> 12; const float rstd = rsqrtf(ss[r] * (1.f / D) + EPS);
                const f32x4 sc = *(const f32x4*)(modl + (size_t)b * 6 * D + 4 * D + c), sh = *(const f32x4*)(modl + (size_t)b * 6 * D + 3 * D + c);
                v[r][j] = v[r][j] * rstd * gn * (1.f + sc) + sh;
                u32x2 w; w.x = cvt_pk_bf16(v[r][j][0], v[r][j][1]); w.y = cvt_pk_bf16(v[r][j][2], v[r][j][3]);
                st8((H + (size_t)m * D + c), w);
            }
#pragma unroll
            for (int i = 0; i < 4; ++i)
#pragma unroll
                for (int c4 = 0; c4 < 4; ++c4) { const f32x4 wv = wl[((j * 4 + i) * 4 + c4) * 64 + lane];
#pragma unroll
                    for (int r = 0; r < RB; ++r) { const float hv = v[r][j][i];
                        acc[r * NE + 4 * c4 + 0] += hv * wv[0]; acc[r * NE + 4 * c4 + 1] += hv * wv[1]; acc[r * NE + 4 * c4 + 2] += hv * wv[2]; acc[r * NE + 4 * c4 + 3] += hv * wv[3]; } }
        }
#pragma unroll
        for (int sft = 32; sft >= 1; sft >>= 1) {
            const bool up = (lane & sft) != 0;
#pragma unroll
            for (int k = 0; k < sft; ++k) { const float a = acc[k], b = acc[k + sft]; const float keep = up ? b : a, send = up ? a : b; acc[k] = keep + __shfl_xor(send, sft); }
        }
        const float logit = acc[0];
        const float score = 1.f / (1.f + expf(-logit));
        float scv[NE], bi[NE];
#pragma unroll
        for (int e = 0; e < NE; ++e) { scv[e] = __shfl(score, (lane & 48) | e); bi[e] = scv[e] + rbias[e]; }
        int gsel = 0; float gbest = -INFINITY;
#pragma unroll
        for (int g = 0; g < 4; ++g) { float m1 = -INFINITY, m2 = -INFINITY;
#pragma unroll
            for (int j = 0; j < 4; ++j) { const float x = bi[g * 4 + j]; if (x > m1) { m2 = m1; m1 = x; } else if (x > m2) m2 = x; }
            const float gs = m1 + m2; if (gs > gbest) { gbest = gs; gsel = g; } }
        int e1 = -1, e2 = -1; float b1 = -INFINITY, b2 = -INFINITY, s1 = 0.f, s2 = 0.f;
#pragma unroll
        for (int j = 0; j < 4; ++j) { float x = -INFINITY, sx = 0.f;
#pragma unroll
            for (int g = 0; g < 4; ++g) if (g == gsel) { x = bi[g * 4 + j]; sx = scv[g * 4 + j]; }
            const int e = gsel * 4 + j;
            if (x > b1) { b2 = b1; e2 = e1; s2 = s1; b1 = x; e1 = e; s1 = sx; } else if (x > b2) { b2 = x; e2 = e; s2 = sx; } }
        if (mye == 0) {
            const float inv = 1.f / (s1 + s2); const int slot = (it * RB + myrow) * NWAVES + F.wave;
            rec[slot * 4 + 0] = e1; rec[slot * 4 + 1] = e2;
            rec[slot * 4 + 2] = __hip_atomic_fetch_add(&lcnt[e1], 1, __ATOMIC_RELAXED, __HIP_MEMORY_SCOPE_WORKGROUP);
            rec[slot * 4 + 3] = __hip_atomic_fetch_add(&lcnt[e2], 1, __ATOMIC_RELAXED, __HIP_MEMORY_SCOPE_WORKGROUP);
            recw[slot * 2 + 0] = s1 * inv; recw[slot * 2 + 1] = s2 * inv;
        }
    }
    __syncthreads();
    if (!record) return;
    if (F.tid < NE) lcnt[16 + F.tid] = (int)__hip_atomic_fetch_add(F.ctl + CW_CNT + (l * NE + F.tid) * 64, (unsigned)lcnt[F.tid], __ATOMIC_RELAXED, __HIP_MEMORY_SCOPE_AGENT);
    __syncthreads();
    unsigned* list = (unsigned*)(F.ws + WS_LIST); float* gwb = (float*)(F.ws + WS_GW);
    const int nrows = it * RB;
    for (int s = F.tid; s < nrows * NWAVES; s += NTHREADS) {
        const int i2 = s / NWAVES, w = s % NWAVES; const int m = F.vcu * NWAVES + w + i2 * NGW;
        const int e1 = rec[s * 4 + 0], e2 = rec[s * 4 + 1];
        list[(size_t)e1 * T + lcnt[16 + e1] + rec[s * 4 + 2]] = (unsigned)(2 * m); list[(size_t)e2 * T + lcnt[16 + e2] + rec[s * 4 + 3]] = (unsigned)(2 * m + 1);
        gwb[2 * m] = recw[s * 2]; gwb[2 * m + 1] = recw[s * 2 + 1];
    }
}
__device__ __forceinline__ const LAS int* moe_table(Frame& F, int l) {
    LAS int* tab = (LAS int*)(F.lds + MISC_OFF + 1024);
    __syncthreads();
    if (F.tid == 0) { int acc = 0;
        for (int e = 0; e < NE; ++e) { const int c = (int)__hip_atomic_load(F.ctl + CW_CNT + (l * NE + e) * 64, __ATOMIC_RELAXED, __HIP_MEMORY_SCOPE_AGENT); tab[e] = acc; tab[32 + e] = c; acc += (c + 255) >> 8; }
        tab[16] = acc; }
    __syncthreads();
    return tab;
}

typedef __attribute__((address_space(4))) const Args CArgs;
#define LAUNDER_GP(T_, p) do { GAS T_* _t = (GAS T_*)(p); asm volatile("" : "+s"(_t)); (p) = (T_*)_t; } while (0)
#define PH_BEGIN() LAUNDER_V(F.tid); F.lane = F.tid & 63; LAUNDER_GP(unsigned, F.ctl); LAUNDER_GP(float, F.OUT); LAUNDER_GP(unsigned char, F.ws); GAS unsigned char* ws = (GAS unsigned char*)F.ws; CArgs* ka = (CArgs*)__builtin_amdgcn_kernarg_segment_ptr(); LAUNDER_S(ka); \
    float* mod = WSP(float, WS_MOD); (void)mod; (void)ka
#define WSP(T_, off) ((T_*)(GAS T_*)(ws + (off)))
#define KIN(i) ((const float*)(GAS const float*)ka->in[i])
__global__ void __launch_bounds__(NTHREADS, 2) fwd_kernel(Args args) {
    extern __shared__ __attribute__((aligned(16))) unsigned char lds_raw[];
    Frame F;
    F.lds = (LAS unsigned char*)lds_raw; F.MISC = (volatile LAS unsigned*)(F.lds + MISC_OFF);
    F.tid = threadIdx.x; F.lane = F.tid & 63; F.wave = __builtin_amdgcn_readfirstlane(F.tid >> 6);
    F.G = gridDim.x; { const int bx = blockIdx.x; F.vcu = (F.G % 8 == 0) ? (bx % 8) * (F.G / 8) + bx / 8 : bx; }
    F.ws = (unsigned char*)(GAS unsigned char*)args.ws; F.ctl = (unsigned*)(GAS unsigned*)(args.ws + WS_CTL); F.OUT = (float*)(GAS float*)args.out;
    if (F.tid < 64) F.MISC[F.tid] = 0u;
    __syncthreads();
    XcdBarrier bar; bar.bar = F.ctl + CW_BAR; bar.x = 0; bar.st = nullptr;
    if (!N_LAUNCH_MODE) bar = xcd_barrier_post(F.ctl + CW_BAR, F.MISC + 8);
    const int lo = args.ph_lo, hi = args.ph_hi;
#define IN(k) (lo <= (k) && (k) < hi)
#define SEAM(k) do { if ((k) + 1 < hi) { if (!N_LAUNCH_MODE) xcd_barrier(bar); } } while (0)
    const int cidx = (int)blockIdx.x;

    if (IN(0)) { PH_BEGIN(); p0_phase(F, KIN(1), KIN(2), KIN(3)); SEAM(0); }
    for (int l = 0; l < NL; ++l) {
        const int pb = 1 + 9 * l;
        if (IN(pb + 0)) {
            PH_BEGIN();
            for (int rep = 0; rep < ((PROBE_DUP & 8) ? 2 : 1); ++rep) { LAUNDER_V(F.tid); F.lane = F.tid & 63; convert_weights(F, ka, l); }
            if (l == 0) row_phase<0>(F, KIN(0), nullptr, KIN(4) + l * D, mod + (size_t)l * NB * 6 * D, 0, D, WSP(bf16_t, WS_H), WSP(bf16_t, WS_XB), nullptr);
            else row_phase<1>(F, nullptr, mod + (size_t)(l - 1) * NB * 6 * D, KIN(4) + l * D, mod + (size_t)l * NB * 6 * D, 0, D, WSP(bf16_t, WS_H), WSP(bf16_t, WS_XB), nullptr);
            SEAM(pb + 0);
        }
        if (IN(pb + 1)) {
            PH_BEGIN();
            gp::Gemm g{WSP(bf16_t, WS_H), WSP(const bf16_t, WS_WIN), D, 0, nullptr}; gp::DenseOrder So; So.init(T, NIN, F.G, cidx);
            gp::EpiIn E{WSP(bf16_t, WS_QA), WSP(bf16_t, WS_KA), WSP(bf16_t, WS_VA), WSP(bf16_t, WS_QLAT), WSP(bf16_t, WS_KVLAT), WSP(bf16_t, WS_KB), WSP(bf16_t, WS_SA), WSP(bf16_t, WS_SB), WSP(float, WS_SSQ), WSP(float, WS_SSKV),
                        KIN(6) + l * 64, KIN(7) + l * 64, WSP(const float, WS_COSA), WSP(const float, WS_SINA), WSP(const float, WS_COSB), WSP(const float, WS_SINB)};
            if (PROBE_DUP & 128) { gp::EpiNull En; gp::gemm_phase<gp::EpiNull, gp::DenseOrder>(F.tid, F.lds, g, So, En); LAUNDER_V(F.tid); }
            gp::gemm_phase<gp::EpiIn, gp::DenseOrder>(F.tid, F.lds, g, So, E); if (PROBE_DUP & (2 | 512)) { LAUNDER_V(F.tid); gp::gemm_phase<gp::EpiIn, gp::DenseOrder>(F.tid, F.lds, g, So, E); }
            SEAM(pb + 1);
        }
        if (IN(pb + 2)) {
            { PH_BEGIN(); gp::Gemm g{WSP(bf16_t, WS_QLAT), WSP(const bf16_t, WS_WQB), 384, 0, nullptr}; gp::DenseOrder So; So.init(T, 768, F.G, cidx);
              gp::EpiQb E{WSP(bf16_t, WS_QB), WSP(const float, WS_SSQ), WSP(const float, WS_COSB), WSP(const float, WS_SINB)}; gp::gemm_phase<gp::EpiQb, gp::DenseOrder>(F.tid, F.lds, g, So, E); if (PROBE_DUP & 2) { LAUNDER_V(F.tid); gp::gemm_phase<gp::EpiQb, gp::DenseOrder>(F.tid, F.lds, g, So, E); } }
            { PH_BEGIN(); gp::Gemm g{WSP(bf16_t, WS_KVLAT), WSP(const bf16_t, WS_WKVB), 256, 0, nullptr}; gp::DenseOrder So; So.init(T, 1024, F.G, F.G - 1 - cidx);
              gp::EpiKvb E{WSP(bf16_t, WS_KB), WSP(bf16_t, WS_VB), WSP(const float, WS_SSKV)}; gp::gemm_phase<gp::EpiKvb, gp::DenseOrder>(F.tid, F.lds, g, So, E); if (PROBE_DUP & 2) { LAUNDER_V(F.tid); gp::gemm_phase<gp::EpiKvb, gp::DenseOrder>(F.tid, F.lds, g, So, E); } }
            if (PROBE_DUP & 1) { PH_BEGIN(); const at::Tensors A{WSP(bf16_t, WS_QA), 512, WSP(bf16_t, WS_KA), 128, WSP(bf16_t, WS_VA), 128, WSP(bf16_t, WS_OB), 512, 4}; at::attn_phase<64>(F.tid, F.lds, A, F.vcu, F.G); }
            { PH_BEGIN(); const at::Tensors A{WSP(bf16_t, WS_QA), 512, WSP(bf16_t, WS_KA), 128, WSP(bf16_t, WS_VA), 128, WSP(bf16_t, WS_QA), 512, 4}; at::attn_phase<64>(F.tid, F.lds, A, F.vcu, F.G); }
            SEAM(pb + 2);
        }
        if (IN(pb + 3)) {
            PH_BEGIN();
            const at::Tensors A{WSP(bf16_t, WS_QB), 768, WSP(bf16_t, WS_KB), 768, WSP(bf16_t, WS_VB), 512, WSP(bf16_t, WS_OB), 512, 1}; for (int rep = 0; rep < ((PROBE_DUP & 1) ? 2 : 1); ++rep) at::attn_phase<96>(F.tid, F.lds, A, F.vcu, F.G);
            SEAM(pb + 3);
        }
        if (IN(pb + 4)) {
            PH_BEGIN();
            gp::Gemm g{WSP(bf16_t, WS_QA), WSP(const bf16_t, WS_WPA), 512, (size_t)(WS_WPB - WS_WPA) / 2, nullptr, (size_t)(WS_OB - WS_QA) / 2}; gp::PairOrder So; So.init(T, D, F.G, cidx);
            gp::EpiProjP E{WSP(bf16_t, WS_H), WSP(const unsigned char, WS_SA), WSP(const unsigned char, WS_SB)};
            gp::gemm_phase<gp::EpiProjP, gp::PairOrder>(F.tid, F.lds, g, So, E);
            if (PROBE_DUP & (2 | 1024)) { LAUNDER_V(F.tid); gp::gemm_phase<gp::EpiProjP, gp::PairOrder>(F.tid, F.lds, g, So, E); }
            SEAM(pb + 4);
        }
        if (IN(pb + 5)) {
            PH_BEGIN();
            gp::Gemm g{WSP(bf16_t, WS_H), WSP(const bf16_t, WS_WO), D, 0, nullptr}; gp::DenseOrder So; So.init(T, D, F.G, cidx);
            gp::EpiWo E{WSP(const bf16_t, WS_XB), mod + (size_t)l * NB * 6 * D, WSP(bf16_t, WS_XB)}; gp::gemm_phase<gp::EpiWo, gp::DenseOrder>(F.tid, F.lds, g, So, E);
            SEAM(pb + 5);
        }
        if (IN(pb + 6)) {
            PH_BEGIN();
            if (PROBE_DUP & 16) { t2_phase(F, KIN(15) + l * D, mod + (size_t)l * NB * 6 * D, KIN(16), KIN(17), l, false); LAUNDER_V(F.tid); F.lane = F.tid & 63; __syncthreads(); }
            t2_phase(F, KIN(15) + l * D, mod + (size_t)l * NB * 6 * D, KIN(16), KIN(17), l, true);
            SEAM(pb + 6);
        }
        if (IN(pb + 7)) {
            PH_BEGIN();
            const LAS int* tab = moe_table(F, l);
            gp::Gemm g{WSP(bf16_t, WS_H), WSP(const bf16_t, WS_W13), D, (size_t)1024 * D, WSP(const unsigned, WS_LIST)}; gp::MoeOrder So; So.init(tab, F.G, cidx);
            if (PROBE_DUP & 256) { gp::EpiNull En; gp::gemm_phase<gp::EpiNull, gp::MoeOrder, true>(F.tid, F.lds, g, So, En); LAUNDER_V(F.tid); }
            gp::EpiUp E{WSP(bf16_t, WS_ACT)}; gp::gemm_phase<gp::EpiUp, gp::MoeOrder, true>(F.tid, F.lds, g, So, E); if (PROBE_DUP & 4) { LAUNDER_V(F.tid); gp::gemm_phase<gp::EpiUp, gp::MoeOrder, true>(F.tid, F.lds, g, So, E); }
            SEAM(pb + 7);
        }
        if (IN(pb + 8)) {
            PH_BEGIN();
            const LAS int* tab = moe_table(F, l);
            gp::Gemm g{WSP(bf16_t, WS_ACT), WSP(const bf16_t, WS_W2), FF, (size_t)D * FF, nullptr}; gp::MoeOrder So; So.init(tab, F.G, cidx);
            gp::EpiDown E{WSP(bf16_t, WS_Y2), WSP(const unsigned, WS_LIST), WSP(const float, WS_GW)}; gp::gemm_phase<gp::EpiDown, gp::MoeOrder, false>(F.tid, F.lds, g, So, E); if (PROBE_DUP & 4) { LAUNDER_V(F.tid); gp::gemm_phase<gp::EpiDown, gp::MoeOrder, false>(F.tid, F.lds, g, So, E); }
            SEAM(pb + 8);
        }
    }
    if (IN(NPHASE - 1)) { PH_BEGIN(); row_phase<2>(F, nullptr, mod + (size_t)(NL - 1) * NB * 6 * D, KIN(21), nullptr, 0, 0, nullptr, WSP(bf16_t, WS_XB), F.OUT); }
#undef IN
#undef SEAM
}

extern "C" void kernel_launch(void* const* d_in, const int* in_sizes, int n_in, void* d_out, int out_size, void* d_ws, size_t ws_size, hipStream_t stream) {
    static int grid = 0;
    if (grid == 0) {
        if (n_in != 22 || out_size != T * D || ws_size < WS_END) { fprintf(stderr, "kernel_launch: unexpected problem (n_in %d out %d ws %zu)\n", n_in, out_size, ws_size); grid = -1; return; }
        int dev = 0, cus = 0, per_cu = 0;
        if (hipGetDevice(&dev) != hipSuccess || hipDeviceGetAttribute(&cus, hipDeviceAttributeMultiprocessorCount, dev) != hipSuccess) { grid = -1; return; }
        if (hipFuncSetAttribute((const void*)fwd_kernel, hipFuncAttributeMaxDynamicSharedMemorySize, LDS_BYTES) != hipSuccess) { grid = -1; return; }
        if (hipOccupancyMaxActiveBlocksPerMultiprocessor(&per_cu, (const void*)fwd_kernel, NTHREADS, LDS_BYTES) != hipSuccess || per_cu < 1) { fprintf(stderr, "kernel_launch: occupancy query says %d\n", per_cu); }
        (void)hipGetLastError();
        grid = cus;
        if (T % (grid * NWAVES * 4) != 0) { fprintf(stderr, "kernel_launch: grid %d does not divide the row phases\n", grid); grid = -1; return; }
    }
    if (grid < 0) return;
    (void)hipMemsetAsync((char*)d_ws + WS_CTL, 0, CTL_BYTES, stream);
    Args a{};
    for (int i = 0; i < 22; ++i) a.in[i] = (const float*)d_in[i];
    a.out = (float*)d_out; a.ws = (unsigned char*)d_ws;
#if N_LAUNCH_MODE
    for (int p = 0; p < NPHASE; ++p) { a.ph_lo = p; a.ph_hi = p + 1; hipLaunchKernelGGL(fwd_kernel, dim3(grid), dim3(NTHREADS), LDS_BYTES, stream, a); }
#else
    a.ph_lo = 0; a.ph_hi = NPHASE;
    hipLaunchKernelGGL(fwd_kernel, dim3(grid), dim3(NTHREADS), LDS_BYTES, stream, a);
#endif
}
```

```cpp
#include <hip/hip_runtime.h>
#include <stdint.h>
#include <stdio.h>
#include <math.h>

#ifndef FAST_GEMM
#define FAST_GEMM 1
#endif
#ifndef FAST_ATTN
#define FAST_ATTN 1
#endif
#ifndef PROBE_DUP
#define PROBE_DUP 0
#endif
#ifndef PROBE_ATT
#define PROBE_ATT 0
#endif
#ifndef ATT_REGSTAGE
#define ATT_REGSTAGE 0
#endif
#ifndef WT_STORES
#define WT_STORES 0
#endif
#ifndef N_LAUNCH_MODE
#define N_LAUNCH_MODE 0
#endif

#define LAS __attribute__((address_space(3)))
#define GAS __attribute__((address_space(1)))
typedef unsigned short bf16_t;
typedef short bf16x8 __attribute__((ext_vector_type(8)));
typedef float f32x4 __attribute__((ext_vector_type(4)));
typedef float f32x2 __attribute__((ext_vector_type(2)));
typedef float f32x16 __attribute__((ext_vector_type(16)));
typedef unsigned u32x4 __attribute__((ext_vector_type(4)));
typedef unsigned u32x2 __attribute__((ext_vector_type(2)));
typedef GAS unsigned gu32;

constexpr int D = 1024, NB = 8, S = 4096, T = NB * S, NL = 4, INC = 3488, NIN = 3584, NE = 16, FF = 512;
constexpr float EPS = 1e-6f, LOG2E = 1.4426950408889634f;
constexpr float QSCALE_A = 0.125f * LOG2E, QSCALE_B = 0.10206207261596577f * LOG2E;
constexpr int NWAVES = 8, NTHREADS = 512;
constexpr int NPHASE = 2 + 9 * NL;

constexpr size_t MiB = 1u << 20;
constexpr size_t WS_CTL = 0, CTL_BYTES = 1 * MiB;
constexpr size_t WS_MOD = 1 * MiB;
constexpr size_t WS_COSA = 2 * MiB, WS_SINA = WS_COSA + 512 * 1024, WS_COSB = 3 * MiB, WS_SINB = WS_COSB + 256 * 1024;
constexpr size_t WS_SSQ = 4 * MiB, WS_SSKV = 5 * MiB;
constexpr size_t WS_GW = 6 * MiB;
constexpr size_t WS_LIST = 7 * MiB;
constexpr size_t WS_WIN = 10 * MiB, WS_WQB = 17 * MiB, WS_WKVB = 18 * MiB, WS_WPA = 19 * MiB, WS_WPB = 20 * MiB, WS_WO = 21 * MiB, WS_W13 = 23 * MiB, WS_W2 = 55 * MiB;
constexpr size_t WS_H = 72 * MiB;
constexpr size_t WS_QA = 136 * MiB, WS_KA = 168 * MiB, WS_VA = 176 * MiB, WS_QLAT = 184 * MiB, WS_KVLAT = 208 * MiB;
constexpr size_t WS_KB = 224 * MiB, WS_VB = 272 * MiB, WS_QB = 304 * MiB, WS_OB = 352 * MiB, WS_SA = 384 * MiB, WS_SB = 448 * MiB, WS_XB = 512 * MiB, WS_END = 576 * MiB;
constexpr size_t WS_ACT = 136 * MiB, WS_Y2 = 208 * MiB;
constexpr int ACT_ROWS = 2 * T + NE * 256;
static_assert(WS_ACT + (size_t)ACT_ROWS * FF * 2 <= WS_Y2 && WS_Y2 + (size_t)2 * T * D * 2 <= WS_XB, "moe overlay");
constexpr int CW_BAR = 4096;
constexpr int CW_CNT = 16384;

constexpr int RING_BYTES = 131072, MISC_OFF = RING_BYTES, LDS_BYTES = 147456;

__device__ __forceinline__ float bf2f(unsigned v) { return __uint_as_float(v << 16); }
typedef __bf16 bf16x2_t __attribute__((ext_vector_type(2)));
__device__ __forceinline__ unsigned cvt_pk_bf16(float lo, float hi) { f32x2 v = {lo, hi}; bf16x2_t b = __builtin_convertvector(v, bf16x2_t); return __builtin_bit_cast(unsigned, b); }
__device__ __forceinline__ u32x4 pack8(f32x4 a, f32x4 b) { u32x4 w; w.x = cvt_pk_bf16(a[0], a[1]); w.y = cvt_pk_bf16(a[2], a[3]); w.z = cvt_pk_bf16(b[0], b[1]); w.w = cvt_pk_bf16(b[2], b[3]); return w; }
__device__ __forceinline__ void unpack8(u32x4 w, f32x4& a, f32x4& b) { a[0] = bf2f(w.x & 0xffffu); a[1] = bf2f(w.x >> 16); a[2] = bf2f(w.y & 0xffffu); a[3] = bf2f(w.y >> 16); b[0] = bf2f(w.z & 0xffffu); b[1] = bf2f(w.z >> 16); b[2] = bf2f(w.w & 0xffffu); b[3] = bf2f(w.w >> 16); }
__device__ __forceinline__ float wave_sum(float v) {
#pragma unroll
    for (int o = 1; o < 64; o <<= 1) v += __shfl_xor(v, o);
    return v;
}
__device__ __forceinline__ float sigm(float v) { return __builtin_amdgcn_rcpf(1.f + __builtin_amdgcn_exp2f(v * (-LOG2E))); }
#if WT_STORES
__device__ __forceinline__ void st16(void* p, u32x4 v) { asm volatile("global_store_dwordx4 %0, %1, off sc1\n\ts_nop 1" :: "v"(p), "v"(v) : "memory"); }
__device__ __forceinline__ void st8(void* p, u32x2 v) { asm volatile("global_store_dwordx2 %0, %1, off sc1\n\ts_nop 1" :: "v"(p), "v"(v) : "memory"); }
#else
__device__ __forceinline__ void st16(void* p, u32x4 v) { *(u32x4*)p = v; }
__device__ __forceinline__ void st8(void* p, u32x2 v) { *(u32x2*)p = v; }
#endif
#define VM_WAIT() asm volatile("s_waitcnt vmcnt(0)" ::: "memory")
#define LAUNDER_S(p) asm volatile("" : "+s"(p))
#define LAUNDER_V(v) asm volatile("" : "+v"(v))
#define LDS_WAIT() asm volatile("s_waitcnt lgkmcnt(0)" ::: "memory")

#define XB_TMO      128
#define XB_XCNT(j)  (256  + 64 * (j))
#define XB_XSUB(j)  (1280 + 64 * (j))
#define XB_XGEN(j)  (2304 + 64 * (j))
#define XB_TOP      3328
#define XB_TOPGEN   3392
#define XCD_BAR_WORDS 3456
#define XB_SPIN_CAP (1u << 22)
__device__ __forceinline__ unsigned xb_ld(unsigned* p)              { return __hip_atomic_load(p, __ATOMIC_RELAXED, __HIP_MEMORY_SCOPE_AGENT); }
__device__ __forceinline__ unsigned xb_add(unsigned* p, unsigned v) { return __hip_atomic_fetch_add(p, v, __ATOMIC_RELAXED, __HIP_MEMORY_SCOPE_AGENT); }
__device__ __forceinline__ unsigned xb_xcc_id() { return (unsigned)__builtin_amdgcn_s_getreg((3 << 11) | 20) & 0xFu; }
#define XB_SPIN(cond, bar) do { unsigned _sp = 0; while (cond) { __builtin_amdgcn_s_sleep(1); \
    if ((++_sp & 255u) == 0u) { if (xb_ld(&(bar)[XB_TMO])) break; if (_sp > XB_SPIN_CAP) { atomicAdd(&(bar)[XB_TMO], 1u); break; } } } } while (0)
struct XcdBarrier { unsigned* bar; unsigned x; volatile LAS unsigned* st; };
__device__ __forceinline__ XcdBarrier xcd_barrier_post(unsigned* bar, volatile LAS unsigned* st) {
    XcdBarrier b; b.bar = bar; b.x = xb_xcc_id(); b.st = st;
    if (threadIdx.x == 0) (void)xb_add(&bar[XB_XCNT(b.x)], 1u);
    return b;
}
__device__ __forceinline__ void xcd_barrier_complete(unsigned* bar, unsigned x, unsigned& nloc, unsigned& nx) {
    const unsigned G = gridDim.x * gridDim.y * gridDim.z;
    unsigned sum, cnt, mine, sp = 0u;
    for (;;) {
        sum = 0u; cnt = 0u; mine = 0u;
#pragma unroll
        for (unsigned j = 0; j < 16; ++j) { const unsigned c = xb_ld(&bar[XB_XCNT(j)]); sum += c; cnt += (c > 0u) ? 1u : 0u; mine = (j == x) ? c : mine; }
        if (sum == G) break;
        __builtin_amdgcn_s_sleep(1);
        if ((++sp & 255u) == 0u) { if (xb_ld(&bar[XB_TMO])) break; if (sp > XB_SPIN_CAP) { atomicAdd(&bar[XB_TMO], 1u); break; } }
    }
    nloc = mine > 0u ? mine : 1u; nx = cnt > 0u ? cnt : 1u;
}
__device__ __forceinline__ void xcd_barrier(const XcdBarrier& b) {
    asm volatile("s_waitcnt vmcnt(0)" ::: "memory");
    __syncthreads();
    if (threadIdx.x == 0) {
        unsigned* bar = b.bar;
        __builtin_amdgcn_s_waitcnt(0);
        unsigned nloc = b.st[0], nx = b.st[1];
        if (nloc == 0u) { xcd_barrier_complete(bar, b.x, nloc, nx); b.st[0] = nloc; b.st[1] = nx; }
        const unsigned old = xb_add(&bar[XB_XSUB(b.x)], 1u);
        const unsigned gen = old / nloc;
        if (old + 1u == (gen + 1u) * nloc) {
            __builtin_amdgcn_fence(__ATOMIC_RELEASE, "agent");
            asm volatile("s_waitcnt vmcnt(0)" ::: "memory");
            const unsigned og = xb_add(&bar[XB_TOP], 1u);
            const unsigned tg = og / nx;
            if (og + 1u == (tg + 1u) * nx) xb_add(&bar[XB_TOPGEN], 1u);
            else XB_SPIN(xb_ld(&bar[XB_TOPGEN]) == tg, bar);
            __builtin_amdgcn_fence(__ATOMIC_ACQUIRE, "agent");
            xb_add(&bar[XB_XGEN(b.x)], 1u);
            asm volatile("s_waitcnt vmcnt(0)" ::: "memory");
        } else {
            XB_SPIN(xb_ld(&bar[XB_XGEN(b.x)]) == gen, bar);
            __builtin_amdgcn_fence(__ATOMIC_ACQUIRE, "agent");
            asm volatile("s_waitcnt vmcnt(0)" ::: "memory");
        }
    }
    __syncthreads();
}

namespace gp {
constexpr int BM = 256, BK = 64, HALF = 128, HTB = HALF * BK * 2, NXCD = 8, WGM = 8;
__host__ __device__ __forceinline__ int lds_byte(int r, int c) { const int st = (r >> 4) * 2 + (c >> 5), rr = r & 15, cc = c & 31, ob = rr * 64 + cc * 2; return st * 1024 + (ob ^ (((ob >> 9) & 1) << 5)); }
__host__ __device__ __forceinline__ void stage_rc(int b, int& R, int& C) { const int st = b / 1024, sb = b % 1024, swz = sb ^ (((sb >> 9) & 1) << 5); R = (st >> 1) * 16 + swz / 64; C = (st & 1) * 32 + (swz % 64) / 2; }
__host__ __device__ __forceinline__ int perm32(int rho) { const int n = rho >> 4, i = rho & 15; return 8 * (i >> 2) + 4 * n + (i & 3); }

struct Unit { int pm, pn, be, rl, nv; };
struct Gemm { const bf16_t* A; const bf16_t* Bt; int K; size_t bstride; const unsigned* list; size_t astride; };

__device__ __forceinline__ int xcd_remap(int wgid, int nwg) { const int q = nwg / NXCD, r = nwg % NXCD, xcd = wgid % NXCD, off = wgid / NXCD; return (xcd < r ? xcd * (q + 1) : r * (q + 1) + (xcd - r) * q) + off; }
struct DenseOrder {
    int nM, nN, nwg, G, c;
    __device__ void init(int M, int N, int G_, int c_) { nM = M / BM; nN = N / BM; nwg = nM * nN; G = G_; c = c_; }
    __device__ bool next(int i, Unit& u) const {
        const long L = (long)i * G + c; if (L >= nwg) return false;
        const int wgid = xcd_remap((int)L, nwg);
        const int nig = WGM * nN, gid = wgid / nig, fm = gid * WGM, gsz = (nM - fm) < WGM ? (nM - fm) : WGM;
        u.pm = fm + ((wgid % nig) % gsz); u.pn = (wgid % nig) / gsz; u.be = 0; u.rl = 0; u.nv = 256; return true;
    }
};
struct PairOrder {
    DenseOrder d;
    __device__ void init(int M, int N, int G_, int c_) { d.init(M, N, G_, c_); }
    __device__ bool next(int i, Unit& u) const { if (!d.next(i >> 1, u)) return false; u.be = i & 1; return true; }
};
struct MoeOrder {
    const LAS int* tab; int nwg, G, c;
    __device__ static int rd(const LAS int* p) { return __builtin_amdgcn_readfirstlane(*p); }
    __device__ void init(const LAS int* tab_, int G_, int c_) { tab = tab_; nwg = rd(tab_ + 16) * 4; G = G_; c = c_; }
    __device__ bool next(int i, Unit& u) const {
        const long L = (long)i * G + c; if (L >= nwg) return false;
        const int wgid = xcd_remap((int)L, nwg);
        const int tile = wgid >> 2; int e = 0;
        for (int k = 1; k < NE; ++k) e += (rd(tab + k) <= tile) ? 1 : 0;
        u.pm = tile; u.pn = wgid & 3; u.be = e; u.rl = tile - rd(tab + e); const int rem = rd(tab + 32 + e) - u.rl * 256; u.nv = rem < 256 ? rem : 256; return true;
    }
};

#define ACC_T f32x4 (&acc)[2][2][4][2]

template <class Epi, class Sched, bool GATHER>
__device__ __forceinline__ void gemm_phase_ref(int tid, const Gemm g, const Sched& S, const Epi& E) {
    const int wid = __builtin_amdgcn_readfirstlane(tid >> 6), lane = tid & 63, wr = wid >> 2, wc = wid & 3, fr = lane & 15, fq = lane >> 4;
    const int K = g.K; Unit u;
    for (int ui = 0; S.next(ui, u); ++ui) {
        f32x4 acc[2][2][4][2];
#pragma unroll
        for (int a = 0; a < 2; ++a)
#pragma unroll
            for (int b = 0; b < 2; ++b)
#pragma unroll
                for (int m = 0; m < 4; ++m)
#pragma unroll
                    for (int n = 0; n < 2; ++n) acc[a][b][m][n] = (f32x4){0.f, 0.f, 0.f, 0.f};
        const bf16_t* Bt = g.Bt + (size_t)u.be * g.bstride + (size_t)u.pn * 256 * K;
        for (int ai = 0; ai < 2; ++ai)
            for (int m = 0; m < 4; ++m) {
                const int rloc = ai * 128 + wr * 64 + m * 16 + fr;
                size_t arow;
                if (GATHER) { arow = (rloc < u.nv) ? (size_t)(g.list[(size_t)u.be * T + u.rl * 256 + rloc] >> 1) : 0; }
                else arow = (size_t)u.pm * 256 + rloc;
                const bf16_t* ap = g.A + arow * K;
                for (int bj = 0; bj < 2; ++bj) {
                    const bf16_t* bp = Bt + (size_t)(bj * 128 + wc * 32 + fq * 8) * K;
                    float s[8];
#pragma unroll
                    for (int c = 0; c < 8; ++c) {
                        float sc = 0.f; const bf16_t* bpc = bp + (size_t)c * K;
#pragma unroll 2
                        for (int k = 0; k < K; k += 8) {
                            f32x4 a0, a1, b0, b1; unpack8(*(const u32x4*)(ap + k), a0, a1); unpack8(*(const u32x4*)(bpc + k), b0, b1);
                            sc += a0[0] * b0[0] + a0[1] * b0[1] + a0[2] * b0[2] + a0[3] * b0[3] + a1[0] * b1[0] + a1[1] * b1[1] + a1[2] * b1[2] + a1[3] * b1[3];
                        }
                        s[c] = sc; asm volatile("" : "+v"(s[c]));
                    }
#pragma unroll
                    for (int a2 = 0; a2 < 2; ++a2)
#pragma unroll
                        for (int b2 = 0; b2 < 2; ++b2)
#pragma unroll
                            for (int m2 = 0; m2 < 4; ++m2)
                                if (a2 == ai && b2 == bj && m2 == m) { acc[a2][b2][m2][0] = (f32x4){s[0], s[1], s[2], s[3]}; acc[a2][b2][m2][1] = (f32x4){s[4], s[5], s[6], s[7]}; }
                }
            }
        E(acc, u, wr, wc, fr, fq);
    }
}

template <class E> struct EpiTraits { static constexpr bool KEEP = false; };
#if FAST_GEMM
template <class Epi, class Sched, bool GATHER>
__device__ __forceinline__ void gemm_phase_fast(int tid, LAS unsigned char* lds, const Gemm g, const Sched& S, const Epi& E) {
    const int wid = __builtin_amdgcn_readfirstlane(tid >> 6), lane = tid & 63, wr = wid >> 2, wc = wid & 3, fr = lane & 15, fq = lane >> 4;
    const int K = g.K, nt = K / BK;
    int Rr[2], Cc[2]; unsigned voffB[2];
#pragma unroll
    for (int i = 0; i < 2; ++i) { stage_rc(tid * 16 + i * 8192, Rr[i], Cc[i]); const int Rb = (Rr[i] & ~31) + perm32(Rr[i] & 31); voffB[i] = (unsigned)(Rb * K + Cc[i]) * 2u; }
    const size_t kstep = (size_t)(BK * 2), hstep = (size_t)HALF * K * 2, tstep = 2 * hstep;
    const unsigned ldsw = (unsigned)wid * 1024u;
    const int aoff = lds_byte(wr * 64 + fr, fq * 8), boff = lds_byte(wc * 32 + fr, fq * 8);
#define GP_SA(b, h) (((b) * 2 + (h)) * HTB)
#define GP_SB(b, h) ((4 + (b) * 2 + (h)) * HTB)
#define GP_STAGE2(bufoff, gbase, v0, v1) do { \
        __builtin_amdgcn_global_load_lds((const unsigned*)((const char*)(gbase) + (v0)), (LAS unsigned*)(lds + (bufoff) + ldsw), 16, 0, 0); \
        __builtin_amdgcn_global_load_lds((const unsigned*)((const char*)(gbase) + (v1)), (LAS unsigned*)(lds + (bufoff) + ldsw + 8192), 16, 0, 0); } while (0)
#define GP_STAGEB(bufoff, gbase) GP_STAGE2(bufoff, gbase, voffB[0], voffB[1])
#define GP_LDA(dst, b, h) do { _Pragma("unroll") for (int m = 0; m < 4; ++m) _Pragma("unroll") for (int k = 0; k < 2; ++k) dst[m][k] = *(const LAS bf16x8*)(lds + GP_SA(b, h) + aoff + m * 2048 + k * 1024); } while (0)
#define GP_LDB(dst, b, h) do { _Pragma("unroll") for (int n = 0; n < 2; ++n) _Pragma("unroll") for (int k = 0; k < 2; ++k) dst[n][k] = *(const LAS bf16x8*)(lds + GP_SB(b, h) + boff + n * 2048 + k * 1024); } while (0)
#define GP_MMA(ai, bj, At, Bt) do { __builtin_amdgcn_s_setprio(1); _Pragma("unroll") for (int m = 0; m < 4; ++m) _Pragma("unroll") for (int n = 0; n < 2; ++n) _Pragma("unroll") for (int k = 0; k < 2; ++k) \
        acc[ai][bj][m][n] = __builtin_amdgcn_mfma_f32_16x16x32_bf16(Bt[n][k], At[m][k], acc[ai][bj][m][n], 0, 0, 0); __builtin_amdgcn_s_setprio(0); } while (0)
#define GP_WAIT_V(n) asm volatile("s_waitcnt vmcnt(" #n ")" ::: "memory")
#define GP_WAIT_L(n) asm volatile("s_waitcnt lgkmcnt(" #n ")" ::: "memory")
#define GP_BAR __builtin_amdgcn_s_barrier()
#define GP_SCHED __builtin_amdgcn_sched_barrier(0)
    Unit cur, nxt; int ui = 0;
    if (!S.next(0, cur)) return;
    f32x4 acc[2][2][4][2];
#pragma unroll
    for (int a = 0; a < 2; ++a)
#pragma unroll
        for (int b = 0; b < 2; ++b)
#pragma unroll
            for (int m = 0; m < 4; ++m)
#pragma unroll
                for (int n = 0; n < 2; ++n) acc[a][b][m][n] = (f32x4){0.f, 0.f, 0.f, 0.f};
    bf16x8 At[4][2], B0[2][2], B1[2][2];
    unsigned vC0, vC1, vC2, vC3, vN0, vN1, vN2, vN3;
#define GP_VOFF(u, o0, o1, o2, o3) do { if (GATHER) { \
        int tl_ = tid; LAUNDER_V(tl_); int R0_, C0_, R1_, C1_; stage_rc(tl_ * 16, R0_, C0_); stage_rc(tl_ * 16 + 8192, R1_, C1_);     \
        const unsigned* lp = g.list + (size_t)(u).be * T + (u).rl * 256; \
        const int nvm = (u).nv - 1; const int p0 = min(R0_, nvm), p1 = min(R1_, nvm), p2 = min(128 + R0_, nvm), p3 = min(128 + R1_, nvm); \
        const unsigned t0 = lp[p0] >> 1, t1 = lp[p1] >> 1, t2 = lp[p2] >> 1, t3 = lp[p3] >> 1; \
        o0 = (t0 * K + C0_) * 2u; o1 = (t1 * K + C1_) * 2u; o2 = (t2 * K + C0_) * 2u; o3 = (t3 * K + C1_) * 2u; \
      } else { o0 = (unsigned)(Rr[0] * K + Cc[0]) * 2u; o1 = (unsigned)(Rr[1] * K + Cc[1]) * 2u; o2 = o0 + (unsigned)hstep; o3 = o1 + (unsigned)hstep; } } while (0)
    GP_VOFF(cur, vC0, vC1, vC2, vC3);
    const char* cA = (const char*)g.A + ((size_t)cur.be * g.astride) * 2 + (GATHER ? (size_t)0 : (size_t)cur.pm * tstep);
    const char* cB = (const char*)g.Bt + ((size_t)cur.be * g.bstride) * 2 + (size_t)cur.pn * tstep;
    GP_STAGEB(GP_SB(0, 0), cB); GP_STAGEB(GP_SB(0, 1), cB + hstep); GP_STAGE2(GP_SA(0, 0), cA, vC0, vC1); GP_STAGE2(GP_SA(0, 1), cA, vC2, vC3);
    if (wr == 1) GP_BAR;
    GP_WAIT_V(2); GP_BAR;
    GP_STAGEB(GP_SB(1, 0), cB + kstep); GP_STAGE2(GP_SA(1, 0), cA + kstep, vC0, vC1); GP_STAGEB(GP_SB(1, 1), cB + hstep + kstep);
    GP_WAIT_V(6); GP_BAR;
    for (;;) {
        const bool has_next = S.next(ui + 1, nxt);
        const char* nA = has_next ? (const char*)g.A + ((size_t)nxt.be * g.astride) * 2 + (GATHER ? (size_t)0 : (size_t)nxt.pm * tstep) : cA;
        const char* nB = has_next ? (const char*)g.Bt + ((size_t)nxt.be * g.bstride) * 2 + (size_t)nxt.pn * tstep : cB;
        if (has_next) { GP_VOFF(nxt, vN0, vN1, vN2, vN3); } else { vN0 = vC0; vN1 = vC1; vN2 = vC2; vN3 = vC3; }
#pragma nounroll
        for (int t = 0; t < nt; t += 2) {
            const bool last = (t == nt - 2);
            const char* a1 = cA + (size_t)(t + 1) * kstep;
            const char* a2 = last ? nA : cA + (size_t)(t + 2) * kstep; const char* b2 = last ? nB : cB + (size_t)(t + 2) * kstep;
            const char* a3 = a2 + kstep; const char* b3 = b2 + kstep;
            const unsigned w0 = last ? vN0 : vC0, w1 = last ? vN1 : vC1, w2 = last ? vN2 : vC2, w3 = last ? vN3 : vC3;
            GP_LDB(B0, 0, 0); GP_LDB(B1, 0, 1); GP_SCHED; GP_LDA(At, 0, 0); GP_STAGE2(GP_SA(1, 1), a1, vC2, vC3);
            GP_WAIT_V(8); GP_WAIT_L(0); GP_BAR; GP_MMA(0, 0, At, B0); GP_MMA(0, 1, At, B1); GP_BAR; GP_SCHED;
            GP_LDA(At, 0, 1); GP_STAGEB(GP_SB(0, 0), b2); GP_STAGEB(GP_SB(0, 1), b2 + hstep); GP_STAGE2(GP_SA(0, 0), a2, w0, w1);
            GP_WAIT_V(8); GP_WAIT_L(0); GP_BAR; GP_MMA(1, 0, At, B0); GP_MMA(1, 1, At, B1); GP_BAR; GP_SCHED;
            GP_LDB(B0, 1, 0); GP_LDB(B1, 1, 1); GP_SCHED; GP_LDA(At, 1, 0); GP_STAGE2(GP_SA(0, 1), a2, w2, w3);
            GP_WAIT_V(8); GP_WAIT_L(0); GP_BAR; GP_MMA(0, 0, At, B0); GP_MMA(0, 1, At, B1); GP_BAR; GP_SCHED;
            GP_LDA(At, 1, 1); GP_STAGEB(GP_SB(1, 0), b3); GP_STAGEB(GP_SB(1, 1), b3 + hstep); GP_STAGE2(GP_SA(1, 0), a3, w0, w1);
            GP_WAIT_V(8); GP_WAIT_L(0); GP_BAR; GP_MMA(1, 0, At, B0); GP_MMA(1, 1, At, B1); GP_BAR; GP_SCHED;
        }
        if (wr == 0) GP_BAR;
        E(acc, cur, wr, wc, fr, fq);
        if (!has_next) break;
        if (!(EpiTraits<Epi>::KEEP && cur.be == 0)) {
#pragma unroll
        for (int a = 0; a < 2; ++a)
#pragma unroll
            for (int b = 0; b < 2; ++b)
#pragma unroll
                for (int m = 0; m < 4; ++m)
#pragma unroll
                    for (int n = 0; n < 2; ++n) acc[a][b][m][n] = (f32x4){0.f, 0.f, 0.f, 0.f};
        }
        cur = nxt; cA = nA; cB = nB; vC0 = vN0; vC1 = vN1; vC2 = vN2; vC3 = vN3; ++ui;
        if (wr == 1) GP_BAR;
    }
    GP_WAIT_V(0);
    GP_BAR;
#undef GP_SA
#undef GP_SB
#undef GP_STAGE2
#undef GP_STAGEB
#undef GP_LDA
#undef GP_LDB
#undef GP_MMA
#undef GP_WAIT_V
#undef GP_WAIT_L
#undef GP_BAR
#undef GP_SCHED
#undef GP_VOFF
}
#endif

template <class Epi, class Sched, bool GATHER = false>
__device__ __forceinline__ void gemm_phase(int tid, LAS unsigned char* lds, const Gemm g, const Sched& S, const Epi& E) {
#if FAST_GEMM
    gemm_phase_fast<Epi, Sched, GATHER>(tid, lds, g, S, E);
#else
    (void)lds; gemm_phase_ref<Epi, Sched, GATHER>(tid, g, S, E);
#endif
}

#define EPI_ROW(ai, m) (u.pm * 256 + (ai) * 128 + wr * 64 + (m) * 16 + fr)
#define EPI_COL(bj) (u.pn * 256 + (bj) * 128 + wc * 32 + fq * 8)
__device__ __forceinline__ float dot4(f32x4 a) { return (a[0] * a[0] + a[1] * a[1]) + (a[2] * a[2] + a[3] * a[3]); }

struct EpiNull {
    __device__ __forceinline__ void operator()(const ACC_T, const Unit& u, int wr, int wc, int fr, int fq) const {
#pragma unroll
        for (int ai = 0; ai < 2; ++ai)
#pragma unroll
            for (int bj = 0; bj < 2; ++bj)
#pragma unroll
                for (int m = 0; m < 4; ++m) asm volatile("" :: "v"(acc[ai][bj][m][0]), "v"(acc[ai][bj][m][1]));
    }
};
struct EpiIn {
    bf16_t *QA, *KA, *VA, *QLAT, *KVLAT, *KB, *SA, *SB; float *SSQ, *SSKV; const float *gq, *gk, *cosA, *sinA, *cosB, *sinB;
    __device__ __forceinline__ void operator()(const ACC_T, const Unit& u, int wr, int wc, int fr, int fq) const {
        const int wb = u.pn * 4 + wc;
        if (wb < 10) {
            const bool isq = wb < 8; const int head = isq ? wb : wb - 8; const float* g = isq ? gq : gk; bf16_t* dst = isq ? QA : KA; const int dp = isq ? 512 : 128; const float qs = isq ? QSCALE_A : 1.f;
            const f32x4 g00 = *(const f32x4*)(g + 8 * fq), g01 = *(const f32x4*)(g + 8 * fq + 4), g10 = *(const f32x4*)(g + 32 + 8 * fq), g11 = *(const f32x4*)(g + 36 + 8 * fq);
#pragma unroll
            for (int ai = 0; ai < 2; ++ai)
#pragma unroll
                for (int m = 0; m < 4; ++m) {
                    const int r = EPI_ROW(ai, m), pos = r & (S - 1);
                    const f32x4 v00 = acc[ai][0][m][0], v01 = acc[ai][0][m][1], v10 = acc[ai][1][m][0], v11 = acc[ai][1][m][1];
                    float ss = (dot4(v00) + dot4(v01)) + (dot4(v10) + dot4(v11)); ss += __shfl_xor(ss, 16); ss += __shfl_xor(ss, 32);
                    const float rstd = rsqrtf(ss * (1.f / 64.f) + EPS);
                    const f32x4 y00 = v00 * rstd * g00, y01 = v01 * rstd * g01, y10 = v10 * rstd * g10, y11 = v11 * rstd * g11;
                    const f32x4 c0 = *(const f32x4*)(cosA + pos * 32 + 8 * fq), c1 = *(const f32x4*)(cosA + pos * 32 + 8 * fq + 4), s0 = *(const f32x4*)(sinA + pos * 32 + 8 * fq), s1 = *(const f32x4*)(sinA + pos * 32 + 8 * fq + 4);
                    const f32x4 o00 = (y00 * c0 - y10 * s0) * qs, o01 = (y01 * c1 - y11 * s1) * qs, o10 = (y10 * c0 + y00 * s0) * qs, o11 = (y11 * c1 + y01 * s1) * qs;
                    bf16_t* p = dst + (size_t)r * dp + head * 64 + 8 * fq;
                    st16(p, pack8(o00, o01)); st16((p + 32), pack8(o10, o11));
                }
        } else if (wb < 12) {
#pragma unroll
            for (int ai = 0; ai < 2; ++ai)
#pragma unroll
                for (int m = 0; m < 4; ++m) { bf16_t* p = VA + (size_t)EPI_ROW(ai, m) * 128 + (wb - 10) * 64 + 8 * fq;
                    st16(p, pack8(acc[ai][0][m][0], acc[ai][0][m][1])); st16((p + 32), pack8(acc[ai][1][m][0], acc[ai][1][m][1])); }
        } else if (wb < 22) {
            const bool isq = wb < 18; const int idx = isq ? wb - 12 : wb - 18; bf16_t* dst = isq ? QLAT : KVLAT; const int dp = isq ? 384 : 256;
#pragma unroll
            for (int ai = 0; ai < 2; ++ai)
#pragma unroll
                for (int m = 0; m < 4; ++m) {
                    const int r = EPI_ROW(ai, m);
                    const f32x4 v00 = acc[ai][0][m][0], v01 = acc[ai][0][m][1], v10 = acc[ai][1][m][0], v11 = acc[ai][1][m][1];
                    float ss = (dot4(v00) + dot4(v01)) + (dot4(v10) + dot4(v11)); ss += __shfl_xor(ss, 16); ss += __shfl_xor(ss, 32);
                    if (fq == 0) { if (isq) SSQ[(size_t)r * 8 + idx] = ss; else SSKV[(size_t)r * 4 + idx] = ss; }
                    bf16_t* p = dst + (size_t)r * dp + idx * 64 + 8 * fq;
                    st16(p, pack8(v00, v01)); st16((p + 32), pack8(v10, v11));
                }
        } else if (wb == 22) {
            if (fq < 2) {
#pragma unroll
                for (int ai = 0; ai < 2; ++ai)
#pragma unroll
                    for (int m = 0; m < 4; ++m) {
                        const int r = EPI_ROW(ai, m), pos = r & (S - 1);
                        const f32x4 x10 = acc[ai][0][m][0], x11 = acc[ai][0][m][1], x20 = acc[ai][1][m][0], x21 = acc[ai][1][m][1];
                        const f32x4 c0 = *(const f32x4*)(cosB + pos * 16 + 8 * fq), c1 = *(const f32x4*)(cosB + pos * 16 + 8 * fq + 4), s0 = *(const f32x4*)(sinB + pos * 16 + 8 * fq), s1 = *(const f32x4*)(sinB + pos * 16 + 8 * fq + 4);
                        const u32x4 w1 = pack8(x10 * c0 - x20 * s0, x11 * c1 - x21 * s1), w2 = pack8(x20 * c0 + x10 * s0, x21 * c1 + x11 * s1);
                        bf16_t* p = KB + (size_t)r * 768 + 64 + 8 * fq;
#pragma unroll
                        for (int h = 0; h < 8; ++h) { st16((p + h * 96), w1); st16((p + h * 96 + 16), w2); }
                    }
            }
        } else if (wb == 23) {
        } else {
            const bool isa = wb < 40; const int idx = isa ? wb - 24 : wb - 40; unsigned char* dst = (unsigned char*)(isa ? SA : SB);
#pragma unroll
            for (int ai = 0; ai < 2; ++ai)
#pragma unroll
                for (int m = 0; m < 4; ++m) { unsigned char* p = dst + (size_t)EPI_ROW(ai, m) * 1024 + idx * 64 + 8 * fq;
#pragma unroll
                    for (int bj = 0; bj < 2; ++bj) { const f32x4 a = acc[ai][bj][m][0], b = acc[ai][bj][m][1]; u32x2 w;
                        w.x = (unsigned)__builtin_amdgcn_cvt_pk_fp8_f32(a[2], a[3], __builtin_amdgcn_cvt_pk_fp8_f32(a[0], a[1], 0, false), true);
                        w.y = (unsigned)__builtin_amdgcn_cvt_pk_fp8_f32(b[2], b[3], __builtin_amdgcn_cvt_pk_fp8_f32(b[0], b[1], 0, false), true);
                        st8((p + bj * 32), w); } }
        }
    }
};
__host__ __device__ __forceinline__ int src_col_in(int n) {
    const int pn = n >> 8, nl = n & 255, bj = nl >> 7, wc = (nl & 127) >> 5, p = nl & 31, wb = pn * 4 + wc, s = bj * 32 + p;
    if (wb < 8) return wb * 64 + s;
    if (wb < 10) return 512 + (wb - 8) * 64 + s;
    if (wb < 12) return 640 + (wb - 10) * 64 + s;
    if (wb < 18) return 768 + (wb - 12) * 64 + s;
    if (wb < 22) return 1152 + (wb - 18) * 64 + s;
    if (wb == 22) return p < 16 ? 1408 + bj * 16 + p : -1;
    if (wb == 23) return -1;
    if (wb < 40) return 1440 + (wb - 24) * 64 + s;
    return 2464 + (wb - 40) * 64 + s;
}
struct EpiQb {
    bf16_t* QB; const float *SSQ, *cosB, *sinB;
    __device__ __forceinline__ void operator()(const ACC_T, const Unit& u, int wr, int wc, int fr, int fq) const {
#pragma unroll
        for (int ai = 0; ai < 2; ++ai)
#pragma unroll
            for (int m = 0; m < 4; ++m) {
                const int r = EPI_ROW(ai, m), pos = r & (S - 1);
                const f32x4 sa = *(const f32x4*)(SSQ + (size_t)r * 8); const f32x2 sb = *(const f32x2*)(SSQ + (size_t)r * 8 + 4);
                const float rstd = rsqrtf((((sa[0] + sa[1]) + (sa[2] + sa[3])) + (sb[0] + sb[1])) * (1.f / 384.f) + EPS);
#pragma unroll
                for (int bj = 0; bj < 2; ++bj) {
                    f32x4 v0 = acc[ai][bj][m][0] * rstd, v1 = acc[ai][bj][m][1] * rstd;
                    const int c32 = u.pn * 8 + bj * 4 + wc;
                    if (c32 % 3 == 2) {
                        f32x4 o0, o1;
#pragma unroll
                        for (int j = 0; j < 4; ++j) { o0[j] = __shfl_xor(v0[j], 32); o1[j] = __shfl_xor(v1[j], 32); }
                        const int i0 = 8 * (fq & 1);
                        const f32x4 c0 = *(const f32x4*)(cosB + pos * 16 + i0), c1 = *(const f32x4*)(cosB + pos * 16 + i0 + 4), s0 = *(const f32x4*)(sinB + pos * 16 + i0), s1 = *(const f32x4*)(sinB + pos * 16 + i0 + 4);
                        if (fq < 2) { v0 = v0 * c0 - o0 * s0; v1 = v1 * c1 - o1 * s1; } else { v0 = v0 * c0 + o0 * s0; v1 = v1 * c1 + o1 * s1; }
                    }
                    st16((QB + (size_t)r * 768 + EPI_COL(bj)), pack8(v0 * QSCALE_B, v1 * QSCALE_B));
                }
            }
    }
};
struct EpiKvb {
    bf16_t *KB, *VB; const float* SSKV;
    __device__ __forceinline__ void operator()(const ACC_T, const Unit& u, int wr, int wc, int fr, int fq) const {
#pragma unroll
        for (int ai = 0; ai < 2; ++ai)
#pragma unroll
            for (int m = 0; m < 4; ++m) {
                const int r = EPI_ROW(ai, m);
                const f32x4 sa = *(const f32x4*)(SSKV + (size_t)r * 4);
                const float rstd = rsqrtf(((sa[0] + sa[1]) + (sa[2] + sa[3])) * (1.f / 256.f) + EPS);
#pragma unroll
                for (int bj = 0; bj < 2; ++bj) {
                    const int head = u.pn * 2 + bj, o = wc * 32 + fq * 8;
                    const u32x4 w = pack8(acc[ai][bj][m][0] * rstd, acc[ai][bj][m][1] * rstd);
                    if (wc < 2) st16((KB + (size_t)r * 768 + head * 96 + o), w); else st16((VB + (size_t)r * 512 + head * 64 + (o - 64)), w);
                }
            }
    }
};
template <int MODE> struct EpiProj {
    bf16_t* O; const bf16_t* gate;
    __device__ __forceinline__ void operator()(const ACC_T, const Unit& u, int wr, int wc, int fr, int fq) const {
#pragma unroll
        for (int ai = 0; ai < 2; ++ai)
#pragma unroll
            for (int m = 0; m < 4; ++m) {
                const int r = EPI_ROW(ai, m);
#pragma unroll
                for (int bj = 0; bj < 2; ++bj) {
                    const size_t off = (size_t)r * D + EPI_COL(bj);
                    const u32x2 gw = *(const u32x2*)((const unsigned char*)gate + off);
                    const f32x2 q0 = __builtin_amdgcn_cvt_pk_f32_fp8((int)gw.x, false), q1 = __builtin_amdgcn_cvt_pk_f32_fp8((int)gw.x, true), q2 = __builtin_amdgcn_cvt_pk_f32_fp8((int)gw.y, false), q3 = __builtin_amdgcn_cvt_pk_f32_fp8((int)gw.y, true);
                    const f32x4 g0 = {sigm(q0[0]), sigm(q0[1]), sigm(q1[0]), sigm(q1[1])}, g1 = {sigm(q2[0]), sigm(q2[1]), sigm(q3[0]), sigm(q3[1])};
                    f32x4 v0 = acc[ai][bj][m][0] * g0, v1 = acc[ai][bj][m][1] * g1;
                    if (MODE == 1) { f32x4 p0, p1; unpack8(*(const u32x4*)(O + off), p0, p1); v0 += p0; v1 += p1; }
                    if (MODE == 1) st16(O + off, pack8(v0, v1)); else *(u32x4*)(O + off) = pack8(v0, v1);
                }
            }
    }
};
struct EpiProjP {
    bf16_t* O; const unsigned char* SA; const unsigned char* SB;
    __device__ static __forceinline__ void gates(const unsigned char* G, size_t off, f32x4& g0, f32x4& g1) {
        const u32x2 gw = *(const u32x2*)(G + off);
        const f32x2 q0 = __builtin_amdgcn_cvt_pk_f32_fp8((int)gw.x, false), q1 = __builtin_amdgcn_cvt_pk_f32_fp8((int)gw.x, true), q2 = __builtin_amdgcn_cvt_pk_f32_fp8((int)gw.y, false), q3 = __builtin_amdgcn_cvt_pk_f32_fp8((int)gw.y, true);
        g0 = (f32x4){sigm(q0[0]), sigm(q0[1]), sigm(q1[0]), sigm(q1[1])}; g1 = (f32x4){sigm(q2[0]), sigm(q2[1]), sigm(q3[0]), sigm(q3[1])};
    }
    __device__ __forceinline__ void operator()(f32x4 (&acc)[2][2][4][2], const Unit& u, int wr, int wc, int fr, int fq) const {
#pragma unroll
        for (int ai = 0; ai < 2; ++ai)
#pragma unroll
            for (int m = 0; m < 4; ++m) {
                const int r = EPI_ROW(ai, m);
#pragma unroll
                for (int bj = 0; bj < 2; ++bj) {
                    const size_t off = (size_t)r * D + EPI_COL(bj);
                    f32x4 b0, b1; gates(SB, off, b0, b1);
#pragma unroll
                    for (int j = 0; j < 4; ++j) { b0[j] = fmaxf(b0[j], 9.094947e-13f); b1[j] = fmaxf(b1[j], 9.094947e-13f); }
                    if (u.be == 0) {
                        f32x4 a0, a1; gates(SA, off, a0, a1);
#pragma unroll
                        for (int j = 0; j < 4; ++j) { acc[ai][bj][m][0][j] *= a0[j] * __builtin_amdgcn_rcpf(b0[j]); acc[ai][bj][m][1][j] *= a1[j] * __builtin_amdgcn_rcpf(b1[j]); }
                    } else st16(O + off, pack8(acc[ai][bj][m][0] * b0, acc[ai][bj][m][1] * b1));
                }
            }
    }
};
template <> struct EpiTraits<EpiProjP> { static constexpr bool KEEP = true; };
struct EpiWo {
    const bf16_t* X; const float* modl; bf16_t* XO;
    __device__ __forceinline__ void operator()(const ACC_T, const Unit& u, int wr, int wc, int fr, int fq) const {
        const float* g1 = modl + (size_t)(u.pm >> 4) * 6 * D + 2 * D;
#pragma unroll
        for (int bj = 0; bj < 2; ++bj) {
            const int c = EPI_COL(bj); const f32x4 ga = *(const f32x4*)(g1 + c), gb = *(const f32x4*)(g1 + c + 4);
#pragma unroll
            for (int ai = 0; ai < 2; ++ai)
#pragma unroll
                for (int m = 0; m < 4; ++m) { const size_t off = (size_t)EPI_ROW(ai, m) * D + c;
                    f32x4 x0, x1; unpack8(*(const u32x4*)(X + off), x0, x1);
                    st16((XO + off), pack8(x0 + ga * acc[ai][bj][m][0], x1 + gb * acc[ai][bj][m][1])); }
        }
    }
};
struct EpiUp {
    bf16_t* ACT;
    __device__ __forceinline__ void operator()(const ACC_T, const Unit& u, int wr, int wc, int fr, int fq) const {
#pragma unroll
        for (int ai = 0; ai < 2; ++ai)
#pragma unroll
            for (int m = 0; m < 4; ++m) {
                f32x4 a = acc[ai][0][m][0], b = acc[ai][0][m][1]; const f32x4 c = acc[ai][1][m][0], d = acc[ai][1][m][1];
#pragma unroll
                for (int j = 0; j < 4; ++j) { a[j] = a[j] * sigm(a[j]) * c[j]; b[j] = b[j] * sigm(b[j]) * d[j]; }
                st16((ACT + (size_t)EPI_ROW(ai, m) * FF + u.pn * 128 + wc * 32 + fq * 8), pack8(a, b));
            }
    }
};
struct EpiDown {
    bf16_t* Y2; const unsigned* list; const float* gw;
    __device__ __forceinline__ void operator()(const ACC_T, const Unit& u, int wr, int wc, int fr, int fq) const {
#pragma unroll
        for (int ai = 0; ai < 2; ++ai)
#pragma unroll
            for (int m = 0; m < 4; ++m) {
                const int rloc = ai * 128 + wr * 64 + m * 16 + fr;
                if (rloc < u.nv) {
                    const unsigned entry = list[(size_t)u.be * T + u.rl * 256 + rloc]; const float w = gw[entry];
#pragma unroll
                    for (int bj = 0; bj < 2; ++bj) { const f32x4 a = acc[ai][bj][m][0] * (w * 16.f), b = acc[ai][bj][m][1] * (w * 16.f); u32x2 q;
                        q.x = (unsigned)__builtin_amdgcn_cvt_pk_fp8_f32(a[2], a[3], __builtin_amdgcn_cvt_pk_fp8_f32(a[0], a[1], 0, false), true);
                        q.y = (unsigned)__builtin_amdgcn_cvt_pk_fp8_f32(b[2], b[3], __builtin_amdgcn_cvt_pk_fp8_f32(b[0], b[1], 0, false), true);
                        st8(((unsigned char*)Y2 + (size_t)entry * D + EPI_COL(bj)), q); }
                }
            }
    }
};
}

namespace at {
struct Tensors { const bf16_t* Q; int qp; const bf16_t* K; int kp; const bf16_t* V; int vp; bf16_t* O; int op; int group; };
__device__ __forceinline__ bool next_unit(int i, int vcu, int G, int& bh, int& qb) {
    int u;
    if (G == 256) { if (i >= 4) return false; u = (vcu >> 5) * 128 + i * 32 + (vcu & 31); }
    else { u = i * G + vcu; if (u >= 1024) return false; }
    bh = u >> 4; qb = u & 15; return true;
}
template <int DQK>
__device__ __forceinline__ void attn_phase_ref(int tid, const Tensors& A, int vcu, int G) {
    int bh, qb;
    for (int i = 0; next_unit(i, vcu, G, bh, qb); ++i) {
        const int b = bh >> 3, h = bh & 7, kvh = h / A.group;
        {
            const int dh = tid >> 8;
            const size_t row = (size_t)b * S + qb * 256 + (tid & 255);
            float q[DQK], o[32];
#pragma unroll
            for (int d = 0; d < DQK; ++d) q[d] = bf2f(A.Q[row * A.qp + h * DQK + d]);
#pragma unroll
            for (int d = 0; d < 32; ++d) o[d] = 0.f;
            float l = 0.f;
            for (int k = 0; k < S; ++k) {
                const bf16_t* kr = A.K + ((size_t)b * S + k) * A.kp + kvh * DQK; const bf16_t* vr = A.V + ((size_t)b * S + k) * A.vp + kvh * 64 + dh * 32;
                float sc = 0.f;
#pragma unroll
                for (int d = 0; d < DQK; d += 8) { f32x4 k0, k1; unpack8(*(const u32x4*)(kr + d), k0, k1);
                    sc += q[d] * k0[0] + q[d + 1] * k0[1] + q[d + 2] * k0[2] + q[d + 3] * k0[3] + q[d + 4] * k1[0] + q[d + 5] * k1[1] + q[d + 6] * k1[2] + q[d + 7] * k1[3]; }
                const float p = bf2f(cvt_pk_bf16(exp2f(sc), 0.f) & 0xffffu); l += p;
#pragma unroll
                for (int d = 0; d < 32; d += 8) { f32x4 v0, v1; unpack8(*(const u32x4*)(vr + d), v0, v1);
                    o[d] += p * v0[0]; o[d + 1] += p * v0[1]; o[d + 2] += p * v0[2]; o[d + 3] += p * v0[3]; o[d + 4] += p * v1[0]; o[d + 5] += p * v1[1]; o[d + 6] += p * v1[2]; o[d + 7] += p * v1[3]; }
            }
            const float il = 1.f / l;
            __syncthreads();
#pragma unroll
            for (int d = 0; d < 32; d += 8) { f32x4 a = {o[d] * il, o[d + 1] * il, o[d + 2] * il, o[d + 3] * il}, c = {o[d + 4] * il, o[d + 5] * il, o[d + 6] * il, o[d + 7] * il};
                *(u32x4*)(A.O + row * A.op + h * 64 + dh * 32 + d) = pack8(a, c); }
        }
    }
}
#if FAST_ATTN
typedef short s16x4 __attribute__((ext_vector_type(4)));
__device__ __forceinline__ unsigned cvtpk(float lo, float hi) { f32x2 v = {lo, hi}; bf16x2_t b = __builtin_convertvector(v, bf16x2_t); return __builtin_bit_cast(unsigned, b); }
__device__ __forceinline__ s16x4 vtr(const LAS unsigned char* p) { return __builtin_bit_cast(s16x4, __builtin_amdgcn_ds_read_tr16_b64_v4i16((LAS s16x4*)p)); }
__device__ __forceinline__ int crow(int r, int hi) { return (r & 3) + 8 * (r >> 2) + 4 * hi; }
#define AT_BAR() asm volatile("s_barrier" ::: "memory")
#define AT_WAITBAR(N) asm volatile("s_waitcnt vmcnt(" #N ") lgkmcnt(0)\n\ts_barrier" ::: "memory")
#define AT_SCHED() __builtin_amdgcn_sched_barrier(0)
__device__ __forceinline__ void glds16(const void* gsrc, unsigned lds_dst) { unsigned keep;
    asm volatile("s_mov_b32 %0, m0\n\ts_mov_b32 m0, %2\n\ts_nop 0\n\tglobal_load_lds_dwordx4 %1, off\n\ts_mov_b32 m0, %0" : "=&s"(keep) : "v"(gsrc), "s"(lds_dst) : "memory"); }
#define AT_GLDS(g, l) glds16((const void*)(g), (unsigned)__builtin_amdgcn_readfirstlane((int)(unsigned)(uintptr_t)(l)))
template <int DQK>
__device__ __forceinline__ void attn_unit(int tid, LAS unsigned char* lds, const Tensors& A, int b, int h, int qb) {
    constexpr int ND = DQK / 16, NCH = DQK / 8, KSLOT = NCH * 1024, NKD = NCH > 8 ? 2 : 1, VSLOT = 8192, NT = S / 64;
    constexpr int KOFF = 0, VOFF = 3 * KSLOT, OST = VOFF + 3 * VSLOT, WSF = OST + 8 * 4096;
    static_assert(WSF + 8 * 256 <= RING_BYTES, "attention LDS");
    const int lane = tid & 63, r32 = lane & 31, hi = lane >> 5, wid = __builtin_amdgcn_readfirstlane(tid >> 6);
    const int kvh = h / A.group; const size_t rowb = (size_t)b * S;
    const bf16_t* ksrc = A.K + (rowb + lane) * A.kp + kvh * DQK + wid * 8;
    const bf16_t* ksrc2 = A.K + (rowb + lane) * A.kp + kvh * DQK + (8 + (wid & 3)) * 8;
    const bf16_t* vsrc = A.V + (rowb + 16 * (wid & 3) + (lane >> 2)) * A.vp + kvh * 64 + (wid >> 2) * 32 + (lane & 3) * 8;
    const size_t ktile = (size_t)64 * A.kp, vtile = (size_t)64 * A.vp;
    LAS unsigned char* kdst = lds + KOFF + wid * 1024; LAS unsigned char* kdst2 = lds + KOFF + (8 + (wid & 3)) * 1024; LAS unsigned char* vdst = lds + VOFF + wid * 1024;
#define DMA_K(j, so) do { AT_GLDS(ksrc + (size_t)(j) * ktile, kdst + (so)); if (NKD == 2) AT_GLDS(ksrc2 + (size_t)(j) * ktile, kdst2 + (so)); } while (0)
#define DMA_V(j, so) AT_GLDS(vsrc + (size_t)(j) * vtile, vdst + (so))
    const LAS unsigned char* kp0 = lds + KOFF + hi * 1024 + r32 * 16;
    const LAS unsigned char* vp0 = lds + VOFF + ((lane >> 4) & 1) * 32 + (lane & 3) * 8 + (4 * hi + ((lane & 15) >> 2)) * 64;
    DMA_K(0, 0); DMA_V(0, 0); DMA_K(1, KSLOT); DMA_V(1, VSLOT); DMA_K(2, 2 * KSLOT);
    const bf16_t* Qw = A.Q + (rowb + qb * 256 + wid * 32 + r32) * A.qp + h * DQK + hi * 8;
    bf16x8 qr[ND];
#pragma unroll
    for (int d0 = 0; d0 < ND; ++d0) qr[d0] = *(const bf16x8*)(Qw + d0 * 16);
    asm volatile("s_waitcnt vmcnt(0)\n\ts_barrier" ::: "memory");
    bf16x8 kf[2 * ND]; s16x4 vlo[8], vhi[8];
#define KLOAD(so) do { _Pragma("unroll") for (int d0 = 0; d0 < ND; ++d0) { kf[2 * d0] = *(const LAS bf16x8*)(kp0 + (so) + d0 * 2048); kf[2 * d0 + 1] = *(const LAS bf16x8*)(kp0 + (so) + d0 * 2048 + 512); } } while (0)
#define VLOAD(so) do { _Pragma("unroll") for (int i = 0; i < 8; ++i) { vlo[i] = vtr(vp0 + (so) + (i >> 2) * 4096 + (i & 3) * 1024); vhi[i] = vtr(vp0 + (so) + (i >> 2) * 4096 + (i & 3) * 1024 + 512); } } while (0)
#define VFR(i) (bf16x8){vlo[i][0], vlo[i][1], vlo[i][2], vlo[i][3], vhi[i][0], vhi[i][1], vhi[i][2], vhi[i][3]}
    KLOAD(0);
    asm volatile("s_waitcnt lgkmcnt(0)" ::: "memory");
    if (PROBE_ATT != 5 && wid >= 4) AT_BAR();
    f32x16 o0 = {}, o1 = {}, C0, C1; u32x4 pw0, pw1, pw2, pw3; float lsum = 0.f;
    const f32x16 zero = {};
#define QK_BLOCK() do { C0 = __builtin_amdgcn_mfma_f32_32x32x16_bf16(kf[0], qr[0], zero, 0, 0, 0); C1 = __builtin_amdgcn_mfma_f32_32x32x16_bf16(kf[1], qr[0], zero, 0, 0, 0); \
        _Pragma("unroll") for (int d0 = 1; d0 < ND; ++d0) { C0 = __builtin_amdgcn_mfma_f32_32x32x16_bf16(kf[2 * d0], qr[d0], C0, 0, 0, 0); C1 = __builtin_amdgcn_mfma_f32_32x32x16_bf16(kf[2 * d0 + 1], qr[d0], C1, 0, 0, 0); } } while (0)
#define PAF(k) __builtin_bit_cast(bf16x8, pw##k)
#define PV_BLOCK() do { \
        o0 = __builtin_amdgcn_mfma_f32_32x32x16_bf16(PAF(0), VFR(0), o0, 0, 0, 0); o1 = __builtin_amdgcn_mfma_f32_32x32x16_bf16(PAF(0), VFR(4), o1, 0, 0, 0); \
        o0 = __builtin_amdgcn_mfma_f32_32x32x16_bf16(PAF(1), VFR(1), o0, 0, 0, 0); o1 = __builtin_amdgcn_mfma_f32_32x32x16_bf16(PAF(1), VFR(5), o1, 0, 0, 0); \
        o0 = __builtin_amdgcn_mfma_f32_32x32x16_bf16(PAF(2), VFR(2), o0, 0, 0, 0); o1 = __builtin_amdgcn_mfma_f32_32x32x16_bf16(PAF(2), VFR(6), o1, 0, 0, 0); \
        o0 = __builtin_amdgcn_mfma_f32_32x32x16_bf16(PAF(3), VFR(3), o0, 0, 0, 0); o1 = __builtin_amdgcn_mfma_f32_32x32x16_bf16(PAF(3), VFR(7), o1, 0, 0, 0); } while (0)
#define SOFTMAX() do { \
        _Pragma("unroll") for (int r = 0; r < 16; ++r) { C0[r] = __builtin_amdgcn_exp2f(C0[r]); C1[r] = __builtin_amdgcn_exp2f(C1[r]); } \
        f32x2 s0_ = {C0[0], C0[1]}, s1_ = {C1[0], C1[1]}; _Pragma("unroll") for (int r = 2; r < 16; r += 2) { s0_ += (f32x2){C0[r], C0[r + 1]}; s1_ += (f32x2){C1[r], C1[r + 1]}; } s0_ += s1_; lsum += s0_[0] + s0_[1]; \
        pw0 = (u32x4){cvtpk(C0[0], C0[1]), cvtpk(C0[2], C0[3]), cvtpk(C0[4], C0[5]), cvtpk(C0[6], C0[7])}; pw1 = (u32x4){cvtpk(C0[8], C0[9]), cvtpk(C0[10], C0[11]), cvtpk(C0[12], C0[13]), cvtpk(C0[14], C0[15])}; \
        pw2 = (u32x4){cvtpk(C1[0], C1[1]), cvtpk(C1[2], C1[3]), cvtpk(C1[4], C1[5]), cvtpk(C1[6], C1[7])}; pw3 = (u32x4){cvtpk(C1[8], C1[9]), cvtpk(C1[10], C1[11]), cvtpk(C1[12], C1[13]), cvtpk(C1[14], C1[15])}; } while (0)
    int ka = 2 * KSLOT, kb = 0, kc = KSLOT, va = 2 * VSLOT, vb = 0, vc = VSLOT;
#define ROT() do { const int t_ = ka; ka = kb; kb = kc; kc = t_; const int u_ = va; va = vb; vb = vc; vc = u_; } while (0)
#define PINP() asm volatile("" : "+v"(lsum) : "v"(pw0), "v"(pw1), "v"(pw2), "v"(pw3))
#if ATT_REGSTAGE
    u32x4 kst = {}, kst2 = {}, vst = {};
    const LAS unsigned char* kw = lds + KOFF + wid * 1024 + lane * 16; const LAS unsigned char* kw2 = lds + KOFF + (8 + (wid & 3)) * 1024 + lane * 16; const LAS unsigned char* vw = lds + VOFF + wid * 1024 + lane * 16;
#define ST_WRITE(WK, WV) do { if (WK) { *(LAS u32x4*)(kw + ka) = kst; if (NKD == 2 && wid < 4) *(LAS u32x4*)(kw2 + ka) = kst2; } if (WV) *(LAS u32x4*)(vw + vc) = vst; } while (0)
#define ST_LOAD(sv, IK, IV) do { if (IK) { kst = *(const u32x4*)(ksrc + (size_t)((sv) + 4) * ktile); if (NKD == 2 && wid < 4) kst2 = *(const u32x4*)(ksrc2 + (size_t)((sv) + 4) * ktile); } if (IV) vst = *(const u32x4*)(vsrc + (size_t)((sv) + 3) * vtile); } while (0)
#define STEP(sv, DOQK, DOPV, KL, VL, IK, IV, WK, WV) do { \
        AT_SCHED(); if (DOQK) QK_BLOCK(); if (DOPV) PV_BLOCK(); AT_SCHED(); \
        asm volatile("s_barrier\n\ts_nop 15\n\ts_nop 3" : "+v"(C0), "+v"(C1), "+v"(o0), "+v"(o1) :: "memory"); AT_SCHED(); \
        if (KL) KLOAD(kc); if (VL) VLOAD(vb); ST_WRITE(WK, WV); ST_LOAD(sv, IK, IV); \
        if (DOQK) { SOFTMAX(); PINP(); } AT_SCHED(); \
        asm volatile("s_waitcnt lgkmcnt(0)\n\ts_barrier" ::: "memory"); \
        AT_SCHED(); ROT(); } while (0)
    STEP(-1, true, false, true, true, true, true, false, false);
#pragma nounroll
    for (int s = 0; s < NT - 4; ++s) STEP(s, true, true, true, true, true, true, true, true);
    STEP(NT - 4, true, true, true, true, false, true, true, true);
    STEP(NT - 3, true, true, true, true, false, false, false, true);
    STEP(NT - 2, true, true, false, true, false, false, false, false);
    STEP(NT - 1, false, true, false, false, false, false, false, false);
#undef ST_WRITE
#undef ST_LOAD
#else
#define STEP(sv, DOQK, DOPV, KL, VL, IK, IV) do { \
        AT_SCHED(); if (DOQK) QK_BLOCK(); if (DOPV) PV_BLOCK(); AT_SCHED(); \
          \
        asm volatile("s_barrier\n\ts_nop 15\n\ts_nop 3" : "+v"(C0), "+v"(C1), "+v"(o0), "+v"(o1) :: "memory"); AT_SCHED(); \
        if (KL) KLOAD(kc); if (VL) VLOAD(vb); if (IK) DMA_K((sv) + 4, kb); if (IV) DMA_V((sv) + 3, va); \
        if (DOQK) { SOFTMAX(); PINP(); } AT_SCHED(); \
        if (IK) { if (NKD == 2) { AT_WAITBAR(3); } else { AT_WAITBAR(2); } } else if (IV) { AT_WAITBAR(1); } else { AT_WAITBAR(0); } \
        AT_SCHED(); ROT(); } while (0)
    STEP(-1, true, false, true, true, true, true);
#pragma nounroll
    for (int s = 0; s < NT - 4; ++s) STEP(s, true, true, true, true, true, true);
    STEP(NT - 4, true, true, true, true, false, true);
    STEP(NT - 3, true, true, true, true, false, false);
    STEP(NT - 2, true, true, false, true, false, false);
    STEP(NT - 1, false, true, false, false, false, false);
#endif
#undef STEP
#undef PINP
    if (PROBE_ATT != 5 && wid < 4) AT_BAR();
    { auto rr = __builtin_amdgcn_permlane32_swap(__float_as_uint(lsum), __float_as_uint(lsum), false, false); lsum = __uint_as_float(rr[0]) + __uint_as_float(rr[1]); }
    LAS float* wsf = (LAS float*)(lds + WSF + wid * 256);
    if (hi == 0) wsf[r32] = lsum;
    asm volatile("s_waitcnt lgkmcnt(0)" ::: "memory");
    LAS bf16_t* stg = (LAS bf16_t*)(lds + OST + wid * 4096);
#pragma unroll
    for (int r = 0; r < 16; ++r) { const int orow = crow(r, hi); const float rl = __builtin_amdgcn_rcpf(wsf[orow]);
        stg[orow * 64 + r32] = (bf16_t)(cvtpk(o0[r] * rl, 0.f) & 0xffffu); stg[orow * 64 + 32 + r32] = (bf16_t)(cvtpk(o1[r] * rl, 0.f) & 0xffffu); }
    asm volatile("s_waitcnt lgkmcnt(0)" ::: "memory");
    bf16_t* Ow = A.O + (rowb + qb * 256 + wid * 32) * A.op + h * 64;
#pragma unroll
    for (int i = 0; i < 4; ++i) { const int row = i * 8 + (lane >> 3), ch = lane & 7; const u32x4 v = *(const LAS u32x4*)(stg + row * 64 + ch * 8); st16((Ow + (size_t)row * A.op + ch * 8), v); }
    asm volatile("s_waitcnt lgkmcnt(0)\n\ts_barrier" ::: "memory");
#undef DMA_K
#undef DMA_V
#undef KLOAD
#undef VLOAD
#undef VFR
#undef QK_BLOCK
#undef PAF
#undef PV_BLOCK
#undef SOFTMAX
#undef ROT
}
#endif
template <int DQK>
__device__ __forceinline__ void attn_phase(int tid, LAS unsigned char* lds, const Tensors& A, int vcu, int G) {
#if FAST_ATTN
    int bh, qb;
    for (int i = 0; next_unit(i, vcu, G, bh, qb); ++i) attn_unit<DQK>(tid, lds, A, bh >> 3, bh & 7, qb);
#else
    (void)lds; attn_phase_ref<DQK>(tid, A, vcu, G);
#endif
}
}


struct Args { const float* in[22]; float* out; unsigned char* ws; int ph_lo, ph_hi; };
struct Frame {
    LAS unsigned char* lds; volatile LAS unsigned* MISC; unsigned* ctl;
    int tid, lane, wave, vcu, G;
    unsigned char* ws; float* OUT;
};

__device__ __forceinline__ void p0_phase(Frame& F, const float* c, const float* w_ada, const float* b_ada) {
    LAS float* cs = (LAS float*)F.lds;
    LAS float* red = (LAS float*)(F.lds + 32768);
    for (int i = F.tid; i < NB * D; i += NTHREADS) { const float v = c[i]; cs[i] = v / (1.f + __expf(-v)); }
    __syncthreads();
    float* mod = (float*)(F.ws + WS_MOD);
    const int kq = F.wave, col = F.lane;
    for (int item = F.vcu; item < NL * 6 * D / 64; item += F.G) {
        const int l = item / (6 * D / 64), n0 = (item % (6 * D / 64)) * 64;
        const float* w = w_ada + (size_t)l * D * 6 * D + n0 + col;
        float acc[NB];
#pragma unroll
        for (int b = 0; b < NB; ++b) acc[b] = 0.f;
#pragma unroll 8
        for (int k = kq * 128; k < kq * 128 + 128; ++k) { const float wv = w[(size_t)k * 6 * D];
#pragma unroll
            for (int b = 0; b < NB; ++b) acc[b] += cs[b * D + k] * wv; }
#pragma unroll
        for (int b = 0; b < NB; ++b) red[(kq * NB + b) * 64 + col] = acc[b];
        __syncthreads();
        { const int b = F.wave; float s = 0.f;
#pragma unroll
          for (int q = 0; q < 8; ++q) s += red[(q * NB + b) * 64 + col];
          mod[((size_t)l * NB + b) * 6 * D + n0 + col] = s + b_ada[(size_t)l * 6 * D + n0 + col]; }
        __syncthreads();
    }
    float* cosA = (float*)(F.ws + WS_COSA); float* sinA = (float*)(F.ws + WS_SINA); float* cosB = (float*)(F.ws + WS_COSB); float* sinB = (float*)(F.ws + WS_SINB);
    for (int idx = F.vcu * NTHREADS + F.tid; idx < S * 48; idx += F.G * NTHREADS) {
        const int s = idx / 48, i = idx % 48; const float row = (float)(s >> 6), col2 = (float)(s & 63);
        if (i < 32) { const int j = i & 15; const float a = (i < 16 ? row : col2) * (1.0f / powf(10000.0f, (float)j / 16.0f)); cosA[s * 32 + i] = cosf(a); sinA[s * 32 + i] = sinf(a); }
        else { const int ii = i - 32, j = ii & 7; const float a = (ii < 8 ? row : col2) * (1.0f / powf(10000.0f, (float)j / 8.0f)); cosB[s * 16 + ii] = cosf(a); sinB[s * 16 + ii] = sinf(a); }
    }
}

template <class SrcFn>
__device__ __forceinline__ void cvt_item(const float* W, int K, int Nsrc, const float* kg, bf16_t* WT, LAS float* scr, int item, int nblk, int lane, const SrcFn& src) {
    const int kb = item / nblk, nb = item % nblk, k0 = 64 * kb, n0 = 32 * nb;
    const int sc = src(n0 + (lane & 31));
#pragma unroll
    for (int i = 0; i < 32; ++i) { const int kk = 2 * i + (lane >> 5); float v = sc >= 0 ? W[(size_t)(k0 + kk) * Nsrc + sc] : 0.f; if (kg) v *= kg[k0 + kk]; scr[kk * 33 + (lane & 31)] = v; }
    LDS_WAIT(); asm volatile("" ::: "memory");
    const int c = lane & 7;
#pragma unroll
    for (int j = 0; j < 4; ++j) { const int n = (lane >> 3) + 8 * j; const LAS float* s = scr + (8 * c) * 33 + n;
        u32x4 o; o.x = cvt_pk_bf16(s[0 * 33], s[1 * 33]); o.y = cvt_pk_bf16(s[2 * 33], s[3 * 33]); o.z = cvt_pk_bf16(s[4 * 33], s[5 * 33]); o.w = cvt_pk_bf16(s[6 * 33], s[7 * 33]);
        *(u32x4*)(WT + (size_t)(n0 + n) * K + k0 + 8 * c) = o; }
    LDS_WAIT(); asm volatile("" ::: "memory");
}
struct SrcId { __device__ int operator()(int n) const { return n; } };
struct SrcIn { __device__ int operator()(int n) const { return gp::src_col_in(n); } };
typedef __attribute__((address_space(4))) const Args CArgsW;
__device__ __forceinline__ void convert_weights(Frame& F, CArgsW* a, int l) {
    LAS float* scr = (LAS float*)(F.lds + F.wave * 16384);
    const int gw = F.vcu * NWAVES + F.wave, NGW = F.G * NWAVES;
    const float* w_in = ((const float*)(GAS const float*)a->in[5]) + (size_t)l * D * INC; const float* w_q_b = ((const float*)(GAS const float*)a->in[10]) + (size_t)l * 384 * 768; const float* w_kv_b = ((const float*)(GAS const float*)a->in[11]) + (size_t)l * 256 * 1024;
    const float* w_pa = ((const float*)(GAS const float*)a->in[12]) + (size_t)l * 512 * D; const float* w_pb = ((const float*)(GAS const float*)a->in[13]) + (size_t)l * 512 * D; const float* w_o = ((const float*)(GAS const float*)a->in[14]) + (size_t)l * D * D;
    const float* w1 = ((const float*)(GAS const float*)a->in[18]) + (size_t)l * NE * D * FF; const float* w3 = ((const float*)(GAS const float*)a->in[19]) + (size_t)l * NE * D * FF; const float* w2 = ((const float*)(GAS const float*)a->in[20]) + (size_t)l * NE * FF * D;
    const float* gqa = ((const float*)(GAS const float*)a->in[8]) + l * 384; const float* gkv = ((const float*)(GAS const float*)a->in[9]) + l * 256;
    bf16_t* Win = (bf16_t*)(F.ws + WS_WIN); bf16_t* Wqb = (bf16_t*)(F.ws + WS_WQB); bf16_t* Wkvb = (bf16_t*)(F.ws + WS_WKVB); bf16_t* Wpa = (bf16_t*)(F.ws + WS_WPA); bf16_t* Wpb = (bf16_t*)(F.ws + WS_WPB);
    bf16_t* Wo = (bf16_t*)(F.ws + WS_WO); bf16_t* W13 = (bf16_t*)(F.ws + WS_W13); bf16_t* W2 = (bf16_t*)(F.ws + WS_W2);
    constexpr int I_IN = (D / 64) * (NIN / 32), I_QB = (384 / 64) * (768 / 32), I_KVB = (256 / 64) * (1024 / 32), I_P = (512 / 64) * (D / 32), I_O = (D / 64) * (D / 32);
    constexpr int I_13 = (D / 64) * (1024 / 32), I_2 = (FF / 64) * (D / 32);
    constexpr int NITEMS = I_IN + I_QB + I_KVB + 2 * I_P + I_O + NE * (I_13 + I_2);
    for (int it = gw; it < NITEMS; it += NGW) {
        int r = it;
        if (r < I_IN) { cvt_item(w_in, D, INC, nullptr, Win, scr, r, NIN / 32, F.lane, SrcIn()); continue; } r -= I_IN;
        if (r < I_QB) { cvt_item(w_q_b, 384, 768, gqa, Wqb, scr, r, 768 / 32, F.lane, SrcId()); continue; } r -= I_QB;
        if (r < I_KVB) { cvt_item(w_kv_b, 256, 1024, gkv, Wkvb, scr, r, 1024 / 32, F.lane, SrcId()); continue; } r -= I_KVB;
        if (r < I_P) { cvt_item(w_pa, 512, D, nullptr, Wpa, scr, r, D / 32, F.lane, SrcId()); continue; } r -= I_P;
        if (r < I_P) { cvt_item(w_pb, 512, D, nullptr, Wpb, scr, r, D / 32, F.lane, SrcId()); continue; } r -= I_P;
        if (r < I_O) { cvt_item(w_o, D, D, nullptr, Wo, scr, r, D / 32, F.lane, SrcId()); continue; } r -= I_O;
        if (r < NE * I_13) { const int e = r / I_13, q = r % I_13, nb = q % 32;
            const float* src = ((nb & 7) < 4 ? w1 : w3) + (size_t)e * D * FF; const int cb = (nb >> 3) * 128 + (nb & 3) * 32;
            struct SrcOff { int n0, cb; __device__ int operator()(int n) const { return cb + (n - n0); } } so{nb * 32, cb};
            cvt_item(src, D, FF, nullptr, W13 + (size_t)e * 1024 * D, scr, q, 32, F.lane, so); continue; } r -= NE * I_13;
        { const int e = r / I_2, q = r % I_2; cvt_item(w2 + (size_t)e * FF * D, FF, D, nullptr, W2 + (size_t)e * D * FF, scr, q, D / 32, F.lane, SrcId()); }
    }
}

template <int MODE>
__device__ __forceinline__ void row_phase(Frame& F, const float* xin, const float* g2prev, const float* gain, const float* modl, int sh_off, int sc_off, bf16_t* H, bf16_t* XB, float* OUT) {
    constexpr int RB = 4;
    const int gw = F.vcu * NWAVES + F.wave, NGW = F.G * NWAVES;
    const bf16_t* Y2 = (const bf16_t*)(F.ws + WS_Y2);
    for (int m0 = gw; m0 < T; m0 += RB * NGW) {
        f32x4 v[RB][4]; float ss[RB];
        if (MODE == 0) {
#pragma unroll
            for (int r = 0; r < RB; ++r)
#pragma unroll
                for (int j = 0; j < 4; ++j) v[r][j] = *(const f32x4*)(xin + (size_t)(m0 + r * NGW) * D + 4 * F.lane + 256 * j);
        } else {
            unsigned ya[RB][4], yb[RB][4]; f32x4 g[RB][4];
#pragma unroll
            for (int r = 0; r < RB; ++r)
#pragma unroll
                for (int j = 0; j < 4; ++j) { const int m = m0 + r * NGW, c = 4 * F.lane + 256 * j;
                    { const u32x2 xb = *(const u32x2*)(XB + (size_t)m * D + c); v[r][j] = (f32x4){bf2f(xb.x & 0xffffu), bf2f(xb.x >> 16), bf2f(xb.y & 0xffffu), bf2f(xb.y >> 16)}; } ya[r][j] = *(const unsigned*)((const unsigned char*)Y2 + (size_t)(2 * m) * D + c); yb[r][j] = *(const unsigned*)((const unsigned char*)Y2 + (size_t)(2 * m + 1) * D + c);
                    g[r][j] = *(const f32x4*)(g2prev + (size_t)(m >> 12) * 6 * D + 5 * D + c); }
#pragma unroll
            for (int r = 0; r < RB; ++r)
#pragma unroll
                for (int j = 0; j < 4; ++j) { const f32x2 a0 = __builtin_amdgcn_cvt_pk_f32_fp8((int)ya[r][j], false), a1 = __builtin_amdgcn_cvt_pk_f32_fp8((int)ya[r][j], true), b0 = __builtin_amdgcn_cvt_pk_f32_fp8((int)yb[r][j], false), b1 = __builtin_amdgcn_cvt_pk_f32_fp8((int)yb[r][j], true);
                    const f32x4 y = (f32x4){a0[0] + b0[0], a0[1] + b0[1], a1[0] + b1[0], a1[1] + b1[1]} * 0.0625f;
                    v[r][j] += g[r][j] * y; }
        }
#pragma unroll
        for (int r = 0; r < RB; ++r) { ss[r] = (gp::dot4(v[r][0]) + gp::dot4(v[r][1])) + (gp::dot4(v[r][2]) + gp::dot4(v[r][3])); }
#pragma unroll
        for (int o = 1; o < 64; o <<= 1)
#pragma unroll
            for (int r = 0; r < RB; ++r) ss[r] += __shfl_xor(ss[r], o);
#pragma unroll
        for (int r = 0; r < RB; ++r) {
            const int m = m0 + r * NGW, b = m >> 12; const float rstd = rsqrtf(ss[r] * (1.f / D) + EPS);
#pragma unroll
            for (int j = 0; j < 4; ++j) {
                const int c = 4 * F.lane + 256 * j; const f32x4 gn = *(const f32x4*)(gain + c);
                if (MODE == 2) { *(f32x4*)(OUT + (size_t)m * D + c) = v[r][j] * rstd * gn; }
                else {
                    { u32x2 xw; xw.x = cvt_pk_bf16(v[r][j][0], v[r][j][1]); xw.y = cvt_pk_bf16(v[r][j][2], v[r][j][3]); st8((XB + (size_t)m * D + c), xw); }
                    const f32x4 sc = *(const f32x4*)(modl + (size_t)b * 6 * D + sc_off + c), sh = *(const f32x4*)(modl + (size_t)b * 6 * D + sh_off + c);
                    const f32x4 hv = v[r][j] * rstd * gn * (1.f + sc) + sh;
                    u32x2 w; w.x = cvt_pk_bf16(hv[0], hv[1]); w.y = cvt_pk_bf16(hv[2], hv[3]);
                    st8((H + (size_t)m * D + c), w);
                }
            }
        }
    }
}

__device__ __forceinline__ void t2_phase(Frame& F, const float* gain, const float* modl, const float* w_router, const float* rbias, int l, bool record) {
    LAS f32x4* wl = (LAS f32x4*)F.lds;
    LAS int* rec = (LAS int*)(F.lds + 65536);
    LAS float* recw = (LAS float*)(F.lds + 65536 + 2048);
    LAS int* lcnt = (LAS int*)(F.lds + 65536 + 4096);
    for (int idx = F.tid; idx < 4096; idx += NTHREADS) {
        const int lane = idx & 63, c = (idx >> 6) & 3, i = (idx >> 8) & 3, j = idx >> 10; const int k = 4 * lane + 256 * j + i;
        wl[idx] = *(const f32x4*)(w_router + (size_t)k * NE + 4 * c);
    }
    if (F.tid < 32) lcnt[F.tid] = 0;
    __syncthreads();
    constexpr int RB = 4;
    const int gw = F.vcu * NWAVES + F.wave, NGW = F.G * NWAVES;
    bf16_t* H = (bf16_t*)(F.ws + WS_H); const bf16_t* XB = (const bf16_t*)(F.ws + WS_XB);
    const int lane = F.lane, myrow = lane >> 4, mye = lane & 15;
    int it = 0;
    for (int m0 = gw; m0 < T; m0 += RB * NGW, ++it) {
        f32x4 v[RB][4]; float ss[RB];
#pragma unroll
        for (int r = 0; r < RB; ++r)
#pragma unroll
            for (int j = 0; j < 4; ++j) { const u32x2 xb = *(const u32x2*)(XB + (size_t)(m0 + r * NGW) * D + 4 * lane + 256 * j); v[r][j] = (f32x4){bf2f(xb.x & 0xffffu), bf2f(xb.x >> 16), bf2f(xb.y & 0xffffu), bf2f(xb.y >> 16)}; }
#pragma unroll
        for (int r = 0; r < RB; ++r) ss[r] = (gp::dot4(v[r][0]) + gp::dot4(v[r][1])) + (gp::dot4(v[r][2]) + gp::dot4(v[r][3]));
#pragma unroll
        for (int o = 1; o < 64; o <<= 1)
#pragma unroll
            for (int r = 0; r < RB; ++r) ss[r] += __shfl_xor(ss[r], o);
        float acc[RB * NE];
#pragma unroll
        for (int q = 0; q < RB * NE; ++q) acc[q] = 0.f;
#pragma unroll
        for (int j = 0; j < 4; ++j) {
            const int c = 4 * lane + 256 * j; const f32x4 gn = *(const f32x4*)(gain + c);
#pragma unroll
            for (int r = 0; r < RB; ++r) {
                const int m = m0 + r * NGW, b = m >> 12; const float rstd = rsqrtf(ss[r] * (1.f / D) + EPS);
                const f32x4 sc = *(const f32x4*)(modl + (size_t)b * 6 * D + 4 * D + c), sh = *(const f32x4*)(modl + (size_t)b * 6 * D + 3 * D + c);
                v[r][j] = v[r][j] * rstd * gn * (1.f + sc) + sh;
                u32x2 w; w.x = cvt_pk_bf16(v[r][j][0], v[r][j][1]); w.y = cvt_pk_bf16(v[r][j][2], v[r][j][3]);
                st8((H + (size_t)m * D + c), w);
            }
#pragma unroll
            for (int i = 0; i < 4; ++i)
#pragma unroll
                for (int c4 = 0; c4 < 4; ++c4) { const f32x4 wv = wl[((j * 4 + i) * 4 + c4) * 64 + lane];
#pragma unroll
                    for (int r = 0; r < RB; ++r) { const float hv = v[r][j][i];
                        acc[r * NE + 4 * c4 + 0] += hv * wv[0]; acc[r * NE + 4 * c4 + 1] += hv * wv[1]; acc[r * NE + 4 * c4 + 2] += hv * wv[2]; acc[r * NE + 4 * c4 + 3] += hv * wv[3]; } }
        }
#pragma unroll
        for (int sft = 32; sft >= 1; sft >>= 1) {
            const bool up = (lane & sft) != 0;
#pragma unroll
            for (int k = 0; k < sft; ++k) { const float a = acc[k], b = acc[k + sft]; const float keep = up ? b : a, send = up ? a : b; acc[k] = keep + __shfl_xor(send, sft); }
        }
        const float logit = acc[0];
        const float score = 1.f / (1.f + expf(-logit));
        float scv[NE], bi[NE];
#pragma unroll
        for (int e = 0; e < NE; ++e) { scv[e] = __shfl(score, (lane & 48) | e); bi[e] = scv[e] + rbias[e]; }
        int gsel = 0; float gbest = -INFINITY;
#pragma unroll
        for (int g = 0; g < 4; ++g) { float m1 = -INFINITY, m2 = -INFINITY;
#pragma unroll
            for (int j = 0; j < 4; ++j) { const float x = bi[g * 4 + j]; if (x > m1) { m2 = m1; m1 = x; } else if (x > m2) m2 = x; }
            const float gs = m1 + m2; if (gs > gbest) { gbest = gs; gsel = g; } }
        int e1 = -1, e2 = -1; float b1 = -INFINITY, b2 = -INFINITY, s1 = 0.f, s2 = 0.f;
#pragma unroll
        for (int j = 0; j < 4; ++j) { float x = -INFINITY, sx = 0.f;
#pragma unroll
            for (int g = 0; g < 4; ++g) if (g == gsel) { x = bi[g * 4 + j]; sx = scv[g * 4 + j]; }
            const int e = gsel * 4 + j;
            if (x > b1) { b2 = b1; e2 = e1; s2 = s1; b1 = x; e1 = e; s1 = sx; } else if (x > b2) { b2 = x; e2 = e; s2 = sx; } }
        if (mye == 0) {
            const float inv = 1.f / (s1 + s2); const int slot = (it * RB + myrow) * NWAVES + F.wave;
            rec[slot * 4 + 0] = e1; rec[slot * 4 + 1] = e2;
            rec[slot * 4 + 2] = __hip_atomic_fetch_add(&lcnt[e1], 1, __ATOMIC_RELAXED, __HIP_MEMORY_SCOPE_WORKGROUP);
            rec[slot * 4 + 3] = __hip_atomic_fetch_add(&lcnt[e2], 1, __ATOMIC_RELAXED, __HIP_MEMORY_SCOPE_WORKGROUP);
            recw[slot * 2 + 0] = s1 * inv; recw[slot * 2 + 1] = s2 * inv;
        }
    }
    __syncthreads();
    if (!record) return;
    if (F.tid < NE) lcnt[16 + F.tid] = (int)__hip_atomic_fetch_add(F.ctl + CW_CNT + (l * NE + F.tid) * 64, (unsigned)lcnt[F.tid], __ATOMIC_RELAXED, __HIP_MEMORY_SCOPE_AGENT);
    __syncthreads();
    unsigned* list = (unsigned*)(F.ws + WS_LIST); float* gwb = (float*)(F.ws + WS_GW);
    const int nrows = it * RB;
    for (int s = F.tid; s < nrows * NWAVES; s += NTHREADS) {
        const int i2 = s / NWAVES, w = s % NWAVES; const int m = F.vcu * NWAVES + w + i2 * NGW;
        const int e1 = rec[s * 4 + 0], e2 = rec[s * 4 + 1];
        list[(size_t)e1 * T + lcnt[16 + e1] + rec[s * 4 + 2]] = (unsigned)(2 * m); list[(size_t)e2 * T + lcnt[16 + e2] + rec[s * 4 + 3]] = (unsigned)(2 * m + 1);
        gwb[2 * m] = recw[s * 2]; gwb[2 * m + 1] = recw[s * 2 + 1];
    }
}
__device__ __forceinline__ const LAS int* moe_table(Frame& F, int l) {
    LAS int* tab = (LAS int*)(F.lds + MISC_OFF + 1024);
    __syncthreads();
    if (F.tid == 0) { int acc = 0;
        for (int e = 0; e < NE; ++e) { const int c = (int)__hip_atomic_load(F.ctl + CW_CNT + (l * NE + e) * 64, __ATOMIC_RELAXED, __HIP_MEMORY_SCOPE_AGENT); tab[e] = acc; tab[32 + e] = c; acc += (c + 255) >> 8; }
        tab[16] = acc; }
    __syncthreads();
    return tab;
}

typedef __attribute__((address_space(4))) const Args CArgs;
#define LAUNDER_GP(T_, p) do { GAS T_* _t = (GAS T_*)(p); asm volatile("" : "+s"(_t)); (p) = (T_*)_t; } while (0)
#define PH_BEGIN() LAUNDER_V(F.tid); F.lane = F.tid & 63; LAUNDER_GP(unsigned, F.ctl); LAUNDER_GP(float, F.OUT); LAUNDER_GP(unsigned char, F.ws); GAS unsigned char* ws = (GAS unsigned char*)F.ws; CArgs* ka = (CArgs*)__builtin_amdgcn_kernarg_segment_ptr(); LAUNDER_S(ka); \
    float* mod = WSP(float, WS_MOD); (void)mod; (void)ka
#define WSP(T_, off) ((T_*)(GAS T_*)(ws + (off)))
#define KIN(i) ((const float*)(GAS const float*)ka->in[i])
__global__ void __launch_bounds__(NTHREADS, 2) fwd_kernel(Args args) {
    extern __shared__ __attribute__((aligned(16))) unsigned char lds_raw[];
    Frame F;
    F.lds = (LAS unsigned char*)lds_raw; F.MISC = (volatile LAS unsigned*)(F.lds + MISC_OFF);
    F.tid = threadIdx.x; F.lane = F.tid & 63; F.wave = __builtin_amdgcn_readfirstlane(F.tid >> 6);
    F.G = gridDim.x; { const int bx = blockIdx.x; F.vcu = (F.G % 8 == 0) ? (bx % 8) * (F.G / 8) + bx / 8 : bx; }
    F.ws = (unsigned char*)(GAS unsigned char*)args.ws; F.ctl = (unsigned*)(GAS unsigned*)(args.ws + WS_CTL); F.OUT = (float*)(GAS float*)args.out;
    if (F.tid < 64) F.MISC[F.tid] = 0u;
    __syncthreads();
    XcdBarrier bar; bar.bar = F.ctl + CW_BAR; bar.x = 0; bar.st = nullptr;
    if (!N_LAUNCH_MODE) bar = xcd_barrier_post(F.ctl + CW_BAR, F.MISC + 8);
    const int lo = args.ph_lo, hi = args.ph_hi;
#define IN(k) (lo <= (k) && (k) < hi)
#define SEAM(k) do { if ((k) + 1 < hi) { if (!N_LAUNCH_MODE) xcd_barrier(bar); } } while (0)
    const int cidx = (int)blockIdx.x;

    if (IN(0)) { PH_BEGIN(); p0_phase(F, KIN(1), KIN(2), KIN(3)); __syncthreads(); LAUNDER_V(F.tid); F.lane = F.tid & 63; convert_weights(F, ka, 0); SEAM(0); }
    for (int l = 0; l < NL; ++l) {
        const int pb = 1 + 9 * l;
        if (IN(pb + 0)) {
            PH_BEGIN();
            if (l > 0) for (int rep = 0; rep < ((PROBE_DUP & 8) ? 2 : 1); ++rep) { LAUNDER_V(F.tid); F.lane = F.tid & 63; convert_weights(F, ka, l); }
            if (l == 0) row_phase<0>(F, KIN(0), nullptr, KIN(4) + l * D, mod + (size_t)l * NB * 6 * D, 0, D, WSP(bf16_t, WS_H), WSP(bf16_t, WS_XB), nullptr);
            else row_phase<1>(F, nullptr, mod + (size_t)(l - 1) * NB * 6 * D, KIN(4) + l * D, mod + (size_t)l * NB * 6 * D, 0, D, WSP(bf16_t, WS_H), WSP(bf16_t, WS_XB), nullptr);
            SEAM(pb + 0);
        }
        if (IN(pb + 1)) {
            PH_BEGIN();
            gp::Gemm g{WSP(bf16_t, WS_H), WSP(const bf16_t, WS_WIN), D, 0, nullptr}; gp::DenseOrder So; So.init(T, NIN, F.G, cidx);
            gp::EpiIn E{WSP(bf16_t, WS_QA), WSP(bf16_t, WS_KA), WSP(bf16_t, WS_VA), WSP(bf16_t, WS_QLAT), WSP(bf16_t, WS_KVLAT), WSP(bf16_t, WS_KB), WSP(bf16_t, WS_SA), WSP(bf16_t, WS_SB), WSP(float, WS_SSQ), WSP(float, WS_SSKV),
                        KIN(6) + l * 64, KIN(7) + l * 64, WSP(const float, WS_COSA), WSP(const float, WS_SINA), WSP(const float, WS_COSB), WSP(const float, WS_SINB)};
            if (PROBE_DUP & 128) { gp::EpiNull En; gp::gemm_phase<gp::EpiNull, gp::DenseOrder>(F.tid, F.lds, g, So, En); LAUNDER_V(F.tid); }
            gp::gemm_phase<gp::EpiIn, gp::DenseOrder>(F.tid, F.lds, g, So, E); if (PROBE_DUP & (2 | 512)) { LAUNDER_V(F.tid); gp::gemm_phase<gp::EpiIn, gp::DenseOrder>(F.tid, F.lds, g, So, E); }
            SEAM(pb + 1);
        }
        if (IN(pb + 2)) {
            { PH_BEGIN(); gp::Gemm g{WSP(bf16_t, WS_QLAT), WSP(const bf16_t, WS_WQB), 384, 0, nullptr}; gp::DenseOrder So; So.init(T, 768, F.G, cidx);
              gp::EpiQb E{WSP(bf16_t, WS_QB), WSP(const float, WS_SSQ), WSP(const float, WS_COSB), WSP(const float, WS_SINB)}; gp::gemm_phase<gp::EpiQb, gp::DenseOrder>(F.tid, F.lds, g, So, E); if (PROBE_DUP & 2) { LAUNDER_V(F.tid); gp::gemm_phase<gp::EpiQb, gp::DenseOrder>(F.tid, F.lds, g, So, E); } }
            { PH_BEGIN(); gp::Gemm g{WSP(bf16_t, WS_KVLAT), WSP(const bf16_t, WS_WKVB), 256, 0, nullptr}; gp::DenseOrder So; So.init(T, 1024, F.G, F.G - 1 - cidx);
              gp::EpiKvb E{WSP(bf16_t, WS_KB), WSP(bf16_t, WS_VB), WSP(const float, WS_SSKV)}; gp::gemm_phase<gp::EpiKvb, gp::DenseOrder>(F.tid, F.lds, g, So, E); if (PROBE_DUP & 2) { LAUNDER_V(F.tid); gp::gemm_phase<gp::EpiKvb, gp::DenseOrder>(F.tid, F.lds, g, So, E); } }
            if (PROBE_DUP & 1) { PH_BEGIN(); const at::Tensors A{WSP(bf16_t, WS_QA), 512, WSP(bf16_t, WS_KA), 128, WSP(bf16_t, WS_VA), 128, WSP(bf16_t, WS_OB), 512, 4}; at::attn_phase<64>(F.tid, F.lds, A, F.vcu, F.G); }
            { PH_BEGIN(); const at::Tensors A{WSP(bf16_t, WS_QA), 512, WSP(bf16_t, WS_KA), 128, WSP(bf16_t, WS_VA), 128, WSP(bf16_t, WS_QA), 512, 4}; at::attn_phase<64>(F.tid, F.lds, A, F.vcu, F.G); }
            SEAM(pb + 2);
        }
        if (IN(pb + 3)) {
            PH_BEGIN();
            const at::Tensors A{WSP(bf16_t, WS_QB), 768, WSP(bf16_t, WS_KB), 768, WSP(bf16_t, WS_VB), 512, WSP(bf16_t, WS_OB), 512, 1}; for (int rep = 0; rep < ((PROBE_DUP & 1) ? 2 : 1); ++rep) at::attn_phase<96>(F.tid, F.lds, A, F.vcu, F.G);
            SEAM(pb + 3);
        }
        if (IN(pb + 4)) {
            PH_BEGIN();
            gp::Gemm g{WSP(bf16_t, WS_QA), WSP(const bf16_t, WS_WPA), 512, (size_t)(WS_WPB - WS_WPA) / 2, nullptr, (size_t)(WS_OB - WS_QA) / 2}; gp::PairOrder So; So.init(T, D, F.G, cidx);
            gp::EpiProjP E{WSP(bf16_t, WS_H), WSP(const unsigned char, WS_SA), WSP(const unsigned char, WS_SB)};
            gp::gemm_phase<gp::EpiProjP, gp::PairOrder>(F.tid, F.lds, g, So, E);
            if (PROBE_DUP & (2 | 1024)) { LAUNDER_V(F.tid); gp::gemm_phase<gp::EpiProjP, gp::PairOrder>(F.tid, F.lds, g, So, E); }
            SEAM(pb + 4);
        }
        if (IN(pb + 5)) {
            PH_BEGIN();
            gp::Gemm g{WSP(bf16_t, WS_H), WSP(const bf16_t, WS_WO), D, 0, nullptr}; gp::DenseOrder So; So.init(T, D, F.G, cidx);
            gp::EpiWo E{WSP(const bf16_t, WS_XB), mod + (size_t)l * NB * 6 * D, WSP(bf16_t, WS_XB)}; gp::gemm_phase<gp::EpiWo, gp::DenseOrder>(F.tid, F.lds, g, So, E);
            SEAM(pb + 5);
        }
        if (IN(pb + 6)) {
            PH_BEGIN();
            if (PROBE_DUP & 16) { t2_phase(F, KIN(15) + l * D, mod + (size_t)l * NB * 6 * D, KIN(16), KIN(17), l, false); LAUNDER_V(F.tid); F.lane = F.tid & 63; __syncthreads(); }
            t2_phase(F, KIN(15) + l * D, mod + (size_t)l * NB * 6 * D, KIN(16), KIN(17), l, true);
            SEAM(pb + 6);
        }
        if (IN(pb + 7)) {
            PH_BEGIN();
            const LAS int* tab = moe_table(F, l);
            gp::Gemm g{WSP(bf16_t, WS_H), WSP(const bf16_t, WS_W13), D, (size_t)1024 * D, WSP(const unsigned, WS_LIST)}; gp::MoeOrder So; So.init(tab, F.G, cidx);
            if (PROBE_DUP & 256) { gp::EpiNull En; gp::gemm_phase<gp::EpiNull, gp::MoeOrder, true>(F.tid, F.lds, g, So, En); LAUNDER_V(F.tid); }
            gp::EpiUp E{WSP(bf16_t, WS_ACT)}; gp::gemm_phase<gp::EpiUp, gp::MoeOrder, true>(F.tid, F.lds, g, So, E); if (PROBE_DUP & 4) { LAUNDER_V(F.tid); gp::gemm_phase<gp::EpiUp, gp::MoeOrder, true>(F.tid, F.lds, g, So, E); }
            SEAM(pb + 7);
        }
        if (IN(pb + 8)) {
            PH_BEGIN();
            const LAS int* tab = moe_table(F, l);
            gp::Gemm g{WSP(bf16_t, WS_ACT), WSP(const bf16_t, WS_W2), FF, (size_t)D * FF, nullptr}; gp::MoeOrder So; So.init(tab, F.G, cidx);
            gp::EpiDown E{WSP(bf16_t, WS_Y2), WSP(const unsigned, WS_LIST), WSP(const float, WS_GW)}; gp::gemm_phase<gp::EpiDown, gp::MoeOrder, false>(F.tid, F.lds, g, So, E); if (PROBE_DUP & 4) { LAUNDER_V(F.tid); gp::gemm_phase<gp::EpiDown, gp::MoeOrder, false>(F.tid, F.lds, g, So, E); }
            SEAM(pb + 8);
        }
    }
    if (IN(NPHASE - 1)) { PH_BEGIN(); row_phase<2>(F, nullptr, mod + (size_t)(NL - 1) * NB * 6 * D, KIN(21), nullptr, 0, 0, nullptr, WSP(bf16_t, WS_XB), F.OUT); }
#undef IN
#undef SEAM
}

extern "C" void kernel_launch(void* const* d_in, const int* in_sizes, int n_in, void* d_out, int out_size, void* d_ws, size_t ws_size, hipStream_t stream) {
    static int grid = 0;
    if (grid == 0) {
        if (n_in != 22 || out_size != T * D || ws_size < WS_END) { fprintf(stderr, "kernel_launch: unexpected problem (n_in %d out %d ws %zu)\n", n_in, out_size, ws_size); grid = -1; return; }
        int dev = 0, cus = 0, per_cu = 0;
        if (hipGetDevice(&dev) != hipSuccess || hipDeviceGetAttribute(&cus, hipDeviceAttributeMultiprocessorCount, dev) != hipSuccess) { grid = -1; return; }
        if (hipFuncSetAttribute((const void*)fwd_kernel, hipFuncAttributeMaxDynamicSharedMemorySize, LDS_BYTES) != hipSuccess) { grid = -1; return; }
        if (hipOccupancyMaxActiveBlocksPerMultiprocessor(&per_cu, (const void*)fwd_kernel, NTHREADS, LDS_BYTES) != hipSuccess || per_cu < 1) { fprintf(stderr, "kernel_launch: occupancy query says %d\n", per_cu); }
        (void)hipGetLastError();
        grid = cus;
        if (T % (grid * NWAVES * 4) != 0) { fprintf(stderr, "kernel_launch: grid %d does not divide the row phases\n", grid); grid = -1; return; }
    }
    if (grid < 0) return;
    (void)hipMemsetAsync((char*)d_ws + WS_CTL, 0, CTL_BYTES, stream);
    Args a{};
    for (int i = 0; i < 22; ++i) a.in[i] = (const float*)d_in[i];
    a.out = (float*)d_out; a.ws = (unsigned char*)d_ws;
#if N_LAUNCH_MODE
    for (int p = 0; p < NPHASE; ++p) { a.ph_lo = p; a.ph_hi = p + 1; hipLaunchKernelGGL(fwd_kernel, dim3(grid), dim3(NTHREADS), LDS_BYTES, stream, a); }
#else
    a.ph_lo = 0; a.ph_hi = NPHASE;
    hipLaunchKernelGGL(fwd_kernel, dim3(grid), dim3(NTHREADS), LDS_BYTES, stream, a);
#endif
}
```

```cpp
#include <hip/hip_runtime.h>
#include <stdint.h>
#include <stdio.h>
#include <math.h>

#ifndef FAST_GEMM
#define FAST_GEMM 1
#endif
#ifndef FAST_ATTN
#define FAST_ATTN 1
#endif
#ifndef PROBE_DUP
#define PROBE_DUP 0
#endif
#ifndef PROBE_ATT
#define PROBE_ATT 0
#endif
#ifndef ATT_REGSTAGE
#define ATT_REGSTAGE 0
#endif
#ifndef WT_STORES
#define WT_STORES 0
#endif
#ifndef ATT_FP8_A
#define ATT_FP8_A 1
#endif
#ifndef N_LAUNCH_MODE
#define N_LAUNCH_MODE 0
#endif

#define LAS __attribute__((address_space(3)))
#define GAS __attribute__((address_space(1)))
typedef unsigned short bf16_t;
typedef short bf16x8 __attribute__((ext_vector_type(8)));
typedef float f32x4 __attribute__((ext_vector_type(4)));
typedef float f32x2 __attribute__((ext_vector_type(2)));
typedef float f32x16 __attribute__((ext_vector_type(16)));
typedef unsigned u32x4 __attribute__((ext_vector_type(4)));
typedef unsigned u32x2 __attribute__((ext_vector_type(2)));
typedef GAS unsigned gu32;

constexpr int D = 1024, NB = 8, S = 4096, T = NB * S, NL = 4, INC = 3488, NIN = 3584, NE = 16, FF = 512;
constexpr float EPS = 1e-6f, LOG2E = 1.4426950408889634f;
constexpr float QSCALE_A = 0.125f * LOG2E, QSCALE_B = 0.10206207261596577f * LOG2E;
constexpr int NWAVES = 8, NTHREADS = 512;
constexpr int NPHASE = 2 + 9 * NL;

constexpr size_t MiB = 1u << 20;
constexpr size_t WS_CTL = 0, CTL_BYTES = 1 * MiB;
constexpr size_t WS_MOD = 1 * MiB;
constexpr size_t WS_COSA = 2 * MiB, WS_SINA = WS_COSA + 512 * 1024, WS_COSB = 3 * MiB, WS_SINB = WS_COSB + 256 * 1024;
constexpr size_t WS_SSQ = 4 * MiB, WS_SSKV = 5 * MiB;
constexpr size_t WS_GW = 6 * MiB;
constexpr size_t WS_LIST = 7 * MiB;
constexpr size_t WS_WIN = 10 * MiB, WS_WQB = 17 * MiB, WS_WKVB = 18 * MiB, WS_WPA = 19 * MiB, WS_WPB = 20 * MiB, WS_WO = 21 * MiB, WS_W13 = 23 * MiB, WS_W2 = 55 * MiB;
constexpr size_t WS_H = 72 * MiB;
constexpr size_t WS_QA = 136 * MiB, WS_KA = 168 * MiB, WS_VA = 176 * MiB, WS_QLAT = 184 * MiB, WS_KVLAT = 208 * MiB;
constexpr size_t WS_KB = 224 * MiB, WS_VB = 272 * MiB, WS_QB = 304 * MiB, WS_OB = 352 * MiB, WS_SA = 384 * MiB, WS_SB = 448 * MiB, WS_XB = 512 * MiB, WS_QA8 = 576 * MiB, WS_KA8 = 592 * MiB, WS_VTA8 = 596 * MiB, WS_END = 600 * MiB;
constexpr size_t WS_ACT = 136 * MiB, WS_Y2 = 208 * MiB;
constexpr int ACT_ROWS = 2 * T + NE * 256;
static_assert(WS_ACT + (size_t)ACT_ROWS * FF * 2 <= WS_Y2 && WS_Y2 + (size_t)2 * T * D * 2 <= WS_XB, "moe overlay");
constexpr int CW_BAR = 4096;
constexpr int CW_CNT = 16384;

constexpr int RING_BYTES = 131072, MISC_OFF = RING_BYTES, LDS_BYTES = 147456;

__device__ __forceinline__ float bf2f(unsigned v) { return __uint_as_float(v << 16); }
typedef __bf16 bf16x2_t __attribute__((ext_vector_type(2)));
__device__ __forceinline__ unsigned cvt_pk_bf16(float lo, float hi) { f32x2 v = {lo, hi}; bf16x2_t b = __builtin_convertvector(v, bf16x2_t); return __builtin_bit_cast(unsigned, b); }
__device__ __forceinline__ u32x4 pack8(f32x4 a, f32x4 b) { u32x4 w; w.x = cvt_pk_bf16(a[0], a[1]); w.y = cvt_pk_bf16(a[2], a[3]); w.z = cvt_pk_bf16(b[0], b[1]); w.w = cvt_pk_bf16(b[2], b[3]); return w; }
__device__ __forceinline__ u32x2 pack8_fp8(f32x4 a, f32x4 b) { u32x2 w;
    w.x = (unsigned)__builtin_amdgcn_cvt_pk_fp8_f32(a[2], a[3], __builtin_amdgcn_cvt_pk_fp8_f32(a[0], a[1], 0, false), true);
    w.y = (unsigned)__builtin_amdgcn_cvt_pk_fp8_f32(b[2], b[3], __builtin_amdgcn_cvt_pk_fp8_f32(b[0], b[1], 0, false), true); return w; }
__device__ __forceinline__ void unpack8(u32x4 w, f32x4& a, f32x4& b) { a[0] = bf2f(w.x & 0xffffu); a[1] = bf2f(w.x >> 16); a[2] = bf2f(w.y & 0xffffu); a[3] = bf2f(w.y >> 16); b[0] = bf2f(w.z & 0xffffu); b[1] = bf2f(w.z >> 16); b[2] = bf2f(w.w & 0xffffu); b[3] = bf2f(w.w >> 16); }
__device__ __forceinline__ float wave_sum(float v) {
#pragma unroll
    for (int o = 1; o < 64; o <<= 1) v += __shfl_xor(v, o);
    return v;
}
__device__ __forceinline__ float sigm(float v) { return __builtin_amdgcn_rcpf(1.f + __builtin_amdgcn_exp2f(v * (-LOG2E))); }
#if WT_STORES
__device__ __forceinline__ void st16(void* p, u32x4 v) { asm volatile("global_store_dwordx4 %0, %1, off sc1\n\ts_nop 1" :: "v"(p), "v"(v) : "memory"); }
__device__ __forceinline__ void st8(void* p, u32x2 v) { asm volatile("global_store_dwordx2 %0, %1, off sc1\n\ts_nop 1" :: "v"(p), "v"(v) : "memory"); }
#else
__device__ __forceinline__ void st16(void* p, u32x4 v) { *(u32x4*)p = v; }
__device__ __forceinline__ void st8(void* p, u32x2 v) { *(u32x2*)p = v; }
#endif
#define VM_WAIT() asm volatile("s_waitcnt vmcnt(0)" ::: "memory")
#define LAUNDER_S(p) asm volatile("" : "+s"(p))
#define LAUNDER_V(v) asm volatile("" : "+v"(v))
#define LDS_WAIT() asm volatile("s_waitcnt lgkmcnt(0)" ::: "memory")

#define XB_TMO      128
#define XB_XCNT(j)  (256  + 64 * (j))
#define XB_XSUB(j)  (1280 + 64 * (j))
#define XB_XGEN(j)  (2304 + 64 * (j))
#define XB_TOP      3328
#define XB_TOPGEN   3392
#define XCD_BAR_WORDS 3456
#define XB_SPIN_CAP (1u << 22)
__device__ __forceinline__ unsigned xb_ld(unsigned* p)              { return __hip_atomic_load(p, __ATOMIC_RELAXED, __HIP_MEMORY_SCOPE_AGENT); }
__device__ __forceinline__ unsigned xb_add(unsigned* p, unsigned v) { return __hip_atomic_fetch_add(p, v, __ATOMIC_RELAXED, __HIP_MEMORY_SCOPE_AGENT); }
__device__ __forceinline__ unsigned xb_xcc_id() { return (unsigned)__builtin_amdgcn_s_getreg((3 << 11) | 20) & 0xFu; }
#define XB_SPIN(cond, bar) do { unsigned _sp = 0; while (cond) { __builtin_amdgcn_s_sleep(1); \
    if ((++_sp & 255u) == 0u) { if (xb_ld(&(bar)[XB_TMO])) break; if (_sp > XB_SPIN_CAP) { atomicAdd(&(bar)[XB_TMO], 1u); break; } } } } while (0)
struct XcdBarrier { unsigned* bar; unsigned x; volatile LAS unsigned* st; };
__device__ __forceinline__ XcdBarrier xcd_barrier_post(unsigned* bar, volatile LAS unsigned* st) {
    XcdBarrier b; b.bar = bar; b.x = xb_xcc_id(); b.st = st;
    if (threadIdx.x == 0) (void)xb_add(&bar[XB_XCNT(b.x)], 1u);
    return b;
}
__device__ __forceinline__ void xcd_barrier_complete(unsigned* bar, unsigned x, unsigned& nloc, unsigned& nx) {
    const unsigned G = gridDim.x * gridDim.y * gridDim.z;
    unsigned sum, cnt, mine, sp = 0u;
    for (;;) {
        sum = 0u; cnt = 0u; mine = 0u;
#pragma unroll
        for (unsigned j = 0; j < 16; ++j) { const unsigned c = xb_ld(&bar[XB_XCNT(j)]); sum += c; cnt += (c > 0u) ? 1u : 0u; mine = (j == x) ? c : mine; }
        if (sum == G) break;
        __builtin_amdgcn_s_sleep(1);
        if ((++sp & 255u) == 0u) { if (xb_ld(&bar[XB_TMO])) break; if (sp > XB_SPIN_CAP) { atomicAdd(&bar[XB_TMO], 1u); break; } }
    }
    nloc = mine > 0u ? mine : 1u; nx = cnt > 0u ? cnt : 1u;
}
__device__ __forceinline__ void xcd_barrier(const XcdBarrier& b) {
    asm volatile("s_waitcnt vmcnt(0)" ::: "memory");
    __syncthreads();
    if (threadIdx.x == 0) {
        unsigned* bar = b.bar;
        __builtin_amdgcn_s_waitcnt(0);
        unsigned nloc = b.st[0], nx = b.st[1];
        if (nloc == 0u) { xcd_barrier_complete(bar, b.x, nloc, nx); b.st[0] = nloc; b.st[1] = nx; }
        const unsigned old = xb_add(&bar[XB_XSUB(b.x)], 1u);
        const unsigned gen = old / nloc;
        if (old + 1u == (gen + 1u) * nloc) {
            __builtin_amdgcn_fence(__ATOMIC_RELEASE, "agent");
            asm volatile("s_waitcnt vmcnt(0)" ::: "memory");
            const unsigned og = xb_add(&bar[XB_TOP], 1u);
            const unsigned tg = og / nx;
            if (og + 1u == (tg + 1u) * nx) xb_add(&bar[XB_TOPGEN], 1u);
            else XB_SPIN(xb_ld(&bar[XB_TOPGEN]) == tg, bar);
            __builtin_amdgcn_fence(__ATOMIC_ACQUIRE, "agent");
            xb_add(&bar[XB_XGEN(b.x)], 1u);
            asm volatile("s_waitcnt vmcnt(0)" ::: "memory");
        } else {
            XB_SPIN(xb_ld(&bar[XB_XGEN(b.x)]) == gen, bar);
            __builtin_amdgcn_fence(__ATOMIC_ACQUIRE, "agent");
            asm volatile("s_waitcnt vmcnt(0)" ::: "memory");
        }
    }
    __syncthreads();
}

namespace gp {
constexpr int BM = 256, BK = 64, HALF = 128, HTB = HALF * BK * 2, NXCD = 8, WGM = 8;
__host__ __device__ __forceinline__ int lds_byte(int r, int c) { const int st = (r >> 4) * 2 + (c >> 5), rr = r & 15, cc = c & 31, ob = rr * 64 + cc * 2; return st * 1024 + (ob ^ (((ob >> 9) & 1) << 5)); }
__host__ __device__ __forceinline__ void stage_rc(int b, int& R, int& C) { const int st = b / 1024, sb = b % 1024, swz = sb ^ (((sb >> 9) & 1) << 5); R = (st >> 1) * 16 + swz / 64; C = (st & 1) * 32 + (swz % 64) / 2; }
__host__ __device__ __forceinline__ int perm32(int rho) { const int n = rho >> 4, i = rho & 15; return 8 * (i >> 2) + 4 * n + (i & 3); }

struct Unit { int pm, pn, be, rl, nv; };
struct Gemm { const bf16_t* A; const bf16_t* Bt; int K; size_t bstride; const unsigned* list; size_t astride; };

__device__ __forceinline__ int xcd_remap(int wgid, int nwg) { const int q = nwg / NXCD, r = nwg % NXCD, xcd = wgid % NXCD, off = wgid / NXCD; return (xcd < r ? xcd * (q + 1) : r * (q + 1) + (xcd - r) * q) + off; }
struct DenseOrder {
    int nM, nN, nwg, G, c;
    __device__ void init(int M, int N, int G_, int c_) { nM = M / BM; nN = N / BM; nwg = nM * nN; G = G_; c = c_; }
    __device__ bool next(int i, Unit& u) const {
        const long L = (long)i * G + c; if (L >= nwg) return false;
        const int wgid = xcd_remap((int)L, nwg);
        const int nig = WGM * nN, gid = wgid / nig, fm = gid * WGM, gsz = (nM - fm) < WGM ? (nM - fm) : WGM;
        u.pm = fm + ((wgid % nig) % gsz); u.pn = (wgid % nig) / gsz; u.be = 0; u.rl = 0; u.nv = 256; return true;
    }
};
struct PairOrder {
    DenseOrder d;
    __device__ void init(int M, int N, int G_, int c_) { d.init(M, N, G_, c_); }
    __device__ bool next(int i, Unit& u) const { if (!d.next(i >> 1, u)) return false; u.be = i & 1; return true; }
};
struct MoeOrder {
    const LAS int* tab; int nwg, G, c;
    __device__ static int rd(const LAS int* p) { return __builtin_amdgcn_readfirstlane(*p); }
    __device__ void init(const LAS int* tab_, int G_, int c_) { tab = tab_; nwg = rd(tab_ + 16) * 4; G = G_; c = c_; }
    __device__ bool next(int i, Unit& u) const {
        const long L = (long)i * G + c; if (L >= nwg) return false;
        const int wgid = xcd_remap((int)L, nwg);
        const int tile = wgid >> 2; int e = 0;
        for (int k = 1; k < NE; ++k) e += (rd(tab + k) <= tile) ? 1 : 0;
        u.pm = tile; u.pn = wgid & 3; u.be = e; u.rl = tile - rd(tab + e); const int rem = rd(tab + 32 + e) - u.rl * 256; u.nv = rem < 256 ? rem : 256; return true;
    }
};

#define ACC_T f32x4 (&acc)[2][2][4][2]

template <class Epi, class Sched, bool GATHER>
__device__ __forceinline__ void gemm_phase_ref(int tid, const Gemm g, const Sched& S, const Epi& E) {
    const int wid = __builtin_amdgcn_readfirstlane(tid >> 6), lane = tid & 63, wr = wid >> 2, wc = wid & 3, fr = lane & 15, fq = lane >> 4;
    const int K = g.K; Unit u;
    for (int ui = 0; S.next(ui, u); ++ui) {
        f32x4 acc[2][2][4][2];
#pragma unroll
        for (int a = 0; a < 2; ++a)
#pragma unroll
            for (int b = 0; b < 2; ++b)
#pragma unroll
                for (int m = 0; m < 4; ++m)
#pragma unroll
                    for (int n = 0; n < 2; ++n) acc[a][b][m][n] = (f32x4){0.f, 0.f, 0.f, 0.f};
        const bf16_t* Bt = g.Bt + (size_t)u.be * g.bstride + (size_t)u.pn * 256 * K;
        for (int ai = 0; ai < 2; ++ai)
            for (int m = 0; m < 4; ++m) {
                const int rloc = ai * 128 + wr * 64 + m * 16 + fr;
                size_t arow;
                if (GATHER) { arow = (rloc < u.nv) ? (size_t)(g.list[(size_t)u.be * T + u.rl * 256 + rloc] >> 1) : 0; }
                else arow = (size_t)u.pm * 256 + rloc;
                const bf16_t* ap = g.A + arow * K;
                for (int bj = 0; bj < 2; ++bj) {
                    const bf16_t* bp = Bt + (size_t)(bj * 128 + wc * 32 + fq * 8) * K;
                    float s[8];
#pragma unroll
                    for (int c = 0; c < 8; ++c) {
                        float sc = 0.f; const bf16_t* bpc = bp + (size_t)c * K;
#pragma unroll 2
                        for (int k = 0; k < K; k += 8) {
                            f32x4 a0, a1, b0, b1; unpack8(*(const u32x4*)(ap + k), a0, a1); unpack8(*(const u32x4*)(bpc + k), b0, b1);
                            sc += a0[0] * b0[0] + a0[1] * b0[1] + a0[2] * b0[2] + a0[3] * b0[3] + a1[0] * b1[0] + a1[1] * b1[1] + a1[2] * b1[2] + a1[3] * b1[3];
                        }
                        s[c] = sc; asm volatile("" : "+v"(s[c]));
                    }
#pragma unroll
                    for (int a2 = 0; a2 < 2; ++a2)
#pragma unroll
                        for (int b2 = 0; b2 < 2; ++b2)
#pragma unroll
                            for (int m2 = 0; m2 < 4; ++m2)
                                if (a2 == ai && b2 == bj && m2 == m) { acc[a2][b2][m2][0] = (f32x4){s[0], s[1], s[2], s[3]}; acc[a2][b2][m2][1] = (f32x4){s[4], s[5], s[6], s[7]}; }
                }
            }
        E(acc, u, wr, wc, fr, fq);
    }
}

template <class E> struct EpiTraits { static constexpr bool KEEP = false; };
#if FAST_GEMM
template <class Epi, class Sched, bool GATHER>
__device__ __forceinline__ void gemm_phase_fast(int tid, LAS unsigned char* lds, const Gemm g, const Sched& S, const Epi& E) {
    const int wid = __builtin_amdgcn_readfirstlane(tid >> 6), lane = tid & 63, wr = wid >> 2, wc = wid & 3, fr = lane & 15, fq = lane >> 4;
    const int K = g.K, nt = K / BK;
    int Rr[2], Cc[2]; unsigned voffB[2];
#pragma unroll
    for (int i = 0; i < 2; ++i) { stage_rc(tid * 16 + i * 8192, Rr[i], Cc[i]); const int Rb = (Rr[i] & ~31) + perm32(Rr[i] & 31); voffB[i] = (unsigned)(Rb * K + Cc[i]) * 2u; }
    const size_t kstep = (size_t)(BK * 2), hstep = (size_t)HALF * K * 2, tstep = 2 * hstep;
    const unsigned ldsw = (unsigned)wid * 1024u;
    const int aoff = lds_byte(wr * 64 + fr, fq * 8), boff = lds_byte(wc * 32 + fr, fq * 8);
#define GP_SA(b, h) (((b) * 2 + (h)) * HTB)
#define GP_SB(b, h) ((4 + (b) * 2 + (h)) * HTB)
#define GP_STAGE2(bufoff, gbase, v0, v1) do { \
        __builtin_amdgcn_global_load_lds((const unsigned*)((const char*)(gbase) + (v0)), (LAS unsigned*)(lds + (bufoff) + ldsw), 16, 0, 0); \
        __builtin_amdgcn_global_load_lds((const unsigned*)((const char*)(gbase) + (v1)), (LAS unsigned*)(lds + (bufoff) + ldsw + 8192), 16, 0, 0); } while (0)
#define GP_STAGEB(bufoff, gbase) GP_STAGE2(bufoff, gbase, voffB[0], voffB[1])
#define GP_LDA(dst, b, h) do { _Pragma("unroll") for (int m = 0; m < 4; ++m) _Pragma("unroll") for (int k = 0; k < 2; ++k) dst[m][k] = *(const LAS bf16x8*)(lds + GP_SA(b, h) + aoff + m * 2048 + k * 1024); } while (0)
#define GP_LDB(dst, b, h) do { _Pragma("unroll") for (int n = 0; n < 2; ++n) _Pragma("unroll") for (int k = 0; k < 2; ++k) dst[n][k] = *(const LAS bf16x8*)(lds + GP_SB(b, h) + boff + n * 2048 + k * 1024); } while (0)
#define GP_MMA(ai, bj, At, Bt) do { __builtin_amdgcn_s_setprio(1); _Pragma("unroll") for (int m = 0; m < 4; ++m) _Pragma("unroll") for (int n = 0; n < 2; ++n) _Pragma("unroll") for (int k = 0; k < 2; ++k) \
        acc[ai][bj][m][n] = __builtin_amdgcn_mfma_f32_16x16x32_bf16(Bt[n][k], At[m][k], acc[ai][bj][m][n], 0, 0, 0); __builtin_amdgcn_s_setprio(0); } while (0)
#define GP_WAIT_V(n) asm volatile("s_waitcnt vmcnt(" #n ")" ::: "memory")
#define GP_WAIT_L(n) asm volatile("s_waitcnt lgkmcnt(" #n ")" ::: "memory")
#define GP_BAR __builtin_amdgcn_s_barrier()
#define GP_SCHED __builtin_amdgcn_sched_barrier(0)
    Unit cur, nxt; int ui = 0;
    if (!S.next(0, cur)) return;
    f32x4 acc[2][2][4][2];
#pragma unroll
    for (int a = 0; a < 2; ++a)
#pragma unroll
        for (int b = 0; b < 2; ++b)
#pragma unroll
            for (int m = 0; m < 4; ++m)
#pragma unroll
                for (int n = 0; n < 2; ++n) acc[a][b][m][n] = (f32x4){0.f, 0.f, 0.f, 0.f};
    bf16x8 At[4][2], B0[2][2], B1[2][2];
    unsigned vC0, vC1, vC2, vC3, vN0, vN1, vN2, vN3;
#define GP_VOFF(u, o0, o1, o2, o3) do { if (GATHER) { \
        int tl_ = tid; LAUNDER_V(tl_); int R0_, C0_, R1_, C1_; stage_rc(tl_ * 16, R0_, C0_); stage_rc(tl_ * 16 + 8192, R1_, C1_);     \
        const unsigned* lp = g.list + (size_t)(u).be * T + (u).rl * 256; \
        const int nvm = (u).nv - 1; const int p0 = min(R0_, nvm), p1 = min(R1_, nvm), p2 = min(128 + R0_, nvm), p3 = min(128 + R1_, nvm); \
        const unsigned t0 = lp[p0] >> 1, t1 = lp[p1] >> 1, t2 = lp[p2] >> 1, t3 = lp[p3] >> 1; \
        o0 = (t0 * K + C0_) * 2u; o1 = (t1 * K + C1_) * 2u; o2 = (t2 * K + C0_) * 2u; o3 = (t3 * K + C1_) * 2u; \
      } else { o0 = (unsigned)(Rr[0] * K + Cc[0]) * 2u; o1 = (unsigned)(Rr[1] * K + Cc[1]) * 2u; o2 = o0 + (unsigned)hstep; o3 = o1 + (unsigned)hstep; } } while (0)
    GP_VOFF(cur, vC0, vC1, vC2, vC3);
    const char* cA = (const char*)g.A + ((size_t)cur.be * g.astride) * 2 + (GATHER ? (size_t)0 : (size_t)cur.pm * tstep);
    const char* cB = (const char*)g.Bt + ((size_t)cur.be * g.bstride) * 2 + (size_t)cur.pn * tstep;
    GP_STAGEB(GP_SB(0, 0), cB); GP_STAGEB(GP_SB(0, 1), cB + hstep); GP_STAGE2(GP_SA(0, 0), cA, vC0, vC1); GP_STAGE2(GP_SA(0, 1), cA, vC2, vC3);
    if (wr == 1) GP_BAR;
    GP_WAIT_V(2); GP_BAR;
    GP_STAGEB(GP_SB(1, 0), cB + kstep); GP_STAGE2(GP_SA(1, 0), cA + kstep, vC0, vC1); GP_STAGEB(GP_SB(1, 1), cB + hstep + kstep);
    GP_WAIT_V(6); GP_BAR;
    for (;;) {
        const bool has_next = S.next(ui + 1, nxt);
        const char* nA = has_next ? (const char*)g.A + ((size_t)nxt.be * g.astride) * 2 + (GATHER ? (size_t)0 : (size_t)nxt.pm * tstep) : cA;
        const char* nB = has_next ? (const char*)g.Bt + ((size_t)nxt.be * g.bstride) * 2 + (size_t)nxt.pn * tstep : cB;
        if (has_next) { GP_VOFF(nxt, vN0, vN1, vN2, vN3); } else { vN0 = vC0; vN1 = vC1; vN2 = vC2; vN3 = vC3; }
#pragma nounroll
        for (int t = 0; t < nt; t += 2) {
            const bool last = (t == nt - 2);
            const char* a1 = cA + (size_t)(t + 1) * kstep;
            const char* a2 = last ? nA : cA + (size_t)(t + 2) * kstep; const char* b2 = last ? nB : cB + (size_t)(t + 2) * kstep;
            const char* a3 = a2 + kstep; const char* b3 = b2 + kstep;
            const unsigned w0 = last ? vN0 : vC0, w1 = last ? vN1 : vC1, w2 = last ? vN2 : vC2, w3 = last ? vN3 : vC3;
            GP_LDB(B0, 0, 0); GP_LDB(B1, 0, 1); GP_SCHED; GP_LDA(At, 0, 0); GP_STAGE2(GP_SA(1, 1), a1, vC2, vC3);
            GP_WAIT_V(8); GP_WAIT_L(0); GP_BAR; GP_MMA(0, 0, At, B0); GP_MMA(0, 1, At, B1); GP_BAR; GP_SCHED;
            GP_LDA(At, 0, 1); GP_STAGEB(GP_SB(0, 0), b2); GP_STAGEB(GP_SB(0, 1), b2 + hstep); GP_STAGE2(GP_SA(0, 0), a2, w0, w1);
            GP_WAIT_V(8); GP_WAIT_L(0); GP_BAR; GP_MMA(1, 0, At, B0); GP_MMA(1, 1, At, B1); GP_BAR; GP_SCHED;
            GP_LDB(B0, 1, 0); GP_LDB(B1, 1, 1); GP_SCHED; GP_LDA(At, 1, 0); GP_STAGE2(GP_SA(0, 1), a2, w2, w3);
            GP_WAIT_V(8); GP_WAIT_L(0); GP_BAR; GP_MMA(0, 0, At, B0); GP_MMA(0, 1, At, B1); GP_BAR; GP_SCHED;
            GP_LDA(At, 1, 1); GP_STAGEB(GP_SB(1, 0), b3); GP_STAGEB(GP_SB(1, 1), b3 + hstep); GP_STAGE2(GP_SA(1, 0), a3, w0, w1);
            GP_WAIT_V(8); GP_WAIT_L(0); GP_BAR; GP_MMA(1, 0, At, B0); GP_MMA(1, 1, At, B1); GP_BAR; GP_SCHED;
        }
        if (wr == 0) GP_BAR;
        E(acc, cur, wr, wc, fr, fq);
        if (!has_next) break;
        if (!(EpiTraits<Epi>::KEEP && cur.be == 0)) {
#pragma unroll
        for (int a = 0; a < 2; ++a)
#pragma unroll
            for (int b = 0; b < 2; ++b)
#pragma unroll
                for (int m = 0; m < 4; ++m)
#pragma unroll
                    for (int n = 0; n < 2; ++n) acc[a][b][m][n] = (f32x4){0.f, 0.f, 0.f, 0.f};
        }
        cur = nxt; cA = nA; cB = nB; vC0 = vN0; vC1 = vN1; vC2 = vN2; vC3 = vN3; ++ui;
        if (wr == 1) GP_BAR;
    }
    GP_WAIT_V(0);
    GP_BAR;
#undef GP_SA
#undef GP_SB
#undef GP_STAGE2
#undef GP_STAGEB
#undef GP_LDA
#undef GP_LDB
#undef GP_MMA
#undef GP_WAIT_V
#undef GP_WAIT_L
#undef GP_BAR
#undef GP_SCHED
#undef GP_VOFF
}
#endif

template <class Epi, class Sched, bool GATHER = false>
__device__ __forceinline__ void gemm_phase(int tid, LAS unsigned char* lds, const Gemm g, const Sched& S, const Epi& E) {
#if FAST_GEMM
    gemm_phase_fast<Epi, Sched, GATHER>(tid, lds, g, S, E);
#else
    (void)lds; gemm_phase_ref<Epi, Sched, GATHER>(tid, g, S, E);
#endif
}

#define EPI_ROW(ai, m) (u.pm * 256 + (ai) * 128 + wr * 64 + (m) * 16 + fr)
#define EPI_COL(bj) (u.pn * 256 + (bj) * 128 + wc * 32 + fq * 8)
__device__ __forceinline__ float dot4(f32x4 a) { return (a[0] * a[0] + a[1] * a[1]) + (a[2] * a[2] + a[3] * a[3]); }

struct EpiNull {
    __device__ __forceinline__ void operator()(const ACC_T, const Unit& u, int wr, int wc, int fr, int fq) const {
#pragma unroll
        for (int ai = 0; ai < 2; ++ai)
#pragma unroll
            for (int bj = 0; bj < 2; ++bj)
#pragma unroll
                for (int m = 0; m < 4; ++m) asm volatile("" :: "v"(acc[ai][bj][m][0]), "v"(acc[ai][bj][m][1]));
    }
};
struct EpiIn {
    bf16_t *QA, *KA, *VA, *QLAT, *KVLAT, *KB, *SA, *SB; float *SSQ, *SSKV; const float *gq, *gk, *cosA, *sinA, *cosB, *sinB;
    __device__ __forceinline__ void operator()(const ACC_T, const Unit& u, int wr, int wc, int fr, int fq) const {
        const int wb = u.pn * 4 + wc;
        if (wb < 10) {
            const bool isq = wb < 8; const int head = isq ? wb : wb - 8; const float* g = isq ? gq : gk; bf16_t* dst = isq ? QA : KA; const int dp = isq ? 512 : 128; const float qs = isq ? QSCALE_A : 1.f;
            const f32x4 g00 = *(const f32x4*)(g + 8 * fq), g01 = *(const f32x4*)(g + 8 * fq + 4), g10 = *(const f32x4*)(g + 32 + 8 * fq), g11 = *(const f32x4*)(g + 36 + 8 * fq);
#pragma unroll
            for (int ai = 0; ai < 2; ++ai)
#pragma unroll
                for (int m = 0; m < 4; ++m) {
                    const int r = EPI_ROW(ai, m), pos = r & (S - 1);
                    const f32x4 v00 = acc[ai][0][m][0], v01 = acc[ai][0][m][1], v10 = acc[ai][1][m][0], v11 = acc[ai][1][m][1];
                    float ss = (dot4(v00) + dot4(v01)) + (dot4(v10) + dot4(v11)); ss += __shfl_xor(ss, 16); ss += __shfl_xor(ss, 32);
                    const float rstd = rsqrtf(ss * (1.f / 64.f) + EPS);
                    const f32x4 y00 = v00 * rstd * g00, y01 = v01 * rstd * g01, y10 = v10 * rstd * g10, y11 = v11 * rstd * g11;
                    const f32x4 c0 = *(const f32x4*)(cosA + pos * 32 + 8 * fq), c1 = *(const f32x4*)(cosA + pos * 32 + 8 * fq + 4), s0 = *(const f32x4*)(sinA + pos * 32 + 8 * fq), s1 = *(const f32x4*)(sinA + pos * 32 + 8 * fq + 4);
                    const f32x4 o00 = (y00 * c0 - y10 * s0) * qs, o01 = (y01 * c1 - y11 * s1) * qs, o10 = (y10 * c0 + y00 * s0) * qs, o11 = (y11 * c1 + y01 * s1) * qs;
#if ATT_FP8_A
                    unsigned char* p8 = (unsigned char*)dst + (size_t)r * dp + head * 64 + 8 * fq;
                    st8(p8, pack8_fp8(o00, o01)); st8(p8 + 32, pack8_fp8(o10, o11));
#else
                    bf16_t* p = dst + (size_t)r * dp + head * 64 + 8 * fq;
                    st16(p, pack8(o00, o01)); st16((p + 32), pack8(o10, o11));
#endif
                }
        } else if (wb < 12) {
#pragma unroll
            for (int ai = 0; ai < 2; ++ai)
#pragma unroll
                for (int m = 0; m < 4; ++m) {
#if ATT_FP8_A
                    const int r = EPI_ROW(ai, m), sq = r & (S - 1), k = sq & 63, pos = 32 * ((k >> 2) & 1) + 16 * (k >> 5) + (k & 3) + 4 * ((k & 31) >> 3);
                    unsigned char* vtb = (unsigned char*)VA; const unsigned vo = (unsigned)(((r >> 12) * 2 + (wb - 10)) * 64 + 8 * fq) * S + (unsigned)((sq & ~63) + pos);
#pragma unroll
                    for (int bj = 0; bj < 2; ++bj)
#pragma unroll
                        for (int n = 0; n < 2; ++n) { const f32x4 x = acc[ai][bj][m][n]; const unsigned w = (unsigned)__builtin_amdgcn_cvt_pk_fp8_f32(x[2], x[3], __builtin_amdgcn_cvt_pk_fp8_f32(x[0], x[1], 0, false), true);
                            const unsigned qo = vo + (unsigned)(bj * 32 + 4 * n) * S;
                            vtb[qo] = (unsigned char)(w & 0xffu); vtb[qo + S] = (unsigned char)((w >> 8) & 0xffu); vtb[qo + 2 * S] = (unsigned char)((w >> 16) & 0xffu); vtb[qo + 3 * S] = (unsigned char)(w >> 24); }
#else
                    bf16_t* p = VA + (size_t)EPI_ROW(ai, m) * 128 + (wb - 10) * 64 + 8 * fq;
                    st16(p, pack8(acc[ai][0][m][0], acc[ai][0][m][1])); st16((p + 32), pack8(acc[ai][1][m][0], acc[ai][1][m][1]));
#endif
                }
        } else if (wb < 22) {
            const bool isq = wb < 18; const int idx = isq ? wb - 12 : wb - 18; bf16_t* dst = isq ? QLAT : KVLAT; const int dp = isq ? 384 : 256;
#pragma unroll
            for (int ai = 0; ai < 2; ++ai)
#pragma unroll
                for (int m = 0; m < 4; ++m) {
                    const int r = EPI_ROW(ai, m);
                    const f32x4 v00 = acc[ai][0][m][0], v01 = acc[ai][0][m][1], v10 = acc[ai][1][m][0], v11 = acc[ai][1][m][1];
                    float ss = (dot4(v00) + dot4(v01)) + (dot4(v10) + dot4(v11)); ss += __shfl_xor(ss, 16); ss += __shfl_xor(ss, 32);
                    if (fq == 0) { if (isq) SSQ[(size_t)r * 8 + idx] = ss; else SSKV[(size_t)r * 4 + idx] = ss; }
                    bf16_t* p = dst + (size_t)r * dp + idx * 64 + 8 * fq;
                    st16(p, pack8(v00, v01)); st16((p + 32), pack8(v10, v11));
                }
        } else if (wb == 22) {
            if (fq < 2) {
#pragma unroll
                for (int ai = 0; ai < 2; ++ai)
#pragma unroll
                    for (int m = 0; m < 4; ++m) {
                        const int r = EPI_ROW(ai, m), pos = r & (S - 1);
                        const f32x4 x10 = acc[ai][0][m][0], x11 = acc[ai][0][m][1], x20 = acc[ai][1][m][0], x21 = acc[ai][1][m][1];
                        const f32x4 c0 = *(const f32x4*)(cosB + pos * 16 + 8 * fq), c1 = *(const f32x4*)(cosB + pos * 16 + 8 * fq + 4), s0 = *(const f32x4*)(sinB + pos * 16 + 8 * fq), s1 = *(const f32x4*)(sinB + pos * 16 + 8 * fq + 4);
                        const u32x4 w1 = pack8(x10 * c0 - x20 * s0, x11 * c1 - x21 * s1), w2 = pack8(x20 * c0 + x10 * s0, x21 * c1 + x11 * s1);
                        bf16_t* p = KB + (size_t)r * 768 + 64 + 8 * fq;
#pragma unroll
                        for (int h = 0; h < 8; ++h) { st16((p + h * 96), w1); st16((p + h * 96 + 16), w2); }
                    }
            }
        } else if (wb == 23) {
        } else {
            const bool isa = wb < 40; const int idx = isa ? wb - 24 : wb - 40; unsigned char* dst = (unsigned char*)(isa ? SA : SB);
#pragma unroll
            for (int ai = 0; ai < 2; ++ai)
#pragma unroll
                for (int m = 0; m < 4; ++m) { unsigned char* p = dst + (size_t)EPI_ROW(ai, m) * 1024 + idx * 64 + 8 * fq;
#pragma unroll
                    for (int bj = 0; bj < 2; ++bj) { const f32x4 a = acc[ai][bj][m][0], b = acc[ai][bj][m][1]; u32x2 w;
                        w.x = (unsigned)__builtin_amdgcn_cvt_pk_fp8_f32(a[2], a[3], __builtin_amdgcn_cvt_pk_fp8_f32(a[0], a[1], 0, false), true);
                        w.y = (unsigned)__builtin_amdgcn_cvt_pk_fp8_f32(b[2], b[3], __builtin_amdgcn_cvt_pk_fp8_f32(b[0], b[1], 0, false), true);
                        st8((p + bj * 32), w); } }
        }
    }
};
__host__ __device__ __forceinline__ int src_col_in(int n) {
    const int pn = n >> 8, nl = n & 255, bj = nl >> 7, wc = (nl & 127) >> 5, p = nl & 31, wb = pn * 4 + wc, s = bj * 32 + p;
    if (wb < 8) return wb * 64 + s;
    if (wb < 10) return 512 + (wb - 8) * 64 + s;
    if (wb < 12) return 640 + (wb - 10) * 64 + s;
    if (wb < 18) return 768 + (wb - 12) * 64 + s;
    if (wb < 22) return 1152 + (wb - 18) * 64 + s;
    if (wb == 22) return p < 16 ? 1408 + bj * 16 + p : -1;
    if (wb == 23) return -1;
    if (wb < 40) return 1440 + (wb - 24) * 64 + s;
    return 2464 + (wb - 40) * 64 + s;
}
struct EpiQb {
    bf16_t* QB; const float *SSQ, *cosB, *sinB;
    __device__ __forceinline__ void operator()(const ACC_T, const Unit& u, int wr, int wc, int fr, int fq) const {
#pragma unroll
        for (int ai = 0; ai < 2; ++ai)
#pragma unroll
            for (int m = 0; m < 4; ++m) {
                const int r = EPI_ROW(ai, m), pos = r & (S - 1);
                const f32x4 sa = *(const f32x4*)(SSQ + (size_t)r * 8); const f32x2 sb = *(const f32x2*)(SSQ + (size_t)r * 8 + 4);
                const float rstd = rsqrtf((((sa[0] + sa[1]) + (sa[2] + sa[3])) + (sb[0] + sb[1])) * (1.f / 384.f) + EPS);
#pragma unroll
                for (int bj = 0; bj < 2; ++bj) {
                    f32x4 v0 = acc[ai][bj][m][0] * rstd, v1 = acc[ai][bj][m][1] * rstd;
                    const int c32 = u.pn * 8 + bj * 4 + wc;
                    if (c32 % 3 == 2) {
                        f32x4 o0, o1;
#pragma unroll
                        for (int j = 0; j < 4; ++j) { o0[j] = __shfl_xor(v0[j], 32); o1[j] = __shfl_xor(v1[j], 32); }
                        const int i0 = 8 * (fq & 1);
                        const f32x4 c0 = *(const f32x4*)(cosB + pos * 16 + i0), c1 = *(const f32x4*)(cosB + pos * 16 + i0 + 4), s0 = *(const f32x4*)(sinB + pos * 16 + i0), s1 = *(const f32x4*)(sinB + pos * 16 + i0 + 4);
                        if (fq < 2) { v0 = v0 * c0 - o0 * s0; v1 = v1 * c1 - o1 * s1; } else { v0 = v0 * c0 + o0 * s0; v1 = v1 * c1 + o1 * s1; }
                    }
                    st16((QB + (size_t)r * 768 + EPI_COL(bj)), pack8(v0 * QSCALE_B, v1 * QSCALE_B));
                }
            }
    }
};
struct EpiKvb {
    bf16_t *KB, *VB; const float* SSKV;
    __device__ __forceinline__ void operator()(const ACC_T, const Unit& u, int wr, int wc, int fr, int fq) const {
#pragma unroll
        for (int ai = 0; ai < 2; ++ai)
#pragma unroll
            for (int m = 0; m < 4; ++m) {
                const int r = EPI_ROW(ai, m);
                const f32x4 sa = *(const f32x4*)(SSKV + (size_t)r * 4);
                const float rstd = rsqrtf(((sa[0] + sa[1]) + (sa[2] + sa[3])) * (1.f / 256.f) + EPS);
#pragma unroll
                for (int bj = 0; bj < 2; ++bj) {
                    const int head = u.pn * 2 + bj, o = wc * 32 + fq * 8;
                    const u32x4 w = pack8(acc[ai][bj][m][0] * rstd, acc[ai][bj][m][1] * rstd);
                    if (wc < 2) st16((KB + (size_t)r * 768 + head * 96 + o), w); else st16((VB + (size_t)r * 512 + head * 64 + (o - 64)), w);
                }
            }
    }
};
template <int MODE> struct EpiProj {
    bf16_t* O; const bf16_t* gate;
    __device__ __forceinline__ void operator()(const ACC_T, const Unit& u, int wr, int wc, int fr, int fq) const {
#pragma unroll
        for (int ai = 0; ai < 2; ++ai)
#pragma unroll
            for (int m = 0; m < 4; ++m) {
                const int r = EPI_ROW(ai, m);
#pragma unroll
                for (int bj = 0; bj < 2; ++bj) {
                    const size_t off = (size_t)r * D + EPI_COL(bj);
                    const u32x2 gw = *(const u32x2*)((const unsigned char*)gate + off);
                    const f32x2 q0 = __builtin_amdgcn_cvt_pk_f32_fp8((int)gw.x, false), q1 = __builtin_amdgcn_cvt_pk_f32_fp8((int)gw.x, true), q2 = __builtin_amdgcn_cvt_pk_f32_fp8((int)gw.y, false), q3 = __builtin_amdgcn_cvt_pk_f32_fp8((int)gw.y, true);
                    const f32x4 g0 = {sigm(q0[0]), sigm(q0[1]), sigm(q1[0]), sigm(q1[1])}, g1 = {sigm(q2[0]), sigm(q2[1]), sigm(q3[0]), sigm(q3[1])};
                    f32x4 v0 = acc[ai][bj][m][0] * g0, v1 = acc[ai][bj][m][1] * g1;
                    if (MODE == 1) { f32x4 p0, p1; unpack8(*(const u32x4*)(O + off), p0, p1); v0 += p0; v1 += p1; }
                    if (MODE == 1) st16(O + off, pack8(v0, v1)); else *(u32x4*)(O + off) = pack8(v0, v1);
                }
            }
    }
};
struct EpiProjP {
    bf16_t* O; const unsigned char* SA; const unsigned char* SB;
    __device__ static __forceinline__ void gates(const unsigned char* G, size_t off, f32x4& g0, f32x4& g1) {
        const u32x2 gw = *(const u32x2*)(G + off);
        const f32x2 q0 = __builtin_amdgcn_cvt_pk_f32_fp8((int)gw.x, false), q1 = __builtin_amdgcn_cvt_pk_f32_fp8((int)gw.x, true), q2 = __builtin_amdgcn_cvt_pk_f32_fp8((int)gw.y, false), q3 = __builtin_amdgcn_cvt_pk_f32_fp8((int)gw.y, true);
        g0 = (f32x4){sigm(q0[0]), sigm(q0[1]), sigm(q1[0]), sigm(q1[1])}; g1 = (f32x4){sigm(q2[0]), sigm(q2[1]), sigm(q3[0]), sigm(q3[1])};
    }
    __device__ __forceinline__ void operator()(f32x4 (&acc)[2][2][4][2], const Unit& u, int wr, int wc, int fr, int fq) const {
#pragma unroll
        for (int ai = 0; ai < 2; ++ai)
#pragma unroll
            for (int m = 0; m < 4; ++m) {
                const int r = EPI_ROW(ai, m);
#pragma unroll
                for (int bj = 0; bj < 2; ++bj) {
                    const size_t off = (size_t)r * D + EPI_COL(bj);
                    f32x4 b0, b1; gates(SB, off, b0, b1);
#pragma unroll
                    for (int j = 0; j < 4; ++j) { b0[j] = fmaxf(b0[j], 9.094947e-13f); b1[j] = fmaxf(b1[j], 9.094947e-13f); }
                    if (u.be == 0) {
                        f32x4 a0, a1; gates(SA, off, a0, a1);
#pragma unroll
                        for (int j = 0; j < 4; ++j) { acc[ai][bj][m][0][j] *= a0[j] * __builtin_amdgcn_rcpf(b0[j]); acc[ai][bj][m][1][j] *= a1[j] * __builtin_amdgcn_rcpf(b1[j]); }
                    } else st16(O + off, pack8(acc[ai][bj][m][0] * b0, acc[ai][bj][m][1] * b1));
                }
            }
    }
};
template <> struct EpiTraits<EpiProjP> { static constexpr bool KEEP = true; };
struct EpiWo {
    const bf16_t* X; const float* modl; bf16_t* XO;
    __device__ __forceinline__ void operator()(const ACC_T, const Unit& u, int wr, int wc, int fr, int fq) const {
        const float* g1 = modl + (size_t)(u.pm >> 4) * 6 * D + 2 * D;
#pragma unroll
        for (int bj = 0; bj < 2; ++bj) {
            const int c = EPI_COL(bj); const f32x4 ga = *(const f32x4*)(g1 + c), gb = *(const f32x4*)(g1 + c + 4);
#pragma unroll
            for (int ai = 0; ai < 2; ++ai)
#pragma unroll
                for (int m = 0; m < 4; ++m) { const size_t off = (size_t)EPI_ROW(ai, m) * D + c;
                    f32x4 x0, x1; unpack8(*(const u32x4*)(X + off), x0, x1);
                    st16((XO + off), pack8(x0 + ga * acc[ai][bj][m][0], x1 + gb * acc[ai][bj][m][1])); }
        }
    }
};
struct EpiUp {
    bf16_t* ACT;
    __device__ __forceinline__ void operator()(const ACC_T, const Unit& u, int wr, int wc, int fr, int fq) const {
#pragma unroll
        for (int ai = 0; ai < 2; ++ai)
#pragma unroll
            for (int m = 0; m < 4; ++m) {
                f32x4 a = acc[ai][0][m][0], b = acc[ai][0][m][1]; const f32x4 c = acc[ai][1][m][0], d = acc[ai][1][m][1];
#pragma unroll
                for (int j = 0; j < 4; ++j) { a[j] = a[j] * sigm(a[j]) * c[j]; b[j] = b[j] * sigm(b[j]) * d[j]; }
                st16((ACT + (size_t)EPI_ROW(ai, m) * FF + u.pn * 128 + wc * 32 + fq * 8), pack8(a, b));
            }
    }
};
struct EpiDown {
    bf16_t* Y2; const unsigned* list; const float* gw;
    __device__ __forceinline__ void operator()(const ACC_T, const Unit& u, int wr, int wc, int fr, int fq) const {
#pragma unroll
        for (int ai = 0; ai < 2; ++ai)
#pragma unroll
            for (int m = 0; m < 4; ++m) {
                const int rloc = ai * 128 + wr * 64 + m * 16 + fr;
                if (rloc < u.nv) {
                    const unsigned entry = list[(size_t)u.be * T + u.rl * 256 + rloc]; const float w = gw[entry];
#pragma unroll
                    for (int bj = 0; bj < 2; ++bj) { const f32x4 a = acc[ai][bj][m][0] * (w * 16.f), b = acc[ai][bj][m][1] * (w * 16.f); u32x2 q;
                        q.x = (unsigned)__builtin_amdgcn_cvt_pk_fp8_f32(a[2], a[3], __builtin_amdgcn_cvt_pk_fp8_f32(a[0], a[1], 0, false), true);
                        q.y = (unsigned)__builtin_amdgcn_cvt_pk_fp8_f32(b[2], b[3], __builtin_amdgcn_cvt_pk_fp8_f32(b[0], b[1], 0, false), true);
                        st8(((unsigned char*)Y2 + (size_t)entry * D + EPI_COL(bj)), q); }
                }
            }
    }
};
}

namespace at {
struct Tensors { const bf16_t* Q; int qp; const bf16_t* K; int kp; const bf16_t* V; int vp; bf16_t* O; int op; int group; };
__device__ __forceinline__ bool next_unit(int i, int vcu, int G, int& bh, int& qb) {
    int u;
    if (G == 256) { if (i >= 4) return false; u = (vcu >> 5) * 128 + i * 32 + (vcu & 31); }
    else { u = i * G + vcu; if (u >= 1024) return false; }
    bh = u >> 4; qb = u & 15; return true;
}
template <int DQK>
__device__ __forceinline__ void attn_phase_ref(int tid, const Tensors& A, int vcu, int G) {
    int bh, qb;
    for (int i = 0; next_unit(i, vcu, G, bh, qb); ++i) {
        const int b = bh >> 3, h = bh & 7, kvh = h / A.group;
        {
            const int dh = tid >> 8;
            const size_t row = (size_t)b * S + qb * 256 + (tid & 255);
            float q[DQK], o[32];
#pragma unroll
            for (int d = 0; d < DQK; ++d) q[d] = bf2f(A.Q[row * A.qp + h * DQK + d]);
#pragma unroll
            for (int d = 0; d < 32; ++d) o[d] = 0.f;
            float l = 0.f;
            for (int k = 0; k < S; ++k) {
                const bf16_t* kr = A.K + ((size_t)b * S + k) * A.kp + kvh * DQK; const bf16_t* vr = A.V + ((size_t)b * S + k) * A.vp + kvh * 64 + dh * 32;
                float sc = 0.f;
#pragma unroll
                for (int d = 0; d < DQK; d += 8) { f32x4 k0, k1; unpack8(*(const u32x4*)(kr + d), k0, k1);
                    sc += q[d] * k0[0] + q[d + 1] * k0[1] + q[d + 2] * k0[2] + q[d + 3] * k0[3] + q[d + 4] * k1[0] + q[d + 5] * k1[1] + q[d + 6] * k1[2] + q[d + 7] * k1[3]; }
                const float p = bf2f(cvt_pk_bf16(exp2f(sc), 0.f) & 0xffffu); l += p;
#pragma unroll
                for (int d = 0; d < 32; d += 8) { f32x4 v0, v1; unpack8(*(const u32x4*)(vr + d), v0, v1);
                    o[d] += p * v0[0]; o[d + 1] += p * v0[1]; o[d + 2] += p * v0[2]; o[d + 3] += p * v0[3]; o[d + 4] += p * v1[0]; o[d + 5] += p * v1[1]; o[d + 6] += p * v1[2]; o[d + 7] += p * v1[3]; }
            }
            const float il = 1.f / l;
            __syncthreads();
#pragma unroll
            for (int d = 0; d < 32; d += 8) { f32x4 a = {o[d] * il, o[d + 1] * il, o[d + 2] * il, o[d + 3] * il}, c = {o[d + 4] * il, o[d + 5] * il, o[d + 6] * il, o[d + 7] * il};
                *(u32x4*)(A.O + row * A.op + h * 64 + dh * 32 + d) = pack8(a, c); }
        }
    }
}
#if FAST_ATTN
typedef short s16x4 __attribute__((ext_vector_type(4)));
__device__ __forceinline__ unsigned cvtpk(float lo, float hi) { f32x2 v = {lo, hi}; bf16x2_t b = __builtin_convertvector(v, bf16x2_t); return __builtin_bit_cast(unsigned, b); }
__device__ __forceinline__ s16x4 vtr(const LAS unsigned char* p) { return __builtin_bit_cast(s16x4, __builtin_amdgcn_ds_read_tr16_b64_v4i16((LAS s16x4*)p)); }
__device__ __forceinline__ int crow(int r, int hi) { return (r & 3) + 8 * (r >> 2) + 4 * hi; }
#define AT_BAR() asm volatile("s_barrier" ::: "memory")
#define AT_WAITBAR(N) asm volatile("s_waitcnt vmcnt(" #N ") lgkmcnt(0)\n\ts_barrier" ::: "memory")
#define AT_SCHED() __builtin_amdgcn_sched_barrier(0)
__device__ __forceinline__ void glds16(const void* gsrc, unsigned lds_dst) { unsigned keep;
    asm volatile("s_mov_b32 %0, m0\n\ts_mov_b32 m0, %2\n\ts_nop 0\n\tglobal_load_lds_dwordx4 %1, off\n\ts_mov_b32 m0, %0" : "=&s"(keep) : "v"(gsrc), "s"(lds_dst) : "memory"); }
#define AT_GLDS(g, l) glds16((const void*)(g), (unsigned)__builtin_amdgcn_readfirstlane((int)(unsigned)(uintptr_t)(l)))
template <int DQK>
__device__ __forceinline__ void attn_unit(int tid, LAS unsigned char* lds, const Tensors& A, int b, int h, int qb) {
    constexpr int ND = DQK / 16, NCH = DQK / 8, KSLOT = NCH * 1024, NKD = NCH > 8 ? 2 : 1, VSLOT = 8192, NT = S / 64;
    constexpr int KOFF = 0, VOFF = 3 * KSLOT, OST = VOFF + 3 * VSLOT, WSF = OST + 8 * 4096;
    static_assert(WSF + 8 * 256 <= RING_BYTES, "attention LDS");
    const int lane = tid & 63, r32 = lane & 31, hi = lane >> 5, wid = __builtin_amdgcn_readfirstlane(tid >> 6);
    const int kvh = h / A.group; const size_t rowb = (size_t)b * S;
    const bf16_t* ksrc = A.K + (rowb + lane) * A.kp + kvh * DQK + wid * 8;
    const bf16_t* ksrc2 = A.K + (rowb + lane) * A.kp + kvh * DQK + (8 + (wid & 3)) * 8;
    const bf16_t* vsrc = A.V + (rowb + 16 * (wid & 3) + (lane >> 2)) * A.vp + kvh * 64 + (wid >> 2) * 32 + (lane & 3) * 8;
    const size_t ktile = (size_t)64 * A.kp, vtile = (size_t)64 * A.vp;
    LAS unsigned char* kdst = lds + KOFF + wid * 1024; LAS unsigned char* kdst2 = lds + KOFF + (8 + (wid & 3)) * 1024; LAS unsigned char* vdst = lds + VOFF + wid * 1024;
#define DMA_K(j, so) do { AT_GLDS(ksrc + (size_t)(j) * ktile, kdst + (so)); if (NKD == 2) AT_GLDS(ksrc2 + (size_t)(j) * ktile, kdst2 + (so)); } while (0)
#define DMA_V(j, so) AT_GLDS(vsrc + (size_t)(j) * vtile, vdst + (so))
    const LAS unsigned char* kp0 = lds + KOFF + hi * 1024 + r32 * 16;
    const LAS unsigned char* vp0 = lds + VOFF + ((lane >> 4) & 1) * 32 + (lane & 3) * 8 + (4 * hi + ((lane & 15) >> 2)) * 64;
    DMA_K(0, 0); DMA_V(0, 0); DMA_K(1, KSLOT); DMA_V(1, VSLOT); DMA_K(2, 2 * KSLOT);
    const bf16_t* Qw = A.Q + (rowb + qb * 256 + wid * 32 + r32) * A.qp + h * DQK + hi * 8;
    bf16x8 qr[ND];
#pragma unroll
    for (int d0 = 0; d0 < ND; ++d0) qr[d0] = *(const bf16x8*)(Qw + d0 * 16);
    asm volatile("s_waitcnt vmcnt(0)\n\ts_barrier" ::: "memory");
    bf16x8 kf[2 * ND]; s16x4 vlo[8], vhi[8];
#define KLOAD(so) do { _Pragma("unroll") for (int d0 = 0; d0 < ND; ++d0) { kf[2 * d0] = *(const LAS bf16x8*)(kp0 + (so) + d0 * 2048); kf[2 * d0 + 1] = *(const LAS bf16x8*)(kp0 + (so) + d0 * 2048 + 512); } } while (0)
#define VLOAD(so) do { _Pragma("unroll") for (int i = 0; i < 8; ++i) { vlo[i] = vtr(vp0 + (so) + (i >> 2) * 4096 + (i & 3) * 1024); vhi[i] = vtr(vp0 + (so) + (i >> 2) * 4096 + (i & 3) * 1024 + 512); } } while (0)
#define VFR(i) (bf16x8){vlo[i][0], vlo[i][1], vlo[i][2], vlo[i][3], vhi[i][0], vhi[i][1], vhi[i][2], vhi[i][3]}
    KLOAD(0);
    asm volatile("s_waitcnt lgkmcnt(0)" ::: "memory");
    if (PROBE_ATT != 5 && wid >= 4) AT_BAR();
    f32x16 o0 = {}, o1 = {}, C0, C1; u32x4 pw0, pw1, pw2, pw3; float lsum = 0.f;
    const f32x16 zero = {};
#define QK_BLOCK() do { C0 = __builtin_amdgcn_mfma_f32_32x32x16_bf16(kf[0], qr[0], zero, 0, 0, 0); C1 = __builtin_amdgcn_mfma_f32_32x32x16_bf16(kf[1], qr[0], zero, 0, 0, 0); \
        _Pragma("unroll") for (int d0 = 1; d0 < ND; ++d0) { C0 = __builtin_amdgcn_mfma_f32_32x32x16_bf16(kf[2 * d0], qr[d0], C0, 0, 0, 0); C1 = __builtin_amdgcn_mfma_f32_32x32x16_bf16(kf[2 * d0 + 1], qr[d0], C1, 0, 0, 0); } } while (0)
#define PAF(k) __builtin_bit_cast(bf16x8, pw##k)
#define PV_BLOCK() do { \
        o0 = __builtin_amdgcn_mfma_f32_32x32x16_bf16(PAF(0), VFR(0), o0, 0, 0, 0); o1 = __builtin_amdgcn_mfma_f32_32x32x16_bf16(PAF(0), VFR(4), o1, 0, 0, 0); \
        o0 = __builtin_amdgcn_mfma_f32_32x32x16_bf16(PAF(1), VFR(1), o0, 0, 0, 0); o1 = __builtin_amdgcn_mfma_f32_32x32x16_bf16(PAF(1), VFR(5), o1, 0, 0, 0); \
        o0 = __builtin_amdgcn_mfma_f32_32x32x16_bf16(PAF(2), VFR(2), o0, 0, 0, 0); o1 = __builtin_amdgcn_mfma_f32_32x32x16_bf16(PAF(2), VFR(6), o1, 0, 0, 0); \
        o0 = __builtin_amdgcn_mfma_f32_32x32x16_bf16(PAF(3), VFR(3), o0, 0, 0, 0); o1 = __builtin_amdgcn_mfma_f32_32x32x16_bf16(PAF(3), VFR(7), o1, 0, 0, 0); } while (0)
#define SOFTMAX() do { \
        _Pragma("unroll") for (int r = 0; r < 16; ++r) { C0[r] = __builtin_amdgcn_exp2f(C0[r]); C1[r] = __builtin_amdgcn_exp2f(C1[r]); } \
        f32x2 s0_ = {C0[0], C0[1]}, s1_ = {C1[0], C1[1]}; _Pragma("unroll") for (int r = 2; r < 16; r += 2) { s0_ += (f32x2){C0[r], C0[r + 1]}; s1_ += (f32x2){C1[r], C1[r + 1]}; } s0_ += s1_; lsum += s0_[0] + s0_[1]; \
        pw0 = (u32x4){cvtpk(C0[0], C0[1]), cvtpk(C0[2], C0[3]), cvtpk(C0[4], C0[5]), cvtpk(C0[6], C0[7])}; pw1 = (u32x4){cvtpk(C0[8], C0[9]), cvtpk(C0[10], C0[11]), cvtpk(C0[12], C0[13]), cvtpk(C0[14], C0[15])}; \
        pw2 = (u32x4){cvtpk(C1[0], C1[1]), cvtpk(C1[2], C1[3]), cvtpk(C1[4], C1[5]), cvtpk(C1[6], C1[7])}; pw3 = (u32x4){cvtpk(C1[8], C1[9]), cvtpk(C1[10], C1[11]), cvtpk(C1[12], C1[13]), cvtpk(C1[14], C1[15])}; } while (0)
    int ka = 2 * KSLOT, kb = 0, kc = KSLOT, va = 2 * VSLOT, vb = 0, vc = VSLOT;
#define ROT() do { const int t_ = ka; ka = kb; kb = kc; kc = t_; const int u_ = va; va = vb; vb = vc; vc = u_; } while (0)
#define PINP() asm volatile("" : "+v"(lsum) : "v"(pw0), "v"(pw1), "v"(pw2), "v"(pw3))
#if ATT_REGSTAGE
    u32x4 kst = {}, kst2 = {}, vst = {};
    const LAS unsigned char* kw = lds + KOFF + wid * 1024 + lane * 16; const LAS unsigned char* kw2 = lds + KOFF + (8 + (wid & 3)) * 1024 + lane * 16; const LAS unsigned char* vw = lds + VOFF + wid * 1024 + lane * 16;
#define ST_WRITE(WK, WV) do { if (WK) { *(LAS u32x4*)(kw + ka) = kst; if (NKD == 2 && wid < 4) *(LAS u32x4*)(kw2 + ka) = kst2; } if (WV) *(LAS u32x4*)(vw + vc) = vst; } while (0)
#define ST_LOAD(sv, IK, IV) do { if (IK) { kst = *(const u32x4*)(ksrc + (size_t)((sv) + 4) * ktile); if (NKD == 2 && wid < 4) kst2 = *(const u32x4*)(ksrc2 + (size_t)((sv) + 4) * ktile); } if (IV) vst = *(const u32x4*)(vsrc + (size_t)((sv) + 3) * vtile); } while (0)
#define STEP(sv, DOQK, DOPV, KL, VL, IK, IV, WK, WV) do { \
        AT_SCHED(); if (DOQK) QK_BLOCK(); if (DOPV) PV_BLOCK(); AT_SCHED(); \
        asm volatile("s_barrier\n\ts_nop 15\n\ts_nop 3" : "+v"(C0), "+v"(C1), "+v"(o0), "+v"(o1) :: "memory"); AT_SCHED(); \
        if (KL) KLOAD(kc); if (VL) VLOAD(vb); ST_WRITE(WK, WV); ST_LOAD(sv, IK, IV); \
        if (DOQK) { SOFTMAX(); PINP(); } AT_SCHED(); \
        asm volatile("s_waitcnt lgkmcnt(0)\n\ts_barrier" ::: "memory"); \
        AT_SCHED(); ROT(); } while (0)
    STEP(-1, true, false, true, true, true, true, false, false);
#pragma nounroll
    for (int s = 0; s < NT - 4; ++s) STEP(s, true, true, true, true, true, true, true, true);
    STEP(NT - 4, true, true, true, true, false, true, true, true);
    STEP(NT - 3, true, true, true, true, false, false, false, true);
    STEP(NT - 2, true, true, false, true, false, false, false, false);
    STEP(NT - 1, false, true, false, false, false, false, false, false);
#undef ST_WRITE
#undef ST_LOAD
#else
#define STEP(sv, DOQK, DOPV, KL, VL, IK, IV) do { \
        AT_SCHED(); if (DOQK) QK_BLOCK(); if (DOPV) PV_BLOCK(); AT_SCHED(); \
          \
        asm volatile("s_barrier\n\ts_nop 15\n\ts_nop 3" : "+v"(C0), "+v"(C1), "+v"(o0), "+v"(o1) :: "memory"); AT_SCHED(); \
        if (KL) KLOAD(kc); if (VL) VLOAD(vb); if (IK) DMA_K((sv) + 4, kb); if (IV) DMA_V((sv) + 3, va); \
        if (DOQK) { SOFTMAX(); PINP(); } AT_SCHED(); \
        if (IK) { if (NKD == 2) { AT_WAITBAR(3); } else { AT_WAITBAR(2); } } else if (IV) { AT_WAITBAR(1); } else { AT_WAITBAR(0); } \
        AT_SCHED(); ROT(); } while (0)
    STEP(-1, true, false, true, true, true, true);
#pragma nounroll
    for (int s = 0; s < NT - 4; ++s) STEP(s, true, true, true, true, true, true);
    STEP(NT - 4, true, true, true, true, false, true);
    STEP(NT - 3, true, true, true, true, false, false);
    STEP(NT - 2, true, true, false, true, false, false);
    STEP(NT - 1, false, true, false, false, false, false);
#endif
#undef STEP
#undef PINP
    if (PROBE_ATT != 5 && wid < 4) AT_BAR();
    { auto rr = __builtin_amdgcn_permlane32_swap(__float_as_uint(lsum), __float_as_uint(lsum), false, false); lsum = __uint_as_float(rr[0]) + __uint_as_float(rr[1]); }
    LAS float* wsf = (LAS float*)(lds + WSF + wid * 256);
    if (hi == 0) wsf[r32] = lsum;
    asm volatile("s_waitcnt lgkmcnt(0)" ::: "memory");
    LAS bf16_t* stg = (LAS bf16_t*)(lds + OST + wid * 4096);
#pragma unroll
    for (int r = 0; r < 16; ++r) { const int orow = crow(r, hi); const float rl = __builtin_amdgcn_rcpf(wsf[orow]);
        stg[orow * 64 + r32] = (bf16_t)(cvtpk(o0[r] * rl, 0.f) & 0xffffu); stg[orow * 64 + 32 + r32] = (bf16_t)(cvtpk(o1[r] * rl, 0.f) & 0xffffu); }
    asm volatile("s_waitcnt lgkmcnt(0)" ::: "memory");
    bf16_t* Ow = A.O + (rowb + qb * 256 + wid * 32) * A.op + h * 64;
#pragma unroll
    for (int i = 0; i < 4; ++i) { const int row = i * 8 + (lane >> 3), ch = lane & 7; const u32x4 v = *(const LAS u32x4*)(stg + row * 64 + ch * 8); st16((Ow + (size_t)row * A.op + ch * 8), v); }
    asm volatile("s_waitcnt lgkmcnt(0)\n\ts_barrier" ::: "memory");
#undef DMA_K
#undef DMA_V
#undef KLOAD
#undef VLOAD
#undef VFR
#undef QK_BLOCK
#undef PAF
#undef PV_BLOCK
#undef SOFTMAX
#undef ROT
}
#endif
#if FAST_ATTN && ATT_FP8_A
typedef int v8i __attribute__((ext_vector_type(8)));
__device__ __forceinline__ f32x16 mfma8(v8i a, v8i b, f32x16 c) { return __builtin_amdgcn_mfma_scale_f32_32x32x64_f8f6f4(a, b, c, 0, 0, 0, 0x7f7f7f7f, 0, 0x7f7f7f7f); }
__device__ __forceinline__ void attn_unit_f8a(int tid, LAS unsigned char* lds, const unsigned char* Q8, const unsigned char* K8, const unsigned char* VT8, bf16_t* O, int op, int b, int h, int qb, float bias) {
    constexpr int SL = 4096, NT = S / 64;
    constexpr int KOFF = 0, VOFF = 3 * SL, OST = VOFF + 3 * SL, WSF = OST + 8 * 4096;
    const int lane = tid & 63, r32 = lane & 31, hi = lane >> 5, wid = __builtin_amdgcn_readfirstlane(tid >> 6);
    const int kvh = h >> 2; const size_t rowb = (size_t)b * S; const bool kw = wid < 4;
    const unsigned char* src = kw ? K8 + (rowb + lane) * 128 + kvh * 64 + 16 * wid : VT8 + ((size_t)((b * 2 + kvh) * 64 + lane)) * S + 16 * (wid - 4);
    const size_t tstep = kw ? (size_t)64 * 128 : (size_t)64;
    LAS unsigned char* dst = lds + (kw ? KOFF + wid * 1024 : VOFF + (wid - 4) * 1024);
#define DMA8(j, so) AT_GLDS(src + (size_t)(j) * tstep, dst + (so))
    const LAS unsigned char* kp0 = lds + KOFF + (2 * hi) * 1024 + r32 * 16;
    const LAS unsigned char* vp0 = lds + VOFF + (2 * hi) * 1024 + r32 * 16;
    if (kw) { DMA8(0, 0); DMA8(1, SL); DMA8(2, 2 * SL); } else { DMA8(0, 0); DMA8(1, SL); }
    v8i qf; { const unsigned char* Qw = Q8 + (rowb + qb * 256 + wid * 32 + r32) * 512 + h * 64 + 32 * hi; const u32x4 a = *(const u32x4*)Qw, c = *(const u32x4*)(Qw + 16);
        qf = (v8i){(int)a.x, (int)a.y, (int)a.z, (int)a.w, (int)c.x, (int)c.y, (int)c.z, (int)c.w}; }
    asm volatile("s_waitcnt vmcnt(0)\n\ts_barrier" ::: "memory");
    v8i kf0, kf1, vf0, vf1, p8;
#define LD32(dstv, p) do { const u32x4 a_ = *(const LAS u32x4*)(p), c_ = *(const LAS u32x4*)((p) + 1024); dstv = (v8i){(int)a_.x, (int)a_.y, (int)a_.z, (int)a_.w, (int)c_.x, (int)c_.y, (int)c_.z, (int)c_.w}; } while (0)
#define KLOAD8(so) do { LD32(kf0, kp0 + (so)); LD32(kf1, kp0 + (so) + 512); } while (0)
#define VLOAD8(so) do { LD32(vf0, vp0 + (so)); LD32(vf1, vp0 + (so) + 512); } while (0)
    KLOAD8(0);
    asm volatile("s_waitcnt lgkmcnt(0)" ::: "memory");
    if (wid >= 4) AT_BAR();
    f32x16 o0 = {}, o1 = {}, C0, C1; float lsum = 0.f;
    f32x16 negb;
#pragma unroll
    for (int r = 0; r < 16; ++r) negb[r] = bias;
    asm volatile("" : "+v"(negb));
#define SOFTMAX8() do { \
        _Pragma("unroll") for (int r = 0; r < 16; ++r) { C0[r] = __builtin_amdgcn_exp2f(C0[r]); C1[r] = __builtin_amdgcn_exp2f(C1[r]); } \
        f32x2 s0_ = {C0[0], C0[1]}, s1_ = {C1[0], C1[1]}; _Pragma("unroll") for (int r = 2; r < 16; r += 2) { s0_ += (f32x2){C0[r], C0[r + 1]}; s1_ += (f32x2){C1[r], C1[r + 1]}; } s0_ += s1_; lsum += s0_[0] + s0_[1]; \
        _Pragma("unroll") for (int i = 0; i < 4; ++i) { \
            p8[i] = __builtin_amdgcn_cvt_pk_fp8_f32(C0[4 * i + 2], C0[4 * i + 3], __builtin_amdgcn_cvt_pk_fp8_f32(C0[4 * i], C0[4 * i + 1], 0, false), true); \
            p8[4 + i] = __builtin_amdgcn_cvt_pk_fp8_f32(C1[4 * i + 2], C1[4 * i + 3], __builtin_amdgcn_cvt_pk_fp8_f32(C1[4 * i], C1[4 * i + 1], 0, false), true); } } while (0)
    int oa = 2 * SL, ob = 0, oc = SL;
#define ROT8() do { const int t_ = oa; oa = ob; ob = oc; oc = t_; } while (0)
#define STEP8(sv, DOQK, DOPV, KL, VL, IK, IV) do { \
        AT_SCHED(); if (DOQK) { C0 = mfma8(kf0, qf, negb); C1 = mfma8(kf1, qf, negb); } if (DOPV) { o0 = mfma8(p8, vf0, o0); o1 = mfma8(p8, vf1, o1); } AT_SCHED(); \
        asm volatile("s_barrier\n\ts_nop 15\n\ts_nop 15" : "+v"(C0), "+v"(C1), "+v"(o0), "+v"(o1) :: "memory"); AT_SCHED(); \
        if (KL) KLOAD8(oc); if (VL) VLOAD8(ob); \
        const bool iss_ = kw ? (IK) : (IV); if (iss_) { if (kw) DMA8((sv) + 4, ob); else DMA8((sv) + 3, oa); } \
        if (DOQK) { SOFTMAX8(); asm volatile("" : "+v"(lsum) : "v"(p8)); } AT_SCHED(); \
        if (iss_) { AT_WAITBAR(1); } else { AT_WAITBAR(0); } \
        AT_SCHED(); ROT8(); } while (0)
    STEP8(-1, true, false, true, true, true, true);
#pragma nounroll
    for (int s = 0; s < NT - 4; ++s) STEP8(s, true, true, true, true, true, true);
    STEP8(NT - 4, true, true, true, true, false, true);
    STEP8(NT - 3, true, true, true, true, false, false);
    STEP8(NT - 2, true, true, false, true, false, false);
    STEP8(NT - 1, false, true, false, false, false, false);
    if (wid < 4) AT_BAR();
    { auto rr = __builtin_amdgcn_permlane32_swap(__float_as_uint(lsum), __float_as_uint(lsum), false, false); lsum = __uint_as_float(rr[0]) + __uint_as_float(rr[1]); }
    LAS float* wsf = (LAS float*)(lds + WSF + wid * 256);
    if (hi == 0) wsf[r32] = lsum;
    asm volatile("s_waitcnt lgkmcnt(0)" ::: "memory");
    LAS bf16_t* stg = (LAS bf16_t*)(lds + OST + wid * 4096);
#pragma unroll
    for (int r = 0; r < 16; ++r) { const int orow = crow(r, hi); const float rl = __builtin_amdgcn_rcpf(wsf[orow]);
        stg[orow * 64 + r32] = (bf16_t)(cvtpk(o0[r] * rl, 0.f) & 0xffffu); stg[orow * 64 + 32 + r32] = (bf16_t)(cvtpk(o1[r] * rl, 0.f) & 0xffffu); }
    asm volatile("s_waitcnt lgkmcnt(0)" ::: "memory");
    bf16_t* Ow = O + (rowb + qb * 256 + wid * 32) * op + h * 64;
#pragma unroll
    for (int i = 0; i < 4; ++i) { const int row = i * 8 + (lane >> 3), ch = lane & 7; const u32x4 v = *(const LAS u32x4*)(stg + row * 64 + ch * 8); st16(Ow + (size_t)row * op + ch * 8, v); }
    asm volatile("s_waitcnt lgkmcnt(0)\n\ts_barrier" ::: "memory");
#undef DMA8
#undef LD32
#undef KLOAD8
#undef VLOAD8
#undef SOFTMAX8
#undef ROT8
#undef STEP8
}
__device__ __forceinline__ void attn_phase_f8a(int tid, LAS unsigned char* lds, const unsigned char* Q8, const unsigned char* K8, const unsigned char* VT8, bf16_t* O, int op, const float* gq, const float* gk, int vcu, int G) {
    float mq = 0.f, mk = 0.f;
    for (int i = 0; i < 64; ++i) { mq = fmaxf(mq, fabsf(gq[i])); mk = fmaxf(mk, fabsf(gk[i])); }
    const float bias = -fmaxf(64.f * mq * mk * QSCALE_A - 8.f, 0.f);
    int bh, qb;
    for (int i = 0; next_unit(i, vcu, G, bh, qb); ++i) attn_unit_f8a(tid, lds, Q8, K8, VT8, O, op, bh >> 3, bh & 7, qb, bias);
}
#endif
template <int DQK>
__device__ __forceinline__ void attn_phase(int tid, LAS unsigned char* lds, const Tensors& A, int vcu, int G) {
#if FAST_ATTN
    int bh, qb;
    for (int i = 0; next_unit(i, vcu, G, bh, qb); ++i) attn_unit<DQK>(tid, lds, A, bh >> 3, bh & 7, qb);
#else
    (void)lds; attn_phase_ref<DQK>(tid, A, vcu, G);
#endif
}
}


struct Args { const float* in[22]; float* out; unsigned char* ws; int ph_lo, ph_hi; };
struct Frame {
    LAS unsigned char* lds; volatile LAS unsigned* MISC; unsigned* ctl;
    int tid, lane, wave, vcu, G;
    unsigned char* ws; float* OUT;
};

__device__ __forceinline__ void p0_phase(Frame& F, const float* c, const float* w_ada, const float* b_ada) {
    LAS float* cs = (LAS float*)F.lds;
    LAS float* red = (LAS float*)(F.lds + 32768);
    for (int i = F.tid; i < NB * D; i += NTHREADS) { const float v = c[i]; cs[i] = v / (1.f + __expf(-v)); }
    __syncthreads();
    float* mod = (float*)(F.ws + WS_MOD);
    const int kq = F.wave, col = F.lane;
    for (int item = F.vcu; item < NL * 6 * D / 64; item += F.G) {
        const int l = item / (6 * D / 64), n0 = (item % (6 * D / 64)) * 64;
        const float* w = w_ada + (size_t)l * D * 6 * D + n0 + col;
        float acc[NB];
#pragma unroll
        for (int b = 0; b < NB; ++b) acc[b] = 0.f;
#pragma unroll 8
        for (int k = kq * 128; k < kq * 128 + 128; ++k) { const float wv = w[(size_t)k * 6 * D];
#pragma unroll
            for (int b = 0; b < NB; ++b) acc[b] += cs[b * D + k] * wv; }
#pragma unroll
        for (int b = 0; b < NB; ++b) red[(kq * NB + b) * 64 + col] = acc[b];
        __syncthreads();
        { const int b = F.wave; float s = 0.f;
#pragma unroll
          for (int q = 0; q < 8; ++q) s += red[(q * NB + b) * 64 + col];
          mod[((size_t)l * NB + b) * 6 * D + n0 + col] = s + b_ada[(size_t)l * 6 * D + n0 + col]; }
        __syncthreads();
    }
    float* cosA = (float*)(F.ws + WS_COSA); float* sinA = (float*)(F.ws + WS_SINA); float* cosB = (float*)(F.ws + WS_COSB); float* sinB = (float*)(F.ws + WS_SINB);
    for (int idx = F.vcu * NTHREADS + F.tid; idx < S * 48; idx += F.G * NTHREADS) {
        const int s = idx / 48, i = idx % 48; const float row = (float)(s >> 6), col2 = (float)(s & 63);
        if (i < 32) { const int j = i & 15; const float a = (i < 16 ? row : col2) * (1.0f / powf(10000.0f, (float)j / 16.0f)); cosA[s * 32 + i] = cosf(a); sinA[s * 32 + i] = sinf(a); }
        else { const int ii = i - 32, j = ii & 7; const float a = (ii < 8 ? row : col2) * (1.0f / powf(10000.0f, (float)j / 8.0f)); cosB[s * 16 + ii] = cosf(a); sinB[s * 16 + ii] = sinf(a); }
    }
}

template <class SrcFn>
__device__ __forceinline__ void cvt_item(const float* W, int K, int Nsrc, const float* kg, bf16_t* WT, LAS float* scr, int item, int nblk, int lane, const SrcFn& src) {
    const int kb = item / nblk, nb = item % nblk, k0 = 64 * kb, n0 = 32 * nb;
    const int sc = src(n0 + (lane & 31));
#pragma unroll
    for (int i = 0; i < 32; ++i) { const int kk = 2 * i + (lane >> 5); float v = sc >= 0 ? W[(size_t)(k0 + kk) * Nsrc + sc] : 0.f; if (kg) v *= kg[k0 + kk]; scr[kk * 33 + (lane & 31)] = v; }
    LDS_WAIT(); asm volatile("" ::: "memory");
    const int c = lane & 7;
#pragma unroll
    for (int j = 0; j < 4; ++j) { const int n = (lane >> 3) + 8 * j; const LAS float* s = scr + (8 * c) * 33 + n;
        u32x4 o; o.x = cvt_pk_bf16(s[0 * 33], s[1 * 33]); o.y = cvt_pk_bf16(s[2 * 33], s[3 * 33]); o.z = cvt_pk_bf16(s[4 * 33], s[5 * 33]); o.w = cvt_pk_bf16(s[6 * 33], s[7 * 33]);
        *(u32x4*)(WT + (size_t)(n0 + n) * K + k0 + 8 * c) = o; }
    LDS_WAIT(); asm volatile("" ::: "memory");
}
struct SrcId { __device__ int operator()(int n) const { return n; } };
struct SrcIn { __device__ int operator()(int n) const { return gp::src_col_in(n); } };
typedef __attribute__((address_space(4))) const Args CArgsW;
__device__ __forceinline__ void convert_weights(Frame& F, CArgsW* a, int l) {
    LAS float* scr = (LAS float*)(F.lds + F.wave * 16384);
    const int gw = F.vcu * NWAVES + F.wave, NGW = F.G * NWAVES;
    const float* w_in = ((const float*)(GAS const float*)a->in[5]) + (size_t)l * D * INC; const float* w_q_b = ((const float*)(GAS const float*)a->in[10]) + (size_t)l * 384 * 768; const float* w_kv_b = ((const float*)(GAS const float*)a->in[11]) + (size_t)l * 256 * 1024;
    const float* w_pa = ((const float*)(GAS const float*)a->in[12]) + (size_t)l * 512 * D; const float* w_pb = ((const float*)(GAS const float*)a->in[13]) + (size_t)l * 512 * D; const float* w_o = ((const float*)(GAS const float*)a->in[14]) + (size_t)l * D * D;
    const float* w1 = ((const float*)(GAS const float*)a->in[18]) + (size_t)l * NE * D * FF; const float* w3 = ((const float*)(GAS const float*)a->in[19]) + (size_t)l * NE * D * FF; const float* w2 = ((const float*)(GAS const float*)a->in[20]) + (size_t)l * NE * FF * D;
    const float* gqa = ((const float*)(GAS const float*)a->in[8]) + l * 384; const float* gkv = ((const float*)(GAS const float*)a->in[9]) + l * 256;
    bf16_t* Win = (bf16_t*)(F.ws + WS_WIN); bf16_t* Wqb = (bf16_t*)(F.ws + WS_WQB); bf16_t* Wkvb = (bf16_t*)(F.ws + WS_WKVB); bf16_t* Wpa = (bf16_t*)(F.ws + WS_WPA); bf16_t* Wpb = (bf16_t*)(F.ws + WS_WPB);
    bf16_t* Wo = (bf16_t*)(F.ws + WS_WO); bf16_t* W13 = (bf16_t*)(F.ws + WS_W13); bf16_t* W2 = (bf16_t*)(F.ws + WS_W2);
    constexpr int I_IN = (D / 64) * (NIN / 32), I_QB = (384 / 64) * (768 / 32), I_KVB = (256 / 64) * (1024 / 32), I_P = (512 / 64) * (D / 32), I_O = (D / 64) * (D / 32);
    constexpr int I_13 = (D / 64) * (1024 / 32), I_2 = (FF / 64) * (D / 32);
    constexpr int NITEMS = I_IN + I_QB + I_KVB + 2 * I_P + I_O + NE * (I_13 + I_2);
    for (int it = gw; it < NITEMS; it += NGW) {
        int r = it;
        if (r < I_IN) { cvt_item(w_in, D, INC, nullptr, Win, scr, r, NIN / 32, F.lane, SrcIn()); continue; } r -= I_IN;
        if (r < I_QB) { cvt_item(w_q_b, 384, 768, gqa, Wqb, scr, r, 768 / 32, F.lane, SrcId()); continue; } r -= I_QB;
        if (r < I_KVB) { cvt_item(w_kv_b, 256, 1024, gkv, Wkvb, scr, r, 1024 / 32, F.lane, SrcId()); continue; } r -= I_KVB;
        if (r < I_P) { cvt_item(w_pa, 512, D, nullptr, Wpa, scr, r, D / 32, F.lane, SrcId()); continue; } r -= I_P;
        if (r < I_P) { cvt_item(w_pb, 512, D, nullptr, Wpb, scr, r, D / 32, F.lane, SrcId()); continue; } r -= I_P;
        if (r < I_O) { cvt_item(w_o, D, D, nullptr, Wo, scr, r, D / 32, F.lane, SrcId()); continue; } r -= I_O;
        if (r < NE * I_13) { const int e = r / I_13, q = r % I_13, nb = q % 32;
            const float* src = ((nb & 7) < 4 ? w1 : w3) + (size_t)e * D * FF; const int cb = (nb >> 3) * 128 + (nb & 3) * 32;
            struct SrcOff { int n0, cb; __device__ int operator()(int n) const { return cb + (n - n0); } } so{nb * 32, cb};
            cvt_item(src, D, FF, nullptr, W13 + (size_t)e * 1024 * D, scr, q, 32, F.lane, so); continue; } r -= NE * I_13;
        { const int e = r / I_2, q = r % I_2; cvt_item(w2 + (size_t)e * FF * D, FF, D, nullptr, W2 + (size_t)e * D * FF, scr, q, D / 32, F.lane, SrcId()); }
    }
}

template <int MODE>
__device__ __forceinline__ void row_phase(Frame& F, const float* xin, const float* g2prev, const float* gain, const float* modl, int sh_off, int sc_off, bf16_t* H, bf16_t* XB, float* OUT) {
    constexpr int RB = 4;
    const int gw = F.vcu * NWAVES + F.wave, NGW = F.G * NWAVES;
    const bf16_t* Y2 = (const bf16_t*)(F.ws + WS_Y2);
    for (int m0 = gw; m0 < T; m0 += RB * NGW) {
        f32x4 v[RB][4]; float ss[RB];
        if (MODE == 0) {
#pragma unroll
            for (int r = 0; r < RB; ++r)
#pragma unroll
                for (int j = 0; j < 4; ++j) v[r][j] = *(const f32x4*)(xin + (size_t)(m0 + r * NGW) * D + 4 * F.lane + 256 * j);
        } else {
            unsigned ya[RB][4], yb[RB][4]; f32x4 g[RB][4];
#pragma unroll
            for (int r = 0; r < RB; ++r)
#pragma unroll
                for (int j = 0; j < 4; ++j) { const int m = m0 + r * NGW, c = 4 * F.lane + 256 * j;
                    { const u32x2 xb = *(const u32x2*)(XB + (size_t)m * D + c); v[r][j] = (f32x4){bf2f(xb.x & 0xffffu), bf2f(xb.x >> 16), bf2f(xb.y & 0xffffu), bf2f(xb.y >> 16)}; } ya[r][j] = *(const unsigned*)((const unsigned char*)Y2 + (size_t)(2 * m) * D + c); yb[r][j] = *(const unsigned*)((const unsigned char*)Y2 + (size_t)(2 * m + 1) * D + c);
                    g[r][j] = *(const f32x4*)(g2prev + (size_t)(m >> 12) * 6 * D + 5 * D + c); }
#pragma unroll
            for (int r = 0; r < RB; ++r)
#pragma unroll
                for (int j = 0; j < 4; ++j) { const f32x2 a0 = __builtin_amdgcn_cvt_pk_f32_fp8((int)ya[r][j], false), a1 = __builtin_amdgcn_cvt_pk_f32_fp8((int)ya[r][j], true), b0 = __builtin_amdgcn_cvt_pk_f32_fp8((int)yb[r][j], false), b1 = __builtin_amdgcn_cvt_pk_f32_fp8((int)yb[r][j], true);
                    const f32x4 y = (f32x4){a0[0] + b0[0], a0[1] + b0[1], a1[0] + b1[0], a1[1] + b1[1]} * 0.0625f;
                    v[r][j] += g[r][j] * y; }
        }
#pragma unroll
        for (int r = 0; r < RB; ++r) { ss[r] = (gp::dot4(v[r][0]) + gp::dot4(v[r][1])) + (gp::dot4(v[r][2]) + gp::dot4(v[r][3])); }
#pragma unroll
        for (int o = 1; o < 64; o <<= 1)
#pragma unroll
            for (int r = 0; r < RB; ++r) ss[r] += __shfl_xor(ss[r], o);
#pragma unroll
        for (int r = 0; r < RB; ++r) {
            const int m = m0 + r * NGW, b = m >> 12; const float rstd = rsqrtf(ss[r] * (1.f / D) + EPS);
#pragma unroll
            for (int j = 0; j < 4; ++j) {
                const int c = 4 * F.lane + 256 * j; const f32x4 gn = *(const f32x4*)(gain + c);
                if (MODE == 2) { *(f32x4*)(OUT + (size_t)m * D + c) = v[r][j] * rstd * gn; }
                else {
                    { u32x2 xw; xw.x = cvt_pk_bf16(v[r][j][0], v[r][j][1]); xw.y = cvt_pk_bf16(v[r][j][2], v[r][j][3]); st8((XB + (size_t)m * D + c), xw); }
                    const f32x4 sc = *(const f32x4*)(modl + (size_t)b * 6 * D + sc_off + c), sh = *(const f32x4*)(modl + (size_t)b * 6 * D + sh_off + c);
                    const f32x4 hv = v[r][j] * rstd * gn * (1.f + sc) + sh;
                    u32x2 w; w.x = cvt_pk_bf16(hv[0], hv[1]); w.y = cvt_pk_bf16(hv[2], hv[3]);
                    st8((H + (size_t)m * D + c), w);
                }
            }
        }
    }
}

__device__ __forceinline__ void t2_phase(Frame& F, const float* gain, const float* modl, const float* w_router, const float* rbias, int l, bool record) {
    LAS f32x4* wl = (LAS f32x4*)F.lds;
    LAS int* rec = (LAS int*)(F.lds + 65536);
    LAS float* recw = (LAS float*)(F.lds + 65536 + 2048);
    LAS int* lcnt = (LAS int*)(F.lds + 65536 + 4096);
    for (int idx = F.tid; idx < 4096; idx += NTHREADS) {
        const int lane = idx & 63, c = (idx >> 6) & 3, i = (idx >> 8) & 3, j = idx >> 10; const int k = 4 * lane + 256 * j + i;
        wl[idx] = *(const f32x4*)(w_router + (size_t)k * NE + 4 * c);
    }
    if (F.tid < 32) lcnt[F.tid] = 0;
    __syncthreads();
    constexpr int RB = 4;
    const int gw = F.vcu * NWAVES + F.wave, NGW = F.G * NWAVES;
    bf16_t* H = (bf16_t*)(F.ws + WS_H); const bf16_t* XB = (const bf16_t*)(F.ws + WS_XB);
    const int lane = F.lane, myrow = lane >> 4, mye = lane & 15;
    int it = 0;
    for (int m0 = gw; m0 < T; m0 += RB * NGW, ++it) {
        f32x4 v[RB][4]; float ss[RB];
#pragma unroll
        for (int r = 0; r < RB; ++r)
#pragma unroll
            for (int j = 0; j < 4; ++j) { const u32x2 xb = *(const u32x2*)(XB + (size_t)(m0 + r * NGW) * D + 4 * lane + 256 * j); v[r][j] = (f32x4){bf2f(xb.x & 0xffffu), bf2f(xb.x >> 16), bf2f(xb.y & 0xffffu), bf2f(xb.y >> 16)}; }
#pragma unroll
        for (int r = 0; r < RB; ++r) ss[r] = (gp::dot4(v[r][0]) + gp::dot4(v[r][1])) + (gp::dot4(v[r][2]) + gp::dot4(v[r][3]));
#pragma unroll
        for (int o = 1; o < 64; o <<= 1)
#pragma unroll
            for (int r = 0; r < RB; ++r) ss[r] += __shfl_xor(ss[r], o);
        float acc[RB * NE];
#pragma unroll
        for (int q = 0; q < RB * NE; ++q) acc[q] = 0.f;
#pragma unroll
        for (int j = 0; j < 4; ++j) {
            const int c = 4 * lane + 256 * j; const f32x4 gn = *(const f32x4*)(gain + c);
#pragma unroll
            for (int r = 0; r < RB; ++r) {
                const int m = m0 + r * NGW, b = m >> 12; const float rstd = rsqrtf(ss[r] * (1.f / D) + EPS);
                const f32x4 sc = *(const f32x4*)(modl + (size_t)b * 6 * D + 4 * D + c), sh = *(const f32x4*)(modl + (size_t)b * 6 * D + 3 * D + c);
                v[r][j] = v[r][j] * rstd * gn * (1.f + sc) + sh;
                u32x2 w; w.x = cvt_pk_bf16(v[r][j][0], v[r][j][1]); w.y = cvt_pk_bf16(v[r][j][2], v[r][j][3]);
                st8((H + (size_t)m * D + c), w);
            }
#pragma unroll
            for (int i = 0; i < 4; ++i)
#pragma unroll
                for (int c4 = 0; c4 < 4; ++c4) { const f32x4 wv = wl[((j * 4 + i) * 4 + c4) * 64 + lane];
#pragma unroll
                    for (int r = 0; r < RB; ++r) { const float hv = v[r][j][i];
                        acc[r * NE + 4 * c4 + 0] += hv * wv[0]; acc[r * NE + 4 * c4 + 1] += hv * wv[1]; acc[r * NE + 4 * c4 + 2] += hv * wv[2]; acc[r * NE + 4 * c4 + 3] += hv * wv[3]; } }
        }
#pragma unroll
        for (int sft = 32; sft >= 1; sft >>= 1) {
            const bool up = (lane & sft) != 0;
#pragma unroll
            for (int k = 0; k < sft; ++k) { const float a = acc[k], b = acc[k + sft]; const float keep = up ? b : a, send = up ? a : b; acc[k] = keep + __shfl_xor(send, sft); }
        }
        const float logit = acc[0];
        const float score = 1.f / (1.f + expf(-logit));
        float scv[NE], bi[NE];
#pragma unroll
        for (int e = 0; e < NE; ++e) { scv[e] = __shfl(score, (lane & 48) | e); bi[e] = scv[e] + rbias[e]; }
        int gsel = 0; float gbest = -INFINITY;
#pragma unroll
        for (int g = 0; g < 4; ++g) { float m1 = -INFINITY, m2 = -INFINITY;
#pragma unroll
            for (int j = 0; j < 4; ++j) { const float x = bi[g * 4 + j]; if (x > m1) { m2 = m1; m1 = x; } else if (x > m2) m2 = x; }
            const float gs = m1 + m2; if (gs > gbest) { gbest = gs; gsel = g; } }
        int e1 = -1, e2 = -1; float b1 = -INFINITY, b2 = -INFINITY, s1 = 0.f, s2 = 0.f;
#pragma unroll
        for (int j = 0; j < 4; ++j) { float x = -INFINITY, sx = 0.f;
#pragma unroll
            for (int g = 0; g < 4; ++g) if (g == gsel) { x = bi[g * 4 + j]; sx = scv[g * 4 + j]; }
            const int e = gsel * 4 + j;
            if (x > b1) { b2 = b1; e2 = e1; s2 = s1; b1 = x; e1 = e; s1 = sx; } else if (x > b2) { b2 = x; e2 = e; s2 = sx; } }
        if (mye == 0) {
            const float inv = 1.f / (s1 + s2); const int slot = (it * RB + myrow) * NWAVES + F.wave;
            rec[slot * 4 + 0] = e1; rec[slot * 4 + 1] = e2;
            rec[slot * 4 + 2] = __hip_atomic_fetch_add(&lcnt[e1], 1, __ATOMIC_RELAXED, __HIP_MEMORY_SCOPE_WORKGROUP);
            rec[slot * 4 + 3] = __hip_atomic_fetch_add(&lcnt[e2], 1, __ATOMIC_RELAXED, __HIP_MEMORY_SCOPE_WORKGROUP);
            recw[slot * 2 + 0] = s1 * inv; recw[slot * 2 + 1] = s2 * inv;
        }
    }
    __syncthreads();
    if (!record) return;
    if (F.tid < NE) lcnt[16 + F.tid] = (int)__hip_atomic_fetch_add(F.ctl + CW_CNT + (l * NE + F.tid) * 64, (unsigned)lcnt[F.tid], __ATOMIC_RELAXED, __HIP_MEMORY_SCOPE_AGENT);
    __syncthreads();
    unsigned* list = (unsigned*)(F.ws + WS_LIST); float* gwb = (float*)(F.ws + WS_GW);
    const int nrows = it * RB;
    for (int s = F.tid; s < nrows * NWAVES; s += NTHREADS) {
        const int i2 = s / NWAVES, w = s % NWAVES; const int m = F.vcu * NWAVES + w + i2 * NGW;
        const int e1 = rec[s * 4 + 0], e2 = rec[s * 4 + 1];
        list[(size_t)e1 * T + lcnt[16 + e1] + rec[s * 4 + 2]] = (unsigned)(2 * m); list[(size_t)e2 * T + lcnt[16 + e2] + rec[s * 4 + 3]] = (unsigned)(2 * m + 1);
        gwb[2 * m] = recw[s * 2]; gwb[2 * m + 1] = recw[s * 2 + 1];
    }
}
__device__ __forceinline__ const LAS int* moe_table(Frame& F, int l) {
    LAS int* tab = (LAS int*)(F.lds + MISC_OFF + 1024);
    __syncthreads();
    if (F.tid == 0) { int acc = 0;
        for (int e = 0; e < NE; ++e) { const int c = (int)__hip_atomic_load(F.ctl + CW_CNT + (l * NE + e) * 64, __ATOMIC_RELAXED, __HIP_MEMORY_SCOPE_AGENT); tab[e] = acc; tab[32 + e] = c; acc += (c + 255) >> 8; }
        tab[16] = acc; }
    __syncthreads();
    return tab;
}

typedef __attribute__((address_space(4))) const Args CArgs;
#define LAUNDER_GP(T_, p) do { GAS T_* _t = (GAS T_*)(p); asm volatile("" : "+s"(_t)); (p) = (T_*)_t; } while (0)
#define PH_BEGIN() LAUNDER_V(F.tid); F.lane = F.tid & 63; LAUNDER_GP(unsigned, F.ctl); LAUNDER_GP(float, F.OUT); LAUNDER_GP(unsigned char, F.ws); GAS unsigned char* ws = (GAS unsigned char*)F.ws; CArgs* ka = (CArgs*)__builtin_amdgcn_kernarg_segment_ptr(); LAUNDER_S(ka); \
    float* mod = WSP(float, WS_MOD); (void)mod; (void)ka
#define WSP(T_, off) ((T_*)(GAS T_*)(ws + (off)))
#define KIN(i) ((const float*)(GAS const float*)ka->in[i])
__global__ void __launch_bounds__(NTHREADS, 2) fwd_kernel(Args args) {
    extern __shared__ __attribute__((aligned(16))) unsigned char lds_raw[];
    Frame F;
    F.lds = (LAS unsigned char*)lds_raw; F.MISC = (volatile LAS unsigned*)(F.lds + MISC_OFF);
    F.tid = threadIdx.x; F.lane = F.tid & 63; F.wave = __builtin_amdgcn_readfirstlane(F.tid >> 6);
    F.G = gridDim.x; { const int bx = blockIdx.x; F.vcu = (F.G % 8 == 0) ? (bx % 8) * (F.G / 8) + bx / 8 : bx; }
    F.ws = (unsigned char*)(GAS unsigned char*)args.ws; F.ctl = (unsigned*)(GAS unsigned*)(args.ws + WS_CTL); F.OUT = (float*)(GAS float*)args.out;
    if (F.tid < 64) F.MISC[F.tid] = 0u;
    __syncthreads();
    XcdBarrier bar; bar.bar = F.ctl + CW_BAR; bar.x = 0; bar.st = nullptr;
    if (!N_LAUNCH_MODE) bar = xcd_barrier_post(F.ctl + CW_BAR, F.MISC + 8);
    const int lo = args.ph_lo, hi = args.ph_hi;
#define IN(k) (lo <= (k) && (k) < hi)
#define SEAM(k) do { if ((k) + 1 < hi) { if (!N_LAUNCH_MODE) xcd_barrier(bar); } } while (0)
    const int cidx = (int)blockIdx.x;

    if (IN(0)) { PH_BEGIN(); p0_phase(F, KIN(1), KIN(2), KIN(3)); __syncthreads(); LAUNDER_V(F.tid); F.lane = F.tid & 63; convert_weights(F, ka, 0); SEAM(0); }
    for (int l = 0; l < NL; ++l) {
        const int pb = 1 + 9 * l;
        if (IN(pb + 0)) {
            PH_BEGIN();
            if (l > 0) for (int rep = 0; rep < ((PROBE_DUP & 8) ? 2 : 1); ++rep) { LAUNDER_V(F.tid); F.lane = F.tid & 63; convert_weights(F, ka, l); }
            if (l == 0) row_phase<0>(F, KIN(0), nullptr, KIN(4) + l * D, mod + (size_t)l * NB * 6 * D, 0, D, WSP(bf16_t, WS_H), WSP(bf16_t, WS_XB), nullptr);
            else row_phase<1>(F, nullptr, mod + (size_t)(l - 1) * NB * 6 * D, KIN(4) + l * D, mod + (size_t)l * NB * 6 * D, 0, D, WSP(bf16_t, WS_H), WSP(bf16_t, WS_XB), nullptr);
            SEAM(pb + 0);
        }
        if (IN(pb + 1)) {
            PH_BEGIN();
            gp::Gemm g{WSP(bf16_t, WS_H), WSP(const bf16_t, WS_WIN), D, 0, nullptr}; gp::DenseOrder So; So.init(T, NIN, F.G, cidx);
            gp::EpiIn E{WSP(bf16_t, ATT_FP8_A ? WS_QA8 : WS_QA), WSP(bf16_t, ATT_FP8_A ? WS_KA8 : WS_KA), WSP(bf16_t, ATT_FP8_A ? WS_VTA8 : WS_VA), WSP(bf16_t, WS_QLAT), WSP(bf16_t, WS_KVLAT), WSP(bf16_t, WS_KB), WSP(bf16_t, WS_SA), WSP(bf16_t, WS_SB), WSP(float, WS_SSQ), WSP(float, WS_SSKV),
                        KIN(6) + l * 64, KIN(7) + l * 64, WSP(const float, WS_COSA), WSP(const float, WS_SINA), WSP(const float, WS_COSB), WSP(const float, WS_SINB)};
            if (PROBE_DUP & 128) { gp::EpiNull En; gp::gemm_phase<gp::EpiNull, gp::DenseOrder>(F.tid, F.lds, g, So, En); LAUNDER_V(F.tid); }
            gp::gemm_phase<gp::EpiIn, gp::DenseOrder>(F.tid, F.lds, g, So, E); if (PROBE_DUP & (2 | 512)) { LAUNDER_V(F.tid); gp::gemm_phase<gp::EpiIn, gp::DenseOrder>(F.tid, F.lds, g, So, E); }
            SEAM(pb + 1);
        }
        if (IN(pb + 2)) {
            { PH_BEGIN(); gp::Gemm g{WSP(bf16_t, WS_QLAT), WSP(const bf16_t, WS_WQB), 384, 0, nullptr}; gp::DenseOrder So; So.init(T, 768, F.G, cidx);
              gp::EpiQb E{WSP(bf16_t, WS_QB), WSP(const float, WS_SSQ), WSP(const float, WS_COSB), WSP(const float, WS_SINB)}; gp::gemm_phase<gp::EpiQb, gp::DenseOrder>(F.tid, F.lds, g, So, E); if (PROBE_DUP & 2) { LAUNDER_V(F.tid); gp::gemm_phase<gp::EpiQb, gp::DenseOrder>(F.tid, F.lds, g, So, E); } }
            { PH_BEGIN(); gp::Gemm g{WSP(bf16_t, WS_KVLAT), WSP(const bf16_t, WS_WKVB), 256, 0, nullptr}; gp::DenseOrder So; So.init(T, 1024, F.G, F.G - 1 - cidx);
              gp::EpiKvb E{WSP(bf16_t, WS_KB), WSP(bf16_t, WS_VB), WSP(const float, WS_SSKV)}; gp::gemm_phase<gp::EpiKvb, gp::DenseOrder>(F.tid, F.lds, g, So, E); if (PROBE_DUP & 2) { LAUNDER_V(F.tid); gp::gemm_phase<gp::EpiKvb, gp::DenseOrder>(F.tid, F.lds, g, So, E); } }
            if (PROBE_DUP & 1) { PH_BEGIN(); const at::Tensors A{WSP(bf16_t, WS_QA), 512, WSP(bf16_t, WS_KA), 128, WSP(bf16_t, WS_VA), 128, WSP(bf16_t, WS_OB), 512, 4}; at::attn_phase<64>(F.tid, F.lds, A, F.vcu, F.G); }
#if FAST_ATTN && ATT_FP8_A
            { PH_BEGIN(); at::attn_phase_f8a(F.tid, F.lds, WSP(const unsigned char, WS_QA8), WSP(const unsigned char, WS_KA8), WSP(const unsigned char, WS_VTA8), WSP(bf16_t, WS_QA), 512, KIN(6) + l * 64, KIN(7) + l * 64, F.vcu, F.G); }
#else
            { PH_BEGIN(); const at::Tensors A{WSP(bf16_t, WS_QA), 512, WSP(bf16_t, WS_KA), 128, WSP(bf16_t, WS_VA), 128, WSP(bf16_t, WS_QA), 512, 4}; at::attn_phase<64>(F.tid, F.lds, A, F.vcu, F.G); }
#endif
            SEAM(pb + 2);
        }
        if (IN(pb + 3)) {
            PH_BEGIN();
            const at::Tensors A{WSP(bf16_t, WS_QB), 768, WSP(bf16_t, WS_KB), 768, WSP(bf16_t, WS_VB), 512, WSP(bf16_t, WS_OB), 512, 1}; for (int rep = 0; rep < ((PROBE_DUP & 1) ? 2 : 1); ++rep) at::attn_phase<96>(F.tid, F.lds, A, F.vcu, F.G);
            SEAM(pb + 3);
        }
        if (IN(pb + 4)) {
            PH_BEGIN();
            gp::Gemm g{WSP(bf16_t, WS_QA), WSP(const bf16_t, WS_WPA), 512, (size_t)(WS_WPB - WS_WPA) / 2, nullptr, (size_t)(WS_OB - WS_QA) / 2}; gp::PairOrder So; So.init(T, D, F.G, cidx);
            gp::EpiProjP E{WSP(bf16_t, WS_H), WSP(const unsigned char, WS_SA), WSP(const unsigned char, WS_SB)};
            gp::gemm_phase<gp::EpiProjP, gp::PairOrder>(F.tid, F.lds, g, So, E);
            if (PROBE_DUP & (2 | 1024)) { LAUNDER_V(F.tid); gp::gemm_phase<gp::EpiProjP, gp::PairOrder>(F.tid, F.lds, g, So, E); }
            SEAM(pb + 4);
        }
        if (IN(pb + 5)) {
            PH_BEGIN();
            gp::Gemm g{WSP(bf16_t, WS_H), WSP(const bf16_t, WS_WO), D, 0, nullptr}; gp::DenseOrder So; So.init(T, D, F.G, cidx);
            gp::EpiWo E{WSP(const bf16_t, WS_XB), mod + (size_t)l * NB * 6 * D, WSP(bf16_t, WS_XB)}; gp::gemm_phase<gp::EpiWo, gp::DenseOrder>(F.tid, F.lds, g, So, E);
            SEAM(pb + 5);
        }
        if (IN(pb + 6)) {
            PH_BEGIN();
            if (PROBE_DUP & 16) { t2_phase(F, KIN(15) + l * D, mod + (size_t)l * NB * 6 * D, KIN(16), KIN(17), l, false); LAUNDER_V(F.tid); F.lane = F.tid & 63; __syncthreads(); }
            t2_phase(F, KIN(15) + l * D, mod + (size_t)l * NB * 6 * D, KIN(16), KIN(17), l, true);
            SEAM(pb + 6);
        }
        if (IN(pb + 7)) {
            PH_BEGIN();
            const LAS int* tab = moe_table(F, l);
            gp::Gemm g{WSP(bf16_t, WS_H), WSP(const bf16_t, WS_W13), D, (size_t)1024 * D, WSP(const unsigned, WS_LIST)}; gp::MoeOrder So; So.init(tab, F.G, cidx);
            if (PROBE_DUP & 256) { gp::EpiNull En; gp::gemm_phase<gp::EpiNull, gp::MoeOrder, true>(F.tid, F.lds, g, So, En); LAUNDER_V(F.tid); }
            gp::EpiUp E{WSP(bf16_t, WS_ACT)}; gp::gemm_phase<gp::EpiUp, gp::MoeOrder, true>(F.tid, F.lds, g, So, E); if (PROBE_DUP & 4) { LAUNDER_V(F.tid); gp::gemm_phase<gp::EpiUp, gp::MoeOrder, true>(F.tid, F.lds, g, So, E); }
            SEAM(pb + 7);
        }
        if (IN(pb + 8)) {
            PH_BEGIN();
            const LAS int* tab = moe_table(F, l);
            gp::Gemm g{WSP(bf16_t, WS_ACT), WSP(const bf16_t, WS_W2), FF, (size_t)D * FF, nullptr}; gp::MoeOrder So; So.init(tab, F.G, cidx);
            gp::EpiDown E{WSP(bf16_t, WS_Y2), WSP(const unsigned, WS_LIST), WSP(const float, WS_GW)}; gp::gemm_phase<gp::EpiDown, gp::MoeOrder, false>(F.tid, F.lds, g, So, E); if (PROBE_DUP & 4) { LAUNDER_V(F.tid); gp::gemm_phase<gp::EpiDown, gp::MoeOrder, false>(F.tid, F.lds, g, So, E); }
            SEAM(pb + 8);
        }
    }
    if (IN(NPHASE - 1)) { PH_BEGIN(); row_phase<2>(F, nullptr, mod + (size_t)(NL - 1) * NB * 6 * D, KIN(21), nullptr, 0, 0, nullptr, WSP(bf16_t, WS_XB), F.OUT); }
#undef IN
#undef SEAM
}

extern "C" void kernel_launch(void* const* d_in, const int* in_sizes, int n_in, void* d_out, int out_size, void* d_ws, size_t ws_size, hipStream_t stream) {
    static int grid = 0;
    if (grid == 0) {
        if (n_in != 22 || out_size != T * D || ws_size < WS_END) { fprintf(stderr, "kernel_launch: unexpected problem (n_in %d out %d ws %zu)\n", n_in, out_size, ws_size); grid = -1; return; }
        int dev = 0, cus = 0, per_cu = 0;
        if (hipGetDevice(&dev) != hipSuccess || hipDeviceGetAttribute(&cus, hipDeviceAttributeMultiprocessorCount, dev) != hipSuccess) { grid = -1; return; }
        if (hipFuncSetAttribute((const void*)fwd_kernel, hipFuncAttributeMaxDynamicSharedMemorySize, LDS_BYTES) != hipSuccess) { grid = -1; return; }
        if (hipOccupancyMaxActiveBlocksPerMultiprocessor(&per_cu, (const void*)fwd_kernel, NTHREADS, LDS_BYTES) != hipSuccess || per_cu < 1) { fprintf(stderr, "kernel_launch: occupancy query says %d\n", per_cu); }
        (void)hipGetLastError();
        grid = cus;
        if (T % (grid * NWAVES * 4) != 0) { fprintf(stderr, "kernel_launch: grid %d does not divide the row phases\n", grid); grid = -1; return; }
    }
    if (grid < 0) return;
    (void)hipMemsetAsync((char*)d_ws + WS_CTL, 0, CTL_BYTES, stream);
    Args a{};
    for (int i = 0; i < 22; ++i) a.in[i] = (const float*)d_in[i];
    a.out = (float*)d_out; a.ws = (unsigned char*)d_ws;
#if N_LAUNCH_MODE
    for (int p = 0; p < NPHASE; ++p) { a.ph_lo = p; a.ph_hi = p + 1; hipLaunchKernelGGL(fwd_kernel, dim3(grid), dim3(NTHREADS), LDS_BYTES, stream, a); }
#else
    a.ph_lo = 0; a.ph_hi = NPHASE;
    hipLaunchKernelGGL(fwd_kernel, dim3(grid), dim3(NTHREADS), LDS_BYTES, stream, a);
#endif
}
```

```cpp
#include <hip/hip_runtime.h>
#include <stdint.h>
#include <stdio.h>
#include <math.h>

#ifndef FAST_GEMM
#define FAST_GEMM 1
#endif
#ifndef FAST_ATTN
#define FAST_ATTN 1
#endif
#ifndef PROBE_DUP
#define PROBE_DUP 0
#endif
#ifndef PROBE_ATT
#define PROBE_ATT 0
#endif
#ifndef ATT_REGSTAGE
#define ATT_REGSTAGE 0
#endif
#ifndef WT_STORES
#define WT_STORES 0
#endif
#ifndef ATT_FP8_A
#define ATT_FP8_A 1
#endif
#ifndef ATT_FP8_B
#define ATT_FP8_B 1
#endif
#ifndef N_LAUNCH_MODE
#define N_LAUNCH_MODE 0
#endif

#define LAS __attribute__((address_space(3)))
#define GAS __attribute__((address_space(1)))
typedef unsigned short bf16_t;
typedef short bf16x8 __attribute__((ext_vector_type(8)));
typedef float f32x4 __attribute__((ext_vector_type(4)));
typedef float f32x2 __attribute__((ext_vector_type(2)));
typedef float f32x16 __attribute__((ext_vector_type(16)));
typedef unsigned u32x4 __attribute__((ext_vector_type(4)));
typedef unsigned u32x2 __attribute__((ext_vector_type(2)));
typedef GAS unsigned gu32;

constexpr int D = 1024, NB = 8, S = 4096, T = NB * S, NL = 4, INC = 3488, NIN = 3584, NE = 16, FF = 512;
constexpr float EPS = 1e-6f, LOG2E = 1.4426950408889634f;
constexpr float QSCALE_A = 0.125f * LOG2E, QSCALE_B = 0.10206207261596577f * LOG2E;
constexpr int NWAVES = 8, NTHREADS = 512;
constexpr int NPHASE = 2 + 9 * NL;

constexpr size_t MiB = 1u << 20;
constexpr size_t WS_CTL = 0, CTL_BYTES = 1 * MiB;
constexpr size_t WS_MOD = 1 * MiB;
constexpr size_t WS_COSA = 2 * MiB, WS_SINA = WS_COSA + 512 * 1024, WS_COSB = 3 * MiB, WS_SINB = WS_COSB + 256 * 1024;
constexpr size_t WS_SSQ = 4 * MiB, WS_SSKV = 5 * MiB;
constexpr size_t WS_GW = 6 * MiB;
constexpr size_t WS_LIST = 7 * MiB;
constexpr size_t WS_WIN = 10 * MiB, WS_WQB = 17 * MiB, WS_WKVB = 18 * MiB, WS_WPA = 19 * MiB, WS_WPB = 20 * MiB, WS_WO = 21 * MiB, WS_W13 = 23 * MiB, WS_W2 = 55 * MiB;
constexpr size_t WS_H = 72 * MiB;
constexpr size_t WS_QA = 136 * MiB, WS_KA = 168 * MiB, WS_VA = 176 * MiB, WS_QLAT = 184 * MiB, WS_KVLAT = 208 * MiB;
constexpr size_t WS_KB = 224 * MiB, WS_VB = 272 * MiB, WS_QB = 304 * MiB, WS_OB = 352 * MiB, WS_SA = 384 * MiB, WS_SB = 448 * MiB, WS_XB = 512 * MiB, WS_QA8 = 576 * MiB, WS_KA8 = 592 * MiB, WS_VTA8 = 596 * MiB, WS_QB8 = 600 * MiB, WS_KB8 = 624 * MiB, WS_VTB8 = 648 * MiB, WS_END = 664 * MiB;
constexpr size_t WS_ACT = 136 * MiB, WS_Y2 = 208 * MiB;
constexpr int ACT_ROWS = 2 * T + NE * 256;
static_assert(WS_ACT + (size_t)ACT_ROWS * FF * 2 <= WS_Y2 && WS_Y2 + (size_t)2 * T * D * 2 <= WS_XB, "moe overlay");
constexpr int CW_BAR = 4096;
constexpr int CW_CNT = 16384;

constexpr int RING_BYTES = 131072, MISC_OFF = RING_BYTES, LDS_BYTES = 147456;

__device__ __forceinline__ float bf2f(unsigned v) { return __uint_as_float(v << 16); }
typedef __bf16 bf16x2_t __attribute__((ext_vector_type(2)));
__device__ __forceinline__ unsigned cvt_pk_bf16(float lo, float hi) { f32x2 v = {lo, hi}; bf16x2_t b = __builtin_convertvector(v, bf16x2_t); return __builtin_bit_cast(unsigned, b); }
__device__ __forceinline__ u32x4 pack8(f32x4 a, f32x4 b) { u32x4 w; w.x = cvt_pk_bf16(a[0], a[1]); w.y = cvt_pk_bf16(a[2], a[3]); w.z = cvt_pk_bf16(b[0], b[1]); w.w = cvt_pk_bf16(b[2], b[3]); return w; }
__device__ __forceinline__ u32x2 pack8_fp8(f32x4 a, f32x4 b) { u32x2 w;
    w.x = (unsigned)__builtin_amdgcn_cvt_pk_fp8_f32(a[2], a[3], __builtin_amdgcn_cvt_pk_fp8_f32(a[0], a[1], 0, false), true);
    w.y = (unsigned)__builtin_amdgcn_cvt_pk_fp8_f32(b[2], b[3], __builtin_amdgcn_cvt_pk_fp8_f32(b[0], b[1], 0, false), true); return w; }
__device__ __forceinline__ void unpack8(u32x4 w, f32x4& a, f32x4& b) { a[0] = bf2f(w.x & 0xffffu); a[1] = bf2f(w.x >> 16); a[2] = bf2f(w.y & 0xffffu); a[3] = bf2f(w.y >> 16); b[0] = bf2f(w.z & 0xffffu); b[1] = bf2f(w.z >> 16); b[2] = bf2f(w.w & 0xffffu); b[3] = bf2f(w.w >> 16); }
__device__ __forceinline__ float wave_sum(float v) {
#pragma unroll
    for (int o = 1; o < 64; o <<= 1) v += __shfl_xor(v, o);
    return v;
}
__device__ __forceinline__ float sigm(float v) { return __builtin_amdgcn_rcpf(1.f + __builtin_amdgcn_exp2f(v * (-LOG2E))); }
#if WT_STORES
__device__ __forceinline__ void st16(void* p, u32x4 v) { asm volatile("global_store_dwordx4 %0, %1, off sc1\n\ts_nop 1" :: "v"(p), "v"(v) : "memory"); }
__device__ __forceinline__ void st8(void* p, u32x2 v) { asm volatile("global_store_dwordx2 %0, %1, off sc1\n\ts_nop 1" :: "v"(p), "v"(v) : "memory"); }
#else
__device__ __forceinline__ void st16(void* p, u32x4 v) { *(u32x4*)p = v; }
__device__ __forceinline__ void st8(void* p, u32x2 v) { *(u32x2*)p = v; }
#endif
#define VM_WAIT() asm volatile("s_waitcnt vmcnt(0)" ::: "memory")
#define LAUNDER_S(p) asm volatile("" : "+s"(p))
#define LAUNDER_V(v) asm volatile("" : "+v"(v))
#define LDS_WAIT() asm volatile("s_waitcnt lgkmcnt(0)" ::: "memory")

#define XB_TMO      128
#define XB_XCNT(j)  (256  + 64 * (j))
#define XB_XSUB(j)  (1280 + 64 * (j))
#define XB_XGEN(j)  (2304 + 64 * (j))
#define XB_TOP      3328
#define XB_TOPGEN   3392
#define XCD_BAR_WORDS 3456
#define XB_SPIN_CAP (1u << 22)
__device__ __forceinline__ unsigned xb_ld(unsigned* p)              { return __hip_atomic_load(p, __ATOMIC_RELAXED, __HIP_MEMORY_SCOPE_AGENT); }
__device__ __forceinline__ unsigned xb_add(unsigned* p, unsigned v) { return __hip_atomic_fetch_add(p, v, __ATOMIC_RELAXED, __HIP_MEMORY_SCOPE_AGENT); }
__device__ __forceinline__ unsigned xb_xcc_id() { return (unsigned)__builtin_amdgcn_s_getreg((3 << 11) | 20) & 0xFu; }
#define XB_SPIN(cond, bar) do { unsigned _sp = 0; while (cond) { __builtin_amdgcn_s_sleep(1); \
    if ((++_sp & 255u) == 0u) { if (xb_ld(&(bar)[XB_TMO])) break; if (_sp > XB_SPIN_CAP) { atomicAdd(&(bar)[XB_TMO], 1u); break; } } } } while (0)
struct XcdBarrier { unsigned* bar; unsigned x; volatile LAS unsigned* st; };
__device__ __forceinline__ XcdBarrier xcd_barrier_post(unsigned* bar, volatile LAS unsigned* st) {
    XcdBarrier b; b.bar = bar; b.x = xb_xcc_id(); b.st = st;
    if (threadIdx.x == 0) (void)xb_add(&bar[XB_XCNT(b.x)], 1u);
    return b;
}
__device__ __forceinline__ void xcd_barrier_complete(unsigned* bar, unsigned x, unsigned& nloc, unsigned& nx) {
    const unsigned G = gridDim.x * gridDim.y * gridDim.z;
    unsigned sum, cnt, mine, sp = 0u;
    for (;;) {
        sum = 0u; cnt = 0u; mine = 0u;
#pragma unroll
        for (unsigned j = 0; j < 16; ++j) { const unsigned c = xb_ld(&bar[XB_XCNT(j)]); sum += c; cnt += (c > 0u) ? 1u : 0u; mine = (j == x) ? c : mine; }
        if (sum == G) break;
        __builtin_amdgcn_s_sleep(1);
        if ((++sp & 255u) == 0u) { if (xb_ld(&bar[XB_TMO])) break; if (sp > XB_SPIN_CAP) { atomicAdd(&bar[XB_TMO], 1u); break; } }
    }
    nloc = mine > 0u ? mine : 1u; nx = cnt > 0u ? cnt : 1u;
}
__device__ __forceinline__ void xcd_barrier(const XcdBarrier& b) {
    asm volatile("s_waitcnt vmcnt(0)" ::: "memory");
    __syncthreads();
    if (threadIdx.x == 0) {
        unsigned* bar = b.bar;
        __builtin_amdgcn_s_waitcnt(0);
        unsigned nloc = b.st[0], nx = b.st[1];
        if (nloc == 0u) { xcd_barrier_complete(bar, b.x, nloc, nx); b.st[0] = nloc; b.st[1] = nx; }
        const unsigned old = xb_add(&bar[XB_XSUB(b.x)], 1u);
        const unsigned gen = old / nloc;
        if (old + 1u == (gen + 1u) * nloc) {
            __builtin_amdgcn_fence(__ATOMIC_RELEASE, "agent");
            asm volatile("s_waitcnt vmcnt(0)" ::: "memory");
            const unsigned og = xb_add(&bar[XB_TOP], 1u);
            const unsigned tg = og / nx;
            if (og + 1u == (tg + 1u) * nx) xb_add(&bar[XB_TOPGEN], 1u);
            else XB_SPIN(xb_ld(&bar[XB_TOPGEN]) == tg, bar);
            __builtin_amdgcn_fence(__ATOMIC_ACQUIRE, "agent");
            xb_add(&bar[XB_XGEN(b.x)], 1u);
            asm volatile("s_waitcnt vmcnt(0)" ::: "memory");
        } else {
            XB_SPIN(xb_ld(&bar[XB_XGEN(b.x)]) == gen, bar);
            __builtin_amdgcn_fence(__ATOMIC_ACQUIRE, "agent");
            asm volatile("s_waitcnt vmcnt(0)" ::: "memory");
        }
    }
    __syncthreads();
}

namespace gp {
constexpr int BM = 256, BK = 64, HALF = 128, HTB = HALF * BK * 2, NXCD = 8, WGM = 8;
__host__ __device__ __forceinline__ int lds_byte(int r, int c) { const int st = (r >> 4) * 2 + (c >> 5), rr = r & 15, cc = c & 31, ob = rr * 64 + cc * 2; return st * 1024 + (ob ^ (((ob >> 9) & 1) << 5)); }
__host__ __device__ __forceinline__ void stage_rc(int b, int& R, int& C) { const int st = b / 1024, sb = b % 1024, swz = sb ^ (((sb >> 9) & 1) << 5); R = (st >> 1) * 16 + swz / 64; C = (st & 1) * 32 + (swz % 64) / 2; }
__host__ __device__ __forceinline__ int perm32(int rho) { const int n = rho >> 4, i = rho & 15; return 8 * (i >> 2) + 4 * n + (i & 3); }

struct Unit { int pm, pn, be, rl, nv; };
struct Gemm { const bf16_t* A; const bf16_t* Bt; int K; size_t bstride; const unsigned* list; size_t astride; };

__device__ __forceinline__ int xcd_remap(int wgid, int nwg) { const int q = nwg / NXCD, r = nwg % NXCD, xcd = wgid % NXCD, off = wgid / NXCD; return (xcd < r ? xcd * (q + 1) : r * (q + 1) + (xcd - r) * q) + off; }
struct DenseOrder {
    int nM, nN, nwg, G, c;
    __device__ void init(int M, int N, int G_, int c_) { nM = M / BM; nN = N / BM; nwg = nM * nN; G = G_; c = c_; }
    __device__ bool next(int i, Unit& u) const {
        const long L = (long)i * G + c; if (L >= nwg) return false;
        const int wgid = xcd_remap((int)L, nwg);
        const int nig = WGM * nN, gid = wgid / nig, fm = gid * WGM, gsz = (nM - fm) < WGM ? (nM - fm) : WGM;
        u.pm = fm + ((wgid % nig) % gsz); u.pn = (wgid % nig) / gsz; u.be = 0; u.rl = 0; u.nv = 256; return true;
    }
};
struct PairOrder {
    DenseOrder d;
    __device__ void init(int M, int N, int G_, int c_) { d.init(M, N, G_, c_); }
    __device__ bool next(int i, Unit& u) const { if (!d.next(i >> 1, u)) return false; u.be = i & 1; return true; }
};
struct MoeOrder {
    const LAS int* tab; int nwg, G, c;
    __device__ static int rd(const LAS int* p) { return __builtin_amdgcn_readfirstlane(*p); }
    __device__ void init(const LAS int* tab_, int G_, int c_) { tab = tab_; nwg = rd(tab_ + 16) * 4; G = G_; c = c_; }
    __device__ bool next(int i, Unit& u) const {
        const long L = (long)i * G + c; if (L >= nwg) return false;
        const int wgid = xcd_remap((int)L, nwg);
        const int tile = wgid >> 2; int e = 0;
        for (int k = 1; k < NE; ++k) e += (rd(tab + k) <= tile) ? 1 : 0;
        u.pm = tile; u.pn = wgid & 3; u.be = e; u.rl = tile - rd(tab + e); const int rem = rd(tab + 32 + e) - u.rl * 256; u.nv = rem < 256 ? rem : 256; return true;
    }
};

#define ACC_T f32x4 (&acc)[2][2][4][2]

template <class Epi, class Sched, bool GATHER>
__device__ __forceinline__ void gemm_phase_ref(int tid, const Gemm g, const Sched& S, const Epi& E) {
    const int wid = __builtin_amdgcn_readfirstlane(tid >> 6), lane = tid & 63, wr = wid >> 2, wc = wid & 3, fr = lane & 15, fq = lane >> 4;
    const int K = g.K; Unit u;
    for (int ui = 0; S.next(ui, u); ++ui) {
        f32x4 acc[2][2][4][2];
#pragma unroll
        for (int a = 0; a < 2; ++a)
#pragma unroll
            for (int b = 0; b < 2; ++b)
#pragma unroll
                for (int m = 0; m < 4; ++m)
#pragma unroll
                    for (int n = 0; n < 2; ++n) acc[a][b][m][n] = (f32x4){0.f, 0.f, 0.f, 0.f};
        const bf16_t* Bt = g.Bt + (size_t)u.be * g.bstride + (size_t)u.pn * 256 * K;
        for (int ai = 0; ai < 2; ++ai)
            for (int m = 0; m < 4; ++m) {
                const int rloc = ai * 128 + wr * 64 + m * 16 + fr;
                size_t arow;
                if (GATHER) { arow = (rloc < u.nv) ? (size_t)(g.list[(size_t)u.be * T + u.rl * 256 + rloc] >> 1) : 0; }
                else arow = (size_t)u.pm * 256 + rloc;
                const bf16_t* ap = g.A + arow * K;
                for (int bj = 0; bj < 2; ++bj) {
                    const bf16_t* bp = Bt + (size_t)(bj * 128 + wc * 32 + fq * 8) * K;
                    float s[8];
#pragma unroll
                    for (int c = 0; c < 8; ++c) {
                        float sc = 0.f; const bf16_t* bpc = bp + (size_t)c * K;
#pragma unroll 2
                        for (int k = 0; k < K; k += 8) {
                            f32x4 a0, a1, b0, b1; unpack8(*(const u32x4*)(ap + k), a0, a1); unpack8(*(const u32x4*)(bpc + k), b0, b1);
                            sc += a0[0] * b0[0] + a0[1] * b0[1] + a0[2] * b0[2] + a0[3] * b0[3] + a1[0] * b1[0] + a1[1] * b1[1] + a1[2] * b1[2] + a1[3] * b1[3];
                        }
                        s[c] = sc; asm volatile("" : "+v"(s[c]));
                    }
#pragma unroll
                    for (int a2 = 0; a2 < 2; ++a2)
#pragma unroll
                        for (int b2 = 0; b2 < 2; ++b2)
#pragma unroll
                            for (int m2 = 0; m2 < 4; ++m2)
                                if (a2 == ai && b2 == bj && m2 == m) { acc[a2][b2][m2][0] = (f32x4){s[0], s[1], s[2], s[3]}; acc[a2][b2][m2][1] = (f32x4){s[4], s[5], s[6], s[7]}; }
                }
            }
        E(acc, u, wr, wc, fr, fq);
    }
}

template <class E> struct EpiTraits { static constexpr bool KEEP = false; };
#if FAST_GEMM
template <class Epi, class Sched, bool GATHER>
__device__ __forceinline__ void gemm_phase_fast(int tid, LAS unsigned char* lds, const Gemm g, const Sched& S, const Epi& E) {
    const int wid = __builtin_amdgcn_readfirstlane(tid >> 6), lane = tid & 63, wr = wid >> 2, wc = wid & 3, fr = lane & 15, fq = lane >> 4;
    const int K = g.K, nt = K / BK;
    int Rr[2], Cc[2]; unsigned voffB[2];
#pragma unroll
    for (int i = 0; i < 2; ++i) { stage_rc(tid * 16 + i * 8192, Rr[i], Cc[i]); const int Rb = (Rr[i] & ~31) + perm32(Rr[i] & 31); voffB[i] = (unsigned)(Rb * K + Cc[i]) * 2u; }
    const size_t kstep = (size_t)(BK * 2), hstep = (size_t)HALF * K * 2, tstep = 2 * hstep;
    const unsigned ldsw = (unsigned)wid * 1024u;
    const int aoff = lds_byte(wr * 64 + fr, fq * 8), boff = lds_byte(wc * 32 + fr, fq * 8);
#define GP_SA(b, h) (((b) * 2 + (h)) * HTB)
#define GP_SB(b, h) ((4 + (b) * 2 + (h)) * HTB)
#define GP_STAGE2(bufoff, gbase, v0, v1) do { \
        __builtin_amdgcn_global_load_lds((const unsigned*)((const char*)(gbase) + (v0)), (LAS unsigned*)(lds + (bufoff) + ldsw), 16, 0, 0); \
        __builtin_amdgcn_global_load_lds((const unsigned*)((const char*)(gbase) + (v1)), (LAS unsigned*)(lds + (bufoff) + ldsw + 8192), 16, 0, 0); } while (0)
#define GP_STAGEB(bufoff, gbase) GP_STAGE2(bufoff, gbase, voffB[0], voffB[1])
#define GP_LDA(dst, b, h) do { _Pragma("unroll") for (int m = 0; m < 4; ++m) _Pragma("unroll") for (int k = 0; k < 2; ++k) dst[m][k] = *(const LAS bf16x8*)(lds + GP_SA(b, h) + aoff + m * 2048 + k * 1024); } while (0)
#define GP_LDB(dst, b, h) do { _Pragma("unroll") for (int n = 0; n < 2; ++n) _Pragma("unroll") for (int k = 0; k < 2; ++k) dst[n][k] = *(const LAS bf16x8*)(lds + GP_SB(b, h) + boff + n * 2048 + k * 1024); } while (0)
#define GP_MMA(ai, bj, At, Bt) do { __builtin_amdgcn_s_setprio(1); _Pragma("unroll") for (int m = 0; m < 4; ++m) _Pragma("unroll") for (int n = 0; n < 2; ++n) _Pragma("unroll") for (int k = 0; k < 2; ++k) \
        acc[ai][bj][m][n] = __builtin_amdgcn_mfma_f32_16x16x32_bf16(Bt[n][k], At[m][k], acc[ai][bj][m][n], 0, 0, 0); __builtin_amdgcn_s_setprio(0); } while (0)
#define GP_WAIT_V(n) asm volatile("s_waitcnt vmcnt(" #n ")" ::: "memory")
#define GP_WAIT_L(n) asm volatile("s_waitcnt lgkmcnt(" #n ")" ::: "memory")
#define GP_BAR __builtin_amdgcn_s_barrier()
#define GP_SCHED __builtin_amdgcn_sched_barrier(0)
    Unit cur, nxt; int ui = 0;
    if (!S.next(0, cur)) return;
    f32x4 acc[2][2][4][2];
#pragma unroll
    for (int a = 0; a < 2; ++a)
#pragma unroll
        for (int b = 0; b < 2; ++b)
#pragma unroll
            for (int m = 0; m < 4; ++m)
#pragma unroll
                for (int n = 0; n < 2; ++n) acc[a][b][m][n] = (f32x4){0.f, 0.f, 0.f, 0.f};
    bf16x8 At[4][2], B0[2][2], B1[2][2];
    unsigned vC0, vC1, vC2, vC3, vN0, vN1, vN2, vN3;
#define GP_VOFF(u, o0, o1, o2, o3) do { if (GATHER) { \
        int tl_ = tid; LAUNDER_V(tl_); int R0_, C0_, R1_, C1_; stage_rc(tl_ * 16, R0_, C0_); stage_rc(tl_ * 16 + 8192, R1_, C1_);     \
        const unsigned* lp = g.list + (size_t)(u).be * T + (u).rl * 256; \
        const int nvm = (u).nv - 1; const int p0 = min(R0_, nvm), p1 = min(R1_, nvm), p2 = min(128 + R0_, nvm), p3 = min(128 + R1_, nvm); \
        const unsigned t0 = lp[p0] >> 1, t1 = lp[p1] >> 1, t2 = lp[p2] >> 1, t3 = lp[p3] >> 1; \
        o0 = (t0 * K + C0_) * 2u; o1 = (t1 * K + C1_) * 2u; o2 = (t2 * K + C0_) * 2u; o3 = (t3 * K + C1_) * 2u; \
      } else { o0 = (unsigned)(Rr[0] * K + Cc[0]) * 2u; o1 = (unsigned)(Rr[1] * K + Cc[1]) * 2u; o2 = o0 + (unsigned)hstep; o3 = o1 + (unsigned)hstep; } } while (0)
    GP_VOFF(cur, vC0, vC1, vC2, vC3);
    const char* cA = (const char*)g.A + ((size_t)cur.be * g.astride) * 2 + (GATHER ? (size_t)0 : (size_t)cur.pm * tstep);
    const char* cB = (const char*)g.Bt + ((size_t)cur.be * g.bstride) * 2 + (size_t)cur.pn * tstep;
    GP_STAGEB(GP_SB(0, 0), cB); GP_STAGEB(GP_SB(0, 1), cB + hstep); GP_STAGE2(GP_SA(0, 0), cA, vC0, vC1); GP_STAGE2(GP_SA(0, 1), cA, vC2, vC3);
    if (wr == 1) GP_BAR;
    GP_WAIT_V(2); GP_BAR;
    GP_STAGEB(GP_SB(1, 0), cB + kstep); GP_STAGE2(GP_SA(1, 0), cA + kstep, vC0, vC1); GP_STAGEB(GP_SB(1, 1), cB + hstep + kstep);
    GP_WAIT_V(6); GP_BAR;
    for (;;) {
        const bool has_next = S.next(ui + 1, nxt);
        const char* nA = has_next ? (const char*)g.A + ((size_t)nxt.be * g.astride) * 2 + (GATHER ? (size_t)0 : (size_t)nxt.pm * tstep) : cA;
        const char* nB = has_next ? (const char*)g.Bt + ((size_t)nxt.be * g.bstride) * 2 + (size_t)nxt.pn * tstep : cB;
        if (has_next) { GP_VOFF(nxt, vN0, vN1, vN2, vN3); } else { vN0 = vC0; vN1 = vC1; vN2 = vC2; vN3 = vC3; }
#pragma nounroll
        for (int t = 0; t < nt; t += 2) {
            const bool last = (t == nt - 2);
            const char* a1 = cA + (size_t)(t + 1) * kstep;
            const char* a2 = last ? nA : cA + (size_t)(t + 2) * kstep; const char* b2 = last ? nB : cB + (size_t)(t + 2) * kstep;
            const char* a3 = a2 + kstep; const char* b3 = b2 + kstep;
            const unsigned w0 = last ? vN0 : vC0, w1 = last ? vN1 : vC1, w2 = last ? vN2 : vC2, w3 = last ? vN3 : vC3;
            GP_LDB(B0, 0, 0); GP_LDB(B1, 0, 1); GP_SCHED; GP_LDA(At, 0, 0); GP_STAGE2(GP_SA(1, 1), a1, vC2, vC3);
            GP_WAIT_V(8); GP_WAIT_L(0); GP_BAR; GP_MMA(0, 0, At, B0); GP_MMA(0, 1, At, B1); GP_BAR; GP_SCHED;
            GP_LDA(At, 0, 1); GP_STAGEB(GP_SB(0, 0), b2); GP_STAGEB(GP_SB(0, 1), b2 + hstep); GP_STAGE2(GP_SA(0, 0), a2, w0, w1);
            GP_WAIT_V(8); GP_WAIT_L(0); GP_BAR; GP_MMA(1, 0, At, B0); GP_MMA(1, 1, At, B1); GP_BAR; GP_SCHED;
            GP_LDB(B0, 1, 0); GP_LDB(B1, 1, 1); GP_SCHED; GP_LDA(At, 1, 0); GP_STAGE2(GP_SA(0, 1), a2, w2, w3);
            GP_WAIT_V(8); GP_WAIT_L(0); GP_BAR; GP_MMA(0, 0, At, B0); GP_MMA(0, 1, At, B1); GP_BAR; GP_SCHED;
            GP_LDA(At, 1, 1); GP_STAGEB(GP_SB(1, 0), b3); GP_STAGEB(GP_SB(1, 1), b3 + hstep); GP_STAGE2(GP_SA(1, 0), a3, w0, w1);
            GP_WAIT_V(8); GP_WAIT_L(0); GP_BAR; GP_MMA(1, 0, At, B0); GP_MMA(1, 1, At, B1); GP_BAR; GP_SCHED;
        }
        if (wr == 0) GP_BAR;
        E(acc, cur, wr, wc, fr, fq);
        if (!has_next) break;
        if (!(EpiTraits<Epi>::KEEP && cur.be == 0)) {
#pragma unroll
        for (int a = 0; a < 2; ++a)
#pragma unroll
            for (int b = 0; b < 2; ++b)
#pragma unroll
                for (int m = 0; m < 4; ++m)
#pragma unroll
                    for (int n = 0; n < 2; ++n) acc[a][b][m][n] = (f32x4){0.f, 0.f, 0.f, 0.f};
        }
        cur = nxt; cA = nA; cB = nB; vC0 = vN0; vC1 = vN1; vC2 = vN2; vC3 = vN3; ++ui;
        if (wr == 1) GP_BAR;
    }
    GP_WAIT_V(0);
    GP_BAR;
#undef GP_SA
#undef GP_SB
#undef GP_STAGE2
#undef GP_STAGEB
#undef GP_LDA
#undef GP_LDB
#undef GP_MMA
#undef GP_WAIT_V
#undef GP_WAIT_L
#undef GP_BAR
#undef GP_SCHED
#undef GP_VOFF
}
#endif

template <class Epi, class Sched, bool GATHER = false>
__device__ __forceinline__ void gemm_phase(int tid, LAS unsigned char* lds, const Gemm g, const Sched& S, const Epi& E) {
#if FAST_GEMM
    gemm_phase_fast<Epi, Sched, GATHER>(tid, lds, g, S, E);
#else
    (void)lds; gemm_phase_ref<Epi, Sched, GATHER>(tid, g, S, E);
#endif
}

#define EPI_ROW(ai, m) (u.pm * 256 + (ai) * 128 + wr * 64 + (m) * 16 + fr)
#define EPI_COL(bj) (u.pn * 256 + (bj) * 128 + wc * 32 + fq * 8)
__device__ __forceinline__ float dot4(f32x4 a) { return (a[0] * a[0] + a[1] * a[1]) + (a[2] * a[2] + a[3] * a[3]); }

struct EpiNull {
    __device__ __forceinline__ void operator()(const ACC_T, const Unit& u, int wr, int wc, int fr, int fq) const {
#pragma unroll
        for (int ai = 0; ai < 2; ++ai)
#pragma unroll
            for (int bj = 0; bj < 2; ++bj)
#pragma unroll
                for (int m = 0; m < 4; ++m) asm volatile("" :: "v"(acc[ai][bj][m][0]), "v"(acc[ai][bj][m][1]));
    }
};
struct EpiIn {
    bf16_t *QA, *KA, *VA, *QLAT, *KVLAT, *KB, *SA, *SB; float *SSQ, *SSKV; const float *gq, *gk, *cosA, *sinA, *cosB, *sinB;
    __device__ __forceinline__ void operator()(const ACC_T, const Unit& u, int wr, int wc, int fr, int fq) const {
        const int wb = u.pn * 4 + wc;
        if (wb < 10) {
            const bool isq = wb < 8; const int head = isq ? wb : wb - 8; const float* g = isq ? gq : gk; bf16_t* dst = isq ? QA : KA; const int dp = isq ? 512 : 128; const float qs = isq ? QSCALE_A : 1.f;
            const f32x4 g00 = *(const f32x4*)(g + 8 * fq), g01 = *(const f32x4*)(g + 8 * fq + 4), g10 = *(const f32x4*)(g + 32 + 8 * fq), g11 = *(const f32x4*)(g + 36 + 8 * fq);
#pragma unroll
            for (int ai = 0; ai < 2; ++ai)
#pragma unroll
                for (int m = 0; m < 4; ++m) {
                    const int r = EPI_ROW(ai, m), pos = r & (S - 1);
                    const f32x4 v00 = acc[ai][0][m][0], v01 = acc[ai][0][m][1], v10 = acc[ai][1][m][0], v11 = acc[ai][1][m][1];
                    float ss = (dot4(v00) + dot4(v01)) + (dot4(v10) + dot4(v11)); ss += __shfl_xor(ss, 16); ss += __shfl_xor(ss, 32);
                    const float rstd = rsqrtf(ss * (1.f / 64.f) + EPS);
                    const f32x4 y00 = v00 * rstd * g00, y01 = v01 * rstd * g01, y10 = v10 * rstd * g10, y11 = v11 * rstd * g11;
                    const f32x4 c0 = *(const f32x4*)(cosA + pos * 32 + 8 * fq), c1 = *(const f32x4*)(cosA + pos * 32 + 8 * fq + 4), s0 = *(const f32x4*)(sinA + pos * 32 + 8 * fq), s1 = *(const f32x4*)(sinA + pos * 32 + 8 * fq + 4);
                    const f32x4 o00 = (y00 * c0 - y10 * s0) * qs, o01 = (y01 * c1 - y11 * s1) * qs, o10 = (y10 * c0 + y00 * s0) * qs, o11 = (y11 * c1 + y01 * s1) * qs;
#if ATT_FP8_A
                    unsigned char* p8 = (unsigned char*)dst + (size_t)r * dp + head * 64 + 8 * fq;
                    st8(p8, pack8_fp8(o00, o01)); st8(p8 + 32, pack8_fp8(o10, o11));
#else
                    bf16_t* p = dst + (size_t)r * dp + head * 64 + 8 * fq;
                    st16(p, pack8(o00, o01)); st16((p + 32), pack8(o10, o11));
#endif
                }
        } else if (wb < 12) {
#pragma unroll
            for (int ai = 0; ai < 2; ++ai)
#pragma unroll
                for (int m = 0; m < 4; ++m) {
#if ATT_FP8_A
                    const int r = EPI_ROW(ai, m), sq = r & (S - 1), k = sq & 63, pos = 32 * ((k >> 2) & 1) + 16 * (k >> 5) + (k & 3) + 4 * ((k & 31) >> 3);
                    unsigned char* vtb = (unsigned char*)VA; const unsigned vo = (unsigned)(((r >> 12) * 2 + (wb - 10)) * 64 + 8 * fq) * S + (unsigned)((sq & ~63) + pos);
#pragma unroll
                    for (int bj = 0; bj < 2; ++bj)
#pragma unroll
                        for (int n = 0; n < 2; ++n) { const f32x4 x = acc[ai][bj][m][n]; const unsigned w = (unsigned)__builtin_amdgcn_cvt_pk_fp8_f32(x[2], x[3], __builtin_amdgcn_cvt_pk_fp8_f32(x[0], x[1], 0, false), true);
                            const unsigned qo = vo + (unsigned)(bj * 32 + 4 * n) * S;
                            vtb[qo] = (unsigned char)(w & 0xffu); vtb[qo + S] = (unsigned char)((w >> 8) & 0xffu); vtb[qo + 2 * S] = (unsigned char)((w >> 16) & 0xffu); vtb[qo + 3 * S] = (unsigned char)(w >> 24); }
#else
                    bf16_t* p = VA + (size_t)EPI_ROW(ai, m) * 128 + (wb - 10) * 64 + 8 * fq;
                    st16(p, pack8(acc[ai][0][m][0], acc[ai][0][m][1])); st16((p + 32), pack8(acc[ai][1][m][0], acc[ai][1][m][1]));
#endif
                }
        } else if (wb < 22) {
            const bool isq = wb < 18; const int idx = isq ? wb - 12 : wb - 18; bf16_t* dst = isq ? QLAT : KVLAT; const int dp = isq ? 384 : 256;
#pragma unroll
            for (int ai = 0; ai < 2; ++ai)
#pragma unroll
                for (int m = 0; m < 4; ++m) {
                    const int r = EPI_ROW(ai, m);
                    const f32x4 v00 = acc[ai][0][m][0], v01 = acc[ai][0][m][1], v10 = acc[ai][1][m][0], v11 = acc[ai][1][m][1];
                    float ss = (dot4(v00) + dot4(v01)) + (dot4(v10) + dot4(v11)); ss += __shfl_xor(ss, 16); ss += __shfl_xor(ss, 32);
                    if (fq == 0) { if (isq) SSQ[(size_t)r * 8 + idx] = ss; else SSKV[(size_t)r * 4 + idx] = ss; }
                    bf16_t* p = dst + (size_t)r * dp + idx * 64 + 8 * fq;
                    st16(p, pack8(v00, v01)); st16((p + 32), pack8(v10, v11));
                }
        } else if (wb == 22) {
            if (fq < 2) {
#pragma unroll
                for (int ai = 0; ai < 2; ++ai)
#pragma unroll
                    for (int m = 0; m < 4; ++m) {
                        const int r = EPI_ROW(ai, m), pos = r & (S - 1);
                        const f32x4 x10 = acc[ai][0][m][0], x11 = acc[ai][0][m][1], x20 = acc[ai][1][m][0], x21 = acc[ai][1][m][1];
                        const f32x4 c0 = *(const f32x4*)(cosB + pos * 16 + 8 * fq), c1 = *(const f32x4*)(cosB + pos * 16 + 8 * fq + 4), s0 = *(const f32x4*)(sinB + pos * 16 + 8 * fq), s1 = *(const f32x4*)(sinB + pos * 16 + 8 * fq + 4);
#if ATT_FP8_B
                        const u32x2 w1 = pack8_fp8(x10 * c0 - x20 * s0, x11 * c1 - x21 * s1), w2 = pack8_fp8(x20 * c0 + x10 * s0, x21 * c1 + x11 * s1);
                        unsigned char* p = (unsigned char*)KB + (size_t)r * 768 + 64 + 8 * fq;
#pragma unroll
                        for (int h = 0; h < 8; ++h) { st8(p + h * 96, w1); st8(p + h * 96 + 16, w2); }
#else
                        const u32x4 w1 = pack8(x10 * c0 - x20 * s0, x11 * c1 - x21 * s1), w2 = pack8(x20 * c0 + x10 * s0, x21 * c1 + x11 * s1);
                        bf16_t* p = KB + (size_t)r * 768 + 64 + 8 * fq;
#pragma unroll
                        for (int h = 0; h < 8; ++h) { st16((p + h * 96), w1); st16((p + h * 96 + 16), w2); }
#endif
                    }
            }
        } else if (wb == 23) {
        } else {
            const bool isa = wb < 40; const int idx = isa ? wb - 24 : wb - 40; unsigned char* dst = (unsigned char*)(isa ? SA : SB);
#pragma unroll
            for (int ai = 0; ai < 2; ++ai)
#pragma unroll
                for (int m = 0; m < 4; ++m) { unsigned char* p = dst + (size_t)EPI_ROW(ai, m) * 1024 + idx * 64 + 8 * fq;
#pragma unroll
                    for (int bj = 0; bj < 2; ++bj) { const f32x4 a = acc[ai][bj][m][0], b = acc[ai][bj][m][1]; u32x2 w;
                        w.x = (unsigned)__builtin_amdgcn_cvt_pk_fp8_f32(a[2], a[3], __builtin_amdgcn_cvt_pk_fp8_f32(a[0], a[1], 0, false), true);
                        w.y = (unsigned)__builtin_amdgcn_cvt_pk_fp8_f32(b[2], b[3], __builtin_amdgcn_cvt_pk_fp8_f32(b[0], b[1], 0, false), true);
                        st8((p + bj * 32), w); } }
        }
    }
};
__host__ __device__ __forceinline__ int src_col_in(int n) {
    const int pn = n >> 8, nl = n & 255, bj = nl >> 7, wc = (nl & 127) >> 5, p = nl & 31, wb = pn * 4 + wc, s = bj * 32 + p;
    if (wb < 8) return wb * 64 + s;
    if (wb < 10) return 512 + (wb - 8) * 64 + s;
    if (wb < 12) return 640 + (wb - 10) * 64 + s;
    if (wb < 18) return 768 + (wb - 12) * 64 + s;
    if (wb < 22) return 1152 + (wb - 18) * 64 + s;
    if (wb == 22) return p < 16 ? 1408 + bj * 16 + p : -1;
    if (wb == 23) return -1;
    if (wb < 40) return 1440 + (wb - 24) * 64 + s;
    return 2464 + (wb - 40) * 64 + s;
}
struct EpiQb {
    bf16_t* QB; const float *SSQ, *cosB, *sinB;
    __device__ __forceinline__ void operator()(const ACC_T, const Unit& u, int wr, int wc, int fr, int fq) const {
#pragma unroll
        for (int ai = 0; ai < 2; ++ai)
#pragma unroll
            for (int m = 0; m < 4; ++m) {
                const int r = EPI_ROW(ai, m), pos = r & (S - 1);
                const f32x4 sa = *(const f32x4*)(SSQ + (size_t)r * 8); const f32x2 sb = *(const f32x2*)(SSQ + (size_t)r * 8 + 4);
                const float rstd = rsqrtf((((sa[0] + sa[1]) + (sa[2] + sa[3])) + (sb[0] + sb[1])) * (1.f / 384.f) + EPS);
#pragma unroll
                for (int bj = 0; bj < 2; ++bj) {
                    f32x4 v0 = acc[ai][bj][m][0] * rstd, v1 = acc[ai][bj][m][1] * rstd;
                    const int c32 = u.pn * 8 + bj * 4 + wc;
                    if (c32 % 3 == 2) {
                        f32x4 o0, o1;
#pragma unroll
                        for (int j = 0; j < 4; ++j) { o0[j] = __shfl_xor(v0[j], 32); o1[j] = __shfl_xor(v1[j], 32); }
                        const int i0 = 8 * (fq & 1);
                        const f32x4 c0 = *(const f32x4*)(cosB + pos * 16 + i0), c1 = *(const f32x4*)(cosB + pos * 16 + i0 + 4), s0 = *(const f32x4*)(sinB + pos * 16 + i0), s1 = *(const f32x4*)(sinB + pos * 16 + i0 + 4);
                        if (fq < 2) { v0 = v0 * c0 - o0 * s0; v1 = v1 * c1 - o1 * s1; } else { v0 = v0 * c0 + o0 * s0; v1 = v1 * c1 + o1 * s1; }
                    }
#if ATT_FP8_B
                    st8((unsigned char*)QB + (size_t)r * 768 + EPI_COL(bj), pack8_fp8(v0 * QSCALE_B, v1 * QSCALE_B));
#else
                    st16((QB + (size_t)r * 768 + EPI_COL(bj)), pack8(v0 * QSCALE_B, v1 * QSCALE_B));
#endif
                }
            }
    }
};
struct EpiKvb {
    bf16_t *KB, *VB; const float* SSKV;
    __device__ __forceinline__ void operator()(const ACC_T, const Unit& u, int wr, int wc, int fr, int fq) const {
#pragma unroll
        for (int ai = 0; ai < 2; ++ai)
#pragma unroll
            for (int m = 0; m < 4; ++m) {
                const int r = EPI_ROW(ai, m);
                const f32x4 sa = *(const f32x4*)(SSKV + (size_t)r * 4);
                const float rstd = rsqrtf(((sa[0] + sa[1]) + (sa[2] + sa[3])) * (1.f / 256.f) + EPS);
#pragma unroll
                for (int bj = 0; bj < 2; ++bj) {
                    const int head = u.pn * 2 + bj, o = wc * 32 + fq * 8;
#if ATT_FP8_B
                    const f32x4 x0 = acc[ai][bj][m][0] * rstd, x1 = acc[ai][bj][m][1] * rstd;
                    if (wc < 2) st8((unsigned char*)KB + (size_t)r * 768 + head * 96 + o, pack8_fp8(x0, x1));
                    else {
                        const int sq = r & (S - 1), k = sq & 63, pos = 32 * ((k >> 2) & 1) + 16 * (k >> 5) + (k & 3) + 4 * ((k & 31) >> 3);
                        unsigned char* vtb = (unsigned char*)VB; const unsigned vo = (unsigned)(((r >> 12) * 8 + head) * 64 + (o - 64)) * S + (unsigned)((sq & ~63) + pos);
                        const u32x2 w = pack8_fp8(x0, x1);
                        vtb[vo] = (unsigned char)(w.x & 0xffu); vtb[vo + S] = (unsigned char)((w.x >> 8) & 0xffu); vtb[vo + 2 * S] = (unsigned char)((w.x >> 16) & 0xffu); vtb[vo + 3 * S] = (unsigned char)(w.x >> 24);
                        vtb[vo + 4 * S] = (unsigned char)(w.y & 0xffu); vtb[vo + 5 * S] = (unsigned char)((w.y >> 8) & 0xffu); vtb[vo + 6 * S] = (unsigned char)((w.y >> 16) & 0xffu); vtb[vo + 7 * S] = (unsigned char)(w.y >> 24);
                    }
#else
                    const u32x4 w = pack8(acc[ai][bj][m][0] * rstd, acc[ai][bj][m][1] * rstd);
                    if (wc < 2) st16((KB + (size_t)r * 768 + head * 96 + o), w); else st16((VB + (size_t)r * 512 + head * 64 + (o - 64)), w);
#endif
                }
            }
    }
};
template <int MODE> struct EpiProj {
    bf16_t* O; const bf16_t* gate;
    __device__ __forceinline__ void operator()(const ACC_T, const Unit& u, int wr, int wc, int fr, int fq) const {
#pragma unroll
        for (int ai = 0; ai < 2; ++ai)
#pragma unroll
            for (int m = 0; m < 4; ++m) {
                const int r = EPI_ROW(ai, m);
#pragma unroll
                for (int bj = 0; bj < 2; ++bj) {
                    const size_t off = (size_t)r * D + EPI_COL(bj);
                    const u32x2 gw = *(const u32x2*)((const unsigned char*)gate + off);
                    const f32x2 q0 = __builtin_amdgcn_cvt_pk_f32_fp8((int)gw.x, false), q1 = __builtin_amdgcn_cvt_pk_f32_fp8((int)gw.x, true), q2 = __builtin_amdgcn_cvt_pk_f32_fp8((int)gw.y, false), q3 = __builtin_amdgcn_cvt_pk_f32_fp8((int)gw.y, true);
                    const f32x4 g0 = {sigm(q0[0]), sigm(q0[1]), sigm(q1[0]), sigm(q1[1])}, g1 = {sigm(q2[0]), sigm(q2[1]), sigm(q3[0]), sigm(q3[1])};
                    f32x4 v0 = acc[ai][bj][m][0] * g0, v1 = acc[ai][bj][m][1] * g1;
                    if (MODE == 1) { f32x4 p0, p1; unpack8(*(const u32x4*)(O + off), p0, p1); v0 += p0; v1 += p1; }
                    if (MODE == 1) st16(O + off, pack8(v0, v1)); else *(u32x4*)(O + off) = pack8(v0, v1);
                }
            }
    }
};
struct EpiProjP {
    bf16_t* O; const unsigned char* SA; const unsigned char* SB;
    __device__ static __forceinline__ void gates(const unsigned char* G, size_t off, f32x4& g0, f32x4& g1) {
        const u32x2 gw = *(const u32x2*)(G + off);
        const f32x2 q0 = __builtin_amdgcn_cvt_pk_f32_fp8((int)gw.x, false), q1 = __builtin_amdgcn_cvt_pk_f32_fp8((int)gw.x, true), q2 = __builtin_amdgcn_cvt_pk_f32_fp8((int)gw.y, false), q3 = __builtin_amdgcn_cvt_pk_f32_fp8((int)gw.y, true);
        g0 = (f32x4){sigm(q0[0]), sigm(q0[1]), sigm(q1[0]), sigm(q1[1])}; g1 = (f32x4){sigm(q2[0]), sigm(q2[1]), sigm(q3[0]), sigm(q3[1])};
    }
    __device__ __forceinline__ void operator()(f32x4 (&acc)[2][2][4][2], const Unit& u, int wr, int wc, int fr, int fq) const {
#pragma unroll
        for (int ai = 0; ai < 2; ++ai)
#pragma unroll
            for (int m = 0; m < 4; ++m) {
                const int r = EPI_ROW(ai, m);
#pragma unroll
                for (int bj = 0; bj < 2; ++bj) {
                    const size_t off = (size_t)r * D + EPI_COL(bj);
                    f32x4 b0, b1; gates(SB, off, b0, b1);
#pragma unroll
                    for (int j = 0; j < 4; ++j) { b0[j] = fmaxf(b0[j], 9.094947e-13f); b1[j] = fmaxf(b1[j], 9.094947e-13f); }
                    if (u.be == 0) {
                        f32x4 a0, a1; gates(SA, off, a0, a1);
#pragma unroll
                        for (int j = 0; j < 4; ++j) { acc[ai][bj][m][0][j] *= a0[j] * __builtin_amdgcn_rcpf(b0[j]); acc[ai][bj][m][1][j] *= a1[j] * __builtin_amdgcn_rcpf(b1[j]); }
                    } else st16(O + off, pack8(acc[ai][bj][m][0] * b0, acc[ai][bj][m][1] * b1));
                }
            }
    }
};
template <> struct EpiTraits<EpiProjP> { static constexpr bool KEEP = true; };
struct EpiWo {
    const bf16_t* X; const float* modl; bf16_t* XO;
    __device__ __forceinline__ void operator()(const ACC_T, const Unit& u, int wr, int wc, int fr, int fq) const {
        const float* g1 = modl + (size_t)(u.pm >> 4) * 6 * D + 2 * D;
#pragma unroll
        for (int bj = 0; bj < 2; ++bj) {
            const int c = EPI_COL(bj); const f32x4 ga = *(const f32x4*)(g1 + c), gb = *(const f32x4*)(g1 + c + 4);
#pragma unroll
            for (int ai = 0; ai < 2; ++ai)
#pragma unroll
                for (int m = 0; m < 4; ++m) { const size_t off = (size_t)EPI_ROW(ai, m) * D + c;
                    f32x4 x0, x1; unpack8(*(const u32x4*)(X + off), x0, x1);
                    st16((XO + off), pack8(x0 + ga * acc[ai][bj][m][0], x1 + gb * acc[ai][bj][m][1])); }
        }
    }
};
struct EpiUp {
    bf16_t* ACT;
    __device__ __forceinline__ void operator()(const ACC_T, const Unit& u, int wr, int wc, int fr, int fq) const {
#pragma unroll
        for (int ai = 0; ai < 2; ++ai)
#pragma unroll
            for (int m = 0; m < 4; ++m) {
                f32x4 a = acc[ai][0][m][0], b = acc[ai][0][m][1]; const f32x4 c = acc[ai][1][m][0], d = acc[ai][1][m][1];
#pragma unroll
                for (int j = 0; j < 4; ++j) { a[j] = a[j] * sigm(a[j]) * c[j]; b[j] = b[j] * sigm(b[j]) * d[j]; }
                st16((ACT + (size_t)EPI_ROW(ai, m) * FF + u.pn * 128 + wc * 32 + fq * 8), pack8(a, b));
            }
    }
};
struct EpiDown {
    bf16_t* Y2; const unsigned* list; const float* gw;
    __device__ __forceinline__ void operator()(const ACC_T, const Unit& u, int wr, int wc, int fr, int fq) const {
#pragma unroll
        for (int ai = 0; ai < 2; ++ai)
#pragma unroll
            for (int m = 0; m < 4; ++m) {
                const int rloc = ai * 128 + wr * 64 + m * 16 + fr;
                if (rloc < u.nv) {
                    const unsigned entry = list[(size_t)u.be * T + u.rl * 256 + rloc]; const float w = gw[entry];
#pragma unroll
                    for (int bj = 0; bj < 2; ++bj) { const f32x4 a = acc[ai][bj][m][0] * (w * 16.f), b = acc[ai][bj][m][1] * (w * 16.f); u32x2 q;
                        q.x = (unsigned)__builtin_amdgcn_cvt_pk_fp8_f32(a[2], a[3], __builtin_amdgcn_cvt_pk_fp8_f32(a[0], a[1], 0, false), true);
                        q.y = (unsigned)__builtin_amdgcn_cvt_pk_fp8_f32(b[2], b[3], __builtin_amdgcn_cvt_pk_fp8_f32(b[0], b[1], 0, false), true);
                        st8(((unsigned char*)Y2 + (size_t)entry * D + EPI_COL(bj)), q); }
                }
            }
    }
};
}

namespace at {
struct Tensors { const bf16_t* Q; int qp; const bf16_t* K; int kp; const bf16_t* V; int vp; bf16_t* O; int op; int group; };
__device__ __forceinline__ bool next_unit(int i, int vcu, int G, int& bh, int& qb) {
    int u;
    if (G == 256) { if (i >= 4) return false; u = (vcu >> 5) * 128 + i * 32 + (vcu & 31); }
    else { u = i * G + vcu; if (u >= 1024) return false; }
    bh = u >> 4; qb = u & 15; return true;
}
template <int DQK>
__device__ __forceinline__ void attn_phase_ref(int tid, const Tensors& A, int vcu, int G) {
    int bh, qb;
    for (int i = 0; next_unit(i, vcu, G, bh, qb); ++i) {
        const int b = bh >> 3, h = bh & 7, kvh = h / A.group;
        {
            const int dh = tid >> 8;
            const size_t row = (size_t)b * S + qb * 256 + (tid & 255);
            float q[DQK], o[32];
#pragma unroll
            for (int d = 0; d < DQK; ++d) q[d] = bf2f(A.Q[row * A.qp + h * DQK + d]);
#pragma unroll
            for (int d = 0; d < 32; ++d) o[d] = 0.f;
            float l = 0.f;
            for (int k = 0; k < S; ++k) {
                const bf16_t* kr = A.K + ((size_t)b * S + k) * A.kp + kvh * DQK; const bf16_t* vr = A.V + ((size_t)b * S + k) * A.vp + kvh * 64 + dh * 32;
                float sc = 0.f;
#pragma unroll
                for (int d = 0; d < DQK; d += 8) { f32x4 k0, k1; unpack8(*(const u32x4*)(kr + d), k0, k1);
                    sc += q[d] * k0[0] + q[d + 1] * k0[1] + q[d + 2] * k0[2] + q[d + 3] * k0[3] + q[d + 4] * k1[0] + q[d + 5] * k1[1] + q[d + 6] * k1[2] + q[d + 7] * k1[3]; }
                const float p = bf2f(cvt_pk_bf16(exp2f(sc), 0.f) & 0xffffu); l += p;
#pragma unroll
                for (int d = 0; d < 32; d += 8) { f32x4 v0, v1; unpack8(*(const u32x4*)(vr + d), v0, v1);
                    o[d] += p * v0[0]; o[d + 1] += p * v0[1]; o[d + 2] += p * v0[2]; o[d + 3] += p * v0[3]; o[d + 4] += p * v1[0]; o[d + 5] += p * v1[1]; o[d + 6] += p * v1[2]; o[d + 7] += p * v1[3]; }
            }
            const float il = 1.f / l;
            __syncthreads();
#pragma unroll
            for (int d = 0; d < 32; d += 8) { f32x4 a = {o[d] * il, o[d + 1] * il, o[d + 2] * il, o[d + 3] * il}, c = {o[d + 4] * il, o[d + 5] * il, o[d + 6] * il, o[d + 7] * il};
                *(u32x4*)(A.O + row * A.op + h * 64 + dh * 32 + d) = pack8(a, c); }
        }
    }
}
#if FAST_ATTN
typedef short s16x4 __attribute__((ext_vector_type(4)));
__device__ __forceinline__ unsigned cvtpk(float lo, float hi) { f32x2 v = {lo, hi}; bf16x2_t b = __builtin_convertvector(v, bf16x2_t); return __builtin_bit_cast(unsigned, b); }
__device__ __forceinline__ s16x4 vtr(const LAS unsigned char* p) { return __builtin_bit_cast(s16x4, __builtin_amdgcn_ds_read_tr16_b64_v4i16((LAS s16x4*)p)); }
__device__ __forceinline__ int crow(int r, int hi) { return (r & 3) + 8 * (r >> 2) + 4 * hi; }
#define AT_BAR() asm volatile("s_barrier" ::: "memory")
#define AT_WAITBAR(N) asm volatile("s_waitcnt vmcnt(" #N ") lgkmcnt(0)\n\ts_barrier" ::: "memory")
#define AT_SCHED() __builtin_amdgcn_sched_barrier(0)
__device__ __forceinline__ void glds16(const void* gsrc, unsigned lds_dst) { unsigned keep;
    asm volatile("s_mov_b32 %0, m0\n\ts_mov_b32 m0, %2\n\ts_nop 0\n\tglobal_load_lds_dwordx4 %1, off\n\ts_mov_b32 m0, %0" : "=&s"(keep) : "v"(gsrc), "s"(lds_dst) : "memory"); }
#define AT_GLDS(g, l) glds16((const void*)(g), (unsigned)__builtin_amdgcn_readfirstlane((int)(unsigned)(uintptr_t)(l)))
template <int DQK>
__device__ __forceinline__ void attn_unit(int tid, LAS unsigned char* lds, const Tensors& A, int b, int h, int qb) {
    constexpr int ND = DQK / 16, NCH = DQK / 8, KSLOT = NCH * 1024, NKD = NCH > 8 ? 2 : 1, VSLOT = 8192, NT = S / 64;
    constexpr int KOFF = 0, VOFF = 3 * KSLOT, OST = VOFF + 3 * VSLOT, WSF = OST + 8 * 4096;
    static_assert(WSF + 8 * 256 <= RING_BYTES, "attention LDS");
    const int lane = tid & 63, r32 = lane & 31, hi = lane >> 5, wid = __builtin_amdgcn_readfirstlane(tid >> 6);
    const int kvh = h / A.group; const size_t rowb = (size_t)b * S;
    const bf16_t* ksrc = A.K + (rowb + lane) * A.kp + kvh * DQK + wid * 8;
    const bf16_t* ksrc2 = A.K + (rowb + lane) * A.kp + kvh * DQK + (8 + (wid & 3)) * 8;
    const bf16_t* vsrc = A.V + (rowb + 16 * (wid & 3) + (lane >> 2)) * A.vp + kvh * 64 + (wid >> 2) * 32 + (lane & 3) * 8;
    const size_t ktile = (size_t)64 * A.kp, vtile = (size_t)64 * A.vp;
    LAS unsigned char* kdst = lds + KOFF + wid * 1024; LAS unsigned char* kdst2 = lds + KOFF + (8 + (wid & 3)) * 1024; LAS unsigned char* vdst = lds + VOFF + wid * 1024;
#define DMA_K(j, so) do { AT_GLDS(ksrc + (size_t)(j) * ktile, kdst + (so)); if (NKD == 2) AT_GLDS(ksrc2 + (size_t)(j) * ktile, kdst2 + (so)); } while (0)
#define DMA_V(j, so) AT_GLDS(vsrc + (size_t)(j) * vtile, vdst + (so))
    const LAS unsigned char* kp0 = lds + KOFF + hi * 1024 + r32 * 16;
    const LAS unsigned char* vp0 = lds + VOFF + ((lane >> 4) & 1) * 32 + (lane & 3) * 8 + (4 * hi + ((lane & 15) >> 2)) * 64;
    DMA_K(0, 0); DMA_V(0, 0); DMA_K(1, KSLOT); DMA_V(1, VSLOT); DMA_K(2, 2 * KSLOT);
    const bf16_t* Qw = A.Q + (rowb + qb * 256 + wid * 32 + r32) * A.qp + h * DQK + hi * 8;
    bf16x8 qr[ND];
#pragma unroll
    for (int d0 = 0; d0 < ND; ++d0) qr[d0] = *(const bf16x8*)(Qw + d0 * 16);
    asm volatile("s_waitcnt vmcnt(0)\n\ts_barrier" ::: "memory");
    bf16x8 kf[2 * ND]; s16x4 vlo[8], vhi[8];
#define KLOAD(so) do { _Pragma("unroll") for (int d0 = 0; d0 < ND; ++d0) { kf[2 * d0] = *(const LAS bf16x8*)(kp0 + (so) + d0 * 2048); kf[2 * d0 + 1] = *(const LAS bf16x8*)(kp0 + (so) + d0 * 2048 + 512); } } while (0)
#define VLOAD(so) do { _Pragma("unroll") for (int i = 0; i < 8; ++i) { vlo[i] = vtr(vp0 + (so) + (i >> 2) * 4096 + (i & 3) * 1024); vhi[i] = vtr(vp0 + (so) + (i >> 2) * 4096 + (i & 3) * 1024 + 512); } } while (0)
#define VFR(i) (bf16x8){vlo[i][0], vlo[i][1], vlo[i][2], vlo[i][3], vhi[i][0], vhi[i][1], vhi[i][2], vhi[i][3]}
    KLOAD(0);
    asm volatile("s_waitcnt lgkmcnt(0)" ::: "memory");
    if (PROBE_ATT != 5 && wid >= 4) AT_BAR();
    f32x16 o0 = {}, o1 = {}, C0, C1; u32x4 pw0, pw1, pw2, pw3; float lsum = 0.f;
    const f32x16 zero = {};
#define QK_BLOCK() do { C0 = __builtin_amdgcn_mfma_f32_32x32x16_bf16(kf[0], qr[0], zero, 0, 0, 0); C1 = __builtin_amdgcn_mfma_f32_32x32x16_bf16(kf[1], qr[0], zero, 0, 0, 0); \
        _Pragma("unroll") for (int d0 = 1; d0 < ND; ++d0) { C0 = __builtin_amdgcn_mfma_f32_32x32x16_bf16(kf[2 * d0], qr[d0], C0, 0, 0, 0); C1 = __builtin_amdgcn_mfma_f32_32x32x16_bf16(kf[2 * d0 + 1], qr[d0], C1, 0, 0, 0); } } while (0)
#define PAF(k) __builtin_bit_cast(bf16x8, pw##k)
#define PV_BLOCK() do { \
        o0 = __builtin_amdgcn_mfma_f32_32x32x16_bf16(PAF(0), VFR(0), o0, 0, 0, 0); o1 = __builtin_amdgcn_mfma_f32_32x32x16_bf16(PAF(0), VFR(4), o1, 0, 0, 0); \
        o0 = __builtin_amdgcn_mfma_f32_32x32x16_bf16(PAF(1), VFR(1), o0, 0, 0, 0); o1 = __builtin_amdgcn_mfma_f32_32x32x16_bf16(PAF(1), VFR(5), o1, 0, 0, 0); \
        o0 = __builtin_amdgcn_mfma_f32_32x32x16_bf16(PAF(2), VFR(2), o0, 0, 0, 0); o1 = __builtin_amdgcn_mfma_f32_32x32x16_bf16(PAF(2), VFR(6), o1, 0, 0, 0); \
        o0 = __builtin_amdgcn_mfma_f32_32x32x16_bf16(PAF(3), VFR(3), o0, 0, 0, 0); o1 = __builtin_amdgcn_mfma_f32_32x32x16_bf16(PAF(3), VFR(7), o1, 0, 0, 0); } while (0)
#define SOFTMAX() do { \
        _Pragma("unroll") for (int r = 0; r < 16; ++r) { C0[r] = __builtin_amdgcn_exp2f(C0[r]); C1[r] = __builtin_amdgcn_exp2f(C1[r]); } \
        f32x2 s0_ = {C0[0], C0[1]}, s1_ = {C1[0], C1[1]}; _Pragma("unroll") for (int r = 2; r < 16; r += 2) { s0_ += (f32x2){C0[r], C0[r + 1]}; s1_ += (f32x2){C1[r], C1[r + 1]}; } s0_ += s1_; lsum += s0_[0] + s0_[1]; \
        pw0 = (u32x4){cvtpk(C0[0], C0[1]), cvtpk(C0[2], C0[3]), cvtpk(C0[4], C0[5]), cvtpk(C0[6], C0[7])}; pw1 = (u32x4){cvtpk(C0[8], C0[9]), cvtpk(C0[10], C0[11]), cvtpk(C0[12], C0[13]), cvtpk(C0[14], C0[15])}; \
        pw2 = (u32x4){cvtpk(C1[0], C1[1]), cvtpk(C1[2], C1[3]), cvtpk(C1[4], C1[5]), cvtpk(C1[6], C1[7])}; pw3 = (u32x4){cvtpk(C1[8], C1[9]), cvtpk(C1[10], C1[11]), cvtpk(C1[12], C1[13]), cvtpk(C1[14], C1[15])}; } while (0)
    int ka = 2 * KSLOT, kb = 0, kc = KSLOT, va = 2 * VSLOT, vb = 0, vc = VSLOT;
#define ROT() do { const int t_ = ka; ka = kb; kb = kc; kc = t_; const int u_ = va; va = vb; vb = vc; vc = u_; } while (0)
#define PINP() asm volatile("" : "+v"(lsum) : "v"(pw0), "v"(pw1), "v"(pw2), "v"(pw3))
#if ATT_REGSTAGE
    u32x4 kst = {}, kst2 = {}, vst = {};
    const LAS unsigned char* kw = lds + KOFF + wid * 1024 + lane * 16; const LAS unsigned char* kw2 = lds + KOFF + (8 + (wid & 3)) * 1024 + lane * 16; const LAS unsigned char* vw = lds + VOFF + wid * 1024 + lane * 16;
#define ST_WRITE(WK, WV) do { if (WK) { *(LAS u32x4*)(kw + ka) = kst; if (NKD == 2 && wid < 4) *(LAS u32x4*)(kw2 + ka) = kst2; } if (WV) *(LAS u32x4*)(vw + vc) = vst; } while (0)
#define ST_LOAD(sv, IK, IV) do { if (IK) { kst = *(const u32x4*)(ksrc + (size_t)((sv) + 4) * ktile); if (NKD == 2 && wid < 4) kst2 = *(const u32x4*)(ksrc2 + (size_t)((sv) + 4) * ktile); } if (IV) vst = *(const u32x4*)(vsrc + (size_t)((sv) + 3) * vtile); } while (0)
#define STEP(sv, DOQK, DOPV, KL, VL, IK, IV, WK, WV) do { \
        AT_SCHED(); if (DOQK) QK_BLOCK(); if (DOPV) PV_BLOCK(); AT_SCHED(); \
        asm volatile("s_barrier\n\ts_nop 15\n\ts_nop 3" : "+v"(C0), "+v"(C1), "+v"(o0), "+v"(o1) :: "memory"); AT_SCHED(); \
        if (KL) KLOAD(kc); if (VL) VLOAD(vb); ST_WRITE(WK, WV); ST_LOAD(sv, IK, IV); \
        if (DOQK) { SOFTMAX(); PINP(); } AT_SCHED(); \
        asm volatile("s_waitcnt lgkmcnt(0)\n\ts_barrier" ::: "memory"); \
        AT_SCHED(); ROT(); } while (0)
    STEP(-1, true, false, true, true, true, true, false, false);
#pragma nounroll
    for (int s = 0; s < NT - 4; ++s) STEP(s, true, true, true, true, true, true, true, true);
    STEP(NT - 4, true, true, true, true, false, true, true, true);
    STEP(NT - 3, true, true, true, true, false, false, false, true);
    STEP(NT - 2, true, true, false, true, false, false, false, false);
    STEP(NT - 1, false, true, false, false, false, false, false, false);
#undef ST_WRITE
#undef ST_LOAD
#else
#define STEP(sv, DOQK, DOPV, KL, VL, IK, IV) do { \
        AT_SCHED(); if (DOQK) QK_BLOCK(); if (DOPV) PV_BLOCK(); AT_SCHED(); \
          \
        asm volatile("s_barrier\n\ts_nop 15\n\ts_nop 3" : "+v"(C0), "+v"(C1), "+v"(o0), "+v"(o1) :: "memory"); AT_SCHED(); \
        if (KL) KLOAD(kc); if (VL) VLOAD(vb); if (IK) DMA_K((sv) + 4, kb); if (IV) DMA_V((sv) + 3, va); \
        if (DOQK) { SOFTMAX(); PINP(); } AT_SCHED(); \
        if (IK) { if (NKD == 2) { AT_WAITBAR(3); } else { AT_WAITBAR(2); } } else if (IV) { AT_WAITBAR(1); } else { AT_WAITBAR(0); } \
        AT_SCHED(); ROT(); } while (0)
    STEP(-1, true, false, true, true, true, true);
#pragma nounroll
    for (int s = 0; s < NT - 4; ++s) STEP(s, true, true, true, true, true, true);
    STEP(NT - 4, true, true, true, true, false, true);
    STEP(NT - 3, true, true, true, true, false, false);
    STEP(NT - 2, true, true, false, true, false, false);
    STEP(NT - 1, false, true, false, false, false, false);
#endif
#undef STEP
#undef PINP
    if (PROBE_ATT != 5 && wid < 4) AT_BAR();
    { auto rr = __builtin_amdgcn_permlane32_swap(__float_as_uint(lsum), __float_as_uint(lsum), false, false); lsum = __uint_as_float(rr[0]) + __uint_as_float(rr[1]); }
    LAS float* wsf = (LAS float*)(lds + WSF + wid * 256);
    if (hi == 0) wsf[r32] = lsum;
    asm volatile("s_waitcnt lgkmcnt(0)" ::: "memory");
    LAS bf16_t* stg = (LAS bf16_t*)(lds + OST + wid * 4096);
#pragma unroll
    for (int r = 0; r < 16; ++r) { const int orow = crow(r, hi); const float rl = __builtin_amdgcn_rcpf(wsf[orow]);
        stg[orow * 64 + r32] = (bf16_t)(cvtpk(o0[r] * rl, 0.f) & 0xffffu); stg[orow * 64 + 32 + r32] = (bf16_t)(cvtpk(o1[r] * rl, 0.f) & 0xffffu); }
    asm volatile("s_waitcnt lgkmcnt(0)" ::: "memory");
    bf16_t* Ow = A.O + (rowb + qb * 256 + wid * 32) * A.op + h * 64;
#pragma unroll
    for (int i = 0; i < 4; ++i) { const int row = i * 8 + (lane >> 3), ch = lane & 7; const u32x4 v = *(const LAS u32x4*)(stg + row * 64 + ch * 8); st16((Ow + (size_t)row * A.op + ch * 8), v); }
    asm volatile("s_waitcnt lgkmcnt(0)\n\ts_barrier" ::: "memory");
#undef DMA_K
#undef DMA_V
#undef KLOAD
#undef VLOAD
#undef VFR
#undef QK_BLOCK
#undef PAF
#undef PV_BLOCK
#undef SOFTMAX
#undef ROT
}
#endif
#if FAST_ATTN && ATT_FP8_A
typedef int v8i __attribute__((ext_vector_type(8)));
__device__ __forceinline__ f32x16 mfma8(v8i a, v8i b, f32x16 c) { return __builtin_amdgcn_mfma_scale_f32_32x32x64_f8f6f4(a, b, c, 0, 0, 0, 0x7f7f7f7f, 0, 0x7f7f7f7f); }
__device__ __forceinline__ void attn_unit_f8a(int tid, LAS unsigned char* lds, const unsigned char* Q8, const unsigned char* K8, const unsigned char* VT8, bf16_t* O, int op, int b, int h, int qb, float bias) {
    constexpr int SL = 4096, NT = S / 64;
    constexpr int KOFF = 0, VOFF = 3 * SL, OST = VOFF + 3 * SL, WSF = OST + 8 * 4096;
    const int lane = tid & 63, r32 = lane & 31, hi = lane >> 5, wid = __builtin_amdgcn_readfirstlane(tid >> 6);
    const int kvh = h >> 2; const size_t rowb = (size_t)b * S; const bool kw = wid < 4;
    const unsigned char* src = kw ? K8 + (rowb + lane) * 128 + kvh * 64 + 16 * wid : VT8 + ((size_t)((b * 2 + kvh) * 64 + lane)) * S + 16 * (wid - 4);
    const size_t tstep = kw ? (size_t)64 * 128 : (size_t)64;
    LAS unsigned char* dst = lds + (kw ? KOFF + wid * 1024 : VOFF + (wid - 4) * 1024);
#define DMA8(j, so) AT_GLDS(src + (size_t)(j) * tstep, dst + (so))
    const LAS unsigned char* kp0 = lds + KOFF + (2 * hi) * 1024 + r32 * 16;
    const LAS unsigned char* vp0 = lds + VOFF + (2 * hi) * 1024 + r32 * 16;
    if (kw) { DMA8(0, 0); DMA8(1, SL); DMA8(2, 2 * SL); } else { DMA8(0, 0); DMA8(1, SL); }
    v8i qf; { const unsigned char* Qw = Q8 + (rowb + qb * 256 + wid * 32 + r32) * 512 + h * 64 + 32 * hi; const u32x4 a = *(const u32x4*)Qw, c = *(const u32x4*)(Qw + 16);
        qf = (v8i){(int)a.x, (int)a.y, (int)a.z, (int)a.w, (int)c.x, (int)c.y, (int)c.z, (int)c.w}; }
    asm volatile("s_waitcnt vmcnt(0)\n\ts_barrier" ::: "memory");
    v8i kf0, kf1, vf0, vf1, p8;
#define LD32(dstv, p) do { const u32x4 a_ = *(const LAS u32x4*)(p), c_ = *(const LAS u32x4*)((p) + 1024); dstv = (v8i){(int)a_.x, (int)a_.y, (int)a_.z, (int)a_.w, (int)c_.x, (int)c_.y, (int)c_.z, (int)c_.w}; } while (0)
#define KLOAD8(so) do { LD32(kf0, kp0 + (so)); LD32(kf1, kp0 + (so) + 512); } while (0)
#define VLOAD8(so) do { LD32(vf0, vp0 + (so)); LD32(vf1, vp0 + (so) + 512); } while (0)
    KLOAD8(0);
    asm volatile("s_waitcnt lgkmcnt(0)" ::: "memory");
    if (wid >= 4) AT_BAR();
    f32x16 o0 = {}, o1 = {}, C0, C1; float lsum = 0.f;
    f32x16 negb;
#pragma unroll
    for (int r = 0; r < 16; ++r) negb[r] = bias;
    asm volatile("" : "+v"(negb));
#define SOFTMAX8() do { \
        _Pragma("unroll") for (int r = 0; r < 16; ++r) { C0[r] = __builtin_amdgcn_exp2f(C0[r]); C1[r] = __builtin_amdgcn_exp2f(C1[r]); } \
        f32x2 s0_ = {C0[0], C0[1]}, s1_ = {C1[0], C1[1]}; _Pragma("unroll") for (int r = 2; r < 16; r += 2) { s0_ += (f32x2){C0[r], C0[r + 1]}; s1_ += (f32x2){C1[r], C1[r + 1]}; } s0_ += s1_; lsum += s0_[0] + s0_[1]; \
        _Pragma("unroll") for (int i = 0; i < 4; ++i) { \
            p8[i] = __builtin_amdgcn_cvt_pk_fp8_f32(C0[4 * i + 2], C0[4 * i + 3], __builtin_amdgcn_cvt_pk_fp8_f32(C0[4 * i], C0[4 * i + 1], 0, false), true); \
            p8[4 + i] = __builtin_amdgcn_cvt_pk_fp8_f32(C1[4 * i + 2], C1[4 * i + 3], __builtin_amdgcn_cvt_pk_fp8_f32(C1[4 * i], C1[4 * i + 1], 0, false), true); } } while (0)
    int oa = 2 * SL, ob = 0, oc = SL;
#define ROT8() do { const int t_ = oa; oa = ob; ob = oc; oc = t_; } while (0)
#define STEP8(sv, DOQK, DOPV, KL, VL, IK, IV) do { \
        AT_SCHED(); if (DOQK) { C0 = mfma8(kf0, qf, negb); C1 = mfma8(kf1, qf, negb); } if (DOPV) { o0 = mfma8(p8, vf0, o0); o1 = mfma8(p8, vf1, o1); } AT_SCHED(); \
        asm volatile("s_barrier\n\ts_nop 15\n\ts_nop 15" : "+v"(C0), "+v"(C1), "+v"(o0), "+v"(o1) :: "memory"); AT_SCHED(); \
        if (KL) KLOAD8(oc); if (VL) VLOAD8(ob); \
        const bool iss_ = kw ? (IK) : (IV); if (iss_) { if (kw) DMA8((sv) + 4, ob); else DMA8((sv) + 3, oa); } \
        if (DOQK) { SOFTMAX8(); asm volatile("" : "+v"(lsum) : "v"(p8)); } AT_SCHED(); \
        if (iss_) { AT_WAITBAR(1); } else { AT_WAITBAR(0); } \
        AT_SCHED(); ROT8(); } while (0)
    STEP8(-1, true, false, true, true, true, true);
#pragma nounroll
    for (int s = 0; s < NT - 4; ++s) STEP8(s, true, true, true, true, true, true);
    STEP8(NT - 4, true, true, true, true, false, true);
    STEP8(NT - 3, true, true, true, true, false, false);
    STEP8(NT - 2, true, true, false, true, false, false);
    STEP8(NT - 1, false, true, false, false, false, false);
    if (wid < 4) AT_BAR();
    { auto rr = __builtin_amdgcn_permlane32_swap(__float_as_uint(lsum), __float_as_uint(lsum), false, false); lsum = __uint_as_float(rr[0]) + __uint_as_float(rr[1]); }
    LAS float* wsf = (LAS float*)(lds + WSF + wid * 256);
    if (hi == 0) wsf[r32] = lsum;
    asm volatile("s_waitcnt lgkmcnt(0)" ::: "memory");
    LAS bf16_t* stg = (LAS bf16_t*)(lds + OST + wid * 4096);
#pragma unroll
    for (int r = 0; r < 16; ++r) { const int orow = crow(r, hi); const float rl = __builtin_amdgcn_rcpf(wsf[orow]);
        stg[orow * 64 + r32] = (bf16_t)(cvtpk(o0[r] * rl, 0.f) & 0xffffu); stg[orow * 64 + 32 + r32] = (bf16_t)(cvtpk(o1[r] * rl, 0.f) & 0xffffu); }
    asm volatile("s_waitcnt lgkmcnt(0)" ::: "memory");
    bf16_t* Ow = O + (rowb + qb * 256 + wid * 32) * op + h * 64;
#pragma unroll
    for (int i = 0; i < 4; ++i) { const int row = i * 8 + (lane >> 3), ch = lane & 7; const u32x4 v = *(const LAS u32x4*)(stg + row * 64 + ch * 8); st16(Ow + (size_t)row * op + ch * 8, v); }
    asm volatile("s_waitcnt lgkmcnt(0)\n\ts_barrier" ::: "memory");
#undef DMA8
#undef LD32
#undef KLOAD8
#undef VLOAD8
#undef SOFTMAX8
#undef ROT8
#undef STEP8
}
__device__ __forceinline__ void attn_phase_f8a(int tid, LAS unsigned char* lds, const unsigned char* Q8, const unsigned char* K8, const unsigned char* VT8, bf16_t* O, int op, const float* gq, const float* gk, int vcu, int G) {
    float mq = 0.f, mk = 0.f;
    for (int i = 0; i < 64; ++i) { mq = fmaxf(mq, fabsf(gq[i])); mk = fmaxf(mk, fabsf(gk[i])); }
    const float bias = -fmaxf(64.f * mq * mk * QSCALE_A - 8.f, 0.f);
    int bh, qb;
    for (int i = 0; next_unit(i, vcu, G, bh, qb); ++i) attn_unit_f8a(tid, lds, Q8, K8, VT8, O, op, bh >> 3, bh & 7, qb, bias);
}
#endif
#if FAST_ATTN && ATT_FP8_B
__device__ __forceinline__ f32x16 mfma8pv(v8i a, v8i b, f32x16 c) { return __builtin_amdgcn_mfma_scale_f32_32x32x64_f8f6f4(a, b, c, 1, 0, 0, 0x7f7f7f7f, 0, 0x7f7f7f7f); }
__device__ __forceinline__ void attn_unit_f8b(int tid, LAS unsigned char* lds, const unsigned char* Q8, const unsigned char* K8, const unsigned char* VT8, bf16_t* O, int op, int b, int h, int qb) {
    constexpr int SLK = 6144, SLV = 4096, NT = S / 64;
    constexpr int KOFF = 0, VOFF = 3 * SLK, OST = VOFF + 3 * SLV, WSF = OST + 8 * 4096;
    static_assert(WSF + 2048 <= RING_BYTES, "attention LDS");
    const int lane = tid & 63, r32 = lane & 31, hi = lane >> 5, wid = __builtin_amdgcn_readfirstlane(tid >> 6);
    const size_t rowb = (size_t)b * S; const bool kw = wid < 6, vw = wid >= 4;
    const unsigned char* ksrc = K8 + (rowb + lane) * 768 + h * 96 + 16 * wid;
    const unsigned char* vsrc = VT8 + ((size_t)((b * 8 + h) * 64 + lane)) * S + 16 * (wid - 4);
    LAS unsigned char* kdst = lds + KOFF + wid * 1024; LAS unsigned char* vdst = lds + VOFF + (wid - 4) * 1024;
#define DMAK(j, so) AT_GLDS(ksrc + (size_t)(j) * (64 * 768), kdst + (so))
#define DMAV(j, so) AT_GLDS(vsrc + (size_t)(j) * 64, vdst + (so))
    const LAS unsigned char* kp0 = lds + KOFF + (2 * hi) * 1024 + r32 * 16;
    const LAS unsigned char* kr0 = lds + KOFF + 4 * 1024 + r32 * 16;
    const LAS unsigned char* vp0 = lds + VOFF + (2 * hi) * 1024 + r32 * 16;
    if (kw) { DMAK(0, 0); DMAK(1, SLK); DMAK(2, 2 * SLK); }
    if (vw) { DMAV(0, 0); DMAV(1, SLV); }
    v8i qn, qr;
    { const unsigned char* Qw = Q8 + (rowb + qb * 256 + wid * 32 + r32) * 768 + h * 96; const u32x4 a = *(const u32x4*)(Qw + 32 * hi), c = *(const u32x4*)(Qw + 32 * hi + 16), e = *(const u32x4*)(Qw + 64), f = *(const u32x4*)(Qw + 80);
      qn = (v8i){(int)a.x, (int)a.y, (int)a.z, (int)a.w, (int)c.x, (int)c.y, (int)c.z, (int)c.w};
      qr = hi ? (v8i){0, 0, 0, 0, 0, 0, 0, 0} : (v8i){(int)e.x, (int)e.y, (int)e.z, (int)e.w, (int)f.x, (int)f.y, (int)f.z, (int)f.w}; }
    asm volatile("s_waitcnt vmcnt(0)\n\ts_barrier" ::: "memory");
    v8i kn0, kn1, kr0v, kr1v, vf0, vf1, p8;
#define LD32(dstv, p) do { const u32x4 a_ = *(const LAS u32x4*)(p), c_ = *(const LAS u32x4*)((p) + 1024); dstv = (v8i){(int)a_.x, (int)a_.y, (int)a_.z, (int)a_.w, (int)c_.x, (int)c_.y, (int)c_.z, (int)c_.w}; } while (0)
#define KLOAD8(so) do { LD32(kn0, kp0 + (so)); LD32(kn1, kp0 + (so) + 512); LD32(kr0v, kr0 + (so)); LD32(kr1v, kr0 + (so) + 512); } while (0)
#define VLOAD8(so) do { LD32(vf0, vp0 + (so)); LD32(vf1, vp0 + (so) + 512); } while (0)
    KLOAD8(0);
    asm volatile("s_waitcnt lgkmcnt(0)" ::: "memory");
    if (wid >= 4) AT_BAR();
    f32x16 o0 = {}, o1 = {}, C0, C1; float lsum = 0.f; const f32x16 zero = {};
#define SOFTMAX8() do { \
        _Pragma("unroll") for (int r = 0; r < 16; ++r) { C0[r] = __builtin_amdgcn_exp2f(C0[r]); C1[r] = __builtin_amdgcn_exp2f(C1[r]); } \
        f32x2 s0_ = {C0[0], C0[1]}, s1_ = {C1[0], C1[1]}; _Pragma("unroll") for (int r = 2; r < 16; r += 2) { s0_ += (f32x2){C0[r], C0[r + 1]}; s1_ += (f32x2){C1[r], C1[r + 1]}; } s0_ += s1_; lsum += s0_[0] + s0_[1]; \
        _Pragma("unroll") for (int i = 0; i < 4; ++i) { \
            p8[i] = __builtin_amdgcn_cvt_pk_bf8_f32(C0[4 * i + 2], C0[4 * i + 3], __builtin_amdgcn_cvt_pk_bf8_f32(C0[4 * i], C0[4 * i + 1], 0, false), true); \
            p8[4 + i] = __builtin_amdgcn_cvt_pk_bf8_f32(C1[4 * i + 2], C1[4 * i + 3], __builtin_amdgcn_cvt_pk_bf8_f32(C1[4 * i], C1[4 * i + 1], 0, false), true); } } while (0)
    int ka = 2 * SLK, kb = 0, kc = SLK, va = 2 * SLV, vb = 0, vc = SLV;
#define ROT8() do { const int t_ = ka; ka = kb; kb = kc; kc = t_; const int u_ = va; va = vb; vb = vc; vc = u_; } while (0)
#define STEP8(sv, DOQK, DOPV, KL, VL, IK, IV) do { \
        AT_SCHED(); if (DOQK) { C0 = mfma8(kn0, qn, zero); C1 = mfma8(kn1, qn, zero); C0 = mfma8(kr0v, qr, C0); C1 = mfma8(kr1v, qr, C1); } if (DOPV) { o0 = mfma8pv(p8, vf0, o0); o1 = mfma8pv(p8, vf1, o1); } AT_SCHED(); \
        asm volatile("s_barrier\n\ts_nop 15\n\ts_nop 15" : "+v"(C0), "+v"(C1), "+v"(o0), "+v"(o1) :: "memory"); AT_SCHED(); \
        if (KL) KLOAD8(kc); if (VL) VLOAD8(vb); \
        const bool ik_ = kw && (IK), iv_ = vw && (IV); if (ik_) DMAK((sv) + 4, kb); if (iv_) DMAV((sv) + 3, va); \
        if (DOQK) { SOFTMAX8(); asm volatile("" : "+v"(lsum) : "v"(p8)); } AT_SCHED(); \
        if (ik_ && iv_) { AT_WAITBAR(2); } else if (ik_ || iv_) { AT_WAITBAR(1); } else { AT_WAITBAR(0); } \
        AT_SCHED(); ROT8(); } while (0)
    STEP8(-1, true, false, true, true, true, true);
#pragma nounroll
    for (int s = 0; s < NT - 4; ++s) STEP8(s, true, true, true, true, true, true);
    STEP8(NT - 4, true, true, true, true, false, true);
    STEP8(NT - 3, true, true, true, true, false, false);
    STEP8(NT - 2, true, true, false, true, false, false);
    STEP8(NT - 1, false, true, false, false, false, false);
    if (wid < 4) AT_BAR();
    { auto rr = __builtin_amdgcn_permlane32_swap(__float_as_uint(lsum), __float_as_uint(lsum), false, false); lsum = __uint_as_float(rr[0]) + __uint_as_float(rr[1]); }
    LAS float* wsf = (LAS float*)(lds + WSF + wid * 256);
    if (hi == 0) wsf[r32] = lsum;
    asm volatile("s_waitcnt lgkmcnt(0)" ::: "memory");
    LAS bf16_t* stg = (LAS bf16_t*)(lds + OST + wid * 4096);
#pragma unroll
    for (int r = 0; r < 16; ++r) { const int orow = crow(r, hi); const float rl = __builtin_amdgcn_rcpf(wsf[orow]);
        stg[orow * 64 + r32] = (bf16_t)(cvtpk(o0[r] * rl, 0.f) & 0xffffu); stg[orow * 64 + 32 + r32] = (bf16_t)(cvtpk(o1[r] * rl, 0.f) & 0xffffu); }
    asm volatile("s_waitcnt lgkmcnt(0)" ::: "memory");
    bf16_t* Ow = O + (rowb + qb * 256 + wid * 32) * op + h * 64;
#pragma unroll
    for (int i = 0; i < 4; ++i) { const int row = i * 8 + (lane >> 3), ch = lane & 7; const u32x4 v = *(const LAS u32x4*)(stg + row * 64 + ch * 8); st16(Ow + (size_t)row * op + ch * 8, v); }
    asm volatile("s_waitcnt lgkmcnt(0)\n\ts_barrier" ::: "memory");
#undef DMAK
#undef DMAV
#undef LD32
#undef KLOAD8
#undef VLOAD8
#undef SOFTMAX8
#undef ROT8
#undef STEP8
}
__device__ __forceinline__ void attn_phase_f8b(int tid, LAS unsigned char* lds, const unsigned char* Q8, const unsigned char* K8, const unsigned char* VT8, bf16_t* O, int op, int vcu, int G) {
    int bh, qb;
    for (int i = 0; next_unit(i, vcu, G, bh, qb); ++i) attn_unit_f8b(tid, lds, Q8, K8, VT8, O, op, bh >> 3, bh & 7, qb);
}
#endif
template <int DQK>
__device__ __forceinline__ void attn_phase(int tid, LAS unsigned char* lds, const Tensors& A, int vcu, int G) {
#if FAST_ATTN
    int bh, qb;
    for (int i = 0; next_unit(i, vcu, G, bh, qb); ++i) attn_unit<DQK>(tid, lds, A, bh >> 3, bh & 7, qb);
#else
    (void)lds; attn_phase_ref<DQK>(tid, A, vcu, G);
#endif
}
}


struct Args { const float* in[22]; float* out; unsigned char* ws; int ph_lo, ph_hi; };
struct Frame {
    LAS unsigned char* lds; volatile LAS unsigned* MISC; unsigned* ctl;
    int tid, lane, wave, vcu, G;
    unsigned char* ws; float* OUT;
};

__device__ __forceinline__ void p0_phase(Frame& F, const float* c, const float* w_ada, const float* b_ada) {
    LAS float* cs = (LAS float*)F.lds;
    LAS float* red = (LAS float*)(F.lds + 32768);
    for (int i = F.tid; i < NB * D; i += NTHREADS) { const float v = c[i]; cs[i] = v / (1.f + __expf(-v)); }
    __syncthreads();
    float* mod = (float*)(F.ws + WS_MOD);
    const int kq = F.wave, col = F.lane;
    for (int item = F.vcu; item < NL * 6 * D / 64; item += F.G) {
        const int l = item / (6 * D / 64), n0 = (item % (6 * D / 64)) * 64;
        const float* w = w_ada + (size_t)l * D * 6 * D + n0 + col;
        float acc[NB];
#pragma unroll
        for (int b = 0; b < NB; ++b) acc[b] = 0.f;
#pragma unroll 8
        for (int k = kq * 128; k < kq * 128 + 128; ++k) { const float wv = w[(size_t)k * 6 * D];
#pragma unroll
            for (int b = 0; b < NB; ++b) acc[b] += cs[b * D + k] * wv; }
#pragma unroll
        for (int b = 0; b < NB; ++b) red[(kq * NB + b) * 64 + col] = acc[b];
        __syncthreads();
        { const int b = F.wave; float s = 0.f;
#pragma unroll
          for (int q = 0; q < 8; ++q) s += red[(q * NB + b) * 64 + col];
          mod[((size_t)l * NB + b) * 6 * D + n0 + col] = s + b_ada[(size_t)l * 6 * D + n0 + col]; }
        __syncthreads();
    }
    float* cosA = (float*)(F.ws + WS_COSA); float* sinA = (float*)(F.ws + WS_SINA); float* cosB = (float*)(F.ws + WS_COSB); float* sinB = (float*)(F.ws + WS_SINB);
    for (int idx = F.vcu * NTHREADS + F.tid; idx < S * 48; idx += F.G * NTHREADS) {
        const int s = idx / 48, i = idx % 48; const float row = (float)(s >> 6), col2 = (float)(s & 63);
        if (i < 32) { const int j = i & 15; const float a = (i < 16 ? row : col2) * (1.0f / powf(10000.0f, (float)j / 16.0f)); cosA[s * 32 + i] = cosf(a); sinA[s * 32 + i] = sinf(a); }
        else { const int ii = i - 32, j = ii & 7; const float a = (ii < 8 ? row : col2) * (1.0f / powf(10000.0f, (float)j / 8.0f)); cosB[s * 16 + ii] = cosf(a); sinB[s * 16 + ii] = sinf(a); }
    }
}

template <class SrcFn>
__device__ __forceinline__ void cvt_item(const float* W, int K, int Nsrc, const float* kg, bf16_t* WT, LAS float* scr, int item, int nblk, int lane, const SrcFn& src) {
    const int kb = item / nblk, nb = item % nblk, k0 = 64 * kb, n0 = 32 * nb;
    const int sc = src(n0 + (lane & 31));
#pragma unroll
    for (int i = 0; i < 32; ++i) { const int kk = 2 * i + (lane >> 5); float v = sc >= 0 ? W[(size_t)(k0 + kk) * Nsrc + sc] : 0.f; if (kg) v *= kg[k0 + kk]; scr[kk * 33 + (lane & 31)] = v; }
    LDS_WAIT(); asm volatile("" ::: "memory");
    const int c = lane & 7;
#pragma unroll
    for (int j = 0; j < 4; ++j) { const int n = (lane >> 3) + 8 * j; const LAS float* s = scr + (8 * c) * 33 + n;
        u32x4 o; o.x = cvt_pk_bf16(s[0 * 33], s[1 * 33]); o.y = cvt_pk_bf16(s[2 * 33], s[3 * 33]); o.z = cvt_pk_bf16(s[4 * 33], s[5 * 33]); o.w = cvt_pk_bf16(s[6 * 33], s[7 * 33]);
        *(u32x4*)(WT + (size_t)(n0 + n) * K + k0 + 8 * c) = o; }
    LDS_WAIT(); asm volatile("" ::: "memory");
}
struct SrcId { __device__ int operator()(int n) const { return n; } };
struct SrcIn { __device__ int operator()(int n) const { return gp::src_col_in(n); } };
typedef __attribute__((address_space(4))) const Args CArgsW;
__device__ __forceinline__ void convert_weights(Frame& F, CArgsW* a, int l) {
    LAS float* scr = (LAS float*)(F.lds + F.wave * 16384);
    const int gw = F.vcu * NWAVES + F.wave, NGW = F.G * NWAVES;
    const float* w_in = ((const float*)(GAS const float*)a->in[5]) + (size_t)l * D * INC; const float* w_q_b = ((const float*)(GAS const float*)a->in[10]) + (size_t)l * 384 * 768; const float* w_kv_b = ((const float*)(GAS const float*)a->in[11]) + (size_t)l * 256 * 1024;
    const float* w_pa = ((const float*)(GAS const float*)a->in[12]) + (size_t)l * 512 * D; const float* w_pb = ((const float*)(GAS const float*)a->in[13]) + (size_t)l * 512 * D; const float* w_o = ((const float*)(GAS const float*)a->in[14]) + (size_t)l * D * D;
    const float* w1 = ((const float*)(GAS const float*)a->in[18]) + (size_t)l * NE * D * FF; const float* w3 = ((const float*)(GAS const float*)a->in[19]) + (size_t)l * NE * D * FF; const float* w2 = ((const float*)(GAS const float*)a->in[20]) + (size_t)l * NE * FF * D;
    const float* gqa = ((const float*)(GAS const float*)a->in[8]) + l * 384; const float* gkv = ((const float*)(GAS const float*)a->in[9]) + l * 256;
    bf16_t* Win = (bf16_t*)(F.ws + WS_WIN); bf16_t* Wqb = (bf16_t*)(F.ws + WS_WQB); bf16_t* Wkvb = (bf16_t*)(F.ws + WS_WKVB); bf16_t* Wpa = (bf16_t*)(F.ws + WS_WPA); bf16_t* Wpb = (bf16_t*)(F.ws + WS_WPB);
    bf16_t* Wo = (bf16_t*)(F.ws + WS_WO); bf16_t* W13 = (bf16_t*)(F.ws + WS_W13); bf16_t* W2 = (bf16_t*)(F.ws + WS_W2);
    constexpr int I_IN = (D / 64) * (NIN / 32), I_QB = (384 / 64) * (768 / 32), I_KVB = (256 / 64) * (1024 / 32), I_P = (512 / 64) * (D / 32), I_O = (D / 64) * (D / 32);
    constexpr int I_13 = (D / 64) * (1024 / 32), I_2 = (FF / 64) * (D / 32);
    constexpr int NITEMS = I_IN + I_QB + I_KVB + 2 * I_P + I_O + NE * (I_13 + I_2);
    for (int it = gw; it < NITEMS; it += NGW) {
        int r = it;
        if (r < I_IN) { cvt_item(w_in, D, INC, nullptr, Win, scr, r, NIN / 32, F.lane, SrcIn()); continue; } r -= I_IN;
        if (r < I_QB) { cvt_item(w_q_b, 384, 768, gqa, Wqb, scr, r, 768 / 32, F.lane, SrcId()); continue; } r -= I_QB;
        if (r < I_KVB) { cvt_item(w_kv_b, 256, 1024, gkv, Wkvb, scr, r, 1024 / 32, F.lane, SrcId()); continue; } r -= I_KVB;
        if (r < I_P) { cvt_item(w_pa, 512, D, nullptr, Wpa, scr, r, D / 32, F.lane, SrcId()); continue; } r -= I_P;
        if (r < I_P) { cvt_item(w_pb, 512, D, nullptr, Wpb, scr, r, D / 32, F.lane, SrcId()); continue; } r -= I_P;
        if (r < I_O) { cvt_item(w_o, D, D, nullptr, Wo, scr, r, D / 32, F.lane, SrcId()); continue; } r -= I_O;
        if (r < NE * I_13) { const int e = r / I_13, q = r % I_13, nb = q % 32;
            const float* src = ((nb & 7) < 4 ? w1 : w3) + (size_t)e * D * FF; const int cb = (nb >> 3) * 128 + (nb & 3) * 32;
            struct SrcOff { int n0, cb; __device__ int operator()(int n) const { return cb + (n - n0); } } so{nb * 32, cb};
            cvt_item(src, D, FF, nullptr, W13 + (size_t)e * 1024 * D, scr, q, 32, F.lane, so); continue; } r -= NE * I_13;
        { const int e = r / I_2, q = r % I_2; cvt_item(w2 + (size_t)e * FF * D, FF, D, nullptr, W2 + (size_t)e * D * FF, scr, q, D / 32, F.lane, SrcId()); }
    }
}

template <int MODE>
__device__ __forceinline__ void row_phase(Frame& F, const float* xin, const float* g2prev, const float* gain, const float* modl, int sh_off, int sc_off, bf16_t* H, bf16_t* XB, float* OUT) {
    constexpr int RB = 4;
    const int gw = F.vcu * NWAVES + F.wave, NGW = F.G * NWAVES;
    const bf16_t* Y2 = (const bf16_t*)(F.ws + WS_Y2);
    for (int m0 = gw; m0 < T; m0 += RB * NGW) {
        f32x4 v[RB][4]; float ss[RB];
        if (MODE == 0) {
#pragma unroll
            for (int r = 0; r < RB; ++r)
#pragma unroll
                for (int j = 0; j < 4; ++j) v[r][j] = *(const f32x4*)(xin + (size_t)(m0 + r * NGW) * D + 4 * F.lane + 256 * j);
        } else {
            unsigned ya[RB][4], yb[RB][4]; f32x4 g[RB][4];
#pragma unroll
            for (int r = 0; r < RB; ++r)
#pragma unroll
                for (int j = 0; j < 4; ++j) { const int m = m0 + r * NGW, c = 4 * F.lane + 256 * j;
                    { const u32x2 xb = *(const u32x2*)(XB + (size_t)m * D + c); v[r][j] = (f32x4){bf2f(xb.x & 0xffffu), bf2f(xb.x >> 16), bf2f(xb.y & 0xffffu), bf2f(xb.y >> 16)}; } ya[r][j] = *(const unsigned*)((const unsigned char*)Y2 + (size_t)(2 * m) * D + c); yb[r][j] = *(const unsigned*)((const unsigned char*)Y2 + (size_t)(2 * m + 1) * D + c);
                    g[r][j] = *(const f32x4*)(g2prev + (size_t)(m >> 12) * 6 * D + 5 * D + c); }
#pragma unroll
            for (int r = 0; r < RB; ++r)
#pragma unroll
                for (int j = 0; j < 4; ++j) { const f32x2 a0 = __builtin_amdgcn_cvt_pk_f32_fp8((int)ya[r][j], false), a1 = __builtin_amdgcn_cvt_pk_f32_fp8((int)ya[r][j], true), b0 = __builtin_amdgcn_cvt_pk_f32_fp8((int)yb[r][j], false), b1 = __builtin_amdgcn_cvt_pk_f32_fp8((int)yb[r][j], true);
                    const f32x4 y = (f32x4){a0[0] + b0[0], a0[1] + b0[1], a1[0] + b1[0], a1[1] + b1[1]} * 0.0625f;
                    v[r][j] += g[r][j] * y; }
        }
#pragma unroll
        for (int r = 0; r < RB; ++r) { ss[r] = (gp::dot4(v[r][0]) + gp::dot4(v[r][1])) + (gp::dot4(v[r][2]) + gp::dot4(v[r][3])); }
#pragma unroll
        for (int o = 1; o < 64; o <<= 1)
#pragma unroll
            for (int r = 0; r < RB; ++r) ss[r] += __shfl_xor(ss[r], o);
#pragma unroll
        for (int r = 0; r < RB; ++r) {
            const int m = m0 + r * NGW, b = m >> 12; const float rstd = rsqrtf(ss[r] * (1.f / D) + EPS);
#pragma unroll
            for (int j = 0; j < 4; ++j) {
                const int c = 4 * F.lane + 256 * j; const f32x4 gn = *(const f32x4*)(gain + c);
                if (MODE == 2) { *(f32x4*)(OUT + (size_t)m * D + c) = v[r][j] * rstd * gn; }
                else {
                    { u32x2 xw; xw.x = cvt_pk_bf16(v[r][j][0], v[r][j][1]); xw.y = cvt_pk_bf16(v[r][j][2], v[r][j][3]); st8((XB + (size_t)m * D + c), xw); }
                    const f32x4 sc = *(const f32x4*)(modl + (size_t)b * 6 * D + sc_off + c), sh = *(const f32x4*)(modl + (size_t)b * 6 * D + sh_off + c);
                    const f32x4 hv = v[r][j] * rstd * gn * (1.f + sc) + sh;
                    u32x2 w; w.x = cvt_pk_bf16(hv[0], hv[1]); w.y = cvt_pk_bf16(hv[2], hv[3]);
                    st8((H + (size_t)m * D + c), w);
                }
            }
        }
    }
}

__device__ __forceinline__ void t2_phase(Frame& F, const float* gain, const float* modl, const float* w_router, const float* rbias, int l, bool record) {
    LAS f32x4* wl = (LAS f32x4*)F.lds;
    LAS int* rec = (LAS int*)(F.lds + 65536);
    LAS float* recw = (LAS float*)(F.lds + 65536 + 2048);
    LAS int* lcnt = (LAS int*)(F.lds + 65536 + 4096);
    for (int idx = F.tid; idx < 4096; idx += NTHREADS) {
        const int lane = idx & 63, c = (idx >> 6) & 3, i = (idx >> 8) & 3, j = idx >> 10; const int k = 4 * lane + 256 * j + i;
        wl[idx] = *(const f32x4*)(w_router + (size_t)k * NE + 4 * c);
    }
    if (F.tid < 32) lcnt[F.tid] = 0;
    __syncthreads();
    constexpr int RB = 4;
    const int gw = F.vcu * NWAVES + F.wave, NGW = F.G * NWAVES;
    bf16_t* H = (bf16_t*)(F.ws + WS_H); const bf16_t* XB = (const bf16_t*)(F.ws + WS_XB);
    const int lane = F.lane, myrow = lane >> 4, mye = lane & 15;
    int it = 0;
    for (int m0 = gw; m0 < T; m0 += RB * NGW, ++it) {
        f32x4 v[RB][4]; float ss[RB];
#pragma unroll
        for (int r = 0; r < RB; ++r)
#pragma unroll
            for (int j = 0; j < 4; ++j) { const u32x2 xb = *(const u32x2*)(XB + (size_t)(m0 + r * NGW) * D + 4 * lane + 256 * j); v[r][j] = (f32x4){bf2f(xb.x & 0xffffu), bf2f(xb.x >> 16), bf2f(xb.y & 0xffffu), bf2f(xb.y >> 16)}; }
#pragma unroll
        for (int r = 0; r < RB; ++r) ss[r] = (gp::dot4(v[r][0]) + gp::dot4(v[r][1])) + (gp::dot4(v[r][2]) + gp::dot4(v[r][3]));
#pragma unroll
        for (int o = 1; o < 64; o <<= 1)
#pragma unroll
            for (int r = 0; r < RB; ++r) ss[r] += __shfl_xor(ss[r], o);
        float acc[RB * NE];
#pragma unroll
        for (int q = 0; q < RB * NE; ++q) acc[q] = 0.f;
#pragma unroll
        for (int j = 0; j < 4; ++j) {
            const int c = 4 * lane + 256 * j; const f32x4 gn = *(const f32x4*)(gain + c);
#pragma unroll
            for (int r = 0; r < RB; ++r) {
                const int m = m0 + r * NGW, b = m >> 12; const float rstd = rsqrtf(ss[r] * (1.f / D) + EPS);
                const f32x4 sc = *(const f32x4*)(modl + (size_t)b * 6 * D + 4 * D + c), sh = *(const f32x4*)(modl + (size_t)b * 6 * D + 3 * D + c);
                v[r][j] = v[r][j] * rstd * gn * (1.f + sc) + sh;
                u32x2 w; w.x = cvt_pk_bf16(v[r][j][0], v[r][j][1]); w.y = cvt_pk_bf16(v[r][j][2], v[r][j][3]);
                st8((H + (size_t)m * D + c), w);
            }
#pragma unroll
            for (int i = 0; i < 4; ++i)
#pragma unroll
                for (int c4 = 0; c4 < 4; ++c4) { const f32x4 wv = wl[((j * 4 + i) * 4 + c4) * 64 + lane];
#pragma unroll
                    for (int r = 0; r < RB; ++r) { const float hv = v[r][j][i];
                        acc[r * NE + 4 * c4 + 0] += hv * wv[0]; acc[r * NE + 4 * c4 + 1] += hv * wv[1]; acc[r * NE + 4 * c4 + 2] += hv * wv[2]; acc[r * NE + 4 * c4 + 3] += hv * wv[3]; } }
        }
#pragma unroll
        for (int sft = 32; sft >= 1; sft >>= 1) {
            const bool up = (lane & sft) != 0;
#pragma unroll
            for (int k = 0; k < sft; ++k) { const float a = acc[k], b = acc[k + sft]; const float keep = up ? b : a, send = up ? a : b; acc[k] = keep + __shfl_xor(send, sft); }
        }
        const float logit = acc[0];
        const float score = 1.f / (1.f + expf(-logit));
        float scv[NE], bi[NE];
#pragma unroll
        for (int e = 0; e < NE; ++e) { scv[e] = __shfl(score, (lane & 48) | e); bi[e] = scv[e] + rbias[e]; }
        int gsel = 0; float gbest = -INFINITY;
#pragma unroll
        for (int g = 0; g < 4; ++g) { float m1 = -INFINITY, m2 = -INFINITY;
#pragma unroll
            for (int j = 0; j < 4; ++j) { const float x = bi[g * 4 + j]; if (x > m1) { m2 = m1; m1 = x; } else if (x > m2) m2 = x; }
            const float gs = m1 + m2; if (gs > gbest) { gbest = gs; gsel = g; } }
        int e1 = -1, e2 = -1; float b1 = -INFINITY, b2 = -INFINITY, s1 = 0.f, s2 = 0.f;
#pragma unroll
        for (int j = 0; j < 4; ++j) { float x = -INFINITY, sx = 0.f;
#pragma unroll
            for (int g = 0; g < 4; ++g) if (g == gsel) { x = bi[g * 4 + j]; sx = scv[g * 4 + j]; }
            const int e = gsel * 4 + j;
            if (x > b1) { b2 = b1; e2 = e1; s2 = s1; b1 = x; e1 = e; s1 = sx; } else if (x > b2) { b2 = x; e2 = e; s2 = sx; } }
        if (mye == 0) {
            const float inv = 1.f / (s1 + s2); const int slot = (it * RB + myrow) * NWAVES + F.wave;
            rec[slot * 4 + 0] = e1; rec[slot * 4 + 1] = e2;
            rec[slot * 4 + 2] = __hip_atomic_fetch_add(&lcnt[e1], 1, __ATOMIC_RELAXED, __HIP_MEMORY_SCOPE_WORKGROUP);
            rec[slot * 4 + 3] = __hip_atomic_fetch_add(&lcnt[e2], 1, __ATOMIC_RELAXED, __HIP_MEMORY_SCOPE_WORKGROUP);
            recw[slot * 2 + 0] = s1 * inv; recw[slot * 2 + 1] = s2 * inv;
        }
    }
    __syncthreads();
    if (!record) return;
    if (F.tid < NE) lcnt[16 + F.tid] = (int)__hip_atomic_fetch_add(F.ctl + CW_CNT + (l * NE + F.tid) * 64, (unsigned)lcnt[F.tid], __ATOMIC_RELAXED, __HIP_MEMORY_SCOPE_AGENT);
    __syncthreads();
    unsigned* list = (unsigned*)(F.ws + WS_LIST); float* gwb = (float*)(F.ws + WS_GW);
    const int nrows = it * RB;
    for (int s = F.tid; s < nrows * NWAVES; s += NTHREADS) {
        const int i2 = s / NWAVES, w = s % NWAVES; const int m = F.vcu * NWAVES + w + i2 * NGW;
        const int e1 = rec[s * 4 + 0], e2 = rec[s * 4 + 1];
        list[(size_t)e1 * T + lcnt[16 + e1] + rec[s * 4 + 2]] = (unsigned)(2 * m); list[(size_t)e2 * T + lcnt[16 + e2] + rec[s * 4 + 3]] = (unsigned)(2 * m + 1);
        gwb[2 * m] = recw[s * 2]; gwb[2 * m + 1] = recw[s * 2 + 1];
    }
}
__device__ __forceinline__ const LAS int* moe_table(Frame& F, int l) {
    LAS int* tab = (LAS int*)(F.lds + MISC_OFF + 1024);
    __syncthreads();
    if (F.tid == 0) { int acc = 0;
        for (int e = 0; e < NE; ++e) { const int c = (int)__hip_atomic_load(F.ctl + CW_CNT + (l * NE + e) * 64, __ATOMIC_RELAXED, __HIP_MEMORY_SCOPE_AGENT); tab[e] = acc; tab[32 + e] = c; acc += (c + 255) >> 8; }
        tab[16] = acc; }
    __syncthreads();
    return tab;
}

typedef __attribute__((address_space(4))) const Args CArgs;
#define LAUNDER_GP(T_, p) do { GAS T_* _t = (GAS T_*)(p); asm volatile("" : "+s"(_t)); (p) = (T_*)_t; } while (0)
#define PH_BEGIN() LAUNDER_V(F.tid); F.lane = F.tid & 63; LAUNDER_GP(unsigned, F.ctl); LAUNDER_GP(float, F.OUT); LAUNDER_GP(unsigned char, F.ws); GAS unsigned char* ws = (GAS unsigned char*)F.ws; CArgs* ka = (CArgs*)__builtin_amdgcn_kernarg_segment_ptr(); LAUNDER_S(ka); \
    float* mod = WSP(float, WS_MOD); (void)mod; (void)ka
#define WSP(T_, off) ((T_*)(GAS T_*)(ws + (off)))
#define KIN(i) ((const float*)(GAS const float*)ka->in[i])
__global__ void __launch_bounds__(NTHREADS, 2) fwd_kernel(Args args) {
    extern __shared__ __attribute__((aligned(16))) unsigned char lds_raw[];
    Frame F;
    F.lds = (LAS unsigned char*)lds_raw; F.MISC = (volatile LAS unsigned*)(F.lds + MISC_OFF);
    F.tid = threadIdx.x; F.lane = F.tid & 63; F.wave = __builtin_amdgcn_readfirstlane(F.tid >> 6);
    F.G = gridDim.x; { const int bx = blockIdx.x; F.vcu = (F.G % 8 == 0) ? (bx % 8) * (F.G / 8) + bx / 8 : bx; }
    F.ws = (unsigned char*)(GAS unsigned char*)args.ws; F.ctl = (unsigned*)(GAS unsigned*)(args.ws + WS_CTL); F.OUT = (float*)(GAS float*)args.out;
    if (F.tid < 64) F.MISC[F.tid] = 0u;
    __syncthreads();
    XcdBarrier bar; bar.bar = F.ctl + CW_BAR; bar.x = 0; bar.st = nullptr;
    if (!N_LAUNCH_MODE) bar = xcd_barrier_post(F.ctl + CW_BAR, F.MISC + 8);
    const int lo = args.ph_lo, hi = args.ph_hi;
#define IN(k) (lo <= (k) && (k) < hi)
#define SEAM(k) do { if ((k) + 1 < hi) { if (!N_LAUNCH_MODE) xcd_barrier(bar); } } while (0)
    const int cidx = (int)blockIdx.x;

    if (IN(0)) { PH_BEGIN(); p0_phase(F, KIN(1), KIN(2), KIN(3)); __syncthreads(); LAUNDER_V(F.tid); F.lane = F.tid & 63; convert_weights(F, ka, 0); SEAM(0); }
    for (int l = 0; l < NL; ++l) {
        const int pb = 1 + 9 * l;
        if (IN(pb + 0)) {
            PH_BEGIN();
            if (l > 0) for (int rep = 0; rep < ((PROBE_DUP & 8) ? 2 : 1); ++rep) { LAUNDER_V(F.tid); F.lane = F.tid & 63; convert_weights(F, ka, l); }
            if (l == 0) row_phase<0>(F, KIN(0), nullptr, KIN(4) + l * D, mod + (size_t)l * NB * 6 * D, 0, D, WSP(bf16_t, WS_H), WSP(bf16_t, WS_XB), nullptr);
            else row_phase<1>(F, nullptr, mod + (size_t)(l - 1) * NB * 6 * D, KIN(4) + l * D, mod + (size_t)l * NB * 6 * D, 0, D, WSP(bf16_t, WS_H), WSP(bf16_t, WS_XB), nullptr);
            SEAM(pb + 0);
        }
        if (IN(pb + 1)) {
            PH_BEGIN();
            gp::Gemm g{WSP(bf16_t, WS_H), WSP(const bf16_t, WS_WIN), D, 0, nullptr}; gp::DenseOrder So; So.init(T, NIN, F.G, cidx);
            gp::EpiIn E{WSP(bf16_t, ATT_FP8_A ? WS_QA8 : WS_QA), WSP(bf16_t, ATT_FP8_A ? WS_KA8 : WS_KA), WSP(bf16_t, ATT_FP8_A ? WS_VTA8 : WS_VA), WSP(bf16_t, WS_QLAT), WSP(bf16_t, WS_KVLAT), WSP(bf16_t, ATT_FP8_B ? WS_KB8 : WS_KB), WSP(bf16_t, WS_SA), WSP(bf16_t, WS_SB), WSP(float, WS_SSQ), WSP(float, WS_SSKV),
                        KIN(6) + l * 64, KIN(7) + l * 64, WSP(const float, WS_COSA), WSP(const float, WS_SINA), WSP(const float, WS_COSB), WSP(const float, WS_SINB)};
            if (PROBE_DUP & 128) { gp::EpiNull En; gp::gemm_phase<gp::EpiNull, gp::DenseOrder>(F.tid, F.lds, g, So, En); LAUNDER_V(F.tid); }
            gp::gemm_phase<gp::EpiIn, gp::DenseOrder>(F.tid, F.lds, g, So, E); if (PROBE_DUP & (2 | 512)) { LAUNDER_V(F.tid); gp::gemm_phase<gp::EpiIn, gp::DenseOrder>(F.tid, F.lds, g, So, E); }
            SEAM(pb + 1);
        }
        if (IN(pb + 2)) {
            { PH_BEGIN(); gp::Gemm g{WSP(bf16_t, WS_QLAT), WSP(const bf16_t, WS_WQB), 384, 0, nullptr}; gp::DenseOrder So; So.init(T, 768, F.G, cidx);
              gp::EpiQb E{WSP(bf16_t, ATT_FP8_B ? WS_QB8 : WS_QB), WSP(const float, WS_SSQ), WSP(const float, WS_COSB), WSP(const float, WS_SINB)}; gp::gemm_phase<gp::EpiQb, gp::DenseOrder>(F.tid, F.lds, g, So, E); if (PROBE_DUP & 2) { LAUNDER_V(F.tid); gp::gemm_phase<gp::EpiQb, gp::DenseOrder>(F.tid, F.lds, g, So, E); } }
            { PH_BEGIN(); gp::Gemm g{WSP(bf16_t, WS_KVLAT), WSP(const bf16_t, WS_WKVB), 256, 0, nullptr}; gp::DenseOrder So; So.init(T, 1024, F.G, F.G - 1 - cidx);
              gp::EpiKvb E{WSP(bf16_t, ATT_FP8_B ? WS_KB8 : WS_KB), WSP(bf16_t, ATT_FP8_B ? WS_VTB8 : WS_VB), WSP(const float, WS_SSKV)}; gp::gemm_phase<gp::EpiKvb, gp::DenseOrder>(F.tid, F.lds, g, So, E); if (PROBE_DUP & 2) { LAUNDER_V(F.tid); gp::gemm_phase<gp::EpiKvb, gp::DenseOrder>(F.tid, F.lds, g, So, E); } }
            if (PROBE_DUP & 1) { PH_BEGIN(); const at::Tensors A{WSP(bf16_t, WS_QA), 512, WSP(bf16_t, WS_KA), 128, WSP(bf16_t, WS_VA), 128, WSP(bf16_t, WS_OB), 512, 4}; at::attn_phase<64>(F.tid, F.lds, A, F.vcu, F.G); }
#if FAST_ATTN && ATT_FP8_A
            { PH_BEGIN(); at::attn_phase_f8a(F.tid, F.lds, WSP(const unsigned char, WS_QA8), WSP(const unsigned char, WS_KA8), WSP(const unsigned char, WS_VTA8), WSP(bf16_t, WS_QA), 512, KIN(6) + l * 64, KIN(7) + l * 64, F.vcu, F.G); }
#else
            { PH_BEGIN(); const at::Tensors A{WSP(bf16_t, WS_QA), 512, WSP(bf16_t, WS_KA), 128, WSP(bf16_t, WS_VA), 128, WSP(bf16_t, WS_QA), 512, 4}; at::attn_phase<64>(F.tid, F.lds, A, F.vcu, F.G); }
#endif
            SEAM(pb + 2);
        }
        if (IN(pb + 3)) {
            PH_BEGIN();
#if FAST_ATTN && ATT_FP8_B
            at::attn_phase_f8b(F.tid, F.lds, WSP(const unsigned char, WS_QB8), WSP(const unsigned char, WS_KB8), WSP(const unsigned char, WS_VTB8), WSP(bf16_t, WS_OB), 512, F.vcu, F.G);
#else
            const at::Tensors A{WSP(bf16_t, WS_QB), 768, WSP(bf16_t, WS_KB), 768, WSP(bf16_t, WS_VB), 512, WSP(bf16_t, WS_OB), 512, 1}; for (int rep = 0; rep < ((PROBE_DUP & 1) ? 2 : 1); ++rep) at::attn_phase<96>(F.tid, F.lds, A, F.vcu, F.G);
#endif
            SEAM(pb + 3);
        }
        if (IN(pb + 4)) {
            PH_BEGIN();
            gp::Gemm g{WSP(bf16_t, WS_QA), WSP(const bf16_t, WS_WPA), 512, (size_t)(WS_WPB - WS_WPA) / 2, nullptr, (size_t)(WS_OB - WS_QA) / 2}; gp::PairOrder So; So.init(T, D, F.G, cidx);
            gp::EpiProjP E{WSP(bf16_t, WS_H), WSP(const unsigned char, WS_SA), WSP(const unsigned char, WS_SB)};
            gp::gemm_phase<gp::EpiProjP, gp::PairOrder>(F.tid, F.lds, g, So, E);
            if (PROBE_DUP & (2 | 1024)) { LAUNDER_V(F.tid); gp::gemm_phase<gp::EpiProjP, gp::PairOrder>(F.tid, F.lds, g, So, E); }
            SEAM(pb + 4);
        }
        if (IN(pb + 5)) {
            PH_BEGIN();
            gp::Gemm g{WSP(bf16_t, WS_H), WSP(const bf16_t, WS_WO), D, 0, nullptr}; gp::DenseOrder So; So.init(T, D, F.G, cidx);
            gp::EpiWo E{WSP(const bf16_t, WS_XB), mod + (size_t)l * NB * 6 * D, WSP(bf16_t, WS_XB)}; gp::gemm_phase<gp::EpiWo, gp::DenseOrder>(F.tid, F.lds, g, So, E);
            SEAM(pb + 5);
        }
        if (IN(pb + 6)) {
            PH_BEGIN();
            if (PROBE_DUP & 16) { t2_phase(F, KIN(15) + l * D, mod + (size_t)l * NB * 6 * D, KIN(16), KIN(17), l, false); LAUNDER_V(F.tid); F.lane = F.tid & 63; __syncthreads(); }
            t2_phase(F, KIN(15) + l * D, mod + (size_t)l * NB * 6 * D, KIN(16), KIN(17), l, true);
            SEAM(pb + 6);
        }
        if (IN(pb + 7)) {
            PH_BEGIN();
            const LAS int* tab = moe_table(F, l);
            gp::Gemm g{WSP(bf16_t, WS_H), WSP(const bf16_t, WS_W13), D, (size_t)1024 * D, WSP(const unsigned, WS_LIST)}; gp::MoeOrder So; So.init(tab, F.G, cidx);
            if (PROBE_DUP & 256) { gp::EpiNull En; gp::gemm_phase<gp::EpiNull, gp::MoeOrder, true>(F.tid, F.lds, g, So, En); LAUNDER_V(F.tid); }
            gp::EpiUp E{WSP(bf16_t, WS_ACT)}; gp::gemm_phase<gp::EpiUp, gp::MoeOrder, true>(F.tid, F.lds, g, So, E); if (PROBE_DUP & 4) { LAUNDER_V(F.tid); gp::gemm_phase<gp::EpiUp, gp::MoeOrder, true>(F.tid, F.lds, g, So, E); }
            SEAM(pb + 7);
        }
        if (IN(pb + 8)) {
            PH_BEGIN();
            const LAS int* tab = moe_table(F, l);
            gp::Gemm g{WSP(bf16_t, WS_ACT), WSP(const bf16_t, WS_W2), FF, (size_t)D * FF, nullptr}; gp::MoeOrder So; So.init(tab, F.G, cidx);
            gp::EpiDown E{WSP(bf16_t, WS_Y2), WSP(const unsigned, WS_LIST), WSP(const float, WS_GW)}; gp::gemm_phase<gp::EpiDown, gp::MoeOrder, false>(F.tid, F.lds, g, So, E); if (PROBE_DUP & 4) { LAUNDER_V(F.tid); gp::gemm_phase<gp::EpiDown, gp::MoeOrder, false>(F.tid, F.lds, g, So, E); }
            SEAM(pb + 8);
        }
    }
    if (IN(NPHASE - 1)) { PH_BEGIN(); row_phase<2>(F, nullptr, mod + (size_t)(NL - 1) * NB * 6 * D, KIN(21), nullptr, 0, 0, nullptr, WSP(bf16_t, WS_XB), F.OUT); }
#undef IN
#undef SEAM
}

extern "C" void kernel_launch(void* const* d_in, const int* in_sizes, int n_in, void* d_out, int out_size, void* d_ws, size_t ws_size, hipStream_t stream) {
    static int grid = 0;
    if (grid == 0) {
        if (n_in != 22 || out_size != T * D || ws_size < WS_END) { fprintf(stderr, "kernel_launch: unexpected problem (n_in %d out %d ws %zu)\n", n_in, out_size, ws_size); grid = -1; return; }
        int dev = 0, cus = 0, per_cu = 0;
        if (hipGetDevice(&dev) != hipSuccess || hipDeviceGetAttribute(&cus, hipDeviceAttributeMultiprocessorCount, dev) != hipSuccess) { grid = -1; return; }
        if (hipFuncSetAttribute((const void*)fwd_kernel, hipFuncAttributeMaxDynamicSharedMemorySize, LDS_BYTES) != hipSuccess) { grid = -1; return; }
        if (hipOccupancyMaxActiveBlocksPerMultiprocessor(&per_cu, (const void*)fwd_kernel, NTHREADS, LDS_BYTES) != hipSuccess || per_cu < 1) { fprintf(stderr, "kernel_launch: occupancy query says %d\n", per_cu); }
        (void)hipGetLastError();
        grid = cus;
        if (T % (grid * NWAVES * 4) != 0) { fprintf(stderr, "kernel_launch: grid %d does not divide the row phases\n", grid); grid = -1; return; }
    }
    if (grid < 0) return;
    (void)hipMemsetAsync((char*)d_ws + WS_CTL, 0, CTL_BYTES, stream);
    Args a{};
    for (int i = 0; i < 22; ++i) a.in[i] = (const float*)d_in[i];
    a.out = (float*)d_out; a.ws = (unsigned char*)d_ws;
#if N_LAUNCH_MODE
    for (int p = 0; p < NPHASE; ++p) { a.ph_lo = p; a.ph_hi = p + 1; hipLaunchKernelGGL(fwd_kernel, dim3(grid), dim3(NTHREADS), LDS_BYTES, stream, a); }
#else
    a.ph_lo = 0; a.ph_hi = NPHASE;
    hipLaunchKernelGGL(fwd_kernel, dim3(grid), dim3(NTHREADS), LDS_BYTES, stream, a);
#endif
}
```

```cpp
#include <hip/hip_runtime.h>
#include <stdint.h>
#include <stdio.h>
#include <math.h>

#ifndef FAST_GEMM
#define FAST_GEMM 1
#endif
#ifndef FAST_ATTN
#define FAST_ATTN 1
#endif
#ifndef PROBE_DUP
#define PROBE_DUP 0
#endif
#ifndef PROBE_ATT
#define PROBE_ATT 0
#endif
#ifndef ATT_REGSTAGE
#define ATT_REGSTAGE 0
#endif
#ifndef WT_STORES
#define WT_STORES 0
#endif
#ifndef ATT_FP8_A
#define ATT_FP8_A 1
#endif
#ifndef ATT_FP8_B
#define ATT_FP8_B 1
#endif
#ifndef N_LAUNCH_MODE
#define N_LAUNCH_MODE 0
#endif

#define LAS __attribute__((address_space(3)))
#define GAS __attribute__((address_space(1)))
typedef unsigned short bf16_t;
typedef short bf16x8 __attribute__((ext_vector_type(8)));
typedef float f32x4 __attribute__((ext_vector_type(4)));
typedef float f32x2 __attribute__((ext_vector_type(2)));
typedef float f32x16 __attribute__((ext_vector_type(16)));
typedef unsigned u32x4 __attribute__((ext_vector_type(4)));
typedef unsigned u32x2 __attribute__((ext_vector_type(2)));
typedef GAS unsigned gu32;

constexpr int D = 1024, NB = 8, S = 4096, T = NB * S, NL = 4, INC = 3488, NIN = 3584, NE = 16, FF = 512;
constexpr float EPS = 1e-6f, LOG2E = 1.4426950408889634f;
constexpr float QSCALE_A = 0.125f * LOG2E, QSCALE_B = 0.10206207261596577f * LOG2E;
constexpr int NWAVES = 8, NTHREADS = 512;
constexpr int NPHASE = 2 + 9 * NL;

constexpr size_t MiB = 1u << 20;
constexpr size_t WS_CTL = 0, CTL_BYTES = 1 * MiB;
constexpr size_t WS_MOD = 1 * MiB;
constexpr size_t WS_COSA = 2 * MiB, WS_SINA = WS_COSA + 512 * 1024, WS_COSB = 3 * MiB, WS_SINB = WS_COSB + 256 * 1024;
constexpr size_t WS_SSQ = 4 * MiB, WS_SSKV = 5 * MiB;
constexpr size_t WS_GW = 6 * MiB;
constexpr size_t WS_LIST = 7 * MiB;
constexpr size_t WS_WIN = 10 * MiB, WS_WQB = 17 * MiB, WS_WKVB = 18 * MiB, WS_WPA = 19 * MiB, WS_WPB = 20 * MiB, WS_WO = 21 * MiB, WS_W13 = 23 * MiB, WS_W2 = 55 * MiB;
constexpr size_t WS_H = 72 * MiB;
constexpr size_t WS_QA = 136 * MiB, WS_KA = 168 * MiB, WS_VA = 176 * MiB, WS_QLAT = 184 * MiB, WS_KVLAT = 208 * MiB;
constexpr size_t WS_KB = 224 * MiB, WS_VB = 272 * MiB, WS_QB = 304 * MiB, WS_OB = 352 * MiB, WS_SA = 384 * MiB, WS_SB = 448 * MiB, WS_XB = 512 * MiB, WS_QA8 = 576 * MiB, WS_KA8 = 592 * MiB, WS_VTA8 = 596 * MiB, WS_QB8 = 600 * MiB, WS_KB8 = 624 * MiB, WS_VTB8 = 648 * MiB, WS_END = 664 * MiB;
constexpr size_t WS_ACT = 136 * MiB, WS_Y2 = 208 * MiB;
constexpr int ACT_ROWS = 2 * T + NE * 256;
static_assert(WS_ACT + (size_t)ACT_ROWS * FF * 2 <= WS_Y2 && WS_Y2 + (size_t)2 * T * D * 2 <= WS_XB, "moe overlay");
constexpr int CW_BAR = 4096;
constexpr int CW_CNT = 16384;

constexpr int RING_BYTES = 131072, MISC_OFF = RING_BYTES, LDS_BYTES = 147456;

__device__ __forceinline__ float bf2f(unsigned v) { return __uint_as_float(v << 16); }
typedef __bf16 bf16x2_t __attribute__((ext_vector_type(2)));
__device__ __forceinline__ unsigned cvt_pk_bf16(float lo, float hi) { f32x2 v = {lo, hi}; bf16x2_t b = __builtin_convertvector(v, bf16x2_t); return __builtin_bit_cast(unsigned, b); }
__device__ __forceinline__ u32x4 pack8(f32x4 a, f32x4 b) { u32x4 w; w.x = cvt_pk_bf16(a[0], a[1]); w.y = cvt_pk_bf16(a[2], a[3]); w.z = cvt_pk_bf16(b[0], b[1]); w.w = cvt_pk_bf16(b[2], b[3]); return w; }
__device__ __forceinline__ u32x2 pack8_fp8(f32x4 a, f32x4 b) { u32x2 w;
    w.x = (unsigned)__builtin_amdgcn_cvt_pk_fp8_f32(a[2], a[3], __builtin_amdgcn_cvt_pk_fp8_f32(a[0], a[1], 0, false), true);
    w.y = (unsigned)__builtin_amdgcn_cvt_pk_fp8_f32(b[2], b[3], __builtin_amdgcn_cvt_pk_fp8_f32(b[0], b[1], 0, false), true); return w; }
__device__ __forceinline__ void unpack8(u32x4 w, f32x4& a, f32x4& b) { a[0] = bf2f(w.x & 0xffffu); a[1] = bf2f(w.x >> 16); a[2] = bf2f(w.y & 0xffffu); a[3] = bf2f(w.y >> 16); b[0] = bf2f(w.z & 0xffffu); b[1] = bf2f(w.z >> 16); b[2] = bf2f(w.w & 0xffffu); b[3] = bf2f(w.w >> 16); }
__device__ __forceinline__ float wave_sum(float v) {
#pragma unroll
    for (int o = 1; o < 64; o <<= 1) v += __shfl_xor(v, o);
    return v;
}
__device__ __forceinline__ float sigm(float v) { return __builtin_amdgcn_rcpf(1.f + __builtin_amdgcn_exp2f(v * (-LOG2E))); }
#if WT_STORES
__device__ __forceinline__ void st16(void* p, u32x4 v) { asm volatile("global_store_dwordx4 %0, %1, off sc1\n\ts_nop 1" :: "v"(p), "v"(v) : "memory"); }
__device__ __forceinline__ void st8(void* p, u32x2 v) { asm volatile("global_store_dwordx2 %0, %1, off sc1\n\ts_nop 1" :: "v"(p), "v"(v) : "memory"); }
#else
__device__ __forceinline__ void st16(void* p, u32x4 v) { *(u32x4*)p = v; }
__device__ __forceinline__ void st8(void* p, u32x2 v) { *(u32x2*)p = v; }
#endif
#define VM_WAIT() asm volatile("s_waitcnt vmcnt(0)" ::: "memory")
#define LAUNDER_S(p) asm volatile("" : "+s"(p))
#define LAUNDER_V(v) asm volatile("" : "+v"(v))
#define LDS_WAIT() asm volatile("s_waitcnt lgkmcnt(0)" ::: "memory")

#define XB_TMO      128
#define XB_XCNT(j)  (256  + 64 * (j))
#define XB_XSUB(j)  (1280 + 64 * (j))
#define XB_XGEN(j)  (2304 + 64 * (j))
#define XB_TOP      3328
#define XB_TOPGEN   3392
#define XCD_BAR_WORDS 3456
#define XB_SPIN_CAP (1u << 22)
__device__ __forceinline__ unsigned xb_ld(unsigned* p)              { return __hip_atomic_load(p, __ATOMIC_RELAXED, __HIP_MEMORY_SCOPE_AGENT); }
__device__ __forceinline__ unsigned xb_add(unsigned* p, unsigned v) { return __hip_atomic_fetch_add(p, v, __ATOMIC_RELAXED, __HIP_MEMORY_SCOPE_AGENT); }
__device__ __forceinline__ unsigned xb_xcc_id() { return (unsigned)__builtin_amdgcn_s_getreg((3 << 11) | 20) & 0xFu; }
#define XB_SPIN(cond, bar) do { unsigned _sp = 0; while (cond) { __builtin_amdgcn_s_sleep(1); \
    if ((++_sp & 255u) == 0u) { if (xb_ld(&(bar)[XB_TMO])) break; if (_sp > XB_SPIN_CAP) { atomicAdd(&(bar)[XB_TMO], 1u); break; } } } } while (0)
struct XcdBarrier { unsigned* bar; unsigned x; volatile LAS unsigned* st; };
__device__ __forceinline__ XcdBarrier xcd_barrier_post(unsigned* bar, volatile LAS unsigned* st) {
    XcdBarrier b; b.bar = bar; b.x = xb_xcc_id(); b.st = st;
    if (threadIdx.x == 0) (void)xb_add(&bar[XB_XCNT(b.x)], 1u);
    return b;
}
__device__ __forceinline__ void xcd_barrier_complete(unsigned* bar, unsigned x, unsigned& nloc, unsigned& nx) {
    const unsigned G = gridDim.x * gridDim.y * gridDim.z;
    unsigned sum, cnt, mine, sp = 0u;
    for (;;) {
        sum = 0u; cnt = 0u; mine = 0u;
#pragma unroll
        for (unsigned j = 0; j < 16; ++j) { const unsigned c = xb_ld(&bar[XB_XCNT(j)]); sum += c; cnt += (c > 0u) ? 1u : 0u; mine = (j == x) ? c : mine; }
        if (sum == G) break;
        __builtin_amdgcn_s_sleep(1);
        if ((++sp & 255u) == 0u) { if (xb_ld(&bar[XB_TMO])) break; if (sp > XB_SPIN_CAP) { atomicAdd(&bar[XB_TMO], 1u); break; } }
    }
    nloc = mine > 0u ? mine : 1u; nx = cnt > 0u ? cnt : 1u;
}
__device__ __forceinline__ void xcd_barrier(const XcdBarrier& b) {
    asm volatile("s_waitcnt vmcnt(0)" ::: "memory");
    __syncthreads();
    if (threadIdx.x == 0) {
        unsigned* bar = b.bar;
        __builtin_amdgcn_s_waitcnt(0);
        unsigned nloc = b.st[0], nx = b.st[1];
        if (nloc == 0u) { xcd_barrier_complete(bar, b.x, nloc, nx); b.st[0] = nloc; b.st[1] = nx; }
        const unsigned old = xb_add(&bar[XB_XSUB(b.x)], 1u);
        const unsigned gen = old / nloc;
        if (old + 1u == (gen + 1u) * nloc) {
            __builtin_amdgcn_fence(__ATOMIC_RELEASE, "agent");
            asm volatile("s_waitcnt vmcnt(0)" ::: "memory");
            const unsigned og = xb_add(&bar[XB_TOP], 1u);
            const unsigned tg = og / nx;
            if (og + 1u == (tg + 1u) * nx) xb_add(&bar[XB_TOPGEN], 1u);
            else XB_SPIN(xb_ld(&bar[XB_TOPGEN]) == tg, bar);
            __builtin_amdgcn_fence(__ATOMIC_ACQUIRE, "agent");
            xb_add(&bar[XB_XGEN(b.x)], 1u);
            asm volatile("s_waitcnt vmcnt(0)" ::: "memory");
        } else {
            XB_SPIN(xb_ld(&bar[XB_XGEN(b.x)]) == gen, bar);
            __builtin_amdgcn_fence(__ATOMIC_ACQUIRE, "agent");
            asm volatile("s_waitcnt vmcnt(0)" ::: "memory");
        }
    }
    __syncthreads();
}

namespace gp {
constexpr int BM = 256, BK = 64, HALF = 128, HTB = HALF * BK * 2, NXCD = 8, WGM = 8;
__host__ __device__ __forceinline__ int lds_byte(int r, int c) { const int st = (r >> 4) * 2 + (c >> 5), rr = r & 15, cc = c & 31, ob = rr * 64 + cc * 2; return st * 1024 + (ob ^ (((ob >> 9) & 1) << 5)); }
__host__ __device__ __forceinline__ void stage_rc(int b, int& R, int& C) { const int st = b / 1024, sb = b % 1024, swz = sb ^ (((sb >> 9) & 1) << 5); R = (st >> 1) * 16 + swz / 64; C = (st & 1) * 32 + (swz % 64) / 2; }
__host__ __device__ __forceinline__ int perm32(int rho) { const int n = rho >> 4, i = rho & 15; return 8 * (i >> 2) + 4 * n + (i & 3); }

struct Unit { int pm, pn, be, rl, nv; };
struct Gemm { const bf16_t* A; const bf16_t* Bt; int K; size_t bstride; const unsigned* list; size_t astride; };

__device__ __forceinline__ int xcd_remap(int wgid, int nwg) { const int q = nwg / NXCD, r = nwg % NXCD, xcd = wgid % NXCD, off = wgid / NXCD; return (xcd < r ? xcd * (q + 1) : r * (q + 1) + (xcd - r) * q) + off; }
struct DenseOrder {
    int nM, nN, nwg, G, c;
    __device__ void init(int M, int N, int G_, int c_) { nM = M / BM; nN = N / BM; nwg = nM * nN; G = G_; c = c_; }
    __device__ bool next(int i, Unit& u) const {
        const long L = (long)i * G + c; if (L >= nwg) return false;
        const int wgid = xcd_remap((int)L, nwg);
        const int nig = WGM * nN, gid = wgid / nig, fm = gid * WGM, gsz = (nM - fm) < WGM ? (nM - fm) : WGM;
        u.pm = fm + ((wgid % nig) % gsz); u.pn = (wgid % nig) / gsz; u.be = 0; u.rl = 0; u.nv = 256; return true;
    }
};
struct PairOrder {
    DenseOrder d;
    __device__ void init(int M, int N, int G_, int c_) { d.init(M, N, G_, c_); }
    __device__ bool next(int i, Unit& u) const { if (!d.next(i >> 1, u)) return false; u.be = i & 1; return true; }
};
struct MoeOrder {
    const LAS int* tab; int nwg, G, c;
    __device__ static int rd(const LAS int* p) { return __builtin_amdgcn_readfirstlane(*p); }
    __device__ void init(const LAS int* tab_, int G_, int c_) { tab = tab_; nwg = rd(tab_ + 16) * 4; G = G_; c = c_; }
    __device__ bool next(int i, Unit& u) const {
        const long L = (long)i * G + c; if (L >= nwg) return false;
        const int wgid = xcd_remap((int)L, nwg);
        const int tile = wgid >> 2; int e = 0;
        for (int k = 1; k < NE; ++k) e += (rd(tab + k) <= tile) ? 1 : 0;
        u.pm = tile; u.pn = wgid & 3; u.be = e; u.rl = tile - rd(tab + e); const int rem = rd(tab + 32 + e) - u.rl * 256; u.nv = rem < 256 ? rem : 256; return true;
    }
};

#define ACC_T f32x4 (&acc)[2][2][4][2]

template <class Epi, class Sched, bool GATHER>
__device__ __forceinline__ void gemm_phase_ref(int tid, const Gemm g, const Sched& S, const Epi& E) {
    const int wid = __builtin_amdgcn_readfirstlane(tid >> 6), lane = tid & 63, wr = wid >> 2, wc = wid & 3, fr = lane & 15, fq = lane >> 4;
    const int K = g.K; Unit u;
    for (int ui = 0; S.next(ui, u); ++ui) {
        f32x4 acc[2][2][4][2];
#pragma unroll
        for (int a = 0; a < 2; ++a)
#pragma unroll
            for (int b = 0; b < 2; ++b)
#pragma unroll
                for (int m = 0; m < 4; ++m)
#pragma unroll
                    for (int n = 0; n < 2; ++n) acc[a][b][m][n] = (f32x4){0.f, 0.f, 0.f, 0.f};
        const bf16_t* Bt = g.Bt + (size_t)u.be * g.bstride + (size_t)u.pn * 256 * K;
        for (int ai = 0; ai < 2; ++ai)
            for (int m = 0; m < 4; ++m) {
                const int rloc = ai * 128 + wr * 64 + m * 16 + fr;
                size_t arow;
                if (GATHER) { arow = (rloc < u.nv) ? (size_t)(g.list[(size_t)u.be * T + u.rl * 256 + rloc] >> 1) : 0; }
                else arow = (size_t)u.pm * 256 + rloc;
                const bf16_t* ap = g.A + arow * K;
                for (int bj = 0; bj < 2; ++bj) {
                    const bf16_t* bp = Bt + (size_t)(bj * 128 + wc * 32 + fq * 8) * K;
                    float s[8];
#pragma unroll
                    for (int c = 0; c < 8; ++c) {
                        float sc = 0.f; const bf16_t* bpc = bp + (size_t)c * K;
#pragma unroll 2
                        for (int k = 0; k < K; k += 8) {
                            f32x4 a0, a1, b0, b1; unpack8(*(const u32x4*)(ap + k), a0, a1); unpack8(*(const u32x4*)(bpc + k), b0, b1);
                            sc += a0[0] * b0[0] + a0[1] * b0[1] + a0[2] * b0[2] + a0[3] * b0[3] + a1[0] * b1[0] + a1[1] * b1[1] + a1[2] * b1[2] + a1[3] * b1[3];
                        }
                        s[c] = sc; asm volatile("" : "+v"(s[c]));
                    }
#pragma unroll
                    for (int a2 = 0; a2 < 2; ++a2)
#pragma unroll
                        for (int b2 = 0; b2 < 2; ++b2)
#pragma unroll
                            for (int m2 = 0; m2 < 4; ++m2)
                                if (a2 == ai && b2 == bj && m2 == m) { acc[a2][b2][m2][0] = (f32x4){s[0], s[1], s[2], s[3]}; acc[a2][b2][m2][1] = (f32x4){s[4], s[5], s[6], s[7]}; }
                }
            }
        E(acc, u, wr, wc, fr, fq);
    }
}

template <class E> struct EpiTraits { static constexpr bool KEEP = false; };
#if FAST_GEMM
template <class Epi, class Sched, bool GATHER>
__device__ __forceinline__ void gemm_phase_fast(int tid, LAS unsigned char* lds, const Gemm g, const Sched& S, const Epi& E) {
    const int wid = __builtin_amdgcn_readfirstlane(tid >> 6), lane = tid & 63, wr = wid >> 2, wc = wid & 3, fr = lane & 15, fq = lane >> 4;
    const int K = g.K, nt = K / BK;
    int Rr[2], Cc[2]; unsigned voffB[2];
#pragma unroll
    for (int i = 0; i < 2; ++i) { stage_rc(tid * 16 + i * 8192, Rr[i], Cc[i]); const int Rb = (Rr[i] & ~31) + perm32(Rr[i] & 31); voffB[i] = (unsigned)(Rb * K + Cc[i]) * 2u; }
    const size_t kstep = (size_t)(BK * 2), hstep = (size_t)HALF * K * 2, tstep = 2 * hstep;
    const unsigned ldsw = (unsigned)wid * 1024u;
    const int aoff = lds_byte(wr * 64 + fr, fq * 8), boff = lds_byte(wc * 32 + fr, fq * 8);
#define GP_SA(b, h) (((b) * 2 + (h)) * HTB)
#define GP_SB(b, h) ((4 + (b) * 2 + (h)) * HTB)
#define GP_STAGE2(bufoff, gbase, v0, v1) do { \
        __builtin_amdgcn_global_load_lds((const unsigned*)((const char*)(gbase) + (v0)), (LAS unsigned*)(lds + (bufoff) + ldsw), 16, 0, 0); \
        __builtin_amdgcn_global_load_lds((const unsigned*)((const char*)(gbase) + (v1)), (LAS unsigned*)(lds + (bufoff) + ldsw + 8192), 16, 0, 0); } while (0)
#define GP_STAGEB(bufoff, gbase) GP_STAGE2(bufoff, gbase, voffB[0], voffB[1])
#define GP_LDA(dst, b, h) do { _Pragma("unroll") for (int m = 0; m < 4; ++m) _Pragma("unroll") for (int k = 0; k < 2; ++k) dst[m][k] = *(const LAS bf16x8*)(lds + GP_SA(b, h) + aoff + m * 2048 + k * 1024); } while (0)
#define GP_LDB(dst, b, h) do { _Pragma("unroll") for (int n = 0; n < 2; ++n) _Pragma("unroll") for (int k = 0; k < 2; ++k) dst[n][k] = *(const LAS bf16x8*)(lds + GP_SB(b, h) + boff + n * 2048 + k * 1024); } while (0)
#define GP_MMA(ai, bj, At, Bt) do { __builtin_amdgcn_s_setprio(1); _Pragma("unroll") for (int m = 0; m < 4; ++m) _Pragma("unroll") for (int n = 0; n < 2; ++n) _Pragma("unroll") for (int k = 0; k < 2; ++k) \
        acc[ai][bj][m][n] = __builtin_amdgcn_mfma_f32_16x16x32_bf16(Bt[n][k], At[m][k], acc[ai][bj][m][n], 0, 0, 0); __builtin_amdgcn_s_setprio(0); } while (0)
#define GP_WAIT_V(n) asm volatile("s_waitcnt vmcnt(" #n ")" ::: "memory")
#define GP_WAIT_L(n) asm volatile("s_waitcnt lgkmcnt(" #n ")" ::: "memory")
#define GP_BAR __builtin_amdgcn_s_barrier()
#define GP_SCHED __builtin_amdgcn_sched_barrier(0)
    Unit cur, nxt; int ui = 0;
    if (!S.next(0, cur)) return;
    f32x4 acc[2][2][4][2];
#pragma unroll
    for (int a = 0; a < 2; ++a)
#pragma unroll
        for (int b = 0; b < 2; ++b)
#pragma unroll
            for (int m = 0; m < 4; ++m)
#pragma unroll
                for (int n = 0; n < 2; ++n) acc[a][b][m][n] = (f32x4){0.f, 0.f, 0.f, 0.f};
    bf16x8 At[4][2], B0[2][2], B1[2][2];
    unsigned vC0, vC1, vC2, vC3, vN0, vN1, vN2, vN3;
#define GP_VOFF(u, o0, o1, o2, o3) do { if (GATHER) { \
        int tl_ = tid; LAUNDER_V(tl_); int R0_, C0_, R1_, C1_; stage_rc(tl_ * 16, R0_, C0_); stage_rc(tl_ * 16 + 8192, R1_, C1_);     \
        const unsigned* lp = g.list + (size_t)(u).be * T + (u).rl * 256; \
        const int nvm = (u).nv - 1; const int p0 = min(R0_, nvm), p1 = min(R1_, nvm), p2 = min(128 + R0_, nvm), p3 = min(128 + R1_, nvm); \
        const unsigned t0 = lp[p0] >> 1, t1 = lp[p1] >> 1, t2 = lp[p2] >> 1, t3 = lp[p3] >> 1; \
        o0 = (t0 * K + C0_) * 2u; o1 = (t1 * K + C1_) * 2u; o2 = (t2 * K + C0_) * 2u; o3 = (t3 * K + C1_) * 2u; \
      } else { o0 = (unsigned)(Rr[0] * K + Cc[0]) * 2u; o1 = (unsigned)(Rr[1] * K + Cc[1]) * 2u; o2 = o0 + (unsigned)hstep; o3 = o1 + (unsigned)hstep; } } while (0)
    GP_VOFF(cur, vC0, vC1, vC2, vC3);
    const char* cA = (const char*)g.A + ((size_t)cur.be * g.astride) * 2 + (GATHER ? (size_t)0 : (size_t)cur.pm * tstep);
    const char* cB = (const char*)g.Bt + ((size_t)cur.be * g.bstride) * 2 + (size_t)cur.pn * tstep;
    GP_STAGEB(GP_SB(0, 0), cB); GP_STAGEB(GP_SB(0, 1), cB + hstep); GP_STAGE2(GP_SA(0, 0), cA, vC0, vC1); GP_STAGE2(GP_SA(0, 1), cA, vC2, vC3);
    if (wr == 1) GP_BAR;
    GP_WAIT_V(2); GP_BAR;
    GP_STAGEB(GP_SB(1, 0), cB + kstep); GP_STAGE2(GP_SA(1, 0), cA + kstep, vC0, vC1); GP_STAGEB(GP_SB(1, 1), cB + hstep + kstep);
    GP_WAIT_V(6); GP_BAR;
    for (;;) {
        const bool has_next = S.next(ui + 1, nxt);
        const char* nA = has_next ? (const char*)g.A + ((size_t)nxt.be * g.astride) * 2 + (GATHER ? (size_t)0 : (size_t)nxt.pm * tstep) : cA;
        const char* nB = has_next ? (const char*)g.Bt + ((size_t)nxt.be * g.bstride) * 2 + (size_t)nxt.pn * tstep : cB;
        if (has_next) { GP_VOFF(nxt, vN0, vN1, vN2, vN3); } else { vN0 = vC0; vN1 = vC1; vN2 = vC2; vN3 = vC3; }
#pragma nounroll
        for (int t = 0; t < nt; t += 2) {
            const bool last = (t == nt - 2);
            const char* a1 = cA + (size_t)(t + 1) * kstep;
            const char* a2 = last ? nA : cA + (size_t)(t + 2) * kstep; const char* b2 = last ? nB : cB + (size_t)(t + 2) * kstep;
            const char* a3 = a2 + kstep; const char* b3 = b2 + kstep;
            const unsigned w0 = last ? vN0 : vC0, w1 = last ? vN1 : vC1, w2 = last ? vN2 : vC2, w3 = last ? vN3 : vC3;
            GP_LDB(B0, 0, 0); GP_LDB(B1, 0, 1); GP_SCHED; GP_LDA(At, 0, 0); GP_STAGE2(GP_SA(1, 1), a1, vC2, vC3);
            GP_WAIT_V(8); GP_WAIT_L(0); GP_BAR; GP_MMA(0, 0, At, B0); GP_MMA(0, 1, At, B1); GP_BAR; GP_SCHED;
            GP_LDA(At, 0, 1); GP_STAGEB(GP_SB(0, 0), b2); GP_STAGEB(GP_SB(0, 1), b2 + hstep); GP_STAGE2(GP_SA(0, 0), a2, w0, w1);
            GP_WAIT_V(8); GP_WAIT_L(0); GP_BAR; GP_MMA(1, 0, At, B0); GP_MMA(1, 1, At, B1); GP_BAR; GP_SCHED;
            GP_LDB(B0, 1, 0); GP_LDB(B1, 1, 1); GP_SCHED; GP_LDA(At, 1, 0); GP_STAGE2(GP_SA(0, 1), a2, w2, w3);
            GP_WAIT_V(8); GP_WAIT_L(0); GP_BAR; GP_MMA(0, 0, At, B0); GP_MMA(0, 1, At, B1); GP_BAR; GP_SCHED;
            GP_LDA(At, 1, 1); GP_STAGEB(GP_SB(1, 0), b3); GP_STAGEB(GP_SB(1, 1), b3 + hstep); GP_STAGE2(GP_SA(1, 0), a3, w0, w1);
            GP_WAIT_V(8); GP_WAIT_L(0); GP_BAR; GP_MMA(1, 0, At, B0); GP_MMA(1, 1, At, B1); GP_BAR; GP_SCHED;
        }
        if (wr == 0) GP_BAR;
        E(acc, cur, wr, wc, fr, fq);
        if (!has_next) break;
        if (!(EpiTraits<Epi>::KEEP && cur.be == 0)) {
#pragma unroll
        for (int a = 0; a < 2; ++a)
#pragma unroll
            for (int b = 0; b < 2; ++b)
#pragma unroll
                for (int m = 0; m < 4; ++m)
#pragma unroll
                    for (int n = 0; n < 2; ++n) acc[a][b][m][n] = (f32x4){0.f, 0.f, 0.f, 0.f};
        }
        cur = nxt; cA = nA; cB = nB; vC0 = vN0; vC1 = vN1; vC2 = vN2; vC3 = vN3; ++ui;
        if (wr == 1) GP_BAR;
    }
    GP_WAIT_V(0);
    GP_BAR;
#undef GP_SA
#undef GP_SB
#undef GP_STAGE2
#undef GP_STAGEB
#undef GP_LDA
#undef GP_LDB
#undef GP_MMA
#undef GP_WAIT_V
#undef GP_WAIT_L
#undef GP_BAR
#undef GP_SCHED
#undef GP_VOFF
}
#endif

template <class Epi, class Sched, bool GATHER = false>
__device__ __forceinline__ void gemm_phase(int tid, LAS unsigned char* lds, const Gemm g, const Sched& S, const Epi& E) {
#if FAST_GEMM
    gemm_phase_fast<Epi, Sched, GATHER>(tid, lds, g, S, E);
#else
    (void)lds; gemm_phase_ref<Epi, Sched, GATHER>(tid, g, S, E);
#endif
}

#define EPI_ROW(ai, m) (u.pm * 256 + (ai) * 128 + wr * 64 + (m) * 16 + fr)
#define EPI_COL(bj) (u.pn * 256 + (bj) * 128 + wc * 32 + fq * 8)
__device__ __forceinline__ float dot4(f32x4 a) { return (a[0] * a[0] + a[1] * a[1]) + (a[2] * a[2] + a[3] * a[3]); }

struct EpiNull {
    __device__ __forceinline__ void operator()(const ACC_T, const Unit& u, int wr, int wc, int fr, int fq) const {
#pragma unroll
        for (int ai = 0; ai < 2; ++ai)
#pragma unroll
            for (int bj = 0; bj < 2; ++bj)
#pragma unroll
                for (int m = 0; m < 4; ++m) asm volatile("" :: "v"(acc[ai][bj][m][0]), "v"(acc[ai][bj][m][1]));
    }
};
struct EpiIn {
    bf16_t *QA, *KA, *VA, *QLAT, *KVLAT, *KB, *SA, *SB; float *SSQ, *SSKV; const float *gq, *gk, *cosA, *sinA, *cosB, *sinB;
    __device__ __forceinline__ void operator()(const ACC_T, const Unit& u, int wr, int wc, int fr, int fq) const {
        const int wb = u.pn * 4 + wc;
        if (wb < 10) {
            const bool isq = wb < 8; const int head = isq ? wb : wb - 8; const float* g = isq ? gq : gk; bf16_t* dst = isq ? QA : KA; const int dp = isq ? 512 : 128; const float qs = isq ? QSCALE_A : 1.f;
            const f32x4 g00 = *(const f32x4*)(g + 8 * fq), g01 = *(const f32x4*)(g + 8 * fq + 4), g10 = *(const f32x4*)(g + 32 + 8 * fq), g11 = *(const f32x4*)(g + 36 + 8 * fq);
#pragma unroll
            for (int ai = 0; ai < 2; ++ai)
#pragma unroll
                for (int m = 0; m < 4; ++m) {
                    const int r = EPI_ROW(ai, m), pos = r & (S - 1);
                    const f32x4 v00 = acc[ai][0][m][0], v01 = acc[ai][0][m][1], v10 = acc[ai][1][m][0], v11 = acc[ai][1][m][1];
                    float ss = (dot4(v00) + dot4(v01)) + (dot4(v10) + dot4(v11)); ss += __shfl_xor(ss, 16); ss += __shfl_xor(ss, 32);
                    const float rstd = rsqrtf(ss * (1.f / 64.f) + EPS);
                    const f32x4 y00 = v00 * rstd * g00, y01 = v01 * rstd * g01, y10 = v10 * rstd * g10, y11 = v11 * rstd * g11;
                    const f32x4 c0 = *(const f32x4*)(cosA + pos * 32 + 8 * fq), c1 = *(const f32x4*)(cosA + pos * 32 + 8 * fq + 4), s0 = *(const f32x4*)(sinA + pos * 32 + 8 * fq), s1 = *(const f32x4*)(sinA + pos * 32 + 8 * fq + 4);
                    const f32x4 o00 = (y00 * c0 - y10 * s0) * qs, o01 = (y01 * c1 - y11 * s1) * qs, o10 = (y10 * c0 + y00 * s0) * qs, o11 = (y11 * c1 + y01 * s1) * qs;
#if ATT_FP8_A
                    unsigned char* p8 = (unsigned char*)dst + (size_t)r * dp + head * 64 + 8 * fq;
                    st8(p8, pack8_fp8(o00, o01)); st8(p8 + 32, pack8_fp8(o10, o11));
#else
                    bf16_t* p = dst + (size_t)r * dp + head * 64 + 8 * fq;
                    st16(p, pack8(o00, o01)); st16((p + 32), pack8(o10, o11));
#endif
                }
        } else if (wb < 12) {
#pragma unroll
            for (int ai = 0; ai < 2; ++ai)
#pragma unroll
                for (int m = 0; m < 4; ++m) {
#if ATT_FP8_A
                    const int r = EPI_ROW(ai, m), sq = r & (S - 1), k = sq & 63, pos = 32 * ((k >> 2) & 1) + 16 * (k >> 5) + (k & 3) + 4 * ((k & 31) >> 3);
                    unsigned char* vtb = (unsigned char*)VA; const unsigned vo = (unsigned)(((r >> 12) * 2 + (wb - 10)) * 64 + 8 * fq) * S + (unsigned)((sq & ~63) + pos);
#pragma unroll
                    for (int bj = 0; bj < 2; ++bj)
#pragma unroll
                        for (int n = 0; n < 2; ++n) { const f32x4 x = acc[ai][bj][m][n]; const unsigned w = (unsigned)__builtin_amdgcn_cvt_pk_fp8_f32(x[2], x[3], __builtin_amdgcn_cvt_pk_fp8_f32(x[0], x[1], 0, false), true);
                            const unsigned qo = vo + (unsigned)(bj * 32 + 4 * n) * S;
                            vtb[qo] = (unsigned char)(w & 0xffu); vtb[qo + S] = (unsigned char)((w >> 8) & 0xffu); vtb[qo + 2 * S] = (unsigned char)((w >> 16) & 0xffu); vtb[qo + 3 * S] = (unsigned char)(w >> 24); }
#else
                    bf16_t* p = VA + (size_t)EPI_ROW(ai, m) * 128 + (wb - 10) * 64 + 8 * fq;
                    st16(p, pack8(acc[ai][0][m][0], acc[ai][0][m][1])); st16((p + 32), pack8(acc[ai][1][m][0], acc[ai][1][m][1]));
#endif
                }
        } else if (wb < 22) {
            const bool isq = wb < 18; const int idx = isq ? wb - 12 : wb - 18; bf16_t* dst = isq ? QLAT : KVLAT; const int dp = isq ? 384 : 256;
#pragma unroll
            for (int ai = 0; ai < 2; ++ai)
#pragma unroll
                for (int m = 0; m < 4; ++m) {
                    const int r = EPI_ROW(ai, m);
                    const f32x4 v00 = acc[ai][0][m][0], v01 = acc[ai][0][m][1], v10 = acc[ai][1][m][0], v11 = acc[ai][1][m][1];
                    float ss = (dot4(v00) + dot4(v01)) + (dot4(v10) + dot4(v11)); ss += __shfl_xor(ss, 16); ss += __shfl_xor(ss, 32);
                    if (fq == 0) { if (isq) SSQ[(size_t)r * 8 + idx] = ss; else SSKV[(size_t)r * 4 + idx] = ss; }
                    bf16_t* p = dst + (size_t)r * dp + idx * 64 + 8 * fq;
                    st16(p, pack8(v00, v01)); st16((p + 32), pack8(v10, v11));
                }
        } else if (wb == 22) {
            if (fq < 2) {
#pragma unroll
                for (int ai = 0; ai < 2; ++ai)
#pragma unroll
                    for (int m = 0; m < 4; ++m) {
                        const int r = EPI_ROW(ai, m), pos = r & (S - 1);
                        const f32x4 x10 = acc[ai][0][m][0], x11 = acc[ai][0][m][1], x20 = acc[ai][1][m][0], x21 = acc[ai][1][m][1];
                        const f32x4 c0 = *(const f32x4*)(cosB + pos * 16 + 8 * fq), c1 = *(const f32x4*)(cosB + pos * 16 + 8 * fq + 4), s0 = *(const f32x4*)(sinB + pos * 16 + 8 * fq), s1 = *(const f32x4*)(sinB + pos * 16 + 8 * fq + 4);
#if ATT_FP8_B
                        const u32x2 w1 = pack8_fp8(x10 * c0 - x20 * s0, x11 * c1 - x21 * s1), w2 = pack8_fp8(x20 * c0 + x10 * s0, x21 * c1 + x11 * s1);
                        unsigned char* p = (unsigned char*)KB + (size_t)r * 768 + 64 + 8 * fq;
#pragma unroll
                        for (int h = 0; h < 8; ++h) { st8(p + h * 96, w1); st8(p + h * 96 + 16, w2); }
#else
                        const u32x4 w1 = pack8(x10 * c0 - x20 * s0, x11 * c1 - x21 * s1), w2 = pack8(x20 * c0 + x10 * s0, x21 * c1 + x11 * s1);
                        bf16_t* p = KB + (size_t)r * 768 + 64 + 8 * fq;
#pragma unroll
                        for (int h = 0; h < 8; ++h) { st16((p + h * 96), w1); st16((p + h * 96 + 16), w2); }
#endif
                    }
            }
        } else if (wb == 23) {
        } else {
            const bool isa = wb < 40; const int idx = isa ? wb - 24 : wb - 40; unsigned char* dst = (unsigned char*)(isa ? SA : SB);
#pragma unroll
            for (int ai = 0; ai < 2; ++ai)
#pragma unroll
                for (int m = 0; m < 4; ++m) { unsigned char* p = dst + (size_t)EPI_ROW(ai, m) * 1024 + idx * 64 + 8 * fq;
#pragma unroll
                    for (int bj = 0; bj < 2; ++bj) { const f32x4 a = acc[ai][bj][m][0], b = acc[ai][bj][m][1]; u32x2 w;
                        w.x = (unsigned)__builtin_amdgcn_cvt_pk_fp8_f32(a[2], a[3], __builtin_amdgcn_cvt_pk_fp8_f32(a[0], a[1], 0, false), true);
                        w.y = (unsigned)__builtin_amdgcn_cvt_pk_fp8_f32(b[2], b[3], __builtin_amdgcn_cvt_pk_fp8_f32(b[0], b[1], 0, false), true);
                        st8((p + bj * 32), w); } }
        }
    }
};
__host__ __device__ __forceinline__ int src_col_in(int n) {
    const int pn = n >> 8, nl = n & 255, bj = nl >> 7, wc = (nl & 127) >> 5, p = nl & 31, wb = pn * 4 + wc, s = bj * 32 + p;
    if (wb < 8) return wb * 64 + s;
    if (wb < 10) return 512 + (wb - 8) * 64 + s;
    if (wb < 12) return 640 + (wb - 10) * 64 + s;
    if (wb < 18) return 768 + (wb - 12) * 64 + s;
    if (wb < 22) return 1152 + (wb - 18) * 64 + s;
    if (wb == 22) return p < 16 ? 1408 + bj * 16 + p : -1;
    if (wb == 23) return -1;
    if (wb < 40) return 1440 + (wb - 24) * 64 + s;
    return 2464 + (wb - 40) * 64 + s;
}
struct EpiQb {
    bf16_t* QB; const float *SSQ, *cosB, *sinB;
    __device__ __forceinline__ void operator()(const ACC_T, const Unit& u, int wr, int wc, int fr, int fq) const {
#pragma unroll
        for (int ai = 0; ai < 2; ++ai)
#pragma unroll
            for (int m = 0; m < 4; ++m) {
                const int r = EPI_ROW(ai, m), pos = r & (S - 1);
                const f32x4 sa = *(const f32x4*)(SSQ + (size_t)r * 8); const f32x2 sb = *(const f32x2*)(SSQ + (size_t)r * 8 + 4);
                const float rstd = rsqrtf((((sa[0] + sa[1]) + (sa[2] + sa[3])) + (sb[0] + sb[1])) * (1.f / 384.f) + EPS);
#pragma unroll
                for (int bj = 0; bj < 2; ++bj) {
                    f32x4 v0 = acc[ai][bj][m][0] * rstd, v1 = acc[ai][bj][m][1] * rstd;
                    const int c32 = u.pn * 8 + bj * 4 + wc;
                    if (c32 % 3 == 2) {
                        f32x4 o0, o1;
#pragma unroll
                        for (int j = 0; j < 4; ++j) { o0[j] = __shfl_xor(v0[j], 32); o1[j] = __shfl_xor(v1[j], 32); }
                        const int i0 = 8 * (fq & 1);
                        const f32x4 c0 = *(const f32x4*)(cosB + pos * 16 + i0), c1 = *(const f32x4*)(cosB + pos * 16 + i0 + 4), s0 = *(const f32x4*)(sinB + pos * 16 + i0), s1 = *(const f32x4*)(sinB + pos * 16 + i0 + 4);
                        if (fq < 2) { v0 = v0 * c0 - o0 * s0; v1 = v1 * c1 - o1 * s1; } else { v0 = v0 * c0 + o0 * s0; v1 = v1 * c1 + o1 * s1; }
                    }
#if ATT_FP8_B
                    st8((unsigned char*)QB + (size_t)r * 768 + EPI_COL(bj), pack8_fp8(v0 * QSCALE_B, v1 * QSCALE_B));
#else
                    st16((QB + (size_t)r * 768 + EPI_COL(bj)), pack8(v0 * QSCALE_B, v1 * QSCALE_B));
#endif
                }
            }
    }
};
struct EpiKvb {
    bf16_t *KB, *VB; const float* SSKV;
    __device__ __forceinline__ void operator()(const ACC_T, const Unit& u, int wr, int wc, int fr, int fq) const {
#pragma unroll
        for (int ai = 0; ai < 2; ++ai)
#pragma unroll
            for (int m = 0; m < 4; ++m) {
                const int r = EPI_ROW(ai, m);
                const f32x4 sa = *(const f32x4*)(SSKV + (size_t)r * 4);
                const float rstd = rsqrtf(((sa[0] + sa[1]) + (sa[2] + sa[3])) * (1.f / 256.f) + EPS);
#pragma unroll
                for (int bj = 0; bj < 2; ++bj) {
                    const int head = u.pn * 2 + bj, o = wc * 32 + fq * 8;
#if ATT_FP8_B
                    const f32x4 x0 = acc[ai][bj][m][0] * rstd, x1 = acc[ai][bj][m][1] * rstd;
                    if (wc < 2) st8((unsigned char*)KB + (size_t)r * 768 + head * 96 + o, pack8_fp8(x0, x1));
                    else {
                        const int sq = r & (S - 1), k = sq & 63, pos = 32 * ((k >> 2) & 1) + 16 * (k >> 5) + (k & 3) + 4 * ((k & 31) >> 3);
                        unsigned char* vtb = (unsigned char*)VB; const unsigned vo = (unsigned)(((r >> 12) * 8 + head) * 64 + (o - 64)) * S + (unsigned)((sq & ~63) + pos);
                        const u32x2 w = pack8_fp8(x0, x1);
                        vtb[vo] = (unsigned char)(w.x & 0xffu); vtb[vo + S] = (unsigned char)((w.x >> 8) & 0xffu); vtb[vo + 2 * S] = (unsigned char)((w.x >> 16) & 0xffu); vtb[vo + 3 * S] = (unsigned char)(w.x >> 24);
                        vtb[vo + 4 * S] = (unsigned char)(w.y & 0xffu); vtb[vo + 5 * S] = (unsigned char)((w.y >> 8) & 0xffu); vtb[vo + 6 * S] = (unsigned char)((w.y >> 16) & 0xffu); vtb[vo + 7 * S] = (unsigned char)(w.y >> 24);
                    }
#else
                    const u32x4 w = pack8(acc[ai][bj][m][0] * rstd, acc[ai][bj][m][1] * rstd);
                    if (wc < 2) st16((KB + (size_t)r * 768 + head * 96 + o), w); else st16((VB + (size_t)r * 512 + head * 64 + (o - 64)), w);
#endif
                }
            }
    }
};
template <int MODE> struct EpiProj {
    bf16_t* O; const bf16_t* gate;
    __device__ __forceinline__ void operator()(const ACC_T, const Unit& u, int wr, int wc, int fr, int fq) const {
#pragma unroll
        for (int ai = 0; ai < 2; ++ai)
#pragma unroll
            for (int m = 0; m < 4; ++m) {
                const int r = EPI_ROW(ai, m);
#pragma unroll
                for (int bj = 0; bj < 2; ++bj) {
                    const size_t off = (size_t)r * D + EPI_COL(bj);
                    const u32x2 gw = *(const u32x2*)((const unsigned char*)gate + off);
                    const f32x2 q0 = __builtin_amdgcn_cvt_pk_f32_fp8((int)gw.x, false), q1 = __builtin_amdgcn_cvt_pk_f32_fp8((int)gw.x, true), q2 = __builtin_amdgcn_cvt_pk_f32_fp8((int)gw.y, false), q3 = __builtin_amdgcn_cvt_pk_f32_fp8((int)gw.y, true);
                    const f32x4 g0 = {sigm(q0[0]), sigm(q0[1]), sigm(q1[0]), sigm(q1[1])}, g1 = {sigm(q2[0]), sigm(q2[1]), sigm(q3[0]), sigm(q3[1])};
                    f32x4 v0 = acc[ai][bj][m][0] * g0, v1 = acc[ai][bj][m][1] * g1;
                    if (MODE == 1) { f32x4 p0, p1; unpack8(*(const u32x4*)(O + off), p0, p1); v0 += p0; v1 += p1; }
                    if (MODE == 1) st16(O + off, pack8(v0, v1)); else *(u32x4*)(O + off) = pack8(v0, v1);
                }
            }
    }
};
struct EpiProjP {
    bf16_t* O; const unsigned char* SA; const unsigned char* SB;
    __device__ static __forceinline__ void gates(const unsigned char* G, size_t off, f32x4& g0, f32x4& g1) {
        const u32x2 gw = *(const u32x2*)(G + off);
        const f32x2 q0 = __builtin_amdgcn_cvt_pk_f32_fp8((int)gw.x, false), q1 = __builtin_amdgcn_cvt_pk_f32_fp8((int)gw.x, true), q2 = __builtin_amdgcn_cvt_pk_f32_fp8((int)gw.y, false), q3 = __builtin_amdgcn_cvt_pk_f32_fp8((int)gw.y, true);
        g0 = (f32x4){sigm(q0[0]), sigm(q0[1]), sigm(q1[0]), sigm(q1[1])}; g1 = (f32x4){sigm(q2[0]), sigm(q2[1]), sigm(q3[0]), sigm(q3[1])};
    }
    __device__ __forceinline__ void operator()(f32x4 (&acc)[2][2][4][2], const Unit& u, int wr, int wc, int fr, int fq) const {
#pragma unroll
        for (int ai = 0; ai < 2; ++ai)
#pragma unroll
            for (int m = 0; m < 4; ++m) {
                const int r = EPI_ROW(ai, m);
#pragma unroll
                for (int bj = 0; bj < 2; ++bj) {
                    const size_t off = (size_t)r * D + EPI_COL(bj);
                    f32x4 b0, b1; gates(SB, off, b0, b1);
#pragma unroll
                    for (int j = 0; j < 4; ++j) { b0[j] = fmaxf(b0[j], 9.094947e-13f); b1[j] = fmaxf(b1[j], 9.094947e-13f); }
                    if (u.be == 0) {
                        f32x4 a0, a1; gates(SA, off, a0, a1);
#pragma unroll
                        for (int j = 0; j < 4; ++j) { acc[ai][bj][m][0][j] *= a0[j] * __builtin_amdgcn_rcpf(b0[j]); acc[ai][bj][m][1][j] *= a1[j] * __builtin_amdgcn_rcpf(b1[j]); }
                    } else st16(O + off, pack8(acc[ai][bj][m][0] * b0, acc[ai][bj][m][1] * b1));
                }
            }
    }
};
template <> struct EpiTraits<EpiProjP> { static constexpr bool KEEP = true; };
struct EpiWo {
    const bf16_t* X; const float* modl; bf16_t* XO;
    __device__ __forceinline__ void operator()(const ACC_T, const Unit& u, int wr, int wc, int fr, int fq) const {
        const float* g1 = modl + (size_t)(u.pm >> 4) * 6 * D + 2 * D;
#pragma unroll
        for (int bj = 0; bj < 2; ++bj) {
            const int c = EPI_COL(bj); const f32x4 ga = *(const f32x4*)(g1 + c), gb = *(const f32x4*)(g1 + c + 4);
#pragma unroll
            for (int ai = 0; ai < 2; ++ai)
#pragma unroll
                for (int m = 0; m < 4; ++m) { const size_t off = (size_t)EPI_ROW(ai, m) * D + c;
                    f32x4 x0, x1; unpack8(*(const u32x4*)(X + off), x0, x1);
                    st16((XO + off), pack8(x0 + ga * acc[ai][bj][m][0], x1 + gb * acc[ai][bj][m][1])); }
        }
    }
};
struct EpiUp {
    bf16_t* ACT;
    __device__ __forceinline__ void operator()(const ACC_T, const Unit& u, int wr, int wc, int fr, int fq) const {
#pragma unroll
        for (int ai = 0; ai < 2; ++ai)
#pragma unroll
            for (int m = 0; m < 4; ++m) {
                f32x4 a = acc[ai][0][m][0], b = acc[ai][0][m][1]; const f32x4 c = acc[ai][1][m][0], d = acc[ai][1][m][1];
#pragma unroll
                for (int j = 0; j < 4; ++j) { a[j] = a[j] * sigm(a[j]) * c[j]; b[j] = b[j] * sigm(b[j]) * d[j]; }
                st16((ACT + (size_t)EPI_ROW(ai, m) * FF + u.pn * 128 + wc * 32 + fq * 8), pack8(a, b));
            }
    }
};
struct EpiDown {
    bf16_t* Y2; const unsigned* list; const float* gw;
    __device__ __forceinline__ void operator()(const ACC_T, const Unit& u, int wr, int wc, int fr, int fq) const {
#pragma unroll
        for (int ai = 0; ai < 2; ++ai)
#pragma unroll
            for (int m = 0; m < 4; ++m) {
                const int rloc = ai * 128 + wr * 64 + m * 16 + fr;
                if (rloc < u.nv) {
                    const unsigned entry = list[(size_t)u.be * T + u.rl * 256 + rloc]; const float w = gw[entry];
#pragma unroll
                    for (int bj = 0; bj < 2; ++bj) { const f32x4 a = acc[ai][bj][m][0] * (w * 16.f), b = acc[ai][bj][m][1] * (w * 16.f); u32x2 q;
                        q.x = (unsigned)__builtin_amdgcn_cvt_pk_fp8_f32(a[2], a[3], __builtin_amdgcn_cvt_pk_fp8_f32(a[0], a[1], 0, false), true);
                        q.y = (unsigned)__builtin_amdgcn_cvt_pk_fp8_f32(b[2], b[3], __builtin_amdgcn_cvt_pk_fp8_f32(b[0], b[1], 0, false), true);
                        st8(((unsigned char*)Y2 + (size_t)entry * D + EPI_COL(bj)), q); }
                }
            }
    }
};
}

namespace at {
struct Tensors { const bf16_t* Q; int qp; const bf16_t* K; int kp; const bf16_t* V; int vp; bf16_t* O; int op; int group; };
__device__ __forceinline__ bool next_unit(int i, int vcu, int G, int& bh, int& qb) {
    int u;
    if (G == 256) { if (i >= 4) return false; u = (vcu >> 5) * 128 + i * 32 + (vcu & 31); }
    else { u = i * G + vcu; if (u >= 1024) return false; }
    bh = u >> 4; qb = u & 15; return true;
}
template <int DQK>
__device__ __forceinline__ void attn_phase_ref(int tid, const Tensors& A, int vcu, int G) {
    int bh, qb;
    for (int i = 0; next_unit(i, vcu, G, bh, qb); ++i) {
        const int b = bh >> 3, h = bh & 7, kvh = h / A.group;
        {
            const int dh = tid >> 8;
            const size_t row = (size_t)b * S + qb * 256 + (tid & 255);
            float q[DQK], o[32];
#pragma unroll
            for (int d = 0; d < DQK; ++d) q[d] = bf2f(A.Q[row * A.qp + h * DQK + d]);
#pragma unroll
            for (int d = 0; d < 32; ++d) o[d] = 0.f;
            float l = 0.f;
            for (int k = 0; k < S; ++k) {
                const bf16_t* kr = A.K + ((size_t)b * S + k) * A.kp + kvh * DQK; const bf16_t* vr = A.V + ((size_t)b * S + k) * A.vp + kvh * 64 + dh * 32;
                float sc = 0.f;
#pragma unroll
                for (int d = 0; d < DQK; d += 8) { f32x4 k0, k1; unpack8(*(const u32x4*)(kr + d), k0, k1);
                    sc += q[d] * k0[0] + q[d + 1] * k0[1] + q[d + 2] * k0[2] + q[d + 3] * k0[3] + q[d + 4] * k1[0] + q[d + 5] * k1[1] + q[d + 6] * k1[2] + q[d + 7] * k1[3]; }
                const float p = bf2f(cvt_pk_bf16(exp2f(sc), 0.f) & 0xffffu); l += p;
#pragma unroll
                for (int d = 0; d < 32; d += 8) { f32x4 v0, v1; unpack8(*(const u32x4*)(vr + d), v0, v1);
                    o[d] += p * v0[0]; o[d + 1] += p * v0[1]; o[d + 2] += p * v0[2]; o[d + 3] += p * v0[3]; o[d + 4] += p * v1[0]; o[d + 5] += p * v1[1]; o[d + 6] += p * v1[2]; o[d + 7] += p * v1[3]; }
            }
            const float il = 1.f / l;
            __syncthreads();
#pragma unroll
            for (int d = 0; d < 32; d += 8) { f32x4 a = {o[d] * il, o[d + 1] * il, o[d + 2] * il, o[d + 3] * il}, c = {o[d + 4] * il, o[d + 5] * il, o[d + 6] * il, o[d + 7] * il};
                *(u32x4*)(A.O + row * A.op + h * 64 + dh * 32 + d) = pack8(a, c); }
        }
    }
}
#if FAST_ATTN
typedef short s16x4 __attribute__((ext_vector_type(4)));
__device__ __forceinline__ unsigned cvtpk(float lo, float hi) { f32x2 v = {lo, hi}; bf16x2_t b = __builtin_convertvector(v, bf16x2_t); return __builtin_bit_cast(unsigned, b); }
__device__ __forceinline__ s16x4 vtr(const LAS unsigned char* p) { return __builtin_bit_cast(s16x4, __builtin_amdgcn_ds_read_tr16_b64_v4i16((LAS s16x4*)p)); }
__device__ __forceinline__ int crow(int r, int hi) { return (r & 3) + 8 * (r >> 2) + 4 * hi; }
#define AT_BAR() asm volatile("s_barrier" ::: "memory")
#define AT_WAITBAR(N) asm volatile("s_waitcnt vmcnt(" #N ") lgkmcnt(0)\n\ts_barrier" ::: "memory")
#define AT_SCHED() __builtin_amdgcn_sched_barrier(0)
__device__ __forceinline__ void glds16(const void* gsrc, unsigned lds_dst) { unsigned keep;
    asm volatile("s_mov_b32 %0, m0\n\ts_mov_b32 m0, %2\n\ts_nop 0\n\tglobal_load_lds_dwordx4 %1, off\n\ts_mov_b32 m0, %0" : "=&s"(keep) : "v"(gsrc), "s"(lds_dst) : "memory"); }
#define AT_GLDS(g, l) glds16((const void*)(g), (unsigned)__builtin_amdgcn_readfirstlane((int)(unsigned)(uintptr_t)(l)))
template <int DQK>
__device__ __forceinline__ void attn_unit(int tid, LAS unsigned char* lds, const Tensors& A, int b, int h, int qb) {
    constexpr int ND = DQK / 16, NCH = DQK / 8, KSLOT = NCH * 1024, NKD = NCH > 8 ? 2 : 1, VSLOT = 8192, NT = S / 64;
    constexpr int KOFF = 0, VOFF = 3 * KSLOT, OST = VOFF + 3 * VSLOT, WSF = OST + 8 * 4096;
    static_assert(WSF + 8 * 256 <= RING_BYTES, "attention LDS");
    const int lane = tid & 63, r32 = lane & 31, hi = lane >> 5, wid = __builtin_amdgcn_readfirstlane(tid >> 6);
    const int kvh = h / A.group; const size_t rowb = (size_t)b * S;
    const bf16_t* ksrc = A.K + (rowb + lane) * A.kp + kvh * DQK + wid * 8;
    const bf16_t* ksrc2 = A.K + (rowb + lane) * A.kp + kvh * DQK + (8 + (wid & 3)) * 8;
    const bf16_t* vsrc = A.V + (rowb + 16 * (wid & 3) + (lane >> 2)) * A.vp + kvh * 64 + (wid >> 2) * 32 + (lane & 3) * 8;
    const size_t ktile = (size_t)64 * A.kp, vtile = (size_t)64 * A.vp;
    LAS unsigned char* kdst = lds + KOFF + wid * 1024; LAS unsigned char* kdst2 = lds + KOFF + (8 + (wid & 3)) * 1024; LAS unsigned char* vdst = lds + VOFF + wid * 1024;
#define DMA_K(j, so) do { AT_GLDS(ksrc + (size_t)(j) * ktile, kdst + (so)); if (NKD == 2) AT_GLDS(ksrc2 + (size_t)(j) * ktile, kdst2 + (so)); } while (0)
#define DMA_V(j, so) AT_GLDS(vsrc + (size_t)(j) * vtile, vdst + (so))
    const LAS unsigned char* kp0 = lds + KOFF + hi * 1024 + r32 * 16;
    const LAS unsigned char* vp0 = lds + VOFF + ((lane >> 4) & 1) * 32 + (lane & 3) * 8 + (4 * hi + ((lane & 15) >> 2)) * 64;
    DMA_K(0, 0); DMA_V(0, 0); DMA_K(1, KSLOT); DMA_V(1, VSLOT); DMA_K(2, 2 * KSLOT);
    const bf16_t* Qw = A.Q + (rowb + qb * 256 + wid * 32 + r32) * A.qp + h * DQK + hi * 8;
    bf16x8 qr[ND];
#pragma unroll
    for (int d0 = 0; d0 < ND; ++d0) qr[d0] = *(const bf16x8*)(Qw + d0 * 16);
    asm volatile("s_waitcnt vmcnt(0)\n\ts_barrier" ::: "memory");
    bf16x8 kf[2 * ND]; s16x4 vlo[8], vhi[8];
#define KLOAD(so) do { _Pragma("unroll") for (int d0 = 0; d0 < ND; ++d0) { kf[2 * d0] = *(const LAS bf16x8*)(kp0 + (so) + d0 * 2048); kf[2 * d0 + 1] = *(const LAS bf16x8*)(kp0 + (so) + d0 * 2048 + 512); } } while (0)
#define VLOAD(so) do { _Pragma("unroll") for (int i = 0; i < 8; ++i) { vlo[i] = vtr(vp0 + (so) + (i >> 2) * 4096 + (i & 3) * 1024); vhi[i] = vtr(vp0 + (so) + (i >> 2) * 4096 + (i & 3) * 1024 + 512); } } while (0)
#define VFR(i) (bf16x8){vlo[i][0], vlo[i][1], vlo[i][2], vlo[i][3], vhi[i][0], vhi[i][1], vhi[i][2], vhi[i][3]}
    KLOAD(0);
    asm volatile("s_waitcnt lgkmcnt(0)" ::: "memory");
    if (PROBE_ATT != 5 && wid >= 4) AT_BAR();
    f32x16 o0 = {}, o1 = {}, C0, C1; u32x4 pw0, pw1, pw2, pw3; float lsum = 0.f;
    const f32x16 zero = {};
#define QK_BLOCK() do { C0 = __builtin_amdgcn_mfma_f32_32x32x16_bf16(kf[0], qr[0], zero, 0, 0, 0); C1 = __builtin_amdgcn_mfma_f32_32x32x16_bf16(kf[1], qr[0], zero, 0, 0, 0); \
        _Pragma("unroll") for (int d0 = 1; d0 < ND; ++d0) { C0 = __builtin_amdgcn_mfma_f32_32x32x16_bf16(kf[2 * d0], qr[d0], C0, 0, 0, 0); C1 = __builtin_amdgcn_mfma_f32_32x32x16_bf16(kf[2 * d0 + 1], qr[d0], C1, 0, 0, 0); } } while (0)
#define PAF(k) __builtin_bit_cast(bf16x8, pw##k)
#define PV_BLOCK() do { \
        o0 = __builtin_amdgcn_mfma_f32_32x32x16_bf16(PAF(0), VFR(0), o0, 0, 0, 0); o1 = __builtin_amdgcn_mfma_f32_32x32x16_bf16(PAF(0), VFR(4), o1, 0, 0, 0); \
        o0 = __builtin_amdgcn_mfma_f32_32x32x16_bf16(PAF(1), VFR(1), o0, 0, 0, 0); o1 = __builtin_amdgcn_mfma_f32_32x32x16_bf16(PAF(1), VFR(5), o1, 0, 0, 0); \
        o0 = __builtin_amdgcn_mfma_f32_32x32x16_bf16(PAF(2), VFR(2), o0, 0, 0, 0); o1 = __builtin_amdgcn_mfma_f32_32x32x16_bf16(PAF(2), VFR(6), o1, 0, 0, 0); \
        o0 = __builtin_amdgcn_mfma_f32_32x32x16_bf16(PAF(3), VFR(3), o0, 0, 0, 0); o1 = __builtin_amdgcn_mfma_f32_32x32x16_bf16(PAF(3), VFR(7), o1, 0, 0, 0); } while (0)
#define SOFTMAX() do { \
        _Pragma("unroll") for (int r = 0; r < 16; ++r) { C0[r] = __builtin_amdgcn_exp2f(C0[r]); C1[r] = __builtin_amdgcn_exp2f(C1[r]); } \
        f32x2 s0_ = {C0[0], C0[1]}, s1_ = {C1[0], C1[1]}; _Pragma("unroll") for (int r = 2; r < 16; r += 2) { s0_ += (f32x2){C0[r], C0[r + 1]}; s1_ += (f32x2){C1[r], C1[r + 1]}; } s0_ += s1_; lsum += s0_[0] + s0_[1]; \
        pw0 = (u32x4){cvtpk(C0[0], C0[1]), cvtpk(C0[2], C0[3]), cvtpk(C0[4], C0[5]), cvtpk(C0[6], C0[7])}; pw1 = (u32x4){cvtpk(C0[8], C0[9]), cvtpk(C0[10], C0[11]), cvtpk(C0[12], C0[13]), cvtpk(C0[14], C0[15])}; \
        pw2 = (u32x4){cvtpk(C1[0], C1[1]), cvtpk(C1[2], C1[3]), cvtpk(C1[4], C1[5]), cvtpk(C1[6], C1[7])}; pw3 = (u32x4){cvtpk(C1[8], C1[9]), cvtpk(C1[10], C1[11]), cvtpk(C1[12], C1[13]), cvtpk(C1[14], C1[15])}; } while (0)
    int ka = 2 * KSLOT, kb = 0, kc = KSLOT, va = 2 * VSLOT, vb = 0, vc = VSLOT;
#define ROT() do { const int t_ = ka; ka = kb; kb = kc; kc = t_; const int u_ = va; va = vb; vb = vc; vc = u_; } while (0)
#define PINP() asm volatile("" : "+v"(lsum) : "v"(pw0), "v"(pw1), "v"(pw2), "v"(pw3))
#if ATT_REGSTAGE
    u32x4 kst = {}, kst2 = {}, vst = {};
    const LAS unsigned char* kw = lds + KOFF + wid * 1024 + lane * 16; const LAS unsigned char* kw2 = lds + KOFF + (8 + (wid & 3)) * 1024 + lane * 16; const LAS unsigned char* vw = lds + VOFF + wid * 1024 + lane * 16;
#define ST_WRITE(WK, WV) do { if (WK) { *(LAS u32x4*)(kw + ka) = kst; if (NKD == 2 && wid < 4) *(LAS u32x4*)(kw2 + ka) = kst2; } if (WV) *(LAS u32x4*)(vw + vc) = vst; } while (0)
#define ST_LOAD(sv, IK, IV) do { if (IK) { kst = *(const u32x4*)(ksrc + (size_t)((sv) + 4) * ktile); if (NKD == 2 && wid < 4) kst2 = *(const u32x4*)(ksrc2 + (size_t)((sv) + 4) * ktile); } if (IV) vst = *(const u32x4*)(vsrc + (size_t)((sv) + 3) * vtile); } while (0)
#define STEP(sv, DOQK, DOPV, KL, VL, IK, IV, WK, WV) do { \
        AT_SCHED(); if (DOQK) QK_BLOCK(); if (DOPV) PV_BLOCK(); AT_SCHED(); \
        asm volatile("s_barrier\n\ts_nop 15\n\ts_nop 3" : "+v"(C0), "+v"(C1), "+v"(o0), "+v"(o1) :: "memory"); AT_SCHED(); \
        if (KL) KLOAD(kc); if (VL) VLOAD(vb); ST_WRITE(WK, WV); ST_LOAD(sv, IK, IV); \
        if (DOQK) { SOFTMAX(); PINP(); } AT_SCHED(); \
        asm volatile("s_waitcnt lgkmcnt(0)\n\ts_barrier" ::: "memory"); \
        AT_SCHED(); ROT(); } while (0)
    STEP(-1, true, false, true, true, true, true, false, false);
#pragma nounroll
    for (int s = 0; s < NT - 4; ++s) STEP(s, true, true, true, true, true, true, true, true);
    STEP(NT - 4, true, true, true, true, false, true, true, true);
    STEP(NT - 3, true, true, true, true, false, false, false, true);
    STEP(NT - 2, true, true, false, true, false, false, false, false);
    STEP(NT - 1, false, true, false, false, false, false, false, false);
#undef ST_WRITE
#undef ST_LOAD
#else
#define STEP(sv, DOQK, DOPV, KL, VL, IK, IV) do { \
        AT_SCHED(); if (DOQK) QK_BLOCK(); if (DOPV) PV_BLOCK(); AT_SCHED(); \
          \
        asm volatile("s_barrier\n\ts_nop 15\n\ts_nop 3" : "+v"(C0), "+v"(C1), "+v"(o0), "+v"(o1) :: "memory"); AT_SCHED(); \
        if (KL) KLOAD(kc); if (VL) VLOAD(vb); if (IK) DMA_K((sv) + 4, kb); if (IV) DMA_V((sv) + 3, va); \
        if (DOQK) { SOFTMAX(); PINP(); } AT_SCHED(); \
        if (IK) { if (NKD == 2) { AT_WAITBAR(3); } else { AT_WAITBAR(2); } } else if (IV) { AT_WAITBAR(1); } else { AT_WAITBAR(0); } \
        AT_SCHED(); ROT(); } while (0)
    STEP(-1, true, false, true, true, true, true);
#pragma nounroll
    for (int s = 0; s < NT - 4; ++s) STEP(s, true, true, true, true, true, true);
    STEP(NT - 4, true, true, true, true, false, true);
    STEP(NT - 3, true, true, true, true, false, false);
    STEP(NT - 2, true, true, false, true, false, false);
    STEP(NT - 1, false, true, false, false, false, false);
#endif
#undef STEP
#undef PINP
    if (PROBE_ATT != 5 && wid < 4) AT_BAR();
    { auto rr = __builtin_amdgcn_permlane32_swap(__float_as_uint(lsum), __float_as_uint(lsum), false, false); lsum = __uint_as_float(rr[0]) + __uint_as_float(rr[1]); }
    LAS float* wsf = (LAS float*)(lds + WSF + wid * 256);
    if (hi == 0) wsf[r32] = lsum;
    asm volatile("s_waitcnt lgkmcnt(0)" ::: "memory");
    LAS bf16_t* stg = (LAS bf16_t*)(lds + OST + wid * 4096);
#pragma unroll
    for (int r = 0; r < 16; ++r) { const int orow = crow(r, hi); const float rl = __builtin_amdgcn_rcpf(wsf[orow]);
        stg[orow * 64 + r32] = (bf16_t)(cvtpk(o0[r] * rl, 0.f) & 0xffffu); stg[orow * 64 + 32 + r32] = (bf16_t)(cvtpk(o1[r] * rl, 0.f) & 0xffffu); }
    asm volatile("s_waitcnt lgkmcnt(0)" ::: "memory");
    bf16_t* Ow = A.O + (rowb + qb * 256 + wid * 32) * A.op + h * 64;
#pragma unroll
    for (int i = 0; i < 4; ++i) { const int row = i * 8 + (lane >> 3), ch = lane & 7; const u32x4 v = *(const LAS u32x4*)(stg + row * 64 + ch * 8); st16((Ow + (size_t)row * A.op + ch * 8), v); }
    asm volatile("s_waitcnt lgkmcnt(0)\n\ts_barrier" ::: "memory");
#undef DMA_K
#undef DMA_V
#undef KLOAD
#undef VLOAD
#undef VFR
#undef QK_BLOCK
#undef PAF
#undef PV_BLOCK
#undef SOFTMAX
#undef ROT
}
#endif
#if FAST_ATTN && ATT_FP8_A
typedef int v8i __attribute__((ext_vector_type(8)));
__device__ __forceinline__ f32x16 mfma8(v8i a, v8i b, f32x16 c) { return __builtin_amdgcn_mfma_scale_f32_32x32x64_f8f6f4(a, b, c, 0, 0, 0, 0x7f7f7f7f, 0, 0x7f7f7f7f); }
__device__ __forceinline__ void attn_unit_f8a(int tid, LAS unsigned char* lds, const unsigned char* Q8, const unsigned char* K8, const unsigned char* VT8, bf16_t* O, int op, int b, int h, int qb, float bias) {
    constexpr int SL = 4096, NT = S / 64;
    constexpr int KOFF = 0, VOFF = 3 * SL, OST = VOFF + 3 * SL, WSF = OST + 8 * 4096;
    const int lane = tid & 63, r32 = lane & 31, hi = lane >> 5, wid = __builtin_amdgcn_readfirstlane(tid >> 6);
    const int kvh = h >> 2; const size_t rowb = (size_t)b * S; const bool kw = wid < 4;
    const unsigned char* src = kw ? K8 + (rowb + lane) * 128 + kvh * 64 + 16 * wid : VT8 + ((size_t)((b * 2 + kvh) * 64 + lane)) * S + 16 * (wid - 4);
    const size_t tstep = kw ? (size_t)64 * 128 : (size_t)64;
    LAS unsigned char* dst = lds + (kw ? KOFF + wid * 1024 : VOFF + (wid - 4) * 1024);
#define DMA8(j, so) AT_GLDS(src + (size_t)(j) * tstep, dst + (so))
    const LAS unsigned char* kp0 = lds + KOFF + (2 * hi) * 1024 + r32 * 16;
    const LAS unsigned char* vp0 = lds + VOFF + (2 * hi) * 1024 + r32 * 16;
    if (kw) { DMA8(0, 0); DMA8(1, SL); DMA8(2, 2 * SL); } else { DMA8(0, 0); DMA8(1, SL); }
    v8i qf; { const unsigned char* Qw = Q8 + (rowb + qb * 256 + wid * 32 + r32) * 512 + h * 64 + 32 * hi; const u32x4 a = *(const u32x4*)Qw, c = *(const u32x4*)(Qw + 16);
        qf = (v8i){(int)a.x, (int)a.y, (int)a.z, (int)a.w, (int)c.x, (int)c.y, (int)c.z, (int)c.w}; }
    asm volatile("s_waitcnt vmcnt(0)\n\ts_barrier" ::: "memory");
    v8i kf0, kf1, vf0, vf1, p8;
#define LD32(dstv, p) do { const u32x4 a_ = *(const LAS u32x4*)(p), c_ = *(const LAS u32x4*)((p) + 1024); dstv = (v8i){(int)a_.x, (int)a_.y, (int)a_.z, (int)a_.w, (int)c_.x, (int)c_.y, (int)c_.z, (int)c_.w}; } while (0)
#define KLOAD8(so) do { LD32(kf0, kp0 + (so)); LD32(kf1, kp0 + (so) + 512); } while (0)
#define VLOAD8(so) do { LD32(vf0, vp0 + (so)); LD32(vf1, vp0 + (so) + 512); } while (0)
    KLOAD8(0);
    asm volatile("s_waitcnt lgkmcnt(0)" ::: "memory");
    if (wid >= 4) AT_BAR();
    f32x16 o0 = {}, o1 = {}, C0, C1; float lsum = 0.f;
    f32x16 negb;
#pragma unroll
    for (int r = 0; r < 16; ++r) negb[r] = bias;
    asm volatile("" : "+v"(negb));
#define SOFTMAX8() do { \
        _Pragma("unroll") for (int r = 0; r < 16; ++r) { C0[r] = __builtin_amdgcn_exp2f(C0[r]); C1[r] = __builtin_amdgcn_exp2f(C1[r]); } \
        f32x2 s0_ = {C0[0], C0[1]}, s1_ = {C1[0], C1[1]}; _Pragma("unroll") for (int r = 2; r < 16; r += 2) { s0_ += (f32x2){C0[r], C0[r + 1]}; s1_ += (f32x2){C1[r], C1[r + 1]}; } s0_ += s1_; lsum += s0_[0] + s0_[1]; \
        _Pragma("unroll") for (int i = 0; i < 4; ++i) { \
            p8[i] = __builtin_amdgcn_cvt_pk_fp8_f32(C0[4 * i + 2], C0[4 * i + 3], __builtin_amdgcn_cvt_pk_fp8_f32(C0[4 * i], C0[4 * i + 1], 0, false), true); \
            p8[4 + i] = __builtin_amdgcn_cvt_pk_fp8_f32(C1[4 * i + 2], C1[4 * i + 3], __builtin_amdgcn_cvt_pk_fp8_f32(C1[4 * i], C1[4 * i + 1], 0, false), true); } } while (0)
    int oa = 2 * SL, ob = 0, oc = SL;
#define ROT8() do { const int t_ = oa; oa = ob; ob = oc; oc = t_; } while (0)
#define STEP8(sv, DOQK, DOPV, KL, VL, IK, IV) do { \
        AT_SCHED(); if (DOQK) { C0 = mfma8(kf0, qf, negb); C1 = mfma8(kf1, qf, negb); } if (DOPV) { o0 = mfma8(p8, vf0, o0); o1 = mfma8(p8, vf1, o1); } AT_SCHED(); \
        asm volatile("s_barrier\n\ts_nop 15\n\ts_nop 15" : "+v"(C0), "+v"(C1), "+v"(o0), "+v"(o1) :: "memory"); AT_SCHED(); \
        if (KL) KLOAD8(oc); if (VL) VLOAD8(ob); \
        const bool iss_ = kw ? (IK) : (IV); if (iss_) { if (kw) DMA8((sv) + 4, ob); else DMA8((sv) + 3, oa); } \
        if (DOQK) { SOFTMAX8(); asm volatile("" : "+v"(lsum) : "v"(p8)); } AT_SCHED(); \
        if (iss_) { AT_WAITBAR(1); } else { AT_WAITBAR(0); } \
        AT_SCHED(); ROT8(); } while (0)
    STEP8(-1, true, false, true, true, true, true);
#pragma nounroll
    for (int s = 0; s < NT - 4; ++s) STEP8(s, true, true, true, true, true, true);
    STEP8(NT - 4, true, true, true, true, false, true);
    STEP8(NT - 3, true, true, true, true, false, false);
    STEP8(NT - 2, true, true, false, true, false, false);
    STEP8(NT - 1, false, true, false, false, false, false);
    if (wid < 4) AT_BAR();
    { auto rr = __builtin_amdgcn_permlane32_swap(__float_as_uint(lsum), __float_as_uint(lsum), false, false); lsum = __uint_as_float(rr[0]) + __uint_as_float(rr[1]); }
    LAS float* wsf = (LAS float*)(lds + WSF + wid * 256);
    if (hi == 0) wsf[r32] = lsum;
    asm volatile("s_waitcnt lgkmcnt(0)" ::: "memory");
    LAS bf16_t* stg = (LAS bf16_t*)(lds + OST + wid * 4096);
#pragma unroll
    for (int r = 0; r < 16; ++r) { const int orow = crow(r, hi); const float rl = __builtin_amdgcn_rcpf(wsf[orow]);
        stg[orow * 64 + r32] = (bf16_t)(cvtpk(o0[r] * rl, 0.f) & 0xffffu); stg[orow * 64 + 32 + r32] = (bf16_t)(cvtpk(o1[r] * rl, 0.f) & 0xffffu); }
    asm volatile("s_waitcnt lgkmcnt(0)" ::: "memory");
    bf16_t* Ow = O + (rowb + qb * 256 + wid * 32) * op + h * 64;
#pragma unroll
    for (int i = 0; i < 4; ++i) { const int row = i * 8 + (lane >> 3), ch = lane & 7; const u32x4 v = *(const LAS u32x4*)(stg + row * 64 + ch * 8); st16(Ow + (size_t)row * op + ch * 8, v); }
    asm volatile("s_waitcnt lgkmcnt(0)\n\ts_barrier" ::: "memory");
#undef DMA8
#undef LD32
#undef KLOAD8
#undef VLOAD8
#undef SOFTMAX8
#undef ROT8
#undef STEP8
}
__device__ __forceinline__ void attn_phase_f8a(int tid, LAS unsigned char* lds, const unsigned char* Q8, const unsigned char* K8, const unsigned char* VT8, bf16_t* O, int op, const float* gq, const float* gk, int vcu, int G) {
    float mq = 0.f, mk = 0.f;
    for (int i = 0; i < 64; ++i) { mq = fmaxf(mq, fabsf(gq[i])); mk = fmaxf(mk, fabsf(gk[i])); }
    const float bias = -fmaxf(64.f * mq * mk * QSCALE_A - 8.f, 0.f);
    int bh, qb;
    for (int i = 0; next_unit(i, vcu, G, bh, qb); ++i) attn_unit_f8a(tid, lds, Q8, K8, VT8, O, op, bh >> 3, bh & 7, qb, bias);
}
#endif
#if FAST_ATTN && ATT_FP8_B
__device__ __forceinline__ f32x16 mfma8pv(v8i a, v8i b, f32x16 c) { return __builtin_amdgcn_mfma_scale_f32_32x32x64_f8f6f4(a, b, c, 1, 0, 0, 0x7f7f7f7f, 0, 0x7f7f7f7f); }
__device__ __forceinline__ void attn_unit_f8b(int tid, LAS unsigned char* lds, const unsigned char* Q8, const unsigned char* K8, const unsigned char* VT8, bf16_t* O, int op, int b, int h, int qb) {
    constexpr int SLK = 6144, SLV = 4096, NT = S / 64;
    constexpr int KOFF = 0, VOFF = 3 * SLK, OST = VOFF + 3 * SLV, WSF = OST + 8 * 4096;
    static_assert(WSF + 2048 <= RING_BYTES, "attention LDS");
    const int lane = tid & 63, r32 = lane & 31, hi = lane >> 5, wid = __builtin_amdgcn_readfirstlane(tid >> 6);
    const size_t rowb = (size_t)b * S; const bool kw = wid < 6, vw = wid >= 4;
    const unsigned char* ksrc = K8 + (rowb + lane) * 768 + h * 96 + 16 * wid;
    const unsigned char* vsrc = VT8 + ((size_t)((b * 8 + h) * 64 + lane)) * S + 16 * (wid - 4);
    LAS unsigned char* kdst = lds + KOFF + wid * 1024; LAS unsigned char* vdst = lds + VOFF + (wid - 4) * 1024;
#define DMAK(j, so) AT_GLDS(ksrc + (size_t)(j) * (64 * 768), kdst + (so))
#define DMAV(j, so) AT_GLDS(vsrc + (size_t)(j) * 64, vdst + (so))
    const LAS unsigned char* kp0 = lds + KOFF + (2 * hi) * 1024 + r32 * 16;
    const LAS unsigned char* kr0 = lds + KOFF + 4 * 1024 + r32 * 16;
    const LAS unsigned char* vp0 = lds + VOFF + (2 * hi) * 1024 + r32 * 16;
    if (kw) { DMAK(0, 0); DMAK(1, SLK); DMAK(2, 2 * SLK); }
    if (vw) { DMAV(0, 0); DMAV(1, SLV); }
    v8i qn, qr;
    { const unsigned char* Qw = Q8 + (rowb + qb * 256 + wid * 32 + r32) * 768 + h * 96; const u32x4 a = *(const u32x4*)(Qw + 32 * hi), c = *(const u32x4*)(Qw + 32 * hi + 16), e = *(const u32x4*)(Qw + 64), f = *(const u32x4*)(Qw + 80);
      qn = (v8i){(int)a.x, (int)a.y, (int)a.z, (int)a.w, (int)c.x, (int)c.y, (int)c.z, (int)c.w};
      qr = hi ? (v8i){0, 0, 0, 0, 0, 0, 0, 0} : (v8i){(int)e.x, (int)e.y, (int)e.z, (int)e.w, (int)f.x, (int)f.y, (int)f.z, (int)f.w}; }
    asm volatile("s_waitcnt vmcnt(0)\n\ts_barrier" ::: "memory");
    v8i kn0, kn1, kr0v, kr1v, vf0, vf1, p8;
#define LD32(dstv, p) do { const u32x4 a_ = *(const LAS u32x4*)(p), c_ = *(const LAS u32x4*)((p) + 1024); dstv = (v8i){(int)a_.x, (int)a_.y, (int)a_.z, (int)a_.w, (int)c_.x, (int)c_.y, (int)c_.z, (int)c_.w}; } while (0)
#define KLOAD8(so) do { LD32(kn0, kp0 + (so)); LD32(kn1, kp0 + (so) + 512); LD32(kr0v, kr0 + (so)); LD32(kr1v, kr0 + (so) + 512); } while (0)
#define VLOAD8(so) do { LD32(vf0, vp0 + (so)); LD32(vf1, vp0 + (so) + 512); } while (0)
    KLOAD8(0);
    asm volatile("s_waitcnt lgkmcnt(0)" ::: "memory");
    if (wid >= 4) AT_BAR();
    f32x16 o0 = {}, o1 = {}, C0, C1; float lsum = 0.f; const f32x16 zero = {};
#define SOFTMAX8() do { \
        _Pragma("unroll") for (int r = 0; r < 16; ++r) { C0[r] = __builtin_amdgcn_exp2f(C0[r]); C1[r] = __builtin_amdgcn_exp2f(C1[r]); } \
        f32x2 s0_ = {C0[0], C0[1]}, s1_ = {C1[0], C1[1]}; _Pragma("unroll") for (int r = 2; r < 16; r += 2) { s0_ += (f32x2){C0[r], C0[r + 1]}; s1_ += (f32x2){C1[r], C1[r + 1]}; } s0_ += s1_; lsum += s0_[0] + s0_[1]; \
        _Pragma("unroll") for (int i = 0; i < 4; ++i) { \
            p8[i] = __builtin_amdgcn_cvt_pk_bf8_f32(C0[4 * i + 2], C0[4 * i + 3], __builtin_amdgcn_cvt_pk_bf8_f32(C0[4 * i], C0[4 * i + 1], 0, false), true); \
            p8[4 + i] = __builtin_amdgcn_cvt_pk_bf8_f32(C1[4 * i + 2], C1[4 * i + 3], __builtin_amdgcn_cvt_pk_bf8_f32(C1[4 * i], C1[4 * i + 1], 0, false), true); } } while (0)
    int ka = 2 * SLK, kb = 0, kc = SLK, va = 2 * SLV, vb = 0, vc = SLV;
#define ROT8() do { const int t_ = ka; ka = kb; kb = kc; kc = t_; const int u_ = va; va = vb; vb = vc; vc = u_; } while (0)
#define STEP8(sv, DOQK, DOPV, KL, VL, IK, IV) do { \
        AT_SCHED(); if (DOQK) { C0 = mfma8(kn0, qn, zero); C1 = mfma8(kn1, qn, zero); C0 = mfma8(kr0v, qr, C0); C1 = mfma8(kr1v, qr, C1); } if (DOPV) { o0 = mfma8pv(p8, vf0, o0); o1 = mfma8pv(p8, vf1, o1); } AT_SCHED(); \
        asm volatile("s_barrier\n\ts_nop 15\n\ts_nop 15" : "+v"(C0), "+v"(C1), "+v"(o0), "+v"(o1) :: "memory"); AT_SCHED(); \
        if (KL) KLOAD8(kc); if (VL) VLOAD8(vb); \
        const bool ik_ = kw && (IK), iv_ = vw && (IV); if (ik_) DMAK((sv) + 4, kb); if (iv_) DMAV((sv) + 3, va); \
        if (DOQK) { SOFTMAX8(); asm volatile("" : "+v"(lsum) : "v"(p8)); } AT_SCHED(); \
        if (ik_ && iv_) { AT_WAITBAR(2); } else if (ik_ || iv_) { AT_WAITBAR(1); } else { AT_WAITBAR(0); } \
        AT_SCHED(); ROT8(); } while (0)
    STEP8(-1, true, false, true, true, true, true);
#pragma nounroll
    for (int s = 0; s < NT - 4; ++s) STEP8(s, true, true, true, true, true, true);
    STEP8(NT - 4, true, true, true, true, false, true);
    STEP8(NT - 3, true, true, true, true, false, false);
    STEP8(NT - 2, true, true, false, true, false, false);
    STEP8(NT - 1, false, true, false, false, false, false);
    if (wid < 4) AT_BAR();
    { auto rr = __builtin_amdgcn_permlane32_swap(__float_as_uint(lsum), __float_as_uint(lsum), false, false); lsum = __uint_as_float(rr[0]) + __uint_as_float(rr[1]); }
    LAS float* wsf = (LAS float*)(lds + WSF + wid * 256);
    if (hi == 0) wsf[r32] = lsum;
    asm volatile("s_waitcnt lgkmcnt(0)" ::: "memory");
    LAS bf16_t* stg = (LAS bf16_t*)(lds + OST + wid * 4096);
#pragma unroll
    for (int r = 0; r < 16; ++r) { const int orow = crow(r, hi); const float rl = __builtin_amdgcn_rcpf(wsf[orow]);
        stg[orow * 64 + r32] = (bf16_t)(cvtpk(o0[r] * rl, 0.f) & 0xffffu); stg[orow * 64 + 32 + r32] = (bf16_t)(cvtpk(o1[r] * rl, 0.f) & 0xffffu); }
    asm volatile("s_waitcnt lgkmcnt(0)" ::: "memory");
    bf16_t* Ow = O + (rowb + qb * 256 + wid * 32) * op + h * 64;
#pragma unroll
    for (int i = 0; i < 4; ++i) { const int row = i * 8 + (lane >> 3), ch = lane & 7; const u32x4 v = *(const LAS u32x4*)(stg + row * 64 + ch * 8); st16(Ow + (size_t)row * op + ch * 8, v); }
    asm volatile("s_waitcnt lgkmcnt(0)\n\ts_barrier" ::: "memory");
#undef DMAK
#undef DMAV
#undef LD32
#undef KLOAD8
#undef VLOAD8
#undef SOFTMAX8
#undef ROT8
#undef STEP8
}
__device__ __forceinline__ void attn_phase_f8b(int tid, LAS unsigned char* lds, const unsigned char* Q8, const unsigned char* K8, const unsigned char* VT8, bf16_t* O, int op, int vcu, int G) {
    int bh, qb;
    for (int i = 0; next_unit(i, vcu, G, bh, qb); ++i) attn_unit_f8b(tid, lds, Q8, K8, VT8, O, op, bh >> 3, bh & 7, qb);
}
#endif
template <int DQK>
__device__ __forceinline__ void attn_phase(int tid, LAS unsigned char* lds, const Tensors& A, int vcu, int G) {
#if FAST_ATTN
    int bh, qb;
    for (int i = 0; next_unit(i, vcu, G, bh, qb); ++i) attn_unit<DQK>(tid, lds, A, bh >> 3, bh & 7, qb);
#else
    (void)lds; attn_phase_ref<DQK>(tid, A, vcu, G);
#endif
}
}


struct Args { const float* in[22]; float* out; unsigned char* ws; int ph_lo, ph_hi; };
struct Frame {
    LAS unsigned char* lds; volatile LAS unsigned* MISC; unsigned* ctl;
    int tid, lane, wave, vcu, G;
    unsigned char* ws; float* OUT;
};

__device__ __forceinline__ void p0_phase(Frame& F, const float* c, const float* w_ada, const float* b_ada) {
    LAS float* cs = (LAS float*)F.lds;
    LAS float* red = (LAS float*)(F.lds + 32768);
    for (int i = F.tid; i < NB * D; i += NTHREADS) { const float v = c[i]; cs[i] = v / (1.f + __expf(-v)); }
    __syncthreads();
    float* mod = (float*)(F.ws + WS_MOD);
    const int kq = F.wave, col = F.lane;
    for (int item = F.vcu; item < NL * 6 * D / 64; item += F.G) {
        const int l = item / (6 * D / 64), n0 = (item % (6 * D / 64)) * 64;
        const float* w = w_ada + (size_t)l * D * 6 * D + n0 + col;
        float acc[NB];
#pragma unroll
        for (int b = 0; b < NB; ++b) acc[b] = 0.f;
#pragma unroll 8
        for (int k = kq * 128; k < kq * 128 + 128; ++k) { const float wv = w[(size_t)k * 6 * D];
#pragma unroll
            for (int b = 0; b < NB; ++b) acc[b] += cs[b * D + k] * wv; }
#pragma unroll
        for (int b = 0; b < NB; ++b) red[(kq * NB + b) * 64 + col] = acc[b];
        __syncthreads();
        { const int b = F.wave; float s = 0.f;
#pragma unroll
          for (int q = 0; q < 8; ++q) s += red[(q * NB + b) * 64 + col];
          mod[((size_t)l * NB + b) * 6 * D + n0 + col] = s + b_ada[(size_t)l * 6 * D + n0 + col]; }
        __syncthreads();
    }
    float* cosA = (float*)(F.ws + WS_COSA); float* sinA = (float*)(F.ws + WS_SINA); float* cosB = (float*)(F.ws + WS_COSB); float* sinB = (float*)(F.ws + WS_SINB);
    for (int idx = F.vcu * NTHREADS + F.tid; idx < S * 48; idx += F.G * NTHREADS) {
        const int s = idx / 48, i = idx % 48; const float row = (float)(s >> 6), col2 = (float)(s & 63);
        if (i < 32) { const int j = i & 15; const float a = (i < 16 ? row : col2) * (1.0f / powf(10000.0f, (float)j / 16.0f)); cosA[s * 32 + i] = cosf(a); sinA[s * 32 + i] = sinf(a); }
        else { const int ii = i - 32, j = ii & 7; const float a = (ii < 8 ? row : col2) * (1.0f / powf(10000.0f, (float)j / 8.0f)); cosB[s * 16 + ii] = cosf(a); sinB[s * 16 + ii] = sinf(a); }
    }
}

template <class SrcFn>
__device__ __forceinline__ void cvt_item(const float* W, int K, int Nsrc, const float* kg, bf16_t* WT, LAS float* scr, int item, int nblk, int lane, const SrcFn& src) {
    const int kb = item / nblk, nb = item % nblk, k0 = 64 * kb, n0 = 32 * nb;
    const int sc = src(n0 + (lane & 31));
#pragma unroll
    for (int i = 0; i < 32; ++i) { const int kk = 2 * i + (lane >> 5); float v = sc >= 0 ? W[(size_t)(k0 + kk) * Nsrc + sc] : 0.f; if (kg) v *= kg[k0 + kk]; scr[kk * 33 + (lane & 31)] = v; }
    LDS_WAIT(); asm volatile("" ::: "memory");
    const int c = lane & 7;
#pragma unroll
    for (int j = 0; j < 4; ++j) { const int n = (lane >> 3) + 8 * j; const LAS float* s = scr + (8 * c) * 33 + n;
        u32x4 o; o.x = cvt_pk_bf16(s[0 * 33], s[1 * 33]); o.y = cvt_pk_bf16(s[2 * 33], s[3 * 33]); o.z = cvt_pk_bf16(s[4 * 33], s[5 * 33]); o.w = cvt_pk_bf16(s[6 * 33], s[7 * 33]);
        *(u32x4*)(WT + (size_t)(n0 + n) * K + k0 + 8 * c) = o; }
    LDS_WAIT(); asm volatile("" ::: "memory");
}
struct SrcId { __device__ int operator()(int n) const { return n; } };
struct SrcIn { __device__ int operator()(int n) const { return gp::src_col_in(n); } };
typedef __attribute__((address_space(4))) const Args CArgsW;
__device__ __forceinline__ void convert_weights(Frame& F, CArgsW* a, int l) {
    LAS float* scr = (LAS float*)(F.lds + F.wave * 16384);
    const int gw = F.vcu * NWAVES + F.wave, NGW = F.G * NWAVES;
    const float* w_in = ((const float*)(GAS const float*)a->in[5]) + (size_t)l * D * INC; const float* w_q_b = ((const float*)(GAS const float*)a->in[10]) + (size_t)l * 384 * 768; const float* w_kv_b = ((const float*)(GAS const float*)a->in[11]) + (size_t)l * 256 * 1024;
    const float* w_pa = ((const float*)(GAS const float*)a->in[12]) + (size_t)l * 512 * D; const float* w_pb = ((const float*)(GAS const float*)a->in[13]) + (size_t)l * 512 * D; const float* w_o = ((const float*)(GAS const float*)a->in[14]) + (size_t)l * D * D;
    const float* w1 = ((const float*)(GAS const float*)a->in[18]) + (size_t)l * NE * D * FF; const float* w3 = ((const float*)(GAS const float*)a->in[19]) + (size_t)l * NE * D * FF; const float* w2 = ((const float*)(GAS const float*)a->in[20]) + (size_t)l * NE * FF * D;
    const float* gqa = ((const float*)(GAS const float*)a->in[8]) + l * 384; const float* gkv = ((const float*)(GAS const float*)a->in[9]) + l * 256;
    bf16_t* Win = (bf16_t*)(F.ws + WS_WIN); bf16_t* Wqb = (bf16_t*)(F.ws + WS_WQB); bf16_t* Wkvb = (bf16_t*)(F.ws + WS_WKVB); bf16_t* Wpa = (bf16_t*)(F.ws + WS_WPA); bf16_t* Wpb = (bf16_t*)(F.ws + WS_WPB);
    bf16_t* Wo = (bf16_t*)(F.ws + WS_WO); bf16_t* W13 = (bf16_t*)(F.ws + WS_W13); bf16_t* W2 = (bf16_t*)(F.ws + WS_W2);
    constexpr int I_IN = (D / 64) * (NIN / 32), I_QB = (384 / 64) * (768 / 32), I_KVB = (256 / 64) * (1024 / 32), I_P = (512 / 64) * (D / 32), I_O = (D / 64) * (D / 32);
    constexpr int I_13 = (D / 64) * (1024 / 32), I_2 = (FF / 64) * (D / 32);
    constexpr int NITEMS = I_IN + I_QB + I_KVB + 2 * I_P + I_O + NE * (I_13 + I_2);
    for (int it = gw; it < NITEMS; it += NGW) {
        int r = it;
        if (r < I_IN) { cvt_item(w_in, D, INC, nullptr, Win, scr, r, NIN / 32, F.lane, SrcIn()); continue; } r -= I_IN;
        if (r < I_QB) { cvt_item(w_q_b, 384, 768, gqa, Wqb, scr, r, 768 / 32, F.lane, SrcId()); continue; } r -= I_QB;
        if (r < I_KVB) { cvt_item(w_kv_b, 256, 1024, gkv, Wkvb, scr, r, 1024 / 32, F.lane, SrcId()); continue; } r -= I_KVB;
        if (r < I_P) { cvt_item(w_pa, 512, D, nullptr, Wpa, scr, r, D / 32, F.lane, SrcId()); continue; } r -= I_P;
        if (r < I_P) { cvt_item(w_pb, 512, D, nullptr, Wpb, scr, r, D / 32, F.lane, SrcId()); continue; } r -= I_P;
        if (r < I_O) { cvt_item(w_o, D, D, nullptr, Wo, scr, r, D / 32, F.lane, SrcId()); continue; } r -= I_O;
        if (r < NE * I_13) { const int e = r / I_13, q = r % I_13, nb = q % 32;
            const float* src = ((nb & 7) < 4 ? w1 : w3) + (size_t)e * D * FF; const int cb = (nb >> 3) * 128 + (nb & 3) * 32;
            struct SrcOff { int n0, cb; __device__ int operator()(int n) const { return cb + (n - n0); } } so{nb * 32, cb};
            cvt_item(src, D, FF, nullptr, W13 + (size_t)e * 1024 * D, scr, q, 32, F.lane, so); continue; } r -= NE * I_13;
        { const int e = r / I_2, q = r % I_2; cvt_item(w2 + (size_t)e * FF * D, FF, D, nullptr, W2 + (size_t)e * D * FF, scr, q, D / 32, F.lane, SrcId()); }
    }
}

template <int MODE>
__device__ __forceinline__ void row_phase(Frame& F, const float* xin, const float* g2prev, const float* gain, const float* modl, int sh_off, int sc_off, bf16_t* H, bf16_t* XB, float* OUT) {
    constexpr int RB = 4, RPW = T / (256 * NWAVES);
    const int gw = F.vcu * NWAVES + F.wave, b = (gw * RPW) >> 12;
    const bf16_t* Y2 = (const bf16_t*)(F.ws + WS_Y2);
    f32x4 gs[4], shv[4], g2v[4];
#pragma unroll
    for (int j = 0; j < 4; ++j) { const int c = 4 * F.lane + 256 * j; gs[j] = *(const f32x4*)(gain + c);
        if (MODE != 2) { gs[j] = gs[j] * (1.f + *(const f32x4*)(modl + (size_t)b * 6 * D + sc_off + c)); shv[j] = *(const f32x4*)(modl + (size_t)b * 6 * D + sh_off + c); }
        if (MODE != 0) g2v[j] = *(const f32x4*)(g2prev + (size_t)b * 6 * D + 5 * D + c); }
    for (int m0 = gw * RPW; m0 < gw * RPW + RPW; m0 += RB) {
        f32x4 v[RB][4]; float ss[RB];
        if (MODE == 0) {
#pragma unroll
            for (int r = 0; r < RB; ++r)
#pragma unroll
                for (int j = 0; j < 4; ++j) v[r][j] = *(const f32x4*)(xin + (size_t)(m0 + r) * D + 4 * F.lane + 256 * j);
        } else {
            unsigned ya[RB][4], yb[RB][4];
#pragma unroll
            for (int r = 0; r < RB; ++r)
#pragma unroll
                for (int j = 0; j < 4; ++j) { const int m = m0 + r, c = 4 * F.lane + 256 * j;
                    { const u32x2 xb = *(const u32x2*)(XB + (size_t)m * D + c); v[r][j] = (f32x4){bf2f(xb.x & 0xffffu), bf2f(xb.x >> 16), bf2f(xb.y & 0xffffu), bf2f(xb.y >> 16)}; }
                    ya[r][j] = *(const unsigned*)((const unsigned char*)Y2 + (size_t)(2 * m) * D + c); yb[r][j] = *(const unsigned*)((const unsigned char*)Y2 + (size_t)(2 * m + 1) * D + c); }
#pragma unroll
            for (int r = 0; r < RB; ++r)
#pragma unroll
                for (int j = 0; j < 4; ++j) { const f32x2 a0 = __builtin_amdgcn_cvt_pk_f32_fp8((int)ya[r][j], false), a1 = __builtin_amdgcn_cvt_pk_f32_fp8((int)ya[r][j], true), b0 = __builtin_amdgcn_cvt_pk_f32_fp8((int)yb[r][j], false), b1 = __builtin_amdgcn_cvt_pk_f32_fp8((int)yb[r][j], true);
                    const f32x4 y = (f32x4){a0[0] + b0[0], a0[1] + b0[1], a1[0] + b1[0], a1[1] + b1[1]} * 0.0625f;
                    v[r][j] += g2v[j] * y; }
        }
#pragma unroll
        for (int r = 0; r < RB; ++r) { ss[r] = (gp::dot4(v[r][0]) + gp::dot4(v[r][1])) + (gp::dot4(v[r][2]) + gp::dot4(v[r][3])); }
#pragma unroll
        for (int o = 1; o < 64; o <<= 1)
#pragma unroll
            for (int r = 0; r < RB; ++r) ss[r] += __shfl_xor(ss[r], o);
#pragma unroll
        for (int r = 0; r < RB; ++r) {
            const int m = m0 + r; const float rstd = rsqrtf(ss[r] * (1.f / D) + EPS);
#pragma unroll
            for (int j = 0; j < 4; ++j) {
                const int c = 4 * F.lane + 256 * j;
                if (MODE == 2) { *(f32x4*)(OUT + (size_t)m * D + c) = v[r][j] * rstd * gs[j]; }
                else {
                    { u32x2 xw; xw.x = cvt_pk_bf16(v[r][j][0], v[r][j][1]); xw.y = cvt_pk_bf16(v[r][j][2], v[r][j][3]); st8((XB + (size_t)m * D + c), xw); }
                    const f32x4 hv = v[r][j] * rstd * gs[j] + shv[j];
                    u32x2 w; w.x = cvt_pk_bf16(hv[0], hv[1]); w.y = cvt_pk_bf16(hv[2], hv[3]);
                    st8((H + (size_t)m * D + c), w);
                }
            }
        }
    }
}

__device__ __forceinline__ void t2_phase(Frame& F, const float* gain, const float* modl, const float* w_router, const float* rbias, int l, bool record) {
    LAS f32x4* wl = (LAS f32x4*)F.lds;
    LAS int* rec = (LAS int*)(F.lds + 65536);
    LAS float* recw = (LAS float*)(F.lds + 65536 + 2048);
    LAS int* lcnt = (LAS int*)(F.lds + 65536 + 4096);
    for (int idx = F.tid; idx < 4096; idx += NTHREADS) {
        const int lane = idx & 63, c = (idx >> 6) & 3, i = (idx >> 8) & 3, j = idx >> 10; const int k = 4 * lane + 256 * j + i;
        wl[idx] = *(const f32x4*)(w_router + (size_t)k * NE + 4 * c);
    }
    if (F.tid < 32) lcnt[F.tid] = 0;
    __syncthreads();
    constexpr int RB = 4, RPW = T / (256 * NWAVES);
    const int gw = F.vcu * NWAVES + F.wave, bt = (gw * RPW) >> 12;
    bf16_t* H = (bf16_t*)(F.ws + WS_H); const bf16_t* XB = (const bf16_t*)(F.ws + WS_XB);
    const int lane = F.lane, myrow = lane >> 4, mye = lane & 15;
    f32x4 gs[4], shv[4];
#pragma unroll
    for (int j = 0; j < 4; ++j) { const int c = 4 * lane + 256 * j; gs[j] = *(const f32x4*)(gain + c) * (1.f + *(const f32x4*)(modl + (size_t)bt * 6 * D + 4 * D + c)); shv[j] = *(const f32x4*)(modl + (size_t)bt * 6 * D + 3 * D + c); }
    int it = 0;
    for (int m0 = gw * RPW; m0 < gw * RPW + RPW; m0 += RB, ++it) {
        f32x4 v[RB][4]; float ss[RB];
#pragma unroll
        for (int r = 0; r < RB; ++r)
#pragma unroll
            for (int j = 0; j < 4; ++j) { const u32x2 xb = *(const u32x2*)(XB + (size_t)(m0 + r) * D + 4 * lane + 256 * j); v[r][j] = (f32x4){bf2f(xb.x & 0xffffu), bf2f(xb.x >> 16), bf2f(xb.y & 0xffffu), bf2f(xb.y >> 16)}; }
#pragma unroll
        for (int r = 0; r < RB; ++r) ss[r] = (gp::dot4(v[r][0]) + gp::dot4(v[r][1])) + (gp::dot4(v[r][2]) + gp::dot4(v[r][3]));
#pragma unroll
        for (int o = 1; o < 64; o <<= 1)
#pragma unroll
            for (int r = 0; r < RB; ++r) ss[r] += __shfl_xor(ss[r], o);
        float acc[RB * NE];
#pragma unroll
        for (int q = 0; q < RB * NE; ++q) acc[q] = 0.f;
#pragma unroll
        for (int j = 0; j < 4; ++j) {
            const int c = 4 * lane + 256 * j;
#pragma unroll
            for (int r = 0; r < RB; ++r) {
                const int m = m0 + r; const float rstd = rsqrtf(ss[r] * (1.f / D) + EPS);
                v[r][j] = v[r][j] * rstd * gs[j] + shv[j];
                u32x2 w; w.x = cvt_pk_bf16(v[r][j][0], v[r][j][1]); w.y = cvt_pk_bf16(v[r][j][2], v[r][j][3]);
                st8((H + (size_t)m * D + c), w);
            }
#pragma unroll
            for (int i = 0; i < 4; ++i)
#pragma unroll
                for (int c4 = 0; c4 < 4; ++c4) { const f32x4 wv = wl[((j * 4 + i) * 4 + c4) * 64 + lane];
#pragma unroll
                    for (int r = 0; r < RB; ++r) { const float hv = v[r][j][i];
                        acc[r * NE + 4 * c4 + 0] += hv * wv[0]; acc[r * NE + 4 * c4 + 1] += hv * wv[1]; acc[r * NE + 4 * c4 + 2] += hv * wv[2]; acc[r * NE + 4 * c4 + 3] += hv * wv[3]; } }
        }
#pragma unroll
        for (int sft = 32; sft >= 1; sft >>= 1) {
            const bool up = (lane & sft) != 0;
#pragma unroll
            for (int k = 0; k < sft; ++k) { const float a = acc[k], b = acc[k + sft]; const float keep = up ? b : a, send = up ? a : b; acc[k] = keep + __shfl_xor(send, sft); }
        }
        const float logit = acc[0];
        const float score = 1.f / (1.f + expf(-logit));
        float scv[NE], bi[NE];
#pragma unroll
        for (int e = 0; e < NE; ++e) { scv[e] = __shfl(score, (lane & 48) | e); bi[e] = scv[e] + rbias[e]; }
        int gsel = 0; float gbest = -INFINITY;
#pragma unroll
        for (int g = 0; g < 4; ++g) { float m1 = -INFINITY, m2 = -INFINITY;
#pragma unroll
            for (int j = 0; j < 4; ++j) { const float x = bi[g * 4 + j]; if (x > m1) { m2 = m1; m1 = x; } else if (x > m2) m2 = x; }
            const float gs = m1 + m2; if (gs > gbest) { gbest = gs; gsel = g; } }
        int e1 = -1, e2 = -1; float b1 = -INFINITY, b2 = -INFINITY, s1 = 0.f, s2 = 0.f;
#pragma unroll
        for (int j = 0; j < 4; ++j) { float x = -INFINITY, sx = 0.f;
#pragma unroll
            for (int g = 0; g < 4; ++g) if (g == gsel) { x = bi[g * 4 + j]; sx = scv[g * 4 + j]; }
            const int e = gsel * 4 + j;
            if (x > b1) { b2 = b1; e2 = e1; s2 = s1; b1 = x; e1 = e; s1 = sx; } else if (x > b2) { b2 = x; e2 = e; s2 = sx; } }
        if (mye == 0) {
            const float inv = 1.f / (s1 + s2); const int slot = (it * RB + myrow) * NWAVES + F.wave;
            rec[slot * 4 + 0] = e1; rec[slot * 4 + 1] = e2;
            rec[slot * 4 + 2] = __hip_atomic_fetch_add(&lcnt[e1], 1, __ATOMIC_RELAXED, __HIP_MEMORY_SCOPE_WORKGROUP);
            rec[slot * 4 + 3] = __hip_atomic_fetch_add(&lcnt[e2], 1, __ATOMIC_RELAXED, __HIP_MEMORY_SCOPE_WORKGROUP);
            recw[slot * 2 + 0] = s1 * inv; recw[slot * 2 + 1] = s2 * inv;
        }
    }
    __syncthreads();
    if (!record) return;
    if (F.tid < NE) lcnt[16 + F.tid] = (int)__hip_atomic_fetch_add(F.ctl + CW_CNT + (l * NE + F.tid) * 64, (unsigned)lcnt[F.tid], __ATOMIC_RELAXED, __HIP_MEMORY_SCOPE_AGENT);
    __syncthreads();
    unsigned* list = (unsigned*)(F.ws + WS_LIST); float* gwb = (float*)(F.ws + WS_GW);
    const int nrows = it * RB;
    for (int s = F.tid; s < nrows * NWAVES; s += NTHREADS) {
        const int i2 = s / NWAVES, w = s % NWAVES; const int m = (F.vcu * NWAVES + w) * RPW + i2;
        const int e1 = rec[s * 4 + 0], e2 = rec[s * 4 + 1];
        list[(size_t)e1 * T + lcnt[16 + e1] + rec[s * 4 + 2]] = (unsigned)(2 * m); list[(size_t)e2 * T + lcnt[16 + e2] + rec[s * 4 + 3]] = (unsigned)(2 * m + 1);
        gwb[2 * m] = recw[s * 2]; gwb[2 * m + 1] = recw[s * 2 + 1];
    }
}
__device__ __forceinline__ const LAS int* moe_table(Frame& F, int l) {
    LAS int* tab = (LAS int*)(F.lds + MISC_OFF + 1024);
    __syncthreads();
    if (F.tid == 0) { int acc = 0;
        for (int e = 0; e < NE; ++e) { const int c = (int)__hip_atomic_load(F.ctl + CW_CNT + (l * NE + e) * 64, __ATOMIC_RELAXED, __HIP_MEMORY_SCOPE_AGENT); tab[e] = acc; tab[32 + e] = c; acc += (c + 255) >> 8; }
        tab[16] = acc; }
    __syncthreads();
    return tab;
}

typedef __attribute__((address_space(4))) const Args CArgs;
#define LAUNDER_GP(T_, p) do { GAS T_* _t = (GAS T_*)(p); asm volatile("" : "+s"(_t)); (p) = (T_*)_t; } while (0)
#define PH_BEGIN() LAUNDER_V(F.tid); F.lane = F.tid & 63; LAUNDER_GP(unsigned, F.ctl); LAUNDER_GP(float, F.OUT); LAUNDER_GP(unsigned char, F.ws); GAS unsigned char* ws = (GAS unsigned char*)F.ws; CArgs* ka = (CArgs*)__builtin_amdgcn_kernarg_segment_ptr(); LAUNDER_S(ka); \
    float* mod = WSP(float, WS_MOD); (void)mod; (void)ka
#define WSP(T_, off) ((T_*)(GAS T_*)(ws + (off)))
#define KIN(i) ((const float*)(GAS const float*)ka->in[i])
__global__ void __launch_bounds__(NTHREADS, 2) fwd_kernel(Args args) {
    extern __shared__ __attribute__((aligned(16))) unsigned char lds_raw[];
    Frame F;
    F.lds = (LAS unsigned char*)lds_raw; F.MISC = (volatile LAS unsigned*)(F.lds + MISC_OFF);
    F.tid = threadIdx.x; F.lane = F.tid & 63; F.wave = __builtin_amdgcn_readfirstlane(F.tid >> 6);
    F.G = gridDim.x; { const int bx = blockIdx.x; F.vcu = (F.G % 8 == 0) ? (bx % 8) * (F.G / 8) + bx / 8 : bx; }
    F.ws = (unsigned char*)(GAS unsigned char*)args.ws; F.ctl = (unsigned*)(GAS unsigned*)(args.ws + WS_CTL); F.OUT = (float*)(GAS float*)args.out;
    if (F.tid < 64) F.MISC[F.tid] = 0u;
    __syncthreads();
    XcdBarrier bar; bar.bar = F.ctl + CW_BAR; bar.x = 0; bar.st = nullptr;
    if (!N_LAUNCH_MODE) bar = xcd_barrier_post(F.ctl + CW_BAR, F.MISC + 8);
    const int lo = args.ph_lo, hi = args.ph_hi;
#define IN(k) (lo <= (k) && (k) < hi)
#define SEAM(k) do { if ((k) + 1 < hi) { if (!N_LAUNCH_MODE) xcd_barrier(bar); } } while (0)
    const int cidx = (int)blockIdx.x;

    if (IN(0)) { PH_BEGIN(); p0_phase(F, KIN(1), KIN(2), KIN(3)); __syncthreads(); LAUNDER_V(F.tid); F.lane = F.tid & 63; convert_weights(F, ka, 0); SEAM(0); }
    for (int l = 0; l < NL; ++l) {
        const int pb = 1 + 9 * l;
        if (IN(pb + 0)) {
            PH_BEGIN();
            if (l > 0) for (int rep = 0; rep < ((PROBE_DUP & 8) ? 2 : 1); ++rep) { LAUNDER_V(F.tid); F.lane = F.tid & 63; convert_weights(F, ka, l); }
            if (l == 0) row_phase<0>(F, KIN(0), nullptr, KIN(4) + l * D, mod + (size_t)l * NB * 6 * D, 0, D, WSP(bf16_t, WS_H), WSP(bf16_t, WS_XB), nullptr);
            else row_phase<1>(F, nullptr, mod + (size_t)(l - 1) * NB * 6 * D, KIN(4) + l * D, mod + (size_t)l * NB * 6 * D, 0, D, WSP(bf16_t, WS_H), WSP(bf16_t, WS_XB), nullptr);
            SEAM(pb + 0);
        }
        if (IN(pb + 1)) {
            PH_BEGIN();
            gp::Gemm g{WSP(bf16_t, WS_H), WSP(const bf16_t, WS_WIN), D, 0, nullptr}; gp::DenseOrder So; So.init(T, NIN, F.G, cidx);
            gp::EpiIn E{WSP(bf16_t, ATT_FP8_A ? WS_QA8 : WS_QA), WSP(bf16_t, ATT_FP8_A ? WS_KA8 : WS_KA), WSP(bf16_t, ATT_FP8_A ? WS_VTA8 : WS_VA), WSP(bf16_t, WS_QLAT), WSP(bf16_t, WS_KVLAT), WSP(bf16_t, ATT_FP8_B ? WS_KB8 : WS_KB), WSP(bf16_t, WS_SA), WSP(bf16_t, WS_SB), WSP(float, WS_SSQ), WSP(float, WS_SSKV),
                        KIN(6) + l * 64, KIN(7) + l * 64, WSP(const float, WS_COSA), WSP(const float, WS_SINA), WSP(const float, WS_COSB), WSP(const float, WS_SINB)};
            if (PROBE_DUP & 128) { gp::EpiNull En; gp::gemm_phase<gp::EpiNull, gp::DenseOrder>(F.tid, F.lds, g, So, En); LAUNDER_V(F.tid); }
            gp::gemm_phase<gp::EpiIn, gp::DenseOrder>(F.tid, F.lds, g, So, E); if (PROBE_DUP & (2 | 512)) { LAUNDER_V(F.tid); gp::gemm_phase<gp::EpiIn, gp::DenseOrder>(F.tid, F.lds, g, So, E); }
            SEAM(pb + 1);
        }
        if (IN(pb + 2)) {
            { PH_BEGIN(); gp::Gemm g{WSP(bf16_t, WS_QLAT), WSP(const bf16_t, WS_WQB), 384, 0, nullptr}; gp::DenseOrder So; So.init(T, 768, F.G, cidx);
              gp::EpiQb E{WSP(bf16_t, ATT_FP8_B ? WS_QB8 : WS_QB), WSP(const float, WS_SSQ), WSP(const float, WS_COSB), WSP(const float, WS_SINB)}; gp::gemm_phase<gp::EpiQb, gp::DenseOrder>(F.tid, F.lds, g, So, E); if (PROBE_DUP & 2) { LAUNDER_V(F.tid); gp::gemm_phase<gp::EpiQb, gp::DenseOrder>(F.tid, F.lds, g, So, E); } }
            { PH_BEGIN(); gp::Gemm g{WSP(bf16_t, WS_KVLAT), WSP(const bf16_t, WS_WKVB), 256, 0, nullptr}; gp::DenseOrder So; So.init(T, 1024, F.G, F.G - 1 - cidx);
              gp::EpiKvb E{WSP(bf16_t, ATT_FP8_B ? WS_KB8 : WS_KB), WSP(bf16_t, ATT_FP8_B ? WS_VTB8 : WS_VB), WSP(const float, WS_SSKV)}; gp::gemm_phase<gp::EpiKvb, gp::DenseOrder>(F.tid, F.lds, g, So, E); if (PROBE_DUP & 2) { LAUNDER_V(F.tid); gp::gemm_phase<gp::EpiKvb, gp::DenseOrder>(F.tid, F.lds, g, So, E); } }
            if (PROBE_DUP & 1) { PH_BEGIN(); const at::Tensors A{WSP(bf16_t, WS_QA), 512, WSP(bf16_t, WS_KA), 128, WSP(bf16_t, WS_VA), 128, WSP(bf16_t, WS_OB), 512, 4}; at::attn_phase<64>(F.tid, F.lds, A, F.vcu, F.G); }
#if FAST_ATTN && ATT_FP8_A
            { PH_BEGIN(); at::attn_phase_f8a(F.tid, F.lds, WSP(const unsigned char, WS_QA8), WSP(const unsigned char, WS_KA8), WSP(const unsigned char, WS_VTA8), WSP(bf16_t, WS_QA), 512, KIN(6) + l * 64, KIN(7) + l * 64, F.vcu, F.G); }
#else
            { PH_BEGIN(); const at::Tensors A{WSP(bf16_t, WS_QA), 512, WSP(bf16_t, WS_KA), 128, WSP(bf16_t, WS_VA), 128, WSP(bf16_t, WS_QA), 512, 4}; at::attn_phase<64>(F.tid, F.lds, A, F.vcu, F.G); }
#endif
            SEAM(pb + 2);
        }
        if (IN(pb + 3)) {
            PH_BEGIN();
#if FAST_ATTN && ATT_FP8_B
            at::attn_phase_f8b(F.tid, F.lds, WSP(const unsigned char, WS_QB8), WSP(const unsigned char, WS_KB8), WSP(const unsigned char, WS_VTB8), WSP(bf16_t, WS_OB), 512, F.vcu, F.G);
#else
            const at::Tensors A{WSP(bf16_t, WS_QB), 768, WSP(bf16_t, WS_KB), 768, WSP(bf16_t, WS_VB), 512, WSP(bf16_t, WS_OB), 512, 1}; for (int rep = 0; rep < ((PROBE_DUP & 1) ? 2 : 1); ++rep) at::attn_phase<96>(F.tid, F.lds, A, F.vcu, F.G);
#endif
            SEAM(pb + 3);
        }
        if (IN(pb + 4)) {
            PH_BEGIN();
            gp::Gemm g{WSP(bf16_t, WS_QA), WSP(const bf16_t, WS_WPA), 512, (size_t)(WS_WPB - WS_WPA) / 2, nullptr, (size_t)(WS_OB - WS_QA) / 2}; gp::PairOrder So; So.init(T, D, F.G, cidx);
            gp::EpiProjP E{WSP(bf16_t, WS_H), WSP(const unsigned char, WS_SA), WSP(const unsigned char, WS_SB)};
            gp::gemm_phase<gp::EpiProjP, gp::PairOrder>(F.tid, F.lds, g, So, E);
            if (PROBE_DUP & (2 | 1024)) { LAUNDER_V(F.tid); gp::gemm_phase<gp::EpiProjP, gp::PairOrder>(F.tid, F.lds, g, So, E); }
            SEAM(pb + 4);
        }
        if (IN(pb + 5)) {
            PH_BEGIN();
            gp::Gemm g{WSP(bf16_t, WS_H), WSP(const bf16_t, WS_WO), D, 0, nullptr}; gp::DenseOrder So; So.init(T, D, F.G, cidx);
            gp::EpiWo E{WSP(const bf16_t, WS_XB), mod + (size_t)l * NB * 6 * D, WSP(bf16_t, WS_XB)}; gp::gemm_phase<gp::EpiWo, gp::DenseOrder>(F.tid, F.lds, g, So, E);
            SEAM(pb + 5);
        }
        if (IN(pb + 6)) {
            PH_BEGIN();
            if (PROBE_DUP & 16) { t2_phase(F, KIN(15) + l * D, mod + (size_t)l * NB * 6 * D, KIN(16), KIN(17), l, false); LAUNDER_V(F.tid); F.lane = F.tid & 63; __syncthreads(); }
            t2_phase(F, KIN(15) + l * D, mod + (size_t)l * NB * 6 * D, KIN(16), KIN(17), l, true);
            SEAM(pb + 6);
        }
        if (IN(pb + 7)) {
            PH_BEGIN();
            const LAS int* tab = moe_table(F, l);
            gp::Gemm g{WSP(bf16_t, WS_H), WSP(const bf16_t, WS_W13), D, (size_t)1024 * D, WSP(const unsigned, WS_LIST)}; gp::MoeOrder So; So.init(tab, F.G, cidx);
            if (PROBE_DUP & 256) { gp::EpiNull En; gp::gemm_phase<gp::EpiNull, gp::MoeOrder, true>(F.tid, F.lds, g, So, En); LAUNDER_V(F.tid); }
            gp::EpiUp E{WSP(bf16_t, WS_ACT)}; gp::gemm_phase<gp::EpiUp, gp::MoeOrder, true>(F.tid, F.lds, g, So, E); if (PROBE_DUP & 4) { LAUNDER_V(F.tid); gp::gemm_phase<gp::EpiUp, gp::MoeOrder, true>(F.tid, F.lds, g, So, E); }
            SEAM(pb + 7);
        }
        if (IN(pb + 8)) {
            PH_BEGIN();
            const LAS int* tab = moe_table(F, l);
            gp::Gemm g{WSP(bf16_t, WS_ACT), WSP(const bf16_t, WS_W2), FF, (size_t)D * FF, nullptr}; gp::MoeOrder So; So.init(tab, F.G, cidx);
            gp::EpiDown E{WSP(bf16_t, WS_Y2), WSP(const unsigned, WS_LIST), WSP(const float, WS_GW)}; gp::gemm_phase<gp::EpiDown, gp::MoeOrder, false>(F.tid, F.lds, g, So, E); if (PROBE_DUP & 4) { LAUNDER_V(F.tid); gp::gemm_phase<gp::EpiDown, gp::MoeOrder, false>(F.tid, F.lds, g, So, E); }
            SEAM(pb + 8);
        }
    }
    if (IN(NPHASE - 1)) { PH_BEGIN(); row_phase<2>(F, nullptr, mod + (size_t)(NL - 1) * NB * 6 * D, KIN(21), nullptr, 0, 0, nullptr, WSP(bf16_t, WS_XB), F.OUT); }
#undef IN
#undef SEAM
}

extern "C" void kernel_launch(void* const* d_in, const int* in_sizes, int n_in, void* d_out, int out_size, void* d_ws, size_t ws_size, hipStream_t stream) {
    static int grid = 0;
    if (grid == 0) {
        if (n_in != 22 || out_size != T * D || ws_size < WS_END) { fprintf(stderr, "kernel_launch: unexpected problem (n_in %d out %d ws %zu)\n", n_in, out_size, ws_size); grid = -1; return; }
        int dev = 0, cus = 0, per_cu = 0;
        if (hipGetDevice(&dev) != hipSuccess || hipDeviceGetAttribute(&cus, hipDeviceAttributeMultiprocessorCount, dev) != hipSuccess) { grid = -1; return; }
        if (hipFuncSetAttribute((const void*)fwd_kernel, hipFuncAttributeMaxDynamicSharedMemorySize, LDS_BYTES) != hipSuccess) { grid = -1; return; }
        if (hipOccupancyMaxActiveBlocksPerMultiprocessor(&per_cu, (const void*)fwd_kernel, NTHREADS, LDS_BYTES) != hipSuccess || per_cu < 1) { fprintf(stderr, "kernel_launch: occupancy query says %d\n", per_cu); }
        (void)hipGetLastError();
        grid = cus;
        if (grid != 256 || T % (grid * NWAVES * 4) != 0) {   fprintf(stderr, "kernel_launch: grid %d does not divide the row phases\n", grid); grid = -1; return; }
    }
    if (grid < 0) return;
    (void)hipMemsetAsync((char*)d_ws + WS_CTL, 0, CTL_BYTES, stream);
    Args a{};
    for (int i = 0; i < 22; ++i) a.in[i] = (const float*)d_in[i];
    a.out = (float*)d_out; a.ws = (unsigned char*)d_ws;
#if N_LAUNCH_MODE
    for (int p = 0; p < NPHASE; ++p) { a.ph_lo = p; a.ph_hi = p + 1; hipLaunchKernelGGL(fwd_kernel, dim3(grid), dim3(NTHREADS), LDS_BYTES, stream, a); }
#else
    a.ph_lo = 0; a.ph_hi = NPHASE;
    hipLaunchKernelGGL(fwd_kernel, dim3(grid), dim3(NTHREADS), LDS_BYTES, stream, a);
#endif
}
```

```cpp
#include <hip/hip_runtime.h>
#include <stdint.h>
#include <stdio.h>
#include <math.h>

#ifndef FAST_GEMM
#define FAST_GEMM 1
#endif
#ifndef FAST_ATTN
#define FAST_ATTN 1
#endif
#ifndef PROBE_DUP
#define PROBE_DUP 0
#endif
#ifndef PROBE_ATT
#define PROBE_ATT 0
#endif
#ifndef ATT_REGSTAGE
#define ATT_REGSTAGE 0
#endif
#ifndef WT_STORES
#define WT_STORES 0
#endif
#ifndef ATT_FP8_A
#define ATT_FP8_A 1
#endif
#ifndef ATT_FP8_B
#define ATT_FP8_B 1
#endif
#ifndef N_LAUNCH_MODE
#define N_LAUNCH_MODE 0
#endif

#define LAS __attribute__((address_space(3)))
#define GAS __attribute__((address_space(1)))
typedef unsigned short bf16_t;
typedef short bf16x8 __attribute__((ext_vector_type(8)));
typedef float f32x4 __attribute__((ext_vector_type(4)));
typedef float f32x2 __attribute__((ext_vector_type(2)));
typedef float f32x16 __attribute__((ext_vector_type(16)));
typedef unsigned u32x4 __attribute__((ext_vector_type(4)));
typedef unsigned u32x2 __attribute__((ext_vector_type(2)));
typedef GAS unsigned gu32;

constexpr int D = 1024, NB = 8, S = 4096, T = NB * S, NL = 4, INC = 3488, NIN = 3584, NE = 16, FF = 512;
constexpr float EPS = 1e-6f, LOG2E = 1.4426950408889634f;
constexpr float QSCALE_A = 0.125f * LOG2E, QSCALE_B = 0.10206207261596577f * LOG2E;
constexpr int NWAVES = 8, NTHREADS = 512;
constexpr int NPHASE = 2 + 9 * NL;

constexpr size_t MiB = 1u << 20;
constexpr size_t WS_CTL = 0, CTL_BYTES = 1 * MiB;
constexpr size_t WS_MOD = 1 * MiB;
constexpr size_t WS_COSA = 2 * MiB, WS_SINA = WS_COSA + 512 * 1024, WS_COSB = 3 * MiB, WS_SINB = WS_COSB + 256 * 1024;
constexpr size_t WS_SSQ = 4 * MiB, WS_SSKV = 5 * MiB;
constexpr size_t WS_GW = 6 * MiB;
constexpr size_t WS_LIST = 7 * MiB;
constexpr size_t WS_WIN = 10 * MiB, WS_WQB = 17 * MiB, WS_WKVB = 18 * MiB, WS_WPA = 19 * MiB, WS_WPB = 20 * MiB, WS_WO = 21 * MiB, WS_W13 = 23 * MiB, WS_W2 = 55 * MiB;
constexpr size_t WS_H = 72 * MiB;
constexpr size_t WS_QA = 136 * MiB, WS_KA = 168 * MiB, WS_VA = 176 * MiB, WS_QLAT = 184 * MiB, WS_KVLAT = 208 * MiB;
constexpr size_t WS_KB = 224 * MiB, WS_VB = 272 * MiB, WS_QB = 304 * MiB, WS_OB = 352 * MiB, WS_SA = 384 * MiB, WS_SB = 448 * MiB, WS_XB = 512 * MiB, WS_QA8 = 576 * MiB, WS_KA8 = 592 * MiB, WS_VTA8 = 596 * MiB, WS_QB8 = 600 * MiB, WS_KB8 = 624 * MiB, WS_VTB8 = 648 * MiB, WS_END = 664 * MiB;
constexpr size_t WS_ACT = 136 * MiB, WS_Y2 = 208 * MiB;
constexpr int ACT_ROWS = 2 * T + NE * 256;
static_assert(WS_ACT + (size_t)ACT_ROWS * FF * 2 <= WS_Y2 && WS_Y2 + (size_t)2 * T * D * 2 <= WS_XB, "moe overlay");
constexpr int CW_BAR = 4096;
constexpr int CW_CNT = 16384;

constexpr int RING_BYTES = 131072, MISC_OFF = RING_BYTES, LDS_BYTES = 147456;

__device__ __forceinline__ float bf2f(unsigned v) { return __uint_as_float(v << 16); }
typedef __bf16 bf16x2_t __attribute__((ext_vector_type(2)));
__device__ __forceinline__ unsigned cvt_pk_bf16(float lo, float hi) { f32x2 v = {lo, hi}; bf16x2_t b = __builtin_convertvector(v, bf16x2_t); return __builtin_bit_cast(unsigned, b); }
__device__ __forceinline__ u32x4 pack8(f32x4 a, f32x4 b) { u32x4 w; w.x = cvt_pk_bf16(a[0], a[1]); w.y = cvt_pk_bf16(a[2], a[3]); w.z = cvt_pk_bf16(b[0], b[1]); w.w = cvt_pk_bf16(b[2], b[3]); return w; }
__device__ __forceinline__ u32x2 pack8_fp8(f32x4 a, f32x4 b) { u32x2 w;
    w.x = (unsigned)__builtin_amdgcn_cvt_pk_fp8_f32(a[2], a[3], __builtin_amdgcn_cvt_pk_fp8_f32(a[0], a[1], 0, false), true);
    w.y = (unsigned)__builtin_amdgcn_cvt_pk_fp8_f32(b[2], b[3], __builtin_amdgcn_cvt_pk_fp8_f32(b[0], b[1], 0, false), true); return w; }
__device__ __forceinline__ void unpack8(u32x4 w, f32x4& a, f32x4& b) { a[0] = bf2f(w.x & 0xffffu); a[1] = bf2f(w.x >> 16); a[2] = bf2f(w.y & 0xffffu); a[3] = bf2f(w.y >> 16); b[0] = bf2f(w.z & 0xffffu); b[1] = bf2f(w.z >> 16); b[2] = bf2f(w.w & 0xffffu); b[3] = bf2f(w.w >> 16); }
__device__ __forceinline__ float wave_sum(float v) {
#pragma unroll
    for (int o = 1; o < 64; o <<= 1) v += __shfl_xor(v, o);
    return v;
}
__device__ __forceinline__ float sigm(float v) { return __builtin_amdgcn_rcpf(1.f + __builtin_amdgcn_exp2f(v * (-LOG2E))); }
#if WT_STORES
__device__ __forceinline__ void st16(void* p, u32x4 v) { asm volatile("global_store_dwordx4 %0, %1, off sc1\n\ts_nop 1" :: "v"(p), "v"(v) : "memory"); }
__device__ __forceinline__ void st8(void* p, u32x2 v) { asm volatile("global_store_dwordx2 %0, %1, off sc1\n\ts_nop 1" :: "v"(p), "v"(v) : "memory"); }
#else
__device__ __forceinline__ void st16(void* p, u32x4 v) { *(u32x4*)p = v; }
__device__ __forceinline__ void st8(void* p, u32x2 v) { *(u32x2*)p = v; }
#endif
#define VM_WAIT() asm volatile("s_waitcnt vmcnt(0)" ::: "memory")
#define LAUNDER_S(p) asm volatile("" : "+s"(p))
#define LAUNDER_V(v) asm volatile("" : "+v"(v))
#define LDS_WAIT() asm volatile("s_waitcnt lgkmcnt(0)" ::: "memory")

#define XB_TMO      128
#define XB_XCNT(j)  (256  + 64 * (j))
#define XB_XSUB(j)  (1280 + 64 * (j))
#define XB_XGEN(j)  (2304 + 64 * (j))
#define XB_TOP      3328
#define XB_TOPGEN   3392
#define XCD_BAR_WORDS 3456
#define XB_SPIN_CAP (1u << 22)
__device__ __forceinline__ unsigned xb_ld(unsigned* p)              { return __hip_atomic_load(p, __ATOMIC_RELAXED, __HIP_MEMORY_SCOPE_AGENT); }
__device__ __forceinline__ unsigned xb_add(unsigned* p, unsigned v) { return __hip_atomic_fetch_add(p, v, __ATOMIC_RELAXED, __HIP_MEMORY_SCOPE_AGENT); }
__device__ __forceinline__ unsigned xb_xcc_id() { return (unsigned)__builtin_amdgcn_s_getreg((3 << 11) | 20) & 0xFu; }
#define XB_SPIN(cond, bar) do { unsigned _sp = 0; while (cond) { __builtin_amdgcn_s_sleep(1); \
    if ((++_sp & 255u) == 0u) { if (xb_ld(&(bar)[XB_TMO])) break; if (_sp > XB_SPIN_CAP) { atomicAdd(&(bar)[XB_TMO], 1u); break; } } } } while (0)
struct XcdBarrier { unsigned* bar; unsigned x; volatile LAS unsigned* st; };
__device__ __forceinline__ XcdBarrier xcd_barrier_post(unsigned* bar, volatile LAS unsigned* st) {
    XcdBarrier b; b.bar = bar; b.x = xb_xcc_id(); b.st = st;
    if (threadIdx.x == 0) (void)xb_add(&bar[XB_XCNT(b.x)], 1u);
    return b;
}
__device__ __forceinline__ void xcd_barrier_complete(unsigned* bar, unsigned x, unsigned& nloc, unsigned& nx) {
    const unsigned G = gridDim.x * gridDim.y * gridDim.z;
    unsigned sum, cnt, mine, sp = 0u;
    for (;;) {
        sum = 0u; cnt = 0u; mine = 0u;
#pragma unroll
        for (unsigned j = 0; j < 16; ++j) { const unsigned c = xb_ld(&bar[XB_XCNT(j)]); sum += c; cnt += (c > 0u) ? 1u : 0u; mine = (j == x) ? c : mine; }
        if (sum == G) break;
        __builtin_amdgcn_s_sleep(1);
        if ((++sp & 255u) == 0u) { if (xb_ld(&bar[XB_TMO])) break; if (sp > XB_SPIN_CAP) { atomicAdd(&bar[XB_TMO], 1u); break; } }
    }
    nloc = mine > 0u ? mine : 1u; nx = cnt > 0u ? cnt : 1u;
}
__device__ __forceinline__ void xcd_barrier(const XcdBarrier& b) {
    asm volatile("s_waitcnt vmcnt(0)" ::: "memory");
    __syncthreads();
    if (threadIdx.x == 0) {
        unsigned* bar = b.bar;
        __builtin_amdgcn_s_waitcnt(0);
        unsigned nloc = b.st[0], nx = b.st[1];
        if (nloc == 0u) { xcd_barrier_complete(bar, b.x, nloc, nx); b.st[0] = nloc; b.st[1] = nx; }
        const unsigned old = xb_add(&bar[XB_XSUB(b.x)], 1u);
        const unsigned gen = old / nloc;
        if (old + 1u == (gen + 1u) * nloc) {
            __builtin_amdgcn_fence(__ATOMIC_RELEASE, "agent");
            asm volatile("s_waitcnt vmcnt(0)" ::: "memory");
            const unsigned og = xb_add(&bar[XB_TOP], 1u);
            const unsigned tg = og / nx;
            if (og + 1u == (tg + 1u) * nx) xb_add(&bar[XB_TOPGEN], 1u);
            else XB_SPIN(xb_ld(&bar[XB_TOPGEN]) == tg, bar);
            __builtin_amdgcn_fence(__ATOMIC_ACQUIRE, "agent");
            xb_add(&bar[XB_XGEN(b.x)], 1u);
            asm volatile("s_waitcnt vmcnt(0)" ::: "memory");
        } else {
            XB_SPIN(xb_ld(&bar[XB_XGEN(b.x)]) == gen, bar);
            __builtin_amdgcn_fence(__ATOMIC_ACQUIRE, "agent");
            asm volatile("s_waitcnt vmcnt(0)" ::: "memory");
        }
    }
    __syncthreads();
}

namespace gp {
constexpr int BM = 256, BK = 64, HALF = 128, HTB = HALF * BK * 2, NXCD = 8, WGM = 8;
__host__ __device__ __forceinline__ int lds_byte(int r, int c) { const int st = (r >> 4) * 2 + (c >> 5), rr = r & 15, cc = c & 31, ob = rr * 64 + cc * 2; return st * 1024 + (ob ^ (((ob >> 9) & 1) << 5)); }
__host__ __device__ __forceinline__ void stage_rc(int b, int& R, int& C) { const int st = b / 1024, sb = b % 1024, swz = sb ^ (((sb >> 9) & 1) << 5); R = (st >> 1) * 16 + swz / 64; C = (st & 1) * 32 + (swz % 64) / 2; }
__host__ __device__ __forceinline__ int perm32(int rho) { const int n = rho >> 4, i = rho & 15; return 8 * (i >> 2) + 4 * n + (i & 3); }

struct Unit { int pm, pn, be, rl, nv; };
struct Gemm { const bf16_t* A; const bf16_t* Bt; int K; size_t bstride; const unsigned* list; size_t astride; };

__device__ __forceinline__ int xcd_remap(int wgid, int nwg) { const int q = nwg / NXCD, r = nwg % NXCD, xcd = wgid % NXCD, off = wgid / NXCD; return (xcd < r ? xcd * (q + 1) : r * (q + 1) + (xcd - r) * q) + off; }
struct DenseOrder {
    int nM, nN, nwg, G, c;
    __device__ void init(int M, int N, int G_, int c_) { nM = M / BM; nN = N / BM; nwg = nM * nN; G = G_; c = c_; }
    __device__ bool next(int i, Unit& u) const {
        const long L = (long)i * G + c; if (L >= nwg) return false;
        const int wgid = xcd_remap((int)L, nwg);
        const int nig = WGM * nN, gid = wgid / nig, fm = gid * WGM, gsz = (nM - fm) < WGM ? (nM - fm) : WGM;
        u.pm = fm + ((wgid % nig) % gsz); u.pn = (wgid % nig) / gsz; u.be = 0; u.rl = 0; u.nv = 256; return true;
    }
};
struct PairOrder {
    DenseOrder d;
    __device__ void init(int M, int N, int G_, int c_) { d.init(M, N, G_, c_); }
    __device__ bool next(int i, Unit& u) const { if (!d.next(i >> 1, u)) return false; u.be = i & 1; return true; }
};
struct MoeOrder {
    const LAS int* tab; int nwg, G, c;
    __device__ static int rd(const LAS int* p) { return __builtin_amdgcn_readfirstlane(*p); }
    __device__ void init(const LAS int* tab_, int G_, int c_) { tab = tab_; nwg = rd(tab_ + 16) * 4; G = G_; c = c_; }
    __device__ bool next(int i, Unit& u) const {
        const long L = (long)i * G + c; if (L >= nwg) return false;
        const int wgid = xcd_remap((int)L, nwg);
        const int tile = wgid >> 2; int e = 0;
        for (int k = 1; k < NE; ++k) e += (rd(tab + k) <= tile) ? 1 : 0;
        u.pm = tile; u.pn = wgid & 3; u.be = e; u.rl = tile - rd(tab + e); const int rem = rd(tab + 32 + e) - u.rl * 256; u.nv = rem < 256 ? rem : 256; return true;
    }
};

#define ACC_T f32x4 (&acc)[2][2][4][2]

template <class Epi, class Sched, bool GATHER>
__device__ __forceinline__ void gemm_phase_ref(int tid, const Gemm g, const Sched& S, const Epi& E) {
    const int wid = __builtin_amdgcn_readfirstlane(tid >> 6), lane = tid & 63, wr = wid >> 2, wc = wid & 3, fr = lane & 15, fq = lane >> 4;
    const int K = g.K; Unit u;
    for (int ui = 0; S.next(ui, u); ++ui) {
        f32x4 acc[2][2][4][2];
#pragma unroll
        for (int a = 0; a < 2; ++a)
#pragma unroll
            for (int b = 0; b < 2; ++b)
#pragma unroll
                for (int m = 0; m < 4; ++m)
#pragma unroll
                    for (int n = 0; n < 2; ++n) acc[a][b][m][n] = (f32x4){0.f, 0.f, 0.f, 0.f};
        const bf16_t* Bt = g.Bt + (size_t)u.be * g.bstride + (size_t)u.pn * 256 * K;
        for (int ai = 0; ai < 2; ++ai)
            for (int m = 0; m < 4; ++m) {
                const int rloc = ai * 128 + wr * 64 + m * 16 + fr;
                size_t arow;
                if (GATHER) { arow = (rloc < u.nv) ? (size_t)(g.list[(size_t)u.be * T + u.rl * 256 + rloc] >> 1) : 0; }
                else arow = (size_t)u.pm * 256 + rloc;
                const bf16_t* ap = g.A + arow * K;
                for (int bj = 0; bj < 2; ++bj) {
                    const bf16_t* bp = Bt + (size_t)(bj * 128 + wc * 32 + fq * 8) * K;
                    float s[8];
#pragma unroll
                    for (int c = 0; c < 8; ++c) {
                        float sc = 0.f; const bf16_t* bpc = bp + (size_t)c * K;
#pragma unroll 2
                        for (int k = 0; k < K; k += 8) {
                            f32x4 a0, a1, b0, b1; unpack8(*(const u32x4*)(ap + k), a0, a1); unpack8(*(const u32x4*)(bpc + k), b0, b1);
                            sc += a0[0] * b0[0] + a0[1] * b0[1] + a0[2] * b0[2] + a0[3] * b0[3] + a1[0] * b1[0] + a1[1] * b1[1] + a1[2] * b1[2] + a1[3] * b1[3];
                        }
                        s[c] = sc; asm volatile("" : "+v"(s[c]));
                    }
#pragma unroll
                    for (int a2 = 0; a2 < 2; ++a2)
#pragma unroll
                        for (int b2 = 0; b2 < 2; ++b2)
#pragma unroll
                            for (int m2 = 0; m2 < 4; ++m2)
                                if (a2 == ai && b2 == bj && m2 == m) { acc[a2][b2][m2][0] = (f32x4){s[0], s[1], s[2], s[3]}; acc[a2][b2][m2][1] = (f32x4){s[4], s[5], s[6], s[7]}; }
                }
            }
        E(acc, u, wr, wc, fr, fq);
    }
}

template <class E> struct EpiTraits { static constexpr bool KEEP = false; };
#if FAST_GEMM
template <class Epi, class Sched, bool GATHER>
__device__ __forceinline__ void gemm_phase_fast(int tid, LAS unsigned char* lds, const Gemm g, const Sched& S, const Epi& E) {
    const int wid = __builtin_amdgcn_readfirstlane(tid >> 6), lane = tid & 63, wr = wid >> 2, wc = wid & 3, fr = lane & 15, fq = lane >> 4;
    const int K = g.K, nt = K / BK;
    int Rr[2], Cc[2]; unsigned voffB[2];
#pragma unroll
    for (int i = 0; i < 2; ++i) { stage_rc(tid * 16 + i * 8192, Rr[i], Cc[i]); const int Rb = (Rr[i] & ~31) + perm32(Rr[i] & 31); voffB[i] = (unsigned)(Rb * K + Cc[i]) * 2u; }
    const size_t kstep = (size_t)(BK * 2), hstep = (size_t)HALF * K * 2, tstep = 2 * hstep;
    const unsigned ldsw = (unsigned)wid * 1024u;
    const int aoff = lds_byte(wr * 64 + fr, fq * 8), boff = lds_byte(wc * 32 + fr, fq * 8);
#define GP_SA(b, h) (((b) * 2 + (h)) * HTB)
#define GP_SB(b, h) ((4 + (b) * 2 + (h)) * HTB)
#define GP_STAGE2(bufoff, gbase, v0, v1) do { \
        __builtin_amdgcn_global_load_lds((const unsigned*)((const char*)(gbase) + (v0)), (LAS unsigned*)(lds + (bufoff) + ldsw), 16, 0, 0); \
        __builtin_amdgcn_global_load_lds((const unsigned*)((const char*)(gbase) + (v1)), (LAS unsigned*)(lds + (bufoff) + ldsw + 8192), 16, 0, 0); } while (0)
#define GP_STAGEB(bufoff, gbase) GP_STAGE2(bufoff, gbase, voffB[0], voffB[1])
#define GP_LDA(dst, b, h) do { _Pragma("unroll") for (int m = 0; m < 4; ++m) _Pragma("unroll") for (int k = 0; k < 2; ++k) dst[m][k] = *(const LAS bf16x8*)(lds + GP_SA(b, h) + aoff + m * 2048 + k * 1024); } while (0)
#define GP_LDB(dst, b, h) do { _Pragma("unroll") for (int n = 0; n < 2; ++n) _Pragma("unroll") for (int k = 0; k < 2; ++k) dst[n][k] = *(const LAS bf16x8*)(lds + GP_SB(b, h) + boff + n * 2048 + k * 1024); } while (0)
#define GP_MMA(ai, bj, At, Bt) do { __builtin_amdgcn_s_setprio(1); _Pragma("unroll") for (int m = 0; m < 4; ++m) _Pragma("unroll") for (int n = 0; n < 2; ++n) _Pragma("unroll") for (int k = 0; k < 2; ++k) \
        acc[ai][bj][m][n] = __builtin_amdgcn_mfma_f32_16x16x32_bf16(Bt[n][k], At[m][k], acc[ai][bj][m][n], 0, 0, 0); __builtin_amdgcn_s_setprio(0); } while (0)
#define GP_WAIT_V(n) asm volatile("s_waitcnt vmcnt(" #n ")" ::: "memory")
#define GP_WAIT_L(n) asm volatile("s_waitcnt lgkmcnt(" #n ")" ::: "memory")
#define GP_BAR __builtin_amdgcn_s_barrier()
#define GP_SCHED __builtin_amdgcn_sched_barrier(0)
    Unit cur, nxt; int ui = 0;
    if (!S.next(0, cur)) return;
    f32x4 acc[2][2][4][2];
#pragma unroll
    for (int a = 0; a < 2; ++a)
#pragma unroll
        for (int b = 0; b < 2; ++b)
#pragma unroll
            for (int m = 0; m < 4; ++m)
#pragma unroll
                for (int n = 0; n < 2; ++n) acc[a][b][m][n] = (f32x4){0.f, 0.f, 0.f, 0.f};
    bf16x8 At[4][2], B0[2][2], B1[2][2];
    unsigned vC0, vC1, vC2, vC3, vN0, vN1, vN2, vN3;
#define GP_VOFF(u, o0, o1, o2, o3) do { if (GATHER) { \
        int tl_ = tid; LAUNDER_V(tl_); int R0_, C0_, R1_, C1_; stage_rc(tl_ * 16, R0_, C0_); stage_rc(tl_ * 16 + 8192, R1_, C1_);     \
        const unsigned* lp = g.list + (size_t)(u).be * T + (u).rl * 256; \
        const int nvm = (u).nv - 1; const int p0 = min(R0_, nvm), p1 = min(R1_, nvm), p2 = min(128 + R0_, nvm), p3 = min(128 + R1_, nvm); \
        const unsigned t0 = lp[p0] >> 1, t1 = lp[p1] >> 1, t2 = lp[p2] >> 1, t3 = lp[p3] >> 1; \
        o0 = (t0 * K + C0_) * 2u; o1 = (t1 * K + C1_) * 2u; o2 = (t2 * K + C0_) * 2u; o3 = (t3 * K + C1_) * 2u; \
      } else { o0 = (unsigned)(Rr[0] * K + Cc[0]) * 2u; o1 = (unsigned)(Rr[1] * K + Cc[1]) * 2u; o2 = o0 + (unsigned)hstep; o3 = o1 + (unsigned)hstep; } } while (0)
    GP_VOFF(cur, vC0, vC1, vC2, vC3);
    const char* cA = (const char*)g.A + ((size_t)cur.be * g.astride) * 2 + (GATHER ? (size_t)0 : (size_t)cur.pm * tstep);
    const char* cB = (const char*)g.Bt + ((size_t)cur.be * g.bstride) * 2 + (size_t)cur.pn * tstep;
    GP_STAGEB(GP_SB(0, 0), cB); GP_STAGEB(GP_SB(0, 1), cB + hstep); GP_STAGE2(GP_SA(0, 0), cA, vC0, vC1); GP_STAGE2(GP_SA(0, 1), cA, vC2, vC3);
    if (wr == 1) GP_BAR;
    GP_WAIT_V(2); GP_BAR;
    GP_STAGEB(GP_SB(1, 0), cB + kstep); GP_STAGE2(GP_SA(1, 0), cA + kstep, vC0, vC1); GP_STAGEB(GP_SB(1, 1), cB + hstep + kstep);
    GP_WAIT_V(6); GP_BAR;
    for (;;) {
        const bool has_next = S.next(ui + 1, nxt);
        const char* nA = has_next ? (const char*)g.A + ((size_t)nxt.be * g.astride) * 2 + (GATHER ? (size_t)0 : (size_t)nxt.pm * tstep) : cA;
        const char* nB = has_next ? (const char*)g.Bt + ((size_t)nxt.be * g.bstride) * 2 + (size_t)nxt.pn * tstep : cB;
        if (has_next) { GP_VOFF(nxt, vN0, vN1, vN2, vN3); } else { vN0 = vC0; vN1 = vC1; vN2 = vC2; vN3 = vC3; }
#pragma nounroll
        for (int t = 0; t < nt; t += 2) {
            const bool last = (t == nt - 2);
            const char* a1 = cA + (size_t)(t + 1) * kstep;
            const char* a2 = last ? nA : cA + (size_t)(t + 2) * kstep; const char* b2 = last ? nB : cB + (size_t)(t + 2) * kstep;
            const char* a3 = a2 + kstep; const char* b3 = b2 + kstep;
            const unsigned w0 = last ? vN0 : vC0, w1 = last ? vN1 : vC1, w2 = last ? vN2 : vC2, w3 = last ? vN3 : vC3;
            GP_LDB(B0, 0, 0); GP_LDB(B1, 0, 1); GP_SCHED; GP_LDA(At, 0, 0); GP_STAGE2(GP_SA(1, 1), a1, vC2, vC3);
            GP_WAIT_V(8); GP_WAIT_L(0); GP_BAR; GP_MMA(0, 0, At, B0); GP_MMA(0, 1, At, B1); GP_BAR; GP_SCHED;
            GP_LDA(At, 0, 1); GP_STAGEB(GP_SB(0, 0), b2); GP_STAGEB(GP_SB(0, 1), b2 + hstep); GP_STAGE2(GP_SA(0, 0), a2, w0, w1);
            GP_WAIT_V(8); GP_WAIT_L(0); GP_BAR; GP_MMA(1, 0, At, B0); GP_MMA(1, 1, At, B1); GP_BAR; GP_SCHED;
            GP_LDB(B0, 1, 0); GP_LDB(B1, 1, 1); GP_SCHED; GP_LDA(At, 1, 0); GP_STAGE2(GP_SA(0, 1), a2, w2, w3);
            GP_WAIT_V(8); GP_WAIT_L(0); GP_BAR; GP_MMA(0, 0, At, B0); GP_MMA(0, 1, At, B1); GP_BAR; GP_SCHED;
            GP_LDA(At, 1, 1); GP_STAGEB(GP_SB(1, 0), b3); GP_STAGEB(GP_SB(1, 1), b3 + hstep); GP_STAGE2(GP_SA(1, 0), a3, w0, w1);
            GP_WAIT_V(8); GP_WAIT_L(0); GP_BAR; GP_MMA(1, 0, At, B0); GP_MMA(1, 1, At, B1); GP_BAR; GP_SCHED;
        }
        if (wr == 0) GP_BAR;
        E(acc, cur, wr, wc, fr, fq);
        if (!has_next) break;
        if (!(EpiTraits<Epi>::KEEP && cur.be == 0)) {
#pragma unroll
        for (int a = 0; a < 2; ++a)
#pragma unroll
            for (int b = 0; b < 2; ++b)
#pragma unroll
                for (int m = 0; m < 4; ++m)
#pragma unroll
                    for (int n = 0; n < 2; ++n) acc[a][b][m][n] = (f32x4){0.f, 0.f, 0.f, 0.f};
        }
        cur = nxt; cA = nA; cB = nB; vC0 = vN0; vC1 = vN1; vC2 = vN2; vC3 = vN3; ++ui;
        if (wr == 1) GP_BAR;
    }
    GP_WAIT_V(0);
    GP_BAR;
#undef GP_SA
#undef GP_SB
#undef GP_STAGE2
#undef GP_STAGEB
#undef GP_LDA
#undef GP_LDB
#undef GP_MMA
#undef GP_WAIT_V
#undef GP_WAIT_L
#undef GP_BAR
#undef GP_SCHED
#undef GP_VOFF
}
#endif

template <class Epi, class Sched, bool GATHER = false>
__device__ __forceinline__ void gemm_phase(int tid, LAS unsigned char* lds, const Gemm g, const Sched& S, const Epi& E) {
#if FAST_GEMM
    gemm_phase_fast<Epi, Sched, GATHER>(tid, lds, g, S, E);
#else
    (void)lds; gemm_phase_ref<Epi, Sched, GATHER>(tid, g, S, E);
#endif
}

#define EPI_ROW(ai, m) (u.pm * 256 + (ai) * 128 + wr * 64 + (m) * 16 + fr)
#define EPI_COL(bj) (u.pn * 256 + (bj) * 128 + wc * 32 + fq * 8)
__device__ __forceinline__ float dot4(f32x4 a) { return (a[0] * a[0] + a[1] * a[1]) + (a[2] * a[2] + a[3] * a[3]); }

struct EpiNull {
    __device__ __forceinline__ void operator()(const ACC_T, const Unit& u, int wr, int wc, int fr, int fq) const {
#pragma unroll
        for (int ai = 0; ai < 2; ++ai)
#pragma unroll
            for (int bj = 0; bj < 2; ++bj)
#pragma unroll
                for (int m = 0; m < 4; ++m) asm volatile("" :: "v"(acc[ai][bj][m][0]), "v"(acc[ai][bj][m][1]));
    }
};
struct EpiIn {
    bf16_t *QA, *KA, *VA, *QLAT, *KVLAT, *KB, *SA, *SB; float *SSQ, *SSKV; const float *gq, *gk, *cosA, *sinA, *cosB, *sinB;
    __device__ __forceinline__ void operator()(const ACC_T, const Unit& u, int wr, int wc, int fr, int fq) const {
        const int wb = u.pn * 4 + wc;
        if (wb < 10) {
            const bool isq = wb < 8; const int head = isq ? wb : wb - 8; const float* g = isq ? gq : gk; bf16_t* dst = isq ? QA : KA; const int dp = isq ? 512 : 128; const float qs = isq ? QSCALE_A : 1.f;
            const f32x4 g00 = *(const f32x4*)(g + 8 * fq), g01 = *(const f32x4*)(g + 8 * fq + 4), g10 = *(const f32x4*)(g + 32 + 8 * fq), g11 = *(const f32x4*)(g + 36 + 8 * fq);
#pragma unroll
            for (int ai = 0; ai < 2; ++ai)
#pragma unroll
                for (int m = 0; m < 4; ++m) {
                    const int r = EPI_ROW(ai, m), pos = r & (S - 1);
                    const f32x4 v00 = acc[ai][0][m][0], v01 = acc[ai][0][m][1], v10 = acc[ai][1][m][0], v11 = acc[ai][1][m][1];
                    float ss = (dot4(v00) + dot4(v01)) + (dot4(v10) + dot4(v11)); ss += __shfl_xor(ss, 16); ss += __shfl_xor(ss, 32);
                    const float rstd = rsqrtf(ss * (1.f / 64.f) + EPS);
                    const f32x4 y00 = v00 * rstd * g00, y01 = v01 * rstd * g01, y10 = v10 * rstd * g10, y11 = v11 * rstd * g11;
                    const f32x4 c0 = *(const f32x4*)(cosA + pos * 32 + 8 * fq), c1 = *(const f32x4*)(cosA + pos * 32 + 8 * fq + 4), s0 = *(const f32x4*)(sinA + pos * 32 + 8 * fq), s1 = *(const f32x4*)(sinA + pos * 32 + 8 * fq + 4);
                    const f32x4 o00 = (y00 * c0 - y10 * s0) * qs, o01 = (y01 * c1 - y11 * s1) * qs, o10 = (y10 * c0 + y00 * s0) * qs, o11 = (y11 * c1 + y01 * s1) * qs;
#if ATT_FP8_A
                    unsigned char* p8 = (unsigned char*)dst + (size_t)r * dp + head * 64 + 8 * fq;
                    st8(p8, pack8_fp8(o00, o01)); st8(p8 + 32, pack8_fp8(o10, o11));
#else
                    bf16_t* p = dst + (size_t)r * dp + head * 64 + 8 * fq;
                    st16(p, pack8(o00, o01)); st16((p + 32), pack8(o10, o11));
#endif
                }
        } else if (wb < 12) {
#pragma unroll
            for (int ai = 0; ai < 2; ++ai)
#pragma unroll
                for (int m = 0; m < 4; ++m) {
#if ATT_FP8_A
                    const int r = EPI_ROW(ai, m), sq = r & (S - 1), k = sq & 63, pos = 32 * ((k >> 2) & 1) + 16 * (k >> 5) + (k & 3) + 4 * ((k & 31) >> 3);
                    unsigned char* vtb = (unsigned char*)VA; const unsigned vo = (unsigned)(((r >> 12) * 2 + (wb - 10)) * 64 + 8 * fq) * S + (unsigned)((sq & ~63) + pos);
#pragma unroll
                    for (int bj = 0; bj < 2; ++bj)
#pragma unroll
                        for (int n = 0; n < 2; ++n) { const f32x4 x = acc[ai][bj][m][n]; const unsigned w = (unsigned)__builtin_amdgcn_cvt_pk_fp8_f32(x[2], x[3], __builtin_amdgcn_cvt_pk_fp8_f32(x[0], x[1], 0, false), true);
                            const unsigned qo = vo + (unsigned)(bj * 32 + 4 * n) * S;
                            vtb[qo] = (unsigned char)(w & 0xffu); vtb[qo + S] = (unsigned char)((w >> 8) & 0xffu); vtb[qo + 2 * S] = (unsigned char)((w >> 16) & 0xffu); vtb[qo + 3 * S] = (unsigned char)(w >> 24); }
#else
                    bf16_t* p = VA + (size_t)EPI_ROW(ai, m) * 128 + (wb - 10) * 64 + 8 * fq;
                    st16(p, pack8(acc[ai][0][m][0], acc[ai][0][m][1])); st16((p + 32), pack8(acc[ai][1][m][0], acc[ai][1][m][1]));
#endif
                }
        } else if (wb < 22) {
            const bool isq = wb < 18; const int idx = isq ? wb - 12 : wb - 18; bf16_t* dst = isq ? QLAT : KVLAT; const int dp = isq ? 384 : 256;
#pragma unroll
            for (int ai = 0; ai < 2; ++ai)
#pragma unroll
                for (int m = 0; m < 4; ++m) {
                    const int r = EPI_ROW(ai, m);
                    const f32x4 v00 = acc[ai][0][m][0], v01 = acc[ai][0][m][1], v10 = acc[ai][1][m][0], v11 = acc[ai][1][m][1];
                    float ss = (dot4(v00) + dot4(v01)) + (dot4(v10) + dot4(v11)); ss += __shfl_xor(ss, 16); ss += __shfl_xor(ss, 32);
                    if (fq == 0) { if (isq) SSQ[(size_t)r * 8 + idx] = ss; else SSKV[(size_t)r * 4 + idx] = ss; }
                    bf16_t* p = dst + (size_t)r * dp + idx * 64 + 8 * fq;
                    st16(p, pack8(v00, v01)); st16((p + 32), pack8(v10, v11));
                }
        } else if (wb == 22) {
            if (fq < 2) {
#pragma unroll
                for (int ai = 0; ai < 2; ++ai)
#pragma unroll
                    for (int m = 0; m < 4; ++m) {
                        const int r = EPI_ROW(ai, m), pos = r & (S - 1);
                        const f32x4 x10 = acc[ai][0][m][0], x11 = acc[ai][0][m][1], x20 = acc[ai][1][m][0], x21 = acc[ai][1][m][1];
                        const f32x4 c0 = *(const f32x4*)(cosB + pos * 16 + 8 * fq), c1 = *(const f32x4*)(cosB + pos * 16 + 8 * fq + 4), s0 = *(const f32x4*)(sinB + pos * 16 + 8 * fq), s1 = *(const f32x4*)(sinB + pos * 16 + 8 * fq + 4);
#if ATT_FP8_B
                        const u32x2 w1 = pack8_fp8(x10 * c0 - x20 * s0, x11 * c1 - x21 * s1), w2 = pack8_fp8(x20 * c0 + x10 * s0, x21 * c1 + x11 * s1);
                        unsigned char* p = (unsigned char*)KB + (size_t)r * 768 + 64 + 8 * fq;
#pragma unroll
                        for (int h = 0; h < 8; ++h) { st8(p + h * 96, w1); st8(p + h * 96 + 16, w2); }
#else
                        const u32x4 w1 = pack8(x10 * c0 - x20 * s0, x11 * c1 - x21 * s1), w2 = pack8(x20 * c0 + x10 * s0, x21 * c1 + x11 * s1);
                        bf16_t* p = KB + (size_t)r * 768 + 64 + 8 * fq;
#pragma unroll
                        for (int h = 0; h < 8; ++h) { st16((p + h * 96), w1); st16((p + h * 96 + 16), w2); }
#endif
                    }
            }
        } else if (wb == 23) {
        } else {
            const bool isa = wb < 40; const int idx = isa ? wb - 24 : wb - 40; unsigned char* dst = (unsigned char*)(isa ? SA : SB);
#pragma unroll
            for (int ai = 0; ai < 2; ++ai)
#pragma unroll
                for (int m = 0; m < 4; ++m) { unsigned char* p = dst + (size_t)EPI_ROW(ai, m) * 1024 + idx * 64 + 8 * fq;
#pragma unroll
                    for (int bj = 0; bj < 2; ++bj) { const f32x4 a = acc[ai][bj][m][0], b = acc[ai][bj][m][1]; u32x2 w;
                        w.x = (unsigned)__builtin_amdgcn_cvt_pk_fp8_f32(a[2], a[3], __builtin_amdgcn_cvt_pk_fp8_f32(a[0], a[1], 0, false), true);
                        w.y = (unsigned)__builtin_amdgcn_cvt_pk_fp8_f32(b[2], b[3], __builtin_amdgcn_cvt_pk_fp8_f32(b[0], b[1], 0, false), true);
                        st8((p + bj * 32), w); } }
        }
    }
};
__host__ __device__ __forceinline__ int src_col_in(int n) {
    const int pn = n >> 8, nl = n & 255, bj = nl >> 7, wc = (nl & 127) >> 5, p = nl & 31, wb = pn * 4 + wc, s = bj * 32 + p;
    if (wb < 8) return wb * 64 + s;
    if (wb < 10) return 512 + (wb - 8) * 64 + s;
    if (wb < 12) return 640 + (wb - 10) * 64 + s;
    if (wb < 18) return 768 + (wb - 12) * 64 + s;
    if (wb < 22) return 1152 + (wb - 18) * 64 + s;
    if (wb == 22) return p < 16 ? 1408 + bj * 16 + p : -1;
    if (wb == 23) return -1;
    if (wb < 40) return 1440 + (wb - 24) * 64 + s;
    return 2464 + (wb - 40) * 64 + s;
}
struct EpiQb {
    bf16_t* QB; const float *SSQ, *cosB, *sinB;
    __device__ __forceinline__ void operator()(const ACC_T, const Unit& u, int wr, int wc, int fr, int fq) const {
#pragma unroll
        for (int ai = 0; ai < 2; ++ai)
#pragma unroll
            for (int m = 0; m < 4; ++m) {
                const int r = EPI_ROW(ai, m), pos = r & (S - 1);
                const f32x4 sa = *(const f32x4*)(SSQ + (size_t)r * 8); const f32x2 sb = *(const f32x2*)(SSQ + (size_t)r * 8 + 4);
                const float rstd = rsqrtf((((sa[0] + sa[1]) + (sa[2] + sa[3])) + (sb[0] + sb[1])) * (1.f / 384.f) + EPS);
#pragma unroll
                for (int bj = 0; bj < 2; ++bj) {
                    f32x4 v0 = acc[ai][bj][m][0] * rstd, v1 = acc[ai][bj][m][1] * rstd;
                    const int c32 = u.pn * 8 + bj * 4 + wc;
                    if (c32 % 3 == 2) {
                        f32x4 o0, o1;
#pragma unroll
                        for (int j = 0; j < 4; ++j) { o0[j] = __shfl_xor(v0[j], 32); o1[j] = __shfl_xor(v1[j], 32); }
                        const int i0 = 8 * (fq & 1);
                        const f32x4 c0 = *(const f32x4*)(cosB + pos * 16 + i0), c1 = *(const f32x4*)(cosB + pos * 16 + i0 + 4), s0 = *(const f32x4*)(sinB + pos * 16 + i0), s1 = *(const f32x4*)(sinB + pos * 16 + i0 + 4);
                        if (fq < 2) { v0 = v0 * c0 - o0 * s0; v1 = v1 * c1 - o1 * s1; } else { v0 = v0 * c0 + o0 * s0; v1 = v1 * c1 + o1 * s1; }
                    }
#if ATT_FP8_B
                    st8((unsigned char*)QB + (size_t)r * 768 + EPI_COL(bj), pack8_fp8(v0 * QSCALE_B, v1 * QSCALE_B));
#else
                    st16((QB + (size_t)r * 768 + EPI_COL(bj)), pack8(v0 * QSCALE_B, v1 * QSCALE_B));
#endif
                }
            }
    }
};
struct EpiKvb {
    bf16_t *KB, *VB; const float* SSKV;
    __device__ __forceinline__ void operator()(const ACC_T, const Unit& u, int wr, int wc, int fr, int fq) const {
#pragma unroll
        for (int ai = 0; ai < 2; ++ai)
#pragma unroll
            for (int m = 0; m < 4; ++m) {
                const int r = EPI_ROW(ai, m);
                const f32x4 sa = *(const f32x4*)(SSKV + (size_t)r * 4);
                const float rstd = rsqrtf(((sa[0] + sa[1]) + (sa[2] + sa[3])) * (1.f / 256.f) + EPS);
#pragma unroll
                for (int bj = 0; bj < 2; ++bj) {
                    const int head = u.pn * 2 + bj, o = wc * 32 + fq * 8;
#if ATT_FP8_B
                    const f32x4 x0 = acc[ai][bj][m][0] * rstd, x1 = acc[ai][bj][m][1] * rstd;
                    if (wc < 2) st8((unsigned char*)KB + (size_t)r * 768 + head * 96 + o, pack8_fp8(x0, x1));
                    else {
                        const int sq = r & (S - 1), k = sq & 63, pos = 32 * ((k >> 2) & 1) + 16 * (k >> 5) + (k & 3) + 4 * ((k & 31) >> 3);
                        unsigned char* vtb = (unsigned char*)VB; const unsigned vo = (unsigned)(((r >> 12) * 8 + head) * 64 + (o - 64)) * S + (unsigned)((sq & ~63) + pos);
                        const u32x2 w = pack8_fp8(x0, x1);
                        vtb[vo] = (unsigned char)(w.x & 0xffu); vtb[vo + S] = (unsigned char)((w.x >> 8) & 0xffu); vtb[vo + 2 * S] = (unsigned char)((w.x >> 16) & 0xffu); vtb[vo + 3 * S] = (unsigned char)(w.x >> 24);
                        vtb[vo + 4 * S] = (unsigned char)(w.y & 0xffu); vtb[vo + 5 * S] = (unsigned char)((w.y >> 8) & 0xffu); vtb[vo + 6 * S] = (unsigned char)((w.y >> 16) & 0xffu); vtb[vo + 7 * S] = (unsigned char)(w.y >> 24);
                    }
#else
                    const u32x4 w = pack8(acc[ai][bj][m][0] * rstd, acc[ai][bj][m][1] * rstd);
                    if (wc < 2) st16((KB + (size_t)r * 768 + head * 96 + o), w); else st16((VB + (size_t)r * 512 + head * 64 + (o - 64)), w);
#endif
                }
            }
    }
};
template <int MODE> struct EpiProj {
    bf16_t* O; const bf16_t* gate;
    __device__ __forceinline__ void operator()(const ACC_T, const Unit& u, int wr, int wc, int fr, int fq) const {
#pragma unroll
        for (int ai = 0; ai < 2; ++ai)
#pragma unroll
            for (int m = 0; m < 4; ++m) {
                const int r = EPI_ROW(ai, m);
#pragma unroll
                for (int bj = 0; bj < 2; ++bj) {
                    const size_t off = (size_t)r * D + EPI_COL(bj);
                    const u32x2 gw = *(const u32x2*)((const unsigned char*)gate + off);
                    const f32x2 q0 = __builtin_amdgcn_cvt_pk_f32_fp8((int)gw.x, false), q1 = __builtin_amdgcn_cvt_pk_f32_fp8((int)gw.x, true), q2 = __builtin_amdgcn_cvt_pk_f32_fp8((int)gw.y, false), q3 = __builtin_amdgcn_cvt_pk_f32_fp8((int)gw.y, true);
                    const f32x4 g0 = {sigm(q0[0]), sigm(q0[1]), sigm(q1[0]), sigm(q1[1])}, g1 = {sigm(q2[0]), sigm(q2[1]), sigm(q3[0]), sigm(q3[1])};
                    f32x4 v0 = acc[ai][bj][m][0] * g0, v1 = acc[ai][bj][m][1] * g1;
                    if (MODE == 1) { f32x4 p0, p1; unpack8(*(const u32x4*)(O + off), p0, p1); v0 += p0; v1 += p1; }
                    if (MODE == 1) st16(O + off, pack8(v0, v1)); else *(u32x4*)(O + off) = pack8(v0, v1);
                }
            }
    }
};
struct EpiProjP {
    bf16_t* O; const unsigned char* SA; const unsigned char* SB;
    __device__ static __forceinline__ void gates(const unsigned char* G, size_t off, f32x4& g0, f32x4& g1) {
        const u32x2 gw = *(const u32x2*)(G + off);
        const f32x2 q0 = __builtin_amdgcn_cvt_pk_f32_fp8((int)gw.x, false), q1 = __builtin_amdgcn_cvt_pk_f32_fp8((int)gw.x, true), q2 = __builtin_amdgcn_cvt_pk_f32_fp8((int)gw.y, false), q3 = __builtin_amdgcn_cvt_pk_f32_fp8((int)gw.y, true);
        g0 = (f32x4){sigm(q0[0]), sigm(q0[1]), sigm(q1[0]), sigm(q1[1])}; g1 = (f32x4){sigm(q2[0]), sigm(q2[1]), sigm(q3[0]), sigm(q3[1])};
    }
    __device__ __forceinline__ void operator()(f32x4 (&acc)[2][2][4][2], const Unit& u, int wr, int wc, int fr, int fq) const {
#pragma unroll
        for (int ai = 0; ai < 2; ++ai)
#pragma unroll
            for (int m = 0; m < 4; ++m) {
                const int r = EPI_ROW(ai, m);
#pragma unroll
                for (int bj = 0; bj < 2; ++bj) {
                    const size_t off = (size_t)r * D + EPI_COL(bj);
                    f32x4 b0, b1; gates(SB, off, b0, b1);
#pragma unroll
                    for (int j = 0; j < 4; ++j) { b0[j] = fmaxf(b0[j], 9.094947e-13f); b1[j] = fmaxf(b1[j], 9.094947e-13f); }
                    if (u.be == 0) {
                        f32x4 a0, a1; gates(SA, off, a0, a1);
#pragma unroll
                        for (int j = 0; j < 4; ++j) { acc[ai][bj][m][0][j] *= a0[j] * __builtin_amdgcn_rcpf(b0[j]); acc[ai][bj][m][1][j] *= a1[j] * __builtin_amdgcn_rcpf(b1[j]); }
                    } else st16(O + off, pack8(acc[ai][bj][m][0] * b0, acc[ai][bj][m][1] * b1));
                }
            }
    }
};
template <> struct EpiTraits<EpiProjP> { static constexpr bool KEEP = true; };
struct EpiWo {
    const bf16_t* X; const float* modl; bf16_t* XO;
    __device__ __forceinline__ void operator()(const ACC_T, const Unit& u, int wr, int wc, int fr, int fq) const {
        const float* g1 = modl + (size_t)(u.pm >> 4) * 6 * D + 2 * D;
#pragma unroll
        for (int bj = 0; bj < 2; ++bj) {
            const int c = EPI_COL(bj); const f32x4 ga = *(const f32x4*)(g1 + c), gb = *(const f32x4*)(g1 + c + 4);
#pragma unroll
            for (int ai = 0; ai < 2; ++ai)
#pragma unroll
                for (int m = 0; m < 4; ++m) { const size_t off = (size_t)EPI_ROW(ai, m) * D + c;
                    f32x4 x0, x1; unpack8(*(const u32x4*)(X + off), x0, x1);
                    st16((XO + off), pack8(x0 + ga * acc[ai][bj][m][0], x1 + gb * acc[ai][bj][m][1])); }
        }
    }
};
struct EpiUp {
    bf16_t* ACT;
    __device__ __forceinline__ void operator()(const ACC_T, const Unit& u, int wr, int wc, int fr, int fq) const {
#pragma unroll
        for (int ai = 0; ai < 2; ++ai)
#pragma unroll
            for (int m = 0; m < 4; ++m) {
                f32x4 a = acc[ai][0][m][0], b = acc[ai][0][m][1]; const f32x4 c = acc[ai][1][m][0], d = acc[ai][1][m][1];
#pragma unroll
                for (int j = 0; j < 4; ++j) { a[j] = a[j] * sigm(a[j]) * c[j]; b[j] = b[j] * sigm(b[j]) * d[j]; }
                st16((ACT + (size_t)EPI_ROW(ai, m) * FF + u.pn * 128 + wc * 32 + fq * 8), pack8(a, b));
            }
    }
};
struct EpiDown {
    bf16_t* Y2; const unsigned* list; const float* gw;
    __device__ __forceinline__ void operator()(const ACC_T, const Unit& u, int wr, int wc, int fr, int fq) const {
#pragma unroll
        for (int ai = 0; ai < 2; ++ai)
#pragma unroll
            for (int m = 0; m < 4; ++m) {
                const int rloc = ai * 128 + wr * 64 + m * 16 + fr;
                if (rloc < u.nv) {
                    const unsigned entry = list[(size_t)u.be * T + u.rl * 256 + rloc]; const float w = gw[entry];
#pragma unroll
                    for (int bj = 0; bj < 2; ++bj) { const f32x4 a = acc[ai][bj][m][0] * (w * 16.f), b = acc[ai][bj][m][1] * (w * 16.f); u32x2 q;
                        q.x = (unsigned)__builtin_amdgcn_cvt_pk_fp8_f32(a[2], a[3], __builtin_amdgcn_cvt_pk_fp8_f32(a[0], a[1], 0, false), true);
                        q.y = (unsigned)__builtin_amdgcn_cvt_pk_fp8_f32(b[2], b[3], __builtin_amdgcn_cvt_pk_fp8_f32(b[0], b[1], 0, false), true);
                        st8(((unsigned char*)Y2 + (size_t)entry * D + EPI_COL(bj)), q); }
                }
            }
    }
};
}

namespace at {
struct Tensors { const bf16_t* Q; int qp; const bf16_t* K; int kp; const bf16_t* V; int vp; bf16_t* O; int op; int group; };
__device__ __forceinline__ bool next_unit(int i, int vcu, int G, int& bh, int& qb) {
    int u;
    if (G == 256) { if (i >= 4) return false; u = (vcu >> 5) * 128 + i * 32 + (vcu & 31); }
    else { u = i * G + vcu; if (u >= 1024) return false; }
    bh = u >> 4; qb = u & 15; return true;
}
template <int DQK>
__device__ __forceinline__ void attn_phase_ref(int tid, const Tensors& A, int vcu, int G) {
    int bh, qb;
    for (int i = 0; next_unit(i, vcu, G, bh, qb); ++i) {
        const int b = bh >> 3, h = bh & 7, kvh = h / A.group;
        {
            const int dh = tid >> 8;
            const size_t row = (size_t)b * S + qb * 256 + (tid & 255);
            float q[DQK], o[32];
#pragma unroll
            for (int d = 0; d < DQK; ++d) q[d] = bf2f(A.Q[row * A.qp + h * DQK + d]);
#pragma unroll
            for (int d = 0; d < 32; ++d) o[d] = 0.f;
            float l = 0.f;
            for (int k = 0; k < S; ++k) {
                const bf16_t* kr = A.K + ((size_t)b * S + k) * A.kp + kvh * DQK; const bf16_t* vr = A.V + ((size_t)b * S + k) * A.vp + kvh * 64 + dh * 32;
                float sc = 0.f;
#pragma unroll
                for (int d = 0; d < DQK; d += 8) { f32x4 k0, k1; unpack8(*(const u32x4*)(kr + d), k0, k1);
                    sc += q[d] * k0[0] + q[d + 1] * k0[1] + q[d + 2] * k0[2] + q[d + 3] * k0[3] + q[d + 4] * k1[0] + q[d + 5] * k1[1] + q[d + 6] * k1[2] + q[d + 7] * k1[3]; }
                const float p = bf2f(cvt_pk_bf16(exp2f(sc), 0.f) & 0xffffu); l += p;
#pragma unroll
                for (int d = 0; d < 32; d += 8) { f32x4 v0, v1; unpack8(*(const u32x4*)(vr + d), v0, v1);
                    o[d] += p * v0[0]; o[d + 1] += p * v0[1]; o[d + 2] += p * v0[2]; o[d + 3] += p * v0[3]; o[d + 4] += p * v1[0]; o[d + 5] += p * v1[1]; o[d + 6] += p * v1[2]; o[d + 7] += p * v1[3]; }
            }
            const float il = 1.f / l;
            __syncthreads();
#pragma unroll
            for (int d = 0; d < 32; d += 8) { f32x4 a = {o[d] * il, o[d + 1] * il, o[d + 2] * il, o[d + 3] * il}, c = {o[d + 4] * il, o[d + 5] * il, o[d + 6] * il, o[d + 7] * il};
                *(u32x4*)(A.O + row * A.op + h * 64 + dh * 32 + d) = pack8(a, c); }
        }
    }
}
#if FAST_ATTN
typedef short s16x4 __attribute__((ext_vector_type(4)));
__device__ __forceinline__ unsigned cvtpk(float lo, float hi) { f32x2 v = {lo, hi}; bf16x2_t b = __builtin_convertvector(v, bf16x2_t); return __builtin_bit_cast(unsigned, b); }
__device__ __forceinline__ s16x4 vtr(const LAS unsigned char* p) { return __builtin_bit_cast(s16x4, __builtin_amdgcn_ds_read_tr16_b64_v4i16((LAS s16x4*)p)); }
__device__ __forceinline__ int crow(int r, int hi) { return (r & 3) + 8 * (r >> 2) + 4 * hi; }
#define AT_BAR() asm volatile("s_barrier" ::: "memory")
#define AT_WAITBAR(N) asm volatile("s_waitcnt vmcnt(" #N ") lgkmcnt(0)\n\ts_barrier" ::: "memory")
#define AT_SCHED() __builtin_amdgcn_sched_barrier(0)
__device__ __forceinline__ void glds16(const void* gsrc, unsigned lds_dst) { unsigned keep;
    asm volatile("s_mov_b32 %0, m0\n\ts_mov_b32 m0, %2\n\ts_nop 0\n\tglobal_load_lds_dwordx4 %1, off\n\ts_mov_b32 m0, %0" : "=&s"(keep) : "v"(gsrc), "s"(lds_dst) : "memory"); }
#define AT_GLDS(g, l) glds16((const void*)(g), (unsigned)__builtin_amdgcn_readfirstlane((int)(unsigned)(uintptr_t)(l)))
template <int DQK>
__device__ __forceinline__ void attn_unit(int tid, LAS unsigned char* lds, const Tensors& A, int b, int h, int qb) {
    constexpr int ND = DQK / 16, NCH = DQK / 8, KSLOT = NCH * 1024, NKD = NCH > 8 ? 2 : 1, VSLOT = 8192, NT = S / 64;
    constexpr int KOFF = 0, VOFF = 3 * KSLOT, OST = VOFF + 3 * VSLOT, WSF = OST + 8 * 4096;
    static_assert(WSF + 8 * 256 <= RING_BYTES, "attention LDS");
    const int lane = tid & 63, r32 = lane & 31, hi = lane >> 5, wid = __builtin_amdgcn_readfirstlane(tid >> 6);
    const int kvh = h / A.group; const size_t rowb = (size_t)b * S;
    const bf16_t* ksrc = A.K + (rowb + lane) * A.kp + kvh * DQK + wid * 8;
    const bf16_t* ksrc2 = A.K + (rowb + lane) * A.kp + kvh * DQK + (8 + (wid & 3)) * 8;
    const bf16_t* vsrc = A.V + (rowb + 16 * (wid & 3) + (lane >> 2)) * A.vp + kvh * 64 + (wid >> 2) * 32 + (lane & 3) * 8;
    const size_t ktile = (size_t)64 * A.kp, vtile = (size_t)64 * A.vp;
    LAS unsigned char* kdst = lds + KOFF + wid * 1024; LAS unsigned char* kdst2 = lds + KOFF + (8 + (wid & 3)) * 1024; LAS unsigned char* vdst = lds + VOFF + wid * 1024;
#define DMA_K(j, so) do { AT_GLDS(ksrc + (size_t)(j) * ktile, kdst + (so)); if (NKD == 2) AT_GLDS(ksrc2 + (size_t)(j) * ktile, kdst2 + (so)); } while (0)
#define DMA_V(j, so) AT_GLDS(vsrc + (size_t)(j) * vtile, vdst + (so))
    const LAS unsigned char* kp0 = lds + KOFF + hi * 1024 + r32 * 16;
    const LAS unsigned char* vp0 = lds + VOFF + ((lane >> 4) & 1) * 32 + (lane & 3) * 8 + (4 * hi + ((lane & 15) >> 2)) * 64;
    DMA_K(0, 0); DMA_V(0, 0); DMA_K(1, KSLOT); DMA_V(1, VSLOT); DMA_K(2, 2 * KSLOT);
    const bf16_t* Qw = A.Q + (rowb + qb * 256 + wid * 32 + r32) * A.qp + h * DQK + hi * 8;
    bf16x8 qr[ND];
#pragma unroll
    for (int d0 = 0; d0 < ND; ++d0) qr[d0] = *(const bf16x8*)(Qw + d0 * 16);
    asm volatile("s_waitcnt vmcnt(0)\n\ts_barrier" ::: "memory");
    bf16x8 kf[2 * ND]; s16x4 vlo[8], vhi[8];
#define KLOAD(so) do { _Pragma("unroll") for (int d0 = 0; d0 < ND; ++d0) { kf[2 * d0] = *(const LAS bf16x8*)(kp0 + (so) + d0 * 2048); kf[2 * d0 + 1] = *(const LAS bf16x8*)(kp0 + (so) + d0 * 2048 + 512); } } while (0)
#define VLOAD(so) do { _Pragma("unroll") for (int i = 0; i < 8; ++i) { vlo[i] = vtr(vp0 + (so) + (i >> 2) * 4096 + (i & 3) * 1024); vhi[i] = vtr(vp0 + (so) + (i >> 2) * 4096 + (i & 3) * 1024 + 512); } } while (0)
#define VFR(i) (bf16x8){vlo[i][0], vlo[i][1], vlo[i][2], vlo[i][3], vhi[i][0], vhi[i][1], vhi[i][2], vhi[i][3]}
    KLOAD(0);
    asm volatile("s_waitcnt lgkmcnt(0)" ::: "memory");
    if (PROBE_ATT != 5 && wid >= 4) AT_BAR();
    f32x16 o0 = {}, o1 = {}, C0, C1; u32x4 pw0, pw1, pw2, pw3; float lsum = 0.f;
    const f32x16 zero = {};
#define QK_BLOCK() do { C0 = __builtin_amdgcn_mfma_f32_32x32x16_bf16(kf[0], qr[0], zero, 0, 0, 0); C1 = __builtin_amdgcn_mfma_f32_32x32x16_bf16(kf[1], qr[0], zero, 0, 0, 0); \
        _Pragma("unroll") for (int d0 = 1; d0 < ND; ++d0) { C0 = __builtin_amdgcn_mfma_f32_32x32x16_bf16(kf[2 * d0], qr[d0], C0, 0, 0, 0); C1 = __builtin_amdgcn_mfma_f32_32x32x16_bf16(kf[2 * d0 + 1], qr[d0], C1, 0, 0, 0); } } while (0)
#define PAF(k) __builtin_bit_cast(bf16x8, pw##k)
#define PV_BLOCK() do { \
        o0 = __builtin_amdgcn_mfma_f32_32x32x16_bf16(PAF(0), VFR(0), o0, 0, 0, 0); o1 = __builtin_amdgcn_mfma_f32_32x32x16_bf16(PAF(0), VFR(4), o1, 0, 0, 0); \
        o0 = __builtin_amdgcn_mfma_f32_32x32x16_bf16(PAF(1), VFR(1), o0, 0, 0, 0); o1 = __builtin_amdgcn_mfma_f32_32x32x16_bf16(PAF(1), VFR(5), o1, 0, 0, 0); \
        o0 = __builtin_amdgcn_mfma_f32_32x32x16_bf16(PAF(2), VFR(2), o0, 0, 0, 0); o1 = __builtin_amdgcn_mfma_f32_32x32x16_bf16(PAF(2), VFR(6), o1, 0, 0, 0); \
        o0 = __builtin_amdgcn_mfma_f32_32x32x16_bf16(PAF(3), VFR(3), o0, 0, 0, 0); o1 = __builtin_amdgcn_mfma_f32_32x32x16_bf16(PAF(3), VFR(7), o1, 0, 0, 0); } while (0)
#define SOFTMAX() do { \
        _Pragma("unroll") for (int r = 0; r < 16; ++r) { C0[r] = __builtin_amdgcn_exp2f(C0[r]); C1[r] = __builtin_amdgcn_exp2f(C1[r]); } \
        f32x2 s0_ = {C0[0], C0[1]}, s1_ = {C1[0], C1[1]}; _Pragma("unroll") for (int r = 2; r < 16; r += 2) { s0_ += (f32x2){C0[r], C0[r + 1]}; s1_ += (f32x2){C1[r], C1[r + 1]}; } s0_ += s1_; lsum += s0_[0] + s0_[1]; \
        pw0 = (u32x4){cvtpk(C0[0], C0[1]), cvtpk(C0[2], C0[3]), cvtpk(C0[4], C0[5]), cvtpk(C0[6], C0[7])}; pw1 = (u32x4){cvtpk(C0[8], C0[9]), cvtpk(C0[10], C0[11]), cvtpk(C0[12], C0[13]), cvtpk(C0[14], C0[15])}; \
        pw2 = (u32x4){cvtpk(C1[0], C1[1]), cvtpk(C1[2], C1[3]), cvtpk(C1[4], C1[5]), cvtpk(C1[6], C1[7])}; pw3 = (u32x4){cvtpk(C1[8], C1[9]), cvtpk(C1[10], C1[11]), cvtpk(C1[12], C1[13]), cvtpk(C1[14], C1[15])}; } while (0)
    int ka = 2 * KSLOT, kb = 0, kc = KSLOT, va = 2 * VSLOT, vb = 0, vc = VSLOT;
#define ROT() do { const int t_ = ka; ka = kb; kb = kc; kc = t_; const int u_ = va; va = vb; vb = vc; vc = u_; } while (0)
#define PINP() asm volatile("" : "+v"(lsum) : "v"(pw0), "v"(pw1), "v"(pw2), "v"(pw3))
#if ATT_REGSTAGE
    u32x4 kst = {}, kst2 = {}, vst = {};
    const LAS unsigned char* kw = lds + KOFF + wid * 1024 + lane * 16; const LAS unsigned char* kw2 = lds + KOFF + (8 + (wid & 3)) * 1024 + lane * 16; const LAS unsigned char* vw = lds + VOFF + wid * 1024 + lane * 16;
#define ST_WRITE(WK, WV) do { if (WK) { *(LAS u32x4*)(kw + ka) = kst; if (NKD == 2 && wid < 4) *(LAS u32x4*)(kw2 + ka) = kst2; } if (WV) *(LAS u32x4*)(vw + vc) = vst; } while (0)
#define ST_LOAD(sv, IK, IV) do { if (IK) { kst = *(const u32x4*)(ksrc + (size_t)((sv) + 4) * ktile); if (NKD == 2 && wid < 4) kst2 = *(const u32x4*)(ksrc2 + (size_t)((sv) + 4) * ktile); } if (IV) vst = *(const u32x4*)(vsrc + (size_t)((sv) + 3) * vtile); } while (0)
#define STEP(sv, DOQK, DOPV, KL, VL, IK, IV, WK, WV) do { \
        AT_SCHED(); if (DOQK) QK_BLOCK(); if (DOPV) PV_BLOCK(); AT_SCHED(); \
        asm volatile("s_barrier\n\ts_nop 15\n\ts_nop 3" : "+v"(C0), "+v"(C1), "+v"(o0), "+v"(o1) :: "memory"); AT_SCHED(); \
        if (KL) KLOAD(kc); if (VL) VLOAD(vb); ST_WRITE(WK, WV); ST_LOAD(sv, IK, IV); \
        if (DOQK) { SOFTMAX(); PINP(); } AT_SCHED(); \
        asm volatile("s_waitcnt lgkmcnt(0)\n\ts_barrier" ::: "memory"); \
        AT_SCHED(); ROT(); } while (0)
    STEP(-1, true, false, true, true, true, true, false, false);
#pragma nounroll
    for (int s = 0; s < NT - 4; ++s) STEP(s, true, true, true, true, true, true, true, true);
    STEP(NT - 4, true, true, true, true, false, true, true, true);
    STEP(NT - 3, true, true, true, true, false, false, false, true);
    STEP(NT - 2, true, true, false, true, false, false, false, false);
    STEP(NT - 1, false, true, false, false, false, false, false, false);
#undef ST_WRITE
#undef ST_LOAD
#else
#define STEP(sv, DOQK, DOPV, KL, VL, IK, IV) do { \
        AT_SCHED(); if (DOQK) QK_BLOCK(); if (DOPV) PV_BLOCK(); AT_SCHED(); \
          \
        asm volatile("s_barrier\n\ts_nop 15\n\ts_nop 3" : "+v"(C0), "+v"(C1), "+v"(o0), "+v"(o1) :: "memory"); AT_SCHED(); \
        if (KL) KLOAD(kc); if (VL) VLOAD(vb); if (IK) DMA_K((sv) + 4, kb); if (IV) DMA_V((sv) + 3, va); \
        if (DOQK) { SOFTMAX(); PINP(); } AT_SCHED(); \
        if (IK) { if (NKD == 2) { AT_WAITBAR(3); } else { AT_WAITBAR(2); } } else if (IV) { AT_WAITBAR(1); } else { AT_WAITBAR(0); } \
        AT_SCHED(); ROT(); } while (0)
    STEP(-1, true, false, true, true, true, true);
#pragma nounroll
    for (int s = 0; s < NT - 4; ++s) STEP(s, true, true, true, true, true, true);
    STEP(NT - 4, true, true, true, true, false, true);
    STEP(NT - 3, true, true, true, true, false, false);
    STEP(NT - 2, true, true, false, true, false, false);
    STEP(NT - 1, false, true, false, false, false, false);
#endif
#undef STEP
#undef PINP
    if (PROBE_ATT != 5 && wid < 4) AT_BAR();
    { auto rr = __builtin_amdgcn_permlane32_swap(__float_as_uint(lsum), __float_as_uint(lsum), false, false); lsum = __uint_as_float(rr[0]) + __uint_as_float(rr[1]); }
    LAS float* wsf = (LAS float*)(lds + WSF + wid * 256);
    if (hi == 0) wsf[r32] = lsum;
    asm volatile("s_waitcnt lgkmcnt(0)" ::: "memory");
    LAS bf16_t* stg = (LAS bf16_t*)(lds + OST + wid * 4096);
#pragma unroll
    for (int r = 0; r < 16; ++r) { const int orow = crow(r, hi); const float rl = __builtin_amdgcn_rcpf(wsf[orow]);
        stg[orow * 64 + r32] = (bf16_t)(cvtpk(o0[r] * rl, 0.f) & 0xffffu); stg[orow * 64 + 32 + r32] = (bf16_t)(cvtpk(o1[r] * rl, 0.f) & 0xffffu); }
    asm volatile("s_waitcnt lgkmcnt(0)" ::: "memory");
    bf16_t* Ow = A.O + (rowb + qb * 256 + wid * 32) * A.op + h * 64;
#pragma unroll
    for (int i = 0; i < 4; ++i) { const int row = i * 8 + (lane >> 3), ch = lane & 7; const u32x4 v = *(const LAS u32x4*)(stg + row * 64 + ch * 8); st16((Ow + (size_t)row * A.op + ch * 8), v); }
    asm volatile("s_waitcnt lgkmcnt(0)\n\ts_barrier" ::: "memory");
#undef DMA_K
#undef DMA_V
#undef KLOAD
#undef VLOAD
#undef VFR
#undef QK_BLOCK
#undef PAF
#undef PV_BLOCK
#undef SOFTMAX
#undef ROT
}
#endif
#if FAST_ATTN && ATT_FP8_A
typedef int v8i __attribute__((ext_vector_type(8)));
__device__ __forceinline__ f32x16 mfma8(v8i a, v8i b, f32x16 c) { return __builtin_amdgcn_mfma_scale_f32_32x32x64_f8f6f4(a, b, c, 0, 0, 0, 0x7f7f7f7f, 0, 0x7f7f7f7f); }
__device__ __forceinline__ f32x16 mfma8pv(v8i a, v8i b, f32x16 c) { return __builtin_amdgcn_mfma_scale_f32_32x32x64_f8f6f4(a, b, c, 1, 0, 0, 0x7f7f7f7f, 0, 0x7f7f7f7f); }
__device__ __forceinline__ void attn_unit_f8a(int tid, LAS unsigned char* lds, const unsigned char* Q8, const unsigned char* K8, const unsigned char* VT8, bf16_t* O, int op, int b, int h, int qb, float bias) {
    constexpr int SL = 4096, NT = S / 64;
    constexpr int KOFF = 0, VOFF = 3 * SL, OST = VOFF + 3 * SL, WSF = OST + 8 * 4096;
    const int lane = tid & 63, r32 = lane & 31, hi = lane >> 5, wid = __builtin_amdgcn_readfirstlane(tid >> 6);
    const int kvh = h >> 2; const size_t rowb = (size_t)b * S; const bool kw = wid < 4;
    const unsigned char* src = kw ? K8 + (rowb + lane) * 128 + kvh * 64 + 16 * wid : VT8 + ((size_t)((b * 2 + kvh) * 64 + lane)) * S + 16 * (wid - 4);
    const size_t tstep = kw ? (size_t)64 * 128 : (size_t)64;
    LAS unsigned char* dst = lds + (kw ? KOFF + wid * 1024 : VOFF + (wid - 4) * 1024);
#define DMA8(j, so) AT_GLDS(src + (size_t)(j) * tstep, dst + (so))
    const LAS unsigned char* kp0 = lds + KOFF + (2 * hi) * 1024 + r32 * 16;
    const LAS unsigned char* vp0 = lds + VOFF + (2 * hi) * 1024 + r32 * 16;
    if (kw) { DMA8(0, 0); DMA8(1, SL); DMA8(2, 2 * SL); } else { DMA8(0, 0); DMA8(1, SL); }
    v8i qf; { const unsigned char* Qw = Q8 + (rowb + qb * 256 + wid * 32 + r32) * 512 + h * 64 + 32 * hi; const u32x4 a = *(const u32x4*)Qw, c = *(const u32x4*)(Qw + 16);
        qf = (v8i){(int)a.x, (int)a.y, (int)a.z, (int)a.w, (int)c.x, (int)c.y, (int)c.z, (int)c.w}; }
    asm volatile("s_waitcnt vmcnt(0)\n\ts_barrier" ::: "memory");
    v8i kf0, kf1, vf0, vf1, p8;
#define LD32(dstv, p) do { const u32x4 a_ = *(const LAS u32x4*)(p), c_ = *(const LAS u32x4*)((p) + 1024); dstv = (v8i){(int)a_.x, (int)a_.y, (int)a_.z, (int)a_.w, (int)c_.x, (int)c_.y, (int)c_.z, (int)c_.w}; } while (0)
#define KLOAD8(so) do { LD32(kf0, kp0 + (so)); LD32(kf1, kp0 + (so) + 512); } while (0)
#define VLOAD8(so) do { LD32(vf0, vp0 + (so)); LD32(vf1, vp0 + (so) + 512); } while (0)
    KLOAD8(0);
    asm volatile("s_waitcnt lgkmcnt(0)" ::: "memory");
    if (wid >= 4) AT_BAR();
    f32x16 o0 = {}, o1 = {}, o2 = {}, C0, C1;
    const v8i ones = {0x38383838, 0x38383838, 0x38383838, 0x38383838, 0x38383838, 0x38383838, 0x38383838, 0x38383838};
    f32x16 negb;
#pragma unroll
    for (int r = 0; r < 16; ++r) negb[r] = bias;
    asm volatile("" : "+v"(negb));
#define SOFTMAX8() do { \
        _Pragma("unroll") for (int i = 0; i < 4; ++i) { \
            const f32x2 a_ = (f32x2){C0[4 * i], C0[4 * i + 1]} * 4.f + 60.5f, b_ = (f32x2){C0[4 * i + 2], C0[4 * i + 3]} * 4.f + 60.5f, c_ = (f32x2){C1[4 * i], C1[4 * i + 1]} * 4.f + 60.5f, d_ = (f32x2){C1[4 * i + 2], C1[4 * i + 3]} * 4.f + 60.5f; \
            p8[i] = (int)__builtin_amdgcn_cvt_pk_u8_f32(b_[1], 3, __builtin_amdgcn_cvt_pk_u8_f32(b_[0], 2, __builtin_amdgcn_cvt_pk_u8_f32(a_[1], 1, __builtin_amdgcn_cvt_pk_u8_f32(a_[0], 0, 0u)))); \
            p8[4 + i] = (int)__builtin_amdgcn_cvt_pk_u8_f32(d_[1], 3, __builtin_amdgcn_cvt_pk_u8_f32(d_[0], 2, __builtin_amdgcn_cvt_pk_u8_f32(c_[1], 1, __builtin_amdgcn_cvt_pk_u8_f32(c_[0], 0, 0u)))); } } while (0)
    int oa = 2 * SL, ob = 0, oc = SL;
#define ROT8() do { const int t_ = oa; oa = ob; ob = oc; oc = t_; } while (0)
#define STEP8(sv, DOQK, DOPV, KL, VL, IK, IV) do { \
        AT_SCHED(); if (DOQK) { C0 = mfma8(kf0, qf, negb); C1 = mfma8(kf1, qf, negb); } if (DOPV) { o0 = mfma8pv(p8, vf0, o0); o1 = mfma8pv(p8, vf1, o1); o2 = mfma8pv(p8, ones, o2); } AT_SCHED(); \
        asm volatile("s_barrier\n\ts_nop 15\n\ts_nop 15" : "+v"(C0), "+v"(C1), "+v"(o0), "+v"(o1), "+v"(o2) :: "memory"); AT_SCHED(); \
        if (KL) KLOAD8(oc); if (VL) VLOAD8(ob); \
        const bool iss_ = kw ? (IK) : (IV); if (iss_) { if (kw) DMA8((sv) + 4, ob); else DMA8((sv) + 3, oa); } \
        if (DOQK) { SOFTMAX8(); asm volatile("" :: "v"(p8)); } AT_SCHED(); \
        if (iss_) { AT_WAITBAR(1); } else { AT_WAITBAR(0); } \
        AT_SCHED(); ROT8(); } while (0)
    STEP8(-1, true, false, true, true, true, true);
#pragma nounroll
    for (int s = 0; s < NT - 4; ++s) STEP8(s, true, true, true, true, true, true);
    STEP8(NT - 4, true, true, true, true, false, true);
    STEP8(NT - 3, true, true, true, true, false, false);
    STEP8(NT - 2, true, true, false, true, false, false);
    STEP8(NT - 1, false, true, false, false, false, false);
    if (wid < 4) AT_BAR();
    LAS bf16_t* stg = (LAS bf16_t*)(lds + OST + wid * 4096);
#pragma unroll
    for (int r = 0; r < 16; ++r) { const int orow = crow(r, hi); const float rl = __builtin_amdgcn_rcpf(o2[r]);
        stg[orow * 64 + r32] = (bf16_t)(cvtpk(o0[r] * rl, 0.f) & 0xffffu); stg[orow * 64 + 32 + r32] = (bf16_t)(cvtpk(o1[r] * rl, 0.f) & 0xffffu); }
    asm volatile("s_waitcnt lgkmcnt(0)" ::: "memory");
    bf16_t* Ow = O + (rowb + qb * 256 + wid * 32) * op + h * 64;
#pragma unroll
    for (int i = 0; i < 4; ++i) { const int row = i * 8 + (lane >> 3), ch = lane & 7; const u32x4 v = *(const LAS u32x4*)(stg + row * 64 + ch * 8); st16(Ow + (size_t)row * op + ch * 8, v); }
    asm volatile("s_waitcnt lgkmcnt(0)\n\ts_barrier" ::: "memory");
#undef DMA8
#undef LD32
#undef KLOAD8
#undef VLOAD8
#undef SOFTMAX8
#undef ROT8
#undef STEP8
}
__device__ __forceinline__ void attn_phase_f8a(int tid, LAS unsigned char* lds, const unsigned char* Q8, const unsigned char* K8, const unsigned char* VT8, bf16_t* O, int op, const float* gq, const float* gk, int vcu, int G) {
    float mq = 0.f, mk = 0.f;
    for (int i = 0; i < 64; ++i) { mq = fmaxf(mq, fabsf(gq[i])); mk = fmaxf(mk, fabsf(gk[i])); }
    const float bias = -fmaxf(64.f * mq * mk * QSCALE_A * 1.13f - 15.5f, 0.f);
    int bh, qb;
    for (int i = 0; next_unit(i, vcu, G, bh, qb); ++i) attn_unit_f8a(tid, lds, Q8, K8, VT8, O, op, bh >> 3, bh & 7, qb, bias);
}
#endif
#if FAST_ATTN && ATT_FP8_B
__device__ __forceinline__ void attn_unit_f8b(int tid, LAS unsigned char* lds, const unsigned char* Q8, const unsigned char* K8, const unsigned char* VT8, bf16_t* O, int op, int b, int h, int qb) {
    constexpr int SLK = 6144, SLV = 4096, NT = S / 64;
    constexpr int KOFF = 0, VOFF = 3 * SLK, OST = VOFF + 3 * SLV, WSF = OST + 8 * 4096;
    static_assert(WSF + 2048 <= RING_BYTES, "attention LDS");
    const int lane = tid & 63, r32 = lane & 31, hi = lane >> 5, wid = __builtin_amdgcn_readfirstlane(tid >> 6);
    const size_t rowb = (size_t)b * S; const bool kw = wid < 6, vw = wid >= 4;
    const unsigned char* ksrc = K8 + (rowb + lane) * 768 + h * 96 + 16 * wid;
    const unsigned char* vsrc = VT8 + ((size_t)((b * 8 + h) * 64 + lane)) * S + 16 * (wid - 4);
    LAS unsigned char* kdst = lds + KOFF + wid * 1024; LAS unsigned char* vdst = lds + VOFF + (wid - 4) * 1024;
#define DMAK(j, so) AT_GLDS(ksrc + (size_t)(j) * (64 * 768), kdst + (so))
#define DMAV(j, so) AT_GLDS(vsrc + (size_t)(j) * 64, vdst + (so))
    const LAS unsigned char* kp0 = lds + KOFF + (2 * hi) * 1024 + r32 * 16;
    const LAS unsigned char* kr0 = lds + KOFF + 4 * 1024 + r32 * 16;
    const LAS unsigned char* vp0 = lds + VOFF + (2 * hi) * 1024 + r32 * 16;
    if (kw) { DMAK(0, 0); DMAK(1, SLK); DMAK(2, 2 * SLK); }
    if (vw) { DMAV(0, 0); DMAV(1, SLV); }
    v8i qn, qr;
    { const unsigned char* Qw = Q8 + (rowb + qb * 256 + wid * 32 + r32) * 768 + h * 96; const u32x4 a = *(const u32x4*)(Qw + 32 * hi), c = *(const u32x4*)(Qw + 32 * hi + 16), e = *(const u32x4*)(Qw + 64), f = *(const u32x4*)(Qw + 80);
      qn = (v8i){(int)a.x, (int)a.y, (int)a.z, (int)a.w, (int)c.x, (int)c.y, (int)c.z, (int)c.w};
      qr = hi ? (v8i){0, 0, 0, 0, 0, 0, 0, 0} : (v8i){(int)e.x, (int)e.y, (int)e.z, (int)e.w, (int)f.x, (int)f.y, (int)f.z, (int)f.w}; }
    asm volatile("s_waitcnt vmcnt(0)\n\ts_barrier" ::: "memory");
    v8i kn0, kn1, kr0v, kr1v, vf0, vf1, p8;
#define LD32(dstv, p) do { const u32x4 a_ = *(const LAS u32x4*)(p), c_ = *(const LAS u32x4*)((p) + 1024); dstv = (v8i){(int)a_.x, (int)a_.y, (int)a_.z, (int)a_.w, (int)c_.x, (int)c_.y, (int)c_.z, (int)c_.w}; } while (0)
#define KLOAD8(so) do { LD32(kn0, kp0 + (so)); LD32(kn1, kp0 + (so) + 512); LD32(kr0v, kr0 + (so)); LD32(kr1v, kr0 + (so) + 512); } while (0)
#define VLOAD8(so) do { LD32(vf0, vp0 + (so)); LD32(vf1, vp0 + (so) + 512); } while (0)
    KLOAD8(0);
    asm volatile("s_waitcnt lgkmcnt(0)" ::: "memory");
    if (wid >= 4) AT_BAR();
    f32x16 o0 = {}, o1 = {}, o2 = {}, C0, C1; const f32x16 zero = {};
    const v8i ones = {0x38383838, 0x38383838, 0x38383838, 0x38383838, 0x38383838, 0x38383838, 0x38383838, 0x38383838};
#define SOFTMAX8() do { \
        _Pragma("unroll") for (int i = 0; i < 4; ++i) { \
            const f32x2 a_ = (f32x2){C0[4 * i], C0[4 * i + 1]} * 4.f + 60.5f, b_ = (f32x2){C0[4 * i + 2], C0[4 * i + 3]} * 4.f + 60.5f, c_ = (f32x2){C1[4 * i], C1[4 * i + 1]} * 4.f + 60.5f, d_ = (f32x2){C1[4 * i + 2], C1[4 * i + 3]} * 4.f + 60.5f; \
            p8[i] = (int)__builtin_amdgcn_cvt_pk_u8_f32(b_[1], 3, __builtin_amdgcn_cvt_pk_u8_f32(b_[0], 2, __builtin_amdgcn_cvt_pk_u8_f32(a_[1], 1, __builtin_amdgcn_cvt_pk_u8_f32(a_[0], 0, 0u)))); \
            p8[4 + i] = (int)__builtin_amdgcn_cvt_pk_u8_f32(d_[1], 3, __builtin_amdgcn_cvt_pk_u8_f32(d_[0], 2, __builtin_amdgcn_cvt_pk_u8_f32(c_[1], 1, __builtin_amdgcn_cvt_pk_u8_f32(c_[0], 0, 0u)))); } } while (0)
    int ka = 2 * SLK, kb = 0, kc = SLK, va = 2 * SLV, vb = 0, vc = SLV;
#define ROT8() do { const int t_ = ka; ka = kb; kb = kc; kc = t_; const int u_ = va; va = vb; vb = vc; vc = u_; } while (0)
#define STEP8(sv, DOQK, DOPV, KL, VL, IK, IV) do { \
        AT_SCHED(); if (DOQK) { C0 = mfma8(kn0, qn, zero); C1 = mfma8(kn1, qn, zero); C0 = mfma8(kr0v, qr, C0); C1 = mfma8(kr1v, qr, C1); } if (DOPV) { o0 = mfma8pv(p8, vf0, o0); o1 = mfma8pv(p8, vf1, o1); o2 = mfma8pv(p8, ones, o2); } AT_SCHED(); \
        asm volatile("s_barrier\n\ts_nop 15\n\ts_nop 15" : "+v"(C0), "+v"(C1), "+v"(o0), "+v"(o1), "+v"(o2) :: "memory"); AT_SCHED(); \
        if (KL) KLOAD8(kc); if (VL) VLOAD8(vb); \
        const bool ik_ = kw && (IK), iv_ = vw && (IV); if (ik_) DMAK((sv) + 4, kb); if (iv_) DMAV((sv) + 3, va); \
        if (DOQK) { SOFTMAX8(); asm volatile("" :: "v"(p8)); } AT_SCHED(); \
        if (ik_ && iv_) { AT_WAITBAR(2); } else if (ik_ || iv_) { AT_WAITBAR(1); } else { AT_WAITBAR(0); } \
        AT_SCHED(); ROT8(); } while (0)
    STEP8(-1, true, false, true, true, true, true);
#pragma nounroll
    for (int s = 0; s < NT - 4; ++s) STEP8(s, true, true, true, true, true, true);
    STEP8(NT - 4, true, true, true, true, false, true);
    STEP8(NT - 3, true, true, true, true, false, false);
    STEP8(NT - 2, true, true, false, true, false, false);
    STEP8(NT - 1, false, true, false, false, false, false);
    if (wid < 4) AT_BAR();
    LAS bf16_t* stg = (LAS bf16_t*)(lds + OST + wid * 4096);
#pragma unroll
    for (int r = 0; r < 16; ++r) { const int orow = crow(r, hi); const float rl = __builtin_amdgcn_rcpf(o2[r]);
        stg[orow * 64 + r32] = (bf16_t)(cvtpk(o0[r] * rl, 0.f) & 0xffffu); stg[orow * 64 + 32 + r32] = (bf16_t)(cvtpk(o1[r] * rl, 0.f) & 0xffffu); }
    asm volatile("s_waitcnt lgkmcnt(0)" ::: "memory");
    bf16_t* Ow = O + (rowb + qb * 256 + wid * 32) * op + h * 64;
#pragma unroll
    for (int i = 0; i < 4; ++i) { const int row = i * 8 + (lane >> 3), ch = lane & 7; const u32x4 v = *(const LAS u32x4*)(stg + row * 64 + ch * 8); st16(Ow + (size_t)row * op + ch * 8, v); }
    asm volatile("s_waitcnt lgkmcnt(0)\n\ts_barrier" ::: "memory");
#undef DMAK
#undef DMAV
#undef LD32
#undef KLOAD8
#undef VLOAD8
#undef SOFTMAX8
#undef ROT8
#undef STEP8
}
__device__ __forceinline__ void attn_phase_f8b(int tid, LAS unsigned char* lds, const unsigned char* Q8, const unsigned char* K8, const unsigned char* VT8, bf16_t* O, int op, int vcu, int G) {
    int bh, qb;
    for (int i = 0; next_unit(i, vcu, G, bh, qb); ++i) attn_unit_f8b(tid, lds, Q8, K8, VT8, O, op, bh >> 3, bh & 7, qb);
}
#endif
template <int DQK>
__device__ __forceinline__ void attn_phase(int tid, LAS unsigned char* lds, const Tensors& A, int vcu, int G) {
#if FAST_ATTN
    int bh, qb;
    for (int i = 0; next_unit(i, vcu, G, bh, qb); ++i) attn_unit<DQK>(tid, lds, A, bh >> 3, bh & 7, qb);
#else
    (void)lds; attn_phase_ref<DQK>(tid, A, vcu, G);
#endif
}
}


struct Args { const float* in[22]; float* out; unsigned char* ws; int ph_lo, ph_hi; };
struct Frame {
    LAS unsigned char* lds; volatile LAS unsigned* MISC; unsigned* ctl;
    int tid, lane, wave, vcu, G;
    unsigned char* ws; float* OUT;
};

__device__ __forceinline__ void p0_phase(Frame& F, const float* c, const float* w_ada, const float* b_ada) {
    LAS float* cs = (LAS float*)F.lds;
    LAS float* red = (LAS float*)(F.lds + 32768);
    for (int i = F.tid; i < NB * D; i += NTHREADS) { const float v = c[i]; cs[i] = v / (1.f + __expf(-v)); }
    __syncthreads();
    float* mod = (float*)(F.ws + WS_MOD);
    const int kq = F.wave, col = F.lane;
    for (int item = F.vcu; item < NL * 6 * D / 64; item += F.G) {
        const int l = item / (6 * D / 64), n0 = (item % (6 * D / 64)) * 64;
        const float* w = w_ada + (size_t)l * D * 6 * D + n0 + col;
        float acc[NB];
#pragma unroll
        for (int b = 0; b < NB; ++b) acc[b] = 0.f;
#pragma unroll 8
        for (int k = kq * 128; k < kq * 128 + 128; ++k) { const float wv = w[(size_t)k * 6 * D];
#pragma unroll
            for (int b = 0; b < NB; ++b) acc[b] += cs[b * D + k] * wv; }
#pragma unroll
        for (int b = 0; b < NB; ++b) red[(kq * NB + b) * 64 + col] = acc[b];
        __syncthreads();
        { const int b = F.wave; float s = 0.f;
#pragma unroll
          for (int q = 0; q < 8; ++q) s += red[(q * NB + b) * 64 + col];
          mod[((size_t)l * NB + b) * 6 * D + n0 + col] = s + b_ada[(size_t)l * 6 * D + n0 + col]; }
        __syncthreads();
    }
    float* cosA = (float*)(F.ws + WS_COSA); float* sinA = (float*)(F.ws + WS_SINA); float* cosB = (float*)(F.ws + WS_COSB); float* sinB = (float*)(F.ws + WS_SINB);
    for (int idx = F.vcu * NTHREADS + F.tid; idx < S * 48; idx += F.G * NTHREADS) {
        const int s = idx / 48, i = idx % 48; const float row = (float)(s >> 6), col2 = (float)(s & 63);
        if (i < 32) { const int j = i & 15; const float a = (i < 16 ? row : col2) * (1.0f / powf(10000.0f, (float)j / 16.0f)); cosA[s * 32 + i] = cosf(a); sinA[s * 32 + i] = sinf(a); }
        else { const int ii = i - 32, j = ii & 7; const float a = (ii < 8 ? row : col2) * (1.0f / powf(10000.0f, (float)j / 8.0f)); cosB[s * 16 + ii] = cosf(a); sinB[s * 16 + ii] = sinf(a); }
    }
}

template <class SrcFn>
__device__ __forceinline__ void cvt_item(const float* W, int K, int Nsrc, const float* kg, bf16_t* WT, LAS float* scr, int item, int nblk, int lane, const SrcFn& src) {
    const int kb = item / nblk, nb = item % nblk, k0 = 64 * kb, n0 = 32 * nb;
    const int sc = src(n0 + (lane & 31));
#pragma unroll
    for (int i = 0; i < 32; ++i) { const int kk = 2 * i + (lane >> 5); float v = sc >= 0 ? W[(size_t)(k0 + kk) * Nsrc + sc] : 0.f; if (kg) v *= kg[k0 + kk]; scr[kk * 33 + (lane & 31)] = v; }
    LDS_WAIT(); asm volatile("" ::: "memory");
    const int c = lane & 7;
#pragma unroll
    for (int j = 0; j < 4; ++j) { const int n = (lane >> 3) + 8 * j; const LAS float* s = scr + (8 * c) * 33 + n;
        u32x4 o; o.x = cvt_pk_bf16(s[0 * 33], s[1 * 33]); o.y = cvt_pk_bf16(s[2 * 33], s[3 * 33]); o.z = cvt_pk_bf16(s[4 * 33], s[5 * 33]); o.w = cvt_pk_bf16(s[6 * 33], s[7 * 33]);
        *(u32x4*)(WT + (size_t)(n0 + n) * K + k0 + 8 * c) = o; }
    LDS_WAIT(); asm volatile("" ::: "memory");
}
struct SrcId { __device__ int operator()(int n) const { return n; } };
struct SrcIn { __device__ int operator()(int n) const { return gp::src_col_in(n); } };
typedef __attribute__((address_space(4))) const Args CArgsW;
__device__ __forceinline__ void convert_weights(Frame& F, CArgsW* a, int l) {
    LAS float* scr = (LAS float*)(F.lds + F.wave * 16384);
    const int gw = F.vcu * NWAVES + F.wave, NGW = F.G * NWAVES;
    const float* w_in = ((const float*)(GAS const float*)a->in[5]) + (size_t)l * D * INC; const float* w_q_b = ((const float*)(GAS const float*)a->in[10]) + (size_t)l * 384 * 768; const float* w_kv_b = ((const float*)(GAS const float*)a->in[11]) + (size_t)l * 256 * 1024;
    const float* w_pa = ((const float*)(GAS const float*)a->in[12]) + (size_t)l * 512 * D; const float* w_pb = ((const float*)(GAS const float*)a->in[13]) + (size_t)l * 512 * D; const float* w_o = ((const float*)(GAS const float*)a->in[14]) + (size_t)l * D * D;
    const float* w1 = ((const float*)(GAS const float*)a->in[18]) + (size_t)l * NE * D * FF; const float* w3 = ((const float*)(GAS const float*)a->in[19]) + (size_t)l * NE * D * FF; const float* w2 = ((const float*)(GAS const float*)a->in[20]) + (size_t)l * NE * FF * D;
    const float* gqa = ((const float*)(GAS const float*)a->in[8]) + l * 384; const float* gkv = ((const float*)(GAS const float*)a->in[9]) + l * 256;
    bf16_t* Win = (bf16_t*)(F.ws + WS_WIN); bf16_t* Wqb = (bf16_t*)(F.ws + WS_WQB); bf16_t* Wkvb = (bf16_t*)(F.ws + WS_WKVB); bf16_t* Wpa = (bf16_t*)(F.ws + WS_WPA); bf16_t* Wpb = (bf16_t*)(F.ws + WS_WPB);
    bf16_t* Wo = (bf16_t*)(F.ws + WS_WO); bf16_t* W13 = (bf16_t*)(F.ws + WS_W13); bf16_t* W2 = (bf16_t*)(F.ws + WS_W2);
    constexpr int I_IN = (D / 64) * (NIN / 32), I_QB = (384 / 64) * (768 / 32), I_KVB = (256 / 64) * (1024 / 32), I_P = (512 / 64) * (D / 32), I_O = (D / 64) * (D / 32);
    constexpr int I_13 = (D / 64) * (1024 / 32), I_2 = (FF / 64) * (D / 32);
    constexpr int NITEMS = I_IN + I_QB + I_KVB + 2 * I_P + I_O + NE * (I_13 + I_2);
    for (int it = gw; it < NITEMS; it += NGW) {
        int r = it;
        if (r < I_IN) { cvt_item(w_in, D, INC, nullptr, Win, scr, r, NIN / 32, F.lane, SrcIn()); continue; } r -= I_IN;
        if (r < I_QB) { cvt_item(w_q_b, 384, 768, gqa, Wqb, scr, r, 768 / 32, F.lane, SrcId()); continue; } r -= I_QB;
        if (r < I_KVB) { cvt_item(w_kv_b, 256, 1024, gkv, Wkvb, scr, r, 1024 / 32, F.lane, SrcId()); continue; } r -= I_KVB;
        if (r < I_P) { cvt_item(w_pa, 512, D, nullptr, Wpa, scr, r, D / 32, F.lane, SrcId()); continue; } r -= I_P;
        if (r < I_P) { cvt_item(w_pb, 512, D, nullptr, Wpb, scr, r, D / 32, F.lane, SrcId()); continue; } r -= I_P;
        if (r < I_O) { cvt_item(w_o, D, D, nullptr, Wo, scr, r, D / 32, F.lane, SrcId()); continue; } r -= I_O;
        if (r < NE * I_13) { const int e = r / I_13, q = r % I_13, nb = q % 32;
            const float* src = ((nb & 7) < 4 ? w1 : w3) + (size_t)e * D * FF; const int cb = (nb >> 3) * 128 + (nb & 3) * 32;
            struct SrcOff { int n0, cb; __device__ int operator()(int n) const { return cb + (n - n0); } } so{nb * 32, cb};
            cvt_item(src, D, FF, nullptr, W13 + (size_t)e * 1024 * D, scr, q, 32, F.lane, so); continue; } r -= NE * I_13;
        { const int e = r / I_2, q = r % I_2; cvt_item(w2 + (size_t)e * FF * D, FF, D, nullptr, W2 + (size_t)e * D * FF, scr, q, D / 32, F.lane, SrcId()); }
    }
}

template <int MODE>
__device__ __forceinline__ void row_phase(Frame& F, const float* xin, const float* g2prev, const float* gain, const float* modl, int sh_off, int sc_off, bf16_t* H, bf16_t* XB, float* OUT) {
    constexpr int RB = 4, RPW = T / (256 * NWAVES);
    const int gw = F.vcu * NWAVES + F.wave, b = (gw * RPW) >> 12;
    const bf16_t* Y2 = (const bf16_t*)(F.ws + WS_Y2);
    f32x4 gs[4], shv[4], g2v[4];
#pragma unroll
    for (int j = 0; j < 4; ++j) { const int c = 4 * F.lane + 256 * j; gs[j] = *(const f32x4*)(gain + c);
        if (MODE != 2) { gs[j] = gs[j] * (1.f + *(const f32x4*)(modl + (size_t)b * 6 * D + sc_off + c)); shv[j] = *(const f32x4*)(modl + (size_t)b * 6 * D + sh_off + c); }
        if (MODE != 0) g2v[j] = *(const f32x4*)(g2prev + (size_t)b * 6 * D + 5 * D + c); }
    for (int m0 = gw * RPW; m0 < gw * RPW + RPW; m0 += RB) {
        f32x4 v[RB][4]; float ss[RB];
        if (MODE == 0) {
#pragma unroll
            for (int r = 0; r < RB; ++r)
#pragma unroll
                for (int j = 0; j < 4; ++j) v[r][j] = *(const f32x4*)(xin + (size_t)(m0 + r) * D + 4 * F.lane + 256 * j);
        } else {
            unsigned ya[RB][4], yb[RB][4];
#pragma unroll
            for (int r = 0; r < RB; ++r)
#pragma unroll
                for (int j = 0; j < 4; ++j) { const int m = m0 + r, c = 4 * F.lane + 256 * j;
                    { const u32x2 xb = *(const u32x2*)(XB + (size_t)m * D + c); v[r][j] = (f32x4){bf2f(xb.x & 0xffffu), bf2f(xb.x >> 16), bf2f(xb.y & 0xffffu), bf2f(xb.y >> 16)}; }
                    ya[r][j] = *(const unsigned*)((const unsigned char*)Y2 + (size_t)(2 * m) * D + c); yb[r][j] = *(const unsigned*)((const unsigned char*)Y2 + (size_t)(2 * m + 1) * D + c); }
#pragma unroll
            for (int r = 0; r < RB; ++r)
#pragma unroll
                for (int j = 0; j < 4; ++j) { const f32x2 a0 = __builtin_amdgcn_cvt_pk_f32_fp8((int)ya[r][j], false), a1 = __builtin_amdgcn_cvt_pk_f32_fp8((int)ya[r][j], true), b0 = __builtin_amdgcn_cvt_pk_f32_fp8((int)yb[r][j], false), b1 = __builtin_amdgcn_cvt_pk_f32_fp8((int)yb[r][j], true);
                    const f32x4 y = (f32x4){a0[0] + b0[0], a0[1] + b0[1], a1[0] + b1[0], a1[1] + b1[1]} * 0.0625f;
                    v[r][j] += g2v[j] * y; }
        }
#pragma unroll
        for (int r = 0; r < RB; ++r) { ss[r] = (gp::dot4(v[r][0]) + gp::dot4(v[r][1])) + (gp::dot4(v[r][2]) + gp::dot4(v[r][3])); }
#pragma unroll
        for (int o = 1; o < 64; o <<= 1)
#pragma unroll
            for (int r = 0; r < RB; ++r) ss[r] += __shfl_xor(ss[r], o);
#pragma unroll
        for (int r = 0; r < RB; ++r) {
            const int m = m0 + r; const float rstd = rsqrtf(ss[r] * (1.f / D) + EPS);
#pragma unroll
            for (int j = 0; j < 4; ++j) {
                const int c = 4 * F.lane + 256 * j;
                if (MODE == 2) { *(f32x4*)(OUT + (size_t)m * D + c) = v[r][j] * rstd * gs[j]; }
                else {
                    { u32x2 xw; xw.x = cvt_pk_bf16(v[r][j][0], v[r][j][1]); xw.y = cvt_pk_bf16(v[r][j][2], v[r][j][3]); st8((XB + (size_t)m * D + c), xw); }
                    const f32x4 hv = v[r][j] * rstd * gs[j] + shv[j];
                    u32x2 w; w.x = cvt_pk_bf16(hv[0], hv[1]); w.y = cvt_pk_bf16(hv[2], hv[3]);
                    st8((H + (size_t)m * D + c), w);
                }
            }
        }
    }
}

__device__ __forceinline__ void t2_phase(Frame& F, const float* gain, const float* modl, const float* w_router, const float* rbias, int l, bool record) {
    LAS f32x4* wl = (LAS f32x4*)F.lds;
    LAS int* rec = (LAS int*)(F.lds + 65536);
    LAS float* recw = (LAS float*)(F.lds + 65536 + 2048);
    LAS int* lcnt = (LAS int*)(F.lds + 65536 + 4096);
    for (int idx = F.tid; idx < 4096; idx += NTHREADS) {
        const int lane = idx & 63, c = (idx >> 6) & 3, i = (idx >> 8) & 3, j = idx >> 10; const int k = 4 * lane + 256 * j + i;
        wl[idx] = *(const f32x4*)(w_router + (size_t)k * NE + 4 * c);
    }
    if (F.tid < 32) lcnt[F.tid] = 0;
    __syncthreads();
    constexpr int RB = 4, RPW = T / (256 * NWAVES);
    const int gw = F.vcu * NWAVES + F.wave, bt = (gw * RPW) >> 12;
    bf16_t* H = (bf16_t*)(F.ws + WS_H); const bf16_t* XB = (const bf16_t*)(F.ws + WS_XB);
    const int lane = F.lane, myrow = lane >> 4, mye = lane & 15;
    f32x4 gs[4], shv[4];
#pragma unroll
    for (int j = 0; j < 4; ++j) { const int c = 4 * lane + 256 * j; gs[j] = *(const f32x4*)(gain + c) * (1.f + *(const f32x4*)(modl + (size_t)bt * 6 * D + 4 * D + c)); shv[j] = *(const f32x4*)(modl + (size_t)bt * 6 * D + 3 * D + c); }
    int it = 0;
    for (int m0 = gw * RPW; m0 < gw * RPW + RPW; m0 += RB, ++it) {
        f32x4 v[RB][4]; float ss[RB];
#pragma unroll
        for (int r = 0; r < RB; ++r)
#pragma unroll
            for (int j = 0; j < 4; ++j) { const u32x2 xb = *(const u32x2*)(XB + (size_t)(m0 + r) * D + 4 * lane + 256 * j); v[r][j] = (f32x4){bf2f(xb.x & 0xffffu), bf2f(xb.x >> 16), bf2f(xb.y & 0xffffu), bf2f(xb.y >> 16)}; }
#pragma unroll
        for (int r = 0; r < RB; ++r) ss[r] = (gp::dot4(v[r][0]) + gp::dot4(v[r][1])) + (gp::dot4(v[r][2]) + gp::dot4(v[r][3]));
#pragma unroll
        for (int o = 1; o < 64; o <<= 1)
#pragma unroll
            for (int r = 0; r < RB; ++r) ss[r] += __shfl_xor(ss[r], o);
        float acc[RB * NE];
#pragma unroll
        for (int q = 0; q < RB * NE; ++q) acc[q] = 0.f;
#pragma unroll
        for (int j = 0; j < 4; ++j) {
            const int c = 4 * lane + 256 * j;
#pragma unroll
            for (int r = 0; r < RB; ++r) {
                const int m = m0 + r; const float rstd = rsqrtf(ss[r] * (1.f / D) + EPS);
                v[r][j] = v[r][j] * rstd * gs[j] + shv[j];
                u32x2 w; w.x = cvt_pk_bf16(v[r][j][0], v[r][j][1]); w.y = cvt_pk_bf16(v[r][j][2], v[r][j][3]);
                st8((H + (size_t)m * D + c), w);
            }
#pragma unroll
            for (int i = 0; i < 4; ++i)
#pragma unroll
                for (int c4 = 0; c4 < 4; ++c4) { const f32x4 wv = wl[((j * 4 + i) * 4 + c4) * 64 + lane];
#pragma unroll
                    for (int r = 0; r < RB; ++r) { const float hv = v[r][j][i];
                        acc[r * NE + 4 * c4 + 0] += hv * wv[0]; acc[r * NE + 4 * c4 + 1] += hv * wv[1]; acc[r * NE + 4 * c4 + 2] += hv * wv[2]; acc[r * NE + 4 * c4 + 3] += hv * wv[3]; } }
        }
#pragma unroll
        for (int sft = 32; sft >= 1; sft >>= 1) {
            const bool up = (lane & sft) != 0;
#pragma unroll
            for (int k = 0; k < sft; ++k) { const float a = acc[k], b = acc[k + sft]; const float keep = up ? b : a, send = up ? a : b; acc[k] = keep + __shfl_xor(send, sft); }
        }
        const float logit = acc[0];
        const float score = 1.f / (1.f + expf(-logit));
        float scv[NE], bi[NE];
#pragma unroll
        for (int e = 0; e < NE; ++e) { scv[e] = __shfl(score, (lane & 48) | e); bi[e] = scv[e] + rbias[e]; }
        int gsel = 0; float gbest = -INFINITY;
#pragma unroll
        for (int g = 0; g < 4; ++g) { float m1 = -INFINITY, m2 = -INFINITY;
#pragma unroll
            for (int j = 0; j < 4; ++j) { const float x = bi[g * 4 + j]; if (x > m1) { m2 = m1; m1 = x; } else if (x > m2) m2 = x; }
            const float gs = m1 + m2; if (gs > gbest) { gbest = gs; gsel = g; } }
        int e1 = -1, e2 = -1; float b1 = -INFINITY, b2 = -INFINITY, s1 = 0.f, s2 = 0.f;
#pragma unroll
        for (int j = 0; j < 4; ++j) { float x = -INFINITY, sx = 0.f;
#pragma unroll
            for (int g = 0; g < 4; ++g) if (g == gsel) { x = bi[g * 4 + j]; sx = scv[g * 4 + j]; }
            const int e = gsel * 4 + j;
            if (x > b1) { b2 = b1; e2 = e1; s2 = s1; b1 = x; e1 = e; s1 = sx; } else if (x > b2) { b2 = x; e2 = e; s2 = sx; } }
        if (mye == 0) {
            const float inv = 1.f / (s1 + s2); const int slot = (it * RB + myrow) * NWAVES + F.wave;
            rec[slot * 4 + 0] = e1; rec[slot * 4 + 1] = e2;
            rec[slot * 4 + 2] = __hip_atomic_fetch_add(&lcnt[e1], 1, __ATOMIC_RELAXED, __HIP_MEMORY_SCOPE_WORKGROUP);
            rec[slot * 4 + 3] = __hip_atomic_fetch_add(&lcnt[e2], 1, __ATOMIC_RELAXED, __HIP_MEMORY_SCOPE_WORKGROUP);
            recw[slot * 2 + 0] = s1 * inv; recw[slot * 2 + 1] = s2 * inv;
        }
    }
    __syncthreads();
    if (!record) return;
    if (F.tid < NE) lcnt[16 + F.tid] = (int)__hip_atomic_fetch_add(F.ctl + CW_CNT + (l * NE + F.tid) * 64, (unsigned)lcnt[F.tid], __ATOMIC_RELAXED, __HIP_MEMORY_SCOPE_AGENT);
    __syncthreads();
    unsigned* list = (unsigned*)(F.ws + WS_LIST); float* gwb = (float*)(F.ws + WS_GW);
    const int nrows = it * RB;
    for (int s = F.tid; s < nrows * NWAVES; s += NTHREADS) {
        const int i2 = s / NWAVES, w = s % NWAVES; const int m = (F.vcu * NWAVES + w) * RPW + i2;
        const int e1 = rec[s * 4 + 0], e2 = rec[s * 4 + 1];
        list[(size_t)e1 * T + lcnt[16 + e1] + rec[s * 4 + 2]] = (unsigned)(2 * m); list[(size_t)e2 * T + lcnt[16 + e2] + rec[s * 4 + 3]] = (unsigned)(2 * m + 1);
        gwb[2 * m] = recw[s * 2]; gwb[2 * m + 1] = recw[s * 2 + 1];
    }
}
__device__ __forceinline__ const LAS int* moe_table(Frame& F, int l) {
    LAS int* tab = (LAS int*)(F.lds + MISC_OFF + 1024);
    __syncthreads();
    if (F.tid == 0) { int acc = 0;
        for (int e = 0; e < NE; ++e) { const int c = (int)__hip_atomic_load(F.ctl + CW_CNT + (l * NE + e) * 64, __ATOMIC_RELAXED, __HIP_MEMORY_SCOPE_AGENT); tab[e] = acc; tab[32 + e] = c; acc += (c + 255) >> 8; }
        tab[16] = acc; }
    __syncthreads();
    return tab;
}

typedef __attribute__((address_space(4))) const Args CArgs;
#define LAUNDER_GP(T_, p) do { GAS T_* _t = (GAS T_*)(p); asm volatile("" : "+s"(_t)); (p) = (T_*)_t; } while (0)
#define PH_BEGIN() LAUNDER_V(F.tid); F.lane = F.tid & 63; LAUNDER_GP(unsigned, F.ctl); LAUNDER_GP(float, F.OUT); LAUNDER_GP(unsigned char, F.ws); GAS unsigned char* ws = (GAS unsigned char*)F.ws; CArgs* ka = (CArgs*)__builtin_amdgcn_kernarg_segment_ptr(); LAUNDER_S(ka); \
    float* mod = WSP(float, WS_MOD); (void)mod; (void)ka
#define WSP(T_, off) ((T_*)(GAS T_*)(ws + (off)))
#define KIN(i) ((const float*)(GAS const float*)ka->in[i])
__global__ void __launch_bounds__(NTHREADS, 2) fwd_kernel(Args args) {
    extern __shared__ __attribute__((aligned(16))) unsigned char lds_raw[];
    Frame F;
    F.lds = (LAS unsigned char*)lds_raw; F.MISC = (volatile LAS unsigned*)(F.lds + MISC_OFF);
    F.tid = threadIdx.x; F.lane = F.tid & 63; F.wave = __builtin_amdgcn_readfirstlane(F.tid >> 6);
    F.G = gridDim.x; { const int bx = blockIdx.x; F.vcu = (F.G % 8 == 0) ? (bx % 8) * (F.G / 8) + bx / 8 : bx; }
    F.ws = (unsigned char*)(GAS unsigned char*)args.ws; F.ctl = (unsigned*)(GAS unsigned*)(args.ws + WS_CTL); F.OUT = (float*)(GAS float*)args.out;
    if (F.tid < 64) F.MISC[F.tid] = 0u;
    __syncthreads();
    XcdBarrier bar; bar.bar = F.ctl + CW_BAR; bar.x = 0; bar.st = nullptr;
    if (!N_LAUNCH_MODE) bar = xcd_barrier_post(F.ctl + CW_BAR, F.MISC + 8);
    const int lo = args.ph_lo, hi = args.ph_hi;
#define IN(k) (lo <= (k) && (k) < hi)
#define SEAM(k) do { if ((k) + 1 < hi) { if (!N_LAUNCH_MODE) xcd_barrier(bar); } } while (0)
    const int cidx = (int)blockIdx.x;

    if (IN(0)) { PH_BEGIN(); p0_phase(F, KIN(1), KIN(2), KIN(3)); __syncthreads(); LAUNDER_V(F.tid); F.lane = F.tid & 63; convert_weights(F, ka, 0); SEAM(0); }
    for (int l = 0; l < NL; ++l) {
        const int pb = 1 + 9 * l;
        if (IN(pb + 0)) {
            PH_BEGIN();
            if (l > 0) for (int rep = 0; rep < ((PROBE_DUP & 8) ? 2 : 1); ++rep) { LAUNDER_V(F.tid); F.lane = F.tid & 63; convert_weights(F, ka, l); }
            if (l == 0) row_phase<0>(F, KIN(0), nullptr, KIN(4) + l * D, mod + (size_t)l * NB * 6 * D, 0, D, WSP(bf16_t, WS_H), WSP(bf16_t, WS_XB), nullptr);
            else row_phase<1>(F, nullptr, mod + (size_t)(l - 1) * NB * 6 * D, KIN(4) + l * D, mod + (size_t)l * NB * 6 * D, 0, D, WSP(bf16_t, WS_H), WSP(bf16_t, WS_XB), nullptr);
            SEAM(pb + 0);
        }
        if (IN(pb + 1)) {
            PH_BEGIN();
            gp::Gemm g{WSP(bf16_t, WS_H), WSP(const bf16_t, WS_WIN), D, 0, nullptr}; gp::DenseOrder So; So.init(T, NIN, F.G, cidx);
            gp::EpiIn E{WSP(bf16_t, ATT_FP8_A ? WS_QA8 : WS_QA), WSP(bf16_t, ATT_FP8_A ? WS_KA8 : WS_KA), WSP(bf16_t, ATT_FP8_A ? WS_VTA8 : WS_VA), WSP(bf16_t, WS_QLAT), WSP(bf16_t, WS_KVLAT), WSP(bf16_t, ATT_FP8_B ? WS_KB8 : WS_KB), WSP(bf16_t, WS_SA), WSP(bf16_t, WS_SB), WSP(float, WS_SSQ), WSP(float, WS_SSKV),
                        KIN(6) + l * 64, KIN(7) + l * 64, WSP(const float, WS_COSA), WSP(const float, WS_SINA), WSP(const float, WS_COSB), WSP(const float, WS_SINB)};
            if (PROBE_DUP & 128) { gp::EpiNull En; gp::gemm_phase<gp::EpiNull, gp::DenseOrder>(F.tid, F.lds, g, So, En); LAUNDER_V(F.tid); }
            gp::gemm_phase<gp::EpiIn, gp::DenseOrder>(F.tid, F.lds, g, So, E); if (PROBE_DUP & (2 | 512)) { LAUNDER_V(F.tid); gp::gemm_phase<gp::EpiIn, gp::DenseOrder>(F.tid, F.lds, g, So, E); }
            SEAM(pb + 1);
        }
        if (IN(pb + 2)) {
            { PH_BEGIN(); gp::Gemm g{WSP(bf16_t, WS_QLAT), WSP(const bf16_t, WS_WQB), 384, 0, nullptr}; gp::DenseOrder So; So.init(T, 768, F.G, cidx);
              gp::EpiQb E{WSP(bf16_t, ATT_FP8_B ? WS_QB8 : WS_QB), WSP(const float, WS_SSQ), WSP(const float, WS_COSB), WSP(const float, WS_SINB)}; gp::gemm_phase<gp::EpiQb, gp::DenseOrder>(F.tid, F.lds, g, So, E); if (PROBE_DUP & 2) { LAUNDER_V(F.tid); gp::gemm_phase<gp::EpiQb, gp::DenseOrder>(F.tid, F.lds, g, So, E); } }
            { PH_BEGIN(); gp::Gemm g{WSP(bf16_t, WS_KVLAT), WSP(const bf16_t, WS_WKVB), 256, 0, nullptr}; gp::DenseOrder So; So.init(T, 1024, F.G, F.G - 1 - cidx);
              gp::EpiKvb E{WSP(bf16_t, ATT_FP8_B ? WS_KB8 : WS_KB), WSP(bf16_t, ATT_FP8_B ? WS_VTB8 : WS_VB), WSP(const float, WS_SSKV)}; gp::gemm_phase<gp::EpiKvb, gp::DenseOrder>(F.tid, F.lds, g, So, E); if (PROBE_DUP & 2) { LAUNDER_V(F.tid); gp::gemm_phase<gp::EpiKvb, gp::DenseOrder>(F.tid, F.lds, g, So, E); } }
#if FAST_ATTN && ATT_FP8_A
            { PH_BEGIN(); at::attn_phase_f8a(F.tid, F.lds, WSP(const unsigned char, WS_QA8), WSP(const unsigned char, WS_KA8), WSP(const unsigned char, WS_VTA8), WSP(bf16_t, WS_QA), 512, KIN(6) + l * 64, KIN(7) + l * 64, F.vcu, F.G); }
            if (PROBE_DUP & 1) { PH_BEGIN(); at::attn_phase_f8a(F.tid, F.lds, WSP(const unsigned char, WS_QA8), WSP(const unsigned char, WS_KA8), WSP(const unsigned char, WS_VTA8), WSP(bf16_t, WS_QA), 512, KIN(6) + l * 64, KIN(7) + l * 64, F.vcu, F.G); }
#else
            { PH_BEGIN(); const at::Tensors A{WSP(bf16_t, WS_QA), 512, WSP(bf16_t, WS_KA), 128, WSP(bf16_t, WS_VA), 128, WSP(bf16_t, WS_QA), 512, 4}; at::attn_phase<64>(F.tid, F.lds, A, F.vcu, F.G); }
#endif
            SEAM(pb + 2);
        }
        if (IN(pb + 3)) {
            PH_BEGIN();
#if FAST_ATTN && ATT_FP8_B
            at::attn_phase_f8b(F.tid, F.lds, WSP(const unsigned char, WS_QB8), WSP(const unsigned char, WS_KB8), WSP(const unsigned char, WS_VTB8), WSP(bf16_t, WS_OB), 512, F.vcu, F.G);
            if (PROBE_DUP & 1) { LAUNDER_V(F.tid); at::attn_phase_f8b(F.tid, F.lds, WSP(const unsigned char, WS_QB8), WSP(const unsigned char, WS_KB8), WSP(const unsigned char, WS_VTB8), WSP(bf16_t, WS_OB), 512, F.vcu, F.G); }
#else
            const at::Tensors A{WSP(bf16_t, WS_QB), 768, WSP(bf16_t, WS_KB), 768, WSP(bf16_t, WS_VB), 512, WSP(bf16_t, WS_OB), 512, 1}; for (int rep = 0; rep < ((PROBE_DUP & 1) ? 2 : 1); ++rep) at::attn_phase<96>(F.tid, F.lds, A, F.vcu, F.G);
#endif
            SEAM(pb + 3);
        }
        if (IN(pb + 4)) {
            PH_BEGIN();
            gp::Gemm g{WSP(bf16_t, WS_QA), WSP(const bf16_t, WS_WPA), 512, (size_t)(WS_WPB - WS_WPA) / 2, nullptr, (size_t)(WS_OB - WS_QA) / 2}; gp::PairOrder So; So.init(T, D, F.G, cidx);
            gp::EpiProjP E{WSP(bf16_t, WS_H), WSP(const unsigned char, WS_SA), WSP(const unsigned char, WS_SB)};
            gp::gemm_phase<gp::EpiProjP, gp::PairOrder>(F.tid, F.lds, g, So, E);
            if (PROBE_DUP & (2 | 1024)) { LAUNDER_V(F.tid); gp::gemm_phase<gp::EpiProjP, gp::PairOrder>(F.tid, F.lds, g, So, E); }
            SEAM(pb + 4);
        }
        if (IN(pb + 5)) {
            PH_BEGIN();
            gp::Gemm g{WSP(bf16_t, WS_H), WSP(const bf16_t, WS_WO), D, 0, nullptr}; gp::DenseOrder So; So.init(T, D, F.G, cidx);
            gp::EpiWo E{WSP(const bf16_t, WS_XB), mod + (size_t)l * NB * 6 * D, WSP(bf16_t, WS_XB)}; gp::gemm_phase<gp::EpiWo, gp::DenseOrder>(F.tid, F.lds, g, So, E);
            SEAM(pb + 5);
        }
        if (IN(pb + 6)) {
            PH_BEGIN();
            if (PROBE_DUP & 16) { t2_phase(F, KIN(15) + l * D, mod + (size_t)l * NB * 6 * D, KIN(16), KIN(17), l, false); LAUNDER_V(F.tid); F.lane = F.tid & 63; __syncthreads(); }
            t2_phase(F, KIN(15) + l * D, mod + (size_t)l * NB * 6 * D, KIN(16), KIN(17), l, true);
            SEAM(pb + 6);
        }
        if (IN(pb + 7)) {
            PH_BEGIN();
            const LAS int* tab = moe_table(F, l);
            gp::Gemm g{WSP(bf16_t, WS_H), WSP(const bf16_t, WS_W13), D, (size_t)1024 * D, WSP(const unsigned, WS_LIST)}; gp::MoeOrder So; So.init(tab, F.G, cidx);
            if (PROBE_DUP & 256) { gp::EpiNull En; gp::gemm_phase<gp::EpiNull, gp::MoeOrder, true>(F.tid, F.lds, g, So, En); LAUNDER_V(F.tid); }
            gp::EpiUp E{WSP(bf16_t, WS_ACT)}; gp::gemm_phase<gp::EpiUp, gp::MoeOrder, true>(F.tid, F.lds, g, So, E); if (PROBE_DUP & 4) { LAUNDER_V(F.tid); gp::gemm_phase<gp::EpiUp, gp::MoeOrder, true>(F.tid, F.lds, g, So, E); }
            SEAM(pb + 7);
        }
        if (IN(pb + 8)) {
            PH_BEGIN();
            const LAS int* tab = moe_table(F, l);
            gp::Gemm g{WSP(bf16_t, WS_ACT), WSP(const bf16_t, WS_W2), FF, (size_t)D * FF, nullptr}; gp::MoeOrder So; So.init(tab, F.G, cidx);
            gp::EpiDown E{WSP(bf16_t, WS_Y2), WSP(const unsigned, WS_LIST), WSP(const float, WS_GW)}; gp::gemm_phase<gp::EpiDown, gp::MoeOrder, false>(F.tid, F.lds, g, So, E); if (PROBE_DUP & 4) { LAUNDER_V(F.tid); gp::gemm_phase<gp::EpiDown, gp::MoeOrder, false>(F.tid, F.lds, g, So, E); }
            SEAM(pb + 8);
        }
    }
    if (IN(NPHASE - 1)) { PH_BEGIN(); row_phase<2>(F, nullptr, mod + (size_t)(NL - 1) * NB * 6 * D, KIN(21), nullptr, 0, 0, nullptr, WSP(bf16_t, WS_XB), F.OUT); }
#undef IN
#undef SEAM
}

extern "C" void kernel_launch(void* const* d_in, const int* in_sizes, int n_in, void* d_out, int out_size, void* d_ws, size_t ws_size, hipStream_t stream) {
    static int grid = 0;
    if (grid == 0) {
        if (n_in != 22 || out_size != T * D || ws_size < WS_END) { fprintf(stderr, "kernel_launch: unexpected problem (n_in %d out %d ws %zu)\n", n_in, out_size, ws_size); grid = -1; return; }
        int dev = 0, cus = 0, per_cu = 0;
        if (hipGetDevice(&dev) != hipSuccess || hipDeviceGetAttribute(&cus, hipDeviceAttributeMultiprocessorCount, dev) != hipSuccess) { grid = -1; return; }
        if (hipFuncSetAttribute((const void*)fwd_kernel, hipFuncAttributeMaxDynamicSharedMemorySize, LDS_BYTES) != hipSuccess) { grid = -1; return; }
        if (hipOccupancyMaxActiveBlocksPerMultiprocessor(&per_cu, (const void*)fwd_kernel, NTHREADS, LDS_BYTES) != hipSuccess || per_cu < 1) { fprintf(stderr, "kernel_launch: occupancy query says %d\n", per_cu); }
        (void)hipGetLastError();
        grid = cus;
        if (grid != 256 || T % (grid * NWAVES * 4) != 0) {   fprintf(stderr, "kernel_launch: grid %d does not divide the row phases\n", grid); grid = -1; return; }
    }
    if (grid < 0) return;
    (void)hipMemsetAsync((char*)d_ws + WS_CTL, 0, CTL_BYTES, stream);
    Args a{};
    for (int i = 0; i < 22; ++i) a.in[i] = (const float*)d_in[i];
    a.out = (float*)d_out; a.ws = (unsigned char*)d_ws;
#if N_LAUNCH_MODE
    for (int p = 0; p < NPHASE; ++p) { a.ph_lo = p; a.ph_hi = p + 1; hipLaunchKernelGGL(fwd_kernel, dim3(grid), dim3(NTHREADS), LDS_BYTES, stream, a); }
#else
    a.ph_lo = 0; a.ph_hi = NPHASE;
    hipLaunchKernelGGL(fwd_kernel, dim3(grid), dim3(NTHREADS), LDS_BYTES, stream, a);
#endif
}
```

```cpp
#include <hip/hip_runtime.h>
#include <stdint.h>
#include <stdio.h>
#include <math.h>

#ifndef FAST_GEMM
#define FAST_GEMM 1
#endif
#ifndef FAST_ATTN
#define FAST_ATTN 1
#endif
#ifndef PROBE_DUP
#define PROBE_DUP 0
#endif
#ifndef PROBE_ATT
#define PROBE_ATT 0
#endif
#ifndef ATT_REGSTAGE
#define ATT_REGSTAGE 0
#endif
#ifndef WT_STORES
#define WT_STORES 0
#endif
#ifndef ATT_FP8_A
#define ATT_FP8_A 1
#endif
#ifndef ATT_FP8_B
#define ATT_FP8_B 1
#endif
#ifndef N_LAUNCH_MODE
#define N_LAUNCH_MODE 0
#endif

#define LAS __attribute__((address_space(3)))
#define GAS __attribute__((address_space(1)))
typedef unsigned short bf16_t;
typedef short bf16x8 __attribute__((ext_vector_type(8)));
typedef float f32x4 __attribute__((ext_vector_type(4)));
typedef float f32x2 __attribute__((ext_vector_type(2)));
typedef float f32x16 __attribute__((ext_vector_type(16)));
typedef unsigned u32x4 __attribute__((ext_vector_type(4)));
typedef unsigned u32x2 __attribute__((ext_vector_type(2)));
typedef GAS unsigned gu32;

constexpr int D = 1024, NB = 8, S = 4096, T = NB * S, NL = 4, INC = 3488, NIN = 3584, NE = 16, FF = 512;
constexpr float EPS = 1e-6f, LOG2E = 1.4426950408889634f;
constexpr float QSCALE_A = 0.125f * LOG2E, QSCALE_B = 0.10206207261596577f * LOG2E;
constexpr int NWAVES = 8, NTHREADS = 512;
constexpr int NPHASE = 2 + 9 * NL;

constexpr size_t MiB = 1u << 20;
constexpr size_t WS_CTL = 0, CTL_BYTES = 1 * MiB;
constexpr size_t WS_MOD = 1 * MiB;
constexpr size_t WS_COSA = 2 * MiB, WS_SINA = WS_COSA + 512 * 1024, WS_COSB = 3 * MiB, WS_SINB = WS_COSB + 256 * 1024;
constexpr size_t WS_SSQ = 4 * MiB, WS_SSKV = 5 * MiB;
constexpr size_t WS_GW = 6 * MiB;
constexpr size_t WS_LIST = 7 * MiB;
constexpr size_t WS_WIN = 10 * MiB, WS_WQB = 17 * MiB, WS_WKVB = 18 * MiB, WS_WPA = 19 * MiB, WS_WPB = 20 * MiB, WS_WO = 21 * MiB, WS_W13 = 23 * MiB, WS_W2 = 55 * MiB;
constexpr size_t WS_H = 72 * MiB;
constexpr size_t WS_QA = 136 * MiB, WS_KA = 168 * MiB, WS_VA = 176 * MiB, WS_QLAT = 184 * MiB, WS_KVLAT = 208 * MiB;
constexpr size_t WS_KB = 224 * MiB, WS_VB = 272 * MiB, WS_QB = 304 * MiB, WS_OB = 352 * MiB, WS_SA = 384 * MiB, WS_SB = 448 * MiB, WS_XB = 512 * MiB, WS_QA8 = 576 * MiB, WS_KA8 = 592 * MiB, WS_VTA8 = 596 * MiB, WS_QB8 = 600 * MiB, WS_KB8 = 624 * MiB, WS_VTB8 = 648 * MiB, WS_END = 664 * MiB;
constexpr size_t WS_ACT = 136 * MiB, WS_Y2 = 208 * MiB;
constexpr int ACT_ROWS = 2 * T + NE * 256;
static_assert(WS_ACT + (size_t)ACT_ROWS * FF * 2 <= WS_Y2 && WS_Y2 + (size_t)2 * T * D * 2 <= WS_XB, "moe overlay");
constexpr int CW_BAR = 4096;
constexpr int CW_CNT = 16384;

constexpr int RING_BYTES = 131072, MISC_OFF = RING_BYTES, LDS_BYTES = 147456;

__device__ __forceinline__ float bf2f(unsigned v) { return __uint_as_float(v << 16); }
typedef __bf16 bf16x2_t __attribute__((ext_vector_type(2)));
__device__ __forceinline__ unsigned cvt_pk_bf16(float lo, float hi) { f32x2 v = {lo, hi}; bf16x2_t b = __builtin_convertvector(v, bf16x2_t); return __builtin_bit_cast(unsigned, b); }
__device__ __forceinline__ u32x4 pack8(f32x4 a, f32x4 b) { u32x4 w; w.x = cvt_pk_bf16(a[0], a[1]); w.y = cvt_pk_bf16(a[2], a[3]); w.z = cvt_pk_bf16(b[0], b[1]); w.w = cvt_pk_bf16(b[2], b[3]); return w; }
__device__ __forceinline__ u32x2 pack8_fp8(f32x4 a, f32x4 b) { u32x2 w;
    w.x = (unsigned)__builtin_amdgcn_cvt_pk_fp8_f32(a[2], a[3], __builtin_amdgcn_cvt_pk_fp8_f32(a[0], a[1], 0, false), true);
    w.y = (unsigned)__builtin_amdgcn_cvt_pk_fp8_f32(b[2], b[3], __builtin_amdgcn_cvt_pk_fp8_f32(b[0], b[1], 0, false), true); return w; }
__device__ __forceinline__ void unpack8(u32x4 w, f32x4& a, f32x4& b) { a[0] = bf2f(w.x & 0xffffu); a[1] = bf2f(w.x >> 16); a[2] = bf2f(w.y & 0xffffu); a[3] = bf2f(w.y >> 16); b[0] = bf2f(w.z & 0xffffu); b[1] = bf2f(w.z >> 16); b[2] = bf2f(w.w & 0xffffu); b[3] = bf2f(w.w >> 16); }
__device__ __forceinline__ float wave_sum(float v) {
#pragma unroll
    for (int o = 1; o < 64; o <<= 1) v += __shfl_xor(v, o);
    return v;
}
__device__ __forceinline__ float sigm(float v) { return __builtin_amdgcn_rcpf(1.f + __builtin_amdgcn_exp2f(v * (-LOG2E))); }
#if WT_STORES
__device__ __forceinline__ void st16(void* p, u32x4 v) { asm volatile("global_store_dwordx4 %0, %1, off sc1\n\ts_nop 1" :: "v"(p), "v"(v) : "memory"); }
__device__ __forceinline__ void st8(void* p, u32x2 v) { asm volatile("global_store_dwordx2 %0, %1, off sc1\n\ts_nop 1" :: "v"(p), "v"(v) : "memory"); }
#else
__device__ __forceinline__ void st16(void* p, u32x4 v) { *(u32x4*)p = v; }
__device__ __forceinline__ void st8(void* p, u32x2 v) { *(u32x2*)p = v; }
#endif
#define VM_WAIT() asm volatile("s_waitcnt vmcnt(0)" ::: "memory")
#define LAUNDER_S(p) asm volatile("" : "+s"(p))
#define LAUNDER_V(v) asm volatile("" : "+v"(v))
#define LDS_WAIT() asm volatile("s_waitcnt lgkmcnt(0)" ::: "memory")

#define XB_TMO      128
#define XB_XCNT(j)  (256  + 64 * (j))
#define XB_XSUB(j)  (1280 + 64 * (j))
#define XB_XGEN(j)  (2304 + 64 * (j))
#define XB_TOP      3328
#define XB_TOPGEN   3392
#define XCD_BAR_WORDS 3456
#define XB_SPIN_CAP (1u << 22)
__device__ __forceinline__ unsigned xb_ld(unsigned* p)              { return __hip_atomic_load(p, __ATOMIC_RELAXED, __HIP_MEMORY_SCOPE_AGENT); }
__device__ __forceinline__ unsigned xb_add(unsigned* p, unsigned v) { return __hip_atomic_fetch_add(p, v, __ATOMIC_RELAXED, __HIP_MEMORY_SCOPE_AGENT); }
__device__ __forceinline__ unsigned xb_xcc_id() { return (unsigned)__builtin_amdgcn_s_getreg((3 << 11) | 20) & 0xFu; }
#define XB_SPIN(cond, bar) do { unsigned _sp = 0; while (cond) { __builtin_amdgcn_s_sleep(1); \
    if ((++_sp & 255u) == 0u) { if (xb_ld(&(bar)[XB_TMO])) break; if (_sp > XB_SPIN_CAP) { atomicAdd(&(bar)[XB_TMO], 1u); break; } } } } while (0)
struct XcdBarrier { unsigned* bar; unsigned x; volatile LAS unsigned* st; };
__device__ __forceinline__ XcdBarrier xcd_barrier_post(unsigned* bar, volatile LAS unsigned* st) {
    XcdBarrier b; b.bar = bar; b.x = xb_xcc_id(); b.st = st;
    if (threadIdx.x == 0) (void)xb_add(&bar[XB_XCNT(b.x)], 1u);
    return b;
}
__device__ __forceinline__ void xcd_barrier_complete(unsigned* bar, unsigned x, unsigned& nloc, unsigned& nx) {
    const unsigned G = gridDim.x * gridDim.y * gridDim.z;
    unsigned sum, cnt, mine, sp = 0u;
    for (;;) {
        sum = 0u; cnt = 0u; mine = 0u;
#pragma unroll
        for (unsigned j = 0; j < 16; ++j) { const unsigned c = xb_ld(&bar[XB_XCNT(j)]); sum += c; cnt += (c > 0u) ? 1u : 0u; mine = (j == x) ? c : mine; }
        if (sum == G) break;
        __builtin_amdgcn_s_sleep(1);
        if ((++sp & 255u) == 0u) { if (xb_ld(&bar[XB_TMO])) break; if (sp > XB_SPIN_CAP) { atomicAdd(&bar[XB_TMO], 1u); break; } }
    }
    nloc = mine > 0u ? mine : 1u; nx = cnt > 0u ? cnt : 1u;
}
__device__ __forceinline__ void xcd_barrier(const XcdBarrier& b) {
    asm volatile("s_waitcnt vmcnt(0)" ::: "memory");
    __syncthreads();
    if (threadIdx.x == 0) {
        unsigned* bar = b.bar;
        __builtin_amdgcn_s_waitcnt(0);
        unsigned nloc = b.st[0], nx = b.st[1];
        if (nloc == 0u) { xcd_barrier_complete(bar, b.x, nloc, nx); b.st[0] = nloc; b.st[1] = nx; }
        const unsigned old = xb_add(&bar[XB_XSUB(b.x)], 1u);
        const unsigned gen = old / nloc;
        if (old + 1u == (gen + 1u) * nloc) {
            __builtin_amdgcn_fence(__ATOMIC_RELEASE, "agent");
            asm volatile("s_waitcnt vmcnt(0)" ::: "memory");
            const unsigned og = xb_add(&bar[XB_TOP], 1u);
            const unsigned tg = og / nx;
            if (og + 1u == (tg + 1u) * nx) xb_add(&bar[XB_TOPGEN], 1u);
            else XB_SPIN(xb_ld(&bar[XB_TOPGEN]) == tg, bar);
            __builtin_amdgcn_fence(__ATOMIC_ACQUIRE, "agent");
            xb_add(&bar[XB_XGEN(b.x)], 1u);
            asm volatile("s_waitcnt vmcnt(0)" ::: "memory");
        } else {
            XB_SPIN(xb_ld(&bar[XB_XGEN(b.x)]) == gen, bar);
            __builtin_amdgcn_fence(__ATOMIC_ACQUIRE, "agent");
            asm volatile("s_waitcnt vmcnt(0)" ::: "memory");
        }
    }
    __syncthreads();
}

namespace gp {
constexpr int BM = 256, BK = 64, HALF = 128, HTB = HALF * BK * 2, NXCD = 8, WGM = 8;
__host__ __device__ __forceinline__ int lds_byte(int r, int c) { const int st = (r >> 4) * 2 + (c >> 5), rr = r & 15, cc = c & 31, ob = rr * 64 + cc * 2; return st * 1024 + (ob ^ (((ob >> 9) & 1) << 5)); }
__host__ __device__ __forceinline__ void stage_rc(int b, int& R, int& C) { const int st = b / 1024, sb = b % 1024, swz = sb ^ (((sb >> 9) & 1) << 5); R = (st >> 1) * 16 + swz / 64; C = (st & 1) * 32 + (swz % 64) / 2; }
__host__ __device__ __forceinline__ int perm32(int rho) { const int n = rho >> 4, i = rho & 15; return 8 * (i >> 2) + 4 * n + (i & 3); }

struct Unit { int pm, pn, be, rl, nv; };
struct Gemm { const bf16_t* A; const bf16_t* Bt; int K; size_t bstride; const unsigned* list; size_t astride; };

__device__ __forceinline__ int xcd_remap(int wgid, int nwg) { const int q = nwg / NXCD, r = nwg % NXCD, xcd = wgid % NXCD, off = wgid / NXCD; return (xcd < r ? xcd * (q + 1) : r * (q + 1) + (xcd - r) * q) + off; }
struct DenseOrder {
    int nM, nN, nwg, G, c;
    __device__ void init(int M, int N, int G_, int c_) { nM = M / BM; nN = N / BM; nwg = nM * nN; G = G_; c = c_; }
    __device__ bool next(int i, Unit& u) const {
        const long L = (long)i * G + c; if (L >= nwg) return false;
        const int wgid = xcd_remap((int)L, nwg);
        const int nig = WGM * nN, gid = wgid / nig, fm = gid * WGM, gsz = (nM - fm) < WGM ? (nM - fm) : WGM;
        u.pm = fm + ((wgid % nig) % gsz); u.pn = (wgid % nig) / gsz; u.be = 0; u.rl = 0; u.nv = 256; return true;
    }
};
struct PairOrder {
    DenseOrder d;
    __device__ void init(int M, int N, int G_, int c_) { d.init(M, N, G_, c_); }
    __device__ bool next(int i, Unit& u) const { if (!d.next(i >> 1, u)) return false; u.be = i & 1; return true; }
};
struct MoeOrder {
    const LAS int* tab; int nwg, G, c;
    __device__ static int rd(const LAS int* p) { return __builtin_amdgcn_readfirstlane(*p); }
    __device__ void init(const LAS int* tab_, int G_, int c_) { tab = tab_; nwg = rd(tab_ + 16) * 4; G = G_; c = c_; }
    __device__ bool next(int i, Unit& u) const {
        const long L = (long)i * G + c; if (L >= nwg) return false;
        const int wgid = xcd_remap((int)L, nwg);
        const int tile = wgid >> 2; int e = 0;
        for (int k = 1; k < NE; ++k) e += (rd(tab + k) <= tile) ? 1 : 0;
        u.pm = tile; u.pn = wgid & 3; u.be = e; u.rl = tile - rd(tab + e); const int rem = rd(tab + 32 + e) - u.rl * 256; u.nv = rem < 256 ? rem : 256; return true;
    }
};

#define ACC_T f32x4 (&acc)[2][2][4][2]

template <class Epi, class Sched, bool GATHER>
__device__ __forceinline__ void gemm_phase_ref(int tid, const Gemm g, const Sched& S, const Epi& E) {
    const int wid = __builtin_amdgcn_readfirstlane(tid >> 6), lane = tid & 63, wr = wid >> 2, wc = wid & 3, fr = lane & 15, fq = lane >> 4;
    const int K = g.K; Unit u;
    for (int ui = 0; S.next(ui, u); ++ui) {
        f32x4 acc[2][2][4][2];
#pragma unroll
        for (int a = 0; a < 2; ++a)
#pragma unroll
            for (int b = 0; b < 2; ++b)
#pragma unroll
                for (int m = 0; m < 4; ++m)
#pragma unroll
                    for (int n = 0; n < 2; ++n) acc[a][b][m][n] = (f32x4){0.f, 0.f, 0.f, 0.f};
        const bf16_t* Bt = g.Bt + (size_t)u.be * g.bstride + (size_t)u.pn * 256 * K;
        for (int ai = 0; ai < 2; ++ai)
            for (int m = 0; m < 4; ++m) {
                const int rloc = ai * 128 + wr * 64 + m * 16 + fr;
                size_t arow;
                if (GATHER) { arow = (rloc < u.nv) ? (size_t)(g.list[(size_t)u.be * T + u.rl * 256 + rloc] >> 1) : 0; }
                else arow = (size_t)u.pm * 256 + rloc;
                const bf16_t* ap = g.A + arow * K;
                for (int bj = 0; bj < 2; ++bj) {
                    const bf16_t* bp = Bt + (size_t)(bj * 128 + wc * 32 + fq * 8) * K;
                    float s[8];
#pragma unroll
                    for (int c = 0; c < 8; ++c) {
                        float sc = 0.f; const bf16_t* bpc = bp + (size_t)c * K;
#pragma unroll 2
                        for (int k = 0; k < K; k += 8) {
                            f32x4 a0, a1, b0, b1; unpack8(*(const u32x4*)(ap + k), a0, a1); unpack8(*(const u32x4*)(bpc + k), b0, b1);
                            sc += a0[0] * b0[0] + a0[1] * b0[1] + a0[2] * b0[2] + a0[3] * b0[3] + a1[0] * b1[0] + a1[1] * b1[1] + a1[2] * b1[2] + a1[3] * b1[3];
                        }
                        s[c] = sc; asm volatile("" : "+v"(s[c]));
                    }
#pragma unroll
                    for (int a2 = 0; a2 < 2; ++a2)
#pragma unroll
                        for (int b2 = 0; b2 < 2; ++b2)
#pragma unroll
                            for (int m2 = 0; m2 < 4; ++m2)
                                if (a2 == ai && b2 == bj && m2 == m) { acc[a2][b2][m2][0] = (f32x4){s[0], s[1], s[2], s[3]}; acc[a2][b2][m2][1] = (f32x4){s[4], s[5], s[6], s[7]}; }
                }
            }
        E(acc, u, wr, wc, fr, fq);
    }
}

template <class E> struct EpiTraits { static constexpr bool KEEP = false; };
#if FAST_GEMM
template <class Epi, class Sched, bool GATHER>
__device__ __forceinline__ void gemm_phase_fast(int tid, LAS unsigned char* lds, const Gemm g, const Sched& S, const Epi& E) {
    const int wid = __builtin_amdgcn_readfirstlane(tid >> 6), lane = tid & 63, wr = wid >> 2, wc = wid & 3, fr = lane & 15, fq = lane >> 4;
    const int K = g.K, nt = K / BK;
    int Rr[2], Cc[2]; unsigned voffB[2];
#pragma unroll
    for (int i = 0; i < 2; ++i) { stage_rc(tid * 16 + i * 8192, Rr[i], Cc[i]); const int Rb = (Rr[i] & ~31) + perm32(Rr[i] & 31); voffB[i] = (unsigned)(Rb * K + Cc[i]) * 2u; }
    const size_t kstep = (size_t)(BK * 2), hstep = (size_t)HALF * K * 2, tstep = 2 * hstep;
    const unsigned ldsw = (unsigned)wid * 1024u;
    const int aoff = lds_byte(wr * 64 + fr, fq * 8), boff = lds_byte(wc * 32 + fr, fq * 8);
#define GP_SA(b, h) (((b) * 2 + (h)) * HTB)
#define GP_SB(b, h) ((4 + (b) * 2 + (h)) * HTB)
#define GP_STAGE2(bufoff, gbase, v0, v1) do { \
        __builtin_amdgcn_global_load_lds((const unsigned*)((const char*)(gbase) + (v0)), (LAS unsigned*)(lds + (bufoff) + ldsw), 16, 0, 0); \
        __builtin_amdgcn_global_load_lds((const unsigned*)((const char*)(gbase) + (v1)), (LAS unsigned*)(lds + (bufoff) + ldsw + 8192), 16, 0, 0); } while (0)
#define GP_STAGEB(bufoff, gbase) GP_STAGE2(bufoff, gbase, voffB[0], voffB[1])
#define GP_LDA(dst, b, h) do { _Pragma("unroll") for (int m = 0; m < 4; ++m) _Pragma("unroll") for (int k = 0; k < 2; ++k) dst[m][k] = *(const LAS bf16x8*)(lds + GP_SA(b, h) + aoff + m * 2048 + k * 1024); } while (0)
#define GP_LDB(dst, b, h) do { _Pragma("unroll") for (int n = 0; n < 2; ++n) _Pragma("unroll") for (int k = 0; k < 2; ++k) dst[n][k] = *(const LAS bf16x8*)(lds + GP_SB(b, h) + boff + n * 2048 + k * 1024); } while (0)
#define GP_MMA(ai, bj, At, Bt) do { __builtin_amdgcn_s_setprio(1); _Pragma("unroll") for (int m = 0; m < 4; ++m) _Pragma("unroll") for (int n = 0; n < 2; ++n) _Pragma("unroll") for (int k = 0; k < 2; ++k) \
        acc[ai][bj][m][n] = __builtin_amdgcn_mfma_f32_16x16x32_bf16(Bt[n][k], At[m][k], acc[ai][bj][m][n], 0, 0, 0); __builtin_amdgcn_s_setprio(0); } while (0)
#define GP_WAIT_V(n) asm volatile("s_waitcnt vmcnt(" #n ")" ::: "memory")
#define GP_WAIT_L(n) asm volatile("s_waitcnt lgkmcnt(" #n ")" ::: "memory")
#define GP_BAR __builtin_amdgcn_s_barrier()
#define GP_SCHED __builtin_amdgcn_sched_barrier(0)
    Unit cur, nxt; int ui = 0;
    if (!S.next(0, cur)) return;
    f32x4 acc[2][2][4][2];
#pragma unroll
    for (int a = 0; a < 2; ++a)
#pragma unroll
        for (int b = 0; b < 2; ++b)
#pragma unroll
            for (int m = 0; m < 4; ++m)
#pragma unroll
                for (int n = 0; n < 2; ++n) acc[a][b][m][n] = (f32x4){0.f, 0.f, 0.f, 0.f};
    bf16x8 At[4][2], B0[2][2], B1[2][2];
    unsigned vC0, vC1, vC2, vC3, vN0, vN1, vN2, vN3;
#define GP_VOFF(u, o0, o1, o2, o3) do { if (GATHER) { \
        int tl_ = tid; LAUNDER_V(tl_); int R0_, C0_, R1_, C1_; stage_rc(tl_ * 16, R0_, C0_); stage_rc(tl_ * 16 + 8192, R1_, C1_);     \
        const unsigned* lp = g.list + (size_t)(u).be * T + (u).rl * 256; \
        const int nvm = (u).nv - 1; const int p0 = min(R0_, nvm), p1 = min(R1_, nvm), p2 = min(128 + R0_, nvm), p3 = min(128 + R1_, nvm); \
        const unsigned t0 = lp[p0] >> 1, t1 = lp[p1] >> 1, t2 = lp[p2] >> 1, t3 = lp[p3] >> 1; \
        o0 = (t0 * K + C0_) * 2u; o1 = (t1 * K + C1_) * 2u; o2 = (t2 * K + C0_) * 2u; o3 = (t3 * K + C1_) * 2u; \
      } else { o0 = (unsigned)(Rr[0] * K + Cc[0]) * 2u; o1 = (unsigned)(Rr[1] * K + Cc[1]) * 2u; o2 = o0 + (unsigned)hstep; o3 = o1 + (unsigned)hstep; } } while (0)
    GP_VOFF(cur, vC0, vC1, vC2, vC3);
    const char* cA = (const char*)g.A + ((size_t)cur.be * g.astride) * 2 + (GATHER ? (size_t)0 : (size_t)cur.pm * tstep);
    const char* cB = (const char*)g.Bt + ((size_t)cur.be * g.bstride) * 2 + (size_t)cur.pn * tstep;
    GP_STAGEB(GP_SB(0, 0), cB); GP_STAGEB(GP_SB(0, 1), cB + hstep); GP_STAGE2(GP_SA(0, 0), cA, vC0, vC1); GP_STAGE2(GP_SA(0, 1), cA, vC2, vC3);
    if (wr == 1) GP_BAR;
    GP_WAIT_V(2); GP_BAR;
    GP_STAGEB(GP_SB(1, 0), cB + kstep); GP_STAGE2(GP_SA(1, 0), cA + kstep, vC0, vC1); GP_STAGEB(GP_SB(1, 1), cB + hstep + kstep);
    GP_WAIT_V(6); GP_BAR;
    for (;;) {
        const bool has_next = S.next(ui + 1, nxt);
        const char* nA = has_next ? (const char*)g.A + ((size_t)nxt.be * g.astride) * 2 + (GATHER ? (size_t)0 : (size_t)nxt.pm * tstep) : cA;
        const char* nB = has_next ? (const char*)g.Bt + ((size_t)nxt.be * g.bstride) * 2 + (size_t)nxt.pn * tstep : cB;
        if (has_next) { GP_VOFF(nxt, vN0, vN1, vN2, vN3); } else { vN0 = vC0; vN1 = vC1; vN2 = vC2; vN3 = vC3; }
#pragma nounroll
        for (int t = 0; t < nt; t += 2) {
            const bool last = (t == nt - 2);
            const char* a1 = cA + (size_t)(t + 1) * kstep;
            const char* a2 = last ? nA : cA + (size_t)(t + 2) * kstep; const char* b2 = last ? nB : cB + (size_t)(t + 2) * kstep;
            const char* a3 = a2 + kstep; const char* b3 = b2 + kstep;
            const unsigned w0 = last ? vN0 : vC0, w1 = last ? vN1 : vC1, w2 = last ? vN2 : vC2, w3 = last ? vN3 : vC3;
            GP_LDB(B0, 0, 0); GP_LDB(B1, 0, 1); GP_SCHED; GP_LDA(At, 0, 0); GP_STAGE2(GP_SA(1, 1), a1, vC2, vC3);
            GP_WAIT_V(8); GP_WAIT_L(0); GP_BAR; GP_MMA(0, 0, At, B0); GP_MMA(0, 1, At, B1); GP_BAR; GP_SCHED;
            GP_LDA(At, 0, 1); GP_STAGEB(GP_SB(0, 0), b2); GP_STAGEB(GP_SB(0, 1), b2 + hstep); GP_STAGE2(GP_SA(0, 0), a2, w0, w1);
            GP_WAIT_V(8); GP_WAIT_L(0); GP_BAR; GP_MMA(1, 0, At, B0); GP_MMA(1, 1, At, B1); GP_BAR; GP_SCHED;
            GP_LDB(B0, 1, 0); GP_LDB(B1, 1, 1); GP_SCHED; GP_LDA(At, 1, 0); GP_STAGE2(GP_SA(0, 1), a2, w2, w3);
            GP_WAIT_V(8); GP_WAIT_L(0); GP_BAR; GP_MMA(0, 0, At, B0); GP_MMA(0, 1, At, B1); GP_BAR; GP_SCHED;
            GP_LDA(At, 1, 1); GP_STAGEB(GP_SB(1, 0), b3); GP_STAGEB(GP_SB(1, 1), b3 + hstep); GP_STAGE2(GP_SA(1, 0), a3, w0, w1);
            GP_WAIT_V(8); GP_WAIT_L(0); GP_BAR; GP_MMA(1, 0, At, B0); GP_MMA(1, 1, At, B1); GP_BAR; GP_SCHED;
        }
        if (wr == 0) GP_BAR;
        E(acc, cur, wr, wc, fr, fq);
        if (!has_next) break;
        if (!(EpiTraits<Epi>::KEEP && cur.be == 0)) {
#pragma unroll
        for (int a = 0; a < 2; ++a)
#pragma unroll
            for (int b = 0; b < 2; ++b)
#pragma unroll
                for (int m = 0; m < 4; ++m)
#pragma unroll
                    for (int n = 0; n < 2; ++n) acc[a][b][m][n] = (f32x4){0.f, 0.f, 0.f, 0.f};
        }
        cur = nxt; cA = nA; cB = nB; vC0 = vN0; vC1 = vN1; vC2 = vN2; vC3 = vN3; ++ui;
        if (wr == 1) GP_BAR;
    }
    GP_WAIT_V(0);
    GP_BAR;
#undef GP_SA
#undef GP_SB
#undef GP_STAGE2
#undef GP_STAGEB
#undef GP_LDA
#undef GP_LDB
#undef GP_MMA
#undef GP_WAIT_V
#undef GP_WAIT_L
#undef GP_BAR
#undef GP_SCHED
#undef GP_VOFF
}
#endif

template <class Epi, class Sched, bool GATHER = false>
__device__ __forceinline__ void gemm_phase(int tid, LAS unsigned char* lds, const Gemm g, const Sched& S, const Epi& E) {
#if FAST_GEMM
    gemm_phase_fast<Epi, Sched, GATHER>(tid, lds, g, S, E);
#else
    (void)lds; gemm_phase_ref<Epi, Sched, GATHER>(tid, g, S, E);
#endif
}

#define EPI_ROW(ai, m) (u.pm * 256 + (ai) * 128 + wr * 64 + (m) * 16 + fr)
#define EPI_COL(bj) (u.pn * 256 + (bj) * 128 + wc * 32 + fq * 8)
__device__ __forceinline__ float dot4(f32x4 a) { return (a[0] * a[0] + a[1] * a[1]) + (a[2] * a[2] + a[3] * a[3]); }

struct EpiNull {
    __device__ __forceinline__ void operator()(const ACC_T, const Unit& u, int wr, int wc, int fr, int fq) const {
#pragma unroll
        for (int ai = 0; ai < 2; ++ai)
#pragma unroll
            for (int bj = 0; bj < 2; ++bj)
#pragma unroll
                for (int m = 0; m < 4; ++m) asm volatile("" :: "v"(acc[ai][bj][m][0]), "v"(acc[ai][bj][m][1]));
    }
};
struct EpiIn {
    bf16_t *QA, *KA, *VA, *QLAT, *KVLAT, *KB, *SA, *SB; float *SSQ, *SSKV; const float *gq, *gk, *cosA, *sinA, *cosB, *sinB;
    __device__ __forceinline__ void operator()(const ACC_T, const Unit& u, int wr, int wc, int fr, int fq) const {
        const int wb = u.pn * 4 + wc;
        if (wb < 10) {
            const bool isq = wb < 8; const int head = isq ? wb : wb - 8; const float* g = isq ? gq : gk; bf16_t* dst = isq ? QA : KA; const int dp = isq ? 512 : 128; const float qs = isq ? QSCALE_A : 1.f;
            const f32x4 g00 = *(const f32x4*)(g + 8 * fq), g01 = *(const f32x4*)(g + 8 * fq + 4), g10 = *(const f32x4*)(g + 32 + 8 * fq), g11 = *(const f32x4*)(g + 36 + 8 * fq);
#pragma unroll
            for (int ai = 0; ai < 2; ++ai)
#pragma unroll
                for (int m = 0; m < 4; ++m) {
                    const int r = EPI_ROW(ai, m), pos = r & (S - 1);
                    const f32x4 v00 = acc[ai][0][m][0], v01 = acc[ai][0][m][1], v10 = acc[ai][1][m][0], v11 = acc[ai][1][m][1];
                    float ss = (dot4(v00) + dot4(v01)) + (dot4(v10) + dot4(v11)); ss += __shfl_xor(ss, 16); ss += __shfl_xor(ss, 32);
                    const float rstd = rsqrtf(ss * (1.f / 64.f) + EPS);
                    const f32x4 y00 = v00 * rstd * g00, y01 = v01 * rstd * g01, y10 = v10 * rstd * g10, y11 = v11 * rstd * g11;
                    const f32x4 c0 = *(const f32x4*)(cosA + pos * 32 + 8 * fq), c1 = *(const f32x4*)(cosA + pos * 32 + 8 * fq + 4), s0 = *(const f32x4*)(sinA + pos * 32 + 8 * fq), s1 = *(const f32x4*)(sinA + pos * 32 + 8 * fq + 4);
                    const f32x4 o00 = (y00 * c0 - y10 * s0) * qs, o01 = (y01 * c1 - y11 * s1) * qs, o10 = (y10 * c0 + y00 * s0) * qs, o11 = (y11 * c1 + y01 * s1) * qs;
#if ATT_FP8_A
                    unsigned char* p8 = (unsigned char*)dst + (size_t)r * dp + head * 64 + 8 * fq;
                    st8(p8, pack8_fp8(o00, o01)); st8(p8 + 32, pack8_fp8(o10, o11));
#else
                    bf16_t* p = dst + (size_t)r * dp + head * 64 + 8 * fq;
                    st16(p, pack8(o00, o01)); st16((p + 32), pack8(o10, o11));
#endif
                }
        } else if (wb < 12) {
#pragma unroll
            for (int ai = 0; ai < 2; ++ai)
#pragma unroll
                for (int m = 0; m < 4; ++m) {
#if ATT_FP8_A
                    const int r = EPI_ROW(ai, m), sq = r & (S - 1), k = sq & 63, pos = 32 * ((k >> 2) & 1) + 16 * (k >> 5) + (k & 3) + 4 * ((k & 31) >> 3);
                    unsigned char* vtb = (unsigned char*)VA; const unsigned vo = (unsigned)(((r >> 12) * 2 + (wb - 10)) * 64 + 8 * fq) * S + (unsigned)((sq & ~63) + pos);
#pragma unroll
                    for (int bj = 0; bj < 2; ++bj)
#pragma unroll
                        for (int n = 0; n < 2; ++n) { const f32x4 x = acc[ai][bj][m][n]; const unsigned w = (unsigned)__builtin_amdgcn_cvt_pk_fp8_f32(x[2], x[3], __builtin_amdgcn_cvt_pk_fp8_f32(x[0], x[1], 0, false), true);
                            const unsigned qo = vo + (unsigned)(bj * 32 + 4 * n) * S;
                            vtb[qo] = (unsigned char)(w & 0xffu); vtb[qo + S] = (unsigned char)((w >> 8) & 0xffu); vtb[qo + 2 * S] = (unsigned char)((w >> 16) & 0xffu); vtb[qo + 3 * S] = (unsigned char)(w >> 24); }
#else
                    bf16_t* p = VA + (size_t)EPI_ROW(ai, m) * 128 + (wb - 10) * 64 + 8 * fq;
                    st16(p, pack8(acc[ai][0][m][0], acc[ai][0][m][1])); st16((p + 32), pack8(acc[ai][1][m][0], acc[ai][1][m][1]));
#endif
                }
        } else if (wb < 22) {
            const bool isq = wb < 18; const int idx = isq ? wb - 12 : wb - 18; bf16_t* dst = isq ? QLAT : KVLAT; const int dp = isq ? 384 : 256;
#pragma unroll
            for (int ai = 0; ai < 2; ++ai)
#pragma unroll
                for (int m = 0; m < 4; ++m) {
                    const int r = EPI_ROW(ai, m);
                    const f32x4 v00 = acc[ai][0][m][0], v01 = acc[ai][0][m][1], v10 = acc[ai][1][m][0], v11 = acc[ai][1][m][1];
                    float ss = (dot4(v00) + dot4(v01)) + (dot4(v10) + dot4(v11)); ss += __shfl_xor(ss, 16); ss += __shfl_xor(ss, 32);
                    if (fq == 0) { if (isq) SSQ[(size_t)r * 8 + idx] = ss; else SSKV[(size_t)r * 4 + idx] = ss; }
                    bf16_t* p = dst + (size_t)r * dp + idx * 64 + 8 * fq;
                    st16(p, pack8(v00, v01)); st16((p + 32), pack8(v10, v11));
                }
        } else if (wb == 22) {
            if (fq < 2) {
#pragma unroll
                for (int ai = 0; ai < 2; ++ai)
#pragma unroll
                    for (int m = 0; m < 4; ++m) {
                        const int r = EPI_ROW(ai, m), pos = r & (S - 1);
                        const f32x4 x10 = acc[ai][0][m][0], x11 = acc[ai][0][m][1], x20 = acc[ai][1][m][0], x21 = acc[ai][1][m][1];
                        const f32x4 c0 = *(const f32x4*)(cosB + pos * 16 + 8 * fq), c1 = *(const f32x4*)(cosB + pos * 16 + 8 * fq + 4), s0 = *(const f32x4*)(sinB + pos * 16 + 8 * fq), s1 = *(const f32x4*)(sinB + pos * 16 + 8 * fq + 4);
#if ATT_FP8_B
                        const u32x2 w1 = pack8_fp8(x10 * c0 - x20 * s0, x11 * c1 - x21 * s1), w2 = pack8_fp8(x20 * c0 + x10 * s0, x21 * c1 + x11 * s1);
                        unsigned char* p = (unsigned char*)KB + (size_t)r * 768 + 64 + 8 * fq;
#pragma unroll
                        for (int h = 0; h < 8; ++h) { st8(p + h * 96, w1); st8(p + h * 96 + 16, w2); }
#else
                        const u32x4 w1 = pack8(x10 * c0 - x20 * s0, x11 * c1 - x21 * s1), w2 = pack8(x20 * c0 + x10 * s0, x21 * c1 + x11 * s1);
                        bf16_t* p = KB + (size_t)r * 768 + 64 + 8 * fq;
#pragma unroll
                        for (int h = 0; h < 8; ++h) { st16((p + h * 96), w1); st16((p + h * 96 + 16), w2); }
#endif
                    }
            }
        } else if (wb == 23) {
        } else {
            const bool isa = wb < 40; const int idx = isa ? wb - 24 : wb - 40; unsigned char* dst = (unsigned char*)(isa ? SA : SB);
#pragma unroll
            for (int ai = 0; ai < 2; ++ai)
#pragma unroll
                for (int m = 0; m < 4; ++m) { unsigned char* p = dst + (size_t)EPI_ROW(ai, m) * 1024 + idx * 64 + 8 * fq;
#pragma unroll
                    for (int bj = 0; bj < 2; ++bj) { const f32x4 a = acc[ai][bj][m][0], b = acc[ai][bj][m][1]; u32x2 w;
                        w.x = (unsigned)__builtin_amdgcn_cvt_pk_fp8_f32(a[2], a[3], __builtin_amdgcn_cvt_pk_fp8_f32(a[0], a[1], 0, false), true);
                        w.y = (unsigned)__builtin_amdgcn_cvt_pk_fp8_f32(b[2], b[3], __builtin_amdgcn_cvt_pk_fp8_f32(b[0], b[1], 0, false), true);
                        st8((p + bj * 32), w); } }
        }
    }
};
__host__ __device__ __forceinline__ int src_col_in(int n) {
    const int pn = n >> 8, nl = n & 255, bj = nl >> 7, wc = (nl & 127) >> 5, p = nl & 31, wb = pn * 4 + wc, s = bj * 32 + p;
    if (wb < 8) return wb * 64 + s;
    if (wb < 10) return 512 + (wb - 8) * 64 + s;
    if (wb < 12) return 640 + (wb - 10) * 64 + s;
    if (wb < 18) return 768 + (wb - 12) * 64 + s;
    if (wb < 22) return 1152 + (wb - 18) * 64 + s;
    if (wb == 22) return p < 16 ? 1408 + bj * 16 + p : -1;
    if (wb == 23) return -1;
    if (wb < 40) return 1440 + (wb - 24) * 64 + s;
    return 2464 + (wb - 40) * 64 + s;
}
struct EpiQb {
    bf16_t* QB; const float *SSQ, *cosB, *sinB;
    __device__ __forceinline__ void operator()(const ACC_T, const Unit& u, int wr, int wc, int fr, int fq) const {
#pragma unroll
        for (int ai = 0; ai < 2; ++ai)
#pragma unroll
            for (int m = 0; m < 4; ++m) {
                const int r = EPI_ROW(ai, m), pos = r & (S - 1);
                const f32x4 sa = *(const f32x4*)(SSQ + (size_t)r * 8); const f32x2 sb = *(const f32x2*)(SSQ + (size_t)r * 8 + 4);
                const float rstd = rsqrtf((((sa[0] + sa[1]) + (sa[2] + sa[3])) + (sb[0] + sb[1])) * (1.f / 384.f) + EPS);
#pragma unroll
                for (int bj = 0; bj < 2; ++bj) {
                    f32x4 v0 = acc[ai][bj][m][0] * rstd, v1 = acc[ai][bj][m][1] * rstd;
                    const int c32 = u.pn * 8 + bj * 4 + wc;
                    if (c32 % 3 == 2) {
                        f32x4 o0, o1;
#pragma unroll
                        for (int j = 0; j < 4; ++j) { o0[j] = __shfl_xor(v0[j], 32); o1[j] = __shfl_xor(v1[j], 32); }
                        const int i0 = 8 * (fq & 1);
                        const f32x4 c0 = *(const f32x4*)(cosB + pos * 16 + i0), c1 = *(const f32x4*)(cosB + pos * 16 + i0 + 4), s0 = *(const f32x4*)(sinB + pos * 16 + i0), s1 = *(const f32x4*)(sinB + pos * 16 + i0 + 4);
                        if (fq < 2) { v0 = v0 * c0 - o0 * s0; v1 = v1 * c1 - o1 * s1; } else { v0 = v0 * c0 + o0 * s0; v1 = v1 * c1 + o1 * s1; }
                    }
#if ATT_FP8_B
                    st8((unsigned char*)QB + (size_t)r * 768 + EPI_COL(bj), pack8_fp8(v0 * QSCALE_B, v1 * QSCALE_B));
#else
                    st16((QB + (size_t)r * 768 + EPI_COL(bj)), pack8(v0 * QSCALE_B, v1 * QSCALE_B));
#endif
                }
            }
    }
};
struct EpiKvb {
    bf16_t *KB, *VB; const float* SSKV;
    __device__ __forceinline__ void operator()(const ACC_T, const Unit& u, int wr, int wc, int fr, int fq) const {
#pragma unroll
        for (int ai = 0; ai < 2; ++ai)
#pragma unroll
            for (int m = 0; m < 4; ++m) {
                const int r = EPI_ROW(ai, m);
                const f32x4 sa = *(const f32x4*)(SSKV + (size_t)r * 4);
                const float rstd = rsqrtf(((sa[0] + sa[1]) + (sa[2] + sa[3])) * (1.f / 256.f) + EPS);
#pragma unroll
                for (int bj = 0; bj < 2; ++bj) {
                    const int head = u.pn * 2 + bj, o = wc * 32 + fq * 8;
#if ATT_FP8_B
                    const f32x4 x0 = acc[ai][bj][m][0] * rstd, x1 = acc[ai][bj][m][1] * rstd;
                    if (wc < 2) st8((unsigned char*)KB + (size_t)r * 768 + head * 96 + o, pack8_fp8(x0, x1));
                    else {
                        const int sq = r & (S - 1), k = sq & 63, pos = 32 * ((k >> 2) & 1) + 16 * (k >> 5) + (k & 3) + 4 * ((k & 31) >> 3);
                        unsigned char* vtb = (unsigned char*)VB; const unsigned vo = (unsigned)(((r >> 12) * 8 + head) * 64 + (o - 64)) * S + (unsigned)((sq & ~63) + pos);
                        const u32x2 w = pack8_fp8(x0, x1);
                        vtb[vo] = (unsigned char)(w.x & 0xffu); vtb[vo + S] = (unsigned char)((w.x >> 8) & 0xffu); vtb[vo + 2 * S] = (unsigned char)((w.x >> 16) & 0xffu); vtb[vo + 3 * S] = (unsigned char)(w.x >> 24);
                        vtb[vo + 4 * S] = (unsigned char)(w.y & 0xffu); vtb[vo + 5 * S] = (unsigned char)((w.y >> 8) & 0xffu); vtb[vo + 6 * S] = (unsigned char)((w.y >> 16) & 0xffu); vtb[vo + 7 * S] = (unsigned char)(w.y >> 24);
                    }
#else
                    const u32x4 w = pack8(acc[ai][bj][m][0] * rstd, acc[ai][bj][m][1] * rstd);
                    if (wc < 2) st16((KB + (size_t)r * 768 + head * 96 + o), w); else st16((VB + (size_t)r * 512 + head * 64 + (o - 64)), w);
#endif
                }
            }
    }
};
template <int MODE> struct EpiProj {
    bf16_t* O; const bf16_t* gate;
    __device__ __forceinline__ void operator()(const ACC_T, const Unit& u, int wr, int wc, int fr, int fq) const {
#pragma unroll
        for (int ai = 0; ai < 2; ++ai)
#pragma unroll
            for (int m = 0; m < 4; ++m) {
                const int r = EPI_ROW(ai, m);
#pragma unroll
                for (int bj = 0; bj < 2; ++bj) {
                    const size_t off = (size_t)r * D + EPI_COL(bj);
                    const u32x2 gw = *(const u32x2*)((const unsigned char*)gate + off);
                    const f32x2 q0 = __builtin_amdgcn_cvt_pk_f32_fp8((int)gw.x, false), q1 = __builtin_amdgcn_cvt_pk_f32_fp8((int)gw.x, true), q2 = __builtin_amdgcn_cvt_pk_f32_fp8((int)gw.y, false), q3 = __builtin_amdgcn_cvt_pk_f32_fp8((int)gw.y, true);
                    const f32x4 g0 = {sigm(q0[0]), sigm(q0[1]), sigm(q1[0]), sigm(q1[1])}, g1 = {sigm(q2[0]), sigm(q2[1]), sigm(q3[0]), sigm(q3[1])};
                    f32x4 v0 = acc[ai][bj][m][0] * g0, v1 = acc[ai][bj][m][1] * g1;
                    if (MODE == 1) { f32x4 p0, p1; unpack8(*(const u32x4*)(O + off), p0, p1); v0 += p0; v1 += p1; }
                    if (MODE == 1) st16(O + off, pack8(v0, v1)); else *(u32x4*)(O + off) = pack8(v0, v1);
                }
            }
    }
};
struct EpiProjP {
    bf16_t* O; const unsigned char* SA; const unsigned char* SB;
    __device__ static __forceinline__ void gates(const unsigned char* G, size_t off, f32x4& g0, f32x4& g1) {
        const u32x2 gw = *(const u32x2*)(G + off);
        const f32x2 q0 = __builtin_amdgcn_cvt_pk_f32_fp8((int)gw.x, false), q1 = __builtin_amdgcn_cvt_pk_f32_fp8((int)gw.x, true), q2 = __builtin_amdgcn_cvt_pk_f32_fp8((int)gw.y, false), q3 = __builtin_amdgcn_cvt_pk_f32_fp8((int)gw.y, true);
        g0 = (f32x4){sigm(q0[0]), sigm(q0[1]), sigm(q1[0]), sigm(q1[1])}; g1 = (f32x4){sigm(q2[0]), sigm(q2[1]), sigm(q3[0]), sigm(q3[1])};
    }
    __device__ __forceinline__ void operator()(f32x4 (&acc)[2][2][4][2], const Unit& u, int wr, int wc, int fr, int fq) const {
#pragma unroll
        for (int ai = 0; ai < 2; ++ai)
#pragma unroll
            for (int m = 0; m < 4; ++m) {
                const int r = EPI_ROW(ai, m);
#pragma unroll
                for (int bj = 0; bj < 2; ++bj) {
                    const size_t off = (size_t)r * D + EPI_COL(bj);
                    f32x4 b0, b1; gates(SB, off, b0, b1);
#pragma unroll
                    for (int j = 0; j < 4; ++j) { b0[j] = fmaxf(b0[j], 9.094947e-13f); b1[j] = fmaxf(b1[j], 9.094947e-13f); }
                    if (u.be == 0) {
                        f32x4 a0, a1; gates(SA, off, a0, a1);
#pragma unroll
                        for (int j = 0; j < 4; ++j) { acc[ai][bj][m][0][j] *= a0[j] * __builtin_amdgcn_rcpf(b0[j]); acc[ai][bj][m][1][j] *= a1[j] * __builtin_amdgcn_rcpf(b1[j]); }
                    } else st16(O + off, pack8(acc[ai][bj][m][0] * b0, acc[ai][bj][m][1] * b1));
                }
            }
    }
};
template <> struct EpiTraits<EpiProjP> { static constexpr bool KEEP = true; };
struct EpiWo {
    const bf16_t* X; const float* modl; bf16_t* XO;
    __device__ __forceinline__ void operator()(const ACC_T, const Unit& u, int wr, int wc, int fr, int fq) const {
        const float* g1 = modl + (size_t)(u.pm >> 4) * 6 * D + 2 * D;
#pragma unroll
        for (int bj = 0; bj < 2; ++bj) {
            const int c = EPI_COL(bj); const f32x4 ga = *(const f32x4*)(g1 + c), gb = *(const f32x4*)(g1 + c + 4);
#pragma unroll
            for (int ai = 0; ai < 2; ++ai)
#pragma unroll
                for (int m = 0; m < 4; ++m) { const size_t off = (size_t)EPI_ROW(ai, m) * D + c;
                    f32x4 x0, x1; unpack8(*(const u32x4*)(X + off), x0, x1);
                    st16((XO + off), pack8(x0 + ga * acc[ai][bj][m][0], x1 + gb * acc[ai][bj][m][1])); }
        }
    }
};
struct EpiUp {
    bf16_t* ACT;
    __device__ __forceinline__ void operator()(const ACC_T, const Unit& u, int wr, int wc, int fr, int fq) const {
#pragma unroll
        for (int ai = 0; ai < 2; ++ai)
#pragma unroll
            for (int m = 0; m < 4; ++m) {
                f32x4 a = acc[ai][0][m][0], b = acc[ai][0][m][1]; const f32x4 c = acc[ai][1][m][0], d = acc[ai][1][m][1];
#pragma unroll
                for (int j = 0; j < 4; ++j) { a[j] = a[j] * sigm(a[j]) * c[j]; b[j] = b[j] * sigm(b[j]) * d[j]; }
                st16((ACT + (size_t)EPI_ROW(ai, m) * FF + u.pn * 128 + wc * 32 + fq * 8), pack8(a, b));
            }
    }
};
struct EpiDown {
    bf16_t* Y2; const unsigned* list; const float* gw;
    __device__ __forceinline__ void operator()(const ACC_T, const Unit& u, int wr, int wc, int fr, int fq) const {
#pragma unroll
        for (int ai = 0; ai < 2; ++ai)
#pragma unroll
            for (int m = 0; m < 4; ++m) {
                const int rloc = ai * 128 + wr * 64 + m * 16 + fr;
                if (rloc < u.nv) {
                    const unsigned entry = list[(size_t)u.be * T + u.rl * 256 + rloc]; const float w = gw[entry];
#pragma unroll
                    for (int bj = 0; bj < 2; ++bj) { const f32x4 a = acc[ai][bj][m][0] * (w * 16.f), b = acc[ai][bj][m][1] * (w * 16.f); u32x2 q;
                        q.x = (unsigned)__builtin_amdgcn_cvt_pk_fp8_f32(a[2], a[3], __builtin_amdgcn_cvt_pk_fp8_f32(a[0], a[1], 0, false), true);
                        q.y = (unsigned)__builtin_amdgcn_cvt_pk_fp8_f32(b[2], b[3], __builtin_amdgcn_cvt_pk_fp8_f32(b[0], b[1], 0, false), true);
                        st8(((unsigned char*)Y2 + (size_t)entry * D + EPI_COL(bj)), q); }
                }
            }
    }
};
}

namespace at {
struct Tensors { const bf16_t* Q; int qp; const bf16_t* K; int kp; const bf16_t* V; int vp; bf16_t* O; int op; int group; };
__device__ __forceinline__ bool next_unit(int i, int vcu, int G, int& bh, int& qb) {
    int u;
    if (G == 256) { if (i >= 4) return false; u = (vcu >> 5) * 128 + i * 32 + (vcu & 31); }
    else { u = i * G + vcu; if (u >= 1024) return false; }
    bh = u >> 4; qb = u & 15; return true;
}
template <int DQK>
__device__ __forceinline__ void attn_phase_ref(int tid, const Tensors& A, int vcu, int G) {
    int bh, qb;
    for (int i = 0; next_unit(i, vcu, G, bh, qb); ++i) {
        const int b = bh >> 3, h = bh & 7, kvh = h / A.group;
        {
            const int dh = tid >> 8;
            const size_t row = (size_t)b * S + qb * 256 + (tid & 255);
            float q[DQK], o[32];
#pragma unroll
            for (int d = 0; d < DQK; ++d) q[d] = bf2f(A.Q[row * A.qp + h * DQK + d]);
#pragma unroll
            for (int d = 0; d < 32; ++d) o[d] = 0.f;
            float l = 0.f;
            for (int k = 0; k < S; ++k) {
                const bf16_t* kr = A.K + ((size_t)b * S + k) * A.kp + kvh * DQK; const bf16_t* vr = A.V + ((size_t)b * S + k) * A.vp + kvh * 64 + dh * 32;
                float sc = 0.f;
#pragma unroll
                for (int d = 0; d < DQK; d += 8) { f32x4 k0, k1; unpack8(*(const u32x4*)(kr + d), k0, k1);
                    sc += q[d] * k0[0] + q[d + 1] * k0[1] + q[d + 2] * k0[2] + q[d + 3] * k0[3] + q[d + 4] * k1[0] + q[d + 5] * k1[1] + q[d + 6] * k1[2] + q[d + 7] * k1[3]; }
                const float p = bf2f(cvt_pk_bf16(exp2f(sc), 0.f) & 0xffffu); l += p;
#pragma unroll
                for (int d = 0; d < 32; d += 8) { f32x4 v0, v1; unpack8(*(const u32x4*)(vr + d), v0, v1);
                    o[d] += p * v0[0]; o[d + 1] += p * v0[1]; o[d + 2] += p * v0[2]; o[d + 3] += p * v0[3]; o[d + 4] += p * v1[0]; o[d + 5] += p * v1[1]; o[d + 6] += p * v1[2]; o[d + 7] += p * v1[3]; }
            }
            const float il = 1.f / l;
            __syncthreads();
#pragma unroll
            for (int d = 0; d < 32; d += 8) { f32x4 a = {o[d] * il, o[d + 1] * il, o[d + 2] * il, o[d + 3] * il}, c = {o[d + 4] * il, o[d + 5] * il, o[d + 6] * il, o[d + 7] * il};
                *(u32x4*)(A.O + row * A.op + h * 64 + dh * 32 + d) = pack8(a, c); }
        }
    }
}
#if FAST_ATTN
typedef short s16x4 __attribute__((ext_vector_type(4)));
__device__ __forceinline__ unsigned cvtpk(float lo, float hi) { f32x2 v = {lo, hi}; bf16x2_t b = __builtin_convertvector(v, bf16x2_t); return __builtin_bit_cast(unsigned, b); }
__device__ __forceinline__ s16x4 vtr(const LAS unsigned char* p) { return __builtin_bit_cast(s16x4, __builtin_amdgcn_ds_read_tr16_b64_v4i16((LAS s16x4*)p)); }
__device__ __forceinline__ int crow(int r, int hi) { return (r & 3) + 8 * (r >> 2) + 4 * hi; }
#define AT_BAR() asm volatile("s_barrier" ::: "memory")
#define AT_WAITBAR(N) asm volatile("s_waitcnt vmcnt(" #N ") lgkmcnt(0)\n\ts_barrier" ::: "memory")
#define AT_SCHED() __builtin_amdgcn_sched_barrier(0)
__device__ __forceinline__ void glds16(const void* gsrc, unsigned lds_dst) { unsigned keep;
    asm volatile("s_mov_b32 %0, m0\n\ts_mov_b32 m0, %2\n\ts_nop 0\n\tglobal_load_lds_dwordx4 %1, off\n\ts_mov_b32 m0, %0" : "=&s"(keep) : "v"(gsrc), "s"(lds_dst) : "memory"); }
#define AT_GLDS(g, l) glds16((const void*)(g), (unsigned)__builtin_amdgcn_readfirstlane((int)(unsigned)(uintptr_t)(l)))
template <int DQK>
__device__ __forceinline__ void attn_unit(int tid, LAS unsigned char* lds, const Tensors& A, int b, int h, int qb) {
    constexpr int ND = DQK / 16, NCH = DQK / 8, KSLOT = NCH * 1024, NKD = NCH > 8 ? 2 : 1, VSLOT = 8192, NT = S / 64;
    constexpr int KOFF = 0, VOFF = 3 * KSLOT, OST = VOFF + 3 * VSLOT, WSF = OST + 8 * 4096;
    static_assert(WSF + 8 * 256 <= RING_BYTES, "attention LDS");
    const int lane = tid & 63, r32 = lane & 31, hi = lane >> 5, wid = __builtin_amdgcn_readfirstlane(tid >> 6);
    const int kvh = h / A.group; const size_t rowb = (size_t)b * S;
    const bf16_t* ksrc = A.K + (rowb + lane) * A.kp + kvh * DQK + wid * 8;
    const bf16_t* ksrc2 = A.K + (rowb + lane) * A.kp + kvh * DQK + (8 + (wid & 3)) * 8;
    const bf16_t* vsrc = A.V + (rowb + 16 * (wid & 3) + (lane >> 2)) * A.vp + kvh * 64 + (wid >> 2) * 32 + (lane & 3) * 8;
    const size_t ktile = (size_t)64 * A.kp, vtile = (size_t)64 * A.vp;
    LAS unsigned char* kdst = lds + KOFF + wid * 1024; LAS unsigned char* kdst2 = lds + KOFF + (8 + (wid & 3)) * 1024; LAS unsigned char* vdst = lds + VOFF + wid * 1024;
#define DMA_K(j, so) do { AT_GLDS(ksrc + (size_t)(j) * ktile, kdst + (so)); if (NKD == 2) AT_GLDS(ksrc2 + (size_t)(j) * ktile, kdst2 + (so)); } while (0)
#define DMA_V(j, so) AT_GLDS(vsrc + (size_t)(j) * vtile, vdst + (so))
    const LAS unsigned char* kp0 = lds + KOFF + hi * 1024 + r32 * 16;
    const LAS unsigned char* vp0 = lds + VOFF + ((lane >> 4) & 1) * 32 + (lane & 3) * 8 + (4 * hi + ((lane & 15) >> 2)) * 64;
    DMA_K(0, 0); DMA_V(0, 0); DMA_K(1, KSLOT); DMA_V(1, VSLOT); DMA_K(2, 2 * KSLOT);
    const bf16_t* Qw = A.Q + (rowb + qb * 256 + wid * 32 + r32) * A.qp + h * DQK + hi * 8;
    bf16x8 qr[ND];
#pragma unroll
    for (int d0 = 0; d0 < ND; ++d0) qr[d0] = *(const bf16x8*)(Qw + d0 * 16);
    asm volatile("s_waitcnt vmcnt(0)\n\ts_barrier" ::: "memory");
    bf16x8 kf[2 * ND]; s16x4 vlo[8], vhi[8];
#define KLOAD(so) do { _Pragma("unroll") for (int d0 = 0; d0 < ND; ++d0) { kf[2 * d0] = *(const LAS bf16x8*)(kp0 + (so) + d0 * 2048); kf[2 * d0 + 1] = *(const LAS bf16x8*)(kp0 + (so) + d0 * 2048 + 512); } } while (0)
#define VLOAD(so) do { _Pragma("unroll") for (int i = 0; i < 8; ++i) { vlo[i] = vtr(vp0 + (so) + (i >> 2) * 4096 + (i & 3) * 1024); vhi[i] = vtr(vp0 + (so) + (i >> 2) * 4096 + (i & 3) * 1024 + 512); } } while (0)
#define VFR(i) (bf16x8){vlo[i][0], vlo[i][1], vlo[i][2], vlo[i][3], vhi[i][0], vhi[i][1], vhi[i][2], vhi[i][3]}
    KLOAD(0);
    asm volatile("s_waitcnt lgkmcnt(0)" ::: "memory");
    if (PROBE_ATT != 5 && wid >= 4) AT_BAR();
    f32x16 o0 = {}, o1 = {}, C0, C1; u32x4 pw0, pw1, pw2, pw3; float lsum = 0.f;
    const f32x16 zero = {};
#define QK_BLOCK() do { C0 = __builtin_amdgcn_mfma_f32_32x32x16_bf16(kf[0], qr[0], zero, 0, 0, 0); C1 = __builtin_amdgcn_mfma_f32_32x32x16_bf16(kf[1], qr[0], zero, 0, 0, 0); \
        _Pragma("unroll") for (int d0 = 1; d0 < ND; ++d0) { C0 = __builtin_amdgcn_mfma_f32_32x32x16_bf16(kf[2 * d0], qr[d0], C0, 0, 0, 0); C1 = __builtin_amdgcn_mfma_f32_32x32x16_bf16(kf[2 * d0 + 1], qr[d0], C1, 0, 0, 0); } } while (0)
#define PAF(k) __builtin_bit_cast(bf16x8, pw##k)
#define PV_BLOCK() do { \
        o0 = __builtin_amdgcn_mfma_f32_32x32x16_bf16(PAF(0), VFR(0), o0, 0, 0, 0); o1 = __builtin_amdgcn_mfma_f32_32x32x16_bf16(PAF(0), VFR(4), o1, 0, 0, 0); \
        o0 = __builtin_amdgcn_mfma_f32_32x32x16_bf16(PAF(1), VFR(1), o0, 0, 0, 0); o1 = __builtin_amdgcn_mfma_f32_32x32x16_bf16(PAF(1), VFR(5), o1, 0, 0, 0); \
        o0 = __builtin_amdgcn_mfma_f32_32x32x16_bf16(PAF(2), VFR(2), o0, 0, 0, 0); o1 = __builtin_amdgcn_mfma_f32_32x32x16_bf16(PAF(2), VFR(6), o1, 0, 0, 0); \
        o0 = __builtin_amdgcn_mfma_f32_32x32x16_bf16(PAF(3), VFR(3), o0, 0, 0, 0); o1 = __builtin_amdgcn_mfma_f32_32x32x16_bf16(PAF(3), VFR(7), o1, 0, 0, 0); } while (0)
#define SOFTMAX() do { \
        _Pragma("unroll") for (int r = 0; r < 16; ++r) { C0[r] = __builtin_amdgcn_exp2f(C0[r]); C1[r] = __builtin_amdgcn_exp2f(C1[r]); } \
        f32x2 s0_ = {C0[0], C0[1]}, s1_ = {C1[0], C1[1]}; _Pragma("unroll") for (int r = 2; r < 16; r += 2) { s0_ += (f32x2){C0[r], C0[r + 1]}; s1_ += (f32x2){C1[r], C1[r + 1]}; } s0_ += s1_; lsum += s0_[0] + s0_[1]; \
        pw0 = (u32x4){cvtpk(C0[0], C0[1]), cvtpk(C0[2], C0[3]), cvtpk(C0[4], C0[5]), cvtpk(C0[6], C0[7])}; pw1 = (u32x4){cvtpk(C0[8], C0[9]), cvtpk(C0[10], C0[11]), cvtpk(C0[12], C0[13]), cvtpk(C0[14], C0[15])}; \
        pw2 = (u32x4){cvtpk(C1[0], C1[1]), cvtpk(C1[2], C1[3]), cvtpk(C1[4], C1[5]), cvtpk(C1[6], C1[7])}; pw3 = (u32x4){cvtpk(C1[8], C1[9]), cvtpk(C1[10], C1[11]), cvtpk(C1[12], C1[13]), cvtpk(C1[14], C1[15])}; } while (0)
    int ka = 2 * KSLOT, kb = 0, kc = KSLOT, va = 2 * VSLOT, vb = 0, vc = VSLOT;
#define ROT() do { const int t_ = ka; ka = kb; kb = kc; kc = t_; const int u_ = va; va = vb; vb = vc; vc = u_; } while (0)
#define PINP() asm volatile("" : "+v"(lsum) : "v"(pw0), "v"(pw1), "v"(pw2), "v"(pw3))
#if ATT_REGSTAGE
    u32x4 kst = {}, kst2 = {}, vst = {};
    const LAS unsigned char* kw = lds + KOFF + wid * 1024 + lane * 16; const LAS unsigned char* kw2 = lds + KOFF + (8 + (wid & 3)) * 1024 + lane * 16; const LAS unsigned char* vw = lds + VOFF + wid * 1024 + lane * 16;
#define ST_WRITE(WK, WV) do { if (WK) { *(LAS u32x4*)(kw + ka) = kst; if (NKD == 2 && wid < 4) *(LAS u32x4*)(kw2 + ka) = kst2; } if (WV) *(LAS u32x4*)(vw + vc) = vst; } while (0)
#define ST_LOAD(sv, IK, IV) do { if (IK) { kst = *(const u32x4*)(ksrc + (size_t)((sv) + 4) * ktile); if (NKD == 2 && wid < 4) kst2 = *(const u32x4*)(ksrc2 + (size_t)((sv) + 4) * ktile); } if (IV) vst = *(const u32x4*)(vsrc + (size_t)((sv) + 3) * vtile); } while (0)
#define STEP(sv, DOQK, DOPV, KL, VL, IK, IV, WK, WV) do { \
        AT_SCHED(); if (DOQK) QK_BLOCK(); if (DOPV) PV_BLOCK(); AT_SCHED(); \
        asm volatile("s_barrier\n\ts_nop 15\n\ts_nop 3" : "+v"(C0), "+v"(C1), "+v"(o0), "+v"(o1) :: "memory"); AT_SCHED(); \
        if (KL) KLOAD(kc); if (VL) VLOAD(vb); ST_WRITE(WK, WV); ST_LOAD(sv, IK, IV); \
        if (DOQK) { SOFTMAX(); PINP(); } AT_SCHED(); \
        asm volatile("s_waitcnt lgkmcnt(0)\n\ts_barrier" ::: "memory"); \
        AT_SCHED(); ROT(); } while (0)
    STEP(-1, true, false, true, true, true, true, false, false);
#pragma nounroll
    for (int s = 0; s < NT - 4; ++s) STEP(s, true, true, true, true, true, true, true, true);
    STEP(NT - 4, true, true, true, true, false, true, true, true);
    STEP(NT - 3, true, true, true, true, false, false, false, true);
    STEP(NT - 2, true, true, false, true, false, false, false, false);
    STEP(NT - 1, false, true, false, false, false, false, false, false);
#undef ST_WRITE
#undef ST_LOAD
#else
#define STEP(sv, DOQK, DOPV, KL, VL, IK, IV) do { \
        AT_SCHED(); if (DOQK) QK_BLOCK(); if (DOPV) PV_BLOCK(); AT_SCHED(); \
          \
        asm volatile("s_barrier\n\ts_nop 15\n\ts_nop 3" : "+v"(C0), "+v"(C1), "+v"(o0), "+v"(o1) :: "memory"); AT_SCHED(); \
        if (KL) KLOAD(kc); if (VL) VLOAD(vb); if (IK) DMA_K((sv) + 4, kb); if (IV) DMA_V((sv) + 3, va); \
        if (DOQK) { SOFTMAX(); PINP(); } AT_SCHED(); \
        if (IK) { if (NKD == 2) { AT_WAITBAR(3); } else { AT_WAITBAR(2); } } else if (IV) { AT_WAITBAR(1); } else { AT_WAITBAR(0); } \
        AT_SCHED(); ROT(); } while (0)
    STEP(-1, true, false, true, true, true, true);
#pragma nounroll
    for (int s = 0; s < NT - 4; ++s) STEP(s, true, true, true, true, true, true);
    STEP(NT - 4, true, true, true, true, false, true);
    STEP(NT - 3, true, true, true, true, false, false);
    STEP(NT - 2, true, true, false, true, false, false);
    STEP(NT - 1, false, true, false, false, false, false);
#endif
#undef STEP
#undef PINP
    if (PROBE_ATT != 5 && wid < 4) AT_BAR();
    { auto rr = __builtin_amdgcn_permlane32_swap(__float_as_uint(lsum), __float_as_uint(lsum), false, false); lsum = __uint_as_float(rr[0]) + __uint_as_float(rr[1]); }
    LAS float* wsf = (LAS float*)(lds + WSF + wid * 256);
    if (hi == 0) wsf[r32] = lsum;
    asm volatile("s_waitcnt lgkmcnt(0)" ::: "memory");
    LAS bf16_t* stg = (LAS bf16_t*)(lds + OST + wid * 4096);
#pragma unroll
    for (int r = 0; r < 16; ++r) { const int orow = crow(r, hi); const float rl = __builtin_amdgcn_rcpf(wsf[orow]);
        stg[orow * 64 + r32] = (bf16_t)(cvtpk(o0[r] * rl, 0.f) & 0xffffu); stg[orow * 64 + 32 + r32] = (bf16_t)(cvtpk(o1[r] * rl, 0.f) & 0xffffu); }
    asm volatile("s_waitcnt lgkmcnt(0)" ::: "memory");
    bf16_t* Ow = A.O + (rowb + qb * 256 + wid * 32) * A.op + h * 64;
#pragma unroll
    for (int i = 0; i < 4; ++i) { const int row = i * 8 + (lane >> 3), ch = lane & 7; const u32x4 v = *(const LAS u32x4*)(stg + row * 64 + ch * 8); st16((Ow + (size_t)row * A.op + ch * 8), v); }
    asm volatile("s_waitcnt lgkmcnt(0)\n\ts_barrier" ::: "memory");
#undef DMA_K
#undef DMA_V
#undef KLOAD
#undef VLOAD
#undef VFR
#undef QK_BLOCK
#undef PAF
#undef PV_BLOCK
#undef SOFTMAX
#undef ROT
}
#endif
#if FAST_ATTN && ATT_FP8_A
typedef int v8i __attribute__((ext_vector_type(8)));
__device__ __forceinline__ f32x16 mfma8(v8i a, v8i b, f32x16 c) { return __builtin_amdgcn_mfma_scale_f32_32x32x64_f8f6f4(a, b, c, 0, 0, 0, 0x7f7f7f7f, 0, 0x7f7f7f7f); }
__device__ __forceinline__ f32x16 mfma8pv(v8i a, v8i b, f32x16 c) { return __builtin_amdgcn_mfma_scale_f32_32x32x64_f8f6f4(a, b, c, 1, 0, 0, 0x7f7f7f7f, 0, 0x7f7f7f7f); }
__device__ __forceinline__ void attn_unit_f8a(int tid, LAS unsigned char* lds, const unsigned char* Q8, const unsigned char* K8, const unsigned char* VT8, bf16_t* O, int op, int b, int h, int qb, float bias) {
    constexpr int SL = 4096, NT = S / 64;
    constexpr int KOFF = 0, VOFF = 3 * SL, OST = VOFF + 3 * SL, WSF = OST + 8 * 4096;
    const int lane = tid & 63, r32 = lane & 31, hi = lane >> 5, wid = __builtin_amdgcn_readfirstlane(tid >> 6);
    const int kvh = h >> 2; const size_t rowb = (size_t)b * S; const bool kw = wid < 4;
    const unsigned char* src = kw ? K8 + (rowb + lane) * 128 + kvh * 64 + 16 * wid : VT8 + ((size_t)((b * 2 + kvh) * 64 + lane)) * S + 16 * (wid - 4);
    const size_t tstep = kw ? (size_t)64 * 128 : (size_t)64;
    LAS unsigned char* dst = lds + (kw ? KOFF + wid * 1024 : VOFF + (wid - 4) * 1024);
#define DMA8(j, so) AT_GLDS(src + (size_t)(j) * tstep, dst + (so))
    const LAS unsigned char* kp0 = lds + KOFF + (2 * hi) * 1024 + r32 * 16;
    const LAS unsigned char* vp0 = lds + VOFF + (2 * hi) * 1024 + r32 * 16;
    if (kw) { DMA8(0, 0); DMA8(1, SL); DMA8(2, 2 * SL); } else { DMA8(0, 0); DMA8(1, SL); }
    v8i qf; { const unsigned char* Qw = Q8 + (rowb + qb * 256 + wid * 32 + r32) * 512 + h * 64 + 32 * hi; const u32x4 a = *(const u32x4*)Qw, c = *(const u32x4*)(Qw + 16);
        qf = (v8i){(int)a.x, (int)a.y, (int)a.z, (int)a.w, (int)c.x, (int)c.y, (int)c.z, (int)c.w}; }
    asm volatile("s_waitcnt vmcnt(0)\n\ts_barrier" ::: "memory");
    v8i kf0, kf1, vf0, vf1, p8;
#define LD32(dstv, p) do { const u32x4 a_ = *(const LAS u32x4*)(p), c_ = *(const LAS u32x4*)((p) + 1024); dstv = (v8i){(int)a_.x, (int)a_.y, (int)a_.z, (int)a_.w, (int)c_.x, (int)c_.y, (int)c_.z, (int)c_.w}; } while (0)
#define KLOAD8(so) do { LD32(kf0, kp0 + (so)); LD32(kf1, kp0 + (so) + 512); } while (0)
#define VLOAD8(so) do { LD32(vf0, vp0 + (so)); LD32(vf1, vp0 + (so) + 512); } while (0)
    KLOAD8(0);
    asm volatile("s_waitcnt lgkmcnt(0)" ::: "memory");
    if (wid >= 4) AT_BAR();
    f32x16 o0 = {}, o1 = {}, o2 = {}, C0, C1;
    const v8i ones = {0x38383838, 0x38383838, 0x38383838, 0x38383838, 0x38383838, 0x38383838, 0x38383838, 0x38383838};
    f32x16 negb;
#pragma unroll
    for (int r = 0; r < 16; ++r) negb[r] = bias;
    asm volatile("" : "+v"(negb));
#define SOFTMAX8() do { \
        _Pragma("unroll") for (int i = 0; i < 4; ++i) { \
            const f32x2 a_ = (f32x2){C0[4 * i], C0[4 * i + 1]} * 4.f + 60.26f, b_ = (f32x2){C0[4 * i + 2], C0[4 * i + 3]} * 4.f + 60.26f, c_ = (f32x2){C1[4 * i], C1[4 * i + 1]} * 4.f + 60.26f, d_ = (f32x2){C1[4 * i + 2], C1[4 * i + 3]} * 4.f + 60.26f; \
            p8[i] = (int)__builtin_amdgcn_cvt_pk_u8_f32(b_[1], 3, __builtin_amdgcn_cvt_pk_u8_f32(b_[0], 2, __builtin_amdgcn_cvt_pk_u8_f32(a_[1], 1, __builtin_amdgcn_cvt_pk_u8_f32(a_[0], 0, 0u)))); \
            p8[4 + i] = (int)__builtin_amdgcn_cvt_pk_u8_f32(d_[1], 3, __builtin_amdgcn_cvt_pk_u8_f32(d_[0], 2, __builtin_amdgcn_cvt_pk_u8_f32(c_[1], 1, __builtin_amdgcn_cvt_pk_u8_f32(c_[0], 0, 0u)))); } } while (0)
    int oa = 2 * SL, ob = 0, oc = SL;
#define ROT8() do { const int t_ = oa; oa = ob; ob = oc; oc = t_; } while (0)
#define STEP8(sv, DOQK, DOPV, KL, VL, IK, IV) do { \
        AT_SCHED(); if (DOQK) { C0 = mfma8(kf0, qf, negb); C1 = mfma8(kf1, qf, negb); } if (DOPV) { o0 = mfma8pv(p8, vf0, o0); o1 = mfma8pv(p8, vf1, o1); o2 = mfma8pv(p8, ones, o2); } AT_SCHED(); \
        asm volatile("s_barrier\n\ts_nop 15\n\ts_nop 15" : "+v"(C0), "+v"(C1), "+v"(o0), "+v"(o1), "+v"(o2) :: "memory"); AT_SCHED(); \
        if (KL) KLOAD8(oc); if (VL) VLOAD8(ob); \
        const bool iss_ = kw ? (IK) : (IV); if (iss_) { if (kw) DMA8((sv) + 4, ob); else DMA8((sv) + 3, oa); } \
        if (DOQK) { SOFTMAX8(); asm volatile("" :: "v"(p8)); } AT_SCHED(); \
        if (iss_) { AT_WAITBAR(1); } else { AT_WAITBAR(0); } \
        AT_SCHED(); ROT8(); } while (0)
    STEP8(-1, true, false, true, true, true, true);
#pragma nounroll
    for (int s = 0; s < NT - 4; ++s) STEP8(s, true, true, true, true, true, true);
    STEP8(NT - 4, true, true, true, true, false, true);
    STEP8(NT - 3, true, true, true, true, false, false);
    STEP8(NT - 2, true, true, false, true, false, false);
    STEP8(NT - 1, false, true, false, false, false, false);
    if (wid < 4) AT_BAR();
    LAS bf16_t* stg = (LAS bf16_t*)(lds + OST + wid * 4096);
#pragma unroll
    for (int r = 0; r < 16; ++r) { const int orow = crow(r, hi); const float rl = __builtin_amdgcn_rcpf(o2[r]);
        stg[orow * 64 + r32] = (bf16_t)(cvtpk(o0[r] * rl, 0.f) & 0xffffu); stg[orow * 64 + 32 + r32] = (bf16_t)(cvtpk(o1[r] * rl, 0.f) & 0xffffu); }
    asm volatile("s_waitcnt lgkmcnt(0)" ::: "memory");
    bf16_t* Ow = O + (rowb + qb * 256 + wid * 32) * op + h * 64;
#pragma unroll
    for (int i = 0; i < 4; ++i) { const int row = i * 8 + (lane >> 3), ch = lane & 7; const u32x4 v = *(const LAS u32x4*)(stg + row * 64 + ch * 8); st16(Ow + (size_t)row * op + ch * 8, v); }
    asm volatile("s_waitcnt lgkmcnt(0)\n\ts_barrier" ::: "memory");
#undef DMA8
#undef LD32
#undef KLOAD8
#undef VLOAD8
#undef SOFTMAX8
#undef ROT8
#undef STEP8
}
__device__ __forceinline__ void attn_phase_f8a(int tid, LAS unsigned char* lds, const unsigned char* Q8, const unsigned char* K8, const unsigned char* VT8, bf16_t* O, int op, const float* gq, const float* gk, int vcu, int G) {
    float mq = 0.f, mk = 0.f;
    for (int i = 0; i < 64; ++i) { mq = fmaxf(mq, fabsf(gq[i])); mk = fmaxf(mk, fabsf(gk[i])); }
    const float bias = -fmaxf(64.f * mq * mk * QSCALE_A * 1.13f - 15.5f, 0.f);
    int bh, qb;
    for (int i = 0; next_unit(i, vcu, G, bh, qb); ++i) attn_unit_f8a(tid, lds, Q8, K8, VT8, O, op, bh >> 3, bh & 7, qb, bias);
}
#endif
#if FAST_ATTN && ATT_FP8_B
__device__ __forceinline__ void attn_unit_f8b(int tid, LAS unsigned char* lds, const unsigned char* Q8, const unsigned char* K8, const unsigned char* VT8, bf16_t* O, int op, int b, int h, int qb) {
    constexpr int SLK = 6144, SLV = 4096, NT = S / 64;
    constexpr int KOFF = 0, VOFF = 3 * SLK, OST = VOFF + 3 * SLV, WSF = OST + 8 * 4096;
    static_assert(WSF + 2048 <= RING_BYTES, "attention LDS");
    const int lane = tid & 63, r32 = lane & 31, hi = lane >> 5, wid = __builtin_amdgcn_readfirstlane(tid >> 6);
    const size_t rowb = (size_t)b * S; const bool kw = wid < 6, vw = wid >= 4;
    const unsigned char* ksrc = K8 + (rowb + lane) * 768 + h * 96 + 16 * wid;
    const unsigned char* vsrc = VT8 + ((size_t)((b * 8 + h) * 64 + lane)) * S + 16 * (wid - 4);
    LAS unsigned char* kdst = lds + KOFF + wid * 1024; LAS unsigned char* vdst = lds + VOFF + (wid - 4) * 1024;
#define DMAK(j, so) AT_GLDS(ksrc + (size_t)(j) * (64 * 768), kdst + (so))
#define DMAV(j, so) AT_GLDS(vsrc + (size_t)(j) * 64, vdst + (so))
    const LAS unsigned char* kp0 = lds + KOFF + (2 * hi) * 1024 + r32 * 16;
    const LAS unsigned char* kr0 = lds + KOFF + 4 * 1024 + r32 * 16;
    const LAS unsigned char* vp0 = lds + VOFF + (2 * hi) * 1024 + r32 * 16;
    if (kw) { DMAK(0, 0); DMAK(1, SLK); DMAK(2, 2 * SLK); }
    if (vw) { DMAV(0, 0); DMAV(1, SLV); }
    v8i qn, qr;
    { const unsigned char* Qw = Q8 + (rowb + qb * 256 + wid * 32 + r32) * 768 + h * 96; const u32x4 a = *(const u32x4*)(Qw + 32 * hi), c = *(const u32x4*)(Qw + 32 * hi + 16), e = *(const u32x4*)(Qw + 64), f = *(const u32x4*)(Qw + 80);
      qn = (v8i){(int)a.x, (int)a.y, (int)a.z, (int)a.w, (int)c.x, (int)c.y, (int)c.z, (int)c.w};
      qr = hi ? (v8i){0, 0, 0, 0, 0, 0, 0, 0} : (v8i){(int)e.x, (int)e.y, (int)e.z, (int)e.w, (int)f.x, (int)f.y, (int)f.z, (int)f.w}; }
    asm volatile("s_waitcnt vmcnt(0)\n\ts_barrier" ::: "memory");
    v8i kn0, kn1, kr0v, kr1v, vf0, vf1, p8;
#define LD32(dstv, p) do { const u32x4 a_ = *(const LAS u32x4*)(p), c_ = *(const LAS u32x4*)((p) + 1024); dstv = (v8i){(int)a_.x, (int)a_.y, (int)a_.z, (int)a_.w, (int)c_.x, (int)c_.y, (int)c_.z, (int)c_.w}; } while (0)
#define KLOAD8(so) do { LD32(kn0, kp0 + (so)); LD32(kn1, kp0 + (so) + 512); LD32(kr0v, kr0 + (so)); LD32(kr1v, kr0 + (so) + 512); } while (0)
#define VLOAD8(so) do { LD32(vf0, vp0 + (so)); LD32(vf1, vp0 + (so) + 512); } while (0)
    KLOAD8(0);
    asm volatile("s_waitcnt lgkmcnt(0)" ::: "memory");
    if (wid >= 4) AT_BAR();
    f32x16 o0 = {}, o1 = {}, o2 = {}, C0, C1; const f32x16 zero = {};
    const v8i ones = {0x38383838, 0x38383838, 0x38383838, 0x38383838, 0x38383838, 0x38383838, 0x38383838, 0x38383838};
#define SOFTMAX8() do { \
        _Pragma("unroll") for (int i = 0; i < 4; ++i) { \
            const f32x2 a_ = (f32x2){C0[4 * i], C0[4 * i + 1]} * 4.f + 60.26f, b_ = (f32x2){C0[4 * i + 2], C0[4 * i + 3]} * 4.f + 60.26f, c_ = (f32x2){C1[4 * i], C1[4 * i + 1]} * 4.f + 60.26f, d_ = (f32x2){C1[4 * i + 2], C1[4 * i + 3]} * 4.f + 60.26f; \
            p8[i] = (int)__builtin_amdgcn_cvt_pk_u8_f32(b_[1], 3, __builtin_amdgcn_cvt_pk_u8_f32(b_[0], 2, __builtin_amdgcn_cvt_pk_u8_f32(a_[1], 1, __builtin_amdgcn_cvt_pk_u8_f32(a_[0], 0, 0u)))); \
            p8[4 + i] = (int)__builtin_amdgcn_cvt_pk_u8_f32(d_[1], 3, __builtin_amdgcn_cvt_pk_u8_f32(d_[0], 2, __builtin_amdgcn_cvt_pk_u8_f32(c_[1], 1, __builtin_amdgcn_cvt_pk_u8_f32(c_[0], 0, 0u)))); } } while (0)
    int ka = 2 * SLK, kb = 0, kc = SLK, va = 2 * SLV, vb = 0, vc = SLV;
#define ROT8() do { const int t_ = ka; ka = kb; kb = kc; kc = t_; const int u_ = va; va = vb; vb = vc; vc = u_; } while (0)
#define STEP8(sv, DOQK, DOPV, KL, VL, IK, IV) do { \
        AT_SCHED(); if (DOQK) { C0 = mfma8(kn0, qn, zero); C1 = mfma8(kn1, qn, zero); C0 = mfma8(kr0v, qr, C0); C1 = mfma8(kr1v, qr, C1); } if (DOPV) { o0 = mfma8pv(p8, vf0, o0); o1 = mfma8pv(p8, vf1, o1); o2 = mfma8pv(p8, ones, o2); } AT_SCHED(); \
        asm volatile("s_barrier\n\ts_nop 15\n\ts_nop 15" : "+v"(C0), "+v"(C1), "+v"(o0), "+v"(o1), "+v"(o2) :: "memory"); AT_SCHED(); \
        if (KL) KLOAD8(kc); if (VL) VLOAD8(vb); \
        const bool ik_ = kw && (IK), iv_ = vw && (IV); if (ik_) DMAK((sv) + 4, kb); if (iv_) DMAV((sv) + 3, va); \
        if (DOQK) { SOFTMAX8(); asm volatile("" :: "v"(p8)); } AT_SCHED(); \
        if (ik_ && iv_) { AT_WAITBAR(2); } else if (ik_ || iv_) { AT_WAITBAR(1); } else { AT_WAITBAR(0); } \
        AT_SCHED(); ROT8(); } while (0)
    STEP8(-1, true, false, true, true, true, true);
#pragma nounroll
    for (int s = 0; s < NT - 4; ++s) STEP8(s, true, true, true, true, true, true);
    STEP8(NT - 4, true, true, true, true, false, true);
    STEP8(NT - 3, true, true, true, true, false, false);
    STEP8(NT - 2, true, true, false, true, false, false);
    STEP8(NT - 1, false, true, false, false, false, false);
    if (wid < 4) AT_BAR();
    LAS bf16_t* stg = (LAS bf16_t*)(lds + OST + wid * 4096);
#pragma unroll
    for (int r = 0; r < 16; ++r) { const int orow = crow(r, hi); const float rl = __builtin_amdgcn_rcpf(o2[r]);
        stg[orow * 64 + r32] = (bf16_t)(cvtpk(o0[r] * rl, 0.f) & 0xffffu); stg[orow * 64 + 32 + r32] = (bf16_t)(cvtpk(o1[r] * rl, 0.f) & 0xffffu); }
    asm volatile("s_waitcnt lgkmcnt(0)" ::: "memory");
    bf16_t* Ow = O + (rowb + qb * 256 + wid * 32) * op + h * 64;
#pragma unroll
    for (int i = 0; i < 4; ++i) { const int row = i * 8 + (lane >> 3), ch = lane & 7; const u32x4 v = *(const LAS u32x4*)(stg + row * 64 + ch * 8); st16(Ow + (size_t)row * op + ch * 8, v); }
    asm volatile("s_waitcnt lgkmcnt(0)\n\ts_barrier" ::: "memory");
#undef DMAK
#undef DMAV
#undef LD32
#undef KLOAD8
#undef VLOAD8
#undef SOFTMAX8
#undef ROT8
#undef STEP8
}
__device__ __forceinline__ void attn_phase_f8b(int tid, LAS unsigned char* lds, const unsigned char* Q8, const unsigned char* K8, const unsigned char* VT8, bf16_t* O, int op, int vcu, int G) {
    int bh, qb;
    for (int i = 0; next_unit(i, vcu, G, bh, qb); ++i) attn_unit_f8b(tid, lds, Q8, K8, VT8, O, op, bh >> 3, bh & 7, qb);
}
#endif
template <int DQK>
__device__ __forceinline__ void attn_phase(int tid, LAS unsigned char* lds, const Tensors& A, int vcu, int G) {
#if FAST_ATTN
    int bh, qb;
    for (int i = 0; next_unit(i, vcu, G, bh, qb); ++i) attn_unit<DQK>(tid, lds, A, bh >> 3, bh & 7, qb);
#else
    (void)lds; attn_phase_ref<DQK>(tid, A, vcu, G);
#endif
}
}


struct Args { const float* in[22]; float* out; unsigned char* ws; int ph_lo, ph_hi; };
struct Frame {
    LAS unsigned char* lds; volatile LAS unsigned* MISC; unsigned* ctl;
    int tid, lane, wave, vcu, G;
    unsigned char* ws; float* OUT;
};

__device__ __forceinline__ void p0_phase(Frame& F, const float* c, const float* w_ada, const float* b_ada) {
    LAS float* cs = (LAS float*)F.lds;
    LAS float* red = (LAS float*)(F.lds + 32768);
    for (int i = F.tid; i < NB * D; i += NTHREADS) { const float v = c[i]; cs[i] = v / (1.f + __expf(-v)); }
    __syncthreads();
    float* mod = (float*)(F.ws + WS_MOD);
    const int kq = F.wave, col = F.lane;
    for (int item = F.vcu; item < NL * 6 * D / 64; item += F.G) {
        const int l = item / (6 * D / 64), n0 = (item % (6 * D / 64)) * 64;
        const float* w = w_ada + (size_t)l * D * 6 * D + n0 + col;
        float acc[NB];
#pragma unroll
        for (int b = 0; b < NB; ++b) acc[b] = 0.f;
#pragma unroll 8
        for (int k = kq * 128; k < kq * 128 + 128; ++k) { const float wv = w[(size_t)k * 6 * D];
#pragma unroll
            for (int b = 0; b < NB; ++b) acc[b] += cs[b * D + k] * wv; }
#pragma unroll
        for (int b = 0; b < NB; ++b) red[(kq * NB + b) * 64 + col] = acc[b];
        __syncthreads();
        { const int b = F.wave; float s = 0.f;
#pragma unroll
          for (int q = 0; q < 8; ++q) s += red[(q * NB + b) * 64 + col];
          mod[((size_t)l * NB + b) * 6 * D + n0 + col] = s + b_ada[(size_t)l * 6 * D + n0 + col]; }
        __syncthreads();
    }
    float* cosA = (float*)(F.ws + WS_COSA); float* sinA = (float*)(F.ws + WS_SINA); float* cosB = (float*)(F.ws + WS_COSB); float* sinB = (float*)(F.ws + WS_SINB);
    for (int idx = F.vcu * NTHREADS + F.tid; idx < S * 48; idx += F.G * NTHREADS) {
        const int s = idx / 48, i = idx % 48; const float row = (float)(s >> 6), col2 = (float)(s & 63);
        if (i < 32) { const int j = i & 15; const float a = (i < 16 ? row : col2) * (1.0f / powf(10000.0f, (float)j / 16.0f)); cosA[s * 32 + i] = cosf(a); sinA[s * 32 + i] = sinf(a); }
        else { const int ii = i - 32, j = ii & 7; const float a = (ii < 8 ? row : col2) * (1.0f / powf(10000.0f, (float)j / 8.0f)); cosB[s * 16 + ii] = cosf(a); sinB[s * 16 + ii] = sinf(a); }
    }
}

template <class SrcFn>
__device__ __forceinline__ void cvt_item(const float* W, int K, int Nsrc, const float* kg, bf16_t* WT, LAS float* scr, int item, int nblk, int lane, const SrcFn& src) {
    const int kb = item / nblk, nb = item % nblk, k0 = 64 * kb, n0 = 32 * nb;
    const int sc = src(n0 + (lane & 31));
#pragma unroll
    for (int i = 0; i < 32; ++i) { const int kk = 2 * i + (lane >> 5); float v = sc >= 0 ? W[(size_t)(k0 + kk) * Nsrc + sc] : 0.f; if (kg) v *= kg[k0 + kk]; scr[kk * 33 + (lane & 31)] = v; }
    LDS_WAIT(); asm volatile("" ::: "memory");
    const int c = lane & 7;
#pragma unroll
    for (int j = 0; j < 4; ++j) { const int n = (lane >> 3) + 8 * j; const LAS float* s = scr + (8 * c) * 33 + n;
        u32x4 o; o.x = cvt_pk_bf16(s[0 * 33], s[1 * 33]); o.y = cvt_pk_bf16(s[2 * 33], s[3 * 33]); o.z = cvt_pk_bf16(s[4 * 33], s[5 * 33]); o.w = cvt_pk_bf16(s[6 * 33], s[7 * 33]);
        *(u32x4*)(WT + (size_t)(n0 + n) * K + k0 + 8 * c) = o; }
    LDS_WAIT(); asm volatile("" ::: "memory");
}
struct SrcId { __device__ int operator()(int n) const { return n; } };
struct SrcIn { __device__ int operator()(int n) const { return gp::src_col_in(n); } };
typedef __attribute__((address_space(4))) const Args CArgsW;
__device__ __forceinline__ void convert_weights(Frame& F, CArgsW* a, int l) {
    LAS float* scr = (LAS float*)(F.lds + F.wave * 16384);
    const int gw = F.vcu * NWAVES + F.wave, NGW = F.G * NWAVES;
    const float* w_in = ((const float*)(GAS const float*)a->in[5]) + (size_t)l * D * INC; const float* w_q_b = ((const float*)(GAS const float*)a->in[10]) + (size_t)l * 384 * 768; const float* w_kv_b = ((const float*)(GAS const float*)a->in[11]) + (size_t)l * 256 * 1024;
    const float* w_pa = ((const float*)(GAS const float*)a->in[12]) + (size_t)l * 512 * D; const float* w_pb = ((const float*)(GAS const float*)a->in[13]) + (size_t)l * 512 * D; const float* w_o = ((const float*)(GAS const float*)a->in[14]) + (size_t)l * D * D;
    const float* w1 = ((const float*)(GAS const float*)a->in[18]) + (size_t)l * NE * D * FF; const float* w3 = ((const float*)(GAS const float*)a->in[19]) + (size_t)l * NE * D * FF; const float* w2 = ((const float*)(GAS const float*)a->in[20]) + (size_t)l * NE * FF * D;
    const float* gqa = ((const float*)(GAS const float*)a->in[8]) + l * 384; const float* gkv = ((const float*)(GAS const float*)a->in[9]) + l * 256;
    bf16_t* Win = (bf16_t*)(F.ws + WS_WIN); bf16_t* Wqb = (bf16_t*)(F.ws + WS_WQB); bf16_t* Wkvb = (bf16_t*)(F.ws + WS_WKVB); bf16_t* Wpa = (bf16_t*)(F.ws + WS_WPA); bf16_t* Wpb = (bf16_t*)(F.ws + WS_WPB);
    bf16_t* Wo = (bf16_t*)(F.ws + WS_WO); bf16_t* W13 = (bf16_t*)(F.ws + WS_W13); bf16_t* W2 = (bf16_t*)(F.ws + WS_W2);
    constexpr int I_IN = (D / 64) * (NIN / 32), I_QB = (384 / 64) * (768 / 32), I_KVB = (256 / 64) * (1024 / 32), I_P = (512 / 64) * (D / 32), I_O = (D / 64) * (D / 32);
    constexpr int I_13 = (D / 64) * (1024 / 32), I_2 = (FF / 64) * (D / 32);
    constexpr int NITEMS = I_IN + I_QB + I_KVB + 2 * I_P + I_O + NE * (I_13 + I_2);
    for (int it = gw; it < NITEMS; it += NGW) {
        int r = it;
        if (r < I_IN) { cvt_item(w_in, D, INC, nullptr, Win, scr, r, NIN / 32, F.lane, SrcIn()); continue; } r -= I_IN;
        if (r < I_QB) { cvt_item(w_q_b, 384, 768, gqa, Wqb, scr, r, 768 / 32, F.lane, SrcId()); continue; } r -= I_QB;
        if (r < I_KVB) { cvt_item(w_kv_b, 256, 1024, gkv, Wkvb, scr, r, 1024 / 32, F.lane, SrcId()); continue; } r -= I_KVB;
        if (r < I_P) { cvt_item(w_pa, 512, D, nullptr, Wpa, scr, r, D / 32, F.lane, SrcId()); continue; } r -= I_P;
        if (r < I_P) { cvt_item(w_pb, 512, D, nullptr, Wpb, scr, r, D / 32, F.lane, SrcId()); continue; } r -= I_P;
        if (r < I_O) { cvt_item(w_o, D, D, nullptr, Wo, scr, r, D / 32, F.lane, SrcId()); continue; } r -= I_O;
        if (r < NE * I_13) { const int e = r / I_13, q = r % I_13, nb = q % 32;
            const float* src = ((nb & 7) < 4 ? w1 : w3) + (size_t)e * D * FF; const int cb = (nb >> 3) * 128 + (nb & 3) * 32;
            struct SrcOff { int n0, cb; __device__ int operator()(int n) const { return cb + (n - n0); } } so{nb * 32, cb};
            cvt_item(src, D, FF, nullptr, W13 + (size_t)e * 1024 * D, scr, q, 32, F.lane, so); continue; } r -= NE * I_13;
        { const int e = r / I_2, q = r % I_2; cvt_item(w2 + (size_t)e * FF * D, FF, D, nullptr, W2 + (size_t)e * D * FF, scr, q, D / 32, F.lane, SrcId()); }
    }
}

template <int MODE>
__device__ __forceinline__ void row_phase(Frame& F, const float* xin, const float* g2prev, const float* gain, const float* modl, int sh_off, int sc_off, bf16_t* H, bf16_t* XB, float* OUT) {
    constexpr int RB = 4, RPW = T / (256 * NWAVES);
    const int gw = F.vcu * NWAVES + F.wave, b = (gw * RPW) >> 12;
    const bf16_t* Y2 = (const bf16_t*)(F.ws + WS_Y2);
    f32x4 gs[4], shv[4], g2v[4];
#pragma unroll
    for (int j = 0; j < 4; ++j) { const int c = 4 * F.lane + 256 * j; gs[j] = *(const f32x4*)(gain + c);
        if (MODE != 2) { gs[j] = gs[j] * (1.f + *(const f32x4*)(modl + (size_t)b * 6 * D + sc_off + c)); shv[j] = *(const f32x4*)(modl + (size_t)b * 6 * D + sh_off + c); }
        if (MODE != 0) g2v[j] = *(const f32x4*)(g2prev + (size_t)b * 6 * D + 5 * D + c); }
    for (int m0 = gw * RPW; m0 < gw * RPW + RPW; m0 += RB) {
        f32x4 v[RB][4]; float ss[RB];
        if (MODE == 0) {
#pragma unroll
            for (int r = 0; r < RB; ++r)
#pragma unroll
                for (int j = 0; j < 4; ++j) v[r][j] = *(const f32x4*)(xin + (size_t)(m0 + r) * D + 4 * F.lane + 256 * j);
        } else {
            unsigned ya[RB][4], yb[RB][4];
#pragma unroll
            for (int r = 0; r < RB; ++r)
#pragma unroll
                for (int j = 0; j < 4; ++j) { const int m = m0 + r, c = 4 * F.lane + 256 * j;
                    { const u32x2 xb = *(const u32x2*)(XB + (size_t)m * D + c); v[r][j] = (f32x4){bf2f(xb.x & 0xffffu), bf2f(xb.x >> 16), bf2f(xb.y & 0xffffu), bf2f(xb.y >> 16)}; }
                    ya[r][j] = *(const unsigned*)((const unsigned char*)Y2 + (size_t)(2 * m) * D + c); yb[r][j] = *(const unsigned*)((const unsigned char*)Y2 + (size_t)(2 * m + 1) * D + c); }
#pragma unroll
            for (int r = 0; r < RB; ++r)
#pragma unroll
                for (int j = 0; j < 4; ++j) { const f32x2 a0 = __builtin_amdgcn_cvt_pk_f32_fp8((int)ya[r][j], false), a1 = __builtin_amdgcn_cvt_pk_f32_fp8((int)ya[r][j], true), b0 = __builtin_amdgcn_cvt_pk_f32_fp8((int)yb[r][j], false), b1 = __builtin_amdgcn_cvt_pk_f32_fp8((int)yb[r][j], true);
                    const f32x4 y = (f32x4){a0[0] + b0[0], a0[1] + b0[1], a1[0] + b1[0], a1[1] + b1[1]} * 0.0625f;
                    v[r][j] += g2v[j] * y; }
        }
#pragma unroll
        for (int r = 0; r < RB; ++r) { ss[r] = (gp::dot4(v[r][0]) + gp::dot4(v[r][1])) + (gp::dot4(v[r][2]) + gp::dot4(v[r][3])); }
#pragma unroll
        for (int o = 1; o < 64; o <<= 1)
#pragma unroll
            for (int r = 0; r < RB; ++r) ss[r] += __shfl_xor(ss[r], o);
#pragma unroll
        for (int r = 0; r < RB; ++r) {
            const int m = m0 + r; const float rstd = rsqrtf(ss[r] * (1.f / D) + EPS);
#pragma unroll
            for (int j = 0; j < 4; ++j) {
                const int c = 4 * F.lane + 256 * j;
                if (MODE == 2) { *(f32x4*)(OUT + (size_t)m * D + c) = v[r][j] * rstd * gs[j]; }
                else {
                    { u32x2 xw; xw.x = cvt_pk_bf16(v[r][j][0], v[r][j][1]); xw.y = cvt_pk_bf16(v[r][j][2], v[r][j][3]); st8((XB + (size_t)m * D + c), xw); }
                    const f32x4 hv = v[r][j] * rstd * gs[j] + shv[j];
                    u32x2 w; w.x = cvt_pk_bf16(hv[0], hv[1]); w.y = cvt_pk_bf16(hv[2], hv[3]);
                    st8((H + (size_t)m * D + c), w);
                }
            }
        }
    }
}

__device__ __forceinline__ void t2_phase(Frame& F, const float* gain, const float* modl, const float* w_router, const float* rbias, int l, bool record) {
    LAS f32x4* wl = (LAS f32x4*)F.lds;
    LAS int* rec = (LAS int*)(F.lds + 65536);
    LAS float* recw = (LAS float*)(F.lds + 65536 + 2048);
    LAS int* lcnt = (LAS int*)(F.lds + 65536 + 4096);
    for (int idx = F.tid; idx < 4096; idx += NTHREADS) {
        const int lane = idx & 63, c = (idx >> 6) & 3, i = (idx >> 8) & 3, j = idx >> 10; const int k = 4 * lane + 256 * j + i;
        wl[idx] = *(const f32x4*)(w_router + (size_t)k * NE + 4 * c);
    }
    if (F.tid < 32) lcnt[F.tid] = 0;
    __syncthreads();
    constexpr int RB = 4, RPW = T / (256 * NWAVES);
    const int gw = F.vcu * NWAVES + F.wave, bt = (gw * RPW) >> 12;
    bf16_t* H = (bf16_t*)(F.ws + WS_H); const bf16_t* XB = (const bf16_t*)(F.ws + WS_XB);
    const int lane = F.lane, myrow = lane >> 4, mye = lane & 15;
    f32x4 gs[4], shv[4];
#pragma unroll
    for (int j = 0; j < 4; ++j) { const int c = 4 * lane + 256 * j; gs[j] = *(const f32x4*)(gain + c) * (1.f + *(const f32x4*)(modl + (size_t)bt * 6 * D + 4 * D + c)); shv[j] = *(const f32x4*)(modl + (size_t)bt * 6 * D + 3 * D + c); }
    int it = 0;
    for (int m0 = gw * RPW; m0 < gw * RPW + RPW; m0 += RB, ++it) {
        f32x4 v[RB][4]; float ss[RB];
#pragma unroll
        for (int r = 0; r < RB; ++r)
#pragma unroll
            for (int j = 0; j < 4; ++j) { const u32x2 xb = *(const u32x2*)(XB + (size_t)(m0 + r) * D + 4 * lane + 256 * j); v[r][j] = (f32x4){bf2f(xb.x & 0xffffu), bf2f(xb.x >> 16), bf2f(xb.y & 0xffffu), bf2f(xb.y >> 16)}; }
#pragma unroll
        for (int r = 0; r < RB; ++r) ss[r] = (gp::dot4(v[r][0]) + gp::dot4(v[r][1])) + (gp::dot4(v[r][2]) + gp::dot4(v[r][3]));
#pragma unroll
        for (int o = 1; o < 64; o <<= 1)
#pragma unroll
            for (int r = 0; r < RB; ++r) ss[r] += __shfl_xor(ss[r], o);
        float acc[RB * NE];
#pragma unroll
        for (int q = 0; q < RB * NE; ++q) acc[q] = 0.f;
#pragma unroll
        for (int j = 0; j < 4; ++j) {
            const int c = 4 * lane + 256 * j;
#pragma unroll
            for (int r = 0; r < RB; ++r) {
                const int m = m0 + r; const float rstd = rsqrtf(ss[r] * (1.f / D) + EPS);
                v[r][j] = v[r][j] * rstd * gs[j] + shv[j];
                u32x2 w; w.x = cvt_pk_bf16(v[r][j][0], v[r][j][1]); w.y = cvt_pk_bf16(v[r][j][2], v[r][j][3]);
                st8((H + (size_t)m * D + c), w);
            }
#pragma unroll
            for (int i = 0; i < 4; ++i)
#pragma unroll
                for (int c4 = 0; c4 < 4; ++c4) { const f32x4 wv = wl[((j * 4 + i) * 4 + c4) * 64 + lane];
#pragma unroll
                    for (int r = 0; r < RB; ++r) { const float hv = v[r][j][i];
                        acc[r * NE + 4 * c4 + 0] += hv * wv[0]; acc[r * NE + 4 * c4 + 1] += hv * wv[1]; acc[r * NE + 4 * c4 + 2] += hv * wv[2]; acc[r * NE + 4 * c4 + 3] += hv * wv[3]; } }
        }
#pragma unroll
        for (int sft = 32; sft >= 1; sft >>= 1) {
            const bool up = (lane & sft) != 0;
#pragma unroll
            for (int k = 0; k < sft; ++k) { const float a = acc[k], b = acc[k + sft]; const float keep = up ? b : a, send = up ? a : b; acc[k] = keep + __shfl_xor(send, sft); }
        }
        const float logit = acc[0];
        const float score = 1.f / (1.f + expf(-logit));
        float scv[NE], bi[NE];
#pragma unroll
        for (int e = 0; e < NE; ++e) { scv[e] = __shfl(score, (lane & 48) | e); bi[e] = scv[e] + rbias[e]; }
        int gsel = 0; float gbest = -INFINITY;
#pragma unroll
        for (int g = 0; g < 4; ++g) { float m1 = -INFINITY, m2 = -INFINITY;
#pragma unroll
            for (int j = 0; j < 4; ++j) { const float x = bi[g * 4 + j]; if (x > m1) { m2 = m1; m1 = x; } else if (x > m2) m2 = x; }
            const float gs = m1 + m2; if (gs > gbest) { gbest = gs; gsel = g; } }
        int e1 = -1, e2 = -1; float b1 = -INFINITY, b2 = -INFINITY, s1 = 0.f, s2 = 0.f;
#pragma unroll
        for (int j = 0; j < 4; ++j) { float x = -INFINITY, sx = 0.f;
#pragma unroll
            for (int g = 0; g < 4; ++g) if (g == gsel) { x = bi[g * 4 + j]; sx = scv[g * 4 + j]; }
            const int e = gsel * 4 + j;
            if (x > b1) { b2 = b1; e2 = e1; s2 = s1; b1 = x; e1 = e; s1 = sx; } else if (x > b2) { b2 = x; e2 = e; s2 = sx; } }
        if (mye == 0) {
            const float inv = 1.f / (s1 + s2); const int slot = (it * RB + myrow) * NWAVES + F.wave;
            rec[slot * 4 + 0] = e1; rec[slot * 4 + 1] = e2;
            rec[slot * 4 + 2] = __hip_atomic_fetch_add(&lcnt[e1], 1, __ATOMIC_RELAXED, __HIP_MEMORY_SCOPE_WORKGROUP);
            rec[slot * 4 + 3] = __hip_atomic_fetch_add(&lcnt[e2], 1, __ATOMIC_RELAXED, __HIP_MEMORY_SCOPE_WORKGROUP);
            recw[slot * 2 + 0] = s1 * inv; recw[slot * 2 + 1] = s2 * inv;
        }
    }
    __syncthreads();
    if (!record) return;
    if (F.tid < NE) lcnt[16 + F.tid] = (int)__hip_atomic_fetch_add(F.ctl + CW_CNT + (l * NE + F.tid) * 64, (unsigned)lcnt[F.tid], __ATOMIC_RELAXED, __HIP_MEMORY_SCOPE_AGENT);
    __syncthreads();
    unsigned* list = (unsigned*)(F.ws + WS_LIST); float* gwb = (float*)(F.ws + WS_GW);
    const int nrows = it * RB;
    for (int s = F.tid; s < nrows * NWAVES; s += NTHREADS) {
        const int i2 = s / NWAVES, w = s % NWAVES; const int m = (F.vcu * NWAVES + w) * RPW + i2;
        const int e1 = rec[s * 4 + 0], e2 = rec[s * 4 + 1];
        list[(size_t)e1 * T + lcnt[16 + e1] + rec[s * 4 + 2]] = (unsigned)(2 * m); list[(size_t)e2 * T + lcnt[16 + e2] + rec[s * 4 + 3]] = (unsigned)(2 * m + 1);
        gwb[2 * m] = recw[s * 2]; gwb[2 * m + 1] = recw[s * 2 + 1];
    }
}
__device__ __forceinline__ const LAS int* moe_table(Frame& F, int l) {
    LAS int* tab = (LAS int*)(F.lds + MISC_OFF + 1024);
    __syncthreads();
    if (F.tid == 0) { int acc = 0;
        for (int e = 0; e < NE; ++e) { const int c = (int)__hip_atomic_load(F.ctl + CW_CNT + (l * NE + e) * 64, __ATOMIC_RELAXED, __HIP_MEMORY_SCOPE_AGENT); tab[e] = acc; tab[32 + e] = c; acc += (c + 255) >> 8; }
        tab[16] = acc; }
    __syncthreads();
    return tab;
}

typedef __attribute__((address_space(4))) const Args CArgs;
#define LAUNDER_GP(T_, p) do { GAS T_* _t = (GAS T_*)(p); asm volatile("" : "+s"(_t)); (p) = (T_*)_t; } while (0)
#define PH_BEGIN() LAUNDER_V(F.tid); F.lane = F.tid & 63; LAUNDER_GP(unsigned, F.ctl); LAUNDER_GP(float, F.OUT); LAUNDER_GP(unsigned char, F.ws); GAS unsigned char* ws = (GAS unsigned char*)F.ws; CArgs* ka = (CArgs*)__builtin_amdgcn_kernarg_segment_ptr(); LAUNDER_S(ka); \
    float* mod = WSP(float, WS_MOD); (void)mod; (void)ka
#define WSP(T_, off) ((T_*)(GAS T_*)(ws + (off)))
#define KIN(i) ((const float*)(GAS const float*)ka->in[i])
__global__ void __launch_bounds__(NTHREADS, 2) fwd_kernel(Args args) {
    extern __shared__ __attribute__((aligned(16))) unsigned char lds_raw[];
    Frame F;
    F.lds = (LAS unsigned char*)lds_raw; F.MISC = (volatile LAS unsigned*)(F.lds + MISC_OFF);
    F.tid = threadIdx.x; F.lane = F.tid & 63; F.wave = __builtin_amdgcn_readfirstlane(F.tid >> 6);
    F.G = gridDim.x; { const int bx = blockIdx.x; F.vcu = (F.G % 8 == 0) ? (bx % 8) * (F.G / 8) + bx / 8 : bx; }
    F.ws = (unsigned char*)(GAS unsigned char*)args.ws; F.ctl = (unsigned*)(GAS unsigned*)(args.ws + WS_CTL); F.OUT = (float*)(GAS float*)args.out;
    if (F.tid < 64) F.MISC[F.tid] = 0u;
    __syncthreads();
    XcdBarrier bar; bar.bar = F.ctl + CW_BAR; bar.x = 0; bar.st = nullptr;
    if (!N_LAUNCH_MODE) bar = xcd_barrier_post(F.ctl + CW_BAR, F.MISC + 8);
    const int lo = args.ph_lo, hi = args.ph_hi;
#define IN(k) (lo <= (k) && (k) < hi)
#define SEAM(k) do { if ((k) + 1 < hi) { if (!N_LAUNCH_MODE) xcd_barrier(bar); } } while (0)
    const int cidx = (int)blockIdx.x;

    if (IN(0)) { PH_BEGIN(); p0_phase(F, KIN(1), KIN(2), KIN(3)); __syncthreads(); LAUNDER_V(F.tid); F.lane = F.tid & 63; convert_weights(F, ka, 0); SEAM(0); }
    for (int l = 0; l < NL; ++l) {
        const int pb = 1 + 9 * l;
        if (IN(pb + 0)) {
            PH_BEGIN();
            if (l > 0) for (int rep = 0; rep < ((PROBE_DUP & 8) ? 2 : 1); ++rep) { LAUNDER_V(F.tid); F.lane = F.tid & 63; convert_weights(F, ka, l); }
            if (l == 0) row_phase<0>(F, KIN(0), nullptr, KIN(4) + l * D, mod + (size_t)l * NB * 6 * D, 0, D, WSP(bf16_t, WS_H), WSP(bf16_t, WS_XB), nullptr);
            else row_phase<1>(F, nullptr, mod + (size_t)(l - 1) * NB * 6 * D, KIN(4) + l * D, mod + (size_t)l * NB * 6 * D, 0, D, WSP(bf16_t, WS_H), WSP(bf16_t, WS_XB), nullptr);
            SEAM(pb + 0);
        }
        if (IN(pb + 1)) {
            PH_BEGIN();
            gp::Gemm g{WSP(bf16_t, WS_H), WSP(const bf16_t, WS_WIN), D, 0, nullptr}; gp::DenseOrder So; So.init(T, NIN, F.G, cidx);
            gp::EpiIn E{WSP(bf16_t, ATT_FP8_A ? WS_QA8 : WS_QA), WSP(bf16_t, ATT_FP8_A ? WS_KA8 : WS_KA), WSP(bf16_t, ATT_FP8_A ? WS_VTA8 : WS_VA), WSP(bf16_t, WS_QLAT), WSP(bf16_t, WS_KVLAT), WSP(bf16_t, ATT_FP8_B ? WS_KB8 : WS_KB), WSP(bf16_t, WS_SA), WSP(bf16_t, WS_SB), WSP(float, WS_SSQ), WSP(float, WS_SSKV),
                        KIN(6) + l * 64, KIN(7) + l * 64, WSP(const float, WS_COSA), WSP(const float, WS_SINA), WSP(const float, WS_COSB), WSP(const float, WS_SINB)};
            if (PROBE_DUP & 128) { gp::EpiNull En; gp::gemm_phase<gp::EpiNull, gp::DenseOrder>(F.tid, F.lds, g, So, En); LAUNDER_V(F.tid); }
            gp::gemm_phase<gp::EpiIn, gp::DenseOrder>(F.tid, F.lds, g, So, E); if (PROBE_DUP & (2 | 512)) { LAUNDER_V(F.tid); gp::gemm_phase<gp::EpiIn, gp::DenseOrder>(F.tid, F.lds, g, So, E); }
            SEAM(pb + 1);
        }
        if (IN(pb + 2)) {
            { PH_BEGIN(); gp::Gemm g{WSP(bf16_t, WS_QLAT), WSP(const bf16_t, WS_WQB), 384, 0, nullptr}; gp::DenseOrder So; So.init(T, 768, F.G, cidx);
              gp::EpiQb E{WSP(bf16_t, ATT_FP8_B ? WS_QB8 : WS_QB), WSP(const float, WS_SSQ), WSP(const float, WS_COSB), WSP(const float, WS_SINB)}; gp::gemm_phase<gp::EpiQb, gp::DenseOrder>(F.tid, F.lds, g, So, E); if (PROBE_DUP & 2) { LAUNDER_V(F.tid); gp::gemm_phase<gp::EpiQb, gp::DenseOrder>(F.tid, F.lds, g, So, E); } }
            { PH_BEGIN(); gp::Gemm g{WSP(bf16_t, WS_KVLAT), WSP(const bf16_t, WS_WKVB), 256, 0, nullptr}; gp::DenseOrder So; So.init(T, 1024, F.G, F.G - 1 - cidx);
              gp::EpiKvb E{WSP(bf16_t, ATT_FP8_B ? WS_KB8 : WS_KB), WSP(bf16_t, ATT_FP8_B ? WS_VTB8 : WS_VB), WSP(const float, WS_SSKV)}; gp::gemm_phase<gp::EpiKvb, gp::DenseOrder>(F.tid, F.lds, g, So, E); if (PROBE_DUP & 2) { LAUNDER_V(F.tid); gp::gemm_phase<gp::EpiKvb, gp::DenseOrder>(F.tid, F.lds, g, So, E); } }
#if FAST_ATTN && ATT_FP8_A
            { PH_BEGIN(); at::attn_phase_f8a(F.tid, F.lds, WSP(const unsigned char, WS_QA8), WSP(const unsigned char, WS_KA8), WSP(const unsigned char, WS_VTA8), WSP(bf16_t, WS_QA), 512, KIN(6) + l * 64, KIN(7) + l * 64, F.vcu, F.G); }
            if (PROBE_DUP & 1) { PH_BEGIN(); at::attn_phase_f8a(F.tid, F.lds, WSP(const unsigned char, WS_QA8), WSP(const unsigned char, WS_KA8), WSP(const unsigned char, WS_VTA8), WSP(bf16_t, WS_QA), 512, KIN(6) + l * 64, KIN(7) + l * 64, F.vcu, F.G); }
#else
            { PH_BEGIN(); const at::Tensors A{WSP(bf16_t, WS_QA), 512, WSP(bf16_t, WS_KA), 128, WSP(bf16_t, WS_VA), 128, WSP(bf16_t, WS_QA), 512, 4}; at::attn_phase<64>(F.tid, F.lds, A, F.vcu, F.G); }
#endif
            SEAM(pb + 2);
        }
        if (IN(pb + 3)) {
            PH_BEGIN();
#if FAST_ATTN && ATT_FP8_B
            at::attn_phase_f8b(F.tid, F.lds, WSP(const unsigned char, WS_QB8), WSP(const unsigned char, WS_KB8), WSP(const unsigned char, WS_VTB8), WSP(bf16_t, WS_OB), 512, F.vcu, F.G);
            if (PROBE_DUP & 1) { LAUNDER_V(F.tid); at::attn_phase_f8b(F.tid, F.lds, WSP(const unsigned char, WS_QB8), WSP(const unsigned char, WS_KB8), WSP(const unsigned char, WS_VTB8), WSP(bf16_t, WS_OB), 512, F.vcu, F.G); }
#else
            const at::Tensors A{WSP(bf16_t, WS_QB), 768, WSP(bf16_t, WS_KB), 768, WSP(bf16_t, WS_VB), 512, WSP(bf16_t, WS_OB), 512, 1}; for (int rep = 0; rep < ((PROBE_DUP & 1) ? 2 : 1); ++rep) at::attn_phase<96>(F.tid, F.lds, A, F.vcu, F.G);
#endif
            SEAM(pb + 3);
        }
        if (IN(pb + 4)) {
            PH_BEGIN();
            gp::Gemm g{WSP(bf16_t, WS_QA), WSP(const bf16_t, WS_WPA), 512, (size_t)(WS_WPB - WS_WPA) / 2, nullptr, (size_t)(WS_OB - WS_QA) / 2}; gp::PairOrder So; So.init(T, D, F.G, cidx);
            gp::EpiProjP E{WSP(bf16_t, WS_H), WSP(const unsigned char, WS_SA), WSP(const unsigned char, WS_SB)};
            gp::gemm_phase<gp::EpiProjP, gp::PairOrder>(F.tid, F.lds, g, So, E);
            if (PROBE_DUP & (2 | 1024)) { LAUNDER_V(F.tid); gp::gemm_phase<gp::EpiProjP, gp::PairOrder>(F.tid, F.lds, g, So, E); }
            SEAM(pb + 4);
        }
        if (IN(pb + 5)) {
            PH_BEGIN();
            gp::Gemm g{WSP(bf16_t, WS_H), WSP(const bf16_t, WS_WO), D, 0, nullptr}; gp::DenseOrder So; So.init(T, D, F.G, cidx);
            gp::EpiWo E{WSP(const bf16_t, WS_XB), mod + (size_t)l * NB * 6 * D, WSP(bf16_t, WS_XB)}; gp::gemm_phase<gp::EpiWo, gp::DenseOrder>(F.tid, F.lds, g, So, E);
            SEAM(pb + 5);
        }
        if (IN(pb + 6)) {
            PH_BEGIN();
            if (PROBE_DUP & 16) { t2_phase(F, KIN(15) + l * D, mod + (size_t)l * NB * 6 * D, KIN(16), KIN(17), l, false); LAUNDER_V(F.tid); F.lane = F.tid & 63; __syncthreads(); }
            t2_phase(F, KIN(15) + l * D, mod + (size_t)l * NB * 6 * D, KIN(16), KIN(17), l, true);
            SEAM(pb + 6);
        }
        if (IN(pb + 7)) {
            PH_BEGIN();
            const LAS int* tab = moe_table(F, l);
            gp::Gemm g{WSP(bf16_t, WS_H), WSP(const bf16_t, WS_W13), D, (size_t)1024 * D, WSP(const unsigned, WS_LIST)}; gp::MoeOrder So; So.init(tab, F.G, cidx);
            if (PROBE_DUP & 256) { gp::EpiNull En; gp::gemm_phase<gp::EpiNull, gp::MoeOrder, true>(F.tid, F.lds, g, So, En); LAUNDER_V(F.tid); }
            gp::EpiUp E{WSP(bf16_t, WS_ACT)}; gp::gemm_phase<gp::EpiUp, gp::MoeOrder, true>(F.tid, F.lds, g, So, E); if (PROBE_DUP & 4) { LAUNDER_V(F.tid); gp::gemm_phase<gp::EpiUp, gp::MoeOrder, true>(F.tid, F.lds, g, So, E); }
            SEAM(pb + 7);
        }
        if (IN(pb + 8)) {
            PH_BEGIN();
            const LAS int* tab = moe_table(F, l);
            gp::Gemm g{WSP(bf16_t, WS_ACT), WSP(const bf16_t, WS_W2), FF, (size_t)D * FF, nullptr}; gp::MoeOrder So; So.init(tab, F.G, cidx);
            gp::EpiDown E{WSP(bf16_t, WS_Y2), WSP(const unsigned, WS_LIST), WSP(const float, WS_GW)}; gp::gemm_phase<gp::EpiDown, gp::MoeOrder, false>(F.tid, F.lds, g, So, E); if (PROBE_DUP & 4) { LAUNDER_V(F.tid); gp::gemm_phase<gp::EpiDown, gp::MoeOrder, false>(F.tid, F.lds, g, So, E); }
            SEAM(pb + 8);
        }
    }
    if (IN(NPHASE - 1)) { PH_BEGIN(); row_phase<2>(F, nullptr, mod + (size_t)(NL - 1) * NB * 6 * D, KIN(21), nullptr, 0, 0, nullptr, WSP(bf16_t, WS_XB), F.OUT); }
#undef IN
#undef SEAM
}

extern "C" void kernel_launch(void* const* d_in, const int* in_sizes, int n_in, void* d_out, int out_size, void* d_ws, size_t ws_size, hipStream_t stream) {
    static int grid = 0;
    if (grid == 0) {
        if (n_in != 22 || out_size != T * D || ws_size < WS_END) { fprintf(stderr, "kernel_launch: unexpected problem (n_in %d out %d ws %zu)\n", n_in, out_size, ws_size); grid = -1; return; }
        int dev = 0, cus = 0, per_cu = 0;
        if (hipGetDevice(&dev) != hipSuccess || hipDeviceGetAttribute(&cus, hipDeviceAttributeMultiprocessorCount, dev) != hipSuccess) { grid = -1; return; }
        if (hipFuncSetAttribute((const void*)fwd_kernel, hipFuncAttributeMaxDynamicSharedMemorySize, LDS_BYTES) != hipSuccess) { grid = -1; return; }
        if (hipOccupancyMaxActiveBlocksPerMultiprocessor(&per_cu, (const void*)fwd_kernel, NTHREADS, LDS_BYTES) != hipSuccess || per_cu < 1) { fprintf(stderr, "kernel_launch: occupancy query says %d\n", per_cu); }
        (void)hipGetLastError();
        grid = cus;
        if (grid != 256 || T % (grid * NWAVES * 4) != 0) {   fprintf(stderr, "kernel_launch: grid %d does not divide the row phases\n", grid); grid = -1; return; }
    }
    if (grid < 0) return;
    (void)hipMemsetAsync((char*)d_ws + WS_CTL, 0, CTL_BYTES, stream);
    Args a{};
    for (int i = 0; i < 22; ++i) a.in[i] = (const float*)d_in[i];
    a.out = (float*)d_out; a.ws = (unsigned char*)d_ws;
#if N_LAUNCH_MODE
    for (int p = 0; p < NPHASE; ++p) { a.ph_lo = p; a.ph_hi = p + 1; hipLaunchKernelGGL(fwd_kernel, dim3(grid), dim3(NTHREADS), LDS_BYTES, stream, a); }
#else
    a.ph_lo = 0; a.ph_hi = NPHASE;
    hipLaunchKernelGGL(fwd_kernel, dim3(grid), dim3(NTHREADS), LDS_BYTES, stream, a);
#endif
}
```

```cpp
#include <hip/hip_runtime.h>
#include <stdint.h>
#include <stdio.h>
#include <math.h>

#ifndef FAST_GEMM
#define FAST_GEMM 1
#endif
#ifndef FAST_ATTN
#define FAST_ATTN 1
#endif
#ifndef PROBE_DUP
#define PROBE_DUP 0
#endif
#ifndef PROBE_ATT
#define PROBE_ATT 0
#endif
#ifndef ATT_REGSTAGE
#define ATT_REGSTAGE 0
#endif
#ifndef WT_STORES
#define WT_STORES 0
#endif
#ifndef ATT_FP8_A
#define ATT_FP8_A 1
#endif
#ifndef ATT_FP8_B
#define ATT_FP8_B 1
#endif
#ifndef MOE_FP8
#define MOE_FP8 1
#endif
#ifndef N_LAUNCH_MODE
#define N_LAUNCH_MODE 0
#endif

#define LAS __attribute__((address_space(3)))
#define GAS __attribute__((address_space(1)))
typedef unsigned short bf16_t;
typedef short bf16x8 __attribute__((ext_vector_type(8)));
typedef float f32x4 __attribute__((ext_vector_type(4)));
typedef float f32x2 __attribute__((ext_vector_type(2)));
typedef float f32x16 __attribute__((ext_vector_type(16)));
typedef unsigned u32x4 __attribute__((ext_vector_type(4)));
typedef unsigned u32x2 __attribute__((ext_vector_type(2)));
typedef GAS unsigned gu32;

constexpr int D = 1024, NB = 8, S = 4096, T = NB * S, NL = 4, INC = 3488, NIN = 3584, NE = 16, FF = 512;
constexpr float EPS = 1e-6f, LOG2E = 1.4426950408889634f;
constexpr float QSCALE_A = 0.125f * LOG2E, QSCALE_B = 0.10206207261596577f * LOG2E;
constexpr int NWAVES = 8, NTHREADS = 512;
constexpr int NPHASE = 2 + 9 * NL;

constexpr size_t MiB = 1u << 20;
constexpr size_t WS_CTL = 0, CTL_BYTES = 1 * MiB;
constexpr size_t WS_MOD = 1 * MiB;
constexpr size_t WS_COSA = 2 * MiB, WS_SINA = WS_COSA + 512 * 1024, WS_COSB = 3 * MiB, WS_SINB = WS_COSB + 256 * 1024;
constexpr size_t WS_SSQ = 4 * MiB, WS_SSKV = 5 * MiB;
constexpr size_t WS_GW = 6 * MiB;
constexpr size_t WS_LIST = 7 * MiB;
constexpr size_t WS_WIN = 10 * MiB, WS_WQB = 17 * MiB, WS_WKVB = 18 * MiB, WS_WPA = 19 * MiB, WS_WPB = 20 * MiB, WS_WO = 21 * MiB, WS_W13 = 23 * MiB, WS_W2 = 55 * MiB;
constexpr size_t WS_H = 72 * MiB;
constexpr size_t WS_QA = 136 * MiB, WS_KA = 168 * MiB, WS_VA = 176 * MiB, WS_QLAT = 184 * MiB, WS_KVLAT = 208 * MiB;
constexpr size_t WS_KB = 224 * MiB, WS_VB = 272 * MiB, WS_QB = 304 * MiB, WS_OB = 352 * MiB, WS_SA = 384 * MiB, WS_SB = 448 * MiB, WS_XB = 512 * MiB, WS_QA8 = 576 * MiB, WS_KA8 = 592 * MiB, WS_VTA8 = 596 * MiB, WS_QB8 = 600 * MiB, WS_KB8 = 624 * MiB, WS_VTB8 = 648 * MiB, WS_END = 664 * MiB;
constexpr size_t WS_ACT = 136 * MiB, WS_Y2 = 208 * MiB;
constexpr int ACT_ROWS = 2 * T + NE * 256;
static_assert(WS_ACT + (size_t)ACT_ROWS * FF * 2 <= WS_Y2 && WS_Y2 + (size_t)2 * T * D * 2 <= WS_XB, "moe overlay");
constexpr int CW_BAR = 4096;
constexpr int CW_CNT = 16384;

constexpr int RING_BYTES = 131072, MISC_OFF = RING_BYTES, LDS_BYTES = 147456;

__device__ __forceinline__ float bf2f(unsigned v) { return __uint_as_float(v << 16); }
typedef __bf16 bf16x2_t __attribute__((ext_vector_type(2)));
__device__ __forceinline__ unsigned cvt_pk_bf16(float lo, float hi) { f32x2 v = {lo, hi}; bf16x2_t b = __builtin_convertvector(v, bf16x2_t); return __builtin_bit_cast(unsigned, b); }
__device__ __forceinline__ u32x4 pack8(f32x4 a, f32x4 b) { u32x4 w; w.x = cvt_pk_bf16(a[0], a[1]); w.y = cvt_pk_bf16(a[2], a[3]); w.z = cvt_pk_bf16(b[0], b[1]); w.w = cvt_pk_bf16(b[2], b[3]); return w; }
__device__ __forceinline__ u32x2 pack8_fp8(f32x4 a, f32x4 b) { u32x2 w;
    w.x = (unsigned)__builtin_amdgcn_cvt_pk_fp8_f32(a[2], a[3], __builtin_amdgcn_cvt_pk_fp8_f32(a[0], a[1], 0, false), true);
    w.y = (unsigned)__builtin_amdgcn_cvt_pk_fp8_f32(b[2], b[3], __builtin_amdgcn_cvt_pk_fp8_f32(b[0], b[1], 0, false), true); return w; }
__device__ __forceinline__ void unpack8(u32x4 w, f32x4& a, f32x4& b) { a[0] = bf2f(w.x & 0xffffu); a[1] = bf2f(w.x >> 16); a[2] = bf2f(w.y & 0xffffu); a[3] = bf2f(w.y >> 16); b[0] = bf2f(w.z & 0xffffu); b[1] = bf2f(w.z >> 16); b[2] = bf2f(w.w & 0xffffu); b[3] = bf2f(w.w >> 16); }
__device__ __forceinline__ float wave_sum(float v) {
#pragma unroll
    for (int o = 1; o < 64; o <<= 1) v += __shfl_xor(v, o);
    return v;
}
__device__ __forceinline__ float sigm(float v) { return __builtin_amdgcn_rcpf(1.f + __builtin_amdgcn_exp2f(v * (-LOG2E))); }
#if WT_STORES
__device__ __forceinline__ void st16(void* p, u32x4 v) { asm volatile("global_store_dwordx4 %0, %1, off sc1\n\ts_nop 1" :: "v"(p), "v"(v) : "memory"); }
__device__ __forceinline__ void st8(void* p, u32x2 v) { asm volatile("global_store_dwordx2 %0, %1, off sc1\n\ts_nop 1" :: "v"(p), "v"(v) : "memory"); }
#else
__device__ __forceinline__ void st16(void* p, u32x4 v) { *(u32x4*)p = v; }
__device__ __forceinline__ void st8(void* p, u32x2 v) { *(u32x2*)p = v; }
#endif
#define VM_WAIT() asm volatile("s_waitcnt vmcnt(0)" ::: "memory")
#define LAUNDER_S(p) asm volatile("" : "+s"(p))
#define LAUNDER_V(v) asm volatile("" : "+v"(v))
#define LDS_WAIT() asm volatile("s_waitcnt lgkmcnt(0)" ::: "memory")

#define XB_TMO      128
#define XB_XCNT(j)  (256  + 64 * (j))
#define XB_XSUB(j)  (1280 + 64 * (j))
#define XB_XGEN(j)  (2304 + 64 * (j))
#define XB_TOP      3328
#define XB_TOPGEN   3392
#define XCD_BAR_WORDS 3456
#define XB_SPIN_CAP (1u << 22)
__device__ __forceinline__ unsigned xb_ld(unsigned* p)              { return __hip_atomic_load(p, __ATOMIC_RELAXED, __HIP_MEMORY_SCOPE_AGENT); }
__device__ __forceinline__ unsigned xb_add(unsigned* p, unsigned v) { return __hip_atomic_fetch_add(p, v, __ATOMIC_RELAXED, __HIP_MEMORY_SCOPE_AGENT); }
__device__ __forceinline__ unsigned xb_xcc_id() { return (unsigned)__builtin_amdgcn_s_getreg((3 << 11) | 20) & 0xFu; }
#define XB_SPIN(cond, bar) do { unsigned _sp = 0; while (cond) { __builtin_amdgcn_s_sleep(1); \
    if ((++_sp & 255u) == 0u) { if (xb_ld(&(bar)[XB_TMO])) break; if (_sp > XB_SPIN_CAP) { atomicAdd(&(bar)[XB_TMO], 1u); break; } } } } while (0)
struct XcdBarrier { unsigned* bar; unsigned x; volatile LAS unsigned* st; };
__device__ __forceinline__ XcdBarrier xcd_barrier_post(unsigned* bar, volatile LAS unsigned* st) {
    XcdBarrier b; b.bar = bar; b.x = xb_xcc_id(); b.st = st;
    if (threadIdx.x == 0) (void)xb_add(&bar[XB_XCNT(b.x)], 1u);
    return b;
}
__device__ __forceinline__ void xcd_barrier_complete(unsigned* bar, unsigned x, unsigned& nloc, unsigned& nx) {
    const unsigned G = gridDim.x * gridDim.y * gridDim.z;
    unsigned sum, cnt, mine, sp = 0u;
    for (;;) {
        sum = 0u; cnt = 0u; mine = 0u;
#pragma unroll
        for (unsigned j = 0; j < 16; ++j) { const unsigned c = xb_ld(&bar[XB_XCNT(j)]); sum += c; cnt += (c > 0u) ? 1u : 0u; mine = (j == x) ? c : mine; }
        if (sum == G) break;
        __builtin_amdgcn_s_sleep(1);
        if ((++sp & 255u) == 0u) { if (xb_ld(&bar[XB_TMO])) break; if (sp > XB_SPIN_CAP) { atomicAdd(&bar[XB_TMO], 1u); break; } }
    }
    nloc = mine > 0u ? mine : 1u; nx = cnt > 0u ? cnt : 1u;
}
__device__ __forceinline__ void xcd_barrier(const XcdBarrier& b) {
    asm volatile("s_waitcnt vmcnt(0)" ::: "memory");
    __syncthreads();
    if (threadIdx.x == 0) {
        unsigned* bar = b.bar;
        __builtin_amdgcn_s_waitcnt(0);
        unsigned nloc = b.st[0], nx = b.st[1];
        if (nloc == 0u) { xcd_barrier_complete(bar, b.x, nloc, nx); b.st[0] = nloc; b.st[1] = nx; }
        const unsigned old = xb_add(&bar[XB_XSUB(b.x)], 1u);
        const unsigned gen = old / nloc;
        if (old + 1u == (gen + 1u) * nloc) {
            __builtin_amdgcn_fence(__ATOMIC_RELEASE, "agent");
            asm volatile("s_waitcnt vmcnt(0)" ::: "memory");
            const unsigned og = xb_add(&bar[XB_TOP], 1u);
            const unsigned tg = og / nx;
            if (og + 1u == (tg + 1u) * nx) xb_add(&bar[XB_TOPGEN], 1u);
            else XB_SPIN(xb_ld(&bar[XB_TOPGEN]) == tg, bar);
            __builtin_amdgcn_fence(__ATOMIC_ACQUIRE, "agent");
            xb_add(&bar[XB_XGEN(b.x)], 1u);
            asm volatile("s_waitcnt vmcnt(0)" ::: "memory");
        } else {
            XB_SPIN(xb_ld(&bar[XB_XGEN(b.x)]) == gen, bar);
            __builtin_amdgcn_fence(__ATOMIC_ACQUIRE, "agent");
            asm volatile("s_waitcnt vmcnt(0)" ::: "memory");
        }
    }
    __syncthreads();
}

namespace gp {
constexpr int BM = 256, BK = 64, HALF = 128, HTB = HALF * BK * 2, NXCD = 8, WGM = 8;
__host__ __device__ __forceinline__ int lds_byte(int r, int c) { const int st = (r >> 4) * 2 + (c >> 5), rr = r & 15, cc = c & 31, ob = rr * 64 + cc * 2; return st * 1024 + (ob ^ (((ob >> 9) & 1) << 5)); }
__host__ __device__ __forceinline__ void stage_rc(int b, int& R, int& C) { const int st = b / 1024, sb = b % 1024, swz = sb ^ (((sb >> 9) & 1) << 5); R = (st >> 1) * 16 + swz / 64; C = (st & 1) * 32 + (swz % 64) / 2; }
__host__ __device__ __forceinline__ int perm32(int rho) { const int n = rho >> 4, i = rho & 15; return 8 * (i >> 2) + 4 * n + (i & 3); }

struct Unit { int pm, pn, be, rl, nv; };
struct Gemm { const bf16_t* A; const bf16_t* Bt; int K; size_t bstride; const unsigned* list; size_t astride; int sw, sx; };

__device__ __forceinline__ int xcd_remap(int wgid, int nwg) { const int q = nwg / NXCD, r = nwg % NXCD, xcd = wgid % NXCD, off = wgid / NXCD; return (xcd < r ? xcd * (q + 1) : r * (q + 1) + (xcd - r) * q) + off; }
struct DenseOrder {
    int nM, nN, nwg, G, c;
    __device__ void init(int M, int N, int G_, int c_) { nM = M / BM; nN = N / BM; nwg = nM * nN; G = G_; c = c_; }
    __device__ bool next(int i, Unit& u) const {
        const long L = (long)i * G + c; if (L >= nwg) return false;
        const int wgid = xcd_remap((int)L, nwg);
        const int nig = WGM * nN, gid = wgid / nig, fm = gid * WGM, gsz = (nM - fm) < WGM ? (nM - fm) : WGM;
        u.pm = fm + ((wgid % nig) % gsz); u.pn = (wgid % nig) / gsz; u.be = 0; u.rl = 0; u.nv = 256; return true;
    }
};
struct PairOrder {
    DenseOrder d;
    __device__ void init(int M, int N, int G_, int c_) { d.init(M, N, G_, c_); }
    __device__ bool next(int i, Unit& u) const { if (!d.next(i >> 1, u)) return false; u.be = i & 1; return true; }
};
struct MoeOrder {
    const LAS int* tab; int nwg, G, c;
    __device__ static int rd(const LAS int* p) { return __builtin_amdgcn_readfirstlane(*p); }
    __device__ void init(const LAS int* tab_, int G_, int c_) { tab = tab_; nwg = rd(tab_ + 16) * 4; G = G_; c = c_; }
    __device__ bool next(int i, Unit& u) const {
        const long L = (long)i * G + c; if (L >= nwg) return false;
        const int wgid = xcd_remap((int)L, nwg);
        const int tile = wgid >> 2; int e = 0;
        for (int k = 1; k < NE; ++k) { const int tk = rd(tab + k); e = (tk <= tile) ? k : e; }
        e = __builtin_amdgcn_readfirstlane(e);
        u.pm = tile; u.pn = wgid & 3; u.be = e; u.rl = tile - rd(tab + e); const int rem = rd(tab + 32 + e) - u.rl * 256; u.nv = rem < 256 ? rem : 256; return true;
    }
};

#define ACC_T f32x4 (&acc)[2][2][4][2]

template <class Epi, class Sched, bool GATHER>
__device__ __forceinline__ void gemm_phase_ref(int tid, const Gemm g, const Sched& S, const Epi& E) {
    const int wid = __builtin_amdgcn_readfirstlane(tid >> 6), lane = tid & 63, wr = wid >> 2, wc = wid & 3, fr = lane & 15, fq = lane >> 4;
    const int K = g.K; Unit u;
    for (int ui = 0; S.next(ui, u); ++ui) {
        f32x4 acc[2][2][4][2];
#pragma unroll
        for (int a = 0; a < 2; ++a)
#pragma unroll
            for (int b = 0; b < 2; ++b)
#pragma unroll
                for (int m = 0; m < 4; ++m)
#pragma unroll
                    for (int n = 0; n < 2; ++n) acc[a][b][m][n] = (f32x4){0.f, 0.f, 0.f, 0.f};
        const bf16_t* Bt = g.Bt + (size_t)u.be * g.bstride + (size_t)u.pn * 256 * K;
        for (int ai = 0; ai < 2; ++ai)
            for (int m = 0; m < 4; ++m) {
                const int rloc = ai * 128 + wr * 64 + m * 16 + fr;
                size_t arow;
                if (GATHER) { arow = (rloc < u.nv) ? (size_t)(g.list[(size_t)u.be * T + u.rl * 256 + rloc] >> 1) : 0; }
                else arow = (size_t)u.pm * 256 + rloc;
                const bf16_t* ap = g.A + arow * K;
                for (int bj = 0; bj < 2; ++bj) {
                    const bf16_t* bp = Bt + (size_t)(bj * 128 + wc * 32 + fq * 8) * K;
                    float s[8];
#pragma unroll
                    for (int c = 0; c < 8; ++c) {
                        float sc = 0.f; const bf16_t* bpc = bp + (size_t)c * K;
#pragma unroll 2
                        for (int k = 0; k < K; k += 8) {
                            f32x4 a0, a1, b0, b1; unpack8(*(const u32x4*)(ap + k), a0, a1); unpack8(*(const u32x4*)(bpc + k), b0, b1);
                            sc += a0[0] * b0[0] + a0[1] * b0[1] + a0[2] * b0[2] + a0[3] * b0[3] + a1[0] * b1[0] + a1[1] * b1[1] + a1[2] * b1[2] + a1[3] * b1[3];
                        }
                        s[c] = sc; asm volatile("" : "+v"(s[c]));
                    }
#pragma unroll
                    for (int a2 = 0; a2 < 2; ++a2)
#pragma unroll
                        for (int b2 = 0; b2 < 2; ++b2)
#pragma unroll
                            for (int m2 = 0; m2 < 4; ++m2)
                                if (a2 == ai && b2 == bj && m2 == m) { acc[a2][b2][m2][0] = (f32x4){s[0], s[1], s[2], s[3]}; acc[a2][b2][m2][1] = (f32x4){s[4], s[5], s[6], s[7]}; }
                }
            }
        E(acc, u, wr, wc, fr, fq);
    }
}

template <class E> struct EpiTraits { static constexpr bool KEEP = false; };
#if FAST_GEMM
typedef int v8i_t __attribute__((ext_vector_type(8)));
__device__ __forceinline__ unsigned gp_voffb(int tid, int i, int K) { int t_ = tid; LAUNDER_V(t_); int R, C; stage_rc(t_ * 16 + i * 8192, R, C); const int Rb = (R & ~31) + perm32(R & 31); return (unsigned)(Rb * K + C) * 2u; }
template <class Epi, class Sched, bool GATHER, bool F8>
__device__ __forceinline__ void gemm_phase_fast(int tid, LAS unsigned char* lds, const Gemm g, const Sched& S, const Epi& E) {
    const int wid = __builtin_amdgcn_readfirstlane(tid >> 6), lane = tid & 63, wr = wid >> 2, wc = wid & 3, fr = lane & 15, fq = lane >> 4;
    const int K = g.K, nt = K / BK;
    int Rr[2], Cc[2]; unsigned voffB[2];
#pragma unroll
    for (int i = 0; i < 2; ++i) { stage_rc(tid * 16 + i * 8192, Rr[i], Cc[i]); const int Rb = (Rr[i] & ~31) + perm32(Rr[i] & 31); voffB[i] = (unsigned)(Rb * K + Cc[i]) * 2u; }
#define GP_VB(i) (F8 ? gp_voffb(tid, (i), K) : voffB[i])
    const size_t kstep = (size_t)(BK * 2), hstep = (size_t)HALF * K * 2, tstep = 2 * hstep;
    const unsigned ldsw = (unsigned)wid * 1024u;
    const int aoff = lds_byte(wr * 64 + fr, fq * 8), boff = lds_byte(wc * 32 + fr, fq * 8);
#define GP_UNI(p) ((const char*)(((unsigned long long)(unsigned)__builtin_amdgcn_readfirstlane((int)((unsigned long long)(p) >> 32)) << 32) | (unsigned)__builtin_amdgcn_readfirstlane((int)(unsigned long long)(p))))
#define GP_SA(b, h) (((b) * 2 + (h)) * HTB)
#define GP_SB(b, h) ((4 + (b) * 2 + (h)) * HTB)
#define GP_DMA(sbase, voff, ldsdst) do { unsigned keep_; asm volatile("s_mov_b32 %0, m0\n\ts_mov_b32 m0, %3\n\ts_nop 0\n\tglobal_load_lds_dwordx4 %1, %2\n\ts_mov_b32 m0, %0" \
        : "=&s"(keep_) : "v"(voff), "s"(sbase), "s"((unsigned)__builtin_amdgcn_readfirstlane((int)(unsigned)(uintptr_t)(ldsdst))) : "memory"); } while (0)
#define GP_STAGE2(bufoff, gbase, v0, v1) do { const char* gb_ = (gbase); GP_DMA(gb_, (v0), lds + (bufoff) + ldsw); GP_DMA(gb_, (v1), lds + (bufoff) + ldsw + 8192); } while (0)
#define GP_STAGEB(bufoff, gbase) GP_STAGE2(bufoff, gbase, GP_VB(0), GP_VB(1))
#define GP_CAT8(x0, x1) __builtin_bit_cast(v8i_t, __builtin_shufflevector(x0, x1, 0, 1, 2, 3, 4, 5, 6, 7, 8, 9, 10, 11, 12, 13, 14, 15))
#define GP_LDA(dst, b, h) do { _Pragma("unroll") for (int m = 0; m < 4; ++m) _Pragma("unroll") for (int k = 0; k < 2; ++k) dst[m][k] = *(const LAS bf16x8*)(lds + GP_SA(b, h) + aoff + m * 2048 + k * 1024); \
        if constexpr (F8) { _Pragma("unroll") for (int m = 0; m < 4; ++m) dst##8[m] = GP_CAT8(dst[m][0], dst[m][1]); } } while (0)
#define GP_LDB(dst, b, h) do { _Pragma("unroll") for (int n = 0; n < 2; ++n) _Pragma("unroll") for (int k = 0; k < 2; ++k) dst[n][k] = *(const LAS bf16x8*)(lds + GP_SB(b, h) + boff + n * 2048 + k * 1024); \
        if constexpr (F8) { _Pragma("unroll") for (int n = 0; n < 2; ++n) dst##8[n] = GP_CAT8(dst[n][0], dst[n][1]); } } while (0)
#define GP_MMA(ai, bj, At, Bt) do { __builtin_amdgcn_s_setprio(1); \
        if constexpr (F8) { _Pragma("unroll") for (int m = 0; m < 4; ++m) _Pragma("unroll") for (int n = 0; n < 2; ++n) \
            acc[ai][bj][m][n] = __builtin_amdgcn_mfma_scale_f32_16x16x128_f8f6f4(Bt##8[n], At##8[m], acc[ai][bj][m][n], 0, 0, 0, 0, 0, 0); }     \
        else { _Pragma("unroll") for (int m = 0; m < 4; ++m) _Pragma("unroll") for (int n = 0; n < 2; ++n) _Pragma("unroll") for (int k = 0; k < 2; ++k) \
            acc[ai][bj][m][n] = __builtin_amdgcn_mfma_f32_16x16x32_bf16(Bt[n][k], At[m][k], acc[ai][bj][m][n], 0, 0, 0); } \
        __builtin_amdgcn_s_setprio(0); } while (0)
#define GP_WAIT_V(n) asm volatile("s_waitcnt vmcnt(" #n ")" ::: "memory")
#define GP_WAIT_L(n) asm volatile("s_waitcnt lgkmcnt(" #n ")" ::: "memory")
#define GP_BAR __builtin_amdgcn_s_barrier()
#define GP_SCHED __builtin_amdgcn_sched_barrier(0)
    Unit cur, nxt; int ui = 0;
    if (!S.next(0, cur)) return;
    f32x4 acc[2][2][4][2];
#pragma unroll
    for (int a = 0; a < 2; ++a)
#pragma unroll
        for (int b = 0; b < 2; ++b)
#pragma unroll
            for (int m = 0; m < 4; ++m)
#pragma unroll
                for (int n = 0; n < 2; ++n) acc[a][b][m][n] = (f32x4){0.f, 0.f, 0.f, 0.f};
    bf16x8 At[4][2], B0[2][2], B1[2][2];
    v8i_t At8[4], B08[2], B18[2];
    unsigned vC0, vC1, vC2, vC3, vN0, vN1, vN2, vN3;
#define GP_VOFF(u, o0, o1, o2, o3) do { if (GATHER) { \
        int tl_ = tid; LAUNDER_V(tl_); int R0_, C0_, R1_, C1_; stage_rc(tl_ * 16, R0_, C0_); stage_rc(tl_ * 16 + 8192, R1_, C1_);     \
        const unsigned* lp = g.list + (size_t)(u).be * T + (u).rl * 256; \
        const int nvm = (u).nv - 1; const int p0 = min(R0_, nvm), p1 = min(R1_, nvm), p2 = min(128 + R0_, nvm), p3 = min(128 + R1_, nvm); \
        const unsigned t0 = lp[p0] >> 1, t1 = lp[p1] >> 1, t2 = lp[p2] >> 1, t3 = lp[p3] >> 1; \
        o0 = (t0 * K + C0_) * 2u; o1 = (t1 * K + C1_) * 2u; o2 = (t2 * K + C0_) * 2u; o3 = (t3 * K + C1_) * 2u; \
      } else { o0 = (unsigned)(Rr[0] * K + Cc[0]) * 2u; o1 = (unsigned)(Rr[1] * K + Cc[1]) * 2u; o2 = o0 + (unsigned)hstep; o3 = o1 + (unsigned)hstep; } } while (0)
    GP_VOFF(cur, vC0, vC1, vC2, vC3);
    const char* cA = GP_UNI((const char*)g.A + ((size_t)cur.be * g.astride) * 2 + (GATHER ? (size_t)0 : (size_t)cur.pm * tstep));
    const char* cB = GP_UNI((const char*)g.Bt + ((size_t)cur.be * g.bstride) * 2 + (size_t)cur.pn * tstep);
    GP_STAGEB(GP_SB(0, 0), cB); GP_STAGEB(GP_SB(0, 1), cB + hstep); GP_STAGE2(GP_SA(0, 0), cA, vC0, vC1); GP_STAGE2(GP_SA(0, 1), cA, vC2, vC3);
    if (wr == 1) GP_BAR;
    GP_WAIT_V(2); GP_BAR;
    GP_STAGEB(GP_SB(1, 0), cB + kstep); GP_STAGE2(GP_SA(1, 0), cA + kstep, vC0, vC1); GP_STAGEB(GP_SB(1, 1), cB + hstep + kstep);
    GP_WAIT_V(6); GP_BAR;
    for (;;) {
        const bool has_next = S.next(ui + 1, nxt);
        const char* nA = GP_UNI(has_next ? (const char*)g.A + ((size_t)nxt.be * g.astride) * 2 + (GATHER ? (size_t)0 : (size_t)nxt.pm * tstep) : cA);
        const char* nB = GP_UNI(has_next ? (const char*)g.Bt + ((size_t)nxt.be * g.bstride) * 2 + (size_t)nxt.pn * tstep : cB);
        if (GATHER) {
            if (has_next) { GP_VOFF(nxt, vN0, vN1, vN2, vN3); } else { vN0 = vC0; vN1 = vC1; vN2 = vC2; vN3 = vC3; }
            *(LAS u32x4*)(lds + MISC_OFF + 2048 + tid * 16) = (u32x4){vN0, vN1, vN2, vN3};
        } else { vN0 = vC0; vN1 = vC1; vN2 = vC2; vN3 = vC3; }
#pragma nounroll
        for (int t = 0; t < nt; t += 2) {
            LAUNDER_S(cA); LAUNDER_S(cB); LAUNDER_S(nA); LAUNDER_S(nB);
            const bool last = (t == nt - 2);
            if (GATHER) { if (last) { const u32x4 q_ = *(const LAS u32x4*)(lds + MISC_OFF + 2048 + tid * 16); vN0 = q_.x; vN1 = q_.y; vN2 = q_.z; vN3 = q_.w; } }
            const char* a1 = cA + (size_t)(t + 1) * kstep;
            const char* a2 = last ? nA : cA + (size_t)(t + 2) * kstep; const char* b2 = last ? nB : cB + (size_t)(t + 2) * kstep;
            const char* a3 = a2 + kstep; const char* b3 = b2 + kstep;
            const unsigned w0 = last ? vN0 : vC0, w1 = last ? vN1 : vC1, w2 = last ? vN2 : vC2, w3 = last ? vN3 : vC3;
            GP_LDB(B0, 0, 0); GP_LDB(B1, 0, 1); GP_SCHED; GP_LDA(At, 0, 0); GP_STAGE2(GP_SA(1, 1), a1, vC2, vC3);
            GP_WAIT_V(8); GP_WAIT_L(0); GP_BAR; GP_MMA(0, 0, At, B0); GP_MMA(0, 1, At, B1); GP_BAR; GP_SCHED;
            GP_LDA(At, 0, 1); GP_STAGEB(GP_SB(0, 0), b2); GP_STAGEB(GP_SB(0, 1), b2 + hstep); GP_STAGE2(GP_SA(0, 0), a2, w0, w1);
            GP_WAIT_V(8); GP_WAIT_L(0); GP_BAR; GP_MMA(1, 0, At, B0); GP_MMA(1, 1, At, B1); GP_BAR; GP_SCHED;
            GP_LDB(B0, 1, 0); GP_LDB(B1, 1, 1); GP_SCHED; GP_LDA(At, 1, 0); GP_STAGE2(GP_SA(0, 1), a2, w2, w3);
            GP_WAIT_V(8); GP_WAIT_L(0); GP_BAR; GP_MMA(0, 0, At, B0); GP_MMA(0, 1, At, B1); GP_BAR; GP_SCHED;
            GP_LDA(At, 1, 1); GP_STAGEB(GP_SB(1, 0), b3); GP_STAGEB(GP_SB(1, 1), b3 + hstep); GP_STAGE2(GP_SA(1, 0), a3, w0, w1);
            GP_WAIT_V(8); GP_WAIT_L(0); GP_BAR; GP_MMA(1, 0, At, B0); GP_MMA(1, 1, At, B1); GP_BAR; GP_SCHED;
        }
        if (wr == 0) GP_BAR;
        E(acc, cur, wr, wc, fr, fq);
        if (!has_next) break;
        if (!(EpiTraits<Epi>::KEEP && cur.be == 0)) {
#pragma unroll
        for (int a = 0; a < 2; ++a)
#pragma unroll
            for (int b = 0; b < 2; ++b)
#pragma unroll
                for (int m = 0; m < 4; ++m)
#pragma unroll
                    for (int n = 0; n < 2; ++n) acc[a][b][m][n] = (f32x4){0.f, 0.f, 0.f, 0.f};
        }
        cur = nxt; cA = nA; cB = nB; vC0 = vN0; vC1 = vN1; vC2 = vN2; vC3 = vN3; ++ui;
        if (wr == 1) GP_BAR;
    }
    GP_WAIT_V(0);
    GP_BAR;
#undef GP_UNI
#undef GP_SA
#undef GP_SB
#undef GP_STAGE2
#undef GP_DMA
#undef GP_STAGEB
#undef GP_VB
#undef GP_LDA
#undef GP_LDB
#undef GP_MMA
#undef GP_CAT8
#undef GP_WAIT_V
#undef GP_WAIT_L
#undef GP_BAR
#undef GP_SCHED
#undef GP_VOFF
}
#endif

template <class Epi, class Sched, bool GATHER = false, bool F8 = false>
__device__ __forceinline__ void gemm_phase(int tid, LAS unsigned char* lds, const Gemm g, const Sched& S, const Epi& E) {
#if FAST_GEMM
    gemm_phase_fast<Epi, Sched, GATHER, F8>(tid, lds, g, S, E);
#else
    (void)lds; gemm_phase_ref<Epi, Sched, GATHER>(tid, g, S, E);
#endif
}

#define EPI_ROW(ai, m) (u.pm * 256 + (ai) * 128 + wr * 64 + (m) * 16 + fr)
#define EPI_COL(bj) (u.pn * 256 + (bj) * 128 + wc * 32 + fq * 8)
__device__ __forceinline__ float dot4(f32x4 a) { return (a[0] * a[0] + a[1] * a[1]) + (a[2] * a[2] + a[3] * a[3]); }

struct EpiNull {
    __device__ __forceinline__ void operator()(const ACC_T, const Unit& u, int wr, int wc, int fr, int fq) const {
#pragma unroll
        for (int ai = 0; ai < 2; ++ai)
#pragma unroll
            for (int bj = 0; bj < 2; ++bj)
#pragma unroll
                for (int m = 0; m < 4; ++m) asm volatile("" :: "v"(acc[ai][bj][m][0]), "v"(acc[ai][bj][m][1]));
    }
};
struct EpiIn {
    bf16_t *QA, *KA, *VA, *QLAT, *KVLAT, *KB, *SA, *SB; float *SSQ, *SSKV; const float *gq, *gk, *cosA, *sinA, *cosB, *sinB;
    __device__ __forceinline__ void operator()(const ACC_T, const Unit& u, int wr, int wc, int fr, int fq) const {
        const int wb = u.pn * 4 + wc;
        if (wb < 10) {
            const bool isq = wb < 8; const int head = isq ? wb : wb - 8; const float* g = isq ? gq : gk; bf16_t* dst = isq ? QA : KA; const int dp = isq ? 512 : 128; const float qs = isq ? QSCALE_A : 1.f;
            const f32x4 g00 = *(const f32x4*)(g + 8 * fq), g01 = *(const f32x4*)(g + 8 * fq + 4), g10 = *(const f32x4*)(g + 32 + 8 * fq), g11 = *(const f32x4*)(g + 36 + 8 * fq);
#pragma unroll
            for (int ai = 0; ai < 2; ++ai)
#pragma unroll
                for (int m = 0; m < 4; ++m) {
                    const int r = EPI_ROW(ai, m), pos = r & (S - 1);
                    const f32x4 v00 = acc[ai][0][m][0], v01 = acc[ai][0][m][1], v10 = acc[ai][1][m][0], v11 = acc[ai][1][m][1];
                    float ss = (dot4(v00) + dot4(v01)) + (dot4(v10) + dot4(v11)); ss += __shfl_xor(ss, 16); ss += __shfl_xor(ss, 32);
                    const float rstd = rsqrtf(ss * (1.f / 64.f) + EPS);
                    const f32x4 y00 = v00 * rstd * g00, y01 = v01 * rstd * g01, y10 = v10 * rstd * g10, y11 = v11 * rstd * g11;
                    const f32x4 c0 = *(const f32x4*)(cosA + pos * 32 + 8 * fq), c1 = *(const f32x4*)(cosA + pos * 32 + 8 * fq + 4), s0 = *(const f32x4*)(sinA + pos * 32 + 8 * fq), s1 = *(const f32x4*)(sinA + pos * 32 + 8 * fq + 4);
                    const f32x4 o00 = (y00 * c0 - y10 * s0) * qs, o01 = (y01 * c1 - y11 * s1) * qs, o10 = (y10 * c0 + y00 * s0) * qs, o11 = (y11 * c1 + y01 * s1) * qs;
#if ATT_FP8_A
                    unsigned char* p8 = (unsigned char*)dst + (size_t)r * dp + head * 64 + 8 * fq;
                    st8(p8, pack8_fp8(o00, o01)); st8(p8 + 32, pack8_fp8(o10, o11));
#else
                    bf16_t* p = dst + (size_t)r * dp + head * 64 + 8 * fq;
                    st16(p, pack8(o00, o01)); st16((p + 32), pack8(o10, o11));
#endif
                }
        } else if (wb < 12) {
#pragma unroll
            for (int ai = 0; ai < 2; ++ai)
#pragma unroll
                for (int m = 0; m < 4; ++m) {
#if ATT_FP8_A
                    const int r = EPI_ROW(ai, m), sq = r & (S - 1), k = sq & 63, pos = 32 * ((k >> 2) & 1) + 16 * (k >> 5) + (k & 3) + 4 * ((k & 31) >> 3);
                    unsigned char* vtb = (unsigned char*)VA; const unsigned vo = (unsigned)(((r >> 12) * 2 + (wb - 10)) * 64 + 8 * fq) * S + (unsigned)((sq & ~63) + pos);
#pragma unroll
                    for (int bj = 0; bj < 2; ++bj)
#pragma unroll
                        for (int n = 0; n < 2; ++n) { const f32x4 x = acc[ai][bj][m][n]; const unsigned w = (unsigned)__builtin_amdgcn_cvt_pk_fp8_f32(x[2], x[3], __builtin_amdgcn_cvt_pk_fp8_f32(x[0], x[1], 0, false), true);
                            const unsigned qo = vo + (unsigned)(bj * 32 + 4 * n) * S;
                            vtb[qo] = (unsigned char)(w & 0xffu); vtb[qo + S] = (unsigned char)((w >> 8) & 0xffu); vtb[qo + 2 * S] = (unsigned char)((w >> 16) & 0xffu); vtb[qo + 3 * S] = (unsigned char)(w >> 24); }
#else
                    bf16_t* p = VA + (size_t)EPI_ROW(ai, m) * 128 + (wb - 10) * 64 + 8 * fq;
                    st16(p, pack8(acc[ai][0][m][0], acc[ai][0][m][1])); st16((p + 32), pack8(acc[ai][1][m][0], acc[ai][1][m][1]));
#endif
                }
        } else if (wb < 22) {
            const bool isq = wb < 18; const int idx = isq ? wb - 12 : wb - 18; bf16_t* dst = isq ? QLAT : KVLAT; const int dp = isq ? 384 : 256;
#pragma unroll
            for (int ai = 0; ai < 2; ++ai)
#pragma unroll
                for (int m = 0; m < 4; ++m) {
                    const int r = EPI_ROW(ai, m);
                    const f32x4 v00 = acc[ai][0][m][0], v01 = acc[ai][0][m][1], v10 = acc[ai][1][m][0], v11 = acc[ai][1][m][1];
                    float ss = (dot4(v00) + dot4(v01)) + (dot4(v10) + dot4(v11)); ss += __shfl_xor(ss, 16); ss += __shfl_xor(ss, 32);
                    if (fq == 0) { if (isq) SSQ[(size_t)r * 8 + idx] = ss; else SSKV[(size_t)r * 4 + idx] = ss; }
                    bf16_t* p = dst + (size_t)r * dp + idx * 64 + 8 * fq;
                    st16(p, pack8(v00, v01)); st16((p + 32), pack8(v10, v11));
                }
        } else if (wb == 22) {
            if (fq < 2) {
#pragma unroll
                for (int ai = 0; ai < 2; ++ai)
#pragma unroll
                    for (int m = 0; m < 4; ++m) {
                        const int r = EPI_ROW(ai, m), pos = r & (S - 1);
                        const f32x4 x10 = acc[ai][0][m][0], x11 = acc[ai][0][m][1], x20 = acc[ai][1][m][0], x21 = acc[ai][1][m][1];
                        const f32x4 c0 = *(const f32x4*)(cosB + pos * 16 + 8 * fq), c1 = *(const f32x4*)(cosB + pos * 16 + 8 * fq + 4), s0 = *(const f32x4*)(sinB + pos * 16 + 8 * fq), s1 = *(const f32x4*)(sinB + pos * 16 + 8 * fq + 4);
#if ATT_FP8_B
                        const u32x2 w1 = pack8_fp8(x10 * c0 - x20 * s0, x11 * c1 - x21 * s1), w2 = pack8_fp8(x20 * c0 + x10 * s0, x21 * c1 + x11 * s1);
                        unsigned char* p = (unsigned char*)KB + (size_t)r * 768 + 64 + 8 * fq;
#pragma unroll
                        for (int h = 0; h < 8; ++h) { st8(p + h * 96, w1); st8(p + h * 96 + 16, w2); }
#else
                        const u32x4 w1 = pack8(x10 * c0 - x20 * s0, x11 * c1 - x21 * s1), w2 = pack8(x20 * c0 + x10 * s0, x21 * c1 + x11 * s1);
                        bf16_t* p = KB + (size_t)r * 768 + 64 + 8 * fq;
#pragma unroll
                        for (int h = 0; h < 8; ++h) { st16((p + h * 96), w1); st16((p + h * 96 + 16), w2); }
#endif
                    }
            }
        } else if (wb == 23) {
        } else {
            const bool isa = wb < 40; const int idx = isa ? wb - 24 : wb - 40; unsigned char* dst = (unsigned char*)(isa ? SA : SB);
#pragma unroll
            for (int ai = 0; ai < 2; ++ai)
#pragma unroll
                for (int m = 0; m < 4; ++m) { unsigned char* p = dst + (size_t)EPI_ROW(ai, m) * 1024 + idx * 64 + 8 * fq;
#pragma unroll
                    for (int bj = 0; bj < 2; ++bj) { const f32x4 a = acc[ai][bj][m][0], b = acc[ai][bj][m][1]; u32x2 w;
                        w.x = (unsigned)__builtin_amdgcn_cvt_pk_fp8_f32(a[2], a[3], __builtin_amdgcn_cvt_pk_fp8_f32(a[0], a[1], 0, false), true);
                        w.y = (unsigned)__builtin_amdgcn_cvt_pk_fp8_f32(b[2], b[3], __builtin_amdgcn_cvt_pk_fp8_f32(b[0], b[1], 0, false), true);
                        st8((p + bj * 32), w); } }
        }
    }
};
__host__ __device__ __forceinline__ int src_col_in(int n) {
    const int pn = n >> 8, nl = n & 255, bj = nl >> 7, wc = (nl & 127) >> 5, p = nl & 31, wb = pn * 4 + wc, s = bj * 32 + p;
    if (wb < 8) return wb * 64 + s;
    if (wb < 10) return 512 + (wb - 8) * 64 + s;
    if (wb < 12) return 640 + (wb - 10) * 64 + s;
    if (wb < 18) return 768 + (wb - 12) * 64 + s;
    if (wb < 22) return 1152 + (wb - 18) * 64 + s;
    if (wb == 22) return p < 16 ? 1408 + bj * 16 + p : -1;
    if (wb == 23) return -1;
    if (wb < 40) return 1440 + (wb - 24) * 64 + s;
    return 2464 + (wb - 40) * 64 + s;
}
struct EpiQb {
    bf16_t* QB; const float *SSQ, *cosB, *sinB;
    __device__ __forceinline__ void operator()(const ACC_T, const Unit& u, int wr, int wc, int fr, int fq) const {
#pragma unroll
        for (int ai = 0; ai < 2; ++ai)
#pragma unroll
            for (int m = 0; m < 4; ++m) {
                const int r = EPI_ROW(ai, m), pos = r & (S - 1);
                const f32x4 sa = *(const f32x4*)(SSQ + (size_t)r * 8); const f32x2 sb = *(const f32x2*)(SSQ + (size_t)r * 8 + 4);
                const float rstd = rsqrtf((((sa[0] + sa[1]) + (sa[2] + sa[3])) + (sb[0] + sb[1])) * (1.f / 384.f) + EPS);
#pragma unroll
                for (int bj = 0; bj < 2; ++bj) {
                    f32x4 v0 = acc[ai][bj][m][0] * rstd, v1 = acc[ai][bj][m][1] * rstd;
                    const int c32 = u.pn * 8 + bj * 4 + wc;
                    if (c32 % 3 == 2) {
                        f32x4 o0, o1;
#pragma unroll
                        for (int j = 0; j < 4; ++j) { o0[j] = __shfl_xor(v0[j], 32); o1[j] = __shfl_xor(v1[j], 32); }
                        const int i0 = 8 * (fq & 1);
                        const f32x4 c0 = *(const f32x4*)(cosB + pos * 16 + i0), c1 = *(const f32x4*)(cosB + pos * 16 + i0 + 4), s0 = *(const f32x4*)(sinB + pos * 16 + i0), s1 = *(const f32x4*)(sinB + pos * 16 + i0 + 4);
                        if (fq < 2) { v0 = v0 * c0 - o0 * s0; v1 = v1 * c1 - o1 * s1; } else { v0 = v0 * c0 + o0 * s0; v1 = v1 * c1 + o1 * s1; }
                    }
#if ATT_FP8_B
                    st8((unsigned char*)QB + (size_t)r * 768 + EPI_COL(bj), pack8_fp8(v0 * QSCALE_B, v1 * QSCALE_B));
#else
                    st16((QB + (size_t)r * 768 + EPI_COL(bj)), pack8(v0 * QSCALE_B, v1 * QSCALE_B));
#endif
                }
            }
    }
};
struct EpiKvb {
    bf16_t *KB, *VB; const float* SSKV;
    __device__ __forceinline__ void operator()(const ACC_T, const Unit& u, int wr, int wc, int fr, int fq) const {
#pragma unroll
        for (int ai = 0; ai < 2; ++ai)
#pragma unroll
            for (int m = 0; m < 4; ++m) {
                const int r = EPI_ROW(ai, m);
                const f32x4 sa = *(const f32x4*)(SSKV + (size_t)r * 4);
                const float rstd = rsqrtf(((sa[0] + sa[1]) + (sa[2] + sa[3])) * (1.f / 256.f) + EPS);
#pragma unroll
                for (int bj = 0; bj < 2; ++bj) {
                    const int head = u.pn * 2 + bj, o = wc * 32 + fq * 8;
#if ATT_FP8_B
                    const f32x4 x0 = acc[ai][bj][m][0] * rstd, x1 = acc[ai][bj][m][1] * rstd;
                    if (wc < 2) st8((unsigned char*)KB + (size_t)r * 768 + head * 96 + o, pack8_fp8(x0, x1));
                    else {
                        const int sq = r & (S - 1), k = sq & 63, pos = 32 * ((k >> 2) & 1) + 16 * (k >> 5) + (k & 3) + 4 * ((k & 31) >> 3);
                        unsigned char* vtb = (unsigned char*)VB; const unsigned vo = (unsigned)(((r >> 12) * 8 + head) * 64 + (o - 64)) * S + (unsigned)((sq & ~63) + pos);
                        const u32x2 w = pack8_fp8(x0, x1);
                        vtb[vo] = (unsigned char)(w.x & 0xffu); vtb[vo + S] = (unsigned char)((w.x >> 8) & 0xffu); vtb[vo + 2 * S] = (unsigned char)((w.x >> 16) & 0xffu); vtb[vo + 3 * S] = (unsigned char)(w.x >> 24);
                        vtb[vo + 4 * S] = (unsigned char)(w.y & 0xffu); vtb[vo + 5 * S] = (unsigned char)((w.y >> 8) & 0xffu); vtb[vo + 6 * S] = (unsigned char)((w.y >> 16) & 0xffu); vtb[vo + 7 * S] = (unsigned char)(w.y >> 24);
                    }
#else
                    const u32x4 w = pack8(acc[ai][bj][m][0] * rstd, acc[ai][bj][m][1] * rstd);
                    if (wc < 2) st16((KB + (size_t)r * 768 + head * 96 + o), w); else st16((VB + (size_t)r * 512 + head * 64 + (o - 64)), w);
#endif
                }
            }
    }
};
template <int MODE> struct EpiProj {
    bf16_t* O; const bf16_t* gate;
    __device__ __forceinline__ void operator()(const ACC_T, const Unit& u, int wr, int wc, int fr, int fq) const {
#pragma unroll
        for (int ai = 0; ai < 2; ++ai)
#pragma unroll
            for (int m = 0; m < 4; ++m) {
                const int r = EPI_ROW(ai, m);
#pragma unroll
                for (int bj = 0; bj < 2; ++bj) {
                    const size_t off = (size_t)r * D + EPI_COL(bj);
                    const u32x2 gw = *(const u32x2*)((const unsigned char*)gate + off);
                    const f32x2 q0 = __builtin_amdgcn_cvt_pk_f32_fp8((int)gw.x, false), q1 = __builtin_amdgcn_cvt_pk_f32_fp8((int)gw.x, true), q2 = __builtin_amdgcn_cvt_pk_f32_fp8((int)gw.y, false), q3 = __builtin_amdgcn_cvt_pk_f32_fp8((int)gw.y, true);
                    const f32x4 g0 = {sigm(q0[0]), sigm(q0[1]), sigm(q1[0]), sigm(q1[1])}, g1 = {sigm(q2[0]), sigm(q2[1]), sigm(q3[0]), sigm(q3[1])};
                    f32x4 v0 = acc[ai][bj][m][0] * g0, v1 = acc[ai][bj][m][1] * g1;
                    if (MODE == 1) { f32x4 p0, p1; unpack8(*(const u32x4*)(O + off), p0, p1); v0 += p0; v1 += p1; }
                    if (MODE == 1) st16(O + off, pack8(v0, v1)); else *(u32x4*)(O + off) = pack8(v0, v1);
                }
            }
    }
};
struct EpiProjP {
    bf16_t* O; const unsigned char* SA; const unsigned char* SB;
    __device__ static __forceinline__ void gates(const unsigned char* G, size_t off, f32x4& g0, f32x4& g1) {
        const u32x2 gw = *(const u32x2*)(G + off);
        const f32x2 q0 = __builtin_amdgcn_cvt_pk_f32_fp8((int)gw.x, false), q1 = __builtin_amdgcn_cvt_pk_f32_fp8((int)gw.x, true), q2 = __builtin_amdgcn_cvt_pk_f32_fp8((int)gw.y, false), q3 = __builtin_amdgcn_cvt_pk_f32_fp8((int)gw.y, true);
        g0 = (f32x4){sigm(q0[0]), sigm(q0[1]), sigm(q1[0]), sigm(q1[1])}; g1 = (f32x4){sigm(q2[0]), sigm(q2[1]), sigm(q3[0]), sigm(q3[1])};
    }
    __device__ __forceinline__ void operator()(f32x4 (&acc)[2][2][4][2], const Unit& u, int wr, int wc, int fr, int fq) const {
#pragma unroll
        for (int ai = 0; ai < 2; ++ai)
#pragma unroll
            for (int m = 0; m < 4; ++m) {
                const int r = EPI_ROW(ai, m);
#pragma unroll
                for (int bj = 0; bj < 2; ++bj) {
                    const size_t off = (size_t)r * D + EPI_COL(bj);
                    f32x4 b0, b1; gates(SB, off, b0, b1);
#pragma unroll
                    for (int j = 0; j < 4; ++j) { b0[j] = fmaxf(b0[j], 9.094947e-13f); b1[j] = fmaxf(b1[j], 9.094947e-13f); }
                    if (u.be == 0) {
                        f32x4 a0, a1; gates(SA, off, a0, a1);
#pragma unroll
                        for (int j = 0; j < 4; ++j) { acc[ai][bj][m][0][j] *= a0[j] * __builtin_amdgcn_rcpf(b0[j]); acc[ai][bj][m][1][j] *= a1[j] * __builtin_amdgcn_rcpf(b1[j]); }
                    } else st16(O + off, pack8(acc[ai][bj][m][0] * b0, acc[ai][bj][m][1] * b1));
                }
            }
    }
};
template <> struct EpiTraits<EpiProjP> { static constexpr bool KEEP = true; };
struct EpiWo {
    const bf16_t* X; const float* modl; bf16_t* XO;
    __device__ __forceinline__ void operator()(const ACC_T, const Unit& u, int wr, int wc, int fr, int fq) const {
        const float* g1 = modl + (size_t)(u.pm >> 4) * 6 * D + 2 * D;
#pragma unroll
        for (int bj = 0; bj < 2; ++bj) {
            const int c = EPI_COL(bj); const f32x4 ga = *(const f32x4*)(g1 + c), gb = *(const f32x4*)(g1 + c + 4);
#pragma unroll
            for (int ai = 0; ai < 2; ++ai)
#pragma unroll
                for (int m = 0; m < 4; ++m) { const size_t off = (size_t)EPI_ROW(ai, m) * D + c;
                    f32x4 x0, x1; unpack8(*(const u32x4*)(X + off), x0, x1);
                    st16((XO + off), pack8(x0 + ga * acc[ai][bj][m][0], x1 + gb * acc[ai][bj][m][1])); }
        }
    }
};
struct EpiUp {
    bf16_t* ACT; float inscale;
    __device__ __forceinline__ void operator()(const ACC_T, const Unit& u, int wr, int wc, int fr, int fq) const {
#pragma unroll
        for (int ai = 0; ai < 2; ++ai)
#pragma unroll
            for (int m = 0; m < 4; ++m) {
                f32x4 a = acc[ai][0][m][0] * inscale, b = acc[ai][0][m][1] * inscale; const f32x4 c = acc[ai][1][m][0] * inscale, d = acc[ai][1][m][1] * inscale;
#pragma unroll
                for (int j = 0; j < 4; ++j) { a[j] = a[j] * sigm(a[j]) * c[j]; b[j] = b[j] * sigm(b[j]) * d[j]; }
#if MOE_FP8
                st8((unsigned char*)ACT + (size_t)EPI_ROW(ai, m) * FF + u.pn * 128 + wc * 32 + fq * 8, pack8_fp8(a * 8.f, b * 8.f));
#else
                st16((ACT + (size_t)EPI_ROW(ai, m) * FF + u.pn * 128 + wc * 32 + fq * 8), pack8(a, b));
#endif
            }
    }
};
struct EpiDown {
    bf16_t* Y2; const unsigned* list; const float* gw; float inscale;
    __device__ __forceinline__ void operator()(const ACC_T, const Unit& u, int wr, int wc, int fr, int fq) const {
#pragma unroll
        for (int ai = 0; ai < 2; ++ai)
#pragma unroll
            for (int m = 0; m < 4; ++m) {
                const int rloc = ai * 128 + wr * 64 + m * 16 + fr;
                if (rloc < u.nv) {
                    const unsigned entry = list[(size_t)u.be * T + u.rl * 256 + rloc]; const float w = gw[entry] * inscale;
#pragma unroll
                    for (int bj = 0; bj < 2; ++bj) { const f32x4 a = acc[ai][bj][m][0] * (w * 16.f), b = acc[ai][bj][m][1] * (w * 16.f); u32x2 q;
                        q.x = (unsigned)__builtin_amdgcn_cvt_pk_fp8_f32(a[2], a[3], __builtin_amdgcn_cvt_pk_fp8_f32(a[0], a[1], 0, false), true);
                        q.y = (unsigned)__builtin_amdgcn_cvt_pk_fp8_f32(b[2], b[3], __builtin_amdgcn_cvt_pk_fp8_f32(b[0], b[1], 0, false), true);
                        st8(((unsigned char*)Y2 + (size_t)entry * D + EPI_COL(bj)), q); }
                }
            }
    }
};
}

namespace at {
struct Tensors { const bf16_t* Q; int qp; const bf16_t* K; int kp; const bf16_t* V; int vp; bf16_t* O; int op; int group; };
__device__ __forceinline__ bool next_unit(int i, int vcu, int G, int& bh, int& qb) {
    int u;
    if (G == 256) { if (i >= 4) return false; u = (vcu >> 5) * 128 + i * 32 + (vcu & 31); }
    else { u = i * G + vcu; if (u >= 1024) return false; }
    bh = u >> 4; qb = u & 15; return true;
}
template <int DQK>
__device__ __forceinline__ void attn_phase_ref(int tid, const Tensors& A, int vcu, int G) {
    int bh, qb;
    for (int i = 0; next_unit(i, vcu, G, bh, qb); ++i) {
        const int b = bh >> 3, h = bh & 7, kvh = h / A.group;
        {
            const int dh = tid >> 8;
            const size_t row = (size_t)b * S + qb * 256 + (tid & 255);
            float q[DQK], o[32];
#pragma unroll
            for (int d = 0; d < DQK; ++d) q[d] = bf2f(A.Q[row * A.qp + h * DQK + d]);
#pragma unroll
            for (int d = 0; d < 32; ++d) o[d] = 0.f;
            float l = 0.f;
            for (int k = 0; k < S; ++k) {
                const bf16_t* kr = A.K + ((size_t)b * S + k) * A.kp + kvh * DQK; const bf16_t* vr = A.V + ((size_t)b * S + k) * A.vp + kvh * 64 + dh * 32;
                float sc = 0.f;
#pragma unroll
                for (int d = 0; d < DQK; d += 8) { f32x4 k0, k1; unpack8(*(const u32x4*)(kr + d), k0, k1);
                    sc += q[d] * k0[0] + q[d + 1] * k0[1] + q[d + 2] * k0[2] + q[d + 3] * k0[3] + q[d + 4] * k1[0] + q[d + 5] * k1[1] + q[d + 6] * k1[2] + q[d + 7] * k1[3]; }
                const float p = bf2f(cvt_pk_bf16(exp2f(sc), 0.f) & 0xffffu); l += p;
#pragma unroll
                for (int d = 0; d < 32; d += 8) { f32x4 v0, v1; unpack8(*(const u32x4*)(vr + d), v0, v1);
                    o[d] += p * v0[0]; o[d + 1] += p * v0[1]; o[d + 2] += p * v0[2]; o[d + 3] += p * v0[3]; o[d + 4] += p * v1[0]; o[d + 5] += p * v1[1]; o[d + 6] += p * v1[2]; o[d + 7] += p * v1[3]; }
            }
            const float il = 1.f / l;
            __syncthreads();
#pragma unroll
            for (int d = 0; d < 32; d += 8) { f32x4 a = {o[d] * il, o[d + 1] * il, o[d + 2] * il, o[d + 3] * il}, c = {o[d + 4] * il, o[d + 5] * il, o[d + 6] * il, o[d + 7] * il};
                *(u32x4*)(A.O + row * A.op + h * 64 + dh * 32 + d) = pack8(a, c); }
        }
    }
}
#if FAST_ATTN
typedef short s16x4 __attribute__((ext_vector_type(4)));
__device__ __forceinline__ unsigned cvtpk(float lo, float hi) { f32x2 v = {lo, hi}; bf16x2_t b = __builtin_convertvector(v, bf16x2_t); return __builtin_bit_cast(unsigned, b); }
__device__ __forceinline__ s16x4 vtr(const LAS unsigned char* p) { return __builtin_bit_cast(s16x4, __builtin_amdgcn_ds_read_tr16_b64_v4i16((LAS s16x4*)p)); }
__device__ __forceinline__ int crow(int r, int hi) { return (r & 3) + 8 * (r >> 2) + 4 * hi; }
#define AT_BAR() asm volatile("s_barrier" ::: "memory")
#define AT_WAITBAR(N) asm volatile("s_waitcnt vmcnt(" #N ") lgkmcnt(0)\n\ts_barrier" ::: "memory")
#define AT_SCHED() __builtin_amdgcn_sched_barrier(0)
__device__ __forceinline__ void glds16(const void* gsrc, unsigned lds_dst) { unsigned keep;
    asm volatile("s_mov_b32 %0, m0\n\ts_mov_b32 m0, %2\n\ts_nop 0\n\tglobal_load_lds_dwordx4 %1, off\n\ts_mov_b32 m0, %0" : "=&s"(keep) : "v"(gsrc), "s"(lds_dst) : "memory"); }
#define AT_GLDS(g, l) glds16((const void*)(g), (unsigned)__builtin_amdgcn_readfirstlane((int)(unsigned)(uintptr_t)(l)))
template <int DQK>
__device__ __forceinline__ void attn_unit(int tid, LAS unsigned char* lds, const Tensors& A, int b, int h, int qb) {
    constexpr int ND = DQK / 16, NCH = DQK / 8, KSLOT = NCH * 1024, NKD = NCH > 8 ? 2 : 1, VSLOT = 8192, NT = S / 64;
    constexpr int KOFF = 0, VOFF = 3 * KSLOT, OST = VOFF + 3 * VSLOT, WSF = OST + 8 * 4096;
    static_assert(WSF + 8 * 256 <= RING_BYTES, "attention LDS");
    const int lane = tid & 63, r32 = lane & 31, hi = lane >> 5, wid = __builtin_amdgcn_readfirstlane(tid >> 6);
    const int kvh = h / A.group; const size_t rowb = (size_t)b * S;
    const bf16_t* ksrc = A.K + (rowb + lane) * A.kp + kvh * DQK + wid * 8;
    const bf16_t* ksrc2 = A.K + (rowb + lane) * A.kp + kvh * DQK + (8 + (wid & 3)) * 8;
    const bf16_t* vsrc = A.V + (rowb + 16 * (wid & 3) + (lane >> 2)) * A.vp + kvh * 64 + (wid >> 2) * 32 + (lane & 3) * 8;
    const size_t ktile = (size_t)64 * A.kp, vtile = (size_t)64 * A.vp;
    LAS unsigned char* kdst = lds + KOFF + wid * 1024; LAS unsigned char* kdst2 = lds + KOFF + (8 + (wid & 3)) * 1024; LAS unsigned char* vdst = lds + VOFF + wid * 1024;
#define DMA_K(j, so) do { AT_GLDS(ksrc + (size_t)(j) * ktile, kdst + (so)); if (NKD == 2) AT_GLDS(ksrc2 + (size_t)(j) * ktile, kdst2 + (so)); } while (0)
#define DMA_V(j, so) AT_GLDS(vsrc + (size_t)(j) * vtile, vdst + (so))
    const LAS unsigned char* kp0 = lds + KOFF + hi * 1024 + r32 * 16;
    const LAS unsigned char* vp0 = lds + VOFF + ((lane >> 4) & 1) * 32 + (lane & 3) * 8 + (4 * hi + ((lane & 15) >> 2)) * 64;
    DMA_K(0, 0); DMA_V(0, 0); DMA_K(1, KSLOT); DMA_V(1, VSLOT); DMA_K(2, 2 * KSLOT);
    const bf16_t* Qw = A.Q + (rowb + qb * 256 + wid * 32 + r32) * A.qp + h * DQK + hi * 8;
    bf16x8 qr[ND];
#pragma unroll
    for (int d0 = 0; d0 < ND; ++d0) qr[d0] = *(const bf16x8*)(Qw + d0 * 16);
    asm volatile("s_waitcnt vmcnt(0)\n\ts_barrier" ::: "memory");
    bf16x8 kf[2 * ND]; s16x4 vlo[8], vhi[8];
#define KLOAD(so) do { _Pragma("unroll") for (int d0 = 0; d0 < ND; ++d0) { kf[2 * d0] = *(const LAS bf16x8*)(kp0 + (so) + d0 * 2048); kf[2 * d0 + 1] = *(const LAS bf16x8*)(kp0 + (so) + d0 * 2048 + 512); } } while (0)
#define VLOAD(so) do { _Pragma("unroll") for (int i = 0; i < 8; ++i) { vlo[i] = vtr(vp0 + (so) + (i >> 2) * 4096 + (i & 3) * 1024); vhi[i] = vtr(vp0 + (so) + (i >> 2) * 4096 + (i & 3) * 1024 + 512); } } while (0)
#define VFR(i) (bf16x8){vlo[i][0], vlo[i][1], vlo[i][2], vlo[i][3], vhi[i][0], vhi[i][1], vhi[i][2], vhi[i][3]}
    KLOAD(0);
    asm volatile("s_waitcnt lgkmcnt(0)" ::: "memory");
    if (PROBE_ATT != 5 && wid >= 4) AT_BAR();
    f32x16 o0 = {}, o1 = {}, C0, C1; u32x4 pw0, pw1, pw2, pw3; float lsum = 0.f;
    const f32x16 zero = {};
#define QK_BLOCK() do { C0 = __builtin_amdgcn_mfma_f32_32x32x16_bf16(kf[0], qr[0], zero, 0, 0, 0); C1 = __builtin_amdgcn_mfma_f32_32x32x16_bf16(kf[1], qr[0], zero, 0, 0, 0); \
        _Pragma("unroll") for (int d0 = 1; d0 < ND; ++d0) { C0 = __builtin_amdgcn_mfma_f32_32x32x16_bf16(kf[2 * d0], qr[d0], C0, 0, 0, 0); C1 = __builtin_amdgcn_mfma_f32_32x32x16_bf16(kf[2 * d0 + 1], qr[d0], C1, 0, 0, 0); } } while (0)
#define PAF(k) __builtin_bit_cast(bf16x8, pw##k)
#define PV_BLOCK() do { \
        o0 = __builtin_amdgcn_mfma_f32_32x32x16_bf16(PAF(0), VFR(0), o0, 0, 0, 0); o1 = __builtin_amdgcn_mfma_f32_32x32x16_bf16(PAF(0), VFR(4), o1, 0, 0, 0); \
        o0 = __builtin_amdgcn_mfma_f32_32x32x16_bf16(PAF(1), VFR(1), o0, 0, 0, 0); o1 = __builtin_amdgcn_mfma_f32_32x32x16_bf16(PAF(1), VFR(5), o1, 0, 0, 0); \
        o0 = __builtin_amdgcn_mfma_f32_32x32x16_bf16(PAF(2), VFR(2), o0, 0, 0, 0); o1 = __builtin_amdgcn_mfma_f32_32x32x16_bf16(PAF(2), VFR(6), o1, 0, 0, 0); \
        o0 = __builtin_amdgcn_mfma_f32_32x32x16_bf16(PAF(3), VFR(3), o0, 0, 0, 0); o1 = __builtin_amdgcn_mfma_f32_32x32x16_bf16(PAF(3), VFR(7), o1, 0, 0, 0); } while (0)
#define SOFTMAX() do { \
        _Pragma("unroll") for (int r = 0; r < 16; ++r) { C0[r] = __builtin_amdgcn_exp2f(C0[r]); C1[r] = __builtin_amdgcn_exp2f(C1[r]); } \
        f32x2 s0_ = {C0[0], C0[1]}, s1_ = {C1[0], C1[1]}; _Pragma("unroll") for (int r = 2; r < 16; r += 2) { s0_ += (f32x2){C0[r], C0[r + 1]}; s1_ += (f32x2){C1[r], C1[r + 1]}; } s0_ += s1_; lsum += s0_[0] + s0_[1]; \
        pw0 = (u32x4){cvtpk(C0[0], C0[1]), cvtpk(C0[2], C0[3]), cvtpk(C0[4], C0[5]), cvtpk(C0[6], C0[7])}; pw1 = (u32x4){cvtpk(C0[8], C0[9]), cvtpk(C0[10], C0[11]), cvtpk(C0[12], C0[13]), cvtpk(C0[14], C0[15])}; \
        pw2 = (u32x4){cvtpk(C1[0], C1[1]), cvtpk(C1[2], C1[3]), cvtpk(C1[4], C1[5]), cvtpk(C1[6], C1[7])}; pw3 = (u32x4){cvtpk(C1[8], C1[9]), cvtpk(C1[10], C1[11]), cvtpk(C1[12], C1[13]), cvtpk(C1[14], C1[15])}; } while (0)
    int ka = 2 * KSLOT, kb = 0, kc = KSLOT, va = 2 * VSLOT, vb = 0, vc = VSLOT;
#define ROT() do { const int t_ = ka; ka = kb; kb = kc; kc = t_; const int u_ = va; va = vb; vb = vc; vc = u_; } while (0)
#define PINP() asm volatile("" : "+v"(lsum) : "v"(pw0), "v"(pw1), "v"(pw2), "v"(pw3))
#if ATT_REGSTAGE
    u32x4 kst = {}, kst2 = {}, vst = {};
    const LAS unsigned char* kw = lds + KOFF + wid * 1024 + lane * 16; const LAS unsigned char* kw2 = lds + KOFF + (8 + (wid & 3)) * 1024 + lane * 16; const LAS unsigned char* vw = lds + VOFF + wid * 1024 + lane * 16;
#define ST_WRITE(WK, WV) do { if (WK) { *(LAS u32x4*)(kw + ka) = kst; if (NKD == 2 && wid < 4) *(LAS u32x4*)(kw2 + ka) = kst2; } if (WV) *(LAS u32x4*)(vw + vc) = vst; } while (0)
#define ST_LOAD(sv, IK, IV) do { if (IK) { kst = *(const u32x4*)(ksrc + (size_t)((sv) + 4) * ktile); if (NKD == 2 && wid < 4) kst2 = *(const u32x4*)(ksrc2 + (size_t)((sv) + 4) * ktile); } if (IV) vst = *(const u32x4*)(vsrc + (size_t)((sv) + 3) * vtile); } while (0)
#define STEP(sv, DOQK, DOPV, KL, VL, IK, IV, WK, WV) do { \
        AT_SCHED(); if (DOQK) QK_BLOCK(); if (DOPV) PV_BLOCK(); AT_SCHED(); \
        asm volatile("s_barrier\n\ts_nop 15\n\ts_nop 3" : "+v"(C0), "+v"(C1), "+v"(o0), "+v"(o1) :: "memory"); AT_SCHED(); \
        if (KL) KLOAD(kc); if (VL) VLOAD(vb); ST_WRITE(WK, WV); ST_LOAD(sv, IK, IV); \
        if (DOQK) { SOFTMAX(); PINP(); } AT_SCHED(); \
        asm volatile("s_waitcnt lgkmcnt(0)\n\ts_barrier" ::: "memory"); \
        AT_SCHED(); ROT(); } while (0)
    STEP(-1, true, false, true, true, true, true, false, false);
#pragma nounroll
    for (int s = 0; s < NT - 4; ++s) STEP(s, true, true, true, true, true, true, true, true);
    STEP(NT - 4, true, true, true, true, false, true, true, true);
    STEP(NT - 3, true, true, true, true, false, false, false, true);
    STEP(NT - 2, true, true, false, true, false, false, false, false);
    STEP(NT - 1, false, true, false, false, false, false, false, false);
#undef ST_WRITE
#undef ST_LOAD
#else
#define STEP(sv, DOQK, DOPV, KL, VL, IK, IV) do { \
        AT_SCHED(); if (DOQK) QK_BLOCK(); if (DOPV) PV_BLOCK(); AT_SCHED(); \
          \
        asm volatile("s_barrier\n\ts_nop 15\n\ts_nop 3" : "+v"(C0), "+v"(C1), "+v"(o0), "+v"(o1) :: "memory"); AT_SCHED(); \
        if (KL) KLOAD(kc); if (VL) VLOAD(vb); if (IK) DMA_K((sv) + 4, kb); if (IV) DMA_V((sv) + 3, va); \
        if (DOQK) { SOFTMAX(); PINP(); } AT_SCHED(); \
        if (IK) { if (NKD == 2) { AT_WAITBAR(3); } else { AT_WAITBAR(2); } } else if (IV) { AT_WAITBAR(1); } else { AT_WAITBAR(0); } \
        AT_SCHED(); ROT(); } while (0)
    STEP(-1, true, false, true, true, true, true);
#pragma nounroll
    for (int s = 0; s < NT - 4; ++s) STEP(s, true, true, true, true, true, true);
    STEP(NT - 4, true, true, true, true, false, true);
    STEP(NT - 3, true, true, true, true, false, false);
    STEP(NT - 2, true, true, false, true, false, false);
    STEP(NT - 1, false, true, false, false, false, false);
#endif
#undef STEP
#undef PINP
    if (PROBE_ATT != 5 && wid < 4) AT_BAR();
    { auto rr = __builtin_amdgcn_permlane32_swap(__float_as_uint(lsum), __float_as_uint(lsum), false, false); lsum = __uint_as_float(rr[0]) + __uint_as_float(rr[1]); }
    LAS float* wsf = (LAS float*)(lds + WSF + wid * 256);
    if (hi == 0) wsf[r32] = lsum;
    asm volatile("s_waitcnt lgkmcnt(0)" ::: "memory");
    LAS bf16_t* stg = (LAS bf16_t*)(lds + OST + wid * 4096);
#pragma unroll
    for (int r = 0; r < 16; ++r) { const int orow = crow(r, hi); const float rl = __builtin_amdgcn_rcpf(wsf[orow]);
        stg[orow * 64 + r32] = (bf16_t)(cvtpk(o0[r] * rl, 0.f) & 0xffffu); stg[orow * 64 + 32 + r32] = (bf16_t)(cvtpk(o1[r] * rl, 0.f) & 0xffffu); }
    asm volatile("s_waitcnt lgkmcnt(0)" ::: "memory");
    bf16_t* Ow = A.O + (rowb + qb * 256 + wid * 32) * A.op + h * 64;
#pragma unroll
    for (int i = 0; i < 4; ++i) { const int row = i * 8 + (lane >> 3), ch = lane & 7; const u32x4 v = *(const LAS u32x4*)(stg + row * 64 + ch * 8); st16((Ow + (size_t)row * A.op + ch * 8), v); }
    asm volatile("s_waitcnt lgkmcnt(0)\n\ts_barrier" ::: "memory");
#undef DMA_K
#undef DMA_V
#undef KLOAD
#undef VLOAD
#undef VFR
#undef QK_BLOCK
#undef PAF
#undef PV_BLOCK
#undef SOFTMAX
#undef ROT
}
#endif
#if FAST_ATTN && ATT_FP8_A
typedef int v8i __attribute__((ext_vector_type(8)));
__device__ __forceinline__ f32x16 mfma8(v8i a, v8i b, f32x16 c) { return __builtin_amdgcn_mfma_scale_f32_32x32x64_f8f6f4(a, b, c, 0, 0, 0, 0x7f7f7f7f, 0, 0x7f7f7f7f); }
__device__ __forceinline__ f32x16 mfma8pv(v8i a, v8i b, f32x16 c) { return __builtin_amdgcn_mfma_scale_f32_32x32x64_f8f6f4(a, b, c, 1, 0, 0, 0x7f7f7f7f, 0, 0x7f7f7f7f); }
__device__ __forceinline__ void attn_unit_f8a(int tid, LAS unsigned char* lds, const unsigned char* Q8, const unsigned char* K8, const unsigned char* VT8, bf16_t* O, int op, int b, int h, int qb, float bias) {
    constexpr int SL = 4096, NT = S / 64;
    constexpr int KOFF = 0, VOFF = 3 * SL, OST = VOFF + 3 * SL, WSF = OST + 8 * 4096;
    const int lane = tid & 63, r32 = lane & 31, hi = lane >> 5, wid = __builtin_amdgcn_readfirstlane(tid >> 6);
    const int kvh = h >> 2; const size_t rowb = (size_t)b * S; const bool kw = wid < 4;
    const unsigned char* src = kw ? K8 + (rowb + lane) * 128 + kvh * 64 + 16 * wid : VT8 + ((size_t)((b * 2 + kvh) * 64 + lane)) * S + 16 * (wid - 4);
    const size_t tstep = kw ? (size_t)64 * 128 : (size_t)64;
    LAS unsigned char* dst = lds + (kw ? KOFF + wid * 1024 : VOFF + (wid - 4) * 1024);
#define DMA8(j, so) AT_GLDS(src + (size_t)(j) * tstep, dst + (so))
    const LAS unsigned char* kp0 = lds + KOFF + (2 * hi) * 1024 + r32 * 16;
    const LAS unsigned char* vp0 = lds + VOFF + (2 * hi) * 1024 + r32 * 16;
    if (kw) { DMA8(0, 0); DMA8(1, SL); DMA8(2, 2 * SL); } else { DMA8(0, 0); DMA8(1, SL); }
    v8i qf; { const unsigned char* Qw = Q8 + (rowb + qb * 256 + wid * 32 + r32) * 512 + h * 64 + 32 * hi; const u32x4 a = *(const u32x4*)Qw, c = *(const u32x4*)(Qw + 16);
        qf = (v8i){(int)a.x, (int)a.y, (int)a.z, (int)a.w, (int)c.x, (int)c.y, (int)c.z, (int)c.w}; }
    asm volatile("s_waitcnt vmcnt(0)\n\ts_barrier" ::: "memory");
    v8i kf0, kf1, vf0, vf1, p8;
#define LD32(dstv, p) do { const u32x4 a_ = *(const LAS u32x4*)(p), c_ = *(const LAS u32x4*)((p) + 1024); dstv = (v8i){(int)a_.x, (int)a_.y, (int)a_.z, (int)a_.w, (int)c_.x, (int)c_.y, (int)c_.z, (int)c_.w}; } while (0)
#define KLOAD8(so) do { LD32(kf0, kp0 + (so)); LD32(kf1, kp0 + (so) + 512); } while (0)
#define VLOAD8(so) do { LD32(vf0, vp0 + (so)); LD32(vf1, vp0 + (so) + 512); } while (0)
    KLOAD8(0);
    asm volatile("s_waitcnt lgkmcnt(0)" ::: "memory");
    if (wid >= 4) AT_BAR();
    f32x16 o0 = {}, o1 = {}, o2 = {}, C0, C1;
    const v8i ones = {0x38383838, 0x38383838, 0x38383838, 0x38383838, 0x38383838, 0x38383838, 0x38383838, 0x38383838};
    f32x16 negb;
#pragma unroll
    for (int r = 0; r < 16; ++r) negb[r] = bias;
    asm volatile("" : "+v"(negb));
#define SOFTMAX8() do { \
        _Pragma("unroll") for (int i = 0; i < 4; ++i) { \
            const f32x2 a_ = (f32x2){C0[4 * i], C0[4 * i + 1]} * 4.f + 60.26f, b_ = (f32x2){C0[4 * i + 2], C0[4 * i + 3]} * 4.f + 60.26f, c_ = (f32x2){C1[4 * i], C1[4 * i + 1]} * 4.f + 60.26f, d_ = (f32x2){C1[4 * i + 2], C1[4 * i + 3]} * 4.f + 60.26f; \
            p8[i] = (int)__builtin_amdgcn_cvt_pk_u8_f32(b_[1], 3, __builtin_amdgcn_cvt_pk_u8_f32(b_[0], 2, __builtin_amdgcn_cvt_pk_u8_f32(a_[1], 1, __builtin_amdgcn_cvt_pk_u8_f32(a_[0], 0, 0u)))); \
            p8[4 + i] = (int)__builtin_amdgcn_cvt_pk_u8_f32(d_[1], 3, __builtin_amdgcn_cvt_pk_u8_f32(d_[0], 2, __builtin_amdgcn_cvt_pk_u8_f32(c_[1], 1, __builtin_amdgcn_cvt_pk_u8_f32(c_[0], 0, 0u)))); } } while (0)
    int oa = 2 * SL, ob = 0, oc = SL;
#define ROT8() do { const int t_ = oa; oa = ob; ob = oc; oc = t_; } while (0)
#define STEP8(sv, DOQK, DOPV, KL, VL, IK, IV) do { \
        AT_SCHED(); if (DOQK) { C0 = mfma8(kf0, qf, negb); C1 = mfma8(kf1, qf, negb); } if (DOPV) { o0 = mfma8pv(p8, vf0, o0); o1 = mfma8pv(p8, vf1, o1); o2 = mfma8pv(p8, ones, o2); } AT_SCHED(); \
        asm volatile("s_barrier\n\ts_nop 15\n\ts_nop 15" : "+v"(C0), "+v"(C1), "+v"(o0), "+v"(o1), "+v"(o2) :: "memory"); AT_SCHED(); \
        if (KL) KLOAD8(oc); if (VL) VLOAD8(ob); \
        const bool iss_ = kw ? (IK) : (IV); if (iss_) { if (kw) DMA8((sv) + 4, ob); else DMA8((sv) + 3, oa); } \
        if (DOQK) { SOFTMAX8(); asm volatile("" :: "v"(p8)); } AT_SCHED(); \
        if (iss_) { AT_WAITBAR(1); } else { AT_WAITBAR(0); } \
        AT_SCHED(); ROT8(); } while (0)
    STEP8(-1, true, false, true, true, true, true);
#pragma nounroll
    for (int s = 0; s < NT - 4; ++s) STEP8(s, true, true, true, true, true, true);
    STEP8(NT - 4, true, true, true, true, false, true);
    STEP8(NT - 3, true, true, true, true, false, false);
    STEP8(NT - 2, true, true, false, true, false, false);
    STEP8(NT - 1, false, true, false, false, false, false);
    if (wid < 4) AT_BAR();
    LAS bf16_t* stg = (LAS bf16_t*)(lds + OST + wid * 4096);
#pragma unroll
    for (int r = 0; r < 16; ++r) { const int orow = crow(r, hi); const float rl = __builtin_amdgcn_rcpf(o2[r]);
        stg[orow * 64 + r32] = (bf16_t)(cvtpk(o0[r] * rl, 0.f) & 0xffffu); stg[orow * 64 + 32 + r32] = (bf16_t)(cvtpk(o1[r] * rl, 0.f) & 0xffffu); }
    asm volatile("s_waitcnt lgkmcnt(0)" ::: "memory");
    bf16_t* Ow = O + (rowb + qb * 256 + wid * 32) * op + h * 64;
#pragma unroll
    for (int i = 0; i < 4; ++i) { const int row = i * 8 + (lane >> 3), ch = lane & 7; const u32x4 v = *(const LAS u32x4*)(stg + row * 64 + ch * 8); st16(Ow + (size_t)row * op + ch * 8, v); }
    asm volatile("s_waitcnt lgkmcnt(0)\n\ts_barrier" ::: "memory");
#undef DMA8
#undef LD32
#undef KLOAD8
#undef VLOAD8
#undef SOFTMAX8
#undef ROT8
#undef STEP8
}
__device__ __forceinline__ void attn_phase_f8a(int tid, LAS unsigned char* lds, const unsigned char* Q8, const unsigned char* K8, const unsigned char* VT8, bf16_t* O, int op, const float* gq, const float* gk, int vcu, int G) {
    float mq = 0.f, mk = 0.f;
    for (int i = 0; i < 64; ++i) { mq = fmaxf(mq, fabsf(gq[i])); mk = fmaxf(mk, fabsf(gk[i])); }
    const float bias = -fmaxf(64.f * mq * mk * QSCALE_A * 1.13f - 15.5f, 0.f);
    int bh, qb;
    for (int i = 0; next_unit(i, vcu, G, bh, qb); ++i) attn_unit_f8a(tid, lds, Q8, K8, VT8, O, op, bh >> 3, bh & 7, qb, bias);
}
#endif
#if FAST_ATTN && ATT_FP8_B
__device__ __forceinline__ void attn_unit_f8b(int tid, LAS unsigned char* lds, const unsigned char* Q8, const unsigned char* K8, const unsigned char* VT8, bf16_t* O, int op, int b, int h, int qb) {
    constexpr int SLK = 6144, SLV = 4096, NT = S / 64;
    constexpr int KOFF = 0, VOFF = 3 * SLK, OST = VOFF + 3 * SLV, WSF = OST + 8 * 4096;
    static_assert(WSF + 2048 <= RING_BYTES, "attention LDS");
    const int lane = tid & 63, r32 = lane & 31, hi = lane >> 5, wid = __builtin_amdgcn_readfirstlane(tid >> 6);
    const size_t rowb = (size_t)b * S; const bool kw = wid < 6, vw = wid >= 4;
    const unsigned char* ksrc = K8 + (rowb + lane) * 768 + h * 96 + 16 * wid;
    const unsigned char* vsrc = VT8 + ((size_t)((b * 8 + h) * 64 + lane)) * S + 16 * (wid - 4);
    LAS unsigned char* kdst = lds + KOFF + wid * 1024; LAS unsigned char* vdst = lds + VOFF + (wid - 4) * 1024;
#define DMAK(j, so) AT_GLDS(ksrc + (size_t)(j) * (64 * 768), kdst + (so))
#define DMAV(j, so) AT_GLDS(vsrc + (size_t)(j) * 64, vdst + (so))
    const LAS unsigned char* kp0 = lds + KOFF + (2 * hi) * 1024 + r32 * 16;
    const LAS unsigned char* kr0 = lds + KOFF + 4 * 1024 + r32 * 16;
    const LAS unsigned char* vp0 = lds + VOFF + (2 * hi) * 1024 + r32 * 16;
    if (kw) { DMAK(0, 0); DMAK(1, SLK); DMAK(2, 2 * SLK); }
    if (vw) { DMAV(0, 0); DMAV(1, SLV); }
    v8i qn, qr;
    { const unsigned char* Qw = Q8 + (rowb + qb * 256 + wid * 32 + r32) * 768 + h * 96; const u32x4 a = *(const u32x4*)(Qw + 32 * hi), c = *(const u32x4*)(Qw + 32 * hi + 16), e = *(const u32x4*)(Qw + 64), f = *(const u32x4*)(Qw + 80);
      qn = (v8i){(int)a.x, (int)a.y, (int)a.z, (int)a.w, (int)c.x, (int)c.y, (int)c.z, (int)c.w};
      qr = hi ? (v8i){0, 0, 0, 0, 0, 0, 0, 0} : (v8i){(int)e.x, (int)e.y, (int)e.z, (int)e.w, (int)f.x, (int)f.y, (int)f.z, (int)f.w}; }
    asm volatile("s_waitcnt vmcnt(0)\n\ts_barrier" ::: "memory");
    v8i kn0, kn1, kr0v, kr1v, vf0, vf1, p8;
#define LD32(dstv, p) do { const u32x4 a_ = *(const LAS u32x4*)(p), c_ = *(const LAS u32x4*)((p) + 1024); dstv = (v8i){(int)a_.x, (int)a_.y, (int)a_.z, (int)a_.w, (int)c_.x, (int)c_.y, (int)c_.z, (int)c_.w}; } while (0)
#define KLOAD8(so) do { LD32(kn0, kp0 + (so)); LD32(kn1, kp0 + (so) + 512); LD32(kr0v, kr0 + (so)); LD32(kr1v, kr0 + (so) + 512); } while (0)
#define VLOAD8(so) do { LD32(vf0, vp0 + (so)); LD32(vf1, vp0 + (so) + 512); } while (0)
    KLOAD8(0);
    asm volatile("s_waitcnt lgkmcnt(0)" ::: "memory");
    if (wid >= 4) AT_BAR();
    f32x16 o0 = {}, o1 = {}, o2 = {}, C0, C1; const f32x16 zero = {};
    const v8i ones = {0x38383838, 0x38383838, 0x38383838, 0x38383838, 0x38383838, 0x38383838, 0x38383838, 0x38383838};
#define SOFTMAX8() do { \
        _Pragma("unroll") for (int i = 0; i < 4; ++i) { \
            const f32x2 a_ = (f32x2){C0[4 * i], C0[4 * i + 1]} * 4.f + 60.26f, b_ = (f32x2){C0[4 * i + 2], C0[4 * i + 3]} * 4.f + 60.26f, c_ = (f32x2){C1[4 * i], C1[4 * i + 1]} * 4.f + 60.26f, d_ = (f32x2){C1[4 * i + 2], C1[4 * i + 3]} * 4.f + 60.26f; \
            p8[i] = (int)__builtin_amdgcn_cvt_pk_u8_f32(b_[1], 3, __builtin_amdgcn_cvt_pk_u8_f32(b_[0], 2, __builtin_amdgcn_cvt_pk_u8_f32(a_[1], 1, __builtin_amdgcn_cvt_pk_u8_f32(a_[0], 0, 0u)))); \
            p8[4 + i] = (int)__builtin_amdgcn_cvt_pk_u8_f32(d_[1], 3, __builtin_amdgcn_cvt_pk_u8_f32(d_[0], 2, __builtin_amdgcn_cvt_pk_u8_f32(c_[1], 1, __builtin_amdgcn_cvt_pk_u8_f32(c_[0], 0, 0u)))); } } while (0)
    int ka = 2 * SLK, kb = 0, kc = SLK, va = 2 * SLV, vb = 0, vc = SLV;
#define ROT8() do { const int t_ = ka; ka = kb; kb = kc; kc = t_; const int u_ = va; va = vb; vb = vc; vc = u_; } while (0)
#define STEP8(sv, DOQK, DOPV, KL, VL, IK, IV) do { \
        AT_SCHED(); if (DOQK) { C0 = mfma8(kn0, qn, zero); C1 = mfma8(kn1, qn, zero); C0 = mfma8(kr0v, qr, C0); C1 = mfma8(kr1v, qr, C1); } if (DOPV) { o0 = mfma8pv(p8, vf0, o0); o1 = mfma8pv(p8, vf1, o1); o2 = mfma8pv(p8, ones, o2); } AT_SCHED(); \
        asm volatile("s_barrier\n\ts_nop 15\n\ts_nop 15" : "+v"(C0), "+v"(C1), "+v"(o0), "+v"(o1), "+v"(o2) :: "memory"); AT_SCHED(); \
        if (KL) KLOAD8(kc); if (VL) VLOAD8(vb); \
        const bool ik_ = kw && (IK), iv_ = vw && (IV); if (ik_) DMAK((sv) + 4, kb); if (iv_) DMAV((sv) + 3, va); \
        if (DOQK) { SOFTMAX8(); asm volatile("" :: "v"(p8)); } AT_SCHED(); \
        if (ik_ && iv_) { AT_WAITBAR(2); } else if (ik_ || iv_) { AT_WAITBAR(1); } else { AT_WAITBAR(0); } \
        AT_SCHED(); ROT8(); } while (0)
    STEP8(-1, true, false, true, true, true, true);
#pragma nounroll
    for (int s = 0; s < NT - 4; ++s) STEP8(s, true, true, true, true, true, true);
    STEP8(NT - 4, true, true, true, true, false, true);
    STEP8(NT - 3, true, true, true, true, false, false);
    STEP8(NT - 2, true, true, false, true, false, false);
    STEP8(NT - 1, false, true, false, false, false, false);
    if (wid < 4) AT_BAR();
    LAS bf16_t* stg = (LAS bf16_t*)(lds + OST + wid * 4096);
#pragma unroll
    for (int r = 0; r < 16; ++r) { const int orow = crow(r, hi); const float rl = __builtin_amdgcn_rcpf(o2[r]);
        stg[orow * 64 + r32] = (bf16_t)(cvtpk(o0[r] * rl, 0.f) & 0xffffu); stg[orow * 64 + 32 + r32] = (bf16_t)(cvtpk(o1[r] * rl, 0.f) & 0xffffu); }
    asm volatile("s_waitcnt lgkmcnt(0)" ::: "memory");
    bf16_t* Ow = O + (rowb + qb * 256 + wid * 32) * op + h * 64;
#pragma unroll
    for (int i = 0; i < 4; ++i) { const int row = i * 8 + (lane >> 3), ch = lane & 7; const u32x4 v = *(const LAS u32x4*)(stg + row * 64 + ch * 8); st16(Ow + (size_t)row * op + ch * 8, v); }
    asm volatile("s_waitcnt lgkmcnt(0)\n\ts_barrier" ::: "memory");
#undef DMAK
#undef DMAV
#undef LD32
#undef KLOAD8
#undef VLOAD8
#undef SOFTMAX8
#undef ROT8
#undef STEP8
}
__device__ __forceinline__ void attn_phase_f8b(int tid, LAS unsigned char* lds, const unsigned char* Q8, const unsigned char* K8, const unsigned char* VT8, bf16_t* O, int op, int vcu, int G) {
    int bh, qb;
    for (int i = 0; next_unit(i, vcu, G, bh, qb); ++i) attn_unit_f8b(tid, lds, Q8, K8, VT8, O, op, bh >> 3, bh & 7, qb);
}
#endif
template <int DQK>
__device__ __forceinline__ void attn_phase(int tid, LAS unsigned char* lds, const Tensors& A, int vcu, int G) {
#if FAST_ATTN
    int bh, qb;
    for (int i = 0; next_unit(i, vcu, G, bh, qb); ++i) attn_unit<DQK>(tid, lds, A, bh >> 3, bh & 7, qb);
#else
    (void)lds; attn_phase_ref<DQK>(tid, A, vcu, G);
#endif
}
}


struct Args { const float* in[22]; float* out; unsigned char* ws; int ph_lo, ph_hi; };
struct Frame {
    LAS unsigned char* lds; volatile LAS unsigned* MISC; unsigned* ctl;
    int tid, lane, wave, vcu, G;
    unsigned char* ws; float* OUT;
};

__device__ __forceinline__ void p0_phase(Frame& F, const float* c, const float* w_ada, const float* b_ada) {
    LAS float* cs = (LAS float*)F.lds;
    LAS float* red = (LAS float*)(F.lds + 32768);
    for (int i = F.tid; i < NB * D; i += NTHREADS) { const float v = c[i]; cs[i] = v / (1.f + __expf(-v)); }
    __syncthreads();
    float* mod = (float*)(F.ws + WS_MOD);
    const int kq = F.wave, col = F.lane;
    for (int item = F.vcu; item < NL * 6 * D / 64; item += F.G) {
        const int l = item / (6 * D / 64), n0 = (item % (6 * D / 64)) * 64;
        const float* w = w_ada + (size_t)l * D * 6 * D + n0 + col;
        float acc[NB];
#pragma unroll
        for (int b = 0; b < NB; ++b) acc[b] = 0.f;
#pragma unroll 8
        for (int k = kq * 128; k < kq * 128 + 128; ++k) { const float wv = w[(size_t)k * 6 * D];
#pragma unroll
            for (int b = 0; b < NB; ++b) acc[b] += cs[b * D + k] * wv; }
#pragma unroll
        for (int b = 0; b < NB; ++b) red[(kq * NB + b) * 64 + col] = acc[b];
        __syncthreads();
        { const int b = F.wave; float s = 0.f;
#pragma unroll
          for (int q = 0; q < 8; ++q) s += red[(q * NB + b) * 64 + col];
          mod[((size_t)l * NB + b) * 6 * D + n0 + col] = s + b_ada[(size_t)l * 6 * D + n0 + col]; }
        __syncthreads();
    }
    float* cosA = (float*)(F.ws + WS_COSA); float* sinA = (float*)(F.ws + WS_SINA); float* cosB = (float*)(F.ws + WS_COSB); float* sinB = (float*)(F.ws + WS_SINB);
    for (int idx = F.vcu * NTHREADS + F.tid; idx < S * 48; idx += F.G * NTHREADS) {
        const int s = idx / 48, i = idx % 48; const float row = (float)(s >> 6), col2 = (float)(s & 63);
        if (i < 32) { const int j = i & 15; const float a = (i < 16 ? row : col2) * (1.0f / powf(10000.0f, (float)j / 16.0f)); cosA[s * 32 + i] = cosf(a); sinA[s * 32 + i] = sinf(a); }
        else { const int ii = i - 32, j = ii & 7; const float a = (ii < 8 ? row : col2) * (1.0f / powf(10000.0f, (float)j / 8.0f)); cosB[s * 16 + ii] = cosf(a); sinB[s * 16 + ii] = sinf(a); }
    }
}

template <class SrcFn>
__device__ __forceinline__ void cvt_item(const float* W, int K, int Nsrc, const float* kg, bf16_t* WT, LAS float* scr, int item, int nblk, int lane, const SrcFn& src, float f8scale = 0.f) {
    const int kb = item / nblk, nb = item % nblk, k0 = 64 * kb, n0 = 32 * nb;
    const int sc = src(n0 + (lane & 31));
#pragma unroll
    for (int i = 0; i < 32; ++i) { const int kk = 2 * i + (lane >> 5); float v = sc >= 0 ? W[(size_t)(k0 + kk) * Nsrc + sc] : 0.f; if (kg) v *= kg[k0 + kk]; scr[kk * 33 + (lane & 31)] = v; }
    LDS_WAIT(); asm volatile("" ::: "memory");
    const int c = lane & 7;
    if (f8scale != 0.f) {
#pragma unroll
        for (int j = 0; j < 4; ++j) { const int n = (lane >> 3) + 8 * j; const LAS float* sp = scr + (8 * c) * 33 + n;
            const u32x2 o = pack8_fp8((f32x4){sp[0 * 33], sp[1 * 33], sp[2 * 33], sp[3 * 33]} * f8scale, (f32x4){sp[4 * 33], sp[5 * 33], sp[6 * 33], sp[7 * 33]} * f8scale);
            *(u32x2*)((unsigned char*)WT + (size_t)(n0 + n) * K + k0 + 8 * c) = o; }
    } else {
#pragma unroll
    for (int j = 0; j < 4; ++j) { const int n = (lane >> 3) + 8 * j; const LAS float* s = scr + (8 * c) * 33 + n;
        u32x4 o; o.x = cvt_pk_bf16(s[0 * 33], s[1 * 33]); o.y = cvt_pk_bf16(s[2 * 33], s[3 * 33]); o.z = cvt_pk_bf16(s[4 * 33], s[5 * 33]); o.w = cvt_pk_bf16(s[6 * 33], s[7 * 33]);
        *(u32x4*)(WT + (size_t)(n0 + n) * K + k0 + 8 * c) = o; }
    }
    LDS_WAIT(); asm volatile("" ::: "memory");
}
struct SrcId { __device__ int operator()(int n) const { return n; } };
struct SrcIn { __device__ int operator()(int n) const { return gp::src_col_in(n); } };
typedef __attribute__((address_space(4))) const Args CArgsW;
__device__ __forceinline__ void convert_weights(Frame& F, CArgsW* a, int l) {
    LAS float* scr = (LAS float*)(F.lds + F.wave * 16384);
    const int gw = F.vcu * NWAVES + F.wave, NGW = F.G * NWAVES;
    const float* w_in = ((const float*)(GAS const float*)a->in[5]) + (size_t)l * D * INC; const float* w_q_b = ((const float*)(GAS const float*)a->in[10]) + (size_t)l * 384 * 768; const float* w_kv_b = ((const float*)(GAS const float*)a->in[11]) + (size_t)l * 256 * 1024;
    const float* w_pa = ((const float*)(GAS const float*)a->in[12]) + (size_t)l * 512 * D; const float* w_pb = ((const float*)(GAS const float*)a->in[13]) + (size_t)l * 512 * D; const float* w_o = ((const float*)(GAS const float*)a->in[14]) + (size_t)l * D * D;
    const float* w1 = ((const float*)(GAS const float*)a->in[18]) + (size_t)l * NE * D * FF; const float* w3 = ((const float*)(GAS const float*)a->in[19]) + (size_t)l * NE * D * FF; const float* w2 = ((const float*)(GAS const float*)a->in[20]) + (size_t)l * NE * FF * D;
    const float* gqa = ((const float*)(GAS const float*)a->in[8]) + l * 384; const float* gkv = ((const float*)(GAS const float*)a->in[9]) + l * 256;
    bf16_t* Win = (bf16_t*)(F.ws + WS_WIN); bf16_t* Wqb = (bf16_t*)(F.ws + WS_WQB); bf16_t* Wkvb = (bf16_t*)(F.ws + WS_WKVB); bf16_t* Wpa = (bf16_t*)(F.ws + WS_WPA); bf16_t* Wpb = (bf16_t*)(F.ws + WS_WPB);
    bf16_t* Wo = (bf16_t*)(F.ws + WS_WO); bf16_t* W13 = (bf16_t*)(F.ws + WS_W13); bf16_t* W2 = (bf16_t*)(F.ws + WS_W2);
    constexpr int I_IN = (D / 64) * (NIN / 32), I_QB = (384 / 64) * (768 / 32), I_KVB = (256 / 64) * (1024 / 32), I_P = (512 / 64) * (D / 32), I_O = (D / 64) * (D / 32);
    constexpr int I_13 = (D / 64) * (1024 / 32), I_2 = (FF / 64) * (D / 32);
    constexpr int NITEMS = I_IN + I_QB + I_KVB + 2 * I_P + I_O + NE * (I_13 + I_2);
    for (int it = gw; it < NITEMS; it += NGW) {
        int r = it;
        if (r < I_IN) { cvt_item(w_in, D, INC, nullptr, Win, scr, r, NIN / 32, F.lane, SrcIn()); continue; } r -= I_IN;
        if (r < I_QB) { cvt_item(w_q_b, 384, 768, gqa, Wqb, scr, r, 768 / 32, F.lane, SrcId()); continue; } r -= I_QB;
        if (r < I_KVB) { cvt_item(w_kv_b, 256, 1024, gkv, Wkvb, scr, r, 1024 / 32, F.lane, SrcId()); continue; } r -= I_KVB;
        if (r < I_P) { cvt_item(w_pa, 512, D, nullptr, Wpa, scr, r, D / 32, F.lane, SrcId()); continue; } r -= I_P;
        if (r < I_P) { cvt_item(w_pb, 512, D, nullptr, Wpb, scr, r, D / 32, F.lane, SrcId()); continue; } r -= I_P;
        if (r < I_O) { cvt_item(w_o, D, D, nullptr, Wo, scr, r, D / 32, F.lane, SrcId()); continue; } r -= I_O;
        if (r < NE * I_13) { const int e = r / I_13, q = r % I_13, nb = q % 32;
            const float* src = ((nb & 7) < 4 ? w1 : w3) + (size_t)e * D * FF; const int cb = (nb >> 3) * 128 + (nb & 3) * 32;
            struct SrcOff { int n0, cb; __device__ int operator()(int n) const { return cb + (n - n0); } } so{nb * 32, cb};
            if (MOE_FP8) cvt_item(src, D, FF, nullptr, (bf16_t*)((unsigned char*)W13 + (size_t)e * 1024 * D), scr, q, 32, F.lane, so, 16.f);
            else cvt_item(src, D, FF, nullptr, W13 + (size_t)e * 1024 * D, scr, q, 32, F.lane, so);
            continue; } r -= NE * I_13;
        { const int e = r / I_2, q = r % I_2;
          if (MOE_FP8) cvt_item(w2 + (size_t)e * FF * D, FF, D, nullptr, (bf16_t*)((unsigned char*)W2 + (size_t)e * D * FF), scr, q, D / 32, F.lane, SrcId(), 16.f);
          else cvt_item(w2 + (size_t)e * FF * D, FF, D, nullptr, W2 + (size_t)e * D * FF, scr, q, D / 32, F.lane, SrcId()); }
    }
}

template <int MODE>
__device__ __forceinline__ void row_phase(Frame& F, const float* xin, const float* g2prev, const float* gain, const float* modl, int sh_off, int sc_off, bf16_t* H, bf16_t* XB, float* OUT) {
    constexpr int RB = 4, RPW = T / (256 * NWAVES);
    const int gw = F.vcu * NWAVES + F.wave, b = (gw * RPW) >> 12;
    const bf16_t* Y2 = (const bf16_t*)(F.ws + WS_Y2);
    f32x4 gs[4], shv[4], g2v[4];
#pragma unroll
    for (int j = 0; j < 4; ++j) { const int c = 4 * F.lane + 256 * j; gs[j] = *(const f32x4*)(gain + c);
        if (MODE != 2) { gs[j] = gs[j] * (1.f + *(const f32x4*)(modl + (size_t)b * 6 * D + sc_off + c)); shv[j] = *(const f32x4*)(modl + (size_t)b * 6 * D + sh_off + c); }
        if (MODE != 0) g2v[j] = *(const f32x4*)(g2prev + (size_t)b * 6 * D + 5 * D + c); }
    for (int m0 = gw * RPW; m0 < gw * RPW + RPW; m0 += RB) {
        f32x4 v[RB][4]; float ss[RB];
        if (MODE == 0) {
#pragma unroll
            for (int r = 0; r < RB; ++r)
#pragma unroll
                for (int j = 0; j < 4; ++j) v[r][j] = *(const f32x4*)(xin + (size_t)(m0 + r) * D + 4 * F.lane + 256 * j);
        } else {
            unsigned ya[RB][4], yb[RB][4];
#pragma unroll
            for (int r = 0; r < RB; ++r)
#pragma unroll
                for (int j = 0; j < 4; ++j) { const int m = m0 + r, c = 4 * F.lane + 256 * j;
                    { const u32x2 xb = *(const u32x2*)(XB + (size_t)m * D + c); v[r][j] = (f32x4){bf2f(xb.x & 0xffffu), bf2f(xb.x >> 16), bf2f(xb.y & 0xffffu), bf2f(xb.y >> 16)}; }
                    ya[r][j] = *(const unsigned*)((const unsigned char*)Y2 + (size_t)(2 * m) * D + c); yb[r][j] = *(const unsigned*)((const unsigned char*)Y2 + (size_t)(2 * m + 1) * D + c); }
#pragma unroll
            for (int r = 0; r < RB; ++r)
#pragma unroll
                for (int j = 0; j < 4; ++j) { const f32x2 a0 = __builtin_amdgcn_cvt_pk_f32_fp8((int)ya[r][j], false), a1 = __builtin_amdgcn_cvt_pk_f32_fp8((int)ya[r][j], true), b0 = __builtin_amdgcn_cvt_pk_f32_fp8((int)yb[r][j], false), b1 = __builtin_amdgcn_cvt_pk_f32_fp8((int)yb[r][j], true);
                    const f32x4 y = (f32x4){a0[0] + b0[0], a0[1] + b0[1], a1[0] + b1[0], a1[1] + b1[1]} * 0.0625f;
                    v[r][j] += g2v[j] * y; }
        }
#pragma unroll
        for (int r = 0; r < RB; ++r) { ss[r] = (gp::dot4(v[r][0]) + gp::dot4(v[r][1])) + (gp::dot4(v[r][2]) + gp::dot4(v[r][3])); }
#pragma unroll
        for (int o = 1; o < 64; o <<= 1)
#pragma unroll
            for (int r = 0; r < RB; ++r) ss[r] += __shfl_xor(ss[r], o);
#pragma unroll
        for (int r = 0; r < RB; ++r) {
            const int m = m0 + r; const float rstd = rsqrtf(ss[r] * (1.f / D) + EPS);
#pragma unroll
            for (int j = 0; j < 4; ++j) {
                const int c = 4 * F.lane + 256 * j;
                if (MODE == 2) { *(f32x4*)(OUT + (size_t)m * D + c) = v[r][j] * rstd * gs[j]; }
                else {
                    { u32x2 xw; xw.x = cvt_pk_bf16(v[r][j][0], v[r][j][1]); xw.y = cvt_pk_bf16(v[r][j][2], v[r][j][3]); st8((XB + (size_t)m * D + c), xw); }
                    const f32x4 hv = v[r][j] * rstd * gs[j] + shv[j];
                    u32x2 w; w.x = cvt_pk_bf16(hv[0], hv[1]); w.y = cvt_pk_bf16(hv[2], hv[3]);
                    st8((H + (size_t)m * D + c), w);
                }
            }
        }
    }
}

__device__ __forceinline__ void t2_phase(Frame& F, const float* gain, const float* modl, const float* w_router, const float* rbias, int l, bool record) {
    LAS f32x4* wl = (LAS f32x4*)F.lds;
    LAS int* rec = (LAS int*)(F.lds + 65536);
    LAS float* recw = (LAS float*)(F.lds + 65536 + 2048);
    LAS int* lcnt = (LAS int*)(F.lds + 65536 + 4096);
    for (int idx = F.tid; idx < 4096; idx += NTHREADS) {
        const int lane = idx & 63, c = (idx >> 6) & 3, i = (idx >> 8) & 3, j = idx >> 10; const int k = 4 * lane + 256 * j + i;
        wl[idx] = *(const f32x4*)(w_router + (size_t)k * NE + 4 * c);
    }
    if (F.tid < 32) lcnt[F.tid] = 0;
    __syncthreads();
    constexpr int RB = 4, RPW = T / (256 * NWAVES);
    const int gw = F.vcu * NWAVES + F.wave, bt = (gw * RPW) >> 12;
    bf16_t* H = (bf16_t*)(F.ws + WS_H); const bf16_t* XB = (const bf16_t*)(F.ws + WS_XB);
    const int lane = F.lane, myrow = lane >> 4, mye = lane & 15;
    f32x4 gs[4], shv[4];
#pragma unroll
    for (int j = 0; j < 4; ++j) { const int c = 4 * lane + 256 * j; gs[j] = *(const f32x4*)(gain + c) * (1.f + *(const f32x4*)(modl + (size_t)bt * 6 * D + 4 * D + c)); shv[j] = *(const f32x4*)(modl + (size_t)bt * 6 * D + 3 * D + c); }
    int it = 0;
    for (int m0 = gw * RPW; m0 < gw * RPW + RPW; m0 += RB, ++it) {
        f32x4 v[RB][4]; float ss[RB];
#pragma unroll
        for (int r = 0; r < RB; ++r)
#pragma unroll
            for (int j = 0; j < 4; ++j) { const u32x2 xb = *(const u32x2*)(XB + (size_t)(m0 + r) * D + 4 * lane + 256 * j); v[r][j] = (f32x4){bf2f(xb.x & 0xffffu), bf2f(xb.x >> 16), bf2f(xb.y & 0xffffu), bf2f(xb.y >> 16)}; }
#pragma unroll
        for (int r = 0; r < RB; ++r) ss[r] = (gp::dot4(v[r][0]) + gp::dot4(v[r][1])) + (gp::dot4(v[r][2]) + gp::dot4(v[r][3]));
#pragma unroll
        for (int o = 1; o < 64; o <<= 1)
#pragma unroll
            for (int r = 0; r < RB; ++r) ss[r] += __shfl_xor(ss[r], o);
        float acc[RB * NE];
#pragma unroll
        for (int q = 0; q < RB * NE; ++q) acc[q] = 0.f;
#pragma unroll
        for (int j = 0; j < 4; ++j) {
            const int c = 4 * lane + 256 * j;
#pragma unroll
            for (int r = 0; r < RB; ++r) {
                const int m = m0 + r; const float rstd = rsqrtf(ss[r] * (1.f / D) + EPS);
                v[r][j] = v[r][j] * rstd * gs[j] + shv[j];
#if MOE_FP8
                *(unsigned*)((unsigned char*)H + (size_t)m * D + c) = (unsigned)__builtin_amdgcn_cvt_pk_fp8_f32(v[r][j][2], v[r][j][3], __builtin_amdgcn_cvt_pk_fp8_f32(v[r][j][0], v[r][j][1], 0, false), true);
#else
                u32x2 w; w.x = cvt_pk_bf16(v[r][j][0], v[r][j][1]); w.y = cvt_pk_bf16(v[r][j][2], v[r][j][3]);
                st8((H + (size_t)m * D + c), w);
#endif
            }
#pragma unroll
            for (int i = 0; i < 4; ++i)
#pragma unroll
                for (int c4 = 0; c4 < 4; ++c4) { const f32x4 wv = wl[((j * 4 + i) * 4 + c4) * 64 + lane];
#pragma unroll
                    for (int r = 0; r < RB; ++r) { const float hv = v[r][j][i];
                        acc[r * NE + 4 * c4 + 0] += hv * wv[0]; acc[r * NE + 4 * c4 + 1] += hv * wv[1]; acc[r * NE + 4 * c4 + 2] += hv * wv[2]; acc[r * NE + 4 * c4 + 3] += hv * wv[3]; } }
        }
#pragma unroll
        for (int sft = 32; sft >= 1; sft >>= 1) {
            const bool up = (lane & sft) != 0;
#pragma unroll
            for (int k = 0; k < sft; ++k) { const float a = acc[k], b = acc[k + sft]; const float keep = up ? b : a, send = up ? a : b; acc[k] = keep + __shfl_xor(send, sft); }
        }
        const float logit = acc[0];
        const float score = 1.f / (1.f + expf(-logit));
        float scv[NE], bi[NE];
#pragma unroll
        for (int e = 0; e < NE; ++e) { scv[e] = __shfl(score, (lane & 48) | e); bi[e] = scv[e] + rbias[e]; }
        int gsel = 0; float gbest = -INFINITY;
#pragma unroll
        for (int g = 0; g < 4; ++g) { float m1 = -INFINITY, m2 = -INFINITY;
#pragma unroll
            for (int j = 0; j < 4; ++j) { const float x = bi[g * 4 + j]; if (x > m1) { m2 = m1; m1 = x; } else if (x > m2) m2 = x; }
            const float gs = m1 + m2; if (gs > gbest) { gbest = gs; gsel = g; } }
        int e1 = -1, e2 = -1; float b1 = -INFINITY, b2 = -INFINITY, s1 = 0.f, s2 = 0.f;
#pragma unroll
        for (int j = 0; j < 4; ++j) { float x = -INFINITY, sx = 0.f;
#pragma unroll
            for (int g = 0; g < 4; ++g) if (g == gsel) { x = bi[g * 4 + j]; sx = scv[g * 4 + j]; }
            const int e = gsel * 4 + j;
            if (x > b1) { b2 = b1; e2 = e1; s2 = s1; b1 = x; e1 = e; s1 = sx; } else if (x > b2) { b2 = x; e2 = e; s2 = sx; } }
        if (mye == 0) {
            const float inv = 1.f / (s1 + s2); const int slot = (it * RB + myrow) * NWAVES + F.wave;
            rec[slot * 4 + 0] = e1; rec[slot * 4 + 1] = e2;
            rec[slot * 4 + 2] = __hip_atomic_fetch_add(&lcnt[e1], 1, __ATOMIC_RELAXED, __HIP_MEMORY_SCOPE_WORKGROUP);
            rec[slot * 4 + 3] = __hip_atomic_fetch_add(&lcnt[e2], 1, __ATOMIC_RELAXED, __HIP_MEMORY_SCOPE_WORKGROUP);
            recw[slot * 2 + 0] = s1 * inv; recw[slot * 2 + 1] = s2 * inv;
        }
    }
    __syncthreads();
    if (!record) return;
    if (F.tid < NE) lcnt[16 + F.tid] = (int)__hip_atomic_fetch_add(F.ctl + CW_CNT + (l * NE + F.tid) * 64, (unsigned)lcnt[F.tid], __ATOMIC_RELAXED, __HIP_MEMORY_SCOPE_AGENT);
    __syncthreads();
    unsigned* list = (unsigned*)(F.ws + WS_LIST); float* gwb = (float*)(F.ws + WS_GW);
    const int nrows = it * RB;
    for (int s = F.tid; s < nrows * NWAVES; s += NTHREADS) {
        const int i2 = s / NWAVES, w = s % NWAVES; const int m = (F.vcu * NWAVES + w) * RPW + i2;
        const int e1 = rec[s * 4 + 0], e2 = rec[s * 4 + 1];
        list[(size_t)e1 * T + lcnt[16 + e1] + rec[s * 4 + 2]] = (unsigned)(2 * m); list[(size_t)e2 * T + lcnt[16 + e2] + rec[s * 4 + 3]] = (unsigned)(2 * m + 1);
        gwb[2 * m] = recw[s * 2]; gwb[2 * m + 1] = recw[s * 2 + 1];
    }
}
__device__ __forceinline__ LAS int* moe_table(Frame& F, int l) {
    LAS int* tab = (LAS int*)(F.lds + MISC_OFF + 1024);
    __syncthreads();
    if (F.tid == 0) { int acc = 0;
        for (int e = 0; e < NE; ++e) { const int c = (int)__hip_atomic_load(F.ctl + CW_CNT + (l * NE + e) * 64, __ATOMIC_RELAXED, __HIP_MEMORY_SCOPE_AGENT); tab[e] = acc; tab[32 + e] = c; acc += (c + 255) >> 8; }
        tab[16] = acc; }
    __syncthreads();
    return tab;
}

typedef __attribute__((address_space(4))) const Args CArgs;
#define LAUNDER_GP(T_, p) do { GAS T_* _t = (GAS T_*)(p); asm volatile("" : "+s"(_t)); (p) = (T_*)_t; } while (0)
#define PH_BEGIN() LAUNDER_V(F.tid); F.lane = F.tid & 63; LAUNDER_GP(unsigned, F.ctl); LAUNDER_GP(float, F.OUT); LAUNDER_GP(unsigned char, F.ws); GAS unsigned char* ws = (GAS unsigned char*)F.ws; CArgs* ka = (CArgs*)__builtin_amdgcn_kernarg_segment_ptr(); LAUNDER_S(ka); \
    float* mod = WSP(float, WS_MOD); (void)mod; (void)ka
#define WSP(T_, off) ((T_*)(GAS T_*)(ws + (off)))
#define KIN(i) ((const float*)(GAS const float*)ka->in[i])
__global__ void __launch_bounds__(NTHREADS, 2) fwd_kernel(Args args) {
    extern __shared__ __attribute__((aligned(16))) unsigned char lds_raw[];
    Frame F;
    F.lds = (LAS unsigned char*)lds_raw; F.MISC = (volatile LAS unsigned*)(F.lds + MISC_OFF);
    F.tid = threadIdx.x; F.lane = F.tid & 63; F.wave = __builtin_amdgcn_readfirstlane(F.tid >> 6);
    F.G = gridDim.x; { const int bx = blockIdx.x; F.vcu = (F.G % 8 == 0) ? (bx % 8) * (F.G / 8) + bx / 8 : bx; }
    F.ws = (unsigned char*)(GAS unsigned char*)args.ws; F.ctl = (unsigned*)(GAS unsigned*)(args.ws + WS_CTL); F.OUT = (float*)(GAS float*)args.out;
    if (F.tid < 64) F.MISC[F.tid] = 0u;
    __syncthreads();
    XcdBarrier bar; bar.bar = F.ctl + CW_BAR; bar.x = 0; bar.st = nullptr;
    if (!N_LAUNCH_MODE) bar = xcd_barrier_post(F.ctl + CW_BAR, F.MISC + 8);
    const int lo = args.ph_lo, hi = args.ph_hi;
#define IN(k) (lo <= (k) && (k) < hi)
#define SEAM(k) do { if ((k) + 1 < hi) { if (!N_LAUNCH_MODE) xcd_barrier(bar); } } while (0)
    const int cidx = (int)blockIdx.x;

    if (IN(0)) { PH_BEGIN(); p0_phase(F, KIN(1), KIN(2), KIN(3)); __syncthreads(); LAUNDER_V(F.tid); F.lane = F.tid & 63; convert_weights(F, ka, 0); SEAM(0); }
    for (int l = 0; l < NL; ++l) {
        const int pb = 1 + 9 * l;
        if (IN(pb + 0)) {
            PH_BEGIN();
            if (l > 0) for (int rep = 0; rep < ((PROBE_DUP & 8) ? 2 : 1); ++rep) { LAUNDER_V(F.tid); F.lane = F.tid & 63; convert_weights(F, ka, l); }
            if (l == 0) row_phase<0>(F, KIN(0), nullptr, KIN(4) + l * D, mod + (size_t)l * NB * 6 * D, 0, D, WSP(bf16_t, WS_H), WSP(bf16_t, WS_XB), nullptr);
            else row_phase<1>(F, nullptr, mod + (size_t)(l - 1) * NB * 6 * D, KIN(4) + l * D, mod + (size_t)l * NB * 6 * D, 0, D, WSP(bf16_t, WS_H), WSP(bf16_t, WS_XB), nullptr);
            SEAM(pb + 0);
        }
        if (IN(pb + 1)) {
            PH_BEGIN();
            gp::Gemm g{WSP(bf16_t, WS_H), WSP(const bf16_t, WS_WIN), D, 0, nullptr}; gp::DenseOrder So; So.init(T, NIN, F.G, cidx);
            gp::EpiIn E{WSP(bf16_t, ATT_FP8_A ? WS_QA8 : WS_QA), WSP(bf16_t, ATT_FP8_A ? WS_KA8 : WS_KA), WSP(bf16_t, ATT_FP8_A ? WS_VTA8 : WS_VA), WSP(bf16_t, WS_QLAT), WSP(bf16_t, WS_KVLAT), WSP(bf16_t, ATT_FP8_B ? WS_KB8 : WS_KB), WSP(bf16_t, WS_SA), WSP(bf16_t, WS_SB), WSP(float, WS_SSQ), WSP(float, WS_SSKV),
                        KIN(6) + l * 64, KIN(7) + l * 64, WSP(const float, WS_COSA), WSP(const float, WS_SINA), WSP(const float, WS_COSB), WSP(const float, WS_SINB)};
            if (PROBE_DUP & 128) { gp::EpiNull En; gp::gemm_phase<gp::EpiNull, gp::DenseOrder>(F.tid, F.lds, g, So, En); LAUNDER_V(F.tid); }
            gp::gemm_phase<gp::EpiIn, gp::DenseOrder>(F.tid, F.lds, g, So, E); if (PROBE_DUP & (2 | 512)) { LAUNDER_V(F.tid); gp::gemm_phase<gp::EpiIn, gp::DenseOrder>(F.tid, F.lds, g, So, E); }
            SEAM(pb + 1);
        }
        if (IN(pb + 2)) {
            { PH_BEGIN(); gp::Gemm g{WSP(bf16_t, WS_QLAT), WSP(const bf16_t, WS_WQB), 384, 0, nullptr}; gp::DenseOrder So; So.init(T, 768, F.G, cidx);
              gp::EpiQb E{WSP(bf16_t, ATT_FP8_B ? WS_QB8 : WS_QB), WSP(const float, WS_SSQ), WSP(const float, WS_COSB), WSP(const float, WS_SINB)}; gp::gemm_phase<gp::EpiQb, gp::DenseOrder>(F.tid, F.lds, g, So, E); if (PROBE_DUP & 2) { LAUNDER_V(F.tid); gp::gemm_phase<gp::EpiQb, gp::DenseOrder>(F.tid, F.lds, g, So, E); } }
            { PH_BEGIN(); gp::Gemm g{WSP(bf16_t, WS_KVLAT), WSP(const bf16_t, WS_WKVB), 256, 0, nullptr}; gp::DenseOrder So; So.init(T, 1024, F.G, F.G - 1 - cidx);
              gp::EpiKvb E{WSP(bf16_t, ATT_FP8_B ? WS_KB8 : WS_KB), WSP(bf16_t, ATT_FP8_B ? WS_VTB8 : WS_VB), WSP(const float, WS_SSKV)}; gp::gemm_phase<gp::EpiKvb, gp::DenseOrder>(F.tid, F.lds, g, So, E); if (PROBE_DUP & 2) { LAUNDER_V(F.tid); gp::gemm_phase<gp::EpiKvb, gp::DenseOrder>(F.tid, F.lds, g, So, E); } }
#if FAST_ATTN && ATT_FP8_A
            { PH_BEGIN(); at::attn_phase_f8a(F.tid, F.lds, WSP(const unsigned char, WS_QA8), WSP(const unsigned char, WS_KA8), WSP(const unsigned char, WS_VTA8), WSP(bf16_t, WS_QA), 512, KIN(6) + l * 64, KIN(7) + l * 64, F.vcu, F.G); }
            if (PROBE_DUP & 1) { PH_BEGIN(); at::attn_phase_f8a(F.tid, F.lds, WSP(const unsigned char, WS_QA8), WSP(const unsigned char, WS_KA8), WSP(const unsigned char, WS_VTA8), WSP(bf16_t, WS_QA), 512, KIN(6) + l * 64, KIN(7) + l * 64, F.vcu, F.G); }
#else
            { PH_BEGIN(); const at::Tensors A{WSP(bf16_t, WS_QA), 512, WSP(bf16_t, WS_KA), 128, WSP(bf16_t, WS_VA), 128, WSP(bf16_t, WS_QA), 512, 4}; at::attn_phase<64>(F.tid, F.lds, A, F.vcu, F.G); }
#endif
            SEAM(pb + 2);
        }
        if (IN(pb + 3)) {
            PH_BEGIN();
#if FAST_ATTN && ATT_FP8_B
            at::attn_phase_f8b(F.tid, F.lds, WSP(const unsigned char, WS_QB8), WSP(const unsigned char, WS_KB8), WSP(const unsigned char, WS_VTB8), WSP(bf16_t, WS_OB), 512, F.vcu, F.G);
            if (PROBE_DUP & 1) { LAUNDER_V(F.tid); at::attn_phase_f8b(F.tid, F.lds, WSP(const unsigned char, WS_QB8), WSP(const unsigned char, WS_KB8), WSP(const unsigned char, WS_VTB8), WSP(bf16_t, WS_OB), 512, F.vcu, F.G); }
#else
            const at::Tensors A{WSP(bf16_t, WS_QB), 768, WSP(bf16_t, WS_KB), 768, WSP(bf16_t, WS_VB), 512, WSP(bf16_t, WS_OB), 512, 1}; for (int rep = 0; rep < ((PROBE_DUP & 1) ? 2 : 1); ++rep) at::attn_phase<96>(F.tid, F.lds, A, F.vcu, F.G);
#endif
            SEAM(pb + 3);
        }
        if (IN(pb + 4)) {
            PH_BEGIN();
            gp::Gemm g{WSP(bf16_t, WS_QA), WSP(const bf16_t, WS_WPA), 512, (size_t)(WS_WPB - WS_WPA) / 2, nullptr, (size_t)(WS_OB - WS_QA) / 2}; gp::PairOrder So; So.init(T, D, F.G, cidx);
            gp::EpiProjP E{WSP(bf16_t, WS_H), WSP(const unsigned char, WS_SA), WSP(const unsigned char, WS_SB)};
            gp::gemm_phase<gp::EpiProjP, gp::PairOrder>(F.tid, F.lds, g, So, E);
            if (PROBE_DUP & (2 | 1024)) { LAUNDER_V(F.tid); gp::gemm_phase<gp::EpiProjP, gp::PairOrder>(F.tid, F.lds, g, So, E); }
            SEAM(pb + 4);
        }
        if (IN(pb + 5)) {
            PH_BEGIN();
            gp::Gemm g{WSP(bf16_t, WS_H), WSP(const bf16_t, WS_WO), D, 0, nullptr}; gp::DenseOrder So; So.init(T, D, F.G, cidx);
            gp::EpiWo E{WSP(const bf16_t, WS_XB), mod + (size_t)l * NB * 6 * D, WSP(bf16_t, WS_XB)}; gp::gemm_phase<gp::EpiWo, gp::DenseOrder>(F.tid, F.lds, g, So, E);
            SEAM(pb + 5);
        }
        if (IN(pb + 6)) {
            PH_BEGIN();
            if (PROBE_DUP & 16) { t2_phase(F, KIN(15) + l * D, mod + (size_t)l * NB * 6 * D, KIN(16), KIN(17), l, false); LAUNDER_V(F.tid); F.lane = F.tid & 63; __syncthreads(); }
            t2_phase(F, KIN(15) + l * D, mod + (size_t)l * NB * 6 * D, KIN(16), KIN(17), l, true);
            SEAM(pb + 6);
        }
        if (IN(pb + 7)) {
            PH_BEGIN();
            LAS int* tab = moe_table(F, l);
#if MOE_FP8
            gp::Gemm g{WSP(bf16_t, WS_H), WSP(const bf16_t, WS_W13), D / 2, (size_t)1024 * D / 2, WSP(const unsigned, WS_LIST), 0, 0, 0}; gp::MoeOrder So; So.init(tab, F.G, cidx);
            gp::EpiUp E{WSP(bf16_t, WS_ACT), 1.f / 16.f}; gp::gemm_phase<gp::EpiUp, gp::MoeOrder, true, true>(F.tid, F.lds, g, So, E);
            if (PROBE_DUP & 4) { LAUNDER_V(F.tid); gp::gemm_phase<gp::EpiUp, gp::MoeOrder, true, true>(F.tid, F.lds, g, So, E); }
#else
            gp::Gemm g{WSP(bf16_t, WS_H), WSP(const bf16_t, WS_W13), D, (size_t)1024 * D, WSP(const unsigned, WS_LIST)}; gp::MoeOrder So; So.init(tab, F.G, cidx);
            gp::EpiUp E{WSP(bf16_t, WS_ACT), 1.f}; gp::gemm_phase<gp::EpiUp, gp::MoeOrder, true>(F.tid, F.lds, g, So, E);
#endif
            SEAM(pb + 7);
        }
        if (IN(pb + 8)) {
            PH_BEGIN();
            LAS int* tab = moe_table(F, l);
#if MOE_FP8
            gp::Gemm g{WSP(bf16_t, WS_ACT), WSP(const bf16_t, WS_W2), FF / 2, (size_t)D * FF / 2, nullptr, 0, 0, 0}; gp::MoeOrder So; So.init(tab, F.G, cidx);
            gp::EpiDown E{WSP(bf16_t, WS_Y2), WSP(const unsigned, WS_LIST), WSP(const float, WS_GW), 1.f / 128.f}; gp::gemm_phase<gp::EpiDown, gp::MoeOrder, false, true>(F.tid, F.lds, g, So, E);
            if (PROBE_DUP & 4) { LAUNDER_V(F.tid); gp::gemm_phase<gp::EpiDown, gp::MoeOrder, false, true>(F.tid, F.lds, g, So, E); }
#else
            gp::Gemm g{WSP(bf16_t, WS_ACT), WSP(const bf16_t, WS_W2), FF, (size_t)D * FF, nullptr}; gp::MoeOrder So; So.init(tab, F.G, cidx);
            gp::EpiDown E{WSP(bf16_t, WS_Y2), WSP(const unsigned, WS_LIST), WSP(const float, WS_GW), 1.f}; gp::gemm_phase<gp::EpiDown, gp::MoeOrder, false>(F.tid, F.lds, g, So, E);
#endif
            SEAM(pb + 8);
        }
    }
    if (IN(NPHASE - 1)) { PH_BEGIN(); row_phase<2>(F, nullptr, mod + (size_t)(NL - 1) * NB * 6 * D, KIN(21), nullptr, 0, 0, nullptr, WSP(bf16_t, WS_XB), F.OUT); }
#undef IN
#undef SEAM
}

extern "C" void kernel_launch(void* const* d_in, const int* in_sizes, int n_in, void* d_out, int out_size, void* d_ws, size_t ws_size, hipStream_t stream) {
    static int grid = 0;
    if (grid == 0) {
        if (n_in != 22 || out_size != T * D || ws_size < WS_END) { fprintf(stderr, "kernel_launch: unexpected problem (n_in %d out %d ws %zu)\n", n_in, out_size, ws_size); grid = -1; return; }
        int dev = 0, cus = 0, per_cu = 0;
        if (hipGetDevice(&dev) != hipSuccess || hipDeviceGetAttribute(&cus, hipDeviceAttributeMultiprocessorCount, dev) != hipSuccess) { grid = -1; return; }
        if (hipFuncSetAttribute((const void*)fwd_kernel, hipFuncAttributeMaxDynamicSharedMemorySize, LDS_BYTES) != hipSuccess) { grid = -1; return; }
        if (hipOccupancyMaxActiveBlocksPerMultiprocessor(&per_cu, (const void*)fwd_kernel, NTHREADS, LDS_BYTES) != hipSuccess || per_cu < 1) { fprintf(stderr, "kernel_launch: occupancy query says %d\n", per_cu); }
        (void)hipGetLastError();
        grid = cus;
        if (grid != 256 || T % (grid * NWAVES * 4) != 0) {   fprintf(stderr, "kernel_launch: grid %d does not divide the row phases\n", grid); grid = -1; return; }
    }
    if (grid < 0) return;
    (void)hipMemsetAsync((char*)d_ws + WS_CTL, 0, CTL_BYTES, stream);
    Args a{};
    for (int i = 0; i < 22; ++i) a.in[i] = (const float*)d_in[i];
    a.out = (float*)d_out; a.ws = (unsigned char*)d_ws;
#if N_LAUNCH_MODE
    for (int p = 0; p < NPHASE; ++p) { a.ph_lo = p; a.ph_hi = p + 1; hipLaunchKernelGGL(fwd_kernel, dim3(grid), dim3(NTHREADS), LDS_BYTES, stream, a); }
#else
    a.ph_lo = 0; a.ph_hi = NPHASE;
    hipLaunchKernelGGL(fwd_kernel, dim3(grid), dim3(NTHREADS), LDS_BYTES, stream, a);
#endif
}
```

```cpp
#include <hip/hip_runtime.h>
#include <stdint.h>
#include <stdio.h>
#include <math.h>

#ifndef FAST_GEMM
#define FAST_GEMM 1
#endif
#ifndef FAST_ATTN
#define FAST_ATTN 1
#endif
#ifndef PROBE_DUP
#define PROBE_DUP 0
#endif
#ifndef PROBE_ATT
#define PROBE_ATT 0
#endif
#ifndef ATT_REGSTAGE
#define ATT_REGSTAGE 0
#endif
#ifndef WT_STORES
#define WT_STORES 0
#endif
#ifndef ATT_FP8_A
#define ATT_FP8_A 1
#endif
#ifndef ATT_FP8_B
#define ATT_FP8_B 1
#endif
#ifndef MOE_FP8
#define MOE_FP8 1
#endif
#ifndef G1_FP8
#define G1_FP8 1
#endif
#ifndef N_LAUNCH_MODE
#define N_LAUNCH_MODE 0
#endif

#define LAS __attribute__((address_space(3)))
#define GAS __attribute__((address_space(1)))
typedef unsigned short bf16_t;
typedef short bf16x8 __attribute__((ext_vector_type(8)));
typedef float f32x4 __attribute__((ext_vector_type(4)));
typedef float f32x2 __attribute__((ext_vector_type(2)));
typedef float f32x16 __attribute__((ext_vector_type(16)));
typedef unsigned u32x4 __attribute__((ext_vector_type(4)));
typedef unsigned u32x2 __attribute__((ext_vector_type(2)));
typedef GAS unsigned gu32;

constexpr int D = 1024, NB = 8, S = 4096, T = NB * S, NL = 4, INC = 3488, NIN = 3584, NE = 16, FF = 512;
constexpr float EPS = 1e-6f, LOG2E = 1.4426950408889634f;
constexpr float QSCALE_A = 0.125f * LOG2E, QSCALE_B = 0.10206207261596577f * LOG2E;
constexpr int NWAVES = 8, NTHREADS = 512;
constexpr int NPHASE = 2 + 9 * NL;

constexpr size_t MiB = 1u << 20;
constexpr size_t WS_CTL = 0, CTL_BYTES = 1 * MiB;
constexpr size_t WS_MOD = 1 * MiB;
constexpr size_t WS_COSA = 2 * MiB, WS_SINA = WS_COSA + 512 * 1024, WS_COSB = 3 * MiB, WS_SINB = WS_COSB + 256 * 1024;
constexpr size_t WS_SSQ = 4 * MiB, WS_SSKV = 5 * MiB;
constexpr size_t WS_GW = 6 * MiB;
constexpr size_t WS_LIST = 7 * MiB;
constexpr size_t WS_WIN = 10 * MiB, WS_WQB = 17 * MiB, WS_WKVB = 18 * MiB, WS_WPA = 19 * MiB, WS_WPB = 20 * MiB, WS_WO = 21 * MiB, WS_W13 = 23 * MiB, WS_W2 = 55 * MiB;
constexpr size_t WS_H = 72 * MiB;
constexpr size_t WS_QA = 136 * MiB, WS_KA = 168 * MiB, WS_VA = 176 * MiB, WS_QLAT = 184 * MiB, WS_KVLAT = 208 * MiB;
constexpr size_t WS_KB = 224 * MiB, WS_VB = 272 * MiB, WS_QB = 304 * MiB, WS_OB = 352 * MiB, WS_SA = 384 * MiB, WS_SB = 448 * MiB, WS_XB = 512 * MiB, WS_QA8 = 576 * MiB, WS_KA8 = 592 * MiB, WS_VTA8 = 596 * MiB, WS_QB8 = 600 * MiB, WS_KB8 = 624 * MiB, WS_VTB8 = 648 * MiB, WS_END = 664 * MiB;
constexpr size_t WS_ACT = 136 * MiB, WS_Y2 = 208 * MiB;
constexpr int ACT_ROWS = 2 * T + NE * 256;
static_assert(WS_ACT + (size_t)ACT_ROWS * FF * 2 <= WS_Y2 && WS_Y2 + (size_t)2 * T * D * 2 <= WS_XB, "moe overlay");
constexpr int CW_BAR = 4096;
constexpr int CW_CNT = 16384;

constexpr int RING_BYTES = 131072, MISC_OFF = RING_BYTES, LDS_BYTES = 147456;

__device__ __forceinline__ float bf2f(unsigned v) { return __uint_as_float(v << 16); }
typedef __bf16 bf16x2_t __attribute__((ext_vector_type(2)));
__device__ __forceinline__ unsigned cvt_pk_bf16(float lo, float hi) { f32x2 v = {lo, hi}; bf16x2_t b = __builtin_convertvector(v, bf16x2_t); return __builtin_bit_cast(unsigned, b); }
__device__ __forceinline__ u32x4 pack8(f32x4 a, f32x4 b) { u32x4 w; w.x = cvt_pk_bf16(a[0], a[1]); w.y = cvt_pk_bf16(a[2], a[3]); w.z = cvt_pk_bf16(b[0], b[1]); w.w = cvt_pk_bf16(b[2], b[3]); return w; }
__device__ __forceinline__ u32x2 pack8_fp8(f32x4 a, f32x4 b) { u32x2 w;
    w.x = (unsigned)__builtin_amdgcn_cvt_pk_fp8_f32(a[2], a[3], __builtin_amdgcn_cvt_pk_fp8_f32(a[0], a[1], 0, false), true);
    w.y = (unsigned)__builtin_amdgcn_cvt_pk_fp8_f32(b[2], b[3], __builtin_amdgcn_cvt_pk_fp8_f32(b[0], b[1], 0, false), true); return w; }
__device__ __forceinline__ void unpack8(u32x4 w, f32x4& a, f32x4& b) { a[0] = bf2f(w.x & 0xffffu); a[1] = bf2f(w.x >> 16); a[2] = bf2f(w.y & 0xffffu); a[3] = bf2f(w.y >> 16); b[0] = bf2f(w.z & 0xffffu); b[1] = bf2f(w.z >> 16); b[2] = bf2f(w.w & 0xffffu); b[3] = bf2f(w.w >> 16); }
__device__ __forceinline__ float wave_sum(float v) {
#pragma unroll
    for (int o = 1; o < 64; o <<= 1) v += __shfl_xor(v, o);
    return v;
}
__device__ __forceinline__ float sigm(float v) { return __builtin_amdgcn_rcpf(1.f + __builtin_amdgcn_exp2f(v * (-LOG2E))); }
#if WT_STORES
__device__ __forceinline__ void st16(void* p, u32x4 v) { asm volatile("global_store_dwordx4 %0, %1, off sc1\n\ts_nop 1" :: "v"(p), "v"(v) : "memory"); }
__device__ __forceinline__ void st8(void* p, u32x2 v) { asm volatile("global_store_dwordx2 %0, %1, off sc1\n\ts_nop 1" :: "v"(p), "v"(v) : "memory"); }
#else
__device__ __forceinline__ void st16(void* p, u32x4 v) { *(u32x4*)p = v; }
__device__ __forceinline__ void st8(void* p, u32x2 v) { *(u32x2*)p = v; }
#endif
#define VM_WAIT() asm volatile("s_waitcnt vmcnt(0)" ::: "memory")
#define LAUNDER_S(p) asm volatile("" : "+s"(p))
#define LAUNDER_V(v) asm volatile("" : "+v"(v))
#define LDS_WAIT() asm volatile("s_waitcnt lgkmcnt(0)" ::: "memory")

#define XB_TMO      128
#define XB_XCNT(j)  (256  + 64 * (j))
#define XB_XSUB(j)  (1280 + 64 * (j))
#define XB_XGEN(j)  (2304 + 64 * (j))
#define XB_TOP      3328
#define XB_TOPGEN   3392
#define XCD_BAR_WORDS 3456
#define XB_SPIN_CAP (1u << 22)
__device__ __forceinline__ unsigned xb_ld(unsigned* p)              { return __hip_atomic_load(p, __ATOMIC_RELAXED, __HIP_MEMORY_SCOPE_AGENT); }
__device__ __forceinline__ unsigned xb_add(unsigned* p, unsigned v) { return __hip_atomic_fetch_add(p, v, __ATOMIC_RELAXED, __HIP_MEMORY_SCOPE_AGENT); }
__device__ __forceinline__ unsigned xb_xcc_id() { return (unsigned)__builtin_amdgcn_s_getreg((3 << 11) | 20) & 0xFu; }
#define XB_SPIN(cond, bar) do { unsigned _sp = 0; while (cond) { __builtin_amdgcn_s_sleep(1); \
    if ((++_sp & 255u) == 0u) { if (xb_ld(&(bar)[XB_TMO])) break; if (_sp > XB_SPIN_CAP) { atomicAdd(&(bar)[XB_TMO], 1u); break; } } } } while (0)
struct XcdBarrier { unsigned* bar; unsigned x; volatile LAS unsigned* st; };
__device__ __forceinline__ XcdBarrier xcd_barrier_post(unsigned* bar, volatile LAS unsigned* st) {
    XcdBarrier b; b.bar = bar; b.x = xb_xcc_id(); b.st = st;
    if (threadIdx.x == 0) (void)xb_add(&bar[XB_XCNT(b.x)], 1u);
    return b;
}
__device__ __forceinline__ void xcd_barrier_complete(unsigned* bar, unsigned x, unsigned& nloc, unsigned& nx) {
    const unsigned G = gridDim.x * gridDim.y * gridDim.z;
    unsigned sum, cnt, mine, sp = 0u;
    for (;;) {
        sum = 0u; cnt = 0u; mine = 0u;
#pragma unroll
        for (unsigned j = 0; j < 16; ++j) { const unsigned c = xb_ld(&bar[XB_XCNT(j)]); sum += c; cnt += (c > 0u) ? 1u : 0u; mine = (j == x) ? c : mine; }
        if (sum == G) break;
        __builtin_amdgcn_s_sleep(1);
        if ((++sp & 255u) == 0u) { if (xb_ld(&bar[XB_TMO])) break; if (sp > XB_SPIN_CAP) { atomicAdd(&bar[XB_TMO], 1u); break; } }
    }
    nloc = mine > 0u ? mine : 1u; nx = cnt > 0u ? cnt : 1u;
}
__device__ __forceinline__ void xcd_barrier(const XcdBarrier& b) {
    asm volatile("s_waitcnt vmcnt(0)" ::: "memory");
    __syncthreads();
    if (threadIdx.x == 0) {
        unsigned* bar = b.bar;
        __builtin_amdgcn_s_waitcnt(0);
        unsigned nloc = b.st[0], nx = b.st[1];
        if (nloc == 0u) { xcd_barrier_complete(bar, b.x, nloc, nx); b.st[0] = nloc; b.st[1] = nx; }
        const unsigned old = xb_add(&bar[XB_XSUB(b.x)], 1u);
        const unsigned gen = old / nloc;
        if (old + 1u == (gen + 1u) * nloc) {
            __builtin_amdgcn_fence(__ATOMIC_RELEASE, "agent");
            asm volatile("s_waitcnt vmcnt(0)" ::: "memory");
            const unsigned og = xb_add(&bar[XB_TOP], 1u);
            const unsigned tg = og / nx;
            if (og + 1u == (tg + 1u) * nx) xb_add(&bar[XB_TOPGEN], 1u);
            else XB_SPIN(xb_ld(&bar[XB_TOPGEN]) == tg, bar);
            __builtin_amdgcn_fence(__ATOMIC_ACQUIRE, "agent");
            xb_add(&bar[XB_XGEN(b.x)], 1u);
            asm volatile("s_waitcnt vmcnt(0)" ::: "memory");
        } else {
            XB_SPIN(xb_ld(&bar[XB_XGEN(b.x)]) == gen, bar);
            __builtin_amdgcn_fence(__ATOMIC_ACQUIRE, "agent");
            asm volatile("s_waitcnt vmcnt(0)" ::: "memory");
        }
    }
    __syncthreads();
}

namespace gp {
constexpr int BM = 256, BK = 64, HALF = 128, HTB = HALF * BK * 2, NXCD = 8, WGM = 8;
__host__ __device__ __forceinline__ int lds_byte(int r, int c) { const int st = (r >> 4) * 2 + (c >> 5), rr = r & 15, cc = c & 31, ob = rr * 64 + cc * 2; return st * 1024 + (ob ^ (((ob >> 9) & 1) << 5)); }
__host__ __device__ __forceinline__ void stage_rc(int b, int& R, int& C) { const int st = b / 1024, sb = b % 1024, swz = sb ^ (((sb >> 9) & 1) << 5); R = (st >> 1) * 16 + swz / 64; C = (st & 1) * 32 + (swz % 64) / 2; }
__host__ __device__ __forceinline__ int perm32(int rho) { const int n = rho >> 4, i = rho & 15; return 8 * (i >> 2) + 4 * n + (i & 3); }

struct Unit { int pm, pn, be, rl, nv; };
struct Gemm { const bf16_t* A; const bf16_t* Bt; int K; size_t bstride; const unsigned* list; size_t astride; int sw, sx; };

__device__ __forceinline__ int xcd_remap(int wgid, int nwg) { const int q = nwg / NXCD, r = nwg % NXCD, xcd = wgid % NXCD, off = wgid / NXCD; return (xcd < r ? xcd * (q + 1) : r * (q + 1) + (xcd - r) * q) + off; }
struct DenseOrder {
    int nM, nN, nwg, G, c;
    __device__ void init(int M, int N, int G_, int c_) { nM = M / BM; nN = N / BM; nwg = nM * nN; G = G_; c = c_; }
    __device__ bool next(int i, Unit& u) const {
        const long L = (long)i * G + c; if (L >= nwg) return false;
        const int wgid = xcd_remap((int)L, nwg);
        const int nig = WGM * nN, gid = wgid / nig, fm = gid * WGM, gsz = (nM - fm) < WGM ? (nM - fm) : WGM;
        u.pm = fm + ((wgid % nig) % gsz); u.pn = (wgid % nig) / gsz; u.be = 0; u.rl = 0; u.nv = 256; return true;
    }
};
struct PairOrder {
    DenseOrder d;
    __device__ void init(int M, int N, int G_, int c_) { d.init(M, N, G_, c_); }
    __device__ bool next(int i, Unit& u) const { if (!d.next(i >> 1, u)) return false; u.be = i & 1; return true; }
};
struct MoeOrder {
    const LAS int* tab; int nwg, G, c;
    __device__ static int rd(const LAS int* p) { return __builtin_amdgcn_readfirstlane(*p); }
    __device__ void init(const LAS int* tab_, int G_, int c_) { tab = tab_; nwg = rd(tab_ + 16) * 4; G = G_; c = c_; }
    __device__ bool next(int i, Unit& u) const {
        const long L = (long)i * G + c; if (L >= nwg) return false;
        const int wgid = xcd_remap((int)L, nwg);
        const int tile = wgid >> 2; int e = 0;
        for (int k = 1; k < NE; ++k) { const int tk = rd(tab + k); e = (tk <= tile) ? k : e; }
        e = __builtin_amdgcn_readfirstlane(e);
        u.pm = tile; u.pn = wgid & 3; u.be = e; u.rl = tile - rd(tab + e); const int rem = rd(tab + 32 + e) - u.rl * 256; u.nv = rem < 256 ? rem : 256; return true;
    }
};

#define ACC_T f32x4 (&acc)[2][2][4][2]

template <class Epi, class Sched, bool GATHER>
__device__ __forceinline__ void gemm_phase_ref(int tid, const Gemm g, const Sched& S, const Epi& E) {
    const int wid = __builtin_amdgcn_readfirstlane(tid >> 6), lane = tid & 63, wr = wid >> 2, wc = wid & 3, fr = lane & 15, fq = lane >> 4;
    const int K = g.K; Unit u;
    for (int ui = 0; S.next(ui, u); ++ui) {
        f32x4 acc[2][2][4][2];
#pragma unroll
        for (int a = 0; a < 2; ++a)
#pragma unroll
            for (int b = 0; b < 2; ++b)
#pragma unroll
                for (int m = 0; m < 4; ++m)
#pragma unroll
                    for (int n = 0; n < 2; ++n) acc[a][b][m][n] = (f32x4){0.f, 0.f, 0.f, 0.f};
        const bf16_t* Bt = g.Bt + (size_t)u.be * g.bstride + (size_t)u.pn * 256 * K;
        for (int ai = 0; ai < 2; ++ai)
            for (int m = 0; m < 4; ++m) {
                const int rloc = ai * 128 + wr * 64 + m * 16 + fr;
                size_t arow;
                if (GATHER) { arow = (rloc < u.nv) ? (size_t)(g.list[(size_t)u.be * T + u.rl * 256 + rloc] >> 1) : 0; }
                else arow = (size_t)u.pm * 256 + rloc;
                const bf16_t* ap = g.A + arow * K;
                for (int bj = 0; bj < 2; ++bj) {
                    const bf16_t* bp = Bt + (size_t)(bj * 128 + wc * 32 + fq * 8) * K;
                    float s[8];
#pragma unroll
                    for (int c = 0; c < 8; ++c) {
                        float sc = 0.f; const bf16_t* bpc = bp + (size_t)c * K;
#pragma unroll 2
                        for (int k = 0; k < K; k += 8) {
                            f32x4 a0, a1, b0, b1; unpack8(*(const u32x4*)(ap + k), a0, a1); unpack8(*(const u32x4*)(bpc + k), b0, b1);
                            sc += a0[0] * b0[0] + a0[1] * b0[1] + a0[2] * b0[2] + a0[3] * b0[3] + a1[0] * b1[0] + a1[1] * b1[1] + a1[2] * b1[2] + a1[3] * b1[3];
                        }
                        s[c] = sc; asm volatile("" : "+v"(s[c]));
                    }
#pragma unroll
                    for (int a2 = 0; a2 < 2; ++a2)
#pragma unroll
                        for (int b2 = 0; b2 < 2; ++b2)
#pragma unroll
                            for (int m2 = 0; m2 < 4; ++m2)
                                if (a2 == ai && b2 == bj && m2 == m) { acc[a2][b2][m2][0] = (f32x4){s[0], s[1], s[2], s[3]}; acc[a2][b2][m2][1] = (f32x4){s[4], s[5], s[6], s[7]}; }
                }
            }
        E(acc, u, wr, wc, fr, fq);
    }
}

template <class E> struct EpiTraits { static constexpr bool KEEP = false; };
#if FAST_GEMM
typedef int v8i_t __attribute__((ext_vector_type(8)));
__device__ __forceinline__ unsigned gp_voffb(int tid, int i, int K) { int t_ = tid; LAUNDER_V(t_); int R, C; stage_rc(t_ * 16 + i * 8192, R, C); const int Rb = (R & ~31) + perm32(R & 31); return (unsigned)(Rb * K + C) * 2u; }
template <class Epi, class Sched, bool GATHER, bool F8>
__device__ __forceinline__ void gemm_phase_fast(int tid, LAS unsigned char* lds, const Gemm g, const Sched& S, const Epi& E) {
    const int wid = __builtin_amdgcn_readfirstlane(tid >> 6), lane = tid & 63, wr = wid >> 2, wc = wid & 3, fr = lane & 15, fq = lane >> 4;
    const int K = g.K, nt = K / BK;
    int Rr[2], Cc[2]; unsigned voffB[2];
#pragma unroll
    for (int i = 0; i < 2; ++i) { stage_rc(tid * 16 + i * 8192, Rr[i], Cc[i]); const int Rb = (Rr[i] & ~31) + perm32(Rr[i] & 31); voffB[i] = (unsigned)(Rb * K + Cc[i]) * 2u; }
#define GP_VB(i) (F8 ? gp_voffb(tid, (i), K) : voffB[i])
    const size_t kstep = (size_t)(BK * 2), hstep = (size_t)HALF * K * 2, tstep = 2 * hstep;
    const unsigned ldsw = (unsigned)wid * 1024u;
    const int aoff = lds_byte(wr * 64 + fr, fq * 8), boff = lds_byte(wc * 32 + fr, fq * 8);
#define GP_UNI(p) ((const char*)(((unsigned long long)(unsigned)__builtin_amdgcn_readfirstlane((int)((unsigned long long)(p) >> 32)) << 32) | (unsigned)__builtin_amdgcn_readfirstlane((int)(unsigned long long)(p))))
#define GP_SA(b, h) (((b) * 2 + (h)) * HTB)
#define GP_SB(b, h) ((4 + (b) * 2 + (h)) * HTB)
#define GP_DMA(sbase, voff, ldsdst) do { unsigned keep_; asm volatile("s_mov_b32 %0, m0\n\ts_mov_b32 m0, %3\n\ts_nop 0\n\tglobal_load_lds_dwordx4 %1, %2\n\ts_mov_b32 m0, %0" \
        : "=&s"(keep_) : "v"(voff), "s"(sbase), "s"((unsigned)__builtin_amdgcn_readfirstlane((int)(unsigned)(uintptr_t)(ldsdst))) : "memory"); } while (0)
#define GP_STAGE2(bufoff, gbase, v0, v1) do { const char* gb_ = (gbase); GP_DMA(gb_, (v0), lds + (bufoff) + ldsw); GP_DMA(gb_, (v1), lds + (bufoff) + ldsw + 8192); } while (0)
#define GP_STAGEB(bufoff, gbase) GP_STAGE2(bufoff, gbase, GP_VB(0), GP_VB(1))
#define GP_CAT8(x0, x1) __builtin_bit_cast(v8i_t, __builtin_shufflevector(x0, x1, 0, 1, 2, 3, 4, 5, 6, 7, 8, 9, 10, 11, 12, 13, 14, 15))
#define GP_LDA(dst, b, h) do { _Pragma("unroll") for (int m = 0; m < 4; ++m) _Pragma("unroll") for (int k = 0; k < 2; ++k) dst[m][k] = *(const LAS bf16x8*)(lds + GP_SA(b, h) + aoff + m * 2048 + k * 1024); \
        if constexpr (F8) { _Pragma("unroll") for (int m = 0; m < 4; ++m) dst##8[m] = GP_CAT8(dst[m][0], dst[m][1]); } } while (0)
#define GP_LDB(dst, b, h) do { _Pragma("unroll") for (int n = 0; n < 2; ++n) _Pragma("unroll") for (int k = 0; k < 2; ++k) dst[n][k] = *(const LAS bf16x8*)(lds + GP_SB(b, h) + boff + n * 2048 + k * 1024); \
        if constexpr (F8) { _Pragma("unroll") for (int n = 0; n < 2; ++n) dst##8[n] = GP_CAT8(dst[n][0], dst[n][1]); } } while (0)
#define GP_MMA(ai, bj, At, Bt) do { __builtin_amdgcn_s_setprio(1); \
        if constexpr (F8) { _Pragma("unroll") for (int m = 0; m < 4; ++m) _Pragma("unroll") for (int n = 0; n < 2; ++n) \
            acc[ai][bj][m][n] = __builtin_amdgcn_mfma_scale_f32_16x16x128_f8f6f4(Bt##8[n], At##8[m], acc[ai][bj][m][n], 0, 0, 0, 0, 0, 0); }     \
        else { _Pragma("unroll") for (int m = 0; m < 4; ++m) _Pragma("unroll") for (int n = 0; n < 2; ++n) _Pragma("unroll") for (int k = 0; k < 2; ++k) \
            acc[ai][bj][m][n] = __builtin_amdgcn_mfma_f32_16x16x32_bf16(Bt[n][k], At[m][k], acc[ai][bj][m][n], 0, 0, 0); } \
        __builtin_amdgcn_s_setprio(0); } while (0)
#define GP_WAIT_V(n) asm volatile("s_waitcnt vmcnt(" #n ")" ::: "memory")
#define GP_WAIT_L(n) asm volatile("s_waitcnt lgkmcnt(" #n ")" ::: "memory")
#define GP_BAR __builtin_amdgcn_s_barrier()
#define GP_SCHED __builtin_amdgcn_sched_barrier(0)
    Unit cur, nxt; int ui = 0;
    if (!S.next(0, cur)) return;
    f32x4 acc[2][2][4][2];
#pragma unroll
    for (int a = 0; a < 2; ++a)
#pragma unroll
        for (int b = 0; b < 2; ++b)
#pragma unroll
            for (int m = 0; m < 4; ++m)
#pragma unroll
                for (int n = 0; n < 2; ++n) acc[a][b][m][n] = (f32x4){0.f, 0.f, 0.f, 0.f};
    bf16x8 At[4][2], B0[2][2], B1[2][2];
    v8i_t At8[4], B08[2], B18[2];
    unsigned vC0, vC1, vC2, vC3, vN0, vN1, vN2, vN3;
#define GP_VOFF(u, o0, o1, o2, o3) do { if (GATHER) { \
        int tl_ = tid; LAUNDER_V(tl_); int R0_, C0_, R1_, C1_; stage_rc(tl_ * 16, R0_, C0_); stage_rc(tl_ * 16 + 8192, R1_, C1_);     \
        const unsigned* lp = g.list + (size_t)(u).be * T + (u).rl * 256; \
        const int nvm = (u).nv - 1; const int p0 = min(R0_, nvm), p1 = min(R1_, nvm), p2 = min(128 + R0_, nvm), p3 = min(128 + R1_, nvm); \
        const unsigned t0 = lp[p0] >> 1, t1 = lp[p1] >> 1, t2 = lp[p2] >> 1, t3 = lp[p3] >> 1; \
        o0 = (t0 * K + C0_) * 2u; o1 = (t1 * K + C1_) * 2u; o2 = (t2 * K + C0_) * 2u; o3 = (t3 * K + C1_) * 2u; \
      } else { o0 = (unsigned)(Rr[0] * K + Cc[0]) * 2u; o1 = (unsigned)(Rr[1] * K + Cc[1]) * 2u; o2 = o0 + (unsigned)hstep; o3 = o1 + (unsigned)hstep; } } while (0)
    GP_VOFF(cur, vC0, vC1, vC2, vC3);
    const char* cA = GP_UNI((const char*)g.A + ((size_t)cur.be * g.astride) * 2 + (GATHER ? (size_t)0 : (size_t)cur.pm * tstep));
    const char* cB = GP_UNI((const char*)g.Bt + ((size_t)cur.be * g.bstride) * 2 + (size_t)cur.pn * tstep);
    GP_STAGEB(GP_SB(0, 0), cB); GP_STAGEB(GP_SB(0, 1), cB + hstep); GP_STAGE2(GP_SA(0, 0), cA, vC0, vC1); GP_STAGE2(GP_SA(0, 1), cA, vC2, vC3);
    if (wr == 1) GP_BAR;
    GP_WAIT_V(2); GP_BAR;
    GP_STAGEB(GP_SB(1, 0), cB + kstep); GP_STAGE2(GP_SA(1, 0), cA + kstep, vC0, vC1); GP_STAGEB(GP_SB(1, 1), cB + hstep + kstep);
    GP_WAIT_V(6); GP_BAR;
    for (;;) {
        const bool has_next = S.next(ui + 1, nxt);
        const char* nA = GP_UNI(has_next ? (const char*)g.A + ((size_t)nxt.be * g.astride) * 2 + (GATHER ? (size_t)0 : (size_t)nxt.pm * tstep) : cA);
        const char* nB = GP_UNI(has_next ? (const char*)g.Bt + ((size_t)nxt.be * g.bstride) * 2 + (size_t)nxt.pn * tstep : cB);
        if (GATHER) {
            if (has_next) { GP_VOFF(nxt, vN0, vN1, vN2, vN3); } else { vN0 = vC0; vN1 = vC1; vN2 = vC2; vN3 = vC3; }
            *(LAS u32x4*)(lds + MISC_OFF + 2048 + tid * 16) = (u32x4){vN0, vN1, vN2, vN3};
        } else { vN0 = vC0; vN1 = vC1; vN2 = vC2; vN3 = vC3; }
#pragma nounroll
        for (int t = 0; t < nt; t += 2) {
            LAUNDER_S(cA); LAUNDER_S(cB); LAUNDER_S(nA); LAUNDER_S(nB);
            const bool last = (t == nt - 2);
            if (GATHER) { if (last) { const u32x4 q_ = *(const LAS u32x4*)(lds + MISC_OFF + 2048 + tid * 16); vN0 = q_.x; vN1 = q_.y; vN2 = q_.z; vN3 = q_.w; } }
            const char* a1 = cA + (size_t)(t + 1) * kstep;
            const char* a2 = last ? nA : cA + (size_t)(t + 2) * kstep; const char* b2 = last ? nB : cB + (size_t)(t + 2) * kstep;
            const char* a3 = a2 + kstep; const char* b3 = b2 + kstep;
            const unsigned w0 = last ? vN0 : vC0, w1 = last ? vN1 : vC1, w2 = last ? vN2 : vC2, w3 = last ? vN3 : vC3;
            GP_LDB(B0, 0, 0); GP_LDB(B1, 0, 1); GP_SCHED; GP_LDA(At, 0, 0); GP_STAGE2(GP_SA(1, 1), a1, vC2, vC3);
            GP_WAIT_V(8); GP_WAIT_L(0); GP_BAR; GP_MMA(0, 0, At, B0); GP_MMA(0, 1, At, B1); GP_BAR; GP_SCHED;
            GP_LDA(At, 0, 1); GP_STAGEB(GP_SB(0, 0), b2); GP_STAGEB(GP_SB(0, 1), b2 + hstep); GP_STAGE2(GP_SA(0, 0), a2, w0, w1);
            GP_WAIT_V(8); GP_WAIT_L(0); GP_BAR; GP_MMA(1, 0, At, B0); GP_MMA(1, 1, At, B1); GP_BAR; GP_SCHED;
            GP_LDB(B0, 1, 0); GP_LDB(B1, 1, 1); GP_SCHED; GP_LDA(At, 1, 0); GP_STAGE2(GP_SA(0, 1), a2, w2, w3);
            GP_WAIT_V(8); GP_WAIT_L(0); GP_BAR; GP_MMA(0, 0, At, B0); GP_MMA(0, 1, At, B1); GP_BAR; GP_SCHED;
            GP_LDA(At, 1, 1); GP_STAGEB(GP_SB(1, 0), b3); GP_STAGEB(GP_SB(1, 1), b3 + hstep); GP_STAGE2(GP_SA(1, 0), a3, w0, w1);
            GP_WAIT_V(8); GP_WAIT_L(0); GP_BAR; GP_MMA(1, 0, At, B0); GP_MMA(1, 1, At, B1); GP_BAR; GP_SCHED;
        }
        if (wr == 0) GP_BAR;
        E(acc, cur, wr, wc, fr, fq);
        if (!has_next) break;
        if (!(EpiTraits<Epi>::KEEP && cur.be == 0)) {
#pragma unroll
        for (int a = 0; a < 2; ++a)
#pragma unroll
            for (int b = 0; b < 2; ++b)
#pragma unroll
                for (int m = 0; m < 4; ++m)
#pragma unroll
                    for (int n = 0; n < 2; ++n) acc[a][b][m][n] = (f32x4){0.f, 0.f, 0.f, 0.f};
        }
        cur = nxt; cA = nA; cB = nB; vC0 = vN0; vC1 = vN1; vC2 = vN2; vC3 = vN3; ++ui;
        if (wr == 1) GP_BAR;
    }
    GP_WAIT_V(0);
    GP_BAR;
#undef GP_UNI
#undef GP_SA
#undef GP_SB
#undef GP_STAGE2
#undef GP_DMA
#undef GP_STAGEB
#undef GP_VB
#undef GP_LDA
#undef GP_LDB
#undef GP_MMA
#undef GP_CAT8
#undef GP_WAIT_V
#undef GP_WAIT_L
#undef GP_BAR
#undef GP_SCHED
#undef GP_VOFF
}
#endif

template <class Epi, class Sched, bool GATHER = false, bool F8 = false>
__device__ __forceinline__ void gemm_phase(int tid, LAS unsigned char* lds, const Gemm g, const Sched& S, const Epi& E) {
#if FAST_GEMM
    gemm_phase_fast<Epi, Sched, GATHER, F8>(tid, lds, g, S, E);
#else
    (void)lds; gemm_phase_ref<Epi, Sched, GATHER>(tid, g, S, E);
#endif
}

#define EPI_ROW(ai, m) (u.pm * 256 + (ai) * 128 + wr * 64 + (m) * 16 + fr)
#define EPI_COL(bj) (u.pn * 256 + (bj) * 128 + wc * 32 + fq * 8)
__device__ __forceinline__ float dot4(f32x4 a) { return (a[0] * a[0] + a[1] * a[1]) + (a[2] * a[2] + a[3] * a[3]); }

struct EpiNull {
    __device__ __forceinline__ void operator()(const ACC_T, const Unit& u, int wr, int wc, int fr, int fq) const {
#pragma unroll
        for (int ai = 0; ai < 2; ++ai)
#pragma unroll
            for (int bj = 0; bj < 2; ++bj)
#pragma unroll
                for (int m = 0; m < 4; ++m) asm volatile("" :: "v"(acc[ai][bj][m][0]), "v"(acc[ai][bj][m][1]));
    }
};
struct EpiIn {
    bf16_t *QA, *KA, *VA, *QLAT, *KVLAT, *KB, *SA, *SB; float *SSQ, *SSKV; const float *gq, *gk, *cosA, *sinA, *cosB, *sinB;
    __device__ __forceinline__ void operator()(const ACC_T, const Unit& u, int wr, int wc, int fr, int fq) const {
        const int wb = u.pn * 4 + wc;
        if (wb < 10) {
            const bool isq = wb < 8; const int head = isq ? wb : wb - 8; const float* g = isq ? gq : gk; bf16_t* dst = isq ? QA : KA; const int dp = isq ? 512 : 128; const float qs = isq ? QSCALE_A : 1.f;
            const f32x4 g00 = *(const f32x4*)(g + 8 * fq), g01 = *(const f32x4*)(g + 8 * fq + 4), g10 = *(const f32x4*)(g + 32 + 8 * fq), g11 = *(const f32x4*)(g + 36 + 8 * fq);
#pragma unroll
            for (int ai = 0; ai < 2; ++ai)
#pragma unroll
                for (int m = 0; m < 4; ++m) {
                    const int r = EPI_ROW(ai, m), pos = r & (S - 1);
                    const f32x4 v00 = acc[ai][0][m][0], v01 = acc[ai][0][m][1], v10 = acc[ai][1][m][0], v11 = acc[ai][1][m][1];
                    float ss = (dot4(v00) + dot4(v01)) + (dot4(v10) + dot4(v11)); ss += __shfl_xor(ss, 16); ss += __shfl_xor(ss, 32);
                    const float rstd = rsqrtf(ss * (1.f / 64.f) + EPS);
                    const f32x4 y00 = v00 * rstd * g00, y01 = v01 * rstd * g01, y10 = v10 * rstd * g10, y11 = v11 * rstd * g11;
                    const f32x4 c0 = *(const f32x4*)(cosA + pos * 32 + 8 * fq), c1 = *(const f32x4*)(cosA + pos * 32 + 8 * fq + 4), s0 = *(const f32x4*)(sinA + pos * 32 + 8 * fq), s1 = *(const f32x4*)(sinA + pos * 32 + 8 * fq + 4);
                    const f32x4 o00 = (y00 * c0 - y10 * s0) * qs, o01 = (y01 * c1 - y11 * s1) * qs, o10 = (y10 * c0 + y00 * s0) * qs, o11 = (y11 * c1 + y01 * s1) * qs;
#if ATT_FP8_A
                    unsigned char* p8 = (unsigned char*)dst + (size_t)r * dp + head * 64 + 8 * fq;
                    st8(p8, pack8_fp8(o00, o01)); st8(p8 + 32, pack8_fp8(o10, o11));
#else
                    bf16_t* p = dst + (size_t)r * dp + head * 64 + 8 * fq;
                    st16(p, pack8(o00, o01)); st16((p + 32), pack8(o10, o11));
#endif
                }
        } else if (wb < 12) {
#pragma unroll
            for (int ai = 0; ai < 2; ++ai)
#pragma unroll
                for (int m = 0; m < 4; ++m) {
#if ATT_FP8_A
                    const int r = EPI_ROW(ai, m), sq = r & (S - 1), k = sq & 63, pos = 32 * ((k >> 2) & 1) + 16 * (k >> 5) + (k & 3) + 4 * ((k & 31) >> 3);
                    unsigned char* vtb = (unsigned char*)VA; const unsigned vo = (unsigned)(((r >> 12) * 2 + (wb - 10)) * 64 + 8 * fq) * S + (unsigned)((sq & ~63) + pos);
#pragma unroll
                    for (int bj = 0; bj < 2; ++bj)
#pragma unroll
                        for (int n = 0; n < 2; ++n) { const f32x4 x = acc[ai][bj][m][n]; const unsigned w = (unsigned)__builtin_amdgcn_cvt_pk_fp8_f32(x[2], x[3], __builtin_amdgcn_cvt_pk_fp8_f32(x[0], x[1], 0, false), true);
                            const unsigned qo = vo + (unsigned)(bj * 32 + 4 * n) * S;
                            vtb[qo] = (unsigned char)(w & 0xffu); vtb[qo + S] = (unsigned char)((w >> 8) & 0xffu); vtb[qo + 2 * S] = (unsigned char)((w >> 16) & 0xffu); vtb[qo + 3 * S] = (unsigned char)(w >> 24); }
#else
                    bf16_t* p = VA + (size_t)EPI_ROW(ai, m) * 128 + (wb - 10) * 64 + 8 * fq;
                    st16(p, pack8(acc[ai][0][m][0], acc[ai][0][m][1])); st16((p + 32), pack8(acc[ai][1][m][0], acc[ai][1][m][1]));
#endif
                }
        } else if (wb < 22) {
            const bool isq = wb < 18; const int idx = isq ? wb - 12 : wb - 18; bf16_t* dst = isq ? QLAT : KVLAT; const int dp = isq ? 384 : 256;
#pragma unroll
            for (int ai = 0; ai < 2; ++ai)
#pragma unroll
                for (int m = 0; m < 4; ++m) {
                    const int r = EPI_ROW(ai, m);
                    const f32x4 v00 = acc[ai][0][m][0], v01 = acc[ai][0][m][1], v10 = acc[ai][1][m][0], v11 = acc[ai][1][m][1];
                    float ss = (dot4(v00) + dot4(v01)) + (dot4(v10) + dot4(v11)); ss += __shfl_xor(ss, 16); ss += __shfl_xor(ss, 32);
                    if (fq == 0) { if (isq) SSQ[(size_t)r * 8 + idx] = ss; else SSKV[(size_t)r * 4 + idx] = ss; }
                    bf16_t* p = dst + (size_t)r * dp + idx * 64 + 8 * fq;
                    st16(p, pack8(v00, v01)); st16((p + 32), pack8(v10, v11));
                }
        } else if (wb == 22) {
            if (fq < 2) {
#pragma unroll
                for (int ai = 0; ai < 2; ++ai)
#pragma unroll
                    for (int m = 0; m < 4; ++m) {
                        const int r = EPI_ROW(ai, m), pos = r & (S - 1);
                        const f32x4 x10 = acc[ai][0][m][0], x11 = acc[ai][0][m][1], x20 = acc[ai][1][m][0], x21 = acc[ai][1][m][1];
                        const f32x4 c0 = *(const f32x4*)(cosB + pos * 16 + 8 * fq), c1 = *(const f32x4*)(cosB + pos * 16 + 8 * fq + 4), s0 = *(const f32x4*)(sinB + pos * 16 + 8 * fq), s1 = *(const f32x4*)(sinB + pos * 16 + 8 * fq + 4);
#if ATT_FP8_B
                        const u32x2 w1 = pack8_fp8(x10 * c0 - x20 * s0, x11 * c1 - x21 * s1), w2 = pack8_fp8(x20 * c0 + x10 * s0, x21 * c1 + x11 * s1);
                        unsigned char* p = (unsigned char*)KB + (size_t)r * 768 + 64 + 8 * fq;
#pragma unroll
                        for (int h = 0; h < 8; ++h) { st8(p + h * 96, w1); st8(p + h * 96 + 16, w2); }
#else
                        const u32x4 w1 = pack8(x10 * c0 - x20 * s0, x11 * c1 - x21 * s1), w2 = pack8(x20 * c0 + x10 * s0, x21 * c1 + x11 * s1);
                        bf16_t* p = KB + (size_t)r * 768 + 64 + 8 * fq;
#pragma unroll
                        for (int h = 0; h < 8; ++h) { st16((p + h * 96), w1); st16((p + h * 96 + 16), w2); }
#endif
                    }
            }
        } else if (wb == 23) {
        } else {
            const bool isa = wb < 40; const int idx = isa ? wb - 24 : wb - 40; unsigned char* dst = (unsigned char*)(isa ? SA : SB);
#pragma unroll
            for (int ai = 0; ai < 2; ++ai)
#pragma unroll
                for (int m = 0; m < 4; ++m) { unsigned char* p = dst + (size_t)EPI_ROW(ai, m) * 1024 + idx * 64 + 8 * fq;
#pragma unroll
                    for (int bj = 0; bj < 2; ++bj) { const f32x4 a = acc[ai][bj][m][0], b = acc[ai][bj][m][1]; u32x2 w;
                        w.x = (unsigned)__builtin_amdgcn_cvt_pk_fp8_f32(a[2], a[3], __builtin_amdgcn_cvt_pk_fp8_f32(a[0], a[1], 0, false), true);
                        w.y = (unsigned)__builtin_amdgcn_cvt_pk_fp8_f32(b[2], b[3], __builtin_amdgcn_cvt_pk_fp8_f32(b[0], b[1], 0, false), true);
                        st8((p + bj * 32), w); } }
        }
    }
};
__host__ __device__ __forceinline__ int src_col_in(int n) {
    const int pn = n >> 8, nl = n & 255, bj = nl >> 7, wc = (nl & 127) >> 5, p = nl & 31, wb = pn * 4 + wc, s = bj * 32 + p;
    if (wb < 8) return wb * 64 + s;
    if (wb < 10) return 512 + (wb - 8) * 64 + s;
    if (wb < 12) return 640 + (wb - 10) * 64 + s;
    if (wb < 18) return 768 + (wb - 12) * 64 + s;
    if (wb < 22) return 1152 + (wb - 18) * 64 + s;
    if (wb == 22) return p < 16 ? 1408 + bj * 16 + p : -1;
    if (wb == 23) return -1;
    if (wb < 40) return 1440 + (wb - 24) * 64 + s;
    return 2464 + (wb - 40) * 64 + s;
}
struct EpiQb {
    bf16_t* QB; const float *SSQ, *cosB, *sinB;
    __device__ __forceinline__ void operator()(const ACC_T, const Unit& u, int wr, int wc, int fr, int fq) const {
#pragma unroll
        for (int ai = 0; ai < 2; ++ai)
#pragma unroll
            for (int m = 0; m < 4; ++m) {
                const int r = EPI_ROW(ai, m), pos = r & (S - 1);
                const f32x4 sa = *(const f32x4*)(SSQ + (size_t)r * 8); const f32x2 sb = *(const f32x2*)(SSQ + (size_t)r * 8 + 4);
                const float rstd = rsqrtf((((sa[0] + sa[1]) + (sa[2] + sa[3])) + (sb[0] + sb[1])) * (1.f / 384.f) + EPS);
#pragma unroll
                for (int bj = 0; bj < 2; ++bj) {
                    f32x4 v0 = acc[ai][bj][m][0] * rstd, v1 = acc[ai][bj][m][1] * rstd;
                    const int c32 = u.pn * 8 + bj * 4 + wc;
                    if (c32 % 3 == 2) {
                        f32x4 o0, o1;
#pragma unroll
                        for (int j = 0; j < 4; ++j) { o0[j] = __shfl_xor(v0[j], 32); o1[j] = __shfl_xor(v1[j], 32); }
                        const int i0 = 8 * (fq & 1);
                        const f32x4 c0 = *(const f32x4*)(cosB + pos * 16 + i0), c1 = *(const f32x4*)(cosB + pos * 16 + i0 + 4), s0 = *(const f32x4*)(sinB + pos * 16 + i0), s1 = *(const f32x4*)(sinB + pos * 16 + i0 + 4);
                        if (fq < 2) { v0 = v0 * c0 - o0 * s0; v1 = v1 * c1 - o1 * s1; } else { v0 = v0 * c0 + o0 * s0; v1 = v1 * c1 + o1 * s1; }
                    }
#if ATT_FP8_B
                    st8((unsigned char*)QB + (size_t)r * 768 + EPI_COL(bj), pack8_fp8(v0 * QSCALE_B, v1 * QSCALE_B));
#else
                    st16((QB + (size_t)r * 768 + EPI_COL(bj)), pack8(v0 * QSCALE_B, v1 * QSCALE_B));
#endif
                }
            }
    }
};
struct EpiKvb {
    bf16_t *KB, *VB; const float* SSKV;
    __device__ __forceinline__ void operator()(const ACC_T, const Unit& u, int wr, int wc, int fr, int fq) const {
#pragma unroll
        for (int ai = 0; ai < 2; ++ai)
#pragma unroll
            for (int m = 0; m < 4; ++m) {
                const int r = EPI_ROW(ai, m);
                const f32x4 sa = *(const f32x4*)(SSKV + (size_t)r * 4);
                const float rstd = rsqrtf(((sa[0] + sa[1]) + (sa[2] + sa[3])) * (1.f / 256.f) + EPS);
#pragma unroll
                for (int bj = 0; bj < 2; ++bj) {
                    const int head = u.pn * 2 + bj, o = wc * 32 + fq * 8;
#if ATT_FP8_B
                    const f32x4 x0 = acc[ai][bj][m][0] * rstd, x1 = acc[ai][bj][m][1] * rstd;
                    if (wc < 2) st8((unsigned char*)KB + (size_t)r * 768 + head * 96 + o, pack8_fp8(x0, x1));
                    else {
                        const int sq = r & (S - 1), k = sq & 63, pos = 32 * ((k >> 2) & 1) + 16 * (k >> 5) + (k & 3) + 4 * ((k & 31) >> 3);
                        unsigned char* vtb = (unsigned char*)VB; const unsigned vo = (unsigned)(((r >> 12) * 8 + head) * 64 + (o - 64)) * S + (unsigned)((sq & ~63) + pos);
                        const u32x2 w = pack8_fp8(x0, x1);
                        vtb[vo] = (unsigned char)(w.x & 0xffu); vtb[vo + S] = (unsigned char)((w.x >> 8) & 0xffu); vtb[vo + 2 * S] = (unsigned char)((w.x >> 16) & 0xffu); vtb[vo + 3 * S] = (unsigned char)(w.x >> 24);
                        vtb[vo + 4 * S] = (unsigned char)(w.y & 0xffu); vtb[vo + 5 * S] = (unsigned char)((w.y >> 8) & 0xffu); vtb[vo + 6 * S] = (unsigned char)((w.y >> 16) & 0xffu); vtb[vo + 7 * S] = (unsigned char)(w.y >> 24);
                    }
#else
                    const u32x4 w = pack8(acc[ai][bj][m][0] * rstd, acc[ai][bj][m][1] * rstd);
                    if (wc < 2) st16((KB + (size_t)r * 768 + head * 96 + o), w); else st16((VB + (size_t)r * 512 + head * 64 + (o - 64)), w);
#endif
                }
            }
    }
};
template <int MODE> struct EpiProj {
    bf16_t* O; const bf16_t* gate;
    __device__ __forceinline__ void operator()(const ACC_T, const Unit& u, int wr, int wc, int fr, int fq) const {
#pragma unroll
        for (int ai = 0; ai < 2; ++ai)
#pragma unroll
            for (int m = 0; m < 4; ++m) {
                const int r = EPI_ROW(ai, m);
#pragma unroll
                for (int bj = 0; bj < 2; ++bj) {
                    const size_t off = (size_t)r * D + EPI_COL(bj);
                    const u32x2 gw = *(const u32x2*)((const unsigned char*)gate + off);
                    const f32x2 q0 = __builtin_amdgcn_cvt_pk_f32_fp8((int)gw.x, false), q1 = __builtin_amdgcn_cvt_pk_f32_fp8((int)gw.x, true), q2 = __builtin_amdgcn_cvt_pk_f32_fp8((int)gw.y, false), q3 = __builtin_amdgcn_cvt_pk_f32_fp8((int)gw.y, true);
                    const f32x4 g0 = {sigm(q0[0]), sigm(q0[1]), sigm(q1[0]), sigm(q1[1])}, g1 = {sigm(q2[0]), sigm(q2[1]), sigm(q3[0]), sigm(q3[1])};
                    f32x4 v0 = acc[ai][bj][m][0] * g0, v1 = acc[ai][bj][m][1] * g1;
                    if (MODE == 1) { f32x4 p0, p1; unpack8(*(const u32x4*)(O + off), p0, p1); v0 += p0; v1 += p1; }
                    if (MODE == 1) st16(O + off, pack8(v0, v1)); else *(u32x4*)(O + off) = pack8(v0, v1);
                }
            }
    }
};
struct EpiProjP {
    bf16_t* O; const unsigned char* SA; const unsigned char* SB;
    __device__ static __forceinline__ void gates(const unsigned char* G, size_t off, f32x4& g0, f32x4& g1) {
        const u32x2 gw = *(const u32x2*)(G + off);
        const f32x2 q0 = __builtin_amdgcn_cvt_pk_f32_fp8((int)gw.x, false), q1 = __builtin_amdgcn_cvt_pk_f32_fp8((int)gw.x, true), q2 = __builtin_amdgcn_cvt_pk_f32_fp8((int)gw.y, false), q3 = __builtin_amdgcn_cvt_pk_f32_fp8((int)gw.y, true);
        g0 = (f32x4){sigm(q0[0]), sigm(q0[1]), sigm(q1[0]), sigm(q1[1])}; g1 = (f32x4){sigm(q2[0]), sigm(q2[1]), sigm(q3[0]), sigm(q3[1])};
    }
    __device__ __forceinline__ void operator()(f32x4 (&acc)[2][2][4][2], const Unit& u, int wr, int wc, int fr, int fq) const {
#pragma unroll
        for (int ai = 0; ai < 2; ++ai)
#pragma unroll
            for (int m = 0; m < 4; ++m) {
                const int r = EPI_ROW(ai, m);
#pragma unroll
                for (int bj = 0; bj < 2; ++bj) {
                    const size_t off = (size_t)r * D + EPI_COL(bj);
                    f32x4 b0, b1; gates(SB, off, b0, b1);
#pragma unroll
                    for (int j = 0; j < 4; ++j) { b0[j] = fmaxf(b0[j], 9.094947e-13f); b1[j] = fmaxf(b1[j], 9.094947e-13f); }
                    if (u.be == 0) {
                        f32x4 a0, a1; gates(SA, off, a0, a1);
#pragma unroll
                        for (int j = 0; j < 4; ++j) { acc[ai][bj][m][0][j] *= a0[j] * __builtin_amdgcn_rcpf(b0[j]); acc[ai][bj][m][1][j] *= a1[j] * __builtin_amdgcn_rcpf(b1[j]); }
                    } else st16(O + off, pack8(acc[ai][bj][m][0] * b0, acc[ai][bj][m][1] * b1));
                }
            }
    }
};
template <> struct EpiTraits<EpiProjP> { static constexpr bool KEEP = true; };
struct EpiWo {
    const bf16_t* X; const float* modl; bf16_t* XO;
    __device__ __forceinline__ void operator()(const ACC_T, const Unit& u, int wr, int wc, int fr, int fq) const {
        const float* g1 = modl + (size_t)(u.pm >> 4) * 6 * D + 2 * D;
#pragma unroll
        for (int bj = 0; bj < 2; ++bj) {
            const int c = EPI_COL(bj); const f32x4 ga = *(const f32x4*)(g1 + c), gb = *(const f32x4*)(g1 + c + 4);
#pragma unroll
            for (int ai = 0; ai < 2; ++ai)
#pragma unroll
                for (int m = 0; m < 4; ++m) { const size_t off = (size_t)EPI_ROW(ai, m) * D + c;
                    f32x4 x0, x1; unpack8(*(const u32x4*)(X + off), x0, x1);
                    st16((XO + off), pack8(x0 + ga * acc[ai][bj][m][0], x1 + gb * acc[ai][bj][m][1])); }
        }
    }
};
struct EpiUp {
    bf16_t* ACT; float inscale;
    __device__ __forceinline__ void operator()(const ACC_T, const Unit& u, int wr, int wc, int fr, int fq) const {
#pragma unroll
        for (int ai = 0; ai < 2; ++ai)
#pragma unroll
            for (int m = 0; m < 4; ++m) {
                f32x4 a = acc[ai][0][m][0] * inscale, b = acc[ai][0][m][1] * inscale; const f32x4 c = acc[ai][1][m][0] * inscale, d = acc[ai][1][m][1] * inscale;
#pragma unroll
                for (int j = 0; j < 4; ++j) { a[j] = a[j] * sigm(a[j]) * c[j]; b[j] = b[j] * sigm(b[j]) * d[j]; }
#if MOE_FP8
                st8((unsigned char*)ACT + (size_t)EPI_ROW(ai, m) * FF + u.pn * 128 + wc * 32 + fq * 8, pack8_fp8(a * 8.f, b * 8.f));
#else
                st16((ACT + (size_t)EPI_ROW(ai, m) * FF + u.pn * 128 + wc * 32 + fq * 8), pack8(a, b));
#endif
            }
    }
};
struct EpiDown {
    bf16_t* Y2; const unsigned* list; const float* gw; float inscale;
    __device__ __forceinline__ void operator()(const ACC_T, const Unit& u, int wr, int wc, int fr, int fq) const {
#pragma unroll
        for (int ai = 0; ai < 2; ++ai)
#pragma unroll
            for (int m = 0; m < 4; ++m) {
                const int rloc = ai * 128 + wr * 64 + m * 16 + fr;
                if (rloc < u.nv) {
                    const unsigned entry = list[(size_t)u.be * T + u.rl * 256 + rloc]; const float w = gw[entry] * inscale;
#pragma unroll
                    for (int bj = 0; bj < 2; ++bj) { const f32x4 a = acc[ai][bj][m][0] * (w * 16.f), b = acc[ai][bj][m][1] * (w * 16.f); u32x2 q;
                        q.x = (unsigned)__builtin_amdgcn_cvt_pk_fp8_f32(a[2], a[3], __builtin_amdgcn_cvt_pk_fp8_f32(a[0], a[1], 0, false), true);
                        q.y = (unsigned)__builtin_amdgcn_cvt_pk_fp8_f32(b[2], b[3], __builtin_amdgcn_cvt_pk_fp8_f32(b[0], b[1], 0, false), true);
                        st8(((unsigned char*)Y2 + (size_t)entry * D + EPI_COL(bj)), q); }
                }
            }
    }
};
}

namespace at {
struct Tensors { const bf16_t* Q; int qp; const bf16_t* K; int kp; const bf16_t* V; int vp; bf16_t* O; int op; int group; };
__device__ __forceinline__ bool next_unit(int i, int vcu, int G, int& bh, int& qb) {
    int u;
    if (G == 256) { if (i >= 4) return false; u = (vcu >> 5) * 128 + i * 32 + (vcu & 31); }
    else { u = i * G + vcu; if (u >= 1024) return false; }
    bh = u >> 4; qb = u & 15; return true;
}
template <int DQK>
__device__ __forceinline__ void attn_phase_ref(int tid, const Tensors& A, int vcu, int G) {
    int bh, qb;
    for (int i = 0; next_unit(i, vcu, G, bh, qb); ++i) {
        const int b = bh >> 3, h = bh & 7, kvh = h / A.group;
        {
            const int dh = tid >> 8;
            const size_t row = (size_t)b * S + qb * 256 + (tid & 255);
            float q[DQK], o[32];
#pragma unroll
            for (int d = 0; d < DQK; ++d) q[d] = bf2f(A.Q[row * A.qp + h * DQK + d]);
#pragma unroll
            for (int d = 0; d < 32; ++d) o[d] = 0.f;
            float l = 0.f;
            for (int k = 0; k < S; ++k) {
                const bf16_t* kr = A.K + ((size_t)b * S + k) * A.kp + kvh * DQK; const bf16_t* vr = A.V + ((size_t)b * S + k) * A.vp + kvh * 64 + dh * 32;
                float sc = 0.f;
#pragma unroll
                for (int d = 0; d < DQK; d += 8) { f32x4 k0, k1; unpack8(*(const u32x4*)(kr + d), k0, k1);
                    sc += q[d] * k0[0] + q[d + 1] * k0[1] + q[d + 2] * k0[2] + q[d + 3] * k0[3] + q[d + 4] * k1[0] + q[d + 5] * k1[1] + q[d + 6] * k1[2] + q[d + 7] * k1[3]; }
                const float p = bf2f(cvt_pk_bf16(exp2f(sc), 0.f) & 0xffffu); l += p;
#pragma unroll
                for (int d = 0; d < 32; d += 8) { f32x4 v0, v1; unpack8(*(const u32x4*)(vr + d), v0, v1);
                    o[d] += p * v0[0]; o[d + 1] += p * v0[1]; o[d + 2] += p * v0[2]; o[d + 3] += p * v0[3]; o[d + 4] += p * v1[0]; o[d + 5] += p * v1[1]; o[d + 6] += p * v1[2]; o[d + 7] += p * v1[3]; }
            }
            const float il = 1.f / l;
            __syncthreads();
#pragma unroll
            for (int d = 0; d < 32; d += 8) { f32x4 a = {o[d] * il, o[d + 1] * il, o[d + 2] * il, o[d + 3] * il}, c = {o[d + 4] * il, o[d + 5] * il, o[d + 6] * il, o[d + 7] * il};
                *(u32x4*)(A.O + row * A.op + h * 64 + dh * 32 + d) = pack8(a, c); }
        }
    }
}
#if FAST_ATTN
typedef short s16x4 __attribute__((ext_vector_type(4)));
__device__ __forceinline__ unsigned cvtpk(float lo, float hi) { f32x2 v = {lo, hi}; bf16x2_t b = __builtin_convertvector(v, bf16x2_t); return __builtin_bit_cast(unsigned, b); }
__device__ __forceinline__ s16x4 vtr(const LAS unsigned char* p) { return __builtin_bit_cast(s16x4, __builtin_amdgcn_ds_read_tr16_b64_v4i16((LAS s16x4*)p)); }
__device__ __forceinline__ int crow(int r, int hi) { return (r & 3) + 8 * (r >> 2) + 4 * hi; }
#define AT_BAR() asm volatile("s_barrier" ::: "memory")
#define AT_WAITBAR(N) asm volatile("s_waitcnt vmcnt(" #N ") lgkmcnt(0)\n\ts_barrier" ::: "memory")
#define AT_SCHED() __builtin_amdgcn_sched_barrier(0)
__device__ __forceinline__ void glds16(const void* gsrc, unsigned lds_dst) { unsigned keep;
    asm volatile("s_mov_b32 %0, m0\n\ts_mov_b32 m0, %2\n\ts_nop 0\n\tglobal_load_lds_dwordx4 %1, off\n\ts_mov_b32 m0, %0" : "=&s"(keep) : "v"(gsrc), "s"(lds_dst) : "memory"); }
#define AT_GLDS(g, l) glds16((const void*)(g), (unsigned)__builtin_amdgcn_readfirstlane((int)(unsigned)(uintptr_t)(l)))
template <int DQK>
__device__ __forceinline__ void attn_unit(int tid, LAS unsigned char* lds, const Tensors& A, int b, int h, int qb) {
    constexpr int ND = DQK / 16, NCH = DQK / 8, KSLOT = NCH * 1024, NKD = NCH > 8 ? 2 : 1, VSLOT = 8192, NT = S / 64;
    constexpr int KOFF = 0, VOFF = 3 * KSLOT, OST = VOFF + 3 * VSLOT, WSF = OST + 8 * 4096;
    static_assert(WSF + 8 * 256 <= RING_BYTES, "attention LDS");
    const int lane = tid & 63, r32 = lane & 31, hi = lane >> 5, wid = __builtin_amdgcn_readfirstlane(tid >> 6);
    const int kvh = h / A.group; const size_t rowb = (size_t)b * S;
    const bf16_t* ksrc = A.K + (rowb + lane) * A.kp + kvh * DQK + wid * 8;
    const bf16_t* ksrc2 = A.K + (rowb + lane) * A.kp + kvh * DQK + (8 + (wid & 3)) * 8;
    const bf16_t* vsrc = A.V + (rowb + 16 * (wid & 3) + (lane >> 2)) * A.vp + kvh * 64 + (wid >> 2) * 32 + (lane & 3) * 8;
    const size_t ktile = (size_t)64 * A.kp, vtile = (size_t)64 * A.vp;
    LAS unsigned char* kdst = lds + KOFF + wid * 1024; LAS unsigned char* kdst2 = lds + KOFF + (8 + (wid & 3)) * 1024; LAS unsigned char* vdst = lds + VOFF + wid * 1024;
#define DMA_K(j, so) do { AT_GLDS(ksrc + (size_t)(j) * ktile, kdst + (so)); if (NKD == 2) AT_GLDS(ksrc2 + (size_t)(j) * ktile, kdst2 + (so)); } while (0)
#define DMA_V(j, so) AT_GLDS(vsrc + (size_t)(j) * vtile, vdst + (so))
    const LAS unsigned char* kp0 = lds + KOFF + hi * 1024 + r32 * 16;
    const LAS unsigned char* vp0 = lds + VOFF + ((lane >> 4) & 1) * 32 + (lane & 3) * 8 + (4 * hi + ((lane & 15) >> 2)) * 64;
    DMA_K(0, 0); DMA_V(0, 0); DMA_K(1, KSLOT); DMA_V(1, VSLOT); DMA_K(2, 2 * KSLOT);
    const bf16_t* Qw = A.Q + (rowb + qb * 256 + wid * 32 + r32) * A.qp + h * DQK + hi * 8;
    bf16x8 qr[ND];
#pragma unroll
    for (int d0 = 0; d0 < ND; ++d0) qr[d0] = *(const bf16x8*)(Qw + d0 * 16);
    asm volatile("s_waitcnt vmcnt(0)\n\ts_barrier" ::: "memory");
    bf16x8 kf[2 * ND]; s16x4 vlo[8], vhi[8];
#define KLOAD(so) do { _Pragma("unroll") for (int d0 = 0; d0 < ND; ++d0) { kf[2 * d0] = *(const LAS bf16x8*)(kp0 + (so) + d0 * 2048); kf[2 * d0 + 1] = *(const LAS bf16x8*)(kp0 + (so) + d0 * 2048 + 512); } } while (0)
#define VLOAD(so) do { _Pragma("unroll") for (int i = 0; i < 8; ++i) { vlo[i] = vtr(vp0 + (so) + (i >> 2) * 4096 + (i & 3) * 1024); vhi[i] = vtr(vp0 + (so) + (i >> 2) * 4096 + (i & 3) * 1024 + 512); } } while (0)
#define VFR(i) (bf16x8){vlo[i][0], vlo[i][1], vlo[i][2], vlo[i][3], vhi[i][0], vhi[i][1], vhi[i][2], vhi[i][3]}
    KLOAD(0);
    asm volatile("s_waitcnt lgkmcnt(0)" ::: "memory");
    if (PROBE_ATT != 5 && wid >= 4) AT_BAR();
    f32x16 o0 = {}, o1 = {}, C0, C1; u32x4 pw0, pw1, pw2, pw3; float lsum = 0.f;
    const f32x16 zero = {};
#define QK_BLOCK() do { C0 = __builtin_amdgcn_mfma_f32_32x32x16_bf16(kf[0], qr[0], zero, 0, 0, 0); C1 = __builtin_amdgcn_mfma_f32_32x32x16_bf16(kf[1], qr[0], zero, 0, 0, 0); \
        _Pragma("unroll") for (int d0 = 1; d0 < ND; ++d0) { C0 = __builtin_amdgcn_mfma_f32_32x32x16_bf16(kf[2 * d0], qr[d0], C0, 0, 0, 0); C1 = __builtin_amdgcn_mfma_f32_32x32x16_bf16(kf[2 * d0 + 1], qr[d0], C1, 0, 0, 0); } } while (0)
#define PAF(k) __builtin_bit_cast(bf16x8, pw##k)
#define PV_BLOCK() do { \
        o0 = __builtin_amdgcn_mfma_f32_32x32x16_bf16(PAF(0), VFR(0), o0, 0, 0, 0); o1 = __builtin_amdgcn_mfma_f32_32x32x16_bf16(PAF(0), VFR(4), o1, 0, 0, 0); \
        o0 = __builtin_amdgcn_mfma_f32_32x32x16_bf16(PAF(1), VFR(1), o0, 0, 0, 0); o1 = __builtin_amdgcn_mfma_f32_32x32x16_bf16(PAF(1), VFR(5), o1, 0, 0, 0); \
        o0 = __builtin_amdgcn_mfma_f32_32x32x16_bf16(PAF(2), VFR(2), o0, 0, 0, 0); o1 = __builtin_amdgcn_mfma_f32_32x32x16_bf16(PAF(2), VFR(6), o1, 0, 0, 0); \
        o0 = __builtin_amdgcn_mfma_f32_32x32x16_bf16(PAF(3), VFR(3), o0, 0, 0, 0); o1 = __builtin_amdgcn_mfma_f32_32x32x16_bf16(PAF(3), VFR(7), o1, 0, 0, 0); } while (0)
#define SOFTMAX() do { \
        _Pragma("unroll") for (int r = 0; r < 16; ++r) { C0[r] = __builtin_amdgcn_exp2f(C0[r]); C1[r] = __builtin_amdgcn_exp2f(C1[r]); } \
        f32x2 s0_ = {C0[0], C0[1]}, s1_ = {C1[0], C1[1]}; _Pragma("unroll") for (int r = 2; r < 16; r += 2) { s0_ += (f32x2){C0[r], C0[r + 1]}; s1_ += (f32x2){C1[r], C1[r + 1]}; } s0_ += s1_; lsum += s0_[0] + s0_[1]; \
        pw0 = (u32x4){cvtpk(C0[0], C0[1]), cvtpk(C0[2], C0[3]), cvtpk(C0[4], C0[5]), cvtpk(C0[6], C0[7])}; pw1 = (u32x4){cvtpk(C0[8], C0[9]), cvtpk(C0[10], C0[11]), cvtpk(C0[12], C0[13]), cvtpk(C0[14], C0[15])}; \
        pw2 = (u32x4){cvtpk(C1[0], C1[1]), cvtpk(C1[2], C1[3]), cvtpk(C1[4], C1[5]), cvtpk(C1[6], C1[7])}; pw3 = (u32x4){cvtpk(C1[8], C1[9]), cvtpk(C1[10], C1[11]), cvtpk(C1[12], C1[13]), cvtpk(C1[14], C1[15])}; } while (0)
    int ka = 2 * KSLOT, kb = 0, kc = KSLOT, va = 2 * VSLOT, vb = 0, vc = VSLOT;
#define ROT() do { const int t_ = ka; ka = kb; kb = kc; kc = t_; const int u_ = va; va = vb; vb = vc; vc = u_; } while (0)
#define PINP() asm volatile("" : "+v"(lsum) : "v"(pw0), "v"(pw1), "v"(pw2), "v"(pw3))
#if ATT_REGSTAGE
    u32x4 kst = {}, kst2 = {}, vst = {};
    const LAS unsigned char* kw = lds + KOFF + wid * 1024 + lane * 16; const LAS unsigned char* kw2 = lds + KOFF + (8 + (wid & 3)) * 1024 + lane * 16; const LAS unsigned char* vw = lds + VOFF + wid * 1024 + lane * 16;
#define ST_WRITE(WK, WV) do { if (WK) { *(LAS u32x4*)(kw + ka) = kst; if (NKD == 2 && wid < 4) *(LAS u32x4*)(kw2 + ka) = kst2; } if (WV) *(LAS u32x4*)(vw + vc) = vst; } while (0)
#define ST_LOAD(sv, IK, IV) do { if (IK) { kst = *(const u32x4*)(ksrc + (size_t)((sv) + 4) * ktile); if (NKD == 2 && wid < 4) kst2 = *(const u32x4*)(ksrc2 + (size_t)((sv) + 4) * ktile); } if (IV) vst = *(const u32x4*)(vsrc + (size_t)((sv) + 3) * vtile); } while (0)
#define STEP(sv, DOQK, DOPV, KL, VL, IK, IV, WK, WV) do { \
        AT_SCHED(); if (DOQK) QK_BLOCK(); if (DOPV) PV_BLOCK(); AT_SCHED(); \
        asm volatile("s_barrier\n\ts_nop 15\n\ts_nop 3" : "+v"(C0), "+v"(C1), "+v"(o0), "+v"(o1) :: "memory"); AT_SCHED(); \
        if (KL) KLOAD(kc); if (VL) VLOAD(vb); ST_WRITE(WK, WV); ST_LOAD(sv, IK, IV); \
        if (DOQK) { SOFTMAX(); PINP(); } AT_SCHED(); \
        asm volatile("s_waitcnt lgkmcnt(0)\n\ts_barrier" ::: "memory"); \
        AT_SCHED(); ROT(); } while (0)
    STEP(-1, true, false, true, true, true, true, false, false);
#pragma nounroll
    for (int s = 0; s < NT - 4; ++s) STEP(s, true, true, true, true, true, true, true, true);
    STEP(NT - 4, true, true, true, true, false, true, true, true);
    STEP(NT - 3, true, true, true, true, false, false, false, true);
    STEP(NT - 2, true, true, false, true, false, false, false, false);
    STEP(NT - 1, false, true, false, false, false, false, false, false);
#undef ST_WRITE
#undef ST_LOAD
#else
#define STEP(sv, DOQK, DOPV, KL, VL, IK, IV) do { \
        AT_SCHED(); if (DOQK) QK_BLOCK(); if (DOPV) PV_BLOCK(); AT_SCHED(); \
          \
        asm volatile("s_barrier\n\ts_nop 15\n\ts_nop 3" : "+v"(C0), "+v"(C1), "+v"(o0), "+v"(o1) :: "memory"); AT_SCHED(); \
        if (KL) KLOAD(kc); if (VL) VLOAD(vb); if (IK) DMA_K((sv) + 4, kb); if (IV) DMA_V((sv) + 3, va); \
        if (DOQK) { SOFTMAX(); PINP(); } AT_SCHED(); \
        if (IK) { if (NKD == 2) { AT_WAITBAR(3); } else { AT_WAITBAR(2); } } else if (IV) { AT_WAITBAR(1); } else { AT_WAITBAR(0); } \
        AT_SCHED(); ROT(); } while (0)
    STEP(-1, true, false, true, true, true, true);
#pragma nounroll
    for (int s = 0; s < NT - 4; ++s) STEP(s, true, true, true, true, true, true);
    STEP(NT - 4, true, true, true, true, false, true);
    STEP(NT - 3, true, true, true, true, false, false);
    STEP(NT - 2, true, true, false, true, false, false);
    STEP(NT - 1, false, true, false, false, false, false);
#endif
#undef STEP
#undef PINP
    if (PROBE_ATT != 5 && wid < 4) AT_BAR();
    { auto rr = __builtin_amdgcn_permlane32_swap(__float_as_uint(lsum), __float_as_uint(lsum), false, false); lsum = __uint_as_float(rr[0]) + __uint_as_float(rr[1]); }
    LAS float* wsf = (LAS float*)(lds + WSF + wid * 256);
    if (hi == 0) wsf[r32] = lsum;
    asm volatile("s_waitcnt lgkmcnt(0)" ::: "memory");
    LAS bf16_t* stg = (LAS bf16_t*)(lds + OST + wid * 4096);
#pragma unroll
    for (int r = 0; r < 16; ++r) { const int orow = crow(r, hi); const float rl = __builtin_amdgcn_rcpf(wsf[orow]);
        stg[orow * 64 + r32] = (bf16_t)(cvtpk(o0[r] * rl, 0.f) & 0xffffu); stg[orow * 64 + 32 + r32] = (bf16_t)(cvtpk(o1[r] * rl, 0.f) & 0xffffu); }
    asm volatile("s_waitcnt lgkmcnt(0)" ::: "memory");
    bf16_t* Ow = A.O + (rowb + qb * 256 + wid * 32) * A.op + h * 64;
#pragma unroll
    for (int i = 0; i < 4; ++i) { const int row = i * 8 + (lane >> 3), ch = lane & 7; const u32x4 v = *(const LAS u32x4*)(stg + row * 64 + ch * 8); st16((Ow + (size_t)row * A.op + ch * 8), v); }
    asm volatile("s_waitcnt lgkmcnt(0)\n\ts_barrier" ::: "memory");
#undef DMA_K
#undef DMA_V
#undef KLOAD
#undef VLOAD
#undef VFR
#undef QK_BLOCK
#undef PAF
#undef PV_BLOCK
#undef SOFTMAX
#undef ROT
}
#endif
#if FAST_ATTN && ATT_FP8_A
typedef int v8i __attribute__((ext_vector_type(8)));
__device__ __forceinline__ f32x16 mfma8(v8i a, v8i b, f32x16 c) { return __builtin_amdgcn_mfma_scale_f32_32x32x64_f8f6f4(a, b, c, 0, 0, 0, 0x7f7f7f7f, 0, 0x7f7f7f7f); }
__device__ __forceinline__ f32x16 mfma8pv(v8i a, v8i b, f32x16 c) { return __builtin_amdgcn_mfma_scale_f32_32x32x64_f8f6f4(a, b, c, 1, 0, 0, 0x7f7f7f7f, 0, 0x7f7f7f7f); }
__device__ __forceinline__ void attn_unit_f8a(int tid, LAS unsigned char* lds, const unsigned char* Q8, const unsigned char* K8, const unsigned char* VT8, bf16_t* O, int op, int b, int h, int qb, float bias) {
    constexpr int SL = 4096, NT = S / 64;
    constexpr int KOFF = 0, VOFF = 3 * SL, OST = VOFF + 3 * SL, WSF = OST + 8 * 4096;
    const int lane = tid & 63, r32 = lane & 31, hi = lane >> 5, wid = __builtin_amdgcn_readfirstlane(tid >> 6);
    const int kvh = h >> 2; const size_t rowb = (size_t)b * S; const bool kw = wid < 4;
    const unsigned char* src = kw ? K8 + (rowb + lane) * 128 + kvh * 64 + 16 * wid : VT8 + ((size_t)((b * 2 + kvh) * 64 + lane)) * S + 16 * (wid - 4);
    const size_t tstep = kw ? (size_t)64 * 128 : (size_t)64;
    LAS unsigned char* dst = lds + (kw ? KOFF + wid * 1024 : VOFF + (wid - 4) * 1024);
#define DMA8(j, so) AT_GLDS(src + (size_t)(j) * tstep, dst + (so))
    const LAS unsigned char* kp0 = lds + KOFF + (2 * hi) * 1024 + r32 * 16;
    const LAS unsigned char* vp0 = lds + VOFF + (2 * hi) * 1024 + r32 * 16;
    if (kw) { DMA8(0, 0); DMA8(1, SL); DMA8(2, 2 * SL); } else { DMA8(0, 0); DMA8(1, SL); }
    v8i qf; { const unsigned char* Qw = Q8 + (rowb + qb * 256 + wid * 32 + r32) * 512 + h * 64 + 32 * hi; const u32x4 a = *(const u32x4*)Qw, c = *(const u32x4*)(Qw + 16);
        qf = (v8i){(int)a.x, (int)a.y, (int)a.z, (int)a.w, (int)c.x, (int)c.y, (int)c.z, (int)c.w}; }
    asm volatile("s_waitcnt vmcnt(0)\n\ts_barrier" ::: "memory");
    v8i kf0, kf1, vf0, vf1, p8;
#define LD32(dstv, p) do { const u32x4 a_ = *(const LAS u32x4*)(p), c_ = *(const LAS u32x4*)((p) + 1024); dstv = (v8i){(int)a_.x, (int)a_.y, (int)a_.z, (int)a_.w, (int)c_.x, (int)c_.y, (int)c_.z, (int)c_.w}; } while (0)
#define KLOAD8(so) do { LD32(kf0, kp0 + (so)); LD32(kf1, kp0 + (so) + 512); } while (0)
#define VLOAD8(so) do { LD32(vf0, vp0 + (so)); LD32(vf1, vp0 + (so) + 512); } while (0)
    KLOAD8(0);
    asm volatile("s_waitcnt lgkmcnt(0)" ::: "memory");
    if (wid >= 4) AT_BAR();
    f32x16 o0 = {}, o1 = {}, o2 = {}, C0, C1;
    const v8i ones = {0x38383838, 0x38383838, 0x38383838, 0x38383838, 0x38383838, 0x38383838, 0x38383838, 0x38383838};
    f32x16 negb;
#pragma unroll
    for (int r = 0; r < 16; ++r) negb[r] = bias;
    asm volatile("" : "+v"(negb));
#define SOFTMAX8() do { \
        _Pragma("unroll") for (int i = 0; i < 4; ++i) { \
            const f32x2 a_ = (f32x2){C0[4 * i], C0[4 * i + 1]} * 4.f + 60.26f, b_ = (f32x2){C0[4 * i + 2], C0[4 * i + 3]} * 4.f + 60.26f, c_ = (f32x2){C1[4 * i], C1[4 * i + 1]} * 4.f + 60.26f, d_ = (f32x2){C1[4 * i + 2], C1[4 * i + 3]} * 4.f + 60.26f; \
            p8[i] = (int)__builtin_amdgcn_cvt_pk_u8_f32(b_[1], 3, __builtin_amdgcn_cvt_pk_u8_f32(b_[0], 2, __builtin_amdgcn_cvt_pk_u8_f32(a_[1], 1, __builtin_amdgcn_cvt_pk_u8_f32(a_[0], 0, 0u)))); \
            p8[4 + i] = (int)__builtin_amdgcn_cvt_pk_u8_f32(d_[1], 3, __builtin_amdgcn_cvt_pk_u8_f32(d_[0], 2, __builtin_amdgcn_cvt_pk_u8_f32(c_[1], 1, __builtin_amdgcn_cvt_pk_u8_f32(c_[0], 0, 0u)))); } } while (0)
    int oa = 2 * SL, ob = 0, oc = SL;
#define ROT8() do { const int t_ = oa; oa = ob; ob = oc; oc = t_; } while (0)
#define STEP8(sv, DOQK, DOPV, KL, VL, IK, IV) do { \
        AT_SCHED(); if (DOQK) { C0 = mfma8(kf0, qf, negb); C1 = mfma8(kf1, qf, negb); } if (DOPV) { o0 = mfma8pv(p8, vf0, o0); o1 = mfma8pv(p8, vf1, o1); o2 = mfma8pv(p8, ones, o2); } AT_SCHED(); \
        asm volatile("s_barrier\n\ts_nop 15\n\ts_nop 15" : "+v"(C0), "+v"(C1), "+v"(o0), "+v"(o1), "+v"(o2) :: "memory"); AT_SCHED(); \
        if (KL) KLOAD8(oc); if (VL) VLOAD8(ob); \
        const bool iss_ = kw ? (IK) : (IV); if (iss_) { if (kw) DMA8((sv) + 4, ob); else DMA8((sv) + 3, oa); } \
        if (DOQK) { SOFTMAX8(); asm volatile("" :: "v"(p8)); } AT_SCHED(); \
        if (iss_) { AT_WAITBAR(1); } else { AT_WAITBAR(0); } \
        AT_SCHED(); ROT8(); } while (0)
    STEP8(-1, true, false, true, true, true, true);
#pragma nounroll
    for (int s = 0; s < NT - 4; ++s) STEP8(s, true, true, true, true, true, true);
    STEP8(NT - 4, true, true, true, true, false, true);
    STEP8(NT - 3, true, true, true, true, false, false);
    STEP8(NT - 2, true, true, false, true, false, false);
    STEP8(NT - 1, false, true, false, false, false, false);
    if (wid < 4) AT_BAR();
    LAS bf16_t* stg = (LAS bf16_t*)(lds + OST + wid * 4096);
#pragma unroll
    for (int r = 0; r < 16; ++r) { const int orow = crow(r, hi); const float rl = __builtin_amdgcn_rcpf(o2[r]);
        stg[orow * 64 + r32] = (bf16_t)(cvtpk(o0[r] * rl, 0.f) & 0xffffu); stg[orow * 64 + 32 + r32] = (bf16_t)(cvtpk(o1[r] * rl, 0.f) & 0xffffu); }
    asm volatile("s_waitcnt lgkmcnt(0)" ::: "memory");
    bf16_t* Ow = O + (rowb + qb * 256 + wid * 32) * op + h * 64;
#pragma unroll
    for (int i = 0; i < 4; ++i) { const int row = i * 8 + (lane >> 3), ch = lane & 7; const u32x4 v = *(const LAS u32x4*)(stg + row * 64 + ch * 8); st16(Ow + (size_t)row * op + ch * 8, v); }
    asm volatile("s_waitcnt lgkmcnt(0)\n\ts_barrier" ::: "memory");
#undef DMA8
#undef LD32
#undef KLOAD8
#undef VLOAD8
#undef SOFTMAX8
#undef ROT8
#undef STEP8
}
__device__ __forceinline__ void attn_phase_f8a(int tid, LAS unsigned char* lds, const unsigned char* Q8, const unsigned char* K8, const unsigned char* VT8, bf16_t* O, int op, const float* gq, const float* gk, int vcu, int G) {
    float mq = 0.f, mk = 0.f;
    for (int i = 0; i < 64; ++i) { mq = fmaxf(mq, fabsf(gq[i])); mk = fmaxf(mk, fabsf(gk[i])); }
    const float bias = -fmaxf(64.f * mq * mk * QSCALE_A * 1.13f - 15.5f, 0.f);
    int bh, qb;
    for (int i = 0; next_unit(i, vcu, G, bh, qb); ++i) attn_unit_f8a(tid, lds, Q8, K8, VT8, O, op, bh >> 3, bh & 7, qb, bias);
}
#endif
#if FAST_ATTN && ATT_FP8_B
__device__ __forceinline__ void attn_unit_f8b(int tid, LAS unsigned char* lds, const unsigned char* Q8, const unsigned char* K8, const unsigned char* VT8, bf16_t* O, int op, int b, int h, int qb) {
    constexpr int SLK = 6144, SLV = 4096, NT = S / 64;
    constexpr int KOFF = 0, VOFF = 3 * SLK, OST = VOFF + 3 * SLV, WSF = OST + 8 * 4096;
    static_assert(WSF + 2048 <= RING_BYTES, "attention LDS");
    const int lane = tid & 63, r32 = lane & 31, hi = lane >> 5, wid = __builtin_amdgcn_readfirstlane(tid >> 6);
    const size_t rowb = (size_t)b * S; const bool kw = wid < 6, vw = wid >= 4;
    const unsigned char* ksrc = K8 + (rowb + lane) * 768 + h * 96 + 16 * wid;
    const unsigned char* vsrc = VT8 + ((size_t)((b * 8 + h) * 64 + lane)) * S + 16 * (wid - 4);
    LAS unsigned char* kdst = lds + KOFF + wid * 1024; LAS unsigned char* vdst = lds + VOFF + (wid - 4) * 1024;
#define DMAK(j, so) AT_GLDS(ksrc + (size_t)(j) * (64 * 768), kdst + (so))
#define DMAV(j, so) AT_GLDS(vsrc + (size_t)(j) * 64, vdst + (so))
    const LAS unsigned char* kp0 = lds + KOFF + (2 * hi) * 1024 + r32 * 16;
    const LAS unsigned char* kr0 = lds + KOFF + 4 * 1024 + r32 * 16;
    const LAS unsigned char* vp0 = lds + VOFF + (2 * hi) * 1024 + r32 * 16;
    if (kw) { DMAK(0, 0); DMAK(1, SLK); DMAK(2, 2 * SLK); }
    if (vw) { DMAV(0, 0); DMAV(1, SLV); }
    v8i qn, qr;
    { const unsigned char* Qw = Q8 + (rowb + qb * 256 + wid * 32 + r32) * 768 + h * 96; const u32x4 a = *(const u32x4*)(Qw + 32 * hi), c = *(const u32x4*)(Qw + 32 * hi + 16), e = *(const u32x4*)(Qw + 64), f = *(const u32x4*)(Qw + 80);
      qn = (v8i){(int)a.x, (int)a.y, (int)a.z, (int)a.w, (int)c.x, (int)c.y, (int)c.z, (int)c.w};
      qr = hi ? (v8i){0, 0, 0, 0, 0, 0, 0, 0} : (v8i){(int)e.x, (int)e.y, (int)e.z, (int)e.w, (int)f.x, (int)f.y, (int)f.z, (int)f.w}; }
    asm volatile("s_waitcnt vmcnt(0)\n\ts_barrier" ::: "memory");
    v8i kn0, kn1, kr0v, kr1v, vf0, vf1, p8;
#define LD32(dstv, p) do { const u32x4 a_ = *(const LAS u32x4*)(p), c_ = *(const LAS u32x4*)((p) + 1024); dstv = (v8i){(int)a_.x, (int)a_.y, (int)a_.z, (int)a_.w, (int)c_.x, (int)c_.y, (int)c_.z, (int)c_.w}; } while (0)
#define KLOAD8(so) do { LD32(kn0, kp0 + (so)); LD32(kn1, kp0 + (so) + 512); LD32(kr0v, kr0 + (so)); LD32(kr1v, kr0 + (so) + 512); } while (0)
#define VLOAD8(so) do { LD32(vf0, vp0 + (so)); LD32(vf1, vp0 + (so) + 512); } while (0)
    KLOAD8(0);
    asm volatile("s_waitcnt lgkmcnt(0)" ::: "memory");
    if (wid >= 4) AT_BAR();
    f32x16 o0 = {}, o1 = {}, o2 = {}, C0, C1; const f32x16 zero = {};
    const v8i ones = {0x38383838, 0x38383838, 0x38383838, 0x38383838, 0x38383838, 0x38383838, 0x38383838, 0x38383838};
#define SOFTMAX8() do { \
        _Pragma("unroll") for (int i = 0; i < 4; ++i) { \
            const f32x2 a_ = (f32x2){C0[4 * i], C0[4 * i + 1]} * 4.f + 60.26f, b_ = (f32x2){C0[4 * i + 2], C0[4 * i + 3]} * 4.f + 60.26f, c_ = (f32x2){C1[4 * i], C1[4 * i + 1]} * 4.f + 60.26f, d_ = (f32x2){C1[4 * i + 2], C1[4 * i + 3]} * 4.f + 60.26f; \
            p8[i] = (int)__builtin_amdgcn_cvt_pk_u8_f32(b_[1], 3, __builtin_amdgcn_cvt_pk_u8_f32(b_[0], 2, __builtin_amdgcn_cvt_pk_u8_f32(a_[1], 1, __builtin_amdgcn_cvt_pk_u8_f32(a_[0], 0, 0u)))); \
            p8[4 + i] = (int)__builtin_amdgcn_cvt_pk_u8_f32(d_[1], 3, __builtin_amdgcn_cvt_pk_u8_f32(d_[0], 2, __builtin_amdgcn_cvt_pk_u8_f32(c_[1], 1, __builtin_amdgcn_cvt_pk_u8_f32(c_[0], 0, 0u)))); } } while (0)
    int ka = 2 * SLK, kb = 0, kc = SLK, va = 2 * SLV, vb = 0, vc = SLV;
#define ROT8() do { const int t_ = ka; ka = kb; kb = kc; kc = t_; const int u_ = va; va = vb; vb = vc; vc = u_; } while (0)
#define STEP8(sv, DOQK, DOPV, KL, VL, IK, IV) do { \
        AT_SCHED(); if (DOQK) { C0 = mfma8(kn0, qn, zero); C1 = mfma8(kn1, qn, zero); C0 = mfma8(kr0v, qr, C0); C1 = mfma8(kr1v, qr, C1); } if (DOPV) { o0 = mfma8pv(p8, vf0, o0); o1 = mfma8pv(p8, vf1, o1); o2 = mfma8pv(p8, ones, o2); } AT_SCHED(); \
        asm volatile("s_barrier\n\ts_nop 15\n\ts_nop 15" : "+v"(C0), "+v"(C1), "+v"(o0), "+v"(o1), "+v"(o2) :: "memory"); AT_SCHED(); \
        if (KL) KLOAD8(kc); if (VL) VLOAD8(vb); \
        const bool ik_ = kw && (IK), iv_ = vw && (IV); if (ik_) DMAK((sv) + 4, kb); if (iv_) DMAV((sv) + 3, va); \
        if (DOQK) { SOFTMAX8(); asm volatile("" :: "v"(p8)); } AT_SCHED(); \
        if (ik_ && iv_) { AT_WAITBAR(2); } else if (ik_ || iv_) { AT_WAITBAR(1); } else { AT_WAITBAR(0); } \
        AT_SCHED(); ROT8(); } while (0)
    STEP8(-1, true, false, true, true, true, true);
#pragma nounroll
    for (int s = 0; s < NT - 4; ++s) STEP8(s, true, true, true, true, true, true);
    STEP8(NT - 4, true, true, true, true, false, true);
    STEP8(NT - 3, true, true, true, true, false, false);
    STEP8(NT - 2, true, true, false, true, false, false);
    STEP8(NT - 1, false, true, false, false, false, false);
    if (wid < 4) AT_BAR();
    LAS bf16_t* stg = (LAS bf16_t*)(lds + OST + wid * 4096);
#pragma unroll
    for (int r = 0; r < 16; ++r) { const int orow = crow(r, hi); const float rl = __builtin_amdgcn_rcpf(o2[r]);
        stg[orow * 64 + r32] = (bf16_t)(cvtpk(o0[r] * rl, 0.f) & 0xffffu); stg[orow * 64 + 32 + r32] = (bf16_t)(cvtpk(o1[r] * rl, 0.f) & 0xffffu); }
    asm volatile("s_waitcnt lgkmcnt(0)" ::: "memory");
    bf16_t* Ow = O + (rowb + qb * 256 + wid * 32) * op + h * 64;
#pragma unroll
    for (int i = 0; i < 4; ++i) { const int row = i * 8 + (lane >> 3), ch = lane & 7; const u32x4 v = *(const LAS u32x4*)(stg + row * 64 + ch * 8); st16(Ow + (size_t)row * op + ch * 8, v); }
    asm volatile("s_waitcnt lgkmcnt(0)\n\ts_barrier" ::: "memory");
#undef DMAK
#undef DMAV
#undef LD32
#undef KLOAD8
#undef VLOAD8
#undef SOFTMAX8
#undef ROT8
#undef STEP8
}
__device__ __forceinline__ void attn_phase_f8b(int tid, LAS unsigned char* lds, const unsigned char* Q8, const unsigned char* K8, const unsigned char* VT8, bf16_t* O, int op, int vcu, int G) {
    int bh, qb;
    for (int i = 0; next_unit(i, vcu, G, bh, qb); ++i) attn_unit_f8b(tid, lds, Q8, K8, VT8, O, op, bh >> 3, bh & 7, qb);
}
#endif
template <int DQK>
__device__ __forceinline__ void attn_phase(int tid, LAS unsigned char* lds, const Tensors& A, int vcu, int G) {
#if FAST_ATTN
    int bh, qb;
    for (int i = 0; next_unit(i, vcu, G, bh, qb); ++i) attn_unit<DQK>(tid, lds, A, bh >> 3, bh & 7, qb);
#else
    (void)lds; attn_phase_ref<DQK>(tid, A, vcu, G);
#endif
}
}


struct Args { const float* in[22]; float* out; unsigned char* ws; int ph_lo, ph_hi; };
struct Frame {
    LAS unsigned char* lds; volatile LAS unsigned* MISC; unsigned* ctl;
    int tid, lane, wave, vcu, G;
    unsigned char* ws; float* OUT;
};

__device__ __forceinline__ void p0_phase(Frame& F, const float* c, const float* w_ada, const float* b_ada) {
    LAS float* cs = (LAS float*)F.lds;
    LAS float* red = (LAS float*)(F.lds + 32768);
    for (int i = F.tid; i < NB * D; i += NTHREADS) { const float v = c[i]; cs[i] = v / (1.f + __expf(-v)); }
    __syncthreads();
    float* mod = (float*)(F.ws + WS_MOD);
    const int kq = F.wave, col = F.lane;
    for (int item = F.vcu; item < NL * 6 * D / 64; item += F.G) {
        const int l = item / (6 * D / 64), n0 = (item % (6 * D / 64)) * 64;
        const float* w = w_ada + (size_t)l * D * 6 * D + n0 + col;
        float acc[NB];
#pragma unroll
        for (int b = 0; b < NB; ++b) acc[b] = 0.f;
#pragma unroll 8
        for (int k = kq * 128; k < kq * 128 + 128; ++k) { const float wv = w[(size_t)k * 6 * D];
#pragma unroll
            for (int b = 0; b < NB; ++b) acc[b] += cs[b * D + k] * wv; }
#pragma unroll
        for (int b = 0; b < NB; ++b) red[(kq * NB + b) * 64 + col] = acc[b];
        __syncthreads();
        { const int b = F.wave; float s = 0.f;
#pragma unroll
          for (int q = 0; q < 8; ++q) s += red[(q * NB + b) * 64 + col];
          mod[((size_t)l * NB + b) * 6 * D + n0 + col] = s + b_ada[(size_t)l * 6 * D + n0 + col]; }
        __syncthreads();
    }
    float* cosA = (float*)(F.ws + WS_COSA); float* sinA = (float*)(F.ws + WS_SINA); float* cosB = (float*)(F.ws + WS_COSB); float* sinB = (float*)(F.ws + WS_SINB);
    for (int idx = F.vcu * NTHREADS + F.tid; idx < S * 48; idx += F.G * NTHREADS) {
        const int s = idx / 48, i = idx % 48; const float row = (float)(s >> 6), col2 = (float)(s & 63);
        if (i < 32) { const int j = i & 15; const float a = (i < 16 ? row : col2) * (1.0f / powf(10000.0f, (float)j / 16.0f)); cosA[s * 32 + i] = cosf(a); sinA[s * 32 + i] = sinf(a); }
        else { const int ii = i - 32, j = ii & 7; const float a = (ii < 8 ? row : col2) * (1.0f / powf(10000.0f, (float)j / 8.0f)); cosB[s * 16 + ii] = cosf(a); sinB[s * 16 + ii] = sinf(a); }
    }
}

template <class SrcFn>
__device__ __forceinline__ void cvt_item(const float* W, int K, int Nsrc, const float* kg, bf16_t* WT, LAS float* scr, int item, int nblk, int lane, const SrcFn& src, float f8scale = 0.f) {
    const int kb = item / nblk, nb = item % nblk, k0 = 64 * kb, n0 = 32 * nb;
    const int sc = src(n0 + (lane & 31));
#pragma unroll
    for (int i = 0; i < 32; ++i) { const int kk = 2 * i + (lane >> 5); float v = sc >= 0 ? W[(size_t)(k0 + kk) * Nsrc + sc] : 0.f; if (kg) v *= kg[k0 + kk]; scr[kk * 33 + (lane & 31)] = v; }
    LDS_WAIT(); asm volatile("" ::: "memory");
    const int c = lane & 7;
    if (f8scale != 0.f) {
#pragma unroll
        for (int j = 0; j < 4; ++j) { const int n = (lane >> 3) + 8 * j; const LAS float* sp = scr + (8 * c) * 33 + n;
            const u32x2 o = pack8_fp8((f32x4){sp[0 * 33], sp[1 * 33], sp[2 * 33], sp[3 * 33]} * f8scale, (f32x4){sp[4 * 33], sp[5 * 33], sp[6 * 33], sp[7 * 33]} * f8scale);
            *(u32x2*)((unsigned char*)WT + (size_t)(n0 + n) * K + k0 + 8 * c) = o; }
    } else {
#pragma unroll
    for (int j = 0; j < 4; ++j) { const int n = (lane >> 3) + 8 * j; const LAS float* s = scr + (8 * c) * 33 + n;
        u32x4 o; o.x = cvt_pk_bf16(s[0 * 33], s[1 * 33]); o.y = cvt_pk_bf16(s[2 * 33], s[3 * 33]); o.z = cvt_pk_bf16(s[4 * 33], s[5 * 33]); o.w = cvt_pk_bf16(s[6 * 33], s[7 * 33]);
        *(u32x4*)(WT + (size_t)(n0 + n) * K + k0 + 8 * c) = o; }
    }
    LDS_WAIT(); asm volatile("" ::: "memory");
}
struct SrcId { __device__ int operator()(int n) const { return n; } };
struct SrcIn { __device__ int operator()(int n) const { return gp::src_col_in(n); } };
typedef __attribute__((address_space(4))) const Args CArgsW;
__device__ __forceinline__ void convert_weights(Frame& F, CArgsW* a, int l) {
    LAS float* scr = (LAS float*)(F.lds + F.wave * 16384);
    const int gw = F.vcu * NWAVES + F.wave, NGW = F.G * NWAVES;
    const float* w_in = ((const float*)(GAS const float*)a->in[5]) + (size_t)l * D * INC; const float* w_q_b = ((const float*)(GAS const float*)a->in[10]) + (size_t)l * 384 * 768; const float* w_kv_b = ((const float*)(GAS const float*)a->in[11]) + (size_t)l * 256 * 1024;
    const float* w_pa = ((const float*)(GAS const float*)a->in[12]) + (size_t)l * 512 * D; const float* w_pb = ((const float*)(GAS const float*)a->in[13]) + (size_t)l * 512 * D; const float* w_o = ((const float*)(GAS const float*)a->in[14]) + (size_t)l * D * D;
    const float* w1 = ((const float*)(GAS const float*)a->in[18]) + (size_t)l * NE * D * FF; const float* w3 = ((const float*)(GAS const float*)a->in[19]) + (size_t)l * NE * D * FF; const float* w2 = ((const float*)(GAS const float*)a->in[20]) + (size_t)l * NE * FF * D;
    const float* gqa = ((const float*)(GAS const float*)a->in[8]) + l * 384; const float* gkv = ((const float*)(GAS const float*)a->in[9]) + l * 256;
    bf16_t* Win = (bf16_t*)(F.ws + WS_WIN); bf16_t* Wqb = (bf16_t*)(F.ws + WS_WQB); bf16_t* Wkvb = (bf16_t*)(F.ws + WS_WKVB); bf16_t* Wpa = (bf16_t*)(F.ws + WS_WPA); bf16_t* Wpb = (bf16_t*)(F.ws + WS_WPB);
    bf16_t* Wo = (bf16_t*)(F.ws + WS_WO); bf16_t* W13 = (bf16_t*)(F.ws + WS_W13); bf16_t* W2 = (bf16_t*)(F.ws + WS_W2);
    constexpr int I_IN = (D / 64) * (NIN / 32), I_QB = (384 / 64) * (768 / 32), I_KVB = (256 / 64) * (1024 / 32), I_P = (512 / 64) * (D / 32), I_O = (D / 64) * (D / 32);
    constexpr int I_13 = (D / 64) * (1024 / 32), I_2 = (FF / 64) * (D / 32);
    constexpr int NITEMS = I_IN + I_QB + I_KVB + 2 * I_P + I_O + NE * (I_13 + I_2);
    for (int it = gw; it < NITEMS; it += NGW) {
        int r = it;
        if (r < I_IN) { cvt_item(w_in, D, INC, nullptr, Win, scr, r, NIN / 32, F.lane, SrcIn(), G1_FP8 ? 16.f : 0.f); continue; } r -= I_IN;
        if (r < I_QB) { cvt_item(w_q_b, 384, 768, gqa, Wqb, scr, r, 768 / 32, F.lane, SrcId()); continue; } r -= I_QB;
        if (r < I_KVB) { cvt_item(w_kv_b, 256, 1024, gkv, Wkvb, scr, r, 1024 / 32, F.lane, SrcId()); continue; } r -= I_KVB;
        if (r < I_P) { cvt_item(w_pa, 512, D, nullptr, Wpa, scr, r, D / 32, F.lane, SrcId()); continue; } r -= I_P;
        if (r < I_P) { cvt_item(w_pb, 512, D, nullptr, Wpb, scr, r, D / 32, F.lane, SrcId()); continue; } r -= I_P;
        if (r < I_O) { cvt_item(w_o, D, D, nullptr, Wo, scr, r, D / 32, F.lane, SrcId()); continue; } r -= I_O;
        if (r < NE * I_13) { const int e = r / I_13, q = r % I_13, nb = q % 32;
            const float* src = ((nb & 7) < 4 ? w1 : w3) + (size_t)e * D * FF; const int cb = (nb >> 3) * 128 + (nb & 3) * 32;
            struct SrcOff { int n0, cb; __device__ int operator()(int n) const { return cb + (n - n0); } } so{nb * 32, cb};
            if (MOE_FP8) cvt_item(src, D, FF, nullptr, (bf16_t*)((unsigned char*)W13 + (size_t)e * 1024 * D), scr, q, 32, F.lane, so, 16.f);
            else cvt_item(src, D, FF, nullptr, W13 + (size_t)e * 1024 * D, scr, q, 32, F.lane, so);
            continue; } r -= NE * I_13;
        { const int e = r / I_2, q = r % I_2;
          if (MOE_FP8) cvt_item(w2 + (size_t)e * FF * D, FF, D, nullptr, (bf16_t*)((unsigned char*)W2 + (size_t)e * D * FF), scr, q, D / 32, F.lane, SrcId(), 16.f);
          else cvt_item(w2 + (size_t)e * FF * D, FF, D, nullptr, W2 + (size_t)e * D * FF, scr, q, D / 32, F.lane, SrcId()); }
    }
}

template <int MODE>
__device__ __forceinline__ void row_phase(Frame& F, const float* xin, const float* g2prev, const float* gain, const float* modl, int sh_off, int sc_off, bf16_t* H, bf16_t* XB, float* OUT) {
    constexpr int RB = 4, RPW = T / (256 * NWAVES);
    const int gw = F.vcu * NWAVES + F.wave, b = (gw * RPW) >> 12;
    const bf16_t* Y2 = (const bf16_t*)(F.ws + WS_Y2);
    f32x4 gs[4], shv[4], g2v[4];
#pragma unroll
    for (int j = 0; j < 4; ++j) { const int c = 4 * F.lane + 256 * j; gs[j] = *(const f32x4*)(gain + c);
        if (MODE != 2) { gs[j] = gs[j] * (1.f + *(const f32x4*)(modl + (size_t)b * 6 * D + sc_off + c)); shv[j] = *(const f32x4*)(modl + (size_t)b * 6 * D + sh_off + c); }
        if (MODE != 0) g2v[j] = *(const f32x4*)(g2prev + (size_t)b * 6 * D + 5 * D + c); }
    for (int m0 = gw * RPW; m0 < gw * RPW + RPW; m0 += RB) {
        f32x4 v[RB][4]; float ss[RB];
        if (MODE == 0) {
#pragma unroll
            for (int r = 0; r < RB; ++r)
#pragma unroll
                for (int j = 0; j < 4; ++j) v[r][j] = *(const f32x4*)(xin + (size_t)(m0 + r) * D + 4 * F.lane + 256 * j);
        } else {
            unsigned ya[RB][4], yb[RB][4];
#pragma unroll
            for (int r = 0; r < RB; ++r)
#pragma unroll
                for (int j = 0; j < 4; ++j) { const int m = m0 + r, c = 4 * F.lane + 256 * j;
                    { const u32x2 xb = *(const u32x2*)(XB + (size_t)m * D + c); v[r][j] = (f32x4){bf2f(xb.x & 0xffffu), bf2f(xb.x >> 16), bf2f(xb.y & 0xffffu), bf2f(xb.y >> 16)}; }
                    ya[r][j] = *(const unsigned*)((const unsigned char*)Y2 + (size_t)(2 * m) * D + c); yb[r][j] = *(const unsigned*)((const unsigned char*)Y2 + (size_t)(2 * m + 1) * D + c); }
#pragma unroll
            for (int r = 0; r < RB; ++r)
#pragma unroll
                for (int j = 0; j < 4; ++j) { const f32x2 a0 = __builtin_amdgcn_cvt_pk_f32_fp8((int)ya[r][j], false), a1 = __builtin_amdgcn_cvt_pk_f32_fp8((int)ya[r][j], true), b0 = __builtin_amdgcn_cvt_pk_f32_fp8((int)yb[r][j], false), b1 = __builtin_amdgcn_cvt_pk_f32_fp8((int)yb[r][j], true);
                    const f32x4 y = (f32x4){a0[0] + b0[0], a0[1] + b0[1], a1[0] + b1[0], a1[1] + b1[1]} * 0.0625f;
                    v[r][j] += g2v[j] * y; }
        }
#pragma unroll
        for (int r = 0; r < RB; ++r) { ss[r] = (gp::dot4(v[r][0]) + gp::dot4(v[r][1])) + (gp::dot4(v[r][2]) + gp::dot4(v[r][3])); }
#pragma unroll
        for (int o = 1; o < 64; o <<= 1)
#pragma unroll
            for (int r = 0; r < RB; ++r) ss[r] += __shfl_xor(ss[r], o);
#pragma unroll
        for (int r = 0; r < RB; ++r) {
            const int m = m0 + r; const float rstd = rsqrtf(ss[r] * (1.f / D) + EPS);
#pragma unroll
            for (int j = 0; j < 4; ++j) {
                const int c = 4 * F.lane + 256 * j;
                if (MODE == 2) { *(f32x4*)(OUT + (size_t)m * D + c) = v[r][j] * rstd * gs[j]; }
                else {
                    { u32x2 xw; xw.x = cvt_pk_bf16(v[r][j][0], v[r][j][1]); xw.y = cvt_pk_bf16(v[r][j][2], v[r][j][3]); st8((XB + (size_t)m * D + c), xw); }
                    const f32x4 hv = v[r][j] * rstd * gs[j] + shv[j];
                    if (G1_FP8) { const f32x4 hq = hv * 0.0625f;
                        *(unsigned*)((unsigned char*)H + (size_t)m * D + c) = (unsigned)__builtin_amdgcn_cvt_pk_fp8_f32(hq[2], hq[3], __builtin_amdgcn_cvt_pk_fp8_f32(hq[0], hq[1], 0, false), true); }
                    else { u32x2 w; w.x = cvt_pk_bf16(hv[0], hv[1]); w.y = cvt_pk_bf16(hv[2], hv[3]);
                    st8((H + (size_t)m * D + c), w); }
                }
            }
        }
    }
}

__device__ __forceinline__ void t2_phase(Frame& F, const float* gain, const float* modl, const float* w_router, const float* rbias, int l, bool record) {
    LAS f32x4* wl = (LAS f32x4*)F.lds;
    LAS int* rec = (LAS int*)(F.lds + 65536);
    LAS float* recw = (LAS float*)(F.lds + 65536 + 2048);
    LAS int* lcnt = (LAS int*)(F.lds + 65536 + 4096);
    for (int idx = F.tid; idx < 4096; idx += NTHREADS) {
        const int lane = idx & 63, c = (idx >> 6) & 3, i = (idx >> 8) & 3, j = idx >> 10; const int k = 4 * lane + 256 * j + i;
        wl[idx] = *(const f32x4*)(w_router + (size_t)k * NE + 4 * c);
    }
    if (F.tid < 32) lcnt[F.tid] = 0;
    __syncthreads();
    constexpr int RB = 4, RPW = T / (256 * NWAVES);
    const int gw = F.vcu * NWAVES + F.wave, bt = (gw * RPW) >> 12;
    bf16_t* H = (bf16_t*)(F.ws + WS_H); const bf16_t* XB = (const bf16_t*)(F.ws + WS_XB);
    const int lane = F.lane, myrow = lane >> 4, mye = lane & 15;
    f32x4 gs[4], shv[4];
#pragma unroll
    for (int j = 0; j < 4; ++j) { const int c = 4 * lane + 256 * j; gs[j] = *(const f32x4*)(gain + c) * (1.f + *(const f32x4*)(modl + (size_t)bt * 6 * D + 4 * D + c)); shv[j] = *(const f32x4*)(modl + (size_t)bt * 6 * D + 3 * D + c); }
    int it = 0;
    for (int m0 = gw * RPW; m0 < gw * RPW + RPW; m0 += RB, ++it) {
        f32x4 v[RB][4]; float ss[RB];
#pragma unroll
        for (int r = 0; r < RB; ++r)
#pragma unroll
            for (int j = 0; j < 4; ++j) { const u32x2 xb = *(const u32x2*)(XB + (size_t)(m0 + r) * D + 4 * lane + 256 * j); v[r][j] = (f32x4){bf2f(xb.x & 0xffffu), bf2f(xb.x >> 16), bf2f(xb.y & 0xffffu), bf2f(xb.y >> 16)}; }
#pragma unroll
        for (int r = 0; r < RB; ++r) ss[r] = (gp::dot4(v[r][0]) + gp::dot4(v[r][1])) + (gp::dot4(v[r][2]) + gp::dot4(v[r][3]));
#pragma unroll
        for (int o = 1; o < 64; o <<= 1)
#pragma unroll
            for (int r = 0; r < RB; ++r) ss[r] += __shfl_xor(ss[r], o);
        float acc[RB * NE];
#pragma unroll
        for (int q = 0; q < RB * NE; ++q) acc[q] = 0.f;
#pragma unroll
        for (int j = 0; j < 4; ++j) {
            const int c = 4 * lane + 256 * j;
#pragma unroll
            for (int r = 0; r < RB; ++r) {
                const int m = m0 + r; const float rstd = rsqrtf(ss[r] * (1.f / D) + EPS);
                v[r][j] = v[r][j] * rstd * gs[j] + shv[j];
#if MOE_FP8
                *(unsigned*)((unsigned char*)H + (size_t)m * D + c) = (unsigned)__builtin_amdgcn_cvt_pk_fp8_f32(v[r][j][2], v[r][j][3], __builtin_amdgcn_cvt_pk_fp8_f32(v[r][j][0], v[r][j][1], 0, false), true);
#else
                u32x2 w; w.x = cvt_pk_bf16(v[r][j][0], v[r][j][1]); w.y = cvt_pk_bf16(v[r][j][2], v[r][j][3]);
                st8((H + (size_t)m * D + c), w);
#endif
            }
#pragma unroll
            for (int i = 0; i < 4; ++i)
#pragma unroll
                for (int c4 = 0; c4 < 4; ++c4) { const f32x4 wv = wl[((j * 4 + i) * 4 + c4) * 64 + lane];
#pragma unroll
                    for (int r = 0; r < RB; ++r) { const float hv = v[r][j][i];
                        acc[r * NE + 4 * c4 + 0] += hv * wv[0]; acc[r * NE + 4 * c4 + 1] += hv * wv[1]; acc[r * NE + 4 * c4 + 2] += hv * wv[2]; acc[r * NE + 4 * c4 + 3] += hv * wv[3]; } }
        }
#pragma unroll
        for (int sft = 32; sft >= 1; sft >>= 1) {
            const bool up = (lane & sft) != 0;
#pragma unroll
            for (int k = 0; k < sft; ++k) { const float a = acc[k], b = acc[k + sft]; const float keep = up ? b : a, send = up ? a : b; acc[k] = keep + __shfl_xor(send, sft); }
        }
        const float logit = acc[0];
        const float score = 1.f / (1.f + expf(-logit));
        float scv[NE], bi[NE];
#pragma unroll
        for (int e = 0; e < NE; ++e) { scv[e] = __shfl(score, (lane & 48) | e); bi[e] = scv[e] + rbias[e]; }
        int gsel = 0; float gbest = -INFINITY;
#pragma unroll
        for (int g = 0; g < 4; ++g) { float m1 = -INFINITY, m2 = -INFINITY;
#pragma unroll
            for (int j = 0; j < 4; ++j) { const float x = bi[g * 4 + j]; if (x > m1) { m2 = m1; m1 = x; } else if (x > m2) m2 = x; }
            const float gs = m1 + m2; if (gs > gbest) { gbest = gs; gsel = g; } }
        int e1 = -1, e2 = -1; float b1 = -INFINITY, b2 = -INFINITY, s1 = 0.f, s2 = 0.f;
#pragma unroll
        for (int j = 0; j < 4; ++j) { float x = -INFINITY, sx = 0.f;
#pragma unroll
            for (int g = 0; g < 4; ++g) if (g == gsel) { x = bi[g * 4 + j]; sx = scv[g * 4 + j]; }
            const int e = gsel * 4 + j;
            if (x > b1) { b2 = b1; e2 = e1; s2 = s1; b1 = x; e1 = e; s1 = sx; } else if (x > b2) { b2 = x; e2 = e; s2 = sx; } }
        if (mye == 0) {
            const float inv = 1.f / (s1 + s2); const int slot = (it * RB + myrow) * NWAVES + F.wave;
            rec[slot * 4 + 0] = e1; rec[slot * 4 + 1] = e2;
            rec[slot * 4 + 2] = __hip_atomic_fetch_add(&lcnt[e1], 1, __ATOMIC_RELAXED, __HIP_MEMORY_SCOPE_WORKGROUP);
            rec[slot * 4 + 3] = __hip_atomic_fetch_add(&lcnt[e2], 1, __ATOMIC_RELAXED, __HIP_MEMORY_SCOPE_WORKGROUP);
            recw[slot * 2 + 0] = s1 * inv; recw[slot * 2 + 1] = s2 * inv;
        }
    }
    __syncthreads();
    if (!record) return;
    if (F.tid < NE) lcnt[16 + F.tid] = (int)__hip_atomic_fetch_add(F.ctl + CW_CNT + (l * NE + F.tid) * 64, (unsigned)lcnt[F.tid], __ATOMIC_RELAXED, __HIP_MEMORY_SCOPE_AGENT);
    __syncthreads();
    unsigned* list = (unsigned*)(F.ws + WS_LIST); float* gwb = (float*)(F.ws + WS_GW);
    const int nrows = it * RB;
    for (int s = F.tid; s < nrows * NWAVES; s += NTHREADS) {
        const int i2 = s / NWAVES, w = s % NWAVES; const int m = (F.vcu * NWAVES + w) * RPW + i2;
        const int e1 = rec[s * 4 + 0], e2 = rec[s * 4 + 1];
        list[(size_t)e1 * T + lcnt[16 + e1] + rec[s * 4 + 2]] = (unsigned)(2 * m); list[(size_t)e2 * T + lcnt[16 + e2] + rec[s * 4 + 3]] = (unsigned)(2 * m + 1);
        gwb[2 * m] = recw[s * 2]; gwb[2 * m + 1] = recw[s * 2 + 1];
    }
}
__device__ __forceinline__ LAS int* moe_table(Frame& F, int l) {
    LAS int* tab = (LAS int*)(F.lds + MISC_OFF + 1024);
    __syncthreads();
    if (F.tid == 0) { int acc = 0;
        for (int e = 0; e < NE; ++e) { const int c = (int)__hip_atomic_load(F.ctl + CW_CNT + (l * NE + e) * 64, __ATOMIC_RELAXED, __HIP_MEMORY_SCOPE_AGENT); tab[e] = acc; tab[32 + e] = c; acc += (c + 255) >> 8; }
        tab[16] = acc; }
    __syncthreads();
    return tab;
}

typedef __attribute__((address_space(4))) const Args CArgs;
#define LAUNDER_GP(T_, p) do { GAS T_* _t = (GAS T_*)(p); asm volatile("" : "+s"(_t)); (p) = (T_*)_t; } while (0)
#define PH_BEGIN() LAUNDER_V(F.tid); F.lane = F.tid & 63; LAUNDER_GP(unsigned, F.ctl); LAUNDER_GP(float, F.OUT); LAUNDER_GP(unsigned char, F.ws); GAS unsigned char* ws = (GAS unsigned char*)F.ws; CArgs* ka = (CArgs*)__builtin_amdgcn_kernarg_segment_ptr(); LAUNDER_S(ka); \
    float* mod = WSP(float, WS_MOD); (void)mod; (void)ka
#define WSP(T_, off) ((T_*)(GAS T_*)(ws + (off)))
#define KIN(i) ((const float*)(GAS const float*)ka->in[i])
__global__ void __launch_bounds__(NTHREADS, 2) fwd_kernel(Args args) {
    extern __shared__ __attribute__((aligned(16))) unsigned char lds_raw[];
    Frame F;
    F.lds = (LAS unsigned char*)lds_raw; F.MISC = (volatile LAS unsigned*)(F.lds + MISC_OFF);
    F.tid = threadIdx.x; F.lane = F.tid & 63; F.wave = __builtin_amdgcn_readfirstlane(F.tid >> 6);
    F.G = gridDim.x; { const int bx = blockIdx.x; F.vcu = (F.G % 8 == 0) ? (bx % 8) * (F.G / 8) + bx / 8 : bx; }
    F.ws = (unsigned char*)(GAS unsigned char*)args.ws; F.ctl = (unsigned*)(GAS unsigned*)(args.ws + WS_CTL); F.OUT = (float*)(GAS float*)args.out;
    if (F.tid < 64) F.MISC[F.tid] = 0u;
    __syncthreads();
    XcdBarrier bar; bar.bar = F.ctl + CW_BAR; bar.x = 0; bar.st = nullptr;
    if (!N_LAUNCH_MODE) bar = xcd_barrier_post(F.ctl + CW_BAR, F.MISC + 8);
    const int lo = args.ph_lo, hi = args.ph_hi;
#define IN(k) (lo <= (k) && (k) < hi)
#define SEAM(k) do { if ((k) + 1 < hi) { if (!N_LAUNCH_MODE) xcd_barrier(bar); } } while (0)
    const int cidx = (int)blockIdx.x;

    if (IN(0)) { PH_BEGIN(); p0_phase(F, KIN(1), KIN(2), KIN(3)); __syncthreads(); LAUNDER_V(F.tid); F.lane = F.tid & 63; convert_weights(F, ka, 0); SEAM(0); }
    for (int l = 0; l < NL; ++l) {
        const int pb = 1 + 9 * l;
        if (IN(pb + 0)) {
            PH_BEGIN();
            if (l > 0) for (int rep = 0; rep < ((PROBE_DUP & 8) ? 2 : 1); ++rep) { LAUNDER_V(F.tid); F.lane = F.tid & 63; convert_weights(F, ka, l); }
            if (l == 0) row_phase<0>(F, KIN(0), nullptr, KIN(4) + l * D, mod + (size_t)l * NB * 6 * D, 0, D, WSP(bf16_t, WS_H), WSP(bf16_t, WS_XB), nullptr);
            else row_phase<1>(F, nullptr, mod + (size_t)(l - 1) * NB * 6 * D, KIN(4) + l * D, mod + (size_t)l * NB * 6 * D, 0, D, WSP(bf16_t, WS_H), WSP(bf16_t, WS_XB), nullptr);
            SEAM(pb + 0);
        }
        if (IN(pb + 1)) {
            PH_BEGIN();
            gp::Gemm g{WSP(bf16_t, WS_H), WSP(const bf16_t, WS_WIN), G1_FP8 ? D / 2 : D, 0, nullptr, 0, 0, 0}; gp::DenseOrder So; So.init(T, NIN, F.G, cidx);
            gp::EpiIn E{WSP(bf16_t, ATT_FP8_A ? WS_QA8 : WS_QA), WSP(bf16_t, ATT_FP8_A ? WS_KA8 : WS_KA), WSP(bf16_t, ATT_FP8_A ? WS_VTA8 : WS_VA), WSP(bf16_t, WS_QLAT), WSP(bf16_t, WS_KVLAT), WSP(bf16_t, ATT_FP8_B ? WS_KB8 : WS_KB), WSP(bf16_t, WS_SA), WSP(bf16_t, WS_SB), WSP(float, WS_SSQ), WSP(float, WS_SSKV),
                        KIN(6) + l * 64, KIN(7) + l * 64, WSP(const float, WS_COSA), WSP(const float, WS_SINA), WSP(const float, WS_COSB), WSP(const float, WS_SINB)};
            if (PROBE_DUP & 128) { gp::EpiNull En; gp::gemm_phase<gp::EpiNull, gp::DenseOrder>(F.tid, F.lds, g, So, En); LAUNDER_V(F.tid); }
            gp::gemm_phase<gp::EpiIn, gp::DenseOrder, false, G1_FP8 != 0>(F.tid, F.lds, g, So, E); if (PROBE_DUP & (2 | 512)) { LAUNDER_V(F.tid); gp::gemm_phase<gp::EpiIn, gp::DenseOrder, false, G1_FP8 != 0>(F.tid, F.lds, g, So, E); }
            SEAM(pb + 1);
        }
        if (IN(pb + 2)) {
            { PH_BEGIN(); gp::Gemm g{WSP(bf16_t, WS_QLAT), WSP(const bf16_t, WS_WQB), 384, 0, nullptr}; gp::DenseOrder So; So.init(T, 768, F.G, cidx);
              gp::EpiQb E{WSP(bf16_t, ATT_FP8_B ? WS_QB8 : WS_QB), WSP(const float, WS_SSQ), WSP(const float, WS_COSB), WSP(const float, WS_SINB)}; gp::gemm_phase<gp::EpiQb, gp::DenseOrder>(F.tid, F.lds, g, So, E); if (PROBE_DUP & 2) { LAUNDER_V(F.tid); gp::gemm_phase<gp::EpiQb, gp::DenseOrder>(F.tid, F.lds, g, So, E); } }
            { PH_BEGIN(); gp::Gemm g{WSP(bf16_t, WS_KVLAT), WSP(const bf16_t, WS_WKVB), 256, 0, nullptr}; gp::DenseOrder So; So.init(T, 1024, F.G, F.G - 1 - cidx);
              gp::EpiKvb E{WSP(bf16_t, ATT_FP8_B ? WS_KB8 : WS_KB), WSP(bf16_t, ATT_FP8_B ? WS_VTB8 : WS_VB), WSP(const float, WS_SSKV)}; gp::gemm_phase<gp::EpiKvb, gp::DenseOrder>(F.tid, F.lds, g, So, E); if (PROBE_DUP & 2) { LAUNDER_V(F.tid); gp::gemm_phase<gp::EpiKvb, gp::DenseOrder>(F.tid, F.lds, g, So, E); } }
#if FAST_ATTN && ATT_FP8_A
            { PH_BEGIN(); at::attn_phase_f8a(F.tid, F.lds, WSP(const unsigned char, WS_QA8), WSP(const unsigned char, WS_KA8), WSP(const unsigned char, WS_VTA8), WSP(bf16_t, WS_QA), 512, KIN(6) + l * 64, KIN(7) + l * 64, F.vcu, F.G); }
            if (PROBE_DUP & 1) { PH_BEGIN(); at::attn_phase_f8a(F.tid, F.lds, WSP(const unsigned char, WS_QA8), WSP(const unsigned char, WS_KA8), WSP(const unsigned char, WS_VTA8), WSP(bf16_t, WS_QA), 512, KIN(6) + l * 64, KIN(7) + l * 64, F.vcu, F.G); }
#else
            { PH_BEGIN(); const at::Tensors A{WSP(bf16_t, WS_QA), 512, WSP(bf16_t, WS_KA), 128, WSP(bf16_t, WS_VA), 128, WSP(bf16_t, WS_QA), 512, 4}; at::attn_phase<64>(F.tid, F.lds, A, F.vcu, F.G); }
#endif
            SEAM(pb + 2);
        }
        if (IN(pb + 3)) {
            PH_BEGIN();
#if FAST_ATTN && ATT_FP8_B
            at::attn_phase_f8b(F.tid, F.lds, WSP(const unsigned char, WS_QB8), WSP(const unsigned char, WS_KB8), WSP(const unsigned char, WS_VTB8), WSP(bf16_t, WS_OB), 512, F.vcu, F.G);
            if (PROBE_DUP & 1) { LAUNDER_V(F.tid); at::attn_phase_f8b(F.tid, F.lds, WSP(const unsigned char, WS_QB8), WSP(const unsigned char, WS_KB8), WSP(const unsigned char, WS_VTB8), WSP(bf16_t, WS_OB), 512, F.vcu, F.G); }
#else
            const at::Tensors A{WSP(bf16_t, WS_QB), 768, WSP(bf16_t, WS_KB), 768, WSP(bf16_t, WS_VB), 512, WSP(bf16_t, WS_OB), 512, 1}; for (int rep = 0; rep < ((PROBE_DUP & 1) ? 2 : 1); ++rep) at::attn_phase<96>(F.tid, F.lds, A, F.vcu, F.G);
#endif
            SEAM(pb + 3);
        }
        if (IN(pb + 4)) {
            PH_BEGIN();
            gp::Gemm g{WSP(bf16_t, WS_QA), WSP(const bf16_t, WS_WPA), 512, (size_t)(WS_WPB - WS_WPA) / 2, nullptr, (size_t)(WS_OB - WS_QA) / 2}; gp::PairOrder So; So.init(T, D, F.G, cidx);
            gp::EpiProjP E{WSP(bf16_t, WS_H), WSP(const unsigned char, WS_SA), WSP(const unsigned char, WS_SB)};
            gp::gemm_phase<gp::EpiProjP, gp::PairOrder>(F.tid, F.lds, g, So, E);
            if (PROBE_DUP & (2 | 1024)) { LAUNDER_V(F.tid); gp::gemm_phase<gp::EpiProjP, gp::PairOrder>(F.tid, F.lds, g, So, E); }
            SEAM(pb + 4);
        }
        if (IN(pb + 5)) {
            PH_BEGIN();
            gp::Gemm g{WSP(bf16_t, WS_H), WSP(const bf16_t, WS_WO), D, 0, nullptr}; gp::DenseOrder So; So.init(T, D, F.G, cidx);
            gp::EpiWo E{WSP(const bf16_t, WS_XB), mod + (size_t)l * NB * 6 * D, WSP(bf16_t, WS_XB)}; gp::gemm_phase<gp::EpiWo, gp::DenseOrder>(F.tid, F.lds, g, So, E);
            SEAM(pb + 5);
        }
        if (IN(pb + 6)) {
            PH_BEGIN();
            if (PROBE_DUP & 16) { t2_phase(F, KIN(15) + l * D, mod + (size_t)l * NB * 6 * D, KIN(16), KIN(17), l, false); LAUNDER_V(F.tid); F.lane = F.tid & 63; __syncthreads(); }
            t2_phase(F, KIN(15) + l * D, mod + (size_t)l * NB * 6 * D, KIN(16), KIN(17), l, true);
            SEAM(pb + 6);
        }
        if (IN(pb + 7)) {
            PH_BEGIN();
            LAS int* tab = moe_table(F, l);
#if MOE_FP8
            gp::Gemm g{WSP(bf16_t, WS_H), WSP(const bf16_t, WS_W13), D / 2, (size_t)1024 * D / 2, WSP(const unsigned, WS_LIST), 0, 0, 0}; gp::MoeOrder So; So.init(tab, F.G, cidx);
            gp::EpiUp E{WSP(bf16_t, WS_ACT), 1.f / 16.f}; gp::gemm_phase<gp::EpiUp, gp::MoeOrder, true, true>(F.tid, F.lds, g, So, E);
            if (PROBE_DUP & 4) { LAUNDER_V(F.tid); gp::gemm_phase<gp::EpiUp, gp::MoeOrder, true, true>(F.tid, F.lds, g, So, E); }
#else
            gp::Gemm g{WSP(bf16_t, WS_H), WSP(const bf16_t, WS_W13), D, (size_t)1024 * D, WSP(const unsigned, WS_LIST)}; gp::MoeOrder So; So.init(tab, F.G, cidx);
            gp::EpiUp E{WSP(bf16_t, WS_ACT), 1.f}; gp::gemm_phase<gp::EpiUp, gp::MoeOrder, true>(F.tid, F.lds, g, So, E);
#endif
            SEAM(pb + 7);
        }
        if (IN(pb + 8)) {
            PH_BEGIN();
            LAS int* tab = moe_table(F, l);
#if MOE_FP8
            gp::Gemm g{WSP(bf16_t, WS_ACT), WSP(const bf16_t, WS_W2), FF / 2, (size_t)D * FF / 2, nullptr, 0, 0, 0}; gp::MoeOrder So; So.init(tab, F.G, cidx);
            gp::EpiDown E{WSP(bf16_t, WS_Y2), WSP(const unsigned, WS_LIST), WSP(const float, WS_GW), 1.f / 128.f}; gp::gemm_phase<gp::EpiDown, gp::MoeOrder, false, true>(F.tid, F.lds, g, So, E);
            if (PROBE_DUP & 4) { LAUNDER_V(F.tid); gp::gemm_phase<gp::EpiDown, gp::MoeOrder, false, true>(F.tid, F.lds, g, So, E); }
#else
            gp::Gemm g{WSP(bf16_t, WS_ACT), WSP(const bf16_t, WS_W2), FF, (size_t)D * FF, nullptr}; gp::MoeOrder So; So.init(tab, F.G, cidx);
            gp::EpiDown E{WSP(bf16_t, WS_Y2), WSP(const unsigned, WS_LIST), WSP(const float, WS_GW), 1.f}; gp::gemm_phase<gp::EpiDown, gp::MoeOrder, false>(F.tid, F.lds, g, So, E);
#endif
            SEAM(pb + 8);
        }
    }
    if (IN(NPHASE - 1)) { PH_BEGIN(); row_phase<2>(F, nullptr, mod + (size_t)(NL - 1) * NB * 6 * D, KIN(21), nullptr, 0, 0, nullptr, WSP(bf16_t, WS_XB), F.OUT); }
#undef IN
#undef SEAM
}

extern "C" void kernel_launch(void* const* d_in, const int* in_sizes, int n_in, void* d_out, int out_size, void* d_ws, size_t ws_size, hipStream_t stream) {
    static int grid = 0;
    if (grid == 0) {
        if (n_in != 22 || out_size != T * D || ws_size < WS_END) { fprintf(stderr, "kernel_launch: unexpected problem (n_in %d out %d ws %zu)\n", n_in, out_size, ws_size); grid = -1; return; }
        int dev = 0, cus = 0, per_cu = 0;
        if (hipGetDevice(&dev) != hipSuccess || hipDeviceGetAttribute(&cus, hipDeviceAttributeMultiprocessorCount, dev) != hipSuccess) { grid = -1; return; }
        if (hipFuncSetAttribute((const void*)fwd_kernel, hipFuncAttributeMaxDynamicSharedMemorySize, LDS_BYTES) != hipSuccess) { grid = -1; return; }
        if (hipOccupancyMaxActiveBlocksPerMultiprocessor(&per_cu, (const void*)fwd_kernel, NTHREADS, LDS_BYTES) != hipSuccess || per_cu < 1) { fprintf(stderr, "kernel_launch: occupancy query says %d\n", per_cu); }
        (void)hipGetLastError();
        grid = cus;
        if (grid != 256 || T % (grid * NWAVES * 4) != 0) {   fprintf(stderr, "kernel_launch: grid %d does not divide the row phases\n", grid); grid = -1; return; }
    }
    if (grid < 0) return;
    (void)hipMemsetAsync((char*)d_ws + WS_CTL, 0, CTL_BYTES, stream);
    Args a{};
    for (int i = 0; i < 22; ++i) a.in[i] = (const float*)d_in[i];
    a.out = (float*)d_out; a.ws = (unsigned char*)d_ws;
#if N_LAUNCH_MODE
    for (int p = 0; p < NPHASE; ++p) { a.ph_lo = p; a.ph_hi = p + 1; hipLaunchKernelGGL(fwd_kernel, dim3(grid), dim3(NTHREADS), LDS_BYTES, stream, a); }
#else
    a.ph_lo = 0; a.ph_hi = NPHASE;
    hipLaunchKernelGGL(fwd_kernel, dim3(grid), dim3(NTHREADS), LDS_BYTES, stream, a);
#endif
}
```

```cpp
#include <hip/hip_runtime.h>
#include <stdint.h>
#include <stdio.h>
#include <math.h>

#ifndef FAST_GEMM
#define FAST_GEMM 1
#endif
#ifndef FAST_ATTN
#define FAST_ATTN 1
#endif
#ifndef PROBE_DUP
#define PROBE_DUP 0
#endif
#ifndef PROBE_ATT
#define PROBE_ATT 0
#endif
#ifndef ATT_REGSTAGE
#define ATT_REGSTAGE 0
#endif
#ifndef WT_STORES
#define WT_STORES 0
#endif
#ifndef ATT_FP8_A
#define ATT_FP8_A 1
#endif
#ifndef ATT_FP8_B
#define ATT_FP8_B 1
#endif
#ifndef MOE_FP8
#define MOE_FP8 1
#endif
#ifndef G1_FP8
#define G1_FP8 1
#endif
#ifndef N_LAUNCH_MODE
#define N_LAUNCH_MODE 0
#endif

#define LAS __attribute__((address_space(3)))
#define GAS __attribute__((address_space(1)))
typedef unsigned short bf16_t;
typedef short bf16x8 __attribute__((ext_vector_type(8)));
typedef float f32x4 __attribute__((ext_vector_type(4)));
typedef float f32x2 __attribute__((ext_vector_type(2)));
typedef float f32x16 __attribute__((ext_vector_type(16)));
typedef unsigned u32x4 __attribute__((ext_vector_type(4)));
typedef unsigned u32x2 __attribute__((ext_vector_type(2)));
typedef GAS unsigned gu32;

constexpr int D = 1024, NB = 8, S = 4096, T = NB * S, NL = 4, INC = 3488, NIN = 3584, NE = 16, FF = 512;
constexpr float EPS = 1e-6f, LOG2E = 1.4426950408889634f;
constexpr float QSCALE_A = 0.125f * LOG2E, QSCALE_B = 0.10206207261596577f * LOG2E;
constexpr float PFOLD = 4.f, PBYTE0 = 60.26f;
constexpr int NWAVES = 8, NTHREADS = 512;
constexpr int NPHASE = 2 + 9 * NL;

constexpr size_t MiB = 1u << 20;
constexpr size_t WS_CTL = 0, CTL_BYTES = 1 * MiB;
constexpr size_t WS_MOD = 1 * MiB;
constexpr size_t WS_COSA = 2 * MiB, WS_SINA = WS_COSA + 512 * 1024, WS_COSB = 3 * MiB, WS_SINB = WS_COSB + 256 * 1024;
constexpr size_t WS_SSQ = 4 * MiB, WS_SSKV = 5 * MiB;
constexpr size_t WS_GW = 6 * MiB;
constexpr size_t WS_LIST = 7 * MiB;
constexpr size_t WS_WIN = 10 * MiB, WS_WQB = 17 * MiB, WS_WKVB = 18 * MiB, WS_WPA = 19 * MiB, WS_WPB = 20 * MiB, WS_WO = 21 * MiB, WS_W13 = 23 * MiB, WS_W2 = 55 * MiB;
constexpr size_t WS_H = 72 * MiB;
constexpr size_t WS_QA = 136 * MiB, WS_KA = 168 * MiB, WS_VA = 176 * MiB, WS_QLAT = 184 * MiB, WS_KVLAT = 208 * MiB;
constexpr size_t WS_KB = 224 * MiB, WS_VB = 272 * MiB, WS_QB = 304 * MiB, WS_OB = 352 * MiB, WS_SA = 384 * MiB, WS_SB = 448 * MiB, WS_XB = 512 * MiB, WS_QA8 = 576 * MiB, WS_KA8 = 592 * MiB, WS_VTA8 = 596 * MiB, WS_QB8 = 600 * MiB, WS_KB8 = 624 * MiB, WS_VTB8 = 648 * MiB, WS_END = 664 * MiB;
constexpr size_t WS_ACT = 136 * MiB, WS_Y2 = 208 * MiB;
constexpr int ACT_ROWS = 2 * T + NE * 256;
static_assert(WS_ACT + (size_t)ACT_ROWS * FF * 2 <= WS_Y2 && WS_Y2 + (size_t)2 * T * D * 2 <= WS_XB, "moe overlay");
constexpr int CW_BAR = 4096;
constexpr int CW_CNT = 16384;

constexpr int RING_BYTES = 131072, MISC_OFF = RING_BYTES, LDS_BYTES = 147456;

__device__ __forceinline__ float bf2f(unsigned v) { return __uint_as_float(v << 16); }
typedef __bf16 bf16x2_t __attribute__((ext_vector_type(2)));
__device__ __forceinline__ unsigned cvt_pk_bf16(float lo, float hi) { f32x2 v = {lo, hi}; bf16x2_t b = __builtin_convertvector(v, bf16x2_t); return __builtin_bit_cast(unsigned, b); }
__device__ __forceinline__ u32x4 pack8(f32x4 a, f32x4 b) { u32x4 w; w.x = cvt_pk_bf16(a[0], a[1]); w.y = cvt_pk_bf16(a[2], a[3]); w.z = cvt_pk_bf16(b[0], b[1]); w.w = cvt_pk_bf16(b[2], b[3]); return w; }
__device__ __forceinline__ u32x2 pack8_fp8(f32x4 a, f32x4 b) { u32x2 w;
    w.x = (unsigned)__builtin_amdgcn_cvt_pk_fp8_f32(a[2], a[3], __builtin_amdgcn_cvt_pk_fp8_f32(a[0], a[1], 0, false), true);
    w.y = (unsigned)__builtin_amdgcn_cvt_pk_fp8_f32(b[2], b[3], __builtin_amdgcn_cvt_pk_fp8_f32(b[0], b[1], 0, false), true); return w; }
__device__ __forceinline__ void unpack8(u32x4 w, f32x4& a, f32x4& b) { a[0] = bf2f(w.x & 0xffffu); a[1] = bf2f(w.x >> 16); a[2] = bf2f(w.y & 0xffffu); a[3] = bf2f(w.y >> 16); b[0] = bf2f(w.z & 0xffffu); b[1] = bf2f(w.z >> 16); b[2] = bf2f(w.w & 0xffffu); b[3] = bf2f(w.w >> 16); }
__device__ __forceinline__ float wave_sum(float v) {
#pragma unroll
    for (int o = 1; o < 64; o <<= 1) v += __shfl_xor(v, o);
    return v;
}
__device__ __forceinline__ float sigm(float v) { return __builtin_amdgcn_rcpf(1.f + __builtin_amdgcn_exp2f(v * (-LOG2E))); }
#if WT_STORES
__device__ __forceinline__ void st16(void* p, u32x4 v) { asm volatile("global_store_dwordx4 %0, %1, off sc1\n\ts_nop 1" :: "v"(p), "v"(v) : "memory"); }
__device__ __forceinline__ void st8(void* p, u32x2 v) { asm volatile("global_store_dwordx2 %0, %1, off sc1\n\ts_nop 1" :: "v"(p), "v"(v) : "memory"); }
#else
__device__ __forceinline__ void st16(void* p, u32x4 v) { *(u32x4*)p = v; }
__device__ __forceinline__ void st8(void* p, u32x2 v) { *(u32x2*)p = v; }
#endif
#define VM_WAIT() asm volatile("s_waitcnt vmcnt(0)" ::: "memory")
#define LAUNDER_S(p) asm volatile("" : "+s"(p))
#define LAUNDER_V(v) asm volatile("" : "+v"(v))
#define LDS_WAIT() asm volatile("s_waitcnt lgkmcnt(0)" ::: "memory")

#define XB_TMO      128
#define XB_XCNT(j)  (256  + 64 * (j))
#define XB_XSUB(j)  (1280 + 64 * (j))
#define XB_XGEN(j)  (2304 + 64 * (j))
#define XB_TOP      3328
#define XB_TOPGEN   3392
#define XCD_BAR_WORDS 3456
#define XB_SPIN_CAP (1u << 22)
__device__ __forceinline__ unsigned xb_ld(unsigned* p)              { return __hip_atomic_load(p, __ATOMIC_RELAXED, __HIP_MEMORY_SCOPE_AGENT); }
__device__ __forceinline__ unsigned xb_add(unsigned* p, unsigned v) { return __hip_atomic_fetch_add(p, v, __ATOMIC_RELAXED, __HIP_MEMORY_SCOPE_AGENT); }
__device__ __forceinline__ unsigned xb_xcc_id() { return (unsigned)__builtin_amdgcn_s_getreg((3 << 11) | 20) & 0xFu; }
#define XB_SPIN(cond, bar) do { unsigned _sp = 0; while (cond) { __builtin_amdgcn_s_sleep(1); \
    if ((++_sp & 255u) == 0u) { if (xb_ld(&(bar)[XB_TMO])) break; if (_sp > XB_SPIN_CAP) { atomicAdd(&(bar)[XB_TMO], 1u); break; } } } } while (0)
struct XcdBarrier { unsigned* bar; unsigned x; volatile LAS unsigned* st; };
__device__ __forceinline__ XcdBarrier xcd_barrier_post(unsigned* bar, volatile LAS unsigned* st) {
    XcdBarrier b; b.bar = bar; b.x = xb_xcc_id(); b.st = st;
    if (threadIdx.x == 0) (void)xb_add(&bar[XB_XCNT(b.x)], 1u);
    return b;
}
__device__ __forceinline__ void xcd_barrier_complete(unsigned* bar, unsigned x, unsigned& nloc, unsigned& nx) {
    const unsigned G = gridDim.x * gridDim.y * gridDim.z;
    unsigned sum, cnt, mine, sp = 0u;
    for (;;) {
        sum = 0u; cnt = 0u; mine = 0u;
#pragma unroll
        for (unsigned j = 0; j < 16; ++j) { const unsigned c = xb_ld(&bar[XB_XCNT(j)]); sum += c; cnt += (c > 0u) ? 1u : 0u; mine = (j == x) ? c : mine; }
        if (sum == G) break;
        __builtin_amdgcn_s_sleep(1);
        if ((++sp & 255u) == 0u) { if (xb_ld(&bar[XB_TMO])) break; if (sp > XB_SPIN_CAP) { atomicAdd(&bar[XB_TMO], 1u); break; } }
    }
    nloc = mine > 0u ? mine : 1u; nx = cnt > 0u ? cnt : 1u;
}
__device__ __forceinline__ void xcd_barrier(const XcdBarrier& b) {
    asm volatile("s_waitcnt vmcnt(0)" ::: "memory");
    __syncthreads();
    if (threadIdx.x == 0) {
        unsigned* bar = b.bar;
        __builtin_amdgcn_s_waitcnt(0);
        unsigned nloc = b.st[0], nx = b.st[1];
        if (nloc == 0u) { xcd_barrier_complete(bar, b.x, nloc, nx); b.st[0] = nloc; b.st[1] = nx; }
        const unsigned old = xb_add(&bar[XB_XSUB(b.x)], 1u);
        const unsigned gen = old / nloc;
        if (old + 1u == (gen + 1u) * nloc) {
            __builtin_amdgcn_fence(__ATOMIC_RELEASE, "agent");
            asm volatile("s_waitcnt vmcnt(0)" ::: "memory");
            const unsigned og = xb_add(&bar[XB_TOP], 1u);
            const unsigned tg = og / nx;
            if (og + 1u == (tg + 1u) * nx) xb_add(&bar[XB_TOPGEN], 1u);
            else XB_SPIN(xb_ld(&bar[XB_TOPGEN]) == tg, bar);
            __builtin_amdgcn_fence(__ATOMIC_ACQUIRE, "agent");
            xb_add(&bar[XB_XGEN(b.x)], 1u);
            asm volatile("s_waitcnt vmcnt(0)" ::: "memory");
        } else {
            XB_SPIN(xb_ld(&bar[XB_XGEN(b.x)]) == gen, bar);
            __builtin_amdgcn_fence(__ATOMIC_ACQUIRE, "agent");
            asm volatile("s_waitcnt vmcnt(0)" ::: "memory");
        }
    }
    __syncthreads();
}

namespace gp {
constexpr int BM = 256, BK = 64, HALF = 128, HTB = HALF * BK * 2, NXCD = 8, WGM = 8;
__host__ __device__ __forceinline__ int lds_byte(int r, int c) { const int st = (r >> 4) * 2 + (c >> 5), rr = r & 15, cc = c & 31, ob = rr * 64 + cc * 2; return st * 1024 + (ob ^ (((ob >> 9) & 1) << 5)); }
__host__ __device__ __forceinline__ void stage_rc(int b, int& R, int& C) { const int st = b / 1024, sb = b % 1024, swz = sb ^ (((sb >> 9) & 1) << 5); R = (st >> 1) * 16 + swz / 64; C = (st & 1) * 32 + (swz % 64) / 2; }
__host__ __device__ __forceinline__ int perm32(int rho) { const int n = rho >> 4, i = rho & 15; return 8 * (i >> 2) + 4 * n + (i & 3); }

struct Unit { int pm, pn, be, rl, nv; };
struct Gemm { const bf16_t* A; const bf16_t* Bt; int K; size_t bstride; const unsigned* list; size_t astride; int sw, sx; };

__device__ __forceinline__ int xcd_remap(int wgid, int nwg) { const int q = nwg / NXCD, r = nwg % NXCD, xcd = wgid % NXCD, off = wgid / NXCD; return (xcd < r ? xcd * (q + 1) : r * (q + 1) + (xcd - r) * q) + off; }
struct DenseOrder {
    int nM, nN, nwg, G, c;
    __device__ void init(int M, int N, int G_, int c_) { nM = M / BM; nN = N / BM; nwg = nM * nN; G = G_; c = c_; }
    __device__ bool next(int i, Unit& u) const {
        const long L = (long)i * G + c; if (L >= nwg) return false;
        const int wgid = xcd_remap((int)L, nwg);
        const int nig = WGM * nN, gid = wgid / nig, fm = gid * WGM, gsz = (nM - fm) < WGM ? (nM - fm) : WGM;
        u.pm = fm + ((wgid % nig) % gsz); u.pn = (wgid % nig) / gsz; u.be = 0; u.rl = 0; u.nv = 256; return true;
    }
};
struct PairOrder {
    DenseOrder d;
    __device__ void init(int M, int N, int G_, int c_) { d.init(M, N, G_, c_); }
    __device__ bool next(int i, Unit& u) const { if (!d.next(i >> 1, u)) return false; u.be = i & 1; return true; }
};
struct MoeOrder {
    const LAS int* tab; int nwg, G, c;
    __device__ static int rd(const LAS int* p) { return __builtin_amdgcn_readfirstlane(*p); }
    __device__ void init(const LAS int* tab_, int G_, int c_) { tab = tab_; nwg = rd(tab_ + 16) * 4; G = G_; c = c_; }
    __device__ bool next(int i, Unit& u) const {
        const long L = (long)i * G + c; if (L >= nwg) return false;
        const int wgid = xcd_remap((int)L, nwg);
        const int tile = wgid >> 2; int e = 0;
        for (int k = 1; k < NE; ++k) { const int tk = rd(tab + k); e = (tk <= tile) ? k : e; }
        e = __builtin_amdgcn_readfirstlane(e);
        u.pm = tile; u.pn = wgid & 3; u.be = e; u.rl = tile - rd(tab + e); const int rem = rd(tab + 32 + e) - u.rl * 256; u.nv = rem < 256 ? rem : 256; return true;
    }
};

#define ACC_T f32x4 (&acc)[2][2][4][2]

template <class Epi, class Sched, bool GATHER>
__device__ __forceinline__ void gemm_phase_ref(int tid, const Gemm g, const Sched& S, const Epi& E) {
    const int wid = __builtin_amdgcn_readfirstlane(tid >> 6), lane = tid & 63, wr = wid >> 2, wc = wid & 3, fr = lane & 15, fq = lane >> 4;
    const int K = g.K; Unit u;
    for (int ui = 0; S.next(ui, u); ++ui) {
        f32x4 acc[2][2][4][2];
#pragma unroll
        for (int a = 0; a < 2; ++a)
#pragma unroll
            for (int b = 0; b < 2; ++b)
#pragma unroll
                for (int m = 0; m < 4; ++m)
#pragma unroll
                    for (int n = 0; n < 2; ++n) acc[a][b][m][n] = (f32x4){0.f, 0.f, 0.f, 0.f};
        const bf16_t* Bt = g.Bt + (size_t)u.be * g.bstride + (size_t)u.pn * 256 * K;
        for (int ai = 0; ai < 2; ++ai)
            for (int m = 0; m < 4; ++m) {
                const int rloc = ai * 128 + wr * 64 + m * 16 + fr;
                size_t arow;
                if (GATHER) { arow = (rloc < u.nv) ? (size_t)(g.list[(size_t)u.be * T + u.rl * 256 + rloc] >> 1) : 0; }
                else arow = (size_t)u.pm * 256 + rloc;
                const bf16_t* ap = g.A + arow * K;
                for (int bj = 0; bj < 2; ++bj) {
                    const bf16_t* bp = Bt + (size_t)(bj * 128 + wc * 32 + fq * 8) * K;
                    float s[8];
#pragma unroll
                    for (int c = 0; c < 8; ++c) {
                        float sc = 0.f; const bf16_t* bpc = bp + (size_t)c * K;
#pragma unroll 2
                        for (int k = 0; k < K; k += 8) {
                            f32x4 a0, a1, b0, b1; unpack8(*(const u32x4*)(ap + k), a0, a1); unpack8(*(const u32x4*)(bpc + k), b0, b1);
                            sc += a0[0] * b0[0] + a0[1] * b0[1] + a0[2] * b0[2] + a0[3] * b0[3] + a1[0] * b1[0] + a1[1] * b1[1] + a1[2] * b1[2] + a1[3] * b1[3];
                        }
                        s[c] = sc; asm volatile("" : "+v"(s[c]));
                    }
#pragma unroll
                    for (int a2 = 0; a2 < 2; ++a2)
#pragma unroll
                        for (int b2 = 0; b2 < 2; ++b2)
#pragma unroll
                            for (int m2 = 0; m2 < 4; ++m2)
                                if (a2 == ai && b2 == bj && m2 == m) { acc[a2][b2][m2][0] = (f32x4){s[0], s[1], s[2], s[3]}; acc[a2][b2][m2][1] = (f32x4){s[4], s[5], s[6], s[7]}; }
                }
            }
        E(acc, u, wr, wc, fr, fq);
    }
}

template <class E> struct EpiTraits { static constexpr bool KEEP = false; };
#if FAST_GEMM
typedef int v8i_t __attribute__((ext_vector_type(8)));
__device__ __forceinline__ unsigned gp_voffb(int tid, int i, int K) { int t_ = tid; LAUNDER_V(t_); int R, C; stage_rc(t_ * 16 + i * 8192, R, C); const int Rb = (R & ~31) + perm32(R & 31); return (unsigned)(Rb * K + C) * 2u; }
template <class Epi, class Sched, bool GATHER, bool F8>
__device__ __forceinline__ void gemm_phase_fast(int tid, LAS unsigned char* lds, const Gemm g, const Sched& S, const Epi& E) {
    const int wid = __builtin_amdgcn_readfirstlane(tid >> 6), lane = tid & 63, wr = wid >> 2, wc = wid & 3, fr = lane & 15, fq = lane >> 4;
    const int K = g.K, nt = K / BK;
    int Rr[2], Cc[2]; unsigned voffB[2];
#pragma unroll
    for (int i = 0; i < 2; ++i) { stage_rc(tid * 16 + i * 8192, Rr[i], Cc[i]); const int Rb = (Rr[i] & ~31) + perm32(Rr[i] & 31); voffB[i] = (unsigned)(Rb * K + Cc[i]) * 2u; }
#define GP_VB(i) (F8 ? gp_voffb(tid, (i), K) : voffB[i])
    const size_t kstep = (size_t)(BK * 2), hstep = (size_t)HALF * K * 2, tstep = 2 * hstep;
    const unsigned ldsw = (unsigned)wid * 1024u;
    const int aoff = lds_byte(wr * 64 + fr, fq * 8), boff = lds_byte(wc * 32 + fr, fq * 8);
#define GP_UNI(p) ((const char*)(((unsigned long long)(unsigned)__builtin_amdgcn_readfirstlane((int)((unsigned long long)(p) >> 32)) << 32) | (unsigned)__builtin_amdgcn_readfirstlane((int)(unsigned long long)(p))))
#define GP_SA(b, h) (((b) * 2 + (h)) * HTB)
#define GP_SB(b, h) ((4 + (b) * 2 + (h)) * HTB)
#define GP_DMA(sbase, voff, ldsdst) do { unsigned keep_; asm volatile("s_mov_b32 %0, m0\n\ts_mov_b32 m0, %3\n\ts_nop 0\n\tglobal_load_lds_dwordx4 %1, %2\n\ts_mov_b32 m0, %0" \
        : "=&s"(keep_) : "v"(voff), "s"(sbase), "s"((unsigned)__builtin_amdgcn_readfirstlane((int)(unsigned)(uintptr_t)(ldsdst))) : "memory"); } while (0)
#define GP_STAGE2(bufoff, gbase, v0, v1) do { const char* gb_ = (gbase); GP_DMA(gb_, (v0), lds + (bufoff) + ldsw); GP_DMA(gb_, (v1), lds + (bufoff) + ldsw + 8192); } while (0)
#define GP_STAGEB(bufoff, gbase) GP_STAGE2(bufoff, gbase, GP_VB(0), GP_VB(1))
#define GP_CAT8(x0, x1) __builtin_bit_cast(v8i_t, __builtin_shufflevector(x0, x1, 0, 1, 2, 3, 4, 5, 6, 7, 8, 9, 10, 11, 12, 13, 14, 15))
#define GP_LDA(dst, b, h) do { _Pragma("unroll") for (int m = 0; m < 4; ++m) _Pragma("unroll") for (int k = 0; k < 2; ++k) dst[m][k] = *(const LAS bf16x8*)(lds + GP_SA(b, h) + aoff + m * 2048 + k * 1024); \
        if constexpr (F8) { _Pragma("unroll") for (int m = 0; m < 4; ++m) dst##8[m] = GP_CAT8(dst[m][0], dst[m][1]); } } while (0)
#define GP_LDB(dst, b, h) do { _Pragma("unroll") for (int n = 0; n < 2; ++n) _Pragma("unroll") for (int k = 0; k < 2; ++k) dst[n][k] = *(const LAS bf16x8*)(lds + GP_SB(b, h) + boff + n * 2048 + k * 1024); \
        if constexpr (F8) { _Pragma("unroll") for (int n = 0; n < 2; ++n) dst##8[n] = GP_CAT8(dst[n][0], dst[n][1]); } } while (0)
#define GP_MMA(ai, bj, At, Bt) do { __builtin_amdgcn_s_setprio(1); \
        if constexpr (F8) { _Pragma("unroll") for (int m = 0; m < 4; ++m) _Pragma("unroll") for (int n = 0; n < 2; ++n) \
            acc[ai][bj][m][n] = __builtin_amdgcn_mfma_scale_f32_16x16x128_f8f6f4(Bt##8[n], At##8[m], acc[ai][bj][m][n], 0, 0, 0, 0, 0, 0); }     \
        else { _Pragma("unroll") for (int m = 0; m < 4; ++m) _Pragma("unroll") for (int n = 0; n < 2; ++n) _Pragma("unroll") for (int k = 0; k < 2; ++k) \
            acc[ai][bj][m][n] = __builtin_amdgcn_mfma_f32_16x16x32_bf16(Bt[n][k], At[m][k], acc[ai][bj][m][n], 0, 0, 0); } \
        __builtin_amdgcn_s_setprio(0); } while (0)
#define GP_WAIT_V(n) asm volatile("s_waitcnt vmcnt(" #n ")" ::: "memory")
#define GP_WAIT_L(n) asm volatile("s_waitcnt lgkmcnt(" #n ")" ::: "memory")
#define GP_BAR __builtin_amdgcn_s_barrier()
#define GP_SCHED __builtin_amdgcn_sched_barrier(0)
    Unit cur, nxt; int ui = 0;
    if (!S.next(0, cur)) return;
    f32x4 acc[2][2][4][2];
#pragma unroll
    for (int a = 0; a < 2; ++a)
#pragma unroll
        for (int b = 0; b < 2; ++b)
#pragma unroll
            for (int m = 0; m < 4; ++m)
#pragma unroll
                for (int n = 0; n < 2; ++n) acc[a][b][m][n] = (f32x4){0.f, 0.f, 0.f, 0.f};
    bf16x8 At[4][2], B0[2][2], B1[2][2];
    v8i_t At8[4], B08[2], B18[2];
    unsigned vC0, vC1, vC2, vC3, vN0, vN1, vN2, vN3;
#define GP_VOFF(u, o0, o1, o2, o3) do { if (GATHER) { \
        int tl_ = tid; LAUNDER_V(tl_); int R0_, C0_, R1_, C1_; stage_rc(tl_ * 16, R0_, C0_); stage_rc(tl_ * 16 + 8192, R1_, C1_);     \
        const unsigned* lp = g.list + (size_t)(u).be * T + (u).rl * 256; \
        const int nvm = (u).nv - 1; const int p0 = min(R0_, nvm), p1 = min(R1_, nvm), p2 = min(128 + R0_, nvm), p3 = min(128 + R1_, nvm); \
        const unsigned t0 = lp[p0] >> 1, t1 = lp[p1] >> 1, t2 = lp[p2] >> 1, t3 = lp[p3] >> 1; \
        o0 = (t0 * K + C0_) * 2u; o1 = (t1 * K + C1_) * 2u; o2 = (t2 * K + C0_) * 2u; o3 = (t3 * K + C1_) * 2u; \
      } else { o0 = (unsigned)(Rr[0] * K + Cc[0]) * 2u; o1 = (unsigned)(Rr[1] * K + Cc[1]) * 2u; o2 = o0 + (unsigned)hstep; o3 = o1 + (unsigned)hstep; } } while (0)
    GP_VOFF(cur, vC0, vC1, vC2, vC3);
    const char* cA = GP_UNI((const char*)g.A + ((size_t)cur.be * g.astride) * 2 + (GATHER ? (size_t)0 : (size_t)cur.pm * tstep));
    const char* cB = GP_UNI((const char*)g.Bt + ((size_t)cur.be * g.bstride) * 2 + (size_t)cur.pn * tstep);
    GP_STAGEB(GP_SB(0, 0), cB); GP_STAGEB(GP_SB(0, 1), cB + hstep); GP_STAGE2(GP_SA(0, 0), cA, vC0, vC1); GP_STAGE2(GP_SA(0, 1), cA, vC2, vC3);
    if (wr == 1) GP_BAR;
    GP_WAIT_V(2); GP_BAR;
    GP_STAGEB(GP_SB(1, 0), cB + kstep); GP_STAGE2(GP_SA(1, 0), cA + kstep, vC0, vC1); GP_STAGEB(GP_SB(1, 1), cB + hstep + kstep);
    GP_WAIT_V(6); GP_BAR;
    for (;;) {
        const bool has_next = S.next(ui + 1, nxt);
        const char* nA = GP_UNI(has_next ? (const char*)g.A + ((size_t)nxt.be * g.astride) * 2 + (GATHER ? (size_t)0 : (size_t)nxt.pm * tstep) : cA);
        const char* nB = GP_UNI(has_next ? (const char*)g.Bt + ((size_t)nxt.be * g.bstride) * 2 + (size_t)nxt.pn * tstep : cB);
        if (GATHER) {
            if (has_next) { GP_VOFF(nxt, vN0, vN1, vN2, vN3); } else { vN0 = vC0; vN1 = vC1; vN2 = vC2; vN3 = vC3; }
            *(LAS u32x4*)(lds + MISC_OFF + 2048 + tid * 16) = (u32x4){vN0, vN1, vN2, vN3};
        } else { vN0 = vC0; vN1 = vC1; vN2 = vC2; vN3 = vC3; }
#pragma nounroll
        for (int t = 0; t < nt; t += 2) {
            LAUNDER_S(cA); LAUNDER_S(cB); LAUNDER_S(nA); LAUNDER_S(nB);
            const bool last = (t == nt - 2);
            if (GATHER) { if (last) { const u32x4 q_ = *(const LAS u32x4*)(lds + MISC_OFF + 2048 + tid * 16); vN0 = q_.x; vN1 = q_.y; vN2 = q_.z; vN3 = q_.w; } }
            const char* a1 = cA + (size_t)(t + 1) * kstep;
            const char* a2 = last ? nA : cA + (size_t)(t + 2) * kstep; const char* b2 = last ? nB : cB + (size_t)(t + 2) * kstep;
            const char* a3 = a2 + kstep; const char* b3 = b2 + kstep;
            const unsigned w0 = last ? vN0 : vC0, w1 = last ? vN1 : vC1, w2 = last ? vN2 : vC2, w3 = last ? vN3 : vC3;
            GP_LDB(B0, 0, 0); GP_LDB(B1, 0, 1); GP_SCHED; GP_LDA(At, 0, 0); GP_STAGE2(GP_SA(1, 1), a1, vC2, vC3);
            GP_WAIT_V(8); GP_WAIT_L(0); GP_BAR; GP_MMA(0, 0, At, B0); GP_MMA(0, 1, At, B1); GP_BAR; GP_SCHED;
            GP_LDA(At, 0, 1); GP_STAGEB(GP_SB(0, 0), b2); GP_STAGEB(GP_SB(0, 1), b2 + hstep); GP_STAGE2(GP_SA(0, 0), a2, w0, w1);
            GP_WAIT_V(8); GP_WAIT_L(0); GP_BAR; GP_MMA(1, 0, At, B0); GP_MMA(1, 1, At, B1); GP_BAR; GP_SCHED;
            GP_LDB(B0, 1, 0); GP_LDB(B1, 1, 1); GP_SCHED; GP_LDA(At, 1, 0); GP_STAGE2(GP_SA(0, 1), a2, w2, w3);
            GP_WAIT_V(8); GP_WAIT_L(0); GP_BAR; GP_MMA(0, 0, At, B0); GP_MMA(0, 1, At, B1); GP_BAR; GP_SCHED;
            GP_LDA(At, 1, 1); GP_STAGEB(GP_SB(1, 0), b3); GP_STAGEB(GP_SB(1, 1), b3 + hstep); GP_STAGE2(GP_SA(1, 0), a3, w0, w1);
            GP_WAIT_V(8); GP_WAIT_L(0); GP_BAR; GP_MMA(1, 0, At, B0); GP_MMA(1, 1, At, B1); GP_BAR; GP_SCHED;
        }
        if (wr == 0) GP_BAR;
        E(acc, cur, wr, wc, fr, fq);
        if (!has_next) break;
        if (!(EpiTraits<Epi>::KEEP && cur.be == 0)) {
#pragma unroll
        for (int a = 0; a < 2; ++a)
#pragma unroll
            for (int b = 0; b < 2; ++b)
#pragma unroll
                for (int m = 0; m < 4; ++m)
#pragma unroll
                    for (int n = 0; n < 2; ++n) acc[a][b][m][n] = (f32x4){0.f, 0.f, 0.f, 0.f};
        }
        cur = nxt; cA = nA; cB = nB; vC0 = vN0; vC1 = vN1; vC2 = vN2; vC3 = vN3; ++ui;
        if (wr == 1) GP_BAR;
    }
    GP_WAIT_V(0);
    GP_BAR;
#undef GP_UNI
#undef GP_SA
#undef GP_SB
#undef GP_STAGE2
#undef GP_DMA
#undef GP_STAGEB
#undef GP_VB
#undef GP_LDA
#undef GP_LDB
#undef GP_MMA
#undef GP_CAT8
#undef GP_WAIT_V
#undef GP_WAIT_L
#undef GP_BAR
#undef GP_SCHED
#undef GP_VOFF
}
#endif

template <class Epi, class Sched, bool GATHER = false, bool F8 = false>
__device__ __forceinline__ void gemm_phase(int tid, LAS unsigned char* lds, const Gemm g, const Sched& S, const Epi& E) {
#if FAST_GEMM
    gemm_phase_fast<Epi, Sched, GATHER, F8>(tid, lds, g, S, E);
#else
    (void)lds; gemm_phase_ref<Epi, Sched, GATHER>(tid, g, S, E);
#endif
}

#define EPI_ROW(ai, m) (u.pm * 256 + (ai) * 128 + wr * 64 + (m) * 16 + fr)
#define EPI_COL(bj) (u.pn * 256 + (bj) * 128 + wc * 32 + fq * 8)
__device__ __forceinline__ float dot4(f32x4 a) { return (a[0] * a[0] + a[1] * a[1]) + (a[2] * a[2] + a[3] * a[3]); }

struct EpiNull {
    __device__ __forceinline__ void operator()(const ACC_T, const Unit& u, int wr, int wc, int fr, int fq) const {
#pragma unroll
        for (int ai = 0; ai < 2; ++ai)
#pragma unroll
            for (int bj = 0; bj < 2; ++bj)
#pragma unroll
                for (int m = 0; m < 4; ++m) asm volatile("" :: "v"(acc[ai][bj][m][0]), "v"(acc[ai][bj][m][1]));
    }
};
struct EpiIn {
    bf16_t *QA, *KA, *VA, *QLAT, *KVLAT, *KB, *SA, *SB; float *SSQ, *SSKV; const float *gq, *gk, *cosA, *sinA, *cosB, *sinB;
    __device__ __forceinline__ void operator()(const ACC_T, const Unit& u, int wr, int wc, int fr, int fq) const {
        const int wb = u.pn * 4 + wc;
        if (wb < 10) {
            const bool isq = wb < 8; const int head = isq ? wb : wb - 8; const float* g = isq ? gq : gk; bf16_t* dst = isq ? QA : KA; const int dp = isq ? 512 : 128; const float qs = isq ? QSCALE_A * (ATT_FP8_A ? PFOLD : 1.f) : 1.f;
            const f32x4 g00 = *(const f32x4*)(g + 8 * fq), g01 = *(const f32x4*)(g + 8 * fq + 4), g10 = *(const f32x4*)(g + 32 + 8 * fq), g11 = *(const f32x4*)(g + 36 + 8 * fq);
#pragma unroll
            for (int ai = 0; ai < 2; ++ai)
#pragma unroll
                for (int m = 0; m < 4; ++m) {
                    const int r = EPI_ROW(ai, m), pos = r & (S - 1);
                    const f32x4 v00 = acc[ai][0][m][0], v01 = acc[ai][0][m][1], v10 = acc[ai][1][m][0], v11 = acc[ai][1][m][1];
                    float ss = (dot4(v00) + dot4(v01)) + (dot4(v10) + dot4(v11)); ss += __shfl_xor(ss, 16); ss += __shfl_xor(ss, 32);
                    const float rstd = rsqrtf(ss * (1.f / 64.f) + EPS);
                    const f32x4 y00 = v00 * rstd * g00, y01 = v01 * rstd * g01, y10 = v10 * rstd * g10, y11 = v11 * rstd * g11;
                    const f32x4 c0 = *(const f32x4*)(cosA + pos * 32 + 8 * fq), c1 = *(const f32x4*)(cosA + pos * 32 + 8 * fq + 4), s0 = *(const f32x4*)(sinA + pos * 32 + 8 * fq), s1 = *(const f32x4*)(sinA + pos * 32 + 8 * fq + 4);
                    const f32x4 o00 = (y00 * c0 - y10 * s0) * qs, o01 = (y01 * c1 - y11 * s1) * qs, o10 = (y10 * c0 + y00 * s0) * qs, o11 = (y11 * c1 + y01 * s1) * qs;
#if ATT_FP8_A
                    unsigned char* p8 = (unsigned char*)dst + (size_t)r * dp + head * 64 + 8 * fq;
                    st8(p8, pack8_fp8(o00, o01)); st8(p8 + 32, pack8_fp8(o10, o11));
#else
                    bf16_t* p = dst + (size_t)r * dp + head * 64 + 8 * fq;
                    st16(p, pack8(o00, o01)); st16((p + 32), pack8(o10, o11));
#endif
                }
        } else if (wb < 12) {
#pragma unroll
            for (int ai = 0; ai < 2; ++ai)
#pragma unroll
                for (int m = 0; m < 4; ++m) {
#if ATT_FP8_A
                    const int r = EPI_ROW(ai, m), sq = r & (S - 1), k = sq & 63, pos = 32 * ((k >> 2) & 1) + 16 * (k >> 5) + (k & 3) + 4 * ((k & 31) >> 3);
                    unsigned char* vtb = (unsigned char*)VA; const unsigned vo = (unsigned)(((r >> 12) * 2 + (wb - 10)) * 64 + 8 * fq) * S + (unsigned)((sq & ~63) + pos);
#pragma unroll
                    for (int bj = 0; bj < 2; ++bj)
#pragma unroll
                        for (int n = 0; n < 2; ++n) { const f32x4 x = acc[ai][bj][m][n]; const unsigned w = (unsigned)__builtin_amdgcn_cvt_pk_fp8_f32(x[2], x[3], __builtin_amdgcn_cvt_pk_fp8_f32(x[0], x[1], 0, false), true);
                            const unsigned qo = vo + (unsigned)(bj * 32 + 4 * n) * S;
                            vtb[qo] = (unsigned char)(w & 0xffu); vtb[qo + S] = (unsigned char)((w >> 8) & 0xffu); vtb[qo + 2 * S] = (unsigned char)((w >> 16) & 0xffu); vtb[qo + 3 * S] = (unsigned char)(w >> 24); }
#else
                    bf16_t* p = VA + (size_t)EPI_ROW(ai, m) * 128 + (wb - 10) * 64 + 8 * fq;
                    st16(p, pack8(acc[ai][0][m][0], acc[ai][0][m][1])); st16((p + 32), pack8(acc[ai][1][m][0], acc[ai][1][m][1]));
#endif
                }
        } else if (wb < 22) {
            const bool isq = wb < 18; const int idx = isq ? wb - 12 : wb - 18; bf16_t* dst = isq ? QLAT : KVLAT; const int dp = isq ? 384 : 256;
#pragma unroll
            for (int ai = 0; ai < 2; ++ai)
#pragma unroll
                for (int m = 0; m < 4; ++m) {
                    const int r = EPI_ROW(ai, m);
                    const f32x4 v00 = acc[ai][0][m][0], v01 = acc[ai][0][m][1], v10 = acc[ai][1][m][0], v11 = acc[ai][1][m][1];
                    float ss = (dot4(v00) + dot4(v01)) + (dot4(v10) + dot4(v11)); ss += __shfl_xor(ss, 16); ss += __shfl_xor(ss, 32);
                    if (fq == 0) { if (isq) SSQ[(size_t)r * 8 + idx] = ss; else SSKV[(size_t)r * 4 + idx] = ss; }
                    bf16_t* p = dst + (size_t)r * dp + idx * 64 + 8 * fq;
                    st16(p, pack8(v00, v01)); st16((p + 32), pack8(v10, v11));
                }
        } else if (wb == 22) {
            if (fq < 2) {
#pragma unroll
                for (int ai = 0; ai < 2; ++ai)
#pragma unroll
                    for (int m = 0; m < 4; ++m) {
                        const int r = EPI_ROW(ai, m), pos = r & (S - 1);
                        const f32x4 x10 = acc[ai][0][m][0], x11 = acc[ai][0][m][1], x20 = acc[ai][1][m][0], x21 = acc[ai][1][m][1];
                        const f32x4 c0 = *(const f32x4*)(cosB + pos * 16 + 8 * fq), c1 = *(const f32x4*)(cosB + pos * 16 + 8 * fq + 4), s0 = *(const f32x4*)(sinB + pos * 16 + 8 * fq), s1 = *(const f32x4*)(sinB + pos * 16 + 8 * fq + 4);
#if ATT_FP8_B
                        const u32x2 w1 = pack8_fp8(x10 * c0 - x20 * s0, x11 * c1 - x21 * s1), w2 = pack8_fp8(x20 * c0 + x10 * s0, x21 * c1 + x11 * s1);
                        unsigned char* p = (unsigned char*)KB + (size_t)r * 768 + 64 + 8 * fq;
#pragma unroll
                        for (int h = 0; h < 8; ++h) { st8(p + h * 96, w1); st8(p + h * 96 + 16, w2); }
#else
                        const u32x4 w1 = pack8(x10 * c0 - x20 * s0, x11 * c1 - x21 * s1), w2 = pack8(x20 * c0 + x10 * s0, x21 * c1 + x11 * s1);
                        bf16_t* p = KB + (size_t)r * 768 + 64 + 8 * fq;
#pragma unroll
                        for (int h = 0; h < 8; ++h) { st16((p + h * 96), w1); st16((p + h * 96 + 16), w2); }
#endif
                    }
            }
        } else if (wb == 23) {
        } else {
            const bool isa = wb < 40; const int idx = isa ? wb - 24 : wb - 40; unsigned char* dst = (unsigned char*)(isa ? SA : SB);
#pragma unroll
            for (int ai = 0; ai < 2; ++ai)
#pragma unroll
                for (int m = 0; m < 4; ++m) { unsigned char* p = dst + (size_t)EPI_ROW(ai, m) * 1024 + idx * 64 + 8 * fq;
#pragma unroll
                    for (int bj = 0; bj < 2; ++bj) { const f32x4 a = acc[ai][bj][m][0], b = acc[ai][bj][m][1]; u32x2 w;
                        w.x = (unsigned)__builtin_amdgcn_cvt_pk_fp8_f32(a[2], a[3], __builtin_amdgcn_cvt_pk_fp8_f32(a[0], a[1], 0, false), true);
                        w.y = (unsigned)__builtin_amdgcn_cvt_pk_fp8_f32(b[2], b[3], __builtin_amdgcn_cvt_pk_fp8_f32(b[0], b[1], 0, false), true);
                        st8((p + bj * 32), w); } }
        }
    }
};
__host__ __device__ __forceinline__ int src_col_in(int n) {
    const int pn = n >> 8, nl = n & 255, bj = nl >> 7, wc = (nl & 127) >> 5, p = nl & 31, wb = pn * 4 + wc, s = bj * 32 + p;
    if (wb < 8) return wb * 64 + s;
    if (wb < 10) return 512 + (wb - 8) * 64 + s;
    if (wb < 12) return 640 + (wb - 10) * 64 + s;
    if (wb < 18) return 768 + (wb - 12) * 64 + s;
    if (wb < 22) return 1152 + (wb - 18) * 64 + s;
    if (wb == 22) return p < 16 ? 1408 + bj * 16 + p : -1;
    if (wb == 23) return -1;
    if (wb < 40) return 1440 + (wb - 24) * 64 + s;
    return 2464 + (wb - 40) * 64 + s;
}
struct EpiQb {
    bf16_t* QB; const float *SSQ, *cosB, *sinB;
    __device__ __forceinline__ void operator()(const ACC_T, const Unit& u, int wr, int wc, int fr, int fq) const {
#pragma unroll
        for (int ai = 0; ai < 2; ++ai)
#pragma unroll
            for (int m = 0; m < 4; ++m) {
                const int r = EPI_ROW(ai, m), pos = r & (S - 1);
                const f32x4 sa = *(const f32x4*)(SSQ + (size_t)r * 8); const f32x2 sb = *(const f32x2*)(SSQ + (size_t)r * 8 + 4);
                const float rstd = rsqrtf((((sa[0] + sa[1]) + (sa[2] + sa[3])) + (sb[0] + sb[1])) * (1.f / 384.f) + EPS);
#pragma unroll
                for (int bj = 0; bj < 2; ++bj) {
                    f32x4 v0 = acc[ai][bj][m][0] * rstd, v1 = acc[ai][bj][m][1] * rstd;
                    const int c32 = u.pn * 8 + bj * 4 + wc;
                    if (c32 % 3 == 2) {
                        f32x4 o0, o1;
#pragma unroll
                        for (int j = 0; j < 4; ++j) { o0[j] = __shfl_xor(v0[j], 32); o1[j] = __shfl_xor(v1[j], 32); }
                        const int i0 = 8 * (fq & 1);
                        const f32x4 c0 = *(const f32x4*)(cosB + pos * 16 + i0), c1 = *(const f32x4*)(cosB + pos * 16 + i0 + 4), s0 = *(const f32x4*)(sinB + pos * 16 + i0), s1 = *(const f32x4*)(sinB + pos * 16 + i0 + 4);
                        if (fq < 2) { v0 = v0 * c0 - o0 * s0; v1 = v1 * c1 - o1 * s1; } else { v0 = v0 * c0 + o0 * s0; v1 = v1 * c1 + o1 * s1; }
                    }
#if ATT_FP8_B
                    st8((unsigned char*)QB + (size_t)r * 768 + EPI_COL(bj), pack8_fp8(v0 * (QSCALE_B * PFOLD), v1 * (QSCALE_B * PFOLD)));
#else
                    st16((QB + (size_t)r * 768 + EPI_COL(bj)), pack8(v0 * QSCALE_B, v1 * QSCALE_B));
#endif
                }
            }
    }
};
struct EpiKvb {
    bf16_t *KB, *VB; const float* SSKV;
    __device__ __forceinline__ void operator()(const ACC_T, const Unit& u, int wr, int wc, int fr, int fq) const {
#pragma unroll
        for (int ai = 0; ai < 2; ++ai)
#pragma unroll
            for (int m = 0; m < 4; ++m) {
                const int r = EPI_ROW(ai, m);
                const f32x4 sa = *(const f32x4*)(SSKV + (size_t)r * 4);
                const float rstd = rsqrtf(((sa[0] + sa[1]) + (sa[2] + sa[3])) * (1.f / 256.f) + EPS);
#pragma unroll
                for (int bj = 0; bj < 2; ++bj) {
                    const int head = u.pn * 2 + bj, o = wc * 32 + fq * 8;
#if ATT_FP8_B
                    const f32x4 x0 = acc[ai][bj][m][0] * rstd, x1 = acc[ai][bj][m][1] * rstd;
                    if (wc < 2) st8((unsigned char*)KB + (size_t)r * 768 + head * 96 + o, pack8_fp8(x0, x1));
                    else {
                        const int sq = r & (S - 1), k = sq & 63, pos = 32 * ((k >> 2) & 1) + 16 * (k >> 5) + (k & 3) + 4 * ((k & 31) >> 3);
                        unsigned char* vtb = (unsigned char*)VB; const unsigned vo = (unsigned)(((r >> 12) * 8 + head) * 64 + (o - 64)) * S + (unsigned)((sq & ~63) + pos);
                        const u32x2 w = pack8_fp8(x0, x1);
                        vtb[vo] = (unsigned char)(w.x & 0xffu); vtb[vo + S] = (unsigned char)((w.x >> 8) & 0xffu); vtb[vo + 2 * S] = (unsigned char)((w.x >> 16) & 0xffu); vtb[vo + 3 * S] = (unsigned char)(w.x >> 24);
                        vtb[vo + 4 * S] = (unsigned char)(w.y & 0xffu); vtb[vo + 5 * S] = (unsigned char)((w.y >> 8) & 0xffu); vtb[vo + 6 * S] = (unsigned char)((w.y >> 16) & 0xffu); vtb[vo + 7 * S] = (unsigned char)(w.y >> 24);
                    }
#else
                    const u32x4 w = pack8(acc[ai][bj][m][0] * rstd, acc[ai][bj][m][1] * rstd);
                    if (wc < 2) st16((KB + (size_t)r * 768 + head * 96 + o), w); else st16((VB + (size_t)r * 512 + head * 64 + (o - 64)), w);
#endif
                }
            }
    }
};
template <int MODE> struct EpiProj {
    bf16_t* O; const bf16_t* gate;
    __device__ __forceinline__ void operator()(const ACC_T, const Unit& u, int wr, int wc, int fr, int fq) const {
#pragma unroll
        for (int ai = 0; ai < 2; ++ai)
#pragma unroll
            for (int m = 0; m < 4; ++m) {
                const int r = EPI_ROW(ai, m);
#pragma unroll
                for (int bj = 0; bj < 2; ++bj) {
                    const size_t off = (size_t)r * D + EPI_COL(bj);
                    const u32x2 gw = *(const u32x2*)((const unsigned char*)gate + off);
                    const f32x2 q0 = __builtin_amdgcn_cvt_pk_f32_fp8((int)gw.x, false), q1 = __builtin_amdgcn_cvt_pk_f32_fp8((int)gw.x, true), q2 = __builtin_amdgcn_cvt_pk_f32_fp8((int)gw.y, false), q3 = __builtin_amdgcn_cvt_pk_f32_fp8((int)gw.y, true);
                    const f32x4 g0 = {sigm(q0[0]), sigm(q0[1]), sigm(q1[0]), sigm(q1[1])}, g1 = {sigm(q2[0]), sigm(q2[1]), sigm(q3[0]), sigm(q3[1])};
                    f32x4 v0 = acc[ai][bj][m][0] * g0, v1 = acc[ai][bj][m][1] * g1;
                    if (MODE == 1) { f32x4 p0, p1; unpack8(*(const u32x4*)(O + off), p0, p1); v0 += p0; v1 += p1; }
                    if (MODE == 1) st16(O + off, pack8(v0, v1)); else *(u32x4*)(O + off) = pack8(v0, v1);
                }
            }
    }
};
struct EpiProjP {
    bf16_t* O; const unsigned char* SA; const unsigned char* SB;
    __device__ static __forceinline__ void gates(const unsigned char* G, size_t off, f32x4& g0, f32x4& g1) {
        const u32x2 gw = *(const u32x2*)(G + off);
        const f32x2 q0 = __builtin_amdgcn_cvt_pk_f32_fp8((int)gw.x, false), q1 = __builtin_amdgcn_cvt_pk_f32_fp8((int)gw.x, true), q2 = __builtin_amdgcn_cvt_pk_f32_fp8((int)gw.y, false), q3 = __builtin_amdgcn_cvt_pk_f32_fp8((int)gw.y, true);
        g0 = (f32x4){sigm(q0[0]), sigm(q0[1]), sigm(q1[0]), sigm(q1[1])}; g1 = (f32x4){sigm(q2[0]), sigm(q2[1]), sigm(q3[0]), sigm(q3[1])};
    }
    __device__ __forceinline__ void operator()(f32x4 (&acc)[2][2][4][2], const Unit& u, int wr, int wc, int fr, int fq) const {
#pragma unroll
        for (int ai = 0; ai < 2; ++ai)
#pragma unroll
            for (int m = 0; m < 4; ++m) {
                const int r = EPI_ROW(ai, m);
#pragma unroll
                for (int bj = 0; bj < 2; ++bj) {
                    const size_t off = (size_t)r * D + EPI_COL(bj);
                    f32x4 b0, b1; gates(SB, off, b0, b1);
#pragma unroll
                    for (int j = 0; j < 4; ++j) { b0[j] = fmaxf(b0[j], 9.094947e-13f); b1[j] = fmaxf(b1[j], 9.094947e-13f); }
                    if (u.be == 0) {
                        f32x4 a0, a1; gates(SA, off, a0, a1);
#pragma unroll
                        for (int j = 0; j < 4; ++j) { acc[ai][bj][m][0][j] *= a0[j] * __builtin_amdgcn_rcpf(b0[j]); acc[ai][bj][m][1][j] *= a1[j] * __builtin_amdgcn_rcpf(b1[j]); }
                    } else st16(O + off, pack8(acc[ai][bj][m][0] * b0, acc[ai][bj][m][1] * b1));
                }
            }
    }
};
template <> struct EpiTraits<EpiProjP> { static constexpr bool KEEP = true; };
struct EpiWo {
    const bf16_t* X; const float* modl; bf16_t* XO;
    __device__ __forceinline__ void operator()(const ACC_T, const Unit& u, int wr, int wc, int fr, int fq) const {
        const float* g1 = modl + (size_t)(u.pm >> 4) * 6 * D + 2 * D;
#pragma unroll
        for (int bj = 0; bj < 2; ++bj) {
            const int c = EPI_COL(bj); const f32x4 ga = *(const f32x4*)(g1 + c), gb = *(const f32x4*)(g1 + c + 4);
#pragma unroll
            for (int ai = 0; ai < 2; ++ai)
#pragma unroll
                for (int m = 0; m < 4; ++m) { const size_t off = (size_t)EPI_ROW(ai, m) * D + c;
                    f32x4 x0, x1; unpack8(*(const u32x4*)(X + off), x0, x1);
                    st16((XO + off), pack8(x0 + ga * acc[ai][bj][m][0], x1 + gb * acc[ai][bj][m][1])); }
        }
    }
};
struct EpiUp {
    bf16_t* ACT; float inscale;
    __device__ __forceinline__ void operator()(const ACC_T, const Unit& u, int wr, int wc, int fr, int fq) const {
#pragma unroll
        for (int ai = 0; ai < 2; ++ai)
#pragma unroll
            for (int m = 0; m < 4; ++m) {
                f32x4 a = acc[ai][0][m][0] * inscale, b = acc[ai][0][m][1] * inscale; const f32x4 c = acc[ai][1][m][0] * inscale, d = acc[ai][1][m][1] * inscale;
#pragma unroll
                for (int j = 0; j < 4; ++j) { a[j] = a[j] * sigm(a[j]) * c[j]; b[j] = b[j] * sigm(b[j]) * d[j]; }
#if MOE_FP8
                st8((unsigned char*)ACT + (size_t)EPI_ROW(ai, m) * FF + u.pn * 128 + wc * 32 + fq * 8, pack8_fp8(a * 8.f, b * 8.f));
#else
                st16((ACT + (size_t)EPI_ROW(ai, m) * FF + u.pn * 128 + wc * 32 + fq * 8), pack8(a, b));
#endif
            }
    }
};
struct EpiDown {
    bf16_t* Y2; const unsigned* list; const float* gw; float inscale;
    __device__ __forceinline__ void operator()(const ACC_T, const Unit& u, int wr, int wc, int fr, int fq) const {
#pragma unroll
        for (int ai = 0; ai < 2; ++ai)
#pragma unroll
            for (int m = 0; m < 4; ++m) {
                const int rloc = ai * 128 + wr * 64 + m * 16 + fr;
                if (rloc < u.nv) {
                    const unsigned entry = list[(size_t)u.be * T + u.rl * 256 + rloc]; const float w = gw[entry] * inscale;
#pragma unroll
                    for (int bj = 0; bj < 2; ++bj) { const f32x4 a = acc[ai][bj][m][0] * (w * 16.f), b = acc[ai][bj][m][1] * (w * 16.f); u32x2 q;
                        q.x = (unsigned)__builtin_amdgcn_cvt_pk_fp8_f32(a[2], a[3], __builtin_amdgcn_cvt_pk_fp8_f32(a[0], a[1], 0, false), true);
                        q.y = (unsigned)__builtin_amdgcn_cvt_pk_fp8_f32(b[2], b[3], __builtin_amdgcn_cvt_pk_fp8_f32(b[0], b[1], 0, false), true);
                        st8(((unsigned char*)Y2 + (size_t)entry * D + EPI_COL(bj)), q); }
                }
            }
    }
};
}

namespace at {
struct Tensors { const bf16_t* Q; int qp; const bf16_t* K; int kp; const bf16_t* V; int vp; bf16_t* O; int op; int group; };
__device__ __forceinline__ bool next_unit(int i, int vcu, int G, int& bh, int& qb) {
    int u;
    if (G == 256) { if (i >= 4) return false; u = (vcu >> 5) * 128 + i * 32 + (vcu & 31); }
    else { u = i * G + vcu; if (u >= 1024) return false; }
    bh = u >> 4; qb = u & 15; return true;
}
template <int DQK>
__device__ __forceinline__ void attn_phase_ref(int tid, const Tensors& A, int vcu, int G) {
    int bh, qb;
    for (int i = 0; next_unit(i, vcu, G, bh, qb); ++i) {
        const int b = bh >> 3, h = bh & 7, kvh = h / A.group;
        {
            const int dh = tid >> 8;
            const size_t row = (size_t)b * S + qb * 256 + (tid & 255);
            float q[DQK], o[32];
#pragma unroll
            for (int d = 0; d < DQK; ++d) q[d] = bf2f(A.Q[row * A.qp + h * DQK + d]);
#pragma unroll
            for (int d = 0; d < 32; ++d) o[d] = 0.f;
            float l = 0.f;
            for (int k = 0; k < S; ++k) {
                const bf16_t* kr = A.K + ((size_t)b * S + k) * A.kp + kvh * DQK; const bf16_t* vr = A.V + ((size_t)b * S + k) * A.vp + kvh * 64 + dh * 32;
                float sc = 0.f;
#pragma unroll
                for (int d = 0; d < DQK; d += 8) { f32x4 k0, k1; unpack8(*(const u32x4*)(kr + d), k0, k1);
                    sc += q[d] * k0[0] + q[d + 1] * k0[1] + q[d + 2] * k0[2] + q[d + 3] * k0[3] + q[d + 4] * k1[0] + q[d + 5] * k1[1] + q[d + 6] * k1[2] + q[d + 7] * k1[3]; }
                const float p = bf2f(cvt_pk_bf16(exp2f(sc), 0.f) & 0xffffu); l += p;
#pragma unroll
                for (int d = 0; d < 32; d += 8) { f32x4 v0, v1; unpack8(*(const u32x4*)(vr + d), v0, v1);
                    o[d] += p * v0[0]; o[d + 1] += p * v0[1]; o[d + 2] += p * v0[2]; o[d + 3] += p * v0[3]; o[d + 4] += p * v1[0]; o[d + 5] += p * v1[1]; o[d + 6] += p * v1[2]; o[d + 7] += p * v1[3]; }
            }
            const float il = 1.f / l;
            __syncthreads();
#pragma unroll
            for (int d = 0; d < 32; d += 8) { f32x4 a = {o[d] * il, o[d + 1] * il, o[d + 2] * il, o[d + 3] * il}, c = {o[d + 4] * il, o[d + 5] * il, o[d + 6] * il, o[d + 7] * il};
                *(u32x4*)(A.O + row * A.op + h * 64 + dh * 32 + d) = pack8(a, c); }
        }
    }
}
#if FAST_ATTN
typedef short s16x4 __attribute__((ext_vector_type(4)));
__device__ __forceinline__ unsigned cvtpk(float lo, float hi) { f32x2 v = {lo, hi}; bf16x2_t b = __builtin_convertvector(v, bf16x2_t); return __builtin_bit_cast(unsigned, b); }
__device__ __forceinline__ s16x4 vtr(const LAS unsigned char* p) { return __builtin_bit_cast(s16x4, __builtin_amdgcn_ds_read_tr16_b64_v4i16((LAS s16x4*)p)); }
__device__ __forceinline__ int crow(int r, int hi) { return (r & 3) + 8 * (r >> 2) + 4 * hi; }
#define AT_BAR() asm volatile("s_barrier" ::: "memory")
#define AT_WAITBAR(N) asm volatile("s_waitcnt vmcnt(" #N ") lgkmcnt(0)\n\ts_barrier" ::: "memory")
#define AT_SCHED() __builtin_amdgcn_sched_barrier(0)
__device__ __forceinline__ void glds16(const void* gsrc, unsigned lds_dst) { unsigned keep;
    asm volatile("s_mov_b32 %0, m0\n\ts_mov_b32 m0, %2\n\ts_nop 0\n\tglobal_load_lds_dwordx4 %1, off\n\ts_mov_b32 m0, %0" : "=&s"(keep) : "v"(gsrc), "s"(lds_dst) : "memory"); }
#define AT_GLDS(g, l) glds16((const void*)(g), (unsigned)__builtin_amdgcn_readfirstlane((int)(unsigned)(uintptr_t)(l)))
template <int DQK>
__device__ __forceinline__ void attn_unit(int tid, LAS unsigned char* lds, const Tensors& A, int b, int h, int qb) {
    constexpr int ND = DQK / 16, NCH = DQK / 8, KSLOT = NCH * 1024, NKD = NCH > 8 ? 2 : 1, VSLOT = 8192, NT = S / 64;
    constexpr int KOFF = 0, VOFF = 3 * KSLOT, OST = VOFF + 3 * VSLOT, WSF = OST + 8 * 4096;
    static_assert(WSF + 8 * 256 <= RING_BYTES, "attention LDS");
    const int lane = tid & 63, r32 = lane & 31, hi = lane >> 5, wid = __builtin_amdgcn_readfirstlane(tid >> 6);
    const int kvh = h / A.group; const size_t rowb = (size_t)b * S;
    const bf16_t* ksrc = A.K + (rowb + lane) * A.kp + kvh * DQK + wid * 8;
    const bf16_t* ksrc2 = A.K + (rowb + lane) * A.kp + kvh * DQK + (8 + (wid & 3)) * 8;
    const bf16_t* vsrc = A.V + (rowb + 16 * (wid & 3) + (lane >> 2)) * A.vp + kvh * 64 + (wid >> 2) * 32 + (lane & 3) * 8;
    const size_t ktile = (size_t)64 * A.kp, vtile = (size_t)64 * A.vp;
    LAS unsigned char* kdst = lds + KOFF + wid * 1024; LAS unsigned char* kdst2 = lds + KOFF + (8 + (wid & 3)) * 1024; LAS unsigned char* vdst = lds + VOFF + wid * 1024;
#define DMA_K(j, so) do { AT_GLDS(ksrc + (size_t)(j) * ktile, kdst + (so)); if (NKD == 2) AT_GLDS(ksrc2 + (size_t)(j) * ktile, kdst2 + (so)); } while (0)
#define DMA_V(j, so) AT_GLDS(vsrc + (size_t)(j) * vtile, vdst + (so))
    const LAS unsigned char* kp0 = lds + KOFF + hi * 1024 + r32 * 16;
    const LAS unsigned char* vp0 = lds + VOFF + ((lane >> 4) & 1) * 32 + (lane & 3) * 8 + (4 * hi + ((lane & 15) >> 2)) * 64;
    DMA_K(0, 0); DMA_V(0, 0); DMA_K(1, KSLOT); DMA_V(1, VSLOT); DMA_K(2, 2 * KSLOT);
    const bf16_t* Qw = A.Q + (rowb + qb * 256 + wid * 32 + r32) * A.qp + h * DQK + hi * 8;
    bf16x8 qr[ND];
#pragma unroll
    for (int d0 = 0; d0 < ND; ++d0) qr[d0] = *(const bf16x8*)(Qw + d0 * 16);
    asm volatile("s_waitcnt vmcnt(0)\n\ts_barrier" ::: "memory");
    bf16x8 kf[2 * ND]; s16x4 vlo[8], vhi[8];
#define KLOAD(so) do { _Pragma("unroll") for (int d0 = 0; d0 < ND; ++d0) { kf[2 * d0] = *(const LAS bf16x8*)(kp0 + (so) + d0 * 2048); kf[2 * d0 + 1] = *(const LAS bf16x8*)(kp0 + (so) + d0 * 2048 + 512); } } while (0)
#define VLOAD(so) do { _Pragma("unroll") for (int i = 0; i < 8; ++i) { vlo[i] = vtr(vp0 + (so) + (i >> 2) * 4096 + (i & 3) * 1024); vhi[i] = vtr(vp0 + (so) + (i >> 2) * 4096 + (i & 3) * 1024 + 512); } } while (0)
#define VFR(i) (bf16x8){vlo[i][0], vlo[i][1], vlo[i][2], vlo[i][3], vhi[i][0], vhi[i][1], vhi[i][2], vhi[i][3]}
    KLOAD(0);
    asm volatile("s_waitcnt lgkmcnt(0)" ::: "memory");
    if (PROBE_ATT != 5 && wid >= 4) AT_BAR();
    f32x16 o0 = {}, o1 = {}, C0, C1; u32x4 pw0, pw1, pw2, pw3; float lsum = 0.f;
    const f32x16 zero = {};
#define QK_BLOCK() do { C0 = __builtin_amdgcn_mfma_f32_32x32x16_bf16(kf[0], qr[0], zero, 0, 0, 0); C1 = __builtin_amdgcn_mfma_f32_32x32x16_bf16(kf[1], qr[0], zero, 0, 0, 0); \
        _Pragma("unroll") for (int d0 = 1; d0 < ND; ++d0) { C0 = __builtin_amdgcn_mfma_f32_32x32x16_bf16(kf[2 * d0], qr[d0], C0, 0, 0, 0); C1 = __builtin_amdgcn_mfma_f32_32x32x16_bf16(kf[2 * d0 + 1], qr[d0], C1, 0, 0, 0); } } while (0)
#define PAF(k) __builtin_bit_cast(bf16x8, pw##k)
#define PV_BLOCK() do { \
        o0 = __builtin_amdgcn_mfma_f32_32x32x16_bf16(PAF(0), VFR(0), o0, 0, 0, 0); o1 = __builtin_amdgcn_mfma_f32_32x32x16_bf16(PAF(0), VFR(4), o1, 0, 0, 0); \
        o0 = __builtin_amdgcn_mfma_f32_32x32x16_bf16(PAF(1), VFR(1), o0, 0, 0, 0); o1 = __builtin_amdgcn_mfma_f32_32x32x16_bf16(PAF(1), VFR(5), o1, 0, 0, 0); \
        o0 = __builtin_amdgcn_mfma_f32_32x32x16_bf16(PAF(2), VFR(2), o0, 0, 0, 0); o1 = __builtin_amdgcn_mfma_f32_32x32x16_bf16(PAF(2), VFR(6), o1, 0, 0, 0); \
        o0 = __builtin_amdgcn_mfma_f32_32x32x16_bf16(PAF(3), VFR(3), o0, 0, 0, 0); o1 = __builtin_amdgcn_mfma_f32_32x32x16_bf16(PAF(3), VFR(7), o1, 0, 0, 0); } while (0)
#define SOFTMAX() do { \
        _Pragma("unroll") for (int r = 0; r < 16; ++r) { C0[r] = __builtin_amdgcn_exp2f(C0[r]); C1[r] = __builtin_amdgcn_exp2f(C1[r]); } \
        f32x2 s0_ = {C0[0], C0[1]}, s1_ = {C1[0], C1[1]}; _Pragma("unroll") for (int r = 2; r < 16; r += 2) { s0_ += (f32x2){C0[r], C0[r + 1]}; s1_ += (f32x2){C1[r], C1[r + 1]}; } s0_ += s1_; lsum += s0_[0] + s0_[1]; \
        pw0 = (u32x4){cvtpk(C0[0], C0[1]), cvtpk(C0[2], C0[3]), cvtpk(C0[4], C0[5]), cvtpk(C0[6], C0[7])}; pw1 = (u32x4){cvtpk(C0[8], C0[9]), cvtpk(C0[10], C0[11]), cvtpk(C0[12], C0[13]), cvtpk(C0[14], C0[15])}; \
        pw2 = (u32x4){cvtpk(C1[0], C1[1]), cvtpk(C1[2], C1[3]), cvtpk(C1[4], C1[5]), cvtpk(C1[6], C1[7])}; pw3 = (u32x4){cvtpk(C1[8], C1[9]), cvtpk(C1[10], C1[11]), cvtpk(C1[12], C1[13]), cvtpk(C1[14], C1[15])}; } while (0)
    int ka = 2 * KSLOT, kb = 0, kc = KSLOT, va = 2 * VSLOT, vb = 0, vc = VSLOT;
#define ROT() do { const int t_ = ka; ka = kb; kb = kc; kc = t_; const int u_ = va; va = vb; vb = vc; vc = u_; } while (0)
#define PINP() asm volatile("" : "+v"(lsum) : "v"(pw0), "v"(pw1), "v"(pw2), "v"(pw3))
#if ATT_REGSTAGE
    u32x4 kst = {}, kst2 = {}, vst = {};
    const LAS unsigned char* kw = lds + KOFF + wid * 1024 + lane * 16; const LAS unsigned char* kw2 = lds + KOFF + (8 + (wid & 3)) * 1024 + lane * 16; const LAS unsigned char* vw = lds + VOFF + wid * 1024 + lane * 16;
#define ST_WRITE(WK, WV) do { if (WK) { *(LAS u32x4*)(kw + ka) = kst; if (NKD == 2 && wid < 4) *(LAS u32x4*)(kw2 + ka) = kst2; } if (WV) *(LAS u32x4*)(vw + vc) = vst; } while (0)
#define ST_LOAD(sv, IK, IV) do { if (IK) { kst = *(const u32x4*)(ksrc + (size_t)((sv) + 4) * ktile); if (NKD == 2 && wid < 4) kst2 = *(const u32x4*)(ksrc2 + (size_t)((sv) + 4) * ktile); } if (IV) vst = *(const u32x4*)(vsrc + (size_t)((sv) + 3) * vtile); } while (0)
#define STEP(sv, DOQK, DOPV, KL, VL, IK, IV, WK, WV) do { \
        AT_SCHED(); if (DOQK) QK_BLOCK(); if (DOPV) PV_BLOCK(); AT_SCHED(); \
        asm volatile("s_barrier\n\ts_nop 15\n\ts_nop 3" : "+v"(C0), "+v"(C1), "+v"(o0), "+v"(o1) :: "memory"); AT_SCHED(); \
        if (KL) KLOAD(kc); if (VL) VLOAD(vb); ST_WRITE(WK, WV); ST_LOAD(sv, IK, IV); \
        if (DOQK) { SOFTMAX(); PINP(); } AT_SCHED(); \
        asm volatile("s_waitcnt lgkmcnt(0)\n\ts_barrier" ::: "memory"); \
        AT_SCHED(); ROT(); } while (0)
    STEP(-1, true, false, true, true, true, true, false, false);
#pragma nounroll
    for (int s = 0; s < NT - 4; ++s) STEP(s, true, true, true, true, true, true, true, true);
    STEP(NT - 4, true, true, true, true, false, true, true, true);
    STEP(NT - 3, true, true, true, true, false, false, false, true);
    STEP(NT - 2, true, true, false, true, false, false, false, false);
    STEP(NT - 1, false, true, false, false, false, false, false, false);
#undef ST_WRITE
#undef ST_LOAD
#else
#define STEP(sv, DOQK, DOPV, KL, VL, IK, IV) do { \
        AT_SCHED(); if (DOQK) QK_BLOCK(); if (DOPV) PV_BLOCK(); AT_SCHED(); \
          \
        asm volatile("s_barrier\n\ts_nop 15\n\ts_nop 3" : "+v"(C0), "+v"(C1), "+v"(o0), "+v"(o1) :: "memory"); AT_SCHED(); \
        if (KL) KLOAD(kc); if (VL) VLOAD(vb); if (IK) DMA_K((sv) + 4, kb); if (IV) DMA_V((sv) + 3, va); \
        if (DOQK) { SOFTMAX(); PINP(); } AT_SCHED(); \
        if (IK) { if (NKD == 2) { AT_WAITBAR(3); } else { AT_WAITBAR(2); } } else if (IV) { AT_WAITBAR(1); } else { AT_WAITBAR(0); } \
        AT_SCHED(); ROT(); } while (0)
    STEP(-1, true, false, true, true, true, true);
#pragma nounroll
    for (int s = 0; s < NT - 4; ++s) STEP(s, true, true, true, true, true, true);
    STEP(NT - 4, true, true, true, true, false, true);
    STEP(NT - 3, true, true, true, true, false, false);
    STEP(NT - 2, true, true, false, true, false, false);
    STEP(NT - 1, false, true, false, false, false, false);
#endif
#undef STEP
#undef PINP
    if (PROBE_ATT != 5 && wid < 4) AT_BAR();
    { auto rr = __builtin_amdgcn_permlane32_swap(__float_as_uint(lsum), __float_as_uint(lsum), false, false); lsum = __uint_as_float(rr[0]) + __uint_as_float(rr[1]); }
    LAS float* wsf = (LAS float*)(lds + WSF + wid * 256);
    if (hi == 0) wsf[r32] = lsum;
    asm volatile("s_waitcnt lgkmcnt(0)" ::: "memory");
    LAS bf16_t* stg = (LAS bf16_t*)(lds + OST + wid * 4096);
#pragma unroll
    for (int r = 0; r < 16; ++r) { const int orow = crow(r, hi); const float rl = __builtin_amdgcn_rcpf(wsf[orow]);
        stg[orow * 64 + r32] = (bf16_t)(cvtpk(o0[r] * rl, 0.f) & 0xffffu); stg[orow * 64 + 32 + r32] = (bf16_t)(cvtpk(o1[r] * rl, 0.f) & 0xffffu); }
    asm volatile("s_waitcnt lgkmcnt(0)" ::: "memory");
    bf16_t* Ow = A.O + (rowb + qb * 256 + wid * 32) * A.op + h * 64;
#pragma unroll
    for (int i = 0; i < 4; ++i) { const int row = i * 8 + (lane >> 3), ch = lane & 7; const u32x4 v = *(const LAS u32x4*)(stg + row * 64 + ch * 8); st16((Ow + (size_t)row * A.op + ch * 8), v); }
    asm volatile("s_waitcnt lgkmcnt(0)\n\ts_barrier" ::: "memory");
#undef DMA_K
#undef DMA_V
#undef KLOAD
#undef VLOAD
#undef VFR
#undef QK_BLOCK
#undef PAF
#undef PV_BLOCK
#undef SOFTMAX
#undef ROT
}
#endif
#if FAST_ATTN && ATT_FP8_A
typedef int v8i __attribute__((ext_vector_type(8)));
__device__ __forceinline__ f32x16 mfma8(v8i a, v8i b, f32x16 c) { return __builtin_amdgcn_mfma_scale_f32_32x32x64_f8f6f4(a, b, c, 0, 0, 0, 0x7f7f7f7f, 0, 0x7f7f7f7f); }
__device__ __forceinline__ f32x16 mfma8pv(v8i a, v8i b, f32x16 c) { return __builtin_amdgcn_mfma_scale_f32_32x32x64_f8f6f4(a, b, c, 1, 0, 0, 0x7f7f7f7f, 0, 0x7f7f7f7f); }
__device__ __forceinline__ void attn_unit_f8a(int tid, LAS unsigned char* lds, const unsigned char* Q8, const unsigned char* K8, const unsigned char* VT8, bf16_t* O, int op, int b, int h, int qb, float bias) {
    constexpr int SL = 4096, NT = S / 64;
    constexpr int KOFF = 0, VOFF = 3 * SL, OST = VOFF + 3 * SL, WSF = OST + 8 * 4096;
    const int lane = tid & 63, r32 = lane & 31, hi = lane >> 5, wid = __builtin_amdgcn_readfirstlane(tid >> 6);
    const int kvh = h >> 2; const size_t rowb = (size_t)b * S; const bool kw = wid < 4;
    const unsigned char* src = kw ? K8 + (rowb + lane) * 128 + kvh * 64 + 16 * wid : VT8 + ((size_t)((b * 2 + kvh) * 64 + lane)) * S + 16 * (wid - 4);
    const size_t tstep = kw ? (size_t)64 * 128 : (size_t)64;
    LAS unsigned char* dst = lds + (kw ? KOFF + wid * 1024 : VOFF + (wid - 4) * 1024);
#define DMA8(j, so) AT_GLDS(src + (size_t)(j) * tstep, dst + (so))
    const LAS unsigned char* kp0 = lds + KOFF + (2 * hi) * 1024 + r32 * 16;
    const LAS unsigned char* vp0 = lds + VOFF + (2 * hi) * 1024 + r32 * 16;
    if (kw) { DMA8(0, 0); DMA8(1, SL); DMA8(2, 2 * SL); } else { DMA8(0, 0); DMA8(1, SL); }
    v8i qf; { const unsigned char* Qw = Q8 + (rowb + qb * 256 + wid * 32 + r32) * 512 + h * 64 + 32 * hi; const u32x4 a = *(const u32x4*)Qw, c = *(const u32x4*)(Qw + 16);
        qf = (v8i){(int)a.x, (int)a.y, (int)a.z, (int)a.w, (int)c.x, (int)c.y, (int)c.z, (int)c.w}; }
    asm volatile("s_waitcnt vmcnt(0)\n\ts_barrier" ::: "memory");
    v8i kf0, kf1, vf0, vf1, p8;
#define LD32(dstv, p) do { const u32x4 a_ = *(const LAS u32x4*)(p), c_ = *(const LAS u32x4*)((p) + 1024); dstv = (v8i){(int)a_.x, (int)a_.y, (int)a_.z, (int)a_.w, (int)c_.x, (int)c_.y, (int)c_.z, (int)c_.w}; } while (0)
#define KLOAD8(so) do { LD32(kf0, kp0 + (so)); LD32(kf1, kp0 + (so) + 512); } while (0)
#define VLOAD8(so) do { LD32(vf0, vp0 + (so)); LD32(vf1, vp0 + (so) + 512); } while (0)
    KLOAD8(0);
    asm volatile("s_waitcnt lgkmcnt(0)" ::: "memory");
    if (wid >= 4) AT_BAR();
    f32x16 o0 = {}, o1 = {}, o2 = {}, C0, C1;
    const v8i ones = {0x38383838, 0x38383838, 0x38383838, 0x38383838, 0x38383838, 0x38383838, 0x38383838, 0x38383838};
    f32x16 negb;
#pragma unroll
    for (int r = 0; r < 16; ++r) negb[r] = PFOLD * bias + PBYTE0;
    asm volatile("" : "+v"(negb));
#define SOFTMAX8() do { \
        _Pragma("unroll") for (int i = 0; i < 4; ++i) { \
            const f32x2 a_ = (f32x2){C0[4 * i], C0[4 * i + 1]}, b_ = (f32x2){C0[4 * i + 2], C0[4 * i + 3]}, c_ = (f32x2){C1[4 * i], C1[4 * i + 1]}, d_ = (f32x2){C1[4 * i + 2], C1[4 * i + 3]}; \
            p8[i] = (int)__builtin_amdgcn_cvt_pk_u8_f32(b_[1], 3, __builtin_amdgcn_cvt_pk_u8_f32(b_[0], 2, __builtin_amdgcn_cvt_pk_u8_f32(a_[1], 1, __builtin_amdgcn_cvt_pk_u8_f32(a_[0], 0, 0u)))); \
            p8[4 + i] = (int)__builtin_amdgcn_cvt_pk_u8_f32(d_[1], 3, __builtin_amdgcn_cvt_pk_u8_f32(d_[0], 2, __builtin_amdgcn_cvt_pk_u8_f32(c_[1], 1, __builtin_amdgcn_cvt_pk_u8_f32(c_[0], 0, 0u)))); } } while (0)
    int oa = 2 * SL, ob = 0, oc = SL;
#define ROT8() do { const int t_ = oa; oa = ob; ob = oc; oc = t_; } while (0)
#define STEP8(sv, DOQK, DOPV, KL, VL, IK, IV) do { \
        AT_SCHED(); if (DOQK) { C0 = mfma8(kf0, qf, negb); C1 = mfma8(kf1, qf, negb); } if (DOPV) { o0 = mfma8pv(p8, vf0, o0); o1 = mfma8pv(p8, vf1, o1); o2 = mfma8pv(p8, ones, o2); } AT_SCHED(); \
        asm volatile("s_barrier\n\ts_nop 15\n\ts_nop 15" : "+v"(C0), "+v"(C1), "+v"(o0), "+v"(o1), "+v"(o2) :: "memory"); AT_SCHED(); \
        if (KL) KLOAD8(oc); if (VL) VLOAD8(ob); \
        const bool iss_ = kw ? (IK) : (IV); if (iss_) { if (kw) DMA8((sv) + 4, ob); else DMA8((sv) + 3, oa); } \
        if (DOQK) { SOFTMAX8(); asm volatile("" :: "v"(p8)); } AT_SCHED(); \
        if (iss_) { AT_WAITBAR(1); } else { AT_WAITBAR(0); } \
        AT_SCHED(); ROT8(); } while (0)
    STEP8(-1, true, false, true, true, true, true);
#pragma nounroll
    for (int s = 0; s < NT - 4; ++s) STEP8(s, true, true, true, true, true, true);
    STEP8(NT - 4, true, true, true, true, false, true);
    STEP8(NT - 3, true, true, true, true, false, false);
    STEP8(NT - 2, true, true, false, true, false, false);
    STEP8(NT - 1, false, true, false, false, false, false);
    if (wid < 4) AT_BAR();
    LAS bf16_t* stg = (LAS bf16_t*)(lds + OST + wid * 4096);
#pragma unroll
    for (int r = 0; r < 16; ++r) { const int orow = crow(r, hi); const float rl = __builtin_amdgcn_rcpf(o2[r]);
        stg[orow * 64 + r32] = (bf16_t)(cvtpk(o0[r] * rl, 0.f) & 0xffffu); stg[orow * 64 + 32 + r32] = (bf16_t)(cvtpk(o1[r] * rl, 0.f) & 0xffffu); }
    asm volatile("s_waitcnt lgkmcnt(0)" ::: "memory");
    bf16_t* Ow = O + (rowb + qb * 256 + wid * 32) * op + h * 64;
#pragma unroll
    for (int i = 0; i < 4; ++i) { const int row = i * 8 + (lane >> 3), ch = lane & 7; const u32x4 v = *(const LAS u32x4*)(stg + row * 64 + ch * 8); st16(Ow + (size_t)row * op + ch * 8, v); }
    asm volatile("s_waitcnt lgkmcnt(0)\n\ts_barrier" ::: "memory");
#undef DMA8
#undef LD32
#undef KLOAD8
#undef VLOAD8
#undef SOFTMAX8
#undef ROT8
#undef STEP8
}
__device__ __forceinline__ void attn_phase_f8a(int tid, LAS unsigned char* lds, const unsigned char* Q8, const unsigned char* K8, const unsigned char* VT8, bf16_t* O, int op, const float* gq, const float* gk, int vcu, int G) {
    float mq = 0.f, mk = 0.f;
    for (int i = 0; i < 64; ++i) { mq = fmaxf(mq, fabsf(gq[i])); mk = fmaxf(mk, fabsf(gk[i])); }
    const float bias = -fmaxf(64.f * mq * mk * QSCALE_A * 1.13f - 15.5f, 0.f);
    int bh, qb;
    for (int i = 0; next_unit(i, vcu, G, bh, qb); ++i) attn_unit_f8a(tid, lds, Q8, K8, VT8, O, op, bh >> 3, bh & 7, qb, bias);
}
#endif
#if FAST_ATTN && ATT_FP8_B
__device__ __forceinline__ void attn_unit_f8b(int tid, LAS unsigned char* lds, const unsigned char* Q8, const unsigned char* K8, const unsigned char* VT8, bf16_t* O, int op, int b, int h, int qb) {
    constexpr int SLK = 6144, SLV = 4096, NT = S / 64;
    constexpr int KOFF = 0, VOFF = 3 * SLK, OST = VOFF + 3 * SLV, WSF = OST + 8 * 4096;
    static_assert(WSF + 2048 <= RING_BYTES, "attention LDS");
    const int lane = tid & 63, r32 = lane & 31, hi = lane >> 5, wid = __builtin_amdgcn_readfirstlane(tid >> 6);
    const size_t rowb = (size_t)b * S; const bool kw = wid < 6, vw = wid >= 4;
    const unsigned char* ksrc = K8 + (rowb + lane) * 768 + h * 96 + 16 * wid;
    const unsigned char* vsrc = VT8 + ((size_t)((b * 8 + h) * 64 + lane)) * S + 16 * (wid - 4);
    LAS unsigned char* kdst = lds + KOFF + wid * 1024; LAS unsigned char* vdst = lds + VOFF + (wid - 4) * 1024;
#define DMAK(j, so) AT_GLDS(ksrc + (size_t)(j) * (64 * 768), kdst + (so))
#define DMAV(j, so) AT_GLDS(vsrc + (size_t)(j) * 64, vdst + (so))
    const LAS unsigned char* kp0 = lds + KOFF + (2 * hi) * 1024 + r32 * 16;
    const LAS unsigned char* kr0 = lds + KOFF + 4 * 1024 + r32 * 16;
    const LAS unsigned char* vp0 = lds + VOFF + (2 * hi) * 1024 + r32 * 16;
    if (kw) { DMAK(0, 0); DMAK(1, SLK); DMAK(2, 2 * SLK); }
    if (vw) { DMAV(0, 0); DMAV(1, SLV); }
    v8i qn, qr;
    { const unsigned char* Qw = Q8 + (rowb + qb * 256 + wid * 32 + r32) * 768 + h * 96; const u32x4 a = *(const u32x4*)(Qw + 32 * hi), c = *(const u32x4*)(Qw + 32 * hi + 16), e = *(const u32x4*)(Qw + 64), f = *(const u32x4*)(Qw + 80);
      qn = (v8i){(int)a.x, (int)a.y, (int)a.z, (int)a.w, (int)c.x, (int)c.y, (int)c.z, (int)c.w};
      qr = hi ? (v8i){0, 0, 0, 0, 0, 0, 0, 0} : (v8i){(int)e.x, (int)e.y, (int)e.z, (int)e.w, (int)f.x, (int)f.y, (int)f.z, (int)f.w}; }
    asm volatile("s_waitcnt vmcnt(0)\n\ts_barrier" ::: "memory");
    v8i kn0, kn1, kr0v, kr1v, vf0, vf1, p8;
#define LD32(dstv, p) do { const u32x4 a_ = *(const LAS u32x4*)(p), c_ = *(const LAS u32x4*)((p) + 1024); dstv = (v8i){(int)a_.x, (int)a_.y, (int)a_.z, (int)a_.w, (int)c_.x, (int)c_.y, (int)c_.z, (int)c_.w}; } while (0)
#define KLOAD8(so) do { LD32(kn0, kp0 + (so)); LD32(kn1, kp0 + (so) + 512); LD32(kr0v, kr0 + (so)); LD32(kr1v, kr0 + (so) + 512); } while (0)
#define VLOAD8(so) do { LD32(vf0, vp0 + (so)); LD32(vf1, vp0 + (so) + 512); } while (0)
    KLOAD8(0);
    asm volatile("s_waitcnt lgkmcnt(0)" ::: "memory");
    if (wid >= 4) AT_BAR();
    f32x16 o0 = {}, o1 = {}, o2 = {}, C0, C1; f32x16 zero;
#pragma unroll
    for (int r = 0; r < 16; ++r) zero[r] = PBYTE0;
    asm volatile("" : "+v"(zero));
    const v8i ones = {0x38383838, 0x38383838, 0x38383838, 0x38383838, 0x38383838, 0x38383838, 0x38383838, 0x38383838};
#define SOFTMAX8() do { \
        _Pragma("unroll") for (int i = 0; i < 4; ++i) { \
            const f32x2 a_ = (f32x2){C0[4 * i], C0[4 * i + 1]}, b_ = (f32x2){C0[4 * i + 2], C0[4 * i + 3]}, c_ = (f32x2){C1[4 * i], C1[4 * i + 1]}, d_ = (f32x2){C1[4 * i + 2], C1[4 * i + 3]}; \
            p8[i] = (int)__builtin_amdgcn_cvt_pk_u8_f32(b_[1], 3, __builtin_amdgcn_cvt_pk_u8_f32(b_[0], 2, __builtin_amdgcn_cvt_pk_u8_f32(a_[1], 1, __builtin_amdgcn_cvt_pk_u8_f32(a_[0], 0, 0u)))); \
            p8[4 + i] = (int)__builtin_amdgcn_cvt_pk_u8_f32(d_[1], 3, __builtin_amdgcn_cvt_pk_u8_f32(d_[0], 2, __builtin_amdgcn_cvt_pk_u8_f32(c_[1], 1, __builtin_amdgcn_cvt_pk_u8_f32(c_[0], 0, 0u)))); } } while (0)
    int ka = 2 * SLK, kb = 0, kc = SLK, va = 2 * SLV, vb = 0, vc = SLV;
#define ROT8() do { const int t_ = ka; ka = kb; kb = kc; kc = t_; const int u_ = va; va = vb; vb = vc; vc = u_; } while (0)
#define STEP8(sv, DOQK, DOPV, KL, VL, IK, IV) do { \
        AT_SCHED(); if (DOQK) { C0 = mfma8(kn0, qn, zero); C1 = mfma8(kn1, qn, zero); C0 = mfma8(kr0v, qr, C0); C1 = mfma8(kr1v, qr, C1); } if (DOPV) { o0 = mfma8pv(p8, vf0, o0); o1 = mfma8pv(p8, vf1, o1); o2 = mfma8pv(p8, ones, o2); } AT_SCHED(); \
        asm volatile("s_barrier\n\ts_nop 15\n\ts_nop 15" : "+v"(C0), "+v"(C1), "+v"(o0), "+v"(o1), "+v"(o2) :: "memory"); AT_SCHED(); \
        if (KL) KLOAD8(kc); if (VL) VLOAD8(vb); \
        const bool ik_ = kw && (IK), iv_ = vw && (IV); if (ik_) DMAK((sv) + 4, kb); if (iv_) DMAV((sv) + 3, va); \
        if (DOQK) { SOFTMAX8(); asm volatile("" :: "v"(p8)); } AT_SCHED(); \
        if (ik_ && iv_) { AT_WAITBAR(2); } else if (ik_ || iv_) { AT_WAITBAR(1); } else { AT_WAITBAR(0); } \
        AT_SCHED(); ROT8(); } while (0)
    STEP8(-1, true, false, true, true, true, true);
#pragma nounroll
    for (int s = 0; s < NT - 4; ++s) STEP8(s, true, true, true, true, true, true);
    STEP8(NT - 4, true, true, true, true, false, true);
    STEP8(NT - 3, true, true, true, true, false, false);
    STEP8(NT - 2, true, true, false, true, false, false);
    STEP8(NT - 1, false, true, false, false, false, false);
    if (wid < 4) AT_BAR();
    LAS bf16_t* stg = (LAS bf16_t*)(lds + OST + wid * 4096);
#pragma unroll
    for (int r = 0; r < 16; ++r) { const int orow = crow(r, hi); const float rl = __builtin_amdgcn_rcpf(o2[r]);
        stg[orow * 64 + r32] = (bf16_t)(cvtpk(o0[r] * rl, 0.f) & 0xffffu); stg[orow * 64 + 32 + r32] = (bf16_t)(cvtpk(o1[r] * rl, 0.f) & 0xffffu); }
    asm volatile("s_waitcnt lgkmcnt(0)" ::: "memory");
    bf16_t* Ow = O + (rowb + qb * 256 + wid * 32) * op + h * 64;
#pragma unroll
    for (int i = 0; i < 4; ++i) { const int row = i * 8 + (lane >> 3), ch = lane & 7; const u32x4 v = *(const LAS u32x4*)(stg + row * 64 + ch * 8); st16(Ow + (size_t)row * op + ch * 8, v); }
    asm volatile("s_waitcnt lgkmcnt(0)\n\ts_barrier" ::: "memory");
#undef DMAK
#undef DMAV
#undef LD32
#undef KLOAD8
#undef VLOAD8
#undef SOFTMAX8
#undef ROT8
#undef STEP8
}
__device__ __forceinline__ void attn_phase_f8b(int tid, LAS unsigned char* lds, const unsigned char* Q8, const unsigned char* K8, const unsigned char* VT8, bf16_t* O, int op, int vcu, int G) {
    int bh, qb;
    for (int i = 0; next_unit(i, vcu, G, bh, qb); ++i) attn_unit_f8b(tid, lds, Q8, K8, VT8, O, op, bh >> 3, bh & 7, qb);
}
#endif
template <int DQK>
__device__ __forceinline__ void attn_phase(int tid, LAS unsigned char* lds, const Tensors& A, int vcu, int G) {
#if FAST_ATTN
    int bh, qb;
    for (int i = 0; next_unit(i, vcu, G, bh, qb); ++i) attn_unit<DQK>(tid, lds, A, bh >> 3, bh & 7, qb);
#else
    (void)lds; attn_phase_ref<DQK>(tid, A, vcu, G);
#endif
}
}


struct Args { const float* in[22]; float* out; unsigned char* ws; int ph_lo, ph_hi; };
struct Frame {
    LAS unsigned char* lds; volatile LAS unsigned* MISC; unsigned* ctl;
    int tid, lane, wave, vcu, G;
    unsigned char* ws; float* OUT;
};

__device__ __forceinline__ void p0_phase(Frame& F, const float* c, const float* w_ada, const float* b_ada) {
    LAS float* cs = (LAS float*)F.lds;
    LAS float* red = (LAS float*)(F.lds + 32768);
    for (int i = F.tid; i < NB * D; i += NTHREADS) { const float v = c[i]; cs[i] = v / (1.f + __expf(-v)); }
    __syncthreads();
    float* mod = (float*)(F.ws + WS_MOD);
    const int kq = F.wave, col = F.lane;
    for (int item = F.vcu; item < NL * 6 * D / 64; item += F.G) {
        const int l = item / (6 * D / 64), n0 = (item % (6 * D / 64)) * 64;
        const float* w = w_ada + (size_t)l * D * 6 * D + n0 + col;
        float acc[NB];
#pragma unroll
        for (int b = 0; b < NB; ++b) acc[b] = 0.f;
#pragma unroll 8
        for (int k = kq * 128; k < kq * 128 + 128; ++k) { const float wv = w[(size_t)k * 6 * D];
#pragma unroll
            for (int b = 0; b < NB; ++b) acc[b] += cs[b * D + k] * wv; }
#pragma unroll
        for (int b = 0; b < NB; ++b) red[(kq * NB + b) * 64 + col] = acc[b];
        __syncthreads();
        { const int b = F.wave; float s = 0.f;
#pragma unroll
          for (int q = 0; q < 8; ++q) s += red[(q * NB + b) * 64 + col];
          mod[((size_t)l * NB + b) * 6 * D + n0 + col] = s + b_ada[(size_t)l * 6 * D + n0 + col]; }
        __syncthreads();
    }
    float* cosA = (float*)(F.ws + WS_COSA); float* sinA = (float*)(F.ws + WS_SINA); float* cosB = (float*)(F.ws + WS_COSB); float* sinB = (float*)(F.ws + WS_SINB);
    for (int idx = F.vcu * NTHREADS + F.tid; idx < S * 48; idx += F.G * NTHREADS) {
        const int s = idx / 48, i = idx % 48; const float row = (float)(s >> 6), col2 = (float)(s & 63);
        if (i < 32) { const int j = i & 15; const float a = (i < 16 ? row : col2) * (1.0f / powf(10000.0f, (float)j / 16.0f)); cosA[s * 32 + i] = cosf(a); sinA[s * 32 + i] = sinf(a); }
        else { const int ii = i - 32, j = ii & 7; const float a = (ii < 8 ? row : col2) * (1.0f / powf(10000.0f, (float)j / 8.0f)); cosB[s * 16 + ii] = cosf(a); sinB[s * 16 + ii] = sinf(a); }
    }
}

template <class SrcFn>
__device__ __forceinline__ void cvt_item(const float* W, int K, int Nsrc, const float* kg, bf16_t* WT, LAS float* scr, int item, int nblk, int lane, const SrcFn& src, float f8scale = 0.f) {
    const int kb = item / nblk, nb = item % nblk, k0 = 64 * kb, n0 = 32 * nb;
    const int sc = src(n0 + (lane & 31));
#pragma unroll
    for (int i = 0; i < 32; ++i) { const int kk = 2 * i + (lane >> 5); float v = sc >= 0 ? W[(size_t)(k0 + kk) * Nsrc + sc] : 0.f; if (kg) v *= kg[k0 + kk]; scr[kk * 33 + (lane & 31)] = v; }
    LDS_WAIT(); asm volatile("" ::: "memory");
    const int c = lane & 7;
    if (f8scale != 0.f) {
#pragma unroll
        for (int j = 0; j < 4; ++j) { const int n = (lane >> 3) + 8 * j; const LAS float* sp = scr + (8 * c) * 33 + n;
            const u32x2 o = pack8_fp8((f32x4){sp[0 * 33], sp[1 * 33], sp[2 * 33], sp[3 * 33]} * f8scale, (f32x4){sp[4 * 33], sp[5 * 33], sp[6 * 33], sp[7 * 33]} * f8scale);
            *(u32x2*)((unsigned char*)WT + (size_t)(n0 + n) * K + k0 + 8 * c) = o; }
    } else {
#pragma unroll
    for (int j = 0; j < 4; ++j) { const int n = (lane >> 3) + 8 * j; const LAS float* s = scr + (8 * c) * 33 + n;
        u32x4 o; o.x = cvt_pk_bf16(s[0 * 33], s[1 * 33]); o.y = cvt_pk_bf16(s[2 * 33], s[3 * 33]); o.z = cvt_pk_bf16(s[4 * 33], s[5 * 33]); o.w = cvt_pk_bf16(s[6 * 33], s[7 * 33]);
        *(u32x4*)(WT + (size_t)(n0 + n) * K + k0 + 8 * c) = o; }
    }
    LDS_WAIT(); asm volatile("" ::: "memory");
}
struct SrcId { __device__ int operator()(int n) const { return n; } };
struct SrcIn { __device__ int operator()(int n) const { return gp::src_col_in(n); } };
typedef __attribute__((address_space(4))) const Args CArgsW;
__device__ __forceinline__ void convert_weights(Frame& F, CArgsW* a, int l) {
    LAS float* scr = (LAS float*)(F.lds + F.wave * 16384);
    const int gw = F.vcu * NWAVES + F.wave, NGW = F.G * NWAVES;
    const float* w_in = ((const float*)(GAS const float*)a->in[5]) + (size_t)l * D * INC; const float* w_q_b = ((const float*)(GAS const float*)a->in[10]) + (size_t)l * 384 * 768; const float* w_kv_b = ((const float*)(GAS const float*)a->in[11]) + (size_t)l * 256 * 1024;
    const float* w_pa = ((const float*)(GAS const float*)a->in[12]) + (size_t)l * 512 * D; const float* w_pb = ((const float*)(GAS const float*)a->in[13]) + (size_t)l * 512 * D; const float* w_o = ((const float*)(GAS const float*)a->in[14]) + (size_t)l * D * D;
    const float* w1 = ((const float*)(GAS const float*)a->in[18]) + (size_t)l * NE * D * FF; const float* w3 = ((const float*)(GAS const float*)a->in[19]) + (size_t)l * NE * D * FF; const float* w2 = ((const float*)(GAS const float*)a->in[20]) + (size_t)l * NE * FF * D;
    const float* gqa = ((const float*)(GAS const float*)a->in[8]) + l * 384; const float* gkv = ((const float*)(GAS const float*)a->in[9]) + l * 256;
    bf16_t* Win = (bf16_t*)(F.ws + WS_WIN); bf16_t* Wqb = (bf16_t*)(F.ws + WS_WQB); bf16_t* Wkvb = (bf16_t*)(F.ws + WS_WKVB); bf16_t* Wpa = (bf16_t*)(F.ws + WS_WPA); bf16_t* Wpb = (bf16_t*)(F.ws + WS_WPB);
    bf16_t* Wo = (bf16_t*)(F.ws + WS_WO); bf16_t* W13 = (bf16_t*)(F.ws + WS_W13); bf16_t* W2 = (bf16_t*)(F.ws + WS_W2);
    constexpr int I_IN = (D / 64) * (NIN / 32), I_QB = (384 / 64) * (768 / 32), I_KVB = (256 / 64) * (1024 / 32), I_P = (512 / 64) * (D / 32), I_O = (D / 64) * (D / 32);
    constexpr int I_13 = (D / 64) * (1024 / 32), I_2 = (FF / 64) * (D / 32);
    constexpr int NITEMS = I_IN + I_QB + I_KVB + 2 * I_P + I_O + NE * (I_13 + I_2);
    for (int it = gw; it < NITEMS; it += NGW) {
        int r = it;
        if (r < I_IN) { cvt_item(w_in, D, INC, nullptr, Win, scr, r, NIN / 32, F.lane, SrcIn(), G1_FP8 ? 16.f : 0.f); continue; } r -= I_IN;
        if (r < I_QB) { cvt_item(w_q_b, 384, 768, gqa, Wqb, scr, r, 768 / 32, F.lane, SrcId()); continue; } r -= I_QB;
        if (r < I_KVB) { cvt_item(w_kv_b, 256, 1024, gkv, Wkvb, scr, r, 1024 / 32, F.lane, SrcId()); continue; } r -= I_KVB;
        if (r < I_P) { cvt_item(w_pa, 512, D, nullptr, Wpa, scr, r, D / 32, F.lane, SrcId()); continue; } r -= I_P;
        if (r < I_P) { cvt_item(w_pb, 512, D, nullptr, Wpb, scr, r, D / 32, F.lane, SrcId()); continue; } r -= I_P;
        if (r < I_O) { cvt_item(w_o, D, D, nullptr, Wo, scr, r, D / 32, F.lane, SrcId()); continue; } r -= I_O;
        if (r < NE * I_13) { const int e = r / I_13, q = r % I_13, nb = q % 32;
            const float* src = ((nb & 7) < 4 ? w1 : w3) + (size_t)e * D * FF; const int cb = (nb >> 3) * 128 + (nb & 3) * 32;
            struct SrcOff { int n0, cb; __device__ int operator()(int n) const { return cb + (n - n0); } } so{nb * 32, cb};
            if (MOE_FP8) cvt_item(src, D, FF, nullptr, (bf16_t*)((unsigned char*)W13 + (size_t)e * 1024 * D), scr, q, 32, F.lane, so, 16.f);
            else cvt_item(src, D, FF, nullptr, W13 + (size_t)e * 1024 * D, scr, q, 32, F.lane, so);
            continue; } r -= NE * I_13;
        { const int e = r / I_2, q = r % I_2;
          if (MOE_FP8) cvt_item(w2 + (size_t)e * FF * D, FF, D, nullptr, (bf16_t*)((unsigned char*)W2 + (size_t)e * D * FF), scr, q, D / 32, F.lane, SrcId(), 16.f);
          else cvt_item(w2 + (size_t)e * FF * D, FF, D, nullptr, W2 + (size_t)e * D * FF, scr, q, D / 32, F.lane, SrcId()); }
    }
}

template <int MODE>
__device__ __forceinline__ void row_phase(Frame& F, const float* xin, const float* g2prev, const float* gain, const float* modl, int sh_off, int sc_off, bf16_t* H, bf16_t* XB, float* OUT) {
    constexpr int RB = 4, RPW = T / (256 * NWAVES);
    const int gw = F.vcu * NWAVES + F.wave, b = (gw * RPW) >> 12;
    const bf16_t* Y2 = (const bf16_t*)(F.ws + WS_Y2);
    f32x4 gs[4], shv[4], g2v[4];
#pragma unroll
    for (int j = 0; j < 4; ++j) { const int c = 4 * F.lane + 256 * j; gs[j] = *(const f32x4*)(gain + c);
        if (MODE != 2) { gs[j] = gs[j] * (1.f + *(const f32x4*)(modl + (size_t)b * 6 * D + sc_off + c)); shv[j] = *(const f32x4*)(modl + (size_t)b * 6 * D + sh_off + c); }
        if (MODE != 0) g2v[j] = *(const f32x4*)(g2prev + (size_t)b * 6 * D + 5 * D + c); }
    for (int m0 = gw * RPW; m0 < gw * RPW + RPW; m0 += RB) {
        f32x4 v[RB][4]; float ss[RB];
        if (MODE == 0) {
#pragma unroll
            for (int r = 0; r < RB; ++r)
#pragma unroll
                for (int j = 0; j < 4; ++j) v[r][j] = *(const f32x4*)(xin + (size_t)(m0 + r) * D + 4 * F.lane + 256 * j);
        } else {
            unsigned ya[RB][4], yb[RB][4];
#pragma unroll
            for (int r = 0; r < RB; ++r)
#pragma unroll
                for (int j = 0; j < 4; ++j) { const int m = m0 + r, c = 4 * F.lane + 256 * j;
                    { const u32x2 xb = *(const u32x2*)(XB + (size_t)m * D + c); v[r][j] = (f32x4){bf2f(xb.x & 0xffffu), bf2f(xb.x >> 16), bf2f(xb.y & 0xffffu), bf2f(xb.y >> 16)}; }
                    ya[r][j] = *(const unsigned*)((const unsigned char*)Y2 + (size_t)(2 * m) * D + c); yb[r][j] = *(const unsigned*)((const unsigned char*)Y2 + (size_t)(2 * m + 1) * D + c); }
#pragma unroll
            for (int r = 0; r < RB; ++r)
#pragma unroll
                for (int j = 0; j < 4; ++j) { const f32x2 a0 = __builtin_amdgcn_cvt_pk_f32_fp8((int)ya[r][j], false), a1 = __builtin_amdgcn_cvt_pk_f32_fp8((int)ya[r][j], true), b0 = __builtin_amdgcn_cvt_pk_f32_fp8((int)yb[r][j], false), b1 = __builtin_amdgcn_cvt_pk_f32_fp8((int)yb[r][j], true);
                    const f32x4 y = (f32x4){a0[0] + b0[0], a0[1] + b0[1], a1[0] + b1[0], a1[1] + b1[1]} * 0.0625f;
                    v[r][j] += g2v[j] * y; }
        }
#pragma unroll
        for (int r = 0; r < RB; ++r) { ss[r] = (gp::dot4(v[r][0]) + gp::dot4(v[r][1])) + (gp::dot4(v[r][2]) + gp::dot4(v[r][3])); }
#pragma unroll
        for (int o = 1; o < 64; o <<= 1)
#pragma unroll
            for (int r = 0; r < RB; ++r) ss[r] += __shfl_xor(ss[r], o);
#pragma unroll
        for (int r = 0; r < RB; ++r) {
            const int m = m0 + r; const float rstd = rsqrtf(ss[r] * (1.f / D) + EPS);
#pragma unroll
            for (int j = 0; j < 4; ++j) {
                const int c = 4 * F.lane + 256 * j;
                if (MODE == 2) { *(f32x4*)(OUT + (size_t)m * D + c) = v[r][j] * rstd * gs[j]; }
                else {
                    { u32x2 xw; xw.x = cvt_pk_bf16(v[r][j][0], v[r][j][1]); xw.y = cvt_pk_bf16(v[r][j][2], v[r][j][3]); st8((XB + (size_t)m * D + c), xw); }
                    const f32x4 hv = v[r][j] * rstd * gs[j] + shv[j];
                    if (G1_FP8) { const f32x4 hq = hv * 0.0625f;
                        *(unsigned*)((unsigned char*)H + (size_t)m * D + c) = (unsigned)__builtin_amdgcn_cvt_pk_fp8_f32(hq[2], hq[3], __builtin_amdgcn_cvt_pk_fp8_f32(hq[0], hq[1], 0, false), true); }
                    else { u32x2 w; w.x = cvt_pk_bf16(hv[0], hv[1]); w.y = cvt_pk_bf16(hv[2], hv[3]);
                    st8((H + (size_t)m * D + c), w); }
                }
            }
        }
    }
}

__device__ __forceinline__ void t2_phase(Frame& F, const float* gain, const float* modl, const float* w_router, const float* rbias, int l, bool record) {
    LAS f32x4* wl = (LAS f32x4*)F.lds;
    LAS int* rec = (LAS int*)(F.lds + 65536);
    LAS float* recw = (LAS float*)(F.lds + 65536 + 2048);
    LAS int* lcnt = (LAS int*)(F.lds + 65536 + 4096);
    for (int idx = F.tid; idx < 4096; idx += NTHREADS) {
        const int lane = idx & 63, c = (idx >> 6) & 3, i = (idx >> 8) & 3, j = idx >> 10; const int k = 4 * lane + 256 * j + i;
        wl[idx] = *(const f32x4*)(w_router + (size_t)k * NE + 4 * c);
    }
    if (F.tid < 32) lcnt[F.tid] = 0;
    __syncthreads();
    constexpr int RB = 4, RPW = T / (256 * NWAVES);
    const int gw = F.vcu * NWAVES + F.wave, bt = (gw * RPW) >> 12;
    bf16_t* H = (bf16_t*)(F.ws + WS_H); const bf16_t* XB = (const bf16_t*)(F.ws + WS_XB);
    const int lane = F.lane, myrow = lane >> 4, mye = lane & 15;
    f32x4 gs[4], shv[4];
#pragma unroll
    for (int j = 0; j < 4; ++j) { const int c = 4 * lane + 256 * j; gs[j] = *(const f32x4*)(gain + c) * (1.f + *(const f32x4*)(modl + (size_t)bt * 6 * D + 4 * D + c)); shv[j] = *(const f32x4*)(modl + (size_t)bt * 6 * D + 3 * D + c); }
    int it = 0;
    for (int m0 = gw * RPW; m0 < gw * RPW + RPW; m0 += RB, ++it) {
        f32x4 v[RB][4]; float ss[RB];
#pragma unroll
        for (int r = 0; r < RB; ++r)
#pragma unroll
            for (int j = 0; j < 4; ++j) { const u32x2 xb = *(const u32x2*)(XB + (size_t)(m0 + r) * D + 4 * lane + 256 * j); v[r][j] = (f32x4){bf2f(xb.x & 0xffffu), bf2f(xb.x >> 16), bf2f(xb.y & 0xffffu), bf2f(xb.y >> 16)}; }
#pragma unroll
        for (int r = 0; r < RB; ++r) ss[r] = (gp::dot4(v[r][0]) + gp::dot4(v[r][1])) + (gp::dot4(v[r][2]) + gp::dot4(v[r][3]));
#pragma unroll
        for (int o = 1; o < 64; o <<= 1)
#pragma unroll
            for (int r = 0; r < RB; ++r) ss[r] += __shfl_xor(ss[r], o);
        float acc[RB * NE];
#pragma unroll
        for (int q = 0; q < RB * NE; ++q) acc[q] = 0.f;
#pragma unroll
        for (int j = 0; j < 4; ++j) {
            const int c = 4 * lane + 256 * j;
#pragma unroll
            for (int r = 0; r < RB; ++r) {
                const int m = m0 + r; const float rstd = rsqrtf(ss[r] * (1.f / D) + EPS);
                v[r][j] = v[r][j] * rstd * gs[j] + shv[j];
#if MOE_FP8
                *(unsigned*)((unsigned char*)H + (size_t)m * D + c) = (unsigned)__builtin_amdgcn_cvt_pk_fp8_f32(v[r][j][2], v[r][j][3], __builtin_amdgcn_cvt_pk_fp8_f32(v[r][j][0], v[r][j][1], 0, false), true);
#else
                u32x2 w; w.x = cvt_pk_bf16(v[r][j][0], v[r][j][1]); w.y = cvt_pk_bf16(v[r][j][2], v[r][j][3]);
                st8((H + (size_t)m * D + c), w);
#endif
            }
#pragma unroll
            for (int i = 0; i < 4; ++i)
#pragma unroll
                for (int c4 = 0; c4 < 4; ++c4) { const f32x4 wv = wl[((j * 4 + i) * 4 + c4) * 64 + lane];
#pragma unroll
                    for (int r = 0; r < RB; ++r) { const float hv = v[r][j][i];
                        acc[r * NE + 4 * c4 + 0] += hv * wv[0]; acc[r * NE + 4 * c4 + 1] += hv * wv[1]; acc[r * NE + 4 * c4 + 2] += hv * wv[2]; acc[r * NE + 4 * c4 + 3] += hv * wv[3]; } }
        }
#pragma unroll
        for (int sft = 32; sft >= 1; sft >>= 1) {
            const bool up = (lane & sft) != 0;
#pragma unroll
            for (int k = 0; k < sft; ++k) { const float a = acc[k], b = acc[k + sft]; const float keep = up ? b : a, send = up ? a : b; acc[k] = keep + __shfl_xor(send, sft); }
        }
        const float logit = acc[0];
        const float score = 1.f / (1.f + expf(-logit));
        float scv[NE], bi[NE];
#pragma unroll
        for (int e = 0; e < NE; ++e) { scv[e] = __shfl(score, (lane & 48) | e); bi[e] = scv[e] + rbias[e]; }
        int gsel = 0; float gbest = -INFINITY;
#pragma unroll
        for (int g = 0; g < 4; ++g) { float m1 = -INFINITY, m2 = -INFINITY;
#pragma unroll
            for (int j = 0; j < 4; ++j) { const float x = bi[g * 4 + j]; if (x > m1) { m2 = m1; m1 = x; } else if (x > m2) m2 = x; }
            const float gs = m1 + m2; if (gs > gbest) { gbest = gs; gsel = g; } }
        int e1 = -1, e2 = -1; float b1 = -INFINITY, b2 = -INFINITY, s1 = 0.f, s2 = 0.f;
#pragma unroll
        for (int j = 0; j < 4; ++j) { float x = -INFINITY, sx = 0.f;
#pragma unroll
            for (int g = 0; g < 4; ++g) if (g == gsel) { x = bi[g * 4 + j]; sx = scv[g * 4 + j]; }
            const int e = gsel * 4 + j;
            if (x > b1) { b2 = b1; e2 = e1; s2 = s1; b1 = x; e1 = e; s1 = sx; } else if (x > b2) { b2 = x; e2 = e; s2 = sx; } }
        if (mye == 0) {
            const float inv = 1.f / (s1 + s2); const int slot = (it * RB + myrow) * NWAVES + F.wave;
            rec[slot * 4 + 0] = e1; rec[slot * 4 + 1] = e2;
            rec[slot * 4 + 2] = __hip_atomic_fetch_add(&lcnt[e1], 1, __ATOMIC_RELAXED, __HIP_MEMORY_SCOPE_WORKGROUP);
            rec[slot * 4 + 3] = __hip_atomic_fetch_add(&lcnt[e2], 1, __ATOMIC_RELAXED, __HIP_MEMORY_SCOPE_WORKGROUP);
            recw[slot * 2 + 0] = s1 * inv; recw[slot * 2 + 1] = s2 * inv;
        }
    }
    __syncthreads();
    if (!record) return;
    if (F.tid < NE) lcnt[16 + F.tid] = (int)__hip_atomic_fetch_add(F.ctl + CW_CNT + (l * NE + F.tid) * 64, (unsigned)lcnt[F.tid], __ATOMIC_RELAXED, __HIP_MEMORY_SCOPE_AGENT);
    __syncthreads();
    unsigned* list = (unsigned*)(F.ws + WS_LIST); float* gwb = (float*)(F.ws + WS_GW);
    const int nrows = it * RB;
    for (int s = F.tid; s < nrows * NWAVES; s += NTHREADS) {
        const int i2 = s / NWAVES, w = s % NWAVES; const int m = (F.vcu * NWAVES + w) * RPW + i2;
        const int e1 = rec[s * 4 + 0], e2 = rec[s * 4 + 1];
        list[(size_t)e1 * T + lcnt[16 + e1] + rec[s * 4 + 2]] = (unsigned)(2 * m); list[(size_t)e2 * T + lcnt[16 + e2] + rec[s * 4 + 3]] = (unsigned)(2 * m + 1);
        gwb[2 * m] = recw[s * 2]; gwb[2 * m + 1] = recw[s * 2 + 1];
    }
}
__device__ __forceinline__ LAS int* moe_table(Frame& F, int l) {
    LAS int* tab = (LAS int*)(F.lds + MISC_OFF + 1024);
    __syncthreads();
    if (F.tid == 0) { int acc = 0;
        for (int e = 0; e < NE; ++e) { const int c = (int)__hip_atomic_load(F.ctl + CW_CNT + (l * NE + e) * 64, __ATOMIC_RELAXED, __HIP_MEMORY_SCOPE_AGENT); tab[e] = acc; tab[32 + e] = c; acc += (c + 255) >> 8; }
        tab[16] = acc; }
    __syncthreads();
    return tab;
}

typedef __attribute__((address_space(4))) const Args CArgs;
#define LAUNDER_GP(T_, p) do { GAS T_* _t = (GAS T_*)(p); asm volatile("" : "+s"(_t)); (p) = (T_*)_t; } while (0)
#define PH_BEGIN() LAUNDER_V(F.tid); F.lane = F.tid & 63; LAUNDER_GP(unsigned, F.ctl); LAUNDER_GP(float, F.OUT); LAUNDER_GP(unsigned char, F.ws); GAS unsigned char* ws = (GAS unsigned char*)F.ws; CArgs* ka = (CArgs*)__builtin_amdgcn_kernarg_segment_ptr(); LAUNDER_S(ka); \
    float* mod = WSP(float, WS_MOD); (void)mod; (void)ka
#define WSP(T_, off) ((T_*)(GAS T_*)(ws + (off)))
#define KIN(i) ((const float*)(GAS const float*)ka->in[i])
__global__ void __launch_bounds__(NTHREADS, 2) fwd_kernel(Args args) {
    extern __shared__ __attribute__((aligned(16))) unsigned char lds_raw[];
    Frame F;
    F.lds = (LAS unsigned char*)lds_raw; F.MISC = (volatile LAS unsigned*)(F.lds + MISC_OFF);
    F.tid = threadIdx.x; F.lane = F.tid & 63; F.wave = __builtin_amdgcn_readfirstlane(F.tid >> 6);
    F.G = gridDim.x; { const int bx = blockIdx.x; F.vcu = (F.G % 8 == 0) ? (bx % 8) * (F.G / 8) + bx / 8 : bx; }
    F.ws = (unsigned char*)(GAS unsigned char*)args.ws; F.ctl = (unsigned*)(GAS unsigned*)(args.ws + WS_CTL); F.OUT = (float*)(GAS float*)args.out;
    if (F.tid < 64) F.MISC[F.tid] = 0u;
    __syncthreads();
    XcdBarrier bar; bar.bar = F.ctl + CW_BAR; bar.x = 0; bar.st = nullptr;
    if (!N_LAUNCH_MODE) bar = xcd_barrier_post(F.ctl + CW_BAR, F.MISC + 8);
    const int lo = args.ph_lo, hi = args.ph_hi;
#define IN(k) (lo <= (k) && (k) < hi)
#define SEAM(k) do { if ((k) + 1 < hi) { if (!N_LAUNCH_MODE) xcd_barrier(bar); } } while (0)
    const int cidx = (int)blockIdx.x;

    if (IN(0)) { PH_BEGIN(); p0_phase(F, KIN(1), KIN(2), KIN(3)); __syncthreads(); LAUNDER_V(F.tid); F.lane = F.tid & 63; convert_weights(F, ka, 0); SEAM(0); }
    for (int l = 0; l < NL; ++l) {
        const int pb = 1 + 9 * l;
        if (IN(pb + 0)) {
            PH_BEGIN();
            if (l > 0) for (int rep = 0; rep < ((PROBE_DUP & 8) ? 2 : 1); ++rep) { LAUNDER_V(F.tid); F.lane = F.tid & 63; convert_weights(F, ka, l); }
            if (l == 0) row_phase<0>(F, KIN(0), nullptr, KIN(4) + l * D, mod + (size_t)l * NB * 6 * D, 0, D, WSP(bf16_t, WS_H), WSP(bf16_t, WS_XB), nullptr);
            else row_phase<1>(F, nullptr, mod + (size_t)(l - 1) * NB * 6 * D, KIN(4) + l * D, mod + (size_t)l * NB * 6 * D, 0, D, WSP(bf16_t, WS_H), WSP(bf16_t, WS_XB), nullptr);
            SEAM(pb + 0);
        }
        if (IN(pb + 1)) {
            PH_BEGIN();
            gp::Gemm g{WSP(bf16_t, WS_H), WSP(const bf16_t, WS_WIN), G1_FP8 ? D / 2 : D, 0, nullptr, 0, 0, 0}; gp::DenseOrder So; So.init(T, NIN, F.G, cidx);
            gp::EpiIn E{WSP(bf16_t, ATT_FP8_A ? WS_QA8 : WS_QA), WSP(bf16_t, ATT_FP8_A ? WS_KA8 : WS_KA), WSP(bf16_t, ATT_FP8_A ? WS_VTA8 : WS_VA), WSP(bf16_t, WS_QLAT), WSP(bf16_t, WS_KVLAT), WSP(bf16_t, ATT_FP8_B ? WS_KB8 : WS_KB), WSP(bf16_t, WS_SA), WSP(bf16_t, WS_SB), WSP(float, WS_SSQ), WSP(float, WS_SSKV),
                        KIN(6) + l * 64, KIN(7) + l * 64, WSP(const float, WS_COSA), WSP(const float, WS_SINA), WSP(const float, WS_COSB), WSP(const float, WS_SINB)};
            if (PROBE_DUP & 128) { gp::EpiNull En; gp::gemm_phase<gp::EpiNull, gp::DenseOrder>(F.tid, F.lds, g, So, En); LAUNDER_V(F.tid); }
            gp::gemm_phase<gp::EpiIn, gp::DenseOrder, false, G1_FP8 != 0>(F.tid, F.lds, g, So, E); if (PROBE_DUP & (2 | 512)) { LAUNDER_V(F.tid); gp::gemm_phase<gp::EpiIn, gp::DenseOrder, false, G1_FP8 != 0>(F.tid, F.lds, g, So, E); }
            SEAM(pb + 1);
        }
        if (IN(pb + 2)) {
            { PH_BEGIN(); gp::Gemm g{WSP(bf16_t, WS_QLAT), WSP(const bf16_t, WS_WQB), 384, 0, nullptr}; gp::DenseOrder So; So.init(T, 768, F.G, cidx);
              gp::EpiQb E{WSP(bf16_t, ATT_FP8_B ? WS_QB8 : WS_QB), WSP(const float, WS_SSQ), WSP(const float, WS_COSB), WSP(const float, WS_SINB)}; gp::gemm_phase<gp::EpiQb, gp::DenseOrder>(F.tid, F.lds, g, So, E); if (PROBE_DUP & 2) { LAUNDER_V(F.tid); gp::gemm_phase<gp::EpiQb, gp::DenseOrder>(F.tid, F.lds, g, So, E); } }
            { PH_BEGIN(); gp::Gemm g{WSP(bf16_t, WS_KVLAT), WSP(const bf16_t, WS_WKVB), 256, 0, nullptr}; gp::DenseOrder So; So.init(T, 1024, F.G, F.G - 1 - cidx);
              gp::EpiKvb E{WSP(bf16_t, ATT_FP8_B ? WS_KB8 : WS_KB), WSP(bf16_t, ATT_FP8_B ? WS_VTB8 : WS_VB), WSP(const float, WS_SSKV)}; gp::gemm_phase<gp::EpiKvb, gp::DenseOrder>(F.tid, F.lds, g, So, E); if (PROBE_DUP & 2) { LAUNDER_V(F.tid); gp::gemm_phase<gp::EpiKvb, gp::DenseOrder>(F.tid, F.lds, g, So, E); } }
#if FAST_ATTN && ATT_FP8_A
            { PH_BEGIN(); at::attn_phase_f8a(F.tid, F.lds, WSP(const unsigned char, WS_QA8), WSP(const unsigned char, WS_KA8), WSP(const unsigned char, WS_VTA8), WSP(bf16_t, WS_QA), 512, KIN(6) + l * 64, KIN(7) + l * 64, F.vcu, F.G); }
            if (PROBE_DUP & 1) { PH_BEGIN(); at::attn_phase_f8a(F.tid, F.lds, WSP(const unsigned char, WS_QA8), WSP(const unsigned char, WS_KA8), WSP(const unsigned char, WS_VTA8), WSP(bf16_t, WS_QA), 512, KIN(6) + l * 64, KIN(7) + l * 64, F.vcu, F.G); }
#else
            { PH_BEGIN(); const at::Tensors A{WSP(bf16_t, WS_QA), 512, WSP(bf16_t, WS_KA), 128, WSP(bf16_t, WS_VA), 128, WSP(bf16_t, WS_QA), 512, 4}; at::attn_phase<64>(F.tid, F.lds, A, F.vcu, F.G); }
#endif
            SEAM(pb + 2);
        }
        if (IN(pb + 3)) {
            PH_BEGIN();
#if FAST_ATTN && ATT_FP8_B
            at::attn_phase_f8b(F.tid, F.lds, WSP(const unsigned char, WS_QB8), WSP(const unsigned char, WS_KB8), WSP(const unsigned char, WS_VTB8), WSP(bf16_t, WS_OB), 512, F.vcu, F.G);
            if (PROBE_DUP & 1) { LAUNDER_V(F.tid); at::attn_phase_f8b(F.tid, F.lds, WSP(const unsigned char, WS_QB8), WSP(const unsigned char, WS_KB8), WSP(const unsigned char, WS_VTB8), WSP(bf16_t, WS_OB), 512, F.vcu, F.G); }
#else
            const at::Tensors A{WSP(bf16_t, WS_QB), 768, WSP(bf16_t, WS_KB), 768, WSP(bf16_t, WS_VB), 512, WSP(bf16_t, WS_OB), 512, 1}; for (int rep = 0; rep < ((PROBE_DUP & 1) ? 2 : 1); ++rep) at::attn_phase<96>(F.tid, F.lds, A, F.vcu, F.G);
#endif
            SEAM(pb + 3);
        }
        if (IN(pb + 4)) {
            PH_BEGIN();
            gp::Gemm g{WSP(bf16_t, WS_QA), WSP(const bf16_t, WS_WPA), 512, (size_t)(WS_WPB - WS_WPA) / 2, nullptr, (size_t)(WS_OB - WS_QA) / 2}; gp::PairOrder So; So.init(T, D, F.G, cidx);
            gp::EpiProjP E{WSP(bf16_t, WS_H), WSP(const unsigned char, WS_SA), WSP(const unsigned char, WS_SB)};
            gp::gemm_phase<gp::EpiProjP, gp::PairOrder>(F.tid, F.lds, g, So, E);
            if (PROBE_DUP & (2 | 1024)) { LAUNDER_V(F.tid); gp::gemm_phase<gp::EpiProjP, gp::PairOrder>(F.tid, F.lds, g, So, E); }
            SEAM(pb + 4);
        }
        if (IN(pb + 5)) {
            PH_BEGIN();
            gp::Gemm g{WSP(bf16_t, WS_H), WSP(const bf16_t, WS_WO), D, 0, nullptr}; gp::DenseOrder So; So.init(T, D, F.G, cidx);
            if (PROBE_DUP & 2048) { gp::EpiNull En; gp::gemm_phase<gp::EpiNull, gp::DenseOrder>(F.tid, F.lds, g, So, En); LAUNDER_V(F.tid); }
            gp::EpiWo E{WSP(const bf16_t, WS_XB), mod + (size_t)l * NB * 6 * D, WSP(bf16_t, WS_XB)}; gp::gemm_phase<gp::EpiWo, gp::DenseOrder>(F.tid, F.lds, g, So, E);
            SEAM(pb + 5);
        }
        if (IN(pb + 6)) {
            PH_BEGIN();
            if (PROBE_DUP & 16) { t2_phase(F, KIN(15) + l * D, mod + (size_t)l * NB * 6 * D, KIN(16), KIN(17), l, false); LAUNDER_V(F.tid); F.lane = F.tid & 63; __syncthreads(); }
            t2_phase(F, KIN(15) + l * D, mod + (size_t)l * NB * 6 * D, KIN(16), KIN(17), l, true);
            SEAM(pb + 6);
        }
        if (IN(pb + 7)) {
            PH_BEGIN();
            LAS int* tab = moe_table(F, l);
#if MOE_FP8
            gp::Gemm g{WSP(bf16_t, WS_H), WSP(const bf16_t, WS_W13), D / 2, (size_t)1024 * D / 2, WSP(const unsigned, WS_LIST), 0, 0, 0}; gp::MoeOrder So; So.init(tab, F.G, cidx);
            gp::EpiUp E{WSP(bf16_t, WS_ACT), 1.f / 16.f}; gp::gemm_phase<gp::EpiUp, gp::MoeOrder, true, true>(F.tid, F.lds, g, So, E);
            if (PROBE_DUP & 4) { LAUNDER_V(F.tid); gp::gemm_phase<gp::EpiUp, gp::MoeOrder, true, true>(F.tid, F.lds, g, So, E); }
#else
            gp::Gemm g{WSP(bf16_t, WS_H), WSP(const bf16_t, WS_W13), D, (size_t)1024 * D, WSP(const unsigned, WS_LIST)}; gp::MoeOrder So; So.init(tab, F.G, cidx);
            gp::EpiUp E{WSP(bf16_t, WS_ACT), 1.f}; gp::gemm_phase<gp::EpiUp, gp::MoeOrder, true>(F.tid, F.lds, g, So, E);
#endif
            SEAM(pb + 7);
        }
        if (IN(pb + 8)) {
            PH_BEGIN();
            LAS int* tab = moe_table(F, l);
#if MOE_FP8
            gp::Gemm g{WSP(bf16_t, WS_ACT), WSP(const bf16_t, WS_W2), FF / 2, (size_t)D * FF / 2, nullptr, 0, 0, 0}; gp::MoeOrder So; So.init(tab, F.G, cidx);
            gp::EpiDown E{WSP(bf16_t, WS_Y2), WSP(const unsigned, WS_LIST), WSP(const float, WS_GW), 1.f / 128.f}; gp::gemm_phase<gp::EpiDown, gp::MoeOrder, false, true>(F.tid, F.lds, g, So, E);
            if (PROBE_DUP & 4) { LAUNDER_V(F.tid); gp::gemm_phase<gp::EpiDown, gp::MoeOrder, false, true>(F.tid, F.lds, g, So, E); }
#else
            gp::Gemm g{WSP(bf16_t, WS_ACT), WSP(const bf16_t, WS_W2), FF, (size_t)D * FF, nullptr}; gp::MoeOrder So; So.init(tab, F.G, cidx);
            gp::EpiDown E{WSP(bf16_t, WS_Y2), WSP(const unsigned, WS_LIST), WSP(const float, WS_GW), 1.f}; gp::gemm_phase<gp::EpiDown, gp::MoeOrder, false>(F.tid, F.lds, g, So, E);
#endif
            SEAM(pb + 8);
        }
    }
    if (IN(NPHASE - 1)) { PH_BEGIN(); row_phase<2>(F, nullptr, mod + (size_t)(NL - 1) * NB * 6 * D, KIN(21), nullptr, 0, 0, nullptr, WSP(bf16_t, WS_XB), F.OUT); }
#undef IN
#undef SEAM
}

extern "C" void kernel_launch(void* const* d_in, const int* in_sizes, int n_in, void* d_out, int out_size, void* d_ws, size_t ws_size, hipStream_t stream) {
    static int grid = 0;
    if (grid == 0) {
        if (n_in != 22 || out_size != T * D || ws_size < WS_END) { fprintf(stderr, "kernel_launch: unexpected problem (n_in %d out %d ws %zu)\n", n_in, out_size, ws_size); grid = -1; return; }
        int dev = 0, cus = 0, per_cu = 0;
        if (hipGetDevice(&dev) != hipSuccess || hipDeviceGetAttribute(&cus, hipDeviceAttributeMultiprocessorCount, dev) != hipSuccess) { grid = -1; return; }
        if (hipFuncSetAttribute((const void*)fwd_kernel, hipFuncAttributeMaxDynamicSharedMemorySize, LDS_BYTES) != hipSuccess) { grid = -1; return; }
        if (hipOccupancyMaxActiveBlocksPerMultiprocessor(&per_cu, (const void*)fwd_kernel, NTHREADS, LDS_BYTES) != hipSuccess || per_cu < 1) { fprintf(stderr, "kernel_launch: occupancy query says %d\n", per_cu); }
        (void)hipGetLastError();
        grid = cus;
        if (grid != 256 || T % (grid * NWAVES * 4) != 0) {   fprintf(stderr, "kernel_launch: grid %d does not divide the row phases\n", grid); grid = -1; return; }
    }
    if (grid < 0) return;
    (void)hipMemsetAsync((char*)d_ws + WS_CTL, 0, CTL_BYTES, stream);
    Args a{};
    for (int i = 0; i < 22; ++i) a.in[i] = (const float*)d_in[i];
    a.out = (float*)d_out; a.ws = (unsigned char*)d_ws;
#if N_LAUNCH_MODE
    for (int p = 0; p < NPHASE; ++p) { a.ph_lo = p; a.ph_hi = p + 1; hipLaunchKernelGGL(fwd_kernel, dim3(grid), dim3(NTHREADS), LDS_BYTES, stream, a); }
#else
    a.ph_lo = 0; a.ph_hi = NPHASE;
    hipLaunchKernelGGL(fwd_kernel, dim3(grid), dim3(NTHREADS), LDS_BYTES, stream, a);
#endif
}
```

```cpp
#include <hip/hip_runtime.h>
#include <stdint.h>
#include <stdio.h>
#include <math.h>

#ifndef FAST_GEMM
#define FAST_GEMM 1
#endif
#ifndef FAST_ATTN
#define FAST_ATTN 1
#endif
#ifndef PROBE_DUP
#define PROBE_DUP 0
#endif
#ifndef PROBE_ATT
#define PROBE_ATT 0
#endif
#ifndef ATT_REGSTAGE
#define ATT_REGSTAGE 0
#endif
#ifndef WT_STORES
#define WT_STORES 0
#endif
#ifndef ATT_FP8_A
#define ATT_FP8_A 1
#endif
#ifndef ATT_FP8_B
#define ATT_FP8_B 1
#endif
#ifndef MOE_FP8
#define MOE_FP8 1
#endif
#ifndef G1_FP8
#define G1_FP8 1
#endif
#ifndef PROJ_FP8
#define PROJ_FP8 1
#endif
#ifndef N_LAUNCH_MODE
#define N_LAUNCH_MODE 0
#endif

#define LAS __attribute__((address_space(3)))
#define GAS __attribute__((address_space(1)))
typedef unsigned short bf16_t;
typedef short bf16x8 __attribute__((ext_vector_type(8)));
typedef float f32x4 __attribute__((ext_vector_type(4)));
typedef float f32x2 __attribute__((ext_vector_type(2)));
typedef float f32x16 __attribute__((ext_vector_type(16)));
typedef unsigned u32x4 __attribute__((ext_vector_type(4)));
typedef unsigned u32x2 __attribute__((ext_vector_type(2)));
typedef GAS unsigned gu32;

constexpr int D = 1024, NB = 8, S = 4096, T = NB * S, NL = 4, INC = 3488, NIN = 3584, NE = 16, FF = 512;
constexpr float EPS = 1e-6f, LOG2E = 1.4426950408889634f;
constexpr float QSCALE_A = 0.125f * LOG2E, QSCALE_B = 0.10206207261596577f * LOG2E;
constexpr float PFOLD = 4.f, PBYTE0 = 60.26f;
constexpr float OSCALE = 64.f, WSCALE = 16.f;
constexpr int NWAVES = 8, NTHREADS = 512;
constexpr int NPHASE = 2 + 9 * NL;

constexpr size_t MiB = 1u << 20;
constexpr size_t WS_CTL = 0, CTL_BYTES = 1 * MiB;
constexpr size_t WS_MOD = 1 * MiB;
constexpr size_t WS_COSA = 2 * MiB, WS_SINA = WS_COSA + 512 * 1024, WS_COSB = 3 * MiB, WS_SINB = WS_COSB + 256 * 1024;
constexpr size_t WS_SSQ = 4 * MiB, WS_SSKV = 5 * MiB;
constexpr size_t WS_GW = 6 * MiB;
constexpr size_t WS_LIST = 7 * MiB;
constexpr size_t WS_WIN = 10 * MiB, WS_WQB = 17 * MiB, WS_WKVB = 18 * MiB, WS_WPA = 19 * MiB, WS_WPB = 20 * MiB, WS_WO = 21 * MiB, WS_W13 = 23 * MiB, WS_W2 = 55 * MiB;
constexpr size_t WS_H = 72 * MiB;
constexpr size_t WS_QA = 136 * MiB, WS_KA = 168 * MiB, WS_VA = 176 * MiB, WS_QLAT = 184 * MiB, WS_KVLAT = 208 * MiB;
constexpr size_t WS_KB = 224 * MiB, WS_VB = 272 * MiB, WS_QB = 304 * MiB, WS_OB = 352 * MiB, WS_SA = 384 * MiB, WS_SB = 448 * MiB, WS_XB = 512 * MiB, WS_QA8 = 576 * MiB, WS_KA8 = 592 * MiB, WS_VTA8 = 596 * MiB, WS_QB8 = 600 * MiB, WS_KB8 = 624 * MiB, WS_VTB8 = 648 * MiB, WS_END = 664 * MiB;
constexpr size_t WS_ACT = 136 * MiB, WS_Y2 = 208 * MiB;
constexpr int ACT_ROWS = 2 * T + NE * 256;
static_assert(WS_ACT + (size_t)ACT_ROWS * FF * 2 <= WS_Y2 && WS_Y2 + (size_t)2 * T * D * 2 <= WS_XB, "moe overlay");
constexpr int CW_BAR = 4096;
constexpr int CW_CNT = 16384;

constexpr int RING_BYTES = 131072, MISC_OFF = RING_BYTES, LDS_BYTES = 147456;

__device__ __forceinline__ float bf2f(unsigned v) { return __uint_as_float(v << 16); }
typedef __bf16 bf16x2_t __attribute__((ext_vector_type(2)));
__device__ __forceinline__ unsigned cvt_pk_bf16(float lo, float hi) { f32x2 v = {lo, hi}; bf16x2_t b = __builtin_convertvector(v, bf16x2_t); return __builtin_bit_cast(unsigned, b); }
__device__ __forceinline__ u32x4 pack8(f32x4 a, f32x4 b) { u32x4 w; w.x = cvt_pk_bf16(a[0], a[1]); w.y = cvt_pk_bf16(a[2], a[3]); w.z = cvt_pk_bf16(b[0], b[1]); w.w = cvt_pk_bf16(b[2], b[3]); return w; }
__device__ __forceinline__ u32x2 pack8_fp8(f32x4 a, f32x4 b) { u32x2 w;
    w.x = (unsigned)__builtin_amdgcn_cvt_pk_fp8_f32(a[2], a[3], __builtin_amdgcn_cvt_pk_fp8_f32(a[0], a[1], 0, false), true);
    w.y = (unsigned)__builtin_amdgcn_cvt_pk_fp8_f32(b[2], b[3], __builtin_amdgcn_cvt_pk_fp8_f32(b[0], b[1], 0, false), true); return w; }
__device__ __forceinline__ u32x4 pair16(u32x2 w0, u32x2 w1) {
    const auto x = __builtin_amdgcn_permlane16_swap(w0.x, w1.x, false, false); const auto y = __builtin_amdgcn_permlane16_swap(w0.y, w1.y, false, false);
    return (u32x4){x[0], y[0], x[1], y[1]};
}
__device__ __forceinline__ void unpack8(u32x4 w, f32x4& a, f32x4& b) { a[0] = bf2f(w.x & 0xffffu); a[1] = bf2f(w.x >> 16); a[2] = bf2f(w.y & 0xffffu); a[3] = bf2f(w.y >> 16); b[0] = bf2f(w.z & 0xffffu); b[1] = bf2f(w.z >> 16); b[2] = bf2f(w.w & 0xffffu); b[3] = bf2f(w.w >> 16); }
__device__ __forceinline__ float wave_sum(float v) {
#pragma unroll
    for (int o = 1; o < 64; o <<= 1) v += __shfl_xor(v, o);
    return v;
}
__device__ __forceinline__ float sigm(float v) { return __builtin_amdgcn_rcpf(1.f + __builtin_amdgcn_exp2f(v * (-LOG2E))); }
#if WT_STORES
__device__ __forceinline__ void st16(void* p, u32x4 v) { asm volatile("global_store_dwordx4 %0, %1, off sc1\n\ts_nop 1" :: "v"(p), "v"(v) : "memory"); }
__device__ __forceinline__ void st8(void* p, u32x2 v) { asm volatile("global_store_dwordx2 %0, %1, off sc1\n\ts_nop 1" :: "v"(p), "v"(v) : "memory"); }
#else
__device__ __forceinline__ void st16(void* p, u32x4 v) { *(u32x4*)p = v; }
__device__ __forceinline__ void st8(void* p, u32x2 v) { *(u32x2*)p = v; }
#endif
#define VM_WAIT() asm volatile("s_waitcnt vmcnt(0)" ::: "memory")
#define LAUNDER_S(p) asm volatile("" : "+s"(p))
#define LAUNDER_V(v) asm volatile("" : "+v"(v))
#define LDS_WAIT() asm volatile("s_waitcnt lgkmcnt(0)" ::: "memory")

#define XB_TMO      128
#define XB_XCNT(j)  (256  + 64 * (j))
#define XB_XSUB(j)  (1280 + 64 * (j))
#define XB_XGEN(j)  (2304 + 64 * (j))
#define XB_TOP      3328
#define XB_TOPGEN   3392
#define XCD_BAR_WORDS 3456
#define XB_SPIN_CAP (1u << 22)
__device__ __forceinline__ unsigned xb_ld(unsigned* p)              { return __hip_atomic_load(p, __ATOMIC_RELAXED, __HIP_MEMORY_SCOPE_AGENT); }
__device__ __forceinline__ unsigned xb_add(unsigned* p, unsigned v) { return __hip_atomic_fetch_add(p, v, __ATOMIC_RELAXED, __HIP_MEMORY_SCOPE_AGENT); }
__device__ __forceinline__ unsigned xb_xcc_id() { return (unsigned)__builtin_amdgcn_s_getreg((3 << 11) | 20) & 0xFu; }
#define XB_SPIN(cond, bar) do { unsigned _sp = 0; while (cond) { __builtin_amdgcn_s_sleep(1); \
    if ((++_sp & 255u) == 0u) { if (xb_ld(&(bar)[XB_TMO])) break; if (_sp > XB_SPIN_CAP) { atomicAdd(&(bar)[XB_TMO], 1u); break; } } } } while (0)
struct XcdBarrier { unsigned* bar; unsigned x; volatile LAS unsigned* st; };
__device__ __forceinline__ XcdBarrier xcd_barrier_post(unsigned* bar, volatile LAS unsigned* st) {
    XcdBarrier b; b.bar = bar; b.x = xb_xcc_id(); b.st = st;
    if (threadIdx.x == 0) (void)xb_add(&bar[XB_XCNT(b.x)], 1u);
    return b;
}
__device__ __forceinline__ void xcd_barrier_complete(unsigned* bar, unsigned x, unsigned& nloc, unsigned& nx) {
    const unsigned G = gridDim.x * gridDim.y * gridDim.z;
    unsigned sum, cnt, mine, sp = 0u;
    for (;;) {
        sum = 0u; cnt = 0u; mine = 0u;
#pragma unroll
        for (unsigned j = 0; j < 16; ++j) { const unsigned c = xb_ld(&bar[XB_XCNT(j)]); sum += c; cnt += (c > 0u) ? 1u : 0u; mine = (j == x) ? c : mine; }
        if (sum == G) break;
        __builtin_amdgcn_s_sleep(1);
        if ((++sp & 255u) == 0u) { if (xb_ld(&bar[XB_TMO])) break; if (sp > XB_SPIN_CAP) { atomicAdd(&bar[XB_TMO], 1u); break; } }
    }
    nloc = mine > 0u ? mine : 1u; nx = cnt > 0u ? cnt : 1u;
}
__device__ __forceinline__ void xcd_barrier(const XcdBarrier& b) {
    asm volatile("s_waitcnt vmcnt(0)" ::: "memory");
    __syncthreads();
    if (threadIdx.x == 0) {
        unsigned* bar = b.bar;
        __builtin_amdgcn_s_waitcnt(0);
        unsigned nloc = b.st[0], nx = b.st[1];
        if (nloc == 0u) { xcd_barrier_complete(bar, b.x, nloc, nx); b.st[0] = nloc; b.st[1] = nx; }
        const unsigned old = xb_add(&bar[XB_XSUB(b.x)], 1u);
        const unsigned gen = old / nloc;
        if (old + 1u == (gen + 1u) * nloc) {
            __builtin_amdgcn_fence(__ATOMIC_RELEASE, "agent");
            asm volatile("s_waitcnt vmcnt(0)" ::: "memory");
            const unsigned og = xb_add(&bar[XB_TOP], 1u);
            const unsigned tg = og / nx;
            if (og + 1u == (tg + 1u) * nx) xb_add(&bar[XB_TOPGEN], 1u);
            else XB_SPIN(xb_ld(&bar[XB_TOPGEN]) == tg, bar);
            __builtin_amdgcn_fence(__ATOMIC_ACQUIRE, "agent");
            xb_add(&bar[XB_XGEN(b.x)], 1u);
            asm volatile("s_waitcnt vmcnt(0)" ::: "memory");
        } else {
            XB_SPIN(xb_ld(&bar[XB_XGEN(b.x)]) == gen, bar);
            __builtin_amdgcn_fence(__ATOMIC_ACQUIRE, "agent");
            asm volatile("s_waitcnt vmcnt(0)" ::: "memory");
        }
    }
    __syncthreads();
}

namespace gp {
constexpr int BM = 256, BK = 64, HALF = 128, HTB = HALF * BK * 2, NXCD = 8, WGM = 8;
__host__ __device__ __forceinline__ int lds_byte(int r, int c) { const int st = (r >> 4) * 2 + (c >> 5), rr = r & 15, cc = c & 31, ob = rr * 64 + cc * 2; return st * 1024 + (ob ^ (((ob >> 9) & 1) << 5)); }
__host__ __device__ __forceinline__ void stage_rc(int b, int& R, int& C) { const int st = b / 1024, sb = b % 1024, swz = sb ^ (((sb >> 9) & 1) << 5); R = (st >> 1) * 16 + swz / 64; C = (st & 1) * 32 + (swz % 64) / 2; }
__host__ __device__ __forceinline__ int perm32(int rho) { const int n = rho >> 4, i = rho & 15; return 8 * (i >> 2) + 4 * n + (i & 3); }

struct Unit { int pm, pn, be, rl, nv; };
struct Gemm { const bf16_t* A; const bf16_t* Bt; int K; size_t bstride; const unsigned* list; size_t astride; int sw, sx; };

__device__ __forceinline__ int xcd_remap(int wgid, int nwg) { const int q = nwg / NXCD, r = nwg % NXCD, xcd = wgid % NXCD, off = wgid / NXCD; return (xcd < r ? xcd * (q + 1) : r * (q + 1) + (xcd - r) * q) + off; }
struct DenseOrder {
    int nM, nN, nwg, G, c;
    __device__ void init(int M, int N, int G_, int c_) { nM = M / BM; nN = N / BM; nwg = nM * nN; G = G_; c = c_; }
    __device__ bool next(int i, Unit& u) const {
        const int L = i * G + c; if (L >= nwg) return false;
        const int wgid = xcd_remap((int)L, nwg);
        const int nig = WGM * nN, gid = wgid / nig, fm = gid * WGM, gsz = (nM - fm) < WGM ? (nM - fm) : WGM;
        u.pm = fm + ((wgid % nig) % gsz); u.pn = (wgid % nig) / gsz; u.be = 0; u.rl = 0; u.nv = 256; return true;
    }
};
struct PairOrder {
    DenseOrder d;
    __device__ void init(int M, int N, int G_, int c_) { d.init(M, N, G_, c_); }
    __device__ bool next(int i, Unit& u) const { if (!d.next(i >> 1, u)) return false; u.be = i & 1; return true; }
};
struct MoeOrder {
    const LAS int* tab; int nwg, G, c;
    __device__ static int rd(const LAS int* p) { return __builtin_amdgcn_readfirstlane(*p); }
    __device__ void init(const LAS int* tab_, int G_, int c_) { tab = tab_; nwg = rd(tab_ + 16) * 4; G = G_; c = c_; }
    __device__ bool next(int i, Unit& u) const {
        const int L = i * G + c; if (L >= nwg) return false;
        const int wgid = xcd_remap((int)L, nwg);
        const int tile = wgid >> 2; int e = 0;
        for (int k = 1; k < NE; ++k) { const int tk = rd(tab + k); e = (tk <= tile) ? k : e; }
        e = __builtin_amdgcn_readfirstlane(e);
        u.pm = tile; u.pn = wgid & 3; u.be = e; u.rl = tile - rd(tab + e); const int rem = rd(tab + 32 + e) - u.rl * 256; u.nv = rem < 256 ? rem : 256; return true;
    }
};

#define ACC_T f32x4 (&acc)[2][2][4][2]

template <class Epi, class Sched, bool GATHER>
__device__ __forceinline__ void gemm_phase_ref(int tid, const Gemm g, const Sched& S, const Epi& E) {
    const int wid = __builtin_amdgcn_readfirstlane(tid >> 6), lane = tid & 63, wr = wid >> 2, wc = wid & 3, fr = lane & 15, fq = lane >> 4;
    const int K = g.K; Unit u;
    for (int ui = 0; S.next(ui, u); ++ui) {
        f32x4 acc[2][2][4][2];
#pragma unroll
        for (int a = 0; a < 2; ++a)
#pragma unroll
            for (int b = 0; b < 2; ++b)
#pragma unroll
                for (int m = 0; m < 4; ++m)
#pragma unroll
                    for (int n = 0; n < 2; ++n) acc[a][b][m][n] = (f32x4){0.f, 0.f, 0.f, 0.f};
        const bf16_t* Bt = g.Bt + (size_t)u.be * g.bstride + (size_t)u.pn * 256 * K;
        for (int ai = 0; ai < 2; ++ai)
            for (int m = 0; m < 4; ++m) {
                const int rloc = ai * 128 + wr * 64 + m * 16 + fr;
                size_t arow;
                if (GATHER) { arow = (rloc < u.nv) ? (size_t)(g.list[(size_t)u.be * T + u.rl * 256 + rloc] >> 1) : 0; }
                else arow = (size_t)u.pm * 256 + rloc;
                const bf16_t* ap = g.A + arow * K;
                for (int bj = 0; bj < 2; ++bj) {
                    const bf16_t* bp = Bt + (size_t)(bj * 128 + wc * 32 + fq * 8) * K;
                    float s[8];
#pragma unroll
                    for (int c = 0; c < 8; ++c) {
                        float sc = 0.f; const bf16_t* bpc = bp + (size_t)c * K;
#pragma unroll 2
                        for (int k = 0; k < K; k += 8) {
                            f32x4 a0, a1, b0, b1; unpack8(*(const u32x4*)(ap + k), a0, a1); unpack8(*(const u32x4*)(bpc + k), b0, b1);
                            sc += a0[0] * b0[0] + a0[1] * b0[1] + a0[2] * b0[2] + a0[3] * b0[3] + a1[0] * b1[0] + a1[1] * b1[1] + a1[2] * b1[2] + a1[3] * b1[3];
                        }
                        s[c] = sc; asm volatile("" : "+v"(s[c]));
                    }
#pragma unroll
                    for (int a2 = 0; a2 < 2; ++a2)
#pragma unroll
                        for (int b2 = 0; b2 < 2; ++b2)
#pragma unroll
                            for (int m2 = 0; m2 < 4; ++m2)
                                if (a2 == ai && b2 == bj && m2 == m) { acc[a2][b2][m2][0] = (f32x4){s[0], s[1], s[2], s[3]}; acc[a2][b2][m2][1] = (f32x4){s[4], s[5], s[6], s[7]}; }
                }
            }
        E(acc, u, wr, wc, fr, fq);
    }
}

template <class E> struct EpiTraits { static constexpr bool KEEP = false; };
#if FAST_GEMM
typedef int v8i_t __attribute__((ext_vector_type(8)));
__device__ __forceinline__ unsigned gp_voffb(int tid, int i, int K) { int t_ = tid; LAUNDER_V(t_); int R, C; stage_rc(t_ * 16 + i * 8192, R, C); const int Rb = (R & ~31) + perm32(R & 31); return (unsigned)(Rb * K + C) * 2u; }
template <class Epi, class Sched, bool GATHER, bool F8>
__device__ __forceinline__ void gemm_phase_fast(int tid, LAS unsigned char* lds, const Gemm g, const Sched& S, const Epi& E) {
    const int wid = __builtin_amdgcn_readfirstlane(tid >> 6), lane = tid & 63, wr = wid >> 2, wc = wid & 3, fr = lane & 15, fq = lane >> 4;
    const int K = g.K, nt = K / BK;
    int Rr[2], Cc[2]; unsigned voffB[2];
#pragma unroll
    for (int i = 0; i < 2; ++i) { stage_rc(tid * 16 + i * 8192, Rr[i], Cc[i]); const int Rb = (Rr[i] & ~31) + perm32(Rr[i] & 31); voffB[i] = (unsigned)(Rb * K + Cc[i]) * 2u; }
#define GP_VB(i) (F8 ? gp_voffb(tid, (i), K) : voffB[i])
    const size_t kstep = (size_t)(BK * 2), hstep = (size_t)HALF * K * 2, tstep = 2 * hstep, r64 = (size_t)64 * K * 2;
    const unsigned ldsw = (unsigned)wid * 1024u;
    const int aoff = lds_byte(wr * 64 + fr, fq * 8), boff = lds_byte(wc * 32 + fr, fq * 8);
#define GP_UNI(p) ((const char*)(((unsigned long long)(unsigned)__builtin_amdgcn_readfirstlane((int)((unsigned long long)(p) >> 32)) << 32) | (unsigned)__builtin_amdgcn_readfirstlane((int)(unsigned long long)(p))))
#define GP_SA(b, h) (((b) * 2 + (h)) * HTB)
#define GP_SB(b, h) ((4 + (b) * 2 + (h)) * HTB)
#define GP_DMA(sbase, voff, ldsdst) do { unsigned keep_; asm volatile("s_mov_b32 %0, m0\n\ts_mov_b32 m0, %3\n\ts_nop 0\n\tglobal_load_lds_dwordx4 %1, %2\n\ts_mov_b32 m0, %0" \
        : "=&s"(keep_) : "v"(voff), "s"(sbase), "s"((unsigned)__builtin_amdgcn_readfirstlane((int)(unsigned)(uintptr_t)(ldsdst))) : "memory"); } while (0)
#define GP_STAGE2(bufoff, gbase, v0, v1) do { const char* gb_ = (gbase); GP_DMA(gb_, (v0), lds + (bufoff) + ldsw); GP_DMA(gb_, (v1), lds + (bufoff) + ldsw + 8192); } while (0)
#define GP_STAGEB(bufoff, gbase) do { if constexpr (F8) { const unsigned vb_ = GP_VB(0); const char* gb_ = (gbase); GP_DMA(gb_, vb_, lds + (bufoff) + ldsw); GP_DMA(gb_ + r64, vb_, lds + (bufoff) + ldsw + 8192); } else { GP_STAGE2(bufoff, gbase, GP_VB(0), GP_VB(1)); } } while (0)
#define GP_CAT8(x0, x1) __builtin_bit_cast(v8i_t, __builtin_shufflevector(x0, x1, 0, 1, 2, 3, 4, 5, 6, 7, 8, 9, 10, 11, 12, 13, 14, 15))
#define GP_LDA(dst, b, h) do { _Pragma("unroll") for (int m = 0; m < 4; ++m) _Pragma("unroll") for (int k = 0; k < 2; ++k) dst[m][k] = *(const LAS bf16x8*)(lds + GP_SA(b, h) + aoff + m * 2048 + k * 1024); \
        if constexpr (F8) { _Pragma("unroll") for (int m = 0; m < 4; ++m) dst##8[m] = GP_CAT8(dst[m][0], dst[m][1]); } } while (0)
#define GP_LDB(dst, b, h) do { _Pragma("unroll") for (int n = 0; n < 2; ++n) _Pragma("unroll") for (int k = 0; k < 2; ++k) dst[n][k] = *(const LAS bf16x8*)(lds + GP_SB(b, h) + boff + n * 2048 + k * 1024); \
        if constexpr (F8) { _Pragma("unroll") for (int n = 0; n < 2; ++n) dst##8[n] = GP_CAT8(dst[n][0], dst[n][1]); } } while (0)
#define GP_MMA(ai, bj, At, Bt) do { __builtin_amdgcn_s_setprio(1); \
        if constexpr (F8) { _Pragma("unroll") for (int m = 0; m < 4; ++m) _Pragma("unroll") for (int n = 0; n < 2; ++n) \
            acc[ai][bj][m][n] = __builtin_amdgcn_mfma_scale_f32_16x16x128_f8f6f4(Bt##8[n], At##8[m], acc[ai][bj][m][n], 0, 0, 0, 0, 0, 0); }     \
        else { _Pragma("unroll") for (int m = 0; m < 4; ++m) _Pragma("unroll") for (int n = 0; n < 2; ++n) _Pragma("unroll") for (int k = 0; k < 2; ++k) \
            acc[ai][bj][m][n] = __builtin_amdgcn_mfma_f32_16x16x32_bf16(Bt[n][k], At[m][k], acc[ai][bj][m][n], 0, 0, 0); } \
        __builtin_amdgcn_s_setprio(0); } while (0)
#define GP_WAIT_V(n) asm volatile("s_waitcnt vmcnt(" #n ")" ::: "memory")
#define GP_WAIT_L(n) asm volatile("s_waitcnt lgkmcnt(" #n ")" ::: "memory")
#define GP_BAR __builtin_amdgcn_s_barrier()
#define GP_SCHED __builtin_amdgcn_sched_barrier(0)
    Unit cur, nxt; int ui = 0;
    if (!S.next(0, cur)) return;
    f32x4 acc[2][2][4][2];
#pragma unroll
    for (int a = 0; a < 2; ++a)
#pragma unroll
        for (int b = 0; b < 2; ++b)
#pragma unroll
            for (int m = 0; m < 4; ++m)
#pragma unroll
                for (int n = 0; n < 2; ++n) acc[a][b][m][n] = (f32x4){0.f, 0.f, 0.f, 0.f};
    bf16x8 At[4][2], B0[2][2], B1[2][2];
    v8i_t At8[4], B08[2], B18[2];
    unsigned vC0, vC1, vC2, vC3, vN0, vN1, vN2, vN3;
#define GP_VOFF(u, o0, o1, o2, o3) do { if (GATHER) { \
        int tl_ = tid; LAUNDER_V(tl_); int R0_, C0_, R1_, C1_; stage_rc(tl_ * 16, R0_, C0_); stage_rc(tl_ * 16 + 8192, R1_, C1_);     \
        const unsigned* lp = g.list + (size_t)(u).be * T + (u).rl * 256; \
        const int nvm = (u).nv - 1; const int p0 = min(R0_, nvm), p1 = min(R1_, nvm), p2 = min(128 + R0_, nvm), p3 = min(128 + R1_, nvm); \
        const unsigned t0 = lp[p0] >> 1, t1 = lp[p1] >> 1, t2 = lp[p2] >> 1, t3 = lp[p3] >> 1; \
        o0 = (t0 * K + C0_) * 2u; o1 = (t1 * K + C1_) * 2u; o2 = (t2 * K + C0_) * 2u; o3 = (t3 * K + C1_) * 2u; \
      } else { o0 = (unsigned)(Rr[0] * K + Cc[0]) * 2u; o1 = (unsigned)(Rr[1] * K + Cc[1]) * 2u; o2 = o0 + (unsigned)hstep; o3 = o1 + (unsigned)hstep; } } while (0)
    GP_VOFF(cur, vC0, vC1, vC2, vC3);
    const char* cA = GP_UNI((const char*)g.A + ((size_t)cur.be * g.astride) * 2 + (GATHER ? (size_t)0 : (size_t)cur.pm * tstep));
    const char* cB = GP_UNI((const char*)g.Bt + ((size_t)cur.be * g.bstride) * 2 + (size_t)cur.pn * tstep);
    GP_STAGEB(GP_SB(0, 0), cB); GP_STAGEB(GP_SB(0, 1), cB + hstep); GP_STAGE2(GP_SA(0, 0), cA, vC0, vC1); GP_STAGE2(GP_SA(0, 1), cA, vC2, vC3);
    if (wr == 1) GP_BAR;
    GP_WAIT_V(2); GP_BAR;
    GP_STAGEB(GP_SB(1, 0), cB + kstep); GP_STAGE2(GP_SA(1, 0), cA + kstep, vC0, vC1); GP_STAGEB(GP_SB(1, 1), cB + hstep + kstep);
    GP_WAIT_V(6); GP_BAR;
    for (;;) {
        const bool has_next = S.next(ui + 1, nxt);
        const char* nA = GP_UNI(has_next ? (const char*)g.A + ((size_t)nxt.be * g.astride) * 2 + (GATHER ? (size_t)0 : (size_t)nxt.pm * tstep) : cA);
        const char* nB = GP_UNI(has_next ? (const char*)g.Bt + ((size_t)nxt.be * g.bstride) * 2 + (size_t)nxt.pn * tstep : cB);
        if (GATHER) {
            if (has_next) { GP_VOFF(nxt, vN0, vN1, vN2, vN3); } else { vN0 = vC0; vN1 = vC1; vN2 = vC2; vN3 = vC3; }
            *(LAS u32x4*)(lds + MISC_OFF + 2048 + tid * 16) = (u32x4){vN0, vN1, vN2, vN3};
        } else { vN0 = vC0; vN1 = vC1; vN2 = vC2; vN3 = vC3; }
#pragma nounroll
        for (int t = 0; t < nt; t += 2) {
            LAUNDER_S(cA); LAUNDER_S(cB); LAUNDER_S(nA); LAUNDER_S(nB);
            const bool last = (t == nt - 2);
            if (GATHER) { if (last) { const u32x4 q_ = *(const LAS u32x4*)(lds + MISC_OFF + 2048 + tid * 16); vN0 = q_.x; vN1 = q_.y; vN2 = q_.z; vN3 = q_.w; } }
            const char* a1 = cA + (size_t)(t + 1) * kstep;
            const char* a2 = last ? nA : cA + (size_t)(t + 2) * kstep; const char* b2 = last ? nB : cB + (size_t)(t + 2) * kstep;
            const char* a3 = a2 + kstep; const char* b3 = b2 + kstep;
            const unsigned w0 = last ? vN0 : vC0, w1 = last ? vN1 : vC1, w2 = last ? vN2 : vC2, w3 = last ? vN3 : vC3;
            GP_LDB(B0, 0, 0); GP_LDB(B1, 0, 1); GP_SCHED; GP_LDA(At, 0, 0); GP_STAGE2(GP_SA(1, 1), a1, vC2, vC3);
            GP_WAIT_V(8); GP_WAIT_L(0); GP_BAR; GP_MMA(0, 0, At, B0); GP_MMA(0, 1, At, B1); GP_BAR; GP_SCHED;
            GP_LDA(At, 0, 1); GP_STAGEB(GP_SB(0, 0), b2); GP_STAGEB(GP_SB(0, 1), b2 + hstep); GP_STAGE2(GP_SA(0, 0), a2, w0, w1);
            GP_WAIT_V(8); GP_WAIT_L(0); GP_BAR; GP_MMA(1, 0, At, B0); GP_MMA(1, 1, At, B1); GP_BAR; GP_SCHED;
            GP_LDB(B0, 1, 0); GP_LDB(B1, 1, 1); GP_SCHED; GP_LDA(At, 1, 0); GP_STAGE2(GP_SA(0, 1), a2, w2, w3);
            GP_WAIT_V(8); GP_WAIT_L(0); GP_BAR; GP_MMA(0, 0, At, B0); GP_MMA(0, 1, At, B1); GP_BAR; GP_SCHED;
            GP_LDA(At, 1, 1); GP_STAGEB(GP_SB(1, 0), b3); GP_STAGEB(GP_SB(1, 1), b3 + hstep); GP_STAGE2(GP_SA(1, 0), a3, w0, w1);
            GP_WAIT_V(8); GP_WAIT_L(0); GP_BAR; GP_MMA(1, 0, At, B0); GP_MMA(1, 1, At, B1); GP_BAR; GP_SCHED;
        }
        if (wr == 0) GP_BAR;
        E(acc, cur, wr, wc, fr, fq);
        if (!has_next) break;
        if (!(EpiTraits<Epi>::KEEP && cur.be == 0)) {
#pragma unroll
        for (int a = 0; a < 2; ++a)
#pragma unroll
            for (int b = 0; b < 2; ++b)
#pragma unroll
                for (int m = 0; m < 4; ++m)
#pragma unroll
                    for (int n = 0; n < 2; ++n) acc[a][b][m][n] = (f32x4){0.f, 0.f, 0.f, 0.f};
        }
        cur = nxt; cA = nA; cB = nB; vC0 = vN0; vC1 = vN1; vC2 = vN2; vC3 = vN3; ++ui;
        if (wr == 1) GP_BAR;
    }
    GP_WAIT_V(0);
    GP_BAR;
#undef GP_UNI
#undef GP_SA
#undef GP_SB
#undef GP_STAGE2
#undef GP_DMA
#undef GP_STAGEB
#undef GP_VB
#undef GP_LDA
#undef GP_LDB
#undef GP_MMA
#undef GP_CAT8
#undef GP_WAIT_V
#undef GP_WAIT_L
#undef GP_BAR
#undef GP_SCHED
#undef GP_VOFF
}
#endif

template <class Epi, class Sched, bool GATHER = false, bool F8 = false>
__device__ __forceinline__ void gemm_phase(int tid, LAS unsigned char* lds, const Gemm g, const Sched& S, const Epi& E) {
#if FAST_GEMM
    gemm_phase_fast<Epi, Sched, GATHER, F8>(tid, lds, g, S, E);
#else
    (void)lds; gemm_phase_ref<Epi, Sched, GATHER>(tid, g, S, E);
#endif
}

#define EPI_ROW(ai, m) (u.pm * 256 + (ai) * 128 + wr * 64 + (m) * 16 + fr)
#define EPI_COL(bj) (u.pn * 256 + (bj) * 128 + wc * 32 + fq * 8)
__device__ __forceinline__ float dot4(f32x4 a) { return (a[0] * a[0] + a[1] * a[1]) + (a[2] * a[2] + a[3] * a[3]); }

struct EpiNull {
    __device__ __forceinline__ void operator()(const ACC_T, const Unit& u, int wr, int wc, int fr, int fq) const {
#pragma unroll
        for (int ai = 0; ai < 2; ++ai)
#pragma unroll
            for (int bj = 0; bj < 2; ++bj)
#pragma unroll
                for (int m = 0; m < 4; ++m) asm volatile("" :: "v"(acc[ai][bj][m][0]), "v"(acc[ai][bj][m][1]));
    }
};
struct EpiIn {
    bf16_t *QA, *KA, *VA, *QLAT, *KVLAT, *KB, *SA, *SB; float *SSQ, *SSKV; const float *gq, *gk, *cosA, *sinA, *cosB, *sinB;
    __device__ __forceinline__ void operator()(const ACC_T, const Unit& u, int wr, int wc, int fr, int fq) const {
        const int wb = u.pn * 4 + wc;
        if (wb < 10) {
            const bool isq = wb < 8; const int head = isq ? wb : wb - 8; const float* g = isq ? gq : gk; bf16_t* dst = isq ? QA : KA; const int dp = isq ? 512 : 128; const float qs = isq ? QSCALE_A * (ATT_FP8_A ? PFOLD : 1.f) : 1.f;
            const f32x4 g00 = *(const f32x4*)(g + 8 * fq), g01 = *(const f32x4*)(g + 8 * fq + 4), g10 = *(const f32x4*)(g + 32 + 8 * fq), g11 = *(const f32x4*)(g + 36 + 8 * fq);
#pragma unroll
            for (int ai = 0; ai < 2; ++ai)
#pragma unroll
                for (int m = 0; m < 4; ++m) {
                    const int r = EPI_ROW(ai, m), pos = r & (S - 1);
                    const f32x4 v00 = acc[ai][0][m][0], v01 = acc[ai][0][m][1], v10 = acc[ai][1][m][0], v11 = acc[ai][1][m][1];
                    float ss = (dot4(v00) + dot4(v01)) + (dot4(v10) + dot4(v11)); ss += __shfl_xor(ss, 16); ss += __shfl_xor(ss, 32);
                    const float rstd = rsqrtf(ss * (1.f / 64.f) + EPS);
                    const f32x4 y00 = v00 * rstd * g00, y01 = v01 * rstd * g01, y10 = v10 * rstd * g10, y11 = v11 * rstd * g11;
                    const f32x4 c0 = *(const f32x4*)(cosA + pos * 32 + 8 * fq), c1 = *(const f32x4*)(cosA + pos * 32 + 8 * fq + 4), s0 = *(const f32x4*)(sinA + pos * 32 + 8 * fq), s1 = *(const f32x4*)(sinA + pos * 32 + 8 * fq + 4);
                    const f32x4 o00 = (y00 * c0 - y10 * s0) * qs, o01 = (y01 * c1 - y11 * s1) * qs, o10 = (y10 * c0 + y00 * s0) * qs, o11 = (y11 * c1 + y01 * s1) * qs;
#if ATT_FP8_A
                    unsigned char* p8 = (unsigned char*)dst + (size_t)r * dp + head * 64 + 8 * fq;
                    st16(p8 + (fq & 1) * 32 - (fq & 1) * 8, pair16(pack8_fp8(o00, o01), pack8_fp8(o10, o11)));
#else
                    bf16_t* p = dst + (size_t)r * dp + head * 64 + 8 * fq;
                    st16(p, pack8(o00, o01)); st16((p + 32), pack8(o10, o11));
#endif
                }
        } else if (wb < 12) {
#pragma unroll
            for (int ai = 0; ai < 2; ++ai)
#pragma unroll
                for (int m = 0; m < 4; ++m) {
#if ATT_FP8_A
                    const int r = EPI_ROW(ai, m), sq = r & (S - 1), k = sq & 63, pos = 32 * ((k >> 2) & 1) + 16 * (k >> 5) + (k & 3) + 4 * ((k & 31) >> 3);
                    unsigned char* vtb = (unsigned char*)VA; const unsigned vo = (unsigned)(((r >> 12) * 2 + (wb - 10)) * 64 + 8 * fq) * S + (unsigned)((sq & ~63) + pos);
#pragma unroll
                    for (int bj = 0; bj < 2; ++bj)
#pragma unroll
                        for (int n = 0; n < 2; ++n) { const f32x4 x = acc[ai][bj][m][n]; const unsigned w = (unsigned)__builtin_amdgcn_cvt_pk_fp8_f32(x[2], x[3], __builtin_amdgcn_cvt_pk_fp8_f32(x[0], x[1], 0, false), true);
                            const unsigned qo = vo + (unsigned)(bj * 32 + 4 * n) * S;
                            vtb[qo] = (unsigned char)(w & 0xffu); vtb[qo + S] = (unsigned char)((w >> 8) & 0xffu); vtb[qo + 2 * S] = (unsigned char)((w >> 16) & 0xffu); vtb[qo + 3 * S] = (unsigned char)(w >> 24); }
#else
                    bf16_t* p = VA + (size_t)EPI_ROW(ai, m) * 128 + (wb - 10) * 64 + 8 * fq;
                    st16(p, pack8(acc[ai][0][m][0], acc[ai][0][m][1])); st16((p + 32), pack8(acc[ai][1][m][0], acc[ai][1][m][1]));
#endif
                }
        } else if (wb < 22) {
            const bool isq = wb < 18; const int idx = isq ? wb - 12 : wb - 18; bf16_t* dst = isq ? QLAT : KVLAT; const int dp = isq ? 384 : 256;
#pragma unroll
            for (int ai = 0; ai < 2; ++ai)
#pragma unroll
                for (int m = 0; m < 4; ++m) {
                    const int r = EPI_ROW(ai, m);
                    const f32x4 v00 = acc[ai][0][m][0], v01 = acc[ai][0][m][1], v10 = acc[ai][1][m][0], v11 = acc[ai][1][m][1];
                    float ss = (dot4(v00) + dot4(v01)) + (dot4(v10) + dot4(v11)); ss += __shfl_xor(ss, 16); ss += __shfl_xor(ss, 32);
                    if (fq == 0) { if (isq) SSQ[(size_t)r * 8 + idx] = ss; else SSKV[(size_t)r * 4 + idx] = ss; }
                    bf16_t* p = dst + (size_t)r * dp + idx * 64 + 8 * fq;
                    st16(p, pack8(v00, v01)); st16((p + 32), pack8(v10, v11));
                }
        } else if (wb == 22) {
            if (fq < 2) {
#pragma unroll
                for (int ai = 0; ai < 2; ++ai)
#pragma unroll
                    for (int m = 0; m < 4; ++m) {
                        const int r = EPI_ROW(ai, m), pos = r & (S - 1);
                        const f32x4 x10 = acc[ai][0][m][0], x11 = acc[ai][0][m][1], x20 = acc[ai][1][m][0], x21 = acc[ai][1][m][1];
                        const f32x4 c0 = *(const f32x4*)(cosB + pos * 16 + 8 * fq), c1 = *(const f32x4*)(cosB + pos * 16 + 8 * fq + 4), s0 = *(const f32x4*)(sinB + pos * 16 + 8 * fq), s1 = *(const f32x4*)(sinB + pos * 16 + 8 * fq + 4);
#if ATT_FP8_B
                        const u32x2 w1 = pack8_fp8(x10 * c0 - x20 * s0, x11 * c1 - x21 * s1), w2 = pack8_fp8(x20 * c0 + x10 * s0, x21 * c1 + x11 * s1);
                        unsigned char* p = (unsigned char*)KB + (size_t)r * 768 + 64 + 8 * fq;
#pragma unroll
                        for (int h = 0; h < 8; ++h) { st8(p + h * 96, w1); st8(p + h * 96 + 16, w2); }
#else
                        const u32x4 w1 = pack8(x10 * c0 - x20 * s0, x11 * c1 - x21 * s1), w2 = pack8(x20 * c0 + x10 * s0, x21 * c1 + x11 * s1);
                        bf16_t* p = KB + (size_t)r * 768 + 64 + 8 * fq;
#pragma unroll
                        for (int h = 0; h < 8; ++h) { st16((p + h * 96), w1); st16((p + h * 96 + 16), w2); }
#endif
                    }
            }
        } else if (wb == 23) {
        } else {
            const bool isa = wb < 40; const int idx = isa ? wb - 24 : wb - 40; unsigned char* dst = (unsigned char*)(isa ? SA : SB);
#pragma unroll
            for (int ai = 0; ai < 2; ++ai)
#pragma unroll
                for (int m = 0; m < 4; ++m) { unsigned char* p = dst + (size_t)EPI_ROW(ai, m) * 1024 + idx * 64 + (fq & 1) * 32 + 8 * (fq & ~1);
                    st16(p, pair16(pack8_fp8(acc[ai][0][m][0], acc[ai][0][m][1]), pack8_fp8(acc[ai][1][m][0], acc[ai][1][m][1]))); }
        }
    }
};
__host__ __device__ __forceinline__ int src_col_in(int n) {
    const int pn = n >> 8, nl = n & 255, bj = nl >> 7, wc = (nl & 127) >> 5, p = nl & 31, wb = pn * 4 + wc, s = bj * 32 + p;
    if (wb < 8) return wb * 64 + s;
    if (wb < 10) return 512 + (wb - 8) * 64 + s;
    if (wb < 12) return 640 + (wb - 10) * 64 + s;
    if (wb < 18) return 768 + (wb - 12) * 64 + s;
    if (wb < 22) return 1152 + (wb - 18) * 64 + s;
    if (wb == 22) return p < 16 ? 1408 + bj * 16 + p : -1;
    if (wb == 23) return -1;
    if (wb < 40) return 1440 + (wb - 24) * 64 + s;
    return 2464 + (wb - 40) * 64 + s;
}
struct EpiQb {
    bf16_t* QB; const float *SSQ, *cosB, *sinB;
    __device__ __forceinline__ void operator()(const ACC_T, const Unit& u, int wr, int wc, int fr, int fq) const {
#pragma unroll
        for (int ai = 0; ai < 2; ++ai)
#pragma unroll
            for (int m = 0; m < 4; ++m) {
                const int r = EPI_ROW(ai, m), pos = r & (S - 1);
                const f32x4 sa = *(const f32x4*)(SSQ + (size_t)r * 8); const f32x2 sb = *(const f32x2*)(SSQ + (size_t)r * 8 + 4);
                const float rstd = rsqrtf((((sa[0] + sa[1]) + (sa[2] + sa[3])) + (sb[0] + sb[1])) * (1.f / 384.f) + EPS);
                u32x2 wq[2];
#pragma unroll
                for (int bj = 0; bj < 2; ++bj) {
                    f32x4 v0 = acc[ai][bj][m][0] * rstd, v1 = acc[ai][bj][m][1] * rstd;
                    const int c32 = u.pn * 8 + bj * 4 + wc;
                    if (c32 % 3 == 2) {
                        f32x4 o0, o1;
#pragma unroll
                        for (int j = 0; j < 4; ++j) { o0[j] = __shfl_xor(v0[j], 32); o1[j] = __shfl_xor(v1[j], 32); }
                        const int i0 = 8 * (fq & 1);
                        const f32x4 c0 = *(const f32x4*)(cosB + pos * 16 + i0), c1 = *(const f32x4*)(cosB + pos * 16 + i0 + 4), s0 = *(const f32x4*)(sinB + pos * 16 + i0), s1 = *(const f32x4*)(sinB + pos * 16 + i0 + 4);
                        if (fq < 2) { v0 = v0 * c0 - o0 * s0; v1 = v1 * c1 - o1 * s1; } else { v0 = v0 * c0 + o0 * s0; v1 = v1 * c1 + o1 * s1; }
                    }
#if ATT_FP8_B
                    wq[bj] = pack8_fp8(v0 * (QSCALE_B * PFOLD), v1 * (QSCALE_B * PFOLD));
#else
                    st16((QB + (size_t)r * 768 + EPI_COL(bj)), pack8(v0 * QSCALE_B, v1 * QSCALE_B));
#endif
                }
#if ATT_FP8_B
                st16((unsigned char*)QB + (size_t)r * 768 + u.pn * 256 + (fq & 1) * 128 + wc * 32 + 8 * (fq & ~1), pair16(wq[0], wq[1]));
#endif
            }
    }
};
struct EpiKvb {
    bf16_t *KB, *VB; const float* SSKV;
    __device__ __forceinline__ void operator()(const ACC_T, const Unit& u, int wr, int wc, int fr, int fq) const {
#pragma unroll
        for (int ai = 0; ai < 2; ++ai)
#pragma unroll
            for (int m = 0; m < 4; ++m) {
                const int r = EPI_ROW(ai, m);
                const f32x4 sa = *(const f32x4*)(SSKV + (size_t)r * 4);
                const float rstd = rsqrtf(((sa[0] + sa[1]) + (sa[2] + sa[3])) * (1.f / 256.f) + EPS);
                u32x2 wk[2] = {};
#pragma unroll
                for (int bj = 0; bj < 2; ++bj) {
                    const int head = u.pn * 2 + bj, o = wc * 32 + fq * 8;
#if ATT_FP8_B
                    const f32x4 x0 = acc[ai][bj][m][0] * rstd, x1 = acc[ai][bj][m][1] * rstd;
                    if (wc < 2) wk[bj] = pack8_fp8(x0, x1);
                    else {
                        const int sq = r & (S - 1), k = sq & 63, pos = 32 * ((k >> 2) & 1) + 16 * (k >> 5) + (k & 3) + 4 * ((k & 31) >> 3);
                        unsigned char* vtb = (unsigned char*)VB; const unsigned vo = (unsigned)(((r >> 12) * 8 + head) * 64 + (o - 64)) * S + (unsigned)((sq & ~63) + pos);
                        const u32x2 w = pack8_fp8(x0, x1);
                        vtb[vo] = (unsigned char)(w.x & 0xffu); vtb[vo + S] = (unsigned char)((w.x >> 8) & 0xffu); vtb[vo + 2 * S] = (unsigned char)((w.x >> 16) & 0xffu); vtb[vo + 3 * S] = (unsigned char)(w.x >> 24);
                        vtb[vo + 4 * S] = (unsigned char)(w.y & 0xffu); vtb[vo + 5 * S] = (unsigned char)((w.y >> 8) & 0xffu); vtb[vo + 6 * S] = (unsigned char)((w.y >> 16) & 0xffu); vtb[vo + 7 * S] = (unsigned char)(w.y >> 24);
                    }
#else
                    const u32x4 w = pack8(acc[ai][bj][m][0] * rstd, acc[ai][bj][m][1] * rstd);
                    if (wc < 2) st16((KB + (size_t)r * 768 + head * 96 + o), w); else st16((VB + (size_t)r * 512 + head * 64 + (o - 64)), w);
#endif
                }
#if ATT_FP8_B
                if (wc < 2) st16((unsigned char*)KB + (size_t)r * 768 + (u.pn * 2 + (fq & 1)) * 96 + wc * 32 + 8 * (fq & ~1), pair16(wk[0], wk[1]));
#endif
            }
    }
};
template <int MODE> struct EpiProj {
    bf16_t* O; const bf16_t* gate;
    __device__ __forceinline__ void operator()(const ACC_T, const Unit& u, int wr, int wc, int fr, int fq) const {
#pragma unroll
        for (int ai = 0; ai < 2; ++ai)
#pragma unroll
            for (int m = 0; m < 4; ++m) {
                const int r = EPI_ROW(ai, m);
#pragma unroll
                for (int bj = 0; bj < 2; ++bj) {
                    const size_t off = (size_t)r * D + EPI_COL(bj);
                    const u32x2 gw = *(const u32x2*)((const unsigned char*)gate + off);
                    const f32x2 q0 = __builtin_amdgcn_cvt_pk_f32_fp8((int)gw.x, false), q1 = __builtin_amdgcn_cvt_pk_f32_fp8((int)gw.x, true), q2 = __builtin_amdgcn_cvt_pk_f32_fp8((int)gw.y, false), q3 = __builtin_amdgcn_cvt_pk_f32_fp8((int)gw.y, true);
                    const f32x4 g0 = {sigm(q0[0]), sigm(q0[1]), sigm(q1[0]), sigm(q1[1])}, g1 = {sigm(q2[0]), sigm(q2[1]), sigm(q3[0]), sigm(q3[1])};
                    f32x4 v0 = acc[ai][bj][m][0] * g0, v1 = acc[ai][bj][m][1] * g1;
                    if (MODE == 1) { f32x4 p0, p1; unpack8(*(const u32x4*)(O + off), p0, p1); v0 += p0; v1 += p1; }
                    if (MODE == 1) st16(O + off, pack8(v0, v1)); else *(u32x4*)(O + off) = pack8(v0, v1);
                }
            }
    }
};
struct EpiProjP {
    bf16_t* O; const unsigned char* SA; const unsigned char* SB;
    __device__ static __forceinline__ void gates(const unsigned char* G, size_t off, f32x4& g0, f32x4& g1) {
        const u32x2 gw = *(const u32x2*)(G + off);
        const f32x2 q0 = __builtin_amdgcn_cvt_pk_f32_fp8((int)gw.x, false), q1 = __builtin_amdgcn_cvt_pk_f32_fp8((int)gw.x, true), q2 = __builtin_amdgcn_cvt_pk_f32_fp8((int)gw.y, false), q3 = __builtin_amdgcn_cvt_pk_f32_fp8((int)gw.y, true);
        g0 = (f32x4){sigm(q0[0]), sigm(q0[1]), sigm(q1[0]), sigm(q1[1])}; g1 = (f32x4){sigm(q2[0]), sigm(q2[1]), sigm(q3[0]), sigm(q3[1])};
    }
    __device__ __forceinline__ void operator()(f32x4 (&acc)[2][2][4][2], const Unit& u, int wr, int wc, int fr, int fq) const {
#pragma unroll
        for (int ai = 0; ai < 2; ++ai)
#pragma unroll
            for (int m = 0; m < 4; ++m) {
                const int r = EPI_ROW(ai, m); u32x2 wm[2] = {};
#pragma unroll
                for (int bj = 0; bj < 2; ++bj) {
                    const size_t off = (size_t)r * D + EPI_COL(bj);
                    f32x4 b0, b1; gates(SB, off, b0, b1);
#pragma unroll
                    for (int j = 0; j < 4; ++j) { b0[j] = fmaxf(b0[j], 9.094947e-13f); b1[j] = fmaxf(b1[j], 9.094947e-13f); }
                    if (u.be == 0) {
                        f32x4 a0, a1; gates(SA, off, a0, a1);
#pragma unroll
                        for (int j = 0; j < 4; ++j) { acc[ai][bj][m][0][j] *= a0[j] * __builtin_amdgcn_rcpf(b0[j]); acc[ai][bj][m][1][j] *= a1[j] * __builtin_amdgcn_rcpf(b1[j]); }
                    } else {
#if PROJ_FP8
                        wm[bj] = pack8_fp8(acc[ai][bj][m][0] * (b0 * (1.f / WSCALE)), acc[ai][bj][m][1] * (b1 * (1.f / WSCALE)));
#else
                        st16(O + off, pack8(acc[ai][bj][m][0] * b0, acc[ai][bj][m][1] * b1));
#endif
                    }
                }
#if PROJ_FP8
                if (u.be != 0) st16((unsigned char*)O + (size_t)r * D + u.pn * 256 + (fq & 1) * 128 + wc * 32 + 8 * (fq & ~1), pair16(wm[0], wm[1]));
#endif
            }
    }
};
template <> struct EpiTraits<EpiProjP> { static constexpr bool KEEP = true; };
struct EpiWo {
    const bf16_t* X; const float* modl; bf16_t* XO;
    __device__ __forceinline__ void operator()(const ACC_T, const Unit& u, int wr, int wc, int fr, int fq) const {
        const float* g1 = modl + (size_t)(u.pm >> 4) * 6 * D + 2 * D;
#pragma unroll
        for (int bj = 0; bj < 2; ++bj) {
            const int c = EPI_COL(bj); const float us = PROJ_FP8 ? 1.f / (OSCALE * WSCALE) : 1.f; const f32x4 ga = *(const f32x4*)(g1 + c) * us, gb = *(const f32x4*)(g1 + c + 4) * us;
#pragma unroll
            for (int ai = 0; ai < 2; ++ai)
#pragma unroll
                for (int m = 0; m < 4; ++m) { const size_t off = (size_t)EPI_ROW(ai, m) * D + c;
                    f32x4 x0, x1; unpack8(*(const u32x4*)(X + off), x0, x1);
                    st16((XO + off), pack8(x0 + ga * acc[ai][bj][m][0], x1 + gb * acc[ai][bj][m][1])); }
        }
    }
};
struct EpiUp {
    bf16_t* ACT; float inscale;
    __device__ __forceinline__ void operator()(const ACC_T, const Unit& u, int wr, int wc, int fr, int fq) const {
#pragma unroll
        for (int ai = 0; ai < 2; ++ai)
#pragma unroll
            for (int m = 0; m < 4; ++m) {
                f32x4 a = acc[ai][0][m][0] * inscale, b = acc[ai][0][m][1] * inscale; const f32x4 c = acc[ai][1][m][0] * inscale, d = acc[ai][1][m][1] * inscale;
#pragma unroll
                for (int j = 0; j < 4; ++j) { a[j] = a[j] * sigm(a[j]) * c[j]; b[j] = b[j] * sigm(b[j]) * d[j]; }
#if MOE_FP8
                st8((unsigned char*)ACT + (size_t)EPI_ROW(ai, m) * FF + u.pn * 128 + wc * 32 + fq * 8, pack8_fp8(a * 8.f, b * 8.f));
#else
                st16((ACT + (size_t)EPI_ROW(ai, m) * FF + u.pn * 128 + wc * 32 + fq * 8), pack8(a, b));
#endif
            }
    }
};
struct EpiDown {
    bf16_t* Y2; const unsigned* list; const float* gw; float inscale;
    __device__ __forceinline__ void operator()(const ACC_T, const Unit& u, int wr, int wc, int fr, int fq) const {
#pragma unroll
        for (int ai = 0; ai < 2; ++ai)
#pragma unroll
            for (int m = 0; m < 4; ++m) {
                const int rloc = ai * 128 + wr * 64 + m * 16 + fr;
                if (rloc < u.nv) {
                    const unsigned entry = list[(size_t)u.be * T + u.rl * 256 + rloc]; const float w = gw[entry] * inscale;
                    const u32x2 q0 = pack8_fp8(acc[ai][0][m][0] * (w * 16.f), acc[ai][0][m][1] * (w * 16.f)), q1 = pack8_fp8(acc[ai][1][m][0] * (w * 16.f), acc[ai][1][m][1] * (w * 16.f));
                    st16((unsigned char*)Y2 + (size_t)entry * D + u.pn * 256 + (fq & 1) * 128 + wc * 32 + 8 * (fq & ~1), pair16(q0, q1));
                }
            }
    }
};
}

namespace at {
struct Tensors { const bf16_t* Q; int qp; const bf16_t* K; int kp; const bf16_t* V; int vp; bf16_t* O; int op; int group; };
__device__ __forceinline__ bool next_unit(int i, int vcu, int G, int& bh, int& qb) {
    int u;
    if (G == 256) { if (i >= 4) return false; u = (vcu >> 5) * 128 + i * 32 + (vcu & 31); }
    else { u = i * G + vcu; if (u >= 1024) return false; }
    bh = u >> 4; qb = u & 15; return true;
}
template <int DQK>
__device__ __forceinline__ void attn_phase_ref(int tid, const Tensors& A, int vcu, int G) {
    int bh, qb;
    for (int i = 0; next_unit(i, vcu, G, bh, qb); ++i) {
        const int b = bh >> 3, h = bh & 7, kvh = h / A.group;
        {
            const int dh = tid >> 8;
            const size_t row = (size_t)b * S + qb * 256 + (tid & 255);
            float q[DQK], o[32];
#pragma unroll
            for (int d = 0; d < DQK; ++d) q[d] = bf2f(A.Q[row * A.qp + h * DQK + d]);
#pragma unroll
            for (int d = 0; d < 32; ++d) o[d] = 0.f;
            float l = 0.f;
            for (int k = 0; k < S; ++k) {
                const bf16_t* kr = A.K + ((size_t)b * S + k) * A.kp + kvh * DQK; const bf16_t* vr = A.V + ((size_t)b * S + k) * A.vp + kvh * 64 + dh * 32;
                float sc = 0.f;
#pragma unroll
                for (int d = 0; d < DQK; d += 8) { f32x4 k0, k1; unpack8(*(const u32x4*)(kr + d), k0, k1);
                    sc += q[d] * k0[0] + q[d + 1] * k0[1] + q[d + 2] * k0[2] + q[d + 3] * k0[3] + q[d + 4] * k1[0] + q[d + 5] * k1[1] + q[d + 6] * k1[2] + q[d + 7] * k1[3]; }
                const float p = bf2f(cvt_pk_bf16(exp2f(sc), 0.f) & 0xffffu); l += p;
#pragma unroll
                for (int d = 0; d < 32; d += 8) { f32x4 v0, v1; unpack8(*(const u32x4*)(vr + d), v0, v1);
                    o[d] += p * v0[0]; o[d + 1] += p * v0[1]; o[d + 2] += p * v0[2]; o[d + 3] += p * v0[3]; o[d + 4] += p * v1[0]; o[d + 5] += p * v1[1]; o[d + 6] += p * v1[2]; o[d + 7] += p * v1[3]; }
            }
            const float il = 1.f / l;
            __syncthreads();
#pragma unroll
            for (int d = 0; d < 32; d += 8) { f32x4 a = {o[d] * il, o[d + 1] * il, o[d + 2] * il, o[d + 3] * il}, c = {o[d + 4] * il, o[d + 5] * il, o[d + 6] * il, o[d + 7] * il};
                *(u32x4*)(A.O + row * A.op + h * 64 + dh * 32 + d) = pack8(a, c); }
        }
    }
}
#if FAST_ATTN
typedef short s16x4 __attribute__((ext_vector_type(4)));
__device__ __forceinline__ unsigned cvtpk(float lo, float hi) { f32x2 v = {lo, hi}; bf16x2_t b = __builtin_convertvector(v, bf16x2_t); return __builtin_bit_cast(unsigned, b); }
__device__ __forceinline__ s16x4 vtr(const LAS unsigned char* p) { return __builtin_bit_cast(s16x4, __builtin_amdgcn_ds_read_tr16_b64_v4i16((LAS s16x4*)p)); }
__device__ __forceinline__ int crow(int r, int hi) { return (r & 3) + 8 * (r >> 2) + 4 * hi; }
#define AT_BAR() asm volatile("s_barrier" ::: "memory")
#define AT_WAITBAR(N) asm volatile("s_waitcnt vmcnt(" #N ") lgkmcnt(0)\n\ts_barrier" ::: "memory")
#define AT_SCHED() __builtin_amdgcn_sched_barrier(0)
__device__ __forceinline__ void glds16(const void* gsrc, unsigned lds_dst) { unsigned keep;
    asm volatile("s_mov_b32 %0, m0\n\ts_mov_b32 m0, %2\n\ts_nop 0\n\tglobal_load_lds_dwordx4 %1, off\n\ts_mov_b32 m0, %0" : "=&s"(keep) : "v"(gsrc), "s"(lds_dst) : "memory"); }
#define AT_GLDS(g, l) glds16((const void*)(g), (unsigned)__builtin_amdgcn_readfirstlane((int)(unsigned)(uintptr_t)(l)))
template <int DQK>
__device__ __forceinline__ void attn_unit(int tid, LAS unsigned char* lds, const Tensors& A, int b, int h, int qb) {
    constexpr int ND = DQK / 16, NCH = DQK / 8, KSLOT = NCH * 1024, NKD = NCH > 8 ? 2 : 1, VSLOT = 8192, NT = S / 64;
    constexpr int KOFF = 0, VOFF = 3 * KSLOT, OST = VOFF + 3 * VSLOT, WSF = OST + 8 * 4096;
    static_assert(WSF + 8 * 256 <= RING_BYTES, "attention LDS");
    const int lane = tid & 63, r32 = lane & 31, hi = lane >> 5, wid = __builtin_amdgcn_readfirstlane(tid >> 6);
    const int kvh = h / A.group; const size_t rowb = (size_t)b * S;
    const bf16_t* ksrc = A.K + (rowb + lane) * A.kp + kvh * DQK + wid * 8;
    const bf16_t* ksrc2 = A.K + (rowb + lane) * A.kp + kvh * DQK + (8 + (wid & 3)) * 8;
    const bf16_t* vsrc = A.V + (rowb + 16 * (wid & 3) + (lane >> 2)) * A.vp + kvh * 64 + (wid >> 2) * 32 + (lane & 3) * 8;
    const size_t ktile = (size_t)64 * A.kp, vtile = (size_t)64 * A.vp;
    LAS unsigned char* kdst = lds + KOFF + wid * 1024; LAS unsigned char* kdst2 = lds + KOFF + (8 + (wid & 3)) * 1024; LAS unsigned char* vdst = lds + VOFF + wid * 1024;
#define DMA_K(j, so) do { AT_GLDS(ksrc + (size_t)(j) * ktile, kdst + (so)); if (NKD == 2) AT_GLDS(ksrc2 + (size_t)(j) * ktile, kdst2 + (so)); } while (0)
#define DMA_V(j, so) AT_GLDS(vsrc + (size_t)(j) * vtile, vdst + (so))
    const LAS unsigned char* kp0 = lds + KOFF + hi * 1024 + r32 * 16;
    const LAS unsigned char* vp0 = lds + VOFF + ((lane >> 4) & 1) * 32 + (lane & 3) * 8 + (4 * hi + ((lane & 15) >> 2)) * 64;
    DMA_K(0, 0); DMA_V(0, 0); DMA_K(1, KSLOT); DMA_V(1, VSLOT); DMA_K(2, 2 * KSLOT);
    const bf16_t* Qw = A.Q + (rowb + qb * 256 + wid * 32 + r32) * A.qp + h * DQK + hi * 8;
    bf16x8 qr[ND];
#pragma unroll
    for (int d0 = 0; d0 < ND; ++d0) qr[d0] = *(const bf16x8*)(Qw + d0 * 16);
    asm volatile("s_waitcnt vmcnt(0)\n\ts_barrier" ::: "memory");
    bf16x8 kf[2 * ND]; s16x4 vlo[8], vhi[8];
#define KLOAD(so) do { _Pragma("unroll") for (int d0 = 0; d0 < ND; ++d0) { kf[2 * d0] = *(const LAS bf16x8*)(kp0 + (so) + d0 * 2048); kf[2 * d0 + 1] = *(const LAS bf16x8*)(kp0 + (so) + d0 * 2048 + 512); } } while (0)
#define VLOAD(so) do { _Pragma("unroll") for (int i = 0; i < 8; ++i) { vlo[i] = vtr(vp0 + (so) + (i >> 2) * 4096 + (i & 3) * 1024); vhi[i] = vtr(vp0 + (so) + (i >> 2) * 4096 + (i & 3) * 1024 + 512); } } while (0)
#define VFR(i) (bf16x8){vlo[i][0], vlo[i][1], vlo[i][2], vlo[i][3], vhi[i][0], vhi[i][1], vhi[i][2], vhi[i][3]}
    KLOAD(0);
    asm volatile("s_waitcnt lgkmcnt(0)" ::: "memory");
    if (PROBE_ATT != 5 && wid >= 4) AT_BAR();
    f32x16 o0 = {}, o1 = {}, C0, C1; u32x4 pw0, pw1, pw2, pw3; float lsum = 0.f;
    const f32x16 zero = {};
#define QK_BLOCK() do { C0 = __builtin_amdgcn_mfma_f32_32x32x16_bf16(kf[0], qr[0], zero, 0, 0, 0); C1 = __builtin_amdgcn_mfma_f32_32x32x16_bf16(kf[1], qr[0], zero, 0, 0, 0); \
        _Pragma("unroll") for (int d0 = 1; d0 < ND; ++d0) { C0 = __builtin_amdgcn_mfma_f32_32x32x16_bf16(kf[2 * d0], qr[d0], C0, 0, 0, 0); C1 = __builtin_amdgcn_mfma_f32_32x32x16_bf16(kf[2 * d0 + 1], qr[d0], C1, 0, 0, 0); } } while (0)
#define PAF(k) __builtin_bit_cast(bf16x8, pw##k)
#define PV_BLOCK() do { \
        o0 = __builtin_amdgcn_mfma_f32_32x32x16_bf16(PAF(0), VFR(0), o0, 0, 0, 0); o1 = __builtin_amdgcn_mfma_f32_32x32x16_bf16(PAF(0), VFR(4), o1, 0, 0, 0); \
        o0 = __builtin_amdgcn_mfma_f32_32x32x16_bf16(PAF(1), VFR(1), o0, 0, 0, 0); o1 = __builtin_amdgcn_mfma_f32_32x32x16_bf16(PAF(1), VFR(5), o1, 0, 0, 0); \
        o0 = __builtin_amdgcn_mfma_f32_32x32x16_bf16(PAF(2), VFR(2), o0, 0, 0, 0); o1 = __builtin_amdgcn_mfma_f32_32x32x16_bf16(PAF(2), VFR(6), o1, 0, 0, 0); \
        o0 = __builtin_amdgcn_mfma_f32_32x32x16_bf16(PAF(3), VFR(3), o0, 0, 0, 0); o1 = __builtin_amdgcn_mfma_f32_32x32x16_bf16(PAF(3), VFR(7), o1, 0, 0, 0); } while (0)
#define SOFTMAX() do { \
        _Pragma("unroll") for (int r = 0; r < 16; ++r) { C0[r] = __builtin_amdgcn_exp2f(C0[r]); C1[r] = __builtin_amdgcn_exp2f(C1[r]); } \
        f32x2 s0_ = {C0[0], C0[1]}, s1_ = {C1[0], C1[1]}; _Pragma("unroll") for (int r = 2; r < 16; r += 2) { s0_ += (f32x2){C0[r], C0[r + 1]}; s1_ += (f32x2){C1[r], C1[r + 1]}; } s0_ += s1_; lsum += s0_[0] + s0_[1]; \
        pw0 = (u32x4){cvtpk(C0[0], C0[1]), cvtpk(C0[2], C0[3]), cvtpk(C0[4], C0[5]), cvtpk(C0[6], C0[7])}; pw1 = (u32x4){cvtpk(C0[8], C0[9]), cvtpk(C0[10], C0[11]), cvtpk(C0[12], C0[13]), cvtpk(C0[14], C0[15])}; \
        pw2 = (u32x4){cvtpk(C1[0], C1[1]), cvtpk(C1[2], C1[3]), cvtpk(C1[4], C1[5]), cvtpk(C1[6], C1[7])}; pw3 = (u32x4){cvtpk(C1[8], C1[9]), cvtpk(C1[10], C1[11]), cvtpk(C1[12], C1[13]), cvtpk(C1[14], C1[15])}; } while (0)
    int ka = 2 * KSLOT, kb = 0, kc = KSLOT, va = 2 * VSLOT, vb = 0, vc = VSLOT;
#define ROT() do { const int t_ = ka; ka = kb; kb = kc; kc = t_; const int u_ = va; va = vb; vb = vc; vc = u_; } while (0)
#define PINP() asm volatile("" : "+v"(lsum) : "v"(pw0), "v"(pw1), "v"(pw2), "v"(pw3))
#if ATT_REGSTAGE
    u32x4 kst = {}, kst2 = {}, vst = {};
    const LAS unsigned char* kw = lds + KOFF + wid * 1024 + lane * 16; const LAS unsigned char* kw2 = lds + KOFF + (8 + (wid & 3)) * 1024 + lane * 16; const LAS unsigned char* vw = lds + VOFF + wid * 1024 + lane * 16;
#define ST_WRITE(WK, WV) do { if (WK) { *(LAS u32x4*)(kw + ka) = kst; if (NKD == 2 && wid < 4) *(LAS u32x4*)(kw2 + ka) = kst2; } if (WV) *(LAS u32x4*)(vw + vc) = vst; } while (0)
#define ST_LOAD(sv, IK, IV) do { if (IK) { kst = *(const u32x4*)(ksrc + (size_t)((sv) + 4) * ktile); if (NKD == 2 && wid < 4) kst2 = *(const u32x4*)(ksrc2 + (size_t)((sv) + 4) * ktile); } if (IV) vst = *(const u32x4*)(vsrc + (size_t)((sv) + 3) * vtile); } while (0)
#define STEP(sv, DOQK, DOPV, KL, VL, IK, IV, WK, WV) do { \
        AT_SCHED(); if (DOQK) QK_BLOCK(); if (DOPV) PV_BLOCK(); AT_SCHED(); \
        asm volatile("s_barrier\n\ts_nop 15\n\ts_nop 3" : "+v"(C0), "+v"(C1), "+v"(o0), "+v"(o1) :: "memory"); AT_SCHED(); \
        if (KL) KLOAD(kc); if (VL) VLOAD(vb); ST_WRITE(WK, WV); ST_LOAD(sv, IK, IV); \
        if (DOQK) { SOFTMAX(); PINP(); } AT_SCHED(); \
        asm volatile("s_waitcnt lgkmcnt(0)\n\ts_barrier" ::: "memory"); \
        AT_SCHED(); ROT(); } while (0)
    STEP(-1, true, false, true, true, true, true, false, false);
#pragma nounroll
    for (int s = 0; s < NT - 4; ++s) STEP(s, true, true, true, true, true, true, true, true);
    STEP(NT - 4, true, true, true, true, false, true, true, true);
    STEP(NT - 3, true, true, true, true, false, false, false, true);
    STEP(NT - 2, true, true, false, true, false, false, false, false);
    STEP(NT - 1, false, true, false, false, false, false, false, false);
#undef ST_WRITE
#undef ST_LOAD
#else
#define STEP(sv, DOQK, DOPV, KL, VL, IK, IV) do { \
        AT_SCHED(); if (DOQK) QK_BLOCK(); if (DOPV) PV_BLOCK(); AT_SCHED(); \
          \
        asm volatile("s_barrier\n\ts_nop 15\n\ts_nop 3" : "+v"(C0), "+v"(C1), "+v"(o0), "+v"(o1) :: "memory"); AT_SCHED(); \
        if (KL) KLOAD(kc); if (VL) VLOAD(vb); if (IK) DMA_K((sv) + 4, kb); if (IV) DMA_V((sv) + 3, va); \
        if (DOQK) { SOFTMAX(); PINP(); } AT_SCHED(); \
        if (IK) { if (NKD == 2) { AT_WAITBAR(3); } else { AT_WAITBAR(2); } } else if (IV) { AT_WAITBAR(1); } else { AT_WAITBAR(0); } \
        AT_SCHED(); ROT(); } while (0)
    STEP(-1, true, false, true, true, true, true);
#pragma nounroll
    for (int s = 0; s < NT - 4; ++s) STEP(s, true, true, true, true, true, true);
    STEP(NT - 4, true, true, true, true, false, true);
    STEP(NT - 3, true, true, true, true, false, false);
    STEP(NT - 2, true, true, false, true, false, false);
    STEP(NT - 1, false, true, false, false, false, false);
#endif
#undef STEP
#undef PINP
    if (PROBE_ATT != 5 && wid < 4) AT_BAR();
    { auto rr = __builtin_amdgcn_permlane32_swap(__float_as_uint(lsum), __float_as_uint(lsum), false, false); lsum = __uint_as_float(rr[0]) + __uint_as_float(rr[1]); }
    LAS float* wsf = (LAS float*)(lds + WSF + wid * 256);
    if (hi == 0) wsf[r32] = lsum;
    asm volatile("s_waitcnt lgkmcnt(0)" ::: "memory");
    LAS bf16_t* stg = (LAS bf16_t*)(lds + OST + wid * 4096);
#pragma unroll
    for (int r = 0; r < 16; ++r) { const int orow = crow(r, hi); const float rl = __builtin_amdgcn_rcpf(wsf[orow]);
        stg[orow * 64 + r32] = (bf16_t)(cvtpk(o0[r] * rl, 0.f) & 0xffffu); stg[orow * 64 + 32 + r32] = (bf16_t)(cvtpk(o1[r] * rl, 0.f) & 0xffffu); }
    asm volatile("s_waitcnt lgkmcnt(0)" ::: "memory");
    bf16_t* Ow = A.O + (rowb + qb * 256 + wid * 32) * A.op + h * 64;
#pragma unroll
    for (int i = 0; i < 4; ++i) { const int row = i * 8 + (lane >> 3), ch = lane & 7; const u32x4 v = *(const LAS u32x4*)(stg + row * 64 + ch * 8); st16((Ow + (size_t)row * A.op + ch * 8), v); }
    asm volatile("s_waitcnt lgkmcnt(0)\n\ts_barrier" ::: "memory");
#undef DMA_K
#undef DMA_V
#undef KLOAD
#undef VLOAD
#undef VFR
#undef QK_BLOCK
#undef PAF
#undef PV_BLOCK
#undef SOFTMAX
#undef ROT
}
#endif
#if FAST_ATTN && ATT_FP8_A
typedef int v8i __attribute__((ext_vector_type(8)));
#define SPLAT16(x) ((f32x16){x, x, x, x, x, x, x, x, x, x, x, x, x, x, x, x})
__device__ __forceinline__ f32x16 mfma8(v8i a, v8i b, f32x16 c) { return __builtin_amdgcn_mfma_scale_f32_32x32x64_f8f6f4(a, b, c, 0, 0, 0, 0, 0, 0); }
__device__ __forceinline__ f32x16 mfma8pv(v8i a, v8i b, f32x16 c) { return __builtin_amdgcn_mfma_scale_f32_32x32x64_f8f6f4(a, b, c, 1, 0, 0, 0, 0, 0); }
__device__ __forceinline__ void attn_unit_f8a(int tid, LAS unsigned char* lds, const unsigned char* Q8, const unsigned char* K8, const unsigned char* VT8, bf16_t* O, int op, int b, int h, int qb, float bias) {
    constexpr int SL = 4096, NT = S / 64;
    constexpr int KOFF = 0, VOFF = 4 * SL, OST = VOFF + 4 * SL, WSF = OST + 8 * 4096;
    const int lane = tid & 63, r32 = lane & 31, hi = lane >> 5, wid = __builtin_amdgcn_readfirstlane(tid >> 6);
    const int kvh = h >> 2; const size_t rowb = (size_t)b * S; const bool kw = wid < 4;
    const unsigned char* src = kw ? K8 + (rowb + lane) * 128 + kvh * 64 + 16 * wid : VT8 + ((size_t)((b * 2 + kvh) * 64 + lane)) * S + 16 * (wid - 4);
    const size_t tstep = kw ? (size_t)64 * 128 : (size_t)64;
    LAS unsigned char* dst = lds + (kw ? KOFF + wid * 1024 : VOFF + (wid - 4) * 1024);
#define DMA8(j, so) AT_GLDS(src + (size_t)(j) * tstep, dst + (so))
    const LAS unsigned char* kp0 = lds + KOFF + (2 * hi) * 1024 + r32 * 16;
    const LAS unsigned char* vp0 = lds + VOFF + (2 * hi) * 1024 + r32 * 16;
    DMA8(0, 0); DMA8(1, SL); DMA8(2, 2 * SL);
    v8i qf; { const unsigned char* Qw = Q8 + (rowb + qb * 256 + wid * 32 + r32) * 512 + h * 64 + 32 * hi; const u32x4 a = *(const u32x4*)Qw, c = *(const u32x4*)(Qw + 16);
        qf = (v8i){(int)a.x, (int)a.y, (int)a.z, (int)a.w, (int)c.x, (int)c.y, (int)c.z, (int)c.w}; }
    asm volatile("s_waitcnt vmcnt(0)\n\ts_barrier" ::: "memory");
    v8i kf0, kf1, vf0, vf1, p8;
#define LD32(dstv, p) do { const u32x4 a_ = *(const LAS u32x4*)(p), c_ = *(const LAS u32x4*)((p) + 1024); dstv = (v8i){(int)a_.x, (int)a_.y, (int)a_.z, (int)a_.w, (int)c_.x, (int)c_.y, (int)c_.z, (int)c_.w}; } while (0)
#define KLOAD8(so) do { LD32(kf0, kp0 + (so)); LD32(kf1, kp0 + (so) + 512); } while (0)
#define VLOAD8(so) do { LD32(vf0, vp0 + (so)); LD32(vf1, vp0 + (so) + 512); } while (0)
    KLOAD8(0);
    asm volatile("s_waitcnt lgkmcnt(0)" ::: "memory");
    if (wid >= 4) AT_BAR();
    float z_ = 0.f; asm volatile("" : "+v"(z_));
    f32x16 o0 = SPLAT16(z_), o1 = SPLAT16(z_), o2 = SPLAT16(z_), C0, C1;
    const v8i ones = {0x38383838, 0x38383838, 0x38383838, 0x38383838, 0x38383838, 0x38383838, 0x38383838, 0x38383838};
    f32x16 negb;
#pragma unroll
    for (int r = 0; r < 16; ++r) negb[r] = PFOLD * bias + PBYTE0;
    asm volatile("" : "+v"(negb));
#define SOFTMAX8() do { \
        _Pragma("unroll") for (int i = 0; i < 4; ++i) { \
            const f32x2 a_ = (f32x2){C0[4 * i], C0[4 * i + 1]}, b_ = (f32x2){C0[4 * i + 2], C0[4 * i + 3]}, c_ = (f32x2){C1[4 * i], C1[4 * i + 1]}, d_ = (f32x2){C1[4 * i + 2], C1[4 * i + 3]}; \
            p8[i] = (int)__builtin_amdgcn_cvt_pk_u8_f32(b_[1], 3, __builtin_amdgcn_cvt_pk_u8_f32(b_[0], 2, __builtin_amdgcn_cvt_pk_u8_f32(a_[1], 1, __builtin_amdgcn_cvt_pk_u8_f32(a_[0], 0, 0u)))); \
            p8[4 + i] = (int)__builtin_amdgcn_cvt_pk_u8_f32(d_[1], 3, __builtin_amdgcn_cvt_pk_u8_f32(d_[0], 2, __builtin_amdgcn_cvt_pk_u8_f32(c_[1], 1, __builtin_amdgcn_cvt_pk_u8_f32(c_[0], 0, 0u)))); } } while (0)
#define STEP8(sv, DOQK2, DOSM, DOPV, KL, VL, ISS, WN, NOPS) do { \
        AT_SCHED(); \
        if (KL) { LD32(kf0, kp0 + (((sv) + 2) & 3) * SL); LD32(kf1, kp0 + (((sv) + 2) & 3) * SL + 512); } AT_SCHED(); \
        if (DOPV) { o0 = mfma8pv(p8, vf0, o0); } if (VL) LD32(vf0, vp0 + (((sv) + 1) & 3) * SL); AT_SCHED(); \
        if (DOPV) { o1 = mfma8pv(p8, vf1, o1); } if (VL) LD32(vf1, vp0 + (((sv) + 1) & 3) * SL + 512); AT_SCHED(); \
        if (DOPV) { o2 = mfma8pv(p8, ones, o2); } if (ISS) DMA8((sv) + 4, (((sv) + 4) & 3) * SL); AT_SCHED(); \
        asm volatile("s_barrier\n\t" NOPS : "+v"(C0), "+v"(C1), "+v"(o0), "+v"(o1), "+v"(o2) :: "memory"); AT_SCHED(); \
        if (DOSM) { SOFTMAX8(); asm volatile("" :: "v"(p8)); } AT_SCHED(); \
        if (DOQK2) { asm volatile("s_waitcnt lgkmcnt(0)" ::: "memory"); C0 = mfma8(kf0, qf, negb); C1 = mfma8(kf1, qf, negb); } AT_SCHED(); \
        asm volatile("s_waitcnt vmcnt(" #WN ") lgkmcnt(0)\n\ts_barrier" : "+v"(C0), "+v"(C1), "+v"(o0), "+v"(o1), "+v"(o2) :: "memory"); \
        AT_SCHED(); } while (0)
    C0 = mfma8(kf0, qf, negb); C1 = mfma8(kf1, qf, negb);
    STEP8(-1, true, true, false, true, true, true, 1, "s_nop 15\n\ts_nop 15");
#pragma nounroll
    for (int s = 0; s < NT - 4; ++s) STEP8(s, true, true, true, true, true, true, 1, "s_nop 1");
    STEP8(NT - 4, true, true, true, true, true, false, 0, "s_nop 1");
    STEP8(NT - 3, true, true, true, true, true, false, 0, "s_nop 1");
    STEP8(NT - 2, false, true, true, false, true, false, 0, "s_nop 15\n\ts_nop 15");
    STEP8(NT - 1, false, false, true, false, false, false, 0, "s_nop 15\n\ts_nop 15");
    if (wid < 4) AT_BAR();
#if PROJ_FP8
    LAS unsigned char* stg8 = lds + OST + wid * 4096;
#pragma unroll
    for (int r = 0; r < 16; ++r) { const int orow = crow(r, hi); const float rl = __builtin_amdgcn_rcpf(o2[r]) * OSCALE;
        const unsigned pk = (unsigned)__builtin_amdgcn_cvt_pk_fp8_f32(o0[r] * rl, o1[r] * rl, 0, false);
        stg8[orow * 64 + r32] = (unsigned char)(pk & 0xffu); stg8[orow * 64 + 32 + r32] = (unsigned char)((pk >> 8) & 0xffu); }
    asm volatile("s_waitcnt lgkmcnt(0)" ::: "memory");
    unsigned char* Ow8 = (unsigned char*)O + (rowb + qb * 256 + wid * 32) * op + h * 64;
#pragma unroll
    for (int i = 0; i < 2; ++i) { const int idx = i * 64 + lane, row = idx >> 2, ch = idx & 3; const u32x4 v = *(const LAS u32x4*)(stg8 + row * 64 + ch * 16); st16(Ow8 + (size_t)row * op + ch * 16, v); }
#else
    LAS bf16_t* stg = (LAS bf16_t*)(lds + OST + wid * 4096);
#pragma unroll
    for (int r = 0; r < 16; ++r) { const int orow = crow(r, hi); const float rl = __builtin_amdgcn_rcpf(o2[r]);
        stg[orow * 64 + r32] = (bf16_t)(cvtpk(o0[r] * rl, 0.f) & 0xffffu); stg[orow * 64 + 32 + r32] = (bf16_t)(cvtpk(o1[r] * rl, 0.f) & 0xffffu); }
    asm volatile("s_waitcnt lgkmcnt(0)" ::: "memory");
    bf16_t* Ow = O + (rowb + qb * 256 + wid * 32) * op + h * 64;
#pragma unroll
    for (int i = 0; i < 4; ++i) { const int row = i * 8 + (lane >> 3), ch = lane & 7; const u32x4 v = *(const LAS u32x4*)(stg + row * 64 + ch * 8); st16(Ow + (size_t)row * op + ch * 8, v); }
    #endif
    asm volatile("s_waitcnt lgkmcnt(0)\n\ts_barrier" ::: "memory");
#undef DMA8
#undef LD32
#undef KLOAD8
#undef VLOAD8
#undef SOFTMAX8
#undef STEP8
}
__device__ __forceinline__ void attn_phase_f8a(int tid, LAS unsigned char* lds, const unsigned char* Q8, const unsigned char* K8, const unsigned char* VT8, bf16_t* O, int op, const float* gq, const float* gk, int vcu, int G) {
    float mq = 0.f, mk = 0.f;
    for (int i = 0; i < 64; ++i) { mq = fmaxf(mq, fabsf(gq[i])); mk = fmaxf(mk, fabsf(gk[i])); }
    const float bias = -fmaxf(64.f * mq * mk * QSCALE_A * 1.13f - 15.5f, 0.f);
    int bh, qb;
    for (int i = 0; next_unit(i, vcu, G, bh, qb); ++i) attn_unit_f8a(tid, lds, Q8, K8, VT8, O, op, bh >> 3, bh & 7, qb, bias);
}
#endif
#if FAST_ATTN && ATT_FP8_B
__device__ __forceinline__ void attn_unit_f8b(int tid, LAS unsigned char* lds, const unsigned char* Q8, const unsigned char* K8, const unsigned char* VT8, bf16_t* O, int op, int b, int h, int qb) {
    constexpr int SLK = 6144, SLV = 4096, NT = S / 64;
    constexpr int KOFF = 0, VOFF = 4 * SLK, OST = VOFF + 4 * SLV, WSF = OST + 8 * 4096;
    static_assert(WSF + 2048 <= RING_BYTES, "attention LDS");
    const int lane = tid & 63, r32 = lane & 31, hi = lane >> 5, wid = __builtin_amdgcn_readfirstlane(tid >> 6);
    const size_t rowb = (size_t)b * S; const bool kw = wid < 6, vw = wid >= 4;
    const unsigned char* ksrc = K8 + (rowb + lane) * 768 + h * 96 + 16 * wid;
    const unsigned char* vsrc = VT8 + ((size_t)((b * 8 + h) * 64 + lane)) * S + 16 * (wid - 4);
    LAS unsigned char* kdst = lds + KOFF + wid * 1024; LAS unsigned char* vdst = lds + VOFF + (wid - 4) * 1024;
#define DMAK(j, so) AT_GLDS(ksrc + (size_t)(j) * (64 * 768), kdst + (so))
#define DMAV(j, so) AT_GLDS(vsrc + (size_t)(j) * 64, vdst + (so))
    const LAS unsigned char* kp0 = lds + KOFF + (2 * hi) * 1024 + r32 * 16;
    const LAS unsigned char* kr0 = lds + KOFF + 4 * 1024 + r32 * 16;
    const LAS unsigned char* vp0 = lds + VOFF + (2 * hi) * 1024 + r32 * 16;
    if (kw) { DMAK(0, 0); DMAK(1, SLK); DMAK(2, 2 * SLK); DMAK(3, 3 * SLK); }
    if (vw) { DMAV(0, 0); DMAV(1, SLV); DMAV(2, 2 * SLV); }
    v8i qn, qr;
    { const unsigned char* Qw = Q8 + (rowb + qb * 256 + wid * 32 + r32) * 768 + h * 96; const u32x4 a = *(const u32x4*)(Qw + 32 * hi), c = *(const u32x4*)(Qw + 32 * hi + 16), e = *(const u32x4*)(Qw + 64), f = *(const u32x4*)(Qw + 80);
      qn = (v8i){(int)a.x, (int)a.y, (int)a.z, (int)a.w, (int)c.x, (int)c.y, (int)c.z, (int)c.w};
      qr = hi ? (v8i){0, 0, 0, 0, 0, 0, 0, 0} : (v8i){(int)e.x, (int)e.y, (int)e.z, (int)e.w, (int)f.x, (int)f.y, (int)f.z, (int)f.w}; }
    asm volatile("s_waitcnt vmcnt(0)\n\ts_barrier" ::: "memory");
    v8i kn0, kn1, kr0v, kr1v, vf0, vf1, p8;
#define LD32(dstv, p) do { const u32x4 a_ = *(const LAS u32x4*)(p), c_ = *(const LAS u32x4*)((p) + 1024); dstv = (v8i){(int)a_.x, (int)a_.y, (int)a_.z, (int)a_.w, (int)c_.x, (int)c_.y, (int)c_.z, (int)c_.w}; } while (0)
#define KLOAD8(so) do { LD32(kn0, kp0 + (so)); LD32(kn1, kp0 + (so) + 512); LD32(kr0v, kr0 + (so)); LD32(kr1v, kr0 + (so) + 512); } while (0)
#define VLOAD8(so) do { LD32(vf0, vp0 + (so)); LD32(vf1, vp0 + (so) + 512); } while (0)
    KLOAD8(0);
    asm volatile("s_waitcnt lgkmcnt(0)" ::: "memory");
    if (wid >= 4) AT_BAR();
    f32x16 o0 = {}, o1 = {}, o2 = {}, C0, C1; f32x16 zero;
#pragma unroll
    for (int r = 0; r < 16; ++r) zero[r] = PBYTE0;
    asm volatile("" : "+v"(zero));
    const v8i ones = {0x38383838, 0x38383838, 0x38383838, 0x38383838, 0x38383838, 0x38383838, 0x38383838, 0x38383838};
#define SOFTMAX8() do { \
        _Pragma("unroll") for (int i = 0; i < 4; ++i) { \
            const f32x2 a_ = (f32x2){C0[4 * i], C0[4 * i + 1]}, b_ = (f32x2){C0[4 * i + 2], C0[4 * i + 3]}, c_ = (f32x2){C1[4 * i], C1[4 * i + 1]}, d_ = (f32x2){C1[4 * i + 2], C1[4 * i + 3]}; \
            p8[i] = (int)__builtin_amdgcn_cvt_pk_u8_f32(b_[1], 3, __builtin_amdgcn_cvt_pk_u8_f32(b_[0], 2, __builtin_amdgcn_cvt_pk_u8_f32(a_[1], 1, __builtin_amdgcn_cvt_pk_u8_f32(a_[0], 0, 0u)))); \
            p8[4 + i] = (int)__builtin_amdgcn_cvt_pk_u8_f32(d_[1], 3, __builtin_amdgcn_cvt_pk_u8_f32(d_[0], 2, __builtin_amdgcn_cvt_pk_u8_f32(c_[1], 1, __builtin_amdgcn_cvt_pk_u8_f32(c_[0], 0, 0u)))); } } while (0)
#define STEP8(sv, DOQK, DOPV, KL, VL, IK, IV, WK, WV, WB, NOPS) do { \
        AT_SCHED(); if (DOQK) { C0 = mfma8(kn0, qn, zero); C1 = mfma8(kn1, qn, zero); C0 = mfma8(kr0v, qr, C0); C1 = mfma8(kr1v, qr, C1); } if (DOPV) { o0 = mfma8pv(p8, vf0, o0); o1 = mfma8pv(p8, vf1, o1); o2 = mfma8pv(p8, ones, o2); } AT_SCHED(); \
        asm volatile("s_barrier\n\t" NOPS : "+v"(C0), "+v"(C1), "+v"(o0), "+v"(o1), "+v"(o2) :: "memory"); AT_SCHED(); \
        if (KL) KLOAD8((((sv) + 2) & 3) * SLK); if (VL) VLOAD8((((sv) + 1) & 3) * SLV); \
        if (kw && (IK)) DMAK((sv) + 5, (((sv) + 1) & 3) * SLK); if (vw && (IV)) DMAV((sv) + 4, ((sv) & 3) * SLV); \
        if (DOQK) { SOFTMAX8(); asm volatile("" :: "v"(p8)); } AT_SCHED(); \
        if (kw && vw) { AT_WAITBAR(WB); } else if (kw) { AT_WAITBAR(WK); } else { AT_WAITBAR(WV); } \
        AT_SCHED(); } while (0)
    STEP8(-1, true, false, true, true, true, true, 2, 2, 4, "s_nop 15\n\ts_nop 15");
#pragma nounroll
    for (int s = 0; s < NT - 5; ++s) STEP8(s, true, true, true, true, true, true, 2, 2, 4, "s_nop 1");
    STEP8(NT - 5, true, true, true, true, false, true, 1, 2, 3, "s_nop 15\n\ts_nop 15");
    STEP8(NT - 4, true, true, true, true, false, false, 0, 1, 1, "s_nop 15\n\ts_nop 15");
    STEP8(NT - 3, true, true, true, true, false, false, 0, 0, 0, "s_nop 15\n\ts_nop 15");
    STEP8(NT - 2, true, true, false, true, false, false, 0, 0, 0, "s_nop 15\n\ts_nop 15");
    STEP8(NT - 1, false, true, false, false, false, false, 0, 0, 0, "s_nop 15\n\ts_nop 15");
    if (wid < 4) AT_BAR();
#if PROJ_FP8
    LAS unsigned char* stg8 = lds + OST + wid * 4096;
#pragma unroll
    for (int r = 0; r < 16; ++r) { const int orow = crow(r, hi); const float rl = __builtin_amdgcn_rcpf(o2[r]) * OSCALE;
        const unsigned pk = (unsigned)__builtin_amdgcn_cvt_pk_fp8_f32(o0[r] * rl, o1[r] * rl, 0, false);
        stg8[orow * 64 + r32] = (unsigned char)(pk & 0xffu); stg8[orow * 64 + 32 + r32] = (unsigned char)((pk >> 8) & 0xffu); }
    asm volatile("s_waitcnt lgkmcnt(0)" ::: "memory");
    unsigned char* Ow8 = (unsigned char*)O + (rowb + qb * 256 + wid * 32) * op + h * 64;
#pragma unroll
    for (int i = 0; i < 2; ++i) { const int idx = i * 64 + lane, row = idx >> 2, ch = idx & 3; const u32x4 v = *(const LAS u32x4*)(stg8 + row * 64 + ch * 16); st16(Ow8 + (size_t)row * op + ch * 16, v); }
#else
    LAS bf16_t* stg = (LAS bf16_t*)(lds + OST + wid * 4096);
#pragma unroll
    for (int r = 0; r < 16; ++r) { const int orow = crow(r, hi); const float rl = __builtin_amdgcn_rcpf(o2[r]);
        stg[orow * 64 + r32] = (bf16_t)(cvtpk(o0[r] * rl, 0.f) & 0xffffu); stg[orow * 64 + 32 + r32] = (bf16_t)(cvtpk(o1[r] * rl, 0.f) & 0xffffu); }
    asm volatile("s_waitcnt lgkmcnt(0)" ::: "memory");
    bf16_t* Ow = O + (rowb + qb * 256 + wid * 32) * op + h * 64;
#pragma unroll
    for (int i = 0; i < 4; ++i) { const int row = i * 8 + (lane >> 3), ch = lane & 7; const u32x4 v = *(const LAS u32x4*)(stg + row * 64 + ch * 8); st16(Ow + (size_t)row * op + ch * 8, v); }
    #endif
    asm volatile("s_waitcnt lgkmcnt(0)\n\ts_barrier" ::: "memory");
#undef DMAK
#undef DMAV
#undef LD32
#undef KLOAD8
#undef VLOAD8
#undef SOFTMAX8
#undef STEP8
}
__device__ __forceinline__ void attn_phase_f8b(int tid, LAS unsigned char* lds, const unsigned char* Q8, const unsigned char* K8, const unsigned char* VT8, bf16_t* O, int op, int vcu, int G) {
    int bh, qb;
    for (int i = 0; next_unit(i, vcu, G, bh, qb); ++i) attn_unit_f8b(tid, lds, Q8, K8, VT8, O, op, bh >> 3, bh & 7, qb);
}
#endif
template <int DQK>
__device__ __forceinline__ void attn_phase(int tid, LAS unsigned char* lds, const Tensors& A, int vcu, int G) {
#if FAST_ATTN
    int bh, qb;
    for (int i = 0; next_unit(i, vcu, G, bh, qb); ++i) attn_unit<DQK>(tid, lds, A, bh >> 3, bh & 7, qb);
#else
    (void)lds; attn_phase_ref<DQK>(tid, A, vcu, G);
#endif
}
}


struct Args { const float* in[22]; float* out; unsigned char* ws; int ph_lo, ph_hi; };
struct Frame {
    LAS unsigned char* lds; volatile LAS unsigned* MISC; unsigned* ctl;
    int tid, lane, wave, vcu, G;
    unsigned char* ws; float* OUT;
};

__device__ __forceinline__ void p0_phase(Frame& F, const float* c, const float* w_ada, const float* b_ada) {
    LAS float* cs = (LAS float*)F.lds;
    LAS float* red = (LAS float*)(F.lds + 32768);
    for (int i = F.tid; i < NB * D; i += NTHREADS) { const float v = c[i]; cs[i] = v / (1.f + __expf(-v)); }
    __syncthreads();
    float* mod = (float*)(F.ws + WS_MOD);
    const int kq = F.wave, col = F.lane;
    for (int item = F.vcu; item < NL * 6 * D / 64; item += F.G) {
        const int l = item / (6 * D / 64), n0 = (item % (6 * D / 64)) * 64;
        const float* w = w_ada + (size_t)l * D * 6 * D + n0 + col;
        float acc[NB];
#pragma unroll
        for (int b = 0; b < NB; ++b) acc[b] = 0.f;
#pragma unroll 8
        for (int k = kq * 128; k < kq * 128 + 128; ++k) { const float wv = w[(size_t)k * 6 * D];
#pragma unroll
            for (int b = 0; b < NB; ++b) acc[b] += cs[b * D + k] * wv; }
#pragma unroll
        for (int b = 0; b < NB; ++b) red[(kq * NB + b) * 64 + col] = acc[b];
        __syncthreads();
        { const int b = F.wave; float s = 0.f;
#pragma unroll
          for (int q = 0; q < 8; ++q) s += red[(q * NB + b) * 64 + col];
          mod[((size_t)l * NB + b) * 6 * D + n0 + col] = s + b_ada[(size_t)l * 6 * D + n0 + col]; }
        __syncthreads();
    }
    float* cosA = (float*)(F.ws + WS_COSA); float* sinA = (float*)(F.ws + WS_SINA); float* cosB = (float*)(F.ws + WS_COSB); float* sinB = (float*)(F.ws + WS_SINB);
    for (int idx = F.vcu * NTHREADS + F.tid; idx < S * 48; idx += F.G * NTHREADS) {
        const int s = idx / 48, i = idx % 48; const float row = (float)(s >> 6), col2 = (float)(s & 63);
        if (i < 32) { const int j = i & 15; const float a = (i < 16 ? row : col2) * (1.0f / powf(10000.0f, (float)j / 16.0f)); cosA[s * 32 + i] = cosf(a); sinA[s * 32 + i] = sinf(a); }
        else { const int ii = i - 32, j = ii & 7; const float a = (ii < 8 ? row : col2) * (1.0f / powf(10000.0f, (float)j / 8.0f)); cosB[s * 16 + ii] = cosf(a); sinB[s * 16 + ii] = sinf(a); }
    }
}

template <class SrcFn>
__device__ __forceinline__ void cvt_item(const float* W, int K, int Nsrc, const float* kg, bf16_t* WT, LAS float* scr, int item, int nblk, int lane, const SrcFn& src, float f8scale = 0.f) {
    const int kb = item / nblk, nb = item % nblk, k0 = 64 * kb, n0 = 32 * nb;
    const int sc = src(n0 + (lane & 31));
#pragma unroll
    for (int i = 0; i < 32; ++i) { const int kk = 2 * i + (lane >> 5); float v = sc >= 0 ? W[(size_t)(k0 + kk) * Nsrc + sc] : 0.f; if (kg) v *= kg[k0 + kk]; scr[kk * 33 + (lane & 31)] = v; }
    LDS_WAIT(); asm volatile("" ::: "memory");
    const int c = lane & 7;
    if (f8scale != 0.f) {
#pragma unroll
        for (int j = 0; j < 4; ++j) { const int n = (lane >> 3) + 8 * j; const LAS float* sp = scr + (8 * c) * 33 + n;
            const u32x2 o = pack8_fp8((f32x4){sp[0 * 33], sp[1 * 33], sp[2 * 33], sp[3 * 33]} * f8scale, (f32x4){sp[4 * 33], sp[5 * 33], sp[6 * 33], sp[7 * 33]} * f8scale);
            *(u32x2*)((unsigned char*)WT + (size_t)(n0 + n) * K + k0 + 8 * c) = o; }
    } else {
#pragma unroll
    for (int j = 0; j < 4; ++j) { const int n = (lane >> 3) + 8 * j; const LAS float* s = scr + (8 * c) * 33 + n;
        u32x4 o; o.x = cvt_pk_bf16(s[0 * 33], s[1 * 33]); o.y = cvt_pk_bf16(s[2 * 33], s[3 * 33]); o.z = cvt_pk_bf16(s[4 * 33], s[5 * 33]); o.w = cvt_pk_bf16(s[6 * 33], s[7 * 33]);
        *(u32x4*)(WT + (size_t)(n0 + n) * K + k0 + 8 * c) = o; }
    }
    LDS_WAIT(); asm volatile("" ::: "memory");
}
struct SrcId { __device__ int operator()(int n) const { return n; } };
struct SrcIn { __device__ int operator()(int n) const { return gp::src_col_in(n); } };
typedef __attribute__((address_space(4))) const Args CArgsW;
__device__ __forceinline__ void convert_weights(Frame& F, CArgsW* a, int l) {
    LAS float* scr = (LAS float*)(F.lds + F.wave * 16384);
    const int gw = F.vcu * NWAVES + F.wave, NGW = F.G * NWAVES;
    const float* w_in = ((const float*)(GAS const float*)a->in[5]) + (size_t)l * D * INC; const float* w_q_b = ((const float*)(GAS const float*)a->in[10]) + (size_t)l * 384 * 768; const float* w_kv_b = ((const float*)(GAS const float*)a->in[11]) + (size_t)l * 256 * 1024;
    const float* w_pa = ((const float*)(GAS const float*)a->in[12]) + (size_t)l * 512 * D; const float* w_pb = ((const float*)(GAS const float*)a->in[13]) + (size_t)l * 512 * D; const float* w_o = ((const float*)(GAS const float*)a->in[14]) + (size_t)l * D * D;
    const float* w1 = ((const float*)(GAS const float*)a->in[18]) + (size_t)l * NE * D * FF; const float* w3 = ((const float*)(GAS const float*)a->in[19]) + (size_t)l * NE * D * FF; const float* w2 = ((const float*)(GAS const float*)a->in[20]) + (size_t)l * NE * FF * D;
    const float* gqa = ((const float*)(GAS const float*)a->in[8]) + l * 384; const float* gkv = ((const float*)(GAS const float*)a->in[9]) + l * 256;
    bf16_t* Win = (bf16_t*)(F.ws + WS_WIN); bf16_t* Wqb = (bf16_t*)(F.ws + WS_WQB); bf16_t* Wkvb = (bf16_t*)(F.ws + WS_WKVB); bf16_t* Wpa = (bf16_t*)(F.ws + WS_WPA); bf16_t* Wpb = (bf16_t*)(F.ws + WS_WPB);
    bf16_t* Wo = (bf16_t*)(F.ws + WS_WO); bf16_t* W13 = (bf16_t*)(F.ws + WS_W13); bf16_t* W2 = (bf16_t*)(F.ws + WS_W2);
    constexpr int I_IN = (D / 64) * (NIN / 32), I_QB = (384 / 64) * (768 / 32), I_KVB = (256 / 64) * (1024 / 32), I_P = (512 / 64) * (D / 32), I_O = (D / 64) * (D / 32);
    constexpr int I_13 = (D / 64) * (1024 / 32), I_2 = (FF / 64) * (D / 32);
    constexpr int NITEMS = I_IN + I_QB + I_KVB + 2 * I_P + I_O + NE * (I_13 + I_2);
    for (int it = gw; it < NITEMS; it += NGW) {
        int r = it;
        if (r < I_IN) { cvt_item(w_in, D, INC, nullptr, Win, scr, r, NIN / 32, F.lane, SrcIn(), G1_FP8 ? 16.f : 0.f); continue; } r -= I_IN;
        if (r < I_QB) { cvt_item(w_q_b, 384, 768, gqa, Wqb, scr, r, 768 / 32, F.lane, SrcId()); continue; } r -= I_QB;
        if (r < I_KVB) { cvt_item(w_kv_b, 256, 1024, gkv, Wkvb, scr, r, 1024 / 32, F.lane, SrcId()); continue; } r -= I_KVB;
        if (r < I_P) { cvt_item(w_pa, 512, D, nullptr, Wpa, scr, r, D / 32, F.lane, SrcId(), PROJ_FP8 ? WSCALE : 0.f); continue; } r -= I_P;
        if (r < I_P) { cvt_item(w_pb, 512, D, nullptr, Wpb, scr, r, D / 32, F.lane, SrcId(), PROJ_FP8 ? WSCALE : 0.f); continue; } r -= I_P;
        if (r < I_O) { cvt_item(w_o, D, D, nullptr, Wo, scr, r, D / 32, F.lane, SrcId(), PROJ_FP8 ? WSCALE : 0.f); continue; } r -= I_O;
        if (r < NE * I_13) { const int e = r / I_13, q = r % I_13, nb = q % 32;
            const float* src = ((nb & 7) < 4 ? w1 : w3) + (size_t)e * D * FF; const int cb = (nb >> 3) * 128 + (nb & 3) * 32;
            struct SrcOff { int n0, cb; __device__ int operator()(int n) const { return cb + (n - n0); } } so{nb * 32, cb};
            if (MOE_FP8) cvt_item(src, D, FF, nullptr, (bf16_t*)((unsigned char*)W13 + (size_t)e * 1024 * D), scr, q, 32, F.lane, so, 16.f);
            else cvt_item(src, D, FF, nullptr, W13 + (size_t)e * 1024 * D, scr, q, 32, F.lane, so);
            continue; } r -= NE * I_13;
        { const int e = r / I_2, q = r % I_2;
          if (MOE_FP8) cvt_item(w2 + (size_t)e * FF * D, FF, D, nullptr, (bf16_t*)((unsigned char*)W2 + (size_t)e * D * FF), scr, q, D / 32, F.lane, SrcId(), 16.f);
          else cvt_item(w2 + (size_t)e * FF * D, FF, D, nullptr, W2 + (size_t)e * D * FF, scr, q, D / 32, F.lane, SrcId()); }
    }
}

template <int MODE>
__device__ __forceinline__ void row_phase(Frame& F, const float* xin, const float* g2prev, const float* gain, const float* modl, int sh_off, int sc_off, bf16_t* H, bf16_t* XB, float* OUT) {
    constexpr int RB = 4, RPW = T / (256 * NWAVES);
    const int gw = F.vcu * NWAVES + F.wave, b = (gw * RPW) >> 12;
    const bf16_t* Y2 = (const bf16_t*)(F.ws + WS_Y2);
    f32x4 gs[4], shv[4], g2v[4];
#pragma unroll
    for (int j = 0; j < 4; ++j) { const int c = 4 * F.lane + 256 * j; gs[j] = *(const f32x4*)(gain + c);
        if (MODE != 2) { gs[j] = gs[j] * (1.f + *(const f32x4*)(modl + (size_t)b * 6 * D + sc_off + c)); shv[j] = *(const f32x4*)(modl + (size_t)b * 6 * D + sh_off + c); }
        if (MODE != 0) g2v[j] = *(const f32x4*)(g2prev + (size_t)b * 6 * D + 5 * D + c); }
    for (int m0 = gw * RPW; m0 < gw * RPW + RPW; m0 += RB) {
        f32x4 v[RB][4]; float ss[RB];
        if (MODE == 0) {
#pragma unroll
            for (int r = 0; r < RB; ++r)
#pragma unroll
                for (int j = 0; j < 4; ++j) v[r][j] = *(const f32x4*)(xin + (size_t)(m0 + r) * D + 4 * F.lane + 256 * j);
        } else {
            unsigned ya[RB][4], yb[RB][4];
#pragma unroll
            for (int r = 0; r < RB; ++r)
#pragma unroll
                for (int j = 0; j < 4; ++j) { const int m = m0 + r, c = 4 * F.lane + 256 * j;
                    { const u32x2 xb = *(const u32x2*)(XB + (size_t)m * D + c); v[r][j] = (f32x4){bf2f(xb.x & 0xffffu), bf2f(xb.x >> 16), bf2f(xb.y & 0xffffu), bf2f(xb.y >> 16)}; }
                    ya[r][j] = *(const unsigned*)((const unsigned char*)Y2 + (size_t)(2 * m) * D + c); yb[r][j] = *(const unsigned*)((const unsigned char*)Y2 + (size_t)(2 * m + 1) * D + c); }
#pragma unroll
            for (int r = 0; r < RB; ++r)
#pragma unroll
                for (int j = 0; j < 4; ++j) { const f32x2 a0 = __builtin_amdgcn_cvt_pk_f32_fp8((int)ya[r][j], false), a1 = __builtin_amdgcn_cvt_pk_f32_fp8((int)ya[r][j], true), b0 = __builtin_amdgcn_cvt_pk_f32_fp8((int)yb[r][j], false), b1 = __builtin_amdgcn_cvt_pk_f32_fp8((int)yb[r][j], true);
                    const f32x4 y = (f32x4){a0[0] + b0[0], a0[1] + b0[1], a1[0] + b1[0], a1[1] + b1[1]} * 0.0625f;
                    v[r][j] += g2v[j] * y; }
        }
#pragma unroll
        for (int r = 0; r < RB; ++r) { ss[r] = (gp::dot4(v[r][0]) + gp::dot4(v[r][1])) + (gp::dot4(v[r][2]) + gp::dot4(v[r][3])); }
#pragma unroll
        for (int o = 1; o < 64; o <<= 1)
#pragma unroll
            for (int r = 0; r < RB; ++r) ss[r] += __shfl_xor(ss[r], o);
#pragma unroll
        for (int r = 0; r < RB; ++r) {
            const int m = m0 + r; const float rstd = rsqrtf(ss[r] * (1.f / D) + EPS);
#pragma unroll
            for (int j = 0; j < 4; ++j) {
                const int c = 4 * F.lane + 256 * j;
                if (MODE == 2) { *(f32x4*)(OUT + (size_t)m * D + c) = v[r][j] * rstd * gs[j]; }
                else {
                    { u32x2 xw; xw.x = cvt_pk_bf16(v[r][j][0], v[r][j][1]); xw.y = cvt_pk_bf16(v[r][j][2], v[r][j][3]); st8((XB + (size_t)m * D + c), xw); }
                    const f32x4 hv = v[r][j] * rstd * gs[j] + shv[j];
                    if (G1_FP8) { const f32x4 hq = hv * 0.0625f;
                        *(unsigned*)((unsigned char*)H + (size_t)m * D + c) = (unsigned)__builtin_amdgcn_cvt_pk_fp8_f32(hq[2], hq[3], __builtin_amdgcn_cvt_pk_fp8_f32(hq[0], hq[1], 0, false), true); }
                    else { u32x2 w; w.x = cvt_pk_bf16(hv[0], hv[1]); w.y = cvt_pk_bf16(hv[2], hv[3]);
                    st8((H + (size_t)m * D + c), w); }
                }
            }
        }
    }
}

__device__ __forceinline__ void t2_phase(Frame& F, const float* gain, const float* modl, const float* w_router, const float* rbias, int l, bool record) {
    LAS f32x4* wl = (LAS f32x4*)F.lds;
    LAS int* rec = (LAS int*)(F.lds + 65536);
    LAS float* recw = (LAS float*)(F.lds + 65536 + 2048);
    LAS int* lcnt = (LAS int*)(F.lds + 65536 + 4096);
    for (int idx = F.tid; idx < 4096; idx += NTHREADS) {
        const int lane = idx & 63, c = (idx >> 6) & 3, i = (idx >> 8) & 3, j = idx >> 10; const int k = 4 * lane + 256 * j + i;
        wl[idx] = *(const f32x4*)(w_router + (size_t)k * NE + 4 * c);
    }
    if (F.tid < 32) lcnt[F.tid] = 0;
    __syncthreads();
    constexpr int RB = 4, RPW = T / (256 * NWAVES);
    const int gw = F.vcu * NWAVES + F.wave, bt = (gw * RPW) >> 12;
    bf16_t* H = (bf16_t*)(F.ws + WS_H); const bf16_t* XB = (const bf16_t*)(F.ws + WS_XB);
    const int lane = F.lane, myrow = lane >> 4, mye = lane & 15;
    f32x4 gs[4], shv[4];
#pragma unroll
    for (int j = 0; j < 4; ++j) { const int c = 4 * lane + 256 * j; gs[j] = *(const f32x4*)(gain + c) * (1.f + *(const f32x4*)(modl + (size_t)bt * 6 * D + 4 * D + c)); shv[j] = *(const f32x4*)(modl + (size_t)bt * 6 * D + 3 * D + c); }
    int it = 0;
    for (int m0 = gw * RPW; m0 < gw * RPW + RPW; m0 += RB, ++it) {
        f32x4 v[RB][4]; float ss[RB];
#pragma unroll
        for (int r = 0; r < RB; ++r)
#pragma unroll
            for (int j = 0; j < 4; ++j) { const u32x2 xb = *(const u32x2*)(XB + (size_t)(m0 + r) * D + 4 * lane + 256 * j); v[r][j] = (f32x4){bf2f(xb.x & 0xffffu), bf2f(xb.x >> 16), bf2f(xb.y & 0xffffu), bf2f(xb.y >> 16)}; }
#pragma unroll
        for (int r = 0; r < RB; ++r) ss[r] = (gp::dot4(v[r][0]) + gp::dot4(v[r][1])) + (gp::dot4(v[r][2]) + gp::dot4(v[r][3]));
#pragma unroll
        for (int o = 1; o < 64; o <<= 1)
#pragma unroll
            for (int r = 0; r < RB; ++r) ss[r] += __shfl_xor(ss[r], o);
        float acc[RB * NE];
#pragma unroll
        for (int q = 0; q < RB * NE; ++q) acc[q] = 0.f;
#pragma unroll
        for (int j = 0; j < 4; ++j) {
            const int c = 4 * lane + 256 * j;
#pragma unroll
            for (int r = 0; r < RB; ++r) {
                const int m = m0 + r; const float rstd = rsqrtf(ss[r] * (1.f / D) + EPS);
                v[r][j] = v[r][j] * rstd * gs[j] + shv[j];
#if MOE_FP8
                *(unsigned*)((unsigned char*)H + (size_t)m * D + c) = (unsigned)__builtin_amdgcn_cvt_pk_fp8_f32(v[r][j][2], v[r][j][3], __builtin_amdgcn_cvt_pk_fp8_f32(v[r][j][0], v[r][j][1], 0, false), true);
#else
                u32x2 w; w.x = cvt_pk_bf16(v[r][j][0], v[r][j][1]); w.y = cvt_pk_bf16(v[r][j][2], v[r][j][3]);
                st8((H + (size_t)m * D + c), w);
#endif
            }
#pragma unroll
            for (int i = 0; i < 4; ++i)
#pragma unroll
                for (int c4 = 0; c4 < 4; ++c4) { const f32x4 wv = wl[((j * 4 + i) * 4 + c4) * 64 + lane];
#pragma unroll
                    for (int r = 0; r < RB; ++r) { const float hv = v[r][j][i];
                        acc[r * NE + 4 * c4 + 0] += hv * wv[0]; acc[r * NE + 4 * c4 + 1] += hv * wv[1]; acc[r * NE + 4 * c4 + 2] += hv * wv[2]; acc[r * NE + 4 * c4 + 3] += hv * wv[3]; } }
        }
#pragma unroll
        for (int sft = 32; sft >= 1; sft >>= 1) {
            const bool up = (lane & sft) != 0;
#pragma unroll
            for (int k = 0; k < sft; ++k) { const float a = acc[k], b = acc[k + sft]; const float keep = up ? b : a, send = up ? a : b; acc[k] = keep + __shfl_xor(send, sft); }
        }
        const float logit = acc[0];
        const float score = 1.f / (1.f + expf(-logit));
        float scv[NE], bi[NE];
#pragma unroll
        for (int e = 0; e < NE; ++e) { scv[e] = __shfl(score, (lane & 48) | e); bi[e] = scv[e] + rbias[e]; }
        int gsel = 0; float gbest = -INFINITY;
#pragma unroll
        for (int g = 0; g < 4; ++g) { float m1 = -INFINITY, m2 = -INFINITY;
#pragma unroll
            for (int j = 0; j < 4; ++j) { const float x = bi[g * 4 + j]; if (x > m1) { m2 = m1; m1 = x; } else if (x > m2) m2 = x; }
            const float gs = m1 + m2; if (gs > gbest) { gbest = gs; gsel = g; } }
        int e1 = -1, e2 = -1; float b1 = -INFINITY, b2 = -INFINITY, s1 = 0.f, s2 = 0.f;
#pragma unroll
        for (int j = 0; j < 4; ++j) { float x = -INFINITY, sx = 0.f;
#pragma unroll
            for (int g = 0; g < 4; ++g) if (g == gsel) { x = bi[g * 4 + j]; sx = scv[g * 4 + j]; }
            const int e = gsel * 4 + j;
            if (x > b1) { b2 = b1; e2 = e1; s2 = s1; b1 = x; e1 = e; s1 = sx; } else if (x > b2) { b2 = x; e2 = e; s2 = sx; } }
        if (mye == 0) {
            const float inv = 1.f / (s1 + s2); const int slot = (it * RB + myrow) * NWAVES + F.wave;
            rec[slot * 4 + 0] = e1; rec[slot * 4 + 1] = e2;
            rec[slot * 4 + 2] = __hip_atomic_fetch_add(&lcnt[e1], 1, __ATOMIC_RELAXED, __HIP_MEMORY_SCOPE_WORKGROUP);
            rec[slot * 4 + 3] = __hip_atomic_fetch_add(&lcnt[e2], 1, __ATOMIC_RELAXED, __HIP_MEMORY_SCOPE_WORKGROUP);
            recw[slot * 2 + 0] = s1 * inv; recw[slot * 2 + 1] = s2 * inv;
        }
    }
    __syncthreads();
    if (!record) return;
    if (F.tid < NE) lcnt[16 + F.tid] = (int)__hip_atomic_fetch_add(F.ctl + CW_CNT + (l * NE + F.tid) * 64, (unsigned)lcnt[F.tid], __ATOMIC_RELAXED, __HIP_MEMORY_SCOPE_AGENT);
    __syncthreads();
    unsigned* list = (unsigned*)(F.ws + WS_LIST); float* gwb = (float*)(F.ws + WS_GW);
    const int nrows = it * RB;
    for (int s = F.tid; s < nrows * NWAVES; s += NTHREADS) {
        const int i2 = s / NWAVES, w = s % NWAVES; const int m = (F.vcu * NWAVES + w) * RPW + i2;
        const int e1 = rec[s * 4 + 0], e2 = rec[s * 4 + 1];
        list[(size_t)e1 * T + lcnt[16 + e1] + rec[s * 4 + 2]] = (unsigned)(2 * m); list[(size_t)e2 * T + lcnt[16 + e2] + rec[s * 4 + 3]] = (unsigned)(2 * m + 1);
        gwb[2 * m] = recw[s * 2]; gwb[2 * m + 1] = recw[s * 2 + 1];
    }
}
__device__ __forceinline__ LAS int* moe_table(Frame& F, int l) {
    LAS int* tab = (LAS int*)(F.lds + MISC_OFF + 1024);
    __syncthreads();
    if (F.tid == 0) { int acc = 0;
        for (int e = 0; e < NE; ++e) { const int c = (int)__hip_atomic_load(F.ctl + CW_CNT + (l * NE + e) * 64, __ATOMIC_RELAXED, __HIP_MEMORY_SCOPE_AGENT); tab[e] = acc; tab[32 + e] = c; acc += (c + 255) >> 8; }
        tab[16] = acc; }
    __syncthreads();
    return tab;
}

typedef __attribute__((address_space(4))) const Args CArgs;
#define LAUNDER_GP(T_, p) do { GAS T_* _t = (GAS T_*)(p); asm volatile("" : "+s"(_t)); (p) = (T_*)_t; } while (0)
#define PH_BEGIN() LAUNDER_V(F.tid); F.lane = F.tid & 63; LAUNDER_GP(unsigned, F.ctl); LAUNDER_GP(float, F.OUT); LAUNDER_GP(unsigned char, F.ws); GAS unsigned char* ws = (GAS unsigned char*)F.ws; CArgs* ka = (CArgs*)__builtin_amdgcn_kernarg_segment_ptr(); LAUNDER_S(ka); \
    float* mod = WSP(float, WS_MOD); (void)mod; (void)ka
#define WSP(T_, off) ((T_*)(GAS T_*)(ws + (off)))
#define KIN(i) ((const float*)(GAS const float*)ka->in[i])
__global__ void __launch_bounds__(NTHREADS, 2) fwd_kernel(Args args) {
    extern __shared__ __attribute__((aligned(16))) unsigned char lds_raw[];
    Frame F;
    F.lds = (LAS unsigned char*)lds_raw; F.MISC = (volatile LAS unsigned*)(F.lds + MISC_OFF);
    F.tid = threadIdx.x; F.lane = F.tid & 63; F.wave = __builtin_amdgcn_readfirstlane(F.tid >> 6);
    F.G = gridDim.x; { const int bx = blockIdx.x; F.vcu = (F.G % 8 == 0) ? (bx % 8) * (F.G / 8) + bx / 8 : bx; }
    F.ws = (unsigned char*)(GAS unsigned char*)args.ws; F.ctl = (unsigned*)(GAS unsigned*)(args.ws + WS_CTL); F.OUT = (float*)(GAS float*)args.out;
    if (F.tid < 64) F.MISC[F.tid] = 0u;
    __syncthreads();
    XcdBarrier bar; bar.bar = F.ctl + CW_BAR; bar.x = 0; bar.st = nullptr;
    if (!N_LAUNCH_MODE) bar = xcd_barrier_post(F.ctl + CW_BAR, F.MISC + 8);
    const int lo = args.ph_lo, hi = args.ph_hi;
#define IN(k) (lo <= (k) && (k) < hi)
#define SEAM(k) do { if ((k) + 1 < hi) { if (!N_LAUNCH_MODE) xcd_barrier(bar); } } while (0)
    const int cidx = (int)blockIdx.x;

    if (IN(0)) { PH_BEGIN(); p0_phase(F, KIN(1), KIN(2), KIN(3)); __syncthreads(); LAUNDER_V(F.tid); F.lane = F.tid & 63; convert_weights(F, ka, 0); SEAM(0); }
    for (int l = 0; l < NL; ++l) {
        const int pb = 1 + 9 * l;
        if (IN(pb + 0)) {
            PH_BEGIN();
            if (l > 0) for (int rep = 0; rep < ((PROBE_DUP & 8) ? 2 : 1); ++rep) { LAUNDER_V(F.tid); F.lane = F.tid & 63; convert_weights(F, ka, l); }
            if (l == 0) row_phase<0>(F, KIN(0), nullptr, KIN(4) + l * D, mod + (size_t)l * NB * 6 * D, 0, D, WSP(bf16_t, WS_H), WSP(bf16_t, WS_XB), nullptr);
            else row_phase<1>(F, nullptr, mod + (size_t)(l - 1) * NB * 6 * D, KIN(4) + l * D, mod + (size_t)l * NB * 6 * D, 0, D, WSP(bf16_t, WS_H), WSP(bf16_t, WS_XB), nullptr);
            SEAM(pb + 0);
        }
        if (IN(pb + 1)) {
            PH_BEGIN();
            gp::Gemm g{WSP(bf16_t, WS_H), WSP(const bf16_t, WS_WIN), G1_FP8 ? D / 2 : D, 0, nullptr, 0, 0, 0}; gp::DenseOrder So; So.init(T, NIN, F.G, cidx);
            gp::EpiIn E{WSP(bf16_t, ATT_FP8_A ? WS_QA8 : WS_QA), WSP(bf16_t, ATT_FP8_A ? WS_KA8 : WS_KA), WSP(bf16_t, ATT_FP8_A ? WS_VTA8 : WS_VA), WSP(bf16_t, WS_QLAT), WSP(bf16_t, WS_KVLAT), WSP(bf16_t, ATT_FP8_B ? WS_KB8 : WS_KB), WSP(bf16_t, WS_SA), WSP(bf16_t, WS_SB), WSP(float, WS_SSQ), WSP(float, WS_SSKV),
                        KIN(6) + l * 64, KIN(7) + l * 64, WSP(const float, WS_COSA), WSP(const float, WS_SINA), WSP(const float, WS_COSB), WSP(const float, WS_SINB)};
            if (PROBE_DUP & 128) { gp::EpiNull En; gp::gemm_phase<gp::EpiNull, gp::DenseOrder>(F.tid, F.lds, g, So, En); LAUNDER_V(F.tid); }
            gp::gemm_phase<gp::EpiIn, gp::DenseOrder, false, G1_FP8 != 0>(F.tid, F.lds, g, So, E); if (PROBE_DUP & (2 | 512)) { LAUNDER_V(F.tid); gp::gemm_phase<gp::EpiIn, gp::DenseOrder, false, G1_FP8 != 0>(F.tid, F.lds, g, So, E); }
            SEAM(pb + 1);
        }
        if (IN(pb + 2)) {
            { PH_BEGIN(); gp::Gemm g{WSP(bf16_t, WS_QLAT), WSP(const bf16_t, WS_WQB), 384, 0, nullptr}; gp::DenseOrder So; So.init(T, 768, F.G, cidx);
              gp::EpiQb E{WSP(bf16_t, ATT_FP8_B ? WS_QB8 : WS_QB), WSP(const float, WS_SSQ), WSP(const float, WS_COSB), WSP(const float, WS_SINB)}; gp::gemm_phase<gp::EpiQb, gp::DenseOrder>(F.tid, F.lds, g, So, E); if (PROBE_DUP & 2) { LAUNDER_V(F.tid); gp::gemm_phase<gp::EpiQb, gp::DenseOrder>(F.tid, F.lds, g, So, E); } }
            { PH_BEGIN(); gp::Gemm g{WSP(bf16_t, WS_KVLAT), WSP(const bf16_t, WS_WKVB), 256, 0, nullptr}; gp::DenseOrder So; So.init(T, 1024, F.G, F.G - 1 - cidx);
              gp::EpiKvb E{WSP(bf16_t, ATT_FP8_B ? WS_KB8 : WS_KB), WSP(bf16_t, ATT_FP8_B ? WS_VTB8 : WS_VB), WSP(const float, WS_SSKV)}; gp::gemm_phase<gp::EpiKvb, gp::DenseOrder>(F.tid, F.lds, g, So, E); if (PROBE_DUP & 2) { LAUNDER_V(F.tid); gp::gemm_phase<gp::EpiKvb, gp::DenseOrder>(F.tid, F.lds, g, So, E); } }
#if FAST_ATTN && ATT_FP8_A
            { PH_BEGIN(); at::attn_phase_f8a(F.tid, F.lds, WSP(const unsigned char, WS_QA8), WSP(const unsigned char, WS_KA8), WSP(const unsigned char, WS_VTA8), WSP(bf16_t, WS_QA), 512, KIN(6) + l * 64, KIN(7) + l * 64, F.vcu, F.G); }
            if (PROBE_DUP & (1 | 4096)) { PH_BEGIN(); at::attn_phase_f8a(F.tid, F.lds, WSP(const unsigned char, WS_QA8), WSP(const unsigned char, WS_KA8), WSP(const unsigned char, WS_VTA8), WSP(bf16_t, WS_QA), 512, KIN(6) + l * 64, KIN(7) + l * 64, F.vcu, F.G); }
#else
            { PH_BEGIN(); const at::Tensors A{WSP(bf16_t, WS_QA), 512, WSP(bf16_t, WS_KA), 128, WSP(bf16_t, WS_VA), 128, WSP(bf16_t, WS_QA), 512, 4}; at::attn_phase<64>(F.tid, F.lds, A, F.vcu, F.G); }
#endif
            SEAM(pb + 2);
        }
        if (IN(pb + 3)) {
            PH_BEGIN();
#if FAST_ATTN && ATT_FP8_B
            at::attn_phase_f8b(F.tid, F.lds, WSP(const unsigned char, WS_QB8), WSP(const unsigned char, WS_KB8), WSP(const unsigned char, WS_VTB8), WSP(bf16_t, WS_OB), 512, F.vcu, F.G);
            if (PROBE_DUP & (1 | 8192)) { LAUNDER_V(F.tid); at::attn_phase_f8b(F.tid, F.lds, WSP(const unsigned char, WS_QB8), WSP(const unsigned char, WS_KB8), WSP(const unsigned char, WS_VTB8), WSP(bf16_t, WS_OB), 512, F.vcu, F.G); }
#else
            const at::Tensors A{WSP(bf16_t, WS_QB), 768, WSP(bf16_t, WS_KB), 768, WSP(bf16_t, WS_VB), 512, WSP(bf16_t, WS_OB), 512, 1}; for (int rep = 0; rep < ((PROBE_DUP & 1) ? 2 : 1); ++rep) at::attn_phase<96>(F.tid, F.lds, A, F.vcu, F.G);
#endif
            SEAM(pb + 3);
        }
        if (IN(pb + 4)) {
            PH_BEGIN();
            gp::Gemm g{WSP(bf16_t, WS_QA), WSP(const bf16_t, WS_WPA), PROJ_FP8 ? 256 : 512, (size_t)(WS_WPB - WS_WPA) / 2, nullptr, (size_t)(WS_OB - WS_QA) / 2, 0, 0}; gp::PairOrder So; So.init(T, D, F.G, cidx);
            gp::EpiProjP E{WSP(bf16_t, WS_H), WSP(const unsigned char, WS_SA), WSP(const unsigned char, WS_SB)};
            gp::gemm_phase<gp::EpiProjP, gp::PairOrder, false, PROJ_FP8 != 0>(F.tid, F.lds, g, So, E);
            if (PROBE_DUP & (2 | 1024)) { LAUNDER_V(F.tid); gp::gemm_phase<gp::EpiProjP, gp::PairOrder, false, PROJ_FP8 != 0>(F.tid, F.lds, g, So, E); }
            SEAM(pb + 4);
        }
        if (IN(pb + 5)) {
            PH_BEGIN();
            gp::Gemm g{WSP(bf16_t, WS_H), WSP(const bf16_t, WS_WO), PROJ_FP8 ? D / 2 : D, 0, nullptr, 0, 0, 0}; gp::DenseOrder So; So.init(T, D, F.G, cidx);
            if (PROBE_DUP & 2048) { gp::EpiNull En; gp::gemm_phase<gp::EpiNull, gp::DenseOrder>(F.tid, F.lds, g, So, En); LAUNDER_V(F.tid); }
            gp::EpiWo E{WSP(const bf16_t, WS_XB), mod + (size_t)l * NB * 6 * D, WSP(bf16_t, WS_XB)}; gp::gemm_phase<gp::EpiWo, gp::DenseOrder, false, PROJ_FP8 != 0>(F.tid, F.lds, g, So, E);
            SEAM(pb + 5);
        }
        if (IN(pb + 6)) {
            PH_BEGIN();
            if (PROBE_DUP & 16) { t2_phase(F, KIN(15) + l * D, mod + (size_t)l * NB * 6 * D, KIN(16), KIN(17), l, false); LAUNDER_V(F.tid); F.lane = F.tid & 63; __syncthreads(); }
            t2_phase(F, KIN(15) + l * D, mod + (size_t)l * NB * 6 * D, KIN(16), KIN(17), l, true);
            SEAM(pb + 6);
        }
        if (IN(pb + 7)) {
            PH_BEGIN();
            LAS int* tab = moe_table(F, l);
#if MOE_FP8
            gp::Gemm g{WSP(bf16_t, WS_H), WSP(const bf16_t, WS_W13), D / 2, (size_t)1024 * D / 2, WSP(const unsigned, WS_LIST), 0, 0, 0}; gp::MoeOrder So; So.init(tab, F.G, cidx);
            gp::EpiUp E{WSP(bf16_t, WS_ACT), 1.f / 16.f}; gp::gemm_phase<gp::EpiUp, gp::MoeOrder, true, true>(F.tid, F.lds, g, So, E);
            if (PROBE_DUP & 4) { LAUNDER_V(F.tid); gp::gemm_phase<gp::EpiUp, gp::MoeOrder, true, true>(F.tid, F.lds, g, So, E); }
#else
            gp::Gemm g{WSP(bf16_t, WS_H), WSP(const bf16_t, WS_W13), D, (size_t)1024 * D, WSP(const unsigned, WS_LIST)}; gp::MoeOrder So; So.init(tab, F.G, cidx);
            gp::EpiUp E{WSP(bf16_t, WS_ACT), 1.f}; gp::gemm_phase<gp::EpiUp, gp::MoeOrder, true>(F.tid, F.lds, g, So, E);
#endif
            SEAM(pb + 7);
        }
        if (IN(pb + 8)) {
            PH_BEGIN();
            LAS int* tab = moe_table(F, l);
#if MOE_FP8
            gp::Gemm g{WSP(bf16_t, WS_ACT), WSP(const bf16_t, WS_W2), FF / 2, (size_t)D * FF / 2, nullptr, 0, 0, 0}; gp::MoeOrder So; So.init(tab, F.G, cidx);
            gp::EpiDown E{WSP(bf16_t, WS_Y2), WSP(const unsigned, WS_LIST), WSP(const float, WS_GW), 1.f / 128.f}; gp::gemm_phase<gp::EpiDown, gp::MoeOrder, false, true>(F.tid, F.lds, g, So, E);
            if (PROBE_DUP & 4) { LAUNDER_V(F.tid); gp::gemm_phase<gp::EpiDown, gp::MoeOrder, false, true>(F.tid, F.lds, g, So, E); }
#else
            gp::Gemm g{WSP(bf16_t, WS_ACT), WSP(const bf16_t, WS_W2), FF, (size_t)D * FF, nullptr}; gp::MoeOrder So; So.init(tab, F.G, cidx);
            gp::EpiDown E{WSP(bf16_t, WS_Y2), WSP(const unsigned, WS_LIST), WSP(const float, WS_GW), 1.f}; gp::gemm_phase<gp::EpiDown, gp::MoeOrder, false>(F.tid, F.lds, g, So, E);
#endif
            SEAM(pb + 8);
        }
    }
    if (IN(NPHASE - 1)) { PH_BEGIN(); row_phase<2>(F, nullptr, mod + (size_t)(NL - 1) * NB * 6 * D, KIN(21), nullptr, 0, 0, nullptr, WSP(bf16_t, WS_XB), F.OUT); }
#undef IN
#undef SEAM
}

extern "C" void kernel_launch(void* const* d_in, const int* in_sizes, int n_in, void* d_out, int out_size, void* d_ws, size_t ws_size, hipStream_t stream) {
    static int grid = 0;
    if (grid == 0) {
        if (n_in != 22 || out_size != T * D || ws_size < WS_END) { fprintf(stderr, "kernel_launch: unexpected problem (n_in %d out %d ws %zu)\n", n_in, out_size, ws_size); grid = -1; return; }
        int dev = 0, cus = 0, per_cu = 0;
        if (hipGetDevice(&dev) != hipSuccess || hipDeviceGetAttribute(&cus, hipDeviceAttributeMultiprocessorCount, dev) != hipSuccess) { grid = -1; return; }
        if (hipFuncSetAttribute((const void*)fwd_kernel, hipFuncAttributeMaxDynamicSharedMemorySize, LDS_BYTES) != hipSuccess) { grid = -1; return; }
        if (hipOccupancyMaxActiveBlocksPerMultiprocessor(&per_cu, (const void*)fwd_kernel, NTHREADS, LDS_BYTES) != hipSuccess || per_cu < 1) { fprintf(stderr, "kernel_launch: occupancy query says %d\n", per_cu); }
        (void)hipGetLastError();
        grid = cus;
        if (grid != 256 || T % (grid * NWAVES * 4) != 0) {   fprintf(stderr, "kernel_launch: grid %d does not divide the row phases\n", grid); grid = -1; return; }
    }
    if (grid < 0) return;
    (void)hipMemsetAsync((char*)d_ws + WS_CTL, 0, CTL_BYTES, stream);
    Args a{};
    for (int i = 0; i < 22; ++i) a.in[i] = (const float*)d_in[i];
    a.out = (float*)d_out; a.ws = (unsigned char*)d_ws;
#if N_LAUNCH_MODE
    for (int p = 0; p < NPHASE; ++p) { a.ph_lo = p; a.ph_hi = p + 1; hipLaunchKernelGGL(fwd_kernel, dim3(grid), dim3(NTHREADS), LDS_BYTES, stream, a); }
#else
    a.ph_lo = 0; a.ph_hi = NPHASE;
    hipLaunchKernelGGL(fwd_kernel, dim3(grid), dim3(NTHREADS), LDS_BYTES, stream, a);
#endif
}
```

```cpp
#include <hip/hip_runtime.h>
#include <stdint.h>
#include <stdio.h>
#include <math.h>

#ifndef FAST_GEMM
#define FAST_GEMM 1
#endif
#ifndef FAST_ATTN
#define FAST_ATTN 1
#endif
#ifndef PROBE_DUP
#define PROBE_DUP 0
#endif
#ifndef PROBE_ATT
#define PROBE_ATT 0
#endif
#ifndef ATT_REGSTAGE
#define ATT_REGSTAGE 0
#endif
#ifndef WT_STORES
#define WT_STORES 0
#endif
#ifndef ATT_FP8_A
#define ATT_FP8_A 1
#endif
#ifndef ATT_FP8_B
#define ATT_FP8_B 1
#endif
#ifndef MOE_FP8
#define MOE_FP8 1
#endif
#ifndef G1_FP8
#define G1_FP8 1
#endif
#ifndef PROJ_FP8
#define PROJ_FP8 1
#endif
#ifndef N_LAUNCH_MODE
#define N_LAUNCH_MODE 0
#endif

#define LAS __attribute__((address_space(3)))
#define GAS __attribute__((address_space(1)))
typedef unsigned short bf16_t;
typedef short bf16x8 __attribute__((ext_vector_type(8)));
typedef float f32x4 __attribute__((ext_vector_type(4)));
typedef float f32x2 __attribute__((ext_vector_type(2)));
typedef float f32x16 __attribute__((ext_vector_type(16)));
typedef unsigned u32x4 __attribute__((ext_vector_type(4)));
typedef unsigned u32x2 __attribute__((ext_vector_type(2)));
typedef GAS unsigned gu32;

constexpr int D = 1024, NB = 8, S = 4096, T = NB * S, NL = 4, INC = 3488, NIN = 3584, NE = 16, FF = 512;
constexpr float EPS = 1e-6f, LOG2E = 1.4426950408889634f;
constexpr float QSCALE_A = 0.125f * LOG2E, QSCALE_B = 0.10206207261596577f * LOG2E;
constexpr float PFOLD = 4.f, PBYTE0 = 60.26f;
constexpr float OSCALE = 64.f, WSCALE = 16.f;
constexpr int NWAVES = 8, NTHREADS = 512;
constexpr int NPHASE = 2 + 9 * NL;

constexpr size_t MiB = 1u << 20;
constexpr size_t WS_CTL = 0, CTL_BYTES = 1 * MiB;
constexpr size_t WS_MOD = 1 * MiB;
constexpr size_t WS_COSA = 2 * MiB, WS_SINA = WS_COSA + 512 * 1024, WS_COSB = 3 * MiB, WS_SINB = WS_COSB + 256 * 1024;
constexpr size_t WS_SSQ = 4 * MiB, WS_SSKV = 5 * MiB;
constexpr size_t WS_GW = 6 * MiB;
constexpr size_t WS_LIST = 7 * MiB;
constexpr size_t WS_WIN = 10 * MiB, WS_WQB = 17 * MiB, WS_WKVB = 18 * MiB, WS_WPA = 19 * MiB, WS_WPB = 20 * MiB, WS_WO = 21 * MiB, WS_W13 = 23 * MiB, WS_W2 = 55 * MiB;
constexpr size_t WS_H = 72 * MiB;
constexpr size_t WS_QA = 136 * MiB, WS_KA = 168 * MiB, WS_VA = 176 * MiB, WS_QLAT = 184 * MiB, WS_KVLAT = 208 * MiB;
constexpr size_t WS_KB = 224 * MiB, WS_VB = 272 * MiB, WS_QB = 304 * MiB, WS_OB = 352 * MiB, WS_SA = 384 * MiB, WS_SB = 448 * MiB, WS_XB = 512 * MiB, WS_QA8 = 576 * MiB, WS_KA8 = 592 * MiB, WS_VTA8 = 596 * MiB, WS_QB8 = 600 * MiB, WS_KB8 = 624 * MiB, WS_VTB8 = 648 * MiB, WS_END = 664 * MiB;
constexpr size_t WS_ACT = 136 * MiB, WS_Y2 = 208 * MiB;
constexpr int ACT_ROWS = 2 * T + NE * 256;
static_assert(WS_ACT + (size_t)ACT_ROWS * FF * 2 <= WS_Y2 && WS_Y2 + (size_t)2 * T * D * 2 <= WS_XB, "moe overlay");
constexpr int CW_BAR = 4096;
constexpr int CW_CNT = 16384;

constexpr int RING_BYTES = 131072, MISC_OFF = RING_BYTES, LDS_BYTES = 147456;

__device__ __forceinline__ float bf2f(unsigned v) { return __uint_as_float(v << 16); }
typedef __bf16 bf16x2_t __attribute__((ext_vector_type(2)));
__device__ __forceinline__ unsigned cvt_pk_bf16(float lo, float hi) { f32x2 v = {lo, hi}; bf16x2_t b = __builtin_convertvector(v, bf16x2_t); return __builtin_bit_cast(unsigned, b); }
__device__ __forceinline__ u32x4 pack8(f32x4 a, f32x4 b) { u32x4 w; w.x = cvt_pk_bf16(a[0], a[1]); w.y = cvt_pk_bf16(a[2], a[3]); w.z = cvt_pk_bf16(b[0], b[1]); w.w = cvt_pk_bf16(b[2], b[3]); return w; }
__device__ __forceinline__ u32x2 pack8_fp8(f32x4 a, f32x4 b) { u32x2 w;
    w.x = (unsigned)__builtin_amdgcn_cvt_pk_fp8_f32(a[2], a[3], __builtin_amdgcn_cvt_pk_fp8_f32(a[0], a[1], 0, false), true);
    w.y = (unsigned)__builtin_amdgcn_cvt_pk_fp8_f32(b[2], b[3], __builtin_amdgcn_cvt_pk_fp8_f32(b[0], b[1], 0, false), true); return w; }
__device__ __forceinline__ u32x4 pair16(u32x2 w0, u32x2 w1) {
    const auto x = __builtin_amdgcn_permlane16_swap(w0.x, w1.x, false, false); const auto y = __builtin_amdgcn_permlane16_swap(w0.y, w1.y, false, false);
    return (u32x4){x[0], y[0], x[1], y[1]};
}
__device__ __forceinline__ void unpack8(u32x4 w, f32x4& a, f32x4& b) { a[0] = bf2f(w.x & 0xffffu); a[1] = bf2f(w.x >> 16); a[2] = bf2f(w.y & 0xffffu); a[3] = bf2f(w.y >> 16); b[0] = bf2f(w.z & 0xffffu); b[1] = bf2f(w.z >> 16); b[2] = bf2f(w.w & 0xffffu); b[3] = bf2f(w.w >> 16); }
__device__ __forceinline__ float shfl_xor_l(float v, int lane, int m) { return __int_as_float(__builtin_amdgcn_ds_bpermute((lane ^ m) << 2, __float_as_int(v))); }
__device__ __forceinline__ float shfl_l(float v, int src) { return __int_as_float(__builtin_amdgcn_ds_bpermute(src << 2, __float_as_int(v))); }
__device__ __forceinline__ float sum_xor16(float v) { const auto r = __builtin_amdgcn_permlane16_swap(__float_as_uint(v), __float_as_uint(v), false, false); return __uint_as_float(r[0]) + __uint_as_float(r[1]); }
__device__ __forceinline__ float sum_xor32(float v) { const auto r = __builtin_amdgcn_permlane32_swap(__float_as_uint(v), __float_as_uint(v), false, false); return __uint_as_float(r[0]) + __uint_as_float(r[1]); }
__device__ __forceinline__ float wave_sum(float v, int lane) {
#pragma unroll
    for (int o = 1; o < 64; o <<= 1) v += shfl_xor_l(v, lane, o);
    return v;
}
__device__ __forceinline__ float sigm(float v) { return __builtin_amdgcn_rcpf(1.f + __builtin_amdgcn_exp2f(v * (-LOG2E))); }
#if WT_STORES
__device__ __forceinline__ void st16(void* p, u32x4 v) { asm volatile("global_store_dwordx4 %0, %1, off sc1\n\ts_nop 1" :: "v"(p), "v"(v) : "memory"); }
__device__ __forceinline__ void st8(void* p, u32x2 v) { asm volatile("global_store_dwordx2 %0, %1, off sc1\n\ts_nop 1" :: "v"(p), "v"(v) : "memory"); }
#else
__device__ __forceinline__ void st16(void* p, u32x4 v) { *(u32x4*)p = v; }
__device__ __forceinline__ void st8(void* p, u32x2 v) { *(u32x2*)p = v; }
#endif
#define VM_WAIT() asm volatile("s_waitcnt vmcnt(0)" ::: "memory")
#define LAUNDER_S(p) asm volatile("" : "+s"(p))
#define LAUNDER_V(v) asm volatile("" : "+v"(v))
#define LDS_WAIT() asm volatile("s_waitcnt lgkmcnt(0)" ::: "memory")

#define XB_TMO      128
#define XB_XCNT(j)  (256  + 64 * (j))
#define XB_XSUB(j)  (1280 + 64 * (j))
#define XB_XGEN(j)  (2304 + 64 * (j))
#define XB_TOP      3328
#define XB_TOPGEN   3392
#define XCD_BAR_WORDS 3456
#define XB_SPIN_CAP (1u << 22)
__device__ __forceinline__ unsigned xb_ld(unsigned* p)              { return __hip_atomic_load(p, __ATOMIC_RELAXED, __HIP_MEMORY_SCOPE_AGENT); }
__device__ __forceinline__ unsigned xb_add(unsigned* p, unsigned v) { return __hip_atomic_fetch_add(p, v, __ATOMIC_RELAXED, __HIP_MEMORY_SCOPE_AGENT); }
__device__ __forceinline__ unsigned xb_xcc_id() { return (unsigned)__builtin_amdgcn_s_getreg((3 << 11) | 20) & 0xFu; }
#define XB_SPIN(cond, bar) do { unsigned _sp = 0; while (cond) { __builtin_amdgcn_s_sleep(1); \
    if ((++_sp & 255u) == 0u) { if (xb_ld(&(bar)[XB_TMO])) break; if (_sp > XB_SPIN_CAP) { atomicAdd(&(bar)[XB_TMO], 1u); break; } } } } while (0)
struct XcdBarrier { unsigned* bar; unsigned x; volatile LAS unsigned* st; };
__device__ __forceinline__ XcdBarrier xcd_barrier_post(unsigned* bar, volatile LAS unsigned* st) {
    XcdBarrier b; b.bar = bar; b.x = xb_xcc_id(); b.st = st;
    if (threadIdx.x == 0) (void)xb_add(&bar[XB_XCNT(b.x)], 1u);
    return b;
}
__device__ __forceinline__ void xcd_barrier_complete(unsigned* bar, unsigned x, unsigned& nloc, unsigned& nx) {
    const unsigned G = gridDim.x * gridDim.y * gridDim.z;
    unsigned sum, cnt, mine, sp = 0u;
    for (;;) {
        sum = 0u; cnt = 0u; mine = 0u;
#pragma unroll
        for (unsigned j = 0; j < 16; ++j) { const unsigned c = xb_ld(&bar[XB_XCNT(j)]); sum += c; cnt += (c > 0u) ? 1u : 0u; mine = (j == x) ? c : mine; }
        if (sum == G) break;
        __builtin_amdgcn_s_sleep(1);
        if ((++sp & 255u) == 0u) { if (xb_ld(&bar[XB_TMO])) break; if (sp > XB_SPIN_CAP) { atomicAdd(&bar[XB_TMO], 1u); break; } }
    }
    nloc = mine > 0u ? mine : 1u; nx = cnt > 0u ? cnt : 1u;
}
__device__ __forceinline__ void xcd_barrier(const XcdBarrier& b) {
    asm volatile("s_waitcnt vmcnt(0)" ::: "memory");
    __syncthreads();
    if (threadIdx.x == 0) {
        unsigned* bar = b.bar;
        __builtin_amdgcn_s_waitcnt(0);
        unsigned nloc = b.st[0], nx = b.st[1];
        if (nloc == 0u) { xcd_barrier_complete(bar, b.x, nloc, nx); b.st[0] = nloc; b.st[1] = nx; }
        const unsigned old = xb_add(&bar[XB_XSUB(b.x)], 1u);
        const unsigned gen = old / nloc;
        if (old + 1u == (gen + 1u) * nloc) {
            __builtin_amdgcn_fence(__ATOMIC_RELEASE, "agent");
            asm volatile("s_waitcnt vmcnt(0)" ::: "memory");
            const unsigned og = xb_add(&bar[XB_TOP], 1u);
            const unsigned tg = og / nx;
            if (og + 1u == (tg + 1u) * nx) xb_add(&bar[XB_TOPGEN], 1u);
            else XB_SPIN(xb_ld(&bar[XB_TOPGEN]) == tg, bar);
            __builtin_amdgcn_fence(__ATOMIC_ACQUIRE, "agent");
            xb_add(&bar[XB_XGEN(b.x)], 1u);
            asm volatile("s_waitcnt vmcnt(0)" ::: "memory");
        } else {
            XB_SPIN(xb_ld(&bar[XB_XGEN(b.x)]) == gen, bar);
            __builtin_amdgcn_fence(__ATOMIC_ACQUIRE, "agent");
            asm volatile("s_waitcnt vmcnt(0)" ::: "memory");
        }
    }
    __syncthreads();
}

namespace gp {
constexpr int BM = 256, BK = 64, HALF = 128, HTB = HALF * BK * 2, NXCD = 8, WGM = 8;
__host__ __device__ __forceinline__ int lds_byte(int r, int c) { const int st = (r >> 4) * 2 + (c >> 5), rr = r & 15, cc = c & 31, ob = rr * 64 + cc * 2; return st * 1024 + (ob ^ (((ob >> 9) & 1) << 5)); }
__host__ __device__ __forceinline__ void stage_rc(int b, int& R, int& C) { const int st = b / 1024, sb = b % 1024, swz = sb ^ (((sb >> 9) & 1) << 5); R = (st >> 1) * 16 + swz / 64; C = (st & 1) * 32 + (swz % 64) / 2; }
__host__ __device__ __forceinline__ int perm32(int rho) { const int n = rho >> 4, i = rho & 15; return 8 * (i >> 2) + 4 * n + (i & 3); }

struct Unit { int pm, pn, be, rl, nv; };
struct Gemm { const bf16_t* A; const bf16_t* Bt; int K; size_t bstride; const unsigned* list; size_t astride; int sw, sx; };

__device__ __forceinline__ int xcd_remap(int wgid, int nwg) { const int q = nwg / NXCD, r = nwg % NXCD, xcd = wgid % NXCD, off = wgid / NXCD; return (xcd < r ? xcd * (q + 1) : r * (q + 1) + (xcd - r) * q) + off; }
struct DenseOrder {
    int nM, nN, nwg, G, c;
    __device__ void init(int M, int N, int G_, int c_) { nM = M / BM; nN = N / BM; nwg = nM * nN; G = G_; c = c_; }
    __device__ bool next(int i, Unit& u) const {
        const int L = i * G + c; if (L >= nwg) return false;
        const int wgid = xcd_remap((int)L, nwg);
        const int nig = WGM * nN, gid = wgid / nig, fm = gid * WGM, gsz = (nM - fm) < WGM ? (nM - fm) : WGM;
        u.pm = fm + ((wgid % nig) % gsz); u.pn = (wgid % nig) / gsz; u.be = 0; u.rl = 0; u.nv = 256; return true;
    }
};
struct PairOrder {
    DenseOrder d;
    __device__ void init(int M, int N, int G_, int c_) { d.init(M, N, G_, c_); }
    __device__ bool next(int i, Unit& u) const { if (!d.next(i >> 1, u)) return false; u.be = i & 1; return true; }
};
struct MoeOrder {
    const LAS int* tab; int nwg, G, c;
    __device__ static int rd(const LAS int* p) { return __builtin_amdgcn_readfirstlane(*p); }
    __device__ void init(const LAS int* tab_, int G_, int c_) { tab = tab_; nwg = rd(tab_ + 16) * 4; G = G_; c = c_; }
    __device__ bool next(int i, Unit& u) const {
        const int L = i * G + c; if (L >= nwg) return false;
        const int wgid = xcd_remap((int)L, nwg);
        const int tile = wgid >> 2; int e = 0;
        for (int k = 1; k < NE; ++k) { const int tk = rd(tab + k); e = (tk <= tile) ? k : e; }
        e = __builtin_amdgcn_readfirstlane(e);
        u.pm = tile; u.pn = wgid & 3; u.be = e; u.rl = tile - rd(tab + e); const int rem = rd(tab + 32 + e) - u.rl * 256; u.nv = rem < 256 ? rem : 256; return true;
    }
};

#define ACC_T f32x4 (&acc)[2][2][4][2]

template <class Epi, class Sched, bool GATHER>
__device__ __forceinline__ void gemm_phase_ref(int tid, const Gemm g, const Sched& S, const Epi& E) {
    const int wid = __builtin_amdgcn_readfirstlane(tid >> 6), lane = tid & 63, wr = wid >> 2, wc = wid & 3, fr = lane & 15, fq = lane >> 4;
    const int K = g.K; Unit u;
    for (int ui = 0; S.next(ui, u); ++ui) {
        f32x4 acc[2][2][4][2];
#pragma unroll
        for (int a = 0; a < 2; ++a)
#pragma unroll
            for (int b = 0; b < 2; ++b)
#pragma unroll
                for (int m = 0; m < 4; ++m)
#pragma unroll
                    for (int n = 0; n < 2; ++n) acc[a][b][m][n] = (f32x4){0.f, 0.f, 0.f, 0.f};
        const bf16_t* Bt = g.Bt + (size_t)u.be * g.bstride + (size_t)u.pn * 256 * K;
        for (int ai = 0; ai < 2; ++ai)
            for (int m = 0; m < 4; ++m) {
                const int rloc = ai * 128 + wr * 64 + m * 16 + fr;
                size_t arow;
                if (GATHER) { arow = (rloc < u.nv) ? (size_t)(g.list[(size_t)u.be * T + u.rl * 256 + rloc] >> 1) : 0; }
                else arow = (size_t)u.pm * 256 + rloc;
                const bf16_t* ap = g.A + arow * K;
                for (int bj = 0; bj < 2; ++bj) {
                    const bf16_t* bp = Bt + (size_t)(bj * 128 + wc * 32 + fq * 8) * K;
                    float s[8];
#pragma unroll
                    for (int c = 0; c < 8; ++c) {
                        float sc = 0.f; const bf16_t* bpc = bp + (size_t)c * K;
#pragma unroll 2
                        for (int k = 0; k < K; k += 8) {
                            f32x4 a0, a1, b0, b1; unpack8(*(const u32x4*)(ap + k), a0, a1); unpack8(*(const u32x4*)(bpc + k), b0, b1);
                            sc += a0[0] * b0[0] + a0[1] * b0[1] + a0[2] * b0[2] + a0[3] * b0[3] + a1[0] * b1[0] + a1[1] * b1[1] + a1[2] * b1[2] + a1[3] * b1[3];
                        }
                        s[c] = sc; asm volatile("" : "+v"(s[c]));
                    }
#pragma unroll
                    for (int a2 = 0; a2 < 2; ++a2)
#pragma unroll
                        for (int b2 = 0; b2 < 2; ++b2)
#pragma unroll
                            for (int m2 = 0; m2 < 4; ++m2)
                                if (a2 == ai && b2 == bj && m2 == m) { acc[a2][b2][m2][0] = (f32x4){s[0], s[1], s[2], s[3]}; acc[a2][b2][m2][1] = (f32x4){s[4], s[5], s[6], s[7]}; }
                }
            }
        E(acc, u, wr, wc, fr, fq);
    }
}

template <class E> struct EpiTraits { static constexpr bool KEEP = false; };
#if FAST_GEMM
typedef int v8i_t __attribute__((ext_vector_type(8)));
__device__ __forceinline__ unsigned gp_voffb(int tid, int i, int K) { int t_ = tid; LAUNDER_V(t_); int R, C; stage_rc(t_ * 16 + i * 8192, R, C); const int Rb = (R & ~31) + perm32(R & 31); return (unsigned)(Rb * K + C) * 2u; }
template <class Epi, class Sched, bool GATHER, bool F8>
__device__ __forceinline__ void gemm_phase_fast(int tid, LAS unsigned char* lds, const Gemm g, const Sched& S, const Epi& E) {
    const int wid = __builtin_amdgcn_readfirstlane(tid >> 6), lane = tid & 63, wr = wid >> 2, wc = wid & 3, fr = lane & 15, fq = lane >> 4;
    const int K = g.K, nt = K / BK;
    int Rr[2], Cc[2]; unsigned voffB[2];
#pragma unroll
    for (int i = 0; i < 2; ++i) { stage_rc(tid * 16 + i * 8192, Rr[i], Cc[i]); const int Rb = (Rr[i] & ~31) + perm32(Rr[i] & 31); voffB[i] = (unsigned)(Rb * K + Cc[i]) * 2u; }
#define GP_VB(i) (F8 ? gp_voffb(tid, (i), K) : voffB[i])
    const size_t kstep = (size_t)(BK * 2), hstep = (size_t)HALF * K * 2, tstep = 2 * hstep, r64 = (size_t)64 * K * 2;
    const unsigned ldsw = (unsigned)wid * 1024u;
    const int aoff = lds_byte(wr * 64 + fr, fq * 8), boff = lds_byte(wc * 32 + fr, fq * 8);
#define GP_UNI(p) ((const char*)(((unsigned long long)(unsigned)__builtin_amdgcn_readfirstlane((int)((unsigned long long)(p) >> 32)) << 32) | (unsigned)__builtin_amdgcn_readfirstlane((int)(unsigned long long)(p))))
#define GP_SA(b, h) (((b) * 2 + (h)) * HTB)
#define GP_SB(b, h) ((4 + (b) * 2 + (h)) * HTB)
#define GP_DMA(sbase, voff, ldsdst) do { unsigned keep_; asm volatile("s_mov_b32 %0, m0\n\ts_mov_b32 m0, %3\n\ts_nop 0\n\tglobal_load_lds_dwordx4 %1, %2\n\ts_mov_b32 m0, %0" \
        : "=&s"(keep_) : "v"(voff), "s"(sbase), "s"((unsigned)__builtin_amdgcn_readfirstlane((int)(unsigned)(uintptr_t)(ldsdst))) : "memory"); } while (0)
#define GP_STAGE2(bufoff, gbase, v0, v1) do { const char* gb_ = (gbase); GP_DMA(gb_, (v0), lds + (bufoff) + ldsw); GP_DMA(gb_, (v1), lds + (bufoff) + ldsw + 8192); } while (0)
#define GP_STAGEB(bufoff, gbase) do { if constexpr (F8) { const unsigned vb_ = GP_VB(0); const char* gb_ = (gbase); GP_DMA(gb_, vb_, lds + (bufoff) + ldsw); GP_DMA(gb_ + r64, vb_, lds + (bufoff) + ldsw + 8192); } else { GP_STAGE2(bufoff, gbase, GP_VB(0), GP_VB(1)); } } while (0)
#define GP_STAGEB2(bufoff0, bufoff1, gbase) do { if constexpr (F8 && !GATHER) { const unsigned vb_ = GP_VB(0); const char* gb_ = (gbase); GP_DMA(gb_, vb_, lds + (bufoff0) + ldsw); GP_DMA(gb_ + r64, vb_, lds + (bufoff0) + ldsw + 8192); \
        GP_DMA(gb_ + hstep, vb_, lds + (bufoff1) + ldsw); GP_DMA(gb_ + hstep + r64, vb_, lds + (bufoff1) + ldsw + 8192); } else { GP_STAGEB(bufoff0, gbase); GP_STAGEB(bufoff1, (gbase) + hstep); } } while (0)
#define GP_CAT8(x0, x1) __builtin_bit_cast(v8i_t, __builtin_shufflevector(x0, x1, 0, 1, 2, 3, 4, 5, 6, 7, 8, 9, 10, 11, 12, 13, 14, 15))
#define GP_LDA(dst, b, h) do { _Pragma("unroll") for (int m = 0; m < 4; ++m) _Pragma("unroll") for (int k = 0; k < 2; ++k) dst[m][k] = *(const LAS bf16x8*)(lds + GP_SA(b, h) + aoff + m * 2048 + k * 1024); \
        if constexpr (F8) { _Pragma("unroll") for (int m = 0; m < 4; ++m) dst##8[m] = GP_CAT8(dst[m][0], dst[m][1]); } } while (0)
#define GP_LDB(dst, b, h) do { _Pragma("unroll") for (int n = 0; n < 2; ++n) _Pragma("unroll") for (int k = 0; k < 2; ++k) dst[n][k] = *(const LAS bf16x8*)(lds + GP_SB(b, h) + boff + n * 2048 + k * 1024); \
        if constexpr (F8) { _Pragma("unroll") for (int n = 0; n < 2; ++n) dst##8[n] = GP_CAT8(dst[n][0], dst[n][1]); } } while (0)
#define GP_MMA(ai, bj, At, Bt) do { __builtin_amdgcn_s_setprio(1); \
        if constexpr (F8) { _Pragma("unroll") for (int m = 0; m < 4; ++m) _Pragma("unroll") for (int n = 0; n < 2; ++n) \
            acc[ai][bj][m][n] = __builtin_amdgcn_mfma_scale_f32_16x16x128_f8f6f4(Bt##8[n], At##8[m], acc[ai][bj][m][n], 0, 0, 0, 0, 0, 0); }     \
        else { _Pragma("unroll") for (int m = 0; m < 4; ++m) _Pragma("unroll") for (int n = 0; n < 2; ++n) _Pragma("unroll") for (int k = 0; k < 2; ++k) \
            acc[ai][bj][m][n] = __builtin_amdgcn_mfma_f32_16x16x32_bf16(Bt[n][k], At[m][k], acc[ai][bj][m][n], 0, 0, 0); } \
        __builtin_amdgcn_s_setprio(0); } while (0)
#define GP_WAIT_V(n) asm volatile("s_waitcnt vmcnt(" #n ")" ::: "memory")
#define GP_WAIT_L(n) asm volatile("s_waitcnt lgkmcnt(" #n ")" ::: "memory")
#define GP_BAR __builtin_amdgcn_s_barrier()
#define GP_SCHED __builtin_amdgcn_sched_barrier(0)
    Unit cur, nxt; int ui = 0;
    if (!S.next(0, cur)) return;
    f32x4 acc[2][2][4][2];
#pragma unroll
    for (int a = 0; a < 2; ++a)
#pragma unroll
        for (int b = 0; b < 2; ++b)
#pragma unroll
            for (int m = 0; m < 4; ++m)
#pragma unroll
                for (int n = 0; n < 2; ++n) acc[a][b][m][n] = (f32x4){0.f, 0.f, 0.f, 0.f};
    bf16x8 At[4][2], B0[2][2], B1[2][2];
    v8i_t At8[4], B08[2], B18[2];
    unsigned vC0, vC1, vC2, vC3, vN0, vN1, vN2, vN3;
#define GP_VOFF(u, o0, o1, o2, o3) do { if (GATHER) { \
        int tl_ = tid; LAUNDER_V(tl_); int R0_, C0_, R1_, C1_; stage_rc(tl_ * 16, R0_, C0_); stage_rc(tl_ * 16 + 8192, R1_, C1_);     \
        const unsigned* lp = g.list + (size_t)(u).be * T + (u).rl * 256; \
        const int nvm = (u).nv - 1; const int p0 = min(R0_, nvm), p1 = min(R1_, nvm), p2 = min(128 + R0_, nvm), p3 = min(128 + R1_, nvm); \
        const unsigned t0 = lp[p0] >> 1, t1 = lp[p1] >> 1, t2 = lp[p2] >> 1, t3 = lp[p3] >> 1; \
        o0 = (t0 * K + C0_) * 2u; o1 = (t1 * K + C1_) * 2u; o2 = (t2 * K + C0_) * 2u; o3 = (t3 * K + C1_) * 2u; \
      } else { o0 = (unsigned)(Rr[0] * K + Cc[0]) * 2u; o1 = (unsigned)(Rr[1] * K + Cc[1]) * 2u; o2 = o0 + (unsigned)hstep; o3 = o1 + (unsigned)hstep; } } while (0)
    GP_VOFF(cur, vC0, vC1, vC2, vC3);
    const char* cA = GP_UNI((const char*)g.A + ((size_t)cur.be * g.astride) * 2 + (GATHER ? (size_t)0 : (size_t)cur.pm * tstep));
    const char* cB = GP_UNI((const char*)g.Bt + ((size_t)cur.be * g.bstride) * 2 + (size_t)cur.pn * tstep);
    GP_STAGEB(GP_SB(0, 0), cB); GP_STAGEB(GP_SB(0, 1), cB + hstep); GP_STAGE2(GP_SA(0, 0), cA, vC0, vC1); GP_STAGE2(GP_SA(0, 1), cA, vC2, vC3);
    if (wr == 1) GP_BAR;
    GP_WAIT_V(2); GP_BAR;
    GP_STAGEB(GP_SB(1, 0), cB + kstep); GP_STAGE2(GP_SA(1, 0), cA + kstep, vC0, vC1); GP_STAGEB(GP_SB(1, 1), cB + hstep + kstep);
    GP_WAIT_V(6); GP_BAR;
    for (;;) {
        const bool has_next = S.next(ui + 1, nxt);
        const char* nA = GP_UNI(has_next ? (const char*)g.A + ((size_t)nxt.be * g.astride) * 2 + (GATHER ? (size_t)0 : (size_t)nxt.pm * tstep) : cA);
        const char* nB = GP_UNI(has_next ? (const char*)g.Bt + ((size_t)nxt.be * g.bstride) * 2 + (size_t)nxt.pn * tstep : cB);
        if (GATHER) {
            if (has_next) { GP_VOFF(nxt, vN0, vN1, vN2, vN3); } else { vN0 = vC0; vN1 = vC1; vN2 = vC2; vN3 = vC3; }
            *(LAS u32x4*)(lds + MISC_OFF + 2048 + tid * 16) = (u32x4){vN0, vN1, vN2, vN3};
        } else { vN0 = vC0; vN1 = vC1; vN2 = vC2; vN3 = vC3; }
#pragma nounroll
        for (int t = 0; t < nt; t += 2) {
            LAUNDER_S(cA); LAUNDER_S(cB); LAUNDER_S(nA); LAUNDER_S(nB);
            const bool last = (t == nt - 2);
            if (GATHER) { if (last) { const u32x4 q_ = *(const LAS u32x4*)(lds + MISC_OFF + 2048 + tid * 16); vN0 = q_.x; vN1 = q_.y; vN2 = q_.z; vN3 = q_.w; } }
            const char* a1 = cA + (size_t)(t + 1) * kstep;
            const char* a2 = last ? nA : cA + (size_t)(t + 2) * kstep; const char* b2 = last ? nB : cB + (size_t)(t + 2) * kstep;
            const char* a3 = a2 + kstep; const char* b3 = b2 + kstep;
            const unsigned w0 = last ? vN0 : vC0, w1 = last ? vN1 : vC1, w2 = last ? vN2 : vC2, w3 = last ? vN3 : vC3;
            GP_LDB(B0, 0, 0); GP_LDB(B1, 0, 1); GP_SCHED; GP_LDA(At, 0, 0); GP_STAGE2(GP_SA(1, 1), a1, vC2, vC3);
            GP_WAIT_V(8); GP_WAIT_L(0); GP_BAR; GP_MMA(0, 0, At, B0); GP_MMA(0, 1, At, B1); GP_BAR; GP_SCHED;
            GP_LDA(At, 0, 1); GP_STAGEB2(GP_SB(0, 0), GP_SB(0, 1), b2); GP_STAGE2(GP_SA(0, 0), a2, w0, w1);
            GP_WAIT_V(8); GP_WAIT_L(0); GP_BAR; GP_MMA(1, 0, At, B0); GP_MMA(1, 1, At, B1); GP_BAR; GP_SCHED;
            GP_LDB(B0, 1, 0); GP_LDB(B1, 1, 1); GP_SCHED; GP_LDA(At, 1, 0); GP_STAGE2(GP_SA(0, 1), a2, w2, w3);
            GP_WAIT_V(8); GP_WAIT_L(0); GP_BAR; GP_MMA(0, 0, At, B0); GP_MMA(0, 1, At, B1); GP_BAR; GP_SCHED;
            GP_LDA(At, 1, 1); GP_STAGEB2(GP_SB(1, 0), GP_SB(1, 1), b3); GP_STAGE2(GP_SA(1, 0), a3, w0, w1);
            GP_WAIT_V(8); GP_WAIT_L(0); GP_BAR; GP_MMA(1, 0, At, B0); GP_MMA(1, 1, At, B1); GP_BAR; GP_SCHED;
        }
        if (wr == 0) GP_BAR;
        { int tl_ = tid; LAUNDER_V(tl_); const int fr_ = tl_ & 15, fq_ = (tl_ & 63) >> 4;
          E(acc, cur, wr, wc, fr_, fq_); }
        if (!has_next) break;
        if (!(EpiTraits<Epi>::KEEP && cur.be == 0)) {
#pragma unroll
        for (int a = 0; a < 2; ++a)
#pragma unroll
            for (int b = 0; b < 2; ++b)
#pragma unroll
                for (int m = 0; m < 4; ++m)
#pragma unroll
                    for (int n = 0; n < 2; ++n) acc[a][b][m][n] = (f32x4){0.f, 0.f, 0.f, 0.f};
        }
        cur = nxt; cA = nA; cB = nB; vC0 = vN0; vC1 = vN1; vC2 = vN2; vC3 = vN3; ++ui;
        if (wr == 1) GP_BAR;
    }
    GP_WAIT_V(0);
    GP_BAR;
#undef GP_UNI
#undef GP_SA
#undef GP_SB
#undef GP_STAGE2
#undef GP_DMA
#undef GP_STAGEB
#undef GP_STAGEB2
#undef GP_VB
#undef GP_LDA
#undef GP_LDB
#undef GP_MMA
#undef GP_CAT8
#undef GP_WAIT_V
#undef GP_WAIT_L
#undef GP_BAR
#undef GP_SCHED
#undef GP_VOFF
}
#endif

template <class Epi, class Sched, bool GATHER = false, bool F8 = false>
__device__ __forceinline__ void gemm_phase(int tid, LAS unsigned char* lds, const Gemm g, const Sched& S, const Epi& E) {
#if FAST_GEMM
    gemm_phase_fast<Epi, Sched, GATHER, F8>(tid, lds, g, S, E);
#else
    (void)lds; gemm_phase_ref<Epi, Sched, GATHER>(tid, g, S, E);
#endif
}

#define EPI_ROW(ai, m) (u.pm * 256 + (ai) * 128 + wr * 64 + (m) * 16 + fr)
#define EPI_COL(bj) (u.pn * 256 + (bj) * 128 + wc * 32 + fq * 8)
__device__ __forceinline__ float dot4(f32x4 a) { return (a[0] * a[0] + a[1] * a[1]) + (a[2] * a[2] + a[3] * a[3]); }

struct EpiNull {
    __device__ __forceinline__ void operator()(const ACC_T, const Unit& u, int wr, int wc, int fr, int fq) const {
#pragma unroll
        for (int ai = 0; ai < 2; ++ai)
#pragma unroll
            for (int bj = 0; bj < 2; ++bj)
#pragma unroll
                for (int m = 0; m < 4; ++m) asm volatile("" :: "v"(acc[ai][bj][m][0]), "v"(acc[ai][bj][m][1]));
    }
};
struct EpiIn {
    bf16_t *QA, *KA, *VA, *QLAT, *KVLAT, *KB, *SA, *SB; float *SSQ, *SSKV; const float *gq, *gk, *cosA, *sinA, *cosB, *sinB;
    __device__ __forceinline__ void operator()(const ACC_T, const Unit& u, int wr, int wc, int fr, int fq) const {
        const int wb = u.pn * 4 + wc;
        if (wb < 10) {
            const bool isq = wb < 8; const int head = isq ? wb : wb - 8; const float* g = isq ? gq : gk; bf16_t* dst = isq ? QA : KA; const int dp = isq ? 512 : 128; const float qs = isq ? QSCALE_A * (ATT_FP8_A ? PFOLD : 1.f) : 1.f;
            const f32x4 g00 = *(const f32x4*)(g + 8 * fq), g01 = *(const f32x4*)(g + 8 * fq + 4), g10 = *(const f32x4*)(g + 32 + 8 * fq), g11 = *(const f32x4*)(g + 36 + 8 * fq);
#pragma unroll
            for (int ai = 0; ai < 2; ++ai)
#pragma unroll
                for (int m = 0; m < 4; ++m) {
                    const int r = EPI_ROW(ai, m), pos = r & (S - 1);
                    const f32x4 v00 = acc[ai][0][m][0], v01 = acc[ai][0][m][1], v10 = acc[ai][1][m][0], v11 = acc[ai][1][m][1];
                    float ss = (dot4(v00) + dot4(v01)) + (dot4(v10) + dot4(v11)); ss = sum_xor16(ss); ss = sum_xor32(ss);
                    const float rstd = rsqrtf(ss * (1.f / 64.f) + EPS);
                    const f32x4 y00 = v00 * rstd * g00, y01 = v01 * rstd * g01, y10 = v10 * rstd * g10, y11 = v11 * rstd * g11;
                    const f32x4 c0 = *(const f32x4*)(cosA + pos * 32 + 8 * fq), c1 = *(const f32x4*)(cosA + pos * 32 + 8 * fq + 4), s0 = *(const f32x4*)(sinA + pos * 32 + 8 * fq), s1 = *(const f32x4*)(sinA + pos * 32 + 8 * fq + 4);
                    const f32x4 o00 = (y00 * c0 - y10 * s0) * qs, o01 = (y01 * c1 - y11 * s1) * qs, o10 = (y10 * c0 + y00 * s0) * qs, o11 = (y11 * c1 + y01 * s1) * qs;
#if ATT_FP8_A
                    unsigned char* p8 = (unsigned char*)dst + (size_t)r * dp + head * 64 + 8 * fq;
                    st16(p8 + (fq & 1) * 32 - (fq & 1) * 8, pair16(pack8_fp8(o00, o01), pack8_fp8(o10, o11)));
#else
                    bf16_t* p = dst + (size_t)r * dp + head * 64 + 8 * fq;
                    st16(p, pack8(o00, o01)); st16((p + 32), pack8(o10, o11));
#endif
                }
        } else if (wb < 12) {
#pragma unroll
            for (int ai = 0; ai < 2; ++ai)
#pragma unroll
                for (int m = 0; m < 4; ++m) {
#if ATT_FP8_A
                    const int r = EPI_ROW(ai, m), sq = r & (S - 1), k = sq & 63, pos = 32 * ((k >> 2) & 1) + 16 * (k >> 5) + (k & 3) + 4 * ((k & 31) >> 3);
                    unsigned char* vtb = (unsigned char*)VA; const unsigned vo = (unsigned)(((r >> 12) * 2 + (wb - 10)) * 64 + 8 * fq) * S + (unsigned)((sq & ~63) + pos);
#pragma unroll
                    for (int bj = 0; bj < 2; ++bj)
#pragma unroll
                        for (int n = 0; n < 2; ++n) { const f32x4 x = acc[ai][bj][m][n]; const unsigned w = (unsigned)__builtin_amdgcn_cvt_pk_fp8_f32(x[2], x[3], __builtin_amdgcn_cvt_pk_fp8_f32(x[0], x[1], 0, false), true);
                            const unsigned qo = vo + (unsigned)(bj * 32 + 4 * n) * S;
                            vtb[qo] = (unsigned char)(w & 0xffu); vtb[qo + S] = (unsigned char)((w >> 8) & 0xffu); vtb[qo + 2 * S] = (unsigned char)((w >> 16) & 0xffu); vtb[qo + 3 * S] = (unsigned char)(w >> 24); }
#else
                    bf16_t* p = VA + (size_t)EPI_ROW(ai, m) * 128 + (wb - 10) * 64 + 8 * fq;
                    st16(p, pack8(acc[ai][0][m][0], acc[ai][0][m][1])); st16((p + 32), pack8(acc[ai][1][m][0], acc[ai][1][m][1]));
#endif
                }
        } else if (wb < 22) {
            const bool isq = wb < 18; const int idx = isq ? wb - 12 : wb - 18; bf16_t* dst = isq ? QLAT : KVLAT; const int dp = isq ? 384 : 256;
#pragma unroll
            for (int ai = 0; ai < 2; ++ai)
#pragma unroll
                for (int m = 0; m < 4; ++m) {
                    const int r = EPI_ROW(ai, m);
                    const f32x4 v00 = acc[ai][0][m][0], v01 = acc[ai][0][m][1], v10 = acc[ai][1][m][0], v11 = acc[ai][1][m][1];
                    float ss = (dot4(v00) + dot4(v01)) + (dot4(v10) + dot4(v11)); ss = sum_xor16(ss); ss = sum_xor32(ss);
                    if (fq == 0) { if (isq) SSQ[(size_t)r * 8 + idx] = ss; else SSKV[(size_t)r * 4 + idx] = ss; }
                    bf16_t* p = dst + (size_t)r * dp + idx * 64 + 8 * fq;
                    st16(p, pack8(v00, v01)); st16((p + 32), pack8(v10, v11));
                }
        } else if (wb == 22) {
            if (fq < 2) {
#pragma unroll
                for (int ai = 0; ai < 2; ++ai)
#pragma unroll
                    for (int m = 0; m < 4; ++m) {
                        const int r = EPI_ROW(ai, m), pos = r & (S - 1);
                        const f32x4 x10 = acc[ai][0][m][0], x11 = acc[ai][0][m][1], x20 = acc[ai][1][m][0], x21 = acc[ai][1][m][1];
                        const f32x4 c0 = *(const f32x4*)(cosB + pos * 16 + 8 * fq), c1 = *(const f32x4*)(cosB + pos * 16 + 8 * fq + 4), s0 = *(const f32x4*)(sinB + pos * 16 + 8 * fq), s1 = *(const f32x4*)(sinB + pos * 16 + 8 * fq + 4);
#if ATT_FP8_B
                        const u32x2 w1 = pack8_fp8(x10 * c0 - x20 * s0, x11 * c1 - x21 * s1), w2 = pack8_fp8(x20 * c0 + x10 * s0, x21 * c1 + x11 * s1);
                        unsigned char* p = (unsigned char*)KB + (size_t)r * 768 + 64 + 8 * fq;
#pragma unroll
                        for (int h = 0; h < 8; ++h) { st8(p + h * 96, w1); st8(p + h * 96 + 16, w2); }
#else
                        const u32x4 w1 = pack8(x10 * c0 - x20 * s0, x11 * c1 - x21 * s1), w2 = pack8(x20 * c0 + x10 * s0, x21 * c1 + x11 * s1);
                        bf16_t* p = KB + (size_t)r * 768 + 64 + 8 * fq;
#pragma unroll
                        for (int h = 0; h < 8; ++h) { st16((p + h * 96), w1); st16((p + h * 96 + 16), w2); }
#endif
                    }
            }
        } else if (wb == 23) {
        } else {
            const bool isa = wb < 40; const int idx = isa ? wb - 24 : wb - 40; unsigned char* dst = (unsigned char*)(isa ? SA : SB);
#pragma unroll
            for (int ai = 0; ai < 2; ++ai)
#pragma unroll
                for (int m = 0; m < 4; ++m) { unsigned char* p = dst + (size_t)EPI_ROW(ai, m) * 1024 + idx * 64 + (fq & 1) * 32 + 8 * (fq & ~1);
                    st16(p, pair16(pack8_fp8(acc[ai][0][m][0], acc[ai][0][m][1]), pack8_fp8(acc[ai][1][m][0], acc[ai][1][m][1]))); }
        }
    }
};
__host__ __device__ __forceinline__ int src_col_in(int n) {
    const int pn = n >> 8, nl = n & 255, bj = nl >> 7, wc = (nl & 127) >> 5, p = nl & 31, wb = pn * 4 + wc, s = bj * 32 + p;
    if (wb < 8) return wb * 64 + s;
    if (wb < 10) return 512 + (wb - 8) * 64 + s;
    if (wb < 12) return 640 + (wb - 10) * 64 + s;
    if (wb < 18) return 768 + (wb - 12) * 64 + s;
    if (wb < 22) return 1152 + (wb - 18) * 64 + s;
    if (wb == 22) return p < 16 ? 1408 + bj * 16 + p : -1;
    if (wb == 23) return -1;
    if (wb < 40) return 1440 + (wb - 24) * 64 + s;
    return 2464 + (wb - 40) * 64 + s;
}
struct EpiQb {
    bf16_t* QB; const float *SSQ, *cosB, *sinB;
    __device__ __forceinline__ void operator()(const ACC_T, const Unit& u, int wr, int wc, int fr, int fq) const {
#pragma unroll
        for (int ai = 0; ai < 2; ++ai)
#pragma unroll
            for (int m = 0; m < 4; ++m) {
                const int r = EPI_ROW(ai, m), pos = r & (S - 1);
                const f32x4 sa = *(const f32x4*)(SSQ + (size_t)r * 8); const f32x2 sb = *(const f32x2*)(SSQ + (size_t)r * 8 + 4);
                const float rstd = rsqrtf((((sa[0] + sa[1]) + (sa[2] + sa[3])) + (sb[0] + sb[1])) * (1.f / 384.f) + EPS);
                u32x2 wq[2];
#pragma unroll
                for (int bj = 0; bj < 2; ++bj) {
                    f32x4 v0 = acc[ai][bj][m][0] * rstd, v1 = acc[ai][bj][m][1] * rstd;
                    const int c32 = u.pn * 8 + bj * 4 + wc;
                    if (c32 % 3 == 2) {
                        f32x4 o0, o1;
#pragma unroll
                        for (int j = 0; j < 4; ++j) { const auto ra = __builtin_amdgcn_permlane32_swap(__float_as_uint(v0[j]), __float_as_uint(v0[j]), false, false), rb = __builtin_amdgcn_permlane32_swap(__float_as_uint(v1[j]), __float_as_uint(v1[j]), false, false);
                            o0[j] = __uint_as_float(fq < 2 ? ra[1] : ra[0]); o1[j] = __uint_as_float(fq < 2 ? rb[1] : rb[0]); }
                        const int i0 = 8 * (fq & 1);
                        const f32x4 c0 = *(const f32x4*)(cosB + pos * 16 + i0), c1 = *(const f32x4*)(cosB + pos * 16 + i0 + 4), s0 = *(const f32x4*)(sinB + pos * 16 + i0), s1 = *(const f32x4*)(sinB + pos * 16 + i0 + 4);
                        if (fq < 2) { v0 = v0 * c0 - o0 * s0; v1 = v1 * c1 - o1 * s1; } else { v0 = v0 * c0 + o0 * s0; v1 = v1 * c1 + o1 * s1; }
                    }
#if ATT_FP8_B
                    wq[bj] = pack8_fp8(v0 * (QSCALE_B * PFOLD), v1 * (QSCALE_B * PFOLD));
#else
                    st16((QB + (size_t)r * 768 + EPI_COL(bj)), pack8(v0 * QSCALE_B, v1 * QSCALE_B));
#endif
                }
#if ATT_FP8_B
                st16((unsigned char*)QB + (size_t)r * 768 + u.pn * 256 + (fq & 1) * 128 + wc * 32 + 8 * (fq & ~1), pair16(wq[0], wq[1]));
#endif
            }
    }
};
struct EpiKvb {
    bf16_t *KB, *VB; const float* SSKV;
    __device__ __forceinline__ void operator()(const ACC_T, const Unit& u, int wr, int wc, int fr, int fq) const {
#pragma unroll
        for (int ai = 0; ai < 2; ++ai)
#pragma unroll
            for (int m = 0; m < 4; ++m) {
                const int r = EPI_ROW(ai, m);
                const f32x4 sa = *(const f32x4*)(SSKV + (size_t)r * 4);
                const float rstd = rsqrtf(((sa[0] + sa[1]) + (sa[2] + sa[3])) * (1.f / 256.f) + EPS);
                u32x2 wk[2] = {};
#pragma unroll
                for (int bj = 0; bj < 2; ++bj) {
                    const int head = u.pn * 2 + bj, o = wc * 32 + fq * 8;
#if ATT_FP8_B
                    const f32x4 x0 = acc[ai][bj][m][0] * rstd, x1 = acc[ai][bj][m][1] * rstd;
                    if (wc < 2) wk[bj] = pack8_fp8(x0, x1);
                    else {
                        const int sq = r & (S - 1), k = sq & 63, pos = 32 * ((k >> 2) & 1) + 16 * (k >> 5) + (k & 3) + 4 * ((k & 31) >> 3);
                        unsigned char* vtb = (unsigned char*)VB; const unsigned vo = (unsigned)(((r >> 12) * 8 + head) * 64 + (o - 64)) * S + (unsigned)((sq & ~63) + pos);
                        const u32x2 w = pack8_fp8(x0, x1);
                        vtb[vo] = (unsigned char)(w.x & 0xffu); vtb[vo + S] = (unsigned char)((w.x >> 8) & 0xffu); vtb[vo + 2 * S] = (unsigned char)((w.x >> 16) & 0xffu); vtb[vo + 3 * S] = (unsigned char)(w.x >> 24);
                        vtb[vo + 4 * S] = (unsigned char)(w.y & 0xffu); vtb[vo + 5 * S] = (unsigned char)((w.y >> 8) & 0xffu); vtb[vo + 6 * S] = (unsigned char)((w.y >> 16) & 0xffu); vtb[vo + 7 * S] = (unsigned char)(w.y >> 24);
                    }
#else
                    const u32x4 w = pack8(acc[ai][bj][m][0] * rstd, acc[ai][bj][m][1] * rstd);
                    if (wc < 2) st16((KB + (size_t)r * 768 + head * 96 + o), w); else st16((VB + (size_t)r * 512 + head * 64 + (o - 64)), w);
#endif
                }
#if ATT_FP8_B
                if (wc < 2) st16((unsigned char*)KB + (size_t)r * 768 + (u.pn * 2 + (fq & 1)) * 96 + wc * 32 + 8 * (fq & ~1), pair16(wk[0], wk[1]));
#endif
            }
    }
};
template <int MODE> struct EpiProj {
    bf16_t* O; const bf16_t* gate;
    __device__ __forceinline__ void operator()(const ACC_T, const Unit& u, int wr, int wc, int fr, int fq) const {
#pragma unroll
        for (int ai = 0; ai < 2; ++ai)
#pragma unroll
            for (int m = 0; m < 4; ++m) {
                const int r = EPI_ROW(ai, m);
#pragma unroll
                for (int bj = 0; bj < 2; ++bj) {
                    const size_t off = (size_t)r * D + EPI_COL(bj);
                    const u32x2 gw = *(const u32x2*)((const unsigned char*)gate + off);
                    const f32x2 q0 = __builtin_amdgcn_cvt_pk_f32_fp8((int)gw.x, false), q1 = __builtin_amdgcn_cvt_pk_f32_fp8((int)gw.x, true), q2 = __builtin_amdgcn_cvt_pk_f32_fp8((int)gw.y, false), q3 = __builtin_amdgcn_cvt_pk_f32_fp8((int)gw.y, true);
                    const f32x4 g0 = {sigm(q0[0]), sigm(q0[1]), sigm(q1[0]), sigm(q1[1])}, g1 = {sigm(q2[0]), sigm(q2[1]), sigm(q3[0]), sigm(q3[1])};
                    f32x4 v0 = acc[ai][bj][m][0] * g0, v1 = acc[ai][bj][m][1] * g1;
                    if (MODE == 1) { f32x4 p0, p1; unpack8(*(const u32x4*)(O + off), p0, p1); v0 += p0; v1 += p1; }
                    if (MODE == 1) st16(O + off, pack8(v0, v1)); else *(u32x4*)(O + off) = pack8(v0, v1);
                }
            }
    }
};
struct EpiProjP {
    bf16_t* O; const unsigned char* SA; const unsigned char* SB;
    __device__ static __forceinline__ void gates(const unsigned char* G, size_t off, f32x4& g0, f32x4& g1) {
        const u32x2 gw = *(const u32x2*)(G + off);
        const f32x2 q0 = __builtin_amdgcn_cvt_pk_f32_fp8((int)gw.x, false), q1 = __builtin_amdgcn_cvt_pk_f32_fp8((int)gw.x, true), q2 = __builtin_amdgcn_cvt_pk_f32_fp8((int)gw.y, false), q3 = __builtin_amdgcn_cvt_pk_f32_fp8((int)gw.y, true);
        g0 = (f32x4){sigm(q0[0]), sigm(q0[1]), sigm(q1[0]), sigm(q1[1])}; g1 = (f32x4){sigm(q2[0]), sigm(q2[1]), sigm(q3[0]), sigm(q3[1])};
    }
    __device__ __forceinline__ void operator()(f32x4 (&acc)[2][2][4][2], const Unit& u, int wr, int wc, int fr, int fq) const {
#pragma unroll
        for (int ai = 0; ai < 2; ++ai)
#pragma unroll
            for (int m = 0; m < 4; ++m) {
                const int r = EPI_ROW(ai, m); u32x2 wm[2] = {};
#pragma unroll
                for (int bj = 0; bj < 2; ++bj) {
                    const size_t off = (size_t)r * D + EPI_COL(bj);
                    f32x4 b0, b1; gates(SB, off, b0, b1);
#pragma unroll
                    for (int j = 0; j < 4; ++j) { b0[j] = fmaxf(b0[j], 9.094947e-13f); b1[j] = fmaxf(b1[j], 9.094947e-13f); }
                    if (u.be == 0) {
                        f32x4 a0, a1; gates(SA, off, a0, a1);
#pragma unroll
                        for (int j = 0; j < 4; ++j) { acc[ai][bj][m][0][j] *= a0[j] * __builtin_amdgcn_rcpf(b0[j]); acc[ai][bj][m][1][j] *= a1[j] * __builtin_amdgcn_rcpf(b1[j]); }
                    } else {
#if PROJ_FP8
                        wm[bj] = pack8_fp8(acc[ai][bj][m][0] * (b0 * (1.f / WSCALE)), acc[ai][bj][m][1] * (b1 * (1.f / WSCALE)));
#else
                        st16(O + off, pack8(acc[ai][bj][m][0] * b0, acc[ai][bj][m][1] * b1));
#endif
                    }
                }
#if PROJ_FP8
                if (u.be != 0) st16((unsigned char*)O + (size_t)r * D + u.pn * 256 + (fq & 1) * 128 + wc * 32 + 8 * (fq & ~1), pair16(wm[0], wm[1]));
#endif
            }
    }
};
template <> struct EpiTraits<EpiProjP> { static constexpr bool KEEP = true; };
struct EpiWo {
    const bf16_t* X; const float* modl; bf16_t* XO;
    __device__ __forceinline__ void operator()(const ACC_T, const Unit& u, int wr, int wc, int fr, int fq) const {
        const float* g1 = modl + (size_t)(u.pm >> 4) * 6 * D + 2 * D;
#pragma unroll
        for (int bj = 0; bj < 2; ++bj) {
            const int c = EPI_COL(bj); const float us = PROJ_FP8 ? 1.f / (OSCALE * WSCALE) : 1.f; const f32x4 ga = *(const f32x4*)(g1 + c) * us, gb = *(const f32x4*)(g1 + c + 4) * us;
#pragma unroll
            for (int ai = 0; ai < 2; ++ai)
#pragma unroll
                for (int m = 0; m < 4; ++m) { const size_t off = (size_t)EPI_ROW(ai, m) * D + c;
                    f32x4 x0, x1; unpack8(*(const u32x4*)(X + off), x0, x1);
                    st16((XO + off), pack8(x0 + ga * acc[ai][bj][m][0], x1 + gb * acc[ai][bj][m][1])); }
        }
    }
};
struct EpiUp {
    bf16_t* ACT; float inscale;
    __device__ __forceinline__ void operator()(const ACC_T, const Unit& u, int wr, int wc, int fr, int fq) const {
#pragma unroll
        for (int ai = 0; ai < 2; ++ai)
#pragma unroll
            for (int m = 0; m < 4; ++m) {
                f32x4 a = acc[ai][0][m][0] * inscale, b = acc[ai][0][m][1] * inscale; const f32x4 c = acc[ai][1][m][0] * inscale, d = acc[ai][1][m][1] * inscale;
#pragma unroll
                for (int j = 0; j < 4; ++j) { a[j] = a[j] * sigm(a[j]) * c[j]; b[j] = b[j] * sigm(b[j]) * d[j]; }
#if MOE_FP8
                st8((unsigned char*)ACT + (size_t)EPI_ROW(ai, m) * FF + u.pn * 128 + wc * 32 + fq * 8, pack8_fp8(a * 8.f, b * 8.f));
#else
                st16((ACT + (size_t)EPI_ROW(ai, m) * FF + u.pn * 128 + wc * 32 + fq * 8), pack8(a, b));
#endif
            }
    }
};
struct EpiDown {
    bf16_t* Y2; const unsigned* list; const float* gw; float inscale;
    __device__ __forceinline__ void operator()(const ACC_T, const Unit& u, int wr, int wc, int fr, int fq) const {
#pragma unroll
        for (int ai = 0; ai < 2; ++ai)
#pragma unroll
            for (int m = 0; m < 4; ++m) {
                const int rloc = ai * 128 + wr * 64 + m * 16 + fr;
                if (rloc < u.nv) {
                    const unsigned entry = list[(size_t)u.be * T + u.rl * 256 + rloc]; const float w = gw[entry] * inscale;
                    const u32x2 q0 = pack8_fp8(acc[ai][0][m][0] * (w * 16.f), acc[ai][0][m][1] * (w * 16.f)), q1 = pack8_fp8(acc[ai][1][m][0] * (w * 16.f), acc[ai][1][m][1] * (w * 16.f));
                    st16((unsigned char*)Y2 + (size_t)entry * D + u.pn * 256 + (fq & 1) * 128 + wc * 32 + 8 * (fq & ~1), pair16(q0, q1));
                }
            }
    }
};
}

namespace at {
struct Tensors { const bf16_t* Q; int qp; const bf16_t* K; int kp; const bf16_t* V; int vp; bf16_t* O; int op; int group; };
__device__ __forceinline__ bool next_unit(int i, int vcu, int G, int& bh, int& qb) {
    int u;
    if (G == 256) { if (i >= 4) return false; u = (vcu >> 5) * 128 + i * 32 + (vcu & 31); }
    else { u = i * G + vcu; if (u >= 1024) return false; }
    bh = u >> 4; qb = u & 15; return true;
}
template <int DQK>
__device__ __forceinline__ void attn_phase_ref(int tid, const Tensors& A, int vcu, int G) {
    int bh, qb;
    for (int i = 0; next_unit(i, vcu, G, bh, qb); ++i) {
        const int b = bh >> 3, h = bh & 7, kvh = h / A.group;
        {
            const int dh = tid >> 8;
            const size_t row = (size_t)b * S + qb * 256 + (tid & 255);
            float q[DQK], o[32];
#pragma unroll
            for (int d = 0; d < DQK; ++d) q[d] = bf2f(A.Q[row * A.qp + h * DQK + d]);
#pragma unroll
            for (int d = 0; d < 32; ++d) o[d] = 0.f;
            float l = 0.f;
            for (int k = 0; k < S; ++k) {
                const bf16_t* kr = A.K + ((size_t)b * S + k) * A.kp + kvh * DQK; const bf16_t* vr = A.V + ((size_t)b * S + k) * A.vp + kvh * 64 + dh * 32;
                float sc = 0.f;
#pragma unroll
                for (int d = 0; d < DQK; d += 8) { f32x4 k0, k1; unpack8(*(const u32x4*)(kr + d), k0, k1);
                    sc += q[d] * k0[0] + q[d + 1] * k0[1] + q[d + 2] * k0[2] + q[d + 3] * k0[3] + q[d + 4] * k1[0] + q[d + 5] * k1[1] + q[d + 6] * k1[2] + q[d + 7] * k1[3]; }
                const float p = bf2f(cvt_pk_bf16(exp2f(sc), 0.f) & 0xffffu); l += p;
#pragma unroll
                for (int d = 0; d < 32; d += 8) { f32x4 v0, v1; unpack8(*(const u32x4*)(vr + d), v0, v1);
                    o[d] += p * v0[0]; o[d + 1] += p * v0[1]; o[d + 2] += p * v0[2]; o[d + 3] += p * v0[3]; o[d + 4] += p * v1[0]; o[d + 5] += p * v1[1]; o[d + 6] += p * v1[2]; o[d + 7] += p * v1[3]; }
            }
            const float il = 1.f / l;
            __syncthreads();
#pragma unroll
            for (int d = 0; d < 32; d += 8) { f32x4 a = {o[d] * il, o[d + 1] * il, o[d + 2] * il, o[d + 3] * il}, c = {o[d + 4] * il, o[d + 5] * il, o[d + 6] * il, o[d + 7] * il};
                *(u32x4*)(A.O + row * A.op + h * 64 + dh * 32 + d) = pack8(a, c); }
        }
    }
}
#if FAST_ATTN
typedef short s16x4 __attribute__((ext_vector_type(4)));
__device__ __forceinline__ unsigned cvtpk(float lo, float hi) { f32x2 v = {lo, hi}; bf16x2_t b = __builtin_convertvector(v, bf16x2_t); return __builtin_bit_cast(unsigned, b); }
__device__ __forceinline__ s16x4 vtr(const LAS unsigned char* p) { return __builtin_bit_cast(s16x4, __builtin_amdgcn_ds_read_tr16_b64_v4i16((LAS s16x4*)p)); }
__device__ __forceinline__ int crow(int r, int hi) { return (r & 3) + 8 * (r >> 2) + 4 * hi; }
#define AT_BAR() asm volatile("s_barrier" ::: "memory")
#define AT_WAITBAR(N) asm volatile("s_waitcnt vmcnt(" #N ") lgkmcnt(0)\n\ts_barrier" ::: "memory")
#define AT_SCHED() __builtin_amdgcn_sched_barrier(0)
__device__ __forceinline__ void glds16(const void* gsrc, unsigned lds_dst) { unsigned keep;
    asm volatile("s_mov_b32 %0, m0\n\ts_mov_b32 m0, %2\n\ts_nop 0\n\tglobal_load_lds_dwordx4 %1, off\n\ts_mov_b32 m0, %0" : "=&s"(keep) : "v"(gsrc), "s"(lds_dst) : "memory"); }
#define AT_GLDS(g, l) glds16((const void*)(g), (unsigned)__builtin_amdgcn_readfirstlane((int)(unsigned)(uintptr_t)(l)))
template <int DQK>
__device__ __forceinline__ void attn_unit(int tid, LAS unsigned char* lds, const Tensors& A, int b, int h, int qb) {
    constexpr int ND = DQK / 16, NCH = DQK / 8, KSLOT = NCH * 1024, NKD = NCH > 8 ? 2 : 1, VSLOT = 8192, NT = S / 64;
    constexpr int KOFF = 0, VOFF = 3 * KSLOT, OST = VOFF + 3 * VSLOT, WSF = OST + 8 * 4096;
    static_assert(WSF + 8 * 256 <= RING_BYTES, "attention LDS");
    const int lane = tid & 63, r32 = lane & 31, hi = lane >> 5, wid = __builtin_amdgcn_readfirstlane(tid >> 6);
    const int kvh = h / A.group; const size_t rowb = (size_t)b * S;
    const bf16_t* ksrc = A.K + (rowb + lane) * A.kp + kvh * DQK + wid * 8;
    const bf16_t* ksrc2 = A.K + (rowb + lane) * A.kp + kvh * DQK + (8 + (wid & 3)) * 8;
    const bf16_t* vsrc = A.V + (rowb + 16 * (wid & 3) + (lane >> 2)) * A.vp + kvh * 64 + (wid >> 2) * 32 + (lane & 3) * 8;
    const size_t ktile = (size_t)64 * A.kp, vtile = (size_t)64 * A.vp;
    LAS unsigned char* kdst = lds + KOFF + wid * 1024; LAS unsigned char* kdst2 = lds + KOFF + (8 + (wid & 3)) * 1024; LAS unsigned char* vdst = lds + VOFF + wid * 1024;
#define DMA_K(j, so) do { AT_GLDS(ksrc + (size_t)(j) * ktile, kdst + (so)); if (NKD == 2) AT_GLDS(ksrc2 + (size_t)(j) * ktile, kdst2 + (so)); } while (0)
#define DMA_V(j, so) AT_GLDS(vsrc + (size_t)(j) * vtile, vdst + (so))
    const LAS unsigned char* kp0 = lds + KOFF + hi * 1024 + r32 * 16;
    const LAS unsigned char* vp0 = lds + VOFF + ((lane >> 4) & 1) * 32 + (lane & 3) * 8 + (4 * hi + ((lane & 15) >> 2)) * 64;
    DMA_K(0, 0); DMA_V(0, 0); DMA_K(1, KSLOT); DMA_V(1, VSLOT); DMA_K(2, 2 * KSLOT);
    const bf16_t* Qw = A.Q + (rowb + qb * 256 + wid * 32 + r32) * A.qp + h * DQK + hi * 8;
    bf16x8 qr[ND];
#pragma unroll
    for (int d0 = 0; d0 < ND; ++d0) qr[d0] = *(const bf16x8*)(Qw + d0 * 16);
    asm volatile("s_waitcnt vmcnt(0)\n\ts_barrier" ::: "memory");
    bf16x8 kf[2 * ND]; s16x4 vlo[8], vhi[8];
#define KLOAD(so) do { _Pragma("unroll") for (int d0 = 0; d0 < ND; ++d0) { kf[2 * d0] = *(const LAS bf16x8*)(kp0 + (so) + d0 * 2048); kf[2 * d0 + 1] = *(const LAS bf16x8*)(kp0 + (so) + d0 * 2048 + 512); } } while (0)
#define VLOAD(so) do { _Pragma("unroll") for (int i = 0; i < 8; ++i) { vlo[i] = vtr(vp0 + (so) + (i >> 2) * 4096 + (i & 3) * 1024); vhi[i] = vtr(vp0 + (so) + (i >> 2) * 4096 + (i & 3) * 1024 + 512); } } while (0)
#define VFR(i) (bf16x8){vlo[i][0], vlo[i][1], vlo[i][2], vlo[i][3], vhi[i][0], vhi[i][1], vhi[i][2], vhi[i][3]}
    KLOAD(0);
    asm volatile("s_waitcnt lgkmcnt(0)" ::: "memory");
    if (PROBE_ATT != 5 && wid >= 4) AT_BAR();
    f32x16 o0 = {}, o1 = {}, C0, C1; u32x4 pw0, pw1, pw2, pw3; float lsum = 0.f;
    const f32x16 zero = {};
#define QK_BLOCK() do { C0 = __builtin_amdgcn_mfma_f32_32x32x16_bf16(kf[0], qr[0], zero, 0, 0, 0); C1 = __builtin_amdgcn_mfma_f32_32x32x16_bf16(kf[1], qr[0], zero, 0, 0, 0); \
        _Pragma("unroll") for (int d0 = 1; d0 < ND; ++d0) { C0 = __builtin_amdgcn_mfma_f32_32x32x16_bf16(kf[2 * d0], qr[d0], C0, 0, 0, 0); C1 = __builtin_amdgcn_mfma_f32_32x32x16_bf16(kf[2 * d0 + 1], qr[d0], C1, 0, 0, 0); } } while (0)
#define PAF(k) __builtin_bit_cast(bf16x8, pw##k)
#define PV_BLOCK() do { \
        o0 = __builtin_amdgcn_mfma_f32_32x32x16_bf16(PAF(0), VFR(0), o0, 0, 0, 0); o1 = __builtin_amdgcn_mfma_f32_32x32x16_bf16(PAF(0), VFR(4), o1, 0, 0, 0); \
        o0 = __builtin_amdgcn_mfma_f32_32x32x16_bf16(PAF(1), VFR(1), o0, 0, 0, 0); o1 = __builtin_amdgcn_mfma_f32_32x32x16_bf16(PAF(1), VFR(5), o1, 0, 0, 0); \
        o0 = __builtin_amdgcn_mfma_f32_32x32x16_bf16(PAF(2), VFR(2), o0, 0, 0, 0); o1 = __builtin_amdgcn_mfma_f32_32x32x16_bf16(PAF(2), VFR(6), o1, 0, 0, 0); \
        o0 = __builtin_amdgcn_mfma_f32_32x32x16_bf16(PAF(3), VFR(3), o0, 0, 0, 0); o1 = __builtin_amdgcn_mfma_f32_32x32x16_bf16(PAF(3), VFR(7), o1, 0, 0, 0); } while (0)
#define SOFTMAX() do { \
        _Pragma("unroll") for (int r = 0; r < 16; ++r) { C0[r] = __builtin_amdgcn_exp2f(C0[r]); C1[r] = __builtin_amdgcn_exp2f(C1[r]); } \
        f32x2 s0_ = {C0[0], C0[1]}, s1_ = {C1[0], C1[1]}; _Pragma("unroll") for (int r = 2; r < 16; r += 2) { s0_ += (f32x2){C0[r], C0[r + 1]}; s1_ += (f32x2){C1[r], C1[r + 1]}; } s0_ += s1_; lsum += s0_[0] + s0_[1]; \
        pw0 = (u32x4){cvtpk(C0[0], C0[1]), cvtpk(C0[2], C0[3]), cvtpk(C0[4], C0[5]), cvtpk(C0[6], C0[7])}; pw1 = (u32x4){cvtpk(C0[8], C0[9]), cvtpk(C0[10], C0[11]), cvtpk(C0[12], C0[13]), cvtpk(C0[14], C0[15])}; \
        pw2 = (u32x4){cvtpk(C1[0], C1[1]), cvtpk(C1[2], C1[3]), cvtpk(C1[4], C1[5]), cvtpk(C1[6], C1[7])}; pw3 = (u32x4){cvtpk(C1[8], C1[9]), cvtpk(C1[10], C1[11]), cvtpk(C1[12], C1[13]), cvtpk(C1[14], C1[15])}; } while (0)
    int ka = 2 * KSLOT, kb = 0, kc = KSLOT, va = 2 * VSLOT, vb = 0, vc = VSLOT;
#define ROT() do { const int t_ = ka; ka = kb; kb = kc; kc = t_; const int u_ = va; va = vb; vb = vc; vc = u_; } while (0)
#define PINP() asm volatile("" : "+v"(lsum) : "v"(pw0), "v"(pw1), "v"(pw2), "v"(pw3))
#if ATT_REGSTAGE
    u32x4 kst = {}, kst2 = {}, vst = {};
    const LAS unsigned char* kw = lds + KOFF + wid * 1024 + lane * 16; const LAS unsigned char* kw2 = lds + KOFF + (8 + (wid & 3)) * 1024 + lane * 16; const LAS unsigned char* vw = lds + VOFF + wid * 1024 + lane * 16;
#define ST_WRITE(WK, WV) do { if (WK) { *(LAS u32x4*)(kw + ka) = kst; if (NKD == 2 && wid < 4) *(LAS u32x4*)(kw2 + ka) = kst2; } if (WV) *(LAS u32x4*)(vw + vc) = vst; } while (0)
#define ST_LOAD(sv, IK, IV) do { if (IK) { kst = *(const u32x4*)(ksrc + (size_t)((sv) + 4) * ktile); if (NKD == 2 && wid < 4) kst2 = *(const u32x4*)(ksrc2 + (size_t)((sv) + 4) * ktile); } if (IV) vst = *(const u32x4*)(vsrc + (size_t)((sv) + 3) * vtile); } while (0)
#define STEP(sv, DOQK, DOPV, KL, VL, IK, IV, WK, WV) do { \
        AT_SCHED(); if (DOQK) QK_BLOCK(); if (DOPV) PV_BLOCK(); AT_SCHED(); \
        asm volatile("s_barrier\n\ts_nop 15\n\ts_nop 3" : "+v"(C0), "+v"(C1), "+v"(o0), "+v"(o1) :: "memory"); AT_SCHED(); \
        if (KL) KLOAD(kc); if (VL) VLOAD(vb); ST_WRITE(WK, WV); ST_LOAD(sv, IK, IV); \
        if (DOQK) { SOFTMAX(); PINP(); } AT_SCHED(); \
        asm volatile("s_waitcnt lgkmcnt(0)\n\ts_barrier" ::: "memory"); \
        AT_SCHED(); ROT(); } while (0)
    STEP(-1, true, false, true, true, true, true, false, false);
#pragma nounroll
    for (int s = 0; s < NT - 4; ++s) STEP(s, true, true, true, true, true, true, true, true);
    STEP(NT - 4, true, true, true, true, false, true, true, true);
    STEP(NT - 3, true, true, true, true, false, false, false, true);
    STEP(NT - 2, true, true, false, true, false, false, false, false);
    STEP(NT - 1, false, true, false, false, false, false, false, false);
#undef ST_WRITE
#undef ST_LOAD
#else
#define STEP(sv, DOQK, DOPV, KL, VL, IK, IV) do { \
        AT_SCHED(); if (DOQK) QK_BLOCK(); if (DOPV) PV_BLOCK(); AT_SCHED(); \
          \
        asm volatile("s_barrier\n\ts_nop 15\n\ts_nop 3" : "+v"(C0), "+v"(C1), "+v"(o0), "+v"(o1) :: "memory"); AT_SCHED(); \
        if (KL) KLOAD(kc); if (VL) VLOAD(vb); if (IK) DMA_K((sv) + 4, kb); if (IV) DMA_V((sv) + 3, va); \
        if (DOQK) { SOFTMAX(); PINP(); } AT_SCHED(); \
        if (IK) { if (NKD == 2) { AT_WAITBAR(3); } else { AT_WAITBAR(2); } } else if (IV) { AT_WAITBAR(1); } else { AT_WAITBAR(0); } \
        AT_SCHED(); ROT(); } while (0)
    STEP(-1, true, false, true, true, true, true);
#pragma nounroll
    for (int s = 0; s < NT - 4; ++s) STEP(s, true, true, true, true, true, true);
    STEP(NT - 4, true, true, true, true, false, true);
    STEP(NT - 3, true, true, true, true, false, false);
    STEP(NT - 2, true, true, false, true, false, false);
    STEP(NT - 1, false, true, false, false, false, false);
#endif
#undef STEP
#undef PINP
    if (PROBE_ATT != 5 && wid < 4) AT_BAR();
    { auto rr = __builtin_amdgcn_permlane32_swap(__float_as_uint(lsum), __float_as_uint(lsum), false, false); lsum = __uint_as_float(rr[0]) + __uint_as_float(rr[1]); }
    LAS float* wsf = (LAS float*)(lds + WSF + wid * 256);
    if (hi == 0) wsf[r32] = lsum;
    asm volatile("s_waitcnt lgkmcnt(0)" ::: "memory");
    LAS bf16_t* stg = (LAS bf16_t*)(lds + OST + wid * 4096);
#pragma unroll
    for (int r = 0; r < 16; ++r) { const int orow = crow(r, hi); const float rl = __builtin_amdgcn_rcpf(wsf[orow]);
        stg[orow * 64 + r32] = (bf16_t)(cvtpk(o0[r] * rl, 0.f) & 0xffffu); stg[orow * 64 + 32 + r32] = (bf16_t)(cvtpk(o1[r] * rl, 0.f) & 0xffffu); }
    asm volatile("s_waitcnt lgkmcnt(0)" ::: "memory");
    bf16_t* Ow = A.O + (rowb + qb * 256 + wid * 32) * A.op + h * 64;
#pragma unroll
    for (int i = 0; i < 4; ++i) { const int row = i * 8 + (lane >> 3), ch = lane & 7; const u32x4 v = *(const LAS u32x4*)(stg + row * 64 + ch * 8); st16((Ow + (size_t)row * A.op + ch * 8), v); }
    asm volatile("s_waitcnt lgkmcnt(0)\n\ts_barrier" ::: "memory");
#undef DMA_K
#undef DMA_V
#undef KLOAD
#undef VLOAD
#undef VFR
#undef QK_BLOCK
#undef PAF
#undef PV_BLOCK
#undef SOFTMAX
#undef ROT
}
#endif
#if FAST_ATTN && ATT_FP8_A
typedef int v8i __attribute__((ext_vector_type(8)));
#define SPLAT16(x) ((f32x16){x, x, x, x, x, x, x, x, x, x, x, x, x, x, x, x})
__device__ __forceinline__ f32x16 mfma8(v8i a, v8i b, f32x16 c) { return __builtin_amdgcn_mfma_scale_f32_32x32x64_f8f6f4(a, b, c, 0, 0, 0, 0, 0, 0); }
__device__ __forceinline__ f32x16 mfma8pv(v8i a, v8i b, f32x16 c) { return __builtin_amdgcn_mfma_scale_f32_32x32x64_f8f6f4(a, b, c, 1, 0, 0, 0, 0, 0); }
__device__ __forceinline__ void attn_unit_f8a(int tid, LAS unsigned char* lds, const unsigned char* Q8, const unsigned char* K8, const unsigned char* VT8, bf16_t* O, int op, int b, int h, int qb, float bias) {
    constexpr int SL = 4096, NT = S / 64;
    constexpr int KOFF = 0, VOFF = 4 * SL, OST = VOFF + 4 * SL, WSF = OST + 8 * 4096;
    const int lane = tid & 63, r32 = lane & 31, hi = lane >> 5, wid = __builtin_amdgcn_readfirstlane(tid >> 6);
    const int kvh = h >> 2; const size_t rowb = (size_t)b * S; const bool kw = wid < 4;
    const unsigned char* src = kw ? K8 + (rowb + lane) * 128 + kvh * 64 + 16 * wid : VT8 + ((size_t)((b * 2 + kvh) * 64 + lane)) * S + 16 * (wid - 4);
    const size_t tstep = kw ? (size_t)64 * 128 : (size_t)64;
    LAS unsigned char* dst = lds + (kw ? KOFF + wid * 1024 : VOFF + (wid - 4) * 1024);
#define DMA8(j, so) AT_GLDS(src + (size_t)(j) * tstep, dst + (so))
    const LAS unsigned char* kp0 = lds + KOFF + (2 * hi) * 1024 + r32 * 16;
    const LAS unsigned char* vp0 = lds + VOFF + (2 * hi) * 1024 + r32 * 16;
    DMA8(0, 0); DMA8(1, SL); DMA8(2, 2 * SL);
    v8i qf; { const unsigned char* Qw = Q8 + (rowb + qb * 256 + wid * 32 + r32) * 512 + h * 64 + 32 * hi; const u32x4 a = *(const u32x4*)Qw, c = *(const u32x4*)(Qw + 16);
        qf = (v8i){(int)a.x, (int)a.y, (int)a.z, (int)a.w, (int)c.x, (int)c.y, (int)c.z, (int)c.w}; }
    asm volatile("s_waitcnt vmcnt(0)\n\ts_barrier" ::: "memory");
    v8i kf0, kf1, vf0, vf1, p8;
#define LD32(dstv, p) do { const u32x4 a_ = *(const LAS u32x4*)(p), c_ = *(const LAS u32x4*)((p) + 1024); dstv = (v8i){(int)a_.x, (int)a_.y, (int)a_.z, (int)a_.w, (int)c_.x, (int)c_.y, (int)c_.z, (int)c_.w}; } while (0)
#define KLOAD8(so) do { LD32(kf0, kp0 + (so)); LD32(kf1, kp0 + (so) + 512); } while (0)
#define VLOAD8(so) do { LD32(vf0, vp0 + (so)); LD32(vf1, vp0 + (so) + 512); } while (0)
    KLOAD8(0);
    asm volatile("s_waitcnt lgkmcnt(0)" ::: "memory");
    if (wid >= 4) AT_BAR();
    float z_ = 0.f; asm volatile("" : "+v"(z_));
    f32x16 o0 = SPLAT16(z_), o1 = SPLAT16(z_), o2 = SPLAT16(z_), C0, C1;
    const v8i ones = {0x38383838, 0x38383838, 0x38383838, 0x38383838, 0x38383838, 0x38383838, 0x38383838, 0x38383838};
    float nb_ = PFOLD * bias + PBYTE0; asm volatile("" : "+v"(nb_));
    f32x16 negb = SPLAT16(nb_);
    asm volatile("" : "+v"(negb));
#define SOFTMAX8() do { \
        _Pragma("unroll") for (int i = 0; i < 4; ++i) { \
            const f32x2 a_ = (f32x2){C0[4 * i], C0[4 * i + 1]}, b_ = (f32x2){C0[4 * i + 2], C0[4 * i + 3]}, c_ = (f32x2){C1[4 * i], C1[4 * i + 1]}, d_ = (f32x2){C1[4 * i + 2], C1[4 * i + 3]}; \
            p8[i] = (int)__builtin_amdgcn_cvt_pk_u8_f32(b_[1], 3, __builtin_amdgcn_cvt_pk_u8_f32(b_[0], 2, __builtin_amdgcn_cvt_pk_u8_f32(a_[1], 1, __builtin_amdgcn_cvt_pk_u8_f32(a_[0], 0, 0u)))); \
            p8[4 + i] = (int)__builtin_amdgcn_cvt_pk_u8_f32(d_[1], 3, __builtin_amdgcn_cvt_pk_u8_f32(d_[0], 2, __builtin_amdgcn_cvt_pk_u8_f32(c_[1], 1, __builtin_amdgcn_cvt_pk_u8_f32(c_[0], 0, 0u)))); } } while (0)
#define STEP8(sv, DOQK2, DOSM, DOPV, KL, VL, ISS, WN, NOPS) do { \
        AT_SCHED(); \
        if (KL) { LD32(kf0, kp0 + (((sv) + 2) & 3) * SL); LD32(kf1, kp0 + (((sv) + 2) & 3) * SL + 512); } AT_SCHED(); \
        if (DOPV) { o0 = mfma8pv(p8, vf0, o0); } if (VL) LD32(vf0, vp0 + (((sv) + 1) & 3) * SL); AT_SCHED(); \
        if (DOPV) { o1 = mfma8pv(p8, vf1, o1); } if (VL) LD32(vf1, vp0 + (((sv) + 1) & 3) * SL + 512); AT_SCHED(); \
        if (DOPV) { o2 = mfma8pv(p8, ones, o2); } if (ISS) DMA8((sv) + 4, (((sv) + 4) & 3) * SL); AT_SCHED(); \
        asm volatile("s_barrier\n\t" NOPS : "+v"(C0), "+v"(C1), "+v"(o0), "+v"(o1), "+v"(o2) :: "memory"); AT_SCHED(); \
        if (DOSM) { SOFTMAX8(); asm volatile("" :: "v"(p8)); } AT_SCHED(); \
        if (DOQK2) { asm volatile("s_waitcnt lgkmcnt(0)" ::: "memory"); C0 = mfma8(kf0, qf, negb); C1 = mfma8(kf1, qf, negb); } AT_SCHED(); \
        asm volatile("s_waitcnt vmcnt(" #WN ") lgkmcnt(0)\n\ts_barrier" : "+v"(C0), "+v"(C1), "+v"(o0), "+v"(o1), "+v"(o2) :: "memory"); \
        AT_SCHED(); } while (0)
    C0 = mfma8(kf0, qf, negb); C1 = mfma8(kf1, qf, negb);
    STEP8(-1, true, true, false, true, true, true, 1, "s_nop 15\n\ts_nop 15");
#pragma nounroll
    for (int s = 0; s < NT - 4; ++s) STEP8(s, true, true, true, true, true, true, 1, "s_nop 1");
    STEP8(NT - 4, true, true, true, true, true, false, 0, "s_nop 1");
    STEP8(NT - 3, true, true, true, true, true, false, 0, "s_nop 1");
    STEP8(NT - 2, false, true, true, false, true, false, 0, "s_nop 15\n\ts_nop 15");
    STEP8(NT - 1, false, false, true, false, false, false, 0, "s_nop 15\n\ts_nop 15");
    if (wid < 4) AT_BAR();
#if PROJ_FP8
    LAS unsigned char* stg8 = lds + OST + wid * 4096;
#pragma unroll
    for (int r = 0; r < 16; ++r) { const int orow = crow(r, hi); const float rl = __builtin_amdgcn_rcpf(o2[r]) * OSCALE;
        const unsigned pk = (unsigned)__builtin_amdgcn_cvt_pk_fp8_f32(o0[r] * rl, o1[r] * rl, 0, false);
        stg8[orow * 64 + r32] = (unsigned char)(pk & 0xffu); stg8[orow * 64 + 32 + r32] = (unsigned char)((pk >> 8) & 0xffu); }
    asm volatile("s_waitcnt lgkmcnt(0)" ::: "memory");
    unsigned char* Ow8 = (unsigned char*)O + (rowb + qb * 256 + wid * 32) * op + h * 64;
#pragma unroll
    for (int i = 0; i < 2; ++i) { const int idx = i * 64 + lane, row = idx >> 2, ch = idx & 3; const u32x4 v = *(const LAS u32x4*)(stg8 + row * 64 + ch * 16); st16(Ow8 + (size_t)row * op + ch * 16, v); }
#else
    LAS bf16_t* stg = (LAS bf16_t*)(lds + OST + wid * 4096);
#pragma unroll
    for (int r = 0; r < 16; ++r) { const int orow = crow(r, hi); const float rl = __builtin_amdgcn_rcpf(o2[r]);
        stg[orow * 64 + r32] = (bf16_t)(cvtpk(o0[r] * rl, 0.f) & 0xffffu); stg[orow * 64 + 32 + r32] = (bf16_t)(cvtpk(o1[r] * rl, 0.f) & 0xffffu); }
    asm volatile("s_waitcnt lgkmcnt(0)" ::: "memory");
    bf16_t* Ow = O + (rowb + qb * 256 + wid * 32) * op + h * 64;
#pragma unroll
    for (int i = 0; i < 4; ++i) { const int row = i * 8 + (lane >> 3), ch = lane & 7; const u32x4 v = *(const LAS u32x4*)(stg + row * 64 + ch * 8); st16(Ow + (size_t)row * op + ch * 8, v); }
    #endif
    asm volatile("s_waitcnt lgkmcnt(0)\n\ts_barrier" ::: "memory");
#undef DMA8
#undef LD32
#undef KLOAD8
#undef VLOAD8
#undef SOFTMAX8
#undef STEP8
}
__device__ __forceinline__ void attn_phase_f8a(int tid, LAS unsigned char* lds, const unsigned char* Q8, const unsigned char* K8, const unsigned char* VT8, bf16_t* O, int op, const float* gq, const float* gk, int vcu, int G) {
    float mq = 0.f, mk = 0.f;
    for (int i = 0; i < 64; ++i) { mq = fmaxf(mq, fabsf(gq[i])); mk = fmaxf(mk, fabsf(gk[i])); }
    const float bias = -fmaxf(64.f * mq * mk * QSCALE_A * 1.13f - 15.5f, 0.f);
    int bh, qb;
    for (int i = 0; next_unit(i, vcu, G, bh, qb); ++i) attn_unit_f8a(tid, lds, Q8, K8, VT8, O, op, bh >> 3, bh & 7, qb, bias);
}
#endif
#if FAST_ATTN && ATT_FP8_B
__device__ __forceinline__ void attn_unit_f8b(int tid, LAS unsigned char* lds, const unsigned char* Q8, const unsigned char* K8, const unsigned char* VT8, bf16_t* O, int op, int b, int h, int qb) {
    constexpr int SLK = 6144, SLV = 4096, NT = S / 64;
    constexpr int KOFF = 0, VOFF = 4 * SLK, OST = VOFF + 4 * SLV, WSF = OST + 8 * 4096;
    static_assert(WSF + 2048 <= RING_BYTES, "attention LDS");
    const int lane = tid & 63, r32 = lane & 31, hi = lane >> 5, wid = __builtin_amdgcn_readfirstlane(tid >> 6);
    const size_t rowb = (size_t)b * S; const bool kw = wid < 6, vw = wid >= 4;
    const unsigned char* ksrc = K8 + (rowb + lane) * 768 + h * 96 + 16 * wid;
    const unsigned char* vsrc = VT8 + ((size_t)((b * 8 + h) * 64 + lane)) * S + 16 * (wid - 4);
    LAS unsigned char* kdst = lds + KOFF + wid * 1024; LAS unsigned char* vdst = lds + VOFF + (wid - 4) * 1024;
#define DMAK(j, so) AT_GLDS(ksrc + (size_t)(j) * (64 * 768), kdst + (so))
#define DMAV(j, so) AT_GLDS(vsrc + (size_t)(j) * 64, vdst + (so))
    const LAS unsigned char* kp0 = lds + KOFF + (2 * hi) * 1024 + r32 * 16;
    const LAS unsigned char* kr0 = lds + KOFF + 4 * 1024 + r32 * 16;
    const LAS unsigned char* vp0 = lds + VOFF + (2 * hi) * 1024 + r32 * 16;
    if (kw) { DMAK(0, 0); DMAK(1, SLK); DMAK(2, 2 * SLK); DMAK(3, 3 * SLK); }
    if (vw) { DMAV(0, 0); DMAV(1, SLV); DMAV(2, 2 * SLV); }
    v8i qn, qr;
    { const unsigned char* Qw = Q8 + (rowb + qb * 256 + wid * 32 + r32) * 768 + h * 96; const u32x4 a = *(const u32x4*)(Qw + 32 * hi), c = *(const u32x4*)(Qw + 32 * hi + 16), e = *(const u32x4*)(Qw + 64), f = *(const u32x4*)(Qw + 80);
      qn = (v8i){(int)a.x, (int)a.y, (int)a.z, (int)a.w, (int)c.x, (int)c.y, (int)c.z, (int)c.w};
      qr = hi ? (v8i){0, 0, 0, 0, 0, 0, 0, 0} : (v8i){(int)e.x, (int)e.y, (int)e.z, (int)e.w, (int)f.x, (int)f.y, (int)f.z, (int)f.w}; }
    asm volatile("s_waitcnt vmcnt(0)\n\ts_barrier" ::: "memory");
    v8i kn0, kn1, kr0v, kr1v, vf0, vf1, p8;
#define LD32(dstv, p) do { const u32x4 a_ = *(const LAS u32x4*)(p), c_ = *(const LAS u32x4*)((p) + 1024); dstv = (v8i){(int)a_.x, (int)a_.y, (int)a_.z, (int)a_.w, (int)c_.x, (int)c_.y, (int)c_.z, (int)c_.w}; } while (0)
#define KLOAD8(so) do { LD32(kn0, kp0 + (so)); LD32(kn1, kp0 + (so) + 512); LD32(kr0v, kr0 + (so)); LD32(kr1v, kr0 + (so) + 512); } while (0)
#define VLOAD8(so) do { LD32(vf0, vp0 + (so)); LD32(vf1, vp0 + (so) + 512); } while (0)
    KLOAD8(0);
    asm volatile("s_waitcnt lgkmcnt(0)" ::: "memory");
    if (wid >= 4) AT_BAR();
    float z_ = 0.f, pb_ = PBYTE0; asm volatile("" : "+v"(z_), "+v"(pb_));
    f32x16 o0 = SPLAT16(z_), o1 = SPLAT16(z_), o2 = SPLAT16(z_), C0, C1;
    f32x16 zero = SPLAT16(pb_);
    asm volatile("" : "+v"(zero));
    const v8i ones = {0x38383838, 0x38383838, 0x38383838, 0x38383838, 0x38383838, 0x38383838, 0x38383838, 0x38383838};
#define SOFTMAX8() do { \
        _Pragma("unroll") for (int i = 0; i < 4; ++i) { \
            const f32x2 a_ = (f32x2){C0[4 * i], C0[4 * i + 1]}, b_ = (f32x2){C0[4 * i + 2], C0[4 * i + 3]}, c_ = (f32x2){C1[4 * i], C1[4 * i + 1]}, d_ = (f32x2){C1[4 * i + 2], C1[4 * i + 3]}; \
            p8[i] = (int)__builtin_amdgcn_cvt_pk_u8_f32(b_[1], 3, __builtin_amdgcn_cvt_pk_u8_f32(b_[0], 2, __builtin_amdgcn_cvt_pk_u8_f32(a_[1], 1, __builtin_amdgcn_cvt_pk_u8_f32(a_[0], 0, 0u)))); \
            p8[4 + i] = (int)__builtin_amdgcn_cvt_pk_u8_f32(d_[1], 3, __builtin_amdgcn_cvt_pk_u8_f32(d_[0], 2, __builtin_amdgcn_cvt_pk_u8_f32(c_[1], 1, __builtin_amdgcn_cvt_pk_u8_f32(c_[0], 0, 0u)))); } } while (0)
#define STEP8(sv, DOQK, DOPV, KL, VL, IK, IV, WK, WV, WB, NOPS) do { \
        AT_SCHED(); if (DOQK) { C0 = mfma8(kn0, qn, zero); C1 = mfma8(kn1, qn, zero); C0 = mfma8(kr0v, qr, C0); C1 = mfma8(kr1v, qr, C1); } if (DOPV) { o0 = mfma8pv(p8, vf0, o0); o1 = mfma8pv(p8, vf1, o1); o2 = mfma8pv(p8, ones, o2); } AT_SCHED(); \
        asm volatile("s_barrier\n\t" NOPS : "+v"(C0), "+v"(C1), "+v"(o0), "+v"(o1), "+v"(o2) :: "memory"); AT_SCHED(); \
        if (KL) KLOAD8((((sv) + 2) & 3) * SLK); if (VL) VLOAD8((((sv) + 1) & 3) * SLV); \
        if (kw && (IK)) DMAK((sv) + 5, (((sv) + 1) & 3) * SLK); if (vw && (IV)) DMAV((sv) + 4, ((sv) & 3) * SLV); \
        if (DOQK) { SOFTMAX8(); asm volatile("" :: "v"(p8)); } AT_SCHED(); \
        if (kw && vw) { AT_WAITBAR(WB); } else if (kw) { AT_WAITBAR(WK); } else { AT_WAITBAR(WV); } \
        AT_SCHED(); } while (0)
    STEP8(-1, true, false, true, true, true, true, 2, 2, 4, "s_nop 15\n\ts_nop 15");
#pragma nounroll
    for (int s = 0; s < NT - 5; ++s) STEP8(s, true, true, true, true, true, true, 2, 2, 4, "s_nop 1");
    STEP8(NT - 5, true, true, true, true, false, true, 1, 2, 3, "s_nop 15\n\ts_nop 15");
    STEP8(NT - 4, true, true, true, true, false, false, 0, 1, 1, "s_nop 15\n\ts_nop 15");
    STEP8(NT - 3, true, true, true, true, false, false, 0, 0, 0, "s_nop 15\n\ts_nop 15");
    STEP8(NT - 2, true, true, false, true, false, false, 0, 0, 0, "s_nop 15\n\ts_nop 15");
    STEP8(NT - 1, false, true, false, false, false, false, 0, 0, 0, "s_nop 15\n\ts_nop 15");
    if (wid < 4) AT_BAR();
#if PROJ_FP8
    LAS unsigned char* stg8 = lds + OST + wid * 4096;
#pragma unroll
    for (int r = 0; r < 16; ++r) { const int orow = crow(r, hi); const float rl = __builtin_amdgcn_rcpf(o2[r]) * OSCALE;
        const unsigned pk = (unsigned)__builtin_amdgcn_cvt_pk_fp8_f32(o0[r] * rl, o1[r] * rl, 0, false);
        stg8[orow * 64 + r32] = (unsigned char)(pk & 0xffu); stg8[orow * 64 + 32 + r32] = (unsigned char)((pk >> 8) & 0xffu); }
    asm volatile("s_waitcnt lgkmcnt(0)" ::: "memory");
    unsigned char* Ow8 = (unsigned char*)O + (rowb + qb * 256 + wid * 32) * op + h * 64;
#pragma unroll
    for (int i = 0; i < 2; ++i) { const int idx = i * 64 + lane, row = idx >> 2, ch = idx & 3; const u32x4 v = *(const LAS u32x4*)(stg8 + row * 64 + ch * 16); st16(Ow8 + (size_t)row * op + ch * 16, v); }
#else
    LAS bf16_t* stg = (LAS bf16_t*)(lds + OST + wid * 4096);
#pragma unroll
    for (int r = 0; r < 16; ++r) { const int orow = crow(r, hi); const float rl = __builtin_amdgcn_rcpf(o2[r]);
        stg[orow * 64 + r32] = (bf16_t)(cvtpk(o0[r] * rl, 0.f) & 0xffffu); stg[orow * 64 + 32 + r32] = (bf16_t)(cvtpk(o1[r] * rl, 0.f) & 0xffffu); }
    asm volatile("s_waitcnt lgkmcnt(0)" ::: "memory");
    bf16_t* Ow = O + (rowb + qb * 256 + wid * 32) * op + h * 64;
#pragma unroll
    for (int i = 0; i < 4; ++i) { const int row = i * 8 + (lane >> 3), ch = lane & 7; const u32x4 v = *(const LAS u32x4*)(stg + row * 64 + ch * 8); st16(Ow + (size_t)row * op + ch * 8, v); }
    #endif
    asm volatile("s_waitcnt lgkmcnt(0)\n\ts_barrier" ::: "memory");
#undef DMAK
#undef DMAV
#undef LD32
#undef KLOAD8
#undef VLOAD8
#undef SOFTMAX8
#undef STEP8
}
__device__ __forceinline__ void attn_phase_f8b(int tid, LAS unsigned char* lds, const unsigned char* Q8, const unsigned char* K8, const unsigned char* VT8, bf16_t* O, int op, int vcu, int G) {
    int bh, qb;
    for (int i = 0; next_unit(i, vcu, G, bh, qb); ++i) attn_unit_f8b(tid, lds, Q8, K8, VT8, O, op, bh >> 3, bh & 7, qb);
}
#endif
template <int DQK>
__device__ __forceinline__ void attn_phase(int tid, LAS unsigned char* lds, const Tensors& A, int vcu, int G) {
#if FAST_ATTN
    int bh, qb;
    for (int i = 0; next_unit(i, vcu, G, bh, qb); ++i) attn_unit<DQK>(tid, lds, A, bh >> 3, bh & 7, qb);
#else
    (void)lds; attn_phase_ref<DQK>(tid, A, vcu, G);
#endif
}
}


struct Args { const float* in[22]; float* out; unsigned char* ws; int ph_lo, ph_hi; };
struct Frame {
    LAS unsigned char* lds; volatile LAS unsigned* MISC; unsigned* ctl;
    int tid, lane, wave, vcu, G;
    unsigned char* ws; float* OUT;
};

__device__ __forceinline__ void p0_phase(Frame& F, const float* c, const float* w_ada, const float* b_ada) {
    LAS float* cs = (LAS float*)F.lds;
    LAS float* red = (LAS float*)(F.lds + 32768);
    for (int i = F.tid; i < NB * D; i += NTHREADS) { const float v = c[i]; cs[i] = v / (1.f + __expf(-v)); }
    __syncthreads();
    float* mod = (float*)(F.ws + WS_MOD);
    const int kq = F.wave, col = F.lane;
    for (int item = F.vcu; item < NL * 6 * D / 64; item += F.G) {
        const int l = item / (6 * D / 64), n0 = (item % (6 * D / 64)) * 64;
        const float* w = w_ada + (size_t)l * D * 6 * D + n0 + col;
        float acc[NB];
#pragma unroll
        for (int b = 0; b < NB; ++b) acc[b] = 0.f;
#pragma unroll 8
        for (int k = kq * 128; k < kq * 128 + 128; ++k) { const float wv = w[(size_t)k * 6 * D];
#pragma unroll
            for (int b = 0; b < NB; ++b) acc[b] += cs[b * D + k] * wv; }
#pragma unroll
        for (int b = 0; b < NB; ++b) red[(kq * NB + b) * 64 + col] = acc[b];
        __syncthreads();
        { const int b = F.wave; float s = 0.f;
#pragma unroll
          for (int q = 0; q < 8; ++q) s += red[(q * NB + b) * 64 + col];
          mod[((size_t)l * NB + b) * 6 * D + n0 + col] = s + b_ada[(size_t)l * 6 * D + n0 + col]; }
        __syncthreads();
    }
    float* cosA = (float*)(F.ws + WS_COSA); float* sinA = (float*)(F.ws + WS_SINA); float* cosB = (float*)(F.ws + WS_COSB); float* sinB = (float*)(F.ws + WS_SINB);
    for (int idx = F.vcu * NTHREADS + F.tid; idx < S * 48; idx += F.G * NTHREADS) {
        const int s = idx / 48, i = idx % 48; const float row = (float)(s >> 6), col2 = (float)(s & 63);
        if (i < 32) { const int j = i & 15; const float a = (i < 16 ? row : col2) * (1.0f / powf(10000.0f, (float)j / 16.0f)); cosA[s * 32 + i] = cosf(a); sinA[s * 32 + i] = sinf(a); }
        else { const int ii = i - 32, j = ii & 7; const float a = (ii < 8 ? row : col2) * (1.0f / powf(10000.0f, (float)j / 8.0f)); cosB[s * 16 + ii] = cosf(a); sinB[s * 16 + ii] = sinf(a); }
    }
}

template <class SrcFn>
__device__ __forceinline__ void cvt_item(const float* W, int K, int Nsrc, const float* kg, bf16_t* WT, LAS float* scr, int item, int nblk, int lane, const SrcFn& src, float f8scale = 0.f) {
    const int kb = item / nblk, nb = item % nblk, k0 = 64 * kb, n0 = 32 * nb;
    const int sc = src(n0 + (lane & 31));
#pragma unroll
    for (int i = 0; i < 32; ++i) { const int kk = 2 * i + (lane >> 5); float v = sc >= 0 ? W[(size_t)(k0 + kk) * Nsrc + sc] : 0.f; if (kg) v *= kg[k0 + kk]; scr[kk * 33 + (lane & 31)] = v; }
    LDS_WAIT(); asm volatile("" ::: "memory");
    const int c = lane & 7;
    if (f8scale != 0.f) {
#pragma unroll
        for (int j = 0; j < 4; ++j) { const int n = (lane >> 3) + 8 * j; const LAS float* sp = scr + (8 * c) * 33 + n;
            const u32x2 o = pack8_fp8((f32x4){sp[0 * 33], sp[1 * 33], sp[2 * 33], sp[3 * 33]} * f8scale, (f32x4){sp[4 * 33], sp[5 * 33], sp[6 * 33], sp[7 * 33]} * f8scale);
            *(u32x2*)((unsigned char*)WT + (size_t)(n0 + n) * K + k0 + 8 * c) = o; }
    } else {
#pragma unroll
    for (int j = 0; j < 4; ++j) { const int n = (lane >> 3) + 8 * j; const LAS float* s = scr + (8 * c) * 33 + n;
        u32x4 o; o.x = cvt_pk_bf16(s[0 * 33], s[1 * 33]); o.y = cvt_pk_bf16(s[2 * 33], s[3 * 33]); o.z = cvt_pk_bf16(s[4 * 33], s[5 * 33]); o.w = cvt_pk_bf16(s[6 * 33], s[7 * 33]);
        *(u32x4*)(WT + (size_t)(n0 + n) * K + k0 + 8 * c) = o; }
    }
    LDS_WAIT(); asm volatile("" ::: "memory");
}
struct SrcId { __device__ int operator()(int n) const { return n; } };
struct SrcIn { __device__ int operator()(int n) const { return gp::src_col_in(n); } };
typedef __attribute__((address_space(4))) const Args CArgsW;
__device__ __forceinline__ void convert_weights(Frame& F, CArgsW* a, int l) {
    LAS float* scr = (LAS float*)(F.lds + F.wave * 16384);
    const int gw = F.vcu * NWAVES + F.wave, NGW = F.G * NWAVES;
    const float* w_in = ((const float*)(GAS const float*)a->in[5]) + (size_t)l * D * INC; const float* w_q_b = ((const float*)(GAS const float*)a->in[10]) + (size_t)l * 384 * 768; const float* w_kv_b = ((const float*)(GAS const float*)a->in[11]) + (size_t)l * 256 * 1024;
    const float* w_pa = ((const float*)(GAS const float*)a->in[12]) + (size_t)l * 512 * D; const float* w_pb = ((const float*)(GAS const float*)a->in[13]) + (size_t)l * 512 * D; const float* w_o = ((const float*)(GAS const float*)a->in[14]) + (size_t)l * D * D;
    const float* w1 = ((const float*)(GAS const float*)a->in[18]) + (size_t)l * NE * D * FF; const float* w3 = ((const float*)(GAS const float*)a->in[19]) + (size_t)l * NE * D * FF; const float* w2 = ((const float*)(GAS const float*)a->in[20]) + (size_t)l * NE * FF * D;
    const float* gqa = ((const float*)(GAS const float*)a->in[8]) + l * 384; const float* gkv = ((const float*)(GAS const float*)a->in[9]) + l * 256;
    bf16_t* Win = (bf16_t*)(F.ws + WS_WIN); bf16_t* Wqb = (bf16_t*)(F.ws + WS_WQB); bf16_t* Wkvb = (bf16_t*)(F.ws + WS_WKVB); bf16_t* Wpa = (bf16_t*)(F.ws + WS_WPA); bf16_t* Wpb = (bf16_t*)(F.ws + WS_WPB);
    bf16_t* Wo = (bf16_t*)(F.ws + WS_WO); bf16_t* W13 = (bf16_t*)(F.ws + WS_W13); bf16_t* W2 = (bf16_t*)(F.ws + WS_W2);
    constexpr int I_IN = (D / 64) * (NIN / 32), I_QB = (384 / 64) * (768 / 32), I_KVB = (256 / 64) * (1024 / 32), I_P = (512 / 64) * (D / 32), I_O = (D / 64) * (D / 32);
    constexpr int I_13 = (D / 64) * (1024 / 32), I_2 = (FF / 64) * (D / 32);
    constexpr int NITEMS = I_IN + I_QB + I_KVB + 2 * I_P + I_O + NE * (I_13 + I_2);
    for (int it = gw; it < NITEMS; it += NGW) {
        int r = it;
        if (r < I_IN) { cvt_item(w_in, D, INC, nullptr, Win, scr, r, NIN / 32, F.lane, SrcIn(), G1_FP8 ? 16.f : 0.f); continue; } r -= I_IN;
        if (r < I_QB) { cvt_item(w_q_b, 384, 768, gqa, Wqb, scr, r, 768 / 32, F.lane, SrcId()); continue; } r -= I_QB;
        if (r < I_KVB) { cvt_item(w_kv_b, 256, 1024, gkv, Wkvb, scr, r, 1024 / 32, F.lane, SrcId()); continue; } r -= I_KVB;
        if (r < I_P) { cvt_item(w_pa, 512, D, nullptr, Wpa, scr, r, D / 32, F.lane, SrcId(), PROJ_FP8 ? WSCALE : 0.f); continue; } r -= I_P;
        if (r < I_P) { cvt_item(w_pb, 512, D, nullptr, Wpb, scr, r, D / 32, F.lane, SrcId(), PROJ_FP8 ? WSCALE : 0.f); continue; } r -= I_P;
        if (r < I_O) { cvt_item(w_o, D, D, nullptr, Wo, scr, r, D / 32, F.lane, SrcId(), PROJ_FP8 ? WSCALE : 0.f); continue; } r -= I_O;
        if (r < NE * I_13) { const int e = r / I_13, q = r % I_13, nb = q % 32;
            const float* src = ((nb & 7) < 4 ? w1 : w3) + (size_t)e * D * FF; const int cb = (nb >> 3) * 128 + (nb & 3) * 32;
            struct SrcOff { int n0, cb; __device__ int operator()(int n) const { return cb + (n - n0); } } so{nb * 32, cb};
            if (MOE_FP8) cvt_item(src, D, FF, nullptr, (bf16_t*)((unsigned char*)W13 + (size_t)e * 1024 * D), scr, q, 32, F.lane, so, 16.f);
            else cvt_item(src, D, FF, nullptr, W13 + (size_t)e * 1024 * D, scr, q, 32, F.lane, so);
            continue; } r -= NE * I_13;
        { const int e = r / I_2, q = r % I_2;
          if (MOE_FP8) cvt_item(w2 + (size_t)e * FF * D, FF, D, nullptr, (bf16_t*)((unsigned char*)W2 + (size_t)e * D * FF), scr, q, D / 32, F.lane, SrcId(), 16.f);
          else cvt_item(w2 + (size_t)e * FF * D, FF, D, nullptr, W2 + (size_t)e * D * FF, scr, q, D / 32, F.lane, SrcId()); }
    }
}

template <int MODE>
__device__ __forceinline__ void row_phase(Frame& F, const float* xin, const float* g2prev, const float* gain, const float* modl, int sh_off, int sc_off, bf16_t* H, bf16_t* XB, float* OUT) {
    constexpr int RB = 4, RPW = T / (256 * NWAVES);
    const int gw = F.vcu * NWAVES + F.wave, b = (gw * RPW) >> 12;
    const bf16_t* Y2 = (const bf16_t*)(F.ws + WS_Y2);
    f32x4 gs[4], shv[4], g2v[4];
#pragma unroll
    for (int j = 0; j < 4; ++j) { const int c = 4 * F.lane + 256 * j; gs[j] = *(const f32x4*)(gain + c);
        if (MODE != 2) { gs[j] = gs[j] * (1.f + *(const f32x4*)(modl + (size_t)b * 6 * D + sc_off + c)); shv[j] = *(const f32x4*)(modl + (size_t)b * 6 * D + sh_off + c); }
        if (MODE != 0) g2v[j] = *(const f32x4*)(g2prev + (size_t)b * 6 * D + 5 * D + c); }
    for (int m0 = gw * RPW; m0 < gw * RPW + RPW; m0 += RB) {
        f32x4 v[RB][4]; float ss[RB];
        if (MODE == 0) {
#pragma unroll
            for (int r = 0; r < RB; ++r)
#pragma unroll
                for (int j = 0; j < 4; ++j) v[r][j] = *(const f32x4*)(xin + (size_t)(m0 + r) * D + 4 * F.lane + 256 * j);
        } else {
            unsigned ya[RB][4], yb[RB][4];
#pragma unroll
            for (int r = 0; r < RB; ++r)
#pragma unroll
                for (int j = 0; j < 4; ++j) { const int m = m0 + r, c = 4 * F.lane + 256 * j;
                    { const u32x2 xb = *(const u32x2*)(XB + (size_t)m * D + c); v[r][j] = (f32x4){bf2f(xb.x & 0xffffu), bf2f(xb.x >> 16), bf2f(xb.y & 0xffffu), bf2f(xb.y >> 16)}; }
                    ya[r][j] = *(const unsigned*)((const unsigned char*)Y2 + (size_t)(2 * m) * D + c); yb[r][j] = *(const unsigned*)((const unsigned char*)Y2 + (size_t)(2 * m + 1) * D + c); }
#pragma unroll
            for (int r = 0; r < RB; ++r)
#pragma unroll
                for (int j = 0; j < 4; ++j) { const f32x2 a0 = __builtin_amdgcn_cvt_pk_f32_fp8((int)ya[r][j], false), a1 = __builtin_amdgcn_cvt_pk_f32_fp8((int)ya[r][j], true), b0 = __builtin_amdgcn_cvt_pk_f32_fp8((int)yb[r][j], false), b1 = __builtin_amdgcn_cvt_pk_f32_fp8((int)yb[r][j], true);
                    const f32x4 y = (f32x4){a0[0] + b0[0], a0[1] + b0[1], a1[0] + b1[0], a1[1] + b1[1]} * 0.0625f;
                    v[r][j] += g2v[j] * y; }
        }
#pragma unroll
        for (int r = 0; r < RB; ++r) { ss[r] = (gp::dot4(v[r][0]) + gp::dot4(v[r][1])) + (gp::dot4(v[r][2]) + gp::dot4(v[r][3])); }
#pragma unroll
        for (int o = 1; o < 64; o <<= 1)
#pragma unroll
            for (int r = 0; r < RB; ++r) ss[r] += shfl_xor_l(ss[r], F.lane, o);
#pragma unroll
        for (int r = 0; r < RB; ++r) {
            const int m = m0 + r; const float rstd = rsqrtf(ss[r] * (1.f / D) + EPS);
#pragma unroll
            for (int j = 0; j < 4; ++j) {
                const int c = 4 * F.lane + 256 * j;
                if (MODE == 2) { *(f32x4*)(OUT + (size_t)m * D + c) = v[r][j] * rstd * gs[j]; }
                else {
                    { u32x2 xw; xw.x = cvt_pk_bf16(v[r][j][0], v[r][j][1]); xw.y = cvt_pk_bf16(v[r][j][2], v[r][j][3]); st8((XB + (size_t)m * D + c), xw); }
                    const f32x4 hv = v[r][j] * rstd * gs[j] + shv[j];
                    if (G1_FP8) { const f32x4 hq = hv * 0.0625f;
                        *(unsigned*)((unsigned char*)H + (size_t)m * D + c) = (unsigned)__builtin_amdgcn_cvt_pk_fp8_f32(hq[2], hq[3], __builtin_amdgcn_cvt_pk_fp8_f32(hq[0], hq[1], 0, false), true); }
                    else { u32x2 w; w.x = cvt_pk_bf16(hv[0], hv[1]); w.y = cvt_pk_bf16(hv[2], hv[3]);
                    st8((H + (size_t)m * D + c), w); }
                }
            }
        }
    }
}

__device__ __forceinline__ void t2_phase(Frame& F, const float* gain, const float* modl, const float* w_router, const float* rbias, int l, bool record) {
    LAS f32x4* wl = (LAS f32x4*)F.lds;
    LAS int* rec = (LAS int*)(F.lds + 65536);
    LAS float* recw = (LAS float*)(F.lds + 65536 + 2048);
    LAS int* lcnt = (LAS int*)(F.lds + 65536 + 4096);
    for (int idx = F.tid; idx < 4096; idx += NTHREADS) {
        const int lane = idx & 63, c = (idx >> 6) & 3, i = (idx >> 8) & 3, j = idx >> 10; const int k = 4 * lane + 256 * j + i;
        wl[idx] = *(const f32x4*)(w_router + (size_t)k * NE + 4 * c);
    }
    if (F.tid < 32) lcnt[F.tid] = 0;
    __syncthreads();
    constexpr int RB = 4, RPW = T / (256 * NWAVES);
    const int gw = F.vcu * NWAVES + F.wave, bt = (gw * RPW) >> 12;
    bf16_t* H = (bf16_t*)(F.ws + WS_H); const bf16_t* XB = (const bf16_t*)(F.ws + WS_XB);
    const int lane = F.lane, myrow = lane >> 4, mye = lane & 15;
    f32x4 gs[4], shv[4];
#pragma unroll
    for (int j = 0; j < 4; ++j) { const int c = 4 * lane + 256 * j; gs[j] = *(const f32x4*)(gain + c) * (1.f + *(const f32x4*)(modl + (size_t)bt * 6 * D + 4 * D + c)); shv[j] = *(const f32x4*)(modl + (size_t)bt * 6 * D + 3 * D + c); }
    int it = 0;
    for (int m0 = gw * RPW; m0 < gw * RPW + RPW; m0 += RB, ++it) {
        f32x4 v[RB][4]; float ss[RB];
#pragma unroll
        for (int r = 0; r < RB; ++r)
#pragma unroll
            for (int j = 0; j < 4; ++j) { const u32x2 xb = *(const u32x2*)(XB + (size_t)(m0 + r) * D + 4 * lane + 256 * j); v[r][j] = (f32x4){bf2f(xb.x & 0xffffu), bf2f(xb.x >> 16), bf2f(xb.y & 0xffffu), bf2f(xb.y >> 16)}; }
#pragma unroll
        for (int r = 0; r < RB; ++r) ss[r] = (gp::dot4(v[r][0]) + gp::dot4(v[r][1])) + (gp::dot4(v[r][2]) + gp::dot4(v[r][3]));
#pragma unroll
        for (int o = 1; o < 64; o <<= 1)
#pragma unroll
            for (int r = 0; r < RB; ++r) ss[r] += shfl_xor_l(ss[r], F.lane, o);
        float acc[RB * NE];
#pragma unroll
        for (int q = 0; q < RB * NE; ++q) acc[q] = 0.f;
#pragma unroll
        for (int j = 0; j < 4; ++j) {
            const int c = 4 * lane + 256 * j;
#pragma unroll
            for (int r = 0; r < RB; ++r) {
                const int m = m0 + r; const float rstd = rsqrtf(ss[r] * (1.f / D) + EPS);
                v[r][j] = v[r][j] * rstd * gs[j] + shv[j];
#if MOE_FP8
                *(unsigned*)((unsigned char*)H + (size_t)m * D + c) = (unsigned)__builtin_amdgcn_cvt_pk_fp8_f32(v[r][j][2], v[r][j][3], __builtin_amdgcn_cvt_pk_fp8_f32(v[r][j][0], v[r][j][1], 0, false), true);
#else
                u32x2 w; w.x = cvt_pk_bf16(v[r][j][0], v[r][j][1]); w.y = cvt_pk_bf16(v[r][j][2], v[r][j][3]);
                st8((H + (size_t)m * D + c), w);
#endif
            }
#pragma unroll
            for (int i = 0; i < 4; ++i)
#pragma unroll
                for (int c4 = 0; c4 < 4; ++c4) { const f32x4 wv = wl[((j * 4 + i) * 4 + c4) * 64 + lane];
#pragma unroll
                    for (int r = 0; r < RB; ++r) { const float hv = v[r][j][i];
                        acc[r * NE + 4 * c4 + 0] += hv * wv[0]; acc[r * NE + 4 * c4 + 1] += hv * wv[1]; acc[r * NE + 4 * c4 + 2] += hv * wv[2]; acc[r * NE + 4 * c4 + 3] += hv * wv[3]; } }
        }
#pragma unroll
        for (int sft = 32; sft >= 1; sft >>= 1) {
            const bool up = (lane & sft) != 0;
#pragma unroll
            for (int k = 0; k < sft; ++k) { const float a = acc[k], b = acc[k + sft]; const float keep = up ? b : a, send = up ? a : b; acc[k] = keep + shfl_xor_l(send, lane, sft); }
        }
        const float logit = acc[0];
        const float score = 1.f / (1.f + expf(-logit));
        float scv[NE], bi[NE];
#pragma unroll
        for (int e = 0; e < NE; ++e) { scv[e] = shfl_l(score, (lane & 48) | e); bi[e] = scv[e] + rbias[e]; }
        int gsel = 0; float gbest = -INFINITY;
#pragma unroll
        for (int g = 0; g < 4; ++g) { float m1 = -INFINITY, m2 = -INFINITY;
#pragma unroll
            for (int j = 0; j < 4; ++j) { const float x = bi[g * 4 + j]; if (x > m1) { m2 = m1; m1 = x; } else if (x > m2) m2 = x; }
            const float gs = m1 + m2; if (gs > gbest) { gbest = gs; gsel = g; } }
        int e1 = -1, e2 = -1; float b1 = -INFINITY, b2 = -INFINITY, s1 = 0.f, s2 = 0.f;
#pragma unroll
        for (int j = 0; j < 4; ++j) { float x = -INFINITY, sx = 0.f;
#pragma unroll
            for (int g = 0; g < 4; ++g) if (g == gsel) { x = bi[g * 4 + j]; sx = scv[g * 4 + j]; }
            const int e = gsel * 4 + j;
            if (x > b1) { b2 = b1; e2 = e1; s2 = s1; b1 = x; e1 = e; s1 = sx; } else if (x > b2) { b2 = x; e2 = e; s2 = sx; } }
        if (mye == 0) {
            const float inv = 1.f / (s1 + s2); const int slot = (it * RB + myrow) * NWAVES + F.wave;
            rec[slot * 4 + 0] = e1; rec[slot * 4 + 1] = e2;
            rec[slot * 4 + 2] = __hip_atomic_fetch_add(&lcnt[e1], 1, __ATOMIC_RELAXED, __HIP_MEMORY_SCOPE_WORKGROUP);
            rec[slot * 4 + 3] = __hip_atomic_fetch_add(&lcnt[e2], 1, __ATOMIC_RELAXED, __HIP_MEMORY_SCOPE_WORKGROUP);
            recw[slot * 2 + 0] = s1 * inv; recw[slot * 2 + 1] = s2 * inv;
        }
    }
    __syncthreads();
    if (!record) return;
    if (F.tid < NE) lcnt[16 + F.tid] = (int)__hip_atomic_fetch_add(F.ctl + CW_CNT + (l * NE + F.tid) * 64, (unsigned)lcnt[F.tid], __ATOMIC_RELAXED, __HIP_MEMORY_SCOPE_AGENT);
    __syncthreads();
    unsigned* list = (unsigned*)(F.ws + WS_LIST); float* gwb = (float*)(F.ws + WS_GW);
    const int nrows = it * RB;
    for (int s = F.tid; s < nrows * NWAVES; s += NTHREADS) {
        const int i2 = s / NWAVES, w = s % NWAVES; const int m = (F.vcu * NWAVES + w) * RPW + i2;
        const int e1 = rec[s * 4 + 0], e2 = rec[s * 4 + 1];
        list[(size_t)e1 * T + lcnt[16 + e1] + rec[s * 4 + 2]] = (unsigned)(2 * m); list[(size_t)e2 * T + lcnt[16 + e2] + rec[s * 4 + 3]] = (unsigned)(2 * m + 1);
        gwb[2 * m] = recw[s * 2]; gwb[2 * m + 1] = recw[s * 2 + 1];
    }
}
__device__ __forceinline__ LAS int* moe_table(Frame& F, int l) {
    LAS int* tab = (LAS int*)(F.lds + MISC_OFF + 1024);
    __syncthreads();
    if (F.tid == 0) { int acc = 0;
        for (int e = 0; e < NE; ++e) { const int c = (int)__hip_atomic_load(F.ctl + CW_CNT + (l * NE + e) * 64, __ATOMIC_RELAXED, __HIP_MEMORY_SCOPE_AGENT); tab[e] = acc; tab[32 + e] = c; acc += (c + 255) >> 8; }
        tab[16] = acc; }
    __syncthreads();
    return tab;
}

typedef __attribute__((address_space(4))) const Args CArgs;
#define LAUNDER_GP(T_, p) do { GAS T_* _t = (GAS T_*)(p); asm volatile("" : "+s"(_t)); (p) = (T_*)_t; } while (0)
#define PH_BEGIN() LAUNDER_V(F.tid); F.lane = F.tid & 63; LAUNDER_GP(unsigned, F.ctl); LAUNDER_GP(float, F.OUT); LAUNDER_GP(unsigned char, F.ws); GAS unsigned char* ws = (GAS unsigned char*)F.ws; CArgs* ka = (CArgs*)__builtin_amdgcn_kernarg_segment_ptr(); LAUNDER_S(ka); \
    float* mod = WSP(float, WS_MOD); (void)mod; (void)ka
#define WSP(T_, off) ((T_*)(GAS T_*)(ws + (off)))
#define KIN(i) ((const float*)(GAS const float*)ka->in[i])
__global__ void __launch_bounds__(NTHREADS, 2) fwd_kernel(Args args) {
    extern __shared__ __attribute__((aligned(16))) unsigned char lds_raw[];
    Frame F;
    F.lds = (LAS unsigned char*)lds_raw; F.MISC = (volatile LAS unsigned*)(F.lds + MISC_OFF);
    F.tid = threadIdx.x; F.lane = F.tid & 63; F.wave = __builtin_amdgcn_readfirstlane(F.tid >> 6);
    F.G = gridDim.x; { const int bx = blockIdx.x; F.vcu = (F.G % 8 == 0) ? (bx % 8) * (F.G / 8) + bx / 8 : bx; }
    F.ws = (unsigned char*)(GAS unsigned char*)args.ws; F.ctl = (unsigned*)(GAS unsigned*)(args.ws + WS_CTL); F.OUT = (float*)(GAS float*)args.out;
    if (F.tid < 64) F.MISC[F.tid] = 0u;
    __syncthreads();
    XcdBarrier bar; bar.bar = F.ctl + CW_BAR; bar.x = 0; bar.st = nullptr;
    if (!N_LAUNCH_MODE) bar = xcd_barrier_post(F.ctl + CW_BAR, F.MISC + 8);
    const int lo = args.ph_lo, hi = args.ph_hi;
#define IN(k) (lo <= (k) && (k) < hi)
#define SEAM(k) do { if ((k) + 1 < hi) { if (!N_LAUNCH_MODE) xcd_barrier(bar); } } while (0)
    const int cidx = (int)blockIdx.x;

    if (IN(0)) { PH_BEGIN(); p0_phase(F, KIN(1), KIN(2), KIN(3)); __syncthreads(); LAUNDER_V(F.tid); F.lane = F.tid & 63; convert_weights(F, ka, 0); SEAM(0); }
    for (int l = 0; l < NL; ++l) {
        const int pb = 1 + 9 * l;
        if (IN(pb + 0)) {
            PH_BEGIN();
            if (l > 0) for (int rep = 0; rep < ((PROBE_DUP & 8) ? 2 : 1); ++rep) { LAUNDER_V(F.tid); F.lane = F.tid & 63; convert_weights(F, ka, l); }
            if (l == 0) row_phase<0>(F, KIN(0), nullptr, KIN(4) + l * D, mod + (size_t)l * NB * 6 * D, 0, D, WSP(bf16_t, WS_H), WSP(bf16_t, WS_XB), nullptr);
            else row_phase<1>(F, nullptr, mod + (size_t)(l - 1) * NB * 6 * D, KIN(4) + l * D, mod + (size_t)l * NB * 6 * D, 0, D, WSP(bf16_t, WS_H), WSP(bf16_t, WS_XB), nullptr);
            SEAM(pb + 0);
        }
        if (IN(pb + 1)) {
            PH_BEGIN();
            gp::Gemm g{WSP(bf16_t, WS_H), WSP(const bf16_t, WS_WIN), G1_FP8 ? D / 2 : D, 0, nullptr, 0, 0, 0}; gp::DenseOrder So; So.init(T, NIN, F.G, cidx);
            gp::EpiIn E{WSP(bf16_t, ATT_FP8_A ? WS_QA8 : WS_QA), WSP(bf16_t, ATT_FP8_A ? WS_KA8 : WS_KA), WSP(bf16_t, ATT_FP8_A ? WS_VTA8 : WS_VA), WSP(bf16_t, WS_QLAT), WSP(bf16_t, WS_KVLAT), WSP(bf16_t, ATT_FP8_B ? WS_KB8 : WS_KB), WSP(bf16_t, WS_SA), WSP(bf16_t, WS_SB), WSP(float, WS_SSQ), WSP(float, WS_SSKV),
                        KIN(6) + l * 64, KIN(7) + l * 64, WSP(const float, WS_COSA), WSP(const float, WS_SINA), WSP(const float, WS_COSB), WSP(const float, WS_SINB)};
            if (PROBE_DUP & 128) { gp::EpiNull En; gp::gemm_phase<gp::EpiNull, gp::DenseOrder>(F.tid, F.lds, g, So, En); LAUNDER_V(F.tid); }
            gp::gemm_phase<gp::EpiIn, gp::DenseOrder, false, G1_FP8 != 0>(F.tid, F.lds, g, So, E); if (PROBE_DUP & (2 | 512)) { LAUNDER_V(F.tid); gp::gemm_phase<gp::EpiIn, gp::DenseOrder, false, G1_FP8 != 0>(F.tid, F.lds, g, So, E); }
            SEAM(pb + 1);
        }
        if (IN(pb + 2)) {
            { PH_BEGIN(); gp::Gemm g{WSP(bf16_t, WS_QLAT), WSP(const bf16_t, WS_WQB), 384, 0, nullptr}; gp::DenseOrder So; So.init(T, 768, F.G, cidx);
              gp::EpiQb E{WSP(bf16_t, ATT_FP8_B ? WS_QB8 : WS_QB), WSP(const float, WS_SSQ), WSP(const float, WS_COSB), WSP(const float, WS_SINB)}; gp::gemm_phase<gp::EpiQb, gp::DenseOrder>(F.tid, F.lds, g, So, E); if (PROBE_DUP & 2) { LAUNDER_V(F.tid); gp::gemm_phase<gp::EpiQb, gp::DenseOrder>(F.tid, F.lds, g, So, E); } }
            { PH_BEGIN(); gp::Gemm g{WSP(bf16_t, WS_KVLAT), WSP(const bf16_t, WS_WKVB), 256, 0, nullptr}; gp::DenseOrder So; So.init(T, 1024, F.G, F.G - 1 - cidx);
              gp::EpiKvb E{WSP(bf16_t, ATT_FP8_B ? WS_KB8 : WS_KB), WSP(bf16_t, ATT_FP8_B ? WS_VTB8 : WS_VB), WSP(const float, WS_SSKV)}; gp::gemm_phase<gp::EpiKvb, gp::DenseOrder>(F.tid, F.lds, g, So, E); if (PROBE_DUP & 2) { LAUNDER_V(F.tid); gp::gemm_phase<gp::EpiKvb, gp::DenseOrder>(F.tid, F.lds, g, So, E); } }
#if FAST_ATTN && ATT_FP8_A
            { PH_BEGIN(); at::attn_phase_f8a(F.tid, F.lds, WSP(const unsigned char, WS_QA8), WSP(const unsigned char, WS_KA8), WSP(const unsigned char, WS_VTA8), WSP(bf16_t, WS_QA), 512, KIN(6) + l * 64, KIN(7) + l * 64, F.vcu, F.G); }
            if (PROBE_DUP & (1 | 4096)) { PH_BEGIN(); at::attn_phase_f8a(F.tid, F.lds, WSP(const unsigned char, WS_QA8), WSP(const unsigned char, WS_KA8), WSP(const unsigned char, WS_VTA8), WSP(bf16_t, WS_QA), 512, KIN(6) + l * 64, KIN(7) + l * 64, F.vcu, F.G); }
#else
            { PH_BEGIN(); const at::Tensors A{WSP(bf16_t, WS_QA), 512, WSP(bf16_t, WS_KA), 128, WSP(bf16_t, WS_VA), 128, WSP(bf16_t, WS_QA), 512, 4}; at::attn_phase<64>(F.tid, F.lds, A, F.vcu, F.G); }
#endif
            SEAM(pb + 2);
        }
        if (IN(pb + 3)) {
            PH_BEGIN();
#if FAST_ATTN && ATT_FP8_B
            at::attn_phase_f8b(F.tid, F.lds, WSP(const unsigned char, WS_QB8), WSP(const unsigned char, WS_KB8), WSP(const unsigned char, WS_VTB8), WSP(bf16_t, WS_OB), 512, F.vcu, F.G);
            if (PROBE_DUP & (1 | 8192)) { LAUNDER_V(F.tid); at::attn_phase_f8b(F.tid, F.lds, WSP(const unsigned char, WS_QB8), WSP(const unsigned char, WS_KB8), WSP(const unsigned char, WS_VTB8), WSP(bf16_t, WS_OB), 512, F.vcu, F.G); }
#else
            const at::Tensors A{WSP(bf16_t, WS_QB), 768, WSP(bf16_t, WS_KB), 768, WSP(bf16_t, WS_VB), 512, WSP(bf16_t, WS_OB), 512, 1}; for (int rep = 0; rep < ((PROBE_DUP & 1) ? 2 : 1); ++rep) at::attn_phase<96>(F.tid, F.lds, A, F.vcu, F.G);
#endif
            SEAM(pb + 3);
        }
        if (IN(pb + 4)) {
            PH_BEGIN();
            gp::Gemm g{WSP(bf16_t, WS_QA), WSP(const bf16_t, WS_WPA), PROJ_FP8 ? 256 : 512, (size_t)(WS_WPB - WS_WPA) / 2, nullptr, (size_t)(WS_OB - WS_QA) / 2, 0, 0}; gp::PairOrder So; So.init(T, D, F.G, cidx);
            gp::EpiProjP E{WSP(bf16_t, WS_H), WSP(const unsigned char, WS_SA), WSP(const unsigned char, WS_SB)};
            gp::gemm_phase<gp::EpiProjP, gp::PairOrder, false, PROJ_FP8 != 0>(F.tid, F.lds, g, So, E);
            if (PROBE_DUP & (2 | 1024)) { LAUNDER_V(F.tid); gp::gemm_phase<gp::EpiProjP, gp::PairOrder, false, PROJ_FP8 != 0>(F.tid, F.lds, g, So, E); }
            SEAM(pb + 4);
        }
        if (IN(pb + 5)) {
            PH_BEGIN();
            gp::Gemm g{WSP(bf16_t, WS_H), WSP(const bf16_t, WS_WO), PROJ_FP8 ? D / 2 : D, 0, nullptr, 0, 0, 0}; gp::DenseOrder So; So.init(T, D, F.G, cidx);
            if (PROBE_DUP & 2048) { gp::EpiNull En; gp::gemm_phase<gp::EpiNull, gp::DenseOrder>(F.tid, F.lds, g, So, En); LAUNDER_V(F.tid); }
            gp::EpiWo E{WSP(const bf16_t, WS_XB), mod + (size_t)l * NB * 6 * D, WSP(bf16_t, WS_XB)}; gp::gemm_phase<gp::EpiWo, gp::DenseOrder, false, PROJ_FP8 != 0>(F.tid, F.lds, g, So, E);
            SEAM(pb + 5);
        }
        if (IN(pb + 6)) {
            PH_BEGIN();
            if (PROBE_DUP & 16) { t2_phase(F, KIN(15) + l * D, mod + (size_t)l * NB * 6 * D, KIN(16), KIN(17), l, false); LAUNDER_V(F.tid); F.lane = F.tid & 63; __syncthreads(); }
            t2_phase(F, KIN(15) + l * D, mod + (size_t)l * NB * 6 * D, KIN(16), KIN(17), l, true);
            SEAM(pb + 6);
        }
        if (IN(pb + 7)) {
            PH_BEGIN();
            LAS int* tab = moe_table(F, l);
#if MOE_FP8
            gp::Gemm g{WSP(bf16_t, WS_H), WSP(const bf16_t, WS_W13), D / 2, (size_t)1024 * D / 2, WSP(const unsigned, WS_LIST), 0, 0, 0}; gp::MoeOrder So; So.init(tab, F.G, cidx);
            gp::EpiUp E{WSP(bf16_t, WS_ACT), 1.f / 16.f}; gp::gemm_phase<gp::EpiUp, gp::MoeOrder, true, true>(F.tid, F.lds, g, So, E);
            if (PROBE_DUP & 4) { LAUNDER_V(F.tid); gp::gemm_phase<gp::EpiUp, gp::MoeOrder, true, true>(F.tid, F.lds, g, So, E); }
#else
            gp::Gemm g{WSP(bf16_t, WS_H), WSP(const bf16_t, WS_W13), D, (size_t)1024 * D, WSP(const unsigned, WS_LIST)}; gp::MoeOrder So; So.init(tab, F.G, cidx);
            gp::EpiUp E{WSP(bf16_t, WS_ACT), 1.f}; gp::gemm_phase<gp::EpiUp, gp::MoeOrder, true>(F.tid, F.lds, g, So, E);
#endif
            SEAM(pb + 7);
        }
        if (IN(pb + 8)) {
            PH_BEGIN();
            LAS int* tab = moe_table(F, l);
#if MOE_FP8
            gp::Gemm g{WSP(bf16_t, WS_ACT), WSP(const bf16_t, WS_W2), FF / 2, (size_t)D * FF / 2, nullptr, 0, 0, 0}; gp::MoeOrder So; So.init(tab, F.G, cidx);
            gp::EpiDown E{WSP(bf16_t, WS_Y2), WSP(const unsigned, WS_LIST), WSP(const float, WS_GW), 1.f / 128.f}; gp::gemm_phase<gp::EpiDown, gp::MoeOrder, false, true>(F.tid, F.lds, g, So, E);
            if (PROBE_DUP & 4) { LAUNDER_V(F.tid); gp::gemm_phase<gp::EpiDown, gp::MoeOrder, false, true>(F.tid, F.lds, g, So, E); }
#else
            gp::Gemm g{WSP(bf16_t, WS_ACT), WSP(const bf16_t, WS_W2), FF, (size_t)D * FF, nullptr}; gp::MoeOrder So; So.init(tab, F.G, cidx);
            gp::EpiDown E{WSP(bf16_t, WS_Y2), WSP(const unsigned, WS_LIST), WSP(const float, WS_GW), 1.f}; gp::gemm_phase<gp::EpiDown, gp::MoeOrder, false>(F.tid, F.lds, g, So, E);
#endif
            SEAM(pb + 8);
        }
    }
    if (IN(NPHASE - 1)) { PH_BEGIN(); row_phase<2>(F, nullptr, mod + (size_t)(NL - 1) * NB * 6 * D, KIN(21), nullptr, 0, 0, nullptr, WSP(bf16_t, WS_XB), F.OUT); }
#undef IN
#undef SEAM
}

extern "C" void kernel_launch(void* const* d_in, const int* in_sizes, int n_in, void* d_out, int out_size, void* d_ws, size_t ws_size, hipStream_t stream) {
    static int grid = 0;
    if (grid == 0) {
        if (n_in != 22 || out_size != T * D || ws_size < WS_END) { fprintf(stderr, "kernel_launch: unexpected problem (n_in %d out %d ws %zu)\n", n_in, out_size, ws_size); grid = -1; return; }
        int dev = 0, cus = 0, per_cu = 0;
        if (hipGetDevice(&dev) != hipSuccess || hipDeviceGetAttribute(&cus, hipDeviceAttributeMultiprocessorCount, dev) != hipSuccess) { grid = -1; return; }
        if (hipFuncSetAttribute((const void*)fwd_kernel, hipFuncAttributeMaxDynamicSharedMemorySize, LDS_BYTES) != hipSuccess) { grid = -1; return; }
        if (hipOccupancyMaxActiveBlocksPerMultiprocessor(&per_cu, (const void*)fwd_kernel, NTHREADS, LDS_BYTES) != hipSuccess || per_cu < 1) { fprintf(stderr, "kernel_launch: occupancy query says %d\n", per_cu); }
        (void)hipGetLastError();
        grid = cus;
        if (grid != 256 || T % (grid * NWAVES * 4) != 0) {   fprintf(stderr, "kernel_launch: grid %d does not divide the row phases\n", grid); grid = -1; return; }
    }
    if (grid < 0) return;
    (void)hipMemsetAsync((char*)d_ws + WS_CTL, 0, CTL_BYTES, stream);
    Args a{};
    for (int i = 0; i < 22; ++i) a.in[i] = (const float*)d_in[i];
    a.out = (float*)d_out; a.ws = (unsigned char*)d_ws;
#if N_LAUNCH_MODE
    for (int p = 0; p < NPHASE; ++p) { a.ph_lo = p; a.ph_hi = p + 1; hipLaunchKernelGGL(fwd_kernel, dim3(grid), dim3(NTHREADS), LDS_BYTES, stream, a); }
#else
    a.ph_lo = 0; a.ph_hi = NPHASE;
    hipLaunchKernelGGL(fwd_kernel, dim3(grid), dim3(NTHREADS), LDS_BYTES, stream, a);
#endif
}
```

```cpp
#include <hip/hip_runtime.h>
#include <stdint.h>
#include <stdio.h>
#include <math.h>

#ifndef FAST_GEMM
#define FAST_GEMM 1
#endif
#ifndef FAST_ATTN
#define FAST_ATTN 1
#endif
#ifndef PROBE_DUP
#define PROBE_DUP 0
#endif
#ifndef PROBE_ATT
#define PROBE_ATT 0
#endif
#ifndef ATT_REGSTAGE
#define ATT_REGSTAGE 0
#endif
#ifndef WT_STORES
#define WT_STORES 0
#endif
#ifndef ATT_FP8_A
#define ATT_FP8_A 1
#endif
#ifndef ATT_FP8_B
#define ATT_FP8_B 1
#endif
#ifndef MOE_FP8
#define MOE_FP8 1
#endif
#ifndef G1_FP8
#define G1_FP8 1
#endif
#ifndef PROJ_FP8
#define PROJ_FP8 1
#endif
#ifndef N_LAUNCH_MODE
#define N_LAUNCH_MODE 0
#endif

#define LAS __attribute__((address_space(3)))
#define GAS __attribute__((address_space(1)))
typedef unsigned short bf16_t;
typedef short bf16x8 __attribute__((ext_vector_type(8)));
typedef float f32x4 __attribute__((ext_vector_type(4)));
typedef float f32x2 __attribute__((ext_vector_type(2)));
typedef float f32x16 __attribute__((ext_vector_type(16)));
typedef unsigned u32x4 __attribute__((ext_vector_type(4)));
typedef unsigned u32x2 __attribute__((ext_vector_type(2)));
typedef GAS unsigned gu32;

constexpr int D = 1024, NB = 8, S = 4096, T = NB * S, NL = 4, INC = 3488, NIN = 3584, NE = 16, FF = 512;
constexpr float EPS = 1e-6f, LOG2E = 1.4426950408889634f;
constexpr float QSCALE_A = 0.125f * LOG2E, QSCALE_B = 0.10206207261596577f * LOG2E;
constexpr float PFOLD = 4.f, PBYTE0 = 60.26f;
constexpr float OSCALE = 64.f, WSCALE = 16.f;
constexpr int NWAVES = 8, NTHREADS = 512;
constexpr int NPHASE = 2 + 9 * NL;

constexpr size_t MiB = 1u << 20;
constexpr size_t WS_CTL = 0, CTL_BYTES = 1 * MiB;
constexpr size_t WS_MOD = 1 * MiB;
constexpr size_t WS_COSA = 2 * MiB, WS_SINA = WS_COSA + 512 * 1024, WS_COSB = 3 * MiB, WS_SINB = WS_COSB + 256 * 1024;
constexpr size_t WS_SSQ = 4 * MiB, WS_SSKV = 5 * MiB;
constexpr size_t WS_GW = 6 * MiB;
constexpr size_t WS_LIST = 7 * MiB;
constexpr size_t WS_WIN = 10 * MiB, WS_WQB = 17 * MiB, WS_WKVB = 18 * MiB, WS_WPA = 19 * MiB, WS_WPB = 20 * MiB, WS_WO = 21 * MiB, WS_W13 = 23 * MiB, WS_W2 = 55 * MiB;
constexpr size_t WS_H = 72 * MiB;
constexpr size_t WS_QA = 136 * MiB, WS_KA = 168 * MiB, WS_VA = 176 * MiB, WS_QLAT = 184 * MiB, WS_KVLAT = 208 * MiB;
constexpr size_t WS_KB = 224 * MiB, WS_VB = 272 * MiB, WS_QB = 304 * MiB, WS_OB = 352 * MiB, WS_SA = 384 * MiB, WS_SB = 448 * MiB, WS_XB = 512 * MiB, WS_QA8 = 576 * MiB, WS_KA8 = 592 * MiB, WS_VTA8 = 596 * MiB, WS_QB8 = 600 * MiB, WS_KB8 = 624 * MiB, WS_VTB8 = 648 * MiB, WS_END = 664 * MiB;
constexpr size_t WS_ACT = 136 * MiB, WS_Y2 = 208 * MiB;
constexpr int ACT_ROWS = 2 * T + NE * 256;
static_assert(WS_ACT + (size_t)ACT_ROWS * FF * 2 <= WS_Y2 && WS_Y2 + (size_t)2 * T * D * 2 <= WS_XB, "moe overlay");
constexpr int CW_BAR = 4096;
constexpr int CW_CNT = 16384;

constexpr int RING_BYTES = 131072, MISC_OFF = RING_BYTES, LDS_BYTES = 147456;

__device__ __forceinline__ float bf2f(unsigned v) { return __uint_as_float(v << 16); }
typedef __bf16 bf16x2_t __attribute__((ext_vector_type(2)));
__device__ __forceinline__ unsigned cvt_pk_bf16(float lo, float hi) { f32x2 v = {lo, hi}; bf16x2_t b = __builtin_convertvector(v, bf16x2_t); return __builtin_bit_cast(unsigned, b); }
__device__ __forceinline__ u32x4 pack8(f32x4 a, f32x4 b) { u32x4 w; w.x = cvt_pk_bf16(a[0], a[1]); w.y = cvt_pk_bf16(a[2], a[3]); w.z = cvt_pk_bf16(b[0], b[1]); w.w = cvt_pk_bf16(b[2], b[3]); return w; }
__device__ __forceinline__ u32x2 pack8_fp8(f32x4 a, f32x4 b) { u32x2 w;
    w.x = (unsigned)__builtin_amdgcn_cvt_pk_fp8_f32(a[2], a[3], __builtin_amdgcn_cvt_pk_fp8_f32(a[0], a[1], 0, false), true);
    w.y = (unsigned)__builtin_amdgcn_cvt_pk_fp8_f32(b[2], b[3], __builtin_amdgcn_cvt_pk_fp8_f32(b[0], b[1], 0, false), true); return w; }
__device__ __forceinline__ u32x4 pair16(u32x2 w0, u32x2 w1) {
    const auto x = __builtin_amdgcn_permlane16_swap(w0.x, w1.x, false, false); const auto y = __builtin_amdgcn_permlane16_swap(w0.y, w1.y, false, false);
    return (u32x4){x[0], y[0], x[1], y[1]};
}
__device__ __forceinline__ void unpack8(u32x4 w, f32x4& a, f32x4& b) { a[0] = bf2f(w.x & 0xffffu); a[1] = bf2f(w.x >> 16); a[2] = bf2f(w.y & 0xffffu); a[3] = bf2f(w.y >> 16); b[0] = bf2f(w.z & 0xffffu); b[1] = bf2f(w.z >> 16); b[2] = bf2f(w.w & 0xffffu); b[3] = bf2f(w.w >> 16); }
__device__ __forceinline__ float shfl_xor_l(float v, int lane, int m) { return __int_as_float(__builtin_amdgcn_ds_bpermute((lane ^ m) << 2, __float_as_int(v))); }
__device__ __forceinline__ float shfl_l(float v, int src) { return __int_as_float(__builtin_amdgcn_ds_bpermute(src << 2, __float_as_int(v))); }
__device__ __forceinline__ float sum_xor16(float v) { const auto r = __builtin_amdgcn_permlane16_swap(__float_as_uint(v), __float_as_uint(v), false, false); return __uint_as_float(r[0]) + __uint_as_float(r[1]); }
__device__ __forceinline__ float sum_xor32(float v) { const auto r = __builtin_amdgcn_permlane32_swap(__float_as_uint(v), __float_as_uint(v), false, false); return __uint_as_float(r[0]) + __uint_as_float(r[1]); }
__device__ __forceinline__ float wave_sum(float v, int lane) {
#pragma unroll
    for (int o = 1; o < 64; o <<= 1) v += shfl_xor_l(v, lane, o);
    return v;
}
__device__ __forceinline__ float sigm(float v) { return __builtin_amdgcn_rcpf(1.f + __builtin_amdgcn_exp2f(v * (-LOG2E))); }
#if WT_STORES
__device__ __forceinline__ void st16(void* p, u32x4 v) { asm volatile("global_store_dwordx4 %0, %1, off sc1\n\ts_nop 1" :: "v"(p), "v"(v) : "memory"); }
__device__ __forceinline__ void st8(void* p, u32x2 v) { asm volatile("global_store_dwordx2 %0, %1, off sc1\n\ts_nop 1" :: "v"(p), "v"(v) : "memory"); }
#else
__device__ __forceinline__ void st16(void* p, u32x4 v) { *(u32x4*)p = v; }
__device__ __forceinline__ void st8(void* p, u32x2 v) { *(u32x2*)p = v; }
#endif
#define VM_WAIT() asm volatile("s_waitcnt vmcnt(0)" ::: "memory")
#define LAUNDER_S(p) asm volatile("" : "+s"(p))
#define LAUNDER_V(v) asm volatile("" : "+v"(v))
#define LDS_WAIT() asm volatile("s_waitcnt lgkmcnt(0)" ::: "memory")

#define XB_TMO      128
#define XB_XCNT(j)  (256  + 64 * (j))
#define XB_XSUB(j)  (1280 + 64 * (j))
#define XB_XGEN(j)  (2304 + 64 * (j))
#define XB_TOP      3328
#define XB_TOPGEN   3392
#define XCD_BAR_WORDS 3456
#define XB_SPIN_CAP (1u << 22)
__device__ __forceinline__ unsigned xb_ld(unsigned* p)              { return __hip_atomic_load(p, __ATOMIC_RELAXED, __HIP_MEMORY_SCOPE_AGENT); }
__device__ __forceinline__ unsigned xb_add(unsigned* p, unsigned v) { return __hip_atomic_fetch_add(p, v, __ATOMIC_RELAXED, __HIP_MEMORY_SCOPE_AGENT); }
__device__ __forceinline__ unsigned xb_xcc_id() { return (unsigned)__builtin_amdgcn_s_getreg((3 << 11) | 20) & 0xFu; }
#define XB_SPIN(cond, bar) do { unsigned _sp = 0; while (cond) { __builtin_amdgcn_s_sleep(1); \
    if ((++_sp & 255u) == 0u) { if (xb_ld(&(bar)[XB_TMO])) break; if (_sp > XB_SPIN_CAP) { atomicAdd(&(bar)[XB_TMO], 1u); break; } } } } while (0)
struct XcdBarrier { unsigned* bar; unsigned x; volatile LAS unsigned* st; };
__device__ __forceinline__ XcdBarrier xcd_barrier_post(unsigned* bar, volatile LAS unsigned* st) {
    XcdBarrier b; b.bar = bar; b.x = xb_xcc_id(); b.st = st;
    if (threadIdx.x == 0) (void)xb_add(&bar[XB_XCNT(b.x)], 1u);
    return b;
}
__device__ __forceinline__ void xcd_barrier_complete(unsigned* bar, unsigned x, unsigned& nloc, unsigned& nx) {
    const unsigned G = gridDim.x * gridDim.y * gridDim.z;
    unsigned sum, cnt, mine, sp = 0u;
    for (;;) {
        sum = 0u; cnt = 0u; mine = 0u;
#pragma unroll
        for (unsigned j = 0; j < 16; ++j) { const unsigned c = xb_ld(&bar[XB_XCNT(j)]); sum += c; cnt += (c > 0u) ? 1u : 0u; mine = (j == x) ? c : mine; }
        if (sum == G) break;
        __builtin_amdgcn_s_sleep(1);
        if ((++sp & 255u) == 0u) { if (xb_ld(&bar[XB_TMO])) break; if (sp > XB_SPIN_CAP) { atomicAdd(&bar[XB_TMO], 1u); break; } }
    }
    nloc = mine > 0u ? mine : 1u; nx = cnt > 0u ? cnt : 1u;
}
__device__ __forceinline__ void xcd_barrier(const XcdBarrier& b) {
    asm volatile("s_waitcnt vmcnt(0)" ::: "memory");
    __syncthreads();
    if (threadIdx.x == 0) {
        unsigned* bar = b.bar;
        __builtin_amdgcn_s_waitcnt(0);
        unsigned nloc = b.st[0], nx = b.st[1];
        if (nloc == 0u) { xcd_barrier_complete(bar, b.x, nloc, nx); b.st[0] = nloc; b.st[1] = nx; }
        const unsigned old = xb_add(&bar[XB_XSUB(b.x)], 1u);
        const unsigned gen = old / nloc;
        if (old + 1u == (gen + 1u) * nloc) {
            __builtin_amdgcn_fence(__ATOMIC_RELEASE, "agent");
            asm volatile("s_waitcnt vmcnt(0)" ::: "memory");
            const unsigned og = xb_add(&bar[XB_TOP], 1u);
            const unsigned tg = og / nx;
            if (og + 1u == (tg + 1u) * nx) xb_add(&bar[XB_TOPGEN], 1u);
            else XB_SPIN(xb_ld(&bar[XB_TOPGEN]) == tg, bar);
            __builtin_amdgcn_fence(__ATOMIC_ACQUIRE, "agent");
            xb_add(&bar[XB_XGEN(b.x)], 1u);
            asm volatile("s_waitcnt vmcnt(0)" ::: "memory");
        } else {
            XB_SPIN(xb_ld(&bar[XB_XGEN(b.x)]) == gen, bar);
            __builtin_amdgcn_fence(__ATOMIC_ACQUIRE, "agent");
            asm volatile("s_waitcnt vmcnt(0)" ::: "memory");
        }
    }
    __syncthreads();
}

namespace gp {
constexpr int BM = 256, BK = 64, HALF = 128, HTB = HALF * BK * 2, NXCD = 8, WGM = 8;
__host__ __device__ __forceinline__ int lds_byte(int r, int c) { const int st = (r >> 4) * 2 + (c >> 5), rr = r & 15, cc = c & 31, ob = rr * 64 + cc * 2; return st * 1024 + (ob ^ (((ob >> 9) & 1) << 5)); }
__host__ __device__ __forceinline__ void stage_rc(int b, int& R, int& C) { const int st = b / 1024, sb = b % 1024, swz = sb ^ (((sb >> 9) & 1) << 5); R = (st >> 1) * 16 + swz / 64; C = (st & 1) * 32 + (swz % 64) / 2; }
__host__ __device__ __forceinline__ int perm32(int rho) { const int n = rho >> 4, i = rho & 15; return 8 * (i >> 2) + 4 * n + (i & 3); }

struct Unit { int pm, pn, be, rl, nv; };
struct Gemm { const bf16_t* A; const bf16_t* Bt; int K; size_t bstride; const unsigned* list; size_t astride; int sw, sx; };

__device__ __forceinline__ int xcd_remap(int wgid, int nwg) { const int q = nwg / NXCD, r = nwg % NXCD, xcd = wgid % NXCD, off = wgid / NXCD; return (xcd < r ? xcd * (q + 1) : r * (q + 1) + (xcd - r) * q) + off; }
struct DenseOrder {
    int nM, nN, nwg, G, c;
    __device__ void init(int M, int N, int G_, int c_) { nM = M / BM; nN = N / BM; nwg = nM * nN; G = G_; c = c_; }
    __device__ bool next(int i, Unit& u) const {
        const int L = i * G + c; if (L >= nwg) return false;
        const int wgid = xcd_remap((int)L, nwg);
        const int nig = WGM * nN, gid = wgid / nig, fm = gid * WGM, gsz = (nM - fm) < WGM ? (nM - fm) : WGM;
        u.pm = fm + ((wgid % nig) % gsz); u.pn = (wgid % nig) / gsz; u.be = 0; u.rl = 0; u.nv = 256; return true;
    }
};
struct PairOrder {
    DenseOrder d;
    __device__ void init(int M, int N, int G_, int c_) { d.init(M, N, G_, c_); }
    __device__ bool next(int i, Unit& u) const { if (!d.next(i >> 1, u)) return false; u.be = i & 1; return true; }
};
struct MoeOrder {
    const LAS int* tab; int nwg, G, c;
    __device__ static int rd(const LAS int* p) { return __builtin_amdgcn_readfirstlane(*p); }
    __device__ void init(const LAS int* tab_, int G_, int c_) { tab = tab_; nwg = rd(tab_ + 16) * 4; G = G_; c = c_; }
    __device__ bool next(int i, Unit& u) const {
        const int L = i * G + c; if (L >= nwg) return false;
        const int wgid = xcd_remap((int)L, nwg);
        const int tile = wgid >> 2; int e = 0;
        for (int k = 1; k < NE; ++k) { const int tk = rd(tab + k); e = (tk <= tile) ? k : e; }
        e = __builtin_amdgcn_readfirstlane(e);
        u.pm = tile; u.pn = wgid & 3; u.be = e; u.rl = tile - rd(tab + e); const int rem = rd(tab + 32 + e) - u.rl * 256; u.nv = rem < 256 ? rem : 256; return true;
    }
};

#define ACC_T f32x4 (&acc)[2][2][4][2]

template <class Epi, class Sched, bool GATHER>
__device__ __forceinline__ void gemm_phase_ref(int tid, const Gemm g, const Sched& S, const Epi& E) {
    const int wid = __builtin_amdgcn_readfirstlane(tid >> 6), lane = tid & 63, wr = wid >> 2, wc = wid & 3, fr = lane & 15, fq = lane >> 4;
    const int K = g.K; Unit u;
    for (int ui = 0; S.next(ui, u); ++ui) {
        f32x4 acc[2][2][4][2];
#pragma unroll
        for (int a = 0; a < 2; ++a)
#pragma unroll
            for (int b = 0; b < 2; ++b)
#pragma unroll
                for (int m = 0; m < 4; ++m)
#pragma unroll
                    for (int n = 0; n < 2; ++n) acc[a][b][m][n] = (f32x4){0.f, 0.f, 0.f, 0.f};
        const bf16_t* Bt = g.Bt + (size_t)u.be * g.bstride + (size_t)u.pn * 256 * K;
        for (int ai = 0; ai < 2; ++ai)
            for (int m = 0; m < 4; ++m) {
                const int rloc = ai * 128 + wr * 64 + m * 16 + fr;
                size_t arow;
                if (GATHER) { arow = (rloc < u.nv) ? (size_t)(g.list[(size_t)u.be * T + u.rl * 256 + rloc] >> 1) : 0; }
                else arow = (size_t)u.pm * 256 + rloc;
                const bf16_t* ap = g.A + arow * K;
                for (int bj = 0; bj < 2; ++bj) {
                    const bf16_t* bp = Bt + (size_t)(bj * 128 + wc * 32 + fq * 8) * K;
                    float s[8];
#pragma unroll
                    for (int c = 0; c < 8; ++c) {
                        float sc = 0.f; const bf16_t* bpc = bp + (size_t)c * K;
#pragma unroll 2
                        for (int k = 0; k < K; k += 8) {
                            f32x4 a0, a1, b0, b1; unpack8(*(const u32x4*)(ap + k), a0, a1); unpack8(*(const u32x4*)(bpc + k), b0, b1);
                            sc += a0[0] * b0[0] + a0[1] * b0[1] + a0[2] * b0[2] + a0[3] * b0[3] + a1[0] * b1[0] + a1[1] * b1[1] + a1[2] * b1[2] + a1[3] * b1[3];
                        }
                        s[c] = sc; asm volatile("" : "+v"(s[c]));
                    }
#pragma unroll
                    for (int a2 = 0; a2 < 2; ++a2)
#pragma unroll
                        for (int b2 = 0; b2 < 2; ++b2)
#pragma unroll
                            for (int m2 = 0; m2 < 4; ++m2)
                                if (a2 == ai && b2 == bj && m2 == m) { acc[a2][b2][m2][0] = (f32x4){s[0], s[1], s[2], s[3]}; acc[a2][b2][m2][1] = (f32x4){s[4], s[5], s[6], s[7]}; }
                }
            }
        E(acc, u, wr, wc, fr, fq);
    }
}

template <class E> struct EpiTraits { static constexpr bool KEEP = false; };
#if FAST_GEMM
typedef int v8i_t __attribute__((ext_vector_type(8)));
__device__ __forceinline__ unsigned gp_voffb(int tid, int i, int K) { int t_ = tid; LAUNDER_V(t_); int R, C; stage_rc(t_ * 16 + i * 8192, R, C); const int Rb = (R & ~31) + perm32(R & 31); return (unsigned)(Rb * K + C) * 2u; }
template <class Epi, class Sched, bool GATHER, bool F8>
__device__ __forceinline__ void gemm_phase_fast(int tid, LAS unsigned char* lds, const Gemm g, const Sched& S, const Epi& E) {
    const int wid = __builtin_amdgcn_readfirstlane(tid >> 6), lane = tid & 63, wr = wid >> 2, wc = wid & 3, fr = lane & 15, fq = lane >> 4;
    const int K = g.K, nt = K / BK;
    int Rr[2], Cc[2]; unsigned voffB[2];
#pragma unroll
    for (int i = 0; i < 2; ++i) { stage_rc(tid * 16 + i * 8192, Rr[i], Cc[i]); const int Rb = (Rr[i] & ~31) + perm32(Rr[i] & 31); voffB[i] = (unsigned)(Rb * K + Cc[i]) * 2u; }
#define GP_VB(i) (F8 ? gp_voffb(tid, (i), K) : voffB[i])
    const size_t kstep = (size_t)(BK * 2), hstep = (size_t)HALF * K * 2, tstep = 2 * hstep, r64 = (size_t)64 * K * 2;
    const unsigned ldsw = (unsigned)wid * 1024u;
    const int aoff = lds_byte(wr * 64 + fr, fq * 8), boff = lds_byte(wc * 32 + fr, fq * 8);
#define GP_UNI(p) ((const char*)(((unsigned long long)(unsigned)__builtin_amdgcn_readfirstlane((int)((unsigned long long)(p) >> 32)) << 32) | (unsigned)__builtin_amdgcn_readfirstlane((int)(unsigned long long)(p))))
#define GP_SA(b, h) (((b) * 2 + (h)) * HTB)
#define GP_SB(b, h) ((4 + (b) * 2 + (h)) * HTB)
#define GP_DMA(sbase, voff, ldsdst) do { unsigned keep_; asm volatile("s_mov_b32 %0, m0\n\ts_mov_b32 m0, %3\n\ts_nop 0\n\tglobal_load_lds_dwordx4 %1, %2\n\ts_mov_b32 m0, %0" \
        : "=&s"(keep_) : "v"(voff), "s"(sbase), "s"((unsigned)__builtin_amdgcn_readfirstlane((int)(unsigned)(uintptr_t)(ldsdst))) : "memory"); } while (0)
#define GP_STAGE2(bufoff, gbase, v0, v1) do { const char* gb_ = (gbase); GP_DMA(gb_, (v0), lds + (bufoff) + ldsw); GP_DMA(gb_, (v1), lds + (bufoff) + ldsw + 8192); } while (0)
#define GP_STAGEB(bufoff, gbase) do { if constexpr (F8) { const unsigned vb_ = GP_VB(0); const char* gb_ = (gbase); GP_DMA(gb_, vb_, lds + (bufoff) + ldsw); GP_DMA(gb_ + r64, vb_, lds + (bufoff) + ldsw + 8192); } else { GP_STAGE2(bufoff, gbase, GP_VB(0), GP_VB(1)); } } while (0)
#define GP_STAGEB2(bufoff0, bufoff1, gbase) do { if constexpr (F8 && !GATHER) { const unsigned vb_ = GP_VB(0); const char* gb_ = (gbase); GP_DMA(gb_, vb_, lds + (bufoff0) + ldsw); GP_DMA(gb_ + r64, vb_, lds + (bufoff0) + ldsw + 8192); \
        GP_DMA(gb_ + hstep, vb_, lds + (bufoff1) + ldsw); GP_DMA(gb_ + hstep + r64, vb_, lds + (bufoff1) + ldsw + 8192); } else { GP_STAGEB(bufoff0, gbase); GP_STAGEB(bufoff1, (gbase) + hstep); } } while (0)
#define GP_CAT8(x0, x1) __builtin_bit_cast(v8i_t, __builtin_shufflevector(x0, x1, 0, 1, 2, 3, 4, 5, 6, 7, 8, 9, 10, 11, 12, 13, 14, 15))
#define GP_LDA(dst, b, h) do { _Pragma("unroll") for (int m = 0; m < 4; ++m) _Pragma("unroll") for (int k = 0; k < 2; ++k) dst[m][k] = *(const LAS bf16x8*)(lds + GP_SA(b, h) + aoff + m * 2048 + k * 1024); \
        if constexpr (F8) { _Pragma("unroll") for (int m = 0; m < 4; ++m) dst##8[m] = GP_CAT8(dst[m][0], dst[m][1]); } } while (0)
#define GP_LDB(dst, b, h) do { _Pragma("unroll") for (int n = 0; n < 2; ++n) _Pragma("unroll") for (int k = 0; k < 2; ++k) dst[n][k] = *(const LAS bf16x8*)(lds + GP_SB(b, h) + boff + n * 2048 + k * 1024); \
        if constexpr (F8) { _Pragma("unroll") for (int n = 0; n < 2; ++n) dst##8[n] = GP_CAT8(dst[n][0], dst[n][1]); } } while (0)
#define GP_MMA(ai, bj, At, Bt) do { __builtin_amdgcn_s_setprio(1); \
        if constexpr (F8) { _Pragma("unroll") for (int m = 0; m < 4; ++m) _Pragma("unroll") for (int n = 0; n < 2; ++n) \
            acc[ai][bj][m][n] = __builtin_amdgcn_mfma_scale_f32_16x16x128_f8f6f4(Bt##8[n], At##8[m], acc[ai][bj][m][n], 0, 0, 0, 0, 0, 0); }     \
        else { _Pragma("unroll") for (int m = 0; m < 4; ++m) _Pragma("unroll") for (int n = 0; n < 2; ++n) _Pragma("unroll") for (int k = 0; k < 2; ++k) \
            acc[ai][bj][m][n] = __builtin_amdgcn_mfma_f32_16x16x32_bf16(Bt[n][k], At[m][k], acc[ai][bj][m][n], 0, 0, 0); } \
        __builtin_amdgcn_s_setprio(0); } while (0)
#define GP_WAIT_V(n) asm volatile("s_waitcnt vmcnt(" #n ")" ::: "memory")
#define GP_WAIT_L(n) asm volatile("s_waitcnt lgkmcnt(" #n ")" ::: "memory")
#define GP_BAR __builtin_amdgcn_s_barrier()
#define GP_SCHED __builtin_amdgcn_sched_barrier(0)
    Unit cur, nxt; int ui = 0;
    if (!S.next(0, cur)) return;
    f32x4 acc[2][2][4][2];
#pragma unroll
    for (int a = 0; a < 2; ++a)
#pragma unroll
        for (int b = 0; b < 2; ++b)
#pragma unroll
            for (int m = 0; m < 4; ++m)
#pragma unroll
                for (int n = 0; n < 2; ++n) acc[a][b][m][n] = (f32x4){0.f, 0.f, 0.f, 0.f};
    bf16x8 At[4][2], B0[2][2], B1[2][2];
    v8i_t At8[4], B08[2], B18[2];
    unsigned vC0, vC1, vC2, vC3, vN0, vN1, vN2, vN3;
#define GP_VOFF(u, o0, o1, o2, o3) do { if (GATHER) { \
        int tl_ = tid; LAUNDER_V(tl_); int R0_, C0_, R1_, C1_; stage_rc(tl_ * 16, R0_, C0_); stage_rc(tl_ * 16 + 8192, R1_, C1_);     \
        const unsigned* lp = g.list + (size_t)(u).be * T + (u).rl * 256; \
        const int nvm = (u).nv - 1; const int p0 = min(R0_, nvm), p1 = min(R1_, nvm), p2 = min(128 + R0_, nvm), p3 = min(128 + R1_, nvm); \
        const unsigned t0 = lp[p0] >> 1, t1 = lp[p1] >> 1, t2 = lp[p2] >> 1, t3 = lp[p3] >> 1; \
        o0 = (t0 * K + C0_) * 2u; o1 = (t1 * K + C1_) * 2u; o2 = (t2 * K + C0_) * 2u; o3 = (t3 * K + C1_) * 2u; \
      } else { o0 = (unsigned)(Rr[0] * K + Cc[0]) * 2u; o1 = (unsigned)(Rr[1] * K + Cc[1]) * 2u; o2 = o0 + (unsigned)hstep; o3 = o1 + (unsigned)hstep; } } while (0)
    GP_VOFF(cur, vC0, vC1, vC2, vC3);
    const char* cA = GP_UNI((const char*)g.A + ((size_t)cur.be * g.astride) * 2 + (GATHER ? (size_t)0 : (size_t)cur.pm * tstep));
    const char* cB = GP_UNI((const char*)g.Bt + ((size_t)cur.be * g.bstride) * 2 + (size_t)cur.pn * tstep);
    GP_STAGEB(GP_SB(0, 0), cB); GP_STAGEB(GP_SB(0, 1), cB + hstep); GP_STAGE2(GP_SA(0, 0), cA, vC0, vC1); GP_STAGE2(GP_SA(0, 1), cA, vC2, vC3);
    if (wr == 1) GP_BAR;
    GP_WAIT_V(2); GP_BAR;
    GP_STAGEB(GP_SB(1, 0), cB + kstep); GP_STAGE2(GP_SA(1, 0), cA + kstep, vC0, vC1); GP_STAGEB(GP_SB(1, 1), cB + hstep + kstep);
    GP_WAIT_V(6); GP_BAR;
    for (;;) {
        const bool has_next = S.next(ui + 1, nxt);
        const char* nA = GP_UNI(has_next ? (const char*)g.A + ((size_t)nxt.be * g.astride) * 2 + (GATHER ? (size_t)0 : (size_t)nxt.pm * tstep) : cA);
        const char* nB = GP_UNI(has_next ? (const char*)g.Bt + ((size_t)nxt.be * g.bstride) * 2 + (size_t)nxt.pn * tstep : cB);
        if (GATHER) {
            if (has_next) { GP_VOFF(nxt, vN0, vN1, vN2, vN3); } else { vN0 = vC0; vN1 = vC1; vN2 = vC2; vN3 = vC3; }
            *(LAS u32x4*)(lds + MISC_OFF + 2048 + tid * 16) = (u32x4){vN0, vN1, vN2, vN3};
        } else { vN0 = vC0; vN1 = vC1; vN2 = vC2; vN3 = vC3; }
#pragma nounroll
        for (int t = 0; t < nt; t += 2) {
            LAUNDER_S(cA); LAUNDER_S(cB); LAUNDER_S(nA); LAUNDER_S(nB);
            const bool last = (t == nt - 2);
            if (GATHER) { if (last) { const u32x4 q_ = *(const LAS u32x4*)(lds + MISC_OFF + 2048 + tid * 16); vN0 = q_.x; vN1 = q_.y; vN2 = q_.z; vN3 = q_.w; } }
            const char* a1 = cA + (size_t)(t + 1) * kstep;
            const char* a2 = last ? nA : cA + (size_t)(t + 2) * kstep; const char* b2 = last ? nB : cB + (size_t)(t + 2) * kstep;
            const char* a3 = a2 + kstep; const char* b3 = b2 + kstep;
            const unsigned w0 = last ? vN0 : vC0, w1 = last ? vN1 : vC1, w2 = last ? vN2 : vC2, w3 = last ? vN3 : vC3;
            GP_LDB(B0, 0, 0); GP_LDB(B1, 0, 1); GP_SCHED; GP_LDA(At, 0, 0); GP_STAGE2(GP_SA(1, 1), a1, vC2, vC3);
            GP_WAIT_V(8); GP_WAIT_L(0); GP_BAR; GP_MMA(0, 0, At, B0); GP_MMA(0, 1, At, B1); GP_BAR; GP_SCHED;
            GP_LDA(At, 0, 1); GP_STAGEB2(GP_SB(0, 0), GP_SB(0, 1), b2); GP_STAGE2(GP_SA(0, 0), a2, w0, w1);
            GP_WAIT_V(8); GP_WAIT_L(0); GP_BAR; GP_MMA(1, 0, At, B0); GP_MMA(1, 1, At, B1); GP_BAR; GP_SCHED;
            GP_LDB(B0, 1, 0); GP_LDB(B1, 1, 1); GP_SCHED; GP_LDA(At, 1, 0); GP_STAGE2(GP_SA(0, 1), a2, w2, w3);
            GP_WAIT_V(8); GP_WAIT_L(0); GP_BAR; GP_MMA(0, 0, At, B0); GP_MMA(0, 1, At, B1); GP_BAR; GP_SCHED;
            GP_LDA(At, 1, 1); GP_STAGEB2(GP_SB(1, 0), GP_SB(1, 1), b3); GP_STAGE2(GP_SA(1, 0), a3, w0, w1);
            GP_WAIT_V(8); GP_WAIT_L(0); GP_BAR; GP_MMA(1, 0, At, B0); GP_MMA(1, 1, At, B1); GP_BAR; GP_SCHED;
        }
        if (wr == 0) GP_BAR;
        { int tl_ = tid; LAUNDER_V(tl_); const int fr_ = tl_ & 15, fq_ = (tl_ & 63) >> 4;
          E(acc, cur, wr, wc, fr_, fq_); }
        if (!has_next) break;
        if (!(EpiTraits<Epi>::KEEP && cur.be == 0)) {
#pragma unroll
        for (int a = 0; a < 2; ++a)
#pragma unroll
            for (int b = 0; b < 2; ++b)
#pragma unroll
                for (int m = 0; m < 4; ++m)
#pragma unroll
                    for (int n = 0; n < 2; ++n) acc[a][b][m][n] = (f32x4){0.f, 0.f, 0.f, 0.f};
        }
        cur = nxt; cA = nA; cB = nB; vC0 = vN0; vC1 = vN1; vC2 = vN2; vC3 = vN3; ++ui;
        if (wr == 1) GP_BAR;
    }
    GP_WAIT_V(0);
    GP_BAR;
#undef GP_UNI
#undef GP_SA
#undef GP_SB
#undef GP_STAGE2
#undef GP_DMA
#undef GP_STAGEB
#undef GP_STAGEB2
#undef GP_VB
#undef GP_LDA
#undef GP_LDB
#undef GP_MMA
#undef GP_CAT8
#undef GP_WAIT_V
#undef GP_WAIT_L
#undef GP_BAR
#undef GP_SCHED
#undef GP_VOFF
}
#endif

template <class Epi, class Sched, bool GATHER = false, bool F8 = false>
__device__ __forceinline__ void gemm_phase(int tid, LAS unsigned char* lds, const Gemm g, const Sched& S, const Epi& E) {
#if FAST_GEMM
    gemm_phase_fast<Epi, Sched, GATHER, F8>(tid, lds, g, S, E);
#else
    (void)lds; gemm_phase_ref<Epi, Sched, GATHER>(tid, g, S, E);
#endif
}

#define EPI_ROW(ai, m) (u.pm * 256 + (ai) * 128 + wr * 64 + (m) * 16 + fr)
#define EPI_COL(bj) (u.pn * 256 + (bj) * 128 + wc * 32 + fq * 8)
__device__ __forceinline__ float dot4(f32x4 a) { return (a[0] * a[0] + a[1] * a[1]) + (a[2] * a[2] + a[3] * a[3]); }

struct EpiNull {
    __device__ __forceinline__ void operator()(const ACC_T, const Unit& u, int wr, int wc, int fr, int fq) const {
#pragma unroll
        for (int ai = 0; ai < 2; ++ai)
#pragma unroll
            for (int bj = 0; bj < 2; ++bj)
#pragma unroll
                for (int m = 0; m < 4; ++m) asm volatile("" :: "v"(acc[ai][bj][m][0]), "v"(acc[ai][bj][m][1]));
    }
};
struct EpiIn {
    bf16_t *QA, *KA, *VA, *QLAT, *KVLAT, *KB, *SA, *SB; float *SSQ, *SSKV; const float *gq, *gk, *cosA, *sinA, *cosB, *sinB;
    __device__ __forceinline__ void operator()(const ACC_T, const Unit& u, int wr, int wc, int fr, int fq) const {
        const int wb = u.pn * 4 + wc;
        if (wb < 10) {
            const bool isq = wb < 8; const int head = isq ? wb : wb - 8; const float* g = isq ? gq : gk; bf16_t* dst = isq ? QA : KA; const int dp = isq ? 512 : 128; const float qs = isq ? QSCALE_A * (ATT_FP8_A ? PFOLD : 1.f) : 1.f;
            const f32x4 g00 = *(const f32x4*)(g + 8 * fq), g01 = *(const f32x4*)(g + 8 * fq + 4), g10 = *(const f32x4*)(g + 32 + 8 * fq), g11 = *(const f32x4*)(g + 36 + 8 * fq);
#pragma unroll
            for (int ai = 0; ai < 2; ++ai)
#pragma unroll
                for (int m = 0; m < 4; ++m) {
                    const int r = EPI_ROW(ai, m), pos = r & (S - 1);
                    const f32x4 v00 = acc[ai][0][m][0], v01 = acc[ai][0][m][1], v10 = acc[ai][1][m][0], v11 = acc[ai][1][m][1];
                    float ss = (dot4(v00) + dot4(v01)) + (dot4(v10) + dot4(v11)); ss = sum_xor16(ss); ss = sum_xor32(ss);
                    const float rstd = rsqrtf(ss * (1.f / 64.f) + EPS);
                    const f32x4 y00 = v00 * rstd * g00, y01 = v01 * rstd * g01, y10 = v10 * rstd * g10, y11 = v11 * rstd * g11;
                    const f32x4 c0 = *(const f32x4*)(cosA + pos * 32 + 8 * fq), c1 = *(const f32x4*)(cosA + pos * 32 + 8 * fq + 4), s0 = *(const f32x4*)(sinA + pos * 32 + 8 * fq), s1 = *(const f32x4*)(sinA + pos * 32 + 8 * fq + 4);
                    const f32x4 o00 = (y00 * c0 - y10 * s0) * qs, o01 = (y01 * c1 - y11 * s1) * qs, o10 = (y10 * c0 + y00 * s0) * qs, o11 = (y11 * c1 + y01 * s1) * qs;
#if ATT_FP8_A
                    unsigned char* p8 = (unsigned char*)dst + (size_t)r * dp + head * 64 + 8 * fq;
                    st16(p8 + (fq & 1) * 32 - (fq & 1) * 8, pair16(pack8_fp8(o00, o01), pack8_fp8(o10, o11)));
#else
                    bf16_t* p = dst + (size_t)r * dp + head * 64 + 8 * fq;
                    st16(p, pack8(o00, o01)); st16((p + 32), pack8(o10, o11));
#endif
                }
        } else if (wb < 12) {
#pragma unroll
            for (int ai = 0; ai < 2; ++ai)
#pragma unroll
                for (int m = 0; m < 4; ++m) {
#if ATT_FP8_A
                    const int r = EPI_ROW(ai, m), sq = r & (S - 1), k = sq & 63, pos = 32 * ((k >> 2) & 1) + 16 * (k >> 5) + (k & 3) + 4 * ((k & 31) >> 3);
                    unsigned char* vtb = (unsigned char*)VA; const unsigned vo = (unsigned)(((r >> 12) * 2 + (wb - 10)) * 64 + 8 * fq) * S + (unsigned)((sq & ~63) + pos);
#pragma unroll
                    for (int bj = 0; bj < 2; ++bj)
#pragma unroll
                        for (int n = 0; n < 2; ++n) { const f32x4 x = acc[ai][bj][m][n]; const unsigned w = (unsigned)__builtin_amdgcn_cvt_pk_fp8_f32(x[2], x[3], __builtin_amdgcn_cvt_pk_fp8_f32(x[0], x[1], 0, false), true);
                            const unsigned qo = vo + (unsigned)(bj * 32 + 4 * n) * S;
                            vtb[qo] = (unsigned char)(w & 0xffu); vtb[qo + S] = (unsigned char)((w >> 8) & 0xffu); vtb[qo + 2 * S] = (unsigned char)((w >> 16) & 0xffu); vtb[qo + 3 * S] = (unsigned char)(w >> 24); }
#else
                    bf16_t* p = VA + (size_t)EPI_ROW(ai, m) * 128 + (wb - 10) * 64 + 8 * fq;
                    st16(p, pack8(acc[ai][0][m][0], acc[ai][0][m][1])); st16((p + 32), pack8(acc[ai][1][m][0], acc[ai][1][m][1]));
#endif
                }
        } else if (wb < 22) {
            const bool isq = wb < 18; const int idx = isq ? wb - 12 : wb - 18; bf16_t* dst = isq ? QLAT : KVLAT; const int dp = isq ? 384 : 256;
#pragma unroll
            for (int ai = 0; ai < 2; ++ai)
#pragma unroll
                for (int m = 0; m < 4; ++m) {
                    const int r = EPI_ROW(ai, m);
                    const f32x4 v00 = acc[ai][0][m][0], v01 = acc[ai][0][m][1], v10 = acc[ai][1][m][0], v11 = acc[ai][1][m][1];
                    float ss = (dot4(v00) + dot4(v01)) + (dot4(v10) + dot4(v11)); ss = sum_xor16(ss); ss = sum_xor32(ss);
                    if (fq == 0) { if (isq) SSQ[(size_t)r * 8 + idx] = ss; else SSKV[(size_t)r * 4 + idx] = ss; }
                    bf16_t* p = dst + (size_t)r * dp + idx * 64 + 8 * fq;
                    st16(p, pack8(v00, v01)); st16((p + 32), pack8(v10, v11));
                }
        } else if (wb == 22) {
            if (fq < 2) {
#pragma unroll
                for (int ai = 0; ai < 2; ++ai)
#pragma unroll
                    for (int m = 0; m < 4; ++m) {
                        const int r = EPI_ROW(ai, m), pos = r & (S - 1);
                        const f32x4 x10 = acc[ai][0][m][0], x11 = acc[ai][0][m][1], x20 = acc[ai][1][m][0], x21 = acc[ai][1][m][1];
                        const f32x4 c0 = *(const f32x4*)(cosB + pos * 16 + 8 * fq), c1 = *(const f32x4*)(cosB + pos * 16 + 8 * fq + 4), s0 = *(const f32x4*)(sinB + pos * 16 + 8 * fq), s1 = *(const f32x4*)(sinB + pos * 16 + 8 * fq + 4);
#if ATT_FP8_B
                        const u32x2 w1 = pack8_fp8(x10 * c0 - x20 * s0, x11 * c1 - x21 * s1), w2 = pack8_fp8(x20 * c0 + x10 * s0, x21 * c1 + x11 * s1);
                        unsigned char* p = (unsigned char*)KB + (size_t)r * 768 + 64 + 8 * fq;
#pragma unroll
                        for (int h = 0; h < 8; ++h) { st8(p + h * 96, w1); st8(p + h * 96 + 16, w2); }
#else
                        const u32x4 w1 = pack8(x10 * c0 - x20 * s0, x11 * c1 - x21 * s1), w2 = pack8(x20 * c0 + x10 * s0, x21 * c1 + x11 * s1);
                        bf16_t* p = KB + (size_t)r * 768 + 64 + 8 * fq;
#pragma unroll
                        for (int h = 0; h < 8; ++h) { st16((p + h * 96), w1); st16((p + h * 96 + 16), w2); }
#endif
                    }
            }
        } else if (wb == 23) {
        } else {
            const bool isa = wb < 40; const int idx = isa ? wb - 24 : wb - 40; unsigned char* dst = (unsigned char*)(isa ? SA : SB);
#pragma unroll
            for (int ai = 0; ai < 2; ++ai)
#pragma unroll
                for (int m = 0; m < 4; ++m) { unsigned char* p = dst + (size_t)EPI_ROW(ai, m) * 1024 + idx * 64 + (fq & 1) * 32 + 8 * (fq & ~1);
                    st16(p, pair16(pack8_fp8(acc[ai][0][m][0], acc[ai][0][m][1]), pack8_fp8(acc[ai][1][m][0], acc[ai][1][m][1]))); }
        }
    }
};
__host__ __device__ __forceinline__ int src_col_in(int n) {
    const int pn = n >> 8, nl = n & 255, bj = nl >> 7, wc = (nl & 127) >> 5, p = nl & 31, wb = pn * 4 + wc, s = bj * 32 + p;
    if (wb < 8) return wb * 64 + s;
    if (wb < 10) return 512 + (wb - 8) * 64 + s;
    if (wb < 12) return 640 + (wb - 10) * 64 + s;
    if (wb < 18) return 768 + (wb - 12) * 64 + s;
    if (wb < 22) return 1152 + (wb - 18) * 64 + s;
    if (wb == 22) return p < 16 ? 1408 + bj * 16 + p : -1;
    if (wb == 23) return -1;
    if (wb < 40) return 1440 + (wb - 24) * 64 + s;
    return 2464 + (wb - 40) * 64 + s;
}
struct EpiQb {
    bf16_t* QB; const float *SSQ, *cosB, *sinB;
    __device__ __forceinline__ void operator()(const ACC_T, const Unit& u, int wr, int wc, int fr, int fq) const {
#pragma unroll
        for (int ai = 0; ai < 2; ++ai)
#pragma unroll
            for (int m = 0; m < 4; ++m) {
                const int r = EPI_ROW(ai, m), pos = r & (S - 1);
                const f32x4 sa = *(const f32x4*)(SSQ + (size_t)r * 8); const f32x2 sb = *(const f32x2*)(SSQ + (size_t)r * 8 + 4);
                const float rstd = rsqrtf((((sa[0] + sa[1]) + (sa[2] + sa[3])) + (sb[0] + sb[1])) * (1.f / 384.f) + EPS);
                u32x2 wq[2];
#pragma unroll
                for (int bj = 0; bj < 2; ++bj) {
                    f32x4 v0 = acc[ai][bj][m][0] * rstd, v1 = acc[ai][bj][m][1] * rstd;
                    const int c32 = u.pn * 8 + bj * 4 + wc;
                    if (c32 % 3 == 2) {
                        f32x4 o0, o1;
#pragma unroll
                        for (int j = 0; j < 4; ++j) { const auto ra = __builtin_amdgcn_permlane32_swap(__float_as_uint(v0[j]), __float_as_uint(v0[j]), false, false), rb = __builtin_amdgcn_permlane32_swap(__float_as_uint(v1[j]), __float_as_uint(v1[j]), false, false);
                            o0[j] = __uint_as_float(fq < 2 ? ra[1] : ra[0]); o1[j] = __uint_as_float(fq < 2 ? rb[1] : rb[0]); }
                        const int i0 = 8 * (fq & 1);
                        const f32x4 c0 = *(const f32x4*)(cosB + pos * 16 + i0), c1 = *(const f32x4*)(cosB + pos * 16 + i0 + 4), s0 = *(const f32x4*)(sinB + pos * 16 + i0), s1 = *(const f32x4*)(sinB + pos * 16 + i0 + 4);
                        if (fq < 2) { v0 = v0 * c0 - o0 * s0; v1 = v1 * c1 - o1 * s1; } else { v0 = v0 * c0 + o0 * s0; v1 = v1 * c1 + o1 * s1; }
                    }
#if ATT_FP8_B
                    wq[bj] = pack8_fp8(v0 * (QSCALE_B * PFOLD), v1 * (QSCALE_B * PFOLD));
#else
                    st16((QB + (size_t)r * 768 + EPI_COL(bj)), pack8(v0 * QSCALE_B, v1 * QSCALE_B));
#endif
                }
#if ATT_FP8_B
                st16((unsigned char*)QB + (size_t)r * 768 + u.pn * 256 + (fq & 1) * 128 + wc * 32 + 8 * (fq & ~1), pair16(wq[0], wq[1]));
#endif
            }
    }
};
struct EpiKvb {
    bf16_t *KB, *VB; const float* SSKV;
    __device__ __forceinline__ void operator()(const ACC_T, const Unit& u, int wr, int wc, int fr, int fq) const {
#pragma unroll
        for (int ai = 0; ai < 2; ++ai) {
            f32x4 sq[4];
#pragma unroll
            for (int m = 0; m < 4; ++m) sq[m] = *(const f32x4*)(SSKV + (size_t)EPI_ROW(ai, m) * 4);
            asm volatile("" : "+v"(sq[0]), "+v"(sq[1]), "+v"(sq[2]), "+v"(sq[3]));
#pragma unroll
            for (int m = 0; m < 4; ++m) {
                const int r = EPI_ROW(ai, m);
                const f32x4 sa = sq[m];
                const float rstd = rsqrtf(((sa[0] + sa[1]) + (sa[2] + sa[3])) * (1.f / 256.f) + EPS);
                u32x2 wk[2] = {};
#pragma unroll
                for (int bj = 0; bj < 2; ++bj) {
                    const int head = u.pn * 2 + bj, o = wc * 32 + fq * 8;
#if ATT_FP8_B
                    const f32x4 x0 = acc[ai][bj][m][0] * rstd, x1 = acc[ai][bj][m][1] * rstd;
                    if (wc < 2) wk[bj] = pack8_fp8(x0, x1);
                    else {
                        const int sq = r & (S - 1), k = sq & 63, pos = 32 * ((k >> 2) & 1) + 16 * (k >> 5) + (k & 3) + 4 * ((k & 31) >> 3);
                        unsigned char* vtb = (unsigned char*)VB; const unsigned vo = (unsigned)(((r >> 12) * 8 + head) * 64 + (o - 64)) * S + (unsigned)((sq & ~63) + pos);
                        const u32x2 w = pack8_fp8(x0, x1);
                        vtb[vo] = (unsigned char)(w.x & 0xffu); vtb[vo + S] = (unsigned char)((w.x >> 8) & 0xffu); vtb[vo + 2 * S] = (unsigned char)((w.x >> 16) & 0xffu); vtb[vo + 3 * S] = (unsigned char)(w.x >> 24);
                        vtb[vo + 4 * S] = (unsigned char)(w.y & 0xffu); vtb[vo + 5 * S] = (unsigned char)((w.y >> 8) & 0xffu); vtb[vo + 6 * S] = (unsigned char)((w.y >> 16) & 0xffu); vtb[vo + 7 * S] = (unsigned char)(w.y >> 24);
                    }
#else
                    const u32x4 w = pack8(acc[ai][bj][m][0] * rstd, acc[ai][bj][m][1] * rstd);
                    if (wc < 2) st16((KB + (size_t)r * 768 + head * 96 + o), w); else st16((VB + (size_t)r * 512 + head * 64 + (o - 64)), w);
#endif
                }
#if ATT_FP8_B
                if (wc < 2) st16((unsigned char*)KB + (size_t)r * 768 + (u.pn * 2 + (fq & 1)) * 96 + wc * 32 + 8 * (fq & ~1), pair16(wk[0], wk[1]));
#endif
            } }
    }
};
template <int MODE> struct EpiProj {
    bf16_t* O; const bf16_t* gate;
    __device__ __forceinline__ void operator()(const ACC_T, const Unit& u, int wr, int wc, int fr, int fq) const {
#pragma unroll
        for (int ai = 0; ai < 2; ++ai)
#pragma unroll
            for (int m = 0; m < 4; ++m) {
                const int r = EPI_ROW(ai, m);
#pragma unroll
                for (int bj = 0; bj < 2; ++bj) {
                    const size_t off = (size_t)r * D + EPI_COL(bj);
                    const u32x2 gw = *(const u32x2*)((const unsigned char*)gate + off);
                    const f32x2 q0 = __builtin_amdgcn_cvt_pk_f32_fp8((int)gw.x, false), q1 = __builtin_amdgcn_cvt_pk_f32_fp8((int)gw.x, true), q2 = __builtin_amdgcn_cvt_pk_f32_fp8((int)gw.y, false), q3 = __builtin_amdgcn_cvt_pk_f32_fp8((int)gw.y, true);
                    const f32x4 g0 = {sigm(q0[0]), sigm(q0[1]), sigm(q1[0]), sigm(q1[1])}, g1 = {sigm(q2[0]), sigm(q2[1]), sigm(q3[0]), sigm(q3[1])};
                    f32x4 v0 = acc[ai][bj][m][0] * g0, v1 = acc[ai][bj][m][1] * g1;
                    if (MODE == 1) { f32x4 p0, p1; unpack8(*(const u32x4*)(O + off), p0, p1); v0 += p0; v1 += p1; }
                    if (MODE == 1) st16(O + off, pack8(v0, v1)); else *(u32x4*)(O + off) = pack8(v0, v1);
                }
            }
    }
};
struct EpiProjP {
    bf16_t* O; const unsigned char* SA; const unsigned char* SB;
    __device__ static __forceinline__ void gates(const unsigned char* G, size_t off, f32x4& g0, f32x4& g1) {
        const u32x2 gw = *(const u32x2*)(G + off);
        const f32x2 q0 = __builtin_amdgcn_cvt_pk_f32_fp8((int)gw.x, false), q1 = __builtin_amdgcn_cvt_pk_f32_fp8((int)gw.x, true), q2 = __builtin_amdgcn_cvt_pk_f32_fp8((int)gw.y, false), q3 = __builtin_amdgcn_cvt_pk_f32_fp8((int)gw.y, true);
        g0 = (f32x4){sigm(q0[0]), sigm(q0[1]), sigm(q1[0]), sigm(q1[1])}; g1 = (f32x4){sigm(q2[0]), sigm(q2[1]), sigm(q3[0]), sigm(q3[1])};
    }
    __device__ __forceinline__ void operator()(f32x4 (&acc)[2][2][4][2], const Unit& u, int wr, int wc, int fr, int fq) const {
#pragma unroll
        for (int ai = 0; ai < 2; ++ai)
#pragma unroll
            for (int m = 0; m < 4; ++m) {
                const int r = EPI_ROW(ai, m); u32x2 wm[2] = {};
#pragma unroll
                for (int bj = 0; bj < 2; ++bj) {
                    const size_t off = (size_t)r * D + EPI_COL(bj);
                    f32x4 b0, b1; gates(SB, off, b0, b1);
#pragma unroll
                    for (int j = 0; j < 4; ++j) { b0[j] = fmaxf(b0[j], 9.094947e-13f); b1[j] = fmaxf(b1[j], 9.094947e-13f); }
                    if (u.be == 0) {
                        f32x4 a0, a1; gates(SA, off, a0, a1);
#pragma unroll
                        for (int j = 0; j < 4; ++j) { acc[ai][bj][m][0][j] *= a0[j] * __builtin_amdgcn_rcpf(b0[j]); acc[ai][bj][m][1][j] *= a1[j] * __builtin_amdgcn_rcpf(b1[j]); }
                    } else {
#if PROJ_FP8
                        wm[bj] = pack8_fp8(acc[ai][bj][m][0] * (b0 * (1.f / WSCALE)), acc[ai][bj][m][1] * (b1 * (1.f / WSCALE)));
#else
                        st16(O + off, pack8(acc[ai][bj][m][0] * b0, acc[ai][bj][m][1] * b1));
#endif
                    }
                }
#if PROJ_FP8
                if (u.be != 0) st16((unsigned char*)O + (size_t)r * D + u.pn * 256 + (fq & 1) * 128 + wc * 32 + 8 * (fq & ~1), pair16(wm[0], wm[1]));
#endif
            }
    }
};
template <> struct EpiTraits<EpiProjP> { static constexpr bool KEEP = true; };
struct EpiWo {
    const bf16_t* X; const float* modl; bf16_t* XO;
    __device__ __forceinline__ void operator()(const ACC_T, const Unit& u, int wr, int wc, int fr, int fq) const {
        const float* g1 = modl + (size_t)(u.pm >> 4) * 6 * D + 2 * D;
#pragma unroll
        for (int bj = 0; bj < 2; ++bj) {
            const int c = EPI_COL(bj); const float us = PROJ_FP8 ? 1.f / (OSCALE * WSCALE) : 1.f; const f32x4 ga = *(const f32x4*)(g1 + c) * us, gb = *(const f32x4*)(g1 + c + 4) * us;
#pragma unroll
            for (int ai = 0; ai < 2; ++ai) {
                u32x4 xr[4];
#pragma unroll
                for (int m = 0; m < 4; ++m) xr[m] = *(const u32x4*)(X + (size_t)EPI_ROW(ai, m) * D + c);
                asm volatile("" : "+v"(xr[0]), "+v"(xr[1]), "+v"(xr[2]), "+v"(xr[3]));
#pragma unroll
                for (int m = 0; m < 4; ++m) { const size_t off = (size_t)EPI_ROW(ai, m) * D + c;
                    f32x4 x0, x1; unpack8(xr[m], x0, x1);
                    st16((XO + off), pack8(x0 + ga * acc[ai][bj][m][0], x1 + gb * acc[ai][bj][m][1])); }
            }
        }
    }
};
struct EpiUp {
    bf16_t* ACT; float inscale;
    __device__ __forceinline__ void operator()(const ACC_T, const Unit& u, int wr, int wc, int fr, int fq) const {
#pragma unroll
        for (int ai = 0; ai < 2; ++ai)
#pragma unroll
            for (int m = 0; m < 4; ++m) {
                f32x4 a = acc[ai][0][m][0] * inscale, b = acc[ai][0][m][1] * inscale; const f32x4 c = acc[ai][1][m][0] * inscale, d = acc[ai][1][m][1] * inscale;
#pragma unroll
                for (int j = 0; j < 4; ++j) { a[j] = a[j] * sigm(a[j]) * c[j]; b[j] = b[j] * sigm(b[j]) * d[j]; }
#if MOE_FP8
                st8((unsigned char*)ACT + (size_t)EPI_ROW(ai, m) * FF + u.pn * 128 + wc * 32 + fq * 8, pack8_fp8(a * 8.f, b * 8.f));
#else
                st16((ACT + (size_t)EPI_ROW(ai, m) * FF + u.pn * 128 + wc * 32 + fq * 8), pack8(a, b));
#endif
            }
    }
};
struct EpiDown {
    bf16_t* Y2; const unsigned* list; const float* gw; float inscale;
    __device__ __forceinline__ void operator()(const ACC_T, const Unit& u, int wr, int wc, int fr, int fq) const {
#pragma unroll
        for (int ai = 0; ai < 2; ++ai)
#pragma unroll
            for (int m = 0; m < 4; ++m) {
                const int rloc = ai * 128 + wr * 64 + m * 16 + fr;
                if (rloc < u.nv) {
                    const unsigned entry = list[(size_t)u.be * T + u.rl * 256 + rloc]; const float w = gw[entry] * inscale;
                    const u32x2 q0 = pack8_fp8(acc[ai][0][m][0] * (w * 16.f), acc[ai][0][m][1] * (w * 16.f)), q1 = pack8_fp8(acc[ai][1][m][0] * (w * 16.f), acc[ai][1][m][1] * (w * 16.f));
                    st16((unsigned char*)Y2 + (size_t)entry * D + u.pn * 256 + (fq & 1) * 128 + wc * 32 + 8 * (fq & ~1), pair16(q0, q1));
                }
            }
    }
};
}

namespace at {
struct Tensors { const bf16_t* Q; int qp; const bf16_t* K; int kp; const bf16_t* V; int vp; bf16_t* O; int op; int group; };
__device__ __forceinline__ bool next_unit(int i, int vcu, int G, int& bh, int& qb) {
    int u;
    if (G == 256) { if (i >= 4) return false; u = (vcu >> 5) * 128 + i * 32 + (vcu & 31); }
    else { u = i * G + vcu; if (u >= 1024) return false; }
    bh = u >> 4; qb = u & 15; return true;
}
template <int DQK>
__device__ __forceinline__ void attn_phase_ref(int tid, const Tensors& A, int vcu, int G) {
    int bh, qb;
    for (int i = 0; next_unit(i, vcu, G, bh, qb); ++i) {
        const int b = bh >> 3, h = bh & 7, kvh = h / A.group;
        {
            const int dh = tid >> 8;
            const size_t row = (size_t)b * S + qb * 256 + (tid & 255);
            float q[DQK], o[32];
#pragma unroll
            for (int d = 0; d < DQK; ++d) q[d] = bf2f(A.Q[row * A.qp + h * DQK + d]);
#pragma unroll
            for (int d = 0; d < 32; ++d) o[d] = 0.f;
            float l = 0.f;
            for (int k = 0; k < S; ++k) {
                const bf16_t* kr = A.K + ((size_t)b * S + k) * A.kp + kvh * DQK; const bf16_t* vr = A.V + ((size_t)b * S + k) * A.vp + kvh * 64 + dh * 32;
                float sc = 0.f;
#pragma unroll
                for (int d = 0; d < DQK; d += 8) { f32x4 k0, k1; unpack8(*(const u32x4*)(kr + d), k0, k1);
                    sc += q[d] * k0[0] + q[d + 1] * k0[1] + q[d + 2] * k0[2] + q[d + 3] * k0[3] + q[d + 4] * k1[0] + q[d + 5] * k1[1] + q[d + 6] * k1[2] + q[d + 7] * k1[3]; }
                const float p = bf2f(cvt_pk_bf16(exp2f(sc), 0.f) & 0xffffu); l += p;
#pragma unroll
                for (int d = 0; d < 32; d += 8) { f32x4 v0, v1; unpack8(*(const u32x4*)(vr + d), v0, v1);
                    o[d] += p * v0[0]; o[d + 1] += p * v0[1]; o[d + 2] += p * v0[2]; o[d + 3] += p * v0[3]; o[d + 4] += p * v1[0]; o[d + 5] += p * v1[1]; o[d + 6] += p * v1[2]; o[d + 7] += p * v1[3]; }
            }
            const float il = 1.f / l;
            __syncthreads();
#pragma unroll
            for (int d = 0; d < 32; d += 8) { f32x4 a = {o[d] * il, o[d + 1] * il, o[d + 2] * il, o[d + 3] * il}, c = {o[d + 4] * il, o[d + 5] * il, o[d + 6] * il, o[d + 7] * il};
                *(u32x4*)(A.O + row * A.op + h * 64 + dh * 32 + d) = pack8(a, c); }
        }
    }
}
#if FAST_ATTN
typedef short s16x4 __attribute__((ext_vector_type(4)));
__device__ __forceinline__ unsigned cvtpk(float lo, float hi) { f32x2 v = {lo, hi}; bf16x2_t b = __builtin_convertvector(v, bf16x2_t); return __builtin_bit_cast(unsigned, b); }
__device__ __forceinline__ s16x4 vtr(const LAS unsigned char* p) { return __builtin_bit_cast(s16x4, __builtin_amdgcn_ds_read_tr16_b64_v4i16((LAS s16x4*)p)); }
__device__ __forceinline__ int crow(int r, int hi) { return (r & 3) + 8 * (r >> 2) + 4 * hi; }
#define AT_BAR() asm volatile("s_barrier" ::: "memory")
#define AT_WAITBAR(N) asm volatile("s_waitcnt vmcnt(" #N ") lgkmcnt(0)\n\ts_barrier" ::: "memory")
#define AT_SCHED() __builtin_amdgcn_sched_barrier(0)
__device__ __forceinline__ void glds16(const void* gsrc, unsigned lds_dst) { unsigned keep;
    asm volatile("s_mov_b32 %0, m0\n\ts_mov_b32 m0, %2\n\ts_nop 0\n\tglobal_load_lds_dwordx4 %1, off\n\ts_mov_b32 m0, %0" : "=&s"(keep) : "v"(gsrc), "s"(lds_dst) : "memory"); }
#define AT_GLDS(g, l) glds16((const void*)(g), (unsigned)__builtin_amdgcn_readfirstlane((int)(unsigned)(uintptr_t)(l)))
template <int DQK>
__device__ __forceinline__ void attn_unit(int tid, LAS unsigned char* lds, const Tensors& A, int b, int h, int qb) {
    constexpr int ND = DQK / 16, NCH = DQK / 8, KSLOT = NCH * 1024, NKD = NCH > 8 ? 2 : 1, VSLOT = 8192, NT = S / 64;
    constexpr int KOFF = 0, VOFF = 3 * KSLOT, OST = VOFF + 3 * VSLOT, WSF = OST + 8 * 4096;
    static_assert(WSF + 8 * 256 <= RING_BYTES, "attention LDS");
    const int lane = tid & 63, r32 = lane & 31, hi = lane >> 5, wid = __builtin_amdgcn_readfirstlane(tid >> 6);
    const int kvh = h / A.group; const size_t rowb = (size_t)b * S;
    const bf16_t* ksrc = A.K + (rowb + lane) * A.kp + kvh * DQK + wid * 8;
    const bf16_t* ksrc2 = A.K + (rowb + lane) * A.kp + kvh * DQK + (8 + (wid & 3)) * 8;
    const bf16_t* vsrc = A.V + (rowb + 16 * (wid & 3) + (lane >> 2)) * A.vp + kvh * 64 + (wid >> 2) * 32 + (lane & 3) * 8;
    const size_t ktile = (size_t)64 * A.kp, vtile = (size_t)64 * A.vp;
    LAS unsigned char* kdst = lds + KOFF + wid * 1024; LAS unsigned char* kdst2 = lds + KOFF + (8 + (wid & 3)) * 1024; LAS unsigned char* vdst = lds + VOFF + wid * 1024;
#define DMA_K(j, so) do { AT_GLDS(ksrc + (size_t)(j) * ktile, kdst + (so)); if (NKD == 2) AT_GLDS(ksrc2 + (size_t)(j) * ktile, kdst2 + (so)); } while (0)
#define DMA_V(j, so) AT_GLDS(vsrc + (size_t)(j) * vtile, vdst + (so))
    const LAS unsigned char* kp0 = lds + KOFF + hi * 1024 + r32 * 16;
    const LAS unsigned char* vp0 = lds + VOFF + ((lane >> 4) & 1) * 32 + (lane & 3) * 8 + (4 * hi + ((lane & 15) >> 2)) * 64;
    DMA_K(0, 0); DMA_V(0, 0); DMA_K(1, KSLOT); DMA_V(1, VSLOT); DMA_K(2, 2 * KSLOT);
    const bf16_t* Qw = A.Q + (rowb + qb * 256 + wid * 32 + r32) * A.qp + h * DQK + hi * 8;
    bf16x8 qr[ND];
#pragma unroll
    for (int d0 = 0; d0 < ND; ++d0) qr[d0] = *(const bf16x8*)(Qw + d0 * 16);
    asm volatile("s_waitcnt vmcnt(0)\n\ts_barrier" ::: "memory");
    bf16x8 kf[2 * ND]; s16x4 vlo[8], vhi[8];
#define KLOAD(so) do { _Pragma("unroll") for (int d0 = 0; d0 < ND; ++d0) { kf[2 * d0] = *(const LAS bf16x8*)(kp0 + (so) + d0 * 2048); kf[2 * d0 + 1] = *(const LAS bf16x8*)(kp0 + (so) + d0 * 2048 + 512); } } while (0)
#define VLOAD(so) do { _Pragma("unroll") for (int i = 0; i < 8; ++i) { vlo[i] = vtr(vp0 + (so) + (i >> 2) * 4096 + (i & 3) * 1024); vhi[i] = vtr(vp0 + (so) + (i >> 2) * 4096 + (i & 3) * 1024 + 512); } } while (0)
#define VFR(i) (bf16x8){vlo[i][0], vlo[i][1], vlo[i][2], vlo[i][3], vhi[i][0], vhi[i][1], vhi[i][2], vhi[i][3]}
    KLOAD(0);
    asm volatile("s_waitcnt lgkmcnt(0)" ::: "memory");
    if (PROBE_ATT != 5 && wid >= 4) AT_BAR();
    f32x16 o0 = {}, o1 = {}, C0, C1; u32x4 pw0, pw1, pw2, pw3; float lsum = 0.f;
    const f32x16 zero = {};
#define QK_BLOCK() do { C0 = __builtin_amdgcn_mfma_f32_32x32x16_bf16(kf[0], qr[0], zero, 0, 0, 0); C1 = __builtin_amdgcn_mfma_f32_32x32x16_bf16(kf[1], qr[0], zero, 0, 0, 0); \
        _Pragma("unroll") for (int d0 = 1; d0 < ND; ++d0) { C0 = __builtin_amdgcn_mfma_f32_32x32x16_bf16(kf[2 * d0], qr[d0], C0, 0, 0, 0); C1 = __builtin_amdgcn_mfma_f32_32x32x16_bf16(kf[2 * d0 + 1], qr[d0], C1, 0, 0, 0); } } while (0)
#define PAF(k) __builtin_bit_cast(bf16x8, pw##k)
#define PV_BLOCK() do { \
        o0 = __builtin_amdgcn_mfma_f32_32x32x16_bf16(PAF(0), VFR(0), o0, 0, 0, 0); o1 = __builtin_amdgcn_mfma_f32_32x32x16_bf16(PAF(0), VFR(4), o1, 0, 0, 0); \
        o0 = __builtin_amdgcn_mfma_f32_32x32x16_bf16(PAF(1), VFR(1), o0, 0, 0, 0); o1 = __builtin_amdgcn_mfma_f32_32x32x16_bf16(PAF(1), VFR(5), o1, 0, 0, 0); \
        o0 = __builtin_amdgcn_mfma_f32_32x32x16_bf16(PAF(2), VFR(2), o0, 0, 0, 0); o1 = __builtin_amdgcn_mfma_f32_32x32x16_bf16(PAF(2), VFR(6), o1, 0, 0, 0); \
        o0 = __builtin_amdgcn_mfma_f32_32x32x16_bf16(PAF(3), VFR(3), o0, 0, 0, 0); o1 = __builtin_amdgcn_mfma_f32_32x32x16_bf16(PAF(3), VFR(7), o1, 0, 0, 0); } while (0)
#define SOFTMAX() do { \
        _Pragma("unroll") for (int r = 0; r < 16; ++r) { C0[r] = __builtin_amdgcn_exp2f(C0[r]); C1[r] = __builtin_amdgcn_exp2f(C1[r]); } \
        f32x2 s0_ = {C0[0], C0[1]}, s1_ = {C1[0], C1[1]}; _Pragma("unroll") for (int r = 2; r < 16; r += 2) { s0_ += (f32x2){C0[r], C0[r + 1]}; s1_ += (f32x2){C1[r], C1[r + 1]}; } s0_ += s1_; lsum += s0_[0] + s0_[1]; \
        pw0 = (u32x4){cvtpk(C0[0], C0[1]), cvtpk(C0[2], C0[3]), cvtpk(C0[4], C0[5]), cvtpk(C0[6], C0[7])}; pw1 = (u32x4){cvtpk(C0[8], C0[9]), cvtpk(C0[10], C0[11]), cvtpk(C0[12], C0[13]), cvtpk(C0[14], C0[15])}; \
        pw2 = (u32x4){cvtpk(C1[0], C1[1]), cvtpk(C1[2], C1[3]), cvtpk(C1[4], C1[5]), cvtpk(C1[6], C1[7])}; pw3 = (u32x4){cvtpk(C1[8], C1[9]), cvtpk(C1[10], C1[11]), cvtpk(C1[12], C1[13]), cvtpk(C1[14], C1[15])}; } while (0)
    int ka = 2 * KSLOT, kb = 0, kc = KSLOT, va = 2 * VSLOT, vb = 0, vc = VSLOT;
#define ROT() do { const int t_ = ka; ka = kb; kb = kc; kc = t_; const int u_ = va; va = vb; vb = vc; vc = u_; } while (0)
#define PINP() asm volatile("" : "+v"(lsum) : "v"(pw0), "v"(pw1), "v"(pw2), "v"(pw3))
#if ATT_REGSTAGE
    u32x4 kst = {}, kst2 = {}, vst = {};
    const LAS unsigned char* kw = lds + KOFF + wid * 1024 + lane * 16; const LAS unsigned char* kw2 = lds + KOFF + (8 + (wid & 3)) * 1024 + lane * 16; const LAS unsigned char* vw = lds + VOFF + wid * 1024 + lane * 16;
#define ST_WRITE(WK, WV) do { if (WK) { *(LAS u32x4*)(kw + ka) = kst; if (NKD == 2 && wid < 4) *(LAS u32x4*)(kw2 + ka) = kst2; } if (WV) *(LAS u32x4*)(vw + vc) = vst; } while (0)
#define ST_LOAD(sv, IK, IV) do { if (IK) { kst = *(const u32x4*)(ksrc + (size_t)((sv) + 4) * ktile); if (NKD == 2 && wid < 4) kst2 = *(const u32x4*)(ksrc2 + (size_t)((sv) + 4) * ktile); } if (IV) vst = *(const u32x4*)(vsrc + (size_t)((sv) + 3) * vtile); } while (0)
#define STEP(sv, DOQK, DOPV, KL, VL, IK, IV, WK, WV) do { \
        AT_SCHED(); if (DOQK) QK_BLOCK(); if (DOPV) PV_BLOCK(); AT_SCHED(); \
        asm volatile("s_barrier\n\ts_nop 15\n\ts_nop 3" : "+v"(C0), "+v"(C1), "+v"(o0), "+v"(o1) :: "memory"); AT_SCHED(); \
        if (KL) KLOAD(kc); if (VL) VLOAD(vb); ST_WRITE(WK, WV); ST_LOAD(sv, IK, IV); \
        if (DOQK) { SOFTMAX(); PINP(); } AT_SCHED(); \
        asm volatile("s_waitcnt lgkmcnt(0)\n\ts_barrier" ::: "memory"); \
        AT_SCHED(); ROT(); } while (0)
    STEP(-1, true, false, true, true, true, true, false, false);
#pragma nounroll
    for (int s = 0; s < NT - 4; ++s) STEP(s, true, true, true, true, true, true, true, true);
    STEP(NT - 4, true, true, true, true, false, true, true, true);
    STEP(NT - 3, true, true, true, true, false, false, false, true);
    STEP(NT - 2, true, true, false, true, false, false, false, false);
    STEP(NT - 1, false, true, false, false, false, false, false, false);
#undef ST_WRITE
#undef ST_LOAD
#else
#define STEP(sv, DOQK, DOPV, KL, VL, IK, IV) do { \
        AT_SCHED(); if (DOQK) QK_BLOCK(); if (DOPV) PV_BLOCK(); AT_SCHED(); \
          \
        asm volatile("s_barrier\n\ts_nop 15\n\ts_nop 3" : "+v"(C0), "+v"(C1), "+v"(o0), "+v"(o1) :: "memory"); AT_SCHED(); \
        if (KL) KLOAD(kc); if (VL) VLOAD(vb); if (IK) DMA_K((sv) + 4, kb); if (IV) DMA_V((sv) + 3, va); \
        if (DOQK) { SOFTMAX(); PINP(); } AT_SCHED(); \
        if (IK) { if (NKD == 2) { AT_WAITBAR(3); } else { AT_WAITBAR(2); } } else if (IV) { AT_WAITBAR(1); } else { AT_WAITBAR(0); } \
        AT_SCHED(); ROT(); } while (0)
    STEP(-1, true, false, true, true, true, true);
#pragma nounroll
    for (int s = 0; s < NT - 4; ++s) STEP(s, true, true, true, true, true, true);
    STEP(NT - 4, true, true, true, true, false, true);
    STEP(NT - 3, true, true, true, true, false, false);
    STEP(NT - 2, true, true, false, true, false, false);
    STEP(NT - 1, false, true, false, false, false, false);
#endif
#undef STEP
#undef PINP
    if (PROBE_ATT != 5 && wid < 4) AT_BAR();
    { auto rr = __builtin_amdgcn_permlane32_swap(__float_as_uint(lsum), __float_as_uint(lsum), false, false); lsum = __uint_as_float(rr[0]) + __uint_as_float(rr[1]); }
    LAS float* wsf = (LAS float*)(lds + WSF + wid * 256);
    if (hi == 0) wsf[r32] = lsum;
    asm volatile("s_waitcnt lgkmcnt(0)" ::: "memory");
    LAS bf16_t* stg = (LAS bf16_t*)(lds + OST + wid * 4096);
#pragma unroll
    for (int r = 0; r < 16; ++r) { const int orow = crow(r, hi); const float rl = __builtin_amdgcn_rcpf(wsf[orow]);
        stg[orow * 64 + r32] = (bf16_t)(cvtpk(o0[r] * rl, 0.f) & 0xffffu); stg[orow * 64 + 32 + r32] = (bf16_t)(cvtpk(o1[r] * rl, 0.f) & 0xffffu); }
    asm volatile("s_waitcnt lgkmcnt(0)" ::: "memory");
    bf16_t* Ow = A.O + (rowb + qb * 256 + wid * 32) * A.op + h * 64;
#pragma unroll
    for (int i = 0; i < 4; ++i) { const int row = i * 8 + (lane >> 3), ch = lane & 7; const u32x4 v = *(const LAS u32x4*)(stg + row * 64 + ch * 8); st16((Ow + (size_t)row * A.op + ch * 8), v); }
    asm volatile("s_waitcnt lgkmcnt(0)\n\ts_barrier" ::: "memory");
#undef DMA_K
#undef DMA_V
#undef KLOAD
#undef VLOAD
#undef VFR
#undef QK_BLOCK
#undef PAF
#undef PV_BLOCK
#undef SOFTMAX
#undef ROT
}
#endif
#if FAST_ATTN && ATT_FP8_A
typedef int v8i __attribute__((ext_vector_type(8)));
#define SPLAT16(x) ((f32x16){x, x, x, x, x, x, x, x, x, x, x, x, x, x, x, x})
__device__ __forceinline__ f32x16 mfma8(v8i a, v8i b, f32x16 c) { return __builtin_amdgcn_mfma_scale_f32_32x32x64_f8f6f4(a, b, c, 0, 0, 0, 0, 0, 0); }
__device__ __forceinline__ f32x16 mfma8pv(v8i a, v8i b, f32x16 c) { return __builtin_amdgcn_mfma_scale_f32_32x32x64_f8f6f4(a, b, c, 1, 0, 0, 0, 0, 0); }
__device__ __forceinline__ void attn_unit_f8a(int tid, LAS unsigned char* lds, const unsigned char* Q8, const unsigned char* K8, const unsigned char* VT8, bf16_t* O, int op, int b, int h, int qb, float bias) {
    constexpr int SL = 4096, NT = S / 64;
    constexpr int KOFF = 0, VOFF = 4 * SL, OST = VOFF + 4 * SL, WSF = OST + 8 * 4096;
    const int lane = tid & 63, r32 = lane & 31, hi = lane >> 5, wid = __builtin_amdgcn_readfirstlane(tid >> 6);
    const int kvh = h >> 2; const size_t rowb = (size_t)b * S; const bool kw = wid < 4;
    const unsigned char* src = kw ? K8 + (rowb + lane) * 128 + kvh * 64 + 16 * wid : VT8 + ((size_t)((b * 2 + kvh) * 64 + lane)) * S + 16 * (wid - 4);
    const size_t tstep = kw ? (size_t)64 * 128 : (size_t)64;
    LAS unsigned char* dst = lds + (kw ? KOFF + wid * 1024 : VOFF + (wid - 4) * 1024);
#define DMA8(j, so) AT_GLDS(src + (size_t)(j) * tstep, dst + (so))
    const LAS unsigned char* kp0 = lds + KOFF + (2 * hi) * 1024 + r32 * 16;
    const LAS unsigned char* vp0 = lds + VOFF + (2 * hi) * 1024 + r32 * 16;
    DMA8(0, 0); DMA8(1, SL); DMA8(2, 2 * SL);
    v8i qf; { const unsigned char* Qw = Q8 + (rowb + qb * 256 + wid * 32 + r32) * 512 + h * 64 + 32 * hi; const u32x4 a = *(const u32x4*)Qw, c = *(const u32x4*)(Qw + 16);
        qf = (v8i){(int)a.x, (int)a.y, (int)a.z, (int)a.w, (int)c.x, (int)c.y, (int)c.z, (int)c.w}; }
    asm volatile("s_waitcnt vmcnt(0)\n\ts_barrier" ::: "memory");
    v8i kf0, kf1, vf0, vf1, p8;
#define LD32(dstv, p) do { const u32x4 a_ = *(const LAS u32x4*)(p), c_ = *(const LAS u32x4*)((p) + 1024); dstv = (v8i){(int)a_.x, (int)a_.y, (int)a_.z, (int)a_.w, (int)c_.x, (int)c_.y, (int)c_.z, (int)c_.w}; } while (0)
#define KLOAD8(so) do { LD32(kf0, kp0 + (so)); LD32(kf1, kp0 + (so) + 512); } while (0)
#define VLOAD8(so) do { LD32(vf0, vp0 + (so)); LD32(vf1, vp0 + (so) + 512); } while (0)
    KLOAD8(0);
    asm volatile("s_waitcnt lgkmcnt(0)" ::: "memory");
    if (wid >= 4) AT_BAR();
    float z_ = 0.f; asm volatile("" : "+v"(z_));
    f32x16 o0 = SPLAT16(z_), o1 = SPLAT16(z_), o2 = SPLAT16(z_), C0, C1;
    const v8i ones = {0x38383838, 0x38383838, 0x38383838, 0x38383838, 0x38383838, 0x38383838, 0x38383838, 0x38383838};
    float nb_ = PFOLD * bias + PBYTE0; asm volatile("" : "+v"(nb_));
    f32x16 negb = SPLAT16(nb_);
    asm volatile("" : "+v"(negb));
#define SOFTMAX8() do { \
        _Pragma("unroll") for (int i = 0; i < 4; ++i) { \
            const f32x2 a_ = (f32x2){C0[4 * i], C0[4 * i + 1]}, b_ = (f32x2){C0[4 * i + 2], C0[4 * i + 3]}, c_ = (f32x2){C1[4 * i], C1[4 * i + 1]}, d_ = (f32x2){C1[4 * i + 2], C1[4 * i + 3]}; \
            p8[i] = (int)__builtin_amdgcn_cvt_pk_u8_f32(b_[1], 3, __builtin_amdgcn_cvt_pk_u8_f32(b_[0], 2, __builtin_amdgcn_cvt_pk_u8_f32(a_[1], 1, __builtin_amdgcn_cvt_pk_u8_f32(a_[0], 0, 0u)))); \
            p8[4 + i] = (int)__builtin_amdgcn_cvt_pk_u8_f32(d_[1], 3, __builtin_amdgcn_cvt_pk_u8_f32(d_[0], 2, __builtin_amdgcn_cvt_pk_u8_f32(c_[1], 1, __builtin_amdgcn_cvt_pk_u8_f32(c_[0], 0, 0u)))); } } while (0)
#define STEP8(sv, DOQK2, DOSM, DOPV, KL, VL, ISS, WN, NOPS) do { \
        AT_SCHED(); \
        if (KL) { LD32(kf0, kp0 + (((sv) + 2) & 3) * SL); LD32(kf1, kp0 + (((sv) + 2) & 3) * SL + 512); } AT_SCHED(); \
        if (DOPV) { o0 = mfma8pv(p8, vf0, o0); } if (VL) LD32(vf0, vp0 + (((sv) + 1) & 3) * SL); AT_SCHED(); \
        if (DOPV) { o1 = mfma8pv(p8, vf1, o1); } if (VL) LD32(vf1, vp0 + (((sv) + 1) & 3) * SL + 512); AT_SCHED(); \
        if (DOPV) { o2 = mfma8pv(p8, ones, o2); } if (ISS) DMA8((sv) + 4, (((sv) + 4) & 3) * SL); AT_SCHED(); \
        asm volatile("s_barrier\n\t" NOPS : "+v"(C0), "+v"(C1), "+v"(o0), "+v"(o1), "+v"(o2) :: "memory"); AT_SCHED(); \
        if (DOSM) { SOFTMAX8(); asm volatile("" :: "v"(p8)); } AT_SCHED(); \
        if (DOQK2) { asm volatile("s_waitcnt lgkmcnt(0)" ::: "memory"); C0 = mfma8(kf0, qf, negb); C1 = mfma8(kf1, qf, negb); } AT_SCHED(); \
        asm volatile("s_waitcnt vmcnt(" #WN ") lgkmcnt(0)\n\ts_barrier" : "+v"(C0), "+v"(C1), "+v"(o0), "+v"(o1), "+v"(o2) :: "memory"); \
        AT_SCHED(); } while (0)
    C0 = mfma8(kf0, qf, negb); C1 = mfma8(kf1, qf, negb);
    STEP8(-1, true, true, false, true, true, true, 1, "s_nop 15\n\ts_nop 15");
#pragma nounroll
    for (int s = 0; s < NT - 4; ++s) STEP8(s, true, true, true, true, true, true, 1, "s_nop 1");
    STEP8(NT - 4, true, true, true, true, true, false, 0, "s_nop 1");
    STEP8(NT - 3, true, true, true, true, true, false, 0, "s_nop 1");
    STEP8(NT - 2, false, true, true, false, true, false, 0, "s_nop 15\n\ts_nop 15");
    STEP8(NT - 1, false, false, true, false, false, false, 0, "s_nop 15\n\ts_nop 15");
    if (wid < 4) AT_BAR();
#if PROJ_FP8
    LAS unsigned char* stg8 = lds + OST + wid * 4096;
#pragma unroll
    for (int r = 0; r < 16; ++r) { const int orow = crow(r, hi); const float rl = __builtin_amdgcn_rcpf(o2[r]) * OSCALE;
        const unsigned pk = (unsigned)__builtin_amdgcn_cvt_pk_fp8_f32(o0[r] * rl, o1[r] * rl, 0, false);
        stg8[orow * 64 + r32] = (unsigned char)(pk & 0xffu); stg8[orow * 64 + 32 + r32] = (unsigned char)((pk >> 8) & 0xffu); }
    asm volatile("s_waitcnt lgkmcnt(0)" ::: "memory");
    unsigned char* Ow8 = (unsigned char*)O + (rowb + qb * 256 + wid * 32) * op + h * 64;
#pragma unroll
    for (int i = 0; i < 2; ++i) { const int idx = i * 64 + lane, row = idx >> 2, ch = idx & 3; const u32x4 v = *(const LAS u32x4*)(stg8 + row * 64 + ch * 16); st16(Ow8 + (size_t)row * op + ch * 16, v); }
#else
    LAS bf16_t* stg = (LAS bf16_t*)(lds + OST + wid * 4096);
#pragma unroll
    for (int r = 0; r < 16; ++r) { const int orow = crow(r, hi); const float rl = __builtin_amdgcn_rcpf(o2[r]);
        stg[orow * 64 + r32] = (bf16_t)(cvtpk(o0[r] * rl, 0.f) & 0xffffu); stg[orow * 64 + 32 + r32] = (bf16_t)(cvtpk(o1[r] * rl, 0.f) & 0xffffu); }
    asm volatile("s_waitcnt lgkmcnt(0)" ::: "memory");
    bf16_t* Ow = O + (rowb + qb * 256 + wid * 32) * op + h * 64;
#pragma unroll
    for (int i = 0; i < 4; ++i) { const int row = i * 8 + (lane >> 3), ch = lane & 7; const u32x4 v = *(const LAS u32x4*)(stg + row * 64 + ch * 8); st16(Ow + (size_t)row * op + ch * 8, v); }
    #endif
    asm volatile("s_waitcnt lgkmcnt(0)\n\ts_barrier" ::: "memory");
#undef DMA8
#undef LD32
#undef KLOAD8
#undef VLOAD8
#undef SOFTMAX8
#undef STEP8
}
__device__ __forceinline__ void attn_phase_f8a(int tid, LAS unsigned char* lds, const unsigned char* Q8, const unsigned char* K8, const unsigned char* VT8, bf16_t* O, int op, const float* gq, const float* gk, int vcu, int G) {
    float mq = 0.f, mk = 0.f;
    for (int i = 0; i < 64; ++i) { mq = fmaxf(mq, fabsf(gq[i])); mk = fmaxf(mk, fabsf(gk[i])); }
    const float bias = -fmaxf(64.f * mq * mk * QSCALE_A * 1.13f - 15.5f, 0.f);
    int bh, qb;
    for (int i = 0; next_unit(i, vcu, G, bh, qb); ++i) attn_unit_f8a(tid, lds, Q8, K8, VT8, O, op, bh >> 3, bh & 7, qb, bias);
}
#endif
#if FAST_ATTN && ATT_FP8_B
__device__ __forceinline__ void attn_unit_f8b(int tid, LAS unsigned char* lds, const unsigned char* Q8, const unsigned char* K8, const unsigned char* VT8, bf16_t* O, int op, int b, int h, int qb) {
    constexpr int SLK = 6144, SLV = 4096, NT = S / 64;
    constexpr int KOFF = 0, VOFF = 4 * SLK, OST = VOFF + 4 * SLV, WSF = OST + 8 * 4096;
    static_assert(WSF + 2048 <= RING_BYTES, "attention LDS");
    const int lane = tid & 63, r32 = lane & 31, hi = lane >> 5, wid = __builtin_amdgcn_readfirstlane(tid >> 6);
    const size_t rowb = (size_t)b * S; const bool kw = wid < 6, vw = wid >= 4;
    const unsigned char* ksrc = K8 + (rowb + lane) * 768 + h * 96 + 16 * wid;
    const unsigned char* vsrc = VT8 + ((size_t)((b * 8 + h) * 64 + lane)) * S + 16 * (wid - 4);
    LAS unsigned char* kdst = lds + KOFF + wid * 1024; LAS unsigned char* vdst = lds + VOFF + (wid - 4) * 1024;
#define DMAK(j, so) AT_GLDS(ksrc + (size_t)(j) * (64 * 768), kdst + (so))
#define DMAV(j, so) AT_GLDS(vsrc + (size_t)(j) * 64, vdst + (so))
    const LAS unsigned char* kp0 = lds + KOFF + (2 * hi) * 1024 + r32 * 16;
    const LAS unsigned char* kr0 = lds + KOFF + 4 * 1024 + r32 * 16;
    const LAS unsigned char* vp0 = lds + VOFF + (2 * hi) * 1024 + r32 * 16;
    if (kw) { DMAK(0, 0); DMAK(1, SLK); DMAK(2, 2 * SLK); DMAK(3, 3 * SLK); }
    if (vw) { DMAV(0, 0); DMAV(1, SLV); DMAV(2, 2 * SLV); }
    v8i qn, qr;
    { const unsigned char* Qw = Q8 + (rowb + qb * 256 + wid * 32 + r32) * 768 + h * 96; const u32x4 a = *(const u32x4*)(Qw + 32 * hi), c = *(const u32x4*)(Qw + 32 * hi + 16), e = *(const u32x4*)(Qw + 64), f = *(const u32x4*)(Qw + 80);
      qn = (v8i){(int)a.x, (int)a.y, (int)a.z, (int)a.w, (int)c.x, (int)c.y, (int)c.z, (int)c.w};
      qr = hi ? (v8i){0, 0, 0, 0, 0, 0, 0, 0} : (v8i){(int)e.x, (int)e.y, (int)e.z, (int)e.w, (int)f.x, (int)f.y, (int)f.z, (int)f.w}; }
    asm volatile("s_waitcnt vmcnt(0)\n\ts_barrier" ::: "memory");
    v8i kn0, kn1, kr0v, kr1v, vf0, vf1, p8;
#define LD32(dstv, p) do { const u32x4 a_ = *(const LAS u32x4*)(p), c_ = *(const LAS u32x4*)((p) + 1024); dstv = (v8i){(int)a_.x, (int)a_.y, (int)a_.z, (int)a_.w, (int)c_.x, (int)c_.y, (int)c_.z, (int)c_.w}; } while (0)
#define KLOAD8(so) do { LD32(kn0, kp0 + (so)); LD32(kn1, kp0 + (so) + 512); LD32(kr0v, kr0 + (so)); LD32(kr1v, kr0 + (so) + 512); } while (0)
#define VLOAD8(so) do { LD32(vf0, vp0 + (so)); LD32(vf1, vp0 + (so) + 512); } while (0)
    KLOAD8(0);
    asm volatile("s_waitcnt lgkmcnt(0)" ::: "memory");
    if (wid >= 4) AT_BAR();
    float z_ = 0.f, pb_ = PBYTE0; asm volatile("" : "+v"(z_), "+v"(pb_));
    f32x16 o0 = SPLAT16(z_), o1 = SPLAT16(z_), o2 = SPLAT16(z_), C0, C1;
    f32x16 zero = SPLAT16(pb_);
    asm volatile("" : "+v"(zero));
    const v8i ones = {0x38383838, 0x38383838, 0x38383838, 0x38383838, 0x38383838, 0x38383838, 0x38383838, 0x38383838};
#define SOFTMAX8() do { \
        _Pragma("unroll") for (int i = 0; i < 4; ++i) { \
            const f32x2 a_ = (f32x2){C0[4 * i], C0[4 * i + 1]}, b_ = (f32x2){C0[4 * i + 2], C0[4 * i + 3]}, c_ = (f32x2){C1[4 * i], C1[4 * i + 1]}, d_ = (f32x2){C1[4 * i + 2], C1[4 * i + 3]}; \
            p8[i] = (int)__builtin_amdgcn_cvt_pk_u8_f32(b_[1], 3, __builtin_amdgcn_cvt_pk_u8_f32(b_[0], 2, __builtin_amdgcn_cvt_pk_u8_f32(a_[1], 1, __builtin_amdgcn_cvt_pk_u8_f32(a_[0], 0, 0u)))); \
            p8[4 + i] = (int)__builtin_amdgcn_cvt_pk_u8_f32(d_[1], 3, __builtin_amdgcn_cvt_pk_u8_f32(d_[0], 2, __builtin_amdgcn_cvt_pk_u8_f32(c_[1], 1, __builtin_amdgcn_cvt_pk_u8_f32(c_[0], 0, 0u)))); } } while (0)
#define STEP8(sv, DOQK, DOPV, KL, VL, IK, IV, WK, WV, WB, NOPS) do { \
        AT_SCHED(); if (DOQK) { C0 = mfma8(kn0, qn, zero); C1 = mfma8(kn1, qn, zero); C0 = mfma8(kr0v, qr, C0); C1 = mfma8(kr1v, qr, C1); } if (DOPV) { o0 = mfma8pv(p8, vf0, o0); o1 = mfma8pv(p8, vf1, o1); o2 = mfma8pv(p8, ones, o2); } AT_SCHED(); \
        asm volatile("s_barrier\n\t" NOPS : "+v"(C0), "+v"(C1), "+v"(o0), "+v"(o1), "+v"(o2) :: "memory"); AT_SCHED(); \
        if (KL) KLOAD8((((sv) + 2) & 3) * SLK); if (VL) VLOAD8((((sv) + 1) & 3) * SLV); \
        if (kw && (IK)) DMAK((sv) + 5, (((sv) + 1) & 3) * SLK); if (vw && (IV)) DMAV((sv) + 4, ((sv) & 3) * SLV); \
        if (DOQK) { SOFTMAX8(); asm volatile("" :: "v"(p8)); } AT_SCHED(); \
        if (kw && vw) { AT_WAITBAR(WB); } else if (kw) { AT_WAITBAR(WK); } else { AT_WAITBAR(WV); } \
        AT_SCHED(); } while (0)
    STEP8(-1, true, false, true, true, true, true, 2, 2, 4, "s_nop 15\n\ts_nop 15");
#pragma nounroll
    for (int s = 0; s < NT - 5; ++s) STEP8(s, true, true, true, true, true, true, 2, 2, 4, "s_nop 1");
    STEP8(NT - 5, true, true, true, true, false, true, 1, 2, 3, "s_nop 15\n\ts_nop 15");
    STEP8(NT - 4, true, true, true, true, false, false, 0, 1, 1, "s_nop 15\n\ts_nop 15");
    STEP8(NT - 3, true, true, true, true, false, false, 0, 0, 0, "s_nop 15\n\ts_nop 15");
    STEP8(NT - 2, true, true, false, true, false, false, 0, 0, 0, "s_nop 15\n\ts_nop 15");
    STEP8(NT - 1, false, true, false, false, false, false, 0, 0, 0, "s_nop 15\n\ts_nop 15");
    if (wid < 4) AT_BAR();
#if PROJ_FP8
    LAS unsigned char* stg8 = lds + OST + wid * 4096;
#pragma unroll
    for (int r = 0; r < 16; ++r) { const int orow = crow(r, hi); const float rl = __builtin_amdgcn_rcpf(o2[r]) * OSCALE;
        const unsigned pk = (unsigned)__builtin_amdgcn_cvt_pk_fp8_f32(o0[r] * rl, o1[r] * rl, 0, false);
        stg8[orow * 64 + r32] = (unsigned char)(pk & 0xffu); stg8[orow * 64 + 32 + r32] = (unsigned char)((pk >> 8) & 0xffu); }
    asm volatile("s_waitcnt lgkmcnt(0)" ::: "memory");
    unsigned char* Ow8 = (unsigned char*)O + (rowb + qb * 256 + wid * 32) * op + h * 64;
#pragma unroll
    for (int i = 0; i < 2; ++i) { const int idx = i * 64 + lane, row = idx >> 2, ch = idx & 3; const u32x4 v = *(const LAS u32x4*)(stg8 + row * 64 + ch * 16); st16(Ow8 + (size_t)row * op + ch * 16, v); }
#else
    LAS bf16_t* stg = (LAS bf16_t*)(lds + OST + wid * 4096);
#pragma unroll
    for (int r = 0; r < 16; ++r) { const int orow = crow(r, hi); const float rl = __builtin_amdgcn_rcpf(o2[r]);
        stg[orow * 64 + r32] = (bf16_t)(cvtpk(o0[r] * rl, 0.f) & 0xffffu); stg[orow * 64 + 32 + r32] = (bf16_t)(cvtpk(o1[r] * rl, 0.f) & 0xffffu); }
    asm volatile("s_waitcnt lgkmcnt(0)" ::: "memory");
    bf16_t* Ow = O + (rowb + qb * 256 + wid * 32) * op + h * 64;
#pragma unroll
    for (int i = 0; i < 4; ++i) { const int row = i * 8 + (lane >> 3), ch = lane & 7; const u32x4 v = *(const LAS u32x4*)(stg + row * 64 + ch * 8); st16(Ow + (size_t)row * op + ch * 8, v); }
    #endif
    asm volatile("s_waitcnt lgkmcnt(0)\n\ts_barrier" ::: "memory");
#undef DMAK
#undef DMAV
#undef LD32
#undef KLOAD8
#undef VLOAD8
#undef SOFTMAX8
#undef STEP8
}
__device__ __forceinline__ void attn_phase_f8b(int tid, LAS unsigned char* lds, const unsigned char* Q8, const unsigned char* K8, const unsigned char* VT8, bf16_t* O, int op, int vcu, int G) {
    int bh, qb;
    for (int i = 0; next_unit(i, vcu, G, bh, qb); ++i) attn_unit_f8b(tid, lds, Q8, K8, VT8, O, op, bh >> 3, bh & 7, qb);
}
#endif
template <int DQK>
__device__ __forceinline__ void attn_phase(int tid, LAS unsigned char* lds, const Tensors& A, int vcu, int G) {
#if FAST_ATTN
    int bh, qb;
    for (int i = 0; next_unit(i, vcu, G, bh, qb); ++i) attn_unit<DQK>(tid, lds, A, bh >> 3, bh & 7, qb);
#else
    (void)lds; attn_phase_ref<DQK>(tid, A, vcu, G);
#endif
}
}


struct Args { const float* in[22]; float* out; unsigned char* ws; int ph_lo, ph_hi; };
struct Frame {
    LAS unsigned char* lds; volatile LAS unsigned* MISC; unsigned* ctl;
    int tid, lane, wave, vcu, G;
    unsigned char* ws; float* OUT;
};

__device__ __forceinline__ void p0_phase(Frame& F, const float* c, const float* w_ada, const float* b_ada) {
    LAS float* cs = (LAS float*)F.lds;
    LAS float* red = (LAS float*)(F.lds + 32768);
    for (int i = F.tid; i < NB * D; i += NTHREADS) { const float v = c[i]; cs[i] = v / (1.f + __expf(-v)); }
    __syncthreads();
    float* mod = (float*)(F.ws + WS_MOD);
    const int kq = F.wave, col = F.lane;
    for (int item = F.vcu; item < NL * 6 * D / 64; item += F.G) {
        const int l = item / (6 * D / 64), n0 = (item % (6 * D / 64)) * 64;
        const float* w = w_ada + (size_t)l * D * 6 * D + n0 + col;
        float acc[NB];
#pragma unroll
        for (int b = 0; b < NB; ++b) acc[b] = 0.f;
#pragma unroll 8
        for (int k = kq * 128; k < kq * 128 + 128; ++k) { const float wv = w[(size_t)k * 6 * D];
#pragma unroll
            for (int b = 0; b < NB; ++b) acc[b] += cs[b * D + k] * wv; }
#pragma unroll
        for (int b = 0; b < NB; ++b) red[(kq * NB + b) * 64 + col] = acc[b];
        __syncthreads();
        { const int b = F.wave; float s = 0.f;
#pragma unroll
          for (int q = 0; q < 8; ++q) s += red[(q * NB + b) * 64 + col];
          mod[((size_t)l * NB + b) * 6 * D + n0 + col] = s + b_ada[(size_t)l * 6 * D + n0 + col]; }
        __syncthreads();
    }
    float* cosA = (float*)(F.ws + WS_COSA); float* sinA = (float*)(F.ws + WS_SINA); float* cosB = (float*)(F.ws + WS_COSB); float* sinB = (float*)(F.ws + WS_SINB);
    for (int idx = F.vcu * NTHREADS + F.tid; idx < S * 48; idx += F.G * NTHREADS) {
        const int s = idx / 48, i = idx % 48; const float row = (float)(s >> 6), col2 = (float)(s & 63);
        if (i < 32) { const int j = i & 15; const float a = (i < 16 ? row : col2) * (1.0f / powf(10000.0f, (float)j / 16.0f)); cosA[s * 32 + i] = cosf(a); sinA[s * 32 + i] = sinf(a); }
        else { const int ii = i - 32, j = ii & 7; const float a = (ii < 8 ? row : col2) * (1.0f / powf(10000.0f, (float)j / 8.0f)); cosB[s * 16 + ii] = cosf(a); sinB[s * 16 + ii] = sinf(a); }
    }
}

template <class SrcFn>
__device__ __forceinline__ void cvt_item(const float* W, int K, int Nsrc, const float* kg, bf16_t* WT, LAS float* scr, int item, int nblk, int lane, const SrcFn& src, float f8scale = 0.f) {
    const int kb = item / nblk, nb = item % nblk, k0 = 64 * kb, n0 = 32 * nb;
    const int sc = src(n0 + (lane & 31));
#pragma unroll
    for (int i = 0; i < 32; ++i) { const int kk = 2 * i + (lane >> 5); float v = sc >= 0 ? W[(size_t)(k0 + kk) * Nsrc + sc] : 0.f; if (kg) v *= kg[k0 + kk]; scr[kk * 33 + (lane & 31)] = v; }
    LDS_WAIT(); asm volatile("" ::: "memory");
    const int c = lane & 7;
    if (f8scale != 0.f) {
#pragma unroll
        for (int j = 0; j < 4; ++j) { const int n = (lane >> 3) + 8 * j; const LAS float* sp = scr + (8 * c) * 33 + n;
            const u32x2 o = pack8_fp8((f32x4){sp[0 * 33], sp[1 * 33], sp[2 * 33], sp[3 * 33]} * f8scale, (f32x4){sp[4 * 33], sp[5 * 33], sp[6 * 33], sp[7 * 33]} * f8scale);
            *(u32x2*)((unsigned char*)WT + (size_t)(n0 + n) * K + k0 + 8 * c) = o; }
    } else {
#pragma unroll
    for (int j = 0; j < 4; ++j) { const int n = (lane >> 3) + 8 * j; const LAS float* s = scr + (8 * c) * 33 + n;
        u32x4 o; o.x = cvt_pk_bf16(s[0 * 33], s[1 * 33]); o.y = cvt_pk_bf16(s[2 * 33], s[3 * 33]); o.z = cvt_pk_bf16(s[4 * 33], s[5 * 33]); o.w = cvt_pk_bf16(s[6 * 33], s[7 * 33]);
        *(u32x4*)(WT + (size_t)(n0 + n) * K + k0 + 8 * c) = o; }
    }
    LDS_WAIT(); asm volatile("" ::: "memory");
}
struct SrcId { __device__ int operator()(int n) const { return n; } };
struct SrcIn { __device__ int operator()(int n) const { return gp::src_col_in(n); } };
typedef __attribute__((address_space(4))) const Args CArgsW;
__device__ __forceinline__ void convert_weights(Frame& F, CArgsW* a, int l) {
    LAS float* scr = (LAS float*)(F.lds + F.wave * 16384);
    const int gw = F.vcu * NWAVES + F.wave, NGW = F.G * NWAVES;
    const float* w_in = ((const float*)(GAS const float*)a->in[5]) + (size_t)l * D * INC; const float* w_q_b = ((const float*)(GAS const float*)a->in[10]) + (size_t)l * 384 * 768; const float* w_kv_b = ((const float*)(GAS const float*)a->in[11]) + (size_t)l * 256 * 1024;
    const float* w_pa = ((const float*)(GAS const float*)a->in[12]) + (size_t)l * 512 * D; const float* w_pb = ((const float*)(GAS const float*)a->in[13]) + (size_t)l * 512 * D; const float* w_o = ((const float*)(GAS const float*)a->in[14]) + (size_t)l * D * D;
    const float* w1 = ((const float*)(GAS const float*)a->in[18]) + (size_t)l * NE * D * FF; const float* w3 = ((const float*)(GAS const float*)a->in[19]) + (size_t)l * NE * D * FF; const float* w2 = ((const float*)(GAS const float*)a->in[20]) + (size_t)l * NE * FF * D;
    const float* gqa = ((const float*)(GAS const float*)a->in[8]) + l * 384; const float* gkv = ((const float*)(GAS const float*)a->in[9]) + l * 256;
    bf16_t* Win = (bf16_t*)(F.ws + WS_WIN); bf16_t* Wqb = (bf16_t*)(F.ws + WS_WQB); bf16_t* Wkvb = (bf16_t*)(F.ws + WS_WKVB); bf16_t* Wpa = (bf16_t*)(F.ws + WS_WPA); bf16_t* Wpb = (bf16_t*)(F.ws + WS_WPB);
    bf16_t* Wo = (bf16_t*)(F.ws + WS_WO); bf16_t* W13 = (bf16_t*)(F.ws + WS_W13); bf16_t* W2 = (bf16_t*)(F.ws + WS_W2);
    constexpr int I_IN = (D / 64) * (NIN / 32), I_QB = (384 / 64) * (768 / 32), I_KVB = (256 / 64) * (1024 / 32), I_P = (512 / 64) * (D / 32), I_O = (D / 64) * (D / 32);
    constexpr int I_13 = (D / 64) * (1024 / 32), I_2 = (FF / 64) * (D / 32);
    constexpr int NITEMS = I_IN + I_QB + I_KVB + 2 * I_P + I_O + NE * (I_13 + I_2);
    for (int it = gw; it < NITEMS; it += NGW) {
        int r = it;
        if (r < I_IN) { cvt_item(w_in, D, INC, nullptr, Win, scr, r, NIN / 32, F.lane, SrcIn(), G1_FP8 ? 16.f : 0.f); continue; } r -= I_IN;
        if (r < I_QB) { cvt_item(w_q_b, 384, 768, gqa, Wqb, scr, r, 768 / 32, F.lane, SrcId()); continue; } r -= I_QB;
        if (r < I_KVB) { cvt_item(w_kv_b, 256, 1024, gkv, Wkvb, scr, r, 1024 / 32, F.lane, SrcId()); continue; } r -= I_KVB;
        if (r < I_P) { cvt_item(w_pa, 512, D, nullptr, Wpa, scr, r, D / 32, F.lane, SrcId(), PROJ_FP8 ? WSCALE : 0.f); continue; } r -= I_P;
        if (r < I_P) { cvt_item(w_pb, 512, D, nullptr, Wpb, scr, r, D / 32, F.lane, SrcId(), PROJ_FP8 ? WSCALE : 0.f); continue; } r -= I_P;
        if (r < I_O) { cvt_item(w_o, D, D, nullptr, Wo, scr, r, D / 32, F.lane, SrcId(), PROJ_FP8 ? WSCALE : 0.f); continue; } r -= I_O;
        if (r < NE * I_13) { const int e = r / I_13, q = r % I_13, nb = q % 32;
            const float* src = ((nb & 7) < 4 ? w1 : w3) + (size_t)e * D * FF; const int cb = (nb >> 3) * 128 + (nb & 3) * 32;
            struct SrcOff { int n0, cb; __device__ int operator()(int n) const { return cb + (n - n0); } } so{nb * 32, cb};
            if (MOE_FP8) cvt_item(src, D, FF, nullptr, (bf16_t*)((unsigned char*)W13 + (size_t)e * 1024 * D), scr, q, 32, F.lane, so, 16.f);
            else cvt_item(src, D, FF, nullptr, W13 + (size_t)e * 1024 * D, scr, q, 32, F.lane, so);
            continue; } r -= NE * I_13;
        { const int e = r / I_2, q = r % I_2;
          if (MOE_FP8) cvt_item(w2 + (size_t)e * FF * D, FF, D, nullptr, (bf16_t*)((unsigned char*)W2 + (size_t)e * D * FF), scr, q, D / 32, F.lane, SrcId(), 16.f);
          else cvt_item(w2 + (size_t)e * FF * D, FF, D, nullptr, W2 + (size_t)e * D * FF, scr, q, D / 32, F.lane, SrcId()); }
    }
}

template <int MODE>
__device__ __forceinline__ void row_phase(Frame& F, const float* xin, const float* g2prev, const float* gain, const float* modl, int sh_off, int sc_off, bf16_t* H, bf16_t* XB, float* OUT) {
    constexpr int RB = 4, RPW = T / (256 * NWAVES);
    const int gw = F.vcu * NWAVES + F.wave, b = (gw * RPW) >> 12;
    const bf16_t* Y2 = (const bf16_t*)(F.ws + WS_Y2);
    f32x4 gs[4], shv[4], g2v[4];
#pragma unroll
    for (int j = 0; j < 4; ++j) { const int c = 4 * F.lane + 256 * j; gs[j] = *(const f32x4*)(gain + c);
        if (MODE != 2) { gs[j] = gs[j] * (1.f + *(const f32x4*)(modl + (size_t)b * 6 * D + sc_off + c)); shv[j] = *(const f32x4*)(modl + (size_t)b * 6 * D + sh_off + c); }
        if (MODE != 0) g2v[j] = *(const f32x4*)(g2prev + (size_t)b * 6 * D + 5 * D + c); }
    for (int m0 = gw * RPW; m0 < gw * RPW + RPW; m0 += RB) {
        f32x4 v[RB][4]; float ss[RB];
        if (MODE == 0) {
#pragma unroll
            for (int r = 0; r < RB; ++r)
#pragma unroll
                for (int j = 0; j < 4; ++j) v[r][j] = *(const f32x4*)(xin + (size_t)(m0 + r) * D + 4 * F.lane + 256 * j);
        } else {
            unsigned ya[RB][4], yb[RB][4];
#pragma unroll
            for (int r = 0; r < RB; ++r)
#pragma unroll
                for (int j = 0; j < 4; ++j) { const int m = m0 + r, c = 4 * F.lane + 256 * j;
                    { const u32x2 xb = *(const u32x2*)(XB + (size_t)m * D + c); v[r][j] = (f32x4){bf2f(xb.x & 0xffffu), bf2f(xb.x >> 16), bf2f(xb.y & 0xffffu), bf2f(xb.y >> 16)}; }
                    ya[r][j] = *(const unsigned*)((const unsigned char*)Y2 + (size_t)(2 * m) * D + c); yb[r][j] = *(const unsigned*)((const unsigned char*)Y2 + (size_t)(2 * m + 1) * D + c); }
#pragma unroll
            for (int r = 0; r < RB; ++r)
#pragma unroll
                for (int j = 0; j < 4; ++j) { const f32x2 a0 = __builtin_amdgcn_cvt_pk_f32_fp8((int)ya[r][j], false), a1 = __builtin_amdgcn_cvt_pk_f32_fp8((int)ya[r][j], true), b0 = __builtin_amdgcn_cvt_pk_f32_fp8((int)yb[r][j], false), b1 = __builtin_amdgcn_cvt_pk_f32_fp8((int)yb[r][j], true);
                    const f32x4 y = (f32x4){a0[0] + b0[0], a0[1] + b0[1], a1[0] + b1[0], a1[1] + b1[1]} * 0.0625f;
                    v[r][j] += g2v[j] * y; }
        }
#pragma unroll
        for (int r = 0; r < RB; ++r) { ss[r] = (gp::dot4(v[r][0]) + gp::dot4(v[r][1])) + (gp::dot4(v[r][2]) + gp::dot4(v[r][3])); }
#pragma unroll
        for (int o = 1; o < 64; o <<= 1)
#pragma unroll
            for (int r = 0; r < RB; ++r) ss[r] += shfl_xor_l(ss[r], F.lane, o);
#pragma unroll
        for (int r = 0; r < RB; ++r) {
            const int m = m0 + r; const float rstd = rsqrtf(ss[r] * (1.f / D) + EPS);
#pragma unroll
            for (int j = 0; j < 4; ++j) {
                const int c = 4 * F.lane + 256 * j;
                if (MODE == 2) { *(f32x4*)(OUT + (size_t)m * D + c) = v[r][j] * rstd * gs[j]; }
                else {
                    { u32x2 xw; xw.x = cvt_pk_bf16(v[r][j][0], v[r][j][1]); xw.y = cvt_pk_bf16(v[r][j][2], v[r][j][3]); st8((XB + (size_t)m * D + c), xw); }
                    const f32x4 hv = v[r][j] * rstd * gs[j] + shv[j];
                    if (G1_FP8) { const f32x4 hq = hv * 0.0625f;
                        *(unsigned*)((unsigned char*)H + (size_t)m * D + c) = (unsigned)__builtin_amdgcn_cvt_pk_fp8_f32(hq[2], hq[3], __builtin_amdgcn_cvt_pk_fp8_f32(hq[0], hq[1], 0, false), true); }
                    else { u32x2 w; w.x = cvt_pk_bf16(hv[0], hv[1]); w.y = cvt_pk_bf16(hv[2], hv[3]);
                    st8((H + (size_t)m * D + c), w); }
                }
            }
        }
    }
}

__device__ __forceinline__ void t2_phase(Frame& F, const float* gain, const float* modl, const float* w_router, const float* rbias, int l, bool record) {
    LAS f32x4* wl = (LAS f32x4*)F.lds;
    LAS int* rec = (LAS int*)(F.lds + 65536);
    LAS float* recw = (LAS float*)(F.lds + 65536 + 2048);
    LAS int* lcnt = (LAS int*)(F.lds + 65536 + 4096);
    for (int idx = F.tid; idx < 4096; idx += NTHREADS) {
        const int lane = idx & 63, c = (idx >> 6) & 3, i = (idx >> 8) & 3, j = idx >> 10; const int k = 4 * lane + 256 * j + i;
        wl[idx] = *(const f32x4*)(w_router + (size_t)k * NE + 4 * c);
    }
    if (F.tid < 32) lcnt[F.tid] = 0;
    __syncthreads();
    constexpr int RB = 4, RPW = T / (256 * NWAVES);
    const int gw = F.vcu * NWAVES + F.wave, bt = (gw * RPW) >> 12;
    bf16_t* H = (bf16_t*)(F.ws + WS_H); const bf16_t* XB = (const bf16_t*)(F.ws + WS_XB);
    const int lane = F.lane, myrow = lane >> 4, mye = lane & 15;
    f32x4 gs[4], shv[4];
#pragma unroll
    for (int j = 0; j < 4; ++j) { const int c = 4 * lane + 256 * j; gs[j] = *(const f32x4*)(gain + c) * (1.f + *(const f32x4*)(modl + (size_t)bt * 6 * D + 4 * D + c)); shv[j] = *(const f32x4*)(modl + (size_t)bt * 6 * D + 3 * D + c); }
    int it = 0;
    for (int m0 = gw * RPW; m0 < gw * RPW + RPW; m0 += RB, ++it) {
        f32x4 v[RB][4]; float ss[RB];
#pragma unroll
        for (int r = 0; r < RB; ++r)
#pragma unroll
            for (int j = 0; j < 4; ++j) { const u32x2 xb = *(const u32x2*)(XB + (size_t)(m0 + r) * D + 4 * lane + 256 * j); v[r][j] = (f32x4){bf2f(xb.x & 0xffffu), bf2f(xb.x >> 16), bf2f(xb.y & 0xffffu), bf2f(xb.y >> 16)}; }
#pragma unroll
        for (int r = 0; r < RB; ++r) ss[r] = (gp::dot4(v[r][0]) + gp::dot4(v[r][1])) + (gp::dot4(v[r][2]) + gp::dot4(v[r][3]));
#pragma unroll
        for (int o = 1; o < 64; o <<= 1)
#pragma unroll
            for (int r = 0; r < RB; ++r) ss[r] += shfl_xor_l(ss[r], F.lane, o);
        float acc[RB * NE];
#pragma unroll
        for (int q = 0; q < RB * NE; ++q) acc[q] = 0.f;
#pragma unroll
        for (int j = 0; j < 4; ++j) {
            const int c = 4 * lane + 256 * j;
#pragma unroll
            for (int r = 0; r < RB; ++r) {
                const int m = m0 + r; const float rstd = rsqrtf(ss[r] * (1.f / D) + EPS);
                v[r][j] = v[r][j] * rstd * gs[j] + shv[j];
#if MOE_FP8
                *(unsigned*)((unsigned char*)H + (size_t)m * D + c) = (unsigned)__builtin_amdgcn_cvt_pk_fp8_f32(v[r][j][2], v[r][j][3], __builtin_amdgcn_cvt_pk_fp8_f32(v[r][j][0], v[r][j][1], 0, false), true);
#else
                u32x2 w; w.x = cvt_pk_bf16(v[r][j][0], v[r][j][1]); w.y = cvt_pk_bf16(v[r][j][2], v[r][j][3]);
                st8((H + (size_t)m * D + c), w);
#endif
            }
#pragma unroll
            for (int i = 0; i < 4; ++i)
#pragma unroll
                for (int c4 = 0; c4 < 4; ++c4) { const f32x4 wv = wl[((j * 4 + i) * 4 + c4) * 64 + lane];
#pragma unroll
                    for (int r = 0; r < RB; ++r) { const float hv = v[r][j][i];
                        acc[r * NE + 4 * c4 + 0] += hv * wv[0]; acc[r * NE + 4 * c4 + 1] += hv * wv[1]; acc[r * NE + 4 * c4 + 2] += hv * wv[2]; acc[r * NE + 4 * c4 + 3] += hv * wv[3]; } }
        }
#pragma unroll
        for (int sft = 32; sft >= 1; sft >>= 1) {
            const bool up = (lane & sft) != 0;
#pragma unroll
            for (int k = 0; k < sft; ++k) { const float a = acc[k], b = acc[k + sft]; const float keep = up ? b : a, send = up ? a : b; acc[k] = keep + shfl_xor_l(send, lane, sft); }
        }
        const float logit = acc[0];
        const float score = 1.f / (1.f + expf(-logit));
        float scv[NE], bi[NE];
#pragma unroll
        for (int e = 0; e < NE; ++e) { scv[e] = shfl_l(score, (lane & 48) | e); bi[e] = scv[e] + rbias[e]; }
        int gsel = 0; float gbest = -INFINITY;
#pragma unroll
        for (int g = 0; g < 4; ++g) { float m1 = -INFINITY, m2 = -INFINITY;
#pragma unroll
            for (int j = 0; j < 4; ++j) { const float x = bi[g * 4 + j]; if (x > m1) { m2 = m1; m1 = x; } else if (x > m2) m2 = x; }
            const float gs = m1 + m2; if (gs > gbest) { gbest = gs; gsel = g; } }
        int e1 = -1, e2 = -1; float b1 = -INFINITY, b2 = -INFINITY, s1 = 0.f, s2 = 0.f;
#pragma unroll
        for (int j = 0; j < 4; ++j) { float x = -INFINITY, sx = 0.f;
#pragma unroll
            for (int g = 0; g < 4; ++g) if (g == gsel) { x = bi[g * 4 + j]; sx = scv[g * 4 + j]; }
            const int e = gsel * 4 + j;
            if (x > b1) { b2 = b1; e2 = e1; s2 = s1; b1 = x; e1 = e; s1 = sx; } else if (x > b2) { b2 = x; e2 = e; s2 = sx; } }
        if (mye == 0) {
            const float inv = 1.f / (s1 + s2); const int slot = (it * RB + myrow) * NWAVES + F.wave;
            rec[slot * 4 + 0] = e1; rec[slot * 4 + 1] = e2;
            rec[slot * 4 + 2] = __hip_atomic_fetch_add(&lcnt[e1], 1, __ATOMIC_RELAXED, __HIP_MEMORY_SCOPE_WORKGROUP);
            rec[slot * 4 + 3] = __hip_atomic_fetch_add(&lcnt[e2], 1, __ATOMIC_RELAXED, __HIP_MEMORY_SCOPE_WORKGROUP);
            recw[slot * 2 + 0] = s1 * inv; recw[slot * 2 + 1] = s2 * inv;
        }
    }
    __syncthreads();
    if (!record) return;
    if (F.tid < NE) lcnt[16 + F.tid] = (int)__hip_atomic_fetch_add(F.ctl + CW_CNT + (l * NE + F.tid) * 64, (unsigned)lcnt[F.tid], __ATOMIC_RELAXED, __HIP_MEMORY_SCOPE_AGENT);
    __syncthreads();
    unsigned* list = (unsigned*)(F.ws + WS_LIST); float* gwb = (float*)(F.ws + WS_GW);
    const int nrows = it * RB;
    for (int s = F.tid; s < nrows * NWAVES; s += NTHREADS) {
        const int i2 = s / NWAVES, w = s % NWAVES; const int m = (F.vcu * NWAVES + w) * RPW + i2;
        const int e1 = rec[s * 4 + 0], e2 = rec[s * 4 + 1];
        list[(size_t)e1 * T + lcnt[16 + e1] + rec[s * 4 + 2]] = (unsigned)(2 * m); list[(size_t)e2 * T + lcnt[16 + e2] + rec[s * 4 + 3]] = (unsigned)(2 * m + 1);
        gwb[2 * m] = recw[s * 2]; gwb[2 * m + 1] = recw[s * 2 + 1];
    }
}
__device__ __forceinline__ LAS int* moe_table(Frame& F, int l) {
    LAS int* tab = (LAS int*)(F.lds + MISC_OFF + 1024);
    __syncthreads();
    if (F.tid == 0) { int acc = 0;
        for (int e = 0; e < NE; ++e) { const int c = (int)__hip_atomic_load(F.ctl + CW_CNT + (l * NE + e) * 64, __ATOMIC_RELAXED, __HIP_MEMORY_SCOPE_AGENT); tab[e] = acc; tab[32 + e] = c; acc += (c + 255) >> 8; }
        tab[16] = acc; }
    __syncthreads();
    return tab;
}

typedef __attribute__((address_space(4))) const Args CArgs;
#define LAUNDER_GP(T_, p) do { GAS T_* _t = (GAS T_*)(p); asm volatile("" : "+s"(_t)); (p) = (T_*)_t; } while (0)
#define PH_BEGIN() LAUNDER_V(F.tid); F.lane = F.tid & 63; LAUNDER_GP(unsigned, F.ctl); LAUNDER_GP(float, F.OUT); LAUNDER_GP(unsigned char, F.ws); GAS unsigned char* ws = (GAS unsigned char*)F.ws; CArgs* ka = (CArgs*)__builtin_amdgcn_kernarg_segment_ptr(); LAUNDER_S(ka); \
    float* mod = WSP(float, WS_MOD); (void)mod; (void)ka
#define WSP(T_, off) ((T_*)(GAS T_*)(ws + (off)))
#define KIN(i) ((const float*)(GAS const float*)ka->in[i])
__global__ void __launch_bounds__(NTHREADS, 2) fwd_kernel(Args args) {
    extern __shared__ __attribute__((aligned(16))) unsigned char lds_raw[];
    Frame F;
    F.lds = (LAS unsigned char*)lds_raw; F.MISC = (volatile LAS unsigned*)(F.lds + MISC_OFF);
    F.tid = threadIdx.x; F.lane = F.tid & 63; F.wave = __builtin_amdgcn_readfirstlane(F.tid >> 6);
    F.G = gridDim.x; { const int bx = blockIdx.x; F.vcu = (F.G % 8 == 0) ? (bx % 8) * (F.G / 8) + bx / 8 : bx; }
    F.ws = (unsigned char*)(GAS unsigned char*)args.ws; F.ctl = (unsigned*)(GAS unsigned*)(args.ws + WS_CTL); F.OUT = (float*)(GAS float*)args.out;
    if (F.tid < 64) F.MISC[F.tid] = 0u;
    __syncthreads();
    XcdBarrier bar; bar.bar = F.ctl + CW_BAR; bar.x = 0; bar.st = nullptr;
    if (!N_LAUNCH_MODE) bar = xcd_barrier_post(F.ctl + CW_BAR, F.MISC + 8);
    const int lo = args.ph_lo, hi = args.ph_hi;
#define IN(k) (lo <= (k) && (k) < hi)
#define SEAM(k) do { if ((k) + 1 < hi) { if (!N_LAUNCH_MODE) xcd_barrier(bar); } } while (0)
    const int cidx = (int)blockIdx.x;

    if (IN(0)) { PH_BEGIN(); p0_phase(F, KIN(1), KIN(2), KIN(3)); __syncthreads(); LAUNDER_V(F.tid); F.lane = F.tid & 63; convert_weights(F, ka, 0); SEAM(0); }
    for (int l = 0; l < NL; ++l) {
        const int pb = 1 + 9 * l;
        if (IN(pb + 0)) {
            PH_BEGIN();
            if (l > 0) for (int rep = 0; rep < ((PROBE_DUP & 8) ? 2 : 1); ++rep) { LAUNDER_V(F.tid); F.lane = F.tid & 63; convert_weights(F, ka, l); }
            if (l == 0) row_phase<0>(F, KIN(0), nullptr, KIN(4) + l * D, mod + (size_t)l * NB * 6 * D, 0, D, WSP(bf16_t, WS_H), WSP(bf16_t, WS_XB), nullptr);
            else row_phase<1>(F, nullptr, mod + (size_t)(l - 1) * NB * 6 * D, KIN(4) + l * D, mod + (size_t)l * NB * 6 * D, 0, D, WSP(bf16_t, WS_H), WSP(bf16_t, WS_XB), nullptr);
            SEAM(pb + 0);
        }
        if (IN(pb + 1)) {
            PH_BEGIN();
            gp::Gemm g{WSP(bf16_t, WS_H), WSP(const bf16_t, WS_WIN), G1_FP8 ? D / 2 : D, 0, nullptr, 0, 0, 0}; gp::DenseOrder So; So.init(T, NIN, F.G, cidx);
            gp::EpiIn E{WSP(bf16_t, ATT_FP8_A ? WS_QA8 : WS_QA), WSP(bf16_t, ATT_FP8_A ? WS_KA8 : WS_KA), WSP(bf16_t, ATT_FP8_A ? WS_VTA8 : WS_VA), WSP(bf16_t, WS_QLAT), WSP(bf16_t, WS_KVLAT), WSP(bf16_t, ATT_FP8_B ? WS_KB8 : WS_KB), WSP(bf16_t, WS_SA), WSP(bf16_t, WS_SB), WSP(float, WS_SSQ), WSP(float, WS_SSKV),
                        KIN(6) + l * 64, KIN(7) + l * 64, WSP(const float, WS_COSA), WSP(const float, WS_SINA), WSP(const float, WS_COSB), WSP(const float, WS_SINB)};
            if (PROBE_DUP & 128) { gp::EpiNull En; gp::gemm_phase<gp::EpiNull, gp::DenseOrder>(F.tid, F.lds, g, So, En); LAUNDER_V(F.tid); }
            gp::gemm_phase<gp::EpiIn, gp::DenseOrder, false, G1_FP8 != 0>(F.tid, F.lds, g, So, E); if (PROBE_DUP & (2 | 512)) { LAUNDER_V(F.tid); gp::gemm_phase<gp::EpiIn, gp::DenseOrder, false, G1_FP8 != 0>(F.tid, F.lds, g, So, E); }
            SEAM(pb + 1);
        }
        if (IN(pb + 2)) {
            { PH_BEGIN(); gp::Gemm g{WSP(bf16_t, WS_QLAT), WSP(const bf16_t, WS_WQB), 384, 0, nullptr}; gp::DenseOrder So; So.init(T, 768, F.G, cidx);
              gp::EpiQb E{WSP(bf16_t, ATT_FP8_B ? WS_QB8 : WS_QB), WSP(const float, WS_SSQ), WSP(const float, WS_COSB), WSP(const float, WS_SINB)}; gp::gemm_phase<gp::EpiQb, gp::DenseOrder>(F.tid, F.lds, g, So, E); if (PROBE_DUP & 2) { LAUNDER_V(F.tid); gp::gemm_phase<gp::EpiQb, gp::DenseOrder>(F.tid, F.lds, g, So, E); } }
            { PH_BEGIN(); gp::Gemm g{WSP(bf16_t, WS_KVLAT), WSP(const bf16_t, WS_WKVB), 256, 0, nullptr}; gp::DenseOrder So; So.init(T, 1024, F.G, F.G - 1 - cidx);
              gp::EpiKvb E{WSP(bf16_t, ATT_FP8_B ? WS_KB8 : WS_KB), WSP(bf16_t, ATT_FP8_B ? WS_VTB8 : WS_VB), WSP(const float, WS_SSKV)}; gp::gemm_phase<gp::EpiKvb, gp::DenseOrder>(F.tid, F.lds, g, So, E); if (PROBE_DUP & 2) { LAUNDER_V(F.tid); gp::gemm_phase<gp::EpiKvb, gp::DenseOrder>(F.tid, F.lds, g, So, E); } }
#if FAST_ATTN && ATT_FP8_A
            { PH_BEGIN(); at::attn_phase_f8a(F.tid, F.lds, WSP(const unsigned char, WS_QA8), WSP(const unsigned char, WS_KA8), WSP(const unsigned char, WS_VTA8), WSP(bf16_t, WS_QA), 512, KIN(6) + l * 64, KIN(7) + l * 64, F.vcu, F.G); }
            if (PROBE_DUP & (1 | 4096)) { PH_BEGIN(); at::attn_phase_f8a(F.tid, F.lds, WSP(const unsigned char, WS_QA8), WSP(const unsigned char, WS_KA8), WSP(const unsigned char, WS_VTA8), WSP(bf16_t, WS_QA), 512, KIN(6) + l * 64, KIN(7) + l * 64, F.vcu, F.G); }
#else
            { PH_BEGIN(); const at::Tensors A{WSP(bf16_t, WS_QA), 512, WSP(bf16_t, WS_KA), 128, WSP(bf16_t, WS_VA), 128, WSP(bf16_t, WS_QA), 512, 4}; at::attn_phase<64>(F.tid, F.lds, A, F.vcu, F.G); }
#endif
            SEAM(pb + 2);
        }
        if (IN(pb + 3)) {
            PH_BEGIN();
#if FAST_ATTN && ATT_FP8_B
            at::attn_phase_f8b(F.tid, F.lds, WSP(const unsigned char, WS_QB8), WSP(const unsigned char, WS_KB8), WSP(const unsigned char, WS_VTB8), WSP(bf16_t, WS_OB), 512, F.vcu, F.G);
            if (PROBE_DUP & (1 | 8192)) { LAUNDER_V(F.tid); at::attn_phase_f8b(F.tid, F.lds, WSP(const unsigned char, WS_QB8), WSP(const unsigned char, WS_KB8), WSP(const unsigned char, WS_VTB8), WSP(bf16_t, WS_OB), 512, F.vcu, F.G); }
#else
            const at::Tensors A{WSP(bf16_t, WS_QB), 768, WSP(bf16_t, WS_KB), 768, WSP(bf16_t, WS_VB), 512, WSP(bf16_t, WS_OB), 512, 1}; for (int rep = 0; rep < ((PROBE_DUP & 1) ? 2 : 1); ++rep) at::attn_phase<96>(F.tid, F.lds, A, F.vcu, F.G);
#endif
            SEAM(pb + 3);
        }
        if (IN(pb + 4)) {
            PH_BEGIN();
            gp::Gemm g{WSP(bf16_t, WS_QA), WSP(const bf16_t, WS_WPA), PROJ_FP8 ? 256 : 512, (size_t)(WS_WPB - WS_WPA) / 2, nullptr, (size_t)(WS_OB - WS_QA) / 2, 0, 0}; gp::PairOrder So; So.init(T, D, F.G, cidx);
            gp::EpiProjP E{WSP(bf16_t, WS_H), WSP(const unsigned char, WS_SA), WSP(const unsigned char, WS_SB)};
            gp::gemm_phase<gp::EpiProjP, gp::PairOrder, false, PROJ_FP8 != 0>(F.tid, F.lds, g, So, E);
            if (PROBE_DUP & (2 | 1024)) { LAUNDER_V(F.tid); gp::gemm_phase<gp::EpiProjP, gp::PairOrder, false, PROJ_FP8 != 0>(F.tid, F.lds, g, So, E); }
            SEAM(pb + 4);
        }
        if (IN(pb + 5)) {
            PH_BEGIN();
            gp::Gemm g{WSP(bf16_t, WS_H), WSP(const bf16_t, WS_WO), PROJ_FP8 ? D / 2 : D, 0, nullptr, 0, 0, 0}; gp::DenseOrder So; So.init(T, D, F.G, cidx);
            if (PROBE_DUP & 2048) { gp::EpiNull En; gp::gemm_phase<gp::EpiNull, gp::DenseOrder>(F.tid, F.lds, g, So, En); LAUNDER_V(F.tid); }
            gp::EpiWo E{WSP(const bf16_t, WS_XB), mod + (size_t)l * NB * 6 * D, WSP(bf16_t, WS_XB)}; gp::gemm_phase<gp::EpiWo, gp::DenseOrder, false, PROJ_FP8 != 0>(F.tid, F.lds, g, So, E);
            SEAM(pb + 5);
        }
        if (IN(pb + 6)) {
            PH_BEGIN();
            if (PROBE_DUP & 16) { t2_phase(F, KIN(15) + l * D, mod + (size_t)l * NB * 6 * D, KIN(16), KIN(17), l, false); LAUNDER_V(F.tid); F.lane = F.tid & 63; __syncthreads(); }
            t2_phase(F, KIN(15) + l * D, mod + (size_t)l * NB * 6 * D, KIN(16), KIN(17), l, true);
            SEAM(pb + 6);
        }
        if (IN(pb + 7)) {
            PH_BEGIN();
            LAS int* tab = moe_table(F, l);
#if MOE_FP8
            gp::Gemm g{WSP(bf16_t, WS_H), WSP(const bf16_t, WS_W13), D / 2, (size_t)1024 * D / 2, WSP(const unsigned, WS_LIST), 0, 0, 0}; gp::MoeOrder So; So.init(tab, F.G, cidx);
            gp::EpiUp E{WSP(bf16_t, WS_ACT), 1.f / 16.f}; gp::gemm_phase<gp::EpiUp, gp::MoeOrder, true, true>(F.tid, F.lds, g, So, E);
            if (PROBE_DUP & 4) { LAUNDER_V(F.tid); gp::gemm_phase<gp::EpiUp, gp::MoeOrder, true, true>(F.tid, F.lds, g, So, E); }
#else
            gp::Gemm g{WSP(bf16_t, WS_H), WSP(const bf16_t, WS_W13), D, (size_t)1024 * D, WSP(const unsigned, WS_LIST)}; gp::MoeOrder So; So.init(tab, F.G, cidx);
            gp::EpiUp E{WSP(bf16_t, WS_ACT), 1.f}; gp::gemm_phase<gp::EpiUp, gp::MoeOrder, true>(F.tid, F.lds, g, So, E);
#endif
            SEAM(pb + 7);
        }
        if (IN(pb + 8)) {
            PH_BEGIN();
            LAS int* tab = moe_table(F, l);
#if MOE_FP8
            gp::Gemm g{WSP(bf16_t, WS_ACT), WSP(const bf16_t, WS_W2), FF / 2, (size_t)D * FF / 2, nullptr, 0, 0, 0}; gp::MoeOrder So; So.init(tab, F.G, cidx);
            gp::EpiDown E{WSP(bf16_t, WS_Y2), WSP(const unsigned, WS_LIST), WSP(const float, WS_GW), 1.f / 128.f}; gp::gemm_phase<gp::EpiDown, gp::MoeOrder, false, true>(F.tid, F.lds, g, So, E);
            if (PROBE_DUP & 4) { LAUNDER_V(F.tid); gp::gemm_phase<gp::EpiDown, gp::MoeOrder, false, true>(F.tid, F.lds, g, So, E); }
#else
            gp::Gemm g{WSP(bf16_t, WS_ACT), WSP(const bf16_t, WS_W2), FF, (size_t)D * FF, nullptr}; gp::MoeOrder So; So.init(tab, F.G, cidx);
            gp::EpiDown E{WSP(bf16_t, WS_Y2), WSP(const unsigned, WS_LIST), WSP(const float, WS_GW), 1.f}; gp::gemm_phase<gp::EpiDown, gp::MoeOrder, false>(F.tid, F.lds, g, So, E);
#endif
            SEAM(pb + 8);
        }
    }
    if (IN(NPHASE - 1)) { PH_BEGIN(); row_phase<2>(F, nullptr, mod + (size_t)(NL - 1) * NB * 6 * D, KIN(21), nullptr, 0, 0, nullptr, WSP(bf16_t, WS_XB), F.OUT); }
#undef IN
#undef SEAM
}

extern "C" void kernel_launch(void* const* d_in, const int* in_sizes, int n_in, void* d_out, int out_size, void* d_ws, size_t ws_size, hipStream_t stream) {
    static int grid = 0;
    if (grid == 0) {
        if (n_in != 22 || out_size != T * D || ws_size < WS_END) { fprintf(stderr, "kernel_launch: unexpected problem (n_in %d out %d ws %zu)\n", n_in, out_size, ws_size); grid = -1; return; }
        int dev = 0, cus = 0, per_cu = 0;
        if (hipGetDevice(&dev) != hipSuccess || hipDeviceGetAttribute(&cus, hipDeviceAttributeMultiprocessorCount, dev) != hipSuccess) { grid = -1; return; }
        if (hipFuncSetAttribute((const void*)fwd_kernel, hipFuncAttributeMaxDynamicSharedMemorySize, LDS_BYTES) != hipSuccess) { grid = -1; return; }
        if (hipOccupancyMaxActiveBlocksPerMultiprocessor(&per_cu, (const void*)fwd_kernel, NTHREADS, LDS_BYTES) != hipSuccess || per_cu < 1) { fprintf(stderr, "kernel_launch: occupancy query says %d\n", per_cu); }
        (void)hipGetLastError();
        grid = cus;
        if (grid != 256 || T % (grid * NWAVES * 4) != 0) {   fprintf(stderr, "kernel_launch: grid %d does not divide the row phases\n", grid); grid = -1; return; }
    }
    if (grid < 0) return;
    (void)hipMemsetAsync((char*)d_ws + WS_CTL, 0, CTL_BYTES, stream);
    Args a{};
    for (int i = 0; i < 22; ++i) a.in[i] = (const float*)d_in[i];
    a.out = (float*)d_out; a.ws = (unsigned char*)d_ws;
#if N_LAUNCH_MODE
    for (int p = 0; p < NPHASE; ++p) { a.ph_lo = p; a.ph_hi = p + 1; hipLaunchKernelGGL(fwd_kernel, dim3(grid), dim3(NTHREADS), LDS_BYTES, stream, a); }
#else
    a.ph_lo = 0; a.ph_hi = NPHASE;
    hipLaunchKernelGGL(fwd_kernel, dim3(grid), dim3(NTHREADS), LDS_BYTES, stream, a);
#endif
}
```

```cpp
#include <hip/hip_runtime.h>
#include <stdint.h>
#include <stdio.h>
#include <math.h>

#ifndef FAST_GEMM
#define FAST_GEMM 1
#endif
#ifndef FAST_ATTN
#define FAST_ATTN 1
#endif
#ifndef PROBE_DUP
#define PROBE_DUP 0
#endif
#ifndef PROBE_ATT
#define PROBE_ATT 0
#endif
#ifndef ATT_REGSTAGE
#define ATT_REGSTAGE 0
#endif
#ifndef WT_STORES
#define WT_STORES 0
#endif
#ifndef ATT_FP8_A
#define ATT_FP8_A 1
#endif
#ifndef ATT_FP8_B
#define ATT_FP8_B 1
#endif
#ifndef MOE_FP8
#define MOE_FP8 1
#endif
#ifndef G1_FP8
#define G1_FP8 1
#endif
#ifndef PROJ_FP8
#define PROJ_FP8 1
#endif
#ifndef XCD_LOCAL_SEAMS
#define XCD_LOCAL_SEAMS 1
#endif
#ifndef N_LAUNCH_MODE
#define N_LAUNCH_MODE 0
#endif

#define LAS __attribute__((address_space(3)))
#define GAS __attribute__((address_space(1)))
typedef unsigned short bf16_t;
typedef short bf16x8 __attribute__((ext_vector_type(8)));
typedef float f32x4 __attribute__((ext_vector_type(4)));
typedef float f32x2 __attribute__((ext_vector_type(2)));
typedef float f32x16 __attribute__((ext_vector_type(16)));
typedef unsigned u32x4 __attribute__((ext_vector_type(4)));
typedef unsigned u32x2 __attribute__((ext_vector_type(2)));
typedef GAS unsigned gu32;

constexpr int D = 1024, NB = 8, S = 4096, T = NB * S, NL = 4, INC = 3488, NIN = 3584, NE = 16, FF = 512;
constexpr float EPS = 1e-6f, LOG2E = 1.4426950408889634f;
constexpr float QSCALE_A = 0.125f * LOG2E, QSCALE_B = 0.10206207261596577f * LOG2E;
constexpr float PFOLD = 4.f, PBYTE0 = 60.26f;
constexpr float OSCALE = 64.f, WSCALE = 16.f;
constexpr int NWAVES = 8, NTHREADS = 512;
constexpr int NPHASE = 2 + 9 * NL;

constexpr size_t MiB = 1u << 20;
constexpr size_t WS_CTL = 0, CTL_BYTES = 1 * MiB;
constexpr size_t WS_MOD = 1 * MiB;
constexpr size_t WS_COSA = 2 * MiB, WS_SINA = WS_COSA + 512 * 1024, WS_COSB = 3 * MiB, WS_SINB = WS_COSB + 256 * 1024;
constexpr size_t WS_SSQ = 4 * MiB, WS_SSKV = 5 * MiB;
constexpr size_t WS_GW = 6 * MiB;
constexpr size_t WS_LIST = 7 * MiB;
constexpr size_t WS_WIN = 10 * MiB, WS_WQB = 17 * MiB, WS_WKVB = 18 * MiB, WS_WPA = 19 * MiB, WS_WPB = 20 * MiB, WS_WO = 21 * MiB, WS_W13 = 23 * MiB, WS_W2 = 55 * MiB;
constexpr size_t WS_H = 72 * MiB;
constexpr size_t WS_QA = 136 * MiB, WS_KA = 168 * MiB, WS_VA = 176 * MiB, WS_QLAT = 184 * MiB, WS_KVLAT = 208 * MiB;
constexpr size_t WS_KB = 224 * MiB, WS_VB = 272 * MiB, WS_QB = 304 * MiB, WS_OB = 352 * MiB, WS_SA = 384 * MiB, WS_SB = 448 * MiB, WS_XB = 512 * MiB, WS_QA8 = 576 * MiB, WS_KA8 = 592 * MiB, WS_VTA8 = 596 * MiB, WS_QB8 = 600 * MiB, WS_KB8 = 624 * MiB, WS_VTB8 = 648 * MiB, WS_END = 664 * MiB;
constexpr size_t WS_ACT = 136 * MiB, WS_Y2 = 208 * MiB;
constexpr int ACT_ROWS = 2 * T + NE * 256;
static_assert(WS_ACT + (size_t)ACT_ROWS * FF * 2 <= WS_Y2 && WS_Y2 + (size_t)2 * T * D * 2 <= WS_XB, "moe overlay");
constexpr int CW_BAR = 4096;
constexpr int CW_CNT = 16384;

constexpr int RING_BYTES = 131072, MISC_OFF = RING_BYTES, LDS_BYTES = 147456;

__device__ __forceinline__ float bf2f(unsigned v) { return __uint_as_float(v << 16); }
typedef __bf16 bf16x2_t __attribute__((ext_vector_type(2)));
__device__ __forceinline__ unsigned cvt_pk_bf16(float lo, float hi) { f32x2 v = {lo, hi}; bf16x2_t b = __builtin_convertvector(v, bf16x2_t); return __builtin_bit_cast(unsigned, b); }
__device__ __forceinline__ u32x4 pack8(f32x4 a, f32x4 b) { u32x4 w; w.x = cvt_pk_bf16(a[0], a[1]); w.y = cvt_pk_bf16(a[2], a[3]); w.z = cvt_pk_bf16(b[0], b[1]); w.w = cvt_pk_bf16(b[2], b[3]); return w; }
__device__ __forceinline__ u32x2 pack8_fp8(f32x4 a, f32x4 b) { u32x2 w;
    w.x = (unsigned)__builtin_amdgcn_cvt_pk_fp8_f32(a[2], a[3], __builtin_amdgcn_cvt_pk_fp8_f32(a[0], a[1], 0, false), true);
    w.y = (unsigned)__builtin_amdgcn_cvt_pk_fp8_f32(b[2], b[3], __builtin_amdgcn_cvt_pk_fp8_f32(b[0], b[1], 0, false), true); return w; }
__device__ __forceinline__ u32x4 pair16(u32x2 w0, u32x2 w1) {
    const auto x = __builtin_amdgcn_permlane16_swap(w0.x, w1.x, false, false); const auto y = __builtin_amdgcn_permlane16_swap(w0.y, w1.y, false, false);
    return (u32x4){x[0], y[0], x[1], y[1]};
}
__device__ __forceinline__ void unpack8(u32x4 w, f32x4& a, f32x4& b) { a[0] = bf2f(w.x & 0xffffu); a[1] = bf2f(w.x >> 16); a[2] = bf2f(w.y & 0xffffu); a[3] = bf2f(w.y >> 16); b[0] = bf2f(w.z & 0xffffu); b[1] = bf2f(w.z >> 16); b[2] = bf2f(w.w & 0xffffu); b[3] = bf2f(w.w >> 16); }
__device__ __forceinline__ float shfl_xor_l(float v, int lane, int m) { return __int_as_float(__builtin_amdgcn_ds_bpermute((lane ^ m) << 2, __float_as_int(v))); }
__device__ __forceinline__ float shfl_l(float v, int src) { return __int_as_float(__builtin_amdgcn_ds_bpermute(src << 2, __float_as_int(v))); }
__device__ __forceinline__ float sum_xor16(float v) { const auto r = __builtin_amdgcn_permlane16_swap(__float_as_uint(v), __float_as_uint(v), false, false); return __uint_as_float(r[0]) + __uint_as_float(r[1]); }
__device__ __forceinline__ float sum_xor32(float v) { const auto r = __builtin_amdgcn_permlane32_swap(__float_as_uint(v), __float_as_uint(v), false, false); return __uint_as_float(r[0]) + __uint_as_float(r[1]); }
__device__ __forceinline__ float wave_sum(float v, int lane) {
#pragma unroll
    for (int o = 1; o < 64; o <<= 1) v += shfl_xor_l(v, lane, o);
    return v;
}
__device__ __forceinline__ float sigm(float v) { return __builtin_amdgcn_rcpf(1.f + __builtin_amdgcn_exp2f(v * (-LOG2E))); }
#if WT_STORES
__device__ __forceinline__ void st16(void* p, u32x4 v) { asm volatile("global_store_dwordx4 %0, %1, off sc1\n\ts_nop 1" :: "v"(p), "v"(v) : "memory"); }
__device__ __forceinline__ void st8(void* p, u32x2 v) { asm volatile("global_store_dwordx2 %0, %1, off sc1\n\ts_nop 1" :: "v"(p), "v"(v) : "memory"); }
#else
__device__ __forceinline__ void st16(void* p, u32x4 v) { *(u32x4*)p = v; }
__device__ __forceinline__ void st8(void* p, u32x2 v) { *(u32x2*)p = v; }
#endif
#define VM_WAIT() asm volatile("s_waitcnt vmcnt(0)" ::: "memory")
#define LAUNDER_S(p) asm volatile("" : "+s"(p))
#define LAUNDER_V(v) asm volatile("" : "+v"(v))
#define LDS_WAIT() asm volatile("s_waitcnt lgkmcnt(0)" ::: "memory")

#define XB_TMO      128
#define XB_XCNT(j)  (256  + 64 * (j))
#define XB_XSUB(j)  (1280 + 64 * (j))
#define XB_XGEN(j)  (2304 + 64 * (j))
#define XB_TOP      3328
#define XB_TOPGEN   3392
#define XCD_BAR_WORDS 3456
#define XB_LSUB(j)  (3456 + 64 * (j))
#define XB_LGEN(j)  (3456 + 1024 + 64 * (j))
#define XB_SPIN_CAP (1u << 22)
__device__ __forceinline__ unsigned xb_ld(unsigned* p)              { return __hip_atomic_load(p, __ATOMIC_RELAXED, __HIP_MEMORY_SCOPE_AGENT); }
__device__ __forceinline__ unsigned xb_add(unsigned* p, unsigned v) { return __hip_atomic_fetch_add(p, v, __ATOMIC_RELAXED, __HIP_MEMORY_SCOPE_AGENT); }
__device__ __forceinline__ unsigned xb_xcc_id() { return (unsigned)__builtin_amdgcn_s_getreg((3 << 11) | 20) & 0xFu; }
#define XB_SPIN(cond, bar) do { unsigned _sp = 0; while (cond) { __builtin_amdgcn_s_sleep(1); \
    if ((++_sp & 255u) == 0u) { if (xb_ld(&(bar)[XB_TMO])) break; if (_sp > XB_SPIN_CAP) { atomicAdd(&(bar)[XB_TMO], 1u); break; } } } } while (0)
struct XcdBarrier { unsigned* bar; unsigned x; volatile LAS unsigned* st; };
__device__ __forceinline__ XcdBarrier xcd_barrier_post(unsigned* bar, volatile LAS unsigned* st) {
    XcdBarrier b; b.bar = bar; b.x = xb_xcc_id(); b.st = st;
    if (threadIdx.x == 0) st[2] = xb_add(&bar[XB_XCNT(b.x)], 1u);
    return b;
}
__device__ __forceinline__ void xcd_barrier_complete(unsigned* bar, unsigned x, unsigned& nloc, unsigned& nx) {
    const unsigned G = gridDim.x * gridDim.y * gridDim.z;
    unsigned sum, cnt, mine, sp = 0u;
    for (;;) {
        sum = 0u; cnt = 0u; mine = 0u;
#pragma unroll
        for (unsigned j = 0; j < 16; ++j) { const unsigned c = xb_ld(&bar[XB_XCNT(j)]); sum += c; cnt += (c > 0u) ? 1u : 0u; mine = (j == x) ? c : mine; }
        if (sum == G) break;
        __builtin_amdgcn_s_sleep(1);
        if ((++sp & 255u) == 0u) { if (xb_ld(&bar[XB_TMO])) break; if (sp > XB_SPIN_CAP) { atomicAdd(&bar[XB_TMO], 1u); break; } }
    }
    nloc = mine > 0u ? mine : 1u; nx = cnt > 0u ? cnt : 1u;
}
__device__ __forceinline__ void xcd_barrier(const XcdBarrier& b) {
    asm volatile("s_waitcnt vmcnt(0)" ::: "memory");
    __syncthreads();
    if (threadIdx.x == 0) {
        unsigned* bar = b.bar;
        __builtin_amdgcn_s_waitcnt(0);
        unsigned nloc = b.st[0], nx = b.st[1];
        if (nloc == 0u) { xcd_barrier_complete(bar, b.x, nloc, nx); b.st[0] = nloc; b.st[1] = nx; }
        const unsigned old = xb_add(&bar[XB_XSUB(b.x)], 1u);
        const unsigned gen = old / nloc;
        if (old + 1u == (gen + 1u) * nloc) {
            __builtin_amdgcn_fence(__ATOMIC_RELEASE, "agent");
            asm volatile("s_waitcnt vmcnt(0)" ::: "memory");
            const unsigned og = xb_add(&bar[XB_TOP], 1u);
            const unsigned tg = og / nx;
            if (og + 1u == (tg + 1u) * nx) xb_add(&bar[XB_TOPGEN], 1u);
            else XB_SPIN(xb_ld(&bar[XB_TOPGEN]) == tg, bar);
            __builtin_amdgcn_fence(__ATOMIC_ACQUIRE, "agent");
            xb_add(&bar[XB_XGEN(b.x)], 1u);
            asm volatile("s_waitcnt vmcnt(0)" ::: "memory");
        } else {
            XB_SPIN(xb_ld(&bar[XB_XGEN(b.x)]) == gen, bar);
            __builtin_amdgcn_fence(__ATOMIC_ACQUIRE, "agent");
            asm volatile("s_waitcnt vmcnt(0)" ::: "memory");
        }
    }
    __syncthreads();
}

namespace gp {
constexpr int BM = 256, BK = 64, HALF = 128, HTB = HALF * BK * 2, NXCD = 8, WGM = 8;
__host__ __device__ __forceinline__ int lds_byte(int r, int c) { const int st = (r >> 4) * 2 + (c >> 5), rr = r & 15, cc = c & 31, ob = rr * 64 + cc * 2; return st * 1024 + (ob ^ (((ob >> 9) & 1) << 5)); }
__host__ __device__ __forceinline__ void stage_rc(int b, int& R, int& C) { const int st = b / 1024, sb = b % 1024, swz = sb ^ (((sb >> 9) & 1) << 5); R = (st >> 1) * 16 + swz / 64; C = (st & 1) * 32 + (swz % 64) / 2; }
__host__ __device__ __forceinline__ int perm32(int rho) { const int n = rho >> 4, i = rho & 15; return 8 * (i >> 2) + 4 * n + (i & 3); }

struct Unit { int pm, pn, be, rl, nv; };
struct Gemm { const bf16_t* A; const bf16_t* Bt; int K; size_t bstride; const unsigned* list; size_t astride; int sw, sx; };

__device__ __forceinline__ int xcd_remap(int wgid, int nwg) { const int q = nwg / NXCD, r = nwg % NXCD, xcd = wgid % NXCD, off = wgid / NXCD; return (xcd < r ? xcd * (q + 1) : r * (q + 1) + (xcd - r) * q) + off; }
struct DenseOrder {
    int nM, nN, nwg, G, c;
    __device__ void init(int M, int N, int G_, int c_) { nM = M / BM; nN = N / BM; nwg = nM * nN; G = G_; c = c_; }
    __device__ bool next(int i, Unit& u) const {
        const int L = i * G + c; if (L >= nwg) return false;
        const int wgid = xcd_remap((int)L, nwg);
        const int nig = WGM * nN, gid = wgid / nig, fm = gid * WGM, gsz = (nM - fm) < WGM ? (nM - fm) : WGM;
        u.pm = fm + ((wgid % nig) % gsz); u.pn = (wgid % nig) / gsz; u.be = 0; u.rl = 0; u.nv = 256; return true;
    }
};
struct PairOrder {
    DenseOrder d;
    __device__ void init(int M, int N, int G_, int c_) { d.init(M, N, G_, c_); }
    __device__ bool next(int i, Unit& u) const { if (!d.next(i >> 1, u)) return false; u.be = i & 1; return true; }
};
struct MoeOrder {
    const LAS int* tab; int nwg, G, c;
    __device__ static int rd(const LAS int* p) { return __builtin_amdgcn_readfirstlane(*p); }
    __device__ void init(const LAS int* tab_, int G_, int c_) { tab = tab_; nwg = rd(tab_ + 16) * 4; G = G_; c = c_; }
    __device__ bool next(int i, Unit& u) const {
        const int L = i * G + c; if (L >= nwg) return false;
        const int wgid = xcd_remap((int)L, nwg);
        const int tile = wgid >> 2; int e = 0;
        for (int k = 1; k < NE; ++k) { const int tk = rd(tab + k); e = (tk <= tile) ? k : e; }
        e = __builtin_amdgcn_readfirstlane(e);
        u.pm = tile; u.pn = wgid & 3; u.be = e; u.rl = tile - rd(tab + e); const int rem = rd(tab + 32 + e) - u.rl * 256; u.nv = rem < 256 ? rem : 256; return true;
    }
};

#define ACC_T f32x4 (&acc)[2][2][4][2]

template <class Epi, class Sched, bool GATHER>
__device__ __forceinline__ void gemm_phase_ref(int tid, const Gemm g, const Sched& S, const Epi& E) {
    const int wid = __builtin_amdgcn_readfirstlane(tid >> 6), lane = tid & 63, wr = wid >> 2, wc = wid & 3, fr = lane & 15, fq = lane >> 4;
    const int K = g.K; Unit u;
    for (int ui = 0; S.next(ui, u); ++ui) {
        f32x4 acc[2][2][4][2];
#pragma unroll
        for (int a = 0; a < 2; ++a)
#pragma unroll
            for (int b = 0; b < 2; ++b)
#pragma unroll
                for (int m = 0; m < 4; ++m)
#pragma unroll
                    for (int n = 0; n < 2; ++n) acc[a][b][m][n] = (f32x4){0.f, 0.f, 0.f, 0.f};
        const bf16_t* Bt = g.Bt + (size_t)u.be * g.bstride + (size_t)u.pn * 256 * K;
        for (int ai = 0; ai < 2; ++ai)
            for (int m = 0; m < 4; ++m) {
                const int rloc = ai * 128 + wr * 64 + m * 16 + fr;
                size_t arow;
                if (GATHER) { arow = (rloc < u.nv) ? (size_t)(g.list[(size_t)u.be * T + u.rl * 256 + rloc] >> 1) : 0; }
                else arow = (size_t)u.pm * 256 + rloc;
                const bf16_t* ap = g.A + arow * K;
                for (int bj = 0; bj < 2; ++bj) {
                    const bf16_t* bp = Bt + (size_t)(bj * 128 + wc * 32 + fq * 8) * K;
                    float s[8];
#pragma unroll
                    for (int c = 0; c < 8; ++c) {
                        float sc = 0.f; const bf16_t* bpc = bp + (size_t)c * K;
#pragma unroll 2
                        for (int k = 0; k < K; k += 8) {
                            f32x4 a0, a1, b0, b1; unpack8(*(const u32x4*)(ap + k), a0, a1); unpack8(*(const u32x4*)(bpc + k), b0, b1);
                            sc += a0[0] * b0[0] + a0[1] * b0[1] + a0[2] * b0[2] + a0[3] * b0[3] + a1[0] * b1[0] + a1[1] * b1[1] + a1[2] * b1[2] + a1[3] * b1[3];
                        }
                        s[c] = sc; asm volatile("" : "+v"(s[c]));
                    }
#pragma unroll
                    for (int a2 = 0; a2 < 2; ++a2)
#pragma unroll
                        for (int b2 = 0; b2 < 2; ++b2)
#pragma unroll
                            for (int m2 = 0; m2 < 4; ++m2)
                                if (a2 == ai && b2 == bj && m2 == m) { acc[a2][b2][m2][0] = (f32x4){s[0], s[1], s[2], s[3]}; acc[a2][b2][m2][1] = (f32x4){s[4], s[5], s[6], s[7]}; }
                }
            }
        E(acc, u, wr, wc, fr, fq);
    }
}

template <class E> struct EpiTraits { static constexpr bool KEEP = false; };
#if FAST_GEMM
typedef int v8i_t __attribute__((ext_vector_type(8)));
__device__ __forceinline__ unsigned gp_voffb(int tid, int i, int K) { int t_ = tid; LAUNDER_V(t_); int R, C; stage_rc(t_ * 16 + i * 8192, R, C); const int Rb = (R & ~31) + perm32(R & 31); return (unsigned)(Rb * K + C) * 2u; }
template <class Epi, class Sched, bool GATHER, bool F8>
__device__ __forceinline__ void gemm_phase_fast(int tid, LAS unsigned char* lds, const Gemm g, const Sched& S, const Epi& E) {
    const int wid = __builtin_amdgcn_readfirstlane(tid >> 6), lane = tid & 63, wr = wid >> 2, wc = wid & 3, fr = lane & 15, fq = lane >> 4;
    const int K = g.K, nt = K / BK;
    int Rr[2], Cc[2]; unsigned voffB[2];
#pragma unroll
    for (int i = 0; i < 2; ++i) { stage_rc(tid * 16 + i * 8192, Rr[i], Cc[i]); const int Rb = (Rr[i] & ~31) + perm32(Rr[i] & 31); voffB[i] = (unsigned)(Rb * K + Cc[i]) * 2u; }
#define GP_VB(i) (F8 ? gp_voffb(tid, (i), K) : voffB[i])
    const size_t kstep = (size_t)(BK * 2), hstep = (size_t)HALF * K * 2, tstep = 2 * hstep, r64 = (size_t)64 * K * 2;
    const unsigned ldsw = (unsigned)wid * 1024u;
    const int aoff = lds_byte(wr * 64 + fr, fq * 8), boff = lds_byte(wc * 32 + fr, fq * 8);
#define GP_UNI(p) ((const char*)(((unsigned long long)(unsigned)__builtin_amdgcn_readfirstlane((int)((unsigned long long)(p) >> 32)) << 32) | (unsigned)__builtin_amdgcn_readfirstlane((int)(unsigned long long)(p))))
#define GP_SA(b, h) (((b) * 2 + (h)) * HTB)
#define GP_SB(b, h) ((4 + (b) * 2 + (h)) * HTB)
#define GP_DMA(sbase, voff, ldsdst) do { unsigned keep_; asm volatile("s_mov_b32 %0, m0\n\ts_mov_b32 m0, %3\n\ts_nop 0\n\tglobal_load_lds_dwordx4 %1, %2\n\ts_mov_b32 m0, %0" \
        : "=&s"(keep_) : "v"(voff), "s"(sbase), "s"((unsigned)__builtin_amdgcn_readfirstlane((int)(unsigned)(uintptr_t)(ldsdst))) : "memory"); } while (0)
#define GP_STAGE2(bufoff, gbase, v0, v1) do { const char* gb_ = (gbase); GP_DMA(gb_, (v0), lds + (bufoff) + ldsw); GP_DMA(gb_, (v1), lds + (bufoff) + ldsw + 8192); } while (0)
#define GP_STAGEB(bufoff, gbase) do { if constexpr (F8) { const unsigned vb_ = GP_VB(0); const char* gb_ = (gbase); GP_DMA(gb_, vb_, lds + (bufoff) + ldsw); GP_DMA(gb_ + r64, vb_, lds + (bufoff) + ldsw + 8192); } else { GP_STAGE2(bufoff, gbase, GP_VB(0), GP_VB(1)); } } while (0)
#define GP_STAGEB2(bufoff0, bufoff1, gbase) do { if constexpr (F8 && !GATHER) { const unsigned vb_ = GP_VB(0); const char* gb_ = (gbase); GP_DMA(gb_, vb_, lds + (bufoff0) + ldsw); GP_DMA(gb_ + r64, vb_, lds + (bufoff0) + ldsw + 8192); \
        GP_DMA(gb_ + hstep, vb_, lds + (bufoff1) + ldsw); GP_DMA(gb_ + hstep + r64, vb_, lds + (bufoff1) + ldsw + 8192); } else { GP_STAGEB(bufoff0, gbase); GP_STAGEB(bufoff1, (gbase) + hstep); } } while (0)
#define GP_CAT8(x0, x1) __builtin_bit_cast(v8i_t, __builtin_shufflevector(x0, x1, 0, 1, 2, 3, 4, 5, 6, 7, 8, 9, 10, 11, 12, 13, 14, 15))
#define GP_LDA(dst, b, h) do { _Pragma("unroll") for (int m = 0; m < 4; ++m) _Pragma("unroll") for (int k = 0; k < 2; ++k) dst[m][k] = *(const LAS bf16x8*)(lds + GP_SA(b, h) + aoff + m * 2048 + k * 1024); \
        if constexpr (F8) { _Pragma("unroll") for (int m = 0; m < 4; ++m) dst##8[m] = GP_CAT8(dst[m][0], dst[m][1]); } } while (0)
#define GP_LDB(dst, b, h) do { _Pragma("unroll") for (int n = 0; n < 2; ++n) _Pragma("unroll") for (int k = 0; k < 2; ++k) dst[n][k] = *(const LAS bf16x8*)(lds + GP_SB(b, h) + boff + n * 2048 + k * 1024); \
        if constexpr (F8) { _Pragma("unroll") for (int n = 0; n < 2; ++n) dst##8[n] = GP_CAT8(dst[n][0], dst[n][1]); } } while (0)
#define GP_MMA(ai, bj, At, Bt) do { __builtin_amdgcn_s_setprio(1); \
        if constexpr (F8) { _Pragma("unroll") for (int m = 0; m < 4; ++m) _Pragma("unroll") for (int n = 0; n < 2; ++n) \
            acc[ai][bj][m][n] = __builtin_amdgcn_mfma_scale_f32_16x16x128_f8f6f4(Bt##8[n], At##8[m], acc[ai][bj][m][n], 0, 0, 0, 0, 0, 0); }     \
        else { _Pragma("unroll") for (int m = 0; m < 4; ++m) _Pragma("unroll") for (int n = 0; n < 2; ++n) _Pragma("unroll") for (int k = 0; k < 2; ++k) \
            acc[ai][bj][m][n] = __builtin_amdgcn_mfma_f32_16x16x32_bf16(Bt[n][k], At[m][k], acc[ai][bj][m][n], 0, 0, 0); } \
        __builtin_amdgcn_s_setprio(0); } while (0)
#define GP_WAIT_V(n) asm volatile("s_waitcnt vmcnt(" #n ")" ::: "memory")
#define GP_WAIT_L(n) asm volatile("s_waitcnt lgkmcnt(" #n ")" ::: "memory")
#define GP_BAR __builtin_amdgcn_s_barrier()
#define GP_SCHED __builtin_amdgcn_sched_barrier(0)
    Unit cur, nxt; int ui = 0;
    if (!S.next(0, cur)) return;
    f32x4 acc[2][2][4][2];
#pragma unroll
    for (int a = 0; a < 2; ++a)
#pragma unroll
        for (int b = 0; b < 2; ++b)
#pragma unroll
            for (int m = 0; m < 4; ++m)
#pragma unroll
                for (int n = 0; n < 2; ++n) acc[a][b][m][n] = (f32x4){0.f, 0.f, 0.f, 0.f};
    bf16x8 At[4][2], B0[2][2], B1[2][2];
    v8i_t At8[4], B08[2], B18[2];
    unsigned vC0, vC1, vC2, vC3, vN0, vN1, vN2, vN3;
#define GP_VOFF(u, o0, o1, o2, o3) do { if (GATHER) { \
        int tl_ = tid; LAUNDER_V(tl_); int R0_, C0_, R1_, C1_; stage_rc(tl_ * 16, R0_, C0_); stage_rc(tl_ * 16 + 8192, R1_, C1_);     \
        const unsigned* lp = g.list + (size_t)(u).be * T + (u).rl * 256; \
        const int nvm = (u).nv - 1; const int p0 = min(R0_, nvm), p1 = min(R1_, nvm), p2 = min(128 + R0_, nvm), p3 = min(128 + R1_, nvm); \
        const unsigned t0 = lp[p0] >> 1, t1 = lp[p1] >> 1, t2 = lp[p2] >> 1, t3 = lp[p3] >> 1; \
        o0 = (t0 * K + C0_) * 2u; o1 = (t1 * K + C1_) * 2u; o2 = (t2 * K + C0_) * 2u; o3 = (t3 * K + C1_) * 2u; \
      } else { o0 = (unsigned)(Rr[0] * K + Cc[0]) * 2u; o1 = (unsigned)(Rr[1] * K + Cc[1]) * 2u; o2 = o0 + (unsigned)hstep; o3 = o1 + (unsigned)hstep; } } while (0)
    GP_VOFF(cur, vC0, vC1, vC2, vC3);
    const char* cA = GP_UNI((const char*)g.A + ((size_t)cur.be * g.astride) * 2 + (GATHER ? (size_t)0 : (size_t)cur.pm * tstep));
    const char* cB = GP_UNI((const char*)g.Bt + ((size_t)cur.be * g.bstride) * 2 + (size_t)cur.pn * tstep);
    GP_STAGEB(GP_SB(0, 0), cB); GP_STAGEB(GP_SB(0, 1), cB + hstep); GP_STAGE2(GP_SA(0, 0), cA, vC0, vC1); GP_STAGE2(GP_SA(0, 1), cA, vC2, vC3);
    if (wr == 1) GP_BAR;
    GP_WAIT_V(2); GP_BAR;
    GP_STAGEB(GP_SB(1, 0), cB + kstep); GP_STAGE2(GP_SA(1, 0), cA + kstep, vC0, vC1); GP_STAGEB(GP_SB(1, 1), cB + hstep + kstep);
    GP_WAIT_V(6); GP_BAR;
    for (;;) {
        const bool has_next = S.next(ui + 1, nxt);
        const char* nA = GP_UNI(has_next ? (const char*)g.A + ((size_t)nxt.be * g.astride) * 2 + (GATHER ? (size_t)0 : (size_t)nxt.pm * tstep) : cA);
        const char* nB = GP_UNI(has_next ? (const char*)g.Bt + ((size_t)nxt.be * g.bstride) * 2 + (size_t)nxt.pn * tstep : cB);
        if (GATHER) {
            if (has_next) { GP_VOFF(nxt, vN0, vN1, vN2, vN3); } else { vN0 = vC0; vN1 = vC1; vN2 = vC2; vN3 = vC3; }
            *(LAS u32x4*)(lds + MISC_OFF + 2048 + tid * 16) = (u32x4){vN0, vN1, vN2, vN3};
        } else { vN0 = vC0; vN1 = vC1; vN2 = vC2; vN3 = vC3; }
#pragma nounroll
        for (int t = 0; t < nt; t += 2) {
            LAUNDER_S(cA); LAUNDER_S(cB); LAUNDER_S(nA); LAUNDER_S(nB);
            const bool last = (t == nt - 2);
            if (GATHER) { if (last) { const u32x4 q_ = *(const LAS u32x4*)(lds + MISC_OFF + 2048 + tid * 16); vN0 = q_.x; vN1 = q_.y; vN2 = q_.z; vN3 = q_.w; } }
            const char* a1 = cA + (size_t)(t + 1) * kstep;
            const char* a2 = last ? nA : cA + (size_t)(t + 2) * kstep; const char* b2 = last ? nB : cB + (size_t)(t + 2) * kstep;
            const char* a3 = a2 + kstep; const char* b3 = b2 + kstep;
            const unsigned w0 = last ? vN0 : vC0, w1 = last ? vN1 : vC1, w2 = last ? vN2 : vC2, w3 = last ? vN3 : vC3;
            GP_LDB(B0, 0, 0); GP_LDB(B1, 0, 1); GP_SCHED; GP_LDA(At, 0, 0); GP_STAGE2(GP_SA(1, 1), a1, vC2, vC3);
            GP_WAIT_V(8); GP_WAIT_L(0); GP_BAR; GP_MMA(0, 0, At, B0); GP_MMA(0, 1, At, B1); GP_BAR; GP_SCHED;
            GP_LDA(At, 0, 1); GP_STAGEB2(GP_SB(0, 0), GP_SB(0, 1), b2); GP_STAGE2(GP_SA(0, 0), a2, w0, w1);
            GP_WAIT_V(8); GP_WAIT_L(0); GP_BAR; GP_MMA(1, 0, At, B0); GP_MMA(1, 1, At, B1); GP_BAR; GP_SCHED;
            GP_LDB(B0, 1, 0); GP_LDB(B1, 1, 1); GP_SCHED; GP_LDA(At, 1, 0); GP_STAGE2(GP_SA(0, 1), a2, w2, w3);
            GP_WAIT_V(8); GP_WAIT_L(0); GP_BAR; GP_MMA(0, 0, At, B0); GP_MMA(0, 1, At, B1); GP_BAR; GP_SCHED;
            GP_LDA(At, 1, 1); GP_STAGEB2(GP_SB(1, 0), GP_SB(1, 1), b3); GP_STAGE2(GP_SA(1, 0), a3, w0, w1);
            GP_WAIT_V(8); GP_WAIT_L(0); GP_BAR; GP_MMA(1, 0, At, B0); GP_MMA(1, 1, At, B1); GP_BAR; GP_SCHED;
        }
        if (wr == 0) GP_BAR;
        { int tl_ = tid; LAUNDER_V(tl_); const int fr_ = tl_ & 15, fq_ = (tl_ & 63) >> 4;
          E(acc, cur, wr, wc, fr_, fq_); }
        if (!has_next) break;
        if (!(EpiTraits<Epi>::KEEP && cur.be == 0)) {
#pragma unroll
        for (int a = 0; a < 2; ++a)
#pragma unroll
            for (int b = 0; b < 2; ++b)
#pragma unroll
                for (int m = 0; m < 4; ++m)
#pragma unroll
                    for (int n = 0; n < 2; ++n) acc[a][b][m][n] = (f32x4){0.f, 0.f, 0.f, 0.f};
        }
        cur = nxt; cA = nA; cB = nB; vC0 = vN0; vC1 = vN1; vC2 = vN2; vC3 = vN3; ++ui;
        if (wr == 1) GP_BAR;
    }
    GP_WAIT_V(0);
    GP_BAR;
#undef GP_UNI
#undef GP_SA
#undef GP_SB
#undef GP_STAGE2
#undef GP_DMA
#undef GP_STAGEB
#undef GP_STAGEB2
#undef GP_VB
#undef GP_LDA
#undef GP_LDB
#undef GP_MMA
#undef GP_CAT8
#undef GP_WAIT_V
#undef GP_WAIT_L
#undef GP_BAR
#undef GP_SCHED
#undef GP_VOFF
}
#endif

template <class Epi, class Sched, bool GATHER = false, bool F8 = false>
__device__ __forceinline__ void gemm_phase(int tid, LAS unsigned char* lds, const Gemm g, const Sched& S, const Epi& E) {
#if FAST_GEMM
    gemm_phase_fast<Epi, Sched, GATHER, F8>(tid, lds, g, S, E);
#else
    (void)lds; gemm_phase_ref<Epi, Sched, GATHER>(tid, g, S, E);
#endif
}

#define EPI_ROW(ai, m) (u.pm * 256 + (ai) * 128 + wr * 64 + (m) * 16 + fr)
#define EPI_COL(bj) (u.pn * 256 + (bj) * 128 + wc * 32 + fq * 8)
__device__ __forceinline__ float dot4(f32x4 a) { return (a[0] * a[0] + a[1] * a[1]) + (a[2] * a[2] + a[3] * a[3]); }

struct EpiNull {
    __device__ __forceinline__ void operator()(const ACC_T, const Unit& u, int wr, int wc, int fr, int fq) const {
#pragma unroll
        for (int ai = 0; ai < 2; ++ai)
#pragma unroll
            for (int bj = 0; bj < 2; ++bj)
#pragma unroll
                for (int m = 0; m < 4; ++m) asm volatile("" :: "v"(acc[ai][bj][m][0]), "v"(acc[ai][bj][m][1]));
    }
};
struct EpiIn {
    bf16_t *QA, *KA, *VA, *QLAT, *KVLAT, *KB, *SA, *SB; float *SSQ, *SSKV; const float *gq, *gk, *cosA, *sinA, *cosB, *sinB;
    __device__ __forceinline__ void operator()(const ACC_T, const Unit& u, int wr, int wc, int fr, int fq) const {
        const int wb = u.pn * 4 + wc;
        if (wb < 10) {
            const bool isq = wb < 8; const int head = isq ? wb : wb - 8; const float* g = isq ? gq : gk; bf16_t* dst = isq ? QA : KA; const int dp = isq ? 512 : 128; const float qs = isq ? QSCALE_A * (ATT_FP8_A ? PFOLD : 1.f) : 1.f;
            const f32x4 g00 = *(const f32x4*)(g + 8 * fq), g01 = *(const f32x4*)(g + 8 * fq + 4), g10 = *(const f32x4*)(g + 32 + 8 * fq), g11 = *(const f32x4*)(g + 36 + 8 * fq);
#pragma unroll
            for (int ai = 0; ai < 2; ++ai)
#pragma unroll
                for (int m = 0; m < 4; ++m) {
                    const int r = EPI_ROW(ai, m), pos = r & (S - 1);
                    const f32x4 v00 = acc[ai][0][m][0], v01 = acc[ai][0][m][1], v10 = acc[ai][1][m][0], v11 = acc[ai][1][m][1];
                    float ss = (dot4(v00) + dot4(v01)) + (dot4(v10) + dot4(v11)); ss = sum_xor16(ss); ss = sum_xor32(ss);
                    const float rstd = rsqrtf(ss * (1.f / 64.f) + EPS);
                    const f32x4 y00 = v00 * rstd * g00, y01 = v01 * rstd * g01, y10 = v10 * rstd * g10, y11 = v11 * rstd * g11;
                    const f32x4 c0 = *(const f32x4*)(cosA + pos * 32 + 8 * fq), c1 = *(const f32x4*)(cosA + pos * 32 + 8 * fq + 4), s0 = *(const f32x4*)(sinA + pos * 32 + 8 * fq), s1 = *(const f32x4*)(sinA + pos * 32 + 8 * fq + 4);
                    const f32x4 o00 = (y00 * c0 - y10 * s0) * qs, o01 = (y01 * c1 - y11 * s1) * qs, o10 = (y10 * c0 + y00 * s0) * qs, o11 = (y11 * c1 + y01 * s1) * qs;
#if ATT_FP8_A
                    unsigned char* p8 = (unsigned char*)dst + (size_t)r * dp + head * 64 + 8 * fq;
                    st16(p8 + (fq & 1) * 32 - (fq & 1) * 8, pair16(pack8_fp8(o00, o01), pack8_fp8(o10, o11)));
#else
                    bf16_t* p = dst + (size_t)r * dp + head * 64 + 8 * fq;
                    st16(p, pack8(o00, o01)); st16((p + 32), pack8(o10, o11));
#endif
                }
        } else if (wb < 12) {
#pragma unroll
            for (int ai = 0; ai < 2; ++ai)
#pragma unroll
                for (int m = 0; m < 4; ++m) {
#if ATT_FP8_A
                    const int r = EPI_ROW(ai, m), sq = r & (S - 1), k = sq & 63, pos = 32 * ((k >> 2) & 1) + 16 * (k >> 5) + (k & 3) + 4 * ((k & 31) >> 3);
                    unsigned char* vtb = (unsigned char*)VA; const unsigned vo = (unsigned)(((r >> 12) * 2 + (wb - 10)) * 64 + 8 * fq) * S + (unsigned)((sq & ~63) + pos);
#pragma unroll
                    for (int bj = 0; bj < 2; ++bj)
#pragma unroll
                        for (int n = 0; n < 2; ++n) { const f32x4 x = acc[ai][bj][m][n]; const unsigned w = (unsigned)__builtin_amdgcn_cvt_pk_fp8_f32(x[2], x[3], __builtin_amdgcn_cvt_pk_fp8_f32(x[0], x[1], 0, false), true);
                            const unsigned qo = vo + (unsigned)(bj * 32 + 4 * n) * S;
                            vtb[qo] = (unsigned char)(w & 0xffu); vtb[qo + S] = (unsigned char)((w >> 8) & 0xffu); vtb[qo + 2 * S] = (unsigned char)((w >> 16) & 0xffu); vtb[qo + 3 * S] = (unsigned char)(w >> 24); }
#else
                    bf16_t* p = VA + (size_t)EPI_ROW(ai, m) * 128 + (wb - 10) * 64 + 8 * fq;
                    st16(p, pack8(acc[ai][0][m][0], acc[ai][0][m][1])); st16((p + 32), pack8(acc[ai][1][m][0], acc[ai][1][m][1]));
#endif
                }
        } else if (wb < 22) {
            const bool isq = wb < 18; const int idx = isq ? wb - 12 : wb - 18; bf16_t* dst = isq ? QLAT : KVLAT; const int dp = isq ? 384 : 256;
#pragma unroll
            for (int ai = 0; ai < 2; ++ai)
#pragma unroll
                for (int m = 0; m < 4; ++m) {
                    const int r = EPI_ROW(ai, m);
                    const f32x4 v00 = acc[ai][0][m][0], v01 = acc[ai][0][m][1], v10 = acc[ai][1][m][0], v11 = acc[ai][1][m][1];
                    float ss = (dot4(v00) + dot4(v01)) + (dot4(v10) + dot4(v11)); ss = sum_xor16(ss); ss = sum_xor32(ss);
                    if (fq == 0) { if (isq) SSQ[(size_t)r * 8 + idx] = ss; else SSKV[(size_t)r * 4 + idx] = ss; }
                    bf16_t* p = dst + (size_t)r * dp + idx * 64 + 8 * fq;
                    st16(p, pack8(v00, v01)); st16((p + 32), pack8(v10, v11));
                }
        } else if (wb == 22) {
            if (fq < 2) {
#pragma unroll
                for (int ai = 0; ai < 2; ++ai)
#pragma unroll
                    for (int m = 0; m < 4; ++m) {
                        const int r = EPI_ROW(ai, m), pos = r & (S - 1);
                        const f32x4 x10 = acc[ai][0][m][0], x11 = acc[ai][0][m][1], x20 = acc[ai][1][m][0], x21 = acc[ai][1][m][1];
                        const f32x4 c0 = *(const f32x4*)(cosB + pos * 16 + 8 * fq), c1 = *(const f32x4*)(cosB + pos * 16 + 8 * fq + 4), s0 = *(const f32x4*)(sinB + pos * 16 + 8 * fq), s1 = *(const f32x4*)(sinB + pos * 16 + 8 * fq + 4);
#if ATT_FP8_B
                        const u32x2 w1 = pack8_fp8(x10 * c0 - x20 * s0, x11 * c1 - x21 * s1), w2 = pack8_fp8(x20 * c0 + x10 * s0, x21 * c1 + x11 * s1);
                        unsigned char* p = (unsigned char*)KB + (size_t)r * 768 + 64 + 8 * fq;
#pragma unroll
                        for (int h = 0; h < 8; ++h) { st8(p + h * 96, w1); st8(p + h * 96 + 16, w2); }
#else
                        const u32x4 w1 = pack8(x10 * c0 - x20 * s0, x11 * c1 - x21 * s1), w2 = pack8(x20 * c0 + x10 * s0, x21 * c1 + x11 * s1);
                        bf16_t* p = KB + (size_t)r * 768 + 64 + 8 * fq;
#pragma unroll
                        for (int h = 0; h < 8; ++h) { st16((p + h * 96), w1); st16((p + h * 96 + 16), w2); }
#endif
                    }
            }
        } else if (wb == 23) {
        } else {
            const bool isa = wb < 40; const int idx = isa ? wb - 24 : wb - 40; unsigned char* dst = (unsigned char*)(isa ? SA : SB);
#pragma unroll
            for (int ai = 0; ai < 2; ++ai)
#pragma unroll
                for (int m = 0; m < 4; ++m) { unsigned char* p = dst + (size_t)EPI_ROW(ai, m) * 1024 + idx * 64 + (fq & 1) * 32 + 8 * (fq & ~1);
                    st16(p, pair16(pack8_fp8(acc[ai][0][m][0], acc[ai][0][m][1]), pack8_fp8(acc[ai][1][m][0], acc[ai][1][m][1]))); }
        }
    }
};
__host__ __device__ __forceinline__ int src_col_in(int n) {
    const int pn = n >> 8, nl = n & 255, bj = nl >> 7, wc = (nl & 127) >> 5, p = nl & 31, wb = pn * 4 + wc, s = bj * 32 + p;
    if (wb < 8) return wb * 64 + s;
    if (wb < 10) return 512 + (wb - 8) * 64 + s;
    if (wb < 12) return 640 + (wb - 10) * 64 + s;
    if (wb < 18) return 768 + (wb - 12) * 64 + s;
    if (wb < 22) return 1152 + (wb - 18) * 64 + s;
    if (wb == 22) return p < 16 ? 1408 + bj * 16 + p : -1;
    if (wb == 23) return -1;
    if (wb < 40) return 1440 + (wb - 24) * 64 + s;
    return 2464 + (wb - 40) * 64 + s;
}
struct EpiQb {
    bf16_t* QB; const float *SSQ, *cosB, *sinB;
    __device__ __forceinline__ void operator()(const ACC_T, const Unit& u, int wr, int wc, int fr, int fq) const {
#pragma unroll
        for (int ai = 0; ai < 2; ++ai)
#pragma unroll
            for (int m = 0; m < 4; ++m) {
                const int r = EPI_ROW(ai, m), pos = r & (S - 1);
                const f32x4 sa = *(const f32x4*)(SSQ + (size_t)r * 8); const f32x2 sb = *(const f32x2*)(SSQ + (size_t)r * 8 + 4);
                const float rstd = rsqrtf((((sa[0] + sa[1]) + (sa[2] + sa[3])) + (sb[0] + sb[1])) * (1.f / 384.f) + EPS);
                u32x2 wq[2];
#pragma unroll
                for (int bj = 0; bj < 2; ++bj) {
                    f32x4 v0 = acc[ai][bj][m][0] * rstd, v1 = acc[ai][bj][m][1] * rstd;
                    const int c32 = u.pn * 8 + bj * 4 + wc;
                    if (c32 % 3 == 2) {
                        f32x4 o0, o1;
#pragma unroll
                        for (int j = 0; j < 4; ++j) { const auto ra = __builtin_amdgcn_permlane32_swap(__float_as_uint(v0[j]), __float_as_uint(v0[j]), false, false), rb = __builtin_amdgcn_permlane32_swap(__float_as_uint(v1[j]), __float_as_uint(v1[j]), false, false);
                            o0[j] = __uint_as_float(fq < 2 ? ra[1] : ra[0]); o1[j] = __uint_as_float(fq < 2 ? rb[1] : rb[0]); }
                        const int i0 = 8 * (fq & 1);
                        const f32x4 c0 = *(const f32x4*)(cosB + pos * 16 + i0), c1 = *(const f32x4*)(cosB + pos * 16 + i0 + 4), s0 = *(const f32x4*)(sinB + pos * 16 + i0), s1 = *(const f32x4*)(sinB + pos * 16 + i0 + 4);
                        if (fq < 2) { v0 = v0 * c0 - o0 * s0; v1 = v1 * c1 - o1 * s1; } else { v0 = v0 * c0 + o0 * s0; v1 = v1 * c1 + o1 * s1; }
                    }
#if ATT_FP8_B
                    wq[bj] = pack8_fp8(v0 * (QSCALE_B * PFOLD), v1 * (QSCALE_B * PFOLD));
#else
                    st16((QB + (size_t)r * 768 + EPI_COL(bj)), pack8(v0 * QSCALE_B, v1 * QSCALE_B));
#endif
                }
#if ATT_FP8_B
                st16((unsigned char*)QB + (size_t)r * 768 + u.pn * 256 + (fq & 1) * 128 + wc * 32 + 8 * (fq & ~1), pair16(wq[0], wq[1]));
#endif
            }
    }
};
struct EpiKvb {
    bf16_t *KB, *VB; const float* SSKV;
    __device__ __forceinline__ void operator()(const ACC_T, const Unit& u, int wr, int wc, int fr, int fq) const {
#pragma unroll
        for (int ai = 0; ai < 2; ++ai) {
            f32x4 sq[4];
#pragma unroll
            for (int m = 0; m < 4; ++m) sq[m] = *(const f32x4*)(SSKV + (size_t)EPI_ROW(ai, m) * 4);
            asm volatile("" : "+v"(sq[0]), "+v"(sq[1]), "+v"(sq[2]), "+v"(sq[3]));
#pragma unroll
            for (int m = 0; m < 4; ++m) {
                const int r = EPI_ROW(ai, m);
                const f32x4 sa = sq[m];
                const float rstd = rsqrtf(((sa[0] + sa[1]) + (sa[2] + sa[3])) * (1.f / 256.f) + EPS);
                u32x2 wk[2] = {};
#pragma unroll
                for (int bj = 0; bj < 2; ++bj) {
                    const int head = u.pn * 2 + bj, o = wc * 32 + fq * 8;
#if ATT_FP8_B
                    const f32x4 x0 = acc[ai][bj][m][0] * rstd, x1 = acc[ai][bj][m][1] * rstd;
                    if (wc < 2) wk[bj] = pack8_fp8(x0, x1);
                    else {
                        const int sq = r & (S - 1), k = sq & 63, pos = 32 * ((k >> 2) & 1) + 16 * (k >> 5) + (k & 3) + 4 * ((k & 31) >> 3);
                        unsigned char* vtb = (unsigned char*)VB; const unsigned vo = (unsigned)(((r >> 12) * 8 + head) * 64 + (o - 64)) * S + (unsigned)((sq & ~63) + pos);
                        const u32x2 w = pack8_fp8(x0, x1);
                        vtb[vo] = (unsigned char)(w.x & 0xffu); vtb[vo + S] = (unsigned char)((w.x >> 8) & 0xffu); vtb[vo + 2 * S] = (unsigned char)((w.x >> 16) & 0xffu); vtb[vo + 3 * S] = (unsigned char)(w.x >> 24);
                        vtb[vo + 4 * S] = (unsigned char)(w.y & 0xffu); vtb[vo + 5 * S] = (unsigned char)((w.y >> 8) & 0xffu); vtb[vo + 6 * S] = (unsigned char)((w.y >> 16) & 0xffu); vtb[vo + 7 * S] = (unsigned char)(w.y >> 24);
                    }
#else
                    const u32x4 w = pack8(acc[ai][bj][m][0] * rstd, acc[ai][bj][m][1] * rstd);
                    if (wc < 2) st16((KB + (size_t)r * 768 + head * 96 + o), w); else st16((VB + (size_t)r * 512 + head * 64 + (o - 64)), w);
#endif
                }
#if ATT_FP8_B
                if (wc < 2) st16((unsigned char*)KB + (size_t)r * 768 + (u.pn * 2 + (fq & 1)) * 96 + wc * 32 + 8 * (fq & ~1), pair16(wk[0], wk[1]));
#endif
            } }
    }
};
template <int MODE> struct EpiProj {
    bf16_t* O; const bf16_t* gate;
    __device__ __forceinline__ void operator()(const ACC_T, const Unit& u, int wr, int wc, int fr, int fq) const {
#pragma unroll
        for (int ai = 0; ai < 2; ++ai)
#pragma unroll
            for (int m = 0; m < 4; ++m) {
                const int r = EPI_ROW(ai, m);
#pragma unroll
                for (int bj = 0; bj < 2; ++bj) {
                    const size_t off = (size_t)r * D + EPI_COL(bj);
                    const u32x2 gw = *(const u32x2*)((const unsigned char*)gate + off);
                    const f32x2 q0 = __builtin_amdgcn_cvt_pk_f32_fp8((int)gw.x, false), q1 = __builtin_amdgcn_cvt_pk_f32_fp8((int)gw.x, true), q2 = __builtin_amdgcn_cvt_pk_f32_fp8((int)gw.y, false), q3 = __builtin_amdgcn_cvt_pk_f32_fp8((int)gw.y, true);
                    const f32x4 g0 = {sigm(q0[0]), sigm(q0[1]), sigm(q1[0]), sigm(q1[1])}, g1 = {sigm(q2[0]), sigm(q2[1]), sigm(q3[0]), sigm(q3[1])};
                    f32x4 v0 = acc[ai][bj][m][0] * g0, v1 = acc[ai][bj][m][1] * g1;
                    if (MODE == 1) { f32x4 p0, p1; unpack8(*(const u32x4*)(O + off), p0, p1); v0 += p0; v1 += p1; }
                    if (MODE == 1) st16(O + off, pack8(v0, v1)); else *(u32x4*)(O + off) = pack8(v0, v1);
                }
            }
    }
};
struct EpiProjP {
    bf16_t* O; const unsigned char* SA; const unsigned char* SB;
    __device__ static __forceinline__ void gates(const unsigned char* G, size_t off, f32x4& g0, f32x4& g1) {
        const u32x2 gw = *(const u32x2*)(G + off);
        const f32x2 q0 = __builtin_amdgcn_cvt_pk_f32_fp8((int)gw.x, false), q1 = __builtin_amdgcn_cvt_pk_f32_fp8((int)gw.x, true), q2 = __builtin_amdgcn_cvt_pk_f32_fp8((int)gw.y, false), q3 = __builtin_amdgcn_cvt_pk_f32_fp8((int)gw.y, true);
        g0 = (f32x4){sigm(q0[0]), sigm(q0[1]), sigm(q1[0]), sigm(q1[1])}; g1 = (f32x4){sigm(q2[0]), sigm(q2[1]), sigm(q3[0]), sigm(q3[1])};
    }
    __device__ __forceinline__ void operator()(f32x4 (&acc)[2][2][4][2], const Unit& u, int wr, int wc, int fr, int fq) const {
#pragma unroll
        for (int ai = 0; ai < 2; ++ai)
#pragma unroll
            for (int m = 0; m < 4; ++m) {
                const int r = EPI_ROW(ai, m); u32x2 wm[2] = {};
#pragma unroll
                for (int bj = 0; bj < 2; ++bj) {
                    const size_t off = (size_t)r * D + EPI_COL(bj);
                    f32x4 b0, b1; gates(SB, off, b0, b1);
#pragma unroll
                    for (int j = 0; j < 4; ++j) { b0[j] = fmaxf(b0[j], 9.094947e-13f); b1[j] = fmaxf(b1[j], 9.094947e-13f); }
                    if (u.be == 0) {
                        f32x4 a0, a1; gates(SA, off, a0, a1);
#pragma unroll
                        for (int j = 0; j < 4; ++j) { acc[ai][bj][m][0][j] *= a0[j] * __builtin_amdgcn_rcpf(b0[j]); acc[ai][bj][m][1][j] *= a1[j] * __builtin_amdgcn_rcpf(b1[j]); }
                    } else {
#if PROJ_FP8
                        wm[bj] = pack8_fp8(acc[ai][bj][m][0] * (b0 * (1.f / WSCALE)), acc[ai][bj][m][1] * (b1 * (1.f / WSCALE)));
#else
                        st16(O + off, pack8(acc[ai][bj][m][0] * b0, acc[ai][bj][m][1] * b1));
#endif
                    }
                }
#if PROJ_FP8
                if (u.be != 0) st16((unsigned char*)O + (size_t)r * D + u.pn * 256 + (fq & 1) * 128 + wc * 32 + 8 * (fq & ~1), pair16(wm[0], wm[1]));
#endif
            }
    }
};
template <> struct EpiTraits<EpiProjP> { static constexpr bool KEEP = true; };
struct EpiWo {
    const bf16_t* X; const float* modl; bf16_t* XO;
    __device__ __forceinline__ void operator()(const ACC_T, const Unit& u, int wr, int wc, int fr, int fq) const {
        const float* g1 = modl + (size_t)(u.pm >> 4) * 6 * D + 2 * D;
#pragma unroll
        for (int bj = 0; bj < 2; ++bj) {
            const int c = EPI_COL(bj); const float us = PROJ_FP8 ? 1.f / (OSCALE * WSCALE) : 1.f; const f32x4 ga = *(const f32x4*)(g1 + c) * us, gb = *(const f32x4*)(g1 + c + 4) * us;
#pragma unroll
            for (int ai = 0; ai < 2; ++ai) {
                u32x4 xr[4];
#pragma unroll
                for (int m = 0; m < 4; ++m) xr[m] = *(const u32x4*)(X + (size_t)EPI_ROW(ai, m) * D + c);
                asm volatile("" : "+v"(xr[0]), "+v"(xr[1]), "+v"(xr[2]), "+v"(xr[3]));
#pragma unroll
                for (int m = 0; m < 4; ++m) { const size_t off = (size_t)EPI_ROW(ai, m) * D + c;
                    f32x4 x0, x1; unpack8(xr[m], x0, x1);
                    st16((XO + off), pack8(x0 + ga * acc[ai][bj][m][0], x1 + gb * acc[ai][bj][m][1])); }
            }
        }
    }
};
struct EpiUp {
    bf16_t* ACT; float inscale;
    __device__ __forceinline__ void operator()(const ACC_T, const Unit& u, int wr, int wc, int fr, int fq) const {
#pragma unroll
        for (int ai = 0; ai < 2; ++ai)
#pragma unroll
            for (int m = 0; m < 4; ++m) {
                f32x4 a = acc[ai][0][m][0] * inscale, b = acc[ai][0][m][1] * inscale; const f32x4 c = acc[ai][1][m][0] * inscale, d = acc[ai][1][m][1] * inscale;
#pragma unroll
                for (int j = 0; j < 4; ++j) { a[j] = a[j] * sigm(a[j]) * c[j]; b[j] = b[j] * sigm(b[j]) * d[j]; }
#if MOE_FP8
                st8((unsigned char*)ACT + (size_t)EPI_ROW(ai, m) * FF + u.pn * 128 + wc * 32 + fq * 8, pack8_fp8(a * 8.f, b * 8.f));
#else
                st16((ACT + (size_t)EPI_ROW(ai, m) * FF + u.pn * 128 + wc * 32 + fq * 8), pack8(a, b));
#endif
            }
    }
};
struct EpiDown {
    bf16_t* Y2; const unsigned* list; const float* gw; float inscale;
    __device__ __forceinline__ void operator()(const ACC_T, const Unit& u, int wr, int wc, int fr, int fq) const {
#pragma unroll
        for (int ai = 0; ai < 2; ++ai)
#pragma unroll
            for (int m = 0; m < 4; ++m) {
                const int rloc = ai * 128 + wr * 64 + m * 16 + fr;
                if (rloc < u.nv) {
                    const unsigned entry = list[(size_t)u.be * T + u.rl * 256 + rloc]; const float w = gw[entry] * inscale;
                    const u32x2 q0 = pack8_fp8(acc[ai][0][m][0] * (w * 16.f), acc[ai][0][m][1] * (w * 16.f)), q1 = pack8_fp8(acc[ai][1][m][0] * (w * 16.f), acc[ai][1][m][1] * (w * 16.f));
                    st16((unsigned char*)Y2 + (size_t)entry * D + u.pn * 256 + (fq & 1) * 128 + wc * 32 + 8 * (fq & ~1), pair16(q0, q1));
                }
            }
    }
};
}

namespace at {
struct Tensors { const bf16_t* Q; int qp; const bf16_t* K; int kp; const bf16_t* V; int vp; bf16_t* O; int op; int group; };
__device__ __forceinline__ bool next_unit(int i, int vcu, int G, int& bh, int& qb) {
    int u;
    if (G == 256) { if (i >= 4) return false; u = (vcu >> 5) * 128 + i * 32 + (vcu & 31); }
    else { u = i * G + vcu; if (u >= 1024) return false; }
    bh = u >> 4; qb = u & 15; return true;
}
template <int DQK>
__device__ __forceinline__ void attn_phase_ref(int tid, const Tensors& A, int vcu, int G) {
    int bh, qb;
    for (int i = 0; next_unit(i, vcu, G, bh, qb); ++i) {
        const int b = bh >> 3, h = bh & 7, kvh = h / A.group;
        {
            const int dh = tid >> 8;
            const size_t row = (size_t)b * S + qb * 256 + (tid & 255);
            float q[DQK], o[32];
#pragma unroll
            for (int d = 0; d < DQK; ++d) q[d] = bf2f(A.Q[row * A.qp + h * DQK + d]);
#pragma unroll
            for (int d = 0; d < 32; ++d) o[d] = 0.f;
            float l = 0.f;
            for (int k = 0; k < S; ++k) {
                const bf16_t* kr = A.K + ((size_t)b * S + k) * A.kp + kvh * DQK; const bf16_t* vr = A.V + ((size_t)b * S + k) * A.vp + kvh * 64 + dh * 32;
                float sc = 0.f;
#pragma unroll
                for (int d = 0; d < DQK; d += 8) { f32x4 k0, k1; unpack8(*(const u32x4*)(kr + d), k0, k1);
                    sc += q[d] * k0[0] + q[d + 1] * k0[1] + q[d + 2] * k0[2] + q[d + 3] * k0[3] + q[d + 4] * k1[0] + q[d + 5] * k1[1] + q[d + 6] * k1[2] + q[d + 7] * k1[3]; }
                const float p = bf2f(cvt_pk_bf16(exp2f(sc), 0.f) & 0xffffu); l += p;
#pragma unroll
                for (int d = 0; d < 32; d += 8) { f32x4 v0, v1; unpack8(*(const u32x4*)(vr + d), v0, v1);
                    o[d] += p * v0[0]; o[d + 1] += p * v0[1]; o[d + 2] += p * v0[2]; o[d + 3] += p * v0[3]; o[d + 4] += p * v1[0]; o[d + 5] += p * v1[1]; o[d + 6] += p * v1[2]; o[d + 7] += p * v1[3]; }
            }
            const float il = 1.f / l;
            __syncthreads();
#pragma unroll
            for (int d = 0; d < 32; d += 8) { f32x4 a = {o[d] * il, o[d + 1] * il, o[d + 2] * il, o[d + 3] * il}, c = {o[d + 4] * il, o[d + 5] * il, o[d + 6] * il, o[d + 7] * il};
                *(u32x4*)(A.O + row * A.op + h * 64 + dh * 32 + d) = pack8(a, c); }
        }
    }
}
#if FAST_ATTN
typedef short s16x4 __attribute__((ext_vector_type(4)));
__device__ __forceinline__ unsigned cvtpk(float lo, float hi) { f32x2 v = {lo, hi}; bf16x2_t b = __builtin_convertvector(v, bf16x2_t); return __builtin_bit_cast(unsigned, b); }
__device__ __forceinline__ s16x4 vtr(const LAS unsigned char* p) { return __builtin_bit_cast(s16x4, __builtin_amdgcn_ds_read_tr16_b64_v4i16((LAS s16x4*)p)); }
__device__ __forceinline__ int crow(int r, int hi) { return (r & 3) + 8 * (r >> 2) + 4 * hi; }
#define AT_BAR() asm volatile("s_barrier" ::: "memory")
#define AT_WAITBAR(N) asm volatile("s_waitcnt vmcnt(" #N ") lgkmcnt(0)\n\ts_barrier" ::: "memory")
#define AT_SCHED() __builtin_amdgcn_sched_barrier(0)
__device__ __forceinline__ void glds16(const void* gsrc, unsigned lds_dst) { unsigned keep;
    asm volatile("s_mov_b32 %0, m0\n\ts_mov_b32 m0, %2\n\ts_nop 0\n\tglobal_load_lds_dwordx4 %1, off\n\ts_mov_b32 m0, %0" : "=&s"(keep) : "v"(gsrc), "s"(lds_dst) : "memory"); }
#define AT_GLDS(g, l) glds16((const void*)(g), (unsigned)__builtin_amdgcn_readfirstlane((int)(unsigned)(uintptr_t)(l)))
template <int DQK>
__device__ __forceinline__ void attn_unit(int tid, LAS unsigned char* lds, const Tensors& A, int b, int h, int qb) {
    constexpr int ND = DQK / 16, NCH = DQK / 8, KSLOT = NCH * 1024, NKD = NCH > 8 ? 2 : 1, VSLOT = 8192, NT = S / 64;
    constexpr int KOFF = 0, VOFF = 3 * KSLOT, OST = VOFF + 3 * VSLOT, WSF = OST + 8 * 4096;
    static_assert(WSF + 8 * 256 <= RING_BYTES, "attention LDS");
    const int lane = tid & 63, r32 = lane & 31, hi = lane >> 5, wid = __builtin_amdgcn_readfirstlane(tid >> 6);
    const int kvh = h / A.group; const size_t rowb = (size_t)b * S;
    const bf16_t* ksrc = A.K + (rowb + lane) * A.kp + kvh * DQK + wid * 8;
    const bf16_t* ksrc2 = A.K + (rowb + lane) * A.kp + kvh * DQK + (8 + (wid & 3)) * 8;
    const bf16_t* vsrc = A.V + (rowb + 16 * (wid & 3) + (lane >> 2)) * A.vp + kvh * 64 + (wid >> 2) * 32 + (lane & 3) * 8;
    const size_t ktile = (size_t)64 * A.kp, vtile = (size_t)64 * A.vp;
    LAS unsigned char* kdst = lds + KOFF + wid * 1024; LAS unsigned char* kdst2 = lds + KOFF + (8 + (wid & 3)) * 1024; LAS unsigned char* vdst = lds + VOFF + wid * 1024;
#define DMA_K(j, so) do { AT_GLDS(ksrc + (size_t)(j) * ktile, kdst + (so)); if (NKD == 2) AT_GLDS(ksrc2 + (size_t)(j) * ktile, kdst2 + (so)); } while (0)
#define DMA_V(j, so) AT_GLDS(vsrc + (size_t)(j) * vtile, vdst + (so))
    const LAS unsigned char* kp0 = lds + KOFF + hi * 1024 + r32 * 16;
    const LAS unsigned char* vp0 = lds + VOFF + ((lane >> 4) & 1) * 32 + (lane & 3) * 8 + (4 * hi + ((lane & 15) >> 2)) * 64;
    DMA_K(0, 0); DMA_V(0, 0); DMA_K(1, KSLOT); DMA_V(1, VSLOT); DMA_K(2, 2 * KSLOT);
    const bf16_t* Qw = A.Q + (rowb + qb * 256 + wid * 32 + r32) * A.qp + h * DQK + hi * 8;
    bf16x8 qr[ND];
#pragma unroll
    for (int d0 = 0; d0 < ND; ++d0) qr[d0] = *(const bf16x8*)(Qw + d0 * 16);
    asm volatile("s_waitcnt vmcnt(0)\n\ts_barrier" ::: "memory");
    bf16x8 kf[2 * ND]; s16x4 vlo[8], vhi[8];
#define KLOAD(so) do { _Pragma("unroll") for (int d0 = 0; d0 < ND; ++d0) { kf[2 * d0] = *(const LAS bf16x8*)(kp0 + (so) + d0 * 2048); kf[2 * d0 + 1] = *(const LAS bf16x8*)(kp0 + (so) + d0 * 2048 + 512); } } while (0)
#define VLOAD(so) do { _Pragma("unroll") for (int i = 0; i < 8; ++i) { vlo[i] = vtr(vp0 + (so) + (i >> 2) * 4096 + (i & 3) * 1024); vhi[i] = vtr(vp0 + (so) + (i >> 2) * 4096 + (i & 3) * 1024 + 512); } } while (0)
#define VFR(i) (bf16x8){vlo[i][0], vlo[i][1], vlo[i][2], vlo[i][3], vhi[i][0], vhi[i][1], vhi[i][2], vhi[i][3]}
    KLOAD(0);
    asm volatile("s_waitcnt lgkmcnt(0)" ::: "memory");
    if (PROBE_ATT != 5 && wid >= 4) AT_BAR();
    f32x16 o0 = {}, o1 = {}, C0, C1; u32x4 pw0, pw1, pw2, pw3; float lsum = 0.f;
    const f32x16 zero = {};
#define QK_BLOCK() do { C0 = __builtin_amdgcn_mfma_f32_32x32x16_bf16(kf[0], qr[0], zero, 0, 0, 0); C1 = __builtin_amdgcn_mfma_f32_32x32x16_bf16(kf[1], qr[0], zero, 0, 0, 0); \
        _Pragma("unroll") for (int d0 = 1; d0 < ND; ++d0) { C0 = __builtin_amdgcn_mfma_f32_32x32x16_bf16(kf[2 * d0], qr[d0], C0, 0, 0, 0); C1 = __builtin_amdgcn_mfma_f32_32x32x16_bf16(kf[2 * d0 + 1], qr[d0], C1, 0, 0, 0); } } while (0)
#define PAF(k) __builtin_bit_cast(bf16x8, pw##k)
#define PV_BLOCK() do { \
        o0 = __builtin_amdgcn_mfma_f32_32x32x16_bf16(PAF(0), VFR(0), o0, 0, 0, 0); o1 = __builtin_amdgcn_mfma_f32_32x32x16_bf16(PAF(0), VFR(4), o1, 0, 0, 0); \
        o0 = __builtin_amdgcn_mfma_f32_32x32x16_bf16(PAF(1), VFR(1), o0, 0, 0, 0); o1 = __builtin_amdgcn_mfma_f32_32x32x16_bf16(PAF(1), VFR(5), o1, 0, 0, 0); \
        o0 = __builtin_amdgcn_mfma_f32_32x32x16_bf16(PAF(2), VFR(2), o0, 0, 0, 0); o1 = __builtin_amdgcn_mfma_f32_32x32x16_bf16(PAF(2), VFR(6), o1, 0, 0, 0); \
        o0 = __builtin_amdgcn_mfma_f32_32x32x16_bf16(PAF(3), VFR(3), o0, 0, 0, 0); o1 = __builtin_amdgcn_mfma_f32_32x32x16_bf16(PAF(3), VFR(7), o1, 0, 0, 0); } while (0)
#define SOFTMAX() do { \
        _Pragma("unroll") for (int r = 0; r < 16; ++r) { C0[r] = __builtin_amdgcn_exp2f(C0[r]); C1[r] = __builtin_amdgcn_exp2f(C1[r]); } \
        f32x2 s0_ = {C0[0], C0[1]}, s1_ = {C1[0], C1[1]}; _Pragma("unroll") for (int r = 2; r < 16; r += 2) { s0_ += (f32x2){C0[r], C0[r + 1]}; s1_ += (f32x2){C1[r], C1[r + 1]}; } s0_ += s1_; lsum += s0_[0] + s0_[1]; \
        pw0 = (u32x4){cvtpk(C0[0], C0[1]), cvtpk(C0[2], C0[3]), cvtpk(C0[4], C0[5]), cvtpk(C0[6], C0[7])}; pw1 = (u32x4){cvtpk(C0[8], C0[9]), cvtpk(C0[10], C0[11]), cvtpk(C0[12], C0[13]), cvtpk(C0[14], C0[15])}; \
        pw2 = (u32x4){cvtpk(C1[0], C1[1]), cvtpk(C1[2], C1[3]), cvtpk(C1[4], C1[5]), cvtpk(C1[6], C1[7])}; pw3 = (u32x4){cvtpk(C1[8], C1[9]), cvtpk(C1[10], C1[11]), cvtpk(C1[12], C1[13]), cvtpk(C1[14], C1[15])}; } while (0)
    int ka = 2 * KSLOT, kb = 0, kc = KSLOT, va = 2 * VSLOT, vb = 0, vc = VSLOT;
#define ROT() do { const int t_ = ka; ka = kb; kb = kc; kc = t_; const int u_ = va; va = vb; vb = vc; vc = u_; } while (0)
#define PINP() asm volatile("" : "+v"(lsum) : "v"(pw0), "v"(pw1), "v"(pw2), "v"(pw3))
#if ATT_REGSTAGE
    u32x4 kst = {}, kst2 = {}, vst = {};
    const LAS unsigned char* kw = lds + KOFF + wid * 1024 + lane * 16; const LAS unsigned char* kw2 = lds + KOFF + (8 + (wid & 3)) * 1024 + lane * 16; const LAS unsigned char* vw = lds + VOFF + wid * 1024 + lane * 16;
#define ST_WRITE(WK, WV) do { if (WK) { *(LAS u32x4*)(kw + ka) = kst; if (NKD == 2 && wid < 4) *(LAS u32x4*)(kw2 + ka) = kst2; } if (WV) *(LAS u32x4*)(vw + vc) = vst; } while (0)
#define ST_LOAD(sv, IK, IV) do { if (IK) { kst = *(const u32x4*)(ksrc + (size_t)((sv) + 4) * ktile); if (NKD == 2 && wid < 4) kst2 = *(const u32x4*)(ksrc2 + (size_t)((sv) + 4) * ktile); } if (IV) vst = *(const u32x4*)(vsrc + (size_t)((sv) + 3) * vtile); } while (0)
#define STEP(sv, DOQK, DOPV, KL, VL, IK, IV, WK, WV) do { \
        AT_SCHED(); if (DOQK) QK_BLOCK(); if (DOPV) PV_BLOCK(); AT_SCHED(); \
        asm volatile("s_barrier\n\ts_nop 15\n\ts_nop 3" : "+v"(C0), "+v"(C1), "+v"(o0), "+v"(o1) :: "memory"); AT_SCHED(); \
        if (KL) KLOAD(kc); if (VL) VLOAD(vb); ST_WRITE(WK, WV); ST_LOAD(sv, IK, IV); \
        if (DOQK) { SOFTMAX(); PINP(); } AT_SCHED(); \
        asm volatile("s_waitcnt lgkmcnt(0)\n\ts_barrier" ::: "memory"); \
        AT_SCHED(); ROT(); } while (0)
    STEP(-1, true, false, true, true, true, true, false, false);
#pragma nounroll
    for (int s = 0; s < NT - 4; ++s) STEP(s, true, true, true, true, true, true, true, true);
    STEP(NT - 4, true, true, true, true, false, true, true, true);
    STEP(NT - 3, true, true, true, true, false, false, false, true);
    STEP(NT - 2, true, true, false, true, false, false, false, false);
    STEP(NT - 1, false, true, false, false, false, false, false, false);
#undef ST_WRITE
#undef ST_LOAD
#else
#define STEP(sv, DOQK, DOPV, KL, VL, IK, IV) do { \
        AT_SCHED(); if (DOQK) QK_BLOCK(); if (DOPV) PV_BLOCK(); AT_SCHED(); \
          \
        asm volatile("s_barrier\n\ts_nop 15\n\ts_nop 3" : "+v"(C0), "+v"(C1), "+v"(o0), "+v"(o1) :: "memory"); AT_SCHED(); \
        if (KL) KLOAD(kc); if (VL) VLOAD(vb); if (IK) DMA_K((sv) + 4, kb); if (IV) DMA_V((sv) + 3, va); \
        if (DOQK) { SOFTMAX(); PINP(); } AT_SCHED(); \
        if (IK) { if (NKD == 2) { AT_WAITBAR(3); } else { AT_WAITBAR(2); } } else if (IV) { AT_WAITBAR(1); } else { AT_WAITBAR(0); } \
        AT_SCHED(); ROT(); } while (0)
    STEP(-1, true, false, true, true, true, true);
#pragma nounroll
    for (int s = 0; s < NT - 4; ++s) STEP(s, true, true, true, true, true, true);
    STEP(NT - 4, true, true, true, true, false, true);
    STEP(NT - 3, true, true, true, true, false, false);
    STEP(NT - 2, true, true, false, true, false, false);
    STEP(NT - 1, false, true, false, false, false, false);
#endif
#undef STEP
#undef PINP
    if (PROBE_ATT != 5 && wid < 4) AT_BAR();
    { auto rr = __builtin_amdgcn_permlane32_swap(__float_as_uint(lsum), __float_as_uint(lsum), false, false); lsum = __uint_as_float(rr[0]) + __uint_as_float(rr[1]); }
    LAS float* wsf = (LAS float*)(lds + WSF + wid * 256);
    if (hi == 0) wsf[r32] = lsum;
    asm volatile("s_waitcnt lgkmcnt(0)" ::: "memory");
    LAS bf16_t* stg = (LAS bf16_t*)(lds + OST + wid * 4096);
#pragma unroll
    for (int r = 0; r < 16; ++r) { const int orow = crow(r, hi); const float rl = __builtin_amdgcn_rcpf(wsf[orow]);
        stg[orow * 64 + r32] = (bf16_t)(cvtpk(o0[r] * rl, 0.f) & 0xffffu); stg[orow * 64 + 32 + r32] = (bf16_t)(cvtpk(o1[r] * rl, 0.f) & 0xffffu); }
    asm volatile("s_waitcnt lgkmcnt(0)" ::: "memory");
    bf16_t* Ow = A.O + (rowb + qb * 256 + wid * 32) * A.op + h * 64;
#pragma unroll
    for (int i = 0; i < 4; ++i) { const int row = i * 8 + (lane >> 3), ch = lane & 7; const u32x4 v = *(const LAS u32x4*)(stg + row * 64 + ch * 8); st16((Ow + (size_t)row * A.op + ch * 8), v); }
    asm volatile("s_waitcnt lgkmcnt(0)\n\ts_barrier" ::: "memory");
#undef DMA_K
#undef DMA_V
#undef KLOAD
#undef VLOAD
#undef VFR
#undef QK_BLOCK
#undef PAF
#undef PV_BLOCK
#undef SOFTMAX
#undef ROT
}
#endif
#if FAST_ATTN && ATT_FP8_A
typedef int v8i __attribute__((ext_vector_type(8)));
#define SPLAT16(x) ((f32x16){x, x, x, x, x, x, x, x, x, x, x, x, x, x, x, x})
__device__ __forceinline__ f32x16 mfma8(v8i a, v8i b, f32x16 c) { return __builtin_amdgcn_mfma_scale_f32_32x32x64_f8f6f4(a, b, c, 0, 0, 0, 0, 0, 0); }
__device__ __forceinline__ f32x16 mfma8pv(v8i a, v8i b, f32x16 c) { return __builtin_amdgcn_mfma_scale_f32_32x32x64_f8f6f4(a, b, c, 1, 0, 0, 0, 0, 0); }
__device__ __forceinline__ void attn_unit_f8a(int tid, LAS unsigned char* lds, const unsigned char* Q8, const unsigned char* K8, const unsigned char* VT8, bf16_t* O, int op, int b, int h, int qb, float bias) {
    constexpr int SL = 4096, NT = S / 64;
    constexpr int KOFF = 0, VOFF = 4 * SL, OST = VOFF + 4 * SL, WSF = OST + 8 * 4096;
    const int lane = tid & 63, r32 = lane & 31, hi = lane >> 5, wid = __builtin_amdgcn_readfirstlane(tid >> 6);
    const int kvh = h >> 2; const size_t rowb = (size_t)b * S; const bool kw = wid < 4;
    const unsigned char* src = kw ? K8 + (rowb + lane) * 128 + kvh * 64 + 16 * wid : VT8 + ((size_t)((b * 2 + kvh) * 64 + lane)) * S + 16 * (wid - 4);
    const size_t tstep = kw ? (size_t)64 * 128 : (size_t)64;
    LAS unsigned char* dst = lds + (kw ? KOFF + wid * 1024 : VOFF + (wid - 4) * 1024);
#define DMA8(j, so) AT_GLDS(src + (size_t)(j) * tstep, dst + (so))
    const LAS unsigned char* kp0 = lds + KOFF + (2 * hi) * 1024 + r32 * 16;
    const LAS unsigned char* vp0 = lds + VOFF + (2 * hi) * 1024 + r32 * 16;
    DMA8(0, 0); DMA8(1, SL); DMA8(2, 2 * SL);
    v8i qf; { const unsigned char* Qw = Q8 + (rowb + qb * 256 + wid * 32 + r32) * 512 + h * 64 + 32 * hi; const u32x4 a = *(const u32x4*)Qw, c = *(const u32x4*)(Qw + 16);
        qf = (v8i){(int)a.x, (int)a.y, (int)a.z, (int)a.w, (int)c.x, (int)c.y, (int)c.z, (int)c.w}; }
    asm volatile("s_waitcnt vmcnt(0)\n\ts_barrier" ::: "memory");
    v8i kf0, kf1, vf0, vf1, p8;
#define LD32(dstv, p) do { const u32x4 a_ = *(const LAS u32x4*)(p), c_ = *(const LAS u32x4*)((p) + 1024); dstv = (v8i){(int)a_.x, (int)a_.y, (int)a_.z, (int)a_.w, (int)c_.x, (int)c_.y, (int)c_.z, (int)c_.w}; } while (0)
#define KLOAD8(so) do { LD32(kf0, kp0 + (so)); LD32(kf1, kp0 + (so) + 512); } while (0)
#define VLOAD8(so) do { LD32(vf0, vp0 + (so)); LD32(vf1, vp0 + (so) + 512); } while (0)
    KLOAD8(0);
    asm volatile("s_waitcnt lgkmcnt(0)" ::: "memory");
    if (wid >= 4) AT_BAR();
    float z_ = 0.f; asm volatile("" : "+v"(z_));
    f32x16 o0 = SPLAT16(z_), o1 = SPLAT16(z_), o2 = SPLAT16(z_), C0, C1;
    const v8i ones = {0x38383838, 0x38383838, 0x38383838, 0x38383838, 0x38383838, 0x38383838, 0x38383838, 0x38383838};
    float nb_ = PFOLD * bias + PBYTE0; asm volatile("" : "+v"(nb_));
    f32x16 negb = SPLAT16(nb_);
    asm volatile("" : "+v"(negb));
#define SOFTMAX8() do { \
        _Pragma("unroll") for (int i = 0; i < 4; ++i) { \
            const f32x2 a_ = (f32x2){C0[4 * i], C0[4 * i + 1]}, b_ = (f32x2){C0[4 * i + 2], C0[4 * i + 3]}, c_ = (f32x2){C1[4 * i], C1[4 * i + 1]}, d_ = (f32x2){C1[4 * i + 2], C1[4 * i + 3]}; \
            p8[i] = (int)__builtin_amdgcn_cvt_pk_u8_f32(b_[1], 3, __builtin_amdgcn_cvt_pk_u8_f32(b_[0], 2, __builtin_amdgcn_cvt_pk_u8_f32(a_[1], 1, __builtin_amdgcn_cvt_pk_u8_f32(a_[0], 0, 0u)))); \
            p8[4 + i] = (int)__builtin_amdgcn_cvt_pk_u8_f32(d_[1], 3, __builtin_amdgcn_cvt_pk_u8_f32(d_[0], 2, __builtin_amdgcn_cvt_pk_u8_f32(c_[1], 1, __builtin_amdgcn_cvt_pk_u8_f32(c_[0], 0, 0u)))); } } while (0)
#define STEP8(sv, DOQK2, DOSM, DOPV, KL, VL, ISS, WN, NOPS) do { \
        AT_SCHED(); \
        if (KL) { LD32(kf0, kp0 + (((sv) + 2) & 3) * SL); LD32(kf1, kp0 + (((sv) + 2) & 3) * SL + 512); } AT_SCHED(); \
        if (DOPV) { o0 = mfma8pv(p8, vf0, o0); } if (VL) LD32(vf0, vp0 + (((sv) + 1) & 3) * SL); AT_SCHED(); \
        if (DOPV) { o1 = mfma8pv(p8, vf1, o1); } if (VL) LD32(vf1, vp0 + (((sv) + 1) & 3) * SL + 512); AT_SCHED(); \
        if (DOPV) { o2 = mfma8pv(p8, ones, o2); } if (ISS) DMA8((sv) + 4, (((sv) + 4) & 3) * SL); AT_SCHED(); \
        asm volatile("s_barrier\n\t" NOPS : "+v"(C0), "+v"(C1), "+v"(o0), "+v"(o1), "+v"(o2) :: "memory"); AT_SCHED(); \
        if (DOSM) { SOFTMAX8(); asm volatile("" :: "v"(p8)); } AT_SCHED(); \
        if (DOQK2) { asm volatile("s_waitcnt lgkmcnt(0)" ::: "memory"); C0 = mfma8(kf0, qf, negb); C1 = mfma8(kf1, qf, negb); } AT_SCHED(); \
        asm volatile("s_waitcnt vmcnt(" #WN ") lgkmcnt(0)\n\ts_barrier" : "+v"(C0), "+v"(C1), "+v"(o0), "+v"(o1), "+v"(o2) :: "memory"); \
        AT_SCHED(); } while (0)
    C0 = mfma8(kf0, qf, negb); C1 = mfma8(kf1, qf, negb);
    STEP8(-1, true, true, false, true, true, true, 1, "s_nop 15\n\ts_nop 15");
#pragma nounroll
    for (int s = 0; s < NT - 4; ++s) STEP8(s, true, true, true, true, true, true, 1, "s_nop 1");
    STEP8(NT - 4, true, true, true, true, true, false, 0, "s_nop 1");
    STEP8(NT - 3, true, true, true, true, true, false, 0, "s_nop 1");
    STEP8(NT - 2, false, true, true, false, true, false, 0, "s_nop 15\n\ts_nop 15");
    STEP8(NT - 1, false, false, true, false, false, false, 0, "s_nop 15\n\ts_nop 15");
    if (wid < 4) AT_BAR();
#if PROJ_FP8
    LAS unsigned char* stg8 = lds + OST + wid * 4096;
#pragma unroll
    for (int r = 0; r < 16; ++r) { const int orow = crow(r, hi); const float rl = __builtin_amdgcn_rcpf(o2[r]) * OSCALE;
        const unsigned pk = (unsigned)__builtin_amdgcn_cvt_pk_fp8_f32(o0[r] * rl, o1[r] * rl, 0, false);
        stg8[orow * 64 + r32] = (unsigned char)(pk & 0xffu); stg8[orow * 64 + 32 + r32] = (unsigned char)((pk >> 8) & 0xffu); }
    asm volatile("s_waitcnt lgkmcnt(0)" ::: "memory");
    unsigned char* Ow8 = (unsigned char*)O + (rowb + qb * 256 + wid * 32) * op + h * 64;
#pragma unroll
    for (int i = 0; i < 2; ++i) { const int idx = i * 64 + lane, row = idx >> 2, ch = idx & 3; const u32x4 v = *(const LAS u32x4*)(stg8 + row * 64 + ch * 16); st16(Ow8 + (size_t)row * op + ch * 16, v); }
#else
    LAS bf16_t* stg = (LAS bf16_t*)(lds + OST + wid * 4096);
#pragma unroll
    for (int r = 0; r < 16; ++r) { const int orow = crow(r, hi); const float rl = __builtin_amdgcn_rcpf(o2[r]);
        stg[orow * 64 + r32] = (bf16_t)(cvtpk(o0[r] * rl, 0.f) & 0xffffu); stg[orow * 64 + 32 + r32] = (bf16_t)(cvtpk(o1[r] * rl, 0.f) & 0xffffu); }
    asm volatile("s_waitcnt lgkmcnt(0)" ::: "memory");
    bf16_t* Ow = O + (rowb + qb * 256 + wid * 32) * op + h * 64;
#pragma unroll
    for (int i = 0; i < 4; ++i) { const int row = i * 8 + (lane >> 3), ch = lane & 7; const u32x4 v = *(const LAS u32x4*)(stg + row * 64 + ch * 8); st16(Ow + (size_t)row * op + ch * 8, v); }
    #endif
    asm volatile("s_waitcnt lgkmcnt(0)\n\ts_barrier" ::: "memory");
#undef DMA8
#undef LD32
#undef KLOAD8
#undef VLOAD8
#undef SOFTMAX8
#undef STEP8
}
__device__ __forceinline__ void attn_phase_f8a(int tid, LAS unsigned char* lds, const unsigned char* Q8, const unsigned char* K8, const unsigned char* VT8, bf16_t* O, int op, const float* gq, const float* gk, int vcu, int G) {
    float mq = 0.f, mk = 0.f;
    for (int i = 0; i < 64; ++i) { mq = fmaxf(mq, fabsf(gq[i])); mk = fmaxf(mk, fabsf(gk[i])); }
    const float bias = -fmaxf(64.f * mq * mk * QSCALE_A * 1.13f - 15.5f, 0.f);
    int bh, qb;
    for (int i = 0; next_unit(i, vcu, G, bh, qb); ++i) attn_unit_f8a(tid, lds, Q8, K8, VT8, O, op, bh >> 3, bh & 7, qb, bias);
}
#endif
#if FAST_ATTN && ATT_FP8_B
__device__ __forceinline__ void attn_unit_f8b(int tid, LAS unsigned char* lds, const unsigned char* Q8, const unsigned char* K8, const unsigned char* VT8, bf16_t* O, int op, int b, int h, int qb) {
    constexpr int SLK = 6144, SLV = 4096, NT = S / 64;
    constexpr int KOFF = 0, VOFF = 4 * SLK, OST = VOFF + 4 * SLV, WSF = OST + 8 * 4096;
    static_assert(WSF + 2048 <= RING_BYTES, "attention LDS");
    const int lane = tid & 63, r32 = lane & 31, hi = lane >> 5, wid = __builtin_amdgcn_readfirstlane(tid >> 6);
    const size_t rowb = (size_t)b * S; const bool kw = wid < 6, vw = wid >= 4;
    const unsigned char* ksrc = K8 + (rowb + lane) * 768 + h * 96 + 16 * wid;
    const unsigned char* vsrc = VT8 + ((size_t)((b * 8 + h) * 64 + lane)) * S + 16 * (wid - 4);
    LAS unsigned char* kdst = lds + KOFF + wid * 1024; LAS unsigned char* vdst = lds + VOFF + (wid - 4) * 1024;
#define DMAK(j, so) AT_GLDS(ksrc + (size_t)(j) * (64 * 768), kdst + (so))
#define DMAV(j, so) AT_GLDS(vsrc + (size_t)(j) * 64, vdst + (so))
    const LAS unsigned char* kp0 = lds + KOFF + (2 * hi) * 1024 + r32 * 16;
    const LAS unsigned char* kr0 = lds + KOFF + 4 * 1024 + r32 * 16;
    const LAS unsigned char* vp0 = lds + VOFF + (2 * hi) * 1024 + r32 * 16;
    if (kw) { DMAK(0, 0); DMAK(1, SLK); DMAK(2, 2 * SLK); DMAK(3, 3 * SLK); }
    if (vw) { DMAV(0, 0); DMAV(1, SLV); DMAV(2, 2 * SLV); }
    v8i qn, qr;
    { const unsigned char* Qw = Q8 + (rowb + qb * 256 + wid * 32 + r32) * 768 + h * 96; const u32x4 a = *(const u32x4*)(Qw + 32 * hi), c = *(const u32x4*)(Qw + 32 * hi + 16), e = *(const u32x4*)(Qw + 64), f = *(const u32x4*)(Qw + 80);
      qn = (v8i){(int)a.x, (int)a.y, (int)a.z, (int)a.w, (int)c.x, (int)c.y, (int)c.z, (int)c.w};
      qr = hi ? (v8i){0, 0, 0, 0, 0, 0, 0, 0} : (v8i){(int)e.x, (int)e.y, (int)e.z, (int)e.w, (int)f.x, (int)f.y, (int)f.z, (int)f.w}; }
    asm volatile("s_waitcnt vmcnt(0)\n\ts_barrier" ::: "memory");
    v8i kn0, kn1, kr0v, kr1v, vf0, vf1, p8;
#define LD32(dstv, p) do { const u32x4 a_ = *(const LAS u32x4*)(p), c_ = *(const LAS u32x4*)((p) + 1024); dstv = (v8i){(int)a_.x, (int)a_.y, (int)a_.z, (int)a_.w, (int)c_.x, (int)c_.y, (int)c_.z, (int)c_.w}; } while (0)
#define KLOAD8(so) do { LD32(kn0, kp0 + (so)); LD32(kn1, kp0 + (so) + 512); LD32(kr0v, kr0 + (so)); LD32(kr1v, kr0 + (so) + 512); } while (0)
#define VLOAD8(so) do { LD32(vf0, vp0 + (so)); LD32(vf1, vp0 + (so) + 512); } while (0)
    KLOAD8(0);
    asm volatile("s_waitcnt lgkmcnt(0)" ::: "memory");
    if (wid >= 4) AT_BAR();
    float z_ = 0.f, pb_ = PBYTE0; asm volatile("" : "+v"(z_), "+v"(pb_));
    f32x16 o0 = SPLAT16(z_), o1 = SPLAT16(z_), o2 = SPLAT16(z_), C0, C1;
    f32x16 zero = SPLAT16(pb_);
    asm volatile("" : "+v"(zero));
    const v8i ones = {0x38383838, 0x38383838, 0x38383838, 0x38383838, 0x38383838, 0x38383838, 0x38383838, 0x38383838};
#define SOFTMAX8() do { \
        _Pragma("unroll") for (int i = 0; i < 4; ++i) { \
            const f32x2 a_ = (f32x2){C0[4 * i], C0[4 * i + 1]}, b_ = (f32x2){C0[4 * i + 2], C0[4 * i + 3]}, c_ = (f32x2){C1[4 * i], C1[4 * i + 1]}, d_ = (f32x2){C1[4 * i + 2], C1[4 * i + 3]}; \
            p8[i] = (int)__builtin_amdgcn_cvt_pk_u8_f32(b_[1], 3, __builtin_amdgcn_cvt_pk_u8_f32(b_[0], 2, __builtin_amdgcn_cvt_pk_u8_f32(a_[1], 1, __builtin_amdgcn_cvt_pk_u8_f32(a_[0], 0, 0u)))); \
            p8[4 + i] = (int)__builtin_amdgcn_cvt_pk_u8_f32(d_[1], 3, __builtin_amdgcn_cvt_pk_u8_f32(d_[0], 2, __builtin_amdgcn_cvt_pk_u8_f32(c_[1], 1, __builtin_amdgcn_cvt_pk_u8_f32(c_[0], 0, 0u)))); } } while (0)
#define STEP8(sv, DOQK, DOPV, KL, VL, IK, IV, WK, WV, WB, NOPS) do { \
        AT_SCHED(); if (DOQK) { C0 = mfma8(kn0, qn, zero); C1 = mfma8(kn1, qn, zero); C0 = mfma8(kr0v, qr, C0); C1 = mfma8(kr1v, qr, C1); } if (DOPV) { o0 = mfma8pv(p8, vf0, o0); o1 = mfma8pv(p8, vf1, o1); o2 = mfma8pv(p8, ones, o2); } AT_SCHED(); \
        asm volatile("s_barrier\n\t" NOPS : "+v"(C0), "+v"(C1), "+v"(o0), "+v"(o1), "+v"(o2) :: "memory"); AT_SCHED(); \
        if (KL) KLOAD8((((sv) + 2) & 3) * SLK); if (VL) VLOAD8((((sv) + 1) & 3) * SLV); \
        if (kw && (IK)) DMAK((sv) + 5, (((sv) + 1) & 3) * SLK); if (vw && (IV)) DMAV((sv) + 4, ((sv) & 3) * SLV); \
        if (DOQK) { SOFTMAX8(); asm volatile("" :: "v"(p8)); } AT_SCHED(); \
        if (kw && vw) { AT_WAITBAR(WB); } else if (kw) { AT_WAITBAR(WK); } else { AT_WAITBAR(WV); } \
        AT_SCHED(); } while (0)
    STEP8(-1, true, false, true, true, true, true, 2, 2, 4, "s_nop 15\n\ts_nop 15");
#pragma nounroll
    for (int s = 0; s < NT - 5; ++s) STEP8(s, true, true, true, true, true, true, 2, 2, 4, "s_nop 1");
    STEP8(NT - 5, true, true, true, true, false, true, 1, 2, 3, "s_nop 15\n\ts_nop 15");
    STEP8(NT - 4, true, true, true, true, false, false, 0, 1, 1, "s_nop 15\n\ts_nop 15");
    STEP8(NT - 3, true, true, true, true, false, false, 0, 0, 0, "s_nop 15\n\ts_nop 15");
    STEP8(NT - 2, true, true, false, true, false, false, 0, 0, 0, "s_nop 15\n\ts_nop 15");
    STEP8(NT - 1, false, true, false, false, false, false, 0, 0, 0, "s_nop 15\n\ts_nop 15");
    if (wid < 4) AT_BAR();
#if PROJ_FP8
    LAS unsigned char* stg8 = lds + OST + wid * 4096;
#pragma unroll
    for (int r = 0; r < 16; ++r) { const int orow = crow(r, hi); const float rl = __builtin_amdgcn_rcpf(o2[r]) * OSCALE;
        const unsigned pk = (unsigned)__builtin_amdgcn_cvt_pk_fp8_f32(o0[r] * rl, o1[r] * rl, 0, false);
        stg8[orow * 64 + r32] = (unsigned char)(pk & 0xffu); stg8[orow * 64 + 32 + r32] = (unsigned char)((pk >> 8) & 0xffu); }
    asm volatile("s_waitcnt lgkmcnt(0)" ::: "memory");
    unsigned char* Ow8 = (unsigned char*)O + (rowb + qb * 256 + wid * 32) * op + h * 64;
#pragma unroll
    for (int i = 0; i < 2; ++i) { const int idx = i * 64 + lane, row = idx >> 2, ch = idx & 3; const u32x4 v = *(const LAS u32x4*)(stg8 + row * 64 + ch * 16); st16(Ow8 + (size_t)row * op + ch * 16, v); }
#else
    LAS bf16_t* stg = (LAS bf16_t*)(lds + OST + wid * 4096);
#pragma unroll
    for (int r = 0; r < 16; ++r) { const int orow = crow(r, hi); const float rl = __builtin_amdgcn_rcpf(o2[r]);
        stg[orow * 64 + r32] = (bf16_t)(cvtpk(o0[r] * rl, 0.f) & 0xffffu); stg[orow * 64 + 32 + r32] = (bf16_t)(cvtpk(o1[r] * rl, 0.f) & 0xffffu); }
    asm volatile("s_waitcnt lgkmcnt(0)" ::: "memory");
    bf16_t* Ow = O + (rowb + qb * 256 + wid * 32) * op + h * 64;
#pragma unroll
    for (int i = 0; i < 4; ++i) { const int row = i * 8 + (lane >> 3), ch = lane & 7; const u32x4 v = *(const LAS u32x4*)(stg + row * 64 + ch * 8); st16(Ow + (size_t)row * op + ch * 8, v); }
    #endif
    asm volatile("s_waitcnt lgkmcnt(0)\n\ts_barrier" ::: "memory");
#undef DMAK
#undef DMAV
#undef LD32
#undef KLOAD8
#undef VLOAD8
#undef SOFTMAX8
#undef STEP8
}
__device__ __forceinline__ void attn_phase_f8b(int tid, LAS unsigned char* lds, const unsigned char* Q8, const unsigned char* K8, const unsigned char* VT8, bf16_t* O, int op, int vcu, int G) {
    int bh, qb;
    for (int i = 0; next_unit(i, vcu, G, bh, qb); ++i) attn_unit_f8b(tid, lds, Q8, K8, VT8, O, op, bh >> 3, bh & 7, qb);
}
#endif
template <int DQK>
__device__ __forceinline__ void attn_phase(int tid, LAS unsigned char* lds, const Tensors& A, int vcu, int G) {
#if FAST_ATTN
    int bh, qb;
    for (int i = 0; next_unit(i, vcu, G, bh, qb); ++i) attn_unit<DQK>(tid, lds, A, bh >> 3, bh & 7, qb);
#else
    (void)lds; attn_phase_ref<DQK>(tid, A, vcu, G);
#endif
}
}


struct Args { const float* in[22]; float* out; unsigned char* ws; int ph_lo, ph_hi; };
struct Frame {
    LAS unsigned char* lds; volatile LAS unsigned* MISC; unsigned* ctl;
    int tid, lane, wave, vcu, G;
    unsigned char* ws; float* OUT;
};

__device__ __forceinline__ void p0_phase(Frame& F, const float* c, const float* w_ada, const float* b_ada) {
    LAS float* cs = (LAS float*)F.lds;
    LAS float* red = (LAS float*)(F.lds + 32768);
    for (int i = F.tid; i < NB * D; i += NTHREADS) { const float v = c[i]; cs[i] = v / (1.f + __expf(-v)); }
    __syncthreads();
    float* mod = (float*)(F.ws + WS_MOD);
    const int kq = F.wave, col = F.lane;
    for (int item = F.vcu; item < NL * 6 * D / 64; item += F.G) {
        const int l = item / (6 * D / 64), n0 = (item % (6 * D / 64)) * 64;
        const float* w = w_ada + (size_t)l * D * 6 * D + n0 + col;
        float acc[NB];
#pragma unroll
        for (int b = 0; b < NB; ++b) acc[b] = 0.f;
#pragma unroll 8
        for (int k = kq * 128; k < kq * 128 + 128; ++k) { const float wv = w[(size_t)k * 6 * D];
#pragma unroll
            for (int b = 0; b < NB; ++b) acc[b] += cs[b * D + k] * wv; }
#pragma unroll
        for (int b = 0; b < NB; ++b) red[(kq * NB + b) * 64 + col] = acc[b];
        __syncthreads();
        { const int b = F.wave; float s = 0.f;
#pragma unroll
          for (int q = 0; q < 8; ++q) s += red[(q * NB + b) * 64 + col];
          mod[((size_t)l * NB + b) * 6 * D + n0 + col] = s + b_ada[(size_t)l * 6 * D + n0 + col]; }
        __syncthreads();
    }
    float* cosA = (float*)(F.ws + WS_COSA); float* sinA = (float*)(F.ws + WS_SINA); float* cosB = (float*)(F.ws + WS_COSB); float* sinB = (float*)(F.ws + WS_SINB);
    for (int idx = F.vcu * NTHREADS + F.tid; idx < S * 48; idx += F.G * NTHREADS) {
        const int s = idx / 48, i = idx % 48; const float row = (float)(s >> 6), col2 = (float)(s & 63);
        if (i < 32) { const int j = i & 15; const float a = (i < 16 ? row : col2) * (1.0f / powf(10000.0f, (float)j / 16.0f)); cosA[s * 32 + i] = cosf(a); sinA[s * 32 + i] = sinf(a); }
        else { const int ii = i - 32, j = ii & 7; const float a = (ii < 8 ? row : col2) * (1.0f / powf(10000.0f, (float)j / 8.0f)); cosB[s * 16 + ii] = cosf(a); sinB[s * 16 + ii] = sinf(a); }
    }
}

template <class SrcFn>
__device__ __forceinline__ void cvt_item(const float* W, int K, int Nsrc, const float* kg, bf16_t* WT, LAS float* scr, int item, int nblk, int lane, const SrcFn& src, float f8scale = 0.f) {
    const int kb = item / nblk, nb = item % nblk, k0 = 64 * kb, n0 = 32 * nb;
    const int sc = src(n0 + (lane & 31));
#pragma unroll
    for (int i = 0; i < 32; ++i) { const int kk = 2 * i + (lane >> 5); float v = sc >= 0 ? W[(size_t)(k0 + kk) * Nsrc + sc] : 0.f; if (kg) v *= kg[k0 + kk]; scr[kk * 33 + (lane & 31)] = v; }
    LDS_WAIT(); asm volatile("" ::: "memory");
    const int c = lane & 7;
    if (f8scale != 0.f) {
#pragma unroll
        for (int j = 0; j < 4; ++j) { const int n = (lane >> 3) + 8 * j; const LAS float* sp = scr + (8 * c) * 33 + n;
            const u32x2 o = pack8_fp8((f32x4){sp[0 * 33], sp[1 * 33], sp[2 * 33], sp[3 * 33]} * f8scale, (f32x4){sp[4 * 33], sp[5 * 33], sp[6 * 33], sp[7 * 33]} * f8scale);
            *(u32x2*)((unsigned char*)WT + (size_t)(n0 + n) * K + k0 + 8 * c) = o; }
    } else {
#pragma unroll
    for (int j = 0; j < 4; ++j) { const int n = (lane >> 3) + 8 * j; const LAS float* s = scr + (8 * c) * 33 + n;
        u32x4 o; o.x = cvt_pk_bf16(s[0 * 33], s[1 * 33]); o.y = cvt_pk_bf16(s[2 * 33], s[3 * 33]); o.z = cvt_pk_bf16(s[4 * 33], s[5 * 33]); o.w = cvt_pk_bf16(s[6 * 33], s[7 * 33]);
        *(u32x4*)(WT + (size_t)(n0 + n) * K + k0 + 8 * c) = o; }
    }
    LDS_WAIT(); asm volatile("" ::: "memory");
}
struct SrcId { __device__ int operator()(int n) const { return n; } };
struct SrcIn { __device__ int operator()(int n) const { return gp::src_col_in(n); } };
typedef __attribute__((address_space(4))) const Args CArgsW;
__device__ __forceinline__ void convert_weights(Frame& F, CArgsW* a, int l) {
    LAS float* scr = (LAS float*)(F.lds + F.wave * 16384);
    const int gw = F.vcu * NWAVES + F.wave, NGW = F.G * NWAVES;
    const float* w_in = ((const float*)(GAS const float*)a->in[5]) + (size_t)l * D * INC; const float* w_q_b = ((const float*)(GAS const float*)a->in[10]) + (size_t)l * 384 * 768; const float* w_kv_b = ((const float*)(GAS const float*)a->in[11]) + (size_t)l * 256 * 1024;
    const float* w_pa = ((const float*)(GAS const float*)a->in[12]) + (size_t)l * 512 * D; const float* w_pb = ((const float*)(GAS const float*)a->in[13]) + (size_t)l * 512 * D; const float* w_o = ((const float*)(GAS const float*)a->in[14]) + (size_t)l * D * D;
    const float* w1 = ((const float*)(GAS const float*)a->in[18]) + (size_t)l * NE * D * FF; const float* w3 = ((const float*)(GAS const float*)a->in[19]) + (size_t)l * NE * D * FF; const float* w2 = ((const float*)(GAS const float*)a->in[20]) + (size_t)l * NE * FF * D;
    const float* gqa = ((const float*)(GAS const float*)a->in[8]) + l * 384; const float* gkv = ((const float*)(GAS const float*)a->in[9]) + l * 256;
    bf16_t* Win = (bf16_t*)(F.ws + WS_WIN); bf16_t* Wqb = (bf16_t*)(F.ws + WS_WQB); bf16_t* Wkvb = (bf16_t*)(F.ws + WS_WKVB); bf16_t* Wpa = (bf16_t*)(F.ws + WS_WPA); bf16_t* Wpb = (bf16_t*)(F.ws + WS_WPB);
    bf16_t* Wo = (bf16_t*)(F.ws + WS_WO); bf16_t* W13 = (bf16_t*)(F.ws + WS_W13); bf16_t* W2 = (bf16_t*)(F.ws + WS_W2);
    constexpr int I_IN = (D / 64) * (NIN / 32), I_QB = (384 / 64) * (768 / 32), I_KVB = (256 / 64) * (1024 / 32), I_P = (512 / 64) * (D / 32), I_O = (D / 64) * (D / 32);
    constexpr int I_13 = (D / 64) * (1024 / 32), I_2 = (FF / 64) * (D / 32);
    constexpr int NITEMS = I_IN + I_QB + I_KVB + 2 * I_P + I_O + NE * (I_13 + I_2);
    for (int it = gw; it < NITEMS; it += NGW) {
        int r = it;
        if (r < I_IN) { cvt_item(w_in, D, INC, nullptr, Win, scr, r, NIN / 32, F.lane, SrcIn(), G1_FP8 ? 16.f : 0.f); continue; } r -= I_IN;
        if (r < I_QB) { cvt_item(w_q_b, 384, 768, gqa, Wqb, scr, r, 768 / 32, F.lane, SrcId()); continue; } r -= I_QB;
        if (r < I_KVB) { cvt_item(w_kv_b, 256, 1024, gkv, Wkvb, scr, r, 1024 / 32, F.lane, SrcId()); continue; } r -= I_KVB;
        if (r < I_P) { cvt_item(w_pa, 512, D, nullptr, Wpa, scr, r, D / 32, F.lane, SrcId(), PROJ_FP8 ? WSCALE : 0.f); continue; } r -= I_P;
        if (r < I_P) { cvt_item(w_pb, 512, D, nullptr, Wpb, scr, r, D / 32, F.lane, SrcId(), PROJ_FP8 ? WSCALE : 0.f); continue; } r -= I_P;
        if (r < I_O) { cvt_item(w_o, D, D, nullptr, Wo, scr, r, D / 32, F.lane, SrcId(), PROJ_FP8 ? WSCALE : 0.f); continue; } r -= I_O;
        if (r < NE * I_13) { const int e = r / I_13, q = r % I_13, nb = q % 32;
            const float* src = ((nb & 7) < 4 ? w1 : w3) + (size_t)e * D * FF; const int cb = (nb >> 3) * 128 + (nb & 3) * 32;
            struct SrcOff { int n0, cb; __device__ int operator()(int n) const { return cb + (n - n0); } } so{nb * 32, cb};
            if (MOE_FP8) cvt_item(src, D, FF, nullptr, (bf16_t*)((unsigned char*)W13 + (size_t)e * 1024 * D), scr, q, 32, F.lane, so, 16.f);
            else cvt_item(src, D, FF, nullptr, W13 + (size_t)e * 1024 * D, scr, q, 32, F.lane, so);
            continue; } r -= NE * I_13;
        { const int e = r / I_2, q = r % I_2;
          if (MOE_FP8) cvt_item(w2 + (size_t)e * FF * D, FF, D, nullptr, (bf16_t*)((unsigned char*)W2 + (size_t)e * D * FF), scr, q, D / 32, F.lane, SrcId(), 16.f);
          else cvt_item(w2 + (size_t)e * FF * D, FF, D, nullptr, W2 + (size_t)e * D * FF, scr, q, D / 32, F.lane, SrcId()); }
    }
}

template <int MODE>
__device__ __forceinline__ void row_phase(Frame& F, const float* xin, const float* g2prev, const float* gain, const float* modl, int sh_off, int sc_off, bf16_t* H, bf16_t* XB, float* OUT) {
    constexpr int RB = 4, RPW = T / (256 * NWAVES);
    const int gw = F.vcu * NWAVES + F.wave, b = (gw * RPW) >> 12;
    const bf16_t* Y2 = (const bf16_t*)(F.ws + WS_Y2);
    f32x4 gs[4], shv[4], g2v[4];
#pragma unroll
    for (int j = 0; j < 4; ++j) { const int c = 4 * F.lane + 256 * j; gs[j] = *(const f32x4*)(gain + c);
        if (MODE != 2) { gs[j] = gs[j] * (1.f + *(const f32x4*)(modl + (size_t)b * 6 * D + sc_off + c)); shv[j] = *(const f32x4*)(modl + (size_t)b * 6 * D + sh_off + c); }
        if (MODE != 0) g2v[j] = *(const f32x4*)(g2prev + (size_t)b * 6 * D + 5 * D + c); }
    for (int m0 = gw * RPW; m0 < gw * RPW + RPW; m0 += RB) {
        f32x4 v[RB][4]; float ss[RB];
        if (MODE == 0) {
#pragma unroll
            for (int r = 0; r < RB; ++r)
#pragma unroll
                for (int j = 0; j < 4; ++j) v[r][j] = *(const f32x4*)(xin + (size_t)(m0 + r) * D + 4 * F.lane + 256 * j);
        } else {
            unsigned ya[RB][4], yb[RB][4];
#pragma unroll
            for (int r = 0; r < RB; ++r)
#pragma unroll
                for (int j = 0; j < 4; ++j) { const int m = m0 + r, c = 4 * F.lane + 256 * j;
                    { const u32x2 xb = *(const u32x2*)(XB + (size_t)m * D + c); v[r][j] = (f32x4){bf2f(xb.x & 0xffffu), bf2f(xb.x >> 16), bf2f(xb.y & 0xffffu), bf2f(xb.y >> 16)}; }
                    ya[r][j] = *(const unsigned*)((const unsigned char*)Y2 + (size_t)(2 * m) * D + c); yb[r][j] = *(const unsigned*)((const unsigned char*)Y2 + (size_t)(2 * m + 1) * D + c); }
#pragma unroll
            for (int r = 0; r < RB; ++r)
#pragma unroll
                for (int j = 0; j < 4; ++j) { const f32x2 a0 = __builtin_amdgcn_cvt_pk_f32_fp8((int)ya[r][j], false), a1 = __builtin_amdgcn_cvt_pk_f32_fp8((int)ya[r][j], true), b0 = __builtin_amdgcn_cvt_pk_f32_fp8((int)yb[r][j], false), b1 = __builtin_amdgcn_cvt_pk_f32_fp8((int)yb[r][j], true);
                    const f32x4 y = (f32x4){a0[0] + b0[0], a0[1] + b0[1], a1[0] + b1[0], a1[1] + b1[1]} * 0.0625f;
                    v[r][j] += g2v[j] * y; }
        }
#pragma unroll
        for (int r = 0; r < RB; ++r) { ss[r] = (gp::dot4(v[r][0]) + gp::dot4(v[r][1])) + (gp::dot4(v[r][2]) + gp::dot4(v[r][3])); }
#pragma unroll
        for (int o = 1; o < 64; o <<= 1)
#pragma unroll
            for (int r = 0; r < RB; ++r) ss[r] += shfl_xor_l(ss[r], F.lane, o);
#pragma unroll
        for (int r = 0; r < RB; ++r) {
            const int m = m0 + r; const float rstd = rsqrtf(ss[r] * (1.f / D) + EPS);
#pragma unroll
            for (int j = 0; j < 4; ++j) {
                const int c = 4 * F.lane + 256 * j;
                if (MODE == 2) { *(f32x4*)(OUT + (size_t)m * D + c) = v[r][j] * rstd * gs[j]; }
                else {
                    { u32x2 xw; xw.x = cvt_pk_bf16(v[r][j][0], v[r][j][1]); xw.y = cvt_pk_bf16(v[r][j][2], v[r][j][3]); st8((XB + (size_t)m * D + c), xw); }
                    const f32x4 hv = v[r][j] * rstd * gs[j] + shv[j];
                    if (G1_FP8) { const f32x4 hq = hv * 0.0625f;
                        *(unsigned*)((unsigned char*)H + (size_t)m * D + c) = (unsigned)__builtin_amdgcn_cvt_pk_fp8_f32(hq[2], hq[3], __builtin_amdgcn_cvt_pk_fp8_f32(hq[0], hq[1], 0, false), true); }
                    else { u32x2 w; w.x = cvt_pk_bf16(hv[0], hv[1]); w.y = cvt_pk_bf16(hv[2], hv[3]);
                    st8((H + (size_t)m * D + c), w); }
                }
            }
        }
    }
}

__device__ __forceinline__ void t2_phase(Frame& F, const float* gain, const float* modl, const float* w_router, const float* rbias, int l, bool record) {
    LAS f32x4* wl = (LAS f32x4*)F.lds;
    LAS int* rec = (LAS int*)(F.lds + 65536);
    LAS float* recw = (LAS float*)(F.lds + 65536 + 2048);
    LAS int* lcnt = (LAS int*)(F.lds + 65536 + 4096);
    for (int idx = F.tid; idx < 4096; idx += NTHREADS) {
        const int lane = idx & 63, c = (idx >> 6) & 3, i = (idx >> 8) & 3, j = idx >> 10; const int k = 4 * lane + 256 * j + i;
        wl[idx] = *(const f32x4*)(w_router + (size_t)k * NE + 4 * c);
    }
    if (F.tid < 32) lcnt[F.tid] = 0;
    __syncthreads();
    constexpr int RB = 4, RPW = T / (256 * NWAVES);
    const int gw = F.vcu * NWAVES + F.wave, bt = (gw * RPW) >> 12;
    bf16_t* H = (bf16_t*)(F.ws + WS_H); const bf16_t* XB = (const bf16_t*)(F.ws + WS_XB);
    const int lane = F.lane, myrow = lane >> 4, mye = lane & 15;
    f32x4 gs[4], shv[4];
#pragma unroll
    for (int j = 0; j < 4; ++j) { const int c = 4 * lane + 256 * j; gs[j] = *(const f32x4*)(gain + c) * (1.f + *(const f32x4*)(modl + (size_t)bt * 6 * D + 4 * D + c)); shv[j] = *(const f32x4*)(modl + (size_t)bt * 6 * D + 3 * D + c); }
    int it = 0;
    for (int m0 = gw * RPW; m0 < gw * RPW + RPW; m0 += RB, ++it) {
        f32x4 v[RB][4]; float ss[RB];
#pragma unroll
        for (int r = 0; r < RB; ++r)
#pragma unroll
            for (int j = 0; j < 4; ++j) { const u32x2 xb = *(const u32x2*)(XB + (size_t)(m0 + r) * D + 4 * lane + 256 * j); v[r][j] = (f32x4){bf2f(xb.x & 0xffffu), bf2f(xb.x >> 16), bf2f(xb.y & 0xffffu), bf2f(xb.y >> 16)}; }
#pragma unroll
        for (int r = 0; r < RB; ++r) ss[r] = (gp::dot4(v[r][0]) + gp::dot4(v[r][1])) + (gp::dot4(v[r][2]) + gp::dot4(v[r][3]));
#pragma unroll
        for (int o = 1; o < 64; o <<= 1)
#pragma unroll
            for (int r = 0; r < RB; ++r) ss[r] += shfl_xor_l(ss[r], F.lane, o);
        float acc[RB * NE];
#pragma unroll
        for (int q = 0; q < RB * NE; ++q) acc[q] = 0.f;
#pragma unroll
        for (int j = 0; j < 4; ++j) {
            const int c = 4 * lane + 256 * j;
#pragma unroll
            for (int r = 0; r < RB; ++r) {
                const int m = m0 + r; const float rstd = rsqrtf(ss[r] * (1.f / D) + EPS);
                v[r][j] = v[r][j] * rstd * gs[j] + shv[j];
#if MOE_FP8
                *(unsigned*)((unsigned char*)H + (size_t)m * D + c) = (unsigned)__builtin_amdgcn_cvt_pk_fp8_f32(v[r][j][2], v[r][j][3], __builtin_amdgcn_cvt_pk_fp8_f32(v[r][j][0], v[r][j][1], 0, false), true);
#else
                u32x2 w; w.x = cvt_pk_bf16(v[r][j][0], v[r][j][1]); w.y = cvt_pk_bf16(v[r][j][2], v[r][j][3]);
                st8((H + (size_t)m * D + c), w);
#endif
            }
#pragma unroll
            for (int i = 0; i < 4; ++i)
#pragma unroll
                for (int c4 = 0; c4 < 4; ++c4) { const f32x4 wv = wl[((j * 4 + i) * 4 + c4) * 64 + lane];
#pragma unroll
                    for (int r = 0; r < RB; ++r) { const float hv = v[r][j][i];
                        acc[r * NE + 4 * c4 + 0] += hv * wv[0]; acc[r * NE + 4 * c4 + 1] += hv * wv[1]; acc[r * NE + 4 * c4 + 2] += hv * wv[2]; acc[r * NE + 4 * c4 + 3] += hv * wv[3]; } }
        }
#pragma unroll
        for (int sft = 32; sft >= 1; sft >>= 1) {
            const bool up = (lane & sft) != 0;
#pragma unroll
            for (int k = 0; k < sft; ++k) { const float a = acc[k], b = acc[k + sft]; const float keep = up ? b : a, send = up ? a : b; acc[k] = keep + shfl_xor_l(send, lane, sft); }
        }
        const float logit = acc[0];
        const float score = 1.f / (1.f + expf(-logit));
        float scv[NE], bi[NE];
#pragma unroll
        for (int e = 0; e < NE; ++e) { scv[e] = shfl_l(score, (lane & 48) | e); bi[e] = scv[e] + rbias[e]; }
        int gsel = 0; float gbest = -INFINITY;
#pragma unroll
        for (int g = 0; g < 4; ++g) { float m1 = -INFINITY, m2 = -INFINITY;
#pragma unroll
            for (int j = 0; j < 4; ++j) { const float x = bi[g * 4 + j]; if (x > m1) { m2 = m1; m1 = x; } else if (x > m2) m2 = x; }
            const float gs = m1 + m2; if (gs > gbest) { gbest = gs; gsel = g; } }
        int e1 = -1, e2 = -1; float b1 = -INFINITY, b2 = -INFINITY, s1 = 0.f, s2 = 0.f;
#pragma unroll
        for (int j = 0; j < 4; ++j) { float x = -INFINITY, sx = 0.f;
#pragma unroll
            for (int g = 0; g < 4; ++g) if (g == gsel) { x = bi[g * 4 + j]; sx = scv[g * 4 + j]; }
            const int e = gsel * 4 + j;
            if (x > b1) { b2 = b1; e2 = e1; s2 = s1; b1 = x; e1 = e; s1 = sx; } else if (x > b2) { b2 = x; e2 = e; s2 = sx; } }
        if (mye == 0) {
            const float inv = 1.f / (s1 + s2); const int slot = (it * RB + myrow) * NWAVES + F.wave;
            rec[slot * 4 + 0] = e1; rec[slot * 4 + 1] = e2;
            rec[slot * 4 + 2] = __hip_atomic_fetch_add(&lcnt[e1], 1, __ATOMIC_RELAXED, __HIP_MEMORY_SCOPE_WORKGROUP);
            rec[slot * 4 + 3] = __hip_atomic_fetch_add(&lcnt[e2], 1, __ATOMIC_RELAXED, __HIP_MEMORY_SCOPE_WORKGROUP);
            recw[slot * 2 + 0] = s1 * inv; recw[slot * 2 + 1] = s2 * inv;
        }
    }
    __syncthreads();
    if (!record) return;
    if (F.tid < NE) lcnt[16 + F.tid] = (int)__hip_atomic_fetch_add(F.ctl + CW_CNT + (l * NE + F.tid) * 64, (unsigned)lcnt[F.tid], __ATOMIC_RELAXED, __HIP_MEMORY_SCOPE_AGENT);
    __syncthreads();
    unsigned* list = (unsigned*)(F.ws + WS_LIST); float* gwb = (float*)(F.ws + WS_GW);
    const int nrows = it * RB;
    for (int s = F.tid; s < nrows * NWAVES; s += NTHREADS) {
        const int i2 = s / NWAVES, w = s % NWAVES; const int m = (F.vcu * NWAVES + w) * RPW + i2;
        const int e1 = rec[s * 4 + 0], e2 = rec[s * 4 + 1];
        list[(size_t)e1 * T + lcnt[16 + e1] + rec[s * 4 + 2]] = (unsigned)(2 * m); list[(size_t)e2 * T + lcnt[16 + e2] + rec[s * 4 + 3]] = (unsigned)(2 * m + 1);
        gwb[2 * m] = recw[s * 2]; gwb[2 * m + 1] = recw[s * 2 + 1];
    }
}
__device__ __forceinline__ LAS int* moe_table(Frame& F, int l) {
    LAS int* tab = (LAS int*)(F.lds + MISC_OFF + 1024);
    __syncthreads();
    if (F.tid == 0) { int acc = 0;
        for (int e = 0; e < NE; ++e) { const int c = (int)__hip_atomic_load(F.ctl + CW_CNT + (l * NE + e) * 64, __ATOMIC_RELAXED, __HIP_MEMORY_SCOPE_AGENT); tab[e] = acc; tab[32 + e] = c; acc += (c + 255) >> 8; }
        tab[16] = acc; }
    __syncthreads();
    return tab;
}

typedef __attribute__((address_space(4))) const Args CArgs;
__device__ __forceinline__ void xcd_local_barrier(const XcdBarrier& b) {
    asm volatile("s_waitcnt vmcnt(0)" ::: "memory");
    __syncthreads();
    if (threadIdx.x == 0) {
        unsigned* bar = b.bar;
        __builtin_amdgcn_s_waitcnt(0);
        const unsigned nloc = b.st[0];
        const unsigned old = xb_add(&bar[XB_LSUB(b.x)], 1u);
        const unsigned gen = old / nloc;
        if (old + 1u == (gen + 1u) * nloc) xb_add(&bar[XB_LGEN(b.x)], 1u);
        else XB_SPIN(xb_ld(&bar[XB_LGEN(b.x)]) == gen, bar);
        __builtin_amdgcn_fence(__ATOMIC_ACQUIRE, "agent");
        asm volatile("s_waitcnt vmcnt(0)" ::: "memory");
    }
    __syncthreads();
}
#define LAUNDER_GP(T_, p) do { GAS T_* _t = (GAS T_*)(p); asm volatile("" : "+s"(_t)); (p) = (T_*)_t; } while (0)
#define PH_BEGIN() LAUNDER_V(F.tid); F.lane = F.tid & 63; LAUNDER_GP(unsigned, F.ctl); LAUNDER_GP(float, F.OUT); LAUNDER_GP(unsigned char, F.ws); GAS unsigned char* ws = (GAS unsigned char*)F.ws; CArgs* ka = (CArgs*)__builtin_amdgcn_kernarg_segment_ptr(); LAUNDER_S(ka); \
    float* mod = WSP(float, WS_MOD); (void)mod; (void)ka
#define WSP(T_, off) ((T_*)(GAS T_*)(ws + (off)))
#define KIN(i) ((const float*)(GAS const float*)ka->in[i])
__global__ void __launch_bounds__(NTHREADS, 2) fwd_kernel(Args args) {
    extern __shared__ __attribute__((aligned(16))) unsigned char lds_raw[];
    Frame F;
    F.lds = (LAS unsigned char*)lds_raw; F.MISC = (volatile LAS unsigned*)(F.lds + MISC_OFF);
    F.tid = threadIdx.x; F.lane = F.tid & 63; F.wave = __builtin_amdgcn_readfirstlane(F.tid >> 6);
    F.G = gridDim.x; { const int bx = blockIdx.x; F.vcu = (F.G % 8 == 0) ? (bx % 8) * (F.G / 8) + bx / 8 : bx; }
    F.ws = (unsigned char*)(GAS unsigned char*)args.ws; F.ctl = (unsigned*)(GAS unsigned*)(args.ws + WS_CTL); F.OUT = (float*)(GAS float*)args.out;
    if (F.tid < 64) F.MISC[F.tid] = 0u;
    __syncthreads();
    XcdBarrier bar; bar.bar = F.ctl + CW_BAR; bar.x = 0; bar.st = nullptr;
    if (!N_LAUNCH_MODE) bar = xcd_barrier_post(F.ctl + CW_BAR, F.MISC + 8);
    const int lo = args.ph_lo, hi = args.ph_hi;
#define IN(k) (lo <= (k) && (k) < hi)
#define SEAM(k) do { if ((k) + 1 < hi) { if (!N_LAUNCH_MODE) xcd_barrier(bar); } } while (0)
    int cidx = (int)blockIdx.x; bool lseam = false;
#define SEAML(k) do { if ((k) + 1 < hi) { if (!N_LAUNCH_MODE) { if (lseam) xcd_local_barrier(bar); else xcd_barrier(bar); } } } while (0)

    if (IN(0)) { PH_BEGIN(); p0_phase(F, KIN(1), KIN(2), KIN(3)); __syncthreads(); LAUNDER_V(F.tid); F.lane = F.tid & 63; convert_weights(F, ka, 0); SEAM(0);
        if (XCD_LOCAL_SEAMS && !N_LAUNCH_MODE && F.G == 256) {
            bool ok = true;
            for (int j = 0; j < 8; ++j) ok = ok && (xb_ld(F.ctl + CW_BAR + XB_XCNT(j)) == 32u);
            ok = __builtin_amdgcn_readfirstlane(ok ? 1 : 0) != 0;
            if (ok) { const int rk = __builtin_amdgcn_readfirstlane((int)F.MISC[10]), xx = (int)bar.x; F.vcu = xx * 32 + rk; cidx = rk * 8 + xx; lseam = true; } } }
    for (int l = 0; l < NL; ++l) {
        const int pb = 1 + 9 * l;
        if (IN(pb + 0)) {
            PH_BEGIN();
            if (l > 0) for (int rep = 0; rep < ((PROBE_DUP & 8) ? 2 : 1); ++rep) { LAUNDER_V(F.tid); F.lane = F.tid & 63; convert_weights(F, ka, l); }
            if (l == 0) row_phase<0>(F, KIN(0), nullptr, KIN(4) + l * D, mod + (size_t)l * NB * 6 * D, 0, D, WSP(bf16_t, WS_H), WSP(bf16_t, WS_XB), nullptr);
            else row_phase<1>(F, nullptr, mod + (size_t)(l - 1) * NB * 6 * D, KIN(4) + l * D, mod + (size_t)l * NB * 6 * D, 0, D, WSP(bf16_t, WS_H), WSP(bf16_t, WS_XB), nullptr);
            SEAM(pb + 0);
        }
        if (IN(pb + 1)) {
            PH_BEGIN();
            gp::Gemm g{WSP(bf16_t, WS_H), WSP(const bf16_t, WS_WIN), G1_FP8 ? D / 2 : D, 0, nullptr, 0, 0, 0}; gp::DenseOrder So; So.init(T, NIN, F.G, cidx);
            gp::EpiIn E{WSP(bf16_t, ATT_FP8_A ? WS_QA8 : WS_QA), WSP(bf16_t, ATT_FP8_A ? WS_KA8 : WS_KA), WSP(bf16_t, ATT_FP8_A ? WS_VTA8 : WS_VA), WSP(bf16_t, WS_QLAT), WSP(bf16_t, WS_KVLAT), WSP(bf16_t, ATT_FP8_B ? WS_KB8 : WS_KB), WSP(bf16_t, WS_SA), WSP(bf16_t, WS_SB), WSP(float, WS_SSQ), WSP(float, WS_SSKV),
                        KIN(6) + l * 64, KIN(7) + l * 64, WSP(const float, WS_COSA), WSP(const float, WS_SINA), WSP(const float, WS_COSB), WSP(const float, WS_SINB)};
            if (PROBE_DUP & 128) { gp::EpiNull En; gp::gemm_phase<gp::EpiNull, gp::DenseOrder>(F.tid, F.lds, g, So, En); LAUNDER_V(F.tid); }
            gp::gemm_phase<gp::EpiIn, gp::DenseOrder, false, G1_FP8 != 0>(F.tid, F.lds, g, So, E); if (PROBE_DUP & (2 | 512)) { LAUNDER_V(F.tid); gp::gemm_phase<gp::EpiIn, gp::DenseOrder, false, G1_FP8 != 0>(F.tid, F.lds, g, So, E); }
            SEAML(pb + 1);
        }
        if (IN(pb + 2)) {
            { PH_BEGIN(); gp::Gemm g{WSP(bf16_t, WS_QLAT), WSP(const bf16_t, WS_WQB), 384, 0, nullptr}; gp::DenseOrder So; So.init(T, 768, F.G, cidx);
              gp::EpiQb E{WSP(bf16_t, ATT_FP8_B ? WS_QB8 : WS_QB), WSP(const float, WS_SSQ), WSP(const float, WS_COSB), WSP(const float, WS_SINB)}; gp::gemm_phase<gp::EpiQb, gp::DenseOrder>(F.tid, F.lds, g, So, E); if (PROBE_DUP & 2) { LAUNDER_V(F.tid); gp::gemm_phase<gp::EpiQb, gp::DenseOrder>(F.tid, F.lds, g, So, E); } }
            { PH_BEGIN(); gp::Gemm g{WSP(bf16_t, WS_KVLAT), WSP(const bf16_t, WS_WKVB), 256, 0, nullptr}; gp::DenseOrder So; So.init(T, 1024, F.G, cidx);
              gp::EpiKvb E{WSP(bf16_t, ATT_FP8_B ? WS_KB8 : WS_KB), WSP(bf16_t, ATT_FP8_B ? WS_VTB8 : WS_VB), WSP(const float, WS_SSKV)}; gp::gemm_phase<gp::EpiKvb, gp::DenseOrder>(F.tid, F.lds, g, So, E); if (PROBE_DUP & 2) { LAUNDER_V(F.tid); gp::gemm_phase<gp::EpiKvb, gp::DenseOrder>(F.tid, F.lds, g, So, E); } }
#if FAST_ATTN && ATT_FP8_A
            { PH_BEGIN(); at::attn_phase_f8a(F.tid, F.lds, WSP(const unsigned char, WS_QA8), WSP(const unsigned char, WS_KA8), WSP(const unsigned char, WS_VTA8), WSP(bf16_t, WS_QA), 512, KIN(6) + l * 64, KIN(7) + l * 64, F.vcu, F.G); }
            if (PROBE_DUP & (1 | 4096)) { PH_BEGIN(); at::attn_phase_f8a(F.tid, F.lds, WSP(const unsigned char, WS_QA8), WSP(const unsigned char, WS_KA8), WSP(const unsigned char, WS_VTA8), WSP(bf16_t, WS_QA), 512, KIN(6) + l * 64, KIN(7) + l * 64, F.vcu, F.G); }
#else
            { PH_BEGIN(); const at::Tensors A{WSP(bf16_t, WS_QA), 512, WSP(bf16_t, WS_KA), 128, WSP(bf16_t, WS_VA), 128, WSP(bf16_t, WS_QA), 512, 4}; at::attn_phase<64>(F.tid, F.lds, A, F.vcu, F.G); }
#endif
            SEAML(pb + 2);
        }
        if (IN(pb + 3)) {
            PH_BEGIN();
#if FAST_ATTN && ATT_FP8_B
            at::attn_phase_f8b(F.tid, F.lds, WSP(const unsigned char, WS_QB8), WSP(const unsigned char, WS_KB8), WSP(const unsigned char, WS_VTB8), WSP(bf16_t, WS_OB), 512, F.vcu, F.G);
            if (PROBE_DUP & (1 | 8192)) { LAUNDER_V(F.tid); at::attn_phase_f8b(F.tid, F.lds, WSP(const unsigned char, WS_QB8), WSP(const unsigned char, WS_KB8), WSP(const unsigned char, WS_VTB8), WSP(bf16_t, WS_OB), 512, F.vcu, F.G); }
#else
            const at::Tensors A{WSP(bf16_t, WS_QB), 768, WSP(bf16_t, WS_KB), 768, WSP(bf16_t, WS_VB), 512, WSP(bf16_t, WS_OB), 512, 1}; for (int rep = 0; rep < ((PROBE_DUP & 1) ? 2 : 1); ++rep) at::attn_phase<96>(F.tid, F.lds, A, F.vcu, F.G);
#endif
            SEAML(pb + 3);
        }
        if (IN(pb + 4)) {
            PH_BEGIN();
            gp::Gemm g{WSP(bf16_t, WS_QA), WSP(const bf16_t, WS_WPA), PROJ_FP8 ? 256 : 512, (size_t)(WS_WPB - WS_WPA) / 2, nullptr, (size_t)(WS_OB - WS_QA) / 2, 0, 0}; gp::PairOrder So; So.init(T, D, F.G, cidx);
            gp::EpiProjP E{WSP(bf16_t, WS_H), WSP(const unsigned char, WS_SA), WSP(const unsigned char, WS_SB)};
            gp::gemm_phase<gp::EpiProjP, gp::PairOrder, false, PROJ_FP8 != 0>(F.tid, F.lds, g, So, E);
            if (PROBE_DUP & (2 | 1024)) { LAUNDER_V(F.tid); gp::gemm_phase<gp::EpiProjP, gp::PairOrder, false, PROJ_FP8 != 0>(F.tid, F.lds, g, So, E); }
            SEAML(pb + 4);
        }
        if (IN(pb + 5)) {
            PH_BEGIN();
            gp::Gemm g{WSP(bf16_t, WS_H), WSP(const bf16_t, WS_WO), PROJ_FP8 ? D / 2 : D, 0, nullptr, 0, 0, 0}; gp::DenseOrder So; So.init(T, D, F.G, cidx);
            if (PROBE_DUP & 2048) { gp::EpiNull En; gp::gemm_phase<gp::EpiNull, gp::DenseOrder>(F.tid, F.lds, g, So, En); LAUNDER_V(F.tid); }
            gp::EpiWo E{WSP(const bf16_t, WS_XB), mod + (size_t)l * NB * 6 * D, WSP(bf16_t, WS_XB)}; gp::gemm_phase<gp::EpiWo, gp::DenseOrder, false, PROJ_FP8 != 0>(F.tid, F.lds, g, So, E);
            SEAML(pb + 5);
        }
        if (IN(pb + 6)) {
            PH_BEGIN();
            if (PROBE_DUP & 16) { t2_phase(F, KIN(15) + l * D, mod + (size_t)l * NB * 6 * D, KIN(16), KIN(17), l, false); LAUNDER_V(F.tid); F.lane = F.tid & 63; __syncthreads(); }
            t2_phase(F, KIN(15) + l * D, mod + (size_t)l * NB * 6 * D, KIN(16), KIN(17), l, true);
            SEAM(pb + 6);
        }
        if (IN(pb + 7)) {
            PH_BEGIN();
            LAS int* tab = moe_table(F, l);
#if MOE_FP8
            gp::Gemm g{WSP(bf16_t, WS_H), WSP(const bf16_t, WS_W13), D / 2, (size_t)1024 * D / 2, WSP(const unsigned, WS_LIST), 0, 0, 0}; gp::MoeOrder So; So.init(tab, F.G, cidx);
            gp::EpiUp E{WSP(bf16_t, WS_ACT), 1.f / 16.f}; gp::gemm_phase<gp::EpiUp, gp::MoeOrder, true, true>(F.tid, F.lds, g, So, E);
            if (PROBE_DUP & 4) { LAUNDER_V(F.tid); gp::gemm_phase<gp::EpiUp, gp::MoeOrder, true, true>(F.tid, F.lds, g, So, E); }
#else
            gp::Gemm g{WSP(bf16_t, WS_H), WSP(const bf16_t, WS_W13), D, (size_t)1024 * D, WSP(const unsigned, WS_LIST)}; gp::MoeOrder So; So.init(tab, F.G, cidx);
            gp::EpiUp E{WSP(bf16_t, WS_ACT), 1.f}; gp::gemm_phase<gp::EpiUp, gp::MoeOrder, true>(F.tid, F.lds, g, So, E);
#endif
            SEAM(pb + 7);
        }
        if (IN(pb + 8)) {
            PH_BEGIN();
            LAS int* tab = moe_table(F, l);
#if MOE_FP8
            gp::Gemm g{WSP(bf16_t, WS_ACT), WSP(const bf16_t, WS_W2), FF / 2, (size_t)D * FF / 2, nullptr, 0, 0, 0}; gp::MoeOrder So; So.init(tab, F.G, cidx);
            gp::EpiDown E{WSP(bf16_t, WS_Y2), WSP(const unsigned, WS_LIST), WSP(const float, WS_GW), 1.f / 128.f}; gp::gemm_phase<gp::EpiDown, gp::MoeOrder, false, true>(F.tid, F.lds, g, So, E);
            if (PROBE_DUP & 4) { LAUNDER_V(F.tid); gp::gemm_phase<gp::EpiDown, gp::MoeOrder, false, true>(F.tid, F.lds, g, So, E); }
#else
            gp::Gemm g{WSP(bf16_t, WS_ACT), WSP(const bf16_t, WS_W2), FF, (size_t)D * FF, nullptr}; gp::MoeOrder So; So.init(tab, F.G, cidx);
            gp::EpiDown E{WSP(bf16_t, WS_Y2), WSP(const unsigned, WS_LIST), WSP(const float, WS_GW), 1.f}; gp::gemm_phase<gp::EpiDown, gp::MoeOrder, false>(F.tid, F.lds, g, So, E);
#endif
            SEAM(pb + 8);
        }
    }
    if (IN(NPHASE - 1)) { PH_BEGIN(); row_phase<2>(F, nullptr, mod + (size_t)(NL - 1) * NB * 6 * D, KIN(21), nullptr, 0, 0, nullptr, WSP(bf16_t, WS_XB), F.OUT); }
#undef IN
#undef SEAM
#undef SEAML
}

extern "C" void kernel_launch(void* const* d_in, const int* in_sizes, int n_in, void* d_out, int out_size, void* d_ws, size_t ws_size, hipStream_t stream) {
    static int grid = 0;
    if (grid == 0) {
        if (n_in != 22 || out_size != T * D || ws_size < WS_END) { fprintf(stderr, "kernel_launch: unexpected problem (n_in %d out %d ws %zu)\n", n_in, out_size, ws_size); grid = -1; return; }
        int dev = 0, cus = 0, per_cu = 0;
        if (hipGetDevice(&dev) != hipSuccess || hipDeviceGetAttribute(&cus, hipDeviceAttributeMultiprocessorCount, dev) != hipSuccess) { grid = -1; return; }
        if (hipFuncSetAttribute((const void*)fwd_kernel, hipFuncAttributeMaxDynamicSharedMemorySize, LDS_BYTES) != hipSuccess) { grid = -1; return; }
        if (hipOccupancyMaxActiveBlocksPerMultiprocessor(&per_cu, (const void*)fwd_kernel, NTHREADS, LDS_BYTES) != hipSuccess || per_cu < 1) { fprintf(stderr, "kernel_launch: occupancy query says %d\n", per_cu); }
        (void)hipGetLastError();
        grid = cus;
        if (grid != 256 || T % (grid * NWAVES * 4) != 0) {   fprintf(stderr, "kernel_launch: grid %d does not divide the row phases\n", grid); grid = -1; return; }
    }
    if (grid < 0) return;
    (void)hipMemsetAsync((char*)d_ws + WS_CTL, 0, CTL_BYTES, stream);
    Args a{};
    for (int i = 0; i < 22; ++i) a.in[i] = (const float*)d_in[i];
    a.out = (float*)d_out; a.ws = (unsigned char*)d_ws;
#if N_LAUNCH_MODE
    for (int p = 0; p < NPHASE; ++p) { a.ph_lo = p; a.ph_hi = p + 1; hipLaunchKernelGGL(fwd_kernel, dim3(grid), dim3(NTHREADS), LDS_BYTES, stream, a); }
#else
    a.ph_lo = 0; a.ph_hi = NPHASE;
    hipLaunchKernelGGL(fwd_kernel, dim3(grid), dim3(NTHREADS), LDS_BYTES, stream, a);
#endif
}
```

```cpp
#include <hip/hip_runtime.h>
#include <stdint.h>
#include <stdio.h>
#include <math.h>

#ifndef FAST_GEMM
#define FAST_GEMM 1
#endif
#ifndef FAST_ATTN
#define FAST_ATTN 1
#endif
#ifndef PROBE_DUP
#define PROBE_DUP 0
#endif
#ifndef PROBE_ATT
#define PROBE_ATT 0
#endif
#ifndef ATT_REGSTAGE
#define ATT_REGSTAGE 0
#endif
#ifndef WT_STORES
#define WT_STORES 0
#endif
#ifndef ATT_FP8_A
#define ATT_FP8_A 1
#endif
#ifndef ATT_FP8_B
#define ATT_FP8_B 1
#endif
#ifndef MOE_FP8
#define MOE_FP8 1
#endif
#ifndef G1_FP8
#define G1_FP8 1
#endif
#ifndef PROJ_FP8
#define PROJ_FP8 1
#endif
#ifndef XCD_LOCAL_SEAMS
#define XCD_LOCAL_SEAMS 1
#endif
#ifndef N_LAUNCH_MODE
#define N_LAUNCH_MODE 0
#endif

#define LAS __attribute__((address_space(3)))
#define GAS __attribute__((address_space(1)))
typedef unsigned short bf16_t;
typedef short bf16x8 __attribute__((ext_vector_type(8)));
typedef float f32x4 __attribute__((ext_vector_type(4)));
typedef float f32x2 __attribute__((ext_vector_type(2)));
typedef float f32x16 __attribute__((ext_vector_type(16)));
typedef unsigned u32x4 __attribute__((ext_vector_type(4)));
typedef unsigned u32x2 __attribute__((ext_vector_type(2)));
typedef GAS unsigned gu32;

constexpr int D = 1024, NB = 8, S = 4096, T = NB * S, NL = 4, INC = 3488, NIN = 3584, NE = 16, FF = 512;
constexpr float EPS = 1e-6f, LOG2E = 1.4426950408889634f;
constexpr float QSCALE_A = 0.125f * LOG2E, QSCALE_B = 0.10206207261596577f * LOG2E;
constexpr float PFOLD = 4.f, PBYTE0 = 60.26f;
constexpr float OSCALE = 64.f, WSCALE = 16.f;
constexpr int NWAVES = 8, NTHREADS = 512;
constexpr int NPHASE = 2 + 9 * NL;

constexpr size_t MiB = 1u << 20;
constexpr size_t WS_CTL = 0, CTL_BYTES = 1 * MiB;
constexpr size_t WS_MOD = 1 * MiB;
constexpr size_t WS_COSA = 2 * MiB, WS_SINA = WS_COSA + 512 * 1024, WS_COSB = 3 * MiB, WS_SINB = WS_COSB + 256 * 1024;
constexpr size_t WS_SSQ = 4 * MiB, WS_SSKV = 5 * MiB;
constexpr size_t WS_GW = 6 * MiB;
constexpr size_t WS_LIST = 7 * MiB;
constexpr size_t WS_WIN = 10 * MiB, WS_WQB = 17 * MiB, WS_WKVB = 18 * MiB, WS_WPA = 19 * MiB, WS_WPB = 20 * MiB, WS_WO = 21 * MiB, WS_W13 = 23 * MiB, WS_W2 = 55 * MiB;
constexpr size_t WS_H = 72 * MiB;
constexpr size_t WS_QA = 136 * MiB, WS_KA = 168 * MiB, WS_VA = 176 * MiB, WS_QLAT = 184 * MiB, WS_KVLAT = 208 * MiB;
constexpr size_t WS_KB = 224 * MiB, WS_VB = 272 * MiB, WS_QB = 304 * MiB, WS_OB = 352 * MiB, WS_SA = 384 * MiB, WS_SB = 448 * MiB, WS_XB = 512 * MiB, WS_QA8 = 576 * MiB, WS_KA8 = 592 * MiB, WS_VTA8 = 596 * MiB, WS_QB8 = 600 * MiB, WS_KB8 = 624 * MiB, WS_VTB8 = 648 * MiB, WS_END = 664 * MiB;
constexpr size_t WS_ACT = 136 * MiB, WS_Y2 = 208 * MiB;
constexpr int ACT_ROWS = 2 * T + NE * 256;
static_assert(WS_ACT + (size_t)ACT_ROWS * FF * 2 <= WS_Y2 && WS_Y2 + (size_t)2 * T * D * 2 <= WS_XB, "moe overlay");
constexpr int CW_BAR = 4096;
constexpr int CW_CNT = 16384;

constexpr int RING_BYTES = 131072, MISC_OFF = RING_BYTES, LDS_BYTES = 147456;

__device__ __forceinline__ float bf2f(unsigned v) { return __uint_as_float(v << 16); }
typedef __bf16 bf16x2_t __attribute__((ext_vector_type(2)));
__device__ __forceinline__ unsigned cvt_pk_bf16(float lo, float hi) { f32x2 v = {lo, hi}; bf16x2_t b = __builtin_convertvector(v, bf16x2_t); return __builtin_bit_cast(unsigned, b); }
__device__ __forceinline__ u32x4 pack8(f32x4 a, f32x4 b) { u32x4 w; w.x = cvt_pk_bf16(a[0], a[1]); w.y = cvt_pk_bf16(a[2], a[3]); w.z = cvt_pk_bf16(b[0], b[1]); w.w = cvt_pk_bf16(b[2], b[3]); return w; }
__device__ __forceinline__ u32x2 pack8_fp8(f32x4 a, f32x4 b) { u32x2 w;
    w.x = (unsigned)__builtin_amdgcn_cvt_pk_fp8_f32(a[2], a[3], __builtin_amdgcn_cvt_pk_fp8_f32(a[0], a[1], 0, false), true);
    w.y = (unsigned)__builtin_amdgcn_cvt_pk_fp8_f32(b[2], b[3], __builtin_amdgcn_cvt_pk_fp8_f32(b[0], b[1], 0, false), true); return w; }
__device__ __forceinline__ u32x4 pair16(u32x2 w0, u32x2 w1) {
    const auto x = __builtin_amdgcn_permlane16_swap(w0.x, w1.x, false, false); const auto y = __builtin_amdgcn_permlane16_swap(w0.y, w1.y, false, false);
    return (u32x4){x[0], y[0], x[1], y[1]};
}
__device__ __forceinline__ void unpack8(u32x4 w, f32x4& a, f32x4& b) { a[0] = bf2f(w.x & 0xffffu); a[1] = bf2f(w.x >> 16); a[2] = bf2f(w.y & 0xffffu); a[3] = bf2f(w.y >> 16); b[0] = bf2f(w.z & 0xffffu); b[1] = bf2f(w.z >> 16); b[2] = bf2f(w.w & 0xffffu); b[3] = bf2f(w.w >> 16); }
__device__ __forceinline__ float shfl_xor_l(float v, int lane, int m) { return __int_as_float(__builtin_amdgcn_ds_bpermute((lane ^ m) << 2, __float_as_int(v))); }
__device__ __forceinline__ float shfl_l(float v, int src) { return __int_as_float(__builtin_amdgcn_ds_bpermute(src << 2, __float_as_int(v))); }
__device__ __forceinline__ float sum_xor16(float v) { const auto r = __builtin_amdgcn_permlane16_swap(__float_as_uint(v), __float_as_uint(v), false, false); return __uint_as_float(r[0]) + __uint_as_float(r[1]); }
__device__ __forceinline__ float sum_xor32(float v) { const auto r = __builtin_amdgcn_permlane32_swap(__float_as_uint(v), __float_as_uint(v), false, false); return __uint_as_float(r[0]) + __uint_as_float(r[1]); }
__device__ __forceinline__ float wave_sum(float v, int lane) {
#pragma unroll
    for (int o = 1; o < 64; o <<= 1) v += shfl_xor_l(v, lane, o);
    return v;
}
__device__ __forceinline__ float sigm(float v) { return __builtin_amdgcn_rcpf(1.f + __builtin_amdgcn_exp2f(v * (-LOG2E))); }
#if WT_STORES
__device__ __forceinline__ void st16(void* p, u32x4 v) { asm volatile("global_store_dwordx4 %0, %1, off sc1\n\ts_nop 1" :: "v"(p), "v"(v) : "memory"); }
__device__ __forceinline__ void st8(void* p, u32x2 v) { asm volatile("global_store_dwordx2 %0, %1, off sc1\n\ts_nop 1" :: "v"(p), "v"(v) : "memory"); }
#else
__device__ __forceinline__ void st16(void* p, u32x4 v) { *(u32x4*)p = v; }
__device__ __forceinline__ void st8(void* p, u32x2 v) { *(u32x2*)p = v; }
#endif
#define VM_WAIT() asm volatile("s_waitcnt vmcnt(0)" ::: "memory")
#define LAUNDER_S(p) asm volatile("" : "+s"(p))
#define LAUNDER_V(v) asm volatile("" : "+v"(v))
#define LDS_WAIT() asm volatile("s_waitcnt lgkmcnt(0)" ::: "memory")

#define XB_TMO      128
#define XB_XCNT(j)  (256  + 64 * (j))
#define XB_XSUB(j)  (1280 + 64 * (j))
#define XB_XGEN(j)  (2304 + 64 * (j))
#define XB_TOP      3328
#define XB_TOPGEN   3392
#define XCD_BAR_WORDS 3456
#define XB_LSUB(j)  (3456 + 64 * (j))
#define XB_LGEN(j)  (3456 + 1024 + 64 * (j))
#define XB_SPIN_CAP (1u << 22)
__device__ __forceinline__ unsigned xb_ld(unsigned* p)              { return __hip_atomic_load(p, __ATOMIC_RELAXED, __HIP_MEMORY_SCOPE_AGENT); }
__device__ __forceinline__ unsigned xb_add(unsigned* p, unsigned v) { return __hip_atomic_fetch_add(p, v, __ATOMIC_RELAXED, __HIP_MEMORY_SCOPE_AGENT); }
__device__ __forceinline__ unsigned xb_xcc_id() { return (unsigned)__builtin_amdgcn_s_getreg((3 << 11) | 20) & 0xFu; }
#define XB_SPIN(cond, bar) do { unsigned _sp = 0; while (cond) { __builtin_amdgcn_s_sleep(1); \
    if ((++_sp & 255u) == 0u) { if (xb_ld(&(bar)[XB_TMO])) break; if (_sp > XB_SPIN_CAP) { atomicAdd(&(bar)[XB_TMO], 1u); break; } } } } while (0)
struct XcdBarrier { unsigned* bar; unsigned x; volatile LAS unsigned* st; };
__device__ __forceinline__ XcdBarrier xcd_barrier_post(unsigned* bar, volatile LAS unsigned* st) {
    XcdBarrier b; b.bar = bar; b.x = xb_xcc_id(); b.st = st;
    if (threadIdx.x == 0) st[2] = xb_add(&bar[XB_XCNT(b.x)], 1u);
    return b;
}
__device__ __forceinline__ void xcd_barrier_complete(unsigned* bar, unsigned x, unsigned& nloc, unsigned& nx) {
    const unsigned G = gridDim.x * gridDim.y * gridDim.z;
    unsigned sum, cnt, mine, sp = 0u;
    for (;;) {
        sum = 0u; cnt = 0u; mine = 0u;
#pragma unroll
        for (unsigned j = 0; j < 16; ++j) { const unsigned c = xb_ld(&bar[XB_XCNT(j)]); sum += c; cnt += (c > 0u) ? 1u : 0u; mine = (j == x) ? c : mine; }
        if (sum == G) break;
        __builtin_amdgcn_s_sleep(1);
        if ((++sp & 255u) == 0u) { if (xb_ld(&bar[XB_TMO])) break; if (sp > XB_SPIN_CAP) { atomicAdd(&bar[XB_TMO], 1u); break; } }
    }
    nloc = mine > 0u ? mine : 1u; nx = cnt > 0u ? cnt : 1u;
}
__device__ __forceinline__ void xcd_barrier(const XcdBarrier& b) {
    asm volatile("s_waitcnt vmcnt(0)" ::: "memory");
    __syncthreads();
    if (threadIdx.x == 0) {
        unsigned* bar = b.bar;
        __builtin_amdgcn_s_waitcnt(0);
        unsigned nloc = b.st[0], nx = b.st[1];
        if (nloc == 0u) { xcd_barrier_complete(bar, b.x, nloc, nx); b.st[0] = nloc; b.st[1] = nx; }
        const unsigned old = xb_add(&bar[XB_XSUB(b.x)], 1u);
        const unsigned gen = old / nloc;
        if (old + 1u == (gen + 1u) * nloc) {
            __builtin_amdgcn_fence(__ATOMIC_RELEASE, "agent");
            asm volatile("s_waitcnt vmcnt(0)" ::: "memory");
            const unsigned og = xb_add(&bar[XB_TOP], 1u);
            const unsigned tg = og / nx;
            if (og + 1u == (tg + 1u) * nx) xb_add(&bar[XB_TOPGEN], 1u);
            else XB_SPIN(xb_ld(&bar[XB_TOPGEN]) == tg, bar);
            __builtin_amdgcn_fence(__ATOMIC_ACQUIRE, "agent");
            xb_add(&bar[XB_XGEN(b.x)], 1u);
            asm volatile("s_waitcnt vmcnt(0)" ::: "memory");
        } else {
            XB_SPIN(xb_ld(&bar[XB_XGEN(b.x)]) == gen, bar);
            __builtin_amdgcn_fence(__ATOMIC_ACQUIRE, "agent");
            asm volatile("s_waitcnt vmcnt(0)" ::: "memory");
        }
    }
    __syncthreads();
}

namespace gp {
constexpr int BM = 256, BK = 64, HALF = 128, HTB = HALF * BK * 2, NXCD = 8, WGM = 8;
__host__ __device__ __forceinline__ int lds_byte(int r, int c) { const int st = (r >> 4) * 2 + (c >> 5), rr = r & 15, cc = c & 31, ob = rr * 64 + cc * 2; return st * 1024 + (ob ^ (((ob >> 9) & 1) << 5)); }
__host__ __device__ __forceinline__ void stage_rc(int b, int& R, int& C) { const int st = b / 1024, sb = b % 1024, swz = sb ^ (((sb >> 9) & 1) << 5); R = (st >> 1) * 16 + swz / 64; C = (st & 1) * 32 + (swz % 64) / 2; }
__host__ __device__ __forceinline__ int perm32(int rho) { const int n = rho >> 4, i = rho & 15; return 8 * (i >> 2) + 4 * n + (i & 3); }

struct Unit { int pm, pn, be, rl, nv; };
struct Gemm { const bf16_t* A; const bf16_t* Bt; int K; size_t bstride; const unsigned* list; size_t astride; int sw, sx; };

__device__ __forceinline__ int xcd_remap(int wgid, int nwg) { const int q = nwg / NXCD, r = nwg % NXCD, xcd = wgid % NXCD, off = wgid / NXCD; return (xcd < r ? xcd * (q + 1) : r * (q + 1) + (xcd - r) * q) + off; }
struct DenseOrder {
    int nM, nN, nwg, G, c;
    __device__ void init(int M, int N, int G_, int c_) { nM = M / BM; nN = N / BM; nwg = nM * nN; G = G_; c = c_; }
    __device__ bool next(int i, Unit& u) const {
        const int L = i * G + c; if (L >= nwg) return false;
        const int wgid = xcd_remap((int)L, nwg);
        const int nig = WGM * nN, gid = wgid / nig, fm = gid * WGM, gsz = (nM - fm) < WGM ? (nM - fm) : WGM;
        u.pm = fm + ((wgid % nig) % gsz); u.pn = (wgid % nig) / gsz; u.be = 0; u.rl = 0; u.nv = 256; return true;
    }
};
struct PairOrder {
    DenseOrder d;
    __device__ void init(int M, int N, int G_, int c_) { d.init(M, N, G_, c_); }
    __device__ bool next(int i, Unit& u) const { if (!d.next(i >> 1, u)) return false; u.be = i & 1; return true; }
};
struct MoeOrder {
    const LAS int* tab; int nwg, G, c;
    __device__ static int rd(const LAS int* p) { return __builtin_amdgcn_readfirstlane(*p); }
    __device__ void init(const LAS int* tab_, int G_, int c_) { tab = tab_; nwg = rd(tab_ + 16) * 4; G = G_; c = c_; }
    __device__ bool next(int i, Unit& u) const {
        const int ntl = nwg >> 2, x_ = c & 7, tlo = (ntl * x_) >> 3, thi = (ntl * (x_ + 1)) >> 3;
        const int j_ = i * (G >> 3) + (c >> 3); const int tile = tlo + (j_ >> 2); if (tile >= thi) return false;
        const int wgid = tile * 4 + (j_ & 3); int e = 0;
        for (int k = 1; k < NE; ++k) { const int tk = rd(tab + k); e = (tk <= tile) ? k : e; }
        e = __builtin_amdgcn_readfirstlane(e);
        u.pm = tile; u.pn = wgid & 3; u.be = e; u.rl = tile - rd(tab + e); const int rem = rd(tab + 32 + e) - u.rl * 256; u.nv = rem < 256 ? rem : 256; return true;
    }
};

#define ACC_T f32x4 (&acc)[2][2][4][2]

template <class Epi, class Sched, bool GATHER>
__device__ __forceinline__ void gemm_phase_ref(int tid, const Gemm g, const Sched& S, const Epi& E) {
    const int wid = __builtin_amdgcn_readfirstlane(tid >> 6), lane = tid & 63, wr = wid >> 2, wc = wid & 3, fr = lane & 15, fq = lane >> 4;
    const int K = g.K; Unit u;
    for (int ui = 0; S.next(ui, u); ++ui) {
        f32x4 acc[2][2][4][2];
#pragma unroll
        for (int a = 0; a < 2; ++a)
#pragma unroll
            for (int b = 0; b < 2; ++b)
#pragma unroll
                for (int m = 0; m < 4; ++m)
#pragma unroll
                    for (int n = 0; n < 2; ++n) acc[a][b][m][n] = (f32x4){0.f, 0.f, 0.f, 0.f};
        const bf16_t* Bt = g.Bt + (size_t)u.be * g.bstride + (size_t)u.pn * 256 * K;
        for (int ai = 0; ai < 2; ++ai)
            for (int m = 0; m < 4; ++m) {
                const int rloc = ai * 128 + wr * 64 + m * 16 + fr;
                size_t arow;
                if (GATHER) { arow = (rloc < u.nv) ? (size_t)(g.list[(size_t)u.be * T + u.rl * 256 + rloc] >> 1) : 0; }
                else arow = (size_t)u.pm * 256 + rloc;
                const bf16_t* ap = g.A + arow * K;
                for (int bj = 0; bj < 2; ++bj) {
                    const bf16_t* bp = Bt + (size_t)(bj * 128 + wc * 32 + fq * 8) * K;
                    float s[8];
#pragma unroll
                    for (int c = 0; c < 8; ++c) {
                        float sc = 0.f; const bf16_t* bpc = bp + (size_t)c * K;
#pragma unroll 2
                        for (int k = 0; k < K; k += 8) {
                            f32x4 a0, a1, b0, b1; unpack8(*(const u32x4*)(ap + k), a0, a1); unpack8(*(const u32x4*)(bpc + k), b0, b1);
                            sc += a0[0] * b0[0] + a0[1] * b0[1] + a0[2] * b0[2] + a0[3] * b0[3] + a1[0] * b1[0] + a1[1] * b1[1] + a1[2] * b1[2] + a1[3] * b1[3];
                        }
                        s[c] = sc; asm volatile("" : "+v"(s[c]));
                    }
#pragma unroll
                    for (int a2 = 0; a2 < 2; ++a2)
#pragma unroll
                        for (int b2 = 0; b2 < 2; ++b2)
#pragma unroll
                            for (int m2 = 0; m2 < 4; ++m2)
                                if (a2 == ai && b2 == bj && m2 == m) { acc[a2][b2][m2][0] = (f32x4){s[0], s[1], s[2], s[3]}; acc[a2][b2][m2][1] = (f32x4){s[4], s[5], s[6], s[7]}; }
                }
            }
        E(acc, u, wr, wc, fr, fq);
    }
}

template <class E> struct EpiTraits { static constexpr bool KEEP = false; };
#if FAST_GEMM
typedef int v8i_t __attribute__((ext_vector_type(8)));
__device__ __forceinline__ unsigned gp_voffb(int tid, int i, int K) { int t_ = tid; LAUNDER_V(t_); int R, C; stage_rc(t_ * 16 + i * 8192, R, C); const int Rb = (R & ~31) + perm32(R & 31); return (unsigned)(Rb * K + C) * 2u; }
template <class Epi, class Sched, bool GATHER, bool F8>
__device__ __forceinline__ void gemm_phase_fast(int tid, LAS unsigned char* lds, const Gemm g, const Sched& S, const Epi& E) {
    const int wid = __builtin_amdgcn_readfirstlane(tid >> 6), lane = tid & 63, wr = wid >> 2, wc = wid & 3, fr = lane & 15, fq = lane >> 4;
    const int K = g.K, nt = K / BK;
    int Rr[2], Cc[2]; unsigned voffB[2];
#pragma unroll
    for (int i = 0; i < 2; ++i) { stage_rc(tid * 16 + i * 8192, Rr[i], Cc[i]); const int Rb = (Rr[i] & ~31) + perm32(Rr[i] & 31); voffB[i] = (unsigned)(Rb * K + Cc[i]) * 2u; }
#define GP_VB(i) (F8 ? gp_voffb(tid, (i), K) : voffB[i])
    const size_t kstep = (size_t)(BK * 2), hstep = (size_t)HALF * K * 2, tstep = 2 * hstep, r64 = (size_t)64 * K * 2;
    const unsigned ldsw = (unsigned)wid * 1024u;
    const int aoff = lds_byte(wr * 64 + fr, fq * 8), boff = lds_byte(wc * 32 + fr, fq * 8);
#define GP_UNI(p) ((const char*)(((unsigned long long)(unsigned)__builtin_amdgcn_readfirstlane((int)((unsigned long long)(p) >> 32)) << 32) | (unsigned)__builtin_amdgcn_readfirstlane((int)(unsigned long long)(p))))
#define GP_SA(b, h) (((b) * 2 + (h)) * HTB)
#define GP_SB(b, h) ((4 + (b) * 2 + (h)) * HTB)
#define GP_DMA(sbase, voff, ldsdst) do { unsigned keep_; asm volatile("s_mov_b32 %0, m0\n\ts_mov_b32 m0, %3\n\ts_nop 0\n\tglobal_load_lds_dwordx4 %1, %2\n\ts_mov_b32 m0, %0" \
        : "=&s"(keep_) : "v"(voff), "s"(sbase), "s"((unsigned)__builtin_amdgcn_readfirstlane((int)(unsigned)(uintptr_t)(ldsdst))) : "memory"); } while (0)
#define GP_STAGE2(bufoff, gbase, v0, v1) do { const char* gb_ = (gbase); GP_DMA(gb_, (v0), lds + (bufoff) + ldsw); GP_DMA(gb_, (v1), lds + (bufoff) + ldsw + 8192); } while (0)
#define GP_STAGEB(bufoff, gbase) do { if constexpr (F8) { const unsigned vb_ = GP_VB(0); const char* gb_ = (gbase); GP_DMA(gb_, vb_, lds + (bufoff) + ldsw); GP_DMA(gb_ + r64, vb_, lds + (bufoff) + ldsw + 8192); } else { GP_STAGE2(bufoff, gbase, GP_VB(0), GP_VB(1)); } } while (0)
#define GP_STAGEB2(bufoff0, bufoff1, gbase) do { if constexpr (F8 && !GATHER) { const unsigned vb_ = GP_VB(0); const char* gb_ = (gbase); GP_DMA(gb_, vb_, lds + (bufoff0) + ldsw); GP_DMA(gb_ + r64, vb_, lds + (bufoff0) + ldsw + 8192); \
        GP_DMA(gb_ + hstep, vb_, lds + (bufoff1) + ldsw); GP_DMA(gb_ + hstep + r64, vb_, lds + (bufoff1) + ldsw + 8192); } else { GP_STAGEB(bufoff0, gbase); GP_STAGEB(bufoff1, (gbase) + hstep); } } while (0)
#define GP_CAT8(x0, x1) __builtin_bit_cast(v8i_t, __builtin_shufflevector(x0, x1, 0, 1, 2, 3, 4, 5, 6, 7, 8, 9, 10, 11, 12, 13, 14, 15))
#define GP_LDA(dst, b, h) do { _Pragma("unroll") for (int m = 0; m < 4; ++m) _Pragma("unroll") for (int k = 0; k < 2; ++k) dst[m][k] = *(const LAS bf16x8*)(lds + GP_SA(b, h) + aoff + m * 2048 + k * 1024); \
        if constexpr (F8) { _Pragma("unroll") for (int m = 0; m < 4; ++m) dst##8[m] = GP_CAT8(dst[m][0], dst[m][1]); } } while (0)
#define GP_LDB(dst, b, h) do { _Pragma("unroll") for (int n = 0; n < 2; ++n) _Pragma("unroll") for (int k = 0; k < 2; ++k) dst[n][k] = *(const LAS bf16x8*)(lds + GP_SB(b, h) + boff + n * 2048 + k * 1024); \
        if constexpr (F8) { _Pragma("unroll") for (int n = 0; n < 2; ++n) dst##8[n] = GP_CAT8(dst[n][0], dst[n][1]); } } while (0)
#define GP_MMA(ai, bj, At, Bt) do { __builtin_amdgcn_s_setprio(1); \
        if constexpr (F8) { _Pragma("unroll") for (int m = 0; m < 4; ++m) _Pragma("unroll") for (int n = 0; n < 2; ++n) \
            acc[ai][bj][m][n] = __builtin_amdgcn_mfma_scale_f32_16x16x128_f8f6f4(Bt##8[n], At##8[m], acc[ai][bj][m][n], 0, 0, 0, 0, 0, 0); }     \
        else { _Pragma("unroll") for (int m = 0; m < 4; ++m) _Pragma("unroll") for (int n = 0; n < 2; ++n) _Pragma("unroll") for (int k = 0; k < 2; ++k) \
            acc[ai][bj][m][n] = __builtin_amdgcn_mfma_f32_16x16x32_bf16(Bt[n][k], At[m][k], acc[ai][bj][m][n], 0, 0, 0); } \
        __builtin_amdgcn_s_setprio(0); } while (0)
#define GP_WAIT_V(n) asm volatile("s_waitcnt vmcnt(" #n ")" ::: "memory")
#define GP_WAIT_L(n) asm volatile("s_waitcnt lgkmcnt(" #n ")" ::: "memory")
#define GP_BAR __builtin_amdgcn_s_barrier()
#define GP_SCHED __builtin_amdgcn_sched_barrier(0)
    Unit cur, nxt; int ui = 0;
    if (!S.next(0, cur)) return;
    f32x4 acc[2][2][4][2];
#pragma unroll
    for (int a = 0; a < 2; ++a)
#pragma unroll
        for (int b = 0; b < 2; ++b)
#pragma unroll
            for (int m = 0; m < 4; ++m)
#pragma unroll
                for (int n = 0; n < 2; ++n) acc[a][b][m][n] = (f32x4){0.f, 0.f, 0.f, 0.f};
    bf16x8 At[4][2], B0[2][2], B1[2][2];
    v8i_t At8[4], B08[2], B18[2];
    unsigned vC0, vC1, vC2, vC3, vN0, vN1, vN2, vN3;
#define GP_VOFF(u, o0, o1, o2, o3) do { if (GATHER) { \
        int tl_ = tid; LAUNDER_V(tl_); int R0_, C0_, R1_, C1_; stage_rc(tl_ * 16, R0_, C0_); stage_rc(tl_ * 16 + 8192, R1_, C1_);     \
        const unsigned* lp = g.list + (size_t)(u).be * T + (u).rl * 256; \
        const int nvm = (u).nv - 1; const int p0 = min(R0_, nvm), p1 = min(R1_, nvm), p2 = min(128 + R0_, nvm), p3 = min(128 + R1_, nvm); \
        const unsigned t0 = lp[p0] >> 1, t1 = lp[p1] >> 1, t2 = lp[p2] >> 1, t3 = lp[p3] >> 1; \
        o0 = (t0 * K + C0_) * 2u; o1 = (t1 * K + C1_) * 2u; o2 = (t2 * K + C0_) * 2u; o3 = (t3 * K + C1_) * 2u; \
      } else { o0 = (unsigned)(Rr[0] * K + Cc[0]) * 2u; o1 = (unsigned)(Rr[1] * K + Cc[1]) * 2u; o2 = o0 + (unsigned)hstep; o3 = o1 + (unsigned)hstep; } } while (0)
    GP_VOFF(cur, vC0, vC1, vC2, vC3);
    const char* cA = GP_UNI((const char*)g.A + ((size_t)cur.be * g.astride) * 2 + (GATHER ? (size_t)0 : (size_t)cur.pm * tstep));
    const char* cB = GP_UNI((const char*)g.Bt + ((size_t)cur.be * g.bstride) * 2 + (size_t)cur.pn * tstep);
    GP_STAGEB(GP_SB(0, 0), cB); GP_STAGEB(GP_SB(0, 1), cB + hstep); GP_STAGE2(GP_SA(0, 0), cA, vC0, vC1); GP_STAGE2(GP_SA(0, 1), cA, vC2, vC3);
    if (wr == 1) GP_BAR;
    GP_WAIT_V(2); GP_BAR;
    GP_STAGEB(GP_SB(1, 0), cB + kstep); GP_STAGE2(GP_SA(1, 0), cA + kstep, vC0, vC1); GP_STAGEB(GP_SB(1, 1), cB + hstep + kstep);
    GP_WAIT_V(6); GP_BAR;
    for (;;) {
        const bool has_next = S.next(ui + 1, nxt);
        const char* nA = GP_UNI(has_next ? (const char*)g.A + ((size_t)nxt.be * g.astride) * 2 + (GATHER ? (size_t)0 : (size_t)nxt.pm * tstep) : cA);
        const char* nB = GP_UNI(has_next ? (const char*)g.Bt + ((size_t)nxt.be * g.bstride) * 2 + (size_t)nxt.pn * tstep : cB);
        if (GATHER) {
            if (has_next) { GP_VOFF(nxt, vN0, vN1, vN2, vN3); } else { vN0 = vC0; vN1 = vC1; vN2 = vC2; vN3 = vC3; }
            *(LAS u32x4*)(lds + MISC_OFF + 2048 + tid * 16) = (u32x4){vN0, vN1, vN2, vN3};
        } else { vN0 = vC0; vN1 = vC1; vN2 = vC2; vN3 = vC3; }
#pragma nounroll
        for (int t = 0; t < nt; t += 2) {
            LAUNDER_S(cA); LAUNDER_S(cB); LAUNDER_S(nA); LAUNDER_S(nB);
            const bool last = (t == nt - 2);
            if (GATHER) { if (last) { const u32x4 q_ = *(const LAS u32x4*)(lds + MISC_OFF + 2048 + tid * 16); vN0 = q_.x; vN1 = q_.y; vN2 = q_.z; vN3 = q_.w; } }
            const char* a1 = cA + (size_t)(t + 1) * kstep;
            const char* a2 = last ? nA : cA + (size_t)(t + 2) * kstep; const char* b2 = last ? nB : cB + (size_t)(t + 2) * kstep;
            const char* a3 = a2 + kstep; const char* b3 = b2 + kstep;
            const unsigned w0 = last ? vN0 : vC0, w1 = last ? vN1 : vC1, w2 = last ? vN2 : vC2, w3 = last ? vN3 : vC3;
            GP_LDB(B0, 0, 0); GP_LDB(B1, 0, 1); GP_SCHED; GP_LDA(At, 0, 0); GP_STAGE2(GP_SA(1, 1), a1, vC2, vC3);
            GP_WAIT_V(8); GP_WAIT_L(0); GP_BAR; GP_MMA(0, 0, At, B0); GP_MMA(0, 1, At, B1); GP_BAR; GP_SCHED;
            GP_LDA(At, 0, 1); GP_STAGEB2(GP_SB(0, 0), GP_SB(0, 1), b2); GP_STAGE2(GP_SA(0, 0), a2, w0, w1);
            GP_WAIT_V(8); GP_WAIT_L(0); GP_BAR; GP_MMA(1, 0, At, B0); GP_MMA(1, 1, At, B1); GP_BAR; GP_SCHED;
            GP_LDB(B0, 1, 0); GP_LDB(B1, 1, 1); GP_SCHED; GP_LDA(At, 1, 0); GP_STAGE2(GP_SA(0, 1), a2, w2, w3);
            GP_WAIT_V(8); GP_WAIT_L(0); GP_BAR; GP_MMA(0, 0, At, B0); GP_MMA(0, 1, At, B1); GP_BAR; GP_SCHED;
            GP_LDA(At, 1, 1); GP_STAGEB2(GP_SB(1, 0), GP_SB(1, 1), b3); GP_STAGE2(GP_SA(1, 0), a3, w0, w1);
            GP_WAIT_V(8); GP_WAIT_L(0); GP_BAR; GP_MMA(1, 0, At, B0); GP_MMA(1, 1, At, B1); GP_BAR; GP_SCHED;
        }
        if (wr == 0) GP_BAR;
        { int tl_ = tid; LAUNDER_V(tl_); const int fr_ = tl_ & 15, fq_ = (tl_ & 63) >> 4;
          E(acc, cur, wr, wc, fr_, fq_); }
        if (!has_next) break;
        if (!(EpiTraits<Epi>::KEEP && cur.be == 0)) {
#pragma unroll
        for (int a = 0; a < 2; ++a)
#pragma unroll
            for (int b = 0; b < 2; ++b)
#pragma unroll
                for (int m = 0; m < 4; ++m)
#pragma unroll
                    for (int n = 0; n < 2; ++n) acc[a][b][m][n] = (f32x4){0.f, 0.f, 0.f, 0.f};
        }
        cur = nxt; cA = nA; cB = nB; vC0 = vN0; vC1 = vN1; vC2 = vN2; vC3 = vN3; ++ui;
        if (wr == 1) GP_BAR;
    }
    GP_WAIT_V(0);
    GP_BAR;
#undef GP_UNI
#undef GP_SA
#undef GP_SB
#undef GP_STAGE2
#undef GP_DMA
#undef GP_STAGEB
#undef GP_STAGEB2
#undef GP_VB
#undef GP_LDA
#undef GP_LDB
#undef GP_MMA
#undef GP_CAT8
#undef GP_WAIT_V
#undef GP_WAIT_L
#undef GP_BAR
#undef GP_SCHED
#undef GP_VOFF
}
#endif

template <class Epi, class Sched, bool GATHER = false, bool F8 = false>
__device__ __forceinline__ void gemm_phase(int tid, LAS unsigned char* lds, const Gemm g, const Sched& S, const Epi& E) {
#if FAST_GEMM
    gemm_phase_fast<Epi, Sched, GATHER, F8>(tid, lds, g, S, E);
#else
    (void)lds; gemm_phase_ref<Epi, Sched, GATHER>(tid, g, S, E);
#endif
}

#define EPI_ROW(ai, m) (u.pm * 256 + (ai) * 128 + wr * 64 + (m) * 16 + fr)
#define EPI_COL(bj) (u.pn * 256 + (bj) * 128 + wc * 32 + fq * 8)
__device__ __forceinline__ float dot4(f32x4 a) { return (a[0] * a[0] + a[1] * a[1]) + (a[2] * a[2] + a[3] * a[3]); }

struct EpiNull {
    __device__ __forceinline__ void operator()(const ACC_T, const Unit& u, int wr, int wc, int fr, int fq) const {
#pragma unroll
        for (int ai = 0; ai < 2; ++ai)
#pragma unroll
            for (int bj = 0; bj < 2; ++bj)
#pragma unroll
                for (int m = 0; m < 4; ++m) asm volatile("" :: "v"(acc[ai][bj][m][0]), "v"(acc[ai][bj][m][1]));
    }
};
struct EpiIn {
    bf16_t *QA, *KA, *VA, *QLAT, *KVLAT, *KB, *SA, *SB; float *SSQ, *SSKV; const float *gq, *gk, *cosA, *sinA, *cosB, *sinB;
    __device__ __forceinline__ void operator()(const ACC_T, const Unit& u, int wr, int wc, int fr, int fq) const {
        const int wb = u.pn * 4 + wc;
        if (wb < 10) {
            const bool isq = wb < 8; const int head = isq ? wb : wb - 8; const float* g = isq ? gq : gk; bf16_t* dst = isq ? QA : KA; const int dp = isq ? 512 : 128; const float qs = isq ? QSCALE_A * (ATT_FP8_A ? PFOLD : 1.f) : 1.f;
            const f32x4 g00 = *(const f32x4*)(g + 8 * fq), g01 = *(const f32x4*)(g + 8 * fq + 4), g10 = *(const f32x4*)(g + 32 + 8 * fq), g11 = *(const f32x4*)(g + 36 + 8 * fq);
#pragma unroll
            for (int ai = 0; ai < 2; ++ai)
#pragma unroll
                for (int m = 0; m < 4; ++m) {
                    const int r = EPI_ROW(ai, m), pos = r & (S - 1);
                    const f32x4 v00 = acc[ai][0][m][0], v01 = acc[ai][0][m][1], v10 = acc[ai][1][m][0], v11 = acc[ai][1][m][1];
                    float ss = (dot4(v00) + dot4(v01)) + (dot4(v10) + dot4(v11)); ss = sum_xor16(ss); ss = sum_xor32(ss);
                    const float rstd = rsqrtf(ss * (1.f / 64.f) + EPS);
                    const f32x4 y00 = v00 * rstd * g00, y01 = v01 * rstd * g01, y10 = v10 * rstd * g10, y11 = v11 * rstd * g11;
                    const f32x4 c0 = *(const f32x4*)(cosA + pos * 32 + 8 * fq), c1 = *(const f32x4*)(cosA + pos * 32 + 8 * fq + 4), s0 = *(const f32x4*)(sinA + pos * 32 + 8 * fq), s1 = *(const f32x4*)(sinA + pos * 32 + 8 * fq + 4);
                    const f32x4 o00 = (y00 * c0 - y10 * s0) * qs, o01 = (y01 * c1 - y11 * s1) * qs, o10 = (y10 * c0 + y00 * s0) * qs, o11 = (y11 * c1 + y01 * s1) * qs;
#if ATT_FP8_A
                    unsigned char* p8 = (unsigned char*)dst + (size_t)r * dp + head * 64 + 8 * fq;
                    st16(p8 + (fq & 1) * 32 - (fq & 1) * 8, pair16(pack8_fp8(o00, o01), pack8_fp8(o10, o11)));
#else
                    bf16_t* p = dst + (size_t)r * dp + head * 64 + 8 * fq;
                    st16(p, pack8(o00, o01)); st16((p + 32), pack8(o10, o11));
#endif
                }
        } else if (wb < 12) {
#pragma unroll
            for (int ai = 0; ai < 2; ++ai)
#pragma unroll
                for (int m = 0; m < 4; ++m) {
#if ATT_FP8_A
                    const int r = EPI_ROW(ai, m), sq = r & (S - 1), k = sq & 63, pos = 32 * ((k >> 2) & 1) + 16 * (k >> 5) + (k & 3) + 4 * ((k & 31) >> 3);
                    unsigned char* vtb = (unsigned char*)VA; const unsigned vo = (unsigned)(((r >> 12) * 2 + (wb - 10)) * 64 + 8 * fq) * S + (unsigned)((sq & ~63) + pos);
#pragma unroll
                    for (int bj = 0; bj < 2; ++bj)
#pragma unroll
                        for (int n = 0; n < 2; ++n) { const f32x4 x = acc[ai][bj][m][n]; const unsigned w = (unsigned)__builtin_amdgcn_cvt_pk_fp8_f32(x[2], x[3], __builtin_amdgcn_cvt_pk_fp8_f32(x[0], x[1], 0, false), true);
                            const unsigned qo = vo + (unsigned)(bj * 32 + 4 * n) * S;
                            vtb[qo] = (unsigned char)(w & 0xffu); vtb[qo + S] = (unsigned char)((w >> 8) & 0xffu); vtb[qo + 2 * S] = (unsigned char)((w >> 16) & 0xffu); vtb[qo + 3 * S] = (unsigned char)(w >> 24); }
#else
                    bf16_t* p = VA + (size_t)EPI_ROW(ai, m) * 128 + (wb - 10) * 64 + 8 * fq;
                    st16(p, pack8(acc[ai][0][m][0], acc[ai][0][m][1])); st16((p + 32), pack8(acc[ai][1][m][0], acc[ai][1][m][1]));
#endif
                }
        } else if (wb < 22) {
            const bool isq = wb < 18; const int idx = isq ? wb - 12 : wb - 18; bf16_t* dst = isq ? QLAT : KVLAT; const int dp = isq ? 384 : 256;
#pragma unroll
            for (int ai = 0; ai < 2; ++ai)
#pragma unroll
                for (int m = 0; m < 4; ++m) {
                    const int r = EPI_ROW(ai, m);
                    const f32x4 v00 = acc[ai][0][m][0], v01 = acc[ai][0][m][1], v10 = acc[ai][1][m][0], v11 = acc[ai][1][m][1];
                    float ss = (dot4(v00) + dot4(v01)) + (dot4(v10) + dot4(v11)); ss = sum_xor16(ss); ss = sum_xor32(ss);
                    if (fq == 0) { if (isq) SSQ[(size_t)r * 8 + idx] = ss; else SSKV[(size_t)r * 4 + idx] = ss; }
                    bf16_t* p = dst + (size_t)r * dp + idx * 64 + 8 * fq;
                    st16(p, pack8(v00, v01)); st16((p + 32), pack8(v10, v11));
                }
        } else if (wb == 22) {
            if (fq < 2) {
#pragma unroll
                for (int ai = 0; ai < 2; ++ai)
#pragma unroll
                    for (int m = 0; m < 4; ++m) {
                        const int r = EPI_ROW(ai, m), pos = r & (S - 1);
                        const f32x4 x10 = acc[ai][0][m][0], x11 = acc[ai][0][m][1], x20 = acc[ai][1][m][0], x21 = acc[ai][1][m][1];
                        const f32x4 c0 = *(const f32x4*)(cosB + pos * 16 + 8 * fq), c1 = *(const f32x4*)(cosB + pos * 16 + 8 * fq + 4), s0 = *(const f32x4*)(sinB + pos * 16 + 8 * fq), s1 = *(const f32x4*)(sinB + pos * 16 + 8 * fq + 4);
#if ATT_FP8_B
                        const u32x2 w1 = pack8_fp8(x10 * c0 - x20 * s0, x11 * c1 - x21 * s1), w2 = pack8_fp8(x20 * c0 + x10 * s0, x21 * c1 + x11 * s1);
                        unsigned char* p = (unsigned char*)KB + (size_t)r * 768 + 64 + 8 * fq;
#pragma unroll
                        for (int h = 0; h < 8; ++h) { st8(p + h * 96, w1); st8(p + h * 96 + 16, w2); }
#else
                        const u32x4 w1 = pack8(x10 * c0 - x20 * s0, x11 * c1 - x21 * s1), w2 = pack8(x20 * c0 + x10 * s0, x21 * c1 + x11 * s1);
                        bf16_t* p = KB + (size_t)r * 768 + 64 + 8 * fq;
#pragma unroll
                        for (int h = 0; h < 8; ++h) { st16((p + h * 96), w1); st16((p + h * 96 + 16), w2); }
#endif
                    }
            }
        } else if (wb == 23) {
        } else {
            const bool isa = wb < 40; const int idx = isa ? wb - 24 : wb - 40; unsigned char* dst = (unsigned char*)(isa ? SA : SB);
#pragma unroll
            for (int ai = 0; ai < 2; ++ai)
#pragma unroll
                for (int m = 0; m < 4; ++m) { unsigned char* p = dst + (size_t)EPI_ROW(ai, m) * 1024 + idx * 64 + (fq & 1) * 32 + 8 * (fq & ~1);
                    st16(p, pair16(pack8_fp8(acc[ai][0][m][0], acc[ai][0][m][1]), pack8_fp8(acc[ai][1][m][0], acc[ai][1][m][1]))); }
        }
    }
};
__host__ __device__ __forceinline__ int src_col_in(int n) {
    const int pn = n >> 8, nl = n & 255, bj = nl >> 7, wc = (nl & 127) >> 5, p = nl & 31, wb = pn * 4 + wc, s = bj * 32 + p;
    if (wb < 8) return wb * 64 + s;
    if (wb < 10) return 512 + (wb - 8) * 64 + s;
    if (wb < 12) return 640 + (wb - 10) * 64 + s;
    if (wb < 18) return 768 + (wb - 12) * 64 + s;
    if (wb < 22) return 1152 + (wb - 18) * 64 + s;
    if (wb == 22) return p < 16 ? 1408 + bj * 16 + p : -1;
    if (wb == 23) return -1;
    if (wb < 40) return 1440 + (wb - 24) * 64 + s;
    return 2464 + (wb - 40) * 64 + s;
}
struct EpiQb {
    bf16_t* QB; const float *SSQ, *cosB, *sinB;
    __device__ __forceinline__ void operator()(const ACC_T, const Unit& u, int wr, int wc, int fr, int fq) const {
#pragma unroll
        for (int ai = 0; ai < 2; ++ai)
#pragma unroll
            for (int m = 0; m < 4; ++m) {
                const int r = EPI_ROW(ai, m), pos = r & (S - 1);
                const f32x4 sa = *(const f32x4*)(SSQ + (size_t)r * 8); const f32x2 sb = *(const f32x2*)(SSQ + (size_t)r * 8 + 4);
                const float rstd = rsqrtf((((sa[0] + sa[1]) + (sa[2] + sa[3])) + (sb[0] + sb[1])) * (1.f / 384.f) + EPS);
                u32x2 wq[2];
#pragma unroll
                for (int bj = 0; bj < 2; ++bj) {
                    f32x4 v0 = acc[ai][bj][m][0] * rstd, v1 = acc[ai][bj][m][1] * rstd;
                    const int c32 = u.pn * 8 + bj * 4 + wc;
                    if (c32 % 3 == 2) {
                        f32x4 o0, o1;
#pragma unroll
                        for (int j = 0; j < 4; ++j) { const auto ra = __builtin_amdgcn_permlane32_swap(__float_as_uint(v0[j]), __float_as_uint(v0[j]), false, false), rb = __builtin_amdgcn_permlane32_swap(__float_as_uint(v1[j]), __float_as_uint(v1[j]), false, false);
                            o0[j] = __uint_as_float(fq < 2 ? ra[1] : ra[0]); o1[j] = __uint_as_float(fq < 2 ? rb[1] : rb[0]); }
                        const int i0 = 8 * (fq & 1);
                        const f32x4 c0 = *(const f32x4*)(cosB + pos * 16 + i0), c1 = *(const f32x4*)(cosB + pos * 16 + i0 + 4), s0 = *(const f32x4*)(sinB + pos * 16 + i0), s1 = *(const f32x4*)(sinB + pos * 16 + i0 + 4);
                        if (fq < 2) { v0 = v0 * c0 - o0 * s0; v1 = v1 * c1 - o1 * s1; } else { v0 = v0 * c0 + o0 * s0; v1 = v1 * c1 + o1 * s1; }
                    }
#if ATT_FP8_B
                    wq[bj] = pack8_fp8(v0 * (QSCALE_B * PFOLD), v1 * (QSCALE_B * PFOLD));
#else
                    st16((QB + (size_t)r * 768 + EPI_COL(bj)), pack8(v0 * QSCALE_B, v1 * QSCALE_B));
#endif
                }
#if ATT_FP8_B
                st16((unsigned char*)QB + (size_t)r * 768 + u.pn * 256 + (fq & 1) * 128 + wc * 32 + 8 * (fq & ~1), pair16(wq[0], wq[1]));
#endif
            }
    }
};
struct EpiKvb {
    bf16_t *KB, *VB; const float* SSKV;
    __device__ __forceinline__ void operator()(const ACC_T, const Unit& u, int wr, int wc, int fr, int fq) const {
#pragma unroll
        for (int ai = 0; ai < 2; ++ai) {
            f32x4 sq[4];
#pragma unroll
            for (int m = 0; m < 4; ++m) sq[m] = *(const f32x4*)(SSKV + (size_t)EPI_ROW(ai, m) * 4);
            asm volatile("" : "+v"(sq[0]), "+v"(sq[1]), "+v"(sq[2]), "+v"(sq[3]));
#pragma unroll
            for (int m = 0; m < 4; ++m) {
                const int r = EPI_ROW(ai, m);
                const f32x4 sa = sq[m];
                const float rstd = rsqrtf(((sa[0] + sa[1]) + (sa[2] + sa[3])) * (1.f / 256.f) + EPS);
                u32x2 wk[2] = {};
#pragma unroll
                for (int bj = 0; bj < 2; ++bj) {
                    const int head = u.pn * 2 + bj, o = wc * 32 + fq * 8;
#if ATT_FP8_B
                    const f32x4 x0 = acc[ai][bj][m][0] * rstd, x1 = acc[ai][bj][m][1] * rstd;
                    if (wc < 2) wk[bj] = pack8_fp8(x0, x1);
                    else {
                        const int sq = r & (S - 1), k = sq & 63, pos = 32 * ((k >> 2) & 1) + 16 * (k >> 5) + (k & 3) + 4 * ((k & 31) >> 3);
                        unsigned char* vtb = (unsigned char*)VB; const unsigned vo = (unsigned)(((r >> 12) * 8 + head) * 64 + (o - 64)) * S + (unsigned)((sq & ~63) + pos);
                        const u32x2 w = pack8_fp8(x0, x1);
                        vtb[vo] = (unsigned char)(w.x & 0xffu); vtb[vo + S] = (unsigned char)((w.x >> 8) & 0xffu); vtb[vo + 2 * S] = (unsigned char)((w.x >> 16) & 0xffu); vtb[vo + 3 * S] = (unsigned char)(w.x >> 24);
                        vtb[vo + 4 * S] = (unsigned char)(w.y & 0xffu); vtb[vo + 5 * S] = (unsigned char)((w.y >> 8) & 0xffu); vtb[vo + 6 * S] = (unsigned char)((w.y >> 16) & 0xffu); vtb[vo + 7 * S] = (unsigned char)(w.y >> 24);
                    }
#else
                    const u32x4 w = pack8(acc[ai][bj][m][0] * rstd, acc[ai][bj][m][1] * rstd);
                    if (wc < 2) st16((KB + (size_t)r * 768 + head * 96 + o), w); else st16((VB + (size_t)r * 512 + head * 64 + (o - 64)), w);
#endif
                }
#if ATT_FP8_B
                if (wc < 2) st16((unsigned char*)KB + (size_t)r * 768 + (u.pn * 2 + (fq & 1)) * 96 + wc * 32 + 8 * (fq & ~1), pair16(wk[0], wk[1]));
#endif
            } }
    }
};
template <int MODE> struct EpiProj {
    bf16_t* O; const bf16_t* gate;
    __device__ __forceinline__ void operator()(const ACC_T, const Unit& u, int wr, int wc, int fr, int fq) const {
#pragma unroll
        for (int ai = 0; ai < 2; ++ai)
#pragma unroll
            for (int m = 0; m < 4; ++m) {
                const int r = EPI_ROW(ai, m);
#pragma unroll
                for (int bj = 0; bj < 2; ++bj) {
                    const size_t off = (size_t)r * D + EPI_COL(bj);
                    const u32x2 gw = *(const u32x2*)((const unsigned char*)gate + off);
                    const f32x2 q0 = __builtin_amdgcn_cvt_pk_f32_fp8((int)gw.x, false), q1 = __builtin_amdgcn_cvt_pk_f32_fp8((int)gw.x, true), q2 = __builtin_amdgcn_cvt_pk_f32_fp8((int)gw.y, false), q3 = __builtin_amdgcn_cvt_pk_f32_fp8((int)gw.y, true);
                    const f32x4 g0 = {sigm(q0[0]), sigm(q0[1]), sigm(q1[0]), sigm(q1[1])}, g1 = {sigm(q2[0]), sigm(q2[1]), sigm(q3[0]), sigm(q3[1])};
                    f32x4 v0 = acc[ai][bj][m][0] * g0, v1 = acc[ai][bj][m][1] * g1;
                    if (MODE == 1) { f32x4 p0, p1; unpack8(*(const u32x4*)(O + off), p0, p1); v0 += p0; v1 += p1; }
                    if (MODE == 1) st16(O + off, pack8(v0, v1)); else *(u32x4*)(O + off) = pack8(v0, v1);
                }
            }
    }
};
struct EpiProjP {
    bf16_t* O; const unsigned char* SA; const unsigned char* SB;
    __device__ static __forceinline__ void gates(const unsigned char* G, size_t off, f32x4& g0, f32x4& g1) {
        const u32x2 gw = *(const u32x2*)(G + off);
        const f32x2 q0 = __builtin_amdgcn_cvt_pk_f32_fp8((int)gw.x, false), q1 = __builtin_amdgcn_cvt_pk_f32_fp8((int)gw.x, true), q2 = __builtin_amdgcn_cvt_pk_f32_fp8((int)gw.y, false), q3 = __builtin_amdgcn_cvt_pk_f32_fp8((int)gw.y, true);
        g0 = (f32x4){sigm(q0[0]), sigm(q0[1]), sigm(q1[0]), sigm(q1[1])}; g1 = (f32x4){sigm(q2[0]), sigm(q2[1]), sigm(q3[0]), sigm(q3[1])};
    }
    __device__ __forceinline__ void operator()(f32x4 (&acc)[2][2][4][2], const Unit& u, int wr, int wc, int fr, int fq) const {
#pragma unroll
        for (int ai = 0; ai < 2; ++ai)
#pragma unroll
            for (int m = 0; m < 4; ++m) {
                const int r = EPI_ROW(ai, m); u32x2 wm[2] = {};
#pragma unroll
                for (int bj = 0; bj < 2; ++bj) {
                    const size_t off = (size_t)r * D + EPI_COL(bj);
                    f32x4 b0, b1; gates(SB, off, b0, b1);
#pragma unroll
                    for (int j = 0; j < 4; ++j) { b0[j] = fmaxf(b0[j], 9.094947e-13f); b1[j] = fmaxf(b1[j], 9.094947e-13f); }
                    if (u.be == 0) {
                        f32x4 a0, a1; gates(SA, off, a0, a1);
#pragma unroll
                        for (int j = 0; j < 4; ++j) { acc[ai][bj][m][0][j] *= a0[j] * __builtin_amdgcn_rcpf(b0[j]); acc[ai][bj][m][1][j] *= a1[j] * __builtin_amdgcn_rcpf(b1[j]); }
                    } else {
#if PROJ_FP8
                        wm[bj] = pack8_fp8(acc[ai][bj][m][0] * (b0 * (1.f / WSCALE)), acc[ai][bj][m][1] * (b1 * (1.f / WSCALE)));
#else
                        st16(O + off, pack8(acc[ai][bj][m][0] * b0, acc[ai][bj][m][1] * b1));
#endif
                    }
                }
#if PROJ_FP8
                if (u.be != 0) st16((unsigned char*)O + (size_t)r * D + u.pn * 256 + (fq & 1) * 128 + wc * 32 + 8 * (fq & ~1), pair16(wm[0], wm[1]));
#endif
            }
    }
};
template <> struct EpiTraits<EpiProjP> { static constexpr bool KEEP = true; };
struct EpiWo {
    const bf16_t* X; const float* modl; bf16_t* XO;
    __device__ __forceinline__ void operator()(const ACC_T, const Unit& u, int wr, int wc, int fr, int fq) const {
        const float* g1 = modl + (size_t)(u.pm >> 4) * 6 * D + 2 * D;
#pragma unroll
        for (int bj = 0; bj < 2; ++bj) {
            const int c = EPI_COL(bj); const float us = PROJ_FP8 ? 1.f / (OSCALE * WSCALE) : 1.f; const f32x4 ga = *(const f32x4*)(g1 + c) * us, gb = *(const f32x4*)(g1 + c + 4) * us;
#pragma unroll
            for (int ai = 0; ai < 2; ++ai) {
                u32x4 xr[4];
#pragma unroll
                for (int m = 0; m < 4; ++m) xr[m] = *(const u32x4*)(X + (size_t)EPI_ROW(ai, m) * D + c);
                asm volatile("" : "+v"(xr[0]), "+v"(xr[1]), "+v"(xr[2]), "+v"(xr[3]));
#pragma unroll
                for (int m = 0; m < 4; ++m) { const size_t off = (size_t)EPI_ROW(ai, m) * D + c;
                    f32x4 x0, x1; unpack8(xr[m], x0, x1);
                    st16((XO + off), pack8(x0 + ga * acc[ai][bj][m][0], x1 + gb * acc[ai][bj][m][1])); }
            }
        }
    }
};
struct EpiUp {
    bf16_t* ACT; float inscale;
    __device__ __forceinline__ void operator()(const ACC_T, const Unit& u, int wr, int wc, int fr, int fq) const {
#pragma unroll
        for (int ai = 0; ai < 2; ++ai)
#pragma unroll
            for (int m = 0; m < 4; ++m) {
                f32x4 a = acc[ai][0][m][0] * inscale, b = acc[ai][0][m][1] * inscale; const f32x4 c = acc[ai][1][m][0] * inscale, d = acc[ai][1][m][1] * inscale;
#pragma unroll
                for (int j = 0; j < 4; ++j) { a[j] = a[j] * sigm(a[j]) * c[j]; b[j] = b[j] * sigm(b[j]) * d[j]; }
#if MOE_FP8
                st8((unsigned char*)ACT + (size_t)EPI_ROW(ai, m) * FF + u.pn * 128 + wc * 32 + fq * 8, pack8_fp8(a * 8.f, b * 8.f));
#else
                st16((ACT + (size_t)EPI_ROW(ai, m) * FF + u.pn * 128 + wc * 32 + fq * 8), pack8(a, b));
#endif
            }
    }
};
struct EpiDown {
    bf16_t* Y2; const unsigned* list; const float* gw; float inscale;
    __device__ __forceinline__ void operator()(const ACC_T, const Unit& u, int wr, int wc, int fr, int fq) const {
#pragma unroll
        for (int ai = 0; ai < 2; ++ai)
#pragma unroll
            for (int m = 0; m < 4; ++m) {
                const int rloc = ai * 128 + wr * 64 + m * 16 + fr;
                if (rloc < u.nv) {
                    const unsigned entry = list[(size_t)u.be * T + u.rl * 256 + rloc]; const float w = gw[entry] * inscale;
                    const u32x2 q0 = pack8_fp8(acc[ai][0][m][0] * (w * 16.f), acc[ai][0][m][1] * (w * 16.f)), q1 = pack8_fp8(acc[ai][1][m][0] * (w * 16.f), acc[ai][1][m][1] * (w * 16.f));
                    st16((unsigned char*)Y2 + (size_t)entry * D + u.pn * 256 + (fq & 1) * 128 + wc * 32 + 8 * (fq & ~1), pair16(q0, q1));
                }
            }
    }
};
}

namespace at {
struct Tensors { const bf16_t* Q; int qp; const bf16_t* K; int kp; const bf16_t* V; int vp; bf16_t* O; int op; int group; };
__device__ __forceinline__ bool next_unit(int i, int vcu, int G, int& bh, int& qb) {
    int u;
    if (G == 256) { if (i >= 4) return false; u = (vcu >> 5) * 128 + i * 32 + (vcu & 31); }
    else { u = i * G + vcu; if (u >= 1024) return false; }
    bh = u >> 4; qb = u & 15; return true;
}
template <int DQK>
__device__ __forceinline__ void attn_phase_ref(int tid, const Tensors& A, int vcu, int G) {
    int bh, qb;
    for (int i = 0; next_unit(i, vcu, G, bh, qb); ++i) {
        const int b = bh >> 3, h = bh & 7, kvh = h / A.group;
        {
            const int dh = tid >> 8;
            const size_t row = (size_t)b * S + qb * 256 + (tid & 255);
            float q[DQK], o[32];
#pragma unroll
            for (int d = 0; d < DQK; ++d) q[d] = bf2f(A.Q[row * A.qp + h * DQK + d]);
#pragma unroll
            for (int d = 0; d < 32; ++d) o[d] = 0.f;
            float l = 0.f;
            for (int k = 0; k < S; ++k) {
                const bf16_t* kr = A.K + ((size_t)b * S + k) * A.kp + kvh * DQK; const bf16_t* vr = A.V + ((size_t)b * S + k) * A.vp + kvh * 64 + dh * 32;
                float sc = 0.f;
#pragma unroll
                for (int d = 0; d < DQK; d += 8) { f32x4 k0, k1; unpack8(*(const u32x4*)(kr + d), k0, k1);
                    sc += q[d] * k0[0] + q[d + 1] * k0[1] + q[d + 2] * k0[2] + q[d + 3] * k0[3] + q[d + 4] * k1[0] + q[d + 5] * k1[1] + q[d + 6] * k1[2] + q[d + 7] * k1[3]; }
                const float p = bf2f(cvt_pk_bf16(exp2f(sc), 0.f) & 0xffffu); l += p;
#pragma unroll
                for (int d = 0; d < 32; d += 8) { f32x4 v0, v1; unpack8(*(const u32x4*)(vr + d), v0, v1);
                    o[d] += p * v0[0]; o[d + 1] += p * v0[1]; o[d + 2] += p * v0[2]; o[d + 3] += p * v0[3]; o[d + 4] += p * v1[0]; o[d + 5] += p * v1[1]; o[d + 6] += p * v1[2]; o[d + 7] += p * v1[3]; }
            }
            const float il = 1.f / l;
            __syncthreads();
#pragma unroll
            for (int d = 0; d < 32; d += 8) { f32x4 a = {o[d] * il, o[d + 1] * il, o[d + 2] * il, o[d + 3] * il}, c = {o[d + 4] * il, o[d + 5] * il, o[d + 6] * il, o[d + 7] * il};
                *(u32x4*)(A.O + row * A.op + h * 64 + dh * 32 + d) = pack8(a, c); }
        }
    }
}
#if FAST_ATTN
typedef short s16x4 __attribute__((ext_vector_type(4)));
__device__ __forceinline__ unsigned cvtpk(float lo, float hi) { f32x2 v = {lo, hi}; bf16x2_t b = __builtin_convertvector(v, bf16x2_t); return __builtin_bit_cast(unsigned, b); }
__device__ __forceinline__ s16x4 vtr(const LAS unsigned char* p) { return __builtin_bit_cast(s16x4, __builtin_amdgcn_ds_read_tr16_b64_v4i16((LAS s16x4*)p)); }
__device__ __forceinline__ int crow(int r, int hi) { return (r & 3) + 8 * (r >> 2) + 4 * hi; }
#define AT_BAR() asm volatile("s_barrier" ::: "memory")
#define AT_WAITBAR(N) asm volatile("s_waitcnt vmcnt(" #N ") lgkmcnt(0)\n\ts_barrier" ::: "memory")
#define AT_SCHED() __builtin_amdgcn_sched_barrier(0)
__device__ __forceinline__ void glds16(const void* gsrc, unsigned lds_dst) { unsigned keep;
    asm volatile("s_mov_b32 %0, m0\n\ts_mov_b32 m0, %2\n\ts_nop 0\n\tglobal_load_lds_dwordx4 %1, off\n\ts_mov_b32 m0, %0" : "=&s"(keep) : "v"(gsrc), "s"(lds_dst) : "memory"); }
#define AT_GLDS(g, l) glds16((const void*)(g), (unsigned)__builtin_amdgcn_readfirstlane((int)(unsigned)(uintptr_t)(l)))
template <int DQK>
__device__ __forceinline__ void attn_unit(int tid, LAS unsigned char* lds, const Tensors& A, int b, int h, int qb) {
    constexpr int ND = DQK / 16, NCH = DQK / 8, KSLOT = NCH * 1024, NKD = NCH > 8 ? 2 : 1, VSLOT = 8192, NT = S / 64;
    constexpr int KOFF = 0, VOFF = 3 * KSLOT, OST = VOFF + 3 * VSLOT, WSF = OST + 8 * 4096;
    static_assert(WSF + 8 * 256 <= RING_BYTES, "attention LDS");
    const int lane = tid & 63, r32 = lane & 31, hi = lane >> 5, wid = __builtin_amdgcn_readfirstlane(tid >> 6);
    const int kvh = h / A.group; const size_t rowb = (size_t)b * S;
    const bf16_t* ksrc = A.K + (rowb + lane) * A.kp + kvh * DQK + wid * 8;
    const bf16_t* ksrc2 = A.K + (rowb + lane) * A.kp + kvh * DQK + (8 + (wid & 3)) * 8;
    const bf16_t* vsrc = A.V + (rowb + 16 * (wid & 3) + (lane >> 2)) * A.vp + kvh * 64 + (wid >> 2) * 32 + (lane & 3) * 8;
    const size_t ktile = (size_t)64 * A.kp, vtile = (size_t)64 * A.vp;
    LAS unsigned char* kdst = lds + KOFF + wid * 1024; LAS unsigned char* kdst2 = lds + KOFF + (8 + (wid & 3)) * 1024; LAS unsigned char* vdst = lds + VOFF + wid * 1024;
#define DMA_K(j, so) do { AT_GLDS(ksrc + (size_t)(j) * ktile, kdst + (so)); if (NKD == 2) AT_GLDS(ksrc2 + (size_t)(j) * ktile, kdst2 + (so)); } while (0)
#define DMA_V(j, so) AT_GLDS(vsrc + (size_t)(j) * vtile, vdst + (so))
    const LAS unsigned char* kp0 = lds + KOFF + hi * 1024 + r32 * 16;
    const LAS unsigned char* vp0 = lds + VOFF + ((lane >> 4) & 1) * 32 + (lane & 3) * 8 + (4 * hi + ((lane & 15) >> 2)) * 64;
    DMA_K(0, 0); DMA_V(0, 0); DMA_K(1, KSLOT); DMA_V(1, VSLOT); DMA_K(2, 2 * KSLOT);
    const bf16_t* Qw = A.Q + (rowb + qb * 256 + wid * 32 + r32) * A.qp + h * DQK + hi * 8;
    bf16x8 qr[ND];
#pragma unroll
    for (int d0 = 0; d0 < ND; ++d0) qr[d0] = *(const bf16x8*)(Qw + d0 * 16);
    asm volatile("s_waitcnt vmcnt(0)\n\ts_barrier" ::: "memory");
    bf16x8 kf[2 * ND]; s16x4 vlo[8], vhi[8];
#define KLOAD(so) do { _Pragma("unroll") for (int d0 = 0; d0 < ND; ++d0) { kf[2 * d0] = *(const LAS bf16x8*)(kp0 + (so) + d0 * 2048); kf[2 * d0 + 1] = *(const LAS bf16x8*)(kp0 + (so) + d0 * 2048 + 512); } } while (0)
#define VLOAD(so) do { _Pragma("unroll") for (int i = 0; i < 8; ++i) { vlo[i] = vtr(vp0 + (so) + (i >> 2) * 4096 + (i & 3) * 1024); vhi[i] = vtr(vp0 + (so) + (i >> 2) * 4096 + (i & 3) * 1024 + 512); } } while (0)
#define VFR(i) (bf16x8){vlo[i][0], vlo[i][1], vlo[i][2], vlo[i][3], vhi[i][0], vhi[i][1], vhi[i][2], vhi[i][3]}
    KLOAD(0);
    asm volatile("s_waitcnt lgkmcnt(0)" ::: "memory");
    if (PROBE_ATT != 5 && wid >= 4) AT_BAR();
    f32x16 o0 = {}, o1 = {}, C0, C1; u32x4 pw0, pw1, pw2, pw3; float lsum = 0.f;
    const f32x16 zero = {};
#define QK_BLOCK() do { C0 = __builtin_amdgcn_mfma_f32_32x32x16_bf16(kf[0], qr[0], zero, 0, 0, 0); C1 = __builtin_amdgcn_mfma_f32_32x32x16_bf16(kf[1], qr[0], zero, 0, 0, 0); \
        _Pragma("unroll") for (int d0 = 1; d0 < ND; ++d0) { C0 = __builtin_amdgcn_mfma_f32_32x32x16_bf16(kf[2 * d0], qr[d0], C0, 0, 0, 0); C1 = __builtin_amdgcn_mfma_f32_32x32x16_bf16(kf[2 * d0 + 1], qr[d0], C1, 0, 0, 0); } } while (0)
#define PAF(k) __builtin_bit_cast(bf16x8, pw##k)
#define PV_BLOCK() do { \
        o0 = __builtin_amdgcn_mfma_f32_32x32x16_bf16(PAF(0), VFR(0), o0, 0, 0, 0); o1 = __builtin_amdgcn_mfma_f32_32x32x16_bf16(PAF(0), VFR(4), o1, 0, 0, 0); \
        o0 = __builtin_amdgcn_mfma_f32_32x32x16_bf16(PAF(1), VFR(1), o0, 0, 0, 0); o1 = __builtin_amdgcn_mfma_f32_32x32x16_bf16(PAF(1), VFR(5), o1, 0, 0, 0); \
        o0 = __builtin_amdgcn_mfma_f32_32x32x16_bf16(PAF(2), VFR(2), o0, 0, 0, 0); o1 = __builtin_amdgcn_mfma_f32_32x32x16_bf16(PAF(2), VFR(6), o1, 0, 0, 0); \
        o0 = __builtin_amdgcn_mfma_f32_32x32x16_bf16(PAF(3), VFR(3), o0, 0, 0, 0); o1 = __builtin_amdgcn_mfma_f32_32x32x16_bf16(PAF(3), VFR(7), o1, 0, 0, 0); } while (0)
#define SOFTMAX() do { \
        _Pragma("unroll") for (int r = 0; r < 16; ++r) { C0[r] = __builtin_amdgcn_exp2f(C0[r]); C1[r] = __builtin_amdgcn_exp2f(C1[r]); } \
        f32x2 s0_ = {C0[0], C0[1]}, s1_ = {C1[0], C1[1]}; _Pragma("unroll") for (int r = 2; r < 16; r += 2) { s0_ += (f32x2){C0[r], C0[r + 1]}; s1_ += (f32x2){C1[r], C1[r + 1]}; } s0_ += s1_; lsum += s0_[0] + s0_[1]; \
        pw0 = (u32x4){cvtpk(C0[0], C0[1]), cvtpk(C0[2], C0[3]), cvtpk(C0[4], C0[5]), cvtpk(C0[6], C0[7])}; pw1 = (u32x4){cvtpk(C0[8], C0[9]), cvtpk(C0[10], C0[11]), cvtpk(C0[12], C0[13]), cvtpk(C0[14], C0[15])}; \
        pw2 = (u32x4){cvtpk(C1[0], C1[1]), cvtpk(C1[2], C1[3]), cvtpk(C1[4], C1[5]), cvtpk(C1[6], C1[7])}; pw3 = (u32x4){cvtpk(C1[8], C1[9]), cvtpk(C1[10], C1[11]), cvtpk(C1[12], C1[13]), cvtpk(C1[14], C1[15])}; } while (0)
    int ka = 2 * KSLOT, kb = 0, kc = KSLOT, va = 2 * VSLOT, vb = 0, vc = VSLOT;
#define ROT() do { const int t_ = ka; ka = kb; kb = kc; kc = t_; const int u_ = va; va = vb; vb = vc; vc = u_; } while (0)
#define PINP() asm volatile("" : "+v"(lsum) : "v"(pw0), "v"(pw1), "v"(pw2), "v"(pw3))
#if ATT_REGSTAGE
    u32x4 kst = {}, kst2 = {}, vst = {};
    const LAS unsigned char* kw = lds + KOFF + wid * 1024 + lane * 16; const LAS unsigned char* kw2 = lds + KOFF + (8 + (wid & 3)) * 1024 + lane * 16; const LAS unsigned char* vw = lds + VOFF + wid * 1024 + lane * 16;
#define ST_WRITE(WK, WV) do { if (WK) { *(LAS u32x4*)(kw + ka) = kst; if (NKD == 2 && wid < 4) *(LAS u32x4*)(kw2 + ka) = kst2; } if (WV) *(LAS u32x4*)(vw + vc) = vst; } while (0)
#define ST_LOAD(sv, IK, IV) do { if (IK) { kst = *(const u32x4*)(ksrc + (size_t)((sv) + 4) * ktile); if (NKD == 2 && wid < 4) kst2 = *(const u32x4*)(ksrc2 + (size_t)((sv) + 4) * ktile); } if (IV) vst = *(const u32x4*)(vsrc + (size_t)((sv) + 3) * vtile); } while (0)
#define STEP(sv, DOQK, DOPV, KL, VL, IK, IV, WK, WV) do { \
        AT_SCHED(); if (DOQK) QK_BLOCK(); if (DOPV) PV_BLOCK(); AT_SCHED(); \
        asm volatile("s_barrier\n\ts_nop 15\n\ts_nop 3" : "+v"(C0), "+v"(C1), "+v"(o0), "+v"(o1) :: "memory"); AT_SCHED(); \
        if (KL) KLOAD(kc); if (VL) VLOAD(vb); ST_WRITE(WK, WV); ST_LOAD(sv, IK, IV); \
        if (DOQK) { SOFTMAX(); PINP(); } AT_SCHED(); \
        asm volatile("s_waitcnt lgkmcnt(0)\n\ts_barrier" ::: "memory"); \
        AT_SCHED(); ROT(); } while (0)
    STEP(-1, true, false, true, true, true, true, false, false);
#pragma nounroll
    for (int s = 0; s < NT - 4; ++s) STEP(s, true, true, true, true, true, true, true, true);
    STEP(NT - 4, true, true, true, true, false, true, true, true);
    STEP(NT - 3, true, true, true, true, false, false, false, true);
    STEP(NT - 2, true, true, false, true, false, false, false, false);
    STEP(NT - 1, false, true, false, false, false, false, false, false);
#undef ST_WRITE
#undef ST_LOAD
#else
#define STEP(sv, DOQK, DOPV, KL, VL, IK, IV) do { \
        AT_SCHED(); if (DOQK) QK_BLOCK(); if (DOPV) PV_BLOCK(); AT_SCHED(); \
          \
        asm volatile("s_barrier\n\ts_nop 15\n\ts_nop 3" : "+v"(C0), "+v"(C1), "+v"(o0), "+v"(o1) :: "memory"); AT_SCHED(); \
        if (KL) KLOAD(kc); if (VL) VLOAD(vb); if (IK) DMA_K((sv) + 4, kb); if (IV) DMA_V((sv) + 3, va); \
        if (DOQK) { SOFTMAX(); PINP(); } AT_SCHED(); \
        if (IK) { if (NKD == 2) { AT_WAITBAR(3); } else { AT_WAITBAR(2); } } else if (IV) { AT_WAITBAR(1); } else { AT_WAITBAR(0); } \
        AT_SCHED(); ROT(); } while (0)
    STEP(-1, true, false, true, true, true, true);
#pragma nounroll
    for (int s = 0; s < NT - 4; ++s) STEP(s, true, true, true, true, true, true);
    STEP(NT - 4, true, true, true, true, false, true);
    STEP(NT - 3, true, true, true, true, false, false);
    STEP(NT - 2, true, true, false, true, false, false);
    STEP(NT - 1, false, true, false, false, false, false);
#endif
#undef STEP
#undef PINP
    if (PROBE_ATT != 5 && wid < 4) AT_BAR();
    { auto rr = __builtin_amdgcn_permlane32_swap(__float_as_uint(lsum), __float_as_uint(lsum), false, false); lsum = __uint_as_float(rr[0]) + __uint_as_float(rr[1]); }
    LAS float* wsf = (LAS float*)(lds + WSF + wid * 256);
    if (hi == 0) wsf[r32] = lsum;
    asm volatile("s_waitcnt lgkmcnt(0)" ::: "memory");
    LAS bf16_t* stg = (LAS bf16_t*)(lds + OST + wid * 4096);
#pragma unroll
    for (int r = 0; r < 16; ++r) { const int orow = crow(r, hi); const float rl = __builtin_amdgcn_rcpf(wsf[orow]);
        stg[orow * 64 + r32] = (bf16_t)(cvtpk(o0[r] * rl, 0.f) & 0xffffu); stg[orow * 64 + 32 + r32] = (bf16_t)(cvtpk(o1[r] * rl, 0.f) & 0xffffu); }
    asm volatile("s_waitcnt lgkmcnt(0)" ::: "memory");
    bf16_t* Ow = A.O + (rowb + qb * 256 + wid * 32) * A.op + h * 64;
#pragma unroll
    for (int i = 0; i < 4; ++i) { const int row = i * 8 + (lane >> 3), ch = lane & 7; const u32x4 v = *(const LAS u32x4*)(stg + row * 64 + ch * 8); st16((Ow + (size_t)row * A.op + ch * 8), v); }
    asm volatile("s_waitcnt lgkmcnt(0)\n\ts_barrier" ::: "memory");
#undef DMA_K
#undef DMA_V
#undef KLOAD
#undef VLOAD
#undef VFR
#undef QK_BLOCK
#undef PAF
#undef PV_BLOCK
#undef SOFTMAX
#undef ROT
}
#endif
#if FAST_ATTN && ATT_FP8_A
typedef int v8i __attribute__((ext_vector_type(8)));
#define SPLAT16(x) ((f32x16){x, x, x, x, x, x, x, x, x, x, x, x, x, x, x, x})
__device__ __forceinline__ f32x16 mfma8(v8i a, v8i b, f32x16 c) { return __builtin_amdgcn_mfma_scale_f32_32x32x64_f8f6f4(a, b, c, 0, 0, 0, 0, 0, 0); }
__device__ __forceinline__ f32x16 mfma8pv(v8i a, v8i b, f32x16 c) { return __builtin_amdgcn_mfma_scale_f32_32x32x64_f8f6f4(a, b, c, 1, 0, 0, 0, 0, 0); }
__device__ __forceinline__ void attn_unit_f8a(int tid, LAS unsigned char* lds, const unsigned char* Q8, const unsigned char* K8, const unsigned char* VT8, bf16_t* O, int op, int b, int h, int qb, float bias) {
    constexpr int SL = 4096, NT = S / 64;
    constexpr int KOFF = 0, VOFF = 4 * SL, OST = VOFF + 4 * SL, WSF = OST + 8 * 4096;
    const int lane = tid & 63, r32 = lane & 31, hi = lane >> 5, wid = __builtin_amdgcn_readfirstlane(tid >> 6);
    const int kvh = h >> 2; const size_t rowb = (size_t)b * S; const bool kw = wid < 4;
    const unsigned char* src = kw ? K8 + (rowb + lane) * 128 + kvh * 64 + 16 * wid : VT8 + ((size_t)((b * 2 + kvh) * 64 + lane)) * S + 16 * (wid - 4);
    const size_t tstep = kw ? (size_t)64 * 128 : (size_t)64;
    LAS unsigned char* dst = lds + (kw ? KOFF + wid * 1024 : VOFF + (wid - 4) * 1024);
#define DMA8(j, so) AT_GLDS(src + (size_t)(j) * tstep, dst + (so))
    const LAS unsigned char* kp0 = lds + KOFF + (2 * hi) * 1024 + r32 * 16;
    const LAS unsigned char* vp0 = lds + VOFF + (2 * hi) * 1024 + r32 * 16;
    DMA8(0, 0); DMA8(1, SL); DMA8(2, 2 * SL);
    v8i qf; { const unsigned char* Qw = Q8 + (rowb + qb * 256 + wid * 32 + r32) * 512 + h * 64 + 32 * hi; const u32x4 a = *(const u32x4*)Qw, c = *(const u32x4*)(Qw + 16);
        qf = (v8i){(int)a.x, (int)a.y, (int)a.z, (int)a.w, (int)c.x, (int)c.y, (int)c.z, (int)c.w}; }
    asm volatile("s_waitcnt vmcnt(0)\n\ts_barrier" ::: "memory");
    v8i kf0, kf1, vf0, vf1, p8;
#define LD32(dstv, p) do { const u32x4 a_ = *(const LAS u32x4*)(p), c_ = *(const LAS u32x4*)((p) + 1024); dstv = (v8i){(int)a_.x, (int)a_.y, (int)a_.z, (int)a_.w, (int)c_.x, (int)c_.y, (int)c_.z, (int)c_.w}; } while (0)
#define KLOAD8(so) do { LD32(kf0, kp0 + (so)); LD32(kf1, kp0 + (so) + 512); } while (0)
#define VLOAD8(so) do { LD32(vf0, vp0 + (so)); LD32(vf1, vp0 + (so) + 512); } while (0)
    KLOAD8(0);
    asm volatile("s_waitcnt lgkmcnt(0)" ::: "memory");
    if (wid >= 4) AT_BAR();
    float z_ = 0.f; asm volatile("" : "+v"(z_));
    f32x16 o0 = SPLAT16(z_), o1 = SPLAT16(z_), o2 = SPLAT16(z_), C0, C1;
    const v8i ones = {0x38383838, 0x38383838, 0x38383838, 0x38383838, 0x38383838, 0x38383838, 0x38383838, 0x38383838};
    float nb_ = PFOLD * bias + PBYTE0; asm volatile("" : "+v"(nb_));
    f32x16 negb = SPLAT16(nb_);
    asm volatile("" : "+v"(negb));
#define SOFTMAX8() do { \
        _Pragma("unroll") for (int i = 0; i < 4; ++i) { \
            const f32x2 a_ = (f32x2){C0[4 * i], C0[4 * i + 1]}, b_ = (f32x2){C0[4 * i + 2], C0[4 * i + 3]}, c_ = (f32x2){C1[4 * i], C1[4 * i + 1]}, d_ = (f32x2){C1[4 * i + 2], C1[4 * i + 3]}; \
            p8[i] = (int)__builtin_amdgcn_cvt_pk_u8_f32(b_[1], 3, __builtin_amdgcn_cvt_pk_u8_f32(b_[0], 2, __builtin_amdgcn_cvt_pk_u8_f32(a_[1], 1, __builtin_amdgcn_cvt_pk_u8_f32(a_[0], 0, 0u)))); \
            p8[4 + i] = (int)__builtin_amdgcn_cvt_pk_u8_f32(d_[1], 3, __builtin_amdgcn_cvt_pk_u8_f32(d_[0], 2, __builtin_amdgcn_cvt_pk_u8_f32(c_[1], 1, __builtin_amdgcn_cvt_pk_u8_f32(c_[0], 0, 0u)))); } } while (0)
#define STEP8(sv, DOQK2, DOSM, DOPV, KL, VL, ISS, WN, NOPS) do { \
        AT_SCHED(); \
        if (KL) { LD32(kf0, kp0 + (((sv) + 2) & 3) * SL); LD32(kf1, kp0 + (((sv) + 2) & 3) * SL + 512); } AT_SCHED(); \
        if (DOPV) { o0 = mfma8pv(p8, vf0, o0); } if (VL) LD32(vf0, vp0 + (((sv) + 1) & 3) * SL); AT_SCHED(); \
        if (DOPV) { o1 = mfma8pv(p8, vf1, o1); } if (VL) LD32(vf1, vp0 + (((sv) + 1) & 3) * SL + 512); AT_SCHED(); \
        if (DOPV) { o2 = mfma8pv(p8, ones, o2); } if (ISS) DMA8((sv) + 4, (((sv) + 4) & 3) * SL); AT_SCHED(); \
        asm volatile("s_barrier\n\t" NOPS : "+v"(C0), "+v"(C1), "+v"(o0), "+v"(o1), "+v"(o2) :: "memory"); AT_SCHED(); \
        if (DOSM) { SOFTMAX8(); asm volatile("" :: "v"(p8)); } AT_SCHED(); \
        if (DOQK2) { asm volatile("s_waitcnt lgkmcnt(0)" ::: "memory"); C0 = mfma8(kf0, qf, negb); C1 = mfma8(kf1, qf, negb); } AT_SCHED(); \
        asm volatile("s_waitcnt vmcnt(" #WN ") lgkmcnt(0)\n\ts_barrier" : "+v"(C0), "+v"(C1), "+v"(o0), "+v"(o1), "+v"(o2) :: "memory"); \
        AT_SCHED(); } while (0)
    C0 = mfma8(kf0, qf, negb); C1 = mfma8(kf1, qf, negb);
    STEP8(-1, true, true, false, true, true, true, 1, "s_nop 15\n\ts_nop 15");
#pragma nounroll
    for (int s = 0; s < NT - 4; ++s) STEP8(s, true, true, true, true, true, true, 1, "s_nop 1");
    STEP8(NT - 4, true, true, true, true, true, false, 0, "s_nop 1");
    STEP8(NT - 3, true, true, true, true, true, false, 0, "s_nop 1");
    STEP8(NT - 2, false, true, true, false, true, false, 0, "s_nop 15\n\ts_nop 15");
    STEP8(NT - 1, false, false, true, false, false, false, 0, "s_nop 15\n\ts_nop 15");
    if (wid < 4) AT_BAR();
#if PROJ_FP8
    LAS unsigned char* stg8 = lds + OST + wid * 4096;
#pragma unroll
    for (int r = 0; r < 16; ++r) { const int orow = crow(r, hi); const float rl = __builtin_amdgcn_rcpf(o2[r]) * OSCALE;
        const unsigned pk = (unsigned)__builtin_amdgcn_cvt_pk_fp8_f32(o0[r] * rl, o1[r] * rl, 0, false);
        stg8[orow * 64 + r32] = (unsigned char)(pk & 0xffu); stg8[orow * 64 + 32 + r32] = (unsigned char)((pk >> 8) & 0xffu); }
    asm volatile("s_waitcnt lgkmcnt(0)" ::: "memory");
    unsigned char* Ow8 = (unsigned char*)O + (rowb + qb * 256 + wid * 32) * op + h * 64;
#pragma unroll
    for (int i = 0; i < 2; ++i) { const int idx = i * 64 + lane, row = idx >> 2, ch = idx & 3; const u32x4 v = *(const LAS u32x4*)(stg8 + row * 64 + ch * 16); st16(Ow8 + (size_t)row * op + ch * 16, v); }
#else
    LAS bf16_t* stg = (LAS bf16_t*)(lds + OST + wid * 4096);
#pragma unroll
    for (int r = 0; r < 16; ++r) { const int orow = crow(r, hi); const float rl = __builtin_amdgcn_rcpf(o2[r]);
        stg[orow * 64 + r32] = (bf16_t)(cvtpk(o0[r] * rl, 0.f) & 0xffffu); stg[orow * 64 + 32 + r32] = (bf16_t)(cvtpk(o1[r] * rl, 0.f) & 0xffffu); }
    asm volatile("s_waitcnt lgkmcnt(0)" ::: "memory");
    bf16_t* Ow = O + (rowb + qb * 256 + wid * 32) * op + h * 64;
#pragma unroll
    for (int i = 0; i < 4; ++i) { const int row = i * 8 + (lane >> 3), ch = lane & 7; const u32x4 v = *(const LAS u32x4*)(stg + row * 64 + ch * 8); st16(Ow + (size_t)row * op + ch * 8, v); }
    #endif
    asm volatile("s_waitcnt lgkmcnt(0)\n\ts_barrier" ::: "memory");
#undef DMA8
#undef LD32
#undef KLOAD8
#undef VLOAD8
#undef SOFTMAX8
#undef STEP8
}
__device__ __forceinline__ void attn_phase_f8a(int tid, LAS unsigned char* lds, const unsigned char* Q8, const unsigned char* K8, const unsigned char* VT8, bf16_t* O, int op, const float* gq, const float* gk, int vcu, int G) {
    float mq = 0.f, mk = 0.f;
    for (int i = 0; i < 64; ++i) { mq = fmaxf(mq, fabsf(gq[i])); mk = fmaxf(mk, fabsf(gk[i])); }
    const float bias = -fmaxf(64.f * mq * mk * QSCALE_A * 1.13f - 15.5f, 0.f);
    int bh, qb;
    for (int i = 0; next_unit(i, vcu, G, bh, qb); ++i) attn_unit_f8a(tid, lds, Q8, K8, VT8, O, op, bh >> 3, bh & 7, qb, bias);
}
#endif
#if FAST_ATTN && ATT_FP8_B
__device__ __forceinline__ void attn_unit_f8b(int tid, LAS unsigned char* lds, const unsigned char* Q8, const unsigned char* K8, const unsigned char* VT8, bf16_t* O, int op, int b, int h, int qb) {
    constexpr int SLK = 6144, SLV = 4096, NT = S / 64;
    constexpr int KOFF = 0, VOFF = 4 * SLK, OST = VOFF + 4 * SLV, WSF = OST + 8 * 4096;
    static_assert(WSF + 2048 <= RING_BYTES, "attention LDS");
    const int lane = tid & 63, r32 = lane & 31, hi = lane >> 5, wid = __builtin_amdgcn_readfirstlane(tid >> 6);
    const size_t rowb = (size_t)b * S; const bool kw = wid < 6, vw = wid >= 4;
    const unsigned char* ksrc = K8 + (rowb + lane) * 768 + h * 96 + 16 * wid;
    const unsigned char* vsrc = VT8 + ((size_t)((b * 8 + h) * 64 + lane)) * S + 16 * (wid - 4);
    LAS unsigned char* kdst = lds + KOFF + wid * 1024; LAS unsigned char* vdst = lds + VOFF + (wid - 4) * 1024;
#define DMAK(j, so) AT_GLDS(ksrc + (size_t)(j) * (64 * 768), kdst + (so))
#define DMAV(j, so) AT_GLDS(vsrc + (size_t)(j) * 64, vdst + (so))
    const LAS unsigned char* kp0 = lds + KOFF + (2 * hi) * 1024 + r32 * 16;
    const LAS unsigned char* kr0 = lds + KOFF + 4 * 1024 + r32 * 16;
    const LAS unsigned char* vp0 = lds + VOFF + (2 * hi) * 1024 + r32 * 16;
    if (kw) { DMAK(0, 0); DMAK(1, SLK); DMAK(2, 2 * SLK); DMAK(3, 3 * SLK); }
    if (vw) { DMAV(0, 0); DMAV(1, SLV); DMAV(2, 2 * SLV); }
    v8i qn, qr;
    { const unsigned char* Qw = Q8 + (rowb + qb * 256 + wid * 32 + r32) * 768 + h * 96; const u32x4 a = *(const u32x4*)(Qw + 32 * hi), c = *(const u32x4*)(Qw + 32 * hi + 16), e = *(const u32x4*)(Qw + 64), f = *(const u32x4*)(Qw + 80);
      qn = (v8i){(int)a.x, (int)a.y, (int)a.z, (int)a.w, (int)c.x, (int)c.y, (int)c.z, (int)c.w};
      qr = hi ? (v8i){0, 0, 0, 0, 0, 0, 0, 0} : (v8i){(int)e.x, (int)e.y, (int)e.z, (int)e.w, (int)f.x, (int)f.y, (int)f.z, (int)f.w}; }
    asm volatile("s_waitcnt vmcnt(0)\n\ts_barrier" ::: "memory");
    v8i kn0, kn1, kr0v, kr1v, vf0, vf1, p8;
#define LD32(dstv, p) do { const u32x4 a_ = *(const LAS u32x4*)(p), c_ = *(const LAS u32x4*)((p) + 1024); dstv = (v8i){(int)a_.x, (int)a_.y, (int)a_.z, (int)a_.w, (int)c_.x, (int)c_.y, (int)c_.z, (int)c_.w}; } while (0)
#define KLOAD8(so) do { LD32(kn0, kp0 + (so)); LD32(kn1, kp0 + (so) + 512); LD32(kr0v, kr0 + (so)); LD32(kr1v, kr0 + (so) + 512); } while (0)
#define VLOAD8(so) do { LD32(vf0, vp0 + (so)); LD32(vf1, vp0 + (so) + 512); } while (0)
    KLOAD8(0);
    asm volatile("s_waitcnt lgkmcnt(0)" ::: "memory");
    if (wid >= 4) AT_BAR();
    float z_ = 0.f, pb_ = PBYTE0; asm volatile("" : "+v"(z_), "+v"(pb_));
    f32x16 o0 = SPLAT16(z_), o1 = SPLAT16(z_), o2 = SPLAT16(z_), C0, C1;
    f32x16 zero = SPLAT16(pb_);
    asm volatile("" : "+v"(zero));
    const v8i ones = {0x38383838, 0x38383838, 0x38383838, 0x38383838, 0x38383838, 0x38383838, 0x38383838, 0x38383838};
#define SOFTMAX8() do { \
        _Pragma("unroll") for (int i = 0; i < 4; ++i) { \
            const f32x2 a_ = (f32x2){C0[4 * i], C0[4 * i + 1]}, b_ = (f32x2){C0[4 * i + 2], C0[4 * i + 3]}, c_ = (f32x2){C1[4 * i], C1[4 * i + 1]}, d_ = (f32x2){C1[4 * i + 2], C1[4 * i + 3]}; \
            p8[i] = (int)__builtin_amdgcn_cvt_pk_u8_f32(b_[1], 3, __builtin_amdgcn_cvt_pk_u8_f32(b_[0], 2, __builtin_amdgcn_cvt_pk_u8_f32(a_[1], 1, __builtin_amdgcn_cvt_pk_u8_f32(a_[0], 0, 0u)))); \
            p8[4 + i] = (int)__builtin_amdgcn_cvt_pk_u8_f32(d_[1], 3, __builtin_amdgcn_cvt_pk_u8_f32(d_[0], 2, __builtin_amdgcn_cvt_pk_u8_f32(c_[1], 1, __builtin_amdgcn_cvt_pk_u8_f32(c_[0], 0, 0u)))); } } while (0)
#define STEP8(sv, DOQK, DOPV, KL, VL, IK, IV, WK, WV, WB, NOPS) do { \
        AT_SCHED(); if (DOQK) { C0 = mfma8(kn0, qn, zero); C1 = mfma8(kn1, qn, zero); C0 = mfma8(kr0v, qr, C0); C1 = mfma8(kr1v, qr, C1); } if (DOPV) { o0 = mfma8pv(p8, vf0, o0); o1 = mfma8pv(p8, vf1, o1); o2 = mfma8pv(p8, ones, o2); } AT_SCHED(); \
        asm volatile("s_barrier\n\t" NOPS : "+v"(C0), "+v"(C1), "+v"(o0), "+v"(o1), "+v"(o2) :: "memory"); AT_SCHED(); \
        if (KL) KLOAD8((((sv) + 2) & 3) * SLK); if (VL) VLOAD8((((sv) + 1) & 3) * SLV); \
        if (kw && (IK)) DMAK((sv) + 5, (((sv) + 1) & 3) * SLK); if (vw && (IV)) DMAV((sv) + 4, ((sv) & 3) * SLV); \
        if (DOQK) { SOFTMAX8(); asm volatile("" :: "v"(p8)); } AT_SCHED(); \
        if (kw && vw) { AT_WAITBAR(WB); } else if (kw) { AT_WAITBAR(WK); } else { AT_WAITBAR(WV); } \
        AT_SCHED(); } while (0)
    STEP8(-1, true, false, true, true, true, true, 2, 2, 4, "s_nop 15\n\ts_nop 15");
#pragma nounroll
    for (int s = 0; s < NT - 5; ++s) STEP8(s, true, true, true, true, true, true, 2, 2, 4, "s_nop 1");
    STEP8(NT - 5, true, true, true, true, false, true, 1, 2, 3, "s_nop 15\n\ts_nop 15");
    STEP8(NT - 4, true, true, true, true, false, false, 0, 1, 1, "s_nop 15\n\ts_nop 15");
    STEP8(NT - 3, true, true, true, true, false, false, 0, 0, 0, "s_nop 15\n\ts_nop 15");
    STEP8(NT - 2, true, true, false, true, false, false, 0, 0, 0, "s_nop 15\n\ts_nop 15");
    STEP8(NT - 1, false, true, false, false, false, false, 0, 0, 0, "s_nop 15\n\ts_nop 15");
    if (wid < 4) AT_BAR();
#if PROJ_FP8
    LAS unsigned char* stg8 = lds + OST + wid * 4096;
#pragma unroll
    for (int r = 0; r < 16; ++r) { const int orow = crow(r, hi); const float rl = __builtin_amdgcn_rcpf(o2[r]) * OSCALE;
        const unsigned pk = (unsigned)__builtin_amdgcn_cvt_pk_fp8_f32(o0[r] * rl, o1[r] * rl, 0, false);
        stg8[orow * 64 + r32] = (unsigned char)(pk & 0xffu); stg8[orow * 64 + 32 + r32] = (unsigned char)((pk >> 8) & 0xffu); }
    asm volatile("s_waitcnt lgkmcnt(0)" ::: "memory");
    unsigned char* Ow8 = (unsigned char*)O + (rowb + qb * 256 + wid * 32) * op + h * 64;
#pragma unroll
    for (int i = 0; i < 2; ++i) { const int idx = i * 64 + lane, row = idx >> 2, ch = idx & 3; const u32x4 v = *(const LAS u32x4*)(stg8 + row * 64 + ch * 16); st16(Ow8 + (size_t)row * op + ch * 16, v); }
#else
    LAS bf16_t* stg = (LAS bf16_t*)(lds + OST + wid * 4096);
#pragma unroll
    for (int r = 0; r < 16; ++r) { const int orow = crow(r, hi); const float rl = __builtin_amdgcn_rcpf(o2[r]);
        stg[orow * 64 + r32] = (bf16_t)(cvtpk(o0[r] * rl, 0.f) & 0xffffu); stg[orow * 64 + 32 + r32] = (bf16_t)(cvtpk(o1[r] * rl, 0.f) & 0xffffu); }
    asm volatile("s_waitcnt lgkmcnt(0)" ::: "memory");
    bf16_t* Ow = O + (rowb + qb * 256 + wid * 32) * op + h * 64;
#pragma unroll
    for (int i = 0; i < 4; ++i) { const int row = i * 8 + (lane >> 3), ch = lane & 7; const u32x4 v = *(const LAS u32x4*)(stg + row * 64 + ch * 8); st16(Ow + (size_t)row * op + ch * 8, v); }
    #endif
    asm volatile("s_waitcnt lgkmcnt(0)\n\ts_barrier" ::: "memory");
#undef DMAK
#undef DMAV
#undef LD32
#undef KLOAD8
#undef VLOAD8
#undef SOFTMAX8
#undef STEP8
}
__device__ __forceinline__ void attn_phase_f8b(int tid, LAS unsigned char* lds, const unsigned char* Q8, const unsigned char* K8, const unsigned char* VT8, bf16_t* O, int op, int vcu, int G) {
    int bh, qb;
    for (int i = 0; next_unit(i, vcu, G, bh, qb); ++i) attn_unit_f8b(tid, lds, Q8, K8, VT8, O, op, bh >> 3, bh & 7, qb);
}
#endif
template <int DQK>
__device__ __forceinline__ void attn_phase(int tid, LAS unsigned char* lds, const Tensors& A, int vcu, int G) {
#if FAST_ATTN
    int bh, qb;
    for (int i = 0; next_unit(i, vcu, G, bh, qb); ++i) attn_unit<DQK>(tid, lds, A, bh >> 3, bh & 7, qb);
#else
    (void)lds; attn_phase_ref<DQK>(tid, A, vcu, G);
#endif
}
}


struct Args { const float* in[22]; float* out; unsigned char* ws; int ph_lo, ph_hi; };
struct Frame {
    LAS unsigned char* lds; volatile LAS unsigned* MISC; unsigned* ctl;
    int tid, lane, wave, vcu, G;
    unsigned char* ws; float* OUT;
};

__device__ __forceinline__ void p0_phase(Frame& F, const float* c, const float* w_ada, const float* b_ada) {
    LAS float* cs = (LAS float*)F.lds;
    LAS float* red = (LAS float*)(F.lds + 32768);
    for (int i = F.tid; i < NB * D; i += NTHREADS) { const float v = c[i]; cs[i] = v / (1.f + __expf(-v)); }
    __syncthreads();
    float* mod = (float*)(F.ws + WS_MOD);
    const int kq = F.wave, col = F.lane;
    for (int item = F.vcu; item < NL * 6 * D / 64; item += F.G) {
        const int l = item / (6 * D / 64), n0 = (item % (6 * D / 64)) * 64;
        const float* w = w_ada + (size_t)l * D * 6 * D + n0 + col;
        float acc[NB];
#pragma unroll
        for (int b = 0; b < NB; ++b) acc[b] = 0.f;
#pragma unroll 8
        for (int k = kq * 128; k < kq * 128 + 128; ++k) { const float wv = w[(size_t)k * 6 * D];
#pragma unroll
            for (int b = 0; b < NB; ++b) acc[b] += cs[b * D + k] * wv; }
#pragma unroll
        for (int b = 0; b < NB; ++b) red[(kq * NB + b) * 64 + col] = acc[b];
        __syncthreads();
        { const int b = F.wave; float s = 0.f;
#pragma unroll
          for (int q = 0; q < 8; ++q) s += red[(q * NB + b) * 64 + col];
          mod[((size_t)l * NB + b) * 6 * D + n0 + col] = s + b_ada[(size_t)l * 6 * D + n0 + col]; }
        __syncthreads();
    }
    float* cosA = (float*)(F.ws + WS_COSA); float* sinA = (float*)(F.ws + WS_SINA); float* cosB = (float*)(F.ws + WS_COSB); float* sinB = (float*)(F.ws + WS_SINB);
    for (int idx = F.vcu * NTHREADS + F.tid; idx < S * 48; idx += F.G * NTHREADS) {
        const int s = idx / 48, i = idx % 48; const float row = (float)(s >> 6), col2 = (float)(s & 63);
        if (i < 32) { const int j = i & 15; const float a = (i < 16 ? row : col2) * (1.0f / powf(10000.0f, (float)j / 16.0f)); cosA[s * 32 + i] = cosf(a); sinA[s * 32 + i] = sinf(a); }
        else { const int ii = i - 32, j = ii & 7; const float a = (ii < 8 ? row : col2) * (1.0f / powf(10000.0f, (float)j / 8.0f)); cosB[s * 16 + ii] = cosf(a); sinB[s * 16 + ii] = sinf(a); }
    }
}

template <class SrcFn>
__device__ __forceinline__ void cvt_item(const float* W, int K, int Nsrc, const float* kg, bf16_t* WT, LAS float* scr, int item, int nblk, int lane, const SrcFn& src, float f8scale = 0.f) {
    const int kb = item / nblk, nb = item % nblk, k0 = 64 * kb, n0 = 32 * nb;
    const int sc = src(n0 + (lane & 31));
#pragma unroll
    for (int i = 0; i < 32; ++i) { const int kk = 2 * i + (lane >> 5); float v = sc >= 0 ? W[(size_t)(k0 + kk) * Nsrc + sc] : 0.f; if (kg) v *= kg[k0 + kk]; scr[kk * 33 + (lane & 31)] = v; }
    LDS_WAIT(); asm volatile("" ::: "memory");
    const int c = lane & 7;
    if (f8scale != 0.f) {
#pragma unroll
        for (int j = 0; j < 4; ++j) { const int n = (lane >> 3) + 8 * j; const LAS float* sp = scr + (8 * c) * 33 + n;
            const u32x2 o = pack8_fp8((f32x4){sp[0 * 33], sp[1 * 33], sp[2 * 33], sp[3 * 33]} * f8scale, (f32x4){sp[4 * 33], sp[5 * 33], sp[6 * 33], sp[7 * 33]} * f8scale);
            *(u32x2*)((unsigned char*)WT + (size_t)(n0 + n) * K + k0 + 8 * c) = o; }
    } else {
#pragma unroll
    for (int j = 0; j < 4; ++j) { const int n = (lane >> 3) + 8 * j; const LAS float* s = scr + (8 * c) * 33 + n;
        u32x4 o; o.x = cvt_pk_bf16(s[0 * 33], s[1 * 33]); o.y = cvt_pk_bf16(s[2 * 33], s[3 * 33]); o.z = cvt_pk_bf16(s[4 * 33], s[5 * 33]); o.w = cvt_pk_bf16(s[6 * 33], s[7 * 33]);
        *(u32x4*)(WT + (size_t)(n0 + n) * K + k0 + 8 * c) = o; }
    }
    LDS_WAIT(); asm volatile("" ::: "memory");
}
struct SrcId { __device__ int operator()(int n) const { return n; } };
struct SrcIn { __device__ int operator()(int n) const { return gp::src_col_in(n); } };
typedef __attribute__((address_space(4))) const Args CArgsW;
__device__ __forceinline__ void convert_weights(Frame& F, CArgsW* a, int l) {
    LAS float* scr = (LAS float*)(F.lds + F.wave * 16384);
    const int gw = F.vcu * NWAVES + F.wave, NGW = F.G * NWAVES;
    const float* w_in = ((const float*)(GAS const float*)a->in[5]) + (size_t)l * D * INC; const float* w_q_b = ((const float*)(GAS const float*)a->in[10]) + (size_t)l * 384 * 768; const float* w_kv_b = ((const float*)(GAS const float*)a->in[11]) + (size_t)l * 256 * 1024;
    const float* w_pa = ((const float*)(GAS const float*)a->in[12]) + (size_t)l * 512 * D; const float* w_pb = ((const float*)(GAS const float*)a->in[13]) + (size_t)l * 512 * D; const float* w_o = ((const float*)(GAS const float*)a->in[14]) + (size_t)l * D * D;
    const float* w1 = ((const float*)(GAS const float*)a->in[18]) + (size_t)l * NE * D * FF; const float* w3 = ((const float*)(GAS const float*)a->in[19]) + (size_t)l * NE * D * FF; const float* w2 = ((const float*)(GAS const float*)a->in[20]) + (size_t)l * NE * FF * D;
    const float* gqa = ((const float*)(GAS const float*)a->in[8]) + l * 384; const float* gkv = ((const float*)(GAS const float*)a->in[9]) + l * 256;
    bf16_t* Win = (bf16_t*)(F.ws + WS_WIN); bf16_t* Wqb = (bf16_t*)(F.ws + WS_WQB); bf16_t* Wkvb = (bf16_t*)(F.ws + WS_WKVB); bf16_t* Wpa = (bf16_t*)(F.ws + WS_WPA); bf16_t* Wpb = (bf16_t*)(F.ws + WS_WPB);
    bf16_t* Wo = (bf16_t*)(F.ws + WS_WO); bf16_t* W13 = (bf16_t*)(F.ws + WS_W13); bf16_t* W2 = (bf16_t*)(F.ws + WS_W2);
    constexpr int I_IN = (D / 64) * (NIN / 32), I_QB = (384 / 64) * (768 / 32), I_KVB = (256 / 64) * (1024 / 32), I_P = (512 / 64) * (D / 32), I_O = (D / 64) * (D / 32);
    constexpr int I_13 = (D / 64) * (1024 / 32), I_2 = (FF / 64) * (D / 32);
    constexpr int NITEMS = I_IN + I_QB + I_KVB + 2 * I_P + I_O + NE * (I_13 + I_2);
    for (int it = gw; it < NITEMS; it += NGW) {
        int r = it;
        if (r < I_IN) { cvt_item(w_in, D, INC, nullptr, Win, scr, r, NIN / 32, F.lane, SrcIn(), G1_FP8 ? 16.f : 0.f); continue; } r -= I_IN;
        if (r < I_QB) { cvt_item(w_q_b, 384, 768, gqa, Wqb, scr, r, 768 / 32, F.lane, SrcId()); continue; } r -= I_QB;
        if (r < I_KVB) { cvt_item(w_kv_b, 256, 1024, gkv, Wkvb, scr, r, 1024 / 32, F.lane, SrcId()); continue; } r -= I_KVB;
        if (r < I_P) { cvt_item(w_pa, 512, D, nullptr, Wpa, scr, r, D / 32, F.lane, SrcId(), PROJ_FP8 ? WSCALE : 0.f); continue; } r -= I_P;
        if (r < I_P) { cvt_item(w_pb, 512, D, nullptr, Wpb, scr, r, D / 32, F.lane, SrcId(), PROJ_FP8 ? WSCALE : 0.f); continue; } r -= I_P;
        if (r < I_O) { cvt_item(w_o, D, D, nullptr, Wo, scr, r, D / 32, F.lane, SrcId(), PROJ_FP8 ? WSCALE : 0.f); continue; } r -= I_O;
        if (r < NE * I_13) { const int e = r / I_13, q = r % I_13, nb = q % 32;
            const float* src = ((nb & 7) < 4 ? w1 : w3) + (size_t)e * D * FF; const int cb = (nb >> 3) * 128 + (nb & 3) * 32;
            struct SrcOff { int n0, cb; __device__ int operator()(int n) const { return cb + (n - n0); } } so{nb * 32, cb};
            if (MOE_FP8) cvt_item(src, D, FF, nullptr, (bf16_t*)((unsigned char*)W13 + (size_t)e * 1024 * D), scr, q, 32, F.lane, so, 16.f);
            else cvt_item(src, D, FF, nullptr, W13 + (size_t)e * 1024 * D, scr, q, 32, F.lane, so);
            continue; } r -= NE * I_13;
        { const int e = r / I_2, q = r % I_2;
          if (MOE_FP8) cvt_item(w2 + (size_t)e * FF * D, FF, D, nullptr, (bf16_t*)((unsigned char*)W2 + (size_t)e * D * FF), scr, q, D / 32, F.lane, SrcId(), 16.f);
          else cvt_item(w2 + (size_t)e * FF * D, FF, D, nullptr, W2 + (size_t)e * D * FF, scr, q, D / 32, F.lane, SrcId()); }
    }
}

template <int MODE>
__device__ __forceinline__ void row_phase(Frame& F, const float* xin, const float* g2prev, const float* gain, const float* modl, int sh_off, int sc_off, bf16_t* H, bf16_t* XB, float* OUT) {
    constexpr int RB = 4, RPW = T / (256 * NWAVES);
    const int gw = F.vcu * NWAVES + F.wave, b = (gw * RPW) >> 12;
    const bf16_t* Y2 = (const bf16_t*)(F.ws + WS_Y2);
    f32x4 gs[4], shv[4], g2v[4];
#pragma unroll
    for (int j = 0; j < 4; ++j) { const int c = 4 * F.lane + 256 * j; gs[j] = *(const f32x4*)(gain + c);
        if (MODE != 2) { gs[j] = gs[j] * (1.f + *(const f32x4*)(modl + (size_t)b * 6 * D + sc_off + c)); shv[j] = *(const f32x4*)(modl + (size_t)b * 6 * D + sh_off + c); }
        if (MODE != 0) g2v[j] = *(const f32x4*)(g2prev + (size_t)b * 6 * D + 5 * D + c); }
    for (int m0 = gw * RPW; m0 < gw * RPW + RPW; m0 += RB) {
        f32x4 v[RB][4]; float ss[RB];
        if (MODE == 0) {
#pragma unroll
            for (int r = 0; r < RB; ++r)
#pragma unroll
                for (int j = 0; j < 4; ++j) v[r][j] = *(const f32x4*)(xin + (size_t)(m0 + r) * D + 4 * F.lane + 256 * j);
        } else {
            unsigned ya[RB][4], yb[RB][4];
#pragma unroll
            for (int r = 0; r < RB; ++r)
#pragma unroll
                for (int j = 0; j < 4; ++j) { const int m = m0 + r, c = 4 * F.lane + 256 * j;
                    { const u32x2 xb = *(const u32x2*)(XB + (size_t)m * D + c); v[r][j] = (f32x4){bf2f(xb.x & 0xffffu), bf2f(xb.x >> 16), bf2f(xb.y & 0xffffu), bf2f(xb.y >> 16)}; }
                    ya[r][j] = *(const unsigned*)((const unsigned char*)Y2 + (size_t)(2 * m) * D + c); yb[r][j] = *(const unsigned*)((const unsigned char*)Y2 + (size_t)(2 * m + 1) * D + c); }
#pragma unroll
            for (int r = 0; r < RB; ++r)
#pragma unroll
                for (int j = 0; j < 4; ++j) { const f32x2 a0 = __builtin_amdgcn_cvt_pk_f32_fp8((int)ya[r][j], false), a1 = __builtin_amdgcn_cvt_pk_f32_fp8((int)ya[r][j], true), b0 = __builtin_amdgcn_cvt_pk_f32_fp8((int)yb[r][j], false), b1 = __builtin_amdgcn_cvt_pk_f32_fp8((int)yb[r][j], true);
                    const f32x4 y = (f32x4){a0[0] + b0[0], a0[1] + b0[1], a1[0] + b1[0], a1[1] + b1[1]} * 0.0625f;
                    v[r][j] += g2v[j] * y; }
        }
#pragma unroll
        for (int r = 0; r < RB; ++r) { ss[r] = (gp::dot4(v[r][0]) + gp::dot4(v[r][1])) + (gp::dot4(v[r][2]) + gp::dot4(v[r][3])); }
#pragma unroll
        for (int o = 1; o < 64; o <<= 1)
#pragma unroll
            for (int r = 0; r < RB; ++r) ss[r] += shfl_xor_l(ss[r], F.lane, o);
#pragma unroll
        for (int r = 0; r < RB; ++r) {
            const int m = m0 + r; const float rstd = rsqrtf(ss[r] * (1.f / D) + EPS);
#pragma unroll
            for (int j = 0; j < 4; ++j) {
                const int c = 4 * F.lane + 256 * j;
                if (MODE == 2) { *(f32x4*)(OUT + (size_t)m * D + c) = v[r][j] * rstd * gs[j]; }
                else {
                    { u32x2 xw; xw.x = cvt_pk_bf16(v[r][j][0], v[r][j][1]); xw.y = cvt_pk_bf16(v[r][j][2], v[r][j][3]); st8((XB + (size_t)m * D + c), xw); }
                    const f32x4 hv = v[r][j] * rstd * gs[j] + shv[j];
                    if (G1_FP8) { const f32x4 hq = hv * 0.0625f;
                        *(unsigned*)((unsigned char*)H + (size_t)m * D + c) = (unsigned)__builtin_amdgcn_cvt_pk_fp8_f32(hq[2], hq[3], __builtin_amdgcn_cvt_pk_fp8_f32(hq[0], hq[1], 0, false), true); }
                    else { u32x2 w; w.x = cvt_pk_bf16(hv[0], hv[1]); w.y = cvt_pk_bf16(hv[2], hv[3]);
                    st8((H + (size_t)m * D + c), w); }
                }
            }
        }
    }
}

__device__ __forceinline__ void t2_phase(Frame& F, const float* gain, const float* modl, const float* w_router, const float* rbias, int l, bool record) {
    LAS f32x4* wl = (LAS f32x4*)F.lds;
    LAS int* rec = (LAS int*)(F.lds + 65536);
    LAS float* recw = (LAS float*)(F.lds + 65536 + 2048);
    LAS int* lcnt = (LAS int*)(F.lds + 65536 + 4096);
    for (int idx = F.tid; idx < 4096; idx += NTHREADS) {
        const int lane = idx & 63, c = (idx >> 6) & 3, i = (idx >> 8) & 3, j = idx >> 10; const int k = 4 * lane + 256 * j + i;
        wl[idx] = *(const f32x4*)(w_router + (size_t)k * NE + 4 * c);
    }
    if (F.tid < 32) lcnt[F.tid] = 0;
    __syncthreads();
    constexpr int RB = 4, RPW = T / (256 * NWAVES);
    const int gw = F.vcu * NWAVES + F.wave, bt = (gw * RPW) >> 12;
    bf16_t* H = (bf16_t*)(F.ws + WS_H); const bf16_t* XB = (const bf16_t*)(F.ws + WS_XB);
    const int lane = F.lane, myrow = lane >> 4, mye = lane & 15;
    f32x4 gs[4], shv[4];
#pragma unroll
    for (int j = 0; j < 4; ++j) { const int c = 4 * lane + 256 * j; gs[j] = *(const f32x4*)(gain + c) * (1.f + *(const f32x4*)(modl + (size_t)bt * 6 * D + 4 * D + c)); shv[j] = *(const f32x4*)(modl + (size_t)bt * 6 * D + 3 * D + c); }
    int it = 0;
    for (int m0 = gw * RPW; m0 < gw * RPW + RPW; m0 += RB, ++it) {
        f32x4 v[RB][4]; float ss[RB];
#pragma unroll
        for (int r = 0; r < RB; ++r)
#pragma unroll
            for (int j = 0; j < 4; ++j) { const u32x2 xb = *(const u32x2*)(XB + (size_t)(m0 + r) * D + 4 * lane + 256 * j); v[r][j] = (f32x4){bf2f(xb.x & 0xffffu), bf2f(xb.x >> 16), bf2f(xb.y & 0xffffu), bf2f(xb.y >> 16)}; }
#pragma unroll
        for (int r = 0; r < RB; ++r) ss[r] = (gp::dot4(v[r][0]) + gp::dot4(v[r][1])) + (gp::dot4(v[r][2]) + gp::dot4(v[r][3]));
#pragma unroll
        for (int o = 1; o < 64; o <<= 1)
#pragma unroll
            for (int r = 0; r < RB; ++r) ss[r] += shfl_xor_l(ss[r], F.lane, o);
        float acc[RB * NE];
#pragma unroll
        for (int q = 0; q < RB * NE; ++q) acc[q] = 0.f;
#pragma unroll
        for (int j = 0; j < 4; ++j) {
            const int c = 4 * lane + 256 * j;
#pragma unroll
            for (int r = 0; r < RB; ++r) {
                const int m = m0 + r; const float rstd = rsqrtf(ss[r] * (1.f / D) + EPS);
                v[r][j] = v[r][j] * rstd * gs[j] + shv[j];
#if MOE_FP8
                *(unsigned*)((unsigned char*)H + (size_t)m * D + c) = (unsigned)__builtin_amdgcn_cvt_pk_fp8_f32(v[r][j][2], v[r][j][3], __builtin_amdgcn_cvt_pk_fp8_f32(v[r][j][0], v[r][j][1], 0, false), true);
#else
                u32x2 w; w.x = cvt_pk_bf16(v[r][j][0], v[r][j][1]); w.y = cvt_pk_bf16(v[r][j][2], v[r][j][3]);
                st8((H + (size_t)m * D + c), w);
#endif
            }
#pragma unroll
            for (int i = 0; i < 4; ++i)
#pragma unroll
                for (int c4 = 0; c4 < 4; ++c4) { const f32x4 wv = wl[((j * 4 + i) * 4 + c4) * 64 + lane];
#pragma unroll
                    for (int r = 0; r < RB; ++r) { const float hv = v[r][j][i];
                        acc[r * NE + 4 * c4 + 0] += hv * wv[0]; acc[r * NE + 4 * c4 + 1] += hv * wv[1]; acc[r * NE + 4 * c4 + 2] += hv * wv[2]; acc[r * NE + 4 * c4 + 3] += hv * wv[3]; } }
        }
#pragma unroll
        for (int sft = 32; sft >= 1; sft >>= 1) {
            const bool up = (lane & sft) != 0;
#pragma unroll
            for (int k = 0; k < sft; ++k) { const float a = acc[k], b = acc[k + sft]; const float keep = up ? b : a, send = up ? a : b; acc[k] = keep + shfl_xor_l(send, lane, sft); }
        }
        const float logit = acc[0];
        const float score = 1.f / (1.f + expf(-logit));
        float scv[NE], bi[NE];
#pragma unroll
        for (int e = 0; e < NE; ++e) { scv[e] = shfl_l(score, (lane & 48) | e); bi[e] = scv[e] + rbias[e]; }
        int gsel = 0; float gbest = -INFINITY;
#pragma unroll
        for (int g = 0; g < 4; ++g) { float m1 = -INFINITY, m2 = -INFINITY;
#pragma unroll
            for (int j = 0; j < 4; ++j) { const float x = bi[g * 4 + j]; if (x > m1) { m2 = m1; m1 = x; } else if (x > m2) m2 = x; }
            const float gs = m1 + m2; if (gs > gbest) { gbest = gs; gsel = g; } }
        int e1 = -1, e2 = -1; float b1 = -INFINITY, b2 = -INFINITY, s1 = 0.f, s2 = 0.f;
#pragma unroll
        for (int j = 0; j < 4; ++j) { float x = -INFINITY, sx = 0.f;
#pragma unroll
            for (int g = 0; g < 4; ++g) if (g == gsel) { x = bi[g * 4 + j]; sx = scv[g * 4 + j]; }
            const int e = gsel * 4 + j;
            if (x > b1) { b2 = b1; e2 = e1; s2 = s1; b1 = x; e1 = e; s1 = sx; } else if (x > b2) { b2 = x; e2 = e; s2 = sx; } }
        if (mye == 0) {
            const float inv = 1.f / (s1 + s2); const int slot = (it * RB + myrow) * NWAVES + F.wave;
            rec[slot * 4 + 0] = e1; rec[slot * 4 + 1] = e2;
            rec[slot * 4 + 2] = __hip_atomic_fetch_add(&lcnt[e1], 1, __ATOMIC_RELAXED, __HIP_MEMORY_SCOPE_WORKGROUP);
            rec[slot * 4 + 3] = __hip_atomic_fetch_add(&lcnt[e2], 1, __ATOMIC_RELAXED, __HIP_MEMORY_SCOPE_WORKGROUP);
            recw[slot * 2 + 0] = s1 * inv; recw[slot * 2 + 1] = s2 * inv;
        }
    }
    __syncthreads();
    if (!record) return;
    if (F.tid < NE) lcnt[16 + F.tid] = (int)__hip_atomic_fetch_add(F.ctl + CW_CNT + (l * NE + F.tid) * 64, (unsigned)lcnt[F.tid], __ATOMIC_RELAXED, __HIP_MEMORY_SCOPE_AGENT);
    __syncthreads();
    unsigned* list = (unsigned*)(F.ws + WS_LIST); float* gwb = (float*)(F.ws + WS_GW);
    const int nrows = it * RB;
    for (int s = F.tid; s < nrows * NWAVES; s += NTHREADS) {
        const int i2 = s / NWAVES, w = s % NWAVES; const int m = (F.vcu * NWAVES + w) * RPW + i2;
        const int e1 = rec[s * 4 + 0], e2 = rec[s * 4 + 1];
        list[(size_t)e1 * T + lcnt[16 + e1] + rec[s * 4 + 2]] = (unsigned)(2 * m); list[(size_t)e2 * T + lcnt[16 + e2] + rec[s * 4 + 3]] = (unsigned)(2 * m + 1);
        gwb[2 * m] = recw[s * 2]; gwb[2 * m + 1] = recw[s * 2 + 1];
    }
}
__device__ __forceinline__ LAS int* moe_table(Frame& F, int l) {
    LAS int* tab = (LAS int*)(F.lds + MISC_OFF + 1024);
    __syncthreads();
    if (F.tid == 0) { int acc = 0;
        for (int e = 0; e < NE; ++e) { const int c = (int)__hip_atomic_load(F.ctl + CW_CNT + (l * NE + e) * 64, __ATOMIC_RELAXED, __HIP_MEMORY_SCOPE_AGENT); tab[e] = acc; tab[32 + e] = c; acc += (c + 255) >> 8; }
        tab[16] = acc; }
    __syncthreads();
    return tab;
}

typedef __attribute__((address_space(4))) const Args CArgs;
__device__ __forceinline__ void xcd_local_barrier(const XcdBarrier& b) {
    asm volatile("s_waitcnt vmcnt(0)" ::: "memory");
    __syncthreads();
    if (threadIdx.x == 0) {
        unsigned* bar = b.bar;
        __builtin_amdgcn_s_waitcnt(0);
        const unsigned nloc = b.st[0];
        const unsigned old = xb_add(&bar[XB_LSUB(b.x)], 1u);
        const unsigned gen = old / nloc;
        if (old + 1u == (gen + 1u) * nloc) xb_add(&bar[XB_LGEN(b.x)], 1u);
        else XB_SPIN(xb_ld(&bar[XB_LGEN(b.x)]) == gen, bar);
        __builtin_amdgcn_fence(__ATOMIC_ACQUIRE, "agent");
        asm volatile("s_waitcnt vmcnt(0)" ::: "memory");
    }
    __syncthreads();
}
#define LAUNDER_GP(T_, p) do { GAS T_* _t = (GAS T_*)(p); asm volatile("" : "+s"(_t)); (p) = (T_*)_t; } while (0)
#define PH_BEGIN() LAUNDER_V(F.tid); F.lane = F.tid & 63; LAUNDER_GP(unsigned, F.ctl); LAUNDER_GP(float, F.OUT); LAUNDER_GP(unsigned char, F.ws); GAS unsigned char* ws = (GAS unsigned char*)F.ws; CArgs* ka = (CArgs*)__builtin_amdgcn_kernarg_segment_ptr(); LAUNDER_S(ka); \
    float* mod = WSP(float, WS_MOD); (void)mod; (void)ka
#define WSP(T_, off) ((T_*)(GAS T_*)(ws + (off)))
#define KIN(i) ((const float*)(GAS const float*)ka->in[i])
__global__ void __launch_bounds__(NTHREADS, 2) fwd_kernel(Args args) {
    extern __shared__ __attribute__((aligned(16))) unsigned char lds_raw[];
    Frame F;
    F.lds = (LAS unsigned char*)lds_raw; F.MISC = (volatile LAS unsigned*)(F.lds + MISC_OFF);
    F.tid = threadIdx.x; F.lane = F.tid & 63; F.wave = __builtin_amdgcn_readfirstlane(F.tid >> 6);
    F.G = gridDim.x; { const int bx = blockIdx.x; F.vcu = (F.G % 8 == 0) ? (bx % 8) * (F.G / 8) + bx / 8 : bx; }
    F.ws = (unsigned char*)(GAS unsigned char*)args.ws; F.ctl = (unsigned*)(GAS unsigned*)(args.ws + WS_CTL); F.OUT = (float*)(GAS float*)args.out;
    if (F.tid < 64) F.MISC[F.tid] = 0u;
    __syncthreads();
    XcdBarrier bar; bar.bar = F.ctl + CW_BAR; bar.x = 0; bar.st = nullptr;
    if (!N_LAUNCH_MODE) bar = xcd_barrier_post(F.ctl + CW_BAR, F.MISC + 8);
    const int lo = args.ph_lo, hi = args.ph_hi;
#define IN(k) (lo <= (k) && (k) < hi)
#define SEAM(k) do { if ((k) + 1 < hi) { if (!N_LAUNCH_MODE) xcd_barrier(bar); } } while (0)
    int cidx = (int)blockIdx.x; bool lseam = false;
#define SEAML(k) do { if ((k) + 1 < hi) { if (!N_LAUNCH_MODE) { if (lseam) xcd_local_barrier(bar); else xcd_barrier(bar); } } } while (0)

    if (IN(0)) { PH_BEGIN(); p0_phase(F, KIN(1), KIN(2), KIN(3)); __syncthreads(); LAUNDER_V(F.tid); F.lane = F.tid & 63; convert_weights(F, ka, 0); SEAM(0);
        if (XCD_LOCAL_SEAMS && !N_LAUNCH_MODE && F.G == 256) {
            bool ok = true;
            for (int j = 0; j < 8; ++j) ok = ok && (xb_ld(F.ctl + CW_BAR + XB_XCNT(j)) == 32u);
            ok = __builtin_amdgcn_readfirstlane(ok ? 1 : 0) != 0;
            if (ok) { const int rk = __builtin_amdgcn_readfirstlane((int)F.MISC[10]), xx = (int)bar.x; F.vcu = xx * 32 + rk; cidx = rk * 8 + xx; lseam = true; } } }
    for (int l = 0; l < NL; ++l) {
        const int pb = 1 + 9 * l;
        if (IN(pb + 0)) {
            PH_BEGIN();
            if (l > 0) for (int rep = 0; rep < ((PROBE_DUP & 8) ? 2 : 1); ++rep) { LAUNDER_V(F.tid); F.lane = F.tid & 63; convert_weights(F, ka, l); }
            if (l == 0) row_phase<0>(F, KIN(0), nullptr, KIN(4) + l * D, mod + (size_t)l * NB * 6 * D, 0, D, WSP(bf16_t, WS_H), WSP(bf16_t, WS_XB), nullptr);
            else row_phase<1>(F, nullptr, mod + (size_t)(l - 1) * NB * 6 * D, KIN(4) + l * D, mod + (size_t)l * NB * 6 * D, 0, D, WSP(bf16_t, WS_H), WSP(bf16_t, WS_XB), nullptr);
            SEAM(pb + 0);
        }
        if (IN(pb + 1)) {
            PH_BEGIN();
            gp::Gemm g{WSP(bf16_t, WS_H), WSP(const bf16_t, WS_WIN), G1_FP8 ? D / 2 : D, 0, nullptr, 0, 0, 0}; gp::DenseOrder So; So.init(T, NIN, F.G, cidx);
            gp::EpiIn E{WSP(bf16_t, ATT_FP8_A ? WS_QA8 : WS_QA), WSP(bf16_t, ATT_FP8_A ? WS_KA8 : WS_KA), WSP(bf16_t, ATT_FP8_A ? WS_VTA8 : WS_VA), WSP(bf16_t, WS_QLAT), WSP(bf16_t, WS_KVLAT), WSP(bf16_t, ATT_FP8_B ? WS_KB8 : WS_KB), WSP(bf16_t, WS_SA), WSP(bf16_t, WS_SB), WSP(float, WS_SSQ), WSP(float, WS_SSKV),
                        KIN(6) + l * 64, KIN(7) + l * 64, WSP(const float, WS_COSA), WSP(const float, WS_SINA), WSP(const float, WS_COSB), WSP(const float, WS_SINB)};
            if (PROBE_DUP & 128) { gp::EpiNull En; gp::gemm_phase<gp::EpiNull, gp::DenseOrder>(F.tid, F.lds, g, So, En); LAUNDER_V(F.tid); }
            gp::gemm_phase<gp::EpiIn, gp::DenseOrder, false, G1_FP8 != 0>(F.tid, F.lds, g, So, E); if (PROBE_DUP & (2 | 512)) { LAUNDER_V(F.tid); gp::gemm_phase<gp::EpiIn, gp::DenseOrder, false, G1_FP8 != 0>(F.tid, F.lds, g, So, E); }
            SEAML(pb + 1);
        }
        if (IN(pb + 2)) {
            { PH_BEGIN(); gp::Gemm g{WSP(bf16_t, WS_QLAT), WSP(const bf16_t, WS_WQB), 384, 0, nullptr}; gp::DenseOrder So; So.init(T, 768, F.G, cidx);
              gp::EpiQb E{WSP(bf16_t, ATT_FP8_B ? WS_QB8 : WS_QB), WSP(const float, WS_SSQ), WSP(const float, WS_COSB), WSP(const float, WS_SINB)}; gp::gemm_phase<gp::EpiQb, gp::DenseOrder>(F.tid, F.lds, g, So, E); if (PROBE_DUP & 2) { LAUNDER_V(F.tid); gp::gemm_phase<gp::EpiQb, gp::DenseOrder>(F.tid, F.lds, g, So, E); } }
            { PH_BEGIN(); gp::Gemm g{WSP(bf16_t, WS_KVLAT), WSP(const bf16_t, WS_WKVB), 256, 0, nullptr}; gp::DenseOrder So; So.init(T, 1024, F.G, cidx);
              gp::EpiKvb E{WSP(bf16_t, ATT_FP8_B ? WS_KB8 : WS_KB), WSP(bf16_t, ATT_FP8_B ? WS_VTB8 : WS_VB), WSP(const float, WS_SSKV)}; gp::gemm_phase<gp::EpiKvb, gp::DenseOrder>(F.tid, F.lds, g, So, E); if (PROBE_DUP & 2) { LAUNDER_V(F.tid); gp::gemm_phase<gp::EpiKvb, gp::DenseOrder>(F.tid, F.lds, g, So, E); } }
#if FAST_ATTN && ATT_FP8_A
            { PH_BEGIN(); at::attn_phase_f8a(F.tid, F.lds, WSP(const unsigned char, WS_QA8), WSP(const unsigned char, WS_KA8), WSP(const unsigned char, WS_VTA8), WSP(bf16_t, WS_QA), 512, KIN(6) + l * 64, KIN(7) + l * 64, F.vcu, F.G); }
            if (PROBE_DUP & (1 | 4096)) { PH_BEGIN(); at::attn_phase_f8a(F.tid, F.lds, WSP(const unsigned char, WS_QA8), WSP(const unsigned char, WS_KA8), WSP(const unsigned char, WS_VTA8), WSP(bf16_t, WS_QA), 512, KIN(6) + l * 64, KIN(7) + l * 64, F.vcu, F.G); }
#else
            { PH_BEGIN(); const at::Tensors A{WSP(bf16_t, WS_QA), 512, WSP(bf16_t, WS_KA), 128, WSP(bf16_t, WS_VA), 128, WSP(bf16_t, WS_QA), 512, 4}; at::attn_phase<64>(F.tid, F.lds, A, F.vcu, F.G); }
#endif
            SEAML(pb + 2);
        }
        if (IN(pb + 3)) {
            PH_BEGIN();
#if FAST_ATTN && ATT_FP8_B
            at::attn_phase_f8b(F.tid, F.lds, WSP(const unsigned char, WS_QB8), WSP(const unsigned char, WS_KB8), WSP(const unsigned char, WS_VTB8), WSP(bf16_t, WS_OB), 512, F.vcu, F.G);
            if (PROBE_DUP & (1 | 8192)) { LAUNDER_V(F.tid); at::attn_phase_f8b(F.tid, F.lds, WSP(const unsigned char, WS_QB8), WSP(const unsigned char, WS_KB8), WSP(const unsigned char, WS_VTB8), WSP(bf16_t, WS_OB), 512, F.vcu, F.G); }
#else
            const at::Tensors A{WSP(bf16_t, WS_QB), 768, WSP(bf16_t, WS_KB), 768, WSP(bf16_t, WS_VB), 512, WSP(bf16_t, WS_OB), 512, 1}; for (int rep = 0; rep < ((PROBE_DUP & 1) ? 2 : 1); ++rep) at::attn_phase<96>(F.tid, F.lds, A, F.vcu, F.G);
#endif
            SEAML(pb + 3);
        }
        if (IN(pb + 4)) {
            PH_BEGIN();
            gp::Gemm g{WSP(bf16_t, WS_QA), WSP(const bf16_t, WS_WPA), PROJ_FP8 ? 256 : 512, (size_t)(WS_WPB - WS_WPA) / 2, nullptr, (size_t)(WS_OB - WS_QA) / 2, 0, 0}; gp::PairOrder So; So.init(T, D, F.G, cidx);
            gp::EpiProjP E{WSP(bf16_t, WS_H), WSP(const unsigned char, WS_SA), WSP(const unsigned char, WS_SB)};
            gp::gemm_phase<gp::EpiProjP, gp::PairOrder, false, PROJ_FP8 != 0>(F.tid, F.lds, g, So, E);
            if (PROBE_DUP & (2 | 1024)) { LAUNDER_V(F.tid); gp::gemm_phase<gp::EpiProjP, gp::PairOrder, false, PROJ_FP8 != 0>(F.tid, F.lds, g, So, E); }
            SEAML(pb + 4);
        }
        if (IN(pb + 5)) {
            PH_BEGIN();
            gp::Gemm g{WSP(bf16_t, WS_H), WSP(const bf16_t, WS_WO), PROJ_FP8 ? D / 2 : D, 0, nullptr, 0, 0, 0}; gp::DenseOrder So; So.init(T, D, F.G, cidx);
            if (PROBE_DUP & 2048) { gp::EpiNull En; gp::gemm_phase<gp::EpiNull, gp::DenseOrder>(F.tid, F.lds, g, So, En); LAUNDER_V(F.tid); }
            gp::EpiWo E{WSP(const bf16_t, WS_XB), mod + (size_t)l * NB * 6 * D, WSP(bf16_t, WS_XB)}; gp::gemm_phase<gp::EpiWo, gp::DenseOrder, false, PROJ_FP8 != 0>(F.tid, F.lds, g, So, E);
            SEAML(pb + 5);
        }
        if (IN(pb + 6)) {
            PH_BEGIN();
            if (PROBE_DUP & 16) { t2_phase(F, KIN(15) + l * D, mod + (size_t)l * NB * 6 * D, KIN(16), KIN(17), l, false); LAUNDER_V(F.tid); F.lane = F.tid & 63; __syncthreads(); }
            t2_phase(F, KIN(15) + l * D, mod + (size_t)l * NB * 6 * D, KIN(16), KIN(17), l, true);
            SEAM(pb + 6);
        }
        if (IN(pb + 7)) {
            PH_BEGIN();
            LAS int* tab = moe_table(F, l);
#if MOE_FP8
            gp::Gemm g{WSP(bf16_t, WS_H), WSP(const bf16_t, WS_W13), D / 2, (size_t)1024 * D / 2, WSP(const unsigned, WS_LIST), 0, 0, 0}; gp::MoeOrder So; So.init(tab, F.G, cidx);
            gp::EpiUp E{WSP(bf16_t, WS_ACT), 1.f / 16.f}; gp::gemm_phase<gp::EpiUp, gp::MoeOrder, true, true>(F.tid, F.lds, g, So, E);
            if (PROBE_DUP & 4) { LAUNDER_V(F.tid); gp::gemm_phase<gp::EpiUp, gp::MoeOrder, true, true>(F.tid, F.lds, g, So, E); }
#else
            gp::Gemm g{WSP(bf16_t, WS_H), WSP(const bf16_t, WS_W13), D, (size_t)1024 * D, WSP(const unsigned, WS_LIST)}; gp::MoeOrder So; So.init(tab, F.G, cidx);
            gp::EpiUp E{WSP(bf16_t, WS_ACT), 1.f}; gp::gemm_phase<gp::EpiUp, gp::MoeOrder, true>(F.tid, F.lds, g, So, E);
#endif
            SEAML(pb + 7);
        }
        if (IN(pb + 8)) {
            PH_BEGIN();
            LAS int* tab = moe_table(F, l);
#if MOE_FP8
            gp::Gemm g{WSP(bf16_t, WS_ACT), WSP(const bf16_t, WS_W2), FF / 2, (size_t)D * FF / 2, nullptr, 0, 0, 0}; gp::MoeOrder So; So.init(tab, F.G, cidx);
            gp::EpiDown E{WSP(bf16_t, WS_Y2), WSP(const unsigned, WS_LIST), WSP(const float, WS_GW), 1.f / 128.f}; gp::gemm_phase<gp::EpiDown, gp::MoeOrder, false, true>(F.tid, F.lds, g, So, E);
            if (PROBE_DUP & 4) { LAUNDER_V(F.tid); gp::gemm_phase<gp::EpiDown, gp::MoeOrder, false, true>(F.tid, F.lds, g, So, E); }
#else
            gp::Gemm g{WSP(bf16_t, WS_ACT), WSP(const bf16_t, WS_W2), FF, (size_t)D * FF, nullptr}; gp::MoeOrder So; So.init(tab, F.G, cidx);
            gp::EpiDown E{WSP(bf16_t, WS_Y2), WSP(const unsigned, WS_LIST), WSP(const float, WS_GW), 1.f}; gp::gemm_phase<gp::EpiDown, gp::MoeOrder, false>(F.tid, F.lds, g, So, E);
#endif
            SEAM(pb + 8);
        }
    }
    if (IN(NPHASE - 1)) { PH_BEGIN(); row_phase<2>(F, nullptr, mod + (size_t)(NL - 1) * NB * 6 * D, KIN(21), nullptr, 0, 0, nullptr, WSP(bf16_t, WS_XB), F.OUT); }
#undef IN
#undef SEAM
#undef SEAML
}

extern "C" void kernel_launch(void* const* d_in, const int* in_sizes, int n_in, void* d_out, int out_size, void* d_ws, size_t ws_size, hipStream_t stream) {
    static int grid = 0;
    if (grid == 0) {
        if (n_in != 22 || out_size != T * D || ws_size < WS_END) { fprintf(stderr, "kernel_launch: unexpected problem (n_in %d out %d ws %zu)\n", n_in, out_size, ws_size); grid = -1; return; }
        int dev = 0, cus = 0, per_cu = 0;
        if (hipGetDevice(&dev) != hipSuccess || hipDeviceGetAttribute(&cus, hipDeviceAttributeMultiprocessorCount, dev) != hipSuccess) { grid = -1; return; }
        if (hipFuncSetAttribute((const void*)fwd_kernel, hipFuncAttributeMaxDynamicSharedMemorySize, LDS_BYTES) != hipSuccess) { grid = -1; return; }
        if (hipOccupancyMaxActiveBlocksPerMultiprocessor(&per_cu, (const void*)fwd_kernel, NTHREADS, LDS_BYTES) != hipSuccess || per_cu < 1) { fprintf(stderr, "kernel_launch: occupancy query says %d\n", per_cu); }
        (void)hipGetLastError();
        grid = cus;
        if (grid != 256 || T % (grid * NWAVES * 4) != 0) {   fprintf(stderr, "kernel_launch: grid %d does not divide the row phases\n", grid); grid = -1; return; }
    }
    if (grid < 0) return;
    (void)hipMemsetAsync((char*)d_ws + WS_CTL, 0, CTL_BYTES, stream);
    Args a{};
    for (int i = 0; i < 22; ++i) a.in[i] = (const float*)d_in[i];
    a.out = (float*)d_out; a.ws = (unsigned char*)d_ws;
#if N_LAUNCH_MODE
    for (int p = 0; p < NPHASE; ++p) { a.ph_lo = p; a.ph_hi = p + 1; hipLaunchKernelGGL(fwd_kernel, dim3(grid), dim3(NTHREADS), LDS_BYTES, stream, a); }
#else
    a.ph_lo = 0; a.ph_hi = NPHASE;
    hipLaunchKernelGGL(fwd_kernel, dim3(grid), dim3(NTHREADS), LDS_BYTES, stream, a);
#endif
}
```

```cpp
#include <hip/hip_runtime.h>
#include <stdint.h>
#include <stdio.h>
#include <math.h>

#ifndef FAST_GEMM
#define FAST_GEMM 1
#endif
#ifndef FAST_ATTN
#define FAST_ATTN 1
#endif
#ifndef PROBE_DUP
#define PROBE_DUP 0
#endif
#ifndef PROBE_ATT
#define PROBE_ATT 0
#endif
#ifndef ATT_REGSTAGE
#define ATT_REGSTAGE 0
#endif
#ifndef WT_STORES
#define WT_STORES 0
#endif
#ifndef ATT_FP8_A
#define ATT_FP8_A 1
#endif
#ifndef ATT_FP8_B
#define ATT_FP8_B 1
#endif
#ifndef MOE_FP8
#define MOE_FP8 1
#endif
#ifndef G1_FP8
#define G1_FP8 1
#endif
#ifndef PROJ_FP8
#define PROJ_FP8 1
#endif
#ifndef XCD_LOCAL_SEAMS
#define XCD_LOCAL_SEAMS 1
#endif
#ifndef GATES_LATE
#define GATES_LATE 1
#endif
#ifndef N_LAUNCH_MODE
#define N_LAUNCH_MODE 0
#endif

#define LAS __attribute__((address_space(3)))
#define GAS __attribute__((address_space(1)))
typedef unsigned short bf16_t;
typedef short bf16x8 __attribute__((ext_vector_type(8)));
typedef float f32x4 __attribute__((ext_vector_type(4)));
typedef float f32x2 __attribute__((ext_vector_type(2)));
typedef float f32x16 __attribute__((ext_vector_type(16)));
typedef unsigned u32x4 __attribute__((ext_vector_type(4)));
typedef unsigned u32x2 __attribute__((ext_vector_type(2)));
typedef GAS unsigned gu32;

constexpr int D = 1024, NB = 8, S = 4096, T = NB * S, NL = 4, INC = 3488, NIN = 3584, NE = 16, FF = 512;
constexpr float EPS = 1e-6f, LOG2E = 1.4426950408889634f;
constexpr float QSCALE_A = 0.125f * LOG2E, QSCALE_B = 0.10206207261596577f * LOG2E;
constexpr float PFOLD = 4.f, PBYTE0 = 60.26f;
constexpr float OSCALE = 64.f, WSCALE = 16.f;
constexpr int NWAVES = 8, NTHREADS = 512;
constexpr int NPHASE = 2 + 9 * NL;

constexpr size_t MiB = 1u << 20;
constexpr size_t WS_CTL = 0, CTL_BYTES = 1 * MiB;
constexpr size_t WS_MOD = 1 * MiB;
constexpr size_t WS_COSA = 2 * MiB, WS_SINA = WS_COSA + 512 * 1024, WS_COSB = 3 * MiB, WS_SINB = WS_COSB + 256 * 1024;
constexpr size_t WS_SSQ = 4 * MiB, WS_SSKV = 5 * MiB;
constexpr size_t WS_GW = 6 * MiB;
constexpr size_t WS_LIST = 7 * MiB;
constexpr size_t WS_WIN = 10 * MiB, WS_WQB = 17 * MiB, WS_WKVB = 18 * MiB, WS_WPA = 19 * MiB, WS_WPB = 20 * MiB, WS_WO = 21 * MiB, WS_W13 = 23 * MiB, WS_W2 = 55 * MiB;
constexpr size_t WS_H = 72 * MiB;
constexpr size_t WS_QA = 136 * MiB, WS_KA = 168 * MiB, WS_VA = 176 * MiB, WS_QLAT = 184 * MiB, WS_KVLAT = 208 * MiB;
constexpr size_t WS_KB = 224 * MiB, WS_VB = 272 * MiB, WS_QB = 304 * MiB, WS_OB = 352 * MiB, WS_SA = 384 * MiB, WS_SB = 448 * MiB, WS_XB = 512 * MiB, WS_QA8 = 576 * MiB, WS_KA8 = 592 * MiB, WS_VTA8 = 596 * MiB, WS_QB8 = 600 * MiB, WS_KB8 = 624 * MiB, WS_VTB8 = 648 * MiB, WS_END = 664 * MiB;
constexpr size_t WS_ACT = 136 * MiB, WS_Y2 = 208 * MiB;
constexpr int ACT_ROWS = 2 * T + NE * 256;
static_assert(WS_ACT + (size_t)ACT_ROWS * FF * 2 <= WS_Y2 && WS_Y2 + (size_t)2 * T * D * 2 <= WS_XB, "moe overlay");
constexpr int CW_BAR = 4096;
constexpr int CW_TILE = 32768;
constexpr int CW_CNT = 16384;

constexpr int RING_BYTES = 131072, MISC_OFF = RING_BYTES, LDS_BYTES = 147456;

__device__ __forceinline__ float bf2f(unsigned v) { return __uint_as_float(v << 16); }
typedef __bf16 bf16x2_t __attribute__((ext_vector_type(2)));
__device__ __forceinline__ unsigned cvt_pk_bf16(float lo, float hi) { f32x2 v = {lo, hi}; bf16x2_t b = __builtin_convertvector(v, bf16x2_t); return __builtin_bit_cast(unsigned, b); }
__device__ __forceinline__ u32x4 pack8(f32x4 a, f32x4 b) { u32x4 w; w.x = cvt_pk_bf16(a[0], a[1]); w.y = cvt_pk_bf16(a[2], a[3]); w.z = cvt_pk_bf16(b[0], b[1]); w.w = cvt_pk_bf16(b[2], b[3]); return w; }
__device__ __forceinline__ u32x2 pack8_fp8(f32x4 a, f32x4 b) { u32x2 w;
    w.x = (unsigned)__builtin_amdgcn_cvt_pk_fp8_f32(a[2], a[3], __builtin_amdgcn_cvt_pk_fp8_f32(a[0], a[1], 0, false), true);
    w.y = (unsigned)__builtin_amdgcn_cvt_pk_fp8_f32(b[2], b[3], __builtin_amdgcn_cvt_pk_fp8_f32(b[0], b[1], 0, false), true); return w; }
__device__ __forceinline__ u32x4 pair16(u32x2 w0, u32x2 w1) {
    const auto x = __builtin_amdgcn_permlane16_swap(w0.x, w1.x, false, false); const auto y = __builtin_amdgcn_permlane16_swap(w0.y, w1.y, false, false);
    return (u32x4){x[0], y[0], x[1], y[1]};
}
__device__ __forceinline__ void unpack8(u32x4 w, f32x4& a, f32x4& b) { a[0] = bf2f(w.x & 0xffffu); a[1] = bf2f(w.x >> 16); a[2] = bf2f(w.y & 0xffffu); a[3] = bf2f(w.y >> 16); b[0] = bf2f(w.z & 0xffffu); b[1] = bf2f(w.z >> 16); b[2] = bf2f(w.w & 0xffffu); b[3] = bf2f(w.w >> 16); }
__device__ __forceinline__ float shfl_xor_l(float v, int lane, int m) { return __int_as_float(__builtin_amdgcn_ds_bpermute((lane ^ m) << 2, __float_as_int(v))); }
__device__ __forceinline__ float shfl_l(float v, int src) { return __int_as_float(__builtin_amdgcn_ds_bpermute(src << 2, __float_as_int(v))); }
__device__ __forceinline__ float sum_xor16(float v) { const auto r = __builtin_amdgcn_permlane16_swap(__float_as_uint(v), __float_as_uint(v), false, false); return __uint_as_float(r[0]) + __uint_as_float(r[1]); }
__device__ __forceinline__ float sum_xor32(float v) { const auto r = __builtin_amdgcn_permlane32_swap(__float_as_uint(v), __float_as_uint(v), false, false); return __uint_as_float(r[0]) + __uint_as_float(r[1]); }
__device__ __forceinline__ float wave_sum(float v, int lane) {
#pragma unroll
    for (int o = 1; o < 64; o <<= 1) v += shfl_xor_l(v, lane, o);
    return v;
}
__device__ __forceinline__ float sigm(float v) { return __builtin_amdgcn_rcpf(1.f + __builtin_amdgcn_exp2f(v * (-LOG2E))); }
#if WT_STORES
__device__ __forceinline__ void st16(void* p, u32x4 v) { asm volatile("global_store_dwordx4 %0, %1, off sc1\n\ts_nop 1" :: "v"(p), "v"(v) : "memory"); }
__device__ __forceinline__ void st8(void* p, u32x2 v) { asm volatile("global_store_dwordx2 %0, %1, off sc1\n\ts_nop 1" :: "v"(p), "v"(v) : "memory"); }
#else
__device__ __forceinline__ void st16(void* p, u32x4 v) { *(u32x4*)p = v; }
__device__ __forceinline__ void st8(void* p, u32x2 v) { *(u32x2*)p = v; }
#endif
#define VM_WAIT() asm volatile("s_waitcnt vmcnt(0)" ::: "memory")
#define LAUNDER_S(p) asm volatile("" : "+s"(p))
#define LAUNDER_V(v) asm volatile("" : "+v"(v))
#define LDS_WAIT() asm volatile("s_waitcnt lgkmcnt(0)" ::: "memory")

#define XB_TMO      128
#define XB_XCNT(j)  (256  + 64 * (j))
#define XB_XSUB(j)  (1280 + 64 * (j))
#define XB_XGEN(j)  (2304 + 64 * (j))
#define XB_TOP      3328
#define XB_TOPGEN   3392
#define XCD_BAR_WORDS 3456
#define XB_LSUB(j)  (3456 + 64 * (j))
#define XB_LGEN(j)  (3456 + 1024 + 64 * (j))
#define XB_SPIN_CAP (1u << 22)
__device__ __forceinline__ unsigned xb_ld(unsigned* p)              { return __hip_atomic_load(p, __ATOMIC_RELAXED, __HIP_MEMORY_SCOPE_AGENT); }
__device__ __forceinline__ unsigned xb_add(unsigned* p, unsigned v) { return __hip_atomic_fetch_add(p, v, __ATOMIC_RELAXED, __HIP_MEMORY_SCOPE_AGENT); }
__device__ __forceinline__ unsigned xb_xcc_id() { return (unsigned)__builtin_amdgcn_s_getreg((3 << 11) | 20) & 0xFu; }
#define XB_SPIN(cond, bar) do { unsigned _sp = 0; while (cond) { __builtin_amdgcn_s_sleep(1); \
    if ((++_sp & 255u) == 0u) { if (xb_ld(&(bar)[XB_TMO])) break; if (_sp > XB_SPIN_CAP) { atomicAdd(&(bar)[XB_TMO], 1u); break; } } } } while (0)
struct XcdBarrier { unsigned* bar; unsigned x; volatile LAS unsigned* st; };
__device__ __forceinline__ XcdBarrier xcd_barrier_post(unsigned* bar, volatile LAS unsigned* st) {
    XcdBarrier b; b.bar = bar; b.x = xb_xcc_id(); b.st = st;
    if (threadIdx.x == 0) st[2] = xb_add(&bar[XB_XCNT(b.x)], 1u);
    return b;
}
__device__ __forceinline__ void xcd_barrier_complete(unsigned* bar, unsigned x, unsigned& nloc, unsigned& nx) {
    const unsigned G = gridDim.x * gridDim.y * gridDim.z;
    unsigned sum, cnt, mine, sp = 0u;
    for (;;) {
        sum = 0u; cnt = 0u; mine = 0u;
#pragma unroll
        for (unsigned j = 0; j < 16; ++j) { const unsigned c = xb_ld(&bar[XB_XCNT(j)]); sum += c; cnt += (c > 0u) ? 1u : 0u; mine = (j == x) ? c : mine; }
        if (sum == G) break;
        __builtin_amdgcn_s_sleep(1);
        if ((++sp & 255u) == 0u) { if (xb_ld(&bar[XB_TMO])) break; if (sp > XB_SPIN_CAP) { atomicAdd(&bar[XB_TMO], 1u); break; } }
    }
    nloc = mine > 0u ? mine : 1u; nx = cnt > 0u ? cnt : 1u;
}
__device__ __forceinline__ void xcd_barrier(const XcdBarrier& b) {
    asm volatile("s_waitcnt vmcnt(0)" ::: "memory");
    __syncthreads();
    if (threadIdx.x == 0) {
        unsigned* bar = b.bar;
        __builtin_amdgcn_s_waitcnt(0);
        unsigned nloc = b.st[0], nx = b.st[1];
        if (nloc == 0u) { xcd_barrier_complete(bar, b.x, nloc, nx); b.st[0] = nloc; b.st[1] = nx; }
        const unsigned old = xb_add(&bar[XB_XSUB(b.x)], 1u);
        const unsigned gen = old / nloc;
        if (old + 1u == (gen + 1u) * nloc) {
            __builtin_amdgcn_fence(__ATOMIC_RELEASE, "agent");
            asm volatile("s_waitcnt vmcnt(0)" ::: "memory");
            const unsigned og = xb_add(&bar[XB_TOP], 1u);
            const unsigned tg = og / nx;
            if (og + 1u == (tg + 1u) * nx) xb_add(&bar[XB_TOPGEN], 1u);
            else XB_SPIN(xb_ld(&bar[XB_TOPGEN]) == tg, bar);
            __builtin_amdgcn_fence(__ATOMIC_ACQUIRE, "agent");
            xb_add(&bar[XB_XGEN(b.x)], 1u);
            asm volatile("s_waitcnt vmcnt(0)" ::: "memory");
        } else {
            XB_SPIN(xb_ld(&bar[XB_XGEN(b.x)]) == gen, bar);
            __builtin_amdgcn_fence(__ATOMIC_ACQUIRE, "agent");
            asm volatile("s_waitcnt vmcnt(0)" ::: "memory");
        }
    }
    __syncthreads();
}

namespace gp {
constexpr int BM = 256, BK = 64, HALF = 128, HTB = HALF * BK * 2, NXCD = 8, WGM = 8;
__host__ __device__ __forceinline__ int lds_byte(int r, int c) { const int st = (r >> 4) * 2 + (c >> 5), rr = r & 15, cc = c & 31, ob = rr * 64 + cc * 2; return st * 1024 + (ob ^ (((ob >> 9) & 1) << 5)); }
__host__ __device__ __forceinline__ void stage_rc(int b, int& R, int& C) { const int st = b / 1024, sb = b % 1024, swz = sb ^ (((sb >> 9) & 1) << 5); R = (st >> 1) * 16 + swz / 64; C = (st & 1) * 32 + (swz % 64) / 2; }
__host__ __device__ __forceinline__ int perm32(int rho) { const int n = rho >> 4, i = rho & 15; return 8 * (i >> 2) + 4 * n + (i & 3); }

struct Unit { int pm, pn, be, rl, nv; };
struct Gemm { const bf16_t* A; const bf16_t* Bt; int K; size_t bstride; const unsigned* list; size_t astride; int sw, sx; };

__device__ __forceinline__ int xcd_remap(int wgid, int nwg) { const int q = nwg / NXCD, r = nwg % NXCD, xcd = wgid % NXCD, off = wgid / NXCD; return (xcd < r ? xcd * (q + 1) : r * (q + 1) + (xcd - r) * q) + off; }
struct DenseOrder {
    int nM, nN, nwg, G, c, pn0, i0, ni;
    __device__ void init(int M, int N, int G_, int c_) { nM = M / BM; nN = N / BM; nwg = nM * nN; G = G_; c = c_; pn0 = 0; i0 = 0; ni = 1 << 20; }
    __device__ void window(int pn0_, int nNw, int i0_, int ni_) { pn0 = pn0_; nN = nNw; nwg = nM * nN; i0 = i0_; ni = ni_; }
    __device__ bool next(int i, Unit& u) const {
        if (i >= ni) return false;
        const int L = (i + i0) * G + c; if (L >= nwg) return false;
        const int wgid = xcd_remap((int)L, nwg);
        const int nig = WGM * nN, gid = wgid / nig, fm = gid * WGM, gsz = (nM - fm) < WGM ? (nM - fm) : WGM;
        u.pm = fm + ((wgid % nig) % gsz); u.pn = pn0 + (wgid % nig) / gsz; u.be = 0; u.rl = 0; u.nv = 256; return true;
    }
};
struct PairOrder {
    DenseOrder d;
    __device__ void init(int M, int N, int G_, int c_) { d.init(M, N, G_, c_); }
    __device__ bool next(int i, Unit& u) const { if (!d.next(i >> 1, u)) return false; u.be = i & 1; return true; }
};
struct MoeOrder {
    const LAS int* tab; int nwg, G, c; unsigned* cnt; int mode;
    __device__ static int rd(const LAS int* p) { return __builtin_amdgcn_readfirstlane(*p); }
    __device__ void init(const LAS int* tab_, int G_, int c_) { tab = tab_; nwg = rd(tab_ + 16) * 4; G = G_; c = c_; cnt = nullptr; mode = 0; }
    __device__ void handoff(unsigned* cnt_, int mode_) { cnt = cnt_; mode = mode_; }
    __device__ void wait(int tile) const { unsigned sp = 0; while (xb_ld(cnt + tile) < 4u && ++sp < XB_SPIN_CAP) __builtin_amdgcn_s_sleep(1); __builtin_amdgcn_fence(__ATOMIC_ACQUIRE, "agent"); }
    __device__ bool next(int i, Unit& u) const {
        const int ntl = nwg >> 2, x_ = c & 7, tlo = (ntl * x_) >> 3, thi = (ntl * (x_ + 1)) >> 3;
        const int R_ = G >> 3, r_ = c >> 3; int j_ = i * R_ + r_;
        if (mode == 2) {
            const int U_ = (thi - tlo) * 4, nr_ = U_ / R_, e_ = U_ - nr_ * R_;
            if (e_ > 0 && 3 * e_ <= R_ && nr_ >= 1) {
                if (r_ < e_) { if (i >= nr_ - 1) return false; }
                else if (i >= nr_) { const int k_ = r_ - e_; if (i > nr_ || k_ >= 2 * e_) return false; j_ = (k_ < e_) ? (nr_ - 1) * R_ + k_ : nr_ * R_ + (k_ - e_); }
            }
        }
        const int tile = tlo + (j_ >> 2); if (tile >= thi) return false;
        const int wgid = tile * 4 + (j_ & 3); int e = 0;
        for (int k = 1; k < NE; ++k) { const int tk = rd(tab + k); e = (tk <= tile) ? k : e; }
        e = __builtin_amdgcn_readfirstlane(e);
        u.pm = tile; u.pn = wgid & 3; u.be = e; u.rl = tile - rd(tab + e); const int rem = rd(tab + 32 + e) - u.rl * 256; u.nv = rem < 256 ? rem : 256; return true;
    }
};

#define ACC_T f32x4 (&acc)[2][2][4][2]

template <class Epi, class Sched, bool GATHER>
__device__ __forceinline__ void gemm_phase_ref(int tid, const Gemm g, const Sched& S, const Epi& E) {
    const int wid = __builtin_amdgcn_readfirstlane(tid >> 6), lane = tid & 63, wr = wid >> 2, wc = wid & 3, fr = lane & 15, fq = lane >> 4;
    const int K = g.K; Unit u;
    for (int ui = 0; S.next(ui, u); ++ui) {
        f32x4 acc[2][2][4][2];
#pragma unroll
        for (int a = 0; a < 2; ++a)
#pragma unroll
            for (int b = 0; b < 2; ++b)
#pragma unroll
                for (int m = 0; m < 4; ++m)
#pragma unroll
                    for (int n = 0; n < 2; ++n) acc[a][b][m][n] = (f32x4){0.f, 0.f, 0.f, 0.f};
        const bf16_t* Bt = g.Bt + (size_t)u.be * g.bstride + (size_t)u.pn * 256 * K;
        for (int ai = 0; ai < 2; ++ai)
            for (int m = 0; m < 4; ++m) {
                const int rloc = ai * 128 + wr * 64 + m * 16 + fr;
                size_t arow;
                if (GATHER) { arow = (rloc < u.nv) ? (size_t)(g.list[(size_t)u.be * T + u.rl * 256 + rloc] >> 1) : 0; }
                else arow = (size_t)u.pm * 256 + rloc;
                const bf16_t* ap = g.A + arow * K;
                for (int bj = 0; bj < 2; ++bj) {
                    const bf16_t* bp = Bt + (size_t)(bj * 128 + wc * 32 + fq * 8) * K;
                    float s[8];
#pragma unroll
                    for (int c = 0; c < 8; ++c) {
                        float sc = 0.f; const bf16_t* bpc = bp + (size_t)c * K;
#pragma unroll 2
                        for (int k = 0; k < K; k += 8) {
                            f32x4 a0, a1, b0, b1; unpack8(*(const u32x4*)(ap + k), a0, a1); unpack8(*(const u32x4*)(bpc + k), b0, b1);
                            sc += a0[0] * b0[0] + a0[1] * b0[1] + a0[2] * b0[2] + a0[3] * b0[3] + a1[0] * b1[0] + a1[1] * b1[1] + a1[2] * b1[2] + a1[3] * b1[3];
                        }
                        s[c] = sc; asm volatile("" : "+v"(s[c]));
                    }
#pragma unroll
                    for (int a2 = 0; a2 < 2; ++a2)
#pragma unroll
                        for (int b2 = 0; b2 < 2; ++b2)
#pragma unroll
                            for (int m2 = 0; m2 < 4; ++m2)
                                if (a2 == ai && b2 == bj && m2 == m) { acc[a2][b2][m2][0] = (f32x4){s[0], s[1], s[2], s[3]}; acc[a2][b2][m2][1] = (f32x4){s[4], s[5], s[6], s[7]}; }
                }
            }
        E(acc, u, wr, wc, fr, fq);
    }
}

template <class E> struct EpiTraits { static constexpr bool KEEP = false; };
#if FAST_GEMM
typedef int v8i_t __attribute__((ext_vector_type(8)));
__device__ __forceinline__ unsigned gp_voffb(int tid, int i, int K) { int t_ = tid; LAUNDER_V(t_); int R, C; stage_rc(t_ * 16 + i * 8192, R, C); const int Rb = (R & ~31) + perm32(R & 31); return (unsigned)(Rb * K + C) * 2u; }
template <class S_> struct SchedHand { static constexpr bool V = false; };
template <> struct SchedHand<MoeOrder> { static constexpr bool V = true; };
template <class Epi, class Sched, bool GATHER, bool F8>
__device__ __forceinline__ void gemm_phase_fast(int tid, LAS unsigned char* lds, const Gemm g, const Sched& S, const Epi& E) {
    const int wid = __builtin_amdgcn_readfirstlane(tid >> 6), lane = tid & 63, wr = wid >> 2, wc = wid & 3, fr = lane & 15, fq = lane >> 4;
    const int K = g.K, nt = K / BK;
    int Rr[2], Cc[2]; unsigned voffB[2];
#pragma unroll
    for (int i = 0; i < 2; ++i) { stage_rc(tid * 16 + i * 8192, Rr[i], Cc[i]); const int Rb = (Rr[i] & ~31) + perm32(Rr[i] & 31); voffB[i] = (unsigned)(Rb * K + Cc[i]) * 2u; }
#define GP_VB(i) (F8 ? gp_voffb(tid, (i), K) : voffB[i])
    const size_t kstep = (size_t)(BK * 2), hstep = (size_t)HALF * K * 2, tstep = 2 * hstep, r64 = (size_t)64 * K * 2;
    const unsigned ldsw = (unsigned)wid * 1024u;
    const int aoff = lds_byte(wr * 64 + fr, fq * 8), boff = lds_byte(wc * 32 + fr, fq * 8);
#define GP_UNI(p) ((const char*)(((unsigned long long)(unsigned)__builtin_amdgcn_readfirstlane((int)((unsigned long long)(p) >> 32)) << 32) | (unsigned)__builtin_amdgcn_readfirstlane((int)(unsigned long long)(p))))
#define GP_SA(b, h) (((b) * 2 + (h)) * HTB)
#define GP_SB(b, h) ((4 + (b) * 2 + (h)) * HTB)
#define GP_DMA(sbase, voff, ldsdst) do { unsigned keep_; asm volatile("s_mov_b32 %0, m0\n\ts_mov_b32 m0, %3\n\ts_nop 0\n\tglobal_load_lds_dwordx4 %1, %2\n\ts_mov_b32 m0, %0" \
        : "=&s"(keep_) : "v"(voff), "s"(sbase), "s"((unsigned)__builtin_amdgcn_readfirstlane((int)(unsigned)(uintptr_t)(ldsdst))) : "memory"); } while (0)
#define GP_STAGE2(bufoff, gbase, v0, v1) do { const char* gb_ = (gbase); GP_DMA(gb_, (v0), lds + (bufoff) + ldsw); GP_DMA(gb_, (v1), lds + (bufoff) + ldsw + 8192); } while (0)
#define GP_STAGEB(bufoff, gbase) do { if constexpr (F8) { const unsigned vb_ = GP_VB(0); const char* gb_ = (gbase); GP_DMA(gb_, vb_, lds + (bufoff) + ldsw); GP_DMA(gb_ + r64, vb_, lds + (bufoff) + ldsw + 8192); } else { GP_STAGE2(bufoff, gbase, GP_VB(0), GP_VB(1)); } } while (0)
#define GP_STAGEB2(bufoff0, bufoff1, gbase) do { if constexpr (F8 && !GATHER) { const unsigned vb_ = GP_VB(0); const char* gb_ = (gbase); GP_DMA(gb_, vb_, lds + (bufoff0) + ldsw); GP_DMA(gb_ + r64, vb_, lds + (bufoff0) + ldsw + 8192); \
        GP_DMA(gb_ + hstep, vb_, lds + (bufoff1) + ldsw); GP_DMA(gb_ + hstep + r64, vb_, lds + (bufoff1) + ldsw + 8192); } else { GP_STAGEB(bufoff0, gbase); GP_STAGEB(bufoff1, (gbase) + hstep); } } while (0)
#define GP_CAT8(x0, x1) __builtin_bit_cast(v8i_t, __builtin_shufflevector(x0, x1, 0, 1, 2, 3, 4, 5, 6, 7, 8, 9, 10, 11, 12, 13, 14, 15))
#define GP_LDA(dst, b, h) do { _Pragma("unroll") for (int m = 0; m < 4; ++m) _Pragma("unroll") for (int k = 0; k < 2; ++k) dst[m][k] = *(const LAS bf16x8*)(lds + GP_SA(b, h) + aoff + m * 2048 + k * 1024); \
        if constexpr (F8) { _Pragma("unroll") for (int m = 0; m < 4; ++m) dst##8[m] = GP_CAT8(dst[m][0], dst[m][1]); } } while (0)
#define GP_LDB(dst, b, h) do { _Pragma("unroll") for (int n = 0; n < 2; ++n) _Pragma("unroll") for (int k = 0; k < 2; ++k) dst[n][k] = *(const LAS bf16x8*)(lds + GP_SB(b, h) + boff + n * 2048 + k * 1024); \
        if constexpr (F8) { _Pragma("unroll") for (int n = 0; n < 2; ++n) dst##8[n] = GP_CAT8(dst[n][0], dst[n][1]); } } while (0)
#define GP_MMA(ai, bj, At, Bt) do { __builtin_amdgcn_s_setprio(1); \
        if constexpr (F8) { _Pragma("unroll") for (int m = 0; m < 4; ++m) _Pragma("unroll") for (int n = 0; n < 2; ++n) \
            acc[ai][bj][m][n] = __builtin_amdgcn_mfma_scale_f32_16x16x128_f8f6f4(Bt##8[n], At##8[m], acc[ai][bj][m][n], 0, 0, 0, 0, 0, 0); }     \
        else { _Pragma("unroll") for (int m = 0; m < 4; ++m) _Pragma("unroll") for (int n = 0; n < 2; ++n) _Pragma("unroll") for (int k = 0; k < 2; ++k) \
            acc[ai][bj][m][n] = __builtin_amdgcn_mfma_f32_16x16x32_bf16(Bt[n][k], At[m][k], acc[ai][bj][m][n], 0, 0, 0); } \
        __builtin_amdgcn_s_setprio(0); } while (0)
#define GP_WAIT_V(n) asm volatile("s_waitcnt vmcnt(" #n ")" ::: "memory")
#define GP_WAIT_L(n) asm volatile("s_waitcnt lgkmcnt(" #n ")" ::: "memory")
#define GP_BAR __builtin_amdgcn_s_barrier()
#define GP_SCHED __builtin_amdgcn_sched_barrier(0)
    Unit cur, nxt; int ui = 0;
    if (!S.next(0, cur)) return;
    if constexpr (SchedHand<Sched>::V) { if (S.mode == 2) { if (tid == 0) S.wait(cur.pm); GP_BAR; } }
    f32x4 acc[2][2][4][2];
#pragma unroll
    for (int a = 0; a < 2; ++a)
#pragma unroll
        for (int b = 0; b < 2; ++b)
#pragma unroll
            for (int m = 0; m < 4; ++m)
#pragma unroll
                for (int n = 0; n < 2; ++n) acc[a][b][m][n] = (f32x4){0.f, 0.f, 0.f, 0.f};
    bf16x8 At[4][2], B0[2][2], B1[2][2];
    v8i_t At8[4], B08[2], B18[2];
    unsigned vC0, vC1, vC2, vC3, vN0, vN1, vN2, vN3;
#define GP_VOFF(u, o0, o1, o2, o3) do { if (GATHER) { \
        int tl_ = tid; LAUNDER_V(tl_); int R0_, C0_, R1_, C1_; stage_rc(tl_ * 16, R0_, C0_); stage_rc(tl_ * 16 + 8192, R1_, C1_);     \
        const unsigned* lp = g.list + (size_t)(u).be * T + (u).rl * 256; \
        const int nvm = (u).nv - 1; const int p0 = min(R0_, nvm), p1 = min(R1_, nvm), p2 = min(128 + R0_, nvm), p3 = min(128 + R1_, nvm); \
        const unsigned t0 = lp[p0] >> 1, t1 = lp[p1] >> 1, t2 = lp[p2] >> 1, t3 = lp[p3] >> 1; \
        o0 = (t0 * K + C0_) * 2u; o1 = (t1 * K + C1_) * 2u; o2 = (t2 * K + C0_) * 2u; o3 = (t3 * K + C1_) * 2u; \
      } else { o0 = (unsigned)(Rr[0] * K + Cc[0]) * 2u; o1 = (unsigned)(Rr[1] * K + Cc[1]) * 2u; o2 = o0 + (unsigned)hstep; o3 = o1 + (unsigned)hstep; } } while (0)
    GP_VOFF(cur, vC0, vC1, vC2, vC3);
    const char* cA = GP_UNI((const char*)g.A + ((size_t)cur.be * g.astride) * 2 + (GATHER ? (size_t)0 : (size_t)cur.pm * tstep));
    const char* cB = GP_UNI((const char*)g.Bt + ((size_t)cur.be * g.bstride) * 2 + (size_t)cur.pn * tstep);
    GP_STAGEB(GP_SB(0, 0), cB); GP_STAGEB(GP_SB(0, 1), cB + hstep); GP_STAGE2(GP_SA(0, 0), cA, vC0, vC1); GP_STAGE2(GP_SA(0, 1), cA, vC2, vC3);
    if (wr == 1) GP_BAR;
    GP_WAIT_V(2); GP_BAR;
    GP_STAGEB(GP_SB(1, 0), cB + kstep); GP_STAGE2(GP_SA(1, 0), cA + kstep, vC0, vC1); GP_STAGEB(GP_SB(1, 1), cB + hstep + kstep);
    GP_WAIT_V(6); GP_BAR;
    for (;;) {
        const bool has_next = S.next(ui + 1, nxt);
        if constexpr (SchedHand<Sched>::V) { if (S.mode == 2 && has_next) { if (tid == 0) S.wait(nxt.pm); } }
        const char* nA = GP_UNI(has_next ? (const char*)g.A + ((size_t)nxt.be * g.astride) * 2 + (GATHER ? (size_t)0 : (size_t)nxt.pm * tstep) : cA);
        const char* nB = GP_UNI(has_next ? (const char*)g.Bt + ((size_t)nxt.be * g.bstride) * 2 + (size_t)nxt.pn * tstep : cB);
        if (GATHER) {
            if (has_next) { GP_VOFF(nxt, vN0, vN1, vN2, vN3); } else { vN0 = vC0; vN1 = vC1; vN2 = vC2; vN3 = vC3; }
            *(LAS u32x4*)(lds + MISC_OFF + 2048 + tid * 16) = (u32x4){vN0, vN1, vN2, vN3};
        } else { vN0 = vC0; vN1 = vC1; vN2 = vC2; vN3 = vC3; }
#pragma nounroll
        for (int t = 0; t < nt; t += 2) {
            LAUNDER_S(cA); LAUNDER_S(cB); LAUNDER_S(nA); LAUNDER_S(nB);
            const bool last = (t == nt - 2);
            if (GATHER) { if (last) { const u32x4 q_ = *(const LAS u32x4*)(lds + MISC_OFF + 2048 + tid * 16); vN0 = q_.x; vN1 = q_.y; vN2 = q_.z; vN3 = q_.w; } }
            const char* a1 = cA + (size_t)(t + 1) * kstep;
            const char* a2 = last ? nA : cA + (size_t)(t + 2) * kstep; const char* b2 = last ? nB : cB + (size_t)(t + 2) * kstep;
            const char* a3 = a2 + kstep; const char* b3 = b2 + kstep;
            const unsigned w0 = last ? vN0 : vC0, w1 = last ? vN1 : vC1, w2 = last ? vN2 : vC2, w3 = last ? vN3 : vC3;
            GP_LDB(B0, 0, 0); GP_LDB(B1, 0, 1); GP_SCHED; GP_LDA(At, 0, 0); GP_STAGE2(GP_SA(1, 1), a1, vC2, vC3);
            GP_WAIT_V(8); GP_WAIT_L(0); GP_BAR; GP_MMA(0, 0, At, B0); GP_MMA(0, 1, At, B1); GP_BAR; GP_SCHED;
            GP_LDA(At, 0, 1); GP_STAGEB2(GP_SB(0, 0), GP_SB(0, 1), b2); GP_STAGE2(GP_SA(0, 0), a2, w0, w1);
            GP_WAIT_V(8); GP_WAIT_L(0); GP_BAR; GP_MMA(1, 0, At, B0); GP_MMA(1, 1, At, B1); GP_BAR; GP_SCHED;
            GP_LDB(B0, 1, 0); GP_LDB(B1, 1, 1); GP_SCHED; GP_LDA(At, 1, 0); GP_STAGE2(GP_SA(0, 1), a2, w2, w3);
            GP_WAIT_V(8); GP_WAIT_L(0); GP_BAR; GP_MMA(0, 0, At, B0); GP_MMA(0, 1, At, B1); GP_BAR; GP_SCHED;
            GP_LDA(At, 1, 1); GP_STAGEB2(GP_SB(1, 0), GP_SB(1, 1), b3); GP_STAGE2(GP_SA(1, 0), a3, w0, w1);
            GP_WAIT_V(8); GP_WAIT_L(0); GP_BAR; GP_MMA(1, 0, At, B0); GP_MMA(1, 1, At, B1); GP_BAR; GP_SCHED;
        }
        if (wr == 0) GP_BAR;
        { int tl_ = tid; LAUNDER_V(tl_); const int fr_ = tl_ & 15, fq_ = (tl_ & 63) >> 4;
          E(acc, cur, wr, wc, fr_, fq_); }
        if constexpr (SchedHand<Sched>::V) { if (S.mode == 1) { GP_WAIT_V(0); GP_BAR; if (tid == 0) xb_add(S.cnt + cur.pm, 1u); } }
        if (!has_next) break;
        if (!(EpiTraits<Epi>::KEEP && cur.be == 0)) {
#pragma unroll
        for (int a = 0; a < 2; ++a)
#pragma unroll
            for (int b = 0; b < 2; ++b)
#pragma unroll
                for (int m = 0; m < 4; ++m)
#pragma unroll
                    for (int n = 0; n < 2; ++n) acc[a][b][m][n] = (f32x4){0.f, 0.f, 0.f, 0.f};
        }
        cur = nxt; cA = nA; cB = nB; vC0 = vN0; vC1 = vN1; vC2 = vN2; vC3 = vN3; ++ui;
        if (wr == 1) GP_BAR;
    }
    GP_WAIT_V(0);
    GP_BAR;
#undef GP_UNI
#undef GP_SA
#undef GP_SB
#undef GP_STAGE2
#undef GP_DMA
#undef GP_STAGEB
#undef GP_STAGEB2
#undef GP_VB
#undef GP_LDA
#undef GP_LDB
#undef GP_MMA
#undef GP_CAT8
#undef GP_WAIT_V
#undef GP_WAIT_L
#undef GP_BAR
#undef GP_SCHED
#undef GP_VOFF
}
#endif

template <class Epi, class Sched, bool GATHER = false, bool F8 = false>
__device__ __forceinline__ void gemm_phase(int tid, LAS unsigned char* lds, const Gemm g, const Sched& S, const Epi& E) {
#if FAST_GEMM
    gemm_phase_fast<Epi, Sched, GATHER, F8>(tid, lds, g, S, E);
#else
    (void)lds; gemm_phase_ref<Epi, Sched, GATHER>(tid, g, S, E);
#endif
}

#define EPI_ROW(ai, m) (u.pm * 256 + (ai) * 128 + wr * 64 + (m) * 16 + fr)
#define EPI_COL(bj) (u.pn * 256 + (bj) * 128 + wc * 32 + fq * 8)
__device__ __forceinline__ float dot4(f32x4 a) { return (a[0] * a[0] + a[1] * a[1]) + (a[2] * a[2] + a[3] * a[3]); }

struct EpiNull {
    __device__ __forceinline__ void operator()(const ACC_T, const Unit& u, int wr, int wc, int fr, int fq) const {
#pragma unroll
        for (int ai = 0; ai < 2; ++ai)
#pragma unroll
            for (int bj = 0; bj < 2; ++bj)
#pragma unroll
                for (int m = 0; m < 4; ++m) asm volatile("" :: "v"(acc[ai][bj][m][0]), "v"(acc[ai][bj][m][1]));
    }
};
struct EpiIn {
    bf16_t *QA, *KA, *VA, *QLAT, *KVLAT, *KB, *SA, *SB; float *SSQ, *SSKV; const float *gq, *gk, *cosA, *sinA, *cosB, *sinB;
    __device__ __forceinline__ void operator()(const ACC_T, const Unit& u, int wr, int wc, int fr, int fq) const {
        const int wb = u.pn * 4 + wc;
        if (wb < 10) {
            const bool isq = wb < 8; const int head = isq ? wb : wb - 8; const float* g = isq ? gq : gk; bf16_t* dst = isq ? QA : KA; const int dp = isq ? 512 : 128; const float qs = isq ? QSCALE_A * (ATT_FP8_A ? PFOLD : 1.f) : 1.f;
            const f32x4 g00 = *(const f32x4*)(g + 8 * fq), g01 = *(const f32x4*)(g + 8 * fq + 4), g10 = *(const f32x4*)(g + 32 + 8 * fq), g11 = *(const f32x4*)(g + 36 + 8 * fq);
#pragma unroll
            for (int ai = 0; ai < 2; ++ai)
#pragma unroll
                for (int m = 0; m < 4; ++m) {
                    const int r = EPI_ROW(ai, m), pos = r & (S - 1);
                    const f32x4 v00 = acc[ai][0][m][0], v01 = acc[ai][0][m][1], v10 = acc[ai][1][m][0], v11 = acc[ai][1][m][1];
                    float ss = (dot4(v00) + dot4(v01)) + (dot4(v10) + dot4(v11)); ss = sum_xor16(ss); ss = sum_xor32(ss);
                    const float rstd = rsqrtf(ss * (1.f / 64.f) + EPS);
                    const f32x4 y00 = v00 * rstd * g00, y01 = v01 * rstd * g01, y10 = v10 * rstd * g10, y11 = v11 * rstd * g11;
                    const f32x4 c0 = *(const f32x4*)(cosA + pos * 32 + 8 * fq), c1 = *(const f32x4*)(cosA + pos * 32 + 8 * fq + 4), s0 = *(const f32x4*)(sinA + pos * 32 + 8 * fq), s1 = *(const f32x4*)(sinA + pos * 32 + 8 * fq + 4);
                    const f32x4 o00 = (y00 * c0 - y10 * s0) * qs, o01 = (y01 * c1 - y11 * s1) * qs, o10 = (y10 * c0 + y00 * s0) * qs, o11 = (y11 * c1 + y01 * s1) * qs;
#if ATT_FP8_A
                    unsigned char* p8 = (unsigned char*)dst + (size_t)r * dp + head * 64 + 8 * fq;
                    st16(p8 + (fq & 1) * 32 - (fq & 1) * 8, pair16(pack8_fp8(o00, o01), pack8_fp8(o10, o11)));
#else
                    bf16_t* p = dst + (size_t)r * dp + head * 64 + 8 * fq;
                    st16(p, pack8(o00, o01)); st16((p + 32), pack8(o10, o11));
#endif
                }
        } else if (wb < 12) {
#pragma unroll
            for (int ai = 0; ai < 2; ++ai)
#pragma unroll
                for (int m = 0; m < 4; ++m) {
#if ATT_FP8_A
                    const int r = EPI_ROW(ai, m), sq = r & (S - 1), k = sq & 63, pos = 32 * ((k >> 2) & 1) + 16 * (k >> 5) + (k & 3) + 4 * ((k & 31) >> 3);
                    unsigned char* vtb = (unsigned char*)VA; const unsigned vo = (unsigned)(((r >> 12) * 2 + (wb - 10)) * 64 + 8 * fq) * S + (unsigned)((sq & ~63) + pos);
#pragma unroll
                    for (int bj = 0; bj < 2; ++bj)
#pragma unroll
                        for (int n = 0; n < 2; ++n) { const f32x4 x = acc[ai][bj][m][n]; const unsigned w = (unsigned)__builtin_amdgcn_cvt_pk_fp8_f32(x[2], x[3], __builtin_amdgcn_cvt_pk_fp8_f32(x[0], x[1], 0, false), true);
                            const unsigned qo = vo + (unsigned)(bj * 32 + 4 * n) * S;
                            vtb[qo] = (unsigned char)(w & 0xffu); vtb[qo + S] = (unsigned char)((w >> 8) & 0xffu); vtb[qo + 2 * S] = (unsigned char)((w >> 16) & 0xffu); vtb[qo + 3 * S] = (unsigned char)(w >> 24); }
#else
                    bf16_t* p = VA + (size_t)EPI_ROW(ai, m) * 128 + (wb - 10) * 64 + 8 * fq;
                    st16(p, pack8(acc[ai][0][m][0], acc[ai][0][m][1])); st16((p + 32), pack8(acc[ai][1][m][0], acc[ai][1][m][1]));
#endif
                }
        } else if (wb < 22) {
            const bool isq = wb < 18; const int idx = isq ? wb - 12 : wb - 18; bf16_t* dst = isq ? QLAT : KVLAT; const int dp = isq ? 384 : 256;
#pragma unroll
            for (int ai = 0; ai < 2; ++ai)
#pragma unroll
                for (int m = 0; m < 4; ++m) {
                    const int r = EPI_ROW(ai, m);
                    const f32x4 v00 = acc[ai][0][m][0], v01 = acc[ai][0][m][1], v10 = acc[ai][1][m][0], v11 = acc[ai][1][m][1];
                    float ss = (dot4(v00) + dot4(v01)) + (dot4(v10) + dot4(v11)); ss = sum_xor16(ss); ss = sum_xor32(ss);
                    if (fq == 0) { if (isq) SSQ[(size_t)r * 8 + idx] = ss; else SSKV[(size_t)r * 4 + idx] = ss; }
                    bf16_t* p = dst + (size_t)r * dp + idx * 64 + 8 * fq;
                    st16(p, pack8(v00, v01)); st16((p + 32), pack8(v10, v11));
                }
        } else if (wb == 22) {
            if (fq < 2) {
#pragma unroll
                for (int ai = 0; ai < 2; ++ai)
#pragma unroll
                    for (int m = 0; m < 4; ++m) {
                        const int r = EPI_ROW(ai, m), pos = r & (S - 1);
                        const f32x4 x10 = acc[ai][0][m][0], x11 = acc[ai][0][m][1], x20 = acc[ai][1][m][0], x21 = acc[ai][1][m][1];
                        const f32x4 c0 = *(const f32x4*)(cosB + pos * 16 + 8 * fq), c1 = *(const f32x4*)(cosB + pos * 16 + 8 * fq + 4), s0 = *(const f32x4*)(sinB + pos * 16 + 8 * fq), s1 = *(const f32x4*)(sinB + pos * 16 + 8 * fq + 4);
#if ATT_FP8_B
                        const u32x2 w1 = pack8_fp8(x10 * c0 - x20 * s0, x11 * c1 - x21 * s1), w2 = pack8_fp8(x20 * c0 + x10 * s0, x21 * c1 + x11 * s1);
                        unsigned char* p = (unsigned char*)KB + (size_t)r * 768 + 64 + 8 * fq;
#pragma unroll
                        for (int h = 0; h < 8; ++h) { st8(p + h * 96, w1); st8(p + h * 96 + 16, w2); }
#else
                        const u32x4 w1 = pack8(x10 * c0 - x20 * s0, x11 * c1 - x21 * s1), w2 = pack8(x20 * c0 + x10 * s0, x21 * c1 + x11 * s1);
                        bf16_t* p = KB + (size_t)r * 768 + 64 + 8 * fq;
#pragma unroll
                        for (int h = 0; h < 8; ++h) { st16((p + h * 96), w1); st16((p + h * 96 + 16), w2); }
#endif
                    }
            }
        } else if (wb == 23) {
        } else {
            const bool isa = wb < 40; const int idx = isa ? wb - 24 : wb - 40; unsigned char* dst = (unsigned char*)(isa ? SA : SB);
#pragma unroll
            for (int ai = 0; ai < 2; ++ai)
#pragma unroll
                for (int m = 0; m < 4; ++m) { unsigned char* p = dst + (size_t)EPI_ROW(ai, m) * 1024 + idx * 64 + (fq & 1) * 32 + 8 * (fq & ~1);
                    st16(p, pair16(pack8_fp8(acc[ai][0][m][0], acc[ai][0][m][1]), pack8_fp8(acc[ai][1][m][0], acc[ai][1][m][1]))); }
        }
    }
};
__host__ __device__ __forceinline__ int src_col_in(int n) {
    const int pn = n >> 8, nl = n & 255, bj = nl >> 7, wc = (nl & 127) >> 5, p = nl & 31, wb = pn * 4 + wc, s = bj * 32 + p;
    if (wb < 8) return wb * 64 + s;
    if (wb < 10) return 512 + (wb - 8) * 64 + s;
    if (wb < 12) return 640 + (wb - 10) * 64 + s;
    if (wb < 18) return 768 + (wb - 12) * 64 + s;
    if (wb < 22) return 1152 + (wb - 18) * 64 + s;
    if (wb == 22) return p < 16 ? 1408 + bj * 16 + p : -1;
    if (wb == 23) return -1;
    if (wb < 40) return 1440 + (wb - 24) * 64 + s;
    return 2464 + (wb - 40) * 64 + s;
}
struct EpiQb {
    bf16_t* QB; const float *SSQ, *cosB, *sinB;
    __device__ __forceinline__ void operator()(const ACC_T, const Unit& u, int wr, int wc, int fr, int fq) const {
#pragma unroll
        for (int ai = 0; ai < 2; ++ai)
#pragma unroll
            for (int m = 0; m < 4; ++m) {
                const int r = EPI_ROW(ai, m), pos = r & (S - 1);
                const f32x4 sa = *(const f32x4*)(SSQ + (size_t)r * 8); const f32x2 sb = *(const f32x2*)(SSQ + (size_t)r * 8 + 4);
                const float rstd = rsqrtf((((sa[0] + sa[1]) + (sa[2] + sa[3])) + (sb[0] + sb[1])) * (1.f / 384.f) + EPS);
                u32x2 wq[2];
#pragma unroll
                for (int bj = 0; bj < 2; ++bj) {
                    f32x4 v0 = acc[ai][bj][m][0] * rstd, v1 = acc[ai][bj][m][1] * rstd;
                    const int c32 = u.pn * 8 + bj * 4 + wc;
                    if (c32 % 3 == 2) {
                        f32x4 o0, o1;
#pragma unroll
                        for (int j = 0; j < 4; ++j) { const auto ra = __builtin_amdgcn_permlane32_swap(__float_as_uint(v0[j]), __float_as_uint(v0[j]), false, false), rb = __builtin_amdgcn_permlane32_swap(__float_as_uint(v1[j]), __float_as_uint(v1[j]), false, false);
                            o0[j] = __uint_as_float(fq < 2 ? ra[1] : ra[0]); o1[j] = __uint_as_float(fq < 2 ? rb[1] : rb[0]); }
                        const int i0 = 8 * (fq & 1);
                        const f32x4 c0 = *(const f32x4*)(cosB + pos * 16 + i0), c1 = *(const f32x4*)(cosB + pos * 16 + i0 + 4), s0 = *(const f32x4*)(sinB + pos * 16 + i0), s1 = *(const f32x4*)(sinB + pos * 16 + i0 + 4);
                        if (fq < 2) { v0 = v0 * c0 - o0 * s0; v1 = v1 * c1 - o1 * s1; } else { v0 = v0 * c0 + o0 * s0; v1 = v1 * c1 + o1 * s1; }
                    }
#if ATT_FP8_B
                    wq[bj] = pack8_fp8(v0 * (QSCALE_B * PFOLD), v1 * (QSCALE_B * PFOLD));
#else
                    st16((QB + (size_t)r * 768 + EPI_COL(bj)), pack8(v0 * QSCALE_B, v1 * QSCALE_B));
#endif
                }
#if ATT_FP8_B
                st16((unsigned char*)QB + (size_t)r * 768 + u.pn * 256 + (fq & 1) * 128 + wc * 32 + 8 * (fq & ~1), pair16(wq[0], wq[1]));
#endif
            }
    }
};
struct EpiKvb {
    bf16_t *KB, *VB; const float* SSKV;
    __device__ __forceinline__ void operator()(const ACC_T, const Unit& u, int wr, int wc, int fr, int fq) const {
#pragma unroll
        for (int ai = 0; ai < 2; ++ai) {
            f32x4 sq[4];
#pragma unroll
            for (int m = 0; m < 4; ++m) sq[m] = *(const f32x4*)(SSKV + (size_t)EPI_ROW(ai, m) * 4);
            asm volatile("" : "+v"(sq[0]), "+v"(sq[1]), "+v"(sq[2]), "+v"(sq[3]));
#pragma unroll
            for (int m = 0; m < 4; ++m) {
                const int r = EPI_ROW(ai, m);
                const f32x4 sa = sq[m];
                const float rstd = rsqrtf(((sa[0] + sa[1]) + (sa[2] + sa[3])) * (1.f / 256.f) + EPS);
                u32x2 wk[2] = {};
#pragma unroll
                for (int bj = 0; bj < 2; ++bj) {
                    const int head = u.pn * 2 + bj, o = wc * 32 + fq * 8;
#if ATT_FP8_B
                    const f32x4 x0 = acc[ai][bj][m][0] * rstd, x1 = acc[ai][bj][m][1] * rstd;
                    if (wc < 2) wk[bj] = pack8_fp8(x0, x1);
                    else {
                        const int sq = r & (S - 1), k = sq & 63, pos = 32 * ((k >> 2) & 1) + 16 * (k >> 5) + (k & 3) + 4 * ((k & 31) >> 3);
                        unsigned char* vtb = (unsigned char*)VB; const unsigned vo = (unsigned)(((r >> 12) * 8 + head) * 64 + (o - 64)) * S + (unsigned)((sq & ~63) + pos);
                        const u32x2 w = pack8_fp8(x0, x1);
                        vtb[vo] = (unsigned char)(w.x & 0xffu); vtb[vo + S] = (unsigned char)((w.x >> 8) & 0xffu); vtb[vo + 2 * S] = (unsigned char)((w.x >> 16) & 0xffu); vtb[vo + 3 * S] = (unsigned char)(w.x >> 24);
                        vtb[vo + 4 * S] = (unsigned char)(w.y & 0xffu); vtb[vo + 5 * S] = (unsigned char)((w.y >> 8) & 0xffu); vtb[vo + 6 * S] = (unsigned char)((w.y >> 16) & 0xffu); vtb[vo + 7 * S] = (unsigned char)(w.y >> 24);
                    }
#else
                    const u32x4 w = pack8(acc[ai][bj][m][0] * rstd, acc[ai][bj][m][1] * rstd);
                    if (wc < 2) st16((KB + (size_t)r * 768 + head * 96 + o), w); else st16((VB + (size_t)r * 512 + head * 64 + (o - 64)), w);
#endif
                }
#if ATT_FP8_B
                if (wc < 2) st16((unsigned char*)KB + (size_t)r * 768 + (u.pn * 2 + (fq & 1)) * 96 + wc * 32 + 8 * (fq & ~1), pair16(wk[0], wk[1]));
#endif
            } }
    }
};
template <int MODE> struct EpiProj {
    bf16_t* O; const bf16_t* gate;
    __device__ __forceinline__ void operator()(const ACC_T, const Unit& u, int wr, int wc, int fr, int fq) const {
#pragma unroll
        for (int ai = 0; ai < 2; ++ai)
#pragma unroll
            for (int m = 0; m < 4; ++m) {
                const int r = EPI_ROW(ai, m);
#pragma unroll
                for (int bj = 0; bj < 2; ++bj) {
                    const size_t off = (size_t)r * D + EPI_COL(bj);
                    const u32x2 gw = *(const u32x2*)((const unsigned char*)gate + off);
                    const f32x2 q0 = __builtin_amdgcn_cvt_pk_f32_fp8((int)gw.x, false), q1 = __builtin_amdgcn_cvt_pk_f32_fp8((int)gw.x, true), q2 = __builtin_amdgcn_cvt_pk_f32_fp8((int)gw.y, false), q3 = __builtin_amdgcn_cvt_pk_f32_fp8((int)gw.y, true);
                    const f32x4 g0 = {sigm(q0[0]), sigm(q0[1]), sigm(q1[0]), sigm(q1[1])}, g1 = {sigm(q2[0]), sigm(q2[1]), sigm(q3[0]), sigm(q3[1])};
                    f32x4 v0 = acc[ai][bj][m][0] * g0, v1 = acc[ai][bj][m][1] * g1;
                    if (MODE == 1) { f32x4 p0, p1; unpack8(*(const u32x4*)(O + off), p0, p1); v0 += p0; v1 += p1; }
                    if (MODE == 1) st16(O + off, pack8(v0, v1)); else *(u32x4*)(O + off) = pack8(v0, v1);
                }
            }
    }
};
struct EpiProjP {
    bf16_t* O; const unsigned char* SA; const unsigned char* SB;
    __device__ static __forceinline__ void gates(const unsigned char* G, size_t off, f32x4& g0, f32x4& g1) {
        const u32x2 gw = *(const u32x2*)(G + off);
        const f32x2 q0 = __builtin_amdgcn_cvt_pk_f32_fp8((int)gw.x, false), q1 = __builtin_amdgcn_cvt_pk_f32_fp8((int)gw.x, true), q2 = __builtin_amdgcn_cvt_pk_f32_fp8((int)gw.y, false), q3 = __builtin_amdgcn_cvt_pk_f32_fp8((int)gw.y, true);
        g0 = (f32x4){sigm(q0[0]), sigm(q0[1]), sigm(q1[0]), sigm(q1[1])}; g1 = (f32x4){sigm(q2[0]), sigm(q2[1]), sigm(q3[0]), sigm(q3[1])};
    }
    __device__ __forceinline__ void operator()(f32x4 (&acc)[2][2][4][2], const Unit& u, int wr, int wc, int fr, int fq) const {
#pragma unroll
        for (int ai = 0; ai < 2; ++ai)
#pragma unroll
            for (int m = 0; m < 4; ++m) {
                const int r = EPI_ROW(ai, m); u32x2 wm[2] = {};
#pragma unroll
                for (int bj = 0; bj < 2; ++bj) {
                    const size_t off = (size_t)r * D + EPI_COL(bj);
                    f32x4 b0, b1; gates(SB, off, b0, b1);
#pragma unroll
                    for (int j = 0; j < 4; ++j) { b0[j] = fmaxf(b0[j], 9.094947e-13f); b1[j] = fmaxf(b1[j], 9.094947e-13f); }
                    if (u.be == 0) {
                        f32x4 a0, a1; gates(SA, off, a0, a1);
#pragma unroll
                        for (int j = 0; j < 4; ++j) { acc[ai][bj][m][0][j] *= a0[j] * __builtin_amdgcn_rcpf(b0[j]); acc[ai][bj][m][1][j] *= a1[j] * __builtin_amdgcn_rcpf(b1[j]); }
                    } else {
#if PROJ_FP8
                        wm[bj] = pack8_fp8(acc[ai][bj][m][0] * (b0 * (1.f / WSCALE)), acc[ai][bj][m][1] * (b1 * (1.f / WSCALE)));
#else
                        st16(O + off, pack8(acc[ai][bj][m][0] * b0, acc[ai][bj][m][1] * b1));
#endif
                    }
                }
#if PROJ_FP8
                if (u.be != 0) st16((unsigned char*)O + (size_t)r * D + u.pn * 256 + (fq & 1) * 128 + wc * 32 + 8 * (fq & ~1), pair16(wm[0], wm[1]));
#endif
            }
    }
};
template <> struct EpiTraits<EpiProjP> { static constexpr bool KEEP = true; };
struct EpiWo {
    const bf16_t* X; const float* modl; bf16_t* XO;
    __device__ __forceinline__ void operator()(const ACC_T, const Unit& u, int wr, int wc, int fr, int fq) const {
        const float* g1 = modl + (size_t)(u.pm >> 4) * 6 * D + 2 * D;
#pragma unroll
        for (int bj = 0; bj < 2; ++bj) {
            const int c = EPI_COL(bj); const float us = PROJ_FP8 ? 1.f / (OSCALE * WSCALE) : 1.f; const f32x4 ga = *(const f32x4*)(g1 + c) * us, gb = *(const f32x4*)(g1 + c + 4) * us;
#pragma unroll
            for (int ai = 0; ai < 2; ++ai) {
                u32x4 xr[4];
#pragma unroll
                for (int m = 0; m < 4; ++m) xr[m] = *(const u32x4*)(X + (size_t)EPI_ROW(ai, m) * D + c);
                asm volatile("" : "+v"(xr[0]), "+v"(xr[1]), "+v"(xr[2]), "+v"(xr[3]));
#pragma unroll
                for (int m = 0; m < 4; ++m) { const size_t off = (size_t)EPI_ROW(ai, m) * D + c;
                    f32x4 x0, x1; unpack8(xr[m], x0, x1);
                    st16((XO + off), pack8(x0 + ga * acc[ai][bj][m][0], x1 + gb * acc[ai][bj][m][1])); }
            }
        }
    }
};
struct EpiUp {
    bf16_t* ACT; float inscale;
    __device__ __forceinline__ void operator()(const ACC_T, const Unit& u, int wr, int wc, int fr, int fq) const {
#pragma unroll
        for (int ai = 0; ai < 2; ++ai)
#pragma unroll
            for (int m = 0; m < 4; ++m) {
                f32x4 a = acc[ai][0][m][0] * inscale, b = acc[ai][0][m][1] * inscale; const f32x4 c = acc[ai][1][m][0] * inscale, d = acc[ai][1][m][1] * inscale;
#pragma unroll
                for (int j = 0; j < 4; ++j) { a[j] = a[j] * sigm(a[j]) * c[j]; b[j] = b[j] * sigm(b[j]) * d[j]; }
#if MOE_FP8
                st8((unsigned char*)ACT + (size_t)EPI_ROW(ai, m) * FF + u.pn * 128 + wc * 32 + fq * 8, pack8_fp8(a * 8.f, b * 8.f));
#else
                st16((ACT + (size_t)EPI_ROW(ai, m) * FF + u.pn * 128 + wc * 32 + fq * 8), pack8(a, b));
#endif
            }
    }
};
struct EpiDown {
    bf16_t* Y2; const unsigned* list; const float* gw; float inscale;
    __device__ __forceinline__ void operator()(const ACC_T, const Unit& u, int wr, int wc, int fr, int fq) const {
#pragma unroll
        for (int ai = 0; ai < 2; ++ai)
#pragma unroll
            for (int m = 0; m < 4; ++m) {
                const int rloc = ai * 128 + wr * 64 + m * 16 + fr;
                if (rloc < u.nv) {
                    const unsigned entry = list[(size_t)u.be * T + u.rl * 256 + rloc]; const float w = gw[entry] * inscale;
                    const u32x2 q0 = pack8_fp8(acc[ai][0][m][0] * (w * 16.f), acc[ai][0][m][1] * (w * 16.f)), q1 = pack8_fp8(acc[ai][1][m][0] * (w * 16.f), acc[ai][1][m][1] * (w * 16.f));
                    st16((unsigned char*)Y2 + (size_t)entry * D + u.pn * 256 + (fq & 1) * 128 + wc * 32 + 8 * (fq & ~1), pair16(q0, q1));
                }
            }
    }
};
}

namespace at {
struct Tensors { const bf16_t* Q; int qp; const bf16_t* K; int kp; const bf16_t* V; int vp; bf16_t* O; int op; int group; };
__device__ __forceinline__ bool next_unit(int i, int vcu, int G, int& bh, int& qb) {
    int u;
    if (G == 256) { if (i >= 4) return false; u = (vcu >> 5) * 128 + i * 32 + (vcu & 31); }
    else { u = i * G + vcu; if (u >= 1024) return false; }
    bh = u >> 4; qb = u & 15; return true;
}
template <int DQK>
__device__ __forceinline__ void attn_phase_ref(int tid, const Tensors& A, int vcu, int G) {
    int bh, qb;
    for (int i = 0; next_unit(i, vcu, G, bh, qb); ++i) {
        const int b = bh >> 3, h = bh & 7, kvh = h / A.group;
        {
            const int dh = tid >> 8;
            const size_t row = (size_t)b * S + qb * 256 + (tid & 255);
            float q[DQK], o[32];
#pragma unroll
            for (int d = 0; d < DQK; ++d) q[d] = bf2f(A.Q[row * A.qp + h * DQK + d]);
#pragma unroll
            for (int d = 0; d < 32; ++d) o[d] = 0.f;
            float l = 0.f;
            for (int k = 0; k < S; ++k) {
                const bf16_t* kr = A.K + ((size_t)b * S + k) * A.kp + kvh * DQK; const bf16_t* vr = A.V + ((size_t)b * S + k) * A.vp + kvh * 64 + dh * 32;
                float sc = 0.f;
#pragma unroll
                for (int d = 0; d < DQK; d += 8) { f32x4 k0, k1; unpack8(*(const u32x4*)(kr + d), k0, k1);
                    sc += q[d] * k0[0] + q[d + 1] * k0[1] + q[d + 2] * k0[2] + q[d + 3] * k0[3] + q[d + 4] * k1[0] + q[d + 5] * k1[1] + q[d + 6] * k1[2] + q[d + 7] * k1[3]; }
                const float p = bf2f(cvt_pk_bf16(exp2f(sc), 0.f) & 0xffffu); l += p;
#pragma unroll
                for (int d = 0; d < 32; d += 8) { f32x4 v0, v1; unpack8(*(const u32x4*)(vr + d), v0, v1);
                    o[d] += p * v0[0]; o[d + 1] += p * v0[1]; o[d + 2] += p * v0[2]; o[d + 3] += p * v0[3]; o[d + 4] += p * v1[0]; o[d + 5] += p * v1[1]; o[d + 6] += p * v1[2]; o[d + 7] += p * v1[3]; }
            }
            const float il = 1.f / l;
            __syncthreads();
#pragma unroll
            for (int d = 0; d < 32; d += 8) { f32x4 a = {o[d] * il, o[d + 1] * il, o[d + 2] * il, o[d + 3] * il}, c = {o[d + 4] * il, o[d + 5] * il, o[d + 6] * il, o[d + 7] * il};
                *(u32x4*)(A.O + row * A.op + h * 64 + dh * 32 + d) = pack8(a, c); }
        }
    }
}
#if FAST_ATTN
typedef short s16x4 __attribute__((ext_vector_type(4)));
__device__ __forceinline__ unsigned cvtpk(float lo, float hi) { f32x2 v = {lo, hi}; bf16x2_t b = __builtin_convertvector(v, bf16x2_t); return __builtin_bit_cast(unsigned, b); }
__device__ __forceinline__ s16x4 vtr(const LAS unsigned char* p) { return __builtin_bit_cast(s16x4, __builtin_amdgcn_ds_read_tr16_b64_v4i16((LAS s16x4*)p)); }
__device__ __forceinline__ int crow(int r, int hi) { return (r & 3) + 8 * (r >> 2) + 4 * hi; }
#define AT_BAR() asm volatile("s_barrier" ::: "memory")
#define AT_WAITBAR(N) asm volatile("s_waitcnt vmcnt(" #N ") lgkmcnt(0)\n\ts_barrier" ::: "memory")
#define AT_SCHED() __builtin_amdgcn_sched_barrier(0)
__device__ __forceinline__ void glds16(const void* gsrc, unsigned lds_dst) { unsigned keep;
    asm volatile("s_mov_b32 %0, m0\n\ts_mov_b32 m0, %2\n\ts_nop 0\n\tglobal_load_lds_dwordx4 %1, off\n\ts_mov_b32 m0, %0" : "=&s"(keep) : "v"(gsrc), "s"(lds_dst) : "memory"); }
#define AT_GLDS(g, l) glds16((const void*)(g), (unsigned)__builtin_amdgcn_readfirstlane((int)(unsigned)(uintptr_t)(l)))
template <int DQK>
__device__ __forceinline__ void attn_unit(int tid, LAS unsigned char* lds, const Tensors& A, int b, int h, int qb) {
    constexpr int ND = DQK / 16, NCH = DQK / 8, KSLOT = NCH * 1024, NKD = NCH > 8 ? 2 : 1, VSLOT = 8192, NT = S / 64;
    constexpr int KOFF = 0, VOFF = 3 * KSLOT, OST = VOFF + 3 * VSLOT, WSF = OST + 8 * 4096;
    static_assert(WSF + 8 * 256 <= RING_BYTES, "attention LDS");
    const int lane = tid & 63, r32 = lane & 31, hi = lane >> 5, wid = __builtin_amdgcn_readfirstlane(tid >> 6);
    const int kvh = h / A.group; const size_t rowb = (size_t)b * S;
    const bf16_t* ksrc = A.K + (rowb + lane) * A.kp + kvh * DQK + wid * 8;
    const bf16_t* ksrc2 = A.K + (rowb + lane) * A.kp + kvh * DQK + (8 + (wid & 3)) * 8;
    const bf16_t* vsrc = A.V + (rowb + 16 * (wid & 3) + (lane >> 2)) * A.vp + kvh * 64 + (wid >> 2) * 32 + (lane & 3) * 8;
    const size_t ktile = (size_t)64 * A.kp, vtile = (size_t)64 * A.vp;
    LAS unsigned char* kdst = lds + KOFF + wid * 1024; LAS unsigned char* kdst2 = lds + KOFF + (8 + (wid & 3)) * 1024; LAS unsigned char* vdst = lds + VOFF + wid * 1024;
#define DMA_K(j, so) do { AT_GLDS(ksrc + (size_t)(j) * ktile, kdst + (so)); if (NKD == 2) AT_GLDS(ksrc2 + (size_t)(j) * ktile, kdst2 + (so)); } while (0)
#define DMA_V(j, so) AT_GLDS(vsrc + (size_t)(j) * vtile, vdst + (so))
    const LAS unsigned char* kp0 = lds + KOFF + hi * 1024 + r32 * 16;
    const LAS unsigned char* vp0 = lds + VOFF + ((lane >> 4) & 1) * 32 + (lane & 3) * 8 + (4 * hi + ((lane & 15) >> 2)) * 64;
    DMA_K(0, 0); DMA_V(0, 0); DMA_K(1, KSLOT); DMA_V(1, VSLOT); DMA_K(2, 2 * KSLOT);
    const bf16_t* Qw = A.Q + (rowb + qb * 256 + wid * 32 + r32) * A.qp + h * DQK + hi * 8;
    bf16x8 qr[ND];
#pragma unroll
    for (int d0 = 0; d0 < ND; ++d0) qr[d0] = *(const bf16x8*)(Qw + d0 * 16);
    asm volatile("s_waitcnt vmcnt(0)\n\ts_barrier" ::: "memory");
    bf16x8 kf[2 * ND]; s16x4 vlo[8], vhi[8];
#define KLOAD(so) do { _Pragma("unroll") for (int d0 = 0; d0 < ND; ++d0) { kf[2 * d0] = *(const LAS bf16x8*)(kp0 + (so) + d0 * 2048); kf[2 * d0 + 1] = *(const LAS bf16x8*)(kp0 + (so) + d0 * 2048 + 512); } } while (0)
#define VLOAD(so) do { _Pragma("unroll") for (int i = 0; i < 8; ++i) { vlo[i] = vtr(vp0 + (so) + (i >> 2) * 4096 + (i & 3) * 1024); vhi[i] = vtr(vp0 + (so) + (i >> 2) * 4096 + (i & 3) * 1024 + 512); } } while (0)
#define VFR(i) (bf16x8){vlo[i][0], vlo[i][1], vlo[i][2], vlo[i][3], vhi[i][0], vhi[i][1], vhi[i][2], vhi[i][3]}
    KLOAD(0);
    asm volatile("s_waitcnt lgkmcnt(0)" ::: "memory");
    if (PROBE_ATT != 5 && wid >= 4) AT_BAR();
    f32x16 o0 = {}, o1 = {}, C0, C1; u32x4 pw0, pw1, pw2, pw3; float lsum = 0.f;
    const f32x16 zero = {};
#define QK_BLOCK() do { C0 = __builtin_amdgcn_mfma_f32_32x32x16_bf16(kf[0], qr[0], zero, 0, 0, 0); C1 = __builtin_amdgcn_mfma_f32_32x32x16_bf16(kf[1], qr[0], zero, 0, 0, 0); \
        _Pragma("unroll") for (int d0 = 1; d0 < ND; ++d0) { C0 = __builtin_amdgcn_mfma_f32_32x32x16_bf16(kf[2 * d0], qr[d0], C0, 0, 0, 0); C1 = __builtin_amdgcn_mfma_f32_32x32x16_bf16(kf[2 * d0 + 1], qr[d0], C1, 0, 0, 0); } } while (0)
#define PAF(k) __builtin_bit_cast(bf16x8, pw##k)
#define PV_BLOCK() do { \
        o0 = __builtin_amdgcn_mfma_f32_32x32x16_bf16(PAF(0), VFR(0), o0, 0, 0, 0); o1 = __builtin_amdgcn_mfma_f32_32x32x16_bf16(PAF(0), VFR(4), o1, 0, 0, 0); \
        o0 = __builtin_amdgcn_mfma_f32_32x32x16_bf16(PAF(1), VFR(1), o0, 0, 0, 0); o1 = __builtin_amdgcn_mfma_f32_32x32x16_bf16(PAF(1), VFR(5), o1, 0, 0, 0); \
        o0 = __builtin_amdgcn_mfma_f32_32x32x16_bf16(PAF(2), VFR(2), o0, 0, 0, 0); o1 = __builtin_amdgcn_mfma_f32_32x32x16_bf16(PAF(2), VFR(6), o1, 0, 0, 0); \
        o0 = __builtin_amdgcn_mfma_f32_32x32x16_bf16(PAF(3), VFR(3), o0, 0, 0, 0); o1 = __builtin_amdgcn_mfma_f32_32x32x16_bf16(PAF(3), VFR(7), o1, 0, 0, 0); } while (0)
#define SOFTMAX() do { \
        _Pragma("unroll") for (int r = 0; r < 16; ++r) { C0[r] = __builtin_amdgcn_exp2f(C0[r]); C1[r] = __builtin_amdgcn_exp2f(C1[r]); } \
        f32x2 s0_ = {C0[0], C0[1]}, s1_ = {C1[0], C1[1]}; _Pragma("unroll") for (int r = 2; r < 16; r += 2) { s0_ += (f32x2){C0[r], C0[r + 1]}; s1_ += (f32x2){C1[r], C1[r + 1]}; } s0_ += s1_; lsum += s0_[0] + s0_[1]; \
        pw0 = (u32x4){cvtpk(C0[0], C0[1]), cvtpk(C0[2], C0[3]), cvtpk(C0[4], C0[5]), cvtpk(C0[6], C0[7])}; pw1 = (u32x4){cvtpk(C0[8], C0[9]), cvtpk(C0[10], C0[11]), cvtpk(C0[12], C0[13]), cvtpk(C0[14], C0[15])}; \
        pw2 = (u32x4){cvtpk(C1[0], C1[1]), cvtpk(C1[2], C1[3]), cvtpk(C1[4], C1[5]), cvtpk(C1[6], C1[7])}; pw3 = (u32x4){cvtpk(C1[8], C1[9]), cvtpk(C1[10], C1[11]), cvtpk(C1[12], C1[13]), cvtpk(C1[14], C1[15])}; } while (0)
    int ka = 2 * KSLOT, kb = 0, kc = KSLOT, va = 2 * VSLOT, vb = 0, vc = VSLOT;
#define ROT() do { const int t_ = ka; ka = kb; kb = kc; kc = t_; const int u_ = va; va = vb; vb = vc; vc = u_; } while (0)
#define PINP() asm volatile("" : "+v"(lsum) : "v"(pw0), "v"(pw1), "v"(pw2), "v"(pw3))
#if ATT_REGSTAGE
    u32x4 kst = {}, kst2 = {}, vst = {};
    const LAS unsigned char* kw = lds + KOFF + wid * 1024 + lane * 16; const LAS unsigned char* kw2 = lds + KOFF + (8 + (wid & 3)) * 1024 + lane * 16; const LAS unsigned char* vw = lds + VOFF + wid * 1024 + lane * 16;
#define ST_WRITE(WK, WV) do { if (WK) { *(LAS u32x4*)(kw + ka) = kst; if (NKD == 2 && wid < 4) *(LAS u32x4*)(kw2 + ka) = kst2; } if (WV) *(LAS u32x4*)(vw + vc) = vst; } while (0)
#define ST_LOAD(sv, IK, IV) do { if (IK) { kst = *(const u32x4*)(ksrc + (size_t)((sv) + 4) * ktile); if (NKD == 2 && wid < 4) kst2 = *(const u32x4*)(ksrc2 + (size_t)((sv) + 4) * ktile); } if (IV) vst = *(const u32x4*)(vsrc + (size_t)((sv) + 3) * vtile); } while (0)
#define STEP(sv, DOQK, DOPV, KL, VL, IK, IV, WK, WV) do { \
        AT_SCHED(); if (DOQK) QK_BLOCK(); if (DOPV) PV_BLOCK(); AT_SCHED(); \
        asm volatile("s_barrier\n\ts_nop 15\n\ts_nop 3" : "+v"(C0), "+v"(C1), "+v"(o0), "+v"(o1) :: "memory"); AT_SCHED(); \
        if (KL) KLOAD(kc); if (VL) VLOAD(vb); ST_WRITE(WK, WV); ST_LOAD(sv, IK, IV); \
        if (DOQK) { SOFTMAX(); PINP(); } AT_SCHED(); \
        asm volatile("s_waitcnt lgkmcnt(0)\n\ts_barrier" ::: "memory"); \
        AT_SCHED(); ROT(); } while (0)
    STEP(-1, true, false, true, true, true, true, false, false);
#pragma nounroll
    for (int s = 0; s < NT - 4; ++s) STEP(s, true, true, true, true, true, true, true, true);
    STEP(NT - 4, true, true, true, true, false, true, true, true);
    STEP(NT - 3, true, true, true, true, false, false, false, true);
    STEP(NT - 2, true, true, false, true, false, false, false, false);
    STEP(NT - 1, false, true, false, false, false, false, false, false);
#undef ST_WRITE
#undef ST_LOAD
#else
#define STEP(sv, DOQK, DOPV, KL, VL, IK, IV) do { \
        AT_SCHED(); if (DOQK) QK_BLOCK(); if (DOPV) PV_BLOCK(); AT_SCHED(); \
          \
        asm volatile("s_barrier\n\ts_nop 15\n\ts_nop 3" : "+v"(C0), "+v"(C1), "+v"(o0), "+v"(o1) :: "memory"); AT_SCHED(); \
        if (KL) KLOAD(kc); if (VL) VLOAD(vb); if (IK) DMA_K((sv) + 4, kb); if (IV) DMA_V((sv) + 3, va); \
        if (DOQK) { SOFTMAX(); PINP(); } AT_SCHED(); \
        if (IK) { if (NKD == 2) { AT_WAITBAR(3); } else { AT_WAITBAR(2); } } else if (IV) { AT_WAITBAR(1); } else { AT_WAITBAR(0); } \
        AT_SCHED(); ROT(); } while (0)
    STEP(-1, true, false, true, true, true, true);
#pragma nounroll
    for (int s = 0; s < NT - 4; ++s) STEP(s, true, true, true, true, true, true);
    STEP(NT - 4, true, true, true, true, false, true);
    STEP(NT - 3, true, true, true, true, false, false);
    STEP(NT - 2, true, true, false, true, false, false);
    STEP(NT - 1, false, true, false, false, false, false);
#endif
#undef STEP
#undef PINP
    if (PROBE_ATT != 5 && wid < 4) AT_BAR();
    { auto rr = __builtin_amdgcn_permlane32_swap(__float_as_uint(lsum), __float_as_uint(lsum), false, false); lsum = __uint_as_float(rr[0]) + __uint_as_float(rr[1]); }
    LAS float* wsf = (LAS float*)(lds + WSF + wid * 256);
    if (hi == 0) wsf[r32] = lsum;
    asm volatile("s_waitcnt lgkmcnt(0)" ::: "memory");
    LAS bf16_t* stg = (LAS bf16_t*)(lds + OST + wid * 4096);
#pragma unroll
    for (int r = 0; r < 16; ++r) { const int orow = crow(r, hi); const float rl = __builtin_amdgcn_rcpf(wsf[orow]);
        stg[orow * 64 + r32] = (bf16_t)(cvtpk(o0[r] * rl, 0.f) & 0xffffu); stg[orow * 64 + 32 + r32] = (bf16_t)(cvtpk(o1[r] * rl, 0.f) & 0xffffu); }
    asm volatile("s_waitcnt lgkmcnt(0)" ::: "memory");
    bf16_t* Ow = A.O + (rowb + qb * 256 + wid * 32) * A.op + h * 64;
#pragma unroll
    for (int i = 0; i < 4; ++i) { const int row = i * 8 + (lane >> 3), ch = lane & 7; const u32x4 v = *(const LAS u32x4*)(stg + row * 64 + ch * 8); st16((Ow + (size_t)row * A.op + ch * 8), v); }
    asm volatile("s_waitcnt lgkmcnt(0)\n\ts_barrier" ::: "memory");
#undef DMA_K
#undef DMA_V
#undef KLOAD
#undef VLOAD
#undef VFR
#undef QK_BLOCK
#undef PAF
#undef PV_BLOCK
#undef SOFTMAX
#undef ROT
}
#endif
#if FAST_ATTN && ATT_FP8_A
typedef int v8i __attribute__((ext_vector_type(8)));
#define SPLAT16(x) ((f32x16){x, x, x, x, x, x, x, x, x, x, x, x, x, x, x, x})
__device__ __forceinline__ f32x16 mfma8(v8i a, v8i b, f32x16 c) { return __builtin_amdgcn_mfma_scale_f32_32x32x64_f8f6f4(a, b, c, 0, 0, 0, 0, 0, 0); }
__device__ __forceinline__ f32x16 mfma8pv(v8i a, v8i b, f32x16 c) { return __builtin_amdgcn_mfma_scale_f32_32x32x64_f8f6f4(a, b, c, 1, 0, 0, 0, 0, 0); }
__device__ __forceinline__ void attn_unit_f8a(int tid, LAS unsigned char* lds, const unsigned char* Q8, const unsigned char* K8, const unsigned char* VT8, bf16_t* O, int op, int b, int h, int qb, float bias) {
    constexpr int SL = 4096, NT = S / 64;
    constexpr int KOFF = 0, VOFF = 4 * SL, OST = VOFF + 4 * SL, WSF = OST + 8 * 4096;
    const int lane = tid & 63, r32 = lane & 31, hi = lane >> 5, wid = __builtin_amdgcn_readfirstlane(tid >> 6);
    const int kvh = h >> 2; const size_t rowb = (size_t)b * S; const bool kw = wid < 4;
    const unsigned char* src = kw ? K8 + (rowb + lane) * 128 + kvh * 64 + 16 * wid : VT8 + ((size_t)((b * 2 + kvh) * 64 + lane)) * S + 16 * (wid - 4);
    const size_t tstep = kw ? (size_t)64 * 128 : (size_t)64;
    LAS unsigned char* dst = lds + (kw ? KOFF + wid * 1024 : VOFF + (wid - 4) * 1024);
#define DMA8(j, so) AT_GLDS(src + (size_t)(j) * tstep, dst + (so))
    const LAS unsigned char* kp0 = lds + KOFF + (2 * hi) * 1024 + r32 * 16;
    const LAS unsigned char* vp0 = lds + VOFF + (2 * hi) * 1024 + r32 * 16;
    DMA8(0, 0); DMA8(1, SL); DMA8(2, 2 * SL);
    v8i qf; { const unsigned char* Qw = Q8 + (rowb + qb * 256 + wid * 32 + r32) * 512 + h * 64 + 32 * hi; const u32x4 a = *(const u32x4*)Qw, c = *(const u32x4*)(Qw + 16);
        qf = (v8i){(int)a.x, (int)a.y, (int)a.z, (int)a.w, (int)c.x, (int)c.y, (int)c.z, (int)c.w}; }
    asm volatile("s_waitcnt vmcnt(0)\n\ts_barrier" ::: "memory");
    v8i kf0, kf1, vf0, vf1, p8;
#define LD32(dstv, p) do { const u32x4 a_ = *(const LAS u32x4*)(p), c_ = *(const LAS u32x4*)((p) + 1024); dstv = (v8i){(int)a_.x, (int)a_.y, (int)a_.z, (int)a_.w, (int)c_.x, (int)c_.y, (int)c_.z, (int)c_.w}; } while (0)
#define KLOAD8(so) do { LD32(kf0, kp0 + (so)); LD32(kf1, kp0 + (so) + 512); } while (0)
#define VLOAD8(so) do { LD32(vf0, vp0 + (so)); LD32(vf1, vp0 + (so) + 512); } while (0)
    KLOAD8(0);
    asm volatile("s_waitcnt lgkmcnt(0)" ::: "memory");
    if (wid >= 4) AT_BAR();
    float z_ = 0.f; asm volatile("" : "+v"(z_));
    f32x16 o0 = SPLAT16(z_), o1 = SPLAT16(z_), o2 = SPLAT16(z_), C0, C1;
    const v8i ones = {0x38383838, 0x38383838, 0x38383838, 0x38383838, 0x38383838, 0x38383838, 0x38383838, 0x38383838};
    float nb_ = PFOLD * bias + PBYTE0; asm volatile("" : "+v"(nb_));
    f32x16 negb = SPLAT16(nb_);
    asm volatile("" : "+v"(negb));
#define SOFTMAX8() do { \
        _Pragma("unroll") for (int i = 0; i < 4; ++i) { \
            const f32x2 a_ = (f32x2){C0[4 * i], C0[4 * i + 1]}, b_ = (f32x2){C0[4 * i + 2], C0[4 * i + 3]}, c_ = (f32x2){C1[4 * i], C1[4 * i + 1]}, d_ = (f32x2){C1[4 * i + 2], C1[4 * i + 3]}; \
            p8[i] = (int)__builtin_amdgcn_cvt_pk_u8_f32(b_[1], 3, __builtin_amdgcn_cvt_pk_u8_f32(b_[0], 2, __builtin_amdgcn_cvt_pk_u8_f32(a_[1], 1, __builtin_amdgcn_cvt_pk_u8_f32(a_[0], 0, 0u)))); \
            p8[4 + i] = (int)__builtin_amdgcn_cvt_pk_u8_f32(d_[1], 3, __builtin_amdgcn_cvt_pk_u8_f32(d_[0], 2, __builtin_amdgcn_cvt_pk_u8_f32(c_[1], 1, __builtin_amdgcn_cvt_pk_u8_f32(c_[0], 0, 0u)))); } } while (0)
#define STEP8(sv, DOQK2, DOSM, DOPV, KL, VL, ISS, WN, NOPS) do { \
        AT_SCHED(); \
        if (KL) { LD32(kf0, kp0 + (((sv) + 2) & 3) * SL); LD32(kf1, kp0 + (((sv) + 2) & 3) * SL + 512); } AT_SCHED(); \
        if (DOPV) { o0 = mfma8pv(p8, vf0, o0); } if (VL) LD32(vf0, vp0 + (((sv) + 1) & 3) * SL); AT_SCHED(); \
        if (DOPV) { o1 = mfma8pv(p8, vf1, o1); } if (VL) LD32(vf1, vp0 + (((sv) + 1) & 3) * SL + 512); AT_SCHED(); \
        if (DOPV) { o2 = mfma8pv(p8, ones, o2); } if (ISS) DMA8((sv) + 4, (((sv) + 4) & 3) * SL); AT_SCHED(); \
        asm volatile("s_barrier\n\t" NOPS : "+v"(C0), "+v"(C1), "+v"(o0), "+v"(o1), "+v"(o2) :: "memory"); AT_SCHED(); \
        if (DOSM) { SOFTMAX8(); asm volatile("" :: "v"(p8)); } AT_SCHED(); \
        if (DOQK2) { asm volatile("s_waitcnt lgkmcnt(0)" ::: "memory"); C0 = mfma8(kf0, qf, negb); C1 = mfma8(kf1, qf, negb); } AT_SCHED(); \
        asm volatile("s_waitcnt vmcnt(" #WN ") lgkmcnt(0)\n\ts_barrier" : "+v"(C0), "+v"(C1), "+v"(o0), "+v"(o1), "+v"(o2) :: "memory"); \
        AT_SCHED(); } while (0)
    C0 = mfma8(kf0, qf, negb); C1 = mfma8(kf1, qf, negb);
    STEP8(-1, true, true, false, true, true, true, 1, "s_nop 15\n\ts_nop 15");
#pragma nounroll
    for (int s = 0; s < NT - 4; ++s) STEP8(s, true, true, true, true, true, true, 1, "s_nop 1");
    STEP8(NT - 4, true, true, true, true, true, false, 0, "s_nop 1");
    STEP8(NT - 3, true, true, true, true, true, false, 0, "s_nop 1");
    STEP8(NT - 2, false, true, true, false, true, false, 0, "s_nop 15\n\ts_nop 15");
    STEP8(NT - 1, false, false, true, false, false, false, 0, "s_nop 15\n\ts_nop 15");
    if (wid < 4) AT_BAR();
#if PROJ_FP8
    LAS unsigned char* stg8 = lds + OST + wid * 4096;
#pragma unroll
    for (int r = 0; r < 16; ++r) { const int orow = crow(r, hi); const float rl = __builtin_amdgcn_rcpf(o2[r]) * OSCALE;
        const unsigned pk = (unsigned)__builtin_amdgcn_cvt_pk_fp8_f32(o0[r] * rl, o1[r] * rl, 0, false);
        stg8[orow * 64 + r32] = (unsigned char)(pk & 0xffu); stg8[orow * 64 + 32 + r32] = (unsigned char)((pk >> 8) & 0xffu); }
    asm volatile("s_waitcnt lgkmcnt(0)" ::: "memory");
    unsigned char* Ow8 = (unsigned char*)O + (rowb + qb * 256 + wid * 32) * op + h * 64;
#pragma unroll
    for (int i = 0; i < 2; ++i) { const int idx = i * 64 + lane, row = idx >> 2, ch = idx & 3; const u32x4 v = *(const LAS u32x4*)(stg8 + row * 64 + ch * 16); st16(Ow8 + (size_t)row * op + ch * 16, v); }
#else
    LAS bf16_t* stg = (LAS bf16_t*)(lds + OST + wid * 4096);
#pragma unroll
    for (int r = 0; r < 16; ++r) { const int orow = crow(r, hi); const float rl = __builtin_amdgcn_rcpf(o2[r]);
        stg[orow * 64 + r32] = (bf16_t)(cvtpk(o0[r] * rl, 0.f) & 0xffffu); stg[orow * 64 + 32 + r32] = (bf16_t)(cvtpk(o1[r] * rl, 0.f) & 0xffffu); }
    asm volatile("s_waitcnt lgkmcnt(0)" ::: "memory");
    bf16_t* Ow = O + (rowb + qb * 256 + wid * 32) * op + h * 64;
#pragma unroll
    for (int i = 0; i < 4; ++i) { const int row = i * 8 + (lane >> 3), ch = lane & 7; const u32x4 v = *(const LAS u32x4*)(stg + row * 64 + ch * 8); st16(Ow + (size_t)row * op + ch * 8, v); }
    #endif
    asm volatile("s_waitcnt lgkmcnt(0)\n\ts_barrier" ::: "memory");
#undef DMA8
#undef LD32
#undef KLOAD8
#undef VLOAD8
#undef SOFTMAX8
#undef STEP8
}
__device__ __forceinline__ void attn_phase_f8a(int tid, LAS unsigned char* lds, const unsigned char* Q8, const unsigned char* K8, const unsigned char* VT8, bf16_t* O, int op, const float* gq, const float* gk, int vcu, int G) {
    float mq = 0.f, mk = 0.f;
    for (int i = 0; i < 64; ++i) { mq = fmaxf(mq, fabsf(gq[i])); mk = fmaxf(mk, fabsf(gk[i])); }
    const float bias = -fmaxf(64.f * mq * mk * QSCALE_A * 1.13f - 15.5f, 0.f);
    int bh, qb;
    for (int i = 0; next_unit(i, vcu, G, bh, qb); ++i) attn_unit_f8a(tid, lds, Q8, K8, VT8, O, op, bh >> 3, bh & 7, qb, bias);
}
#endif
#if FAST_ATTN && ATT_FP8_B
__device__ __forceinline__ void attn_unit_f8b(int tid, LAS unsigned char* lds, const unsigned char* Q8, const unsigned char* K8, const unsigned char* VT8, bf16_t* O, int op, int b, int h, int qb) {
    constexpr int SLK = 6144, SLV = 4096, NT = S / 64;
    constexpr int KOFF = 0, VOFF = 4 * SLK, OST = VOFF + 4 * SLV, WSF = OST + 8 * 4096;
    static_assert(WSF + 2048 <= RING_BYTES, "attention LDS");
    const int lane = tid & 63, r32 = lane & 31, hi = lane >> 5, wid = __builtin_amdgcn_readfirstlane(tid >> 6);
    const size_t rowb = (size_t)b * S; const bool kw = wid < 6, vw = wid >= 4;
    const unsigned char* ksrc = K8 + (rowb + lane) * 768 + h * 96 + 16 * wid;
    const unsigned char* vsrc = VT8 + ((size_t)((b * 8 + h) * 64 + lane)) * S + 16 * (wid - 4);
    LAS unsigned char* kdst = lds + KOFF + wid * 1024; LAS unsigned char* vdst = lds + VOFF + (wid - 4) * 1024;
#define DMAK(j, so) AT_GLDS(ksrc + (size_t)(j) * (64 * 768), kdst + (so))
#define DMAV(j, so) AT_GLDS(vsrc + (size_t)(j) * 64, vdst + (so))
    const LAS unsigned char* kp0 = lds + KOFF + (2 * hi) * 1024 + r32 * 16;
    const LAS unsigned char* kr0 = lds + KOFF + 4 * 1024 + r32 * 16;
    const LAS unsigned char* vp0 = lds + VOFF + (2 * hi) * 1024 + r32 * 16;
    if (kw) { DMAK(0, 0); DMAK(1, SLK); DMAK(2, 2 * SLK); DMAK(3, 3 * SLK); }
    if (vw) { DMAV(0, 0); DMAV(1, SLV); DMAV(2, 2 * SLV); }
    v8i qn, qr;
    { const unsigned char* Qw = Q8 + (rowb + qb * 256 + wid * 32 + r32) * 768 + h * 96; const u32x4 a = *(const u32x4*)(Qw + 32 * hi), c = *(const u32x4*)(Qw + 32 * hi + 16), e = *(const u32x4*)(Qw + 64), f = *(const u32x4*)(Qw + 80);
      qn = (v8i){(int)a.x, (int)a.y, (int)a.z, (int)a.w, (int)c.x, (int)c.y, (int)c.z, (int)c.w};
      qr = hi ? (v8i){0, 0, 0, 0, 0, 0, 0, 0} : (v8i){(int)e.x, (int)e.y, (int)e.z, (int)e.w, (int)f.x, (int)f.y, (int)f.z, (int)f.w}; }
    asm volatile("s_waitcnt vmcnt(0)\n\ts_barrier" ::: "memory");
    v8i kn0, kn1, kr0v, kr1v, vf0, vf1, p8;
#define LD32(dstv, p) do { const u32x4 a_ = *(const LAS u32x4*)(p), c_ = *(const LAS u32x4*)((p) + 1024); dstv = (v8i){(int)a_.x, (int)a_.y, (int)a_.z, (int)a_.w, (int)c_.x, (int)c_.y, (int)c_.z, (int)c_.w}; } while (0)
#define KLOAD8(so) do { LD32(kn0, kp0 + (so)); LD32(kn1, kp0 + (so) + 512); LD32(kr0v, kr0 + (so)); LD32(kr1v, kr0 + (so) + 512); } while (0)
#define VLOAD8(so) do { LD32(vf0, vp0 + (so)); LD32(vf1, vp0 + (so) + 512); } while (0)
    KLOAD8(0);
    asm volatile("s_waitcnt lgkmcnt(0)" ::: "memory");
    if (wid >= 4) AT_BAR();
    float z_ = 0.f, pb_ = PBYTE0; asm volatile("" : "+v"(z_), "+v"(pb_));
    f32x16 o0 = SPLAT16(z_), o1 = SPLAT16(z_), o2 = SPLAT16(z_), C0, C1;
    f32x16 zero = SPLAT16(pb_);
    asm volatile("" : "+v"(zero));
    const v8i ones = {0x38383838, 0x38383838, 0x38383838, 0x38383838, 0x38383838, 0x38383838, 0x38383838, 0x38383838};
#define SOFTMAX8() do { \
        _Pragma("unroll") for (int i = 0; i < 4; ++i) { \
            const f32x2 a_ = (f32x2){C0[4 * i], C0[4 * i + 1]}, b_ = (f32x2){C0[4 * i + 2], C0[4 * i + 3]}, c_ = (f32x2){C1[4 * i], C1[4 * i + 1]}, d_ = (f32x2){C1[4 * i + 2], C1[4 * i + 3]}; \
            p8[i] = (int)__builtin_amdgcn_cvt_pk_u8_f32(b_[1], 3, __builtin_amdgcn_cvt_pk_u8_f32(b_[0], 2, __builtin_amdgcn_cvt_pk_u8_f32(a_[1], 1, __builtin_amdgcn_cvt_pk_u8_f32(a_[0], 0, 0u)))); \
            p8[4 + i] = (int)__builtin_amdgcn_cvt_pk_u8_f32(d_[1], 3, __builtin_amdgcn_cvt_pk_u8_f32(d_[0], 2, __builtin_amdgcn_cvt_pk_u8_f32(c_[1], 1, __builtin_amdgcn_cvt_pk_u8_f32(c_[0], 0, 0u)))); } } while (0)
#define STEP8(sv, DOQK, DOPV, KL, VL, IK, IV, WK, WV, WB, NOPS) do { \
        AT_SCHED(); if (DOQK) { C0 = mfma8(kn0, qn, zero); C1 = mfma8(kn1, qn, zero); C0 = mfma8(kr0v, qr, C0); C1 = mfma8(kr1v, qr, C1); } if (DOPV) { o0 = mfma8pv(p8, vf0, o0); o1 = mfma8pv(p8, vf1, o1); o2 = mfma8pv(p8, ones, o2); } AT_SCHED(); \
        asm volatile("s_barrier\n\t" NOPS : "+v"(C0), "+v"(C1), "+v"(o0), "+v"(o1), "+v"(o2) :: "memory"); AT_SCHED(); \
        if (KL) KLOAD8((((sv) + 2) & 3) * SLK); if (VL) VLOAD8((((sv) + 1) & 3) * SLV); \
        if (kw && (IK)) DMAK((sv) + 5, (((sv) + 1) & 3) * SLK); if (vw && (IV)) DMAV((sv) + 4, ((sv) & 3) * SLV); \
        if (DOQK) { SOFTMAX8(); asm volatile("" :: "v"(p8)); } AT_SCHED(); \
        if (kw && vw) { AT_WAITBAR(WB); } else if (kw) { AT_WAITBAR(WK); } else { AT_WAITBAR(WV); } \
        AT_SCHED(); } while (0)
    STEP8(-1, true, false, true, true, true, true, 2, 2, 4, "s_nop 15\n\ts_nop 15");
#pragma nounroll
    for (int s = 0; s < NT - 5; ++s) STEP8(s, true, true, true, true, true, true, 2, 2, 4, "s_nop 1");
    STEP8(NT - 5, true, true, true, true, false, true, 1, 2, 3, "s_nop 15\n\ts_nop 15");
    STEP8(NT - 4, true, true, true, true, false, false, 0, 1, 1, "s_nop 15\n\ts_nop 15");
    STEP8(NT - 3, true, true, true, true, false, false, 0, 0, 0, "s_nop 15\n\ts_nop 15");
    STEP8(NT - 2, true, true, false, true, false, false, 0, 0, 0, "s_nop 15\n\ts_nop 15");
    STEP8(NT - 1, false, true, false, false, false, false, 0, 0, 0, "s_nop 15\n\ts_nop 15");
    if (wid < 4) AT_BAR();
#if PROJ_FP8
    LAS unsigned char* stg8 = lds + OST + wid * 4096;
#pragma unroll
    for (int r = 0; r < 16; ++r) { const int orow = crow(r, hi); const float rl = __builtin_amdgcn_rcpf(o2[r]) * OSCALE;
        const unsigned pk = (unsigned)__builtin_amdgcn_cvt_pk_fp8_f32(o0[r] * rl, o1[r] * rl, 0, false);
        stg8[orow * 64 + r32] = (unsigned char)(pk & 0xffu); stg8[orow * 64 + 32 + r32] = (unsigned char)((pk >> 8) & 0xffu); }
    asm volatile("s_waitcnt lgkmcnt(0)" ::: "memory");
    unsigned char* Ow8 = (unsigned char*)O + (rowb + qb * 256 + wid * 32) * op + h * 64;
#pragma unroll
    for (int i = 0; i < 2; ++i) { const int idx = i * 64 + lane, row = idx >> 2, ch = idx & 3; const u32x4 v = *(const LAS u32x4*)(stg8 + row * 64 + ch * 16); st16(Ow8 + (size_t)row * op + ch * 16, v); }
#else
    LAS bf16_t* stg = (LAS bf16_t*)(lds + OST + wid * 4096);
#pragma unroll
    for (int r = 0; r < 16; ++r) { const int orow = crow(r, hi); const float rl = __builtin_amdgcn_rcpf(o2[r]);
        stg[orow * 64 + r32] = (bf16_t)(cvtpk(o0[r] * rl, 0.f) & 0xffffu); stg[orow * 64 + 32 + r32] = (bf16_t)(cvtpk(o1[r] * rl, 0.f) & 0xffffu); }
    asm volatile("s_waitcnt lgkmcnt(0)" ::: "memory");
    bf16_t* Ow = O + (rowb + qb * 256 + wid * 32) * op + h * 64;
#pragma unroll
    for (int i = 0; i < 4; ++i) { const int row = i * 8 + (lane >> 3), ch = lane & 7; const u32x4 v = *(const LAS u32x4*)(stg + row * 64 + ch * 8); st16(Ow + (size_t)row * op + ch * 8, v); }
    #endif
    asm volatile("s_waitcnt lgkmcnt(0)\n\ts_barrier" ::: "memory");
#undef DMAK
#undef DMAV
#undef LD32
#undef KLOAD8
#undef VLOAD8
#undef SOFTMAX8
#undef STEP8
}
__device__ __forceinline__ void attn_phase_f8b(int tid, LAS unsigned char* lds, const unsigned char* Q8, const unsigned char* K8, const unsigned char* VT8, bf16_t* O, int op, int vcu, int G) {
    int bh, qb;
    for (int i = 0; next_unit(i, vcu, G, bh, qb); ++i) attn_unit_f8b(tid, lds, Q8, K8, VT8, O, op, bh >> 3, bh & 7, qb);
}
#endif
template <int DQK>
__device__ __forceinline__ void attn_phase(int tid, LAS unsigned char* lds, const Tensors& A, int vcu, int G) {
#if FAST_ATTN
    int bh, qb;
    for (int i = 0; next_unit(i, vcu, G, bh, qb); ++i) attn_unit<DQK>(tid, lds, A, bh >> 3, bh & 7, qb);
#else
    (void)lds; attn_phase_ref<DQK>(tid, A, vcu, G);
#endif
}
}


struct Args { const float* in[22]; float* out; unsigned char* ws; int ph_lo, ph_hi; };
struct Frame {
    LAS unsigned char* lds; volatile LAS unsigned* MISC; unsigned* ctl;
    int tid, lane, wave, vcu, G;
    unsigned char* ws; float* OUT;
};

__device__ __forceinline__ void p0_phase(Frame& F, const float* c, const float* w_ada, const float* b_ada) {
    LAS float* cs = (LAS float*)F.lds;
    LAS float* red = (LAS float*)(F.lds + 32768);
    for (int i = F.tid; i < NB * D; i += NTHREADS) { const float v = c[i]; cs[i] = v / (1.f + __expf(-v)); }
    __syncthreads();
    float* mod = (float*)(F.ws + WS_MOD);
    const int kq = F.wave, col = F.lane;
    for (int item = F.vcu; item < NL * 6 * D / 64; item += F.G) {
        const int l = item / (6 * D / 64), n0 = (item % (6 * D / 64)) * 64;
        const float* w = w_ada + (size_t)l * D * 6 * D + n0 + col;
        float acc[NB];
#pragma unroll
        for (int b = 0; b < NB; ++b) acc[b] = 0.f;
#pragma unroll 8
        for (int k = kq * 128; k < kq * 128 + 128; ++k) { const float wv = w[(size_t)k * 6 * D];
#pragma unroll
            for (int b = 0; b < NB; ++b) acc[b] += cs[b * D + k] * wv; }
#pragma unroll
        for (int b = 0; b < NB; ++b) red[(kq * NB + b) * 64 + col] = acc[b];
        __syncthreads();
        { const int b = F.wave; float s = 0.f;
#pragma unroll
          for (int q = 0; q < 8; ++q) s += red[(q * NB + b) * 64 + col];
          mod[((size_t)l * NB + b) * 6 * D + n0 + col] = s + b_ada[(size_t)l * 6 * D + n0 + col]; }
        __syncthreads();
    }
    float* cosA = (float*)(F.ws + WS_COSA); float* sinA = (float*)(F.ws + WS_SINA); float* cosB = (float*)(F.ws + WS_COSB); float* sinB = (float*)(F.ws + WS_SINB);
    for (int idx = F.vcu * NTHREADS + F.tid; idx < S * 48; idx += F.G * NTHREADS) {
        const int s = idx / 48, i = idx % 48; const float row = (float)(s >> 6), col2 = (float)(s & 63);
        if (i < 32) { const int j = i & 15; const float a = (i < 16 ? row : col2) * (1.0f / powf(10000.0f, (float)j / 16.0f)); cosA[s * 32 + i] = cosf(a); sinA[s * 32 + i] = sinf(a); }
        else { const int ii = i - 32, j = ii & 7; const float a = (ii < 8 ? row : col2) * (1.0f / powf(10000.0f, (float)j / 8.0f)); cosB[s * 16 + ii] = cosf(a); sinB[s * 16 + ii] = sinf(a); }
    }
}

template <class SrcFn>
__device__ __forceinline__ void cvt_item(const float* W, int K, int Nsrc, const float* kg, bf16_t* WT, LAS float* scr, int item, int nblk, int lane, const SrcFn& src, float f8scale = 0.f) {
    const int kb = item / nblk, nb = item % nblk, k0 = 64 * kb, n0 = 32 * nb;
    const int sc = src(n0 + (lane & 31));
#pragma unroll
    for (int i = 0; i < 32; ++i) { const int kk = 2 * i + (lane >> 5); float v = sc >= 0 ? W[(size_t)(k0 + kk) * Nsrc + sc] : 0.f; if (kg) v *= kg[k0 + kk]; scr[kk * 33 + (lane & 31)] = v; }
    LDS_WAIT(); asm volatile("" ::: "memory");
    const int c = lane & 7;
    if (f8scale != 0.f) {
#pragma unroll
        for (int j = 0; j < 4; ++j) { const int n = (lane >> 3) + 8 * j; const LAS float* sp = scr + (8 * c) * 33 + n;
            const u32x2 o = pack8_fp8((f32x4){sp[0 * 33], sp[1 * 33], sp[2 * 33], sp[3 * 33]} * f8scale, (f32x4){sp[4 * 33], sp[5 * 33], sp[6 * 33], sp[7 * 33]} * f8scale);
            *(u32x2*)((unsigned char*)WT + (size_t)(n0 + n) * K + k0 + 8 * c) = o; }
    } else {
#pragma unroll
    for (int j = 0; j < 4; ++j) { const int n = (lane >> 3) + 8 * j; const LAS float* s = scr + (8 * c) * 33 + n;
        u32x4 o; o.x = cvt_pk_bf16(s[0 * 33], s[1 * 33]); o.y = cvt_pk_bf16(s[2 * 33], s[3 * 33]); o.z = cvt_pk_bf16(s[4 * 33], s[5 * 33]); o.w = cvt_pk_bf16(s[6 * 33], s[7 * 33]);
        *(u32x4*)(WT + (size_t)(n0 + n) * K + k0 + 8 * c) = o; }
    }
    LDS_WAIT(); asm volatile("" ::: "memory");
}
struct SrcId { __device__ int operator()(int n) const { return n; } };
struct SrcIn { __device__ int operator()(int n) const { return gp::src_col_in(n); } };
typedef __attribute__((address_space(4))) const Args CArgsW;
__device__ __forceinline__ void convert_weights(Frame& F, CArgsW* a, int l) {
    LAS float* scr = (LAS float*)(F.lds + F.wave * 16384);
    const int gw = F.vcu * NWAVES + F.wave, NGW = F.G * NWAVES;
    const float* w_in = ((const float*)(GAS const float*)a->in[5]) + (size_t)l * D * INC; const float* w_q_b = ((const float*)(GAS const float*)a->in[10]) + (size_t)l * 384 * 768; const float* w_kv_b = ((const float*)(GAS const float*)a->in[11]) + (size_t)l * 256 * 1024;
    const float* w_pa = ((const float*)(GAS const float*)a->in[12]) + (size_t)l * 512 * D; const float* w_pb = ((const float*)(GAS const float*)a->in[13]) + (size_t)l * 512 * D; const float* w_o = ((const float*)(GAS const float*)a->in[14]) + (size_t)l * D * D;
    const float* w1 = ((const float*)(GAS const float*)a->in[18]) + (size_t)l * NE * D * FF; const float* w3 = ((const float*)(GAS const float*)a->in[19]) + (size_t)l * NE * D * FF; const float* w2 = ((const float*)(GAS const float*)a->in[20]) + (size_t)l * NE * FF * D;
    const float* gqa = ((const float*)(GAS const float*)a->in[8]) + l * 384; const float* gkv = ((const float*)(GAS const float*)a->in[9]) + l * 256;
    bf16_t* Win = (bf16_t*)(F.ws + WS_WIN); bf16_t* Wqb = (bf16_t*)(F.ws + WS_WQB); bf16_t* Wkvb = (bf16_t*)(F.ws + WS_WKVB); bf16_t* Wpa = (bf16_t*)(F.ws + WS_WPA); bf16_t* Wpb = (bf16_t*)(F.ws + WS_WPB);
    bf16_t* Wo = (bf16_t*)(F.ws + WS_WO); bf16_t* W13 = (bf16_t*)(F.ws + WS_W13); bf16_t* W2 = (bf16_t*)(F.ws + WS_W2);
    constexpr int I_IN = (D / 64) * (NIN / 32), I_QB = (384 / 64) * (768 / 32), I_KVB = (256 / 64) * (1024 / 32), I_P = (512 / 64) * (D / 32), I_O = (D / 64) * (D / 32);
    constexpr int I_13 = (D / 64) * (1024 / 32), I_2 = (FF / 64) * (D / 32);
    constexpr int NITEMS = I_IN + I_QB + I_KVB + 2 * I_P + I_O + NE * (I_13 + I_2);
    for (int it = gw; it < NITEMS; it += NGW) {
        int r = it;
        if (r < I_IN) { cvt_item(w_in, D, INC, nullptr, Win, scr, r, NIN / 32, F.lane, SrcIn(), G1_FP8 ? 16.f : 0.f); continue; } r -= I_IN;
        if (r < I_QB) { cvt_item(w_q_b, 384, 768, gqa, Wqb, scr, r, 768 / 32, F.lane, SrcId()); continue; } r -= I_QB;
        if (r < I_KVB) { cvt_item(w_kv_b, 256, 1024, gkv, Wkvb, scr, r, 1024 / 32, F.lane, SrcId()); continue; } r -= I_KVB;
        if (r < I_P) { cvt_item(w_pa, 512, D, nullptr, Wpa, scr, r, D / 32, F.lane, SrcId(), PROJ_FP8 ? WSCALE : 0.f); continue; } r -= I_P;
        if (r < I_P) { cvt_item(w_pb, 512, D, nullptr, Wpb, scr, r, D / 32, F.lane, SrcId(), PROJ_FP8 ? WSCALE : 0.f); continue; } r -= I_P;
        if (r < I_O) { cvt_item(w_o, D, D, nullptr, Wo, scr, r, D / 32, F.lane, SrcId(), PROJ_FP8 ? WSCALE : 0.f); continue; } r -= I_O;
        if (r < NE * I_13) { const int e = r / I_13, q = r % I_13, nb = q % 32;
            const float* src = ((nb & 7) < 4 ? w1 : w3) + (size_t)e * D * FF; const int cb = (nb >> 3) * 128 + (nb & 3) * 32;
            struct SrcOff { int n0, cb; __device__ int operator()(int n) const { return cb + (n - n0); } } so{nb * 32, cb};
            if (MOE_FP8) cvt_item(src, D, FF, nullptr, (bf16_t*)((unsigned char*)W13 + (size_t)e * 1024 * D), scr, q, 32, F.lane, so, 16.f);
            else cvt_item(src, D, FF, nullptr, W13 + (size_t)e * 1024 * D, scr, q, 32, F.lane, so);
            continue; } r -= NE * I_13;
        { const int e = r / I_2, q = r % I_2;
          if (MOE_FP8) cvt_item(w2 + (size_t)e * FF * D, FF, D, nullptr, (bf16_t*)((unsigned char*)W2 + (size_t)e * D * FF), scr, q, D / 32, F.lane, SrcId(), 16.f);
          else cvt_item(w2 + (size_t)e * FF * D, FF, D, nullptr, W2 + (size_t)e * D * FF, scr, q, D / 32, F.lane, SrcId()); }
    }
}

template <int MODE>
__device__ __forceinline__ void row_phase(Frame& F, const float* xin, const float* g2prev, const float* gain, const float* modl, int sh_off, int sc_off, bf16_t* H, bf16_t* XB, float* OUT) {
    constexpr int RB = 4, RPW = T / (256 * NWAVES);
    const int gw = F.vcu * NWAVES + F.wave, b = (gw * RPW) >> 12;
    const bf16_t* Y2 = (const bf16_t*)(F.ws + WS_Y2);
    f32x4 gs[4], shv[4], g2v[4];
#pragma unroll
    for (int j = 0; j < 4; ++j) { const int c = 4 * F.lane + 256 * j; gs[j] = *(const f32x4*)(gain + c);
        if (MODE != 2) { gs[j] = gs[j] * (1.f + *(const f32x4*)(modl + (size_t)b * 6 * D + sc_off + c)); shv[j] = *(const f32x4*)(modl + (size_t)b * 6 * D + sh_off + c); }
        if (MODE != 0) g2v[j] = *(const f32x4*)(g2prev + (size_t)b * 6 * D + 5 * D + c); }
    for (int m0 = gw * RPW; m0 < gw * RPW + RPW; m0 += RB) {
        f32x4 v[RB][4]; float ss[RB];
        if (MODE == 0) {
#pragma unroll
            for (int r = 0; r < RB; ++r)
#pragma unroll
                for (int j = 0; j < 4; ++j) v[r][j] = *(const f32x4*)(xin + (size_t)(m0 + r) * D + 4 * F.lane + 256 * j);
        } else {
            unsigned ya[RB][4], yb[RB][4];
#pragma unroll
            for (int r = 0; r < RB; ++r)
#pragma unroll
                for (int j = 0; j < 4; ++j) { const int m = m0 + r, c = 4 * F.lane + 256 * j;
                    { const u32x2 xb = *(const u32x2*)(XB + (size_t)m * D + c); v[r][j] = (f32x4){bf2f(xb.x & 0xffffu), bf2f(xb.x >> 16), bf2f(xb.y & 0xffffu), bf2f(xb.y >> 16)}; }
                    ya[r][j] = *(const unsigned*)((const unsigned char*)Y2 + (size_t)(2 * m) * D + c); yb[r][j] = *(const unsigned*)((const unsigned char*)Y2 + (size_t)(2 * m + 1) * D + c); }
#pragma unroll
            for (int r = 0; r < RB; ++r)
#pragma unroll
                for (int j = 0; j < 4; ++j) { const f32x2 a0 = __builtin_amdgcn_cvt_pk_f32_fp8((int)ya[r][j], false), a1 = __builtin_amdgcn_cvt_pk_f32_fp8((int)ya[r][j], true), b0 = __builtin_amdgcn_cvt_pk_f32_fp8((int)yb[r][j], false), b1 = __builtin_amdgcn_cvt_pk_f32_fp8((int)yb[r][j], true);
                    const f32x4 y = (f32x4){a0[0] + b0[0], a0[1] + b0[1], a1[0] + b1[0], a1[1] + b1[1]} * 0.0625f;
                    v[r][j] += g2v[j] * y; }
        }
#pragma unroll
        for (int r = 0; r < RB; ++r) { ss[r] = (gp::dot4(v[r][0]) + gp::dot4(v[r][1])) + (gp::dot4(v[r][2]) + gp::dot4(v[r][3])); }
#pragma unroll
        for (int o = 1; o < 64; o <<= 1)
#pragma unroll
            for (int r = 0; r < RB; ++r) ss[r] += shfl_xor_l(ss[r], F.lane, o);
#pragma unroll
        for (int r = 0; r < RB; ++r) {
            const int m = m0 + r; const float rstd = rsqrtf(ss[r] * (1.f / D) + EPS);
#pragma unroll
            for (int j = 0; j < 4; ++j) {
                const int c = 4 * F.lane + 256 * j;
                if (MODE == 2) { *(f32x4*)(OUT + (size_t)m * D + c) = v[r][j] * rstd * gs[j]; }
                else {
                    { u32x2 xw; xw.x = cvt_pk_bf16(v[r][j][0], v[r][j][1]); xw.y = cvt_pk_bf16(v[r][j][2], v[r][j][3]); st8((XB + (size_t)m * D + c), xw); }
                    const f32x4 hv = v[r][j] * rstd * gs[j] + shv[j];
                    if (G1_FP8) { const f32x4 hq = hv * 0.0625f;
                        *(unsigned*)((unsigned char*)H + (size_t)m * D + c) = (unsigned)__builtin_amdgcn_cvt_pk_fp8_f32(hq[2], hq[3], __builtin_amdgcn_cvt_pk_fp8_f32(hq[0], hq[1], 0, false), true); }
                    else { u32x2 w; w.x = cvt_pk_bf16(hv[0], hv[1]); w.y = cvt_pk_bf16(hv[2], hv[3]);
                    st8((H + (size_t)m * D + c), w); }
                }
            }
        }
    }
}

__device__ __forceinline__ void t2_phase(Frame& F, const float* gain, const float* modl, const float* w_router, const float* rbias, int l, bool record) {
    LAS f32x4* wl = (LAS f32x4*)F.lds;
    LAS int* rec = (LAS int*)(F.lds + 65536);
    LAS float* recw = (LAS float*)(F.lds + 65536 + 2048);
    LAS int* lcnt = (LAS int*)(F.lds + 65536 + 4096);
    for (int idx = F.tid; idx < 4096; idx += NTHREADS) {
        const int lane = idx & 63, c = (idx >> 6) & 3, i = (idx >> 8) & 3, j = idx >> 10; const int k = 4 * lane + 256 * j + i;
        wl[idx] = *(const f32x4*)(w_router + (size_t)k * NE + 4 * c);
    }
    if (F.tid < 32) lcnt[F.tid] = 0;
    __syncthreads();
    constexpr int RB = 4, RPW = T / (256 * NWAVES);
    const int gw = F.vcu * NWAVES + F.wave, bt = (gw * RPW) >> 12;
    bf16_t* H = (bf16_t*)(F.ws + WS_H); const bf16_t* XB = (const bf16_t*)(F.ws + WS_XB);
    const int lane = F.lane, myrow = lane >> 4, mye = lane & 15;
    f32x4 gs[4], shv[4];
#pragma unroll
    for (int j = 0; j < 4; ++j) { const int c = 4 * lane + 256 * j; gs[j] = *(const f32x4*)(gain + c) * (1.f + *(const f32x4*)(modl + (size_t)bt * 6 * D + 4 * D + c)); shv[j] = *(const f32x4*)(modl + (size_t)bt * 6 * D + 3 * D + c); }
    int it = 0;
    for (int m0 = gw * RPW; m0 < gw * RPW + RPW; m0 += RB, ++it) {
        f32x4 v[RB][4]; float ss[RB];
#pragma unroll
        for (int r = 0; r < RB; ++r)
#pragma unroll
            for (int j = 0; j < 4; ++j) { const u32x2 xb = *(const u32x2*)(XB + (size_t)(m0 + r) * D + 4 * lane + 256 * j); v[r][j] = (f32x4){bf2f(xb.x & 0xffffu), bf2f(xb.x >> 16), bf2f(xb.y & 0xffffu), bf2f(xb.y >> 16)}; }
#pragma unroll
        for (int r = 0; r < RB; ++r) ss[r] = (gp::dot4(v[r][0]) + gp::dot4(v[r][1])) + (gp::dot4(v[r][2]) + gp::dot4(v[r][3]));
#pragma unroll
        for (int o = 1; o < 64; o <<= 1)
#pragma unroll
            for (int r = 0; r < RB; ++r) ss[r] += shfl_xor_l(ss[r], F.lane, o);
        float acc[RB * NE];
#pragma unroll
        for (int q = 0; q < RB * NE; ++q) acc[q] = 0.f;
#pragma unroll
        for (int j = 0; j < 4; ++j) {
            const int c = 4 * lane + 256 * j;
#pragma unroll
            for (int r = 0; r < RB; ++r) {
                const int m = m0 + r; const float rstd = rsqrtf(ss[r] * (1.f / D) + EPS);
                v[r][j] = v[r][j] * rstd * gs[j] + shv[j];
#if MOE_FP8
                *(unsigned*)((unsigned char*)H + (size_t)m * D + c) = (unsigned)__builtin_amdgcn_cvt_pk_fp8_f32(v[r][j][2], v[r][j][3], __builtin_amdgcn_cvt_pk_fp8_f32(v[r][j][0], v[r][j][1], 0, false), true);
#else
                u32x2 w; w.x = cvt_pk_bf16(v[r][j][0], v[r][j][1]); w.y = cvt_pk_bf16(v[r][j][2], v[r][j][3]);
                st8((H + (size_t)m * D + c), w);
#endif
            }
#pragma unroll
            for (int i = 0; i < 4; ++i)
#pragma unroll
                for (int c4 = 0; c4 < 4; ++c4) { const f32x4 wv = wl[((j * 4 + i) * 4 + c4) * 64 + lane];
#pragma unroll
                    for (int r = 0; r < RB; ++r) { const float hv = v[r][j][i];
                        acc[r * NE + 4 * c4 + 0] += hv * wv[0]; acc[r * NE + 4 * c4 + 1] += hv * wv[1]; acc[r * NE + 4 * c4 + 2] += hv * wv[2]; acc[r * NE + 4 * c4 + 3] += hv * wv[3]; } }
        }
#pragma unroll
        for (int sft = 32; sft >= 1; sft >>= 1) {
            const bool up = (lane & sft) != 0;
#pragma unroll
            for (int k = 0; k < sft; ++k) { const float a = acc[k], b = acc[k + sft]; const float keep = up ? b : a, send = up ? a : b; acc[k] = keep + shfl_xor_l(send, lane, sft); }
        }
        const float logit = acc[0];
        const float score = 1.f / (1.f + expf(-logit));
        float scv[NE], bi[NE];
#pragma unroll
        for (int e = 0; e < NE; ++e) { scv[e] = shfl_l(score, (lane & 48) | e); bi[e] = scv[e] + rbias[e]; }
        int gsel = 0; float gbest = -INFINITY;
#pragma unroll
        for (int g = 0; g < 4; ++g) { float m1 = -INFINITY, m2 = -INFINITY;
#pragma unroll
            for (int j = 0; j < 4; ++j) { const float x = bi[g * 4 + j]; if (x > m1) { m2 = m1; m1 = x; } else if (x > m2) m2 = x; }
            const float gs = m1 + m2; if (gs > gbest) { gbest = gs; gsel = g; } }
        int e1 = -1, e2 = -1; float b1 = -INFINITY, b2 = -INFINITY, s1 = 0.f, s2 = 0.f;
#pragma unroll
        for (int j = 0; j < 4; ++j) { float x = -INFINITY, sx = 0.f;
#pragma unroll
            for (int g = 0; g < 4; ++g) if (g == gsel) { x = bi[g * 4 + j]; sx = scv[g * 4 + j]; }
            const int e = gsel * 4 + j;
            if (x > b1) { b2 = b1; e2 = e1; s2 = s1; b1 = x; e1 = e; s1 = sx; } else if (x > b2) { b2 = x; e2 = e; s2 = sx; } }
        if (mye == 0) {
            const float inv = 1.f / (s1 + s2); const int slot = (it * RB + myrow) * NWAVES + F.wave;
            rec[slot * 4 + 0] = e1; rec[slot * 4 + 1] = e2;
            rec[slot * 4 + 2] = __hip_atomic_fetch_add(&lcnt[e1], 1, __ATOMIC_RELAXED, __HIP_MEMORY_SCOPE_WORKGROUP);
            rec[slot * 4 + 3] = __hip_atomic_fetch_add(&lcnt[e2], 1, __ATOMIC_RELAXED, __HIP_MEMORY_SCOPE_WORKGROUP);
            recw[slot * 2 + 0] = s1 * inv; recw[slot * 2 + 1] = s2 * inv;
        }
    }
    __syncthreads();
    if (!record) return;
    if (F.tid < NE) lcnt[16 + F.tid] = (int)__hip_atomic_fetch_add(F.ctl + CW_CNT + (l * NE + F.tid) * 64, (unsigned)lcnt[F.tid], __ATOMIC_RELAXED, __HIP_MEMORY_SCOPE_AGENT);
    __syncthreads();
    unsigned* list = (unsigned*)(F.ws + WS_LIST); float* gwb = (float*)(F.ws + WS_GW);
    const int nrows = it * RB;
    for (int s = F.tid; s < nrows * NWAVES; s += NTHREADS) {
        const int i2 = s / NWAVES, w = s % NWAVES; const int m = (F.vcu * NWAVES + w) * RPW + i2;
        const int e1 = rec[s * 4 + 0], e2 = rec[s * 4 + 1];
        list[(size_t)e1 * T + lcnt[16 + e1] + rec[s * 4 + 2]] = (unsigned)(2 * m); list[(size_t)e2 * T + lcnt[16 + e2] + rec[s * 4 + 3]] = (unsigned)(2 * m + 1);
        gwb[2 * m] = recw[s * 2]; gwb[2 * m + 1] = recw[s * 2 + 1];
    }
}
__device__ __forceinline__ LAS int* moe_table(Frame& F, int l) {
    LAS int* tab = (LAS int*)(F.lds + MISC_OFF + 1024);
    __syncthreads();
    if (F.tid == 0) { int acc = 0; int cq[NE];
#pragma unroll
        for (int e = 0; e < NE; ++e) cq[e] = (int)__hip_atomic_load(F.ctl + CW_CNT + (l * NE + e) * 64, __ATOMIC_RELAXED, __HIP_MEMORY_SCOPE_AGENT);
#pragma unroll
        for (int e = 0; e < NE; ++e) { tab[e] = acc; tab[32 + e] = cq[e]; acc += (cq[e] + 255) >> 8; }
        tab[16] = acc; }
    __syncthreads();
    return tab;
}

typedef __attribute__((address_space(4))) const Args CArgs;
__device__ __forceinline__ void xcd_local_barrier(const XcdBarrier& b) {
    asm volatile("s_waitcnt vmcnt(0)" ::: "memory");
    __syncthreads();
    if (threadIdx.x == 0) {
        unsigned* bar = b.bar;
        __builtin_amdgcn_s_waitcnt(0);
        const unsigned nloc = b.st[0];
        const unsigned old = xb_add(&bar[XB_LSUB(b.x)], 1u);
        const unsigned gen = old / nloc;
        if (old + 1u == (gen + 1u) * nloc) xb_add(&bar[XB_LGEN(b.x)], 1u);
        else XB_SPIN(xb_ld(&bar[XB_LGEN(b.x)]) == gen, bar);
        __builtin_amdgcn_fence(__ATOMIC_ACQUIRE, "agent");
        asm volatile("s_waitcnt vmcnt(0)" ::: "memory");
    }
    __syncthreads();
}
#define LAUNDER_GP(T_, p) do { GAS T_* _t = (GAS T_*)(p); asm volatile("" : "+s"(_t)); (p) = (T_*)_t; } while (0)
#define PH_BEGIN() LAUNDER_V(F.tid); F.lane = F.tid & 63; LAUNDER_GP(unsigned, F.ctl); LAUNDER_GP(float, F.OUT); LAUNDER_GP(unsigned char, F.ws); GAS unsigned char* ws = (GAS unsigned char*)F.ws; CArgs* ka = (CArgs*)__builtin_amdgcn_kernarg_segment_ptr(); LAUNDER_S(ka); \
    float* mod = WSP(float, WS_MOD); (void)mod; (void)ka
#define WSP(T_, off) ((T_*)(GAS T_*)(ws + (off)))
#define KIN(i) ((const float*)(GAS const float*)ka->in[i])
__global__ void __launch_bounds__(NTHREADS, 2) fwd_kernel(Args args) {
    extern __shared__ __attribute__((aligned(16))) unsigned char lds_raw[];
    Frame F;
    F.lds = (LAS unsigned char*)lds_raw; F.MISC = (volatile LAS unsigned*)(F.lds + MISC_OFF);
    F.tid = threadIdx.x; F.lane = F.tid & 63; F.wave = __builtin_amdgcn_readfirstlane(F.tid >> 6);
    F.G = gridDim.x; { const int bx = blockIdx.x; F.vcu = (F.G % 8 == 0) ? (bx % 8) * (F.G / 8) + bx / 8 : bx; }
    F.ws = (unsigned char*)(GAS unsigned char*)args.ws; F.ctl = (unsigned*)(GAS unsigned*)(args.ws + WS_CTL); F.OUT = (float*)(GAS float*)args.out;
    if (F.tid < 64) F.MISC[F.tid] = 0u;
    __syncthreads();
    XcdBarrier bar; bar.bar = F.ctl + CW_BAR; bar.x = 0; bar.st = nullptr;
    if (!N_LAUNCH_MODE) bar = xcd_barrier_post(F.ctl + CW_BAR, F.MISC + 8);
    const int lo = args.ph_lo, hi = args.ph_hi;
#define IN(k) (lo <= (k) && (k) < hi)
#define SEAM(k) do { if ((k) + 1 < hi) { if (!N_LAUNCH_MODE) xcd_barrier(bar); } } while (0)
    int cidx = (int)blockIdx.x; bool lseam = false;
#define SEAML(k) do { if ((k) + 1 < hi) { if (!N_LAUNCH_MODE) { if (lseam) xcd_local_barrier(bar); else xcd_barrier(bar); } } } while (0)

    if (IN(0)) { PH_BEGIN(); p0_phase(F, KIN(1), KIN(2), KIN(3)); __syncthreads(); LAUNDER_V(F.tid); F.lane = F.tid & 63; convert_weights(F, ka, 0); SEAM(0);
        if (XCD_LOCAL_SEAMS && !N_LAUNCH_MODE && F.G == 256) {
            bool ok = true;
            for (int j = 0; j < 8; ++j) ok = ok && (xb_ld(F.ctl + CW_BAR + XB_XCNT(j)) == 32u);
            ok = __builtin_amdgcn_readfirstlane(ok ? 1 : 0) != 0;
            if (ok) { const int rk = __builtin_amdgcn_readfirstlane((int)F.MISC[10]), xx = (int)bar.x; F.vcu = xx * 32 + rk; cidx = rk * 8 + xx; lseam = true; } } }
    for (int l = 0; l < NL; ++l) {
        const int pb = 1 + 9 * l;
        if (IN(pb + 0)) {
            PH_BEGIN();
            if (l > 0) for (int rep = 0; rep < ((PROBE_DUP & 8) ? 2 : 1); ++rep) { LAUNDER_V(F.tid); F.lane = F.tid & 63; convert_weights(F, ka, l); }
            if (l == 0) row_phase<0>(F, KIN(0), nullptr, KIN(4) + l * D, mod + (size_t)l * NB * 6 * D, 0, D, WSP(bf16_t, WS_H), WSP(bf16_t, WS_XB), nullptr);
            else row_phase<1>(F, nullptr, mod + (size_t)(l - 1) * NB * 6 * D, KIN(4) + l * D, mod + (size_t)l * NB * 6 * D, 0, D, WSP(bf16_t, WS_H), WSP(bf16_t, WS_XB), nullptr);
            SEAM(pb + 0);
        }
        if (IN(pb + 1)) {
            PH_BEGIN();
            gp::Gemm g{WSP(bf16_t, WS_H), WSP(const bf16_t, WS_WIN), G1_FP8 ? D / 2 : D, 0, nullptr, 0, 0, 0}; gp::DenseOrder So; So.init(T, NIN, F.G, cidx); if (GATES_LATE) So.window(0, 6, 0, 1 << 20);
            gp::EpiIn E{WSP(bf16_t, ATT_FP8_A ? WS_QA8 : WS_QA), WSP(bf16_t, ATT_FP8_A ? WS_KA8 : WS_KA), WSP(bf16_t, ATT_FP8_A ? WS_VTA8 : WS_VA), WSP(bf16_t, WS_QLAT), WSP(bf16_t, WS_KVLAT), WSP(bf16_t, ATT_FP8_B ? WS_KB8 : WS_KB), WSP(bf16_t, WS_SA), WSP(bf16_t, WS_SB), WSP(float, WS_SSQ), WSP(float, WS_SSKV),
                        KIN(6) + l * 64, KIN(7) + l * 64, WSP(const float, WS_COSA), WSP(const float, WS_SINA), WSP(const float, WS_COSB), WSP(const float, WS_SINB)};
            if (PROBE_DUP & 128) { gp::EpiNull En; gp::gemm_phase<gp::EpiNull, gp::DenseOrder>(F.tid, F.lds, g, So, En); LAUNDER_V(F.tid); }
            gp::gemm_phase<gp::EpiIn, gp::DenseOrder, false, G1_FP8 != 0>(F.tid, F.lds, g, So, E); if (PROBE_DUP & (2 | 512)) { LAUNDER_V(F.tid); gp::gemm_phase<gp::EpiIn, gp::DenseOrder, false, G1_FP8 != 0>(F.tid, F.lds, g, So, E); }
            SEAML(pb + 1);
        }
        if (IN(pb + 2)) {
            { PH_BEGIN(); gp::Gemm g{WSP(bf16_t, WS_QLAT), WSP(const bf16_t, WS_WQB), 384, 0, nullptr}; gp::DenseOrder So; So.init(T, 768, F.G, cidx);
              gp::EpiQb E{WSP(bf16_t, ATT_FP8_B ? WS_QB8 : WS_QB), WSP(const float, WS_SSQ), WSP(const float, WS_COSB), WSP(const float, WS_SINB)}; gp::gemm_phase<gp::EpiQb, gp::DenseOrder>(F.tid, F.lds, g, So, E); if (PROBE_DUP & 2) { LAUNDER_V(F.tid); gp::gemm_phase<gp::EpiQb, gp::DenseOrder>(F.tid, F.lds, g, So, E); } }
            { PH_BEGIN(); gp::Gemm g{WSP(bf16_t, WS_KVLAT), WSP(const bf16_t, WS_WKVB), 256, 0, nullptr}; gp::DenseOrder So; So.init(T, 1024, F.G, cidx);
              gp::EpiKvb E{WSP(bf16_t, ATT_FP8_B ? WS_KB8 : WS_KB), WSP(bf16_t, ATT_FP8_B ? WS_VTB8 : WS_VB), WSP(const float, WS_SSKV)}; gp::gemm_phase<gp::EpiKvb, gp::DenseOrder>(F.tid, F.lds, g, So, E); if (PROBE_DUP & 2) { LAUNDER_V(F.tid); gp::gemm_phase<gp::EpiKvb, gp::DenseOrder>(F.tid, F.lds, g, So, E); } }
#if FAST_ATTN && ATT_FP8_A
            { PH_BEGIN(); at::attn_phase_f8a(F.tid, F.lds, WSP(const unsigned char, WS_QA8), WSP(const unsigned char, WS_KA8), WSP(const unsigned char, WS_VTA8), WSP(bf16_t, WS_QA), 512, KIN(6) + l * 64, KIN(7) + l * 64, F.vcu, F.G); }
            if (PROBE_DUP & (1 | 4096)) { PH_BEGIN(); at::attn_phase_f8a(F.tid, F.lds, WSP(const unsigned char, WS_QA8), WSP(const unsigned char, WS_KA8), WSP(const unsigned char, WS_VTA8), WSP(bf16_t, WS_QA), 512, KIN(6) + l * 64, KIN(7) + l * 64, F.vcu, F.G); }
#else
            { PH_BEGIN(); const at::Tensors A{WSP(bf16_t, WS_QA), 512, WSP(bf16_t, WS_KA), 128, WSP(bf16_t, WS_VA), 128, WSP(bf16_t, WS_QA), 512, 4}; at::attn_phase<64>(F.tid, F.lds, A, F.vcu, F.G); }
#endif
            SEAML(pb + 2);
        }
        if (IN(pb + 3)) {
            PH_BEGIN();
#if FAST_ATTN && ATT_FP8_B
            at::attn_phase_f8b(F.tid, F.lds, WSP(const unsigned char, WS_QB8), WSP(const unsigned char, WS_KB8), WSP(const unsigned char, WS_VTB8), WSP(bf16_t, WS_OB), 512, F.vcu, F.G);
            if (PROBE_DUP & (1 | 8192)) { LAUNDER_V(F.tid); at::attn_phase_f8b(F.tid, F.lds, WSP(const unsigned char, WS_QB8), WSP(const unsigned char, WS_KB8), WSP(const unsigned char, WS_VTB8), WSP(bf16_t, WS_OB), 512, F.vcu, F.G); }
#else
            const at::Tensors A{WSP(bf16_t, WS_QB), 768, WSP(bf16_t, WS_KB), 768, WSP(bf16_t, WS_VB), 512, WSP(bf16_t, WS_OB), 512, 1}; for (int rep = 0; rep < ((PROBE_DUP & 1) ? 2 : 1); ++rep) at::attn_phase<96>(F.tid, F.lds, A, F.vcu, F.G);
#endif
            SEAML(pb + 3);
        }
        if (IN(pb + 4)) {
#define LBAR() do { if (!N_LAUNCH_MODE) { if (lseam) xcd_local_barrier(bar); else xcd_barrier(bar); } } while (0)
#if GATES_LATE
            { PH_BEGIN();
              gp::Gemm g{WSP(bf16_t, WS_H), WSP(const bf16_t, WS_WIN), G1_FP8 ? D / 2 : D, 0, nullptr, 0, 0, 0}; gp::DenseOrder So; So.init(T, NIN, F.G, cidx); So.window(6, 8, 0, 1 << 20);
              gp::EpiIn E{WSP(bf16_t, ATT_FP8_A ? WS_QA8 : WS_QA), WSP(bf16_t, ATT_FP8_A ? WS_KA8 : WS_KA), WSP(bf16_t, ATT_FP8_A ? WS_VTA8 : WS_VA), WSP(bf16_t, WS_QLAT), WSP(bf16_t, WS_KVLAT), WSP(bf16_t, ATT_FP8_B ? WS_KB8 : WS_KB), WSP(bf16_t, WS_SA), WSP(bf16_t, WS_SB), WSP(float, WS_SSQ), WSP(float, WS_SSKV),
                          KIN(6) + l * 64, KIN(7) + l * 64, WSP(const float, WS_COSA), WSP(const float, WS_SINA), WSP(const float, WS_COSB), WSP(const float, WS_SINB)};
              gp::gemm_phase<gp::EpiIn, gp::DenseOrder, false, G1_FP8 != 0>(F.tid, F.lds, g, So, E); }
            LBAR();
            { PH_BEGIN();
              gp::Gemm g{WSP(bf16_t, WS_QA), WSP(const bf16_t, WS_WPA), PROJ_FP8 ? 256 : 512, (size_t)(WS_WPB - WS_WPA) / 2, nullptr, (size_t)(WS_OB - WS_QA) / 2, 0, 0}; gp::PairOrder So; So.init(T, D, F.G, cidx);
              gp::EpiProjP E{WSP(bf16_t, WS_H), WSP(const unsigned char, WS_SA), WSP(const unsigned char, WS_SB)};
              gp::gemm_phase<gp::EpiProjP, gp::PairOrder, false, PROJ_FP8 != 0>(F.tid, F.lds, g, So, E); }
#else
            PH_BEGIN();
            gp::Gemm g{WSP(bf16_t, WS_QA), WSP(const bf16_t, WS_WPA), PROJ_FP8 ? 256 : 512, (size_t)(WS_WPB - WS_WPA) / 2, nullptr, (size_t)(WS_OB - WS_QA) / 2, 0, 0}; gp::PairOrder So; So.init(T, D, F.G, cidx);
            gp::EpiProjP E{WSP(bf16_t, WS_H), WSP(const unsigned char, WS_SA), WSP(const unsigned char, WS_SB)};
            gp::gemm_phase<gp::EpiProjP, gp::PairOrder, false, PROJ_FP8 != 0>(F.tid, F.lds, g, So, E);
            if (PROBE_DUP & (2 | 1024)) { LAUNDER_V(F.tid); gp::gemm_phase<gp::EpiProjP, gp::PairOrder, false, PROJ_FP8 != 0>(F.tid, F.lds, g, So, E); }
#endif
            SEAML(pb + 4);
        }
        if (IN(pb + 5)) {
            PH_BEGIN();
            gp::Gemm g{WSP(bf16_t, WS_H), WSP(const bf16_t, WS_WO), PROJ_FP8 ? D / 2 : D, 0, nullptr, 0, 0, 0}; gp::DenseOrder So; So.init(T, D, F.G, cidx);
            if (PROBE_DUP & 2048) { gp::EpiNull En; gp::gemm_phase<gp::EpiNull, gp::DenseOrder>(F.tid, F.lds, g, So, En); LAUNDER_V(F.tid); }
            gp::EpiWo E{WSP(const bf16_t, WS_XB), mod + (size_t)l * NB * 6 * D, WSP(bf16_t, WS_XB)}; gp::gemm_phase<gp::EpiWo, gp::DenseOrder, false, PROJ_FP8 != 0>(F.tid, F.lds, g, So, E);
            SEAML(pb + 5);
        }
        if (IN(pb + 6)) {
            PH_BEGIN();
            if (PROBE_DUP & 16) { t2_phase(F, KIN(15) + l * D, mod + (size_t)l * NB * 6 * D, KIN(16), KIN(17), l, false); LAUNDER_V(F.tid); F.lane = F.tid & 63; __syncthreads(); }
            t2_phase(F, KIN(15) + l * D, mod + (size_t)l * NB * 6 * D, KIN(16), KIN(17), l, true);
            SEAM(pb + 6);
        }
        if (IN(pb + 7)) {
            PH_BEGIN();
            LAS int* tab = moe_table(F, l);
#if MOE_FP8
            gp::Gemm g{WSP(bf16_t, WS_H), WSP(const bf16_t, WS_W13), D / 2, (size_t)1024 * D / 2, WSP(const unsigned, WS_LIST), 0, 0, 0}; gp::MoeOrder So; So.init(tab, F.G, cidx); if (lseam) So.handoff(F.ctl + CW_TILE + l * 512, 1);
            gp::EpiUp E{WSP(bf16_t, WS_ACT), 1.f / 16.f}; gp::gemm_phase<gp::EpiUp, gp::MoeOrder, true, true>(F.tid, F.lds, g, So, E);
            if (PROBE_DUP & 4) { LAUNDER_V(F.tid); gp::gemm_phase<gp::EpiUp, gp::MoeOrder, true, true>(F.tid, F.lds, g, So, E); }
#else
            gp::Gemm g{WSP(bf16_t, WS_H), WSP(const bf16_t, WS_W13), D, (size_t)1024 * D, WSP(const unsigned, WS_LIST)}; gp::MoeOrder So; So.init(tab, F.G, cidx);
            gp::EpiUp E{WSP(bf16_t, WS_ACT), 1.f}; gp::gemm_phase<gp::EpiUp, gp::MoeOrder, true>(F.tid, F.lds, g, So, E);
#endif
            if (!lseam) SEAML(pb + 7);
        }
        if (IN(pb + 8)) {
            PH_BEGIN();
            LAS int* tab = (lseam && IN(pb + 7)) ? (LAS int*)(F.lds + MISC_OFF + 1024) : moe_table(F, l);
#if MOE_FP8
            gp::Gemm g{WSP(bf16_t, WS_ACT), WSP(const bf16_t, WS_W2), FF / 2, (size_t)D * FF / 2, nullptr, 0, 0, 0}; gp::MoeOrder So; So.init(tab, F.G, cidx); if (lseam) So.handoff(F.ctl + CW_TILE + l * 512, 2);
            gp::EpiDown E{WSP(bf16_t, WS_Y2), WSP(const unsigned, WS_LIST), WSP(const float, WS_GW), 1.f / 128.f}; gp::gemm_phase<gp::EpiDown, gp::MoeOrder, false, true>(F.tid, F.lds, g, So, E);
            if (PROBE_DUP & 4) { LAUNDER_V(F.tid); gp::gemm_phase<gp::EpiDown, gp::MoeOrder, false, true>(F.tid, F.lds, g, So, E); }
#else
            gp::Gemm g{WSP(bf16_t, WS_ACT), WSP(const bf16_t, WS_W2), FF, (size_t)D * FF, nullptr}; gp::MoeOrder So; So.init(tab, F.G, cidx);
            gp::EpiDown E{WSP(bf16_t, WS_Y2), WSP(const unsigned, WS_LIST), WSP(const float, WS_GW), 1.f}; gp::gemm_phase<gp::EpiDown, gp::MoeOrder, false>(F.tid, F.lds, g, So, E);
#endif
            SEAM(pb + 8);
        }
    }
    if (IN(NPHASE - 1)) { PH_BEGIN(); row_phase<2>(F, nullptr, mod + (size_t)(NL - 1) * NB * 6 * D, KIN(21), nullptr, 0, 0, nullptr, WSP(bf16_t, WS_XB), F.OUT); }
#undef IN
#undef SEAM
#undef SEAML
}

extern "C" void kernel_launch(void* const* d_in, const int* in_sizes, int n_in, void* d_out, int out_size, void* d_ws, size_t ws_size, hipStream_t stream) {
    static int grid = 0;
    if (grid == 0) {
        if (n_in != 22 || out_size != T * D || ws_size < WS_END) { fprintf(stderr, "kernel_launch: unexpected problem (n_in %d out %d ws %zu)\n", n_in, out_size, ws_size); grid = -1; return; }
        int dev = 0, cus = 0, per_cu = 0;
        if (hipGetDevice(&dev) != hipSuccess || hipDeviceGetAttribute(&cus, hipDeviceAttributeMultiprocessorCount, dev) != hipSuccess) { grid = -1; return; }
        if (hipFuncSetAttribute((const void*)fwd_kernel, hipFuncAttributeMaxDynamicSharedMemorySize, LDS_BYTES) != hipSuccess) { grid = -1; return; }
        if (hipOccupancyMaxActiveBlocksPerMultiprocessor(&per_cu, (const void*)fwd_kernel, NTHREADS, LDS_BYTES) != hipSuccess || per_cu < 1) { fprintf(stderr, "kernel_launch: occupancy query says %d\n", per_cu); }
        (void)hipGetLastError();
        grid = cus;
        if (grid != 256 || T % (grid * NWAVES * 4) != 0) {   fprintf(stderr, "kernel_launch: grid %d does not divide the row phases\n", grid); grid = -1; return; }
    }
    if (grid < 0) return;
    (void)hipMemsetAsync((char*)d_ws + WS_CTL, 0, CTL_BYTES, stream);
    Args a{};
    for (int i = 0; i < 22; ++i) a.in[i] = (const float*)d_in[i];
    a.out = (float*)d_out; a.ws = (unsigned char*)d_ws;
#if N_LAUNCH_MODE
    for (int p = 0; p < NPHASE; ++p) { a.ph_lo = p; a.ph_hi = p + 1; hipLaunchKernelGGL(fwd_kernel, dim3(grid), dim3(NTHREADS), LDS_BYTES, stream, a); }
#else
    a.ph_lo = 0; a.ph_hi = NPHASE;
    hipLaunchKernelGGL(fwd_kernel, dim3(grid), dim3(NTHREADS), LDS_BYTES, stream, a);
#endif
}
```
